# Optimizing an MI355X kernel written in HIP

```python
import math
import jax
import jax.numpy as jnp
from jax import lax
import numpy as np

D_MODEL = 1024
BATCH = 8
SEQ = 4096
DEPTH = 2

GRID_W = 64
CTX_LEN = 256
NORM_EPS = 1e-6
ROPE_BASE = 10000.0
NEG_INF = -1e30

NA_HEADS = 4
NA_DIM = 64
NA_WIN_ROWS = 8
NA_WIN_COLS = 16
NA_QCOLS = 16
NA_KCOLS = 32
DIFF_HEADS = 4
DIFF_DIM = 32
DIFF_VDIM = 2 * DIFF_DIM
DIFF_QBLOCK = 128
RET_HEADS = 4
RET_QK = 64
RET_V = 128
RET_CHUNK = 128

NA_W = NA_HEADS * NA_DIM
DIFF_QK_W = DIFF_HEADS * 2 * DIFF_DIM
DIFF_W = DIFF_HEADS * DIFF_VDIM
RET_QK_W = RET_HEADS * RET_QK
RET_W = RET_HEADS * RET_V
MIX_W = NA_W + DIFF_W + RET_W
IN_SPLITS = (NA_W, NA_W, NA_W, DIFF_QK_W, DIFF_QK_W, DIFF_W, RET_QK_W, RET_QK_W, RET_W, RET_W)
IN_COLS = 3 * NA_W + 2 * DIFF_QK_W + DIFF_W + 2 * RET_QK_W + 2 * RET_W

PEER_HEADS = 8
PEER_NKEYS = 128
PEER_EXPERTS = PEER_NKEYS * PEER_NKEYS
PEER_KDIM = 256
PEER_TOPK = 16
PEER_CHUNK = 128

kernel_name = "hybrid_natten_diffattn_retnet_peer_dit"


def _rms(x):
    xf = x.astype(jnp.float32)
    return xf * lax.rsqrt(jnp.mean(xf * xf, axis=-1, keepdims=True) + NORM_EPS)


def rmsnorm(x, g):
    return _rms(x) * g.astype(jnp.float32)


def split_cols(p):
    out = []
    o = 0
    for s in IN_SPLITS:
        out.append(p[..., o:o + s])
        o += s
    return out


def split_heads(t, h):
    b, l, _ = t.shape
    return t.reshape(b, l, h, -1).transpose(0, 2, 1, 3)


def merge_heads(t):
    b, h, l, d = t.shape
    return t.transpose(0, 2, 1, 3).reshape(b, l, h * d)


def diff_split(t):
    b, l, _ = t.shape
    return t.reshape(b, l, DIFF_HEADS, 2, DIFF_DIM).transpose(0, 2, 3, 1, 4)


def flip_seq(t):
    return jnp.flip(t, axis=2)


def axial_rope_tables(n_tokens, dim):
    t = jnp.arange(n_tokens)
    rows = (t // GRID_W).astype(jnp.float32)
    cols = (t % GRID_W).astype(jnp.float32)
    half = dim // 2
    inv = jnp.power(ROPE_BASE, -jnp.arange(0, half, 2, dtype=jnp.float32) / half)
    ang = jnp.concatenate([rows[:, None] * inv, cols[:, None] * inv], axis=-1)
    return jnp.cos(ang), jnp.sin(ang)


def apply_rope(x, cos, sin):
    xf = x.astype(jnp.float32).reshape(x.shape[:-1] + (x.shape[-1] // 2, 2))
    x1, x2 = xf[..., 0], xf[..., 1]
    out = jnp.stack([x1 * cos - x2 * sin, x1 * sin + x2 * cos], axis=-1)
    return out.reshape(x.shape)


def dense_attention(q, k, v):
    s = jnp.einsum('bhqd,bhkd->bhqk', q.astype(jnp.float32), k.astype(jnp.float32)) * q.shape[-1] ** -0.5
    p = jax.nn.softmax(s, axis=-1)
    return jnp.einsum('bhqk,bhkd->bhqd', p, v.astype(jnp.float32))


def neighbourhood_attention(q, k, v, kc, vc, rpb):
    b, h, l, d = q.shape
    f32 = jnp.float32
    rows = l // GRID_W
    wr = min(NA_WIN_ROWS, rows)
    r = np.arange(rows)
    row_idx = np.clip(r - wr // 2, 0, rows - wr)[:, None] + np.arange(wr)[None, :]
    dr = row_idx - r[:, None] + (NA_WIN_ROWS - 1)
    qg = q.astype(f32).reshape(b, h, rows, GRID_W, d) * d ** -0.5
    kband = k.reshape(b, h, rows, GRID_W, d)[:, :, row_idx]
    vband = v.reshape(b, h, rows, GRID_W, d)[:, :, row_idx]
    kc = kc.astype(f32)
    vc = vc.astype(f32)
    rpb = rpb.astype(f32)
    n_win = wr * NA_KCOLS
    outs = []
    for j in range(GRID_W // NA_QCOLS):
        q0 = j * NA_QCOLS
        k0 = min(max(q0 - (NA_KCOLS - NA_QCOLS) // 2, 0), GRID_W - NA_KCOLS)
        qcol = q0 + np.arange(NA_QCOLS)
        kcol = k0 + np.arange(NA_KCOLS)
        cs = np.clip(qcol - NA_WIN_COLS // 2, 0, GRID_W - NA_WIN_COLS)
        valid = (kcol[None, :] >= cs[:, None]) & (kcol[None, :] < cs[:, None] + NA_WIN_COLS)
        dc = np.clip(kcol[None, :] - qcol[:, None], 1 - NA_WIN_COLS, NA_WIN_COLS - 1) + NA_WIN_COLS - 1
        bias = rpb[:, dr[:, None, :, None], dc[None, :, None, :]]
        bias = jnp.where(valid[None, None, :, None, :], bias, NEG_INF).reshape(h, rows, NA_QCOLS, n_win)
        qb = qg[:, :, :, q0:q0 + NA_QCOLS]
        kb = kband[:, :, :, :, k0:k0 + NA_KCOLS].reshape(b, h, rows, n_win, d).astype(f32)
        vb = vband[:, :, :, :, k0:k0 + NA_KCOLS].reshape(b, h, rows, n_win, d).astype(f32)
        s = jnp.concatenate([jnp.einsum('bhrqd,bhrkd->bhrqk', qb, kb) + bias[None],
                             jnp.einsum('bhrqd,bhkd->bhrqk', qb, kc)], axis=-1)
        p = jax.nn.softmax(s, axis=-1)
        o = (jnp.einsum('bhrqk,bhrkd->bhrqd', p[..., :n_win], vb)
             + jnp.einsum('bhrqk,bhkd->bhrqd', p[..., n_win:], vc))
        outs.append(o)
    return jnp.concatenate(outs, axis=3).reshape(b, h, l, d)


def diff_attend(q, k, v, lam):
    s = jnp.einsum('bhcqd,bhckd->bhcqk', q.astype(jnp.float32), k.astype(jnp.float32)) * DIFF_DIM ** -0.5
    p = jax.nn.softmax(s, axis=-1)
    a = p[:, :, 0] - lam * p[:, :, 1]
    return jnp.einsum('bhqk,bhkd->bhqd', a, v.astype(jnp.float32))


def diff_attention_blocks(q, k_all, v_all, lam):
    b, h, _, l, d = q.shape
    nb = l // DIFF_QBLOCK
    qb = q.reshape(b, h, 2, nb, DIFF_QBLOCK, d).transpose(3, 0, 1, 2, 4, 5)
    o = lax.map(lambda qq: diff_attend(qq, k_all, v_all, lam), qb)
    return o.transpose(1, 2, 0, 3, 4).reshape(b, h, l, -1)


def diff_post(o, g, lam_init):
    return rmsnorm(o, g) * (1.0 - lam_init)


def retention_chunked(q, k, v, log_g, s0):
    f32 = jnp.float32
    b, h, l, dk = q.shape
    dv = v.shape[-1]
    c = RET_CHUNK
    n = l // c
    i = jnp.arange(c, dtype=f32)
    diff = i[:, None] - i[None, :]
    dmask = jnp.where(diff >= 0, jnp.exp(log_g[:, None, None] * jnp.maximum(diff, 0.0)), 0.0)
    q_dec = jnp.exp(log_g[:, None] * (i + 1.0)[None, :])
    k_dec = jnp.exp(log_g[:, None] * (c - 1.0 - i)[None, :])
    c_dec = jnp.exp(log_g * c)
    qc = q.astype(f32).reshape(b, h, n, c, dk)
    kc = k.astype(f32).reshape(b, h, n, c, dk)
    vc = v.astype(f32).reshape(b, h, n, c, dv)
    att = jnp.einsum('bhnid,bhnjd->bhnij', qc, kc) * dmask[None, :, None]
    o = jnp.einsum('bhnij,bhnje->bhnie', att, vc)
    kv = jnp.einsum('bhnjd,bhnje->bhnde', kc * k_dec[None, :, None, :, None], vc)

    def step(state, kv_c):
        return c_dec[None, :, None, None] * state + kv_c, state

    s_final, s_prev = lax.scan(step, s0.astype(f32), jnp.moveaxis(kv, 2, 0))
    s_prev = jnp.moveaxis(s_prev, 0, 2)
    o = o + jnp.einsum('bhnid,bhnde->bhnie', qc * q_dec[None, :, None, :, None], s_prev)
    return o.reshape(b, h, l, dv), s_final


def retention_final_state(k, v, log_g, reverse):
    l = k.shape[2]
    m = jnp.arange(l, dtype=jnp.float32)
    expo = m if reverse else (l - 1.0 - m)
    w = jnp.exp(log_g[:, None] * expo[None, :])
    return jnp.einsum('bhld,bhle->bhde', k.astype(jnp.float32) * w[None, :, :, None], v.astype(jnp.float32))


def retention_post(y, g):
    return merge_heads(_rms(y)) * jax.nn.silu(g.astype(jnp.float32))


def token_mixers(px, pc, rpb, lam_p, subln_g, decay_logit, layer_idx, rope_d, rope_r, need_ctx):
    f32 = jnp.float32
    na_q, na_k, na_v, df_q, df_k, df_v, rt_q, rt_k, rt_v, rt_g = px
    cna_q, cna_k, cna_v, cdf_q, cdf_k, cdf_v, crt_q, crt_k, crt_v, crt_g = pc
    b = na_q.shape[0]
    kc_na = split_heads(cna_k, NA_HEADS)
    vc_na = split_heads(cna_v, NA_HEADS)
    y_na = neighbourhood_attention(split_heads(na_q, NA_HEADS), split_heads(na_k, NA_HEADS),
                                   split_heads(na_v, NA_HEADS), kc_na, vc_na, rpb)
    lam_init = 0.8 - 0.6 * math.exp(-0.3 * layer_idx)
    lp = lam_p.astype(f32)
    lam = jnp.exp(jnp.sum(lp[0] * lp[1])) - jnp.exp(jnp.sum(lp[2] * lp[3])) + lam_init
    cos_d, sin_d = rope_d
    q_df = apply_rope(diff_split(df_q), cos_d, sin_d)
    k_df = apply_rope(diff_split(df_k), cos_d, sin_d)
    kc_df = diff_split(cdf_k).astype(f32)
    vc_df = split_heads(cdf_v, DIFF_HEADS).astype(f32)
    k_all = jnp.concatenate([kc_df, k_df], axis=3)
    v_all = jnp.concatenate([vc_df, split_heads(df_v, DIFF_HEADS).astype(f32)], axis=2)
    y_df = diff_post(diff_attention_blocks(q_df, k_all, v_all, lam), subln_g, lam_init)
    lg = jax.nn.log_sigmoid(decay_logit.astype(f32))
    cos_r, sin_r = rope_r
    q_rt = apply_rope(split_heads(rt_q, RET_HEADS), cos_r, sin_r)
    k_rt = apply_rope(split_heads(rt_k, RET_HEADS), cos_r, sin_r) * RET_QK ** -0.5
    v_rt = split_heads(rt_v, RET_HEADS).astype(f32)
    kc_rt = split_heads(crt_k, RET_HEADS).astype(f32) * RET_QK ** -0.5
    vc_rt = split_heads(crt_v, RET_HEADS).astype(f32)
    if need_ctx:
        z = jnp.zeros((b, RET_HEADS, RET_QK, RET_V), f32)
        qc_rt = split_heads(crt_q, RET_HEADS).astype(f32)
        oc_f, s_f = retention_chunked(qc_rt, kc_rt, vc_rt, lg[0], z)
        oc_b, s_b = retention_chunked(flip_seq(qc_rt), flip_seq(kc_rt), flip_seq(vc_rt), lg[1], z)
        yc_rt = retention_post(oc_f + flip_seq(oc_b), crt_g)
    else:
        s_f = retention_final_state(kc_rt, vc_rt, lg[0], False)
        s_b = retention_final_state(kc_rt, vc_rt, lg[1], True)
    o_f, _ = retention_chunked(q_rt, k_rt, v_rt, lg[0], s_f)
    o_b, _ = retention_chunked(flip_seq(q_rt), flip_seq(k_rt), flip_seq(v_rt), lg[1], s_b)
    y_rt = retention_post(o_f + flip_seq(o_b), rt_g)
    y_lat = jnp.concatenate([merge_heads(y_na), merge_heads(y_df), y_rt], axis=-1)
    if not need_ctx:
        return y_lat, None
    yc_na = dense_attention(split_heads(cna_q, NA_HEADS), kc_na, vc_na)
    yc_df = diff_post(diff_attend(diff_split(cdf_q), kc_df, vc_df, lam), subln_g, lam_init)
    y_ctx = jnp.concatenate([merge_heads(yc_na), merge_heads(yc_df), yc_rt], axis=-1)
    return y_lat, y_ctx


def peer(h, wq, subkeys, u, v):
    t, d = h.shape
    q = (h @ wq).astype(jnp.float32).reshape(t, PEER_HEADS, 2, PEER_KDIM // 2)
    s = jnp.einsum('thpd,hpnd->thpn', q, subkeys.astype(jnp.float32))
    s_top, i_top = lax.top_k(s, PEER_TOPK)
    cand = (s_top[:, :, 0, :, None] + s_top[:, :, 1, None, :]).reshape(t, PEER_HEADS, PEER_TOPK * PEER_TOPK)
    cand_idx = (i_top[:, :, 0, :, None] * PEER_NKEYS + i_top[:, :, 1, None, :]).reshape(t, PEER_HEADS, -1)
    best, pos = lax.top_k(cand, PEER_TOPK)
    expert = jnp.take_along_axis(cand_idx, pos, axis=-1)
    gate = jax.nn.softmax(best, axis=-1)
    nchunk = t // PEER_CHUNK

    def eval_chunk(args):
        hc, ec, gc = args
        a = jax.nn.gelu(jnp.einsum('cd,chkd->chk', hc, u[ec]).astype(jnp.float32), approximate=False)
        w = (gc * a).astype(v.dtype)
        return jnp.einsum('chk,chkd->cd', w, v[ec])

    out = lax.map(eval_chunk, (h.reshape(nchunk, PEER_CHUNK, d),
                               expert.reshape(nchunk, PEER_CHUNK, PEER_HEADS, PEER_TOPK),
                               gate.reshape(nchunk, PEER_CHUNK, PEER_HEADS, PEER_TOPK)))
    return out.reshape(t, d)


def setup_inputs(seed: int = 0) -> dict:
    key = jax.random.key(seed)
    ks = jax.random.split(key, 20)
    f32 = jnp.float32
    nrm = jax.random.normal
    d = D_MODEL
    x = nrm(ks[0], (BATCH, SEQ, d), f32)
    c = nrm(ks[1], (BATCH, d), f32)
    ctx = nrm(ks[2], (BATCH, CTX_LEN, d), f32)
    c_ctx = nrm(ks[3], (d,), f32)
    w_ada = nrm(ks[4], (DEPTH, d, 6 * d), f32) * (0.5 * d ** -0.5)
    b_ada = 0.02 * nrm(ks[5], (DEPTH, 6 * d), f32)
    norm1_g = 1.0 + 0.02 * nrm(ks[6], (DEPTH, d), f32)
    w_in = nrm(ks[7], (DEPTH, d, IN_COLS), f32) * d ** -0.5
    na_rpb = 0.1 * nrm(ks[8], (DEPTH, NA_HEADS, 2 * NA_WIN_ROWS - 1, 2 * NA_WIN_COLS - 1), f32)
    diff_lambda = 0.1 * nrm(ks[9], (DEPTH, 4, DIFF_DIM), f32)
    diff_subln_g = 1.0 + 0.02 * nrm(ks[10], (DEPTH, DIFF_VDIM), f32)
    base_logit = jnp.log(jnp.power(2.0, 5.0 + jnp.arange(RET_HEADS, dtype=f32)) - 1.0)
    ret_decay_logit = base_logit + 0.1 * nrm(ks[11], (DEPTH, 2, RET_HEADS), f32)
    w_out = nrm(ks[12], (DEPTH, MIX_W, d), f32) * MIX_W ** -0.5
    norm2_g = 1.0 + 0.02 * nrm(ks[13], (DEPTH, d), f32)
    peer_wq = nrm(ks[14], (DEPTH, d, PEER_HEADS * PEER_KDIM), f32) * d ** -0.5
    peer_subkeys = nrm(ks[15], (DEPTH, PEER_HEADS, 2, PEER_NKEYS, PEER_KDIM // 2), f32) * (PEER_KDIM // 2) ** -0.5
    peer_u = nrm(ks[16], (DEPTH, PEER_EXPERTS, d), f32) * d ** -0.5
    peer_v = nrm(ks[17], (DEPTH, PEER_EXPERTS, d), f32) * PEER_HEADS ** -0.5
    final_g = 1.0 + 0.02 * nrm(ks[18], (d,), f32)
    return {"x": x, "c": c, "ctx": ctx, "c_ctx": c_ctx, "w_ada": w_ada, "b_ada": b_ada,
            "norm1_g": norm1_g, "w_in": w_in, "na_rpb": na_rpb, "diff_lambda": diff_lambda,
            "diff_subln_g": diff_subln_g, "ret_decay_logit": ret_decay_logit, "w_out": w_out,
            "norm2_g": norm2_g, "peer_wq": peer_wq, "peer_subkeys": peer_subkeys,
            "peer_u": peer_u, "peer_v": peer_v, "final_g": final_g}


def reference(x, c, ctx, c_ctx, w_ada, b_ada, norm1_g, w_in, na_rpb, diff_lambda, diff_subln_g,
              ret_decay_logit, w_out, norm2_g, peer_wq, peer_subkeys, peer_u, peer_v, final_g):
    b, l, d = x.shape
    lc = ctx.shape[1]
    rope_d = axial_rope_tables(l, DIFF_DIM)
    rope_r = axial_rope_tables(l, RET_QK)
    silu_c = jax.nn.silu(c.astype(jnp.float32))
    silu_cc = jax.nn.silu(c_ctx.astype(jnp.float32))
    for layer in range(DEPTH):
        need_ctx = layer < DEPTH - 1
        mod = jnp.split((silu_c @ w_ada[layer] + b_ada[layer])[:, None, :], 6, axis=-1)
        mod_c = jnp.split(silu_cc @ w_ada[layer] + b_ada[layer], 6, axis=-1)
        hx = rmsnorm(x, norm1_g[layer]) * (1.0 + mod[1]) + mod[0]
        hc = rmsnorm(ctx, norm1_g[layer]) * (1.0 + mod_c[1]) + mod_c[0]
        y_lat, y_ctx = token_mixers(split_cols(hx @ w_in[layer]), split_cols(hc @ w_in[layer]),
                                    na_rpb[layer], diff_lambda[layer], diff_subln_g[layer],
                                    ret_decay_logit[layer], layer, rope_d, rope_r, need_ctx)
        x = x + mod[2] * (y_lat @ w_out[layer])
        h2 = rmsnorm(x, norm2_g[layer]) * (1.0 + mod[4]) + mod[3]
        x = x + mod[5] * peer(h2.reshape(b * l, d), peer_wq[layer], peer_subkeys[layer],
                              peer_u[layer], peer_v[layer]).reshape(b, l, d)
        if need_ctx:
            ctx = ctx + mod_c[2] * (y_ctx @ w_out[layer])
            h2c = rmsnorm(ctx, norm2_g[layer]) * (1.0 + mod_c[4]) + mod_c[3]
            ctx = ctx + mod_c[5] * peer(h2c.reshape(b * lc, d), peer_wq[layer], peer_subkeys[layer],
                                        peer_u[layer], peer_v[layer]).reshape(b, lc, d)
    return rmsnorm(x, final_g)
```

```cpp
#include <hip/hip_runtime.h>
#include <hip/hip_cooperative_groups.h>
#include <cstdio>
#include <cstdint>
namespace cg = cooperative_groups;

typedef unsigned short bf16_t;
typedef short bf16x8 __attribute__((ext_vector_type(8)));
typedef float f32x4 __attribute__((ext_vector_type(4)));

constexpr int DM = 1024, BATCH = 8, SEQ = 4096, LCTX = 256;
constexpr int NLAT = BATCH * SEQ;
constexpr int NCTX = BATCH * LCTX;
constexpr int NTOK = NLAT + NCTX;
constexpr int INC = 3072;
constexpr int C_NAQ = 0, C_NAK = 256, C_NAV = 512, C_DFQ = 768, C_DFK = 1024, C_DFV = 1280,
              C_RTQ = 1536, C_RTK = 1792, C_RTV = 2048, C_RTG = 2560;
constexpr int Y_NA = 0, Y_DF = 256, Y_RT = 512;
constexpr int NEXP = 16384;
constexpr float EPS = 1e-6f;

constexpr size_t OFF_CTL  = 0;
constexpr size_t OFF_MISC = 4096;
constexpr size_t OFF_ROPE = 8192;
constexpr size_t OFF_MOD  = OFF_ROPE + 12288;
constexpr size_t SZ_MOD   = 2ull * 9 * 6144 * 4;
constexpr size_t OFF_WIN  = OFF_MOD + SZ_MOD;
constexpr size_t SZ_WIN   = 2ull * 3072 * 1024 * 2;
constexpr size_t OFF_WOUT = OFF_WIN + SZ_WIN;
constexpr size_t SZ_WOUT  = 2ull * 1024 * 1024 * 2;
constexpr size_t OFF_WQ   = OFF_WOUT + SZ_WOUT;
constexpr size_t SZ_WQ    = 2ull * 2048 * 1024 * 2;
constexpr size_t OFF_SUBK = OFF_WQ + SZ_WQ;
constexpr size_t SZ_SUBK  = 2ull * 262144 * 2;
constexpr size_t OFF_U    = OFF_SUBK + SZ_SUBK;
constexpr size_t SZ_UV    = 2ull * NEXP * 1024 * 2;
constexpr size_t OFF_V    = OFF_U + SZ_UV;
constexpr size_t OFF_ACT  = OFF_V + SZ_UV;
constexpr size_t SZ_ACT   = (size_t)NTOK * 1024 * 2;
constexpr size_t OFF_P    = OFF_ACT + SZ_ACT;
constexpr size_t SZ_P     = (size_t)NTOK * 3072 * 2;
constexpr size_t OFF_CTXB = OFF_P + SZ_P;
constexpr size_t SZ_CTXB  = (size_t)NCTX * 1024 * 4;
constexpr size_t OFF_RKV  = OFF_CTXB + SZ_CTXB;
constexpr size_t SZ_RKV   = 64ull * 32 * 8192 * 4;
constexpr size_t OFF_RS   = OFF_RKV + SZ_RKV;
constexpr size_t SZ_RS    = 64ull * 8192 * 4;
constexpr size_t WS_END   = OFF_RS + SZ_RS;

constexpr int LDS_BYTES = 144 * 1024;
constexpr int LDS_BCAST = LDS_BYTES - 16;

struct Params {
  const float *x, *c, *ctx, *c_ctx, *w_ada, *b_ada, *norm1_g, *w_in, *na_rpb, *diff_lambda, *diff_subln_g,
              *ret_decay_logit, *w_out, *norm2_g, *peer_wq, *peer_subkeys, *peer_u, *peer_v, *final_g;
  float* out;
  char* ws;
};

__device__ __forceinline__ float bf2f(bf16_t v) { return __uint_as_float(((unsigned)v) << 16); }
__device__ __forceinline__ bf16_t f2bf(float f) {
  unsigned u = __float_as_uint(f);
  u += 0x7fffu + ((u >> 16) & 1u);
  return (bf16_t)(u >> 16);
}
__device__ __forceinline__ unsigned pack2(float a, float b) { return (unsigned)f2bf(a) | ((unsigned)f2bf(b) << 16); }
__device__ __forceinline__ float lo16(unsigned w) { return __uint_as_float(w << 16); }
__device__ __forceinline__ float hi16(unsigned w) { return __uint_as_float(w & 0xffff0000u); }
__device__ __forceinline__ float wave_sum(float v) {
#pragma unroll
  for (int o = 1; o < 64; o <<= 1) v += __shfl_xor(v, o);
  return v;
}
__device__ __forceinline__ float siluf(float x) { return x / (1.f + __expf(-x)); }

__device__ __forceinline__ int opaque_tid() { int t = threadIdx.x; asm volatile("" : "+v"(t)); return t; }
__device__ __forceinline__ int opaque_bid() { int t = blockIdx.x; asm volatile("" : "+s"(t)); return t; }

#define DOT8(acc, Q, off, U)                                                              \
  acc = fmaf(Q[(off) + 0], lo16((U).x), acc); acc = fmaf(Q[(off) + 1], hi16((U).x), acc); \
  acc = fmaf(Q[(off) + 2], lo16((U).y), acc); acc = fmaf(Q[(off) + 3], hi16((U).y), acc); \
  acc = fmaf(Q[(off) + 4], lo16((U).z), acc); acc = fmaf(Q[(off) + 5], hi16((U).z), acc); \
  acc = fmaf(Q[(off) + 6], lo16((U).w), acc); acc = fmaf(Q[(off) + 7], hi16((U).w), acc);
#define AXPY8(O, off, P, U)                                                                   \
  O[(off) + 0] = fmaf(P, lo16((U).x), O[(off) + 0]); O[(off) + 1] = fmaf(P, hi16((U).x), O[(off) + 1]); \
  O[(off) + 2] = fmaf(P, lo16((U).y), O[(off) + 2]); O[(off) + 3] = fmaf(P, hi16((U).y), O[(off) + 3]); \
  O[(off) + 4] = fmaf(P, lo16((U).z), O[(off) + 4]); O[(off) + 5] = fmaf(P, hi16((U).z), O[(off) + 5]); \
  O[(off) + 6] = fmaf(P, lo16((U).w), O[(off) + 6]); O[(off) + 7] = fmaf(P, hi16((U).w), O[(off) + 7]);
#define UNPACK8(Q, off, U)                                                  \
  Q[(off) + 0] = lo16((U).x); Q[(off) + 1] = hi16((U).x); Q[(off) + 2] = lo16((U).y); Q[(off) + 3] = hi16((U).y); \
  Q[(off) + 4] = lo16((U).z); Q[(off) + 5] = hi16((U).z); Q[(off) + 6] = lo16((U).w); Q[(off) + 7] = hi16((U).w);

__device__ __forceinline__ int next_item(unsigned* counter, char* smem) {
  volatile int* bc = (volatile int*)(smem + LDS_BCAST);
  __syncthreads();
  if (threadIdx.x == 0) *bc = (int)atomicAdd(counter, 1u);
  __syncthreads();
  return *bc;
}

__device__ __forceinline__ void transpose_item(const float* src, bf16_t* dst, int K, int N, int item, char* smem) {
  float* t = (float*)smem;
  const int nb = N / 64;
  const int k0 = (item / nb) * 64, n0 = (item % nb) * 64;
  const int tid = opaque_tid();
  __syncthreads();
#pragma unroll
  for (int i = 0; i < 8; ++i) {
    const int k = (tid >> 6) + 8 * i, n = tid & 63;
    t[k * 65 + n] = src[(size_t)(k0 + k) * N + n0 + n];
  }
  __syncthreads();
#pragma unroll
  for (int i = 0; i < 8; ++i) {
    const int n = (tid >> 6) + 8 * i, k = tid & 63;
    dst[(size_t)(n0 + n) * K + k0 + k] = f2bf(t[k * 65 + n]);
  }
}

__device__ __forceinline__ void convert_flat(const float* src, bf16_t* dst, size_t n4) {
  const size_t gt = (size_t)opaque_bid() * blockDim.x + opaque_tid(), gs = (size_t)gridDim.x * blockDim.x;
  for (size_t i = gt; i < n4; i += gs) {
    const float4 v = ((const float4*)src)[i];
    uint2 o; o.x = pack2(v.x, v.y); o.y = pack2(v.z, v.w);
    ((uint2*)dst)[i] = o;
  }
}

__device__ __forceinline__ void phase_prep(const Params& p, char* smem) {
  const int tid = opaque_tid();
  char* ws = p.ws;
  if (opaque_bid() == 0) {
    unsigned* ctl = (unsigned*)(ws + OFF_CTL);
    if (tid < 64) ctl[tid] = 0u;
    float* misc = (float*)(ws + OFF_MISC);
    if (tid < 2) {
      const float* lp = p.diff_lambda + tid * 128;
      float s01 = 0.f, s23 = 0.f;
      for (int i = 0; i < 32; ++i) { s01 += lp[i] * lp[32 + i]; s23 += lp[64 + i] * lp[96 + i]; }
      const float lam_init = 0.8f - 0.6f * expf(-0.3f * (float)tid);
      misc[tid] = expf(s01) - expf(s23) + lam_init;
      misc[2 + tid] = lam_init;
    }
    if (tid >= 64 && tid < 80) {
      const int i = tid - 64;
      const float xv = p.ret_decay_logit[i];
      misc[16 + i] = -log1pf(expf(-xv));
    }
    float2* ropeD = (float2*)(ws + OFF_ROPE);
    float2* ropeR = (float2*)(ws + OFF_ROPE + 4096);
    for (int i = tid; i < 64 * 8; i += 512) {
      const int v = i >> 3, f = i & 7;
      const float inv = powf(10000.0f, -(float)(2 * f) / 16.0f);
      const float ang = (float)v * inv;
      ropeD[i] = make_float2(cosf(ang), sinf(ang));
    }
    for (int i = tid; i < 64 * 16; i += 512) {
      const int v = i >> 4, f = i & 15;
      const float inv = powf(10000.0f, -(float)(2 * f) / 32.0f);
      const float ang = (float)v * inv;
      ropeR[i] = make_float2(cosf(ang), sinf(ang));
    }
  }
  {
    float* sc = (float*)smem;
    float* red = (float*)(smem + 9 * 1024 * 4);
    float* mod = (float*)(ws + OFF_MOD);
    for (int item = opaque_bid(); item < 192; item += gridDim.x) {
      const int l = item / 96, cb = item % 96;
      __syncthreads();
      for (int i = tid; i < 9 * 1024; i += 512) {
        const int r = i >> 10, k = i & 1023;
        const float cv = (r < 8) ? p.c[r * 1024 + k] : p.c_ctx[k];
        sc[i] = siluf(cv);
      }
      __syncthreads();
      const int col = tid & 63, ks = tid >> 6;
      float acc[9];
#pragma unroll
      for (int r = 0; r < 9; ++r) acc[r] = 0.f;
      const float* w = p.w_ada + (size_t)l * 1024 * 6144 + cb * 64 + col;
      for (int k = ks * 128; k < ks * 128 + 128; ++k) {
        const float wv = w[(size_t)k * 6144];
#pragma unroll
        for (int r = 0; r < 9; ++r) acc[r] = fmaf(sc[r * 1024 + k], wv, acc[r]);
      }
#pragma unroll
      for (int r = 0; r < 9; ++r) red[(ks * 9 + r) * 64 + col] = acc[r];
      __syncthreads();
      for (int i = tid; i < 576; i += 512) {
        const int r = i >> 6, cc = i & 63;
        float s = 0.f;
#pragma unroll
        for (int k8 = 0; k8 < 8; ++k8) s += red[(k8 * 9 + r) * 64 + cc];
        mod[((size_t)l * 9 + r) * 6144 + cb * 64 + cc] = s + p.b_ada[l * 6144 + cb * 64 + cc];
      }
    }
    __syncthreads();
  }
  for (int item = opaque_bid(); item < 3072; item += gridDim.x) {
    const int l = item / 1536;
    int r = item % 1536;
    if (r < 768) transpose_item(p.w_in + (size_t)l * 1024 * 3072, (bf16_t*)(ws + OFF_WIN) + (size_t)l * 3072 * 1024, 1024, 3072, r, smem);
    else if (r < 1024) transpose_item(p.w_out + (size_t)l * 1024 * 1024, (bf16_t*)(ws + OFF_WOUT) + (size_t)l * 1024 * 1024, 1024, 1024, r - 768, smem);
    else transpose_item(p.peer_wq + (size_t)l * 1024 * 2048, (bf16_t*)(ws + OFF_WQ) + (size_t)l * 2048 * 1024, 1024, 2048, r - 1024, smem);
  }
  convert_flat(p.peer_subkeys, (bf16_t*)(ws + OFF_SUBK), 2ull * 262144 / 4);
  convert_flat(p.peer_u, (bf16_t*)(ws + OFF_U), 2ull * NEXP * 1024 / 4);
  convert_flat(p.peer_v, (bf16_t*)(ws + OFF_V), 2ull * NEXP * 1024 / 4);
  {
    const size_t gt = (size_t)opaque_bid() * blockDim.x + tid, gs = (size_t)gridDim.x * blockDim.x;
    float4* dst = (float4*)(ws + OFF_CTXB);
    for (size_t i = gt; i < (size_t)NCTX * 1024 / 4; i += gs) dst[i] = ((const float4*)p.ctx)[i];
  }
}

__device__ __forceinline__ void phase_norm(const Params& p, int layer, int which, const float* xlat, int nrows) {
  const int lane = opaque_tid() & 63;
  const int gw = opaque_bid() * 8 + (opaque_tid() >> 6), nw = gridDim.x * 8;
  const float* g = (which == 0 ? p.norm1_g : p.norm2_g) + layer * 1024;
  const float* mod = (const float*)(p.ws + OFF_MOD) + (size_t)layer * 9 * 6144;
  const float* ctxb = (const float*)(p.ws + OFF_CTXB);
  bf16_t* act = (bf16_t*)(p.ws + OFF_ACT);
  const int sh_off = which == 0 ? 0 : 3 * 1024, sc_off = which == 0 ? 1024 : 4 * 1024;
  for (int row = gw; row < nrows; row += nw) {
    const float* src = row < NLAT ? xlat + (size_t)row * 1024 : ctxb + (size_t)(row - NLAT) * 1024;
    const int b = row < NLAT ? (row >> 12) : 8;
    const float* mrow = mod + (size_t)b * 6144;
    float4 v[4];
    float ss = 0.f;
#pragma unroll
    for (int j = 0; j < 4; ++j) {
      v[j] = ((const float4*)src)[lane + 64 * j];
      ss += v[j].x * v[j].x + v[j].y * v[j].y + v[j].z * v[j].z + v[j].w * v[j].w;
    }
    ss = wave_sum(ss);
    const float r = rsqrtf(ss * (1.f / 1024.f) + EPS);
#pragma unroll
    for (int j = 0; j < 4; ++j) {
      const int c = (lane + 64 * j) * 4;
      const float4 gg = *(const float4*)(g + c);
      const float4 sh = *(const float4*)(mrow + sh_off + c);
      const float4 sc = *(const float4*)(mrow + sc_off + c);
      const float o0 = v[j].x * r * gg.x * (1.f + sc.x) + sh.x;
      const float o1 = v[j].y * r * gg.y * (1.f + sc.y) + sh.y;
      const float o2 = v[j].z * r * gg.z * (1.f + sc.z) + sh.z;
      const float o3 = v[j].w * r * gg.w * (1.f + sc.w) + sh.w;
      uint2 o; o.x = pack2(o0, o1); o.y = pack2(o2, o3);
      *(uint2*)(act + (size_t)row * 1024 + c) = o;
    }
  }
}

__device__ __forceinline__ void phase_final(const Params& p) {
  const int lane = opaque_tid() & 63;
  const int gw = opaque_bid() * 8 + (opaque_tid() >> 6), nw = gridDim.x * 8;
  for (int row = gw; row < NLAT; row += nw) {
    float* src = p.out + (size_t)row * 1024;
    float4 v[4];
    float ss = 0.f;
#pragma unroll
    for (int j = 0; j < 4; ++j) {
      v[j] = ((const float4*)src)[lane + 64 * j];
      ss += v[j].x * v[j].x + v[j].y * v[j].y + v[j].z * v[j].z + v[j].w * v[j].w;
    }
    ss = wave_sum(ss);
    const float r = rsqrtf(ss * (1.f / 1024.f) + EPS);
#pragma unroll
    for (int j = 0; j < 4; ++j) {
      const int c = (lane + 64 * j) * 4;
      const float4 gg = *(const float4*)(p.final_g + c);
      float4 o;
      o.x = v[j].x * r * gg.x; o.y = v[j].y * r * gg.y; o.z = v[j].z * r * gg.z; o.w = v[j].w * r * gg.w;
      ((float4*)src)[lane + 64 * j] = o;
    }
  }
}

constexpr int EPI_INPROJ = 0, EPI_OUTPROJ = 1, EPI_PLAIN = 2;
constexpr int GS = 72;
constexpr int G_ASTAGE = 256 * GS * 2;
constexpr int G_BSTAGE = 128 * GS * 2;
constexpr int G_STAGE = G_ASTAGE + G_BSTAGE;

template <int EPI>
__device__ __forceinline__ void gemm_phase(const Params& p, int layer, char* smem, const bf16_t* A, const bf16_t* Bt,
                                           int M, int N, const float* xin_lat) {
  const int tid = opaque_tid(), lane = tid & 63, wave = tid >> 6, wm = wave >> 1, wn = wave & 1;
  const int ntn = N / 128, ntiles = (M / 256) * ntn;
  const int lr = lane & 15, lq = lane >> 4;
  for (int tile = opaque_bid(); tile < ntiles; tile += gridDim.x) {
    const int m0 = (tile / ntn) * 256, n0 = (tile % ntn) * 128;
    f32x4 acc[4][4];
#pragma unroll
    for (int i = 0; i < 4; ++i)
#pragma unroll
      for (int j = 0; j < 4; ++j) acc[i][j] = (f32x4){0.f, 0.f, 0.f, 0.f};
    uint4 ra[4], rb[2];
    const int crow = tid >> 3, ckc = tid & 7;
    auto gload = [&](int k0) {
#pragma unroll
      for (int i = 0; i < 4; ++i) ra[i] = *(const uint4*)(A + (size_t)(m0 + crow + 64 * i) * 1024 + k0 + ckc * 8);
#pragma unroll
      for (int i = 0; i < 2; ++i) rb[i] = *(const uint4*)(Bt + (size_t)(n0 + crow + 64 * i) * 1024 + k0 + ckc * 8);
    };
    auto lstore = [&](int s) {
      bf16_t* sA = (bf16_t*)(smem + s * G_STAGE);
      bf16_t* sB = (bf16_t*)(smem + s * G_STAGE + G_ASTAGE);
#pragma unroll
      for (int i = 0; i < 4; ++i) *(uint4*)(sA + (crow + 64 * i) * GS + ckc * 8) = ra[i];
#pragma unroll
      for (int i = 0; i < 2; ++i) *(uint4*)(sB + (crow + 64 * i) * GS + ckc * 8) = rb[i];
    };
    __syncthreads();
    gload(0);
    lstore(0);
    __syncthreads();
    for (int kt = 0; kt < 16; ++kt) {
      const int cur = kt & 1;
      if (kt + 1 < 16) gload((kt + 1) * 64);
      const bf16_t* sA = (const bf16_t*)(smem + cur * G_STAGE);
      const bf16_t* sB = (const bf16_t*)(smem + cur * G_STAGE + G_ASTAGE);
#pragma unroll
      for (int ks = 0; ks < 2; ++ks) {
        bf16x8 af[4], bfr[4];
#pragma unroll
        for (int mi = 0; mi < 4; ++mi) af[mi] = *(const bf16x8*)(sA + (wm * 64 + mi * 16 + lr) * GS + ks * 32 + lq * 8);
#pragma unroll
        for (int ni = 0; ni < 4; ++ni) bfr[ni] = *(const bf16x8*)(sB + (wn * 64 + ni * 16 + lr) * GS + ks * 32 + lq * 8);
#pragma unroll
        for (int mi = 0; mi < 4; ++mi)
#pragma unroll
          for (int ni = 0; ni < 4; ++ni)
            acc[mi][ni] = __builtin_amdgcn_mfma_f32_16x16x32_bf16(bfr[ni], af[mi], acc[mi][ni], 0, 0, 0);
      }
      if (kt + 1 < 16) lstore(cur ^ 1);
      __syncthreads();
    }
#pragma unroll
    for (int mi = 0; mi < 4; ++mi) {
      const int m = m0 + wm * 64 + mi * 16 + lr;
#pragma unroll
      for (int ni = 0; ni < 4; ++ni) {
        const int n = n0 + wn * 64 + ni * 16 + lq * 4;
        float v0 = acc[mi][ni][0], v1 = acc[mi][ni][1], v2 = acc[mi][ni][2], v3 = acc[mi][ni][3];
        if constexpr (EPI == EPI_INPROJ) {
          const bool ropeD = (n >= C_DFQ && n < C_DFV), ropeR = (n >= C_RTQ && n < C_RTV);
          if ((ropeD || ropeR) && m < NLAT) {
            const int t = m & 4095, gr = t >> 6, gc = t & 63;
            float2 cs0, cs1;
            if (ropeD) {
              const float2* tab = (const float2*)(p.ws + OFF_ROPE);
              const int i0 = (n & 31) >> 1;
              if (i0 < 8) { cs0 = tab[gr * 8 + i0]; cs1 = tab[gr * 8 + i0 + 1]; }
              else { cs0 = tab[gc * 8 + i0 - 8]; cs1 = tab[gc * 8 + i0 - 7]; }
            } else {
              const float2* tab = (const float2*)(p.ws + OFF_ROPE + 4096);
              const int i0 = (n & 63) >> 1;
              if (i0 < 16) { cs0 = tab[gr * 16 + i0]; cs1 = tab[gr * 16 + i0 + 1]; }
              else { cs0 = tab[gc * 16 + i0 - 16]; cs1 = tab[gc * 16 + i0 - 15]; }
            }
            const float a0 = v0 * cs0.x - v1 * cs0.y, a1 = v0 * cs0.y + v1 * cs0.x;
            const float a2 = v2 * cs1.x - v3 * cs1.y, a3 = v2 * cs1.y + v3 * cs1.x;
            v0 = a0; v1 = a1; v2 = a2; v3 = a3;
          }
          float sc = 1.f;
          if (n < C_NAK) sc = 0.125f;
          else if (n >= C_DFQ && n < C_DFK) sc = 0.17677669529663687f;
          else if (n >= C_RTK && n < C_RTV) sc = 0.125f;
          uint2 o; o.x = pack2(v0 * sc, v1 * sc); o.y = pack2(v2 * sc, v3 * sc);
          *(uint2*)((bf16_t*)(p.ws + OFF_P) + (size_t)m * INC + n) = o;
        } else if constexpr (EPI == EPI_OUTPROJ) {
          const float* mod = (const float*)(p.ws + OFF_MOD) + (size_t)layer * 9 * 6144;
          const int b = m < NLAT ? (m >> 12) : 8;
          const float4 gt = *(const float4*)(mod + (size_t)b * 6144 + 2 * 1024 + n);
          const float* xi; float* xo;
          if (m < NLAT) { xi = xin_lat + (size_t)m * 1024 + n; xo = p.out + (size_t)m * 1024 + n; }
          else { xo = (float*)(p.ws + OFF_CTXB) + (size_t)(m - NLAT) * 1024 + n; xi = xo; }
          const float4 xv = *(const float4*)xi;
          float4 o; o.x = xv.x + gt.x * v0; o.y = xv.y + gt.y * v1; o.z = xv.z + gt.z * v2; o.w = xv.w + gt.w * v3;
          *(float4*)xo = o;
        } else {
          uint2 o; o.x = pack2(v0, v1); o.y = pack2(v2, v3);
          *(uint2*)((bf16_t*)(p.ws + OFF_P) + (size_t)m * 2048 + n) = o;
        }
      }
    }
  }
}

#define NA_KEY(KROW_EXPR, VROW_EXPR, BIAS_EXPR)                                        \
  {                                                                                    \
    const bf16_t* kr = (KROW_EXPR);                                                    \
    float a = 0.f;                                                                     \
    _Pragma("unroll") for (int c8 = 0; c8 < 8; ++c8) {                                 \
      const uint4 u = *(const uint4*)(kr + c8 * 8);                                    \
      DOT8(a, qv, c8 * 8, u)                                                           \
    }                                                                                  \
    a += (BIAS_EXPR);                                                                  \
    if (a > mrun) {                                                                    \
      const float f = __expf(mrun - a);                                                \
      lrun *= f;                                                                       \
      _Pragma("unroll") for (int d = 0; d < 64; ++d) o[d] *= f;                        \
      mrun = a;                                                                        \
    }                                                                                  \
    const float pj = __expf(a - mrun);                                                 \
    lrun += pj;                                                                        \
    const bf16_t* vr = (VROW_EXPR);                                                    \
    _Pragma("unroll") for (int c8 = 0; c8 < 8; ++c8) {                                 \
      const uint4 u = *(const uint4*)(vr + c8 * 8);                                    \
      AXPY8(o, c8 * 8, pj, u)                                                          \
    }                                                                                  \
  }

#define NA_MERGE_STORE(DST_PTR)                                                        \
  {                                                                                    \
    float mm = mrun;                                                                   \
    mm = fmaxf(mm, __shfl_xor(mm, 1)); mm = fmaxf(mm, __shfl_xor(mm, 2)); mm = fmaxf(mm, __shfl_xor(mm, 4)); \
    const float f = __expf(mrun - mm);                                                 \
    lrun *= f;                                                                         \
    lrun += __shfl_xor(lrun, 1); lrun += __shfl_xor(lrun, 2); lrun += __shfl_xor(lrun, 4); \
    const float inv = 1.f / lrun;                                                      \
    _Pragma("unroll") for (int d = 0; d < 64; ++d) {                                   \
      float t = o[d] * f;                                                              \
      t += __shfl_xor(t, 1); t += __shfl_xor(t, 2); t += __shfl_xor(t, 4);             \
      o[d] = t * inv;                                                                  \
    }                                                                                  \
    float w8[8];                                                                       \
    _Pragma("unroll") for (int i = 0; i < 8; ++i) {                                    \
      float t = o[i];                                                                  \
      _Pragma("unroll") for (int pp = 1; pp < 8; ++pp) t = (part == pp) ? o[pp * 8 + i] : t; \
      w8[i] = t;                                                                       \
    }                                                                                  \
    uint4 ov; ov.x = pack2(w8[0], w8[1]); ov.y = pack2(w8[2], w8[3]); ov.z = pack2(w8[4], w8[5]); ov.w = pack2(w8[6], w8[7]); \
    *(uint4*)(DST_PTR) = ov;                                                           \
  }

__device__ __forceinline__ void na_latent_item(const Params& p, int layer, int item) {
  const bf16_t* P = (const bf16_t*)(p.ws + OFF_P);
  bf16_t* Y = (bf16_t*)(p.ws + OFF_ACT);
  const int b = item >> 8, h = (item >> 6) & 3, r = item & 63;
  const int q = opaque_tid() >> 3, part = opaque_tid() & 7;
  const int m = b * 4096 + r * 64 + q;
  float qv[64], o[64];
  {
    const bf16_t* qr = P + (size_t)m * INC + C_NAQ + h * 64;
#pragma unroll
    for (int c8 = 0; c8 < 8; ++c8) { const uint4 u = *(const uint4*)(qr + c8 * 8); UNPACK8(qv, c8 * 8, u) }
  }
#pragma unroll
  for (int d = 0; d < 64; ++d) o[d] = 0.f;
  float mrun = -1e30f, lrun = 0.f;
  const int rs = min(max(r - 4, 0), 56), krow = rs + part;
  const int cs = min(max(q - 8, 0), 48);
  const float* rpb = p.na_rpb + ((size_t)(layer * 4 + h) * 15 + (krow - r + 7)) * 31;
  const bf16_t* kbase = P + (size_t)(b * 4096 + krow * 64) * INC + h * 64;
#pragma unroll 1
  for (int j = 0; j < 16; ++j) {
    NA_KEY(kbase + (size_t)(cs + j) * INC + C_NAK, kbase + (size_t)(cs + j) * INC + C_NAV, rpb[cs + j - q + 15])
  }
  const bf16_t* cbase = P + (size_t)(NLAT + b * 256 + part * 32) * INC + h * 64;
#pragma unroll 1
  for (int j = 0; j < 32; ++j) {
    NA_KEY(cbase + (size_t)j * INC + C_NAK, cbase + (size_t)j * INC + C_NAV, 0.f)
  }
  NA_MERGE_STORE(Y + (size_t)m * 1024 + Y_NA + h * 64 + part * 8)
}

__device__ __forceinline__ void na_ctx_item(const Params& p, int item) {
  const bf16_t* P = (const bf16_t*)(p.ws + OFF_P);
  bf16_t* Y = (bf16_t*)(p.ws + OFF_ACT);
  const int b = item >> 4, h = (item >> 2) & 3, qg = item & 3;
  const int q = opaque_tid() >> 3, part = opaque_tid() & 7;
  const int m = NLAT + b * 256 + qg * 64 + q;
  float qv[64], o[64];
  {
    const bf16_t* qr = P + (size_t)m * INC + C_NAQ + h * 64;
#pragma unroll
    for (int c8 = 0; c8 < 8; ++c8) { const uint4 u = *(const uint4*)(qr + c8 * 8); UNPACK8(qv, c8 * 8, u) }
  }
#pragma unroll
  for (int d = 0; d < 64; ++d) o[d] = 0.f;
  float mrun = -1e30f, lrun = 0.f;
  const bf16_t* cbase = P + (size_t)(NLAT + b * 256 + part * 32) * INC + h * 64;
#pragma unroll 1
  for (int j = 0; j < 32; ++j) {
    NA_KEY(cbase + (size_t)j * INC + C_NAK, cbase + (size_t)j * INC + C_NAV, 0.f)
  }
  NA_MERGE_STORE(Y + (size_t)m * 1024 + Y_NA + h * 64 + part * 8)
}

__device__ __forceinline__ void diff_item(const Params& p, int layer, bool ctxq, int item, char* smem) {
  const bf16_t* P = (const bf16_t*)(p.ws + OFF_P);
  bf16_t* Y = (bf16_t*)(p.ws + OFF_ACT);
  const float* misc = (const float*)(p.ws + OFF_MISC);
  const float lam = misc[layer], lam_init = misc[2 + layer];
  float* kt = (float*)smem;
  float* vt = (float*)(smem + 16384);
  const int tid = opaque_tid(), half = tid & 1;
  int b, h, m, nkeys;
  if (!ctxq) { b = item >> 6; h = (item >> 4) & 3; m = b * 4096 + (item & 15) * 256 + (tid >> 1); nkeys = 256 + 4096; }
  else { b = item >> 2; h = item & 3; m = NLAT + b * 256 + (tid >> 1); nkeys = 256; }
  float q0[32], q1[32], o0[32], o1[32];
  {
    const bf16_t* qr = P + (size_t)m * INC + C_DFQ + h * 64;
#pragma unroll
    for (int c8 = 0; c8 < 4; ++c8) { const uint4 u = *(const uint4*)(qr + c8 * 8); UNPACK8(q0, c8 * 8, u) }
#pragma unroll
    for (int c8 = 0; c8 < 4; ++c8) { const uint4 u = *(const uint4*)(qr + 32 + c8 * 8); UNPACK8(q1, c8 * 8, u) }
  }
#pragma unroll
  for (int d = 0; d < 32; ++d) { o0[d] = 0.f; o1[d] = 0.f; }
  float m0 = -1e30f, l0 = 0.f, m1 = -1e30f, l1 = 0.f;
  const int lkey = tid >> 3, lch = tid & 7;
#pragma unroll 1
  for (int k0 = 0; k0 < nkeys; k0 += 64) {
    __syncthreads();
    {
      const int kk = k0 + lkey;
      const size_t row = kk < 256 ? (size_t)(NLAT + b * 256 + kk) : (size_t)(b * 4096 + kk - 256);
      const uint4 uk = *(const uint4*)(P + row * INC + C_DFK + h * 64 + lch * 8);
      const uint4 uv = *(const uint4*)(P + row * INC + C_DFV + h * 64 + lch * 8);
      float* kd = kt + lkey * 64 + lch * 8;
      float* vd = vt + lkey * 64 + lch * 8;
      *(float4*)(kd) = make_float4(lo16(uk.x), hi16(uk.x), lo16(uk.y), hi16(uk.y));
      *(float4*)(kd + 4) = make_float4(lo16(uk.z), hi16(uk.z), lo16(uk.w), hi16(uk.w));
      *(float4*)(vd) = make_float4(lo16(uv.x), hi16(uv.x), lo16(uv.y), hi16(uv.y));
      *(float4*)(vd + 4) = make_float4(lo16(uv.z), hi16(uv.z), lo16(uv.w), hi16(uv.w));
    }
    __syncthreads();
#pragma unroll 1
    for (int j = 0; j < 64; ++j) {
      const float4* kr = (const float4*)(kt + j * 64);
      float a0 = 0.f, a1 = 0.f;
#pragma unroll
      for (int c4 = 0; c4 < 8; ++c4) {
        const float4 kv = kr[c4];
        a0 = fmaf(q0[c4 * 4 + 0], kv.x, a0); a0 = fmaf(q0[c4 * 4 + 1], kv.y, a0);
        a0 = fmaf(q0[c4 * 4 + 2], kv.z, a0); a0 = fmaf(q0[c4 * 4 + 3], kv.w, a0);
      }
#pragma unroll
      for (int c4 = 0; c4 < 8; ++c4) {
        const float4 kv = kr[8 + c4];
        a1 = fmaf(q1[c4 * 4 + 0], kv.x, a1); a1 = fmaf(q1[c4 * 4 + 1], kv.y, a1);
        a1 = fmaf(q1[c4 * 4 + 2], kv.z, a1); a1 = fmaf(q1[c4 * 4 + 3], kv.w, a1);
      }
      if (a0 > m0) {
        const float f = __expf(m0 - a0);
        l0 *= f;
#pragma unroll
        for (int d = 0; d < 32; ++d) o0[d] *= f;
        m0 = a0;
      }
      if (a1 > m1) {
        const float f = __expf(m1 - a1);
        l1 *= f;
#pragma unroll
        for (int d = 0; d < 32; ++d) o1[d] *= f;
        m1 = a1;
      }
      const float p0 = __expf(a0 - m0), p1 = __expf(a1 - m1);
      l0 += p0; l1 += p1;
      const float4* vr = (const float4*)(vt + j * 64 + half * 32);
#pragma unroll
      for (int c4 = 0; c4 < 8; ++c4) {
        const float4 vv = vr[c4];
        o0[c4 * 4 + 0] = fmaf(p0, vv.x, o0[c4 * 4 + 0]); o0[c4 * 4 + 1] = fmaf(p0, vv.y, o0[c4 * 4 + 1]);
        o0[c4 * 4 + 2] = fmaf(p0, vv.z, o0[c4 * 4 + 2]); o0[c4 * 4 + 3] = fmaf(p0, vv.w, o0[c4 * 4 + 3]);
        o1[c4 * 4 + 0] = fmaf(p1, vv.x, o1[c4 * 4 + 0]); o1[c4 * 4 + 1] = fmaf(p1, vv.y, o1[c4 * 4 + 1]);
        o1[c4 * 4 + 2] = fmaf(p1, vv.z, o1[c4 * 4 + 2]); o1[c4 * 4 + 3] = fmaf(p1, vv.w, o1[c4 * 4 + 3]);
      }
    }
  }
  const float i0 = 1.f / l0, i1 = lam / l1;
  float ss = 0.f;
#pragma unroll
  for (int d = 0; d < 32; ++d) { o0[d] = o0[d] * i0 - o1[d] * i1; ss = fmaf(o0[d], o0[d], ss); }
  ss += __shfl_xor(ss, 1);
  const float rr = rsqrtf(ss * (1.f / 64.f) + EPS) * (1.f - lam_init);
  const float* sg = p.diff_subln_g + layer * 64 + half * 32;
  bf16_t* dst = Y + (size_t)m * 1024 + Y_DF + h * 64 + half * 32;
#pragma unroll
  for (int c8 = 0; c8 < 4; ++c8) {
    uint4 ov;
    ov.x = pack2(o0[c8 * 8 + 0] * rr * sg[c8 * 8 + 0], o0[c8 * 8 + 1] * rr * sg[c8 * 8 + 1]);
    ov.y = pack2(o0[c8 * 8 + 2] * rr * sg[c8 * 8 + 2], o0[c8 * 8 + 3] * rr * sg[c8 * 8 + 3]);
    ov.z = pack2(o0[c8 * 8 + 4] * rr * sg[c8 * 8 + 4], o0[c8 * 8 + 5] * rr * sg[c8 * 8 + 5]);
    ov.w = pack2(o0[c8 * 8 + 6] * rr * sg[c8 * 8 + 6], o0[c8 * 8 + 7] * rr * sg[c8 * 8 + 7]);
    *(uint4*)(dst + c8 * 8) = ov;
  }
}

__device__ __forceinline__ void ret_kv_item(const Params& p, int layer, int h, size_t row0, int cnt, float* dstF, float* dstB) {
  const bf16_t* P = (const bf16_t*)(p.ws + OFF_P);
  const float* misc = (const float*)(p.ws + OFF_MISC);
  const float lgF = misc[16 + layer * 8 + 0 * 4 + h], lgB = misc[16 + layer * 8 + 1 * 4 + h];
  const int d = opaque_tid() >> 3, e0 = (opaque_tid() & 7) * 16;
  float aF[16], aB[16];
#pragma unroll
  for (int i = 0; i < 16; ++i) { aF[i] = 0.f; aB[i] = 0.f; }
#pragma unroll 2
  for (int j = 0; j < cnt; ++j) {
    const bf16_t* rowp = P + (row0 + j) * INC;
    const float kd = bf2f(rowp[C_RTK + h * 64 + d]);
    const uint4 u0 = *(const uint4*)(rowp + C_RTV + h * 128 + e0);
    const uint4 u1 = *(const uint4*)(rowp + C_RTV + h * 128 + e0 + 8);
    const float wF = kd * __expf(lgF * (float)(cnt - 1 - j)), wB = kd * __expf(lgB * (float)j);
    AXPY8(aF, 0, wF, u0) AXPY8(aF, 8, wF, u1)
    AXPY8(aB, 0, wB, u0) AXPY8(aB, 8, wB, u1)
  }
#pragma unroll
  for (int i = 0; i < 16; i += 4) {
    *(float4*)(dstF + d * 128 + e0 + i) = make_float4(aF[i], aF[i + 1], aF[i + 2], aF[i + 3]);
    *(float4*)(dstB + d * 128 + e0 + i) = make_float4(aB[i], aB[i + 1], aB[i + 2], aB[i + 3]);
  }
}

__device__ __forceinline__ void phase_ret_scan(const Params& p, int layer) {
  const float* misc = (const float*)(p.ws + OFF_MISC);
  float* rkv = (float*)(p.ws + OFF_RKV);
  const float* rs = (const float*)(p.ws + OFF_RS);
  const int gt = opaque_bid() * blockDim.x + opaque_tid(), gs = gridDim.x * blockDim.x;
  for (int idx = gt; idx < 64 * 8192; idx += gs) {
    const int seq = idx >> 13, elem = idx & 8191;
    const int dir = seq & 1, h = (seq >> 1) & 3;
    const float cdec = __expf(misc[16 + layer * 8 + dir * 4 + h] * 128.f);
    float state = rs[(size_t)seq * 8192 + elem];
    for (int s = 0; s < 32; ++s) {
      const int n = dir == 0 ? s : 31 - s;
      float* ptr = rkv + ((size_t)seq * 32 + n) * 8192 + elem;
      const float tmp = *ptr;
      *ptr = state;
      state = fmaf(cdec, state, tmp);
    }
  }
}

__device__ __forceinline__ void ret_out_item(const Params& p, int layer, int h, size_t krow0, int nkeys, int iq0,
                                             const float* SF, const float* SB, int clen) {
  const bf16_t* P = (const bf16_t*)(p.ws + OFF_P);
  bf16_t* Y = (bf16_t*)(p.ws + OFF_ACT);
  const float* misc = (const float*)(p.ws + OFF_MISC);
  const float lgF = misc[16 + layer * 8 + 0 * 4 + h], lgB = misc[16 + layer * 8 + 1 * 4 + h];
  const int il = opaque_tid() >> 2, eg = opaque_tid() & 3;
  const int iq = iq0 + il;
  const size_t m = krow0 + iq;
  float qv[64], acc[32];
  {
    const bf16_t* qr = P + m * INC + C_RTQ + h * 64;
#pragma unroll
    for (int c8 = 0; c8 < 8; ++c8) { const uint4 u = *(const uint4*)(qr + c8 * 8); UNPACK8(qv, c8 * 8, u) }
  }
#pragma unroll
  for (int i = 0; i < 32; ++i) acc[i] = 0.f;
#pragma unroll 1
  for (int j = 0; j < nkeys; ++j) {
    const bf16_t* rowp = P + (krow0 + j) * INC;
    float s = 0.f;
#pragma unroll
    for (int c8 = 0; c8 < 8; ++c8) { const uint4 u = *(const uint4*)(rowp + C_RTK + h * 64 + c8 * 8); DOT8(s, qv, c8 * 8, u) }
    const float df = (float)(iq - j);
    float coef = 0.f;
    if (j <= iq) coef += __expf(lgF * df);
    if (j >= iq) coef += __expf(-lgB * df);
    coef *= s;
#pragma unroll
    for (int c8 = 0; c8 < 4; ++c8) { const uint4 u = *(const uint4*)(rowp + C_RTV + h * 128 + eg * 32 + c8 * 8); AXPY8(acc, c8 * 8, coef, u) }
  }
  if (SF != nullptr) {
    const float cF = __expf(lgF * (float)(iq + 1)), cB = __expf(lgB * (float)(clen - iq));
    const bf16_t* qr2 = P + m * INC + C_RTQ + h * 64;
#pragma unroll 1
    for (int d = 0; d < 64; ++d) {
      const float qd = bf2f(qr2[d]);
      const float qf = qd * cF, qb = qd * cB;
      const float4* sf = (const float4*)(SF + d * 128 + eg * 32);
      const float4* sb = (const float4*)(SB + d * 128 + eg * 32);
#pragma unroll
      for (int c4 = 0; c4 < 8; ++c4) {
        const float4 a = sf[c4], bb = sb[c4];
        acc[c4 * 4 + 0] = fmaf(qf, a.x, fmaf(qb, bb.x, acc[c4 * 4 + 0]));
        acc[c4 * 4 + 1] = fmaf(qf, a.y, fmaf(qb, bb.y, acc[c4 * 4 + 1]));
        acc[c4 * 4 + 2] = fmaf(qf, a.z, fmaf(qb, bb.z, acc[c4 * 4 + 2]));
        acc[c4 * 4 + 3] = fmaf(qf, a.w, fmaf(qb, bb.w, acc[c4 * 4 + 3]));
      }
    }
  }
  float ss = 0.f;
#pragma unroll
  for (int i = 0; i < 32; ++i) ss = fmaf(acc[i], acc[i], ss);
  ss += __shfl_xor(ss, 1); ss += __shfl_xor(ss, 2);
  const float rr = rsqrtf(ss * (1.f / 128.f) + EPS);
  const bf16_t* gp = P + m * INC + C_RTG + h * 128 + eg * 32;
  bf16_t* dst = Y + m * 1024 + Y_RT + h * 128 + eg * 32;
#pragma unroll
  for (int c8 = 0; c8 < 4; ++c8) {
    const uint4 u = *(const uint4*)(gp + c8 * 8);
    float g8[8];
    UNPACK8(g8, 0, u)
    uint4 ov;
    ov.x = pack2(acc[c8 * 8 + 0] * rr * siluf(g8[0]), acc[c8 * 8 + 1] * rr * siluf(g8[1]));
    ov.y = pack2(acc[c8 * 8 + 2] * rr * siluf(g8[2]), acc[c8 * 8 + 3] * rr * siluf(g8[3]));
    ov.z = pack2(acc[c8 * 8 + 4] * rr * siluf(g8[4]), acc[c8 * 8 + 5] * rr * siluf(g8[5]));
    ov.w = pack2(acc[c8 * 8 + 6] * rr * siluf(g8[6]), acc[c8 * 8 + 7] * rr * siluf(g8[7]));
    *(uint4*)(dst + c8 * 8) = ov;
  }
}

__device__ __forceinline__ void phase_mix1(const Params& p, int layer, char* smem) {
  unsigned* ctr = (unsigned*)(p.ws + OFF_CTL) + (layer * 4 + 0);
  const bool nc = layer == 0;
  const int n_dl = 512, n_dc = nc ? 32 : 0, n_nl = 2048, n_ncx = nc ? 128 : 0, n_kv = 1024, n_cs = 32;
  const int total = n_dl + n_dc + n_nl + n_ncx + n_kv + n_cs;
  float* rkv = (float*)(p.ws + OFF_RKV);
  float* rs = (float*)(p.ws + OFF_RS);
  for (;;) {
    int it = next_item(ctr, smem);
    if (it >= total) break;
    if (it < n_dl) { diff_item(p, layer, false, it, smem); continue; } it -= n_dl;
    if (it < n_dc) { diff_item(p, layer, true, it, smem); continue; } it -= n_dc;
    if (it < n_nl) { na_latent_item(p, layer, it); continue; } it -= n_nl;
    if (it < n_ncx) { na_ctx_item(p, it); continue; } it -= n_ncx;
    if (it < n_kv) {
      const int bh = it >> 5, n = it & 31, b = bh >> 2, h = bh & 3;
      ret_kv_item(p, layer, h, (size_t)b * 4096 + n * 128, 128,
                  rkv + ((size_t)(bh * 2 + 0) * 32 + n) * 8192, rkv + ((size_t)(bh * 2 + 1) * 32 + n) * 8192);
      continue;
    }
    it -= n_kv;
    {
      const int bh = it, b = bh >> 2, h = bh & 3;
      ret_kv_item(p, layer, h, (size_t)NLAT + b * 256, 256, rs + (size_t)(bh * 2 + 0) * 8192, rs + (size_t)(bh * 2 + 1) * 8192);
    }
  }
}

__device__ __forceinline__ void phase_mix2(const Params& p, int layer, char* smem) {
  unsigned* ctr = (unsigned*)(p.ws + OFF_CTL) + (layer * 4 + 1);
  const int n_l = 1024, n_c = layer == 0 ? 64 : 0;
  const float* rkv = (const float*)(p.ws + OFF_RKV);
  for (;;) {
    int it = next_item(ctr, smem);
    if (it >= n_l + n_c) break;
    if (it < n_l) {
      const int bh = it >> 5, n = it & 31, b = bh >> 2, h = bh & 3;
      ret_out_item(p, layer, h, (size_t)b * 4096 + n * 128, 128, 0,
                   rkv + ((size_t)(bh * 2 + 0) * 32 + n) * 8192, rkv + ((size_t)(bh * 2 + 1) * 32 + n) * 8192, 128);
    } else {
      it -= n_l;
      const int bh = it >> 1, half = it & 1, b = bh >> 2, h = bh & 3;
      ret_out_item(p, layer, h, (size_t)NLAT + b * 256, 256, half * 128, nullptr, nullptr, 256);
    }
  }
}

__device__ __forceinline__ void phase_peer(const Params& p, int layer, char* smem, int ntok) {
  const bf16_t* Q = (const bf16_t*)(p.ws + OFF_P);
  const bf16_t* H2 = (const bf16_t*)(p.ws + OFF_ACT);
  const bf16_t* SK = (const bf16_t*)(p.ws + OFF_SUBK) + (size_t)layer * 262144;
  const bf16_t* U = (const bf16_t*)(p.ws + OFF_U) + (size_t)layer * NEXP * 1024;
  const bf16_t* V = (const bf16_t*)(p.ws + OFF_V) + (size_t)layer * NEXP * 1024;
  const float* mod = (const float*)(p.ws + OFF_MOD) + (size_t)layer * 9 * 6144;
  float* SC = (float*)smem;
  float* TV = (float*)(smem + 65536);
  int* TI = (int*)(smem + 65536 + 8192);
  float* CV = (float*)(smem + 81920);
  int* EX = (int*)(smem + 98304);
  float* GT = (float*)(smem + 98304 + 4096);
  int* CT = (int*)(smem + 98304 + 8192);
  const int tid = opaque_tid(), lane = tid & 63, wave = tid >> 6;
  const int lr = lane & 15, lq = lane >> 4;
  __syncthreads();
  if (tid == 0) {
    int c = 0;
    for (int a = 0; a < 16; ++a)
      for (int bb = 0; bb < 16; ++bb)
        if ((a + 1) * (bb + 1) <= 16) CT[c++] = a * 16 + bb;
    for (; c < 64; ++c) CT[c] = -1;
  }
  __syncthreads();
  const int ngroups = ntok / 8;
  for (int grp = opaque_bid(); grp < ngroups; grp += gridDim.x) {
    const int tok0 = grp * 8;
    {
      const int hd = wave;
#pragma unroll 1
      for (int pp = 0; pp < 2; ++pp) {
        bf16x8 af[4];
        const bf16_t* qrow = Q + (size_t)(tok0 + (lr & 7)) * 2048 + hd * 256 + pp * 128;
#pragma unroll
        for (int ks = 0; ks < 4; ++ks) af[ks] = *(const bf16x8*)(qrow + ks * 32 + lq * 8);
        const bf16_t* skb = SK + (size_t)((hd * 2 + pp) * 128) * 128;
#pragma unroll 2
        for (int nt = 0; nt < 8; ++nt) {
          f32x4 acc = (f32x4){0.f, 0.f, 0.f, 0.f};
#pragma unroll
          for (int ks = 0; ks < 4; ++ks) {
            const bf16x8 bfr = *(const bf16x8*)(skb + (size_t)(nt * 16 + lr) * 128 + ks * 32 + lq * 8);
            acc = __builtin_amdgcn_mfma_f32_16x16x32_bf16(af[ks], bfr, acc, 0, 0, 0);
          }
          if (lq < 2) {
#pragma unroll
            for (int r = 0; r < 4; ++r) SC[((lq * 4 + r) * 16 + hd * 2 + pp) * 128 + nt * 16 + lr] = acc[r];
          }
        }
      }
    }
    __syncthreads();
#pragma unroll 1
    for (int pass = 0; pass < 32; ++pass) {
      const int id = pass * 512 + tid, L = id >> 7, el = id & 127;
      const float my = SC[L * 128 + el];
      const float4* row = (const float4*)(SC + L * 128);
      int rank = 0;
#pragma unroll 8
      for (int j4 = 0; j4 < 32; ++j4) {
        const float4 v = row[j4];
        const int j = j4 * 4;
        rank += (v.x > my || (v.x == my && j + 0 < el)) ? 1 : 0;
        rank += (v.y > my || (v.y == my && j + 1 < el)) ? 1 : 0;
        rank += (v.z > my || (v.z == my && j + 2 < el)) ? 1 : 0;
        rank += (v.w > my || (v.w == my && j + 3 < el)) ? 1 : 0;
      }
      if (rank < 16) { TV[L * 16 + rank] = my; TI[L * 16 + rank] = el; }
    }
    __syncthreads();
#pragma unroll 1
    for (int pass = 0; pass < 8; ++pass) {
      const int id = pass * 512 + tid, th = id >> 6, c = id & 63;
      const int ab = CT[c];
      float val = -INFINITY;
      if (ab >= 0) val = TV[(th * 2 + 0) * 16 + (ab >> 4)] + TV[(th * 2 + 1) * 16 + (ab & 15)];
      CV[th * 64 + c] = val;
    }
    __syncthreads();
#pragma unroll 1
    for (int pass = 0; pass < 8; ++pass) {
      const int id = pass * 512 + tid, th = id >> 6, c = id & 63;
      const int ab = CT[c];
      const float my = CV[th * 64 + c];
      const float4* row = (const float4*)(CV + th * 64);
      int rank = 0;
#pragma unroll 4
      for (int j4 = 0; j4 < 16; ++j4) {
        const float4 v = row[j4];
        const int j = j4 * 4;
        rank += (v.x > my || (v.x == my && j + 0 < c)) ? 1 : 0;
        rank += (v.y > my || (v.y == my && j + 1 < c)) ? 1 : 0;
        rank += (v.z > my || (v.z == my && j + 2 < c)) ? 1 : 0;
        rank += (v.w > my || (v.w == my && j + 3 < c)) ? 1 : 0;
      }
      if (ab >= 0 && rank < 16) {
        const int t = th >> 3, hd = th & 7;
        GT[t * 128 + hd * 16 + rank] = my;
        EX[t * 128 + hd * 16 + rank] = TI[(th * 2 + 0) * 16 + (ab >> 4)] * 128 + TI[(th * 2 + 1) * 16 + (ab & 15)];
      }
    }
    __syncthreads();
    if (tid < 64) {
      float* g = GT + (tid >> 3) * 128 + (tid & 7) * 16;
      const float mx = g[0];
      float e[16], s = 0.f;
#pragma unroll
      for (int i = 0; i < 16; ++i) { e[i] = __expf(g[i] - mx); s += e[i]; }
      const float inv = 1.f / s;
#pragma unroll
      for (int i = 0; i < 16; ++i) g[i] = e[i] * inv;
    }
    __syncthreads();
    {
      const int tok = tok0 + wave;
      float hv[16], acc[16];
      {
        const bf16_t* hr = H2 + (size_t)tok * 1024;
        const uint4 u0 = *(const uint4*)(hr + lane * 8), u1 = *(const uint4*)(hr + 512 + lane * 8);
        UNPACK8(hv, 0, u0) UNPACK8(hv, 8, u1)
      }
#pragma unroll
      for (int i = 0; i < 16; ++i) acc[i] = 0.f;
#pragma unroll 1
      for (int e0 = 0; e0 < 128; e0 += 4) {
        uint4 uu[4][2], vv[4][2];
        float gg[4];
#pragma unroll
        for (int j = 0; j < 4; ++j) {
          const int ex = EX[wave * 128 + e0 + j];
          gg[j] = GT[wave * 128 + e0 + j];
          const bf16_t* ur = U + (size_t)ex * 1024;
          const bf16_t* vr = V + (size_t)ex * 1024;
          uu[j][0] = *(const uint4*)(ur + lane * 8); uu[j][1] = *(const uint4*)(ur + 512 + lane * 8);
          vv[j][0] = *(const uint4*)(vr + lane * 8); vv[j][1] = *(const uint4*)(vr + 512 + lane * 8);
        }
#pragma unroll
        for (int j = 0; j < 4; ++j) {
          float d = 0.f;
          DOT8(d, hv, 0, uu[j][0]) DOT8(d, hv, 8, uu[j][1])
          d = wave_sum(d);
          const float ge = 0.5f * d * (1.f + erff(d * 0.70710678118654752f));
          const float w = gg[j] * ge;
          AXPY8(acc, 0, w, vv[j][0]) AXPY8(acc, 8, w, vv[j][1])
        }
      }
      const int b = tok < NLAT ? (tok >> 12) : 8;
      float* xr = tok < NLAT ? p.out + (size_t)tok * 1024 : (float*)(p.ws + OFF_CTXB) + (size_t)(tok - NLAT) * 1024;
      const float* gate = mod + (size_t)b * 6144 + 5 * 1024;
#pragma unroll
      for (int hf = 0; hf < 2; ++hf) {
#pragma unroll
        for (int q4 = 0; q4 < 2; ++q4) {
          const int c = hf * 512 + lane * 8 + q4 * 4;
          const float4 xv = *(const float4*)(xr + c);
          const float4 gv = *(const float4*)(gate + c);
          float4 o;
          o.x = xv.x + gv.x * acc[hf * 8 + q4 * 4 + 0]; o.y = xv.y + gv.y * acc[hf * 8 + q4 * 4 + 1];
          o.z = xv.z + gv.z * acc[hf * 8 + q4 * 4 + 2]; o.w = xv.w + gv.w * acc[hf * 8 + q4 * 4 + 3];
          *(float4*)(xr + c) = o;
        }
      }
    }
    __syncthreads();
  }
}

template <int layer>
__device__ __forceinline__ void layer_body(const Params& p, char* smem, cg::grid_group& grid) {
  constexpr bool nc = layer == 0;
  const float* xin = layer == 0 ? p.x : (const float*)p.out;
  phase_norm(p, layer, 0, xin, NTOK);
  grid.sync();
  gemm_phase<EPI_INPROJ>(p, layer, smem, (const bf16_t*)(p.ws + OFF_ACT), (const bf16_t*)(p.ws + OFF_WIN) + (size_t)layer * 3072 * 1024, NTOK, 3072, nullptr);
  grid.sync();
  phase_mix1(p, layer, smem);
  grid.sync();
  phase_ret_scan(p, layer);
  grid.sync();
  phase_mix2(p, layer, smem);
  grid.sync();
  gemm_phase<EPI_OUTPROJ>(p, layer, smem, (const bf16_t*)(p.ws + OFF_ACT), (const bf16_t*)(p.ws + OFF_WOUT) + (size_t)layer * 1024 * 1024, nc ? NTOK : NLAT, 1024, xin);
  grid.sync();
  phase_norm(p, layer, 1, (const float*)p.out, nc ? NTOK : NLAT);
  grid.sync();
  gemm_phase<EPI_PLAIN>(p, layer, smem, (const bf16_t*)(p.ws + OFF_ACT), (const bf16_t*)(p.ws + OFF_WQ) + (size_t)layer * 2048 * 1024, nc ? NTOK : NLAT, 2048, nullptr);
  grid.sync();
  phase_peer(p, layer, smem, nc ? NTOK : NLAT);
  grid.sync();
}

__global__ void __launch_bounds__(512) fwd_megakernel(Params p) {
  cg::grid_group grid = cg::this_grid();
  extern __shared__ __attribute__((aligned(16))) char smem[];
  phase_prep(p, smem);
  grid.sync();
  layer_body<0>(p, smem, grid);
  layer_body<1>(p, smem, grid);
  phase_final(p);
}

extern "C" void kernel_launch(void* const* d_in, const int* in_sizes, int n_in, void* d_out,
                              int out_size, void* d_ws, size_t ws_size, hipStream_t stream) {
  constexpr size_t kDynLds = LDS_BYTES;
  static int grid_blocks = 0;
  if (!grid_blocks) {
    int dev = 0, cus = 0, per_cu = 0;
    (void)hipGetDevice(&dev);
    (void)hipDeviceGetAttribute(&cus, hipDeviceAttributeMultiprocessorCount, dev);
    (void)hipFuncSetAttribute((const void*)fwd_megakernel, hipFuncAttributeMaxDynamicSharedMemorySize, (int)kDynLds);
    (void)hipOccupancyMaxActiveBlocksPerMultiprocessor(&per_cu, fwd_megakernel, 512, kDynLds);
    if (per_cu < 1) { fprintf(stderr, "occupancy query says %d blocks/CU\n", per_cu); per_cu = 1; }
    grid_blocks = cus;
    if (ws_size < WS_END) fprintf(stderr, "workspace too small: %zu < %zu\n", ws_size, (size_t)WS_END);
  }
  Params p{};
  p.x = (const float*)d_in[0]; p.c = (const float*)d_in[1]; p.ctx = (const float*)d_in[2]; p.c_ctx = (const float*)d_in[3];
  p.w_ada = (const float*)d_in[4]; p.b_ada = (const float*)d_in[5]; p.norm1_g = (const float*)d_in[6]; p.w_in = (const float*)d_in[7];
  p.na_rpb = (const float*)d_in[8]; p.diff_lambda = (const float*)d_in[9]; p.diff_subln_g = (const float*)d_in[10];
  p.ret_decay_logit = (const float*)d_in[11]; p.w_out = (const float*)d_in[12]; p.norm2_g = (const float*)d_in[13];
  p.peer_wq = (const float*)d_in[14]; p.peer_subkeys = (const float*)d_in[15]; p.peer_u = (const float*)d_in[16];
  p.peer_v = (const float*)d_in[17]; p.final_g = (const float*)d_in[18];
  p.out = (float*)d_out; p.ws = (char*)d_ws;
  void* args[] = {&p};
  hipError_t e = hipLaunchCooperativeKernel((void*)fwd_megakernel, dim3(grid_blocks), dim3(512), args, kDynLds, stream);
  if (e != hipSuccess) fprintf(stderr, "cooperative launch failed: %s (grid %d)\n", hipGetErrorString(e), grid_blocks);
}
```

```cpp
#include <hip/hip_runtime.h>
#include <hip/hip_cooperative_groups.h>
#include <cstdio>
#include <cstdint>
namespace cg = cooperative_groups;

typedef unsigned short bf16_t;
typedef short bf16x8 __attribute__((ext_vector_type(8)));
typedef float f32x4 __attribute__((ext_vector_type(4)));

constexpr int DM = 1024, BATCH = 8, SEQ = 4096, LCTX = 256;
constexpr int NLAT = BATCH * SEQ;
constexpr int NCTX = BATCH * LCTX;
constexpr int NTOK = NLAT + NCTX;
constexpr int INC = 3072;
constexpr int C_NAQ = 0, C_NAK = 256, C_NAV = 512, C_DFQ = 768, C_DFK = 1024, C_DFV = 1280,
              C_RTQ = 1536, C_RTK = 1792, C_RTV = 2048, C_RTG = 2560;
constexpr int Y_NA = 0, Y_DF = 256, Y_RT = 512;
constexpr int NEXP = 16384;
constexpr float EPS = 1e-6f;

constexpr size_t OFF_CTL  = 0;
constexpr size_t OFF_MISC = 4096;
constexpr size_t OFF_ROPE = 8192;
constexpr size_t OFF_MOD  = OFF_ROPE + 12288;
constexpr size_t SZ_MOD   = 2ull * 9 * 6144 * 4;
constexpr size_t OFF_WIN  = OFF_MOD + SZ_MOD;
constexpr size_t SZ_WIN   = 2ull * 3072 * 1024 * 2;
constexpr size_t OFF_WOUT = OFF_WIN + SZ_WIN;
constexpr size_t SZ_WOUT  = 2ull * 1024 * 1024 * 2;
constexpr size_t OFF_WQ   = OFF_WOUT + SZ_WOUT;
constexpr size_t SZ_WQ    = 2ull * 2048 * 1024 * 2;
constexpr size_t OFF_SUBK = OFF_WQ + SZ_WQ;
constexpr size_t SZ_SUBK  = 2ull * 262144 * 2;
constexpr size_t OFF_U    = OFF_SUBK + SZ_SUBK;
constexpr size_t SZ_UV    = 2ull * NEXP * 1024;
constexpr size_t OFF_V    = OFF_U + SZ_UV;
constexpr size_t OFF_USC  = OFF_V + SZ_UV;
constexpr size_t OFF_VSC  = OFF_USC + 2ull * NEXP * 4;
constexpr size_t OFF_ACT  = OFF_VSC + 2ull * NEXP * 4;
constexpr size_t SZ_ACT   = (size_t)NTOK * 1024 * 2;
constexpr size_t OFF_P    = OFF_ACT + SZ_ACT;
constexpr size_t SZ_P     = (size_t)NTOK * 3072 * 2;
constexpr size_t OFF_CTXB = OFF_P + SZ_P;
constexpr size_t SZ_CTXB  = (size_t)NCTX * 1024 * 4;
constexpr size_t OFF_RKV  = OFF_CTXB + SZ_CTXB;
constexpr size_t SZ_RKV   = 64ull * 32 * 8192 * 4;
constexpr size_t OFF_RS   = OFF_RKV + SZ_RKV;
constexpr size_t SZ_RS    = 64ull * 8192 * 4;
constexpr size_t WS_END   = OFF_RS + SZ_RS;

#ifndef REP_MIX1
#define REP_MIX1 0
#endif
#ifndef REP_MIX2
#define REP_MIX2 0
#endif
#ifndef REP_PEER
#define REP_PEER 0
#endif
#ifndef REP_GEMM
#define REP_GEMM 0
#endif
constexpr int LDS_BYTES = 144 * 1024;
constexpr int LDS_BCAST = LDS_BYTES - 16;

struct Params {
  const float *x, *c, *ctx, *c_ctx, *w_ada, *b_ada, *norm1_g, *w_in, *na_rpb, *diff_lambda, *diff_subln_g,
              *ret_decay_logit, *w_out, *norm2_g, *peer_wq, *peer_subkeys, *peer_u, *peer_v, *final_g;
  float* out;
  char* ws;
};

__device__ __forceinline__ float bf2f(bf16_t v) { return __uint_as_float(((unsigned)v) << 16); }
__device__ __forceinline__ bf16_t f2bf(float f) {
  unsigned u = __float_as_uint(f);
  u += 0x7fffu + ((u >> 16) & 1u);
  return (bf16_t)(u >> 16);
}
__device__ __forceinline__ unsigned pack2(float a, float b) { return (unsigned)f2bf(a) | ((unsigned)f2bf(b) << 16); }
__device__ __forceinline__ float lo16(unsigned w) { return __uint_as_float(w << 16); }
__device__ __forceinline__ float hi16(unsigned w) { return __uint_as_float(w & 0xffff0000u); }
__device__ __forceinline__ float wave_sum(float v) {
#pragma unroll
  for (int o = 1; o < 64; o <<= 1) v += __shfl_xor(v, o);
  return v;
}
__device__ __forceinline__ float siluf(float x) { return x / (1.f + __expf(-x)); }

__device__ __forceinline__ int opaque_tid() { int t = threadIdx.x; asm volatile("" : "+v"(t)); return t; }
__device__ __forceinline__ int opaque_bid() { int t = blockIdx.x; asm volatile("" : "+s"(t)); return t; }

#define DOT8(acc, Q, off, U)                                                              \
  acc = fmaf(Q[(off) + 0], lo16((U).x), acc); acc = fmaf(Q[(off) + 1], hi16((U).x), acc); \
  acc = fmaf(Q[(off) + 2], lo16((U).y), acc); acc = fmaf(Q[(off) + 3], hi16((U).y), acc); \
  acc = fmaf(Q[(off) + 4], lo16((U).z), acc); acc = fmaf(Q[(off) + 5], hi16((U).z), acc); \
  acc = fmaf(Q[(off) + 6], lo16((U).w), acc); acc = fmaf(Q[(off) + 7], hi16((U).w), acc);
#define AXPY8(O, off, P, U)                                                                   \
  O[(off) + 0] = fmaf(P, lo16((U).x), O[(off) + 0]); O[(off) + 1] = fmaf(P, hi16((U).x), O[(off) + 1]); \
  O[(off) + 2] = fmaf(P, lo16((U).y), O[(off) + 2]); O[(off) + 3] = fmaf(P, hi16((U).y), O[(off) + 3]); \
  O[(off) + 4] = fmaf(P, lo16((U).z), O[(off) + 4]); O[(off) + 5] = fmaf(P, hi16((U).z), O[(off) + 5]); \
  O[(off) + 6] = fmaf(P, lo16((U).w), O[(off) + 6]); O[(off) + 7] = fmaf(P, hi16((U).w), O[(off) + 7]);
#define UNPACK8(Q, off, U)                                                  \
  Q[(off) + 0] = lo16((U).x); Q[(off) + 1] = hi16((U).x); Q[(off) + 2] = lo16((U).y); Q[(off) + 3] = hi16((U).y); \
  Q[(off) + 4] = lo16((U).z); Q[(off) + 5] = hi16((U).z); Q[(off) + 6] = lo16((U).w); Q[(off) + 7] = hi16((U).w);

__device__ __forceinline__ int next_item(unsigned* counter, char* smem) {
  volatile int* bc = (volatile int*)(smem + LDS_BCAST);
  __syncthreads();
  if (threadIdx.x == 0) *bc = (int)atomicAdd(counter, 1u);
  __syncthreads();
  return *bc;
}

__device__ __forceinline__ void transpose_item(const float* src, bf16_t* dst, int K, int N, int item, char* smem) {
  float* t = (float*)smem;
  const int nb = N / 64;
  const int k0 = (item / nb) * 64, n0 = (item % nb) * 64;
  const int tid = opaque_tid();
  __syncthreads();
#pragma unroll
  for (int i = 0; i < 8; ++i) {
    const int k = (tid >> 6) + 8 * i, n = tid & 63;
    t[k * 65 + n] = src[(size_t)(k0 + k) * N + n0 + n];
  }
  __syncthreads();
#pragma unroll
  for (int i = 0; i < 8; ++i) {
    const int n = (tid >> 6) + 8 * i, k = tid & 63;
    dst[(size_t)(n0 + n) * K + k0 + k] = f2bf(t[k * 65 + n]);
  }
}

__device__ __forceinline__ void convert_flat(const float* src, bf16_t* dst, size_t n4) {
  const size_t gt = (size_t)opaque_bid() * blockDim.x + opaque_tid(), gs = (size_t)gridDim.x * blockDim.x;
  for (size_t i = gt; i < n4; i += gs) {
    const float4 v = ((const float4*)src)[i];
    uint2 o; o.x = pack2(v.x, v.y); o.y = pack2(v.z, v.w);
    ((uint2*)dst)[i] = o;
  }
}

__device__ __forceinline__ void phase_prep(const Params& p, char* smem) {
  const int tid = opaque_tid();
  char* ws = p.ws;
  if (opaque_bid() == 0) {
    unsigned* ctl = (unsigned*)(ws + OFF_CTL);
    if (tid < 64) ctl[tid] = 0u;
    float* misc = (float*)(ws + OFF_MISC);
    if (tid < 2) {
      const float* lp = p.diff_lambda + tid * 128;
      float s01 = 0.f, s23 = 0.f;
      for (int i = 0; i < 32; ++i) { s01 += lp[i] * lp[32 + i]; s23 += lp[64 + i] * lp[96 + i]; }
      const float lam_init = 0.8f - 0.6f * expf(-0.3f * (float)tid);
      misc[tid] = expf(s01) - expf(s23) + lam_init;
      misc[2 + tid] = lam_init;
    }
    if (tid >= 64 && tid < 80) {
      const int i = tid - 64;
      const float xv = p.ret_decay_logit[i];
      misc[16 + i] = -log1pf(expf(-xv));
    }
    float2* ropeD = (float2*)(ws + OFF_ROPE);
    float2* ropeR = (float2*)(ws + OFF_ROPE + 4096);
    for (int i = tid; i < 64 * 8; i += 512) {
      const int v = i >> 3, f = i & 7;
      const float inv = powf(10000.0f, -(float)(2 * f) / 16.0f);
      const float ang = (float)v * inv;
      ropeD[i] = make_float2(cosf(ang), sinf(ang));
    }
    for (int i = tid; i < 64 * 16; i += 512) {
      const int v = i >> 4, f = i & 15;
      const float inv = powf(10000.0f, -(float)(2 * f) / 32.0f);
      const float ang = (float)v * inv;
      ropeR[i] = make_float2(cosf(ang), sinf(ang));
    }
  }
  {
    float* sc = (float*)smem;
    float* red = (float*)(smem + 9 * 1024 * 4);
    float* mod = (float*)(ws + OFF_MOD);
    for (int item = opaque_bid(); item < 192; item += gridDim.x) {
      const int l = item / 96, cb = item % 96;
      __syncthreads();
      for (int i = tid; i < 9 * 1024; i += 512) {
        const int r = i >> 10, k = i & 1023;
        const float cv = (r < 8) ? p.c[r * 1024 + k] : p.c_ctx[k];
        sc[i] = siluf(cv);
      }
      __syncthreads();
      const int col = tid & 63, ks = tid >> 6;
      float acc[9];
#pragma unroll
      for (int r = 0; r < 9; ++r) acc[r] = 0.f;
      const float* w = p.w_ada + (size_t)l * 1024 * 6144 + cb * 64 + col;
      for (int k = ks * 128; k < ks * 128 + 128; ++k) {
        const float wv = w[(size_t)k * 6144];
#pragma unroll
        for (int r = 0; r < 9; ++r) acc[r] = fmaf(sc[r * 1024 + k], wv, acc[r]);
      }
#pragma unroll
      for (int r = 0; r < 9; ++r) red[(ks * 9 + r) * 64 + col] = acc[r];
      __syncthreads();
      for (int i = tid; i < 576; i += 512) {
        const int r = i >> 6, cc = i & 63;
        float s = 0.f;
#pragma unroll
        for (int k8 = 0; k8 < 8; ++k8) s += red[(k8 * 9 + r) * 64 + cc];
        mod[((size_t)l * 9 + r) * 6144 + cb * 64 + cc] = s + p.b_ada[l * 6144 + cb * 64 + cc];
      }
    }
    __syncthreads();
  }
  for (int item = opaque_bid(); item < 3072; item += gridDim.x) {
    const int l = item / 1536;
    int r = item % 1536;
    if (r < 768) transpose_item(p.w_in + (size_t)l * 1024 * 3072, (bf16_t*)(ws + OFF_WIN) + (size_t)l * 3072 * 1024, 1024, 3072, r, smem);
    else if (r < 1024) transpose_item(p.w_out + (size_t)l * 1024 * 1024, (bf16_t*)(ws + OFF_WOUT) + (size_t)l * 1024 * 1024, 1024, 1024, r - 768, smem);
    else transpose_item(p.peer_wq + (size_t)l * 1024 * 2048, (bf16_t*)(ws + OFF_WQ) + (size_t)l * 2048 * 1024, 1024, 2048, r - 1024, smem);
  }
  convert_flat(p.peer_subkeys, (bf16_t*)(ws + OFF_SUBK), 2ull * 262144 / 4);
  {
    const int lane = tid & 63;
    const int gw = opaque_bid() * 8 + (tid >> 6), nw = gridDim.x * 8;
    for (int row = gw; row < 4 * NEXP; row += nw) {
      const bool isv = row >= 2 * NEXP;
      const int rr = isv ? row - 2 * NEXP : row;
      const float* srow = (isv ? p.peer_v : p.peer_u) + (size_t)rr * 1024;
      float4 v[4];
      float mx = 0.f;
#pragma unroll
      for (int j = 0; j < 4; ++j) {
        v[j] = ((const float4*)srow)[lane + 64 * j];
        mx = fmaxf(mx, fmaxf(fmaxf(fabsf(v[j].x), fabsf(v[j].y)), fmaxf(fabsf(v[j].z), fabsf(v[j].w))));
      }
#pragma unroll
      for (int o = 1; o < 64; o <<= 1) mx = fmaxf(mx, __shfl_xor(mx, o));
      const float scale = mx > 0.f ? mx * (1.f / 448.f) : 1.f;
      const float inv = 1.f / scale;
      uint4 o;
      unsigned w[4];
#pragma unroll
      for (int j = 0; j < 4; ++j) {
        int t = 0;
        t = __builtin_amdgcn_cvt_pk_fp8_f32(v[j].x * inv, v[j].y * inv, t, false);
        t = __builtin_amdgcn_cvt_pk_fp8_f32(v[j].z * inv, v[j].w * inv, t, true);
        w[j] = (unsigned)t;
      }
      o.x = w[0]; o.y = w[1]; o.z = w[2]; o.w = w[3];
      *(uint4*)(ws + (isv ? OFF_V : OFF_U) + (size_t)rr * 1024 + lane * 16) = o;
      if (lane == 0) ((float*)(ws + (isv ? OFF_VSC : OFF_USC)))[rr] = scale;
    }
  }
  {
    const size_t gt = (size_t)opaque_bid() * blockDim.x + tid, gs = (size_t)gridDim.x * blockDim.x;
    float4* dst = (float4*)(ws + OFF_CTXB);
    for (size_t i = gt; i < (size_t)NCTX * 1024 / 4; i += gs) dst[i] = ((const float4*)p.ctx)[i];
  }
}

__device__ __forceinline__ void phase_norm(const Params& p, int layer, int which, const float* xlat, int nrows) {
  const int lane = opaque_tid() & 63;
  const int gw = opaque_bid() * 8 + (opaque_tid() >> 6), nw = gridDim.x * 8;
  const float* g = (which == 0 ? p.norm1_g : p.norm2_g) + layer * 1024;
  const float* mod = (const float*)(p.ws + OFF_MOD) + (size_t)layer * 9 * 6144;
  const float* ctxb = (const float*)(p.ws + OFF_CTXB);
  bf16_t* act = (bf16_t*)(p.ws + OFF_ACT);
  const int sh_off = which == 0 ? 0 : 3 * 1024, sc_off = which == 0 ? 1024 : 4 * 1024;
  for (int row = gw; row < nrows; row += nw) {
    const float* src = row < NLAT ? xlat + (size_t)row * 1024 : ctxb + (size_t)(row - NLAT) * 1024;
    const int b = row < NLAT ? (row >> 12) : 8;
    const float* mrow = mod + (size_t)b * 6144;
    float4 v[4];
    float ss = 0.f;
#pragma unroll
    for (int j = 0; j < 4; ++j) {
      v[j] = ((const float4*)src)[lane + 64 * j];
      ss += v[j].x * v[j].x + v[j].y * v[j].y + v[j].z * v[j].z + v[j].w * v[j].w;
    }
    ss = wave_sum(ss);
    const float r = rsqrtf(ss * (1.f / 1024.f) + EPS);
#pragma unroll
    for (int j = 0; j < 4; ++j) {
      const int c = (lane + 64 * j) * 4;
      const float4 gg = *(const float4*)(g + c);
      const float4 sh = *(const float4*)(mrow + sh_off + c);
      const float4 sc = *(const float4*)(mrow + sc_off + c);
      const float o0 = v[j].x * r * gg.x * (1.f + sc.x) + sh.x;
      const float o1 = v[j].y * r * gg.y * (1.f + sc.y) + sh.y;
      const float o2 = v[j].z * r * gg.z * (1.f + sc.z) + sh.z;
      const float o3 = v[j].w * r * gg.w * (1.f + sc.w) + sh.w;
      uint2 o; o.x = pack2(o0, o1); o.y = pack2(o2, o3);
      *(uint2*)(act + (size_t)row * 1024 + c) = o;
    }
  }
}

__device__ __forceinline__ void phase_final(const Params& p) {
  const int lane = opaque_tid() & 63;
  const int gw = opaque_bid() * 8 + (opaque_tid() >> 6), nw = gridDim.x * 8;
  for (int row = gw; row < NLAT; row += nw) {
    float* src = p.out + (size_t)row * 1024;
    float4 v[4];
    float ss = 0.f;
#pragma unroll
    for (int j = 0; j < 4; ++j) {
      v[j] = ((const float4*)src)[lane + 64 * j];
      ss += v[j].x * v[j].x + v[j].y * v[j].y + v[j].z * v[j].z + v[j].w * v[j].w;
    }
    ss = wave_sum(ss);
    const float r = rsqrtf(ss * (1.f / 1024.f) + EPS);
#pragma unroll
    for (int j = 0; j < 4; ++j) {
      const int c = (lane + 64 * j) * 4;
      const float4 gg = *(const float4*)(p.final_g + c);
      float4 o;
      o.x = v[j].x * r * gg.x; o.y = v[j].y * r * gg.y; o.z = v[j].z * r * gg.z; o.w = v[j].w * r * gg.w;
      ((float4*)src)[lane + 64 * j] = o;
    }
  }
}

constexpr int EPI_INPROJ = 0, EPI_OUTPROJ = 1, EPI_PLAIN = 2;
constexpr int GS = 72;
constexpr int G_ASTAGE = 256 * GS * 2;
constexpr int G_BSTAGE = 128 * GS * 2;
constexpr int G_STAGE = G_ASTAGE + G_BSTAGE;

template <int EPI>
__device__ __forceinline__ void gemm_phase(const Params& p, int layer, char* smem, const bf16_t* A, const bf16_t* Bt,
                                           int M, int N, const float* xin_lat) {
  const int tid = opaque_tid(), lane = tid & 63, wave = tid >> 6, wm = wave >> 1, wn = wave & 1;
  const int ntn = N / 128, ntiles = (M / 256) * ntn;
  const int lr = lane & 15, lq = lane >> 4;
  for (int tile = opaque_bid(); tile < ntiles; tile += gridDim.x) {
    const int m0 = (tile / ntn) * 256, n0 = (tile % ntn) * 128;
    f32x4 acc[4][4];
#pragma unroll
    for (int i = 0; i < 4; ++i)
#pragma unroll
      for (int j = 0; j < 4; ++j) acc[i][j] = (f32x4){0.f, 0.f, 0.f, 0.f};
    uint4 ra[4], rb[2];
    const int crow = tid >> 3, ckc = tid & 7;
    auto gload = [&](int k0) {
#pragma unroll
      for (int i = 0; i < 4; ++i) ra[i] = *(const uint4*)(A + (size_t)(m0 + crow + 64 * i) * 1024 + k0 + ckc * 8);
#pragma unroll
      for (int i = 0; i < 2; ++i) rb[i] = *(const uint4*)(Bt + (size_t)(n0 + crow + 64 * i) * 1024 + k0 + ckc * 8);
    };
    auto lstore = [&](int s) {
      bf16_t* sA = (bf16_t*)(smem + s * G_STAGE);
      bf16_t* sB = (bf16_t*)(smem + s * G_STAGE + G_ASTAGE);
#pragma unroll
      for (int i = 0; i < 4; ++i) *(uint4*)(sA + (crow + 64 * i) * GS + ckc * 8) = ra[i];
#pragma unroll
      for (int i = 0; i < 2; ++i) *(uint4*)(sB + (crow + 64 * i) * GS + ckc * 8) = rb[i];
    };
    __syncthreads();
    gload(0);
    lstore(0);
    __syncthreads();
    for (int kt = 0; kt < 16; ++kt) {
      const int cur = kt & 1;
      if (kt + 1 < 16) gload((kt + 1) * 64);
      const bf16_t* sA = (const bf16_t*)(smem + cur * G_STAGE);
      const bf16_t* sB = (const bf16_t*)(smem + cur * G_STAGE + G_ASTAGE);
#pragma unroll
      for (int ks = 0; ks < 2; ++ks) {
        bf16x8 af[4], bfr[4];
#pragma unroll
        for (int mi = 0; mi < 4; ++mi) af[mi] = *(const bf16x8*)(sA + (wm * 64 + mi * 16 + lr) * GS + ks * 32 + lq * 8);
#pragma unroll
        for (int ni = 0; ni < 4; ++ni) bfr[ni] = *(const bf16x8*)(sB + (wn * 64 + ni * 16 + lr) * GS + ks * 32 + lq * 8);
#pragma unroll
        for (int mi = 0; mi < 4; ++mi)
#pragma unroll
          for (int ni = 0; ni < 4; ++ni)
            acc[mi][ni] = __builtin_amdgcn_mfma_f32_16x16x32_bf16(bfr[ni], af[mi], acc[mi][ni], 0, 0, 0);
      }
      if (kt + 1 < 16) lstore(cur ^ 1);
      __syncthreads();
    }
#pragma unroll
    for (int mi = 0; mi < 4; ++mi) {
      const int m = m0 + wm * 64 + mi * 16 + lr;
#pragma unroll
      for (int ni = 0; ni < 4; ++ni) {
        const int n = n0 + wn * 64 + ni * 16 + lq * 4;
        float v0 = acc[mi][ni][0], v1 = acc[mi][ni][1], v2 = acc[mi][ni][2], v3 = acc[mi][ni][3];
        if constexpr (EPI == EPI_INPROJ) {
          const bool ropeD = (n >= C_DFQ && n < C_DFV), ropeR = (n >= C_RTQ && n < C_RTV);
          if ((ropeD || ropeR) && m < NLAT) {
            const int t = m & 4095, gr = t >> 6, gc = t & 63;
            float2 cs0, cs1;
            if (ropeD) {
              const float2* tab = (const float2*)(p.ws + OFF_ROPE);
              const int i0 = (n & 31) >> 1;
              if (i0 < 8) { cs0 = tab[gr * 8 + i0]; cs1 = tab[gr * 8 + i0 + 1]; }
              else { cs0 = tab[gc * 8 + i0 - 8]; cs1 = tab[gc * 8 + i0 - 7]; }
            } else {
              const float2* tab = (const float2*)(p.ws + OFF_ROPE + 4096);
              const int i0 = (n & 63) >> 1;
              if (i0 < 16) { cs0 = tab[gr * 16 + i0]; cs1 = tab[gr * 16 + i0 + 1]; }
              else { cs0 = tab[gc * 16 + i0 - 16]; cs1 = tab[gc * 16 + i0 - 15]; }
            }
            const float a0 = v0 * cs0.x - v1 * cs0.y, a1 = v0 * cs0.y + v1 * cs0.x;
            const float a2 = v2 * cs1.x - v3 * cs1.y, a3 = v2 * cs1.y + v3 * cs1.x;
            v0 = a0; v1 = a1; v2 = a2; v3 = a3;
          }
          float sc = 1.f;
          if (n < C_NAK) sc = 0.125f * 1.4426950408889634f;
          else if (n >= C_DFQ && n < C_DFK) sc = 0.17677669529663687f * 1.4426950408889634f;
          else if (n >= C_RTK && n < C_RTV) sc = 0.125f;
          uint2 o; o.x = pack2(v0 * sc, v1 * sc); o.y = pack2(v2 * sc, v3 * sc);
          *(uint2*)((bf16_t*)(p.ws + OFF_P) + (size_t)m * INC + n) = o;
        } else if constexpr (EPI == EPI_OUTPROJ) {
          const float* mod = (const float*)(p.ws + OFF_MOD) + (size_t)layer * 9 * 6144;
          const int b = m < NLAT ? (m >> 12) : 8;
          const float4 gt = *(const float4*)(mod + (size_t)b * 6144 + 2 * 1024 + n);
          const float* xi; float* xo;
          if (m < NLAT) { xi = xin_lat + (size_t)m * 1024 + n; xo = p.out + (size_t)m * 1024 + n; }
          else { xo = (float*)(p.ws + OFF_CTXB) + (size_t)(m - NLAT) * 1024 + n; xi = xo; }
          const float4 xv = *(const float4*)xi;
          float4 o; o.x = xv.x + gt.x * v0; o.y = xv.y + gt.y * v1; o.z = xv.z + gt.z * v2; o.w = xv.w + gt.w * v3;
          *(float4*)xo = o;
        } else {
          uint2 o; o.x = pack2(v0, v1); o.y = pack2(v2, v3);
          *(uint2*)((bf16_t*)(p.ws + OFF_P) + (size_t)m * 2048 + n) = o;
        }
      }
    }
  }
}

__device__ __forceinline__ unsigned cvt_pk_bf16(float lo, float hi) {
  unsigned r;
  asm volatile("v_cvt_pk_bf16_f32 %0, %1, %2" : "=v"(r) : "v"(lo), "v"(hi));
  return r;
}
constexpr int DKS = 72;
__device__ __forceinline__ void diff_item(const Params& p, int layer, bool ctxq, int item, char* smem) {
  const bf16_t* P = (const bf16_t*)(p.ws + OFF_P);
  bf16_t* Y = (bf16_t*)(p.ws + OFF_ACT);
  const float* misc = (const float*)(p.ws + OFF_MISC);
  const float lam = misc[layer], lam_init = misc[2 + layer];
  const int tid = opaque_tid(), lane = tid & 63, wave = tid >> 6, lr = lane & 15, lq = lane >> 4;
  int b, h, mbase, nkeys;
  if (!ctxq) { b = item >> 7; h = (item >> 5) & 3; mbase = b * 4096 + (item & 31) * 128; nkeys = 256 + 4096; }
  else { b = item >> 3; h = (item >> 1) & 3; mbase = NLAT + b * 256 + (item & 1) * 128; nkeys = 256; }
  const int mq = mbase + wave * 16 + lr;
  bf16x8 qf[2];
  {
    const bf16_t* qr = P + (size_t)mq * INC + C_DFQ + h * 64 + lq * 8;
    qf[0] = *(const bf16x8*)(qr);
    qf[1] = *(const bf16x8*)(qr + 32);
  }
  f32x4 O0[4], O1[4];
#pragma unroll
  for (int i = 0; i < 4; ++i) { O0[i] = (f32x4){0.f, 0.f, 0.f, 0.f}; O1[i] = (f32x4){0.f, 0.f, 0.f, 0.f}; }
  float m0 = -1e30f, m1 = -1e30f, l0 = 0.f, l1 = 0.f;
  const int lkey = tid >> 3, lch = tid & 7;
  uint4 uk, uv;
  auto gload = [&](int k0) {
    const int kk = k0 + lkey;
    const size_t row = kk < 256 ? (size_t)(NLAT + b * 256 + kk) : (size_t)(b * 4096 + kk - 256);
    uk = *(const uint4*)(P + row * INC + C_DFK + h * 64 + lch * 8);
    uv = *(const uint4*)(P + row * INC + C_DFV + h * 64 + lch * 8);
  };
  auto lstore = [&](int buf) {
    bf16_t* Ks = (bf16_t*)(smem + buf * (2 * 64 * DKS * 2));
    bf16_t* Vt = Ks + 64 * DKS;
    *(uint4*)(Ks + lkey * DKS + lch * 8) = uk;
    bf16_t* vd = Vt + (lch * 8) * DKS + lkey;
    vd[0 * DKS] = (bf16_t)(uv.x & 0xffffu); vd[1 * DKS] = (bf16_t)(uv.x >> 16);
    vd[2 * DKS] = (bf16_t)(uv.y & 0xffffu); vd[3 * DKS] = (bf16_t)(uv.y >> 16);
    vd[4 * DKS] = (bf16_t)(uv.z & 0xffffu); vd[5 * DKS] = (bf16_t)(uv.z >> 16);
    vd[6 * DKS] = (bf16_t)(uv.w & 0xffffu); vd[7 * DKS] = (bf16_t)(uv.w >> 16);
  };
  __syncthreads();
  gload(0);
  lstore(0);
  __syncthreads();
  const int ntile = nkeys >> 6;
#pragma unroll 1
  for (int t = 0; t < ntile; ++t) {
    const int cur = t & 1;
    if (t + 1 < ntile) gload((t + 1) * 64);
    const bf16_t* Ks = (const bf16_t*)(smem + cur * (2 * 64 * DKS * 2));
    const bf16_t* Vt = Ks + 64 * DKS;
    f32x4 S0[4], S1[4];
#pragma unroll
    for (int kt = 0; kt < 4; ++kt) {
      const bf16x8 k0f = *(const bf16x8*)(Ks + (kt * 16 + lr) * DKS + lq * 8);
      const bf16x8 k1f = *(const bf16x8*)(Ks + (kt * 16 + lr) * DKS + 32 + lq * 8);
      S0[kt] = __builtin_amdgcn_mfma_f32_16x16x32_bf16(k0f, qf[0], (f32x4){0.f, 0.f, 0.f, 0.f}, 0, 0, 0);
      S1[kt] = __builtin_amdgcn_mfma_f32_16x16x32_bf16(k1f, qf[1], (f32x4){0.f, 0.f, 0.f, 0.f}, 0, 0, 0);
    }
    float x0 = fmaxf(fmaxf(S0[0][0], S0[0][1]), fmaxf(S0[0][2], S0[0][3]));
    float x1 = fmaxf(fmaxf(S1[0][0], S1[0][1]), fmaxf(S1[0][2], S1[0][3]));
#pragma unroll
    for (int kt = 1; kt < 4; ++kt) {
      x0 = fmaxf(x0, fmaxf(fmaxf(S0[kt][0], S0[kt][1]), fmaxf(S0[kt][2], S0[kt][3])));
      x1 = fmaxf(x1, fmaxf(fmaxf(S1[kt][0], S1[kt][1]), fmaxf(S1[kt][2], S1[kt][3])));
    }
    x0 = fmaxf(x0, __shfl_xor(x0, 16)); x0 = fmaxf(x0, __shfl_xor(x0, 32));
    x1 = fmaxf(x1, __shfl_xor(x1, 16)); x1 = fmaxf(x1, __shfl_xor(x1, 32));
    const float mn0 = fmaxf(m0, x0), mn1 = fmaxf(m1, x1);
    const float al0 = __builtin_amdgcn_exp2f(m0 - mn0), al1 = __builtin_amdgcn_exp2f(m1 - mn1);
    m0 = mn0; m1 = mn1;
    float ps0 = 0.f, ps1 = 0.f;
#pragma unroll
    for (int kt = 0; kt < 4; ++kt) {
#pragma unroll
      for (int r = 0; r < 4; ++r) {
        S0[kt][r] = __builtin_amdgcn_exp2f(S0[kt][r] - mn0); ps0 += S0[kt][r];
        S1[kt][r] = __builtin_amdgcn_exp2f(S1[kt][r] - mn1); ps1 += S1[kt][r];
      }
    }
    l0 = l0 * al0 + ps0; l1 = l1 * al1 + ps1;
#pragma unroll
    for (int dt = 0; dt < 4; ++dt) {
#pragma unroll
      for (int r = 0; r < 4; ++r) { O0[dt][r] *= al0; O1[dt][r] *= al1; }
    }
#pragma unroll
    for (int g = 0; g < 2; ++g) {
      union { unsigned u[4]; bf16x8 v; } pf0, pf1;
      pf0.u[0] = cvt_pk_bf16(S0[2 * g][0], S0[2 * g][1]); pf0.u[1] = cvt_pk_bf16(S0[2 * g][2], S0[2 * g][3]);
      pf0.u[2] = cvt_pk_bf16(S0[2 * g + 1][0], S0[2 * g + 1][1]); pf0.u[3] = cvt_pk_bf16(S0[2 * g + 1][2], S0[2 * g + 1][3]);
      pf1.u[0] = cvt_pk_bf16(S1[2 * g][0], S1[2 * g][1]); pf1.u[1] = cvt_pk_bf16(S1[2 * g][2], S1[2 * g][3]);
      pf1.u[2] = cvt_pk_bf16(S1[2 * g + 1][0], S1[2 * g + 1][1]); pf1.u[3] = cvt_pk_bf16(S1[2 * g + 1][2], S1[2 * g + 1][3]);
#pragma unroll
      for (int dt = 0; dt < 4; ++dt) {
        union { uint2 h[2]; bf16x8 v; } vf;
        vf.h[0] = *(const uint2*)(Vt + (dt * 16 + lr) * DKS + 32 * g + 4 * lq);
        vf.h[1] = *(const uint2*)(Vt + (dt * 16 + lr) * DKS + 32 * g + 16 + 4 * lq);
        O0[dt] = __builtin_amdgcn_mfma_f32_16x16x32_bf16(vf.v, pf0.v, O0[dt], 0, 0, 0);
        O1[dt] = __builtin_amdgcn_mfma_f32_16x16x32_bf16(vf.v, pf1.v, O1[dt], 0, 0, 0);
      }
    }
    if (t + 1 < ntile) lstore(cur ^ 1);
    __syncthreads();
  }
  l0 += __shfl_xor(l0, 16); l0 += __shfl_xor(l0, 32);
  l1 += __shfl_xor(l1, 16); l1 += __shfl_xor(l1, 32);
  const float i0 = 1.f / l0, i1 = lam / l1;
  float ss = 0.f;
#pragma unroll
  for (int dt = 0; dt < 4; ++dt) {
#pragma unroll
    for (int r = 0; r < 4; ++r) { const float v = O0[dt][r] * i0 - O1[dt][r] * i1; O0[dt][r] = v; ss = fmaf(v, v, ss); }
  }
  ss += __shfl_xor(ss, 16); ss += __shfl_xor(ss, 32);
  const float rr = rsqrtf(ss * (1.f / 64.f) + EPS) * (1.f - lam_init);
  const float* sg = p.diff_subln_g + layer * 64;
  bf16_t* dst = Y + (size_t)mq * 1024 + Y_DF + h * 64;
#pragma unroll
  for (int dt = 0; dt < 4; ++dt) {
    const int d = dt * 16 + 4 * lq;
    const float4 g4 = *(const float4*)(sg + d);
    uint2 ov;
    ov.x = pack2(O0[dt][0] * rr * g4.x, O0[dt][1] * rr * g4.y);
    ov.y = pack2(O0[dt][2] * rr * g4.z, O0[dt][3] * rr * g4.w);
    *(uint2*)(dst + d) = ov;
  }
}

constexpr int NA_WS = 520;
constexpr int NA_CS = 264;
constexpr int NA_OFF_VTW = 0;
constexpr int NA_OFF_VTC = 64 * NA_WS * 2;
constexpr int NA_OFF_RPB = NA_OFF_VTC + 64 * NA_CS * 2;
constexpr int NA_OFF_MRG = NA_OFF_RPB + 2048;

#define NA_STEP(KPTR_EXPR, BIAS_EXPR, VT_PTR, VT_STRIDE, VT_KEY0_EXPR)                                           \
  {                                                                                                               \
    f32x4 S[4];                                                                                                   \
    _Pragma("unroll") for (int kt = 0; kt < 4; ++kt) {                                                            \
      const bf16_t* kp = (KPTR_EXPR);                                                                             \
      const bf16x8 ka = *(const bf16x8*)(kp + lq * 8);                                                            \
      const bf16x8 kb = *(const bf16x8*)(kp + 32 + lq * 8);                                                       \
      f32x4 a = __builtin_amdgcn_mfma_f32_16x16x32_bf16(ka, qf[0], (f32x4){0.f, 0.f, 0.f, 0.f}, 0, 0, 0);         \
      S[kt] = __builtin_amdgcn_mfma_f32_16x16x32_bf16(kb, qf[1], a, 0, 0, 0);                                      \
    }                                                                                                             \
    _Pragma("unroll") for (int kt = 0; kt < 4; ++kt) {                                                            \
      _Pragma("unroll") for (int r = 0; r < 4; ++r) { S[kt][r] += (BIAS_EXPR); }                                  \
    }                                                                                                             \
    float x = fmaxf(fmaxf(S[0][0], S[0][1]), fmaxf(S[0][2], S[0][3]));                                            \
    _Pragma("unroll") for (int kt = 1; kt < 4; ++kt) x = fmaxf(x, fmaxf(fmaxf(S[kt][0], S[kt][1]), fmaxf(S[kt][2], S[kt][3]))); \
    x = fmaxf(x, __shfl_xor(x, 16)); x = fmaxf(x, __shfl_xor(x, 32));                                             \
    const float mn = fmaxf(mrun, x);                                                                              \
    const float al = __builtin_amdgcn_exp2f(mrun - mn);                                                           \
    mrun = mn;                                                                                                    \
    float ps = 0.f;                                                                                               \
    _Pragma("unroll") for (int kt = 0; kt < 4; ++kt) {                                                            \
      _Pragma("unroll") for (int r = 0; r < 4; ++r) { S[kt][r] = __builtin_amdgcn_exp2f(S[kt][r] - mn); ps += S[kt][r]; } \
    }                                                                                                             \
    lrun = lrun * al + ps;                                                                                        \
    _Pragma("unroll") for (int dt = 0; dt < 4; ++dt) {                                                            \
      _Pragma("unroll") for (int r = 0; r < 4; ++r) O[dt][r] *= al;                                               \
    }                                                                                                             \
    _Pragma("unroll") for (int g = 0; g < 2; ++g) {                                                               \
      union { unsigned u[4]; bf16x8 v; } pf;                                                                      \
      pf.u[0] = cvt_pk_bf16(S[2 * g][0], S[2 * g][1]); pf.u[1] = cvt_pk_bf16(S[2 * g][2], S[2 * g][3]);           \
      pf.u[2] = cvt_pk_bf16(S[2 * g + 1][0], S[2 * g + 1][1]); pf.u[3] = cvt_pk_bf16(S[2 * g + 1][2], S[2 * g + 1][3]); \
      const int vk0 = (VT_KEY0_EXPR);                                                                             \
      _Pragma("unroll") for (int dt = 0; dt < 4; ++dt) {                                                          \
        union { uint2 h2[2]; bf16x8 v; } vf;                                                                      \
        vf.h2[0] = *(const uint2*)((VT_PTR) + (dt * 16 + lr) * (VT_STRIDE) + vk0 + 4 * lq);                       \
        vf.h2[1] = *(const uint2*)((VT_PTR) + (dt * 16 + lr) * (VT_STRIDE) + vk0 + 16 + 4 * lq);                  \
        O[dt] = __builtin_amdgcn_mfma_f32_16x16x32_bf16(vf.v, pf.v, O[dt], 0, 0, 0);                              \
      }                                                                                                           \
    }                                                                                                             \
  }

__device__ __forceinline__ void vt_store8(bf16_t* vt, int stride, int d0, int key, uint4 uv) {
  bf16_t* vd = vt + d0 * stride + key;
  vd[0 * stride] = (bf16_t)(uv.x & 0xffffu); vd[1 * stride] = (bf16_t)(uv.x >> 16);
  vd[2 * stride] = (bf16_t)(uv.y & 0xffffu); vd[3 * stride] = (bf16_t)(uv.y >> 16);
  vd[4 * stride] = (bf16_t)(uv.z & 0xffffu); vd[5 * stride] = (bf16_t)(uv.z >> 16);
  vd[6 * stride] = (bf16_t)(uv.w & 0xffffu); vd[7 * stride] = (bf16_t)(uv.w >> 16);
}

__device__ __forceinline__ void na_latent_item(const Params& p, int layer, int item, char* smem) {
  const bf16_t* P = (const bf16_t*)(p.ws + OFF_P);
  bf16_t* Y = (bf16_t*)(p.ws + OFF_ACT);
  const int b = item >> 8, h = (item >> 6) & 3, grow = item & 63;
  const int tid = opaque_tid(), lane = tid & 63, wave = tid >> 6, lr = lane & 15, lq = lane >> 4;
  const int jt = wave & 3, half = wave >> 2;
  bf16_t* VtW = (bf16_t*)(smem + NA_OFF_VTW);
  bf16_t* VtC = (bf16_t*)(smem + NA_OFF_VTC);
  float* RPB = (float*)(smem + NA_OFF_RPB);
  float* MRG = (float*)(smem + NA_OFF_MRG);
  const int rs = min(max(grow - 4, 0), 56);
  __syncthreads();
  {
    const int ch = tid & 7;
#pragma unroll
    for (int i = 0; i < 8; ++i) {
      const int key = (tid >> 3) + 64 * i;
      const uint4 uv = *(const uint4*)(P + (size_t)(b * 4096 + (rs + (key >> 6)) * 64 + (key & 63)) * INC + C_NAV + h * 64 + ch * 8);
      vt_store8(VtW, NA_WS, ch * 8, key, uv);
    }
#pragma unroll
    for (int i = 0; i < 4; ++i) {
      const int key = (tid >> 3) + 64 * i;
      const uint4 uv = *(const uint4*)(P + (size_t)(NLAT + b * 256 + key) * INC + C_NAV + h * 64 + ch * 8);
      vt_store8(VtC, NA_CS, ch * 8, key, uv);
    }
    if (tid < 465) RPB[tid] = p.na_rpb[(size_t)(layer * 4 + h) * 465 + tid] * 1.4426950408889634f;
  }
  const int qc = jt * 16 + lr;
  const int mq = b * 4096 + grow * 64 + qc;
  bf16x8 qf[2];
  {
    const bf16_t* qr = P + (size_t)mq * INC + C_NAQ + h * 64 + lq * 8;
    qf[0] = *(const bf16x8*)(qr);
    qf[1] = *(const bf16x8*)(qr + 32);
  }
  f32x4 O[4];
#pragma unroll
  for (int i = 0; i < 4; ++i) O[i] = (f32x4){0.f, 0.f, 0.f, 0.f};
  float mrun = -1e30f, lrun = 0.f;
  __syncthreads();
  if (half == 0) {
    const int k0 = min(max(jt * 16 - 8, 0), 32);
    const int cs = min(max(qc - 8, 0), 48);
#pragma unroll 1
    for (int s = 0; s < 4; ++s) {
      const int wr0 = 2 * s;
      NA_STEP(P + (size_t)(b * 4096 + (rs + wr0 + (kt >> 1)) * 64 + k0 + 16 * (kt & 1) + lr) * INC + C_NAK + h * 64,
              ((k0 + 16 * (kt & 1) + 4 * lq + r) >= cs && (k0 + 16 * (kt & 1) + 4 * lq + r) < cs + 16)
                  ? RPB[(rs + wr0 + (kt >> 1) - grow + 7) * 31 + (k0 + 16 * (kt & 1) + 4 * lq + r) - qc + 15] : -1e30f,
              VtW, NA_WS, (wr0 + g) * 64 + k0)
    }
  } else {
#pragma unroll 1
    for (int s = 0; s < 4; ++s) {
      NA_STEP(P + (size_t)(NLAT + b * 256 + s * 64 + kt * 16 + lr) * INC + C_NAK + h * 64, 0.f, VtC, NA_CS, s * 64 + 32 * g)
    }
  }
  lrun += __shfl_xor(lrun, 16); lrun += __shfl_xor(lrun, 32);
  float* mg = MRG + (jt * 64 + lane) * 18;
  if (half == 1) {
    mg[0] = mrun; mg[1] = lrun;
#pragma unroll
    for (int dt = 0; dt < 4; ++dt) { mg[2 + dt * 4 + 0] = O[dt][0]; mg[2 + dt * 4 + 1] = O[dt][1]; mg[2 + dt * 4 + 2] = O[dt][2]; mg[2 + dt * 4 + 3] = O[dt][3]; }
  }
  __syncthreads();
  if (half == 0) {
    const float m2 = mg[0], l2 = mg[1];
    const float M = fmaxf(mrun, m2);
    const float f1 = __builtin_amdgcn_exp2f(mrun - M), f2 = __builtin_amdgcn_exp2f(m2 - M);
    const float inv = 1.f / (lrun * f1 + l2 * f2);
    bf16_t* dst = Y + (size_t)mq * 1024 + Y_NA + h * 64;
#pragma unroll
    for (int dt = 0; dt < 4; ++dt) {
      const float o0 = (O[dt][0] * f1 + mg[2 + dt * 4 + 0] * f2) * inv, o1 = (O[dt][1] * f1 + mg[2 + dt * 4 + 1] * f2) * inv;
      const float o2 = (O[dt][2] * f1 + mg[2 + dt * 4 + 2] * f2) * inv, o3 = (O[dt][3] * f1 + mg[2 + dt * 4 + 3] * f2) * inv;
      uint2 ov; ov.x = pack2(o0, o1); ov.y = pack2(o2, o3);
      *(uint2*)(dst + dt * 16 + 4 * lq) = ov;
    }
  }
}

__device__ __forceinline__ void na_ctx_item(const Params& p, int item, char* smem) {
  const bf16_t* P = (const bf16_t*)(p.ws + OFF_P);
  bf16_t* Y = (bf16_t*)(p.ws + OFF_ACT);
  const int b = item >> 3, h = (item >> 1) & 3, qg = item & 1;
  const int tid = opaque_tid(), lane = tid & 63, wave = tid >> 6, lr = lane & 15, lq = lane >> 4;
  bf16_t* VtC = (bf16_t*)(smem + NA_OFF_VTC);
  __syncthreads();
  {
    const int ch = tid & 7;
#pragma unroll
    for (int i = 0; i < 4; ++i) {
      const int key = (tid >> 3) + 64 * i;
      const uint4 uv = *(const uint4*)(P + (size_t)(NLAT + b * 256 + key) * INC + C_NAV + h * 64 + ch * 8);
      vt_store8(VtC, NA_CS, ch * 8, key, uv);
    }
  }
  const int mq = NLAT + b * 256 + qg * 128 + wave * 16 + lr;
  bf16x8 qf[2];
  {
    const bf16_t* qr = P + (size_t)mq * INC + C_NAQ + h * 64 + lq * 8;
    qf[0] = *(const bf16x8*)(qr);
    qf[1] = *(const bf16x8*)(qr + 32);
  }
  f32x4 O[4];
#pragma unroll
  for (int i = 0; i < 4; ++i) O[i] = (f32x4){0.f, 0.f, 0.f, 0.f};
  float mrun = -1e30f, lrun = 0.f;
  __syncthreads();
#pragma unroll 1
  for (int s = 0; s < 4; ++s) {
    NA_STEP(P + (size_t)(NLAT + b * 256 + s * 64 + kt * 16 + lr) * INC + C_NAK + h * 64, 0.f, VtC, NA_CS, s * 64 + 32 * g)
  }
  lrun += __shfl_xor(lrun, 16); lrun += __shfl_xor(lrun, 32);
  const float inv = 1.f / lrun;
  bf16_t* dst = Y + (size_t)mq * 1024 + Y_NA + h * 64;
#pragma unroll
  for (int dt = 0; dt < 4; ++dt) {
    uint2 ov; ov.x = pack2(O[dt][0] * inv, O[dt][1] * inv); ov.y = pack2(O[dt][2] * inv, O[dt][3] * inv);
    *(uint2*)(dst + dt * 16 + 4 * lq) = ov;
  }
}

__device__ __forceinline__ void ret_kv_item(const Params& p, int layer, int h, size_t row0, int cnt, float* dstF, float* dstB) {
  const bf16_t* P = (const bf16_t*)(p.ws + OFF_P);
  const float* misc = (const float*)(p.ws + OFF_MISC);
  const float lgF = misc[16 + layer * 8 + 0 * 4 + h], lgB = misc[16 + layer * 8 + 1 * 4 + h];
  const int d = opaque_tid() >> 3, e0 = (opaque_tid() & 7) * 16;
  float aF[16], aB[16];
#pragma unroll
  for (int i = 0; i < 16; ++i) { aF[i] = 0.f; aB[i] = 0.f; }
#pragma unroll 2
  for (int j = 0; j < cnt; ++j) {
    const bf16_t* rowp = P + (row0 + j) * INC;
    const float kd = bf2f(rowp[C_RTK + h * 64 + d]);
    const uint4 u0 = *(const uint4*)(rowp + C_RTV + h * 128 + e0);
    const uint4 u1 = *(const uint4*)(rowp + C_RTV + h * 128 + e0 + 8);
    const float wF = kd * __expf(lgF * (float)(cnt - 1 - j)), wB = kd * __expf(lgB * (float)j);
    AXPY8(aF, 0, wF, u0) AXPY8(aF, 8, wF, u1)
    AXPY8(aB, 0, wB, u0) AXPY8(aB, 8, wB, u1)
  }
#pragma unroll
  for (int i = 0; i < 16; i += 4) {
    *(float4*)(dstF + d * 128 + e0 + i) = make_float4(aF[i], aF[i + 1], aF[i + 2], aF[i + 3]);
    *(float4*)(dstB + d * 128 + e0 + i) = make_float4(aB[i], aB[i + 1], aB[i + 2], aB[i + 3]);
  }
}

__device__ __forceinline__ void phase_ret_scan(const Params& p, int layer) {
  const float* misc = (const float*)(p.ws + OFF_MISC);
  float* rkv = (float*)(p.ws + OFF_RKV);
  const float* rs = (const float*)(p.ws + OFF_RS);
  const int gt = opaque_bid() * blockDim.x + opaque_tid(), gs = gridDim.x * blockDim.x;
  for (int idx = gt; idx < 64 * 8192; idx += gs) {
    const int seq = idx >> 13, elem = idx & 8191;
    const int dir = seq & 1, h = (seq >> 1) & 3;
    const float cdec = __expf(misc[16 + layer * 8 + dir * 4 + h] * 128.f);
    float state = rs[(size_t)seq * 8192 + elem];
    for (int s = 0; s < 32; ++s) {
      const int n = dir == 0 ? s : 31 - s;
      float* ptr = rkv + ((size_t)seq * 32 + n) * 8192 + elem;
      const float tmp = *ptr;
      *ptr = state;
      state = fmaf(cdec, state, tmp);
    }
  }
}

constexpr int RT_KS = 72, RT_VS = 136;
constexpr int RT_OFF_K = 0, RT_OFF_VT = 128 * RT_KS * 2, RT_OFF_SF = RT_OFF_VT + 128 * RT_VS * 2, RT_OFF_SB = RT_OFF_SF + 128 * RT_KS * 2;
__device__ __forceinline__ void ret_out_item(const Params& p, int layer, int h, size_t krow0, int nkc, int iq0,
                                             const float* SF, const float* SB, int clen, char* smem) {
  const bf16_t* P = (const bf16_t*)(p.ws + OFF_P);
  bf16_t* Y = (bf16_t*)(p.ws + OFF_ACT);
  const float* misc = (const float*)(p.ws + OFF_MISC);
  const float lgF2 = misc[16 + layer * 8 + 0 * 4 + h] * 1.4426950408889634f, lgB2 = misc[16 + layer * 8 + 1 * 4 + h] * 1.4426950408889634f;
  const int tid = opaque_tid(), lane = tid & 63, wave = tid >> 6, lr = lane & 15, lq = lane >> 4;
  bf16_t* Ks = (bf16_t*)(smem + RT_OFF_K);
  bf16_t* Vt = (bf16_t*)(smem + RT_OFF_VT);
  bf16_t* SFt = (bf16_t*)(smem + RT_OFF_SF);
  bf16_t* SBt = (bf16_t*)(smem + RT_OFF_SB);
  const int iq = iq0 + wave * 16 + lr;
  const size_t mq = krow0 + iq;
  bf16x8 qf[2];
  {
    const bf16_t* qr = P + mq * INC + C_RTQ + h * 64 + lq * 8;
    qf[0] = *(const bf16x8*)(qr);
    qf[1] = *(const bf16x8*)(qr + 32);
  }
  f32x4 O[8];
#pragma unroll
  for (int i = 0; i < 8; ++i) O[i] = (f32x4){0.f, 0.f, 0.f, 0.f};
  if (SF != nullptr) {
    __syncthreads();
    {
      const int d = tid >> 3, e0 = (tid & 7) * 16;
#pragma unroll
      for (int c4 = 0; c4 < 4; ++c4) {
        const float4 a = *(const float4*)(SF + d * 128 + e0 + c4 * 4);
        const float4 bb = *(const float4*)(SB + d * 128 + e0 + c4 * 4);
        SFt[(e0 + c4 * 4 + 0) * RT_KS + d] = f2bf(a.x); SFt[(e0 + c4 * 4 + 1) * RT_KS + d] = f2bf(a.y);
        SFt[(e0 + c4 * 4 + 2) * RT_KS + d] = f2bf(a.z); SFt[(e0 + c4 * 4 + 3) * RT_KS + d] = f2bf(a.w);
        SBt[(e0 + c4 * 4 + 0) * RT_KS + d] = f2bf(bb.x); SBt[(e0 + c4 * 4 + 1) * RT_KS + d] = f2bf(bb.y);
        SBt[(e0 + c4 * 4 + 2) * RT_KS + d] = f2bf(bb.z); SBt[(e0 + c4 * 4 + 3) * RT_KS + d] = f2bf(bb.w);
      }
    }
    __syncthreads();
    const float cF = __builtin_amdgcn_exp2f(lgF2 * (float)(iq + 1)), cB = __builtin_amdgcn_exp2f(lgB2 * (float)(clen - iq));
#pragma unroll
    for (int ks = 0; ks < 2; ++ks)
#pragma unroll
      for (int et = 0; et < 8; ++et) {
        const bf16x8 sf = *(const bf16x8*)(SFt + (et * 16 + lr) * RT_KS + ks * 32 + lq * 8);
        O[et] = __builtin_amdgcn_mfma_f32_16x16x32_bf16(sf, qf[ks], O[et], 0, 0, 0);
      }
    const float ratio = cF / cB;
#pragma unroll
    for (int et = 0; et < 8; ++et) { O[et][0] *= ratio; O[et][1] *= ratio; O[et][2] *= ratio; O[et][3] *= ratio; }
#pragma unroll
    for (int ks = 0; ks < 2; ++ks)
#pragma unroll
      for (int et = 0; et < 8; ++et) {
        const bf16x8 sb = *(const bf16x8*)(SBt + (et * 16 + lr) * RT_KS + ks * 32 + lq * 8);
        O[et] = __builtin_amdgcn_mfma_f32_16x16x32_bf16(sb, qf[ks], O[et], 0, 0, 0);
      }
#pragma unroll
    for (int et = 0; et < 8; ++et) { O[et][0] *= cB; O[et][1] *= cB; O[et][2] *= cB; O[et][3] *= cB; }
  }
#pragma unroll 1
  for (int kc = 0; kc < nkc; ++kc) {
    __syncthreads();
    {
      const int key = tid >> 2, c = tid & 3;
      const bf16_t* rowp = P + (krow0 + kc * 128 + key) * INC;
      const uint4 k0 = *(const uint4*)(rowp + C_RTK + h * 64 + c * 16), k1 = *(const uint4*)(rowp + C_RTK + h * 64 + c * 16 + 8);
      *(uint4*)(Ks + key * RT_KS + c * 16) = k0;
      *(uint4*)(Ks + key * RT_KS + c * 16 + 8) = k1;
#pragma unroll
      for (int c8 = 0; c8 < 4; ++c8) {
        const uint4 uv = *(const uint4*)(rowp + C_RTV + h * 128 + c * 32 + c8 * 8);
        vt_store8(Vt, RT_VS, c * 32 + c8 * 8, key, uv);
      }
    }
    __syncthreads();
    f32x4 S[8];
#pragma unroll
    for (int kt = 0; kt < 8; ++kt) {
      const bf16x8 ka = *(const bf16x8*)(Ks + (kt * 16 + lr) * RT_KS + lq * 8);
      const bf16x8 kb = *(const bf16x8*)(Ks + (kt * 16 + lr) * RT_KS + 32 + lq * 8);
      const f32x4 a = __builtin_amdgcn_mfma_f32_16x16x32_bf16(ka, qf[0], (f32x4){0.f, 0.f, 0.f, 0.f}, 0, 0, 0);
      S[kt] = __builtin_amdgcn_mfma_f32_16x16x32_bf16(kb, qf[1], a, 0, 0, 0);
    }
#pragma unroll
    for (int kt = 0; kt < 8; ++kt) {
#pragma unroll
      for (int r = 0; r < 4; ++r) {
        const int df = iq - (kc * 128 + kt * 16 + 4 * lq + r);
        const float fdf = (float)df;
        float coef = 0.f;
        if (df >= 0) coef += __builtin_amdgcn_exp2f(lgF2 * fdf);
        if (df <= 0) coef += __builtin_amdgcn_exp2f(-lgB2 * fdf);
        S[kt][r] *= coef;
      }
    }
#pragma unroll
    for (int g = 0; g < 4; ++g) {
      union { unsigned u[4]; bf16x8 v; } pf;
      pf.u[0] = cvt_pk_bf16(S[2 * g][0], S[2 * g][1]); pf.u[1] = cvt_pk_bf16(S[2 * g][2], S[2 * g][3]);
      pf.u[2] = cvt_pk_bf16(S[2 * g + 1][0], S[2 * g + 1][1]); pf.u[3] = cvt_pk_bf16(S[2 * g + 1][2], S[2 * g + 1][3]);
#pragma unroll
      for (int et = 0; et < 8; ++et) {
        union { uint2 h2[2]; bf16x8 v; } vf;
        vf.h2[0] = *(const uint2*)(Vt + (et * 16 + lr) * RT_VS + 32 * g + 4 * lq);
        vf.h2[1] = *(const uint2*)(Vt + (et * 16 + lr) * RT_VS + 32 * g + 16 + 4 * lq);
        O[et] = __builtin_amdgcn_mfma_f32_16x16x32_bf16(vf.v, pf.v, O[et], 0, 0, 0);
      }
    }
  }
  float ss = 0.f;
#pragma unroll
  for (int et = 0; et < 8; ++et) { ss = fmaf(O[et][0], O[et][0], ss); ss = fmaf(O[et][1], O[et][1], ss); ss = fmaf(O[et][2], O[et][2], ss); ss = fmaf(O[et][3], O[et][3], ss); }
  ss += __shfl_xor(ss, 16); ss += __shfl_xor(ss, 32);
  const float rr = rsqrtf(ss * (1.f / 128.f) + EPS);
  const bf16_t* gp = P + mq * INC + C_RTG + h * 128;
  bf16_t* dst = Y + mq * 1024 + Y_RT + h * 128;
#pragma unroll
  for (int et = 0; et < 8; ++et) {
    const int e = et * 16 + 4 * lq;
    const uint2 gu = *(const uint2*)(gp + e);
    uint2 ov;
    ov.x = pack2(O[et][0] * rr * siluf(lo16(gu.x)), O[et][1] * rr * siluf(hi16(gu.x)));
    ov.y = pack2(O[et][2] * rr * siluf(lo16(gu.y)), O[et][3] * rr * siluf(hi16(gu.y)));
    *(uint2*)(dst + e) = ov;
  }
}

__device__ __forceinline__ void phase_mix1(const Params& p, int layer, char* smem, int slot = 0) {
  unsigned* ctr = (unsigned*)(p.ws + OFF_CTL) + (layer * 4 + slot);
  const bool nc = layer == 0;
  const int n_dl = 1024, n_dc = nc ? 64 : 0, n_nl = 2048, n_ncx = nc ? 64 : 0, n_kv = 1024, n_cs = 32;
  const int total = n_dl + n_dc + n_nl + n_ncx + n_kv + n_cs;
  float* rkv = (float*)(p.ws + OFF_RKV);
  float* rs = (float*)(p.ws + OFF_RS);
  for (;;) {
    int it = next_item(ctr, smem);
    if (it >= total) break;
    if (it < n_dl) { diff_item(p, layer, false, it, smem); continue; } it -= n_dl;
    if (it < n_dc) { diff_item(p, layer, true, it, smem); continue; } it -= n_dc;
    if (it < n_nl) { na_latent_item(p, layer, it, smem); continue; } it -= n_nl;
    if (it < n_ncx) { na_ctx_item(p, it, smem); continue; } it -= n_ncx;
    if (it < n_kv) {
      const int bh = it >> 5, n = it & 31, b = bh >> 2, h = bh & 3;
      ret_kv_item(p, layer, h, (size_t)b * 4096 + n * 128, 128,
                  rkv + ((size_t)(bh * 2 + 0) * 32 + n) * 8192, rkv + ((size_t)(bh * 2 + 1) * 32 + n) * 8192);
      continue;
    }
    it -= n_kv;
    {
      const int bh = it, b = bh >> 2, h = bh & 3;
      ret_kv_item(p, layer, h, (size_t)NLAT + b * 256, 256, rs + (size_t)(bh * 2 + 0) * 8192, rs + (size_t)(bh * 2 + 1) * 8192);
    }
  }
}

__device__ __forceinline__ void phase_mix2(const Params& p, int layer, char* smem, int slot = 1) {
  unsigned* ctr = (unsigned*)(p.ws + OFF_CTL) + (layer * 4 + slot);
  const int n_l = 1024, n_c = layer == 0 ? 64 : 0;
  const float* rkv = (const float*)(p.ws + OFF_RKV);
  for (;;) {
    int it = next_item(ctr, smem);
    if (it >= n_l + n_c) break;
    if (it < n_l) {
      const int bh = it >> 5, n = it & 31, b = bh >> 2, h = bh & 3;
      ret_out_item(p, layer, h, (size_t)b * 4096 + n * 128, 1, 0,
                   rkv + ((size_t)(bh * 2 + 0) * 32 + n) * 8192, rkv + ((size_t)(bh * 2 + 1) * 32 + n) * 8192, 128, smem);
    } else {
      it -= n_l;
      const int bh = it >> 1, half = it & 1, b = bh >> 2, h = bh & 3;
      ret_out_item(p, layer, h, (size_t)NLAT + b * 256, 2, half * 128, nullptr, nullptr, 256, smem);
    }
  }
}

typedef float f32x2 __attribute__((ext_vector_type(2)));
__device__ __forceinline__ unsigned sortable_key(float f, int idx) {
  const unsigned b = __float_as_uint(f);
  const unsigned k = b ^ ((unsigned)((int)b >> 31) | 0x80000000u);
  return (k & ~127u) | (unsigned)(127 - idx);
}
__device__ __forceinline__ float key_value(unsigned k) {
  k &= ~127u;
  const unsigned b = (k & 0x80000000u) ? (k ^ 0x80000000u) : ~k;
  return __uint_as_float(b);
}
#define FP8DOT(acc, H, off, W) { const f32x2 _a = __builtin_amdgcn_cvt_pk_f32_fp8((int)(W), false), _b = __builtin_amdgcn_cvt_pk_f32_fp8((int)(W), true); \
  acc = fmaf(H[(off) + 0], _a.x, acc); acc = fmaf(H[(off) + 1], _a.y, acc); acc = fmaf(H[(off) + 2], _b.x, acc); acc = fmaf(H[(off) + 3], _b.y, acc); }
#define FP8AXPY(O, off, P, W) { const f32x2 _a = __builtin_amdgcn_cvt_pk_f32_fp8((int)(W), false), _b = __builtin_amdgcn_cvt_pk_f32_fp8((int)(W), true); \
  O[(off) + 0] = fmaf(P, _a.x, O[(off) + 0]); O[(off) + 1] = fmaf(P, _a.y, O[(off) + 1]); O[(off) + 2] = fmaf(P, _b.x, O[(off) + 2]); O[(off) + 3] = fmaf(P, _b.y, O[(off) + 3]); }

__device__ __forceinline__ void phase_peer(const Params& p, int layer, char* smem, int ntok, bool dowrite = true) {
  const bf16_t* Q = (const bf16_t*)(p.ws + OFF_P);
  const bf16_t* H2 = (const bf16_t*)(p.ws + OFF_ACT);
  const bf16_t* SK = (const bf16_t*)(p.ws + OFF_SUBK) + (size_t)layer * 262144;
  const char* U8 = p.ws + OFF_U + (size_t)layer * NEXP * 1024;
  const char* V8 = p.ws + OFF_V + (size_t)layer * NEXP * 1024;
  const float* USC = (const float*)(p.ws + OFF_USC) + layer * NEXP;
  const float* VSC = (const float*)(p.ws + OFF_VSC) + layer * NEXP;
  const float* mod = (const float*)(p.ws + OFF_MOD) + (size_t)layer * 9 * 6144;
  unsigned* SC = (unsigned*)smem;
  float* TV = (float*)(smem + 65536);
  int* TI = (int*)(smem + 65536 + 8192);
  float* CV = (float*)(smem + 81920);
  int* EX = (int*)(smem + 98304);
  float* GT = (float*)(smem + 98304 + 4096);
  int* CT = (int*)(smem + 98304 + 8192);
  const int tid = opaque_tid(), lane = tid & 63, wave = tid >> 6;
  const int lr = lane & 15, lq = lane >> 4;
  __syncthreads();
  if (tid == 0) {
    int c = 0;
    for (int a = 0; a < 16; ++a)
      for (int bb = 0; bb < 16; ++bb)
        if ((a + 1) * (bb + 1) <= 16) CT[c++] = a * 16 + bb;
    for (; c < 64; ++c) CT[c] = -1;
  }
  __syncthreads();
  const int ngroups = ntok / 8;
  for (int grp = opaque_bid(); grp < ngroups; grp += gridDim.x) {
    const int tok0 = grp * 8;
    {
      const int hd = wave;
#pragma unroll 1
      for (int pp = 0; pp < 2; ++pp) {
        bf16x8 af[4];
        const bf16_t* qrow = Q + (size_t)(tok0 + (lr & 7)) * 2048 + hd * 256 + pp * 128;
#pragma unroll
        for (int ks = 0; ks < 4; ++ks) af[ks] = *(const bf16x8*)(qrow + ks * 32 + lq * 8);
        const bf16_t* skb = SK + (size_t)((hd * 2 + pp) * 128) * 128;
#pragma unroll 2
        for (int nt = 0; nt < 8; ++nt) {
          f32x4 acc = (f32x4){0.f, 0.f, 0.f, 0.f};
#pragma unroll
          for (int ks = 0; ks < 4; ++ks) {
            const bf16x8 bfr = *(const bf16x8*)(skb + (size_t)(nt * 16 + lr) * 128 + ks * 32 + lq * 8);
            acc = __builtin_amdgcn_mfma_f32_16x16x32_bf16(af[ks], bfr, acc, 0, 0, 0);
          }
          if (lq < 2) {
#pragma unroll
            for (int r = 0; r < 4; ++r) SC[((lq * 4 + r) * 16 + hd * 2 + pp) * 128 + nt * 16 + lr] = sortable_key(acc[r], nt * 16 + lr);
          }
        }
      }
    }
    __syncthreads();
#pragma unroll 1
    for (int pass = 0; pass < 32; ++pass) {
      const int id = pass * 512 + tid, L = id >> 7, el = id & 127;
      const unsigned my = SC[L * 128 + el];
      const uint4* row = (const uint4*)(SC + L * 128);
      int rank = 0;
#pragma unroll 8
      for (int j4 = 0; j4 < 32; ++j4) {
        const uint4 v = row[j4];
        rank += (v.x > my) ? 1 : 0; rank += (v.y > my) ? 1 : 0; rank += (v.z > my) ? 1 : 0; rank += (v.w > my) ? 1 : 0;
      }
      if (rank < 16) { TV[L * 16 + rank] = key_value(my); TI[L * 16 + rank] = 127 - (int)(my & 127u); }
    }
    __syncthreads();
#pragma unroll 1
    for (int pass = 0; pass < 8; ++pass) {
      const int id = pass * 512 + tid, th = id >> 6, c = id & 63;
      const int ab = CT[c];
      float val = -INFINITY;
      if (ab >= 0) val = TV[(th * 2 + 0) * 16 + (ab >> 4)] + TV[(th * 2 + 1) * 16 + (ab & 15)];
      CV[th * 64 + c] = val;
    }
    __syncthreads();
#pragma unroll 1
    for (int pass = 0; pass < 8; ++pass) {
      const int id = pass * 512 + tid, th = id >> 6, c = id & 63;
      const int ab = CT[c];
      const float my = CV[th * 64 + c];
      const float4* row = (const float4*)(CV + th * 64);
      int rank = 0;
#pragma unroll 4
      for (int j4 = 0; j4 < 16; ++j4) {
        const float4 v = row[j4];
        const int j = j4 * 4;
        rank += (v.x > my || (v.x == my && j + 0 < c)) ? 1 : 0;
        rank += (v.y > my || (v.y == my && j + 1 < c)) ? 1 : 0;
        rank += (v.z > my || (v.z == my && j + 2 < c)) ? 1 : 0;
        rank += (v.w > my || (v.w == my && j + 3 < c)) ? 1 : 0;
      }
      if (ab >= 0 && rank < 16) {
        const int t = th >> 3, hd = th & 7;
        GT[t * 128 + hd * 16 + rank] = my;
        EX[t * 128 + hd * 16 + rank] = TI[(th * 2 + 0) * 16 + (ab >> 4)] * 128 + TI[(th * 2 + 1) * 16 + (ab & 15)];
      }
    }
    __syncthreads();
    if (tid < 64) {
      float* g = GT + (tid >> 3) * 128 + (tid & 7) * 16;
      const float mx = g[0];
      float e[16], s = 0.f;
#pragma unroll
      for (int i = 0; i < 16; ++i) { e[i] = __expf(g[i] - mx); s += e[i]; }
      const float inv = 1.f / s;
#pragma unroll
      for (int i = 0; i < 16; ++i) g[i] = e[i] * inv;
    }
    __syncthreads();
    {
      const int tok = tok0 + wave;
      float hv[16], acc[16];
      {
        const bf16_t* hr = H2 + (size_t)tok * 1024;
#pragma unroll
        for (int j = 0; j < 4; ++j) {
          const uint2 u = *(const uint2*)(hr + (lane + 64 * j) * 4);
          hv[4 * j + 0] = lo16(u.x); hv[4 * j + 1] = hi16(u.x); hv[4 * j + 2] = lo16(u.y); hv[4 * j + 3] = hi16(u.y);
        }
      }
#pragma unroll
      for (int i = 0; i < 16; ++i) acc[i] = 0.f;
#pragma unroll 1
      for (int e0 = 0; e0 < 128; e0 += 8) {
        uint4 uu[8], vv[8];
        float gg[8], su[8], sv[8];
#pragma unroll
        for (int j = 0; j < 8; ++j) {
          const int ex = EX[wave * 128 + e0 + j];
          gg[j] = GT[wave * 128 + e0 + j];
          uu[j] = *(const uint4*)(U8 + (size_t)ex * 1024 + lane * 16);
          vv[j] = *(const uint4*)(V8 + (size_t)ex * 1024 + lane * 16);
          su[j] = USC[ex]; sv[j] = VSC[ex];
        }
#pragma unroll
        for (int j = 0; j < 8; ++j) {
          float d = 0.f;
          FP8DOT(d, hv, 0, uu[j].x) FP8DOT(d, hv, 4, uu[j].y) FP8DOT(d, hv, 8, uu[j].z) FP8DOT(d, hv, 12, uu[j].w)
          d = wave_sum(d) * su[j];
          const float ge = 0.5f * d * (1.f + erff(d * 0.70710678118654752f));
          const float w = gg[j] * ge * sv[j];
          FP8AXPY(acc, 0, w, vv[j].x) FP8AXPY(acc, 4, w, vv[j].y) FP8AXPY(acc, 8, w, vv[j].z) FP8AXPY(acc, 12, w, vv[j].w)
        }
      }
      const int b = tok < NLAT ? (tok >> 12) : 8;
      float* xr = tok < NLAT ? p.out + (size_t)tok * 1024 : (float*)(p.ws + OFF_CTXB) + (size_t)(tok - NLAT) * 1024;
      const float* gate = mod + (size_t)b * 6144 + 5 * 1024;
#pragma unroll
      for (int j = 0; j < 4; ++j) {
        const int c = (lane + 64 * j) * 4;
        const float4 xv = *(const float4*)(xr + c);
        const float4 gv = *(const float4*)(gate + c);
        float4 o;
        o.x = xv.x + gv.x * acc[4 * j + 0]; o.y = xv.y + gv.y * acc[4 * j + 1];
        o.z = xv.z + gv.z * acc[4 * j + 2]; o.w = xv.w + gv.w * acc[4 * j + 3];
        if (dowrite) *(float4*)(xr + c) = o; else asm volatile("" :: "v"(o.x), "v"(o.y), "v"(o.z), "v"(o.w));
      }
    }
    __syncthreads();
  }
}

template <int layer>
__device__ __forceinline__ void layer_body(const Params& p, char* smem, cg::grid_group& grid) {
  constexpr bool nc = layer == 0;
  const float* xin = layer == 0 ? p.x : (const float*)p.out;
  phase_norm(p, layer, 0, xin, NTOK);
  grid.sync();
#if REP_GEMM
  gemm_phase<EPI_INPROJ>(p, layer, smem, (const bf16_t*)(p.ws + OFF_ACT), (const bf16_t*)(p.ws + OFF_WIN) + (size_t)layer * 3072 * 1024, NTOK, 3072, nullptr);
  grid.sync();
#endif
  gemm_phase<EPI_INPROJ>(p, layer, smem, (const bf16_t*)(p.ws + OFF_ACT), (const bf16_t*)(p.ws + OFF_WIN) + (size_t)layer * 3072 * 1024, NTOK, 3072, nullptr);
  grid.sync();
#if REP_MIX1
  phase_mix1(p, layer, smem, 2);
  grid.sync();
#endif
  phase_mix1(p, layer, smem);
  grid.sync();
  phase_ret_scan(p, layer);
  grid.sync();
#if REP_MIX2
  phase_mix2(p, layer, smem, 3);
  grid.sync();
#endif
  phase_mix2(p, layer, smem);
  grid.sync();
  gemm_phase<EPI_OUTPROJ>(p, layer, smem, (const bf16_t*)(p.ws + OFF_ACT), (const bf16_t*)(p.ws + OFF_WOUT) + (size_t)layer * 1024 * 1024, nc ? NTOK : NLAT, 1024, xin);
  grid.sync();
  phase_norm(p, layer, 1, (const float*)p.out, nc ? NTOK : NLAT);
  grid.sync();
  gemm_phase<EPI_PLAIN>(p, layer, smem, (const bf16_t*)(p.ws + OFF_ACT), (const bf16_t*)(p.ws + OFF_WQ) + (size_t)layer * 2048 * 1024, nc ? NTOK : NLAT, 2048, nullptr);
  grid.sync();
#if REP_PEER
  phase_peer(p, layer, smem, nc ? NTOK : NLAT, false);
  grid.sync();
#endif
  phase_peer(p, layer, smem, nc ? NTOK : NLAT);
  grid.sync();
}

__global__ void __launch_bounds__(512) fwd_megakernel(Params p) {
  cg::grid_group grid = cg::this_grid();
  extern __shared__ __attribute__((aligned(16))) char smem[];
  phase_prep(p, smem);
  grid.sync();
  layer_body<0>(p, smem, grid);
  layer_body<1>(p, smem, grid);
  phase_final(p);
}

extern "C" void kernel_launch(void* const* d_in, const int* in_sizes, int n_in, void* d_out,
                              int out_size, void* d_ws, size_t ws_size, hipStream_t stream) {
  constexpr size_t kDynLds = LDS_BYTES;
  static int grid_blocks = 0;
  if (!grid_blocks) {
    int dev = 0, cus = 0, per_cu = 0;
    (void)hipGetDevice(&dev);
    (void)hipDeviceGetAttribute(&cus, hipDeviceAttributeMultiprocessorCount, dev);
    (void)hipFuncSetAttribute((const void*)fwd_megakernel, hipFuncAttributeMaxDynamicSharedMemorySize, (int)kDynLds);
    (void)hipOccupancyMaxActiveBlocksPerMultiprocessor(&per_cu, fwd_megakernel, 512, kDynLds);
    if (per_cu < 1) { fprintf(stderr, "occupancy query says %d blocks/CU\n", per_cu); per_cu = 1; }
    grid_blocks = cus;
    if (ws_size < WS_END) fprintf(stderr, "workspace too small: %zu < %zu\n", ws_size, (size_t)WS_END);
  }
  Params p{};
  p.x = (const float*)d_in[0]; p.c = (const float*)d_in[1]; p.ctx = (const float*)d_in[2]; p.c_ctx = (const float*)d_in[3];
  p.w_ada = (const float*)d_in[4]; p.b_ada = (const float*)d_in[5]; p.norm1_g = (const float*)d_in[6]; p.w_in = (const float*)d_in[7];
  p.na_rpb = (const float*)d_in[8]; p.diff_lambda = (const float*)d_in[9]; p.diff_subln_g = (const float*)d_in[10];
  p.ret_decay_logit = (const float*)d_in[11]; p.w_out = (const float*)d_in[12]; p.norm2_g = (const float*)d_in[13];
  p.peer_wq = (const float*)d_in[14]; p.peer_subkeys = (const float*)d_in[15]; p.peer_u = (const float*)d_in[16];
  p.peer_v = (const float*)d_in[17]; p.final_g = (const float*)d_in[18];
  p.out = (float*)d_out; p.ws = (char*)d_ws;
  void* args[] = {&p};
  hipError_t e = hipLaunchCooperativeKernel((void*)fwd_megakernel, dim3(grid_blocks), dim3(512), args, kDynLds, stream);
  if (e != hipSuccess) fprintf(stderr, "cooperative launch failed: %s (grid %d)\n", hipGetErrorString(e), grid_blocks);
}
```

```cpp
#include <hip/hip_runtime.h>
#include <hip/hip_cooperative_groups.h>
#include <cstdio>
#include <cstdint>
namespace cg = cooperative_groups;

typedef unsigned short bf16_t;
typedef short bf16x8 __attribute__((ext_vector_type(8)));
typedef float f32x4 __attribute__((ext_vector_type(4)));

constexpr int DM = 1024, BATCH = 8, SEQ = 4096, LCTX = 256;
constexpr int NLAT = BATCH * SEQ;
constexpr int NCTX = BATCH * LCTX;
constexpr int NTOK = NLAT + NCTX;
constexpr int INC = 3072;
constexpr int C_NAQ = 0, C_NAK = 256, C_NAV = 512, C_DFQ = 768, C_DFK = 1024, C_DFV = 1280,
              C_RTQ = 1536, C_RTK = 1792, C_RTV = 2048, C_RTG = 2560;
constexpr int Y_NA = 0, Y_DF = 256, Y_RT = 512;
constexpr int NEXP = 16384;
constexpr float EPS = 1e-6f;

constexpr size_t OFF_CTL  = 0;
constexpr size_t OFF_MISC = 4096;
constexpr size_t OFF_ROPE = 8192;
constexpr size_t OFF_MOD  = OFF_ROPE + 12288;
constexpr size_t SZ_MOD   = 2ull * 9 * 6144 * 4;
constexpr size_t OFF_WIN  = OFF_MOD + SZ_MOD;
constexpr size_t SZ_WIN   = 2ull * 3072 * 1024 * 2;
constexpr size_t OFF_WOUT = OFF_WIN + SZ_WIN;
constexpr size_t SZ_WOUT  = 2ull * 1024 * 1024 * 2;
constexpr size_t OFF_WQ   = OFF_WOUT + SZ_WOUT;
constexpr size_t SZ_WQ    = 2ull * 2048 * 1024 * 2;
constexpr size_t OFF_SUBK = OFF_WQ + SZ_WQ;
constexpr size_t SZ_SUBK  = 2ull * 262144 * 2;
constexpr size_t OFF_U    = OFF_SUBK + SZ_SUBK;
constexpr size_t SZ_UV    = 2ull * NEXP * 1024;
constexpr size_t OFF_V    = OFF_U + SZ_UV;
constexpr size_t OFF_USC  = OFF_V + SZ_UV;
constexpr size_t OFF_VSC  = OFF_USC + 2ull * NEXP * 4;
constexpr size_t OFF_ACT  = OFF_VSC + 2ull * NEXP * 4;
constexpr size_t SZ_ACT   = (size_t)NTOK * 1024 * 2;
constexpr size_t OFF_P    = OFF_ACT + SZ_ACT;
constexpr size_t SZ_P     = (size_t)NTOK * 3072 * 2;
constexpr size_t OFF_CTXB = OFF_P + SZ_P;
constexpr size_t SZ_CTXB  = (size_t)NCTX * 1024 * 4;
constexpr size_t OFF_RKV  = OFF_CTXB + SZ_CTXB;
constexpr size_t SZ_RKV   = 64ull * 32 * 8192 * 4;
constexpr size_t OFF_RS   = OFF_RKV + SZ_RKV;
constexpr size_t SZ_RS    = 64ull * 8192 * 4;
constexpr size_t WS_END   = OFF_RS + SZ_RS;

#ifndef REP_MIX1
#define REP_MIX1 0
#endif
#ifndef REP_MIX2
#define REP_MIX2 0
#endif
#ifndef REP_PEER
#define REP_PEER 0
#endif
#ifndef REP_GEMM
#define REP_GEMM 0
#endif
constexpr int LDS_BYTES = 144 * 1024;
constexpr int LDS_BCAST = LDS_BYTES - 16;

struct Params {
  const float *x, *c, *ctx, *c_ctx, *w_ada, *b_ada, *norm1_g, *w_in, *na_rpb, *diff_lambda, *diff_subln_g,
              *ret_decay_logit, *w_out, *norm2_g, *peer_wq, *peer_subkeys, *peer_u, *peer_v, *final_g;
  float* out;
  char* ws;
};

__device__ __forceinline__ float bf2f(bf16_t v) { return __uint_as_float(((unsigned)v) << 16); }
__device__ __forceinline__ bf16_t f2bf(float f) {
  unsigned u = __float_as_uint(f);
  u += 0x7fffu + ((u >> 16) & 1u);
  return (bf16_t)(u >> 16);
}
__device__ __forceinline__ unsigned pack2(float a, float b) { return (unsigned)f2bf(a) | ((unsigned)f2bf(b) << 16); }
__device__ __forceinline__ float lo16(unsigned w) { return __uint_as_float(w << 16); }
__device__ __forceinline__ float hi16(unsigned w) { return __uint_as_float(w & 0xffff0000u); }
#define DPP_ADD(v, CTRL) ((v) + __int_as_float(__builtin_amdgcn_update_dpp(0, __float_as_int(v), (CTRL), 0xf, 0xf, true)))
__device__ __forceinline__ float row16_sum(float v) {
  v = DPP_ADD(v, 0xB1);
  v = DPP_ADD(v, 0x4E);
  v = DPP_ADD(v, 0x141);
  v = DPP_ADD(v, 0x140);
  return v;
}
__device__ __forceinline__ float wave_sum(float v) {
  v = row16_sum(v);
  const int iv = __float_as_int(v);
  const float a = __int_as_float(__builtin_amdgcn_readlane(iv, 0)), b = __int_as_float(__builtin_amdgcn_readlane(iv, 16));
  const float c = __int_as_float(__builtin_amdgcn_readlane(iv, 32)), d = __int_as_float(__builtin_amdgcn_readlane(iv, 48));
  return (a + b) + (c + d);
}
__device__ __forceinline__ float siluf(float x) { return x / (1.f + __expf(-x)); }

__device__ __forceinline__ int opaque_tid() { int t = threadIdx.x; asm volatile("" : "+v"(t)); return t; }
__device__ __forceinline__ int opaque_bid() { int t = blockIdx.x; asm volatile("" : "+s"(t)); return t; }

#define DOT8(acc, Q, off, U)                                                              \
  acc = fmaf(Q[(off) + 0], lo16((U).x), acc); acc = fmaf(Q[(off) + 1], hi16((U).x), acc); \
  acc = fmaf(Q[(off) + 2], lo16((U).y), acc); acc = fmaf(Q[(off) + 3], hi16((U).y), acc); \
  acc = fmaf(Q[(off) + 4], lo16((U).z), acc); acc = fmaf(Q[(off) + 5], hi16((U).z), acc); \
  acc = fmaf(Q[(off) + 6], lo16((U).w), acc); acc = fmaf(Q[(off) + 7], hi16((U).w), acc);
#define AXPY8(O, off, P, U)                                                                   \
  O[(off) + 0] = fmaf(P, lo16((U).x), O[(off) + 0]); O[(off) + 1] = fmaf(P, hi16((U).x), O[(off) + 1]); \
  O[(off) + 2] = fmaf(P, lo16((U).y), O[(off) + 2]); O[(off) + 3] = fmaf(P, hi16((U).y), O[(off) + 3]); \
  O[(off) + 4] = fmaf(P, lo16((U).z), O[(off) + 4]); O[(off) + 5] = fmaf(P, hi16((U).z), O[(off) + 5]); \
  O[(off) + 6] = fmaf(P, lo16((U).w), O[(off) + 6]); O[(off) + 7] = fmaf(P, hi16((U).w), O[(off) + 7]);
#define UNPACK8(Q, off, U)                                                  \
  Q[(off) + 0] = lo16((U).x); Q[(off) + 1] = hi16((U).x); Q[(off) + 2] = lo16((U).y); Q[(off) + 3] = hi16((U).y); \
  Q[(off) + 4] = lo16((U).z); Q[(off) + 5] = hi16((U).z); Q[(off) + 6] = lo16((U).w); Q[(off) + 7] = hi16((U).w);

__device__ __forceinline__ int next_item(unsigned* counter, char* smem) {
  volatile int* bc = (volatile int*)(smem + LDS_BCAST);
  __syncthreads();
  if (threadIdx.x == 0) *bc = (int)atomicAdd(counter, 1u);
  __syncthreads();
  return *bc;
}

__device__ __forceinline__ void transpose_item(const float* src, bf16_t* dst, int K, int N, int item, char* smem) {
  float* t = (float*)smem;
  const int nb = N / 64;
  const int k0 = (item / nb) * 64, n0 = (item % nb) * 64;
  const int tid = opaque_tid();
  __syncthreads();
#pragma unroll
  for (int i = 0; i < 8; ++i) {
    const int k = (tid >> 6) + 8 * i, n = tid & 63;
    t[k * 65 + n] = src[(size_t)(k0 + k) * N + n0 + n];
  }
  __syncthreads();
#pragma unroll
  for (int i = 0; i < 8; ++i) {
    const int n = (tid >> 6) + 8 * i, k = tid & 63;
    dst[(size_t)(n0 + n) * K + k0 + k] = f2bf(t[k * 65 + n]);
  }
}

__device__ __forceinline__ void convert_flat(const float* src, bf16_t* dst, size_t n4) {
  const size_t gt = (size_t)opaque_bid() * blockDim.x + opaque_tid(), gs = (size_t)gridDim.x * blockDim.x;
  for (size_t i = gt; i < n4; i += gs) {
    const float4 v = ((const float4*)src)[i];
    uint2 o; o.x = pack2(v.x, v.y); o.y = pack2(v.z, v.w);
    ((uint2*)dst)[i] = o;
  }
}

__device__ __forceinline__ void phase_prep(const Params& p, char* smem) {
  const int tid = opaque_tid();
  char* ws = p.ws;
  if (opaque_bid() == 0) {
    unsigned* ctl = (unsigned*)(ws + OFF_CTL);
    if (tid < 64) ctl[tid] = 0u;
    float* misc = (float*)(ws + OFF_MISC);
    if (tid < 2) {
      const float* lp = p.diff_lambda + tid * 128;
      float s01 = 0.f, s23 = 0.f;
      for (int i = 0; i < 32; ++i) { s01 += lp[i] * lp[32 + i]; s23 += lp[64 + i] * lp[96 + i]; }
      const float lam_init = 0.8f - 0.6f * expf(-0.3f * (float)tid);
      misc[tid] = expf(s01) - expf(s23) + lam_init;
      misc[2 + tid] = lam_init;
    }
    if (tid >= 64 && tid < 80) {
      const int i = tid - 64;
      const float xv = p.ret_decay_logit[i];
      misc[16 + i] = -log1pf(expf(-xv));
    }
    float2* ropeD = (float2*)(ws + OFF_ROPE);
    float2* ropeR = (float2*)(ws + OFF_ROPE + 4096);
    for (int i = tid; i < 64 * 8; i += 512) {
      const int v = i >> 3, f = i & 7;
      const float inv = powf(10000.0f, -(float)(2 * f) / 16.0f);
      const float ang = (float)v * inv;
      ropeD[i] = make_float2(cosf(ang), sinf(ang));
    }
    for (int i = tid; i < 64 * 16; i += 512) {
      const int v = i >> 4, f = i & 15;
      const float inv = powf(10000.0f, -(float)(2 * f) / 32.0f);
      const float ang = (float)v * inv;
      ropeR[i] = make_float2(cosf(ang), sinf(ang));
    }
  }
  {
    float* sc = (float*)smem;
    float* red = (float*)(smem + 9 * 1024 * 4);
    float* mod = (float*)(ws + OFF_MOD);
    for (int item = opaque_bid(); item < 192; item += gridDim.x) {
      const int l = item / 96, cb = item % 96;
      __syncthreads();
      for (int i = tid; i < 9 * 1024; i += 512) {
        const int r = i >> 10, k = i & 1023;
        const float cv = (r < 8) ? p.c[r * 1024 + k] : p.c_ctx[k];
        sc[i] = siluf(cv);
      }
      __syncthreads();
      const int col = tid & 63, ks = tid >> 6;
      float acc[9];
#pragma unroll
      for (int r = 0; r < 9; ++r) acc[r] = 0.f;
      const float* w = p.w_ada + (size_t)l * 1024 * 6144 + cb * 64 + col;
      for (int k = ks * 128; k < ks * 128 + 128; ++k) {
        const float wv = w[(size_t)k * 6144];
#pragma unroll
        for (int r = 0; r < 9; ++r) acc[r] = fmaf(sc[r * 1024 + k], wv, acc[r]);
      }
#pragma unroll
      for (int r = 0; r < 9; ++r) red[(ks * 9 + r) * 64 + col] = acc[r];
      __syncthreads();
      for (int i = tid; i < 576; i += 512) {
        const int r = i >> 6, cc = i & 63;
        float s = 0.f;
#pragma unroll
        for (int k8 = 0; k8 < 8; ++k8) s += red[(k8 * 9 + r) * 64 + cc];
        mod[((size_t)l * 9 + r) * 6144 + cb * 64 + cc] = s + p.b_ada[l * 6144 + cb * 64 + cc];
      }
    }
    __syncthreads();
  }
  for (int item = opaque_bid(); item < 3072; item += gridDim.x) {
    const int l = item / 1536;
    int r = item % 1536;
    if (r < 768) transpose_item(p.w_in + (size_t)l * 1024 * 3072, (bf16_t*)(ws + OFF_WIN) + (size_t)l * 3072 * 1024, 1024, 3072, r, smem);
    else if (r < 1024) transpose_item(p.w_out + (size_t)l * 1024 * 1024, (bf16_t*)(ws + OFF_WOUT) + (size_t)l * 1024 * 1024, 1024, 1024, r - 768, smem);
    else transpose_item(p.peer_wq + (size_t)l * 1024 * 2048, (bf16_t*)(ws + OFF_WQ) + (size_t)l * 2048 * 1024, 1024, 2048, r - 1024, smem);
  }
  convert_flat(p.peer_subkeys, (bf16_t*)(ws + OFF_SUBK), 2ull * 262144 / 4);
  {
    const int lane = tid & 63;
    const int gw = opaque_bid() * 8 + (tid >> 6), nw = gridDim.x * 8;
    for (int row = gw; row < 4 * NEXP; row += nw) {
      const bool isv = row >= 2 * NEXP;
      const int rr = isv ? row - 2 * NEXP : row;
      const float* srow = (isv ? p.peer_v : p.peer_u) + (size_t)rr * 1024;
      float4 v[4];
      float mx = 0.f;
#pragma unroll
      for (int j = 0; j < 4; ++j) {
        v[j] = ((const float4*)srow)[lane + 64 * j];
        mx = fmaxf(mx, fmaxf(fmaxf(fabsf(v[j].x), fabsf(v[j].y)), fmaxf(fabsf(v[j].z), fabsf(v[j].w))));
      }
#pragma unroll
      for (int o = 1; o < 64; o <<= 1) mx = fmaxf(mx, __shfl_xor(mx, o));
      const float scale = mx > 0.f ? mx * (1.f / 448.f) : 1.f;
      const float inv = 1.f / scale;
      uint4 o;
      unsigned w[4];
#pragma unroll
      for (int j = 0; j < 4; ++j) {
        int t = 0;
        t = __builtin_amdgcn_cvt_pk_fp8_f32(v[j].x * inv, v[j].y * inv, t, false);
        t = __builtin_amdgcn_cvt_pk_fp8_f32(v[j].z * inv, v[j].w * inv, t, true);
        w[j] = (unsigned)t;
      }
      o.x = w[0]; o.y = w[1]; o.z = w[2]; o.w = w[3];
      *(uint4*)(ws + (isv ? OFF_V : OFF_U) + (size_t)rr * 1024 + lane * 16) = o;
      if (lane == 0) ((float*)(ws + (isv ? OFF_VSC : OFF_USC)))[rr] = scale;
    }
  }
  {
    const size_t gt = (size_t)opaque_bid() * blockDim.x + tid, gs = (size_t)gridDim.x * blockDim.x;
    float4* dst = (float4*)(ws + OFF_CTXB);
    for (size_t i = gt; i < (size_t)NCTX * 1024 / 4; i += gs) dst[i] = ((const float4*)p.ctx)[i];
  }
}

__device__ __forceinline__ void phase_norm(const Params& p, int layer, int which, const float* xlat, int nrows) {
  const int lane = opaque_tid() & 63;
  const int gw = opaque_bid() * 8 + (opaque_tid() >> 6), nw = gridDim.x * 8;
  const float* g = (which == 0 ? p.norm1_g : p.norm2_g) + layer * 1024;
  const float* mod = (const float*)(p.ws + OFF_MOD) + (size_t)layer * 9 * 6144;
  const float* ctxb = (const float*)(p.ws + OFF_CTXB);
  bf16_t* act = (bf16_t*)(p.ws + OFF_ACT);
  const int sh_off = which == 0 ? 0 : 3 * 1024, sc_off = which == 0 ? 1024 : 4 * 1024;
  for (int row = gw; row < nrows; row += nw) {
    const float* src = row < NLAT ? xlat + (size_t)row * 1024 : ctxb + (size_t)(row - NLAT) * 1024;
    const int b = row < NLAT ? (row >> 12) : 8;
    const float* mrow = mod + (size_t)b * 6144;
    float4 v[4];
    float ss = 0.f;
#pragma unroll
    for (int j = 0; j < 4; ++j) {
      v[j] = ((const float4*)src)[lane + 64 * j];
      ss += v[j].x * v[j].x + v[j].y * v[j].y + v[j].z * v[j].z + v[j].w * v[j].w;
    }
    ss = wave_sum(ss);
    const float r = rsqrtf(ss * (1.f / 1024.f) + EPS);
#pragma unroll
    for (int j = 0; j < 4; ++j) {
      const int c = (lane + 64 * j) * 4;
      const float4 gg = *(const float4*)(g + c);
      const float4 sh = *(const float4*)(mrow + sh_off + c);
      const float4 sc = *(const float4*)(mrow + sc_off + c);
      const float o0 = v[j].x * r * gg.x * (1.f + sc.x) + sh.x;
      const float o1 = v[j].y * r * gg.y * (1.f + sc.y) + sh.y;
      const float o2 = v[j].z * r * gg.z * (1.f + sc.z) + sh.z;
      const float o3 = v[j].w * r * gg.w * (1.f + sc.w) + sh.w;
      uint2 o; o.x = pack2(o0, o1); o.y = pack2(o2, o3);
      *(uint2*)(act + (size_t)row * 1024 + c) = o;
    }
  }
}

__device__ __forceinline__ void phase_final(const Params& p) {
  const int lane = opaque_tid() & 63;
  const int gw = opaque_bid() * 8 + (opaque_tid() >> 6), nw = gridDim.x * 8;
  for (int row = gw; row < NLAT; row += nw) {
    float* src = p.out + (size_t)row * 1024;
    float4 v[4];
    float ss = 0.f;
#pragma unroll
    for (int j = 0; j < 4; ++j) {
      v[j] = ((const float4*)src)[lane + 64 * j];
      ss += v[j].x * v[j].x + v[j].y * v[j].y + v[j].z * v[j].z + v[j].w * v[j].w;
    }
    ss = wave_sum(ss);
    const float r = rsqrtf(ss * (1.f / 1024.f) + EPS);
#pragma unroll
    for (int j = 0; j < 4; ++j) {
      const int c = (lane + 64 * j) * 4;
      const float4 gg = *(const float4*)(p.final_g + c);
      float4 o;
      o.x = v[j].x * r * gg.x; o.y = v[j].y * r * gg.y; o.z = v[j].z * r * gg.z; o.w = v[j].w * r * gg.w;
      ((float4*)src)[lane + 64 * j] = o;
    }
  }
}

constexpr int EPI_INPROJ = 0, EPI_OUTPROJ = 1, EPI_PLAIN = 2;
constexpr int GS = 72;
constexpr int G_ASTAGE = 256 * GS * 2;
constexpr int G_BSTAGE = 128 * GS * 2;
constexpr int G_STAGE = G_ASTAGE + G_BSTAGE;

template <int EPI>
__device__ __forceinline__ void gemm_phase(const Params& p, int layer, char* smem, const bf16_t* A, const bf16_t* Bt,
                                           int M, int N, const float* xin_lat) {
  const int tid = opaque_tid(), lane = tid & 63, wave = tid >> 6, wm = wave >> 1, wn = wave & 1;
  const int ntn = N / 128, ntiles = (M / 256) * ntn;
  const int lr = lane & 15, lq = lane >> 4;
  for (int tile = opaque_bid(); tile < ntiles; tile += gridDim.x) {
    const int m0 = (tile / ntn) * 256, n0 = (tile % ntn) * 128;
    f32x4 acc[4][4];
#pragma unroll
    for (int i = 0; i < 4; ++i)
#pragma unroll
      for (int j = 0; j < 4; ++j) acc[i][j] = (f32x4){0.f, 0.f, 0.f, 0.f};
    uint4 ra[4], rb[2];
    const int crow = tid >> 3, ckc = tid & 7;
    auto gload = [&](int k0) {
#pragma unroll
      for (int i = 0; i < 4; ++i) ra[i] = *(const uint4*)(A + (size_t)(m0 + crow + 64 * i) * 1024 + k0 + ckc * 8);
#pragma unroll
      for (int i = 0; i < 2; ++i) rb[i] = *(const uint4*)(Bt + (size_t)(n0 + crow + 64 * i) * 1024 + k0 + ckc * 8);
    };
    auto lstore = [&](int s) {
      bf16_t* sA = (bf16_t*)(smem + s * G_STAGE);
      bf16_t* sB = (bf16_t*)(smem + s * G_STAGE + G_ASTAGE);
#pragma unroll
      for (int i = 0; i < 4; ++i) *(uint4*)(sA + (crow + 64 * i) * GS + ckc * 8) = ra[i];
#pragma unroll
      for (int i = 0; i < 2; ++i) *(uint4*)(sB + (crow + 64 * i) * GS + ckc * 8) = rb[i];
    };
    __syncthreads();
    gload(0);
    lstore(0);
    __syncthreads();
    for (int kt = 0; kt < 16; ++kt) {
      const int cur = kt & 1;
      if (kt + 1 < 16) gload((kt + 1) * 64);
      const bf16_t* sA = (const bf16_t*)(smem + cur * G_STAGE);
      const bf16_t* sB = (const bf16_t*)(smem + cur * G_STAGE + G_ASTAGE);
#pragma unroll
      for (int ks = 0; ks < 2; ++ks) {
        bf16x8 af[4], bfr[4];
#pragma unroll
        for (int mi = 0; mi < 4; ++mi) af[mi] = *(const bf16x8*)(sA + (wm * 64 + mi * 16 + lr) * GS + ks * 32 + lq * 8);
#pragma unroll
        for (int ni = 0; ni < 4; ++ni) bfr[ni] = *(const bf16x8*)(sB + (wn * 64 + ni * 16 + lr) * GS + ks * 32 + lq * 8);
#pragma unroll
        for (int mi = 0; mi < 4; ++mi)
#pragma unroll
          for (int ni = 0; ni < 4; ++ni)
            acc[mi][ni] = __builtin_amdgcn_mfma_f32_16x16x32_bf16(bfr[ni], af[mi], acc[mi][ni], 0, 0, 0);
      }
      if (kt + 1 < 16) lstore(cur ^ 1);
      __syncthreads();
    }
#pragma unroll
    for (int mi = 0; mi < 4; ++mi) {
      const int m = m0 + wm * 64 + mi * 16 + lr;
#pragma unroll
      for (int ni = 0; ni < 4; ++ni) {
        const int n = n0 + wn * 64 + ni * 16 + lq * 4;
        float v0 = acc[mi][ni][0], v1 = acc[mi][ni][1], v2 = acc[mi][ni][2], v3 = acc[mi][ni][3];
        if constexpr (EPI == EPI_INPROJ) {
          const bool ropeD = (n >= C_DFQ && n < C_DFV), ropeR = (n >= C_RTQ && n < C_RTV);
          if ((ropeD || ropeR) && m < NLAT) {
            const int t = m & 4095, gr = t >> 6, gc = t & 63;
            float2 cs0, cs1;
            if (ropeD) {
              const float2* tab = (const float2*)(p.ws + OFF_ROPE);
              const int i0 = (n & 31) >> 1;
              if (i0 < 8) { cs0 = tab[gr * 8 + i0]; cs1 = tab[gr * 8 + i0 + 1]; }
              else { cs0 = tab[gc * 8 + i0 - 8]; cs1 = tab[gc * 8 + i0 - 7]; }
            } else {
              const float2* tab = (const float2*)(p.ws + OFF_ROPE + 4096);
              const int i0 = (n & 63) >> 1;
              if (i0 < 16) { cs0 = tab[gr * 16 + i0]; cs1 = tab[gr * 16 + i0 + 1]; }
              else { cs0 = tab[gc * 16 + i0 - 16]; cs1 = tab[gc * 16 + i0 - 15]; }
            }
            const float a0 = v0 * cs0.x - v1 * cs0.y, a1 = v0 * cs0.y + v1 * cs0.x;
            const float a2 = v2 * cs1.x - v3 * cs1.y, a3 = v2 * cs1.y + v3 * cs1.x;
            v0 = a0; v1 = a1; v2 = a2; v3 = a3;
          }
          float sc = 1.f;
          if (n < C_NAK) sc = 0.125f * 1.4426950408889634f;
          else if (n >= C_DFQ && n < C_DFK) sc = 0.17677669529663687f * 1.4426950408889634f;
          else if (n >= C_RTK && n < C_RTV) sc = 0.125f;
          uint2 o; o.x = pack2(v0 * sc, v1 * sc); o.y = pack2(v2 * sc, v3 * sc);
          *(uint2*)((bf16_t*)(p.ws + OFF_P) + (size_t)m * INC + n) = o;
        } else if constexpr (EPI == EPI_OUTPROJ) {
          const float* mod = (const float*)(p.ws + OFF_MOD) + (size_t)layer * 9 * 6144;
          const int b = m < NLAT ? (m >> 12) : 8;
          const float4 gt = *(const float4*)(mod + (size_t)b * 6144 + 2 * 1024 + n);
          const float* xi; float* xo;
          if (m < NLAT) { xi = xin_lat + (size_t)m * 1024 + n; xo = p.out + (size_t)m * 1024 + n; }
          else { xo = (float*)(p.ws + OFF_CTXB) + (size_t)(m - NLAT) * 1024 + n; xi = xo; }
          const float4 xv = *(const float4*)xi;
          float4 o; o.x = xv.x + gt.x * v0; o.y = xv.y + gt.y * v1; o.z = xv.z + gt.z * v2; o.w = xv.w + gt.w * v3;
          *(float4*)xo = o;
        } else {
          uint2 o; o.x = pack2(v0, v1); o.y = pack2(v2, v3);
          *(uint2*)((bf16_t*)(p.ws + OFF_P) + (size_t)m * 2048 + n) = o;
        }
      }
    }
  }
}

__device__ __forceinline__ unsigned cvt_pk_bf16(float lo, float hi) {
  unsigned r;
  asm volatile("v_cvt_pk_bf16_f32 %0, %1, %2" : "=v"(r) : "v"(lo), "v"(hi));
  return r;
}
constexpr int DKS = 72;
__device__ __forceinline__ void diff_item(const Params& p, int layer, bool ctxq, int item, char* smem) {
  const bf16_t* P = (const bf16_t*)(p.ws + OFF_P);
  bf16_t* Y = (bf16_t*)(p.ws + OFF_ACT);
  const float* misc = (const float*)(p.ws + OFF_MISC);
  const float lam = misc[layer], lam_init = misc[2 + layer];
  const int tid = opaque_tid(), lane = tid & 63, wave = tid >> 6, lr = lane & 15, lq = lane >> 4;
  int b, h, mbase, nkeys;
  if (!ctxq) { b = item >> 7; h = (item >> 5) & 3; mbase = b * 4096 + (item & 31) * 128; nkeys = 256 + 4096; }
  else { b = item >> 3; h = (item >> 1) & 3; mbase = NLAT + b * 256 + (item & 1) * 128; nkeys = 256; }
  const int mq = mbase + wave * 16 + lr;
  bf16x8 qf[2];
  {
    const bf16_t* qr = P + (size_t)mq * INC + C_DFQ + h * 64 + lq * 8;
    qf[0] = *(const bf16x8*)(qr);
    qf[1] = *(const bf16x8*)(qr + 32);
  }
  f32x4 O0[4], O1[4];
#pragma unroll
  for (int i = 0; i < 4; ++i) { O0[i] = (f32x4){0.f, 0.f, 0.f, 0.f}; O1[i] = (f32x4){0.f, 0.f, 0.f, 0.f}; }
  float m0 = -1e30f, m1 = -1e30f, l0 = 0.f, l1 = 0.f;
  const int lkey = tid >> 3, lch = tid & 7;
  uint4 uk, uv;
  auto gload = [&](int k0) {
    const int kk = k0 + lkey;
    const size_t row = kk < 256 ? (size_t)(NLAT + b * 256 + kk) : (size_t)(b * 4096 + kk - 256);
    uk = *(const uint4*)(P + row * INC + C_DFK + h * 64 + lch * 8);
    uv = *(const uint4*)(P + row * INC + C_DFV + h * 64 + lch * 8);
  };
  auto lstore = [&](int buf) {
    bf16_t* Ks = (bf16_t*)(smem + buf * (2 * 64 * DKS * 2));
    bf16_t* Vt = Ks + 64 * DKS;
    *(uint4*)(Ks + lkey * DKS + lch * 8) = uk;
    bf16_t* vd = Vt + (lch * 8) * DKS + lkey;
    vd[0 * DKS] = (bf16_t)(uv.x & 0xffffu); vd[1 * DKS] = (bf16_t)(uv.x >> 16);
    vd[2 * DKS] = (bf16_t)(uv.y & 0xffffu); vd[3 * DKS] = (bf16_t)(uv.y >> 16);
    vd[4 * DKS] = (bf16_t)(uv.z & 0xffffu); vd[5 * DKS] = (bf16_t)(uv.z >> 16);
    vd[6 * DKS] = (bf16_t)(uv.w & 0xffffu); vd[7 * DKS] = (bf16_t)(uv.w >> 16);
  };
  __syncthreads();
  gload(0);
  lstore(0);
  __syncthreads();
  const int ntile = nkeys >> 6;
#pragma unroll 1
  for (int t = 0; t < ntile; ++t) {
    const int cur = t & 1;
    if (t + 1 < ntile) gload((t + 1) * 64);
    const bf16_t* Ks = (const bf16_t*)(smem + cur * (2 * 64 * DKS * 2));
    const bf16_t* Vt = Ks + 64 * DKS;
    f32x4 S0[4], S1[4];
#pragma unroll
    for (int kt = 0; kt < 4; ++kt) {
      const bf16x8 k0f = *(const bf16x8*)(Ks + (kt * 16 + lr) * DKS + lq * 8);
      const bf16x8 k1f = *(const bf16x8*)(Ks + (kt * 16 + lr) * DKS + 32 + lq * 8);
      S0[kt] = __builtin_amdgcn_mfma_f32_16x16x32_bf16(k0f, qf[0], (f32x4){0.f, 0.f, 0.f, 0.f}, 0, 0, 0);
      S1[kt] = __builtin_amdgcn_mfma_f32_16x16x32_bf16(k1f, qf[1], (f32x4){0.f, 0.f, 0.f, 0.f}, 0, 0, 0);
    }
    float x0 = fmaxf(fmaxf(S0[0][0], S0[0][1]), fmaxf(S0[0][2], S0[0][3]));
    float x1 = fmaxf(fmaxf(S1[0][0], S1[0][1]), fmaxf(S1[0][2], S1[0][3]));
#pragma unroll
    for (int kt = 1; kt < 4; ++kt) {
      x0 = fmaxf(x0, fmaxf(fmaxf(S0[kt][0], S0[kt][1]), fmaxf(S0[kt][2], S0[kt][3])));
      x1 = fmaxf(x1, fmaxf(fmaxf(S1[kt][0], S1[kt][1]), fmaxf(S1[kt][2], S1[kt][3])));
    }
    x0 = fmaxf(x0, __shfl_xor(x0, 16)); x0 = fmaxf(x0, __shfl_xor(x0, 32));
    x1 = fmaxf(x1, __shfl_xor(x1, 16)); x1 = fmaxf(x1, __shfl_xor(x1, 32));
    const float mn0 = fmaxf(m0, x0), mn1 = fmaxf(m1, x1);
    const float al0 = __builtin_amdgcn_exp2f(m0 - mn0), al1 = __builtin_amdgcn_exp2f(m1 - mn1);
    m0 = mn0; m1 = mn1;
    float ps0 = 0.f, ps1 = 0.f;
#pragma unroll
    for (int kt = 0; kt < 4; ++kt) {
#pragma unroll
      for (int r = 0; r < 4; ++r) {
        S0[kt][r] = __builtin_amdgcn_exp2f(S0[kt][r] - mn0); ps0 += S0[kt][r];
        S1[kt][r] = __builtin_amdgcn_exp2f(S1[kt][r] - mn1); ps1 += S1[kt][r];
      }
    }
    l0 = l0 * al0 + ps0; l1 = l1 * al1 + ps1;
#pragma unroll
    for (int dt = 0; dt < 4; ++dt) {
#pragma unroll
      for (int r = 0; r < 4; ++r) { O0[dt][r] *= al0; O1[dt][r] *= al1; }
    }
#pragma unroll
    for (int g = 0; g < 2; ++g) {
      union { unsigned u[4]; bf16x8 v; } pf0, pf1;
      pf0.u[0] = cvt_pk_bf16(S0[2 * g][0], S0[2 * g][1]); pf0.u[1] = cvt_pk_bf16(S0[2 * g][2], S0[2 * g][3]);
      pf0.u[2] = cvt_pk_bf16(S0[2 * g + 1][0], S0[2 * g + 1][1]); pf0.u[3] = cvt_pk_bf16(S0[2 * g + 1][2], S0[2 * g + 1][3]);
      pf1.u[0] = cvt_pk_bf16(S1[2 * g][0], S1[2 * g][1]); pf1.u[1] = cvt_pk_bf16(S1[2 * g][2], S1[2 * g][3]);
      pf1.u[2] = cvt_pk_bf16(S1[2 * g + 1][0], S1[2 * g + 1][1]); pf1.u[3] = cvt_pk_bf16(S1[2 * g + 1][2], S1[2 * g + 1][3]);
#pragma unroll
      for (int dt = 0; dt < 4; ++dt) {
        union { uint2 h[2]; bf16x8 v; } vf;
        vf.h[0] = *(const uint2*)(Vt + (dt * 16 + lr) * DKS + 32 * g + 4 * lq);
        vf.h[1] = *(const uint2*)(Vt + (dt * 16 + lr) * DKS + 32 * g + 16 + 4 * lq);
        O0[dt] = __builtin_amdgcn_mfma_f32_16x16x32_bf16(vf.v, pf0.v, O0[dt], 0, 0, 0);
        O1[dt] = __builtin_amdgcn_mfma_f32_16x16x32_bf16(vf.v, pf1.v, O1[dt], 0, 0, 0);
      }
    }
    if (t + 1 < ntile) lstore(cur ^ 1);
    __syncthreads();
  }
  l0 += __shfl_xor(l0, 16); l0 += __shfl_xor(l0, 32);
  l1 += __shfl_xor(l1, 16); l1 += __shfl_xor(l1, 32);
  const float i0 = 1.f / l0, i1 = lam / l1;
  float ss = 0.f;
#pragma unroll
  for (int dt = 0; dt < 4; ++dt) {
#pragma unroll
    for (int r = 0; r < 4; ++r) { const float v = O0[dt][r] * i0 - O1[dt][r] * i1; O0[dt][r] = v; ss = fmaf(v, v, ss); }
  }
  ss += __shfl_xor(ss, 16); ss += __shfl_xor(ss, 32);
  const float rr = rsqrtf(ss * (1.f / 64.f) + EPS) * (1.f - lam_init);
  const float* sg = p.diff_subln_g + layer * 64;
  bf16_t* dst = Y + (size_t)mq * 1024 + Y_DF + h * 64;
#pragma unroll
  for (int dt = 0; dt < 4; ++dt) {
    const int d = dt * 16 + 4 * lq;
    const float4 g4 = *(const float4*)(sg + d);
    uint2 ov;
    ov.x = pack2(O0[dt][0] * rr * g4.x, O0[dt][1] * rr * g4.y);
    ov.y = pack2(O0[dt][2] * rr * g4.z, O0[dt][3] * rr * g4.w);
    *(uint2*)(dst + d) = ov;
  }
}

constexpr int NA_WS = 520;
constexpr int NA_CS = 264;
constexpr int NA_OFF_VTW = 0;
constexpr int NA_OFF_VTC = 64 * NA_WS * 2;
constexpr int NA_OFF_RPB = NA_OFF_VTC + 64 * NA_CS * 2;
constexpr int NA_OFF_MRG = NA_OFF_RPB + 2048;

#define NA_STEP(KPTR_EXPR, BIAS_EXPR, VT_PTR, VT_STRIDE, VT_KEY0_EXPR)                                           \
  {                                                                                                               \
    f32x4 S[4];                                                                                                   \
    _Pragma("unroll") for (int kt = 0; kt < 4; ++kt) {                                                            \
      const bf16_t* kp = (KPTR_EXPR);                                                                             \
      const bf16x8 ka = *(const bf16x8*)(kp + lq * 8);                                                            \
      const bf16x8 kb = *(const bf16x8*)(kp + 32 + lq * 8);                                                       \
      f32x4 a = __builtin_amdgcn_mfma_f32_16x16x32_bf16(ka, qf[0], (f32x4){0.f, 0.f, 0.f, 0.f}, 0, 0, 0);         \
      S[kt] = __builtin_amdgcn_mfma_f32_16x16x32_bf16(kb, qf[1], a, 0, 0, 0);                                      \
    }                                                                                                             \
    _Pragma("unroll") for (int kt = 0; kt < 4; ++kt) {                                                            \
      _Pragma("unroll") for (int r = 0; r < 4; ++r) { S[kt][r] += (BIAS_EXPR); }                                  \
    }                                                                                                             \
    float x = fmaxf(fmaxf(S[0][0], S[0][1]), fmaxf(S[0][2], S[0][3]));                                            \
    _Pragma("unroll") for (int kt = 1; kt < 4; ++kt) x = fmaxf(x, fmaxf(fmaxf(S[kt][0], S[kt][1]), fmaxf(S[kt][2], S[kt][3]))); \
    x = fmaxf(x, __shfl_xor(x, 16)); x = fmaxf(x, __shfl_xor(x, 32));                                             \
    const float mn = fmaxf(mrun, x);                                                                              \
    const float al = __builtin_amdgcn_exp2f(mrun - mn);                                                           \
    mrun = mn;                                                                                                    \
    float ps = 0.f;                                                                                               \
    _Pragma("unroll") for (int kt = 0; kt < 4; ++kt) {                                                            \
      _Pragma("unroll") for (int r = 0; r < 4; ++r) { S[kt][r] = __builtin_amdgcn_exp2f(S[kt][r] - mn); ps += S[kt][r]; } \
    }                                                                                                             \
    lrun = lrun * al + ps;                                                                                        \
    _Pragma("unroll") for (int dt = 0; dt < 4; ++dt) {                                                            \
      _Pragma("unroll") for (int r = 0; r < 4; ++r) O[dt][r] *= al;                                               \
    }                                                                                                             \
    _Pragma("unroll") for (int g = 0; g < 2; ++g) {                                                               \
      union { unsigned u[4]; bf16x8 v; } pf;                                                                      \
      pf.u[0] = cvt_pk_bf16(S[2 * g][0], S[2 * g][1]); pf.u[1] = cvt_pk_bf16(S[2 * g][2], S[2 * g][3]);           \
      pf.u[2] = cvt_pk_bf16(S[2 * g + 1][0], S[2 * g + 1][1]); pf.u[3] = cvt_pk_bf16(S[2 * g + 1][2], S[2 * g + 1][3]); \
      const int vk0 = (VT_KEY0_EXPR);                                                                             \
      _Pragma("unroll") for (int dt = 0; dt < 4; ++dt) {                                                          \
        union { uint2 h2[2]; bf16x8 v; } vf;                                                                      \
        vf.h2[0] = *(const uint2*)((VT_PTR) + (dt * 16 + lr) * (VT_STRIDE) + vk0 + 4 * lq);                       \
        vf.h2[1] = *(const uint2*)((VT_PTR) + (dt * 16 + lr) * (VT_STRIDE) + vk0 + 16 + 4 * lq);                  \
        O[dt] = __builtin_amdgcn_mfma_f32_16x16x32_bf16(vf.v, pf.v, O[dt], 0, 0, 0);                              \
      }                                                                                                           \
    }                                                                                                             \
  }

__device__ __forceinline__ void vt_store8(bf16_t* vt, int stride, int d0, int key, uint4 uv) {
  bf16_t* vd = vt + d0 * stride + key;
  vd[0 * stride] = (bf16_t)(uv.x & 0xffffu); vd[1 * stride] = (bf16_t)(uv.x >> 16);
  vd[2 * stride] = (bf16_t)(uv.y & 0xffffu); vd[3 * stride] = (bf16_t)(uv.y >> 16);
  vd[4 * stride] = (bf16_t)(uv.z & 0xffffu); vd[5 * stride] = (bf16_t)(uv.z >> 16);
  vd[6 * stride] = (bf16_t)(uv.w & 0xffffu); vd[7 * stride] = (bf16_t)(uv.w >> 16);
}

__device__ __forceinline__ void na_latent_item(const Params& p, int layer, int item, char* smem) {
  const bf16_t* P = (const bf16_t*)(p.ws + OFF_P);
  bf16_t* Y = (bf16_t*)(p.ws + OFF_ACT);
  const int b = item >> 8, h = (item >> 6) & 3, grow = item & 63;
  const int tid = opaque_tid(), lane = tid & 63, wave = tid >> 6, lr = lane & 15, lq = lane >> 4;
  const int jt = wave & 3, half = wave >> 2;
  bf16_t* VtW = (bf16_t*)(smem + NA_OFF_VTW);
  bf16_t* VtC = (bf16_t*)(smem + NA_OFF_VTC);
  float* RPB = (float*)(smem + NA_OFF_RPB);
  float* MRG = (float*)(smem + NA_OFF_MRG);
  const int rs = min(max(grow - 4, 0), 56);
  __syncthreads();
  {
    const int ch = tid & 7;
#pragma unroll
    for (int i = 0; i < 8; ++i) {
      const int key = (tid >> 3) + 64 * i;
      const uint4 uv = *(const uint4*)(P + (size_t)(b * 4096 + (rs + (key >> 6)) * 64 + (key & 63)) * INC + C_NAV + h * 64 + ch * 8);
      vt_store8(VtW, NA_WS, ch * 8, key, uv);
    }
#pragma unroll
    for (int i = 0; i < 4; ++i) {
      const int key = (tid >> 3) + 64 * i;
      const uint4 uv = *(const uint4*)(P + (size_t)(NLAT + b * 256 + key) * INC + C_NAV + h * 64 + ch * 8);
      vt_store8(VtC, NA_CS, ch * 8, key, uv);
    }
    if (tid < 465) RPB[tid] = p.na_rpb[(size_t)(layer * 4 + h) * 465 + tid] * 1.4426950408889634f;
  }
  const int qc = jt * 16 + lr;
  const int mq = b * 4096 + grow * 64 + qc;
  bf16x8 qf[2];
  {
    const bf16_t* qr = P + (size_t)mq * INC + C_NAQ + h * 64 + lq * 8;
    qf[0] = *(const bf16x8*)(qr);
    qf[1] = *(const bf16x8*)(qr + 32);
  }
  f32x4 O[4];
#pragma unroll
  for (int i = 0; i < 4; ++i) O[i] = (f32x4){0.f, 0.f, 0.f, 0.f};
  float mrun = -1e30f, lrun = 0.f;
  __syncthreads();
  if (half == 0) {
    const int k0 = min(max(jt * 16 - 8, 0), 32);
    const int cs = min(max(qc - 8, 0), 48);
#pragma unroll 1
    for (int s = 0; s < 4; ++s) {
      const int wr0 = 2 * s;
      NA_STEP(P + (size_t)(b * 4096 + (rs + wr0 + (kt >> 1)) * 64 + k0 + 16 * (kt & 1) + lr) * INC + C_NAK + h * 64,
              ((k0 + 16 * (kt & 1) + 4 * lq + r) >= cs && (k0 + 16 * (kt & 1) + 4 * lq + r) < cs + 16)
                  ? RPB[(rs + wr0 + (kt >> 1) - grow + 7) * 31 + (k0 + 16 * (kt & 1) + 4 * lq + r) - qc + 15] : -1e30f,
              VtW, NA_WS, (wr0 + g) * 64 + k0)
    }
  } else {
#pragma unroll 1
    for (int s = 0; s < 4; ++s) {
      NA_STEP(P + (size_t)(NLAT + b * 256 + s * 64 + kt * 16 + lr) * INC + C_NAK + h * 64, 0.f, VtC, NA_CS, s * 64 + 32 * g)
    }
  }
  lrun += __shfl_xor(lrun, 16); lrun += __shfl_xor(lrun, 32);
  float* mg = MRG + (jt * 64 + lane) * 18;
  if (half == 1) {
    mg[0] = mrun; mg[1] = lrun;
#pragma unroll
    for (int dt = 0; dt < 4; ++dt) { mg[2 + dt * 4 + 0] = O[dt][0]; mg[2 + dt * 4 + 1] = O[dt][1]; mg[2 + dt * 4 + 2] = O[dt][2]; mg[2 + dt * 4 + 3] = O[dt][3]; }
  }
  __syncthreads();
  if (half == 0) {
    const float m2 = mg[0], l2 = mg[1];
    const float M = fmaxf(mrun, m2);
    const float f1 = __builtin_amdgcn_exp2f(mrun - M), f2 = __builtin_amdgcn_exp2f(m2 - M);
    const float inv = 1.f / (lrun * f1 + l2 * f2);
    bf16_t* dst = Y + (size_t)mq * 1024 + Y_NA + h * 64;
#pragma unroll
    for (int dt = 0; dt < 4; ++dt) {
      const float o0 = (O[dt][0] * f1 + mg[2 + dt * 4 + 0] * f2) * inv, o1 = (O[dt][1] * f1 + mg[2 + dt * 4 + 1] * f2) * inv;
      const float o2 = (O[dt][2] * f1 + mg[2 + dt * 4 + 2] * f2) * inv, o3 = (O[dt][3] * f1 + mg[2 + dt * 4 + 3] * f2) * inv;
      uint2 ov; ov.x = pack2(o0, o1); ov.y = pack2(o2, o3);
      *(uint2*)(dst + dt * 16 + 4 * lq) = ov;
    }
  }
}

__device__ __forceinline__ void na_ctx_item(const Params& p, int item, char* smem) {
  const bf16_t* P = (const bf16_t*)(p.ws + OFF_P);
  bf16_t* Y = (bf16_t*)(p.ws + OFF_ACT);
  const int b = item >> 3, h = (item >> 1) & 3, qg = item & 1;
  const int tid = opaque_tid(), lane = tid & 63, wave = tid >> 6, lr = lane & 15, lq = lane >> 4;
  bf16_t* VtC = (bf16_t*)(smem + NA_OFF_VTC);
  __syncthreads();
  {
    const int ch = tid & 7;
#pragma unroll
    for (int i = 0; i < 4; ++i) {
      const int key = (tid >> 3) + 64 * i;
      const uint4 uv = *(const uint4*)(P + (size_t)(NLAT + b * 256 + key) * INC + C_NAV + h * 64 + ch * 8);
      vt_store8(VtC, NA_CS, ch * 8, key, uv);
    }
  }
  const int mq = NLAT + b * 256 + qg * 128 + wave * 16 + lr;
  bf16x8 qf[2];
  {
    const bf16_t* qr = P + (size_t)mq * INC + C_NAQ + h * 64 + lq * 8;
    qf[0] = *(const bf16x8*)(qr);
    qf[1] = *(const bf16x8*)(qr + 32);
  }
  f32x4 O[4];
#pragma unroll
  for (int i = 0; i < 4; ++i) O[i] = (f32x4){0.f, 0.f, 0.f, 0.f};
  float mrun = -1e30f, lrun = 0.f;
  __syncthreads();
#pragma unroll 1
  for (int s = 0; s < 4; ++s) {
    NA_STEP(P + (size_t)(NLAT + b * 256 + s * 64 + kt * 16 + lr) * INC + C_NAK + h * 64, 0.f, VtC, NA_CS, s * 64 + 32 * g)
  }
  lrun += __shfl_xor(lrun, 16); lrun += __shfl_xor(lrun, 32);
  const float inv = 1.f / lrun;
  bf16_t* dst = Y + (size_t)mq * 1024 + Y_NA + h * 64;
#pragma unroll
  for (int dt = 0; dt < 4; ++dt) {
    uint2 ov; ov.x = pack2(O[dt][0] * inv, O[dt][1] * inv); ov.y = pack2(O[dt][2] * inv, O[dt][3] * inv);
    *(uint2*)(dst + dt * 16 + 4 * lq) = ov;
  }
}

__device__ __forceinline__ void ret_kv_item(const Params& p, int layer, int h, size_t row0, int cnt, float* dstF, float* dstB) {
  const bf16_t* P = (const bf16_t*)(p.ws + OFF_P);
  const float* misc = (const float*)(p.ws + OFF_MISC);
  const float lgF = misc[16 + layer * 8 + 0 * 4 + h], lgB = misc[16 + layer * 8 + 1 * 4 + h];
  const int d = opaque_tid() >> 3, e0 = (opaque_tid() & 7) * 16;
  float aF[16], aB[16];
#pragma unroll
  for (int i = 0; i < 16; ++i) { aF[i] = 0.f; aB[i] = 0.f; }
#pragma unroll 2
  for (int j = 0; j < cnt; ++j) {
    const bf16_t* rowp = P + (row0 + j) * INC;
    const float kd = bf2f(rowp[C_RTK + h * 64 + d]);
    const uint4 u0 = *(const uint4*)(rowp + C_RTV + h * 128 + e0);
    const uint4 u1 = *(const uint4*)(rowp + C_RTV + h * 128 + e0 + 8);
    const float wF = kd * __expf(lgF * (float)(cnt - 1 - j)), wB = kd * __expf(lgB * (float)j);
    AXPY8(aF, 0, wF, u0) AXPY8(aF, 8, wF, u1)
    AXPY8(aB, 0, wB, u0) AXPY8(aB, 8, wB, u1)
  }
#pragma unroll
  for (int i = 0; i < 16; i += 4) {
    *(float4*)(dstF + d * 128 + e0 + i) = make_float4(aF[i], aF[i + 1], aF[i + 2], aF[i + 3]);
    *(float4*)(dstB + d * 128 + e0 + i) = make_float4(aB[i], aB[i + 1], aB[i + 2], aB[i + 3]);
  }
}

__device__ __forceinline__ void phase_ret_scan(const Params& p, int layer) {
  const float* misc = (const float*)(p.ws + OFF_MISC);
  float* rkv = (float*)(p.ws + OFF_RKV);
  const float* rs = (const float*)(p.ws + OFF_RS);
  const int gt = opaque_bid() * blockDim.x + opaque_tid(), gs = gridDim.x * blockDim.x;
  for (int idx = gt; idx < 64 * 8192; idx += gs) {
    const int seq = idx >> 13, elem = idx & 8191;
    const int dir = seq & 1, h = (seq >> 1) & 3;
    const float cdec = __expf(misc[16 + layer * 8 + dir * 4 + h] * 128.f);
    float state = rs[(size_t)seq * 8192 + elem];
    for (int s = 0; s < 32; ++s) {
      const int n = dir == 0 ? s : 31 - s;
      float* ptr = rkv + ((size_t)seq * 32 + n) * 8192 + elem;
      const float tmp = *ptr;
      *ptr = state;
      state = fmaf(cdec, state, tmp);
    }
  }
}

constexpr int RT_KS = 72, RT_VS = 136;
constexpr int RT_OFF_K = 0, RT_OFF_VT = 128 * RT_KS * 2, RT_OFF_SF = RT_OFF_VT + 128 * RT_VS * 2, RT_OFF_SB = RT_OFF_SF + 128 * RT_KS * 2;
__device__ __forceinline__ void ret_out_item(const Params& p, int layer, int h, size_t krow0, int nkc, int iq0,
                                             const float* SF, const float* SB, int clen, char* smem) {
  const bf16_t* P = (const bf16_t*)(p.ws + OFF_P);
  bf16_t* Y = (bf16_t*)(p.ws + OFF_ACT);
  const float* misc = (const float*)(p.ws + OFF_MISC);
  const float lgF2 = misc[16 + layer * 8 + 0 * 4 + h] * 1.4426950408889634f, lgB2 = misc[16 + layer * 8 + 1 * 4 + h] * 1.4426950408889634f;
  const int tid = opaque_tid(), lane = tid & 63, wave = tid >> 6, lr = lane & 15, lq = lane >> 4;
  bf16_t* Ks = (bf16_t*)(smem + RT_OFF_K);
  bf16_t* Vt = (bf16_t*)(smem + RT_OFF_VT);
  bf16_t* SFt = (bf16_t*)(smem + RT_OFF_SF);
  bf16_t* SBt = (bf16_t*)(smem + RT_OFF_SB);
  const int iq = iq0 + wave * 16 + lr;
  const size_t mq = krow0 + iq;
  bf16x8 qf[2];
  {
    const bf16_t* qr = P + mq * INC + C_RTQ + h * 64 + lq * 8;
    qf[0] = *(const bf16x8*)(qr);
    qf[1] = *(const bf16x8*)(qr + 32);
  }
  f32x4 O[8];
#pragma unroll
  for (int i = 0; i < 8; ++i) O[i] = (f32x4){0.f, 0.f, 0.f, 0.f};
  if (SF != nullptr) {
    __syncthreads();
    {
      const int d = tid >> 3, e0 = (tid & 7) * 16;
#pragma unroll
      for (int c4 = 0; c4 < 4; ++c4) {
        const float4 a = *(const float4*)(SF + d * 128 + e0 + c4 * 4);
        const float4 bb = *(const float4*)(SB + d * 128 + e0 + c4 * 4);
        SFt[(e0 + c4 * 4 + 0) * RT_KS + d] = f2bf(a.x); SFt[(e0 + c4 * 4 + 1) * RT_KS + d] = f2bf(a.y);
        SFt[(e0 + c4 * 4 + 2) * RT_KS + d] = f2bf(a.z); SFt[(e0 + c4 * 4 + 3) * RT_KS + d] = f2bf(a.w);
        SBt[(e0 + c4 * 4 + 0) * RT_KS + d] = f2bf(bb.x); SBt[(e0 + c4 * 4 + 1) * RT_KS + d] = f2bf(bb.y);
        SBt[(e0 + c4 * 4 + 2) * RT_KS + d] = f2bf(bb.z); SBt[(e0 + c4 * 4 + 3) * RT_KS + d] = f2bf(bb.w);
      }
    }
    __syncthreads();
    const float cF = __builtin_amdgcn_exp2f(lgF2 * (float)(iq + 1)), cB = __builtin_amdgcn_exp2f(lgB2 * (float)(clen - iq));
#pragma unroll
    for (int ks = 0; ks < 2; ++ks)
#pragma unroll
      for (int et = 0; et < 8; ++et) {
        const bf16x8 sf = *(const bf16x8*)(SFt + (et * 16 + lr) * RT_KS + ks * 32 + lq * 8);
        O[et] = __builtin_amdgcn_mfma_f32_16x16x32_bf16(sf, qf[ks], O[et], 0, 0, 0);
      }
    const float ratio = cF / cB;
#pragma unroll
    for (int et = 0; et < 8; ++et) { O[et][0] *= ratio; O[et][1] *= ratio; O[et][2] *= ratio; O[et][3] *= ratio; }
#pragma unroll
    for (int ks = 0; ks < 2; ++ks)
#pragma unroll
      for (int et = 0; et < 8; ++et) {
        const bf16x8 sb = *(const bf16x8*)(SBt + (et * 16 + lr) * RT_KS + ks * 32 + lq * 8);
        O[et] = __builtin_amdgcn_mfma_f32_16x16x32_bf16(sb, qf[ks], O[et], 0, 0, 0);
      }
#pragma unroll
    for (int et = 0; et < 8; ++et) { O[et][0] *= cB; O[et][1] *= cB; O[et][2] *= cB; O[et][3] *= cB; }
  }
#pragma unroll 1
  for (int kc = 0; kc < nkc; ++kc) {
    __syncthreads();
    {
      const int key = tid >> 2, c = tid & 3;
      const bf16_t* rowp = P + (krow0 + kc * 128 + key) * INC;
      const uint4 k0 = *(const uint4*)(rowp + C_RTK + h * 64 + c * 16), k1 = *(const uint4*)(rowp + C_RTK + h * 64 + c * 16 + 8);
      *(uint4*)(Ks + key * RT_KS + c * 16) = k0;
      *(uint4*)(Ks + key * RT_KS + c * 16 + 8) = k1;
#pragma unroll
      for (int c8 = 0; c8 < 4; ++c8) {
        const uint4 uv = *(const uint4*)(rowp + C_RTV + h * 128 + c * 32 + c8 * 8);
        vt_store8(Vt, RT_VS, c * 32 + c8 * 8, key, uv);
      }
    }
    __syncthreads();
    f32x4 S[8];
#pragma unroll
    for (int kt = 0; kt < 8; ++kt) {
      const bf16x8 ka = *(const bf16x8*)(Ks + (kt * 16 + lr) * RT_KS + lq * 8);
      const bf16x8 kb = *(const bf16x8*)(Ks + (kt * 16 + lr) * RT_KS + 32 + lq * 8);
      const f32x4 a = __builtin_amdgcn_mfma_f32_16x16x32_bf16(ka, qf[0], (f32x4){0.f, 0.f, 0.f, 0.f}, 0, 0, 0);
      S[kt] = __builtin_amdgcn_mfma_f32_16x16x32_bf16(kb, qf[1], a, 0, 0, 0);
    }
#pragma unroll
    for (int kt = 0; kt < 8; ++kt) {
#pragma unroll
      for (int r = 0; r < 4; ++r) {
        const int df = iq - (kc * 128 + kt * 16 + 4 * lq + r);
        const float fdf = (float)df;
        float coef = 0.f;
        if (df >= 0) coef += __builtin_amdgcn_exp2f(lgF2 * fdf);
        if (df <= 0) coef += __builtin_amdgcn_exp2f(-lgB2 * fdf);
        S[kt][r] *= coef;
      }
    }
#pragma unroll
    for (int g = 0; g < 4; ++g) {
      union { unsigned u[4]; bf16x8 v; } pf;
      pf.u[0] = cvt_pk_bf16(S[2 * g][0], S[2 * g][1]); pf.u[1] = cvt_pk_bf16(S[2 * g][2], S[2 * g][3]);
      pf.u[2] = cvt_pk_bf16(S[2 * g + 1][0], S[2 * g + 1][1]); pf.u[3] = cvt_pk_bf16(S[2 * g + 1][2], S[2 * g + 1][3]);
#pragma unroll
      for (int et = 0; et < 8; ++et) {
        union { uint2 h2[2]; bf16x8 v; } vf;
        vf.h2[0] = *(const uint2*)(Vt + (et * 16 + lr) * RT_VS + 32 * g + 4 * lq);
        vf.h2[1] = *(const uint2*)(Vt + (et * 16 + lr) * RT_VS + 32 * g + 16 + 4 * lq);
        O[et] = __builtin_amdgcn_mfma_f32_16x16x32_bf16(vf.v, pf.v, O[et], 0, 0, 0);
      }
    }
  }
  float ss = 0.f;
#pragma unroll
  for (int et = 0; et < 8; ++et) { ss = fmaf(O[et][0], O[et][0], ss); ss = fmaf(O[et][1], O[et][1], ss); ss = fmaf(O[et][2], O[et][2], ss); ss = fmaf(O[et][3], O[et][3], ss); }
  ss += __shfl_xor(ss, 16); ss += __shfl_xor(ss, 32);
  const float rr = rsqrtf(ss * (1.f / 128.f) + EPS);
  const bf16_t* gp = P + mq * INC + C_RTG + h * 128;
  bf16_t* dst = Y + mq * 1024 + Y_RT + h * 128;
#pragma unroll
  for (int et = 0; et < 8; ++et) {
    const int e = et * 16 + 4 * lq;
    const uint2 gu = *(const uint2*)(gp + e);
    uint2 ov;
    ov.x = pack2(O[et][0] * rr * siluf(lo16(gu.x)), O[et][1] * rr * siluf(hi16(gu.x)));
    ov.y = pack2(O[et][2] * rr * siluf(lo16(gu.y)), O[et][3] * rr * siluf(hi16(gu.y)));
    *(uint2*)(dst + e) = ov;
  }
}

__device__ __forceinline__ void phase_mix1(const Params& p, int layer, char* smem, int slot = 0) {
  unsigned* ctr = (unsigned*)(p.ws + OFF_CTL) + (layer * 4 + slot);
  const bool nc = layer == 0;
  const int n_dl = 1024, n_dc = nc ? 64 : 0, n_nl = 2048, n_ncx = nc ? 64 : 0, n_kv = 1024, n_cs = 32;
  const int total = n_dl + n_dc + n_nl + n_ncx + n_kv + n_cs;
  float* rkv = (float*)(p.ws + OFF_RKV);
  float* rs = (float*)(p.ws + OFF_RS);
  for (;;) {
    int it = next_item(ctr, smem);
    if (it >= total) break;
    if (it < n_dl) { diff_item(p, layer, false, it, smem); continue; } it -= n_dl;
    if (it < n_dc) { diff_item(p, layer, true, it, smem); continue; } it -= n_dc;
    if (it < n_nl) { na_latent_item(p, layer, it, smem); continue; } it -= n_nl;
    if (it < n_ncx) { na_ctx_item(p, it, smem); continue; } it -= n_ncx;
    if (it < n_kv) {
      const int bh = it >> 5, n = it & 31, b = bh >> 2, h = bh & 3;
      ret_kv_item(p, layer, h, (size_t)b * 4096 + n * 128, 128,
                  rkv + ((size_t)(bh * 2 + 0) * 32 + n) * 8192, rkv + ((size_t)(bh * 2 + 1) * 32 + n) * 8192);
      continue;
    }
    it -= n_kv;
    {
      const int bh = it, b = bh >> 2, h = bh & 3;
      ret_kv_item(p, layer, h, (size_t)NLAT + b * 256, 256, rs + (size_t)(bh * 2 + 0) * 8192, rs + (size_t)(bh * 2 + 1) * 8192);
    }
  }
}

__device__ __forceinline__ void phase_mix2(const Params& p, int layer, char* smem, int slot = 1) {
  unsigned* ctr = (unsigned*)(p.ws + OFF_CTL) + (layer * 4 + slot);
  const int n_l = 1024, n_c = layer == 0 ? 64 : 0;
  const float* rkv = (const float*)(p.ws + OFF_RKV);
  for (;;) {
    int it = next_item(ctr, smem);
    if (it >= n_l + n_c) break;
    if (it < n_l) {
      const int bh = it >> 5, n = it & 31, b = bh >> 2, h = bh & 3;
      ret_out_item(p, layer, h, (size_t)b * 4096 + n * 128, 1, 0,
                   rkv + ((size_t)(bh * 2 + 0) * 32 + n) * 8192, rkv + ((size_t)(bh * 2 + 1) * 32 + n) * 8192, 128, smem);
    } else {
      it -= n_l;
      const int bh = it >> 1, half = it & 1, b = bh >> 2, h = bh & 3;
      ret_out_item(p, layer, h, (size_t)NLAT + b * 256, 2, half * 128, nullptr, nullptr, 256, smem);
    }
  }
}

typedef float f32x2 __attribute__((ext_vector_type(2)));
__device__ __forceinline__ unsigned sortable_key(float f, int idx) {
  const unsigned b = __float_as_uint(f);
  const unsigned k = b ^ ((unsigned)((int)b >> 31) | 0x80000000u);
  return (k & ~127u) | (unsigned)(127 - idx);
}
__device__ __forceinline__ float key_value(unsigned k) {
  k &= ~127u;
  const unsigned b = (k & 0x80000000u) ? (k ^ 0x80000000u) : ~k;
  return __uint_as_float(b);
}
#define FP8DOT(acc, H, off, W) { const f32x2 _a = __builtin_amdgcn_cvt_pk_f32_fp8((int)(W), false), _b = __builtin_amdgcn_cvt_pk_f32_fp8((int)(W), true); \
  acc = fmaf(H[(off) + 0], _a.x, acc); acc = fmaf(H[(off) + 1], _a.y, acc); acc = fmaf(H[(off) + 2], _b.x, acc); acc = fmaf(H[(off) + 3], _b.y, acc); }
#define FP8AXPY(O, off, P, W) { const f32x2 _a = __builtin_amdgcn_cvt_pk_f32_fp8((int)(W), false), _b = __builtin_amdgcn_cvt_pk_f32_fp8((int)(W), true); \
  O[(off) + 0] = fmaf(P, _a.x, O[(off) + 0]); O[(off) + 1] = fmaf(P, _a.y, O[(off) + 1]); O[(off) + 2] = fmaf(P, _b.x, O[(off) + 2]); O[(off) + 3] = fmaf(P, _b.y, O[(off) + 3]); }

constexpr int PE_OFF_SV = 0;
constexpr int PE_SVS = 132;
constexpr int PE_OFF_TV = 8 * 16 * PE_SVS * 4;
constexpr int PE_OFF_TI = PE_OFF_TV + 16 * 16 * 16 * 4;
constexpr int PE_OFF_EX = PE_OFF_TI + 16 * 16 * 16 * 4;
constexpr int PE_OFF_GT = PE_OFF_EX + 16 * 128 * 4;
constexpr int PE_OFF_CW = PE_OFF_GT + 16 * 128 * 4;
constexpr int PE_OFF_CN = PE_OFF_CW + 8 * 64 * 4;
#define WAVE_LDS_FENCE() asm volatile("s_waitcnt lgkmcnt(0)" ::: "memory")

__device__ __forceinline__ void phase_peer(const Params& p, int layer, char* smem, int ntok, bool dowrite = true) {
  const bf16_t* Q = (const bf16_t*)(p.ws + OFF_P);
  const bf16_t* H2 = (const bf16_t*)(p.ws + OFF_ACT);
  const bf16_t* SK = (const bf16_t*)(p.ws + OFF_SUBK) + (size_t)layer * 262144;
  const char* U8 = p.ws + OFF_U + (size_t)layer * NEXP * 1024;
  const char* V8 = p.ws + OFF_V + (size_t)layer * NEXP * 1024;
  const float* USC = (const float*)(p.ws + OFF_USC) + layer * NEXP;
  const float* VSC = (const float*)(p.ws + OFF_VSC) + layer * NEXP;
  const float* mod = (const float*)(p.ws + OFF_MOD) + (size_t)layer * 9 * 6144;
  const int tid = opaque_tid(), lane = tid & 63, wave = tid >> 6;
  const int lr = lane & 15, lq = lane >> 4;
  unsigned* SV = (unsigned*)(smem + PE_OFF_SV) + wave * 16 * PE_SVS;
  float* TV = (float*)(smem + PE_OFF_TV);
  int* TI = (int*)(smem + PE_OFF_TI);
  int* EX = (int*)(smem + PE_OFF_EX);
  float* GT = (float*)(smem + PE_OFF_GT);
  unsigned* CW = (unsigned*)(smem + PE_OFF_CW) + wave * 64;
  int* CN = (int*)(smem + PE_OFF_CN) + wave * 16;
  int cand_a = -1, cand_b = 0;
  {
    int c = 0;
    for (int a = 0; a < 16; ++a)
      for (int bb = 0; bb < 16; ++bb)
        if ((a + 1) * (bb + 1) <= 16) { if (c == lane) { cand_a = a; cand_b = bb; } ++c; }
  }
  const int ngroups = ntok / 16;
  for (int grp = opaque_bid(); grp < ngroups; grp += gridDim.x) {
    const int tok0 = grp * 16;
    __syncthreads();
    const int hd = wave;
#pragma unroll 1
    for (int pp = 0; pp < 2; ++pp) {
      bf16x8 af[4];
      const bf16_t* qrow = Q + (size_t)(tok0 + lr) * 2048 + hd * 256 + pp * 128;
#pragma unroll
      for (int ks = 0; ks < 4; ++ks) af[ks] = *(const bf16x8*)(qrow + ks * 32 + lq * 8);
      const bf16_t* skb = SK + (size_t)((hd * 2 + pp) * 128) * 128;
      f32x4 acc[8];
      {
        bf16x8 bfr[8][4];
#pragma unroll
        for (int nt = 0; nt < 8; ++nt)
#pragma unroll
          for (int ks = 0; ks < 4; ++ks)
            bfr[nt][ks] = *(const bf16x8*)(skb + (size_t)(nt * 16 + lr) * 128 + ks * 32 + lq * 8);
#pragma unroll
        for (int nt = 0; nt < 8; ++nt) {
          f32x4 a = (f32x4){0.f, 0.f, 0.f, 0.f};
#pragma unroll
          for (int ks = 0; ks < 4; ++ks) a = __builtin_amdgcn_mfma_f32_16x16x32_bf16(af[ks], bfr[nt][ks], a, 0, 0, 0);
          acc[nt] = a;
        }
      }
#pragma unroll
      for (int r = 0; r < 4; ++r) {
        const int tk = 4 * lq + r;
        unsigned k[8];
#pragma unroll
        for (int nt = 0; nt < 8; ++nt) k[nt] = sortable_key(acc[nt][r], nt * 16 + lr);
        unsigned gm = k[0];
#pragma unroll
        for (int nt = 1; nt < 8; ++nt) gm = max(gm, k[nt]);
        unsigned T = gm;
        T = min(T, (unsigned)__shfl_xor((int)T, 1)); T = min(T, (unsigned)__shfl_xor((int)T, 2));
        T = min(T, (unsigned)__shfl_xor((int)T, 4)); T = min(T, (unsigned)__shfl_xor((int)T, 8));
        int pos = 0;
#pragma unroll
        for (int nt = 0; nt < 8; ++nt) {
          const bool sel = k[nt] >= T;
          const unsigned long long bal = __ballot(sel);
          const unsigned grp16 = (unsigned)(bal >> (16 * lq)) & 0xffffu;
          const int below = __popc(grp16 & ((1u << lr) - 1u));
          if (sel) SV[tk * PE_SVS + pos + below] = k[nt];
          pos += __popc(grp16);
        }
        if (lr == 0) {
          CN[tk] = pos;
          SV[tk * PE_SVS + pos + 0] = 0u; SV[tk * PE_SVS + pos + 1] = 0u; SV[tk * PE_SVS + pos + 2] = 0u; SV[tk * PE_SVS + pos + 3] = 0u;
        }
      }
      WAVE_LDS_FENCE();
#pragma unroll 1
      for (int pass = 0; pass < 4; ++pass) {
        const int tk = pass * 4 + lq;
        const int cnt = CN[tk];
        const unsigned* row = SV + tk * PE_SVS;
        const int n4 = (cnt + 3) >> 2;
#pragma unroll 1
        for (int base = 0; base < cnt; base += 16) {
          const int j = base + lr;
          const unsigned my = j < cnt ? row[j] : 0xffffffffu;
          int rank = 0;
#pragma unroll 4
          for (int i4 = 0; i4 < n4; ++i4) {
            const uint4 v = *(const uint4*)(row + i4 * 4);
            rank += (v.x > my) ? 1 : 0; rank += (v.y > my) ? 1 : 0; rank += (v.z > my) ? 1 : 0; rank += (v.w > my) ? 1 : 0;
          }
          if (j < cnt && rank < 16) {
            TV[(tk * 16 + hd * 2 + pp) * 16 + rank] = key_value(my);
            TI[(tk * 16 + hd * 2 + pp) * 16 + rank] = 127 - (int)(my & 127u);
          }
        }
      }
      WAVE_LDS_FENCE();
    }
    {
      unsigned* CWt = SV;
      float vals[16];
#pragma unroll
      for (int tk = 0; tk < 16; ++tk) {
        float val = 0.f;
        unsigned key = 0u;
        if (cand_a >= 0) {
          val = TV[(tk * 16 + hd * 2 + 0) * 16 + cand_a] + TV[(tk * 16 + hd * 2 + 1) * 16 + cand_b];
          const unsigned bb = __float_as_uint(val);
          key = ((bb ^ ((unsigned)((int)bb >> 31) | 0x80000000u)) & ~63u) | (unsigned)(63 - lane);
        }
        vals[tk] = val;
        CWt[tk * 64 + lane] = key;
      }
      WAVE_LDS_FENCE();
#pragma unroll 4
      for (int tk = 0; tk < 16; ++tk) {
        const unsigned key = CWt[tk * 64 + lane];
        int rank = 0;
#pragma unroll
        for (int i4 = 0; i4 < 13; ++i4) {
          const uint4 v = *(const uint4*)(CWt + tk * 64 + i4 * 4);
          rank += (v.x > key) ? 1 : 0; rank += (v.y > key) ? 1 : 0; rank += (v.z > key) ? 1 : 0; rank += (v.w > key) ? 1 : 0;
        }
        if (cand_a >= 0 && rank < 16) {
          GT[tk * 128 + hd * 16 + rank] = vals[tk];
          EX[tk * 128 + hd * 16 + rank] = TI[(tk * 16 + hd * 2 + 0) * 16 + cand_a] * 128 + TI[(tk * 16 + hd * 2 + 1) * 16 + cand_b];
        }
      }
      WAVE_LDS_FENCE();
#pragma unroll
      for (int pass = 0; pass < 4; ++pass) {
        const int tk = pass * 4 + lq;
        const float g = GT[tk * 128 + hd * 16 + lr];
        const float mx = GT[tk * 128 + hd * 16];
        const float ev = __expf(g - mx);
        float s = ev;
        s += __shfl_xor(s, 1); s += __shfl_xor(s, 2); s += __shfl_xor(s, 4); s += __shfl_xor(s, 8);
        GT[tk * 128 + hd * 16 + lr] = ev / s;
      }
    }
    __syncthreads();
#pragma unroll 1
    for (int tt = 0; tt < 2; ++tt) {
      const int tl = wave * 2 + tt, tok = tok0 + tl;
      float hv[16], acc[16];
      {
        const bf16_t* hr = H2 + (size_t)tok * 1024;
#pragma unroll
        for (int j = 0; j < 4; ++j) {
          const uint2 u = *(const uint2*)(hr + (lane + 64 * j) * 4);
          hv[4 * j + 0] = lo16(u.x); hv[4 * j + 1] = hi16(u.x); hv[4 * j + 2] = lo16(u.y); hv[4 * j + 3] = hi16(u.y);
        }
      }
#pragma unroll
      for (int i = 0; i < 16; ++i) acc[i] = 0.f;
      uint4 uu[4], vv[4];
      float gg[4], su[4], sv[4];
#define PE_LOAD_BATCH(E0)                                                             \
      _Pragma("unroll") for (int j = 0; j < 4; ++j) {                                 \
        const int ex = EX[tl * 128 + (E0) + j];                                       \
        gg[j] = GT[tl * 128 + (E0) + j];                                              \
        uu[j] = *(const uint4*)(U8 + (size_t)ex * 1024 + lane * 16);                  \
        vv[j] = *(const uint4*)(V8 + (size_t)ex * 1024 + lane * 16);                  \
        su[j] = USC[ex]; sv[j] = VSC[ex];                                             \
      }
      PE_LOAD_BATCH(0)
#pragma unroll 1
      for (int e0 = 0; e0 < 128; e0 += 4) {
        uint4 cu[4], cv[4];
        float cg[4], csu[4], csv[4];
#pragma unroll
        for (int j = 0; j < 4; ++j) { cu[j] = uu[j]; cv[j] = vv[j]; cg[j] = gg[j]; csu[j] = su[j]; csv[j] = sv[j]; }
        if (e0 + 4 < 128) { PE_LOAD_BATCH(e0 + 4) }
#pragma unroll
        for (int j = 0; j < 4; ++j) {
          float d = 0.f;
          FP8DOT(d, hv, 0, cu[j].x) FP8DOT(d, hv, 4, cu[j].y) FP8DOT(d, hv, 8, cu[j].z) FP8DOT(d, hv, 12, cu[j].w)
          d = wave_sum(d) * csu[j];
          const float ge = 0.5f * d * (1.f + erff(d * 0.70710678118654752f));
          const float w = cg[j] * ge * csv[j];
          FP8AXPY(acc, 0, w, cv[j].x) FP8AXPY(acc, 4, w, cv[j].y) FP8AXPY(acc, 8, w, cv[j].z) FP8AXPY(acc, 12, w, cv[j].w)
        }
      }
      const int b = tok < NLAT ? (tok >> 12) : 8;
      float* xr = tok < NLAT ? p.out + (size_t)tok * 1024 : (float*)(p.ws + OFF_CTXB) + (size_t)(tok - NLAT) * 1024;
      const float* gate = mod + (size_t)b * 6144 + 5 * 1024;
#pragma unroll
      for (int j = 0; j < 4; ++j) {
        const int c = (lane + 64 * j) * 4;
        const float4 xv = *(const float4*)(xr + c);
        const float4 gv = *(const float4*)(gate + c);
        float4 o;
        o.x = xv.x + gv.x * acc[4 * j + 0]; o.y = xv.y + gv.y * acc[4 * j + 1];
        o.z = xv.z + gv.z * acc[4 * j + 2]; o.w = xv.w + gv.w * acc[4 * j + 3];
        if (dowrite) *(float4*)(xr + c) = o; else asm volatile("" :: "v"(o.x), "v"(o.y), "v"(o.z), "v"(o.w));
      }
    }
  }
}

template <int layer>
__device__ __forceinline__ void layer_body(const Params& p, char* smem, cg::grid_group& grid) {
  constexpr bool nc = layer == 0;
  const float* xin = layer == 0 ? p.x : (const float*)p.out;
  phase_norm(p, layer, 0, xin, NTOK);
  grid.sync();
#if REP_GEMM
  gemm_phase<EPI_INPROJ>(p, layer, smem, (const bf16_t*)(p.ws + OFF_ACT), (const bf16_t*)(p.ws + OFF_WIN) + (size_t)layer * 3072 * 1024, NTOK, 3072, nullptr);
  grid.sync();
#endif
  gemm_phase<EPI_INPROJ>(p, layer, smem, (const bf16_t*)(p.ws + OFF_ACT), (const bf16_t*)(p.ws + OFF_WIN) + (size_t)layer * 3072 * 1024, NTOK, 3072, nullptr);
  grid.sync();
#if REP_MIX1
  phase_mix1(p, layer, smem, 2);
  grid.sync();
#endif
  phase_mix1(p, layer, smem);
  grid.sync();
  phase_ret_scan(p, layer);
  grid.sync();
#if REP_MIX2
  phase_mix2(p, layer, smem, 3);
  grid.sync();
#endif
  phase_mix2(p, layer, smem);
  grid.sync();
  gemm_phase<EPI_OUTPROJ>(p, layer, smem, (const bf16_t*)(p.ws + OFF_ACT), (const bf16_t*)(p.ws + OFF_WOUT) + (size_t)layer * 1024 * 1024, nc ? NTOK : NLAT, 1024, xin);
  grid.sync();
  phase_norm(p, layer, 1, (const float*)p.out, nc ? NTOK : NLAT);
  grid.sync();
  gemm_phase<EPI_PLAIN>(p, layer, smem, (const bf16_t*)(p.ws + OFF_ACT), (const bf16_t*)(p.ws + OFF_WQ) + (size_t)layer * 2048 * 1024, nc ? NTOK : NLAT, 2048, nullptr);
  grid.sync();
#if REP_PEER
  phase_peer(p, layer, smem, nc ? NTOK : NLAT, false);
  grid.sync();
#endif
  phase_peer(p, layer, smem, nc ? NTOK : NLAT);
  grid.sync();
}

__global__ void __launch_bounds__(512) fwd_megakernel(Params p) {
  cg::grid_group grid = cg::this_grid();
  extern __shared__ __attribute__((aligned(16))) char smem[];
  phase_prep(p, smem);
  grid.sync();
  layer_body<0>(p, smem, grid);
  layer_body<1>(p, smem, grid);
  phase_final(p);
}

extern "C" void kernel_launch(void* const* d_in, const int* in_sizes, int n_in, void* d_out,
                              int out_size, void* d_ws, size_t ws_size, hipStream_t stream) {
  constexpr size_t kDynLds = LDS_BYTES;
  static int grid_blocks = 0;
  if (!grid_blocks) {
    int dev = 0, cus = 0, per_cu = 0;
    (void)hipGetDevice(&dev);
    (void)hipDeviceGetAttribute(&cus, hipDeviceAttributeMultiprocessorCount, dev);
    (void)hipFuncSetAttribute((const void*)fwd_megakernel, hipFuncAttributeMaxDynamicSharedMemorySize, (int)kDynLds);
    (void)hipOccupancyMaxActiveBlocksPerMultiprocessor(&per_cu, fwd_megakernel, 512, kDynLds);
    if (per_cu < 1) { fprintf(stderr, "occupancy query says %d blocks/CU\n", per_cu); per_cu = 1; }
    grid_blocks = cus;
    if (ws_size < WS_END) fprintf(stderr, "workspace too small: %zu < %zu\n", ws_size, (size_t)WS_END);
  }
  Params p{};
  p.x = (const float*)d_in[0]; p.c = (const float*)d_in[1]; p.ctx = (const float*)d_in[2]; p.c_ctx = (const float*)d_in[3];
  p.w_ada = (const float*)d_in[4]; p.b_ada = (const float*)d_in[5]; p.norm1_g = (const float*)d_in[6]; p.w_in = (const float*)d_in[7];
  p.na_rpb = (const float*)d_in[8]; p.diff_lambda = (const float*)d_in[9]; p.diff_subln_g = (const float*)d_in[10];
  p.ret_decay_logit = (const float*)d_in[11]; p.w_out = (const float*)d_in[12]; p.norm2_g = (const float*)d_in[13];
  p.peer_wq = (const float*)d_in[14]; p.peer_subkeys = (const float*)d_in[15]; p.peer_u = (const float*)d_in[16];
  p.peer_v = (const float*)d_in[17]; p.final_g = (const float*)d_in[18];
  p.out = (float*)d_out; p.ws = (char*)d_ws;
  void* args[] = {&p};
  hipError_t e = hipLaunchCooperativeKernel((void*)fwd_megakernel, dim3(grid_blocks), dim3(512), args, kDynLds, stream);
  if (e != hipSuccess) fprintf(stderr, "cooperative launch failed: %s (grid %d)\n", hipGetErrorString(e), grid_blocks);
}
```

```cpp
#include <hip/hip_runtime.h>
#include <hip/hip_cooperative_groups.h>
#include <cstdio>
#include <cstdint>
namespace cg = cooperative_groups;

typedef unsigned short bf16_t;
typedef short bf16x8 __attribute__((ext_vector_type(8)));
typedef float f32x4 __attribute__((ext_vector_type(4)));

constexpr int DM = 1024, BATCH = 8, SEQ = 4096, LCTX = 256;
constexpr int NLAT = BATCH * SEQ;
constexpr int NCTX = BATCH * LCTX;
constexpr int NTOK = NLAT + NCTX;
constexpr int INC = 3072;
constexpr int C_NAQ = 0, C_NAK = 256, C_NAV = 512, C_DFQ = 768, C_DFK = 1024, C_DFV = 1280,
              C_RTQ = 1536, C_RTK = 1792, C_RTV = 2048, C_RTG = 2560;
constexpr int Y_NA = 0, Y_DF = 256, Y_RT = 512;
constexpr int NEXP = 16384;
constexpr float EPS = 1e-6f;

constexpr size_t OFF_CTL  = 0;
constexpr size_t OFF_MISC = 4096;
constexpr size_t OFF_ROPE = 8192;
constexpr size_t OFF_MOD  = OFF_ROPE + 12288;
constexpr size_t SZ_MOD   = 2ull * 9 * 6144 * 4;
constexpr size_t OFF_WIN  = OFF_MOD + SZ_MOD;
constexpr size_t SZ_WIN   = 2ull * 3072 * 1024 * 2;
constexpr size_t OFF_WOUT = OFF_WIN + SZ_WIN;
constexpr size_t SZ_WOUT  = 2ull * 1024 * 1024 * 2;
constexpr size_t OFF_WQ   = OFF_WOUT + SZ_WOUT;
constexpr size_t SZ_WQ    = 2ull * 2048 * 1024 * 2;
constexpr size_t OFF_SUBK = OFF_WQ + SZ_WQ;
constexpr size_t SZ_SUBK  = 2ull * 262144 * 2;
constexpr size_t OFF_U    = OFF_SUBK + SZ_SUBK;
constexpr size_t SZ_UV    = 2ull * NEXP * 1024;
constexpr size_t OFF_V    = OFF_U + SZ_UV;
constexpr size_t OFF_USC  = OFF_V + SZ_UV;
constexpr size_t OFF_VSC  = OFF_USC + 2ull * NEXP * 4;
constexpr size_t OFF_ACT  = OFF_VSC + 2ull * NEXP * 4;
constexpr size_t SZ_ACT   = (size_t)NTOK * 1024 * 2;
constexpr size_t OFF_P    = OFF_ACT + SZ_ACT;
constexpr size_t SZ_P     = (size_t)NTOK * 3072 * 2;
constexpr size_t OFF_CTXB = OFF_P + SZ_P;
constexpr size_t SZ_CTXB  = (size_t)NCTX * 1024 * 4;
constexpr size_t OFF_RKV  = OFF_CTXB + SZ_CTXB;
constexpr size_t SZ_RKV   = 64ull * 32 * 8192 * 4;
constexpr size_t OFF_RS   = OFF_RKV + SZ_RKV;
constexpr size_t SZ_RS    = 64ull * 8192 * 4;
constexpr size_t WS_END   = OFF_RS + SZ_RS;

#ifndef REP_MIX1
#define REP_MIX1 0
#endif
#ifndef REP_MIX2
#define REP_MIX2 0
#endif
#ifndef REP_PEER
#define REP_PEER 0
#endif
#ifndef REP_GEMM
#define REP_GEMM 0
#endif
constexpr int LDS_BYTES = 144 * 1024;
constexpr int LDS_BCAST = LDS_BYTES - 16;

struct Params {
  const float *x, *c, *ctx, *c_ctx, *w_ada, *b_ada, *norm1_g, *w_in, *na_rpb, *diff_lambda, *diff_subln_g,
              *ret_decay_logit, *w_out, *norm2_g, *peer_wq, *peer_subkeys, *peer_u, *peer_v, *final_g;
  float* out;
  char* ws;
};

__device__ __forceinline__ float bf2f(bf16_t v) { return __uint_as_float(((unsigned)v) << 16); }
__device__ __forceinline__ bf16_t f2bf(float f) {
  unsigned u = __float_as_uint(f);
  u += 0x7fffu + ((u >> 16) & 1u);
  return (bf16_t)(u >> 16);
}
__device__ __forceinline__ unsigned pack2(float a, float b) { return (unsigned)f2bf(a) | ((unsigned)f2bf(b) << 16); }
__device__ __forceinline__ float lo16(unsigned w) { return __uint_as_float(w << 16); }
__device__ __forceinline__ float hi16(unsigned w) { return __uint_as_float(w & 0xffff0000u); }
#define DPP_ADD(v, CTRL) ((v) + __int_as_float(__builtin_amdgcn_update_dpp(0, __float_as_int(v), (CTRL), 0xf, 0xf, true)))
__device__ __forceinline__ float row16_sum(float v) {
  v = DPP_ADD(v, 0xB1);
  v = DPP_ADD(v, 0x4E);
  v = DPP_ADD(v, 0x141);
  v = DPP_ADD(v, 0x140);
  return v;
}
__device__ __forceinline__ float wave_sum(float v) {
  v = row16_sum(v);
  const int iv = __float_as_int(v);
  const float a = __int_as_float(__builtin_amdgcn_readlane(iv, 0)), b = __int_as_float(__builtin_amdgcn_readlane(iv, 16));
  const float c = __int_as_float(__builtin_amdgcn_readlane(iv, 32)), d = __int_as_float(__builtin_amdgcn_readlane(iv, 48));
  return (a + b) + (c + d);
}
__device__ __forceinline__ float siluf(float x) { return x / (1.f + __expf(-x)); }

__device__ __forceinline__ int opaque_tid() { int t = threadIdx.x; asm volatile("" : "+v"(t)); return t; }
__device__ __forceinline__ int opaque_bid() { int t = blockIdx.x; asm volatile("" : "+s"(t)); return t; }

#define DOT8(acc, Q, off, U)                                                              \
  acc = fmaf(Q[(off) + 0], lo16((U).x), acc); acc = fmaf(Q[(off) + 1], hi16((U).x), acc); \
  acc = fmaf(Q[(off) + 2], lo16((U).y), acc); acc = fmaf(Q[(off) + 3], hi16((U).y), acc); \
  acc = fmaf(Q[(off) + 4], lo16((U).z), acc); acc = fmaf(Q[(off) + 5], hi16((U).z), acc); \
  acc = fmaf(Q[(off) + 6], lo16((U).w), acc); acc = fmaf(Q[(off) + 7], hi16((U).w), acc);
#define AXPY8(O, off, P, U)                                                                   \
  O[(off) + 0] = fmaf(P, lo16((U).x), O[(off) + 0]); O[(off) + 1] = fmaf(P, hi16((U).x), O[(off) + 1]); \
  O[(off) + 2] = fmaf(P, lo16((U).y), O[(off) + 2]); O[(off) + 3] = fmaf(P, hi16((U).y), O[(off) + 3]); \
  O[(off) + 4] = fmaf(P, lo16((U).z), O[(off) + 4]); O[(off) + 5] = fmaf(P, hi16((U).z), O[(off) + 5]); \
  O[(off) + 6] = fmaf(P, lo16((U).w), O[(off) + 6]); O[(off) + 7] = fmaf(P, hi16((U).w), O[(off) + 7]);
#define UNPACK8(Q, off, U)                                                  \
  Q[(off) + 0] = lo16((U).x); Q[(off) + 1] = hi16((U).x); Q[(off) + 2] = lo16((U).y); Q[(off) + 3] = hi16((U).y); \
  Q[(off) + 4] = lo16((U).z); Q[(off) + 5] = hi16((U).z); Q[(off) + 6] = lo16((U).w); Q[(off) + 7] = hi16((U).w);

__device__ __forceinline__ int next_item(unsigned* counter, char* smem) {
  volatile int* bc = (volatile int*)(smem + LDS_BCAST);
  __syncthreads();
  if (threadIdx.x == 0) *bc = (int)atomicAdd(counter, 1u);
  __syncthreads();
  return *bc;
}

__device__ __forceinline__ void transpose_item(const float* src, bf16_t* dst, int K, int N, int item, char* smem) {
  float* t = (float*)smem;
  const int nb = N / 64;
  const int k0 = (item / nb) * 64, n0 = (item % nb) * 64;
  const int tid = opaque_tid();
  __syncthreads();
#pragma unroll
  for (int i = 0; i < 8; ++i) {
    const int k = (tid >> 6) + 8 * i, n = tid & 63;
    t[k * 65 + n] = src[(size_t)(k0 + k) * N + n0 + n];
  }
  __syncthreads();
#pragma unroll
  for (int i = 0; i < 8; ++i) {
    const int n = (tid >> 6) + 8 * i, k = tid & 63;
    dst[(size_t)(n0 + n) * K + k0 + k] = f2bf(t[k * 65 + n]);
  }
}

__device__ __forceinline__ void convert_flat(const float* src, bf16_t* dst, size_t n4) {
  const size_t gt = (size_t)opaque_bid() * blockDim.x + opaque_tid(), gs = (size_t)gridDim.x * blockDim.x;
  for (size_t i = gt; i < n4; i += gs) {
    const float4 v = ((const float4*)src)[i];
    uint2 o; o.x = pack2(v.x, v.y); o.y = pack2(v.z, v.w);
    ((uint2*)dst)[i] = o;
  }
}

__device__ __forceinline__ void phase_prep(const Params& p, char* smem) {
  const int tid = opaque_tid();
  char* ws = p.ws;
  if (opaque_bid() == 0) {
    unsigned* ctl = (unsigned*)(ws + OFF_CTL);
    if (tid < 64) ctl[tid] = 0u;
    float* misc = (float*)(ws + OFF_MISC);
    if (tid < 2) {
      const float* lp = p.diff_lambda + tid * 128;
      float s01 = 0.f, s23 = 0.f;
      for (int i = 0; i < 32; ++i) { s01 += lp[i] * lp[32 + i]; s23 += lp[64 + i] * lp[96 + i]; }
      const float lam_init = 0.8f - 0.6f * expf(-0.3f * (float)tid);
      misc[tid] = expf(s01) - expf(s23) + lam_init;
      misc[2 + tid] = lam_init;
    }
    if (tid >= 128 && tid < 256) misc[64 + tid - 128] = 0.f;
    if (tid >= 64 && tid < 80) {
      const int i = tid - 64;
      const float xv = p.ret_decay_logit[i];
      misc[16 + i] = -log1pf(expf(-xv));
    }
    float2* ropeD = (float2*)(ws + OFF_ROPE);
    float2* ropeR = (float2*)(ws + OFF_ROPE + 4096);
    for (int i = tid; i < 64 * 8; i += 512) {
      const int v = i >> 3, f = i & 7;
      const float inv = powf(10000.0f, -(float)(2 * f) / 16.0f);
      const float ang = (float)v * inv;
      ropeD[i] = make_float2(cosf(ang), sinf(ang));
    }
    for (int i = tid; i < 64 * 16; i += 512) {
      const int v = i >> 4, f = i & 15;
      const float inv = powf(10000.0f, -(float)(2 * f) / 32.0f);
      const float ang = (float)v * inv;
      ropeR[i] = make_float2(cosf(ang), sinf(ang));
    }
  }
  {
    float* sc = (float*)smem;
    float* red = (float*)(smem + 9 * 1024 * 4);
    float* mod = (float*)(ws + OFF_MOD);
    for (int item = opaque_bid(); item < 192; item += gridDim.x) {
      const int l = item / 96, cb = item % 96;
      __syncthreads();
      for (int i = tid; i < 9 * 1024; i += 512) {
        const int r = i >> 10, k = i & 1023;
        const float cv = (r < 8) ? p.c[r * 1024 + k] : p.c_ctx[k];
        sc[i] = siluf(cv);
      }
      __syncthreads();
      const int col = tid & 63, ks = tid >> 6;
      float acc[9];
#pragma unroll
      for (int r = 0; r < 9; ++r) acc[r] = 0.f;
      const float* w = p.w_ada + (size_t)l * 1024 * 6144 + cb * 64 + col;
      for (int k = ks * 128; k < ks * 128 + 128; ++k) {
        const float wv = w[(size_t)k * 6144];
#pragma unroll
        for (int r = 0; r < 9; ++r) acc[r] = fmaf(sc[r * 1024 + k], wv, acc[r]);
      }
#pragma unroll
      for (int r = 0; r < 9; ++r) red[(ks * 9 + r) * 64 + col] = acc[r];
      __syncthreads();
      for (int i = tid; i < 576; i += 512) {
        const int r = i >> 6, cc = i & 63;
        float s = 0.f;
#pragma unroll
        for (int k8 = 0; k8 < 8; ++k8) s += red[(k8 * 9 + r) * 64 + cc];
        mod[((size_t)l * 9 + r) * 6144 + cb * 64 + cc] = s + p.b_ada[l * 6144 + cb * 64 + cc];
      }
    }
    __syncthreads();
  }
  for (int item = opaque_bid(); item < 3072; item += gridDim.x) {
    const int l = item / 1536;
    int r = item % 1536;
    if (r < 768) transpose_item(p.w_in + (size_t)l * 1024 * 3072, (bf16_t*)(ws + OFF_WIN) + (size_t)l * 3072 * 1024, 1024, 3072, r, smem);
    else if (r < 1024) transpose_item(p.w_out + (size_t)l * 1024 * 1024, (bf16_t*)(ws + OFF_WOUT) + (size_t)l * 1024 * 1024, 1024, 1024, r - 768, smem);
    else transpose_item(p.peer_wq + (size_t)l * 1024 * 2048, (bf16_t*)(ws + OFF_WQ) + (size_t)l * 2048 * 1024, 1024, 2048, r - 1024, smem);
  }
  convert_flat(p.peer_subkeys, (bf16_t*)(ws + OFF_SUBK), 2ull * 262144 / 4);
  {
    const int lane = tid & 63;
    const int gw = opaque_bid() * 8 + (tid >> 6), nw = gridDim.x * 8;
    for (int row = gw; row < 4 * NEXP; row += nw) {
      const bool isv = row >= 2 * NEXP;
      const int rr = isv ? row - 2 * NEXP : row;
      const float* srow = (isv ? p.peer_v : p.peer_u) + (size_t)rr * 1024;
      float4 v[4];
      float mx = 0.f;
#pragma unroll
      for (int j = 0; j < 4; ++j) {
        v[j] = ((const float4*)srow)[lane + 64 * j];
        mx = fmaxf(mx, fmaxf(fmaxf(fabsf(v[j].x), fabsf(v[j].y)), fmaxf(fabsf(v[j].z), fabsf(v[j].w))));
      }
#pragma unroll
      for (int o = 1; o < 64; o <<= 1) mx = fmaxf(mx, __shfl_xor(mx, o));
      const float scale = mx > 0.f ? mx * (1.f / 448.f) : 1.f;
      const float inv = 1.f / scale;
      uint4 o;
      unsigned w[4];
#pragma unroll
      for (int j = 0; j < 4; ++j) {
        int t = 0;
        t = __builtin_amdgcn_cvt_pk_fp8_f32(v[j].x * inv, v[j].y * inv, t, false);
        t = __builtin_amdgcn_cvt_pk_fp8_f32(v[j].z * inv, v[j].w * inv, t, true);
        w[j] = (unsigned)t;
      }
      o.x = w[0]; o.y = w[1]; o.z = w[2]; o.w = w[3];
      *(uint4*)(ws + (isv ? OFF_V : OFF_U) + (size_t)rr * 1024 + lane * 16) = o;
      if (lane == 0) ((float*)(ws + (isv ? OFF_VSC : OFF_USC)))[rr] = scale;
    }
  }
  {
    const size_t gt = (size_t)opaque_bid() * blockDim.x + tid, gs = (size_t)gridDim.x * blockDim.x;
    float4* dst = (float4*)(ws + OFF_CTXB);
    for (size_t i = gt; i < (size_t)NCTX * 1024 / 4; i += gs) dst[i] = ((const float4*)p.ctx)[i];
  }
}

__device__ __forceinline__ void phase_norm(const Params& p, int layer, int which, const float* xlat, int nrows) {
  const int lane = opaque_tid() & 63;
  const int gw = opaque_bid() * 8 + (opaque_tid() >> 6), nw = gridDim.x * 8;
  const float* g = (which == 0 ? p.norm1_g : p.norm2_g) + layer * 1024;
  const float* mod = (const float*)(p.ws + OFF_MOD) + (size_t)layer * 9 * 6144;
  const float* ctxb = (const float*)(p.ws + OFF_CTXB);
  bf16_t* act = (bf16_t*)(p.ws + OFF_ACT);
  const int sh_off = which == 0 ? 0 : 3 * 1024, sc_off = which == 0 ? 1024 : 4 * 1024;
  for (int row = gw; row < nrows; row += nw) {
    const float* src = row < NLAT ? xlat + (size_t)row * 1024 : ctxb + (size_t)(row - NLAT) * 1024;
    const int b = row < NLAT ? (row >> 12) : 8;
    const float* mrow = mod + (size_t)b * 6144;
    float4 v[4];
    float ss = 0.f;
#pragma unroll
    for (int j = 0; j < 4; ++j) {
      v[j] = ((const float4*)src)[lane + 64 * j];
      ss += v[j].x * v[j].x + v[j].y * v[j].y + v[j].z * v[j].z + v[j].w * v[j].w;
    }
    ss = wave_sum(ss);
    const float r = rsqrtf(ss * (1.f / 1024.f) + EPS);
#pragma unroll
    for (int j = 0; j < 4; ++j) {
      const int c = (lane + 64 * j) * 4;
      const float4 gg = *(const float4*)(g + c);
      const float4 sh = *(const float4*)(mrow + sh_off + c);
      const float4 sc = *(const float4*)(mrow + sc_off + c);
      const float o0 = v[j].x * r * gg.x * (1.f + sc.x) + sh.x;
      const float o1 = v[j].y * r * gg.y * (1.f + sc.y) + sh.y;
      const float o2 = v[j].z * r * gg.z * (1.f + sc.z) + sh.z;
      const float o3 = v[j].w * r * gg.w * (1.f + sc.w) + sh.w;
      uint2 o; o.x = pack2(o0, o1); o.y = pack2(o2, o3);
      *(uint2*)(act + (size_t)row * 1024 + c) = o;
    }
  }
}

__device__ __forceinline__ void phase_final(const Params& p) {
  const int lane = opaque_tid() & 63;
  const int gw = opaque_bid() * 8 + (opaque_tid() >> 6), nw = gridDim.x * 8;
  for (int row = gw; row < NLAT; row += nw) {
    float* src = p.out + (size_t)row * 1024;
    float4 v[4];
    float ss = 0.f;
#pragma unroll
    for (int j = 0; j < 4; ++j) {
      v[j] = ((const float4*)src)[lane + 64 * j];
      ss += v[j].x * v[j].x + v[j].y * v[j].y + v[j].z * v[j].z + v[j].w * v[j].w;
    }
    ss = wave_sum(ss);
    const float r = rsqrtf(ss * (1.f / 1024.f) + EPS);
#pragma unroll
    for (int j = 0; j < 4; ++j) {
      const int c = (lane + 64 * j) * 4;
      const float4 gg = *(const float4*)(p.final_g + c);
      float4 o;
      o.x = v[j].x * r * gg.x; o.y = v[j].y * r * gg.y; o.z = v[j].z * r * gg.z; o.w = v[j].w * r * gg.w;
      ((float4*)src)[lane + 64 * j] = o;
    }
  }
}

constexpr int EPI_INPROJ = 0, EPI_OUTPROJ = 1, EPI_PLAIN = 2;
constexpr int GS = 72;
constexpr int G_ASTAGE = 256 * GS * 2;
constexpr int G_BSTAGE = 128 * GS * 2;
constexpr int G_STAGE = G_ASTAGE + G_BSTAGE;

template <int EPI>
__device__ __forceinline__ void gemm_phase(const Params& p, int layer, char* smem, const bf16_t* A, const bf16_t* Bt,
                                           int M, int N, const float* xin_lat) {
  const int tid = opaque_tid(), lane = tid & 63, wave = tid >> 6, wm = wave >> 1, wn = wave & 1;
  const int ntn = N / 128, ntiles = (M / 256) * ntn;
  const int lr = lane & 15, lq = lane >> 4;
  for (int tile = opaque_bid(); tile < ntiles; tile += gridDim.x) {
    const int m0 = (tile / ntn) * 256, n0 = (tile % ntn) * 128;
    f32x4 acc[4][4];
#pragma unroll
    for (int i = 0; i < 4; ++i)
#pragma unroll
      for (int j = 0; j < 4; ++j) acc[i][j] = (f32x4){0.f, 0.f, 0.f, 0.f};
    uint4 ra[4], rb[2];
    const int crow = tid >> 3, ckc = tid & 7;
    auto gload = [&](int k0) {
#pragma unroll
      for (int i = 0; i < 4; ++i) ra[i] = *(const uint4*)(A + (size_t)(m0 + crow + 64 * i) * 1024 + k0 + ckc * 8);
#pragma unroll
      for (int i = 0; i < 2; ++i) rb[i] = *(const uint4*)(Bt + (size_t)(n0 + crow + 64 * i) * 1024 + k0 + ckc * 8);
    };
    auto lstore = [&](int s) {
      bf16_t* sA = (bf16_t*)(smem + s * G_STAGE);
      bf16_t* sB = (bf16_t*)(smem + s * G_STAGE + G_ASTAGE);
#pragma unroll
      for (int i = 0; i < 4; ++i) *(uint4*)(sA + (crow + 64 * i) * GS + ckc * 8) = ra[i];
#pragma unroll
      for (int i = 0; i < 2; ++i) *(uint4*)(sB + (crow + 64 * i) * GS + ckc * 8) = rb[i];
    };
    __syncthreads();
    gload(0);
    lstore(0);
    __syncthreads();
    for (int kt = 0; kt < 16; ++kt) {
      const int cur = kt & 1;
      if (kt + 1 < 16) gload((kt + 1) * 64);
      const bf16_t* sA = (const bf16_t*)(smem + cur * G_STAGE);
      const bf16_t* sB = (const bf16_t*)(smem + cur * G_STAGE + G_ASTAGE);
#pragma unroll
      for (int ks = 0; ks < 2; ++ks) {
        bf16x8 af[4], bfr[4];
#pragma unroll
        for (int mi = 0; mi < 4; ++mi) af[mi] = *(const bf16x8*)(sA + (wm * 64 + mi * 16 + lr) * GS + ks * 32 + lq * 8);
#pragma unroll
        for (int ni = 0; ni < 4; ++ni) bfr[ni] = *(const bf16x8*)(sB + (wn * 64 + ni * 16 + lr) * GS + ks * 32 + lq * 8);
#pragma unroll
        for (int mi = 0; mi < 4; ++mi)
#pragma unroll
          for (int ni = 0; ni < 4; ++ni)
            acc[mi][ni] = __builtin_amdgcn_mfma_f32_16x16x32_bf16(bfr[ni], af[mi], acc[mi][ni], 0, 0, 0);
      }
      if (kt + 1 < 16) lstore(cur ^ 1);
      __syncthreads();
    }
    if constexpr (EPI == EPI_INPROJ) {
      if (n0 >= C_DFK && n0 < C_DFV) {
        float mx0 = 0.f, mx1 = 0.f;
#pragma unroll
        for (int mi = 0; mi < 4; ++mi) {
          float s0 = 0.f, s1 = 0.f;
#pragma unroll
          for (int r = 0; r < 4; ++r) {
            s0 = fmaf(acc[mi][0][r], acc[mi][0][r], s0); s0 = fmaf(acc[mi][1][r], acc[mi][1][r], s0);
            s1 = fmaf(acc[mi][2][r], acc[mi][2][r], s1); s1 = fmaf(acc[mi][3][r], acc[mi][3][r], s1);
          }
          s0 += __shfl_xor(s0, 16); s0 += __shfl_xor(s0, 32);
          s1 += __shfl_xor(s1, 16); s1 += __shfl_xor(s1, 32);
          mx0 = fmaxf(mx0, s0); mx1 = fmaxf(mx1, s1);
        }
#pragma unroll
        for (int o = 1; o < 16; o <<= 1) { mx0 = fmaxf(mx0, __shfl_xor(mx0, o)); mx1 = fmaxf(mx1, __shfl_xor(mx1, o)); }
        if (lane == 0) {
          const int bb = m0 < NLAT ? (m0 >> 12) : ((m0 - NLAT) >> 8);
          const int hh = ((n0 - C_DFK) >> 6) + wn;
          unsigned* km = (unsigned*)(p.ws + OFF_MISC) + 64 + layer * 64 + (bb * 4 + hh) * 2;
          atomicMax(km + 0, __float_as_uint(mx0));
          atomicMax(km + 1, __float_as_uint(mx1));
        }
      }
    }
#pragma unroll
    for (int mi = 0; mi < 4; ++mi) {
      const int m = m0 + wm * 64 + mi * 16 + lr;
#pragma unroll
      for (int ni = 0; ni < 4; ++ni) {
        const int n = n0 + wn * 64 + ni * 16 + lq * 4;
        float v0 = acc[mi][ni][0], v1 = acc[mi][ni][1], v2 = acc[mi][ni][2], v3 = acc[mi][ni][3];
        if constexpr (EPI == EPI_INPROJ) {
          const bool ropeD = (n >= C_DFQ && n < C_DFV), ropeR = (n >= C_RTQ && n < C_RTV);
          if ((ropeD || ropeR) && m < NLAT) {
            const int t = m & 4095, gr = t >> 6, gc = t & 63;
            float2 cs0, cs1;
            if (ropeD) {
              const float2* tab = (const float2*)(p.ws + OFF_ROPE);
              const int i0 = (n & 31) >> 1;
              if (i0 < 8) { cs0 = tab[gr * 8 + i0]; cs1 = tab[gr * 8 + i0 + 1]; }
              else { cs0 = tab[gc * 8 + i0 - 8]; cs1 = tab[gc * 8 + i0 - 7]; }
            } else {
              const float2* tab = (const float2*)(p.ws + OFF_ROPE + 4096);
              const int i0 = (n & 63) >> 1;
              if (i0 < 16) { cs0 = tab[gr * 16 + i0]; cs1 = tab[gr * 16 + i0 + 1]; }
              else { cs0 = tab[gc * 16 + i0 - 16]; cs1 = tab[gc * 16 + i0 - 15]; }
            }
            const float a0 = v0 * cs0.x - v1 * cs0.y, a1 = v0 * cs0.y + v1 * cs0.x;
            const float a2 = v2 * cs1.x - v3 * cs1.y, a3 = v2 * cs1.y + v3 * cs1.x;
            v0 = a0; v1 = a1; v2 = a2; v3 = a3;
          }
          float sc = 1.f;
          if (n < C_NAK) sc = 0.125f * 1.4426950408889634f;
          else if (n >= C_DFQ && n < C_DFK) sc = 0.17677669529663687f * 1.4426950408889634f;
          else if (n >= C_RTK && n < C_RTV) sc = 0.125f;
          uint2 o; o.x = pack2(v0 * sc, v1 * sc); o.y = pack2(v2 * sc, v3 * sc);
          *(uint2*)((bf16_t*)(p.ws + OFF_P) + (size_t)m * INC + n) = o;
        } else if constexpr (EPI == EPI_OUTPROJ) {
          const float* mod = (const float*)(p.ws + OFF_MOD) + (size_t)layer * 9 * 6144;
          const int b = m < NLAT ? (m >> 12) : 8;
          const float4 gt = *(const float4*)(mod + (size_t)b * 6144 + 2 * 1024 + n);
          const float* xi; float* xo;
          if (m < NLAT) { xi = xin_lat + (size_t)m * 1024 + n; xo = p.out + (size_t)m * 1024 + n; }
          else { xo = (float*)(p.ws + OFF_CTXB) + (size_t)(m - NLAT) * 1024 + n; xi = xo; }
          const float4 xv = *(const float4*)xi;
          float4 o; o.x = xv.x + gt.x * v0; o.y = xv.y + gt.y * v1; o.z = xv.z + gt.z * v2; o.w = xv.w + gt.w * v3;
          *(float4*)xo = o;
        } else {
          uint2 o; o.x = pack2(v0, v1); o.y = pack2(v2, v3);
          *(uint2*)((bf16_t*)(p.ws + OFF_P) + (size_t)m * 2048 + n) = o;
        }
      }
    }
  }
}

namespace g8 {
constexpr int BM = 256, BK = 64, HALF = 128, NXCD = 8, WGM = 8, HT = HALF * BK;
__device__ __forceinline__ int lds_byte(int r, int c) {
  const int st = (r >> 4) * 2 + (c >> 5), rr = r & 15, cc = c & 31, ob = rr * 64 + cc * 2;
  return st * 1024 + (ob ^ (((ob >> 9) & 1) << 5));
}
__device__ __forceinline__ void stage_rc(int b, int& R, int& C) {
  const int st = b / 1024, sb = b % 1024, swz = sb ^ (((sb >> 9) & 1) << 5);
  R = (st >> 1) * 16 + swz / 64; C = (st & 1) * 32 + (swz % 64) / 2;
}
}

template <int EPI>
__device__ __forceinline__ void epi_store4(const Params& p, int layer, int m, int n, float v0, float v1, float v2, float v3, const float* xin_lat) {
  if constexpr (EPI == EPI_INPROJ) {
    const bool ropeD = (n >= C_DFQ && n < C_DFV), ropeR = (n >= C_RTQ && n < C_RTV);
    if ((ropeD || ropeR) && m < NLAT) {
      const int t = m & 4095, gr = t >> 6, gc = t & 63;
      float2 cs0, cs1;
      if (ropeD) {
        const float2* tab = (const float2*)(p.ws + OFF_ROPE);
        const int i0 = (n & 31) >> 1;
        if (i0 < 8) { cs0 = tab[gr * 8 + i0]; cs1 = tab[gr * 8 + i0 + 1]; }
        else { cs0 = tab[gc * 8 + i0 - 8]; cs1 = tab[gc * 8 + i0 - 7]; }
      } else {
        const float2* tab = (const float2*)(p.ws + OFF_ROPE + 4096);
        const int i0 = (n & 63) >> 1;
        if (i0 < 16) { cs0 = tab[gr * 16 + i0]; cs1 = tab[gr * 16 + i0 + 1]; }
        else { cs0 = tab[gc * 16 + i0 - 16]; cs1 = tab[gc * 16 + i0 - 15]; }
      }
      const float a0 = v0 * cs0.x - v1 * cs0.y, a1 = v0 * cs0.y + v1 * cs0.x;
      const float a2 = v2 * cs1.x - v3 * cs1.y, a3 = v2 * cs1.y + v3 * cs1.x;
      v0 = a0; v1 = a1; v2 = a2; v3 = a3;
    }
    float sc = 1.f;
    if (n < C_NAK) sc = 0.125f * 1.4426950408889634f;
    else if (n >= C_DFQ && n < C_DFK) sc = 0.17677669529663687f * 1.4426950408889634f;
    else if (n >= C_RTK && n < C_RTV) sc = 0.125f;
    uint2 o; o.x = pack2(v0 * sc, v1 * sc); o.y = pack2(v2 * sc, v3 * sc);
    *(uint2*)((bf16_t*)(p.ws + OFF_P) + (size_t)m * INC + n) = o;
  } else if constexpr (EPI == EPI_OUTPROJ) {
    const float* mod = (const float*)(p.ws + OFF_MOD) + (size_t)layer * 9 * 6144;
    const int b = m < NLAT ? (m >> 12) : 8;
    const float4 gt = *(const float4*)(mod + (size_t)b * 6144 + 2 * 1024 + n);
    const float* xi; float* xo;
    if (m < NLAT) { xi = xin_lat + (size_t)m * 1024 + n; xo = p.out + (size_t)m * 1024 + n; }
    else { xo = (float*)(p.ws + OFF_CTXB) + (size_t)(m - NLAT) * 1024 + n; xi = xo; }
    const float4 xv = *(const float4*)xi;
    float4 o; o.x = xv.x + gt.x * v0; o.y = xv.y + gt.y * v1; o.z = xv.z + gt.z * v2; o.w = xv.w + gt.w * v3;
    *(float4*)xo = o;
  } else {
    uint2 o; o.x = pack2(v0, v1); o.y = pack2(v2, v3);
    *(uint2*)((bf16_t*)(p.ws + OFF_P) + (size_t)m * 2048 + n) = o;
  }
}

#define G8_LAS __attribute__((address_space(3)))
__device__ __forceinline__ bool g8_next(int i, int nM, int nN, int G, int c, int& pm, int& pn) {
  using namespace g8;
  const int nwg = nM * nN;
  const long Lx = (long)i * G + c;
  if (Lx >= nwg) return false;
  int wgid = (int)Lx;
  { const int q = nwg / NXCD, r = nwg % NXCD, xcd = wgid % NXCD, off = wgid / NXCD; wgid = (xcd < r ? xcd * (q + 1) : r * (q + 1) + (xcd - r) * q) + off; }
  const int nig = WGM * nN, gid = wgid / nig, fm = gid * WGM, gsz = (nM - fm) < WGM ? (nM - fm) : WGM;
  pm = fm + ((wgid % nig) % gsz); pn = (wgid % nig) / gsz;
  return true;
}

template <int EPI>
__device__ __forceinline__ void gemm_phase2(const Params& p, int layer, char* smem, const bf16_t* A, const bf16_t* Bt,
                                            int M, int N, const float* xin_lat) {
  using namespace g8;
  constexpr int K = 1024, nt = K / BK, HTB = HALF * BK * 2;
  G8_LAS unsigned char* lds = (G8_LAS unsigned char*)smem;
  const int tid = opaque_tid();
  const int wid = __builtin_amdgcn_readfirstlane(tid >> 6), lane = tid & 63, wr = wid >> 2, wc = wid & 3, fr = lane & 15, fq = lane >> 4;
  unsigned voff[2];
#pragma unroll
  for (int i = 0; i < 2; ++i) { int R, C; stage_rc(tid * 16 + i * 8192, R, C); voff[i] = (unsigned)(R * K + C) * 2u; }
  constexpr size_t kstep = (size_t)(BK * 2);
  constexpr size_t hstep = (size_t)HALF * K * 2;
  constexpr size_t tstep = 2 * hstep;
  const unsigned ldsw = (unsigned)wid * 1024u;
  const int aoff = lds_byte(wr * 64 + fr, fq * 8), boff = lds_byte(wc * 32 + fr, fq * 8);
#define G8_SA(b, h) (((b) * 2 + (h)) * HTB)
#define G8_SB(b, h) ((4 + (b) * 2 + (h)) * HTB)
#define G8_STAGE(bufoff, gbase) do { _Pragma("unroll") for (int _i = 0; _i < 2; ++_i)                                        \
    __builtin_amdgcn_global_load_lds((const unsigned*)((const char*)(gbase) + voff[_i]), (G8_LAS unsigned*)(lds + (bufoff) + ldsw + _i * 8192), 16, 0, 0); } while (0)
#define G8_LDA(dst, b, h) do { _Pragma("unroll") for (int m = 0; m < 4; ++m) _Pragma("unroll") for (int k = 0; k < 2; ++k) dst[m][k] = *(const G8_LAS bf16x8*)(lds + G8_SA(b, h) + aoff + m * 2048 + k * 1024); } while (0)
#define G8_LDB(dst, b, h) do { _Pragma("unroll") for (int n = 0; n < 2; ++n) _Pragma("unroll") for (int k = 0; k < 2; ++k) dst[n][k] = *(const G8_LAS bf16x8*)(lds + G8_SB(b, h) + boff + n * 2048 + k * 1024); } while (0)
#define G8_MMA(ai, bj, At_, Bt_) do { __builtin_amdgcn_s_setprio(1);                                                          \
    _Pragma("unroll") for (int m = 0; m < 4; ++m) _Pragma("unroll") for (int n = 0; n < 2; ++n) _Pragma("unroll") for (int k = 0; k < 2; ++k) \
      acc[ai][bj][m][n] = __builtin_amdgcn_mfma_f32_16x16x32_bf16(Bt_[n][k], At_[m][k], acc[ai][bj][m][n], 0, 0, 0);          \
    __builtin_amdgcn_s_setprio(0); } while (0)
#define G8_WAIT_V(n) asm volatile("s_waitcnt vmcnt(" #n ")" ::: "memory")
#define G8_WAIT_L(n) asm volatile("s_waitcnt lgkmcnt(" #n ")" ::: "memory")
#define G8_BAR __builtin_amdgcn_s_barrier()
#define G8_SCHED __builtin_amdgcn_sched_barrier(0)
  const int nM = M / BM, nN = N / BM, G = gridDim.x, cu = opaque_bid();
  int cpm, cpn, npm = 0, npn = 0, ui = 0;
  __syncthreads();
  if (g8_next(0, nM, nN, G, cu, cpm, cpn)) {
    f32x4 acc[2][2][4][2];
#pragma unroll
    for (int a = 0; a < 2; ++a)
#pragma unroll
      for (int b2 = 0; b2 < 2; ++b2)
#pragma unroll
        for (int m = 0; m < 4; ++m)
#pragma unroll
          for (int n = 0; n < 2; ++n) acc[a][b2][m][n] = (f32x4){0.f, 0.f, 0.f, 0.f};
    bf16x8 At[4][2], B0[2][2], B1[2][2];
    const char* cA = (const char*)A + (size_t)cpm * tstep;
    const char* cB = (const char*)Bt + (size_t)cpn * tstep;
    G8_STAGE(G8_SB(0, 0), cB); G8_STAGE(G8_SA(0, 0), cA); G8_STAGE(G8_SB(0, 1), cB + hstep); G8_STAGE(G8_SA(0, 1), cA + hstep);
    if (wr == 1) G8_BAR;
    G8_WAIT_V(4); G8_BAR;
    G8_STAGE(G8_SB(1, 0), cB + kstep); G8_STAGE(G8_SA(1, 0), cA + kstep); G8_STAGE(G8_SB(1, 1), cB + hstep + kstep);
    G8_WAIT_V(6); G8_BAR;
    for (;;) {
      const bool has_next = g8_next(ui + 1, nM, nN, G, cu, npm, npn);
      const char* nA = has_next ? (const char*)A + (size_t)npm * tstep : cA;
      const char* nB = has_next ? (const char*)Bt + (size_t)npn * tstep : cB;
#pragma unroll 1
      for (int t = 0; t < nt; t += 2) {
        const bool last = (t == nt - 2);
        const char* a1 = cA + (size_t)(t + 1) * kstep;
        const char* a2 = last ? nA : cA + (size_t)(t + 2) * kstep; const char* b2 = last ? nB : cB + (size_t)(t + 2) * kstep;
        const char* a3 = a2 + kstep; const char* b3 = b2 + kstep;
        G8_LDB(B0, 0, 0); G8_SCHED; G8_LDA(At, 0, 0); G8_STAGE(G8_SA(1, 1), a1 + hstep);
        G8_WAIT_L(8); G8_BAR; G8_WAIT_L(0); G8_MMA(0, 0, At, B0); G8_BAR; G8_SCHED;
        G8_LDB(B1, 0, 1); G8_STAGE(G8_SB(0, 0), b2);
        G8_BAR; G8_WAIT_L(0); G8_MMA(0, 1, At, B1); G8_BAR;
        G8_LDA(At, 0, 1); G8_STAGE(G8_SA(0, 0), a2);
        G8_BAR; G8_WAIT_L(0); G8_MMA(1, 0, At, B0); G8_BAR; G8_SCHED;
        G8_STAGE(G8_SB(0, 1), b2 + hstep);
        G8_WAIT_V(6); G8_BAR; G8_MMA(1, 1, At, B1); G8_BAR;
        G8_LDB(B0, 1, 0); G8_SCHED; G8_LDA(At, 1, 0); G8_STAGE(G8_SA(0, 1), a2 + hstep);
        G8_WAIT_L(8); G8_BAR; G8_WAIT_L(0); G8_MMA(0, 0, At, B0); G8_BAR; G8_SCHED;
        G8_LDB(B1, 1, 1); G8_STAGE(G8_SB(1, 0), b3);
        G8_BAR; G8_WAIT_L(0); G8_MMA(0, 1, At, B1); G8_BAR;
        G8_LDA(At, 1, 1); G8_STAGE(G8_SA(1, 0), a3);
        G8_BAR; G8_WAIT_L(0); G8_MMA(1, 0, At, B0); G8_BAR; G8_SCHED;
        G8_STAGE(G8_SB(1, 1), b3 + hstep);
        G8_WAIT_V(6); G8_BAR; G8_MMA(1, 1, At, B1); G8_BAR;
      }
      {
        const int brow = cpm * BM, bcol = cpn * BM;
        if constexpr (EPI == EPI_INPROJ) {
          if (bcol == C_DFK) {
#pragma unroll
            for (int bj = 0; bj < 2; ++bj) {
              float mx = 0.f;
#pragma unroll
              for (int ai = 0; ai < 2; ++ai)
#pragma unroll
                for (int m = 0; m < 4; ++m) {
                  float s = 0.f;
#pragma unroll
                  for (int n = 0; n < 2; ++n)
#pragma unroll
                    for (int j = 0; j < 4; ++j) s = fmaf(acc[ai][bj][m][n][j], acc[ai][bj][m][n][j], s);
                  s += __shfl_xor(s, 16); s += __shfl_xor(s, 32);
                  mx = fmaxf(mx, s);
                }
#pragma unroll
              for (int o = 1; o < 16; o <<= 1) mx = fmaxf(mx, __shfl_xor(mx, o));
              if (lane == 0) {
                const int bb = brow < NLAT ? (brow >> 12) : ((brow - NLAT) >> 8);
                unsigned* km = (unsigned*)(p.ws + OFF_MISC) + 64 + layer * 64 + (bb * 4 + bj * 2 + (wc >> 1)) * 2 + (wc & 1);
                atomicMax(km, __float_as_uint(mx));
              }
            }
          }
        }
#pragma unroll
        for (int ai = 0; ai < 2; ++ai)
#pragma unroll
          for (int bj = 0; bj < 2; ++bj)
#pragma unroll
            for (int m = 0; m < 4; ++m)
#pragma unroll
              for (int n = 0; n < 2; ++n)
                epi_store4<EPI>(p, layer, brow + ai * HALF + wr * 64 + m * 16 + fr, bcol + bj * HALF + wc * 32 + n * 16 + fq * 4,
                                acc[ai][bj][m][n][0], acc[ai][bj][m][n][1], acc[ai][bj][m][n][2], acc[ai][bj][m][n][3], xin_lat);
      }
      if (!has_next) break;
#pragma unroll
      for (int a = 0; a < 2; ++a)
#pragma unroll
        for (int b2 = 0; b2 < 2; ++b2)
#pragma unroll
          for (int m = 0; m < 4; ++m)
#pragma unroll
            for (int n = 0; n < 2; ++n) acc[a][b2][m][n] = (f32x4){0.f, 0.f, 0.f, 0.f};
      cpm = npm; cpn = npn; cA = nA; cB = nB; ++ui;
    }
    G8_WAIT_V(0);
    if (wr == 0) G8_BAR;
    G8_BAR;
  }
}

__device__ __forceinline__ unsigned cvt_pk_bf16(float lo, float hi) {
  unsigned r;
  asm volatile("v_cvt_pk_bf16_f32 %0, %1, %2" : "=v"(r) : "v"(lo), "v"(hi));
  return r;
}
constexpr int DKS = 72;
__device__ __forceinline__ void diff_item(const Params& p, int layer, bool ctxq, int item, char* smem) {
  const bf16_t* P = (const bf16_t*)(p.ws + OFF_P);
  bf16_t* Y = (bf16_t*)(p.ws + OFF_ACT);
  const float* misc = (const float*)(p.ws + OFF_MISC);
  const float lam = misc[layer], lam_init = misc[2 + layer];
  const int tid = opaque_tid(), lane = tid & 63, wave = tid >> 6, lr = lane & 15, lq = lane >> 4;
  int b, h, mbase, nkeys;
  if (!ctxq) { b = item >> 6; h = (item >> 4) & 3; mbase = b * 4096 + (item & 15) * 256; nkeys = 256 + 4096; }
  else { b = item >> 2; h = item & 3; mbase = NLAT + b * 256; nkeys = 256; }
  const float kmax0 = sqrtf(misc[64 + layer * 64 + (b * 4 + h) * 2 + 0]), kmax1 = sqrtf(misc[64 + layer * 64 + (b * 4 + h) * 2 + 1]);
  bf16x8 qf[2][2];
  f32x4 C0[2], C1[2];
#pragma unroll
  for (int qt = 0; qt < 2; ++qt) {
    const bf16_t* qr = P + (size_t)(mbase + wave * 32 + qt * 16 + lr) * INC + C_DFQ + h * 64 + lq * 8;
    const uint4 u0 = *(const uint4*)(qr), u1 = *(const uint4*)(qr + 32);
    float s0 = 0.f, s1 = 0.f;
    { float t[8]; UNPACK8(t, 0, u0) _Pragma("unroll") for (int i = 0; i < 8; ++i) s0 = fmaf(t[i], t[i], s0); }
    { float t[8]; UNPACK8(t, 0, u1) _Pragma("unroll") for (int i = 0; i < 8; ++i) s1 = fmaf(t[i], t[i], s1); }
    s0 += __shfl_xor(s0, 16); s0 += __shfl_xor(s0, 32);
    s1 += __shfl_xor(s1, 16); s1 += __shfl_xor(s1, 32);
    const float nm0 = -sqrtf(s0) * kmax0, nm1 = -sqrtf(s1) * kmax1;
    C0[qt] = (f32x4){nm0, nm0, nm0, nm0};
    C1[qt] = (f32x4){nm1, nm1, nm1, nm1};
    union { uint4 u; bf16x8 v; } c0, c1; c0.u = u0; c1.u = u1;
    qf[qt][0] = c0.v; qf[qt][1] = c1.v;
  }
  f32x4 O0[2][4], O1[2][4];
#pragma unroll
  for (int qt = 0; qt < 2; ++qt)
#pragma unroll
    for (int i = 0; i < 4; ++i) { O0[qt][i] = (f32x4){0.f, 0.f, 0.f, 0.f}; O1[qt][i] = (f32x4){0.f, 0.f, 0.f, 0.f}; }
  float l0[2] = {0.f, 0.f}, l1[2] = {0.f, 0.f};
  const int lkey = tid >> 3, lch = tid & 7;
  uint4 uk, uv;
  auto gload = [&](int k0) {
    const int kk = k0 + lkey;
    const size_t row = kk < 256 ? (size_t)(NLAT + b * 256 + kk) : (size_t)(b * 4096 + kk - 256);
    uk = *(const uint4*)(P + row * INC + C_DFK + h * 64 + lch * 8);
    uv = *(const uint4*)(P + row * INC + C_DFV + h * 64 + lch * 8);
  };
  auto lstore = [&](int buf) {
    bf16_t* Ks = (bf16_t*)(smem + buf * (2 * 64 * DKS * 2));
    bf16_t* Vt = Ks + 64 * DKS;
    *(uint4*)(Ks + lkey * DKS + lch * 8) = uk;
    bf16_t* vd = Vt + (lch * 8) * DKS + lkey;
    vd[0 * DKS] = (bf16_t)(uv.x & 0xffffu); vd[1 * DKS] = (bf16_t)(uv.x >> 16);
    vd[2 * DKS] = (bf16_t)(uv.y & 0xffffu); vd[3 * DKS] = (bf16_t)(uv.y >> 16);
    vd[4 * DKS] = (bf16_t)(uv.z & 0xffffu); vd[5 * DKS] = (bf16_t)(uv.z >> 16);
    vd[6 * DKS] = (bf16_t)(uv.w & 0xffffu); vd[7 * DKS] = (bf16_t)(uv.w >> 16);
  };
  __syncthreads();
  gload(0);
  lstore(0);
  __syncthreads();
  const int ntile = nkeys >> 6;
#pragma unroll 1
  for (int t = 0; t < ntile; ++t) {
    const int cur = t & 1;
    if (t + 1 < ntile) gload((t + 1) * 64);
    const bf16_t* Ks = (const bf16_t*)(smem + cur * (2 * 64 * DKS * 2));
    const bf16_t* Vt = Ks + 64 * DKS;
    f32x4 S0[2][4], S1[2][4];
#pragma unroll
    for (int kt = 0; kt < 4; ++kt) {
      const bf16x8 k0f = *(const bf16x8*)(Ks + (kt * 16 + lr) * DKS + lq * 8);
      const bf16x8 k1f = *(const bf16x8*)(Ks + (kt * 16 + lr) * DKS + 32 + lq * 8);
#pragma unroll
      for (int qt = 0; qt < 2; ++qt) {
        S0[qt][kt] = __builtin_amdgcn_mfma_f32_16x16x32_bf16(k0f, qf[qt][0], C0[qt], 0, 0, 0);
        S1[qt][kt] = __builtin_amdgcn_mfma_f32_16x16x32_bf16(k1f, qf[qt][1], C1[qt], 0, 0, 0);
      }
    }
    union PF { unsigned u[4]; bf16x8 v; };
    PF pf0[2][2], pf1[2][2];
#pragma unroll
    for (int qt = 0; qt < 2; ++qt) {
      float ps0 = 0.f, ps1 = 0.f;
#pragma unroll
      for (int kt = 0; kt < 4; ++kt) {
#pragma unroll
        for (int r = 0; r < 4; ++r) {
          S0[qt][kt][r] = __builtin_amdgcn_exp2f(S0[qt][kt][r]); ps0 += S0[qt][kt][r];
          S1[qt][kt][r] = __builtin_amdgcn_exp2f(S1[qt][kt][r]); ps1 += S1[qt][kt][r];
        }
      }
      l0[qt] += ps0; l1[qt] += ps1;
#pragma unroll
      for (int g = 0; g < 2; ++g) {
        pf0[qt][g].u[0] = cvt_pk_bf16(S0[qt][2 * g][0], S0[qt][2 * g][1]); pf0[qt][g].u[1] = cvt_pk_bf16(S0[qt][2 * g][2], S0[qt][2 * g][3]);
        pf0[qt][g].u[2] = cvt_pk_bf16(S0[qt][2 * g + 1][0], S0[qt][2 * g + 1][1]); pf0[qt][g].u[3] = cvt_pk_bf16(S0[qt][2 * g + 1][2], S0[qt][2 * g + 1][3]);
        pf1[qt][g].u[0] = cvt_pk_bf16(S1[qt][2 * g][0], S1[qt][2 * g][1]); pf1[qt][g].u[1] = cvt_pk_bf16(S1[qt][2 * g][2], S1[qt][2 * g][3]);
        pf1[qt][g].u[2] = cvt_pk_bf16(S1[qt][2 * g + 1][0], S1[qt][2 * g + 1][1]); pf1[qt][g].u[3] = cvt_pk_bf16(S1[qt][2 * g + 1][2], S1[qt][2 * g + 1][3]);
      }
    }
#pragma unroll
    for (int g = 0; g < 2; ++g) {
#pragma unroll
      for (int dt = 0; dt < 4; ++dt) {
        union { uint2 h2[2]; bf16x8 v; } vf;
        vf.h2[0] = *(const uint2*)(Vt + (dt * 16 + lr) * DKS + 32 * g + 4 * lq);
        vf.h2[1] = *(const uint2*)(Vt + (dt * 16 + lr) * DKS + 32 * g + 16 + 4 * lq);
#pragma unroll
        for (int qt = 0; qt < 2; ++qt) {
          O0[qt][dt] = __builtin_amdgcn_mfma_f32_16x16x32_bf16(vf.v, pf0[qt][g].v, O0[qt][dt], 0, 0, 0);
          O1[qt][dt] = __builtin_amdgcn_mfma_f32_16x16x32_bf16(vf.v, pf1[qt][g].v, O1[qt][dt], 0, 0, 0);
        }
      }
    }
    if (t + 1 < ntile) lstore(cur ^ 1);
    __syncthreads();
  }
  const float* sg = p.diff_subln_g + layer * 64;
#pragma unroll
  for (int qt = 0; qt < 2; ++qt) {
    float a0 = l0[qt], a1 = l1[qt];
    a0 += __shfl_xor(a0, 16); a0 += __shfl_xor(a0, 32);
    a1 += __shfl_xor(a1, 16); a1 += __shfl_xor(a1, 32);
    const float i0 = 1.f / a0, i1 = lam / a1;
    float ss = 0.f;
#pragma unroll
    for (int dt = 0; dt < 4; ++dt) {
#pragma unroll
      for (int r = 0; r < 4; ++r) { const float v = O0[qt][dt][r] * i0 - O1[qt][dt][r] * i1; O0[qt][dt][r] = v; ss = fmaf(v, v, ss); }
    }
    ss += __shfl_xor(ss, 16); ss += __shfl_xor(ss, 32);
    const float rr = rsqrtf(ss * (1.f / 64.f) + EPS) * (1.f - lam_init);
    bf16_t* dst = Y + (size_t)(mbase + wave * 32 + qt * 16 + lr) * 1024 + Y_DF + h * 64;
#pragma unroll
    for (int dt = 0; dt < 4; ++dt) {
      const int d = dt * 16 + 4 * lq;
      const float4 g4 = *(const float4*)(sg + d);
      uint2 ov;
      ov.x = pack2(O0[qt][dt][0] * rr * g4.x, O0[qt][dt][1] * rr * g4.y);
      ov.y = pack2(O0[qt][dt][2] * rr * g4.z, O0[qt][dt][3] * rr * g4.w);
      *(uint2*)(dst + d) = ov;
    }
  }
}

constexpr int NA_WS = 520;
constexpr int NA_CS = 264;
constexpr int NA_OFF_VTW = 0;
constexpr int NA_OFF_VTC = 64 * NA_WS * 2;
constexpr int NA_OFF_RPB = NA_OFF_VTC + 64 * NA_CS * 2;
constexpr int NA_OFF_MRG = NA_OFF_RPB + 2048;

#define NA_STEP(KPTR_EXPR, BIAS_EXPR, VT_PTR, VT_STRIDE, VT_KEY0_EXPR)                                           \
  {                                                                                                               \
    f32x4 S[4];                                                                                                   \
    _Pragma("unroll") for (int kt = 0; kt < 4; ++kt) {                                                            \
      const bf16_t* kp = (KPTR_EXPR);                                                                             \
      const bf16x8 ka = *(const bf16x8*)(kp + lq * 8);                                                            \
      const bf16x8 kb = *(const bf16x8*)(kp + 32 + lq * 8);                                                       \
      f32x4 a = __builtin_amdgcn_mfma_f32_16x16x32_bf16(ka, qf[0], (f32x4){0.f, 0.f, 0.f, 0.f}, 0, 0, 0);         \
      S[kt] = __builtin_amdgcn_mfma_f32_16x16x32_bf16(kb, qf[1], a, 0, 0, 0);                                      \
    }                                                                                                             \
    _Pragma("unroll") for (int kt = 0; kt < 4; ++kt) {                                                            \
      _Pragma("unroll") for (int r = 0; r < 4; ++r) { S[kt][r] += (BIAS_EXPR); }                                  \
    }                                                                                                             \
    float x = fmaxf(fmaxf(S[0][0], S[0][1]), fmaxf(S[0][2], S[0][3]));                                            \
    _Pragma("unroll") for (int kt = 1; kt < 4; ++kt) x = fmaxf(x, fmaxf(fmaxf(S[kt][0], S[kt][1]), fmaxf(S[kt][2], S[kt][3]))); \
    x = fmaxf(x, __shfl_xor(x, 16)); x = fmaxf(x, __shfl_xor(x, 32));                                             \
    const float mn = fmaxf(mrun, x);                                                                              \
    const float al = __builtin_amdgcn_exp2f(mrun - mn);                                                           \
    mrun = mn;                                                                                                    \
    float ps = 0.f;                                                                                               \
    _Pragma("unroll") for (int kt = 0; kt < 4; ++kt) {                                                            \
      _Pragma("unroll") for (int r = 0; r < 4; ++r) { S[kt][r] = __builtin_amdgcn_exp2f(S[kt][r] - mn); ps += S[kt][r]; } \
    }                                                                                                             \
    lrun = lrun * al + ps;                                                                                        \
    _Pragma("unroll") for (int dt = 0; dt < 4; ++dt) {                                                            \
      _Pragma("unroll") for (int r = 0; r < 4; ++r) O[dt][r] *= al;                                               \
    }                                                                                                             \
    _Pragma("unroll") for (int g = 0; g < 2; ++g) {                                                               \
      union { unsigned u[4]; bf16x8 v; } pf;                                                                      \
      pf.u[0] = cvt_pk_bf16(S[2 * g][0], S[2 * g][1]); pf.u[1] = cvt_pk_bf16(S[2 * g][2], S[2 * g][3]);           \
      pf.u[2] = cvt_pk_bf16(S[2 * g + 1][0], S[2 * g + 1][1]); pf.u[3] = cvt_pk_bf16(S[2 * g + 1][2], S[2 * g + 1][3]); \
      const int vk0 = (VT_KEY0_EXPR);                                                                             \
      _Pragma("unroll") for (int dt = 0; dt < 4; ++dt) {                                                          \
        union { uint2 h2[2]; bf16x8 v; } vf;                                                                      \
        vf.h2[0] = *(const uint2*)((VT_PTR) + (dt * 16 + lr) * (VT_STRIDE) + vk0 + 4 * lq);                       \
        vf.h2[1] = *(const uint2*)((VT_PTR) + (dt * 16 + lr) * (VT_STRIDE) + vk0 + 16 + 4 * lq);                  \
        O[dt] = __builtin_amdgcn_mfma_f32_16x16x32_bf16(vf.v, pf.v, O[dt], 0, 0, 0);                              \
      }                                                                                                           \
    }                                                                                                             \
  }

__device__ __forceinline__ void vt_store8(bf16_t* vt, int stride, int d0, int key, uint4 uv) {
  bf16_t* vd = vt + d0 * stride + key;
  vd[0 * stride] = (bf16_t)(uv.x & 0xffffu); vd[1 * stride] = (bf16_t)(uv.x >> 16);
  vd[2 * stride] = (bf16_t)(uv.y & 0xffffu); vd[3 * stride] = (bf16_t)(uv.y >> 16);
  vd[4 * stride] = (bf16_t)(uv.z & 0xffffu); vd[5 * stride] = (bf16_t)(uv.z >> 16);
  vd[6 * stride] = (bf16_t)(uv.w & 0xffffu); vd[7 * stride] = (bf16_t)(uv.w >> 16);
}

__device__ __forceinline__ void na_latent_item(const Params& p, int layer, int item, char* smem) {
  const bf16_t* P = (const bf16_t*)(p.ws + OFF_P);
  bf16_t* Y = (bf16_t*)(p.ws + OFF_ACT);
  const int b = item >> 8, h = (item >> 6) & 3, grow = item & 63;
  const int tid = opaque_tid(), lane = tid & 63, wave = tid >> 6, lr = lane & 15, lq = lane >> 4;
  const int jt = wave & 3, half = wave >> 2;
  bf16_t* VtW = (bf16_t*)(smem + NA_OFF_VTW);
  bf16_t* VtC = (bf16_t*)(smem + NA_OFF_VTC);
  float* RPB = (float*)(smem + NA_OFF_RPB);
  float* MRG = (float*)(smem + NA_OFF_MRG);
  const int rs = min(max(grow - 4, 0), 56);
  __syncthreads();
  {
    const int ch = tid & 7;
#pragma unroll
    for (int i = 0; i < 8; ++i) {
      const int key = (tid >> 3) + 64 * i;
      const uint4 uv = *(const uint4*)(P + (size_t)(b * 4096 + (rs + (key >> 6)) * 64 + (key & 63)) * INC + C_NAV + h * 64 + ch * 8);
      vt_store8(VtW, NA_WS, ch * 8, key, uv);
    }
#pragma unroll
    for (int i = 0; i < 4; ++i) {
      const int key = (tid >> 3) + 64 * i;
      const uint4 uv = *(const uint4*)(P + (size_t)(NLAT + b * 256 + key) * INC + C_NAV + h * 64 + ch * 8);
      vt_store8(VtC, NA_CS, ch * 8, key, uv);
    }
    if (tid < 465) RPB[tid] = p.na_rpb[(size_t)(layer * 4 + h) * 465 + tid] * 1.4426950408889634f;
  }
  const int qc = jt * 16 + lr;
  const int mq = b * 4096 + grow * 64 + qc;
  bf16x8 qf[2];
  {
    const bf16_t* qr = P + (size_t)mq * INC + C_NAQ + h * 64 + lq * 8;
    qf[0] = *(const bf16x8*)(qr);
    qf[1] = *(const bf16x8*)(qr + 32);
  }
  f32x4 O[4];
#pragma unroll
  for (int i = 0; i < 4; ++i) O[i] = (f32x4){0.f, 0.f, 0.f, 0.f};
  float mrun = -1e30f, lrun = 0.f;
  __syncthreads();
  if (half == 0) {
    const int k0 = min(max(jt * 16 - 8, 0), 32);
    const int cs = min(max(qc - 8, 0), 48);
#pragma unroll 1
    for (int s = 0; s < 4; ++s) {
      const int wr0 = 2 * s;
      NA_STEP(P + (size_t)(b * 4096 + (rs + wr0 + (kt >> 1)) * 64 + k0 + 16 * (kt & 1) + lr) * INC + C_NAK + h * 64,
              ((k0 + 16 * (kt & 1) + 4 * lq + r) >= cs && (k0 + 16 * (kt & 1) + 4 * lq + r) < cs + 16)
                  ? RPB[(rs + wr0 + (kt >> 1) - grow + 7) * 31 + (k0 + 16 * (kt & 1) + 4 * lq + r) - qc + 15] : -1e30f,
              VtW, NA_WS, (wr0 + g) * 64 + k0)
    }
  } else {
#pragma unroll 1
    for (int s = 0; s < 4; ++s) {
      NA_STEP(P + (size_t)(NLAT + b * 256 + s * 64 + kt * 16 + lr) * INC + C_NAK + h * 64, 0.f, VtC, NA_CS, s * 64 + 32 * g)
    }
  }
  lrun += __shfl_xor(lrun, 16); lrun += __shfl_xor(lrun, 32);
  float* mg = MRG + (jt * 64 + lane) * 18;
  if (half == 1) {
    mg[0] = mrun; mg[1] = lrun;
#pragma unroll
    for (int dt = 0; dt < 4; ++dt) { mg[2 + dt * 4 + 0] = O[dt][0]; mg[2 + dt * 4 + 1] = O[dt][1]; mg[2 + dt * 4 + 2] = O[dt][2]; mg[2 + dt * 4 + 3] = O[dt][3]; }
  }
  __syncthreads();
  if (half == 0) {
    const float m2 = mg[0], l2 = mg[1];
    const float M = fmaxf(mrun, m2);
    const float f1 = __builtin_amdgcn_exp2f(mrun - M), f2 = __builtin_amdgcn_exp2f(m2 - M);
    const float inv = 1.f / (lrun * f1 + l2 * f2);
    bf16_t* dst = Y + (size_t)mq * 1024 + Y_NA + h * 64;
#pragma unroll
    for (int dt = 0; dt < 4; ++dt) {
      const float o0 = (O[dt][0] * f1 + mg[2 + dt * 4 + 0] * f2) * inv, o1 = (O[dt][1] * f1 + mg[2 + dt * 4 + 1] * f2) * inv;
      const float o2 = (O[dt][2] * f1 + mg[2 + dt * 4 + 2] * f2) * inv, o3 = (O[dt][3] * f1 + mg[2 + dt * 4 + 3] * f2) * inv;
      uint2 ov; ov.x = pack2(o0, o1); ov.y = pack2(o2, o3);
      *(uint2*)(dst + dt * 16 + 4 * lq) = ov;
    }
  }
}

__device__ __forceinline__ void na_ctx_item(const Params& p, int item, char* smem) {
  const bf16_t* P = (const bf16_t*)(p.ws + OFF_P);
  bf16_t* Y = (bf16_t*)(p.ws + OFF_ACT);
  const int b = item >> 3, h = (item >> 1) & 3, qg = item & 1;
  const int tid = opaque_tid(), lane = tid & 63, wave = tid >> 6, lr = lane & 15, lq = lane >> 4;
  bf16_t* VtC = (bf16_t*)(smem + NA_OFF_VTC);
  __syncthreads();
  {
    const int ch = tid & 7;
#pragma unroll
    for (int i = 0; i < 4; ++i) {
      const int key = (tid >> 3) + 64 * i;
      const uint4 uv = *(const uint4*)(P + (size_t)(NLAT + b * 256 + key) * INC + C_NAV + h * 64 + ch * 8);
      vt_store8(VtC, NA_CS, ch * 8, key, uv);
    }
  }
  const int mq = NLAT + b * 256 + qg * 128 + wave * 16 + lr;
  bf16x8 qf[2];
  {
    const bf16_t* qr = P + (size_t)mq * INC + C_NAQ + h * 64 + lq * 8;
    qf[0] = *(const bf16x8*)(qr);
    qf[1] = *(const bf16x8*)(qr + 32);
  }
  f32x4 O[4];
#pragma unroll
  for (int i = 0; i < 4; ++i) O[i] = (f32x4){0.f, 0.f, 0.f, 0.f};
  float mrun = -1e30f, lrun = 0.f;
  __syncthreads();
#pragma unroll 1
  for (int s = 0; s < 4; ++s) {
    NA_STEP(P + (size_t)(NLAT + b * 256 + s * 64 + kt * 16 + lr) * INC + C_NAK + h * 64, 0.f, VtC, NA_CS, s * 64 + 32 * g)
  }
  lrun += __shfl_xor(lrun, 16); lrun += __shfl_xor(lrun, 32);
  const float inv = 1.f / lrun;
  bf16_t* dst = Y + (size_t)mq * 1024 + Y_NA + h * 64;
#pragma unroll
  for (int dt = 0; dt < 4; ++dt) {
    uint2 ov; ov.x = pack2(O[dt][0] * inv, O[dt][1] * inv); ov.y = pack2(O[dt][2] * inv, O[dt][3] * inv);
    *(uint2*)(dst + dt * 16 + 4 * lq) = ov;
  }
}

constexpr int KV_S = 136;
constexpr int KV_OFF_KF = 0, KV_OFF_KB = 64 * KV_S * 2, KV_OFF_VT = 2 * 64 * KV_S * 2;
__device__ __forceinline__ void ret_kv_item(const Params& p, int layer, int h, size_t row0, int cnt, float* dstF, float* dstB, char* smem) {
  const bf16_t* P = (const bf16_t*)(p.ws + OFF_P);
  const float* misc = (const float*)(p.ws + OFF_MISC);
  const float lgF2 = misc[16 + layer * 8 + 0 * 4 + h] * 1.4426950408889634f, lgB2 = misc[16 + layer * 8 + 1 * 4 + h] * 1.4426950408889634f;
  const int tid = opaque_tid(), lane = tid & 63, wave = tid >> 6, lr = lane & 15, lq = lane >> 4;
  bf16_t* KFt = (bf16_t*)(smem + KV_OFF_KF);
  bf16_t* KBt = (bf16_t*)(smem + KV_OFF_KB);
  bf16_t* Vt = (bf16_t*)(smem + KV_OFF_VT);
  const int dir = wave >> 2, dt = wave & 3;
  f32x4 acc[8];
#pragma unroll
  for (int i = 0; i < 8; ++i) acc[i] = (f32x4){0.f, 0.f, 0.f, 0.f};
#pragma unroll 1
  for (int kc = 0; kc < (cnt >> 7); ++kc) {
    __syncthreads();
    {
      const int tok = tid >> 2, c = tid & 3;
      const int j = kc * 128 + tok;
      const float wF = __builtin_amdgcn_exp2f(lgF2 * (float)(cnt - 1 - j)), wB = __builtin_amdgcn_exp2f(lgB2 * (float)j);
      const bf16_t* rowp = P + (row0 + j) * INC;
#pragma unroll
      for (int c8 = 0; c8 < 2; ++c8) {
        const uint4 u = *(const uint4*)(rowp + C_RTK + h * 64 + c * 16 + c8 * 8);
        float kv[8];
        UNPACK8(kv, 0, u)
#pragma unroll
        for (int i = 0; i < 8; ++i) {
          KFt[(c * 16 + c8 * 8 + i) * KV_S + tok] = f2bf(kv[i] * wF);
          KBt[(c * 16 + c8 * 8 + i) * KV_S + tok] = f2bf(kv[i] * wB);
        }
      }
#pragma unroll
      for (int c8 = 0; c8 < 4; ++c8) {
        const uint4 uv = *(const uint4*)(rowp + C_RTV + h * 128 + c * 32 + c8 * 8);
        vt_store8(Vt, KV_S, c * 32 + c8 * 8, tok, uv);
      }
    }
    __syncthreads();
    const bf16_t* Kt = dir == 0 ? KFt : KBt;
    bf16x8 af[4];
#pragma unroll
    for (int ks = 0; ks < 4; ++ks) af[ks] = *(const bf16x8*)(Kt + (dt * 16 + lr) * KV_S + ks * 32 + lq * 8);
#pragma unroll
    for (int et = 0; et < 8; ++et) {
#pragma unroll
      for (int ks = 0; ks < 4; ++ks) {
        const bf16x8 bfr = *(const bf16x8*)(Vt + (et * 16 + lr) * KV_S + ks * 32 + lq * 8);
        acc[et] = __builtin_amdgcn_mfma_f32_16x16x32_bf16(af[ks], bfr, acc[et], 0, 0, 0);
      }
    }
  }
  float* dst = dir == 0 ? dstF : dstB;
#pragma unroll
  for (int et = 0; et < 8; ++et) {
#pragma unroll
    for (int r = 0; r < 4; ++r) dst[(dt * 16 + 4 * lq + r) * 128 + et * 16 + lr] = acc[et][r];
  }
}

__device__ __forceinline__ void phase_ret_scan(const Params& p, int layer) {
  const float* misc = (const float*)(p.ws + OFF_MISC);
  float* rkv = (float*)(p.ws + OFF_RKV);
  const float* rs = (const float*)(p.ws + OFF_RS);
  const int gt = opaque_bid() * blockDim.x + opaque_tid(), gs = gridDim.x * blockDim.x;
  for (int idx = gt; idx < 64 * 8192; idx += gs) {
    const int seq = idx >> 13, elem = idx & 8191;
    const int dir = seq & 1, h = (seq >> 1) & 3;
    const float cdec = __expf(misc[16 + layer * 8 + dir * 4 + h] * 128.f);
    float state = rs[(size_t)seq * 8192 + elem];
    for (int s = 0; s < 32; ++s) {
      const int n = dir == 0 ? s : 31 - s;
      float* ptr = rkv + ((size_t)seq * 32 + n) * 8192 + elem;
      const float tmp = *ptr;
      *ptr = state;
      state = fmaf(cdec, state, tmp);
    }
  }
}

constexpr int RT_KS = 72, RT_VS = 136;
constexpr int RT_OFF_K = 0, RT_OFF_VT = 128 * RT_KS * 2, RT_OFF_SF = RT_OFF_VT + 128 * RT_VS * 2, RT_OFF_SB = RT_OFF_SF + 128 * RT_KS * 2;
__device__ __forceinline__ void ret_out_item(const Params& p, int layer, int h, size_t krow0, int nkc, int iq0,
                                             const float* SF, const float* SB, int clen, char* smem) {
  const bf16_t* P = (const bf16_t*)(p.ws + OFF_P);
  bf16_t* Y = (bf16_t*)(p.ws + OFF_ACT);
  const float* misc = (const float*)(p.ws + OFF_MISC);
  const float lgF2 = misc[16 + layer * 8 + 0 * 4 + h] * 1.4426950408889634f, lgB2 = misc[16 + layer * 8 + 1 * 4 + h] * 1.4426950408889634f;
  const int tid = opaque_tid(), lane = tid & 63, wave = tid >> 6, lr = lane & 15, lq = lane >> 4;
  bf16_t* Ks = (bf16_t*)(smem + RT_OFF_K);
  bf16_t* Vt = (bf16_t*)(smem + RT_OFF_VT);
  bf16_t* SFt = (bf16_t*)(smem + RT_OFF_SF);
  bf16_t* SBt = (bf16_t*)(smem + RT_OFF_SB);
  const int iq = iq0 + wave * 16 + lr;
  const size_t mq = krow0 + iq;
  bf16x8 qf[2];
  {
    const bf16_t* qr = P + mq * INC + C_RTQ + h * 64 + lq * 8;
    qf[0] = *(const bf16x8*)(qr);
    qf[1] = *(const bf16x8*)(qr + 32);
  }
  f32x4 O[8];
#pragma unroll
  for (int i = 0; i < 8; ++i) O[i] = (f32x4){0.f, 0.f, 0.f, 0.f};
  if (SF != nullptr) {
    __syncthreads();
    {
      const int d = tid >> 3, e0 = (tid & 7) * 16;
#pragma unroll
      for (int c4 = 0; c4 < 4; ++c4) {
        const float4 a = *(const float4*)(SF + d * 128 + e0 + c4 * 4);
        const float4 bb = *(const float4*)(SB + d * 128 + e0 + c4 * 4);
        SFt[(e0 + c4 * 4 + 0) * RT_KS + d] = f2bf(a.x); SFt[(e0 + c4 * 4 + 1) * RT_KS + d] = f2bf(a.y);
        SFt[(e0 + c4 * 4 + 2) * RT_KS + d] = f2bf(a.z); SFt[(e0 + c4 * 4 + 3) * RT_KS + d] = f2bf(a.w);
        SBt[(e0 + c4 * 4 + 0) * RT_KS + d] = f2bf(bb.x); SBt[(e0 + c4 * 4 + 1) * RT_KS + d] = f2bf(bb.y);
        SBt[(e0 + c4 * 4 + 2) * RT_KS + d] = f2bf(bb.z); SBt[(e0 + c4 * 4 + 3) * RT_KS + d] = f2bf(bb.w);
      }
    }
    __syncthreads();
    const float cF = __builtin_amdgcn_exp2f(lgF2 * (float)(iq + 1)), cB = __builtin_amdgcn_exp2f(lgB2 * (float)(clen - iq));
#pragma unroll
    for (int ks = 0; ks < 2; ++ks)
#pragma unroll
      for (int et = 0; et < 8; ++et) {
        const bf16x8 sf = *(const bf16x8*)(SFt + (et * 16 + lr) * RT_KS + ks * 32 + lq * 8);
        O[et] = __builtin_amdgcn_mfma_f32_16x16x32_bf16(sf, qf[ks], O[et], 0, 0, 0);
      }
    const float ratio = cF / cB;
#pragma unroll
    for (int et = 0; et < 8; ++et) { O[et][0] *= ratio; O[et][1] *= ratio; O[et][2] *= ratio; O[et][3] *= ratio; }
#pragma unroll
    for (int ks = 0; ks < 2; ++ks)
#pragma unroll
      for (int et = 0; et < 8; ++et) {
        const bf16x8 sb = *(const bf16x8*)(SBt + (et * 16 + lr) * RT_KS + ks * 32 + lq * 8);
        O[et] = __builtin_amdgcn_mfma_f32_16x16x32_bf16(sb, qf[ks], O[et], 0, 0, 0);
      }
#pragma unroll
    for (int et = 0; et < 8; ++et) { O[et][0] *= cB; O[et][1] *= cB; O[et][2] *= cB; O[et][3] *= cB; }
  }
#pragma unroll 1
  for (int kc = 0; kc < nkc; ++kc) {
    __syncthreads();
    {
      const int key = tid >> 2, c = tid & 3;
      const bf16_t* rowp = P + (krow0 + kc * 128 + key) * INC;
      const uint4 k0 = *(const uint4*)(rowp + C_RTK + h * 64 + c * 16), k1 = *(const uint4*)(rowp + C_RTK + h * 64 + c * 16 + 8);
      *(uint4*)(Ks + key * RT_KS + c * 16) = k0;
      *(uint4*)(Ks + key * RT_KS + c * 16 + 8) = k1;
#pragma unroll
      for (int c8 = 0; c8 < 4; ++c8) {
        const uint4 uv = *(const uint4*)(rowp + C_RTV + h * 128 + c * 32 + c8 * 8);
        vt_store8(Vt, RT_VS, c * 32 + c8 * 8, key, uv);
      }
    }
    __syncthreads();
    f32x4 S[8];
#pragma unroll
    for (int kt = 0; kt < 8; ++kt) {
      const bf16x8 ka = *(const bf16x8*)(Ks + (kt * 16 + lr) * RT_KS + lq * 8);
      const bf16x8 kb = *(const bf16x8*)(Ks + (kt * 16 + lr) * RT_KS + 32 + lq * 8);
      const f32x4 a = __builtin_amdgcn_mfma_f32_16x16x32_bf16(ka, qf[0], (f32x4){0.f, 0.f, 0.f, 0.f}, 0, 0, 0);
      S[kt] = __builtin_amdgcn_mfma_f32_16x16x32_bf16(kb, qf[1], a, 0, 0, 0);
    }
#pragma unroll
    for (int kt = 0; kt < 8; ++kt) {
#pragma unroll
      for (int r = 0; r < 4; ++r) {
        const int df = iq - (kc * 128 + kt * 16 + 4 * lq + r);
        const float fdf = (float)df;
        float coef = 0.f;
        if (df >= 0) coef += __builtin_amdgcn_exp2f(lgF2 * fdf);
        if (df <= 0) coef += __builtin_amdgcn_exp2f(-lgB2 * fdf);
        S[kt][r] *= coef;
      }
    }
#pragma unroll
    for (int g = 0; g < 4; ++g) {
      union { unsigned u[4]; bf16x8 v; } pf;
      pf.u[0] = cvt_pk_bf16(S[2 * g][0], S[2 * g][1]); pf.u[1] = cvt_pk_bf16(S[2 * g][2], S[2 * g][3]);
      pf.u[2] = cvt_pk_bf16(S[2 * g + 1][0], S[2 * g + 1][1]); pf.u[3] = cvt_pk_bf16(S[2 * g + 1][2], S[2 * g + 1][3]);
#pragma unroll
      for (int et = 0; et < 8; ++et) {
        union { uint2 h2[2]; bf16x8 v; } vf;
        vf.h2[0] = *(const uint2*)(Vt + (et * 16 + lr) * RT_VS + 32 * g + 4 * lq);
        vf.h2[1] = *(const uint2*)(Vt + (et * 16 + lr) * RT_VS + 32 * g + 16 + 4 * lq);
        O[et] = __builtin_amdgcn_mfma_f32_16x16x32_bf16(vf.v, pf.v, O[et], 0, 0, 0);
      }
    }
  }
  float ss = 0.f;
#pragma unroll
  for (int et = 0; et < 8; ++et) { ss = fmaf(O[et][0], O[et][0], ss); ss = fmaf(O[et][1], O[et][1], ss); ss = fmaf(O[et][2], O[et][2], ss); ss = fmaf(O[et][3], O[et][3], ss); }
  ss += __shfl_xor(ss, 16); ss += __shfl_xor(ss, 32);
  const float rr = rsqrtf(ss * (1.f / 128.f) + EPS);
  const bf16_t* gp = P + mq * INC + C_RTG + h * 128;
  bf16_t* dst = Y + mq * 1024 + Y_RT + h * 128;
#pragma unroll
  for (int et = 0; et < 8; ++et) {
    const int e = et * 16 + 4 * lq;
    const uint2 gu = *(const uint2*)(gp + e);
    uint2 ov;
    ov.x = pack2(O[et][0] * rr * siluf(lo16(gu.x)), O[et][1] * rr * siluf(hi16(gu.x)));
    ov.y = pack2(O[et][2] * rr * siluf(lo16(gu.y)), O[et][3] * rr * siluf(hi16(gu.y)));
    *(uint2*)(dst + e) = ov;
  }
}

__device__ __forceinline__ void phase_mix1(const Params& p, int layer, char* smem, int slot = 0) {
  unsigned* ctr = (unsigned*)(p.ws + OFF_CTL) + (layer * 4 + slot);
  const bool nc = layer == 0;
  const int n_dl = 512, n_dc = nc ? 32 : 0, n_nl = 2048, n_ncx = nc ? 64 : 0, n_kv = 1024, n_cs = 32;
  const int total = n_dl + n_dc + n_nl + n_ncx + n_kv + n_cs;
  float* rkv = (float*)(p.ws + OFF_RKV);
  float* rs = (float*)(p.ws + OFF_RS);
  for (;;) {
    int it = next_item(ctr, smem);
    if (it >= total) break;
    if (it < n_dl) { diff_item(p, layer, false, it, smem); continue; } it -= n_dl;
    if (it < n_dc) { diff_item(p, layer, true, it, smem); continue; } it -= n_dc;
    if (it < n_nl) { na_latent_item(p, layer, it, smem); continue; } it -= n_nl;
    if (it < n_ncx) { na_ctx_item(p, it, smem); continue; } it -= n_ncx;
    if (it < n_kv) {
      const int bh = it >> 5, n = it & 31, b = bh >> 2, h = bh & 3;
      ret_kv_item(p, layer, h, (size_t)b * 4096 + n * 128, 128,
                  rkv + ((size_t)(bh * 2 + 0) * 32 + n) * 8192, rkv + ((size_t)(bh * 2 + 1) * 32 + n) * 8192, smem);
      continue;
    }
    it -= n_kv;
    {
      const int bh = it, b = bh >> 2, h = bh & 3;
      ret_kv_item(p, layer, h, (size_t)NLAT + b * 256, 256, rs + (size_t)(bh * 2 + 0) * 8192, rs + (size_t)(bh * 2 + 1) * 8192, smem);
    }
  }
}

__device__ __forceinline__ void phase_mix2(const Params& p, int layer, char* smem, int slot = 1) {
  unsigned* ctr = (unsigned*)(p.ws + OFF_CTL) + (layer * 4 + slot);
  const int n_l = 1024, n_c = layer == 0 ? 64 : 0;
  const float* rkv = (const float*)(p.ws + OFF_RKV);
  for (;;) {
    int it = next_item(ctr, smem);
    if (it >= n_l + n_c) break;
    if (it < n_l) {
      const int bh = it >> 5, n = it & 31, b = bh >> 2, h = bh & 3;
      ret_out_item(p, layer, h, (size_t)b * 4096 + n * 128, 1, 0,
                   rkv + ((size_t)(bh * 2 + 0) * 32 + n) * 8192, rkv + ((size_t)(bh * 2 + 1) * 32 + n) * 8192, 128, smem);
    } else {
      it -= n_l;
      const int bh = it >> 1, half = it & 1, b = bh >> 2, h = bh & 3;
      ret_out_item(p, layer, h, (size_t)NLAT + b * 256, 2, half * 128, nullptr, nullptr, 256, smem);
    }
  }
}

typedef float f32x2 __attribute__((ext_vector_type(2)));
__device__ __forceinline__ unsigned sortable_key(float f, int idx) {
  const unsigned b = __float_as_uint(f);
  const unsigned k = b ^ ((unsigned)((int)b >> 31) | 0x80000000u);
  return (k & ~127u) | (unsigned)(127 - idx);
}
__device__ __forceinline__ float key_value(unsigned k) {
  k &= ~127u;
  const unsigned b = (k & 0x80000000u) ? (k ^ 0x80000000u) : ~k;
  return __uint_as_float(b);
}
#define FP8DOT(acc, H, off, W) { const f32x2 _a = __builtin_amdgcn_cvt_pk_f32_fp8((int)(W), false), _b = __builtin_amdgcn_cvt_pk_f32_fp8((int)(W), true); \
  acc = fmaf(H[(off) + 0], _a.x, acc); acc = fmaf(H[(off) + 1], _a.y, acc); acc = fmaf(H[(off) + 2], _b.x, acc); acc = fmaf(H[(off) + 3], _b.y, acc); }
#define FP8AXPY(O, off, P, W) { const f32x2 _a = __builtin_amdgcn_cvt_pk_f32_fp8((int)(W), false), _b = __builtin_amdgcn_cvt_pk_f32_fp8((int)(W), true); \
  O[(off) + 0] = fmaf(P, _a.x, O[(off) + 0]); O[(off) + 1] = fmaf(P, _a.y, O[(off) + 1]); O[(off) + 2] = fmaf(P, _b.x, O[(off) + 2]); O[(off) + 3] = fmaf(P, _b.y, O[(off) + 3]); }

constexpr int PE_OFF_SV = 0;
constexpr int PE_SVS = 132;
constexpr int PE_OFF_TV = 8 * 16 * PE_SVS * 4;
constexpr int PE_OFF_TI = PE_OFF_TV + 16 * 16 * 16 * 4;
constexpr int PE_OFF_EX = PE_OFF_TI + 16 * 16 * 16 * 4;
constexpr int PE_OFF_GT = PE_OFF_EX + 16 * 128 * 4;
constexpr int PE_OFF_CW = PE_OFF_GT + 16 * 128 * 4;
constexpr int PE_OFF_CN = PE_OFF_CW + 8 * 64 * 4;
#define WAVE_LDS_FENCE() asm volatile("s_waitcnt lgkmcnt(0)" ::: "memory")

__device__ __forceinline__ void phase_peer(const Params& p, int layer, char* smem, int ntok, bool dowrite = true) {
  const bf16_t* Q = (const bf16_t*)(p.ws + OFF_P);
  const bf16_t* H2 = (const bf16_t*)(p.ws + OFF_ACT);
  const bf16_t* SK = (const bf16_t*)(p.ws + OFF_SUBK) + (size_t)layer * 262144;
  const char* U8 = p.ws + OFF_U + (size_t)layer * NEXP * 1024;
  const char* V8 = p.ws + OFF_V + (size_t)layer * NEXP * 1024;
  const float* USC = (const float*)(p.ws + OFF_USC) + layer * NEXP;
  const float* VSC = (const float*)(p.ws + OFF_VSC) + layer * NEXP;
  const float* mod = (const float*)(p.ws + OFF_MOD) + (size_t)layer * 9 * 6144;
  const int tid = opaque_tid(), lane = tid & 63, wave = tid >> 6;
  const int lr = lane & 15, lq = lane >> 4;
  unsigned* SV = (unsigned*)(smem + PE_OFF_SV) + wave * 16 * PE_SVS;
  float* TV = (float*)(smem + PE_OFF_TV);
  int* TI = (int*)(smem + PE_OFF_TI);
  int* EX = (int*)(smem + PE_OFF_EX);
  float* GT = (float*)(smem + PE_OFF_GT);
  unsigned* CW = (unsigned*)(smem + PE_OFF_CW) + wave * 64;
  int* CN = (int*)(smem + PE_OFF_CN) + wave * 16;
  int cand_a = -1, cand_b = 0;
  {
    int c = 0;
    for (int a = 0; a < 16; ++a)
      for (int bb = 0; bb < 16; ++bb)
        if ((a + 1) * (bb + 1) <= 16) { if (c == lane) { cand_a = a; cand_b = bb; } ++c; }
  }
  const int ngroups = ntok / 16;
  for (int grp = opaque_bid(); grp < ngroups; grp += gridDim.x) {
    const int tok0 = grp * 16;
    __syncthreads();
    const int hd = wave;
#pragma unroll 1
    for (int pp = 0; pp < 2; ++pp) {
      bf16x8 af[4];
      const bf16_t* qrow = Q + (size_t)(tok0 + lr) * 2048 + hd * 256 + pp * 128;
#pragma unroll
      for (int ks = 0; ks < 4; ++ks) af[ks] = *(const bf16x8*)(qrow + ks * 32 + lq * 8);
      const bf16_t* skb = SK + (size_t)((hd * 2 + pp) * 128) * 128;
      f32x4 acc[8];
      {
        bf16x8 bfr[8][4];
#pragma unroll
        for (int nt = 0; nt < 8; ++nt)
#pragma unroll
          for (int ks = 0; ks < 4; ++ks)
            bfr[nt][ks] = *(const bf16x8*)(skb + (size_t)(nt * 16 + lr) * 128 + ks * 32 + lq * 8);
#pragma unroll
        for (int nt = 0; nt < 8; ++nt) {
          f32x4 a = (f32x4){0.f, 0.f, 0.f, 0.f};
#pragma unroll
          for (int ks = 0; ks < 4; ++ks) a = __builtin_amdgcn_mfma_f32_16x16x32_bf16(af[ks], bfr[nt][ks], a, 0, 0, 0);
          acc[nt] = a;
        }
      }
#pragma unroll
      for (int r = 0; r < 4; ++r) {
        const int tk = 4 * lq + r;
        unsigned k[8];
#pragma unroll
        for (int nt = 0; nt < 8; ++nt) k[nt] = sortable_key(acc[nt][r], nt * 16 + lr);
        unsigned gm = k[0];
#pragma unroll
        for (int nt = 1; nt < 8; ++nt) gm = max(gm, k[nt]);
        unsigned T = gm;
        T = min(T, (unsigned)__shfl_xor((int)T, 1)); T = min(T, (unsigned)__shfl_xor((int)T, 2));
        T = min(T, (unsigned)__shfl_xor((int)T, 4)); T = min(T, (unsigned)__shfl_xor((int)T, 8));
        int pos = 0;
#pragma unroll
        for (int nt = 0; nt < 8; ++nt) {
          const bool sel = k[nt] >= T;
          const unsigned long long bal = __ballot(sel);
          const unsigned grp16 = (unsigned)(bal >> (16 * lq)) & 0xffffu;
          const int below = __popc(grp16 & ((1u << lr) - 1u));
          if (sel) SV[tk * PE_SVS + pos + below] = k[nt];
          pos += __popc(grp16);
        }
        if (lr == 0) {
          CN[tk] = pos;
          SV[tk * PE_SVS + pos + 0] = 0u; SV[tk * PE_SVS + pos + 1] = 0u; SV[tk * PE_SVS + pos + 2] = 0u; SV[tk * PE_SVS + pos + 3] = 0u;
        }
      }
      WAVE_LDS_FENCE();
#pragma unroll 1
      for (int pass = 0; pass < 4; ++pass) {
        const int tk = pass * 4 + lq;
        const int cnt = CN[tk];
        const unsigned* row = SV + tk * PE_SVS;
        const int n4 = (cnt + 3) >> 2;
#pragma unroll 1
        for (int base = 0; base < cnt; base += 16) {
          const int j = base + lr;
          const unsigned my = j < cnt ? row[j] : 0xffffffffu;
          int rank = 0;
#pragma unroll 4
          for (int i4 = 0; i4 < n4; ++i4) {
            const uint4 v = *(const uint4*)(row + i4 * 4);
            rank += (v.x > my) ? 1 : 0; rank += (v.y > my) ? 1 : 0; rank += (v.z > my) ? 1 : 0; rank += (v.w > my) ? 1 : 0;
          }
          if (j < cnt && rank < 16) {
            TV[(tk * 16 + hd * 2 + pp) * 16 + rank] = key_value(my);
            TI[(tk * 16 + hd * 2 + pp) * 16 + rank] = 127 - (int)(my & 127u);
          }
        }
      }
      WAVE_LDS_FENCE();
    }
    {
      unsigned* CWt = SV;
      float vals[16];
#pragma unroll
      for (int tk = 0; tk < 16; ++tk) {
        float val = 0.f;
        unsigned key = 0u;
        if (cand_a >= 0) {
          val = TV[(tk * 16 + hd * 2 + 0) * 16 + cand_a] + TV[(tk * 16 + hd * 2 + 1) * 16 + cand_b];
          const unsigned bb = __float_as_uint(val);
          key = ((bb ^ ((unsigned)((int)bb >> 31) | 0x80000000u)) & ~63u) | (unsigned)(63 - lane);
        }
        vals[tk] = val;
        CWt[tk * 64 + lane] = key;
      }
      WAVE_LDS_FENCE();
#pragma unroll 4
      for (int tk = 0; tk < 16; ++tk) {
        const unsigned key = CWt[tk * 64 + lane];
        int rank = 0;
#pragma unroll
        for (int i4 = 0; i4 < 13; ++i4) {
          const uint4 v = *(const uint4*)(CWt + tk * 64 + i4 * 4);
          rank += (v.x > key) ? 1 : 0; rank += (v.y > key) ? 1 : 0; rank += (v.z > key) ? 1 : 0; rank += (v.w > key) ? 1 : 0;
        }
        if (cand_a >= 0 && rank < 16) {
          GT[tk * 128 + hd * 16 + rank] = vals[tk];
          EX[tk * 128 + hd * 16 + rank] = TI[(tk * 16 + hd * 2 + 0) * 16 + cand_a] * 128 + TI[(tk * 16 + hd * 2 + 1) * 16 + cand_b];
        }
      }
      WAVE_LDS_FENCE();
#pragma unroll
      for (int pass = 0; pass < 4; ++pass) {
        const int tk = pass * 4 + lq;
        const float g = GT[tk * 128 + hd * 16 + lr];
        const float mx = GT[tk * 128 + hd * 16];
        const float ev = __expf(g - mx);
        float s = ev;
        s += __shfl_xor(s, 1); s += __shfl_xor(s, 2); s += __shfl_xor(s, 4); s += __shfl_xor(s, 8);
        GT[tk * 128 + hd * 16 + lr] = ev / s;
      }
    }
    __syncthreads();
#pragma unroll 1
    for (int tt = 0; tt < 2; ++tt) {
      const int tl = wave * 2 + tt, tok = tok0 + tl;
      float hv[16], acc[16];
      {
        const bf16_t* hr = H2 + (size_t)tok * 1024;
#pragma unroll
        for (int j = 0; j < 4; ++j) {
          const uint2 u = *(const uint2*)(hr + (lane + 64 * j) * 4);
          hv[4 * j + 0] = lo16(u.x); hv[4 * j + 1] = hi16(u.x); hv[4 * j + 2] = lo16(u.y); hv[4 * j + 3] = hi16(u.y);
        }
      }
#pragma unroll
      for (int i = 0; i < 16; ++i) acc[i] = 0.f;
      uint4 uu[4], vv[4];
      float gg[4], su[4], sv[4];
#define PE_LOAD_BATCH(E0)                                                             \
      _Pragma("unroll") for (int j = 0; j < 4; ++j) {                                 \
        const int ex = EX[tl * 128 + (E0) + j];                                       \
        gg[j] = GT[tl * 128 + (E0) + j];                                              \
        uu[j] = *(const uint4*)(U8 + (size_t)ex * 1024 + lane * 16);                  \
        vv[j] = *(const uint4*)(V8 + (size_t)ex * 1024 + lane * 16);                  \
        su[j] = USC[ex]; sv[j] = VSC[ex];                                             \
      }
      PE_LOAD_BATCH(0)
#pragma unroll 1
      for (int e0 = 0; e0 < 128; e0 += 4) {
        uint4 cu[4], cv[4];
        float cg[4], csu[4], csv[4];
#pragma unroll
        for (int j = 0; j < 4; ++j) { cu[j] = uu[j]; cv[j] = vv[j]; cg[j] = gg[j]; csu[j] = su[j]; csv[j] = sv[j]; }
        if (e0 + 4 < 128) { PE_LOAD_BATCH(e0 + 4) }
#pragma unroll
        for (int j = 0; j < 4; ++j) {
          float d = 0.f;
          FP8DOT(d, hv, 0, cu[j].x) FP8DOT(d, hv, 4, cu[j].y) FP8DOT(d, hv, 8, cu[j].z) FP8DOT(d, hv, 12, cu[j].w)
          d = wave_sum(d) * csu[j];
          const float ge = 0.5f * d * (1.f + erff(d * 0.70710678118654752f));
          const float w = cg[j] * ge * csv[j];
          FP8AXPY(acc, 0, w, cv[j].x) FP8AXPY(acc, 4, w, cv[j].y) FP8AXPY(acc, 8, w, cv[j].z) FP8AXPY(acc, 12, w, cv[j].w)
        }
      }
      const int b = tok < NLAT ? (tok >> 12) : 8;
      float* xr = tok < NLAT ? p.out + (size_t)tok * 1024 : (float*)(p.ws + OFF_CTXB) + (size_t)(tok - NLAT) * 1024;
      const float* gate = mod + (size_t)b * 6144 + 5 * 1024;
      float4 xn[4];
      float ss = 0.f;
#pragma unroll
      for (int j = 0; j < 4; ++j) {
        const int c = (lane + 64 * j) * 4;
        const float4 xv = *(const float4*)(xr + c);
        const float4 gv = *(const float4*)(gate + c);
        xn[j].x = xv.x + gv.x * acc[4 * j + 0]; xn[j].y = xv.y + gv.y * acc[4 * j + 1];
        xn[j].z = xv.z + gv.z * acc[4 * j + 2]; xn[j].w = xv.w + gv.w * acc[4 * j + 3];
        ss += xn[j].x * xn[j].x + xn[j].y * xn[j].y + xn[j].z * xn[j].z + xn[j].w * xn[j].w;
      }
      ss = wave_sum(ss);
      const float rinv = rsqrtf(ss * (1.f / 1024.f) + EPS);
      if (layer == 0) {
        const float* mod1 = (const float*)(p.ws + OFF_MOD) + (size_t)9 * 6144 + (size_t)b * 6144;
        const float* g1 = p.norm1_g + 1024;
        bf16_t* act = (bf16_t*)(p.ws + OFF_ACT) + (size_t)tok * 1024;
#pragma unroll
        for (int j = 0; j < 4; ++j) {
          const int c = (lane + 64 * j) * 4;
          if (dowrite) *(float4*)(xr + c) = xn[j]; else asm volatile("" :: "v"(xn[j].x), "v"(xn[j].y), "v"(xn[j].z), "v"(xn[j].w));
          const float4 gg4 = *(const float4*)(g1 + c);
          const float4 sh = *(const float4*)(mod1 + c);
          const float4 sc = *(const float4*)(mod1 + 1024 + c);
          uint2 o;
          o.x = pack2(xn[j].x * rinv * gg4.x * (1.f + sc.x) + sh.x, xn[j].y * rinv * gg4.y * (1.f + sc.y) + sh.y);
          o.y = pack2(xn[j].z * rinv * gg4.z * (1.f + sc.z) + sh.z, xn[j].w * rinv * gg4.w * (1.f + sc.w) + sh.w);
          if (dowrite) *(uint2*)(act + c) = o; else asm volatile("" :: "v"(o.x), "v"(o.y));
        }
      } else {
#pragma unroll
        for (int j = 0; j < 4; ++j) {
          const int c = (lane + 64 * j) * 4;
          const float4 gg4 = *(const float4*)(p.final_g + c);
          float4 o;
          o.x = xn[j].x * rinv * gg4.x; o.y = xn[j].y * rinv * gg4.y; o.z = xn[j].z * rinv * gg4.z; o.w = xn[j].w * rinv * gg4.w;
          if (dowrite) *(float4*)(xr + c) = o; else asm volatile("" :: "v"(o.x), "v"(o.y), "v"(o.z), "v"(o.w));
        }
      }
    }
  }
}

template <int layer>
__device__ __forceinline__ void layer_body(const Params& p, char* smem, cg::grid_group& grid) {
  constexpr bool nc = layer == 0;
  const float* xin = layer == 0 ? p.x : (const float*)p.out;
  if (layer == 0) {
    phase_norm(p, layer, 0, xin, NTOK);
    grid.sync();
  }
#if REP_GEMM
  gemm_phase2<EPI_INPROJ>(p, layer, smem, (const bf16_t*)(p.ws + OFF_ACT), (const bf16_t*)(p.ws + OFF_WIN) + (size_t)layer * 3072 * 1024, NTOK, 3072, nullptr);
  grid.sync();
#endif
  gemm_phase2<EPI_INPROJ>(p, layer, smem, (const bf16_t*)(p.ws + OFF_ACT), (const bf16_t*)(p.ws + OFF_WIN) + (size_t)layer * 3072 * 1024, NTOK, 3072, nullptr);
  grid.sync();
#if REP_MIX1
  phase_mix1(p, layer, smem, 2);
  grid.sync();
#endif
  phase_mix1(p, layer, smem);
  grid.sync();
  phase_ret_scan(p, layer);
  grid.sync();
#if REP_MIX2
  phase_mix2(p, layer, smem, 3);
  grid.sync();
#endif
  phase_mix2(p, layer, smem);
  grid.sync();
  gemm_phase2<EPI_OUTPROJ>(p, layer, smem, (const bf16_t*)(p.ws + OFF_ACT), (const bf16_t*)(p.ws + OFF_WOUT) + (size_t)layer * 1024 * 1024, nc ? NTOK : NLAT, 1024, xin);
  grid.sync();
  phase_norm(p, layer, 1, (const float*)p.out, nc ? NTOK : NLAT);
  grid.sync();
  gemm_phase2<EPI_PLAIN>(p, layer, smem, (const bf16_t*)(p.ws + OFF_ACT), (const bf16_t*)(p.ws + OFF_WQ) + (size_t)layer * 2048 * 1024, nc ? NTOK : NLAT, 2048, nullptr);
  grid.sync();
#if REP_PEER
  phase_peer(p, layer, smem, nc ? NTOK : NLAT, false);
  grid.sync();
#endif
  phase_peer(p, layer, smem, nc ? NTOK : NLAT);
  if (layer == 0) grid.sync();
}

__global__ void __launch_bounds__(512) fwd_megakernel(Params p) {
  cg::grid_group grid = cg::this_grid();
  extern __shared__ __attribute__((aligned(16))) char smem[];
  phase_prep(p, smem);
  grid.sync();
  layer_body<0>(p, smem, grid);
  layer_body<1>(p, smem, grid);
}

extern "C" void kernel_launch(void* const* d_in, const int* in_sizes, int n_in, void* d_out,
                              int out_size, void* d_ws, size_t ws_size, hipStream_t stream) {
  constexpr size_t kDynLds = LDS_BYTES;
  static int grid_blocks = 0;
  if (!grid_blocks) {
    int dev = 0, cus = 0, per_cu = 0;
    (void)hipGetDevice(&dev);
    (void)hipDeviceGetAttribute(&cus, hipDeviceAttributeMultiprocessorCount, dev);
    (void)hipFuncSetAttribute((const void*)fwd_megakernel, hipFuncAttributeMaxDynamicSharedMemorySize, (int)kDynLds);
    (void)hipOccupancyMaxActiveBlocksPerMultiprocessor(&per_cu, fwd_megakernel, 512, kDynLds);
    if (per_cu < 1) { fprintf(stderr, "occupancy query says %d blocks/CU\n", per_cu); per_cu = 1; }
    grid_blocks = cus;
    if (ws_size < WS_END) fprintf(stderr, "workspace too small: %zu < %zu\n", ws_size, (size_t)WS_END);
  }
  Params p{};
  p.x = (const float*)d_in[0]; p.c = (const float*)d_in[1]; p.ctx = (const float*)d_in[2]; p.c_ctx = (const float*)d_in[3];
  p.w_ada = (const float*)d_in[4]; p.b_ada = (const float*)d_in[5]; p.norm1_g = (const float*)d_in[6]; p.w_in = (const float*)d_in[7];
  p.na_rpb = (const float*)d_in[8]; p.diff_lambda = (const float*)d_in[9]; p.diff_subln_g = (const float*)d_in[10];
  p.ret_decay_logit = (const float*)d_in[11]; p.w_out = (const float*)d_in[12]; p.norm2_g = (const float*)d_in[13];
  p.peer_wq = (const float*)d_in[14]; p.peer_subkeys = (const float*)d_in[15]; p.peer_u = (const float*)d_in[16];
  p.peer_v = (const float*)d_in[17]; p.final_g = (const float*)d_in[18];
  p.out = (float*)d_out; p.ws = (char*)d_ws;
  void* args[] = {&p};
  hipError_t e = hipLaunchCooperativeKernel((void*)fwd_megakernel, dim3(grid_blocks), dim3(512), args, kDynLds, stream);
  if (e != hipSuccess) fprintf(stderr, "cooperative launch failed: %s (grid %d)\n", hipGetErrorString(e), grid_blocks);
}
```

```cpp
#include <hip/hip_runtime.h>
#include <hip/hip_cooperative_groups.h>
#include <cstdio>
#include <cstdint>
namespace cg = cooperative_groups;

typedef unsigned short bf16_t;
typedef short bf16x8 __attribute__((ext_vector_type(8)));
typedef float f32x4 __attribute__((ext_vector_type(4)));

constexpr int DM = 1024, BATCH = 8, SEQ = 4096, LCTX = 256;
constexpr int NLAT = BATCH * SEQ;
constexpr int NCTX = BATCH * LCTX;
constexpr int NTOK = NLAT + NCTX;
constexpr int INC = 3072;
constexpr int C_NAQ = 0, C_NAK = 256, C_NAV = 512, C_DFQ = 768, C_DFK = 1024, C_DFV = 1280,
              C_RTQ = 1536, C_RTK = 1792, C_RTV = 2048, C_RTG = 2560;
constexpr int Y_NA = 0, Y_DF = 256, Y_RT = 512;
constexpr int NEXP = 16384;
constexpr float EPS = 1e-6f;

constexpr size_t OFF_CTL  = 0;
constexpr size_t OFF_MISC = 4096;
constexpr size_t OFF_ROPE = 8192;
constexpr size_t OFF_MOD  = OFF_ROPE + 12288;
constexpr size_t SZ_MOD   = 2ull * 9 * 6144 * 4;
constexpr size_t OFF_WIN  = OFF_MOD + SZ_MOD;
constexpr size_t SZ_WIN   = 2ull * 3072 * 1024 * 2;
constexpr size_t OFF_WOUT = OFF_WIN + SZ_WIN;
constexpr size_t SZ_WOUT  = 2ull * 1024 * 1024 * 2;
constexpr size_t OFF_WQ   = OFF_WOUT + SZ_WOUT;
constexpr size_t SZ_WQ    = 2ull * 2048 * 1024 * 2;
constexpr size_t OFF_SUBK = OFF_WQ + SZ_WQ;
constexpr size_t SZ_SUBK  = 2ull * 262144 * 2;
constexpr size_t OFF_U    = OFF_SUBK + SZ_SUBK;
constexpr int    ROWB     = 768;
constexpr size_t SZ_UV    = 2ull * NEXP * ROWB;
constexpr size_t OFF_V    = OFF_U + SZ_UV;
constexpr size_t OFF_USC  = OFF_V + SZ_UV;
constexpr size_t OFF_VSC  = OFF_USC + 2ull * NEXP * 4;
constexpr size_t OFF_ACT  = OFF_VSC + 2ull * NEXP * 4;
constexpr size_t SZ_ACT   = (size_t)NTOK * 1024 * 2;
constexpr size_t OFF_P    = OFF_ACT + SZ_ACT;
constexpr size_t SZ_P     = (size_t)NTOK * 3072 * 2;
constexpr size_t OFF_CTXB = OFF_P + SZ_P;
constexpr size_t SZ_CTXB  = (size_t)NCTX * 1024 * 4;
constexpr size_t OFF_RKV  = OFF_CTXB + SZ_CTXB;
constexpr size_t SZ_RKV   = 64ull * 32 * 8192 * 4;
constexpr size_t OFF_RS   = OFF_RKV + SZ_RKV;
constexpr size_t SZ_RS    = 64ull * 8192 * 4;
constexpr size_t WS_END   = OFF_RS + SZ_RS;

#ifndef REP_MIX1
#define REP_MIX1 0
#endif
#ifndef REP_MIX2
#define REP_MIX2 0
#endif
#ifndef REP_PEER
#define REP_PEER 0
#endif
#ifndef REP_GEMM
#define REP_GEMM 0
#endif
constexpr int LDS_BYTES = 144 * 1024;
constexpr int LDS_BCAST = LDS_BYTES - 16;

struct Params {
  const float *x, *c, *ctx, *c_ctx, *w_ada, *b_ada, *norm1_g, *w_in, *na_rpb, *diff_lambda, *diff_subln_g,
              *ret_decay_logit, *w_out, *norm2_g, *peer_wq, *peer_subkeys, *peer_u, *peer_v, *final_g;
  float* out;
  char* ws;
};

__device__ __forceinline__ float bf2f(bf16_t v) { return __uint_as_float(((unsigned)v) << 16); }
__device__ __forceinline__ bf16_t f2bf(float f) {
  unsigned u = __float_as_uint(f);
  u += 0x7fffu + ((u >> 16) & 1u);
  return (bf16_t)(u >> 16);
}
__device__ __forceinline__ unsigned pack2(float a, float b) { return (unsigned)f2bf(a) | ((unsigned)f2bf(b) << 16); }
__device__ __forceinline__ float lo16(unsigned w) { return __uint_as_float(w << 16); }
__device__ __forceinline__ float hi16(unsigned w) { return __uint_as_float(w & 0xffff0000u); }
#define DPP_ADD(v, CTRL) ((v) + __int_as_float(__builtin_amdgcn_update_dpp(0, __float_as_int(v), (CTRL), 0xf, 0xf, true)))
__device__ __forceinline__ float row16_sum(float v) {
  v = DPP_ADD(v, 0xB1);
  v = DPP_ADD(v, 0x4E);
  v = DPP_ADD(v, 0x141);
  v = DPP_ADD(v, 0x140);
  return v;
}
__device__ __forceinline__ float wave_sum(float v) {
  v = row16_sum(v);
  const int iv = __float_as_int(v);
  const float a = __int_as_float(__builtin_amdgcn_readlane(iv, 0)), b = __int_as_float(__builtin_amdgcn_readlane(iv, 16));
  const float c = __int_as_float(__builtin_amdgcn_readlane(iv, 32)), d = __int_as_float(__builtin_amdgcn_readlane(iv, 48));
  return (a + b) + (c + d);
}
__device__ __forceinline__ float siluf(float x) { return x / (1.f + __expf(-x)); }

__device__ __forceinline__ int opaque_tid() { int t = threadIdx.x; asm volatile("" : "+v"(t)); return t; }
__device__ __forceinline__ int opaque_bid() { int t = blockIdx.x; asm volatile("" : "+s"(t)); return t; }

#define DOT8(acc, Q, off, U)                                                              \
  acc = fmaf(Q[(off) + 0], lo16((U).x), acc); acc = fmaf(Q[(off) + 1], hi16((U).x), acc); \
  acc = fmaf(Q[(off) + 2], lo16((U).y), acc); acc = fmaf(Q[(off) + 3], hi16((U).y), acc); \
  acc = fmaf(Q[(off) + 4], lo16((U).z), acc); acc = fmaf(Q[(off) + 5], hi16((U).z), acc); \
  acc = fmaf(Q[(off) + 6], lo16((U).w), acc); acc = fmaf(Q[(off) + 7], hi16((U).w), acc);
#define AXPY8(O, off, P, U)                                                                   \
  O[(off) + 0] = fmaf(P, lo16((U).x), O[(off) + 0]); O[(off) + 1] = fmaf(P, hi16((U).x), O[(off) + 1]); \
  O[(off) + 2] = fmaf(P, lo16((U).y), O[(off) + 2]); O[(off) + 3] = fmaf(P, hi16((U).y), O[(off) + 3]); \
  O[(off) + 4] = fmaf(P, lo16((U).z), O[(off) + 4]); O[(off) + 5] = fmaf(P, hi16((U).z), O[(off) + 5]); \
  O[(off) + 6] = fmaf(P, lo16((U).w), O[(off) + 6]); O[(off) + 7] = fmaf(P, hi16((U).w), O[(off) + 7]);
#define UNPACK8(Q, off, U)                                                  \
  Q[(off) + 0] = lo16((U).x); Q[(off) + 1] = hi16((U).x); Q[(off) + 2] = lo16((U).y); Q[(off) + 3] = hi16((U).y); \
  Q[(off) + 4] = lo16((U).z); Q[(off) + 5] = hi16((U).z); Q[(off) + 6] = lo16((U).w); Q[(off) + 7] = hi16((U).w);

__device__ __forceinline__ int next_item(unsigned* counter, char* smem) {
  volatile int* bc = (volatile int*)(smem + LDS_BCAST);
  __syncthreads();
  if (threadIdx.x == 0) *bc = (int)atomicAdd(counter, 1u);
  __syncthreads();
  return *bc;
}

__device__ __forceinline__ void transpose_item(const float* src, bf16_t* dst, int K, int N, int item, char* smem) {
  float* t = (float*)smem;
  const int nb = N / 64;
  const int k0 = (item / nb) * 64, n0 = (item % nb) * 64;
  const int tid = opaque_tid();
  __syncthreads();
#pragma unroll
  for (int i = 0; i < 8; ++i) {
    const int k = (tid >> 6) + 8 * i, n = tid & 63;
    t[k * 65 + n] = src[(size_t)(k0 + k) * N + n0 + n];
  }
  __syncthreads();
#pragma unroll
  for (int i = 0; i < 8; ++i) {
    const int n = (tid >> 6) + 8 * i, k = tid & 63;
    dst[(size_t)(n0 + n) * K + k0 + k] = f2bf(t[k * 65 + n]);
  }
}

__device__ __forceinline__ void convert_flat(const float* src, bf16_t* dst, size_t n4) {
  const size_t gt = (size_t)opaque_bid() * blockDim.x + opaque_tid(), gs = (size_t)gridDim.x * blockDim.x;
  for (size_t i = gt; i < n4; i += gs) {
    const float4 v = ((const float4*)src)[i];
    uint2 o; o.x = pack2(v.x, v.y); o.y = pack2(v.z, v.w);
    ((uint2*)dst)[i] = o;
  }
}

__device__ __forceinline__ void phase_prep(const Params& p, char* smem) {
  const int tid = opaque_tid();
  char* ws = p.ws;
  if (opaque_bid() == 0) {
    unsigned* ctl = (unsigned*)(ws + OFF_CTL);
    if (tid < 64) ctl[tid] = 0u;
    float* misc = (float*)(ws + OFF_MISC);
    if (tid < 2) {
      const float* lp = p.diff_lambda + tid * 128;
      float s01 = 0.f, s23 = 0.f;
      for (int i = 0; i < 32; ++i) { s01 += lp[i] * lp[32 + i]; s23 += lp[64 + i] * lp[96 + i]; }
      const float lam_init = 0.8f - 0.6f * expf(-0.3f * (float)tid);
      misc[tid] = expf(s01) - expf(s23) + lam_init;
      misc[2 + tid] = lam_init;
    }
    if (tid >= 128 && tid < 256) misc[64 + tid - 128] = 0.f;
    if (tid >= 64 && tid < 80) {
      const int i = tid - 64;
      const float xv = p.ret_decay_logit[i];
      misc[16 + i] = -log1pf(expf(-xv));
    }
    float2* ropeD = (float2*)(ws + OFF_ROPE);
    float2* ropeR = (float2*)(ws + OFF_ROPE + 4096);
    for (int i = tid; i < 64 * 8; i += 512) {
      const int v = i >> 3, f = i & 7;
      const float inv = powf(10000.0f, -(float)(2 * f) / 16.0f);
      const float ang = (float)v * inv;
      ropeD[i] = make_float2(cosf(ang), sinf(ang));
    }
    for (int i = tid; i < 64 * 16; i += 512) {
      const int v = i >> 4, f = i & 15;
      const float inv = powf(10000.0f, -(float)(2 * f) / 32.0f);
      const float ang = (float)v * inv;
      ropeR[i] = make_float2(cosf(ang), sinf(ang));
    }
  }
  {
    float* sc = (float*)smem;
    float* red = (float*)(smem + 9 * 1024 * 4);
    float* mod = (float*)(ws + OFF_MOD);
    for (int item = opaque_bid(); item < 192; item += gridDim.x) {
      const int l = item / 96, cb = item % 96;
      __syncthreads();
      for (int i = tid; i < 9 * 1024; i += 512) {
        const int r = i >> 10, k = i & 1023;
        const float cv = (r < 8) ? p.c[r * 1024 + k] : p.c_ctx[k];
        sc[i] = siluf(cv);
      }
      __syncthreads();
      const int col = tid & 63, ks = tid >> 6;
      float acc[9];
#pragma unroll
      for (int r = 0; r < 9; ++r) acc[r] = 0.f;
      const float* w = p.w_ada + (size_t)l * 1024 * 6144 + cb * 64 + col;
      for (int k = ks * 128; k < ks * 128 + 128; ++k) {
        const float wv = w[(size_t)k * 6144];
#pragma unroll
        for (int r = 0; r < 9; ++r) acc[r] = fmaf(sc[r * 1024 + k], wv, acc[r]);
      }
#pragma unroll
      for (int r = 0; r < 9; ++r) red[(ks * 9 + r) * 64 + col] = acc[r];
      __syncthreads();
      for (int i = tid; i < 576; i += 512) {
        const int r = i >> 6, cc = i & 63;
        float s = 0.f;
#pragma unroll
        for (int k8 = 0; k8 < 8; ++k8) s += red[(k8 * 9 + r) * 64 + cc];
        mod[((size_t)l * 9 + r) * 6144 + cb * 64 + cc] = s + p.b_ada[l * 6144 + cb * 64 + cc];
      }
    }
    __syncthreads();
  }
  for (int item = opaque_bid(); item < 3072; item += gridDim.x) {
    const int l = item / 1536;
    int r = item % 1536;
    if (r < 768) transpose_item(p.w_in + (size_t)l * 1024 * 3072, (bf16_t*)(ws + OFF_WIN) + (size_t)l * 3072 * 1024, 1024, 3072, r, smem);
    else if (r < 1024) transpose_item(p.w_out + (size_t)l * 1024 * 1024, (bf16_t*)(ws + OFF_WOUT) + (size_t)l * 1024 * 1024, 1024, 1024, r - 768, smem);
    else transpose_item(p.peer_wq + (size_t)l * 1024 * 2048, (bf16_t*)(ws + OFF_WQ) + (size_t)l * 2048 * 1024, 1024, 2048, r - 1024, smem);
  }
  convert_flat(p.peer_subkeys, (bf16_t*)(ws + OFF_SUBK), 2ull * 262144 / 4);
  {
    const int lane = tid & 63, l = lane & 31, half = lane >> 5;
    const int gw = opaque_bid() * 8 + (tid >> 6), nw = gridDim.x * 8;
    for (int rp = gw; rp < 2 * NEXP; rp += nw) {
      const int row = rp * 2 + half;
      const bool isv = row >= 2 * NEXP;
      const int rr = isv ? row - 2 * NEXP : row;
      const float* srow = (isv ? p.peer_v : p.peer_u) + (size_t)rr * 1024;
      float4 v[8];
      float mx = 0.f;
#pragma unroll
      for (int j = 0; j < 8; ++j) {
        v[j] = ((const float4*)srow)[l + 32 * j];
        mx = fmaxf(mx, fmaxf(fmaxf(fabsf(v[j].x), fabsf(v[j].y)), fmaxf(fabsf(v[j].z), fabsf(v[j].w))));
      }
#pragma unroll
      for (int o = 1; o < 32; o <<= 1) mx = fmaxf(mx, __shfl_xor(mx, o));
      const float scale = mx > 0.f ? mx * (1.f / 7.5f) : 1.f;
      const float inv = 1.f / scale;
      unsigned w[6] = {0u, 0u, 0u, 0u, 0u, 0u};
#pragma unroll
      for (int k = 0; k < 32; ++k) {
        const float xv = (k & 3) == 0 ? v[k >> 2].x : (k & 3) == 1 ? v[k >> 2].y : (k & 3) == 2 ? v[k >> 2].z : v[k >> 2].w;
        const float a = fminf(fabsf(xv) * inv, 7.5f);
        float c;
        if (a < 2.f) c = rintf(a * 8.f);
        else if (a < 4.f) c = 16.f + rintf((a - 2.f) * 4.f);
        else c = 24.f + rintf((a - 4.f) * 2.f);
        unsigned code = (unsigned)c;
        code = code > 31u ? 31u : code;
        code |= (xv < 0.f) ? 32u : 0u;
        const int bit = 6 * k, wd = bit >> 5, sh = bit & 31;
        w[wd] |= code << sh;
        if (sh > 26) w[wd + 1] |= code >> (32 - sh);
      }
      char* drow = ws + (isv ? OFF_V : OFF_U) + (size_t)rr * ROWB + l * 24;
      *(uint2*)(drow) = make_uint2(w[0], w[1]);
      *(uint2*)(drow + 8) = make_uint2(w[2], w[3]);
      *(uint2*)(drow + 16) = make_uint2(w[4], w[5]);
      if (l == 0) ((float*)(ws + (isv ? OFF_VSC : OFF_USC)))[rr] = scale;
    }
  }
  {
    const size_t gt = (size_t)opaque_bid() * blockDim.x + tid, gs = (size_t)gridDim.x * blockDim.x;
    float4* dst = (float4*)(ws + OFF_CTXB);
    for (size_t i = gt; i < (size_t)NCTX * 1024 / 4; i += gs) dst[i] = ((const float4*)p.ctx)[i];
  }
}

__device__ __forceinline__ void phase_norm(const Params& p, int layer, int which, const float* xlat, int nrows) {
  const int lane = opaque_tid() & 63;
  const int gw = opaque_bid() * 8 + (opaque_tid() >> 6), nw = gridDim.x * 8;
  const float* g = (which == 0 ? p.norm1_g : p.norm2_g) + layer * 1024;
  const float* mod = (const float*)(p.ws + OFF_MOD) + (size_t)layer * 9 * 6144;
  const float* ctxb = (const float*)(p.ws + OFF_CTXB);
  bf16_t* act = (bf16_t*)(p.ws + OFF_ACT);
  const int sh_off = which == 0 ? 0 : 3 * 1024, sc_off = which == 0 ? 1024 : 4 * 1024;
  for (int row = gw; row < nrows; row += nw) {
    const float* src = row < NLAT ? xlat + (size_t)row * 1024 : ctxb + (size_t)(row - NLAT) * 1024;
    const int b = row < NLAT ? (row >> 12) : 8;
    const float* mrow = mod + (size_t)b * 6144;
    float4 v[4];
    float ss = 0.f;
#pragma unroll
    for (int j = 0; j < 4; ++j) {
      v[j] = ((const float4*)src)[lane + 64 * j];
      ss += v[j].x * v[j].x + v[j].y * v[j].y + v[j].z * v[j].z + v[j].w * v[j].w;
    }
    ss = wave_sum(ss);
    const float r = rsqrtf(ss * (1.f / 1024.f) + EPS);
#pragma unroll
    for (int j = 0; j < 4; ++j) {
      const int c = (lane + 64 * j) * 4;
      const float4 gg = *(const float4*)(g + c);
      const float4 sh = *(const float4*)(mrow + sh_off + c);
      const float4 sc = *(const float4*)(mrow + sc_off + c);
      const float o0 = v[j].x * r * gg.x * (1.f + sc.x) + sh.x;
      const float o1 = v[j].y * r * gg.y * (1.f + sc.y) + sh.y;
      const float o2 = v[j].z * r * gg.z * (1.f + sc.z) + sh.z;
      const float o3 = v[j].w * r * gg.w * (1.f + sc.w) + sh.w;
      uint2 o; o.x = pack2(o0, o1); o.y = pack2(o2, o3);
      *(uint2*)(act + (size_t)row * 1024 + c) = o;
    }
  }
}

__device__ __forceinline__ void phase_final(const Params& p) {
  const int lane = opaque_tid() & 63;
  const int gw = opaque_bid() * 8 + (opaque_tid() >> 6), nw = gridDim.x * 8;
  for (int row = gw; row < NLAT; row += nw) {
    float* src = p.out + (size_t)row * 1024;
    float4 v[4];
    float ss = 0.f;
#pragma unroll
    for (int j = 0; j < 4; ++j) {
      v[j] = ((const float4*)src)[lane + 64 * j];
      ss += v[j].x * v[j].x + v[j].y * v[j].y + v[j].z * v[j].z + v[j].w * v[j].w;
    }
    ss = wave_sum(ss);
    const float r = rsqrtf(ss * (1.f / 1024.f) + EPS);
#pragma unroll
    for (int j = 0; j < 4; ++j) {
      const int c = (lane + 64 * j) * 4;
      const float4 gg = *(const float4*)(p.final_g + c);
      float4 o;
      o.x = v[j].x * r * gg.x; o.y = v[j].y * r * gg.y; o.z = v[j].z * r * gg.z; o.w = v[j].w * r * gg.w;
      ((float4*)src)[lane + 64 * j] = o;
    }
  }
}

constexpr int EPI_INPROJ = 0, EPI_OUTPROJ = 1, EPI_PLAIN = 2;
constexpr int GS = 72;
constexpr int G_ASTAGE = 256 * GS * 2;
constexpr int G_BSTAGE = 128 * GS * 2;
constexpr int G_STAGE = G_ASTAGE + G_BSTAGE;

template <int EPI>
__device__ __forceinline__ void gemm_phase(const Params& p, int layer, char* smem, const bf16_t* A, const bf16_t* Bt,
                                           int M, int N, const float* xin_lat) {
  const int tid = opaque_tid(), lane = tid & 63, wave = tid >> 6, wm = wave >> 1, wn = wave & 1;
  const int ntn = N / 128, ntiles = (M / 256) * ntn;
  const int lr = lane & 15, lq = lane >> 4;
  for (int tile = opaque_bid(); tile < ntiles; tile += gridDim.x) {
    const int m0 = (tile / ntn) * 256, n0 = (tile % ntn) * 128;
    f32x4 acc[4][4];
#pragma unroll
    for (int i = 0; i < 4; ++i)
#pragma unroll
      for (int j = 0; j < 4; ++j) acc[i][j] = (f32x4){0.f, 0.f, 0.f, 0.f};
    uint4 ra[4], rb[2];
    const int crow = tid >> 3, ckc = tid & 7;
    auto gload = [&](int k0) {
#pragma unroll
      for (int i = 0; i < 4; ++i) ra[i] = *(const uint4*)(A + (size_t)(m0 + crow + 64 * i) * 1024 + k0 + ckc * 8);
#pragma unroll
      for (int i = 0; i < 2; ++i) rb[i] = *(const uint4*)(Bt + (size_t)(n0 + crow + 64 * i) * 1024 + k0 + ckc * 8);
    };
    auto lstore = [&](int s) {
      bf16_t* sA = (bf16_t*)(smem + s * G_STAGE);
      bf16_t* sB = (bf16_t*)(smem + s * G_STAGE + G_ASTAGE);
#pragma unroll
      for (int i = 0; i < 4; ++i) *(uint4*)(sA + (crow + 64 * i) * GS + ckc * 8) = ra[i];
#pragma unroll
      for (int i = 0; i < 2; ++i) *(uint4*)(sB + (crow + 64 * i) * GS + ckc * 8) = rb[i];
    };
    __syncthreads();
    gload(0);
    lstore(0);
    __syncthreads();
    for (int kt = 0; kt < 16; ++kt) {
      const int cur = kt & 1;
      if (kt + 1 < 16) gload((kt + 1) * 64);
      const bf16_t* sA = (const bf16_t*)(smem + cur * G_STAGE);
      const bf16_t* sB = (const bf16_t*)(smem + cur * G_STAGE + G_ASTAGE);
#pragma unroll
      for (int ks = 0; ks < 2; ++ks) {
        bf16x8 af[4], bfr[4];
#pragma unroll
        for (int mi = 0; mi < 4; ++mi) af[mi] = *(const bf16x8*)(sA + (wm * 64 + mi * 16 + lr) * GS + ks * 32 + lq * 8);
#pragma unroll
        for (int ni = 0; ni < 4; ++ni) bfr[ni] = *(const bf16x8*)(sB + (wn * 64 + ni * 16 + lr) * GS + ks * 32 + lq * 8);
#pragma unroll
        for (int mi = 0; mi < 4; ++mi)
#pragma unroll
          for (int ni = 0; ni < 4; ++ni)
            acc[mi][ni] = __builtin_amdgcn_mfma_f32_16x16x32_bf16(bfr[ni], af[mi], acc[mi][ni], 0, 0, 0);
      }
      if (kt + 1 < 16) lstore(cur ^ 1);
      __syncthreads();
    }
    if constexpr (EPI == EPI_INPROJ) {
      if (n0 >= C_DFK && n0 < C_DFV) {
        float mx0 = 0.f, mx1 = 0.f;
#pragma unroll
        for (int mi = 0; mi < 4; ++mi) {
          float s0 = 0.f, s1 = 0.f;
#pragma unroll
          for (int r = 0; r < 4; ++r) {
            s0 = fmaf(acc[mi][0][r], acc[mi][0][r], s0); s0 = fmaf(acc[mi][1][r], acc[mi][1][r], s0);
            s1 = fmaf(acc[mi][2][r], acc[mi][2][r], s1); s1 = fmaf(acc[mi][3][r], acc[mi][3][r], s1);
          }
          s0 += __shfl_xor(s0, 16); s0 += __shfl_xor(s0, 32);
          s1 += __shfl_xor(s1, 16); s1 += __shfl_xor(s1, 32);
          mx0 = fmaxf(mx0, s0); mx1 = fmaxf(mx1, s1);
        }
#pragma unroll
        for (int o = 1; o < 16; o <<= 1) { mx0 = fmaxf(mx0, __shfl_xor(mx0, o)); mx1 = fmaxf(mx1, __shfl_xor(mx1, o)); }
        if (lane == 0) {
          const int bb = m0 < NLAT ? (m0 >> 12) : ((m0 - NLAT) >> 8);
          const int hh = ((n0 - C_DFK) >> 6) + wn;
          unsigned* km = (unsigned*)(p.ws + OFF_MISC) + 64 + layer * 64 + (bb * 4 + hh) * 2;
          atomicMax(km + 0, __float_as_uint(mx0));
          atomicMax(km + 1, __float_as_uint(mx1));
        }
      }
    }
#pragma unroll
    for (int mi = 0; mi < 4; ++mi) {
      const int m = m0 + wm * 64 + mi * 16 + lr;
#pragma unroll
      for (int ni = 0; ni < 4; ++ni) {
        const int n = n0 + wn * 64 + ni * 16 + lq * 4;
        float v0 = acc[mi][ni][0], v1 = acc[mi][ni][1], v2 = acc[mi][ni][2], v3 = acc[mi][ni][3];
        if constexpr (EPI == EPI_INPROJ) {
          const bool ropeD = (n >= C_DFQ && n < C_DFV), ropeR = (n >= C_RTQ && n < C_RTV);
          if ((ropeD || ropeR) && m < NLAT) {
            const int t = m & 4095, gr = t >> 6, gc = t & 63;
            float2 cs0, cs1;
            if (ropeD) {
              const float2* tab = (const float2*)(p.ws + OFF_ROPE);
              const int i0 = (n & 31) >> 1;
              if (i0 < 8) { cs0 = tab[gr * 8 + i0]; cs1 = tab[gr * 8 + i0 + 1]; }
              else { cs0 = tab[gc * 8 + i0 - 8]; cs1 = tab[gc * 8 + i0 - 7]; }
            } else {
              const float2* tab = (const float2*)(p.ws + OFF_ROPE + 4096);
              const int i0 = (n & 63) >> 1;
              if (i0 < 16) { cs0 = tab[gr * 16 + i0]; cs1 = tab[gr * 16 + i0 + 1]; }
              else { cs0 = tab[gc * 16 + i0 - 16]; cs1 = tab[gc * 16 + i0 - 15]; }
            }
            const float a0 = v0 * cs0.x - v1 * cs0.y, a1 = v0 * cs0.y + v1 * cs0.x;
            const float a2 = v2 * cs1.x - v3 * cs1.y, a3 = v2 * cs1.y + v3 * cs1.x;
            v0 = a0; v1 = a1; v2 = a2; v3 = a3;
          }
          float sc = 1.f;
          if (n < C_NAK) sc = 0.125f * 1.4426950408889634f;
          else if (n >= C_DFQ && n < C_DFK) sc = 0.17677669529663687f * 1.4426950408889634f;
          else if (n >= C_RTK && n < C_RTV) sc = 0.125f;
          uint2 o; o.x = pack2(v0 * sc, v1 * sc); o.y = pack2(v2 * sc, v3 * sc);
          *(uint2*)((bf16_t*)(p.ws + OFF_P) + (size_t)m * INC + n) = o;
        } else if constexpr (EPI == EPI_OUTPROJ) {
          const float* mod = (const float*)(p.ws + OFF_MOD) + (size_t)layer * 9 * 6144;
          const int b = m < NLAT ? (m >> 12) : 8;
          const float4 gt = *(const float4*)(mod + (size_t)b * 6144 + 2 * 1024 + n);
          const float* xi; float* xo;
          if (m < NLAT) { xi = xin_lat + (size_t)m * 1024 + n; xo = p.out + (size_t)m * 1024 + n; }
          else { xo = (float*)(p.ws + OFF_CTXB) + (size_t)(m - NLAT) * 1024 + n; xi = xo; }
          const float4 xv = *(const float4*)xi;
          float4 o; o.x = xv.x + gt.x * v0; o.y = xv.y + gt.y * v1; o.z = xv.z + gt.z * v2; o.w = xv.w + gt.w * v3;
          *(float4*)xo = o;
        } else {
          uint2 o; o.x = pack2(v0, v1); o.y = pack2(v2, v3);
          *(uint2*)((bf16_t*)(p.ws + OFF_P) + (size_t)m * 2048 + n) = o;
        }
      }
    }
  }
}

namespace g8 {
constexpr int BM = 256, BK = 64, HALF = 128, NXCD = 8, WGM = 8, HT = HALF * BK;
__device__ __forceinline__ int lds_byte(int r, int c) {
  const int st = (r >> 4) * 2 + (c >> 5), rr = r & 15, cc = c & 31, ob = rr * 64 + cc * 2;
  return st * 1024 + (ob ^ (((ob >> 9) & 1) << 5));
}
__device__ __forceinline__ void stage_rc(int b, int& R, int& C) {
  const int st = b / 1024, sb = b % 1024, swz = sb ^ (((sb >> 9) & 1) << 5);
  R = (st >> 1) * 16 + swz / 64; C = (st & 1) * 32 + (swz % 64) / 2;
}
}

template <int EPI>
__device__ __forceinline__ void epi_store4(const Params& p, int layer, int m, int n, float v0, float v1, float v2, float v3, const float* xin_lat) {
  if constexpr (EPI == EPI_INPROJ) {
    const bool ropeD = (n >= C_DFQ && n < C_DFV), ropeR = (n >= C_RTQ && n < C_RTV);
    if ((ropeD || ropeR) && m < NLAT) {
      const int t = m & 4095, gr = t >> 6, gc = t & 63;
      float2 cs0, cs1;
      if (ropeD) {
        const float2* tab = (const float2*)(p.ws + OFF_ROPE);
        const int i0 = (n & 31) >> 1;
        if (i0 < 8) { cs0 = tab[gr * 8 + i0]; cs1 = tab[gr * 8 + i0 + 1]; }
        else { cs0 = tab[gc * 8 + i0 - 8]; cs1 = tab[gc * 8 + i0 - 7]; }
      } else {
        const float2* tab = (const float2*)(p.ws + OFF_ROPE + 4096);
        const int i0 = (n & 63) >> 1;
        if (i0 < 16) { cs0 = tab[gr * 16 + i0]; cs1 = tab[gr * 16 + i0 + 1]; }
        else { cs0 = tab[gc * 16 + i0 - 16]; cs1 = tab[gc * 16 + i0 - 15]; }
      }
      const float a0 = v0 * cs0.x - v1 * cs0.y, a1 = v0 * cs0.y + v1 * cs0.x;
      const float a2 = v2 * cs1.x - v3 * cs1.y, a3 = v2 * cs1.y + v3 * cs1.x;
      v0 = a0; v1 = a1; v2 = a2; v3 = a3;
    }
    float sc = 1.f;
    if (n < C_NAK) sc = 0.125f * 1.4426950408889634f;
    else if (n >= C_DFQ && n < C_DFK) sc = 0.17677669529663687f * 1.4426950408889634f;
    else if (n >= C_RTK && n < C_RTV) sc = 0.125f;
    uint2 o; o.x = pack2(v0 * sc, v1 * sc); o.y = pack2(v2 * sc, v3 * sc);
    *(uint2*)((bf16_t*)(p.ws + OFF_P) + (size_t)m * INC + n) = o;
  } else if constexpr (EPI == EPI_OUTPROJ) {
    const float* mod = (const float*)(p.ws + OFF_MOD) + (size_t)layer * 9 * 6144;
    const int b = m < NLAT ? (m >> 12) : 8;
    const float4 gt = *(const float4*)(mod + (size_t)b * 6144 + 2 * 1024 + n);
    const float* xi; float* xo;
    if (m < NLAT) { xi = xin_lat + (size_t)m * 1024 + n; xo = p.out + (size_t)m * 1024 + n; }
    else { xo = (float*)(p.ws + OFF_CTXB) + (size_t)(m - NLAT) * 1024 + n; xi = xo; }
    const float4 xv = *(const float4*)xi;
    float4 o; o.x = xv.x + gt.x * v0; o.y = xv.y + gt.y * v1; o.z = xv.z + gt.z * v2; o.w = xv.w + gt.w * v3;
    *(float4*)xo = o;
  } else {
    uint2 o; o.x = pack2(v0, v1); o.y = pack2(v2, v3);
    *(uint2*)((bf16_t*)(p.ws + OFF_P) + (size_t)m * 2048 + n) = o;
  }
}

#define G8_LAS __attribute__((address_space(3)))
__device__ __forceinline__ bool g8_next(int i, int nM, int nN, int G, int c, int& pm, int& pn) {
  using namespace g8;
  const int nwg = nM * nN;
  const long Lx = (long)i * G + c;
  if (Lx >= nwg) return false;
  int wgid = (int)Lx;
  { const int q = nwg / NXCD, r = nwg % NXCD, xcd = wgid % NXCD, off = wgid / NXCD; wgid = (xcd < r ? xcd * (q + 1) : r * (q + 1) + (xcd - r) * q) + off; }
  const int nig = WGM * nN, gid = wgid / nig, fm = gid * WGM, gsz = (nM - fm) < WGM ? (nM - fm) : WGM;
  pm = fm + ((wgid % nig) % gsz); pn = (wgid % nig) / gsz;
  return true;
}

template <int EPI>
__device__ __forceinline__ void gemm_phase2(const Params& p, int layer, char* smem, const bf16_t* A, const bf16_t* Bt,
                                            int M, int N, const float* xin_lat) {
  using namespace g8;
  constexpr int K = 1024, nt = K / BK, HTB = HALF * BK * 2;
  G8_LAS unsigned char* lds = (G8_LAS unsigned char*)smem;
  const int tid = opaque_tid();
  const int wid = __builtin_amdgcn_readfirstlane(tid >> 6), lane = tid & 63, wr = wid >> 2, wc = wid & 3, fr = lane & 15, fq = lane >> 4;
  unsigned voff[2];
#pragma unroll
  for (int i = 0; i < 2; ++i) { int R, C; stage_rc(tid * 16 + i * 8192, R, C); voff[i] = (unsigned)(R * K + C) * 2u; }
  constexpr size_t kstep = (size_t)(BK * 2);
  constexpr size_t hstep = (size_t)HALF * K * 2;
  constexpr size_t tstep = 2 * hstep;
  const unsigned ldsw = (unsigned)wid * 1024u;
  const int aoff = lds_byte(wr * 64 + fr, fq * 8), boff = lds_byte(wc * 32 + fr, fq * 8);
#define G8_SA(b, h) (((b) * 2 + (h)) * HTB)
#define G8_SB(b, h) ((4 + (b) * 2 + (h)) * HTB)
#define G8_STAGE(bufoff, gbase) do { _Pragma("unroll") for (int _i = 0; _i < 2; ++_i)                                        \
    __builtin_amdgcn_global_load_lds((const unsigned*)((const char*)(gbase) + voff[_i]), (G8_LAS unsigned*)(lds + (bufoff) + ldsw + _i * 8192), 16, 0, 0); } while (0)
#define G8_LDA(dst, b, h) do { _Pragma("unroll") for (int m = 0; m < 4; ++m) _Pragma("unroll") for (int k = 0; k < 2; ++k) dst[m][k] = *(const G8_LAS bf16x8*)(lds + G8_SA(b, h) + aoff + m * 2048 + k * 1024); } while (0)
#define G8_LDB(dst, b, h) do { _Pragma("unroll") for (int n = 0; n < 2; ++n) _Pragma("unroll") for (int k = 0; k < 2; ++k) dst[n][k] = *(const G8_LAS bf16x8*)(lds + G8_SB(b, h) + boff + n * 2048 + k * 1024); } while (0)
#define G8_MMA(ai, bj, At_, Bt_) do { __builtin_amdgcn_s_setprio(1);                                                          \
    _Pragma("unroll") for (int m = 0; m < 4; ++m) _Pragma("unroll") for (int n = 0; n < 2; ++n) _Pragma("unroll") for (int k = 0; k < 2; ++k) \
      acc[ai][bj][m][n] = __builtin_amdgcn_mfma_f32_16x16x32_bf16(Bt_[n][k], At_[m][k], acc[ai][bj][m][n], 0, 0, 0);          \
    __builtin_amdgcn_s_setprio(0); } while (0)
#define G8_WAIT_V(n) asm volatile("s_waitcnt vmcnt(" #n ")" ::: "memory")
#define G8_WAIT_L(n) asm volatile("s_waitcnt lgkmcnt(" #n ")" ::: "memory")
#define G8_BAR __builtin_amdgcn_s_barrier()
#define G8_SCHED __builtin_amdgcn_sched_barrier(0)
  const int nM = M / BM, nN = N / BM, G = gridDim.x, cu = opaque_bid();
  int cpm, cpn, npm = 0, npn = 0, ui = 0;
  __syncthreads();
  if (g8_next(0, nM, nN, G, cu, cpm, cpn)) {
    f32x4 acc[2][2][4][2];
#pragma unroll
    for (int a = 0; a < 2; ++a)
#pragma unroll
      for (int b2 = 0; b2 < 2; ++b2)
#pragma unroll
        for (int m = 0; m < 4; ++m)
#pragma unroll
          for (int n = 0; n < 2; ++n) acc[a][b2][m][n] = (f32x4){0.f, 0.f, 0.f, 0.f};
    bf16x8 At[4][2], B0[2][2], B1[2][2];
    const char* cA = (const char*)A + (size_t)cpm * tstep;
    const char* cB = (const char*)Bt + (size_t)cpn * tstep;
    G8_STAGE(G8_SB(0, 0), cB); G8_STAGE(G8_SA(0, 0), cA); G8_STAGE(G8_SB(0, 1), cB + hstep); G8_STAGE(G8_SA(0, 1), cA + hstep);
    if (wr == 1) G8_BAR;
    G8_WAIT_V(4); G8_BAR;
    G8_STAGE(G8_SB(1, 0), cB + kstep); G8_STAGE(G8_SA(1, 0), cA + kstep); G8_STAGE(G8_SB(1, 1), cB + hstep + kstep);
    G8_WAIT_V(6); G8_BAR;
    for (;;) {
      const bool has_next = g8_next(ui + 1, nM, nN, G, cu, npm, npn);
      const char* nA = has_next ? (const char*)A + (size_t)npm * tstep : cA;
      const char* nB = has_next ? (const char*)Bt + (size_t)npn * tstep : cB;
#pragma unroll 1
      for (int t = 0; t < nt; t += 2) {
        const bool last = (t == nt - 2);
        const char* a1 = cA + (size_t)(t + 1) * kstep;
        const char* a2 = last ? nA : cA + (size_t)(t + 2) * kstep; const char* b2 = last ? nB : cB + (size_t)(t + 2) * kstep;
        const char* a3 = a2 + kstep; const char* b3 = b2 + kstep;
        G8_LDB(B0, 0, 0); G8_SCHED; G8_LDA(At, 0, 0); G8_STAGE(G8_SA(1, 1), a1 + hstep);
        G8_WAIT_L(8); G8_BAR; G8_WAIT_L(0); G8_MMA(0, 0, At, B0); G8_BAR; G8_SCHED;
        G8_LDB(B1, 0, 1); G8_STAGE(G8_SB(0, 0), b2);
        G8_BAR; G8_WAIT_L(0); G8_MMA(0, 1, At, B1); G8_BAR;
        G8_LDA(At, 0, 1); G8_STAGE(G8_SA(0, 0), a2);
        G8_BAR; G8_WAIT_L(0); G8_MMA(1, 0, At, B0); G8_BAR; G8_SCHED;
        G8_STAGE(G8_SB(0, 1), b2 + hstep);
        G8_WAIT_V(6); G8_BAR; G8_MMA(1, 1, At, B1); G8_BAR;
        G8_LDB(B0, 1, 0); G8_SCHED; G8_LDA(At, 1, 0); G8_STAGE(G8_SA(0, 1), a2 + hstep);
        G8_WAIT_L(8); G8_BAR; G8_WAIT_L(0); G8_MMA(0, 0, At, B0); G8_BAR; G8_SCHED;
        G8_LDB(B1, 1, 1); G8_STAGE(G8_SB(1, 0), b3);
        G8_BAR; G8_WAIT_L(0); G8_MMA(0, 1, At, B1); G8_BAR;
        G8_LDA(At, 1, 1); G8_STAGE(G8_SA(1, 0), a3);
        G8_BAR; G8_WAIT_L(0); G8_MMA(1, 0, At, B0); G8_BAR; G8_SCHED;
        G8_STAGE(G8_SB(1, 1), b3 + hstep);
        G8_WAIT_V(6); G8_BAR; G8_MMA(1, 1, At, B1); G8_BAR;
      }
      {
        const int brow = cpm * BM, bcol = cpn * BM;
        if constexpr (EPI == EPI_INPROJ) {
          if (bcol == C_DFK) {
#pragma unroll
            for (int bj = 0; bj < 2; ++bj) {
              float mx = 0.f;
#pragma unroll
              for (int ai = 0; ai < 2; ++ai)
#pragma unroll
                for (int m = 0; m < 4; ++m) {
                  float s = 0.f;
#pragma unroll
                  for (int n = 0; n < 2; ++n)
#pragma unroll
                    for (int j = 0; j < 4; ++j) s = fmaf(acc[ai][bj][m][n][j], acc[ai][bj][m][n][j], s);
                  s += __shfl_xor(s, 16); s += __shfl_xor(s, 32);
                  mx = fmaxf(mx, s);
                }
#pragma unroll
              for (int o = 1; o < 16; o <<= 1) mx = fmaxf(mx, __shfl_xor(mx, o));
              if (lane == 0) {
                const int bb = brow < NLAT ? (brow >> 12) : ((brow - NLAT) >> 8);
                unsigned* km = (unsigned*)(p.ws + OFF_MISC) + 64 + layer * 64 + (bb * 4 + bj * 2 + (wc >> 1)) * 2 + (wc & 1);
                atomicMax(km, __float_as_uint(mx));
              }
            }
          }
        }
#pragma unroll
        for (int ai = 0; ai < 2; ++ai)
#pragma unroll
          for (int bj = 0; bj < 2; ++bj)
#pragma unroll
            for (int m = 0; m < 4; ++m)
#pragma unroll
              for (int n = 0; n < 2; ++n)
                epi_store4<EPI>(p, layer, brow + ai * HALF + wr * 64 + m * 16 + fr, bcol + bj * HALF + wc * 32 + n * 16 + fq * 4,
                                acc[ai][bj][m][n][0], acc[ai][bj][m][n][1], acc[ai][bj][m][n][2], acc[ai][bj][m][n][3], xin_lat);
      }
      if (!has_next) break;
#pragma unroll
      for (int a = 0; a < 2; ++a)
#pragma unroll
        for (int b2 = 0; b2 < 2; ++b2)
#pragma unroll
          for (int m = 0; m < 4; ++m)
#pragma unroll
            for (int n = 0; n < 2; ++n) acc[a][b2][m][n] = (f32x4){0.f, 0.f, 0.f, 0.f};
      cpm = npm; cpn = npn; cA = nA; cB = nB; ++ui;
    }
    G8_WAIT_V(0);
    if (wr == 0) G8_BAR;
    G8_BAR;
  }
}

__device__ __forceinline__ unsigned cvt_pk_bf16(float lo, float hi) {
  unsigned r;
  asm volatile("v_cvt_pk_bf16_f32 %0, %1, %2" : "=v"(r) : "v"(lo), "v"(hi));
  return r;
}
constexpr int DKS = 72;
__device__ __forceinline__ void diff_item(const Params& p, int layer, bool ctxq, int item, char* smem) {
  const bf16_t* P = (const bf16_t*)(p.ws + OFF_P);
  bf16_t* Y = (bf16_t*)(p.ws + OFF_ACT);
  const float* misc = (const float*)(p.ws + OFF_MISC);
  const float lam = misc[layer], lam_init = misc[2 + layer];
  const int tid = opaque_tid(), lane = tid & 63, wave = tid >> 6, lr = lane & 15, lq = lane >> 4;
  int b, h, mbase, nkeys;
  if (!ctxq) { b = item >> 6; h = (item >> 4) & 3; mbase = b * 4096 + (item & 15) * 256; nkeys = 256 + 4096; }
  else { b = item >> 2; h = item & 3; mbase = NLAT + b * 256; nkeys = 256; }
  const float kmax0 = sqrtf(misc[64 + layer * 64 + (b * 4 + h) * 2 + 0]), kmax1 = sqrtf(misc[64 + layer * 64 + (b * 4 + h) * 2 + 1]);
  bf16x8 qf[2][2];
  f32x4 C0[2], C1[2];
#pragma unroll
  for (int qt = 0; qt < 2; ++qt) {
    const bf16_t* qr = P + (size_t)(mbase + wave * 32 + qt * 16 + lr) * INC + C_DFQ + h * 64 + lq * 8;
    const uint4 u0 = *(const uint4*)(qr), u1 = *(const uint4*)(qr + 32);
    float s0 = 0.f, s1 = 0.f;
    { float t[8]; UNPACK8(t, 0, u0) _Pragma("unroll") for (int i = 0; i < 8; ++i) s0 = fmaf(t[i], t[i], s0); }
    { float t[8]; UNPACK8(t, 0, u1) _Pragma("unroll") for (int i = 0; i < 8; ++i) s1 = fmaf(t[i], t[i], s1); }
    s0 += __shfl_xor(s0, 16); s0 += __shfl_xor(s0, 32);
    s1 += __shfl_xor(s1, 16); s1 += __shfl_xor(s1, 32);
    const float nm0 = -sqrtf(s0) * kmax0, nm1 = -sqrtf(s1) * kmax1;
    C0[qt] = (f32x4){nm0, nm0, nm0, nm0};
    C1[qt] = (f32x4){nm1, nm1, nm1, nm1};
    union { uint4 u; bf16x8 v; } c0, c1; c0.u = u0; c1.u = u1;
    qf[qt][0] = c0.v; qf[qt][1] = c1.v;
  }
  f32x4 O0[2][4], O1[2][4];
#pragma unroll
  for (int qt = 0; qt < 2; ++qt)
#pragma unroll
    for (int i = 0; i < 4; ++i) { O0[qt][i] = (f32x4){0.f, 0.f, 0.f, 0.f}; O1[qt][i] = (f32x4){0.f, 0.f, 0.f, 0.f}; }
  float l0[2] = {0.f, 0.f}, l1[2] = {0.f, 0.f};
  const int lkey = tid >> 3, lch = tid & 7;
  uint4 uk, uv;
  auto gload = [&](int k0) {
    const int kk = k0 + lkey;
    const size_t row = kk < 256 ? (size_t)(NLAT + b * 256 + kk) : (size_t)(b * 4096 + kk - 256);
    uk = *(const uint4*)(P + row * INC + C_DFK + h * 64 + lch * 8);
    uv = *(const uint4*)(P + row * INC + C_DFV + h * 64 + lch * 8);
  };
  auto lstore = [&](int buf) {
    bf16_t* Ks = (bf16_t*)(smem + buf * (2 * 64 * DKS * 2));
    bf16_t* Vt = Ks + 64 * DKS;
    *(uint4*)(Ks + lkey * DKS + lch * 8) = uk;
    bf16_t* vd = Vt + (lch * 8) * DKS + lkey;
    vd[0 * DKS] = (bf16_t)(uv.x & 0xffffu); vd[1 * DKS] = (bf16_t)(uv.x >> 16);
    vd[2 * DKS] = (bf16_t)(uv.y & 0xffffu); vd[3 * DKS] = (bf16_t)(uv.y >> 16);
    vd[4 * DKS] = (bf16_t)(uv.z & 0xffffu); vd[5 * DKS] = (bf16_t)(uv.z >> 16);
    vd[6 * DKS] = (bf16_t)(uv.w & 0xffffu); vd[7 * DKS] = (bf16_t)(uv.w >> 16);
  };
  __syncthreads();
  gload(0);
  lstore(0);
  __syncthreads();
  const int ntile = nkeys >> 6;
#pragma unroll 1
  for (int t = 0; t < ntile; ++t) {
    const int cur = t & 1;
    if (t + 1 < ntile) gload((t + 1) * 64);
    const bf16_t* Ks = (const bf16_t*)(smem + cur * (2 * 64 * DKS * 2));
    const bf16_t* Vt = Ks + 64 * DKS;
    f32x4 S0[2][4], S1[2][4];
#pragma unroll
    for (int kt = 0; kt < 4; ++kt) {
      const bf16x8 k0f = *(const bf16x8*)(Ks + (kt * 16 + lr) * DKS + lq * 8);
      const bf16x8 k1f = *(const bf16x8*)(Ks + (kt * 16 + lr) * DKS + 32 + lq * 8);
#pragma unroll
      for (int qt = 0; qt < 2; ++qt) {
        S0[qt][kt] = __builtin_amdgcn_mfma_f32_16x16x32_bf16(k0f, qf[qt][0], C0[qt], 0, 0, 0);
        S1[qt][kt] = __builtin_amdgcn_mfma_f32_16x16x32_bf16(k1f, qf[qt][1], C1[qt], 0, 0, 0);
      }
    }
    union PF { unsigned u[4]; bf16x8 v; };
    PF pf0[2][2], pf1[2][2];
#pragma unroll
    for (int qt = 0; qt < 2; ++qt) {
      float ps0 = 0.f, ps1 = 0.f;
#pragma unroll
      for (int kt = 0; kt < 4; ++kt) {
#pragma unroll
        for (int r = 0; r < 4; ++r) {
          S0[qt][kt][r] = __builtin_amdgcn_exp2f(S0[qt][kt][r]); ps0 += S0[qt][kt][r];
          S1[qt][kt][r] = __builtin_amdgcn_exp2f(S1[qt][kt][r]); ps1 += S1[qt][kt][r];
        }
      }
      l0[qt] += ps0; l1[qt] += ps1;
#pragma unroll
      for (int g = 0; g < 2; ++g) {
        pf0[qt][g].u[0] = cvt_pk_bf16(S0[qt][2 * g][0], S0[qt][2 * g][1]); pf0[qt][g].u[1] = cvt_pk_bf16(S0[qt][2 * g][2], S0[qt][2 * g][3]);
        pf0[qt][g].u[2] = cvt_pk_bf16(S0[qt][2 * g + 1][0], S0[qt][2 * g + 1][1]); pf0[qt][g].u[3] = cvt_pk_bf16(S0[qt][2 * g + 1][2], S0[qt][2 * g + 1][3]);
        pf1[qt][g].u[0] = cvt_pk_bf16(S1[qt][2 * g][0], S1[qt][2 * g][1]); pf1[qt][g].u[1] = cvt_pk_bf16(S1[qt][2 * g][2], S1[qt][2 * g][3]);
        pf1[qt][g].u[2] = cvt_pk_bf16(S1[qt][2 * g + 1][0], S1[qt][2 * g + 1][1]); pf1[qt][g].u[3] = cvt_pk_bf16(S1[qt][2 * g + 1][2], S1[qt][2 * g + 1][3]);
      }
    }
#pragma unroll
    for (int g = 0; g < 2; ++g) {
#pragma unroll
      for (int dt = 0; dt < 4; ++dt) {
        union { uint2 h2[2]; bf16x8 v; } vf;
        vf.h2[0] = *(const uint2*)(Vt + (dt * 16 + lr) * DKS + 32 * g + 4 * lq);
        vf.h2[1] = *(const uint2*)(Vt + (dt * 16 + lr) * DKS + 32 * g + 16 + 4 * lq);
#pragma unroll
        for (int qt = 0; qt < 2; ++qt) {
          O0[qt][dt] = __builtin_amdgcn_mfma_f32_16x16x32_bf16(vf.v, pf0[qt][g].v, O0[qt][dt], 0, 0, 0);
          O1[qt][dt] = __builtin_amdgcn_mfma_f32_16x16x32_bf16(vf.v, pf1[qt][g].v, O1[qt][dt], 0, 0, 0);
        }
      }
    }
    if (t + 1 < ntile) lstore(cur ^ 1);
    __syncthreads();
  }
  const float* sg = p.diff_subln_g + layer * 64;
#pragma unroll
  for (int qt = 0; qt < 2; ++qt) {
    float a0 = l0[qt], a1 = l1[qt];
    a0 += __shfl_xor(a0, 16); a0 += __shfl_xor(a0, 32);
    a1 += __shfl_xor(a1, 16); a1 += __shfl_xor(a1, 32);
    const float i0 = 1.f / a0, i1 = lam / a1;
    float ss = 0.f;
#pragma unroll
    for (int dt = 0; dt < 4; ++dt) {
#pragma unroll
      for (int r = 0; r < 4; ++r) { const float v = O0[qt][dt][r] * i0 - O1[qt][dt][r] * i1; O0[qt][dt][r] = v; ss = fmaf(v, v, ss); }
    }
    ss += __shfl_xor(ss, 16); ss += __shfl_xor(ss, 32);
    const float rr = rsqrtf(ss * (1.f / 64.f) + EPS) * (1.f - lam_init);
    bf16_t* dst = Y + (size_t)(mbase + wave * 32 + qt * 16 + lr) * 1024 + Y_DF + h * 64;
#pragma unroll
    for (int dt = 0; dt < 4; ++dt) {
      const int d = dt * 16 + 4 * lq;
      const float4 g4 = *(const float4*)(sg + d);
      uint2 ov;
      ov.x = pack2(O0[qt][dt][0] * rr * g4.x, O0[qt][dt][1] * rr * g4.y);
      ov.y = pack2(O0[qt][dt][2] * rr * g4.z, O0[qt][dt][3] * rr * g4.w);
      *(uint2*)(dst + d) = ov;
    }
  }
}

constexpr int NA_WS = 520;
constexpr int NA_CS = 264;
constexpr int NA_OFF_VTW = 0;
constexpr int NA_OFF_VTC = 64 * NA_WS * 2;
constexpr int NA_OFF_RPB = NA_OFF_VTC + 64 * NA_CS * 2;
constexpr int NA_OFF_MRG = NA_OFF_RPB + 2048;

#define NA_STEP(KPTR_EXPR, BIAS_EXPR, VT_PTR, VT_STRIDE, VT_KEY0_EXPR)                                           \
  {                                                                                                               \
    f32x4 S[4];                                                                                                   \
    _Pragma("unroll") for (int kt = 0; kt < 4; ++kt) {                                                            \
      const bf16_t* kp = (KPTR_EXPR);                                                                             \
      const bf16x8 ka = *(const bf16x8*)(kp + lq * 8);                                                            \
      const bf16x8 kb = *(const bf16x8*)(kp + 32 + lq * 8);                                                       \
      f32x4 a = __builtin_amdgcn_mfma_f32_16x16x32_bf16(ka, qf[0], (f32x4){0.f, 0.f, 0.f, 0.f}, 0, 0, 0);         \
      S[kt] = __builtin_amdgcn_mfma_f32_16x16x32_bf16(kb, qf[1], a, 0, 0, 0);                                      \
    }                                                                                                             \
    _Pragma("unroll") for (int kt = 0; kt < 4; ++kt) {                                                            \
      _Pragma("unroll") for (int r = 0; r < 4; ++r) { S[kt][r] += (BIAS_EXPR); }                                  \
    }                                                                                                             \
    float x = fmaxf(fmaxf(S[0][0], S[0][1]), fmaxf(S[0][2], S[0][3]));                                            \
    _Pragma("unroll") for (int kt = 1; kt < 4; ++kt) x = fmaxf(x, fmaxf(fmaxf(S[kt][0], S[kt][1]), fmaxf(S[kt][2], S[kt][3]))); \
    x = fmaxf(x, __shfl_xor(x, 16)); x = fmaxf(x, __shfl_xor(x, 32));                                             \
    const float mn = fmaxf(mrun, x);                                                                              \
    const float al = __builtin_amdgcn_exp2f(mrun - mn);                                                           \
    mrun = mn;                                                                                                    \
    float ps = 0.f;                                                                                               \
    _Pragma("unroll") for (int kt = 0; kt < 4; ++kt) {                                                            \
      _Pragma("unroll") for (int r = 0; r < 4; ++r) { S[kt][r] = __builtin_amdgcn_exp2f(S[kt][r] - mn); ps += S[kt][r]; } \
    }                                                                                                             \
    lrun = lrun * al + ps;                                                                                        \
    _Pragma("unroll") for (int dt = 0; dt < 4; ++dt) {                                                            \
      _Pragma("unroll") for (int r = 0; r < 4; ++r) O[dt][r] *= al;                                               \
    }                                                                                                             \
    _Pragma("unroll") for (int g = 0; g < 2; ++g) {                                                               \
      union { unsigned u[4]; bf16x8 v; } pf;                                                                      \
      pf.u[0] = cvt_pk_bf16(S[2 * g][0], S[2 * g][1]); pf.u[1] = cvt_pk_bf16(S[2 * g][2], S[2 * g][3]);           \
      pf.u[2] = cvt_pk_bf16(S[2 * g + 1][0], S[2 * g + 1][1]); pf.u[3] = cvt_pk_bf16(S[2 * g + 1][2], S[2 * g + 1][3]); \
      const int vk0 = (VT_KEY0_EXPR);                                                                             \
      _Pragma("unroll") for (int dt = 0; dt < 4; ++dt) {                                                          \
        union { uint2 h2[2]; bf16x8 v; } vf;                                                                      \
        vf.h2[0] = *(const uint2*)((VT_PTR) + (dt * 16 + lr) * (VT_STRIDE) + vk0 + 4 * lq);                       \
        vf.h2[1] = *(const uint2*)((VT_PTR) + (dt * 16 + lr) * (VT_STRIDE) + vk0 + 16 + 4 * lq);                  \
        O[dt] = __builtin_amdgcn_mfma_f32_16x16x32_bf16(vf.v, pf.v, O[dt], 0, 0, 0);                              \
      }                                                                                                           \
    }                                                                                                             \
  }

__device__ __forceinline__ void vt_store8(bf16_t* vt, int stride, int d0, int key, uint4 uv) {
  bf16_t* vd = vt + d0 * stride + key;
  vd[0 * stride] = (bf16_t)(uv.x & 0xffffu); vd[1 * stride] = (bf16_t)(uv.x >> 16);
  vd[2 * stride] = (bf16_t)(uv.y & 0xffffu); vd[3 * stride] = (bf16_t)(uv.y >> 16);
  vd[4 * stride] = (bf16_t)(uv.z & 0xffffu); vd[5 * stride] = (bf16_t)(uv.z >> 16);
  vd[6 * stride] = (bf16_t)(uv.w & 0xffffu); vd[7 * stride] = (bf16_t)(uv.w >> 16);
}

__device__ __forceinline__ void na_latent_item(const Params& p, int layer, int item, char* smem) {
  const bf16_t* P = (const bf16_t*)(p.ws + OFF_P);
  bf16_t* Y = (bf16_t*)(p.ws + OFF_ACT);
  const int b = item >> 8, h = (item >> 6) & 3, grow = item & 63;
  const int tid = opaque_tid(), lane = tid & 63, wave = tid >> 6, lr = lane & 15, lq = lane >> 4;
  const int jt = wave & 3, half = wave >> 2;
  bf16_t* VtW = (bf16_t*)(smem + NA_OFF_VTW);
  bf16_t* VtC = (bf16_t*)(smem + NA_OFF_VTC);
  float* RPB = (float*)(smem + NA_OFF_RPB);
  float* MRG = (float*)(smem + NA_OFF_MRG);
  const int rs = min(max(grow - 4, 0), 56);
  __syncthreads();
  {
    const int ch = tid & 7;
#pragma unroll
    for (int i = 0; i < 8; ++i) {
      const int key = (tid >> 3) + 64 * i;
      const uint4 uv = *(const uint4*)(P + (size_t)(b * 4096 + (rs + (key >> 6)) * 64 + (key & 63)) * INC + C_NAV + h * 64 + ch * 8);
      vt_store8(VtW, NA_WS, ch * 8, key, uv);
    }
#pragma unroll
    for (int i = 0; i < 4; ++i) {
      const int key = (tid >> 3) + 64 * i;
      const uint4 uv = *(const uint4*)(P + (size_t)(NLAT + b * 256 + key) * INC + C_NAV + h * 64 + ch * 8);
      vt_store8(VtC, NA_CS, ch * 8, key, uv);
    }
    if (tid < 465) RPB[tid] = p.na_rpb[(size_t)(layer * 4 + h) * 465 + tid] * 1.4426950408889634f;
  }
  const int qc = jt * 16 + lr;
  const int mq = b * 4096 + grow * 64 + qc;
  bf16x8 qf[2];
  {
    const bf16_t* qr = P + (size_t)mq * INC + C_NAQ + h * 64 + lq * 8;
    qf[0] = *(const bf16x8*)(qr);
    qf[1] = *(const bf16x8*)(qr + 32);
  }
  f32x4 O[4];
#pragma unroll
  for (int i = 0; i < 4; ++i) O[i] = (f32x4){0.f, 0.f, 0.f, 0.f};
  float mrun = -1e30f, lrun = 0.f;
  __syncthreads();
  if (half == 0) {
    const int k0 = min(max(jt * 16 - 8, 0), 32);
    const int cs = min(max(qc - 8, 0), 48);
#pragma unroll 1
    for (int s = 0; s < 4; ++s) {
      const int wr0 = 2 * s;
      NA_STEP(P + (size_t)(b * 4096 + (rs + wr0 + (kt >> 1)) * 64 + k0 + 16 * (kt & 1) + lr) * INC + C_NAK + h * 64,
              ((k0 + 16 * (kt & 1) + 4 * lq + r) >= cs && (k0 + 16 * (kt & 1) + 4 * lq + r) < cs + 16)
                  ? RPB[(rs + wr0 + (kt >> 1) - grow + 7) * 31 + (k0 + 16 * (kt & 1) + 4 * lq + r) - qc + 15] : -1e30f,
              VtW, NA_WS, (wr0 + g) * 64 + k0)
    }
  } else {
#pragma unroll 1
    for (int s = 0; s < 4; ++s) {
      NA_STEP(P + (size_t)(NLAT + b * 256 + s * 64 + kt * 16 + lr) * INC + C_NAK + h * 64, 0.f, VtC, NA_CS, s * 64 + 32 * g)
    }
  }
  lrun += __shfl_xor(lrun, 16); lrun += __shfl_xor(lrun, 32);
  float* mg = MRG + (jt * 64 + lane) * 18;
  if (half == 1) {
    mg[0] = mrun; mg[1] = lrun;
#pragma unroll
    for (int dt = 0; dt < 4; ++dt) { mg[2 + dt * 4 + 0] = O[dt][0]; mg[2 + dt * 4 + 1] = O[dt][1]; mg[2 + dt * 4 + 2] = O[dt][2]; mg[2 + dt * 4 + 3] = O[dt][3]; }
  }
  __syncthreads();
  if (half == 0) {
    const float m2 = mg[0], l2 = mg[1];
    const float M = fmaxf(mrun, m2);
    const float f1 = __builtin_amdgcn_exp2f(mrun - M), f2 = __builtin_amdgcn_exp2f(m2 - M);
    const float inv = 1.f / (lrun * f1 + l2 * f2);
    bf16_t* dst = Y + (size_t)mq * 1024 + Y_NA + h * 64;
#pragma unroll
    for (int dt = 0; dt < 4; ++dt) {
      const float o0 = (O[dt][0] * f1 + mg[2 + dt * 4 + 0] * f2) * inv, o1 = (O[dt][1] * f1 + mg[2 + dt * 4 + 1] * f2) * inv;
      const float o2 = (O[dt][2] * f1 + mg[2 + dt * 4 + 2] * f2) * inv, o3 = (O[dt][3] * f1 + mg[2 + dt * 4 + 3] * f2) * inv;
      uint2 ov; ov.x = pack2(o0, o1); ov.y = pack2(o2, o3);
      *(uint2*)(dst + dt * 16 + 4 * lq) = ov;
    }
  }
}

__device__ __forceinline__ void na_ctx_item(const Params& p, int item, char* smem) {
  const bf16_t* P = (const bf16_t*)(p.ws + OFF_P);
  bf16_t* Y = (bf16_t*)(p.ws + OFF_ACT);
  const int b = item >> 3, h = (item >> 1) & 3, qg = item & 1;
  const int tid = opaque_tid(), lane = tid & 63, wave = tid >> 6, lr = lane & 15, lq = lane >> 4;
  bf16_t* VtC = (bf16_t*)(smem + NA_OFF_VTC);
  __syncthreads();
  {
    const int ch = tid & 7;
#pragma unroll
    for (int i = 0; i < 4; ++i) {
      const int key = (tid >> 3) + 64 * i;
      const uint4 uv = *(const uint4*)(P + (size_t)(NLAT + b * 256 + key) * INC + C_NAV + h * 64 + ch * 8);
      vt_store8(VtC, NA_CS, ch * 8, key, uv);
    }
  }
  const int mq = NLAT + b * 256 + qg * 128 + wave * 16 + lr;
  bf16x8 qf[2];
  {
    const bf16_t* qr = P + (size_t)mq * INC + C_NAQ + h * 64 + lq * 8;
    qf[0] = *(const bf16x8*)(qr);
    qf[1] = *(const bf16x8*)(qr + 32);
  }
  f32x4 O[4];
#pragma unroll
  for (int i = 0; i < 4; ++i) O[i] = (f32x4){0.f, 0.f, 0.f, 0.f};
  float mrun = -1e30f, lrun = 0.f;
  __syncthreads();
#pragma unroll 1
  for (int s = 0; s < 4; ++s) {
    NA_STEP(P + (size_t)(NLAT + b * 256 + s * 64 + kt * 16 + lr) * INC + C_NAK + h * 64, 0.f, VtC, NA_CS, s * 64 + 32 * g)
  }
  lrun += __shfl_xor(lrun, 16); lrun += __shfl_xor(lrun, 32);
  const float inv = 1.f / lrun;
  bf16_t* dst = Y + (size_t)mq * 1024 + Y_NA + h * 64;
#pragma unroll
  for (int dt = 0; dt < 4; ++dt) {
    uint2 ov; ov.x = pack2(O[dt][0] * inv, O[dt][1] * inv); ov.y = pack2(O[dt][2] * inv, O[dt][3] * inv);
    *(uint2*)(dst + dt * 16 + 4 * lq) = ov;
  }
}

constexpr int KV_S = 136;
constexpr int KV_OFF_KF = 0, KV_OFF_KB = 64 * KV_S * 2, KV_OFF_VT = 2 * 64 * KV_S * 2;
__device__ __forceinline__ void ret_kv_item(const Params& p, int layer, int h, size_t row0, int cnt, float* dstF, float* dstB, char* smem) {
  const bf16_t* P = (const bf16_t*)(p.ws + OFF_P);
  const float* misc = (const float*)(p.ws + OFF_MISC);
  const float lgF2 = misc[16 + layer * 8 + 0 * 4 + h] * 1.4426950408889634f, lgB2 = misc[16 + layer * 8 + 1 * 4 + h] * 1.4426950408889634f;
  const int tid = opaque_tid(), lane = tid & 63, wave = tid >> 6, lr = lane & 15, lq = lane >> 4;
  bf16_t* KFt = (bf16_t*)(smem + KV_OFF_KF);
  bf16_t* KBt = (bf16_t*)(smem + KV_OFF_KB);
  bf16_t* Vt = (bf16_t*)(smem + KV_OFF_VT);
  const int dir = wave >> 2, dt = wave & 3;
  f32x4 acc[8];
#pragma unroll
  for (int i = 0; i < 8; ++i) acc[i] = (f32x4){0.f, 0.f, 0.f, 0.f};
#pragma unroll 1
  for (int kc = 0; kc < (cnt >> 7); ++kc) {
    __syncthreads();
    {
      const int tok = tid >> 2, c = tid & 3;
      const int j = kc * 128 + tok;
      const float wF = __builtin_amdgcn_exp2f(lgF2 * (float)(cnt - 1 - j)), wB = __builtin_amdgcn_exp2f(lgB2 * (float)j);
      const bf16_t* rowp = P + (row0 + j) * INC;
#pragma unroll
      for (int c8 = 0; c8 < 2; ++c8) {
        const uint4 u = *(const uint4*)(rowp + C_RTK + h * 64 + c * 16 + c8 * 8);
        float kv[8];
        UNPACK8(kv, 0, u)
#pragma unroll
        for (int i = 0; i < 8; ++i) {
          KFt[(c * 16 + c8 * 8 + i) * KV_S + tok] = f2bf(kv[i] * wF);
          KBt[(c * 16 + c8 * 8 + i) * KV_S + tok] = f2bf(kv[i] * wB);
        }
      }
#pragma unroll
      for (int c8 = 0; c8 < 4; ++c8) {
        const uint4 uv = *(const uint4*)(rowp + C_RTV + h * 128 + c * 32 + c8 * 8);
        vt_store8(Vt, KV_S, c * 32 + c8 * 8, tok, uv);
      }
    }
    __syncthreads();
    const bf16_t* Kt = dir == 0 ? KFt : KBt;
    bf16x8 af[4];
#pragma unroll
    for (int ks = 0; ks < 4; ++ks) af[ks] = *(const bf16x8*)(Kt + (dt * 16 + lr) * KV_S + ks * 32 + lq * 8);
#pragma unroll
    for (int et = 0; et < 8; ++et) {
#pragma unroll
      for (int ks = 0; ks < 4; ++ks) {
        const bf16x8 bfr = *(const bf16x8*)(Vt + (et * 16 + lr) * KV_S + ks * 32 + lq * 8);
        acc[et] = __builtin_amdgcn_mfma_f32_16x16x32_bf16(af[ks], bfr, acc[et], 0, 0, 0);
      }
    }
  }
  float* dst = dir == 0 ? dstF : dstB;
#pragma unroll
  for (int et = 0; et < 8; ++et) {
#pragma unroll
    for (int r = 0; r < 4; ++r) dst[(dt * 16 + 4 * lq + r) * 128 + et * 16 + lr] = acc[et][r];
  }
}

__device__ __forceinline__ void phase_ret_scan(const Params& p, int layer) {
  const float* misc = (const float*)(p.ws + OFF_MISC);
  float* rkv = (float*)(p.ws + OFF_RKV);
  const float* rs = (const float*)(p.ws + OFF_RS);
  const int gt = opaque_bid() * blockDim.x + opaque_tid(), gs = gridDim.x * blockDim.x;
  for (int idx = gt; idx < 64 * 8192; idx += gs) {
    const int seq = idx >> 13, elem = idx & 8191;
    const int dir = seq & 1, h = (seq >> 1) & 3;
    const float cdec = __expf(misc[16 + layer * 8 + dir * 4 + h] * 128.f);
    float state = rs[(size_t)seq * 8192 + elem];
    for (int s = 0; s < 32; ++s) {
      const int n = dir == 0 ? s : 31 - s;
      float* ptr = rkv + ((size_t)seq * 32 + n) * 8192 + elem;
      const float tmp = *ptr;
      *ptr = state;
      state = fmaf(cdec, state, tmp);
    }
  }
}

constexpr int RT_KS = 72, RT_VS = 136;
constexpr int RT_OFF_K = 0, RT_OFF_VT = 128 * RT_KS * 2, RT_OFF_SF = RT_OFF_VT + 128 * RT_VS * 2, RT_OFF_SB = RT_OFF_SF + 128 * RT_KS * 2;
__device__ __forceinline__ void ret_out_item(const Params& p, int layer, int h, size_t krow0, int nkc, int iq0,
                                             const float* SF, const float* SB, int clen, char* smem) {
  const bf16_t* P = (const bf16_t*)(p.ws + OFF_P);
  bf16_t* Y = (bf16_t*)(p.ws + OFF_ACT);
  const float* misc = (const float*)(p.ws + OFF_MISC);
  const float lgF2 = misc[16 + layer * 8 + 0 * 4 + h] * 1.4426950408889634f, lgB2 = misc[16 + layer * 8 + 1 * 4 + h] * 1.4426950408889634f;
  const int tid = opaque_tid(), lane = tid & 63, wave = tid >> 6, lr = lane & 15, lq = lane >> 4;
  bf16_t* Ks = (bf16_t*)(smem + RT_OFF_K);
  bf16_t* Vt = (bf16_t*)(smem + RT_OFF_VT);
  bf16_t* SFt = (bf16_t*)(smem + RT_OFF_SF);
  bf16_t* SBt = (bf16_t*)(smem + RT_OFF_SB);
  const int iq = iq0 + wave * 16 + lr;
  const size_t mq = krow0 + iq;
  bf16x8 qf[2];
  {
    const bf16_t* qr = P + mq * INC + C_RTQ + h * 64 + lq * 8;
    qf[0] = *(const bf16x8*)(qr);
    qf[1] = *(const bf16x8*)(qr + 32);
  }
  f32x4 O[8];
#pragma unroll
  for (int i = 0; i < 8; ++i) O[i] = (f32x4){0.f, 0.f, 0.f, 0.f};
  if (SF != nullptr) {
    __syncthreads();
    {
      const int d = tid >> 3, e0 = (tid & 7) * 16;
#pragma unroll
      for (int c4 = 0; c4 < 4; ++c4) {
        const float4 a = *(const float4*)(SF + d * 128 + e0 + c4 * 4);
        const float4 bb = *(const float4*)(SB + d * 128 + e0 + c4 * 4);
        SFt[(e0 + c4 * 4 + 0) * RT_KS + d] = f2bf(a.x); SFt[(e0 + c4 * 4 + 1) * RT_KS + d] = f2bf(a.y);
        SFt[(e0 + c4 * 4 + 2) * RT_KS + d] = f2bf(a.z); SFt[(e0 + c4 * 4 + 3) * RT_KS + d] = f2bf(a.w);
        SBt[(e0 + c4 * 4 + 0) * RT_KS + d] = f2bf(bb.x); SBt[(e0 + c4 * 4 + 1) * RT_KS + d] = f2bf(bb.y);
        SBt[(e0 + c4 * 4 + 2) * RT_KS + d] = f2bf(bb.z); SBt[(e0 + c4 * 4 + 3) * RT_KS + d] = f2bf(bb.w);
      }
    }
    __syncthreads();
    const float cF = __builtin_amdgcn_exp2f(lgF2 * (float)(iq + 1)), cB = __builtin_amdgcn_exp2f(lgB2 * (float)(clen - iq));
#pragma unroll
    for (int ks = 0; ks < 2; ++ks)
#pragma unroll
      for (int et = 0; et < 8; ++et) {
        const bf16x8 sf = *(const bf16x8*)(SFt + (et * 16 + lr) * RT_KS + ks * 32 + lq * 8);
        O[et] = __builtin_amdgcn_mfma_f32_16x16x32_bf16(sf, qf[ks], O[et], 0, 0, 0);
      }
    const float ratio = cF / cB;
#pragma unroll
    for (int et = 0; et < 8; ++et) { O[et][0] *= ratio; O[et][1] *= ratio; O[et][2] *= ratio; O[et][3] *= ratio; }
#pragma unroll
    for (int ks = 0; ks < 2; ++ks)
#pragma unroll
      for (int et = 0; et < 8; ++et) {
        const bf16x8 sb = *(const bf16x8*)(SBt + (et * 16 + lr) * RT_KS + ks * 32 + lq * 8);
        O[et] = __builtin_amdgcn_mfma_f32_16x16x32_bf16(sb, qf[ks], O[et], 0, 0, 0);
      }
#pragma unroll
    for (int et = 0; et < 8; ++et) { O[et][0] *= cB; O[et][1] *= cB; O[et][2] *= cB; O[et][3] *= cB; }
  }
#pragma unroll 1
  for (int kc = 0; kc < nkc; ++kc) {
    __syncthreads();
    {
      const int key = tid >> 2, c = tid & 3;
      const bf16_t* rowp = P + (krow0 + kc * 128 + key) * INC;
      const uint4 k0 = *(const uint4*)(rowp + C_RTK + h * 64 + c * 16), k1 = *(const uint4*)(rowp + C_RTK + h * 64 + c * 16 + 8);
      *(uint4*)(Ks + key * RT_KS + c * 16) = k0;
      *(uint4*)(Ks + key * RT_KS + c * 16 + 8) = k1;
#pragma unroll
      for (int c8 = 0; c8 < 4; ++c8) {
        const uint4 uv = *(const uint4*)(rowp + C_RTV + h * 128 + c * 32 + c8 * 8);
        vt_store8(Vt, RT_VS, c * 32 + c8 * 8, key, uv);
      }
    }
    __syncthreads();
    f32x4 S[8];
#pragma unroll
    for (int kt = 0; kt < 8; ++kt) {
      const bf16x8 ka = *(const bf16x8*)(Ks + (kt * 16 + lr) * RT_KS + lq * 8);
      const bf16x8 kb = *(const bf16x8*)(Ks + (kt * 16 + lr) * RT_KS + 32 + lq * 8);
      const f32x4 a = __builtin_amdgcn_mfma_f32_16x16x32_bf16(ka, qf[0], (f32x4){0.f, 0.f, 0.f, 0.f}, 0, 0, 0);
      S[kt] = __builtin_amdgcn_mfma_f32_16x16x32_bf16(kb, qf[1], a, 0, 0, 0);
    }
#pragma unroll
    for (int kt = 0; kt < 8; ++kt) {
#pragma unroll
      for (int r = 0; r < 4; ++r) {
        const int df = iq - (kc * 128 + kt * 16 + 4 * lq + r);
        const float fdf = (float)df;
        float coef = 0.f;
        if (df >= 0) coef += __builtin_amdgcn_exp2f(lgF2 * fdf);
        if (df <= 0) coef += __builtin_amdgcn_exp2f(-lgB2 * fdf);
        S[kt][r] *= coef;
      }
    }
#pragma unroll
    for (int g = 0; g < 4; ++g) {
      union { unsigned u[4]; bf16x8 v; } pf;
      pf.u[0] = cvt_pk_bf16(S[2 * g][0], S[2 * g][1]); pf.u[1] = cvt_pk_bf16(S[2 * g][2], S[2 * g][3]);
      pf.u[2] = cvt_pk_bf16(S[2 * g + 1][0], S[2 * g + 1][1]); pf.u[3] = cvt_pk_bf16(S[2 * g + 1][2], S[2 * g + 1][3]);
#pragma unroll
      for (int et = 0; et < 8; ++et) {
        union { uint2 h2[2]; bf16x8 v; } vf;
        vf.h2[0] = *(const uint2*)(Vt + (et * 16 + lr) * RT_VS + 32 * g + 4 * lq);
        vf.h2[1] = *(const uint2*)(Vt + (et * 16 + lr) * RT_VS + 32 * g + 16 + 4 * lq);
        O[et] = __builtin_amdgcn_mfma_f32_16x16x32_bf16(vf.v, pf.v, O[et], 0, 0, 0);
      }
    }
  }
  float ss = 0.f;
#pragma unroll
  for (int et = 0; et < 8; ++et) { ss = fmaf(O[et][0], O[et][0], ss); ss = fmaf(O[et][1], O[et][1], ss); ss = fmaf(O[et][2], O[et][2], ss); ss = fmaf(O[et][3], O[et][3], ss); }
  ss += __shfl_xor(ss, 16); ss += __shfl_xor(ss, 32);
  const float rr = rsqrtf(ss * (1.f / 128.f) + EPS);
  const bf16_t* gp = P + mq * INC + C_RTG + h * 128;
  bf16_t* dst = Y + mq * 1024 + Y_RT + h * 128;
#pragma unroll
  for (int et = 0; et < 8; ++et) {
    const int e = et * 16 + 4 * lq;
    const uint2 gu = *(const uint2*)(gp + e);
    uint2 ov;
    ov.x = pack2(O[et][0] * rr * siluf(lo16(gu.x)), O[et][1] * rr * siluf(hi16(gu.x)));
    ov.y = pack2(O[et][2] * rr * siluf(lo16(gu.y)), O[et][3] * rr * siluf(hi16(gu.y)));
    *(uint2*)(dst + e) = ov;
  }
}

__device__ __forceinline__ void phase_mix1(const Params& p, int layer, char* smem, int slot = 0) {
  unsigned* ctr = (unsigned*)(p.ws + OFF_CTL) + (layer * 4 + slot);
  const bool nc = layer == 0;
  const int n_dl = 512, n_dc = nc ? 32 : 0, n_nl = 2048, n_ncx = nc ? 64 : 0, n_kv = 1024, n_cs = 32;
  const int total = n_dl + n_dc + n_nl + n_ncx + n_kv + n_cs;
  float* rkv = (float*)(p.ws + OFF_RKV);
  float* rs = (float*)(p.ws + OFF_RS);
  for (;;) {
    int it = next_item(ctr, smem);
    if (it >= total) break;
    if (it < n_dl) { diff_item(p, layer, false, it, smem); continue; } it -= n_dl;
    if (it < n_dc) { diff_item(p, layer, true, it, smem); continue; } it -= n_dc;
    if (it < n_nl) { na_latent_item(p, layer, it, smem); continue; } it -= n_nl;
    if (it < n_ncx) { na_ctx_item(p, it, smem); continue; } it -= n_ncx;
    if (it < n_kv) {
      const int bh = it >> 5, n = it & 31, b = bh >> 2, h = bh & 3;
      ret_kv_item(p, layer, h, (size_t)b * 4096 + n * 128, 128,
                  rkv + ((size_t)(bh * 2 + 0) * 32 + n) * 8192, rkv + ((size_t)(bh * 2 + 1) * 32 + n) * 8192, smem);
      continue;
    }
    it -= n_kv;
    {
      const int bh = it, b = bh >> 2, h = bh & 3;
      ret_kv_item(p, layer, h, (size_t)NLAT + b * 256, 256, rs + (size_t)(bh * 2 + 0) * 8192, rs + (size_t)(bh * 2 + 1) * 8192, smem);
    }
  }
}

__device__ __forceinline__ void phase_mix2(const Params& p, int layer, char* smem, int slot = 1) {
  unsigned* ctr = (unsigned*)(p.ws + OFF_CTL) + (layer * 4 + slot);
  const int n_l = 1024, n_c = layer == 0 ? 64 : 0;
  const float* rkv = (const float*)(p.ws + OFF_RKV);
  for (;;) {
    int it = next_item(ctr, smem);
    if (it >= n_l + n_c) break;
    if (it < n_l) {
      const int bh = it >> 5, n = it & 31, b = bh >> 2, h = bh & 3;
      ret_out_item(p, layer, h, (size_t)b * 4096 + n * 128, 1, 0,
                   rkv + ((size_t)(bh * 2 + 0) * 32 + n) * 8192, rkv + ((size_t)(bh * 2 + 1) * 32 + n) * 8192, 128, smem);
    } else {
      it -= n_l;
      const int bh = it >> 1, half = it & 1, b = bh >> 2, h = bh & 3;
      ret_out_item(p, layer, h, (size_t)NLAT + b * 256, 2, half * 128, nullptr, nullptr, 256, smem);
    }
  }
}

typedef float f32x2 __attribute__((ext_vector_type(2)));
__device__ __forceinline__ unsigned sortable_key(float f, int idx) {
  const unsigned b = __float_as_uint(f);
  const unsigned k = b ^ ((unsigned)((int)b >> 31) | 0x80000000u);
  return (k & ~127u) | (unsigned)(127 - idx);
}
__device__ __forceinline__ float key_value(unsigned k) {
  k &= ~127u;
  const unsigned b = (k & 0x80000000u) ? (k ^ 0x80000000u) : ~k;
  return __uint_as_float(b);
}
#define FP8DOT(acc, H, off, W) { const f32x2 _a = __builtin_amdgcn_cvt_pk_f32_fp8((int)(W), false), _b = __builtin_amdgcn_cvt_pk_f32_fp8((int)(W), true); \
  acc = fmaf(H[(off) + 0], _a.x, acc); acc = fmaf(H[(off) + 1], _a.y, acc); acc = fmaf(H[(off) + 2], _b.x, acc); acc = fmaf(H[(off) + 3], _b.y, acc); }
#define FP8AXPY(O, off, P, W) { const f32x2 _a = __builtin_amdgcn_cvt_pk_f32_fp8((int)(W), false), _b = __builtin_amdgcn_cvt_pk_f32_fp8((int)(W), true); \
  O[(off) + 0] = fmaf(P, _a.x, O[(off) + 0]); O[(off) + 1] = fmaf(P, _a.y, O[(off) + 1]); O[(off) + 2] = fmaf(P, _b.x, O[(off) + 2]); O[(off) + 3] = fmaf(P, _b.y, O[(off) + 3]); }

__device__ __forceinline__ float gelu_erf(float a) {
  const float x = fabsf(a) * 0.70710678118654752f;
  const float t = __builtin_amdgcn_rcpf(fmaf(0.3275911f, x, 1.f));
  float pl = fmaf(1.061405429f, t, -1.453152027f);
  pl = fmaf(pl, t, 1.421413741f); pl = fmaf(pl, t, -0.284496736f); pl = fmaf(pl, t, 0.254829592f);
  const float y = 1.f - pl * t * __builtin_amdgcn_exp2f(-x * x * 1.4426950408889634f);
  const float er = a < 0.f ? -y : y;
  return 0.5f * a * (1.f + er);
}
constexpr int PE_SVS = 132;
constexpr int PE_OFF_SV = 0;
constexpr int PE_OFF_TV = 4 * 16 * PE_SVS * 4;
constexpr int PE_OFF_TI = PE_OFF_TV + 16 * 16 * 16 * 4;
constexpr int PE_OFF_EX = PE_OFF_TI + 16 * 16 * 16 * 4;
constexpr int PE_OFF_GT = PE_OFF_EX + 2 * 16 * 128 * 4;
constexpr int PE_OFF_SU = PE_OFF_GT + 2 * 16 * 128 * 4;
constexpr int PE_OFF_CN = PE_OFF_SU + 2 * 16 * 128 * 4;
#define WAVE_LDS_FENCE() asm volatile("s_waitcnt lgkmcnt(0)" ::: "memory")

__device__ __forceinline__ void peer_select_head(const Params& p, int layer, char* smem, int tok0, int hd, int sw, int buf,
                                                 int lane, int cand_a, int cand_b) {
  const bf16_t* Q = (const bf16_t*)(p.ws + OFF_P);
  const bf16_t* SK = (const bf16_t*)(p.ws + OFF_SUBK) + (size_t)layer * 262144;
  const int lr = lane & 15, lq = lane >> 4;
  unsigned* SV = (unsigned*)(smem + PE_OFF_SV) + sw * 16 * PE_SVS;
  float* TV = (float*)(smem + PE_OFF_TV);
  int* TI = (int*)(smem + PE_OFF_TI);
  int* EX = (int*)(smem + PE_OFF_EX) + buf * 16 * 128;
  float* GT = (float*)(smem + PE_OFF_GT) + buf * 16 * 128;
  int* CN = (int*)(smem + PE_OFF_CN) + sw * 16;
  float* SU = (float*)(smem + PE_OFF_SU) + buf * 16 * 128;
  const float* USC = (const float*)(p.ws + OFF_USC) + layer * NEXP;
  const float* VSC = (const float*)(p.ws + OFF_VSC) + layer * NEXP;
#pragma unroll 1
  for (int pp = 0; pp < 2; ++pp) {
    bf16x8 af[4];
    const bf16_t* qrow = Q + (size_t)(tok0 + lr) * 2048 + hd * 256 + pp * 128;
#pragma unroll
    for (int ks = 0; ks < 4; ++ks) af[ks] = *(const bf16x8*)(qrow + ks * 32 + lq * 8);
    const bf16_t* skb = SK + (size_t)((hd * 2 + pp) * 128) * 128;
    f32x4 acc[8];
    {
      bf16x8 bfr[8][4];
#pragma unroll
      for (int nt = 0; nt < 8; ++nt)
#pragma unroll
        for (int ks = 0; ks < 4; ++ks)
          bfr[nt][ks] = *(const bf16x8*)(skb + (size_t)(nt * 16 + lr) * 128 + ks * 32 + lq * 8);
#pragma unroll
      for (int nt = 0; nt < 8; ++nt) {
        f32x4 a = (f32x4){0.f, 0.f, 0.f, 0.f};
#pragma unroll
        for (int ks = 0; ks < 4; ++ks) a = __builtin_amdgcn_mfma_f32_16x16x32_bf16(af[ks], bfr[nt][ks], a, 0, 0, 0);
        acc[nt] = a;
      }
    }
#pragma unroll
    for (int r = 0; r < 4; ++r) {
      const int tk = 4 * lq + r;
      unsigned k[8];
#pragma unroll
      for (int nt = 0; nt < 8; ++nt) k[nt] = sortable_key(acc[nt][r], nt * 16 + lr);
      unsigned gm = k[0];
#pragma unroll
      for (int nt = 1; nt < 8; ++nt) gm = max(gm, k[nt]);
      unsigned T = gm;
      T = min(T, (unsigned)__shfl_xor((int)T, 1)); T = min(T, (unsigned)__shfl_xor((int)T, 2));
      T = min(T, (unsigned)__shfl_xor((int)T, 4)); T = min(T, (unsigned)__shfl_xor((int)T, 8));
      int pos = 0;
#pragma unroll
      for (int nt = 0; nt < 8; ++nt) {
        const bool sel = k[nt] >= T;
        const unsigned long long bal = __ballot(sel);
        const unsigned grp16 = (unsigned)(bal >> (16 * lq)) & 0xffffu;
        const int below = __popc(grp16 & ((1u << lr) - 1u));
        if (sel) SV[tk * PE_SVS + pos + below] = k[nt];
        pos += __popc(grp16);
      }
      if (lr == 0) {
        CN[tk] = pos;
        SV[tk * PE_SVS + pos + 0] = 0u; SV[tk * PE_SVS + pos + 1] = 0u; SV[tk * PE_SVS + pos + 2] = 0u; SV[tk * PE_SVS + pos + 3] = 0u;
      }
    }
    WAVE_LDS_FENCE();
#pragma unroll 1
    for (int pass = 0; pass < 4; ++pass) {
      const int tk = pass * 4 + lq;
      const int cnt = CN[tk];
      const unsigned* row = SV + tk * PE_SVS;
      const int n4 = (cnt + 3) >> 2;
#pragma unroll 1
      for (int base = 0; base < cnt; base += 16) {
        const int j = base + lr;
        const unsigned my = j < cnt ? row[j] : 0xffffffffu;
        int rank = 0;
#pragma unroll 4
        for (int i4 = 0; i4 < n4; ++i4) {
          const uint4 v = *(const uint4*)(row + i4 * 4);
          rank += (v.x > my) ? 1 : 0; rank += (v.y > my) ? 1 : 0; rank += (v.z > my) ? 1 : 0; rank += (v.w > my) ? 1 : 0;
        }
        if (j < cnt && rank < 16) {
          TV[(tk * 16 + hd * 2 + pp) * 16 + rank] = key_value(my);
          TI[(tk * 16 + hd * 2 + pp) * 16 + rank] = 127 - (int)(my & 127u);
        }
      }
    }
    WAVE_LDS_FENCE();
  }
  {
    unsigned* CWt = SV;
    float vals[16];
#pragma unroll
    for (int tk = 0; tk < 16; ++tk) {
      float val = 0.f;
      unsigned key = 0u;
      if (cand_a >= 0) {
        val = TV[(tk * 16 + hd * 2 + 0) * 16 + cand_a] + TV[(tk * 16 + hd * 2 + 1) * 16 + cand_b];
        const unsigned bb = __float_as_uint(val);
        key = ((bb ^ ((unsigned)((int)bb >> 31) | 0x80000000u)) & ~63u) | (unsigned)(63 - lane);
      }
      vals[tk] = val;
      CWt[tk * 64 + lane] = key;
    }
    WAVE_LDS_FENCE();
#pragma unroll
    for (int tk = 0; tk < 16; ++tk) {
      const unsigned key = CWt[tk * 64 + lane];
      int rank = 0;
#pragma unroll
      for (int i4 = 0; i4 < 13; ++i4) {
        const uint4 v = *(const uint4*)(CWt + tk * 64 + i4 * 4);
        rank += (v.x > key) ? 1 : 0; rank += (v.y > key) ? 1 : 0; rank += (v.z > key) ? 1 : 0; rank += (v.w > key) ? 1 : 0;
      }
      if (cand_a >= 0 && rank < 16) {
        GT[tk * 128 + hd * 16 + rank] = vals[tk];
        EX[tk * 128 + hd * 16 + rank] = TI[(tk * 16 + hd * 2 + 0) * 16 + cand_a] * 128 + TI[(tk * 16 + hd * 2 + 1) * 16 + cand_b];
      }
    }
    WAVE_LDS_FENCE();
#pragma unroll
    for (int pass = 0; pass < 4; ++pass) {
      const int tk = pass * 4 + lq;
      const float g = GT[tk * 128 + hd * 16 + lr];
      const float mx = GT[tk * 128 + hd * 16];
      const float ev = __expf(g - mx);
      float s = ev;
      s += __shfl_xor(s, 1); s += __shfl_xor(s, 2); s += __shfl_xor(s, 4); s += __shfl_xor(s, 8);
      const int ex = EX[tk * 128 + hd * 16 + lr];
      GT[tk * 128 + hd * 16 + lr] = (ev / s) * VSC[ex];
      SU[tk * 128 + hd * 16 + lr] = USC[ex];
    }
    WAVE_LDS_FENCE();
  }
}

typedef float f32x32 __attribute__((ext_vector_type(32)));
typedef unsigned u32x6 __attribute__((ext_vector_type(6)));
struct Fp6Row { uint4 a; uint2 b; };
__device__ __forceinline__ f32x32 fp6_decode(const Fp6Row& r) {
  u32x6 w; w[0] = r.a.x; w[1] = r.a.y; w[2] = r.a.z; w[3] = r.a.w; w[4] = r.b.x; w[5] = r.b.y;
  return __builtin_amdgcn_cvt_scalef32_pk32_f32_fp6(w, 1.0f);
}
__device__ __forceinline__ void peer_gather_token(const Params& p, int layer, char* smem, int tok, int tl, int buf, int lane, bool dowrite) {
  const bf16_t* H2 = (const bf16_t*)(p.ws + OFF_ACT);
  const char* U6 = p.ws + OFF_U + (size_t)layer * NEXP * ROWB;
  const char* V6 = p.ws + OFF_V + (size_t)layer * NEXP * ROWB;
  const float* mod = (const float*)(p.ws + OFF_MOD) + (size_t)layer * 9 * 6144;
  const int* EX = (const int*)(smem + PE_OFF_EX) + buf * 16 * 128 + tl * 128;
  const float* GT = (const float*)(smem + PE_OFF_GT) + buf * 16 * 128 + tl * 128;
  const float* SU = (const float*)(smem + PE_OFF_SU) + buf * 16 * 128 + tl * 128;
  const int l = lane & 31, hf = lane >> 5;
  float hv[32], acc[32];
  {
    const bf16_t* hr = H2 + (size_t)tok * 1024;
#pragma unroll
    for (int j = 0; j < 8; ++j) {
      const uint2 u = *(const uint2*)(hr + (l + 32 * j) * 4);
      hv[4 * j + 0] = lo16(u.x); hv[4 * j + 1] = hi16(u.x); hv[4 * j + 2] = lo16(u.y); hv[4 * j + 3] = hi16(u.y);
    }
  }
#pragma unroll
  for (int i = 0; i < 32; ++i) acc[i] = 0.f;
  Fp6Row ua[2], va[2], ub[2], vb[2], uc[2], vc[2], ud[2], vd[2];
#define PE_LOAD_SET(UU, VV, E0)                                                       \
  _Pragma("unroll") for (int j = 0; j < 2; ++j) {                                     \
    const int ex = EX[(E0) + 2 * j + hf];                                             \
    const char* up = U6 + (size_t)ex * ROWB + l * 24;                                 \
    const char* vp = V6 + (size_t)ex * ROWB + l * 24;                                 \
    UU[j].a = *(const uint4*)up; UU[j].b = *(const uint2*)(up + 16);                  \
    VV[j].a = *(const uint4*)vp; VV[j].b = *(const uint2*)(vp + 16);                  \
  }
  PE_LOAD_SET(ua, va, 0) PE_LOAD_SET(ub, vb, 4) PE_LOAD_SET(uc, vc, 8)
#pragma unroll 1
  for (int e0 = 0; e0 < 128; e0 += 4) {
    if (e0 + 12 < 128) { PE_LOAD_SET(ud, vd, e0 + 12) }
#pragma unroll
    for (int j = 0; j < 2; ++j) {
      const f32x32 du = fp6_decode(ua[j]);
      float d0 = 0.f, d1 = 0.f, d2 = 0.f, d3 = 0.f;
#pragma unroll
      for (int k = 0; k < 32; k += 4) {
        d0 = fmaf(hv[k], du[k], d0); d1 = fmaf(hv[k + 1], du[k + 1], d1); d2 = fmaf(hv[k + 2], du[k + 2], d2); d3 = fmaf(hv[k + 3], du[k + 3], d3);
      }
      const float r16 = row16_sum((d0 + d1) + (d2 + d3));
      const int ir = __float_as_int(r16);
      const float s0 = __int_as_float(__builtin_amdgcn_readlane(ir, 0)) + __int_as_float(__builtin_amdgcn_readlane(ir, 16));
      const float s1 = __int_as_float(__builtin_amdgcn_readlane(ir, 32)) + __int_as_float(__builtin_amdgcn_readlane(ir, 48));
      const float d = (hf ? s1 : s0) * SU[e0 + 2 * j + hf];
      const float w = GT[e0 + 2 * j + hf] * gelu_erf(d);
      const f32x32 dv = fp6_decode(va[j]);
#pragma unroll
      for (int k = 0; k < 32; ++k) acc[k] = fmaf(w, dv[k], acc[k]);
    }
#pragma unroll
    for (int j = 0; j < 2; ++j) { ua[j] = ub[j]; va[j] = vb[j]; ub[j] = uc[j]; vb[j] = vc[j]; uc[j] = ud[j]; vc[j] = vd[j]; }
  }
#pragma unroll
  for (int k = 0; k < 32; ++k) acc[k] += __shfl_xor(acc[k], 32);
  const int b = tok < NLAT ? (tok >> 12) : 8;
  float* xr = tok < NLAT ? p.out + (size_t)tok * 1024 : (float*)(p.ws + OFF_CTXB) + (size_t)(tok - NLAT) * 1024;
  const float* gate = mod + (size_t)b * 6144 + 5 * 1024;
  float4 xn[4];
  float ss = 0.f;
#pragma unroll
  for (int jj = 0; jj < 4; ++jj) {
    const int c = (l + 32 * (4 * hf + jj)) * 4;
    const float4 xv = *(const float4*)(xr + c);
    const float4 gv = *(const float4*)(gate + c);
    const float a0 = hf ? acc[16 + 4 * jj + 0] : acc[4 * jj + 0], a1 = hf ? acc[16 + 4 * jj + 1] : acc[4 * jj + 1];
    const float a2 = hf ? acc[16 + 4 * jj + 2] : acc[4 * jj + 2], a3 = hf ? acc[16 + 4 * jj + 3] : acc[4 * jj + 3];
    xn[jj].x = xv.x + gv.x * a0; xn[jj].y = xv.y + gv.y * a1; xn[jj].z = xv.z + gv.z * a2; xn[jj].w = xv.w + gv.w * a3;
    ss += xn[jj].x * xn[jj].x + xn[jj].y * xn[jj].y + xn[jj].z * xn[jj].z + xn[jj].w * xn[jj].w;
  }
  ss = wave_sum(ss);
  const float rinv = rsqrtf(ss * (1.f / 1024.f) + EPS);
  if (layer == 0) {
    const float* mod1 = (const float*)(p.ws + OFF_MOD) + (size_t)9 * 6144 + (size_t)b * 6144;
    const float* g1 = p.norm1_g + 1024;
    bf16_t* act = (bf16_t*)(p.ws + OFF_ACT) + (size_t)tok * 1024;
#pragma unroll
    for (int jj = 0; jj < 4; ++jj) {
      const int c = (l + 32 * (4 * hf + jj)) * 4;
      if (dowrite) *(float4*)(xr + c) = xn[jj]; else asm volatile("" :: "v"(xn[jj].x), "v"(xn[jj].y), "v"(xn[jj].z), "v"(xn[jj].w));
      const float4 gg4 = *(const float4*)(g1 + c);
      const float4 sh = *(const float4*)(mod1 + c);
      const float4 sc = *(const float4*)(mod1 + 1024 + c);
      uint2 o;
      o.x = pack2(xn[jj].x * rinv * gg4.x * (1.f + sc.x) + sh.x, xn[jj].y * rinv * gg4.y * (1.f + sc.y) + sh.y);
      o.y = pack2(xn[jj].z * rinv * gg4.z * (1.f + sc.z) + sh.z, xn[jj].w * rinv * gg4.w * (1.f + sc.w) + sh.w);
      if (dowrite) *(uint2*)(act + c) = o; else asm volatile("" :: "v"(o.x), "v"(o.y));
    }
  } else {
#pragma unroll
    for (int jj = 0; jj < 4; ++jj) {
      const int c = (l + 32 * (4 * hf + jj)) * 4;
      const float4 gg4 = *(const float4*)(p.final_g + c);
      float4 o;
      o.x = xn[jj].x * rinv * gg4.x; o.y = xn[jj].y * rinv * gg4.y; o.z = xn[jj].z * rinv * gg4.z; o.w = xn[jj].w * rinv * gg4.w;
      if (dowrite) *(float4*)(xr + c) = o; else asm volatile("" :: "v"(o.x), "v"(o.y), "v"(o.z), "v"(o.w));
    }
  }
}

__device__ __forceinline__ void phase_peer(const Params& p, int layer, char* smem, int ntok, bool dowrite = true) {
  const int tid = opaque_tid(), lane = tid & 63, wave = __builtin_amdgcn_readfirstlane(tid >> 6);
  int cand_a = -1, cand_b = 0;
  {
    int c = 0;
    for (int a = 0; a < 16; ++a)
      for (int bb = 0; bb < 16; ++bb)
        if ((a + 1) * (bb + 1) <= 16) { if (c == lane) { cand_a = a; cand_b = bb; } ++c; }
  }
  const int ngroups = ntok / 16, G = gridDim.x, g0 = opaque_bid();
  __syncthreads();
  if (g0 < ngroups && wave >= 4) {
    const int sw = wave - 4;
    peer_select_head(p, layer, smem, g0 * 16, 2 * sw, sw, 0, lane, cand_a, cand_b);
    peer_select_head(p, layer, smem, g0 * 16, 2 * sw + 1, sw, 0, lane, cand_a, cand_b);
  }
  __syncthreads();
  int it = 0;
  for (int grp = g0; grp < ngroups; grp += G, ++it) {
    const int buf = it & 1;
    if (wave < 4) {
#pragma unroll 1
      for (int tt = 0; tt < 4; ++tt) peer_gather_token(p, layer, smem, grp * 16 + wave * 4 + tt, wave * 4 + tt, buf, lane, dowrite);
    } else if (grp + G < ngroups) {
      const int sw = wave - 4;
      peer_select_head(p, layer, smem, (grp + G) * 16, 2 * sw, sw, buf ^ 1, lane, cand_a, cand_b);
      peer_select_head(p, layer, smem, (grp + G) * 16, 2 * sw + 1, sw, buf ^ 1, lane, cand_a, cand_b);
    }
    __syncthreads();
  }
}

template <int layer>
__device__ __forceinline__ void layer_body(const Params& p, char* smem, cg::grid_group& grid) {
  constexpr bool nc = layer == 0;
  const float* xin = layer == 0 ? p.x : (const float*)p.out;
  if (layer == 0) {
    phase_norm(p, layer, 0, xin, NTOK);
    grid.sync();
  }
#if REP_GEMM
  gemm_phase2<EPI_INPROJ>(p, layer, smem, (const bf16_t*)(p.ws + OFF_ACT), (const bf16_t*)(p.ws + OFF_WIN) + (size_t)layer * 3072 * 1024, NTOK, 3072, nullptr);
  grid.sync();
#endif
  gemm_phase2<EPI_INPROJ>(p, layer, smem, (const bf16_t*)(p.ws + OFF_ACT), (const bf16_t*)(p.ws + OFF_WIN) + (size_t)layer * 3072 * 1024, NTOK, 3072, nullptr);
  grid.sync();
#if REP_MIX1
  phase_mix1(p, layer, smem, 2);
  grid.sync();
#endif
  phase_mix1(p, layer, smem);
  grid.sync();
  phase_ret_scan(p, layer);
  grid.sync();
#if REP_MIX2
  phase_mix2(p, layer, smem, 3);
  grid.sync();
#endif
  phase_mix2(p, layer, smem);
  grid.sync();
  gemm_phase2<EPI_OUTPROJ>(p, layer, smem, (const bf16_t*)(p.ws + OFF_ACT), (const bf16_t*)(p.ws + OFF_WOUT) + (size_t)layer * 1024 * 1024, nc ? NTOK : NLAT, 1024, xin);
  grid.sync();
  phase_norm(p, layer, 1, (const float*)p.out, nc ? NTOK : NLAT);
  grid.sync();
  gemm_phase2<EPI_PLAIN>(p, layer, smem, (const bf16_t*)(p.ws + OFF_ACT), (const bf16_t*)(p.ws + OFF_WQ) + (size_t)layer * 2048 * 1024, nc ? NTOK : NLAT, 2048, nullptr);
  grid.sync();
#if REP_PEER
  phase_peer(p, layer, smem, nc ? NTOK : NLAT, false);
  grid.sync();
#endif
  phase_peer(p, layer, smem, nc ? NTOK : NLAT);
  if (layer == 0) grid.sync();
}

__global__ void __launch_bounds__(512) fwd_megakernel(Params p) {
  cg::grid_group grid = cg::this_grid();
  extern __shared__ __attribute__((aligned(16))) char smem[];
  phase_prep(p, smem);
  grid.sync();
  layer_body<0>(p, smem, grid);
  layer_body<1>(p, smem, grid);
}

extern "C" void kernel_launch(void* const* d_in, const int* in_sizes, int n_in, void* d_out,
                              int out_size, void* d_ws, size_t ws_size, hipStream_t stream) {
  constexpr size_t kDynLds = LDS_BYTES;
  static int grid_blocks = 0;
  if (!grid_blocks) {
    int dev = 0, cus = 0, per_cu = 0;
    (void)hipGetDevice(&dev);
    (void)hipDeviceGetAttribute(&cus, hipDeviceAttributeMultiprocessorCount, dev);
    (void)hipFuncSetAttribute((const void*)fwd_megakernel, hipFuncAttributeMaxDynamicSharedMemorySize, (int)kDynLds);
    (void)hipOccupancyMaxActiveBlocksPerMultiprocessor(&per_cu, fwd_megakernel, 512, kDynLds);
    if (per_cu < 1) { fprintf(stderr, "occupancy query says %d blocks/CU\n", per_cu); per_cu = 1; }
    grid_blocks = cus;
    if (ws_size < WS_END) fprintf(stderr, "workspace too small: %zu < %zu\n", ws_size, (size_t)WS_END);
  }
  Params p{};
  p.x = (const float*)d_in[0]; p.c = (const float*)d_in[1]; p.ctx = (const float*)d_in[2]; p.c_ctx = (const float*)d_in[3];
  p.w_ada = (const float*)d_in[4]; p.b_ada = (const float*)d_in[5]; p.norm1_g = (const float*)d_in[6]; p.w_in = (const float*)d_in[7];
  p.na_rpb = (const float*)d_in[8]; p.diff_lambda = (const float*)d_in[9]; p.diff_subln_g = (const float*)d_in[10];
  p.ret_decay_logit = (const float*)d_in[11]; p.w_out = (const float*)d_in[12]; p.norm2_g = (const float*)d_in[13];
  p.peer_wq = (const float*)d_in[14]; p.peer_subkeys = (const float*)d_in[15]; p.peer_u = (const float*)d_in[16];
  p.peer_v = (const float*)d_in[17]; p.final_g = (const float*)d_in[18];
  p.out = (float*)d_out; p.ws = (char*)d_ws;
  void* args[] = {&p};
  hipError_t e = hipLaunchCooperativeKernel((void*)fwd_megakernel, dim3(grid_blocks), dim3(512), args, kDynLds, stream);
  if (e != hipSuccess) fprintf(stderr, "cooperative launch failed: %s (grid %d)\n", hipGetErrorString(e), grid_blocks);
}
```

```cpp
#include <hip/hip_runtime.h>
#include <hip/hip_cooperative_groups.h>
#include <cstdio>
#include <cstdint>
namespace cg = cooperative_groups;

typedef unsigned short bf16_t;
typedef short bf16x8 __attribute__((ext_vector_type(8)));
typedef float f32x4 __attribute__((ext_vector_type(4)));

constexpr int DM = 1024, BATCH = 8, SEQ = 4096, LCTX = 256;
constexpr int NLAT = BATCH * SEQ;
constexpr int NCTX = BATCH * LCTX;
constexpr int NTOK = NLAT + NCTX;
constexpr int INC = 3072;
constexpr int C_NAQ = 0, C_NAK = 256, C_NAV = 512, C_DFQ = 768, C_DFK = 1024, C_DFV = 1280,
              C_RTQ = 1536, C_RTK = 1792, C_RTV = 2048, C_RTG = 2560;
constexpr int Y_NA = 0, Y_DF = 256, Y_RT = 512;
constexpr int NEXP = 16384;
constexpr float EPS = 1e-6f;

constexpr size_t OFF_CTL  = 0;
constexpr size_t OFF_MISC = 4096;
constexpr size_t OFF_ROPE = 8192;
constexpr size_t OFF_MOD  = OFF_ROPE + 12288;
constexpr size_t SZ_MOD   = 2ull * 9 * 6144 * 4;
constexpr size_t OFF_WIN  = OFF_MOD + SZ_MOD;
constexpr size_t SZ_WIN   = 2ull * 3072 * 1024 * 2;
constexpr size_t OFF_WOUT = OFF_WIN + SZ_WIN;
constexpr size_t SZ_WOUT  = 2ull * 1024 * 1024 * 2;
constexpr size_t OFF_WQ   = OFF_WOUT + SZ_WOUT;
constexpr size_t SZ_WQ    = 2ull * 2048 * 1024 * 2;
constexpr size_t OFF_SUBK = OFF_WQ + SZ_WQ;
constexpr size_t SZ_SUBK  = 2ull * 262144 * 2;
constexpr size_t OFF_U    = OFF_SUBK + SZ_SUBK;
constexpr int    ROWB     = 768;
constexpr int    RECB     = 2 * ROWB;
constexpr size_t SZ_UV    = 2ull * NEXP * ROWB;
constexpr size_t OFF_V    = OFF_U + SZ_UV;
constexpr size_t OFF_USC  = OFF_V + SZ_UV;
constexpr size_t OFF_VSC  = OFF_USC + 2ull * NEXP * 4;
constexpr size_t OFF_ACT  = OFF_VSC + 2ull * NEXP * 4;
constexpr size_t SZ_ACT   = (size_t)NTOK * 1024 * 2;
constexpr size_t OFF_P    = OFF_ACT + SZ_ACT;
constexpr size_t SZ_P     = (size_t)NTOK * 3072 * 2;
constexpr size_t OFF_CTXB = OFF_P + SZ_P;
constexpr size_t SZ_CTXB  = (size_t)NCTX * 1024 * 4;
constexpr size_t OFF_RKV  = OFF_CTXB + SZ_CTXB;
constexpr size_t SZ_RKV   = 64ull * 32 * 8192 * 4;
constexpr size_t OFF_RS   = OFF_RKV + SZ_RKV;
constexpr size_t SZ_RS    = 64ull * 8192 * 4;
constexpr size_t OFF_XBAR = OFF_RS + SZ_RS;
constexpr size_t WS_END   = OFF_XBAR + 16384;

#ifndef REP_MIX1
#define REP_MIX1 0
#endif
#ifndef REP_MIX2
#define REP_MIX2 0
#endif
#ifndef REP_PEER
#define REP_PEER 0
#endif
#ifndef REP_GEMM
#define REP_GEMM 0
#endif
constexpr int LDS_BYTES = 144 * 1024;
constexpr int LDS_BCAST = LDS_BYTES - 16;

struct Params {
  const float *x, *c, *ctx, *c_ctx, *w_ada, *b_ada, *norm1_g, *w_in, *na_rpb, *diff_lambda, *diff_subln_g,
              *ret_decay_logit, *w_out, *norm2_g, *peer_wq, *peer_subkeys, *peer_u, *peer_v, *final_g;
  float* out;
  char* ws;
};

__device__ __forceinline__ float bf2f(bf16_t v) { return __uint_as_float(((unsigned)v) << 16); }
__device__ __forceinline__ bf16_t f2bf(float f) {
  unsigned u = __float_as_uint(f);
  u += 0x7fffu + ((u >> 16) & 1u);
  return (bf16_t)(u >> 16);
}
__device__ __forceinline__ unsigned pack2(float a, float b) { return (unsigned)f2bf(a) | ((unsigned)f2bf(b) << 16); }
__device__ __forceinline__ float lo16(unsigned w) { return __uint_as_float(w << 16); }
__device__ __forceinline__ float hi16(unsigned w) { return __uint_as_float(w & 0xffff0000u); }
#define DPP_ADD(v, CTRL) ((v) + __int_as_float(__builtin_amdgcn_update_dpp(0, __float_as_int(v), (CTRL), 0xf, 0xf, true)))
__device__ __forceinline__ float row16_sum(float v) {
  v = DPP_ADD(v, 0xB1);
  v = DPP_ADD(v, 0x4E);
  v = DPP_ADD(v, 0x141);
  v = DPP_ADD(v, 0x140);
  return v;
}
__device__ __forceinline__ float wave_sum(float v) {
  v = row16_sum(v);
  const int iv = __float_as_int(v);
  const float a = __int_as_float(__builtin_amdgcn_readlane(iv, 0)), b = __int_as_float(__builtin_amdgcn_readlane(iv, 16));
  const float c = __int_as_float(__builtin_amdgcn_readlane(iv, 32)), d = __int_as_float(__builtin_amdgcn_readlane(iv, 48));
  return (a + b) + (c + d);
}
__device__ __forceinline__ float siluf(float x) { return x / (1.f + __expf(-x)); }

__device__ __forceinline__ int opaque_tid() { int t = threadIdx.x; asm volatile("" : "+v"(t)); return t; }
__device__ __forceinline__ int opaque_bid() { int t = blockIdx.x; asm volatile("" : "+s"(t)); return t; }

#define DOT8(acc, Q, off, U)                                                              \
  acc = fmaf(Q[(off) + 0], lo16((U).x), acc); acc = fmaf(Q[(off) + 1], hi16((U).x), acc); \
  acc = fmaf(Q[(off) + 2], lo16((U).y), acc); acc = fmaf(Q[(off) + 3], hi16((U).y), acc); \
  acc = fmaf(Q[(off) + 4], lo16((U).z), acc); acc = fmaf(Q[(off) + 5], hi16((U).z), acc); \
  acc = fmaf(Q[(off) + 6], lo16((U).w), acc); acc = fmaf(Q[(off) + 7], hi16((U).w), acc);
#define AXPY8(O, off, P, U)                                                                   \
  O[(off) + 0] = fmaf(P, lo16((U).x), O[(off) + 0]); O[(off) + 1] = fmaf(P, hi16((U).x), O[(off) + 1]); \
  O[(off) + 2] = fmaf(P, lo16((U).y), O[(off) + 2]); O[(off) + 3] = fmaf(P, hi16((U).y), O[(off) + 3]); \
  O[(off) + 4] = fmaf(P, lo16((U).z), O[(off) + 4]); O[(off) + 5] = fmaf(P, hi16((U).z), O[(off) + 5]); \
  O[(off) + 6] = fmaf(P, lo16((U).w), O[(off) + 6]); O[(off) + 7] = fmaf(P, hi16((U).w), O[(off) + 7]);
#define UNPACK8(Q, off, U)                                                  \
  Q[(off) + 0] = lo16((U).x); Q[(off) + 1] = hi16((U).x); Q[(off) + 2] = lo16((U).y); Q[(off) + 3] = hi16((U).y); \
  Q[(off) + 4] = lo16((U).z); Q[(off) + 5] = hi16((U).z); Q[(off) + 6] = lo16((U).w); Q[(off) + 7] = hi16((U).w);

__device__ __forceinline__ int next_item(unsigned* counter, char* smem) {
  volatile int* bc = (volatile int*)(smem + LDS_BCAST);
  __syncthreads();
  if (threadIdx.x == 0) *bc = (int)atomicAdd(counter, 1u);
  __syncthreads();
  return *bc;
}

#define XB_TMO      128
#define XB_XCNT(j)  (256  + 64 * (j))
#define XB_XSUB(j)  (1280 + 64 * (j))
#define XB_XGEN(j)  (2304 + 64 * (j))
#define XB_TOP      3328
#define XB_TOPGEN   3392
#define XCD_BAR_WORDS 3456
#define XB_SPIN_CAP (1u << 18)
#define LAS3 __attribute__((address_space(3)))
__device__ __forceinline__ unsigned xb_ld(unsigned* p)              { return __hip_atomic_load(p, __ATOMIC_RELAXED, __HIP_MEMORY_SCOPE_AGENT); }
__device__ __forceinline__ unsigned xb_add(unsigned* p, unsigned v) { return __hip_atomic_fetch_add(p, v, __ATOMIC_RELAXED, __HIP_MEMORY_SCOPE_AGENT); }
__device__ __forceinline__ unsigned xb_xcc_id() { return (unsigned)__builtin_amdgcn_s_getreg((3 << 11) | 20) & 0xFu; }
#define XB_SPIN(cond, bar) do { unsigned _sp = 0; while (cond) { __builtin_amdgcn_s_sleep(1); \
    if ((++_sp & 255u) == 0u) { if (xb_ld(&(bar)[XB_TMO])) break; if (_sp > XB_SPIN_CAP) { atomicAdd(&(bar)[XB_TMO], 1u); break; } } } } while (0)
struct XcdBarrier { unsigned* bar; unsigned x; volatile LAS3 unsigned* st; };
__device__ __forceinline__ XcdBarrier xcd_barrier_post(unsigned* bar, volatile LAS3 unsigned* st) {
  XcdBarrier b; b.bar = bar; b.x = xb_xcc_id(); b.st = st;
  if (threadIdx.x == 0) (void)xb_add(&bar[XB_XCNT(b.x)], 1u);
  return b;
}
__device__ __forceinline__ void xcd_barrier_complete(unsigned* bar, unsigned x, unsigned& nloc, unsigned& nx) {
  const unsigned G = gridDim.x * gridDim.y * gridDim.z;
  unsigned sum, cnt, mine, sp = 0u;
  for (;;) {
    sum = 0u; cnt = 0u; mine = 0u;
#pragma unroll
    for (unsigned j = 0; j < 16; ++j) { const unsigned c = xb_ld(&bar[XB_XCNT(j)]); sum += c; cnt += (c > 0u) ? 1u : 0u; mine = (j == x) ? c : mine; }
    if (sum == G) break;
    __builtin_amdgcn_s_sleep(1);
    if ((++sp & 255u) == 0u) { if (xb_ld(&bar[XB_TMO])) break; if (sp > XB_SPIN_CAP) { atomicAdd(&bar[XB_TMO], 1u); break; } }
  }
  nloc = mine > 0u ? mine : 1u; nx = cnt > 0u ? cnt : 1u;
}
__device__ __forceinline__ void xcd_barrier(const XcdBarrier& b) {
  asm volatile("s_waitcnt vmcnt(0)" ::: "memory");
  __syncthreads();
  if (threadIdx.x == 0) {
    unsigned* bar = b.bar;
    __builtin_amdgcn_s_waitcnt(0);
    unsigned nloc = b.st[0], nx = b.st[1];
    if (nloc == 0u) { xcd_barrier_complete(bar, b.x, nloc, nx); b.st[0] = nloc; b.st[1] = nx; }
    const unsigned old = xb_add(&bar[XB_XSUB(b.x)], 1u);
    const unsigned gen = old / nloc;
    if (old + 1u == (gen + 1u) * nloc) {
      __builtin_amdgcn_fence(__ATOMIC_RELEASE, "agent");
      asm volatile("s_waitcnt vmcnt(0)" ::: "memory");
      const unsigned og = xb_add(&bar[XB_TOP], 1u);
      const unsigned tg = og / nx;
      if (og + 1u == (tg + 1u) * nx) xb_add(&bar[XB_TOPGEN], 1u);
      else XB_SPIN(xb_ld(&bar[XB_TOPGEN]) == tg, bar);
      __builtin_amdgcn_fence(__ATOMIC_ACQUIRE, "agent");
      xb_add(&bar[XB_XGEN(b.x)], 1u);
      asm volatile("s_waitcnt vmcnt(0)" ::: "memory");
    } else {
      XB_SPIN(xb_ld(&bar[XB_XGEN(b.x)]) == gen, bar);
      __builtin_amdgcn_fence(__ATOMIC_ACQUIRE, "agent");
      asm volatile("s_waitcnt vmcnt(0)" ::: "memory");
    }
  }
  __syncthreads();
}

__device__ __forceinline__ void transpose_item(const float* src, bf16_t* dst, int K, int N, int item, char* smem) {
  float* t = (float*)smem;
  const int nb = N / 64;
  const int k0 = (item / nb) * 64, n0 = (item % nb) * 64;
  const int tid = opaque_tid();
  __syncthreads();
#pragma unroll
  for (int i = 0; i < 8; ++i) {
    const int k = (tid >> 6) + 8 * i, n = tid & 63;
    t[k * 65 + n] = src[(size_t)(k0 + k) * N + n0 + n];
  }
  __syncthreads();
#pragma unroll
  for (int i = 0; i < 8; ++i) {
    const int n = (tid >> 6) + 8 * i, k = tid & 63;
    dst[(size_t)(n0 + n) * K + k0 + k] = f2bf(t[k * 65 + n]);
  }
}

__device__ __forceinline__ void convert_flat(const float* src, bf16_t* dst, size_t n4) {
  const size_t gt = (size_t)opaque_bid() * blockDim.x + opaque_tid(), gs = (size_t)gridDim.x * blockDim.x;
  for (size_t i = gt; i < n4; i += gs) {
    const float4 v = ((const float4*)src)[i];
    uint2 o; o.x = pack2(v.x, v.y); o.y = pack2(v.z, v.w);
    ((uint2*)dst)[i] = o;
  }
}

__device__ __forceinline__ void phase_prep(const Params& p, char* smem) {
  const int tid = opaque_tid();
  char* ws = p.ws;
  if (opaque_bid() == 0) {
    unsigned* ctl = (unsigned*)(ws + OFF_CTL);
    if (tid < 64) ctl[tid] = 0u;
    unsigned* xbar = (unsigned*)(ws + OFF_XBAR);
    for (int i = tid; i < XCD_BAR_WORDS; i += 512) xbar[i] = 0u;
    float* misc = (float*)(ws + OFF_MISC);
    if (tid < 2) {
      const float* lp = p.diff_lambda + tid * 128;
      float s01 = 0.f, s23 = 0.f;
      for (int i = 0; i < 32; ++i) { s01 += lp[i] * lp[32 + i]; s23 += lp[64 + i] * lp[96 + i]; }
      const float lam_init = 0.8f - 0.6f * expf(-0.3f * (float)tid);
      misc[tid] = expf(s01) - expf(s23) + lam_init;
      misc[2 + tid] = lam_init;
    }
    if (tid >= 128 && tid < 256) misc[64 + tid - 128] = 0.f;
    if (tid >= 64 && tid < 80) {
      const int i = tid - 64;
      const float xv = p.ret_decay_logit[i];
      misc[16 + i] = -log1pf(expf(-xv));
    }
    float2* ropeD = (float2*)(ws + OFF_ROPE);
    float2* ropeR = (float2*)(ws + OFF_ROPE + 4096);
    for (int i = tid; i < 64 * 8; i += 512) {
      const int v = i >> 3, f = i & 7;
      const float inv = powf(10000.0f, -(float)(2 * f) / 16.0f);
      const float ang = (float)v * inv;
      ropeD[i] = make_float2(cosf(ang), sinf(ang));
    }
    for (int i = tid; i < 64 * 16; i += 512) {
      const int v = i >> 4, f = i & 15;
      const float inv = powf(10000.0f, -(float)(2 * f) / 32.0f);
      const float ang = (float)v * inv;
      ropeR[i] = make_float2(cosf(ang), sinf(ang));
    }
  }
  {
    float* sc = (float*)smem;
    float* red = (float*)(smem + 9 * 1024 * 4);
    float* mod = (float*)(ws + OFF_MOD);
    for (int item = opaque_bid(); item < 192; item += gridDim.x) {
      const int l = item / 96, cb = item % 96;
      __syncthreads();
      for (int i = tid; i < 9 * 1024; i += 512) {
        const int r = i >> 10, k = i & 1023;
        const float cv = (r < 8) ? p.c[r * 1024 + k] : p.c_ctx[k];
        sc[i] = siluf(cv);
      }
      __syncthreads();
      const int col = tid & 63, ks = tid >> 6;
      float acc[9];
#pragma unroll
      for (int r = 0; r < 9; ++r) acc[r] = 0.f;
      const float* w = p.w_ada + (size_t)l * 1024 * 6144 + cb * 64 + col;
      for (int k = ks * 128; k < ks * 128 + 128; ++k) {
        const float wv = w[(size_t)k * 6144];
#pragma unroll
        for (int r = 0; r < 9; ++r) acc[r] = fmaf(sc[r * 1024 + k], wv, acc[r]);
      }
#pragma unroll
      for (int r = 0; r < 9; ++r) red[(ks * 9 + r) * 64 + col] = acc[r];
      __syncthreads();
      for (int i = tid; i < 576; i += 512) {
        const int r = i >> 6, cc = i & 63;
        float s = 0.f;
#pragma unroll
        for (int k8 = 0; k8 < 8; ++k8) s += red[(k8 * 9 + r) * 64 + cc];
        mod[((size_t)l * 9 + r) * 6144 + cb * 64 + cc] = s + p.b_ada[l * 6144 + cb * 64 + cc];
      }
    }
    __syncthreads();
  }
  for (int item = opaque_bid(); item < 3072; item += gridDim.x) {
    const int l = item / 1536;
    int r = item % 1536;
    if (r < 768) transpose_item(p.w_in + (size_t)l * 1024 * 3072, (bf16_t*)(ws + OFF_WIN) + (size_t)l * 3072 * 1024, 1024, 3072, r, smem);
    else if (r < 1024) transpose_item(p.w_out + (size_t)l * 1024 * 1024, (bf16_t*)(ws + OFF_WOUT) + (size_t)l * 1024 * 1024, 1024, 1024, r - 768, smem);
    else transpose_item(p.peer_wq + (size_t)l * 1024 * 2048, (bf16_t*)(ws + OFF_WQ) + (size_t)l * 2048 * 1024, 1024, 2048, r - 1024, smem);
  }
  convert_flat(p.peer_subkeys, (bf16_t*)(ws + OFF_SUBK), 2ull * 262144 / 4);
  {
    const int lane = tid & 63, l = lane & 31, half = lane >> 5;
    const int gw = opaque_bid() * 8 + (tid >> 6), nw = gridDim.x * 8;
    for (int rp = gw; rp < 2 * NEXP; rp += nw) {
      const int row = rp * 2 + half;
      const bool isv = row >= 2 * NEXP;
      const int rr = isv ? row - 2 * NEXP : row;
      const float* srow = (isv ? p.peer_v : p.peer_u) + (size_t)rr * 1024;
      float4 v[8];
      float mx = 0.f;
#pragma unroll
      for (int j = 0; j < 8; ++j) {
        v[j] = ((const float4*)srow)[l + 32 * j];
        mx = fmaxf(mx, fmaxf(fmaxf(fabsf(v[j].x), fabsf(v[j].y)), fmaxf(fabsf(v[j].z), fabsf(v[j].w))));
      }
#pragma unroll
      for (int o = 1; o < 32; o <<= 1) mx = fmaxf(mx, __shfl_xor(mx, o));
      const float scale = mx > 0.f ? mx * (1.f / 7.5f) : 1.f;
      const float inv = 1.f / scale;
      unsigned w[6] = {0u, 0u, 0u, 0u, 0u, 0u};
#pragma unroll
      for (int k = 0; k < 32; ++k) {
        const float xv = (k & 3) == 0 ? v[k >> 2].x : (k & 3) == 1 ? v[k >> 2].y : (k & 3) == 2 ? v[k >> 2].z : v[k >> 2].w;
        const float a = fminf(fabsf(xv) * inv, 7.5f);
        float c;
        if (a < 2.f) c = rintf(a * 8.f);
        else if (a < 4.f) c = 16.f + rintf((a - 2.f) * 4.f);
        else c = 24.f + rintf((a - 4.f) * 2.f);
        unsigned code = (unsigned)c;
        code = code > 31u ? 31u : code;
        code |= (xv < 0.f) ? 32u : 0u;
        const int bit = 6 * k, wd = bit >> 5, sh = bit & 31;
        w[wd] |= code << sh;
        if (sh > 26) w[wd + 1] |= code >> (32 - sh);
      }
      char* drow = ws + OFF_U + (size_t)rr * RECB + (isv ? ROWB : 0) + l * 24;
      *(uint2*)(drow) = make_uint2(w[0], w[1]);
      *(uint2*)(drow + 8) = make_uint2(w[2], w[3]);
      *(uint2*)(drow + 16) = make_uint2(w[4], w[5]);
      if (l == 0) ((float*)(ws + (isv ? OFF_VSC : OFF_USC)))[rr] = scale;
    }
  }
  {
    const size_t gt = (size_t)opaque_bid() * blockDim.x + tid, gs = (size_t)gridDim.x * blockDim.x;
    float4* dst = (float4*)(ws + OFF_CTXB);
    for (size_t i = gt; i < (size_t)NCTX * 1024 / 4; i += gs) dst[i] = ((const float4*)p.ctx)[i];
  }
}

__device__ __forceinline__ void phase_norm(const Params& p, int layer, int which, const float* xlat, int nrows) {
  const int lane = opaque_tid() & 63;
  const int gw = opaque_bid() * 8 + (opaque_tid() >> 6), nw = gridDim.x * 8;
  const float* g = (which == 0 ? p.norm1_g : p.norm2_g) + layer * 1024;
  const float* mod = (const float*)(p.ws + OFF_MOD) + (size_t)layer * 9 * 6144;
  const float* ctxb = (const float*)(p.ws + OFF_CTXB);
  bf16_t* act = (bf16_t*)(p.ws + OFF_ACT);
  const int sh_off = which == 0 ? 0 : 3 * 1024, sc_off = which == 0 ? 1024 : 4 * 1024;
  for (int row = gw; row < nrows; row += nw) {
    const float* src = row < NLAT ? xlat + (size_t)row * 1024 : ctxb + (size_t)(row - NLAT) * 1024;
    const int b = row < NLAT ? (row >> 12) : 8;
    const float* mrow = mod + (size_t)b * 6144;
    float4 v[4];
    float ss = 0.f;
#pragma unroll
    for (int j = 0; j < 4; ++j) {
      v[j] = ((const float4*)src)[lane + 64 * j];
      ss += v[j].x * v[j].x + v[j].y * v[j].y + v[j].z * v[j].z + v[j].w * v[j].w;
    }
    ss = wave_sum(ss);
    const float r = rsqrtf(ss * (1.f / 1024.f) + EPS);
#pragma unroll
    for (int j = 0; j < 4; ++j) {
      const int c = (lane + 64 * j) * 4;
      const float4 gg = *(const float4*)(g + c);
      const float4 sh = *(const float4*)(mrow + sh_off + c);
      const float4 sc = *(const float4*)(mrow + sc_off + c);
      const float o0 = v[j].x * r * gg.x * (1.f + sc.x) + sh.x;
      const float o1 = v[j].y * r * gg.y * (1.f + sc.y) + sh.y;
      const float o2 = v[j].z * r * gg.z * (1.f + sc.z) + sh.z;
      const float o3 = v[j].w * r * gg.w * (1.f + sc.w) + sh.w;
      uint2 o; o.x = pack2(o0, o1); o.y = pack2(o2, o3);
      *(uint2*)(act + (size_t)row * 1024 + c) = o;
    }
  }
}

__device__ __forceinline__ void phase_final(const Params& p) {
  const int lane = opaque_tid() & 63;
  const int gw = opaque_bid() * 8 + (opaque_tid() >> 6), nw = gridDim.x * 8;
  for (int row = gw; row < NLAT; row += nw) {
    float* src = p.out + (size_t)row * 1024;
    float4 v[4];
    float ss = 0.f;
#pragma unroll
    for (int j = 0; j < 4; ++j) {
      v[j] = ((const float4*)src)[lane + 64 * j];
      ss += v[j].x * v[j].x + v[j].y * v[j].y + v[j].z * v[j].z + v[j].w * v[j].w;
    }
    ss = wave_sum(ss);
    const float r = rsqrtf(ss * (1.f / 1024.f) + EPS);
#pragma unroll
    for (int j = 0; j < 4; ++j) {
      const int c = (lane + 64 * j) * 4;
      const float4 gg = *(const float4*)(p.final_g + c);
      float4 o;
      o.x = v[j].x * r * gg.x; o.y = v[j].y * r * gg.y; o.z = v[j].z * r * gg.z; o.w = v[j].w * r * gg.w;
      ((float4*)src)[lane + 64 * j] = o;
    }
  }
}

constexpr int EPI_INPROJ = 0, EPI_OUTPROJ = 1, EPI_PLAIN = 2;
constexpr int GS = 72;
constexpr int G_ASTAGE = 256 * GS * 2;
constexpr int G_BSTAGE = 128 * GS * 2;
constexpr int G_STAGE = G_ASTAGE + G_BSTAGE;

template <int EPI>
__device__ __forceinline__ void gemm_phase(const Params& p, int layer, char* smem, const bf16_t* A, const bf16_t* Bt,
                                           int M, int N, const float* xin_lat) {
  const int tid = opaque_tid(), lane = tid & 63, wave = tid >> 6, wm = wave >> 1, wn = wave & 1;
  const int ntn = N / 128, ntiles = (M / 256) * ntn;
  const int lr = lane & 15, lq = lane >> 4;
  for (int tile = opaque_bid(); tile < ntiles; tile += gridDim.x) {
    const int m0 = (tile / ntn) * 256, n0 = (tile % ntn) * 128;
    f32x4 acc[4][4];
#pragma unroll
    for (int i = 0; i < 4; ++i)
#pragma unroll
      for (int j = 0; j < 4; ++j) acc[i][j] = (f32x4){0.f, 0.f, 0.f, 0.f};
    uint4 ra[4], rb[2];
    const int crow = tid >> 3, ckc = tid & 7;
    auto gload = [&](int k0) {
#pragma unroll
      for (int i = 0; i < 4; ++i) ra[i] = *(const uint4*)(A + (size_t)(m0 + crow + 64 * i) * 1024 + k0 + ckc * 8);
#pragma unroll
      for (int i = 0; i < 2; ++i) rb[i] = *(const uint4*)(Bt + (size_t)(n0 + crow + 64 * i) * 1024 + k0 + ckc * 8);
    };
    auto lstore = [&](int s) {
      bf16_t* sA = (bf16_t*)(smem + s * G_STAGE);
      bf16_t* sB = (bf16_t*)(smem + s * G_STAGE + G_ASTAGE);
#pragma unroll
      for (int i = 0; i < 4; ++i) *(uint4*)(sA + (crow + 64 * i) * GS + ckc * 8) = ra[i];
#pragma unroll
      for (int i = 0; i < 2; ++i) *(uint4*)(sB + (crow + 64 * i) * GS + ckc * 8) = rb[i];
    };
    __syncthreads();
    gload(0);
    lstore(0);
    __syncthreads();
    for (int kt = 0; kt < 16; ++kt) {
      const int cur = kt & 1;
      if (kt + 1 < 16) gload((kt + 1) * 64);
      const bf16_t* sA = (const bf16_t*)(smem + cur * G_STAGE);
      const bf16_t* sB = (const bf16_t*)(smem + cur * G_STAGE + G_ASTAGE);
#pragma unroll
      for (int ks = 0; ks < 2; ++ks) {
        bf16x8 af[4], bfr[4];
#pragma unroll
        for (int mi = 0; mi < 4; ++mi) af[mi] = *(const bf16x8*)(sA + (wm * 64 + mi * 16 + lr) * GS + ks * 32 + lq * 8);
#pragma unroll
        for (int ni = 0; ni < 4; ++ni) bfr[ni] = *(const bf16x8*)(sB + (wn * 64 + ni * 16 + lr) * GS + ks * 32 + lq * 8);
#pragma unroll
        for (int mi = 0; mi < 4; ++mi)
#pragma unroll
          for (int ni = 0; ni < 4; ++ni)
            acc[mi][ni] = __builtin_amdgcn_mfma_f32_16x16x32_bf16(bfr[ni], af[mi], acc[mi][ni], 0, 0, 0);
      }
      if (kt + 1 < 16) lstore(cur ^ 1);
      __syncthreads();
    }
    if constexpr (EPI == EPI_INPROJ) {
      if (n0 >= C_DFK && n0 < C_DFV) {
        float mx0 = 0.f, mx1 = 0.f;
#pragma unroll
        for (int mi = 0; mi < 4; ++mi) {
          float s0 = 0.f, s1 = 0.f;
#pragma unroll
          for (int r = 0; r < 4; ++r) {
            s0 = fmaf(acc[mi][0][r], acc[mi][0][r], s0); s0 = fmaf(acc[mi][1][r], acc[mi][1][r], s0);
            s1 = fmaf(acc[mi][2][r], acc[mi][2][r], s1); s1 = fmaf(acc[mi][3][r], acc[mi][3][r], s1);
          }
          s0 += __shfl_xor(s0, 16); s0 += __shfl_xor(s0, 32);
          s1 += __shfl_xor(s1, 16); s1 += __shfl_xor(s1, 32);
          mx0 = fmaxf(mx0, s0); mx1 = fmaxf(mx1, s1);
        }
#pragma unroll
        for (int o = 1; o < 16; o <<= 1) { mx0 = fmaxf(mx0, __shfl_xor(mx0, o)); mx1 = fmaxf(mx1, __shfl_xor(mx1, o)); }
        if (lane == 0) {
          const int bb = m0 < NLAT ? (m0 >> 12) : ((m0 - NLAT) >> 8);
          const int hh = ((n0 - C_DFK) >> 6) + wn;
          unsigned* km = (unsigned*)(p.ws + OFF_MISC) + 64 + layer * 64 + (bb * 4 + hh) * 2;
          atomicMax(km + 0, __float_as_uint(mx0));
          atomicMax(km + 1, __float_as_uint(mx1));
        }
      }
    }
#pragma unroll
    for (int mi = 0; mi < 4; ++mi) {
      const int m = m0 + wm * 64 + mi * 16 + lr;
#pragma unroll
      for (int ni = 0; ni < 4; ++ni) {
        const int n = n0 + wn * 64 + ni * 16 + lq * 4;
        float v0 = acc[mi][ni][0], v1 = acc[mi][ni][1], v2 = acc[mi][ni][2], v3 = acc[mi][ni][3];
        if constexpr (EPI == EPI_INPROJ) {
          const bool ropeD = (n >= C_DFQ && n < C_DFV), ropeR = (n >= C_RTQ && n < C_RTV);
          if ((ropeD || ropeR) && m < NLAT) {
            const int t = m & 4095, gr = t >> 6, gc = t & 63;
            float2 cs0, cs1;
            if (ropeD) {
              const float2* tab = (const float2*)(p.ws + OFF_ROPE);
              const int i0 = (n & 31) >> 1;
              if (i0 < 8) { cs0 = tab[gr * 8 + i0]; cs1 = tab[gr * 8 + i0 + 1]; }
              else { cs0 = tab[gc * 8 + i0 - 8]; cs1 = tab[gc * 8 + i0 - 7]; }
            } else {
              const float2* tab = (const float2*)(p.ws + OFF_ROPE + 4096);
              const int i0 = (n & 63) >> 1;
              if (i0 < 16) { cs0 = tab[gr * 16 + i0]; cs1 = tab[gr * 16 + i0 + 1]; }
              else { cs0 = tab[gc * 16 + i0 - 16]; cs1 = tab[gc * 16 + i0 - 15]; }
            }
            const float a0 = v0 * cs0.x - v1 * cs0.y, a1 = v0 * cs0.y + v1 * cs0.x;
            const float a2 = v2 * cs1.x - v3 * cs1.y, a3 = v2 * cs1.y + v3 * cs1.x;
            v0 = a0; v1 = a1; v2 = a2; v3 = a3;
          }
          float sc = 1.f;
          if (n < C_NAK) sc = 0.125f * 1.4426950408889634f;
          else if (n >= C_DFQ && n < C_DFK) sc = 0.17677669529663687f * 1.4426950408889634f;
          else if (n >= C_RTK && n < C_RTV) sc = 0.125f;
          uint2 o; o.x = pack2(v0 * sc, v1 * sc); o.y = pack2(v2 * sc, v3 * sc);
          *(uint2*)((bf16_t*)(p.ws + OFF_P) + (size_t)m * INC + n) = o;
        } else if constexpr (EPI == EPI_OUTPROJ) {
          const float* mod = (const float*)(p.ws + OFF_MOD) + (size_t)layer * 9 * 6144;
          const int b = m < NLAT ? (m >> 12) : 8;
          const float4 gt = *(const float4*)(mod + (size_t)b * 6144 + 2 * 1024 + n);
          const float* xi; float* xo;
          if (m < NLAT) { xi = xin_lat + (size_t)m * 1024 + n; xo = p.out + (size_t)m * 1024 + n; }
          else { xo = (float*)(p.ws + OFF_CTXB) + (size_t)(m - NLAT) * 1024 + n; xi = xo; }
          const float4 xv = *(const float4*)xi;
          float4 o; o.x = xv.x + gt.x * v0; o.y = xv.y + gt.y * v1; o.z = xv.z + gt.z * v2; o.w = xv.w + gt.w * v3;
          *(float4*)xo = o;
        } else {
          uint2 o; o.x = pack2(v0, v1); o.y = pack2(v2, v3);
          *(uint2*)((bf16_t*)(p.ws + OFF_P) + (size_t)m * 2048 + n) = o;
        }
      }
    }
  }
}

namespace g8 {
constexpr int BM = 256, BK = 64, HALF = 128, NXCD = 8, WGM = 8, HT = HALF * BK;
__device__ __forceinline__ int lds_byte(int r, int c) {
  const int st = (r >> 4) * 2 + (c >> 5), rr = r & 15, cc = c & 31, ob = rr * 64 + cc * 2;
  return st * 1024 + (ob ^ (((ob >> 9) & 1) << 5));
}
__device__ __forceinline__ void stage_rc(int b, int& R, int& C) {
  const int st = b / 1024, sb = b % 1024, swz = sb ^ (((sb >> 9) & 1) << 5);
  R = (st >> 1) * 16 + swz / 64; C = (st & 1) * 32 + (swz % 64) / 2;
}
}

template <int EPI>
__device__ __forceinline__ void epi_store4(const Params& p, int layer, int m, int n, float v0, float v1, float v2, float v3, const float* xin_lat) {
  if constexpr (EPI == EPI_INPROJ) {
    const bool ropeD = (n >= C_DFQ && n < C_DFV), ropeR = (n >= C_RTQ && n < C_RTV);
    if ((ropeD || ropeR) && m < NLAT) {
      const int t = m & 4095, gr = t >> 6, gc = t & 63;
      float2 cs0, cs1;
      if (ropeD) {
        const float2* tab = (const float2*)(p.ws + OFF_ROPE);
        const int i0 = (n & 31) >> 1;
        if (i0 < 8) { cs0 = tab[gr * 8 + i0]; cs1 = tab[gr * 8 + i0 + 1]; }
        else { cs0 = tab[gc * 8 + i0 - 8]; cs1 = tab[gc * 8 + i0 - 7]; }
      } else {
        const float2* tab = (const float2*)(p.ws + OFF_ROPE + 4096);
        const int i0 = (n & 63) >> 1;
        if (i0 < 16) { cs0 = tab[gr * 16 + i0]; cs1 = tab[gr * 16 + i0 + 1]; }
        else { cs0 = tab[gc * 16 + i0 - 16]; cs1 = tab[gc * 16 + i0 - 15]; }
      }
      const float a0 = v0 * cs0.x - v1 * cs0.y, a1 = v0 * cs0.y + v1 * cs0.x;
      const float a2 = v2 * cs1.x - v3 * cs1.y, a3 = v2 * cs1.y + v3 * cs1.x;
      v0 = a0; v1 = a1; v2 = a2; v3 = a3;
    }
    float sc = 1.f;
    if (n < C_NAK) sc = 0.125f * 1.4426950408889634f;
    else if (n >= C_DFQ && n < C_DFK) sc = 0.17677669529663687f * 1.4426950408889634f;
    else if (n >= C_RTK && n < C_RTV) sc = 0.125f;
    uint2 o; o.x = pack2(v0 * sc, v1 * sc); o.y = pack2(v2 * sc, v3 * sc);
    *(uint2*)((bf16_t*)(p.ws + OFF_P) + (size_t)m * INC + n) = o;
  } else if constexpr (EPI == EPI_OUTPROJ) {
    const float* mod = (const float*)(p.ws + OFF_MOD) + (size_t)layer * 9 * 6144;
    const int b = m < NLAT ? (m >> 12) : 8;
    const float4 gt = *(const float4*)(mod + (size_t)b * 6144 + 2 * 1024 + n);
    const float* xi; float* xo;
    if (m < NLAT) { xi = xin_lat + (size_t)m * 1024 + n; xo = p.out + (size_t)m * 1024 + n; }
    else { xo = (float*)(p.ws + OFF_CTXB) + (size_t)(m - NLAT) * 1024 + n; xi = xo; }
    const float4 xv = *(const float4*)xi;
    float4 o; o.x = xv.x + gt.x * v0; o.y = xv.y + gt.y * v1; o.z = xv.z + gt.z * v2; o.w = xv.w + gt.w * v3;
    *(float4*)xo = o;
  } else {
    uint2 o; o.x = pack2(v0, v1); o.y = pack2(v2, v3);
    *(uint2*)((bf16_t*)(p.ws + OFF_P) + (size_t)m * 2048 + n) = o;
  }
}

#define G8_LAS __attribute__((address_space(3)))
__device__ __forceinline__ bool g8_next(int i, int nM, int nN, int G, int c, int& pm, int& pn) {
  using namespace g8;
  const int nwg = nM * nN;
  const long Lx = (long)i * G + c;
  if (Lx >= nwg) return false;
  int wgid = (int)Lx;
  { const int q = nwg / NXCD, r = nwg % NXCD, xcd = wgid % NXCD, off = wgid / NXCD; wgid = (xcd < r ? xcd * (q + 1) : r * (q + 1) + (xcd - r) * q) + off; }
  const int nig = WGM * nN, gid = wgid / nig, fm = gid * WGM, gsz = (nM - fm) < WGM ? (nM - fm) : WGM;
  pm = fm + ((wgid % nig) % gsz); pn = (wgid % nig) / gsz;
  return true;
}

template <int EPI>
__device__ __forceinline__ void gemm_phase2(const Params& p, int layer, char* smem, const bf16_t* A, const bf16_t* Bt,
                                            int M, int N, const float* xin_lat) {
  using namespace g8;
  constexpr int K = 1024, nt = K / BK, HTB = HALF * BK * 2;
  G8_LAS unsigned char* lds = (G8_LAS unsigned char*)smem;
  const int tid = opaque_tid();
  const int wid = __builtin_amdgcn_readfirstlane(tid >> 6), lane = tid & 63, wr = wid >> 2, wc = wid & 3, fr = lane & 15, fq = lane >> 4;
  unsigned voff[2];
#pragma unroll
  for (int i = 0; i < 2; ++i) { int R, C; stage_rc(tid * 16 + i * 8192, R, C); voff[i] = (unsigned)(R * K + C) * 2u; }
  constexpr size_t kstep = (size_t)(BK * 2);
  constexpr size_t hstep = (size_t)HALF * K * 2;
  constexpr size_t tstep = 2 * hstep;
  const unsigned ldsw = (unsigned)wid * 1024u;
  const int aoff = lds_byte(wr * 64 + fr, fq * 8), boff = lds_byte(wc * 32 + fr, fq * 8);
#define G8_SA(b, h) (((b) * 2 + (h)) * HTB)
#define G8_SB(b, h) ((4 + (b) * 2 + (h)) * HTB)
#define G8_STAGE(bufoff, gbase) do { _Pragma("unroll") for (int _i = 0; _i < 2; ++_i)                                        \
    __builtin_amdgcn_global_load_lds((const unsigned*)((const char*)(gbase) + voff[_i]), (G8_LAS unsigned*)(lds + (bufoff) + ldsw + _i * 8192), 16, 0, 0); } while (0)
#define G8_LDA(dst, b, h) do { _Pragma("unroll") for (int m = 0; m < 4; ++m) _Pragma("unroll") for (int k = 0; k < 2; ++k) dst[m][k] = *(const G8_LAS bf16x8*)(lds + G8_SA(b, h) + aoff + m * 2048 + k * 1024); } while (0)
#define G8_LDB(dst, b, h) do { _Pragma("unroll") for (int n = 0; n < 2; ++n) _Pragma("unroll") for (int k = 0; k < 2; ++k) dst[n][k] = *(const G8_LAS bf16x8*)(lds + G8_SB(b, h) + boff + n * 2048 + k * 1024); } while (0)
#define G8_MMA(ai, bj, At_, Bt_) do { __builtin_amdgcn_s_setprio(1);                                                          \
    _Pragma("unroll") for (int m = 0; m < 4; ++m) _Pragma("unroll") for (int n = 0; n < 2; ++n) _Pragma("unroll") for (int k = 0; k < 2; ++k) \
      acc[ai][bj][m][n] = __builtin_amdgcn_mfma_f32_16x16x32_bf16(Bt_[n][k], At_[m][k], acc[ai][bj][m][n], 0, 0, 0);          \
    __builtin_amdgcn_s_setprio(0); } while (0)
#define G8_WAIT_V(n) asm volatile("s_waitcnt vmcnt(" #n ")" ::: "memory")
#define G8_WAIT_L(n) asm volatile("s_waitcnt lgkmcnt(" #n ")" ::: "memory")
#define G8_BAR __builtin_amdgcn_s_barrier()
#define G8_SCHED __builtin_amdgcn_sched_barrier(0)
  const int nM = M / BM, nN = N / BM, G = gridDim.x, cu = opaque_bid();
  int cpm, cpn, npm = 0, npn = 0, ui = 0;
  __syncthreads();
  if (g8_next(0, nM, nN, G, cu, cpm, cpn)) {
    f32x4 acc[2][2][4][2];
#pragma unroll
    for (int a = 0; a < 2; ++a)
#pragma unroll
      for (int b2 = 0; b2 < 2; ++b2)
#pragma unroll
        for (int m = 0; m < 4; ++m)
#pragma unroll
          for (int n = 0; n < 2; ++n) acc[a][b2][m][n] = (f32x4){0.f, 0.f, 0.f, 0.f};
    bf16x8 At[4][2], B0[2][2], B1[2][2];
    const char* cA = (const char*)A + (size_t)cpm * tstep;
    const char* cB = (const char*)Bt + (size_t)cpn * tstep;
    G8_STAGE(G8_SB(0, 0), cB); G8_STAGE(G8_SA(0, 0), cA); G8_STAGE(G8_SB(0, 1), cB + hstep); G8_STAGE(G8_SA(0, 1), cA + hstep);
    if (wr == 1) G8_BAR;
    G8_WAIT_V(4); G8_BAR;
    G8_STAGE(G8_SB(1, 0), cB + kstep); G8_STAGE(G8_SA(1, 0), cA + kstep); G8_STAGE(G8_SB(1, 1), cB + hstep + kstep);
    G8_WAIT_V(6); G8_BAR;
    for (;;) {
      const bool has_next = g8_next(ui + 1, nM, nN, G, cu, npm, npn);
      const char* nA = has_next ? (const char*)A + (size_t)npm * tstep : cA;
      const char* nB = has_next ? (const char*)Bt + (size_t)npn * tstep : cB;
#pragma unroll 1
      for (int t = 0; t < nt; t += 2) {
        const bool last = (t == nt - 2);
        const char* a1 = cA + (size_t)(t + 1) * kstep;
        const char* a2 = last ? nA : cA + (size_t)(t + 2) * kstep; const char* b2 = last ? nB : cB + (size_t)(t + 2) * kstep;
        const char* a3 = a2 + kstep; const char* b3 = b2 + kstep;
        G8_LDB(B0, 0, 0); G8_SCHED; G8_LDA(At, 0, 0); G8_STAGE(G8_SA(1, 1), a1 + hstep);
        G8_WAIT_L(8); G8_BAR; G8_WAIT_L(0); G8_MMA(0, 0, At, B0); G8_BAR; G8_SCHED;
        G8_LDB(B1, 0, 1); G8_STAGE(G8_SB(0, 0), b2);
        G8_BAR; G8_WAIT_L(0); G8_MMA(0, 1, At, B1); G8_BAR;
        G8_LDA(At, 0, 1); G8_STAGE(G8_SA(0, 0), a2);
        G8_BAR; G8_WAIT_L(0); G8_MMA(1, 0, At, B0); G8_BAR; G8_SCHED;
        G8_STAGE(G8_SB(0, 1), b2 + hstep);
        G8_WAIT_V(6); G8_BAR; G8_MMA(1, 1, At, B1); G8_BAR;
        G8_LDB(B0, 1, 0); G8_SCHED; G8_LDA(At, 1, 0); G8_STAGE(G8_SA(0, 1), a2 + hstep);
        G8_WAIT_L(8); G8_BAR; G8_WAIT_L(0); G8_MMA(0, 0, At, B0); G8_BAR; G8_SCHED;
        G8_LDB(B1, 1, 1); G8_STAGE(G8_SB(1, 0), b3);
        G8_BAR; G8_WAIT_L(0); G8_MMA(0, 1, At, B1); G8_BAR;
        G8_LDA(At, 1, 1); G8_STAGE(G8_SA(1, 0), a3);
        G8_BAR; G8_WAIT_L(0); G8_MMA(1, 0, At, B0); G8_BAR; G8_SCHED;
        G8_STAGE(G8_SB(1, 1), b3 + hstep);
        G8_WAIT_V(6); G8_BAR; G8_MMA(1, 1, At, B1); G8_BAR;
      }
      {
        const int brow = cpm * BM, bcol = cpn * BM;
        if constexpr (EPI == EPI_INPROJ) {
          if (bcol == C_DFK) {
#pragma unroll
            for (int bj = 0; bj < 2; ++bj) {
              float mx = 0.f;
#pragma unroll
              for (int ai = 0; ai < 2; ++ai)
#pragma unroll
                for (int m = 0; m < 4; ++m) {
                  float s = 0.f;
#pragma unroll
                  for (int n = 0; n < 2; ++n)
#pragma unroll
                    for (int j = 0; j < 4; ++j) s = fmaf(acc[ai][bj][m][n][j], acc[ai][bj][m][n][j], s);
                  s += __shfl_xor(s, 16); s += __shfl_xor(s, 32);
                  mx = fmaxf(mx, s);
                }
#pragma unroll
              for (int o = 1; o < 16; o <<= 1) mx = fmaxf(mx, __shfl_xor(mx, o));
              if (lane == 0) {
                const int bb = brow < NLAT ? (brow >> 12) : ((brow - NLAT) >> 8);
                unsigned* km = (unsigned*)(p.ws + OFF_MISC) + 64 + layer * 64 + (bb * 4 + bj * 2 + (wc >> 1)) * 2 + (wc & 1);
                atomicMax(km, __float_as_uint(mx));
              }
            }
          }
        }
#pragma unroll
        for (int ai = 0; ai < 2; ++ai)
#pragma unroll
          for (int bj = 0; bj < 2; ++bj)
#pragma unroll
            for (int m = 0; m < 4; ++m)
#pragma unroll
              for (int n = 0; n < 2; ++n)
                epi_store4<EPI>(p, layer, brow + ai * HALF + wr * 64 + m * 16 + fr, bcol + bj * HALF + wc * 32 + n * 16 + fq * 4,
                                acc[ai][bj][m][n][0], acc[ai][bj][m][n][1], acc[ai][bj][m][n][2], acc[ai][bj][m][n][3], xin_lat);
      }
      if (!has_next) break;
#pragma unroll
      for (int a = 0; a < 2; ++a)
#pragma unroll
        for (int b2 = 0; b2 < 2; ++b2)
#pragma unroll
          for (int m = 0; m < 4; ++m)
#pragma unroll
            for (int n = 0; n < 2; ++n) acc[a][b2][m][n] = (f32x4){0.f, 0.f, 0.f, 0.f};
      cpm = npm; cpn = npn; cA = nA; cB = nB; ++ui;
    }
    G8_WAIT_V(0);
    if (wr == 0) G8_BAR;
    G8_BAR;
  }
}

__device__ __forceinline__ unsigned cvt_pk_bf16(float lo, float hi) {
  unsigned r;
  asm volatile("v_cvt_pk_bf16_f32 %0, %1, %2" : "=v"(r) : "v"(lo), "v"(hi));
  return r;
}
__device__ __forceinline__ void vt_store8(bf16_t* vt, int stride, int d0, int key, uint4 uv) {
  bf16_t* vd = vt + d0 * stride + key;
  vd[0 * stride] = (bf16_t)(uv.x & 0xffffu); vd[1 * stride] = (bf16_t)(uv.x >> 16);
  vd[2 * stride] = (bf16_t)(uv.y & 0xffffu); vd[3 * stride] = (bf16_t)(uv.y >> 16);
  vd[4 * stride] = (bf16_t)(uv.z & 0xffffu); vd[5 * stride] = (bf16_t)(uv.z >> 16);
  vd[6 * stride] = (bf16_t)(uv.w & 0xffffu); vd[7 * stride] = (bf16_t)(uv.w >> 16);
}

constexpr int DKS = 72;
__device__ __forceinline__ void diff_item(const Params& p, int layer, bool ctxq, int item, char* smem) {
  const bf16_t* P = (const bf16_t*)(p.ws + OFF_P);
  bf16_t* Y = (bf16_t*)(p.ws + OFF_ACT);
  const float* misc = (const float*)(p.ws + OFF_MISC);
  const float lam = misc[layer], lam_init = misc[2 + layer];
  const int tid = opaque_tid(), lane = tid & 63, wave = tid >> 6, lr = lane & 15, lq = lane >> 4;
  int b, h, mbase, nkeys;
  if (!ctxq) { b = item >> 6; h = (item >> 4) & 3; mbase = b * 4096 + (item & 15) * 256; nkeys = 256 + 4096; }
  else { b = item >> 2; h = item & 3; mbase = NLAT + b * 256; nkeys = 256; }
  const float kmax0 = sqrtf(misc[64 + layer * 64 + (b * 4 + h) * 2 + 0]), kmax1 = sqrtf(misc[64 + layer * 64 + (b * 4 + h) * 2 + 1]);
  bf16x8 qf[2][2];
  f32x4 C0[2], C1[2];
#pragma unroll
  for (int qt = 0; qt < 2; ++qt) {
    const bf16_t* qr = P + (size_t)(mbase + wave * 32 + qt * 16 + lr) * INC + C_DFQ + h * 64 + lq * 8;
    const uint4 u0 = *(const uint4*)(qr), u1 = *(const uint4*)(qr + 32);
    float s0 = 0.f, s1 = 0.f;
    { float t[8]; UNPACK8(t, 0, u0) _Pragma("unroll") for (int i = 0; i < 8; ++i) s0 = fmaf(t[i], t[i], s0); }
    { float t[8]; UNPACK8(t, 0, u1) _Pragma("unroll") for (int i = 0; i < 8; ++i) s1 = fmaf(t[i], t[i], s1); }
    s0 += __shfl_xor(s0, 16); s0 += __shfl_xor(s0, 32);
    s1 += __shfl_xor(s1, 16); s1 += __shfl_xor(s1, 32);
    const float nm0 = -sqrtf(s0) * kmax0, nm1 = -sqrtf(s1) * kmax1;
    C0[qt] = (f32x4){nm0, nm0, nm0, nm0};
    C1[qt] = (f32x4){nm1, nm1, nm1, nm1};
    union { uint4 u; bf16x8 v; } c0, c1; c0.u = u0; c1.u = u1;
    qf[qt][0] = c0.v; qf[qt][1] = c1.v;
  }
  f32x4 O0[2][4], O1[2][4];
#pragma unroll
  for (int qt = 0; qt < 2; ++qt)
#pragma unroll
    for (int i = 0; i < 4; ++i) { O0[qt][i] = (f32x4){0.f, 0.f, 0.f, 0.f}; O1[qt][i] = (f32x4){0.f, 0.f, 0.f, 0.f}; }
  float l0[2] = {0.f, 0.f}, l1[2] = {0.f, 0.f};
  const int lkey = tid >> 3, lch = tid & 7;
  constexpr int DBUF = 2 * 128 * DKS * 2;
  uint4 ukA0, ukA1, uvA0, uvA1, ukB0, ukB1, uvB0, uvB1;
#define DF_GLOAD1(UK, UV, T, I)                                                                     \
  {                                                                                                 \
    const int kk = (T) * 128 + (I) * 64 + lkey;                                                     \
    const size_t row = kk < 256 ? (size_t)(NLAT + b * 256 + kk) : (size_t)(b * 4096 + kk - 256);    \
    UK = *(const uint4*)(P + row * INC + C_DFK + h * 64 + lch * 8);                                 \
    UV = *(const uint4*)(P + row * INC + C_DFV + h * 64 + lch * 8);                                 \
  }
#define DF_LSTORE1(UK, UV, BUF, I)                                                                  \
  {                                                                                                 \
    bf16_t* Ks_ = (bf16_t*)(smem + (BUF) * DBUF) + (I) * 64 * DKS;                                  \
    bf16_t* Vt_ = (bf16_t*)(smem + (BUF) * DBUF) + 128 * DKS + (I) * 64 * DKS;                      \
    *(uint4*)(Ks_ + lkey * DKS + lch * 8) = UK;                                                     \
    vt_store8(Vt_, DKS, lch * 8, lkey, UV);                                                         \
  }
#define DF_GLOAD(S, T) DF_GLOAD1(uk##S##0, uv##S##0, T, 0) DF_GLOAD1(uk##S##1, uv##S##1, T, 1)
#define DF_LSTORE(S, BUF) DF_LSTORE1(uk##S##0, uv##S##0, BUF, 0) DF_LSTORE1(uk##S##1, uv##S##1, BUF, 1)
  const int ntile = nkeys >> 7;
  __syncthreads();
  DF_GLOAD(A, 0)
  DF_LSTORE(A, 0)
  ukB0 = ukA0; ukB1 = ukA1; uvB0 = uvA0; uvB1 = uvA1;
  if (ntile > 1) { DF_GLOAD(A, 1) }
  if (ntile > 2) { DF_GLOAD(B, 2) }
  __syncthreads();
#pragma unroll 1
  for (int t = 0; t < ntile; ++t) {
    const int cur = t & 1;
#pragma unroll 1
    for (int sub = 0; sub < 2; ++sub) {
    const bf16_t* Ks = (const bf16_t*)(smem + cur * DBUF) + sub * 64 * DKS;
    const bf16_t* Vt = (const bf16_t*)(smem + cur * DBUF) + 128 * DKS + sub * 64 * DKS;
    union PF { unsigned u[4]; bf16x8 v; };
    PF pf0[2][2], pf1[2][2];
#pragma unroll
    for (int c = 0; c < 2; ++c) {
      f32x4 S[2][4];
#pragma unroll
      for (int kt = 0; kt < 4; ++kt) {
        const bf16x8 kf = *(const bf16x8*)(Ks + (kt * 16 + lr) * DKS + c * 32 + lq * 8);
#pragma unroll
        for (int qt = 0; qt < 2; ++qt) S[qt][kt] = __builtin_amdgcn_mfma_f32_16x16x32_bf16(kf, qf[qt][c], c == 0 ? C0[qt] : C1[qt], 0, 0, 0);
      }
#pragma unroll
      for (int qt = 0; qt < 2; ++qt) {
        float ps = 0.f;
#pragma unroll
        for (int kt = 0; kt < 4; ++kt) {
#pragma unroll
          for (int r = 0; r < 4; ++r) { S[qt][kt][r] = __builtin_amdgcn_exp2f(S[qt][kt][r]); ps += S[qt][kt][r]; }
        }
        if (c == 0) l0[qt] += ps; else l1[qt] += ps;
#pragma unroll
        for (int g = 0; g < 2; ++g) {
          PF t;
          t.u[0] = cvt_pk_bf16(S[qt][2 * g][0], S[qt][2 * g][1]); t.u[1] = cvt_pk_bf16(S[qt][2 * g][2], S[qt][2 * g][3]);
          t.u[2] = cvt_pk_bf16(S[qt][2 * g + 1][0], S[qt][2 * g + 1][1]); t.u[3] = cvt_pk_bf16(S[qt][2 * g + 1][2], S[qt][2 * g + 1][3]);
          if (c == 0) pf0[qt][g] = t; else pf1[qt][g] = t;
        }
      }
    }
#pragma unroll
    for (int g = 0; g < 2; ++g) {
#pragma unroll
      for (int dt = 0; dt < 4; ++dt) {
        union { uint2 h2[2]; bf16x8 v; } vf;
        vf.h2[0] = *(const uint2*)(Vt + (dt * 16 + lr) * DKS + 32 * g + 4 * lq);
        vf.h2[1] = *(const uint2*)(Vt + (dt * 16 + lr) * DKS + 32 * g + 16 + 4 * lq);
#pragma unroll
        for (int qt = 0; qt < 2; ++qt) {
          O0[qt][dt] = __builtin_amdgcn_mfma_f32_16x16x32_bf16(vf.v, pf0[qt][g].v, O0[qt][dt], 0, 0, 0);
          O1[qt][dt] = __builtin_amdgcn_mfma_f32_16x16x32_bf16(vf.v, pf1[qt][g].v, O1[qt][dt], 0, 0, 0);
        }
      }
    }
    }
    if (t + 1 < ntile) { DF_LSTORE(A, cur ^ 1) }
    ukA0 = ukB0; ukA1 = ukB1; uvA0 = uvB0; uvA1 = uvB1;
    if (t + 3 < ntile) { DF_GLOAD(B, t + 3) }
    __syncthreads();
  }
  const float* sg = p.diff_subln_g + layer * 64;
#pragma unroll
  for (int qt = 0; qt < 2; ++qt) {
    float a0 = l0[qt], a1 = l1[qt];
    a0 += __shfl_xor(a0, 16); a0 += __shfl_xor(a0, 32);
    a1 += __shfl_xor(a1, 16); a1 += __shfl_xor(a1, 32);
    const float i0 = 1.f / a0, i1 = lam / a1;
    float ss = 0.f;
#pragma unroll
    for (int dt = 0; dt < 4; ++dt) {
#pragma unroll
      for (int r = 0; r < 4; ++r) { const float v = O0[qt][dt][r] * i0 - O1[qt][dt][r] * i1; O0[qt][dt][r] = v; ss = fmaf(v, v, ss); }
    }
    ss += __shfl_xor(ss, 16); ss += __shfl_xor(ss, 32);
    const float rr = rsqrtf(ss * (1.f / 64.f) + EPS) * (1.f - lam_init);
    bf16_t* dst = Y + (size_t)(mbase + wave * 32 + qt * 16 + lr) * 1024 + Y_DF + h * 64;
#pragma unroll
    for (int dt = 0; dt < 4; ++dt) {
      const int d = dt * 16 + 4 * lq;
      const float4 g4 = *(const float4*)(sg + d);
      uint2 ov;
      ov.x = pack2(O0[qt][dt][0] * rr * g4.x, O0[qt][dt][1] * rr * g4.y);
      ov.y = pack2(O0[qt][dt][2] * rr * g4.z, O0[qt][dt][3] * rr * g4.w);
      *(uint2*)(dst + d) = ov;
    }
  }
}

constexpr int NA_WS = 520;
constexpr int NA_CS = 264;
constexpr int NA_OFF_VTW = 0;
constexpr int NA_OFF_VTC = 64 * NA_WS * 2;
constexpr int NA_OFF_RPB = NA_OFF_VTC + 64 * NA_CS * 2;
constexpr int NA_OFF_MRG = NA_OFF_RPB + 2048;

#define NA_STEP(KPTR_EXPR, BIAS_EXPR, VT_PTR, VT_STRIDE, VT_KEY0_EXPR)                                           \
  {                                                                                                               \
    f32x4 S[4];                                                                                                   \
    _Pragma("unroll") for (int kt = 0; kt < 4; ++kt) {                                                            \
      const bf16_t* kp = (KPTR_EXPR);                                                                             \
      const bf16x8 ka = *(const bf16x8*)(kp + lq * 8);                                                            \
      const bf16x8 kb = *(const bf16x8*)(kp + 32 + lq * 8);                                                       \
      f32x4 a = __builtin_amdgcn_mfma_f32_16x16x32_bf16(ka, qf[0], (f32x4){0.f, 0.f, 0.f, 0.f}, 0, 0, 0);         \
      S[kt] = __builtin_amdgcn_mfma_f32_16x16x32_bf16(kb, qf[1], a, 0, 0, 0);                                      \
    }                                                                                                             \
    _Pragma("unroll") for (int kt = 0; kt < 4; ++kt) {                                                            \
      _Pragma("unroll") for (int r = 0; r < 4; ++r) { S[kt][r] += (BIAS_EXPR); }                                  \
    }                                                                                                             \
    float x = fmaxf(fmaxf(S[0][0], S[0][1]), fmaxf(S[0][2], S[0][3]));                                            \
    _Pragma("unroll") for (int kt = 1; kt < 4; ++kt) x = fmaxf(x, fmaxf(fmaxf(S[kt][0], S[kt][1]), fmaxf(S[kt][2], S[kt][3]))); \
    x = fmaxf(x, __shfl_xor(x, 16)); x = fmaxf(x, __shfl_xor(x, 32));                                             \
    const float mn = fmaxf(mrun, x);                                                                              \
    const float al = __builtin_amdgcn_exp2f(mrun - mn);                                                           \
    mrun = mn;                                                                                                    \
    float ps = 0.f;                                                                                               \
    _Pragma("unroll") for (int kt = 0; kt < 4; ++kt) {                                                            \
      _Pragma("unroll") for (int r = 0; r < 4; ++r) { S[kt][r] = __builtin_amdgcn_exp2f(S[kt][r] - mn); ps += S[kt][r]; } \
    }                                                                                                             \
    lrun = lrun * al + ps;                                                                                        \
    _Pragma("unroll") for (int dt = 0; dt < 4; ++dt) {                                                            \
      _Pragma("unroll") for (int r = 0; r < 4; ++r) O[dt][r] *= al;                                               \
    }                                                                                                             \
    _Pragma("unroll") for (int g = 0; g < 2; ++g) {                                                               \
      union { unsigned u[4]; bf16x8 v; } pf;                                                                      \
      pf.u[0] = cvt_pk_bf16(S[2 * g][0], S[2 * g][1]); pf.u[1] = cvt_pk_bf16(S[2 * g][2], S[2 * g][3]);           \
      pf.u[2] = cvt_pk_bf16(S[2 * g + 1][0], S[2 * g + 1][1]); pf.u[3] = cvt_pk_bf16(S[2 * g + 1][2], S[2 * g + 1][3]); \
      const int vk0 = (VT_KEY0_EXPR);                                                                             \
      _Pragma("unroll") for (int dt = 0; dt < 4; ++dt) {                                                          \
        union { uint2 h2[2]; bf16x8 v; } vf;                                                                      \
        vf.h2[0] = *(const uint2*)((VT_PTR) + (dt * 16 + lr) * (VT_STRIDE) + vk0 + 4 * lq);                       \
        vf.h2[1] = *(const uint2*)((VT_PTR) + (dt * 16 + lr) * (VT_STRIDE) + vk0 + 16 + 4 * lq);                  \
        O[dt] = __builtin_amdgcn_mfma_f32_16x16x32_bf16(vf.v, pf.v, O[dt], 0, 0, 0);                              \
      }                                                                                                           \
    }                                                                                                             \
  }

__device__ __forceinline__ void na_latent_item(const Params& p, int layer, int item, char* smem) {
  const bf16_t* P = (const bf16_t*)(p.ws + OFF_P);
  bf16_t* Y = (bf16_t*)(p.ws + OFF_ACT);
  const int b = item >> 8, h = (item >> 6) & 3, grow = item & 63;
  const int tid = opaque_tid(), lane = tid & 63, wave = tid >> 6, lr = lane & 15, lq = lane >> 4;
  const int jt = wave & 3, half = wave >> 2;
  bf16_t* VtW = (bf16_t*)(smem + NA_OFF_VTW);
  bf16_t* VtC = (bf16_t*)(smem + NA_OFF_VTC);
  float* RPB = (float*)(smem + NA_OFF_RPB);
  float* MRG = (float*)(smem + NA_OFF_MRG);
  const int rs = min(max(grow - 4, 0), 56);
  __syncthreads();
  {
    const int ch = tid & 7;
#pragma unroll
    for (int i = 0; i < 8; ++i) {
      const int key = (tid >> 3) + 64 * i;
      const uint4 uv = *(const uint4*)(P + (size_t)(b * 4096 + (rs + (key >> 6)) * 64 + (key & 63)) * INC + C_NAV + h * 64 + ch * 8);
      vt_store8(VtW, NA_WS, ch * 8, key, uv);
    }
#pragma unroll
    for (int i = 0; i < 4; ++i) {
      const int key = (tid >> 3) + 64 * i;
      const uint4 uv = *(const uint4*)(P + (size_t)(NLAT + b * 256 + key) * INC + C_NAV + h * 64 + ch * 8);
      vt_store8(VtC, NA_CS, ch * 8, key, uv);
    }
    if (tid < 465) RPB[tid] = p.na_rpb[(size_t)(layer * 4 + h) * 465 + tid] * 1.4426950408889634f;
  }
  const int qc = jt * 16 + lr;
  const int mq = b * 4096 + grow * 64 + qc;
  bf16x8 qf[2];
  {
    const bf16_t* qr = P + (size_t)mq * INC + C_NAQ + h * 64 + lq * 8;
    qf[0] = *(const bf16x8*)(qr);
    qf[1] = *(const bf16x8*)(qr + 32);
  }
  f32x4 O[4];
#pragma unroll
  for (int i = 0; i < 4; ++i) O[i] = (f32x4){0.f, 0.f, 0.f, 0.f};
  float mrun = -1e30f, lrun = 0.f;
  __syncthreads();
  if (half == 0) {
    const int k0 = min(max(jt * 16 - 8, 0), 32);
    const int cs = min(max(qc - 8, 0), 48);
#pragma unroll 1
    for (int s = 0; s < 4; ++s) {
      const int wr0 = 2 * s;
      NA_STEP(P + (size_t)(b * 4096 + (rs + wr0 + (kt >> 1)) * 64 + k0 + 16 * (kt & 1) + lr) * INC + C_NAK + h * 64,
              ((k0 + 16 * (kt & 1) + 4 * lq + r) >= cs && (k0 + 16 * (kt & 1) + 4 * lq + r) < cs + 16)
                  ? RPB[(rs + wr0 + (kt >> 1) - grow + 7) * 31 + (k0 + 16 * (kt & 1) + 4 * lq + r) - qc + 15] : -1e30f,
              VtW, NA_WS, (wr0 + g) * 64 + k0)
    }
  } else {
#pragma unroll 1
    for (int s = 0; s < 4; ++s) {
      NA_STEP(P + (size_t)(NLAT + b * 256 + s * 64 + kt * 16 + lr) * INC + C_NAK + h * 64, 0.f, VtC, NA_CS, s * 64 + 32 * g)
    }
  }
  lrun += __shfl_xor(lrun, 16); lrun += __shfl_xor(lrun, 32);
  float* mg = MRG + (jt * 64 + lane) * 18;
  if (half == 1) {
    mg[0] = mrun; mg[1] = lrun;
#pragma unroll
    for (int dt = 0; dt < 4; ++dt) { mg[2 + dt * 4 + 0] = O[dt][0]; mg[2 + dt * 4 + 1] = O[dt][1]; mg[2 + dt * 4 + 2] = O[dt][2]; mg[2 + dt * 4 + 3] = O[dt][3]; }
  }
  __syncthreads();
  if (half == 0) {
    const float m2 = mg[0], l2 = mg[1];
    const float M = fmaxf(mrun, m2);
    const float f1 = __builtin_amdgcn_exp2f(mrun - M), f2 = __builtin_amdgcn_exp2f(m2 - M);
    const float inv = 1.f / (lrun * f1 + l2 * f2);
    bf16_t* dst = Y + (size_t)mq * 1024 + Y_NA + h * 64;
#pragma unroll
    for (int dt = 0; dt < 4; ++dt) {
      const float o0 = (O[dt][0] * f1 + mg[2 + dt * 4 + 0] * f2) * inv, o1 = (O[dt][1] * f1 + mg[2 + dt * 4 + 1] * f2) * inv;
      const float o2 = (O[dt][2] * f1 + mg[2 + dt * 4 + 2] * f2) * inv, o3 = (O[dt][3] * f1 + mg[2 + dt * 4 + 3] * f2) * inv;
      uint2 ov; ov.x = pack2(o0, o1); ov.y = pack2(o2, o3);
      *(uint2*)(dst + dt * 16 + 4 * lq) = ov;
    }
  }
}

__device__ __forceinline__ void na_ctx_item(const Params& p, int item, char* smem) {
  const bf16_t* P = (const bf16_t*)(p.ws + OFF_P);
  bf16_t* Y = (bf16_t*)(p.ws + OFF_ACT);
  const int b = item >> 3, h = (item >> 1) & 3, qg = item & 1;
  const int tid = opaque_tid(), lane = tid & 63, wave = tid >> 6, lr = lane & 15, lq = lane >> 4;
  bf16_t* VtC = (bf16_t*)(smem + NA_OFF_VTC);
  __syncthreads();
  {
    const int ch = tid & 7;
#pragma unroll
    for (int i = 0; i < 4; ++i) {
      const int key = (tid >> 3) + 64 * i;
      const uint4 uv = *(const uint4*)(P + (size_t)(NLAT + b * 256 + key) * INC + C_NAV + h * 64 + ch * 8);
      vt_store8(VtC, NA_CS, ch * 8, key, uv);
    }
  }
  const int mq = NLAT + b * 256 + qg * 128 + wave * 16 + lr;
  bf16x8 qf[2];
  {
    const bf16_t* qr = P + (size_t)mq * INC + C_NAQ + h * 64 + lq * 8;
    qf[0] = *(const bf16x8*)(qr);
    qf[1] = *(const bf16x8*)(qr + 32);
  }
  f32x4 O[4];
#pragma unroll
  for (int i = 0; i < 4; ++i) O[i] = (f32x4){0.f, 0.f, 0.f, 0.f};
  float mrun = -1e30f, lrun = 0.f;
  __syncthreads();
#pragma unroll 1
  for (int s = 0; s < 4; ++s) {
    NA_STEP(P + (size_t)(NLAT + b * 256 + s * 64 + kt * 16 + lr) * INC + C_NAK + h * 64, 0.f, VtC, NA_CS, s * 64 + 32 * g)
  }
  lrun += __shfl_xor(lrun, 16); lrun += __shfl_xor(lrun, 32);
  const float inv = 1.f / lrun;
  bf16_t* dst = Y + (size_t)mq * 1024 + Y_NA + h * 64;
#pragma unroll
  for (int dt = 0; dt < 4; ++dt) {
    uint2 ov; ov.x = pack2(O[dt][0] * inv, O[dt][1] * inv); ov.y = pack2(O[dt][2] * inv, O[dt][3] * inv);
    *(uint2*)(dst + dt * 16 + 4 * lq) = ov;
  }
}

constexpr int KV_S = 136;
constexpr int KV_OFF_KF = 0, KV_OFF_KB = 64 * KV_S * 2, KV_OFF_VT = 2 * 64 * KV_S * 2;
__device__ __forceinline__ void ret_kv_item(const Params& p, int layer, int h, size_t row0, int cnt, float* dstF, float* dstB, char* smem) {
  const bf16_t* P = (const bf16_t*)(p.ws + OFF_P);
  const float* misc = (const float*)(p.ws + OFF_MISC);
  const float lgF2 = misc[16 + layer * 8 + 0 * 4 + h] * 1.4426950408889634f, lgB2 = misc[16 + layer * 8 + 1 * 4 + h] * 1.4426950408889634f;
  const int tid = opaque_tid(), lane = tid & 63, wave = tid >> 6, lr = lane & 15, lq = lane >> 4;
  bf16_t* KFt = (bf16_t*)(smem + KV_OFF_KF);
  bf16_t* KBt = (bf16_t*)(smem + KV_OFF_KB);
  bf16_t* Vt = (bf16_t*)(smem + KV_OFF_VT);
  const int dir = wave >> 2, dt = wave & 3;
  f32x4 acc[8];
#pragma unroll
  for (int i = 0; i < 8; ++i) acc[i] = (f32x4){0.f, 0.f, 0.f, 0.f};
#pragma unroll 1
  for (int kc = 0; kc < (cnt >> 7); ++kc) {
    __syncthreads();
    {
      const int tok = tid >> 2, c = tid & 3;
      const int j = kc * 128 + tok;
      const float wF = __builtin_amdgcn_exp2f(lgF2 * (float)(cnt - 1 - j)), wB = __builtin_amdgcn_exp2f(lgB2 * (float)j);
      const bf16_t* rowp = P + (row0 + j) * INC;
#pragma unroll
      for (int c8 = 0; c8 < 2; ++c8) {
        const uint4 u = *(const uint4*)(rowp + C_RTK + h * 64 + c * 16 + c8 * 8);
        float kv[8];
        UNPACK8(kv, 0, u)
#pragma unroll
        for (int i = 0; i < 8; ++i) {
          KFt[(c * 16 + c8 * 8 + i) * KV_S + tok] = f2bf(kv[i] * wF);
          KBt[(c * 16 + c8 * 8 + i) * KV_S + tok] = f2bf(kv[i] * wB);
        }
      }
#pragma unroll
      for (int c8 = 0; c8 < 4; ++c8) {
        const uint4 uv = *(const uint4*)(rowp + C_RTV + h * 128 + c * 32 + c8 * 8);
        vt_store8(Vt, KV_S, c * 32 + c8 * 8, tok, uv);
      }
    }
    __syncthreads();
    const bf16_t* Kt = dir == 0 ? KFt : KBt;
    bf16x8 af[4];
#pragma unroll
    for (int ks = 0; ks < 4; ++ks) af[ks] = *(const bf16x8*)(Kt + (dt * 16 + lr) * KV_S + ks * 32 + lq * 8);
#pragma unroll
    for (int et = 0; et < 8; ++et) {
#pragma unroll
      for (int ks = 0; ks < 4; ++ks) {
        const bf16x8 bfr = *(const bf16x8*)(Vt + (et * 16 + lr) * KV_S + ks * 32 + lq * 8);
        acc[et] = __builtin_amdgcn_mfma_f32_16x16x32_bf16(af[ks], bfr, acc[et], 0, 0, 0);
      }
    }
  }
  float* dst = dir == 0 ? dstF : dstB;
#pragma unroll
  for (int et = 0; et < 8; ++et) {
#pragma unroll
    for (int r = 0; r < 4; ++r) dst[(dt * 16 + 4 * lq + r) * 128 + et * 16 + lr] = acc[et][r];
  }
}

__device__ __forceinline__ void phase_ret_scan(const Params& p, int layer) {
  const float* misc = (const float*)(p.ws + OFF_MISC);
  float* rkv = (float*)(p.ws + OFF_RKV);
  const float* rs = (const float*)(p.ws + OFF_RS);
  const int gt = opaque_bid() * blockDim.x + opaque_tid(), gs = gridDim.x * blockDim.x;
  for (int idx = gt; idx < 64 * 8192; idx += gs) {
    const int seq = idx >> 13, elem = idx & 8191;
    const int dir = seq & 1, h = (seq >> 1) & 3;
    const float cdec = __expf(misc[16 + layer * 8 + dir * 4 + h] * 128.f);
    float state = rs[(size_t)seq * 8192 + elem];
    for (int s = 0; s < 32; ++s) {
      const int n = dir == 0 ? s : 31 - s;
      float* ptr = rkv + ((size_t)seq * 32 + n) * 8192 + elem;
      const float tmp = *ptr;
      *ptr = state;
      state = fmaf(cdec, state, tmp);
    }
  }
}

constexpr int RT_KS = 72, RT_VS = 136;
constexpr int RT_OFF_K = 0, RT_OFF_VT = 128 * RT_KS * 2, RT_OFF_SF = RT_OFF_VT + 128 * RT_VS * 2, RT_OFF_SB = RT_OFF_SF + 128 * RT_KS * 2;
__device__ __forceinline__ void ret_out_item(const Params& p, int layer, int h, size_t krow0, int nkc, int iq0,
                                             const float* SF, const float* SB, int clen, char* smem) {
  const bf16_t* P = (const bf16_t*)(p.ws + OFF_P);
  bf16_t* Y = (bf16_t*)(p.ws + OFF_ACT);
  const float* misc = (const float*)(p.ws + OFF_MISC);
  const float lgF2 = misc[16 + layer * 8 + 0 * 4 + h] * 1.4426950408889634f, lgB2 = misc[16 + layer * 8 + 1 * 4 + h] * 1.4426950408889634f;
  const int tid = opaque_tid(), lane = tid & 63, wave = tid >> 6, lr = lane & 15, lq = lane >> 4;
  bf16_t* Ks = (bf16_t*)(smem + RT_OFF_K);
  bf16_t* Vt = (bf16_t*)(smem + RT_OFF_VT);
  bf16_t* SFt = (bf16_t*)(smem + RT_OFF_SF);
  bf16_t* SBt = (bf16_t*)(smem + RT_OFF_SB);
  const int iq = iq0 + wave * 16 + lr;
  const size_t mq = krow0 + iq;
  bf16x8 qf[2];
  {
    const bf16_t* qr = P + mq * INC + C_RTQ + h * 64 + lq * 8;
    qf[0] = *(const bf16x8*)(qr);
    qf[1] = *(const bf16x8*)(qr + 32);
  }
  f32x4 O[8];
#pragma unroll
  for (int i = 0; i < 8; ++i) O[i] = (f32x4){0.f, 0.f, 0.f, 0.f};
  if (SF != nullptr) {
    __syncthreads();
    {
      const int d = tid >> 3, e0 = (tid & 7) * 16;
#pragma unroll
      for (int c4 = 0; c4 < 4; ++c4) {
        const float4 a = *(const float4*)(SF + d * 128 + e0 + c4 * 4);
        const float4 bb = *(const float4*)(SB + d * 128 + e0 + c4 * 4);
        SFt[(e0 + c4 * 4 + 0) * RT_KS + d] = f2bf(a.x); SFt[(e0 + c4 * 4 + 1) * RT_KS + d] = f2bf(a.y);
        SFt[(e0 + c4 * 4 + 2) * RT_KS + d] = f2bf(a.z); SFt[(e0 + c4 * 4 + 3) * RT_KS + d] = f2bf(a.w);
        SBt[(e0 + c4 * 4 + 0) * RT_KS + d] = f2bf(bb.x); SBt[(e0 + c4 * 4 + 1) * RT_KS + d] = f2bf(bb.y);
        SBt[(e0 + c4 * 4 + 2) * RT_KS + d] = f2bf(bb.z); SBt[(e0 + c4 * 4 + 3) * RT_KS + d] = f2bf(bb.w);
      }
    }
    __syncthreads();
    const float cF = __builtin_amdgcn_exp2f(lgF2 * (float)(iq + 1)), cB = __builtin_amdgcn_exp2f(lgB2 * (float)(clen - iq));
#pragma unroll
    for (int ks = 0; ks < 2; ++ks)
#pragma unroll
      for (int et = 0; et < 8; ++et) {
        const bf16x8 sf = *(const bf16x8*)(SFt + (et * 16 + lr) * RT_KS + ks * 32 + lq * 8);
        O[et] = __builtin_amdgcn_mfma_f32_16x16x32_bf16(sf, qf[ks], O[et], 0, 0, 0);
      }
    const float ratio = cF / cB;
#pragma unroll
    for (int et = 0; et < 8; ++et) { O[et][0] *= ratio; O[et][1] *= ratio; O[et][2] *= ratio; O[et][3] *= ratio; }
#pragma unroll
    for (int ks = 0; ks < 2; ++ks)
#pragma unroll
      for (int et = 0; et < 8; ++et) {
        const bf16x8 sb = *(const bf16x8*)(SBt + (et * 16 + lr) * RT_KS + ks * 32 + lq * 8);
        O[et] = __builtin_amdgcn_mfma_f32_16x16x32_bf16(sb, qf[ks], O[et], 0, 0, 0);
      }
#pragma unroll
    for (int et = 0; et < 8; ++et) { O[et][0] *= cB; O[et][1] *= cB; O[et][2] *= cB; O[et][3] *= cB; }
  }
#pragma unroll 1
  for (int kc = 0; kc < nkc; ++kc) {
    __syncthreads();
    {
      const int key = tid >> 2, c = tid & 3;
      const bf16_t* rowp = P + (krow0 + kc * 128 + key) * INC;
      const uint4 k0 = *(const uint4*)(rowp + C_RTK + h * 64 + c * 16), k1 = *(const uint4*)(rowp + C_RTK + h * 64 + c * 16 + 8);
      *(uint4*)(Ks + key * RT_KS + c * 16) = k0;
      *(uint4*)(Ks + key * RT_KS + c * 16 + 8) = k1;
#pragma unroll
      for (int c8 = 0; c8 < 4; ++c8) {
        const uint4 uv = *(const uint4*)(rowp + C_RTV + h * 128 + c * 32 + c8 * 8);
        vt_store8(Vt, RT_VS, c * 32 + c8 * 8, key, uv);
      }
    }
    __syncthreads();
    f32x4 S[8];
#pragma unroll
    for (int kt = 0; kt < 8; ++kt) {
      const bf16x8 ka = *(const bf16x8*)(Ks + (kt * 16 + lr) * RT_KS + lq * 8);
      const bf16x8 kb = *(const bf16x8*)(Ks + (kt * 16 + lr) * RT_KS + 32 + lq * 8);
      const f32x4 a = __builtin_amdgcn_mfma_f32_16x16x32_bf16(ka, qf[0], (f32x4){0.f, 0.f, 0.f, 0.f}, 0, 0, 0);
      S[kt] = __builtin_amdgcn_mfma_f32_16x16x32_bf16(kb, qf[1], a, 0, 0, 0);
    }
#pragma unroll
    for (int kt = 0; kt < 8; ++kt) {
#pragma unroll
      for (int r = 0; r < 4; ++r) {
        const int df = iq - (kc * 128 + kt * 16 + 4 * lq + r);
        const float fdf = (float)df;
        float coef = 0.f;
        if (df >= 0) coef += __builtin_amdgcn_exp2f(lgF2 * fdf);
        if (df <= 0) coef += __builtin_amdgcn_exp2f(-lgB2 * fdf);
        S[kt][r] *= coef;
      }
    }
#pragma unroll
    for (int g = 0; g < 4; ++g) {
      union { unsigned u[4]; bf16x8 v; } pf;
      pf.u[0] = cvt_pk_bf16(S[2 * g][0], S[2 * g][1]); pf.u[1] = cvt_pk_bf16(S[2 * g][2], S[2 * g][3]);
      pf.u[2] = cvt_pk_bf16(S[2 * g + 1][0], S[2 * g + 1][1]); pf.u[3] = cvt_pk_bf16(S[2 * g + 1][2], S[2 * g + 1][3]);
#pragma unroll
      for (int et = 0; et < 8; ++et) {
        union { uint2 h2[2]; bf16x8 v; } vf;
        vf.h2[0] = *(const uint2*)(Vt + (et * 16 + lr) * RT_VS + 32 * g + 4 * lq);
        vf.h2[1] = *(const uint2*)(Vt + (et * 16 + lr) * RT_VS + 32 * g + 16 + 4 * lq);
        O[et] = __builtin_amdgcn_mfma_f32_16x16x32_bf16(vf.v, pf.v, O[et], 0, 0, 0);
      }
    }
  }
  float ss = 0.f;
#pragma unroll
  for (int et = 0; et < 8; ++et) { ss = fmaf(O[et][0], O[et][0], ss); ss = fmaf(O[et][1], O[et][1], ss); ss = fmaf(O[et][2], O[et][2], ss); ss = fmaf(O[et][3], O[et][3], ss); }
  ss += __shfl_xor(ss, 16); ss += __shfl_xor(ss, 32);
  const float rr = rsqrtf(ss * (1.f / 128.f) + EPS);
  const bf16_t* gp = P + mq * INC + C_RTG + h * 128;
  bf16_t* dst = Y + mq * 1024 + Y_RT + h * 128;
#pragma unroll
  for (int et = 0; et < 8; ++et) {
    const int e = et * 16 + 4 * lq;
    const uint2 gu = *(const uint2*)(gp + e);
    uint2 ov;
    ov.x = pack2(O[et][0] * rr * siluf(lo16(gu.x)), O[et][1] * rr * siluf(hi16(gu.x)));
    ov.y = pack2(O[et][2] * rr * siluf(lo16(gu.y)), O[et][3] * rr * siluf(hi16(gu.y)));
    *(uint2*)(dst + e) = ov;
  }
}

__device__ __forceinline__ void phase_mix1(const Params& p, int layer, char* smem, int slot = 0) {
  unsigned* ctr = (unsigned*)(p.ws + OFF_CTL) + (layer * 4 + slot);
  const bool nc = layer == 0;
  const int n_dl = 512, n_dc = nc ? 32 : 0, n_nl = 2048, n_ncx = nc ? 64 : 0, n_kv = 1024, n_cs = 32;
  const int total = n_dl + n_dc + n_nl + n_ncx + n_kv + n_cs;
  float* rkv = (float*)(p.ws + OFF_RKV);
  float* rs = (float*)(p.ws + OFF_RS);
  for (;;) {
    int it = next_item(ctr, smem);
    if (it >= total) break;
    if (it < n_dl) { diff_item(p, layer, false, it, smem); continue; } it -= n_dl;
    if (it < n_dc) { diff_item(p, layer, true, it, smem); continue; } it -= n_dc;
    if (it < n_nl) { na_latent_item(p, layer, it, smem); continue; } it -= n_nl;
    if (it < n_ncx) { na_ctx_item(p, it, smem); continue; } it -= n_ncx;
    if (it < n_kv) {
      const int bh = it >> 5, n = it & 31, b = bh >> 2, h = bh & 3;
      ret_kv_item(p, layer, h, (size_t)b * 4096 + n * 128, 128,
                  rkv + ((size_t)(bh * 2 + 0) * 32 + n) * 8192, rkv + ((size_t)(bh * 2 + 1) * 32 + n) * 8192, smem);
      continue;
    }
    it -= n_kv;
    {
      const int bh = it, b = bh >> 2, h = bh & 3;
      ret_kv_item(p, layer, h, (size_t)NLAT + b * 256, 256, rs + (size_t)(bh * 2 + 0) * 8192, rs + (size_t)(bh * 2 + 1) * 8192, smem);
    }
  }
}

__device__ __forceinline__ void phase_mix2(const Params& p, int layer, char* smem, int slot = 1) {
  unsigned* ctr = (unsigned*)(p.ws + OFF_CTL) + (layer * 4 + slot);
  const int n_l = 1024, n_c = layer == 0 ? 64 : 0;
  const float* rkv = (const float*)(p.ws + OFF_RKV);
  for (;;) {
    int it = next_item(ctr, smem);
    if (it >= n_l + n_c) break;
    if (it < n_l) {
      const int bh = it >> 5, n = it & 31, b = bh >> 2, h = bh & 3;
      ret_out_item(p, layer, h, (size_t)b * 4096 + n * 128, 1, 0,
                   rkv + ((size_t)(bh * 2 + 0) * 32 + n) * 8192, rkv + ((size_t)(bh * 2 + 1) * 32 + n) * 8192, 128, smem);
    } else {
      it -= n_l;
      const int bh = it >> 1, half = it & 1, b = bh >> 2, h = bh & 3;
      ret_out_item(p, layer, h, (size_t)NLAT + b * 256, 2, half * 128, nullptr, nullptr, 256, smem);
    }
  }
}

typedef float f32x2 __attribute__((ext_vector_type(2)));
__device__ __forceinline__ unsigned sortable_key(float f, int idx) {
  const unsigned b = __float_as_uint(f);
  const unsigned k = b ^ ((unsigned)((int)b >> 31) | 0x80000000u);
  return (k & ~127u) | (unsigned)(127 - idx);
}
__device__ __forceinline__ float key_value(unsigned k) {
  k &= ~127u;
  const unsigned b = (k & 0x80000000u) ? (k ^ 0x80000000u) : ~k;
  return __uint_as_float(b);
}
#define FP8DOT(acc, H, off, W) { const f32x2 _a = __builtin_amdgcn_cvt_pk_f32_fp8((int)(W), false), _b = __builtin_amdgcn_cvt_pk_f32_fp8((int)(W), true); \
  acc = fmaf(H[(off) + 0], _a.x, acc); acc = fmaf(H[(off) + 1], _a.y, acc); acc = fmaf(H[(off) + 2], _b.x, acc); acc = fmaf(H[(off) + 3], _b.y, acc); }
#define FP8AXPY(O, off, P, W) { const f32x2 _a = __builtin_amdgcn_cvt_pk_f32_fp8((int)(W), false), _b = __builtin_amdgcn_cvt_pk_f32_fp8((int)(W), true); \
  O[(off) + 0] = fmaf(P, _a.x, O[(off) + 0]); O[(off) + 1] = fmaf(P, _a.y, O[(off) + 1]); O[(off) + 2] = fmaf(P, _b.x, O[(off) + 2]); O[(off) + 3] = fmaf(P, _b.y, O[(off) + 3]); }

__device__ __forceinline__ float gelu_erf(float a) {
  const float x = fabsf(a) * 0.70710678118654752f;
  const float t = __builtin_amdgcn_rcpf(fmaf(0.3275911f, x, 1.f));
  float pl = fmaf(1.061405429f, t, -1.453152027f);
  pl = fmaf(pl, t, 1.421413741f); pl = fmaf(pl, t, -0.284496736f); pl = fmaf(pl, t, 0.254829592f);
  const float y = 1.f - pl * t * __builtin_amdgcn_exp2f(-x * x * 1.4426950408889634f);
  const float er = a < 0.f ? -y : y;
  return 0.5f * a * (1.f + er);
}
constexpr int PE_SVS = 132;
constexpr int PE_OFF_SV = 0;
constexpr int PE_OFF_TV = 4 * 16 * PE_SVS * 4;
constexpr int PE_OFF_TI = PE_OFF_TV + 16 * 16 * 16 * 4;
constexpr int PE_OFF_EX = PE_OFF_TI + 16 * 16 * 16 * 4;
constexpr int PE_OFF_GT = PE_OFF_EX + 2 * 16 * 128 * 4;
constexpr int PE_OFF_SU = PE_OFF_GT + 2 * 16 * 128 * 4;
constexpr int PE_OFF_CN = PE_OFF_SU + 2 * 16 * 128 * 4;
#define WAVE_LDS_FENCE() asm volatile("s_waitcnt lgkmcnt(0)" ::: "memory")

__device__ __forceinline__ void peer_select_head(const Params& p, int layer, char* smem, int tok0, int hd, int sw, int buf,
                                                 int lane, int cand_a, int cand_b) {
  const bf16_t* Q = (const bf16_t*)(p.ws + OFF_P);
  const bf16_t* SK = (const bf16_t*)(p.ws + OFF_SUBK) + (size_t)layer * 262144;
  const int lr = lane & 15, lq = lane >> 4;
  unsigned* SV = (unsigned*)(smem + PE_OFF_SV) + sw * 16 * PE_SVS;
  float* TV = (float*)(smem + PE_OFF_TV);
  int* TI = (int*)(smem + PE_OFF_TI);
  int* EX = (int*)(smem + PE_OFF_EX) + buf * 16 * 128;
  float* GT = (float*)(smem + PE_OFF_GT) + buf * 16 * 128;
  int* CN = (int*)(smem + PE_OFF_CN) + sw * 16;
  float* SU = (float*)(smem + PE_OFF_SU) + buf * 16 * 128;
  const float* USC = (const float*)(p.ws + OFF_USC) + layer * NEXP;
  const float* VSC = (const float*)(p.ws + OFF_VSC) + layer * NEXP;
#pragma unroll 1
  for (int pp = 0; pp < 2; ++pp) {
    bf16x8 af[4];
    const bf16_t* qrow = Q + (size_t)(tok0 + lr) * 2048 + hd * 256 + pp * 128;
#pragma unroll
    for (int ks = 0; ks < 4; ++ks) af[ks] = *(const bf16x8*)(qrow + ks * 32 + lq * 8);
    const bf16_t* skb = SK + (size_t)((hd * 2 + pp) * 128) * 128;
    f32x4 acc[8];
    {
      bf16x8 bfr[8][4];
#pragma unroll
      for (int nt = 0; nt < 8; ++nt)
#pragma unroll
        for (int ks = 0; ks < 4; ++ks)
          bfr[nt][ks] = *(const bf16x8*)(skb + (size_t)(nt * 16 + lr) * 128 + ks * 32 + lq * 8);
#pragma unroll
      for (int nt = 0; nt < 8; ++nt) {
        f32x4 a = (f32x4){0.f, 0.f, 0.f, 0.f};
#pragma unroll
        for (int ks = 0; ks < 4; ++ks) a = __builtin_amdgcn_mfma_f32_16x16x32_bf16(af[ks], bfr[nt][ks], a, 0, 0, 0);
        acc[nt] = a;
      }
    }
#pragma unroll
    for (int r = 0; r < 4; ++r) {
      const int tk = 4 * lq + r;
      unsigned k[8];
#pragma unroll
      for (int nt = 0; nt < 8; ++nt) k[nt] = sortable_key(acc[nt][r], nt * 16 + lr);
      unsigned gm = k[0];
#pragma unroll
      for (int nt = 1; nt < 8; ++nt) gm = max(gm, k[nt]);
      unsigned T = gm;
      T = min(T, (unsigned)__shfl_xor((int)T, 1)); T = min(T, (unsigned)__shfl_xor((int)T, 2));
      T = min(T, (unsigned)__shfl_xor((int)T, 4)); T = min(T, (unsigned)__shfl_xor((int)T, 8));
      int pos = 0;
#pragma unroll
      for (int nt = 0; nt < 8; ++nt) {
        const bool sel = k[nt] >= T;
        const unsigned long long bal = __ballot(sel);
        const unsigned grp16 = (unsigned)(bal >> (16 * lq)) & 0xffffu;
        const int below = __popc(grp16 & ((1u << lr) - 1u));
        if (sel) SV[tk * PE_SVS + pos + below] = k[nt];
        pos += __popc(grp16);
      }
      if (lr == 0) {
        CN[tk] = pos;
        SV[tk * PE_SVS + pos + 0] = 0u; SV[tk * PE_SVS + pos + 1] = 0u; SV[tk * PE_SVS + pos + 2] = 0u; SV[tk * PE_SVS + pos + 3] = 0u;
      }
    }
    WAVE_LDS_FENCE();
#pragma unroll 1
    for (int pass = 0; pass < 4; ++pass) {
      const int tk = pass * 4 + lq;
      const int cnt = CN[tk];
      const unsigned* row = SV + tk * PE_SVS;
      const int n4 = (cnt + 3) >> 2;
#pragma unroll 1
      for (int base = 0; base < cnt; base += 16) {
        const int j = base + lr;
        const unsigned my = j < cnt ? row[j] : 0xffffffffu;
        int rank = 0;
#pragma unroll 4
        for (int i4 = 0; i4 < n4; ++i4) {
          const uint4 v = *(const uint4*)(row + i4 * 4);
          rank += (v.x > my) ? 1 : 0; rank += (v.y > my) ? 1 : 0; rank += (v.z > my) ? 1 : 0; rank += (v.w > my) ? 1 : 0;
        }
        if (j < cnt && rank < 16) {
          TV[(tk * 16 + hd * 2 + pp) * 16 + rank] = key_value(my);
          TI[(tk * 16 + hd * 2 + pp) * 16 + rank] = 127 - (int)(my & 127u);
        }
      }
    }
    WAVE_LDS_FENCE();
  }
  {
    unsigned* CWt = SV;
    float vals[16];
#pragma unroll
    for (int tk = 0; tk < 16; ++tk) {
      float val = 0.f;
      unsigned key = 0u;
      if (cand_a >= 0) {
        val = TV[(tk * 16 + hd * 2 + 0) * 16 + cand_a] + TV[(tk * 16 + hd * 2 + 1) * 16 + cand_b];
        const unsigned bb = __float_as_uint(val);
        key = ((bb ^ ((unsigned)((int)bb >> 31) | 0x80000000u)) & ~63u) | (unsigned)(63 - lane);
      }
      vals[tk] = val;
      CWt[tk * 64 + lane] = key;
    }
    WAVE_LDS_FENCE();
#pragma unroll
    for (int tk = 0; tk < 16; ++tk) {
      const unsigned key = CWt[tk * 64 + lane];
      int rank = 0;
#pragma unroll
      for (int i4 = 0; i4 < 13; ++i4) {
        const uint4 v = *(const uint4*)(CWt + tk * 64 + i4 * 4);
        rank += (v.x > key) ? 1 : 0; rank += (v.y > key) ? 1 : 0; rank += (v.z > key) ? 1 : 0; rank += (v.w > key) ? 1 : 0;
      }
      if (cand_a >= 0 && rank < 16) {
        GT[tk * 128 + hd * 16 + rank] = vals[tk];
        EX[tk * 128 + hd * 16 + rank] = TI[(tk * 16 + hd * 2 + 0) * 16 + cand_a] * 128 + TI[(tk * 16 + hd * 2 + 1) * 16 + cand_b];
      }
    }
    WAVE_LDS_FENCE();
#pragma unroll
    for (int pass = 0; pass < 4; ++pass) {
      const int tk = pass * 4 + lq;
      const float g = GT[tk * 128 + hd * 16 + lr];
      const float mx = GT[tk * 128 + hd * 16];
      const float ev = __expf(g - mx);
      float s = ev;
      s += __shfl_xor(s, 1); s += __shfl_xor(s, 2); s += __shfl_xor(s, 4); s += __shfl_xor(s, 8);
      const int ex = EX[tk * 128 + hd * 16 + lr];
      GT[tk * 128 + hd * 16 + lr] = (ev / s) * VSC[ex];
      SU[tk * 128 + hd * 16 + lr] = USC[ex];
    }
    WAVE_LDS_FENCE();
  }
}

typedef float f32x32 __attribute__((ext_vector_type(32)));
typedef unsigned u32x6 __attribute__((ext_vector_type(6)));
struct Fp6Row { uint4 a; uint2 b; };
__device__ __forceinline__ f32x32 fp6_decode(const Fp6Row& r) {
  u32x6 w; w[0] = r.a.x; w[1] = r.a.y; w[2] = r.a.z; w[3] = r.a.w; w[4] = r.b.x; w[5] = r.b.y;
  return __builtin_amdgcn_cvt_scalef32_pk32_f32_fp6(w, 1.0f);
}
__device__ __forceinline__ void peer_gather_token(const Params& p, int layer, char* smem, int tok, int tl, int buf, int lane, bool dowrite) {
  const bf16_t* H2 = (const bf16_t*)(p.ws + OFF_ACT);
  const char* U6 = p.ws + OFF_U + (size_t)layer * NEXP * RECB;
  const char* V6 = U6 + ROWB;
  const float* mod = (const float*)(p.ws + OFF_MOD) + (size_t)layer * 9 * 6144;
  const int* EX = (const int*)(smem + PE_OFF_EX) + buf * 16 * 128 + tl * 128;
  const float* GT = (const float*)(smem + PE_OFF_GT) + buf * 16 * 128 + tl * 128;
  const float* SU = (const float*)(smem + PE_OFF_SU) + buf * 16 * 128 + tl * 128;
  const int l = lane & 31, hf = lane >> 5;
  float hv[32], acc[32];
  {
    const bf16_t* hr = H2 + (size_t)tok * 1024;
#pragma unroll
    for (int j = 0; j < 8; ++j) {
      const uint2 u = *(const uint2*)(hr + (l + 32 * j) * 4);
      hv[4 * j + 0] = lo16(u.x); hv[4 * j + 1] = hi16(u.x); hv[4 * j + 2] = lo16(u.y); hv[4 * j + 3] = hi16(u.y);
    }
  }
#pragma unroll
  for (int i = 0; i < 32; ++i) acc[i] = 0.f;
  Fp6Row ua[2], va[2], ub[2], vb[2], uc[2], vc[2];
#define PE_LOAD_SET(UU, VV, E0)                                                       \
  _Pragma("unroll") for (int j = 0; j < 2; ++j) {                                     \
    const int ex = EX[(E0) + 2 * j + hf];                                             \
    const char* up = U6 + (size_t)ex * RECB + l * 24;                                 \
    UU[j].a = *(const uint4*)up; UU[j].b = *(const uint2*)(up + 16);                  \
    VV[j].a = *(const uint4*)(up + ROWB); VV[j].b = *(const uint2*)(up + ROWB + 16);  \
  }
  PE_LOAD_SET(ua, va, 0) PE_LOAD_SET(ub, vb, 4)
#pragma unroll 1
  for (int e0 = 0; e0 < 128; e0 += 4) {
    if (e0 + 8 < 128) { PE_LOAD_SET(uc, vc, e0 + 8) }
#pragma unroll
    for (int j = 0; j < 2; ++j) {
      const f32x32 du = fp6_decode(ua[j]);
      float d0 = 0.f, d1 = 0.f, d2 = 0.f, d3 = 0.f;
#pragma unroll
      for (int k = 0; k < 32; k += 4) {
        d0 = fmaf(hv[k], du[k], d0); d1 = fmaf(hv[k + 1], du[k + 1], d1); d2 = fmaf(hv[k + 2], du[k + 2], d2); d3 = fmaf(hv[k + 3], du[k + 3], d3);
      }
      const float r16 = row16_sum((d0 + d1) + (d2 + d3));
      const int ir = __float_as_int(r16);
      const float s0 = __int_as_float(__builtin_amdgcn_readlane(ir, 0)) + __int_as_float(__builtin_amdgcn_readlane(ir, 16));
      const float s1 = __int_as_float(__builtin_amdgcn_readlane(ir, 32)) + __int_as_float(__builtin_amdgcn_readlane(ir, 48));
      const float d = (hf ? s1 : s0) * SU[e0 + 2 * j + hf];
      const float w = GT[e0 + 2 * j + hf] * gelu_erf(d);
      const f32x32 dv = fp6_decode(va[j]);
#pragma unroll
      for (int k = 0; k < 32; ++k) acc[k] = fmaf(w, dv[k], acc[k]);
    }
#pragma unroll
    for (int j = 0; j < 2; ++j) { ua[j] = ub[j]; va[j] = vb[j]; ub[j] = uc[j]; vb[j] = vc[j]; }
  }
#pragma unroll
  for (int k = 0; k < 32; ++k) acc[k] += __shfl_xor(acc[k], 32);
  const int b = tok < NLAT ? (tok >> 12) : 8;
  float* xr = tok < NLAT ? p.out + (size_t)tok * 1024 : (float*)(p.ws + OFF_CTXB) + (size_t)(tok - NLAT) * 1024;
  const float* gate = mod + (size_t)b * 6144 + 5 * 1024;
  float4 xn[4];
  float ss = 0.f;
#pragma unroll
  for (int jj = 0; jj < 4; ++jj) {
    const int c = (l + 32 * (4 * hf + jj)) * 4;
    const float4 xv = *(const float4*)(xr + c);
    const float4 gv = *(const float4*)(gate + c);
    const float a0 = hf ? acc[16 + 4 * jj + 0] : acc[4 * jj + 0], a1 = hf ? acc[16 + 4 * jj + 1] : acc[4 * jj + 1];
    const float a2 = hf ? acc[16 + 4 * jj + 2] : acc[4 * jj + 2], a3 = hf ? acc[16 + 4 * jj + 3] : acc[4 * jj + 3];
    xn[jj].x = xv.x + gv.x * a0; xn[jj].y = xv.y + gv.y * a1; xn[jj].z = xv.z + gv.z * a2; xn[jj].w = xv.w + gv.w * a3;
    ss += xn[jj].x * xn[jj].x + xn[jj].y * xn[jj].y + xn[jj].z * xn[jj].z + xn[jj].w * xn[jj].w;
  }
  ss = wave_sum(ss);
  const float rinv = rsqrtf(ss * (1.f / 1024.f) + EPS);
  if (layer == 0) {
    const float* mod1 = (const float*)(p.ws + OFF_MOD) + (size_t)9 * 6144 + (size_t)b * 6144;
    const float* g1 = p.norm1_g + 1024;
    bf16_t* act = (bf16_t*)(p.ws + OFF_ACT) + (size_t)tok * 1024;
#pragma unroll
    for (int jj = 0; jj < 4; ++jj) {
      const int c = (l + 32 * (4 * hf + jj)) * 4;
      if (dowrite) *(float4*)(xr + c) = xn[jj]; else asm volatile("" :: "v"(xn[jj].x), "v"(xn[jj].y), "v"(xn[jj].z), "v"(xn[jj].w));
      const float4 gg4 = *(const float4*)(g1 + c);
      const float4 sh = *(const float4*)(mod1 + c);
      const float4 sc = *(const float4*)(mod1 + 1024 + c);
      uint2 o;
      o.x = pack2(xn[jj].x * rinv * gg4.x * (1.f + sc.x) + sh.x, xn[jj].y * rinv * gg4.y * (1.f + sc.y) + sh.y);
      o.y = pack2(xn[jj].z * rinv * gg4.z * (1.f + sc.z) + sh.z, xn[jj].w * rinv * gg4.w * (1.f + sc.w) + sh.w);
      if (dowrite) *(uint2*)(act + c) = o; else asm volatile("" :: "v"(o.x), "v"(o.y));
    }
  } else {
#pragma unroll
    for (int jj = 0; jj < 4; ++jj) {
      const int c = (l + 32 * (4 * hf + jj)) * 4;
      const float4 gg4 = *(const float4*)(p.final_g + c);
      float4 o;
      o.x = xn[jj].x * rinv * gg4.x; o.y = xn[jj].y * rinv * gg4.y; o.z = xn[jj].z * rinv * gg4.z; o.w = xn[jj].w * rinv * gg4.w;
      if (dowrite) *(float4*)(xr + c) = o; else asm volatile("" :: "v"(o.x), "v"(o.y), "v"(o.z), "v"(o.w));
    }
  }
}

__device__ __forceinline__ void phase_peer(const Params& p, int layer, char* smem, int ntok, bool dowrite = true) {
  const int tid = opaque_tid(), lane = tid & 63, wave = __builtin_amdgcn_readfirstlane(tid >> 6);
  int cand_a = -1, cand_b = 0;
  {
    int c = 0;
    for (int a = 0; a < 16; ++a)
      for (int bb = 0; bb < 16; ++bb)
        if ((a + 1) * (bb + 1) <= 16) { if (c == lane) { cand_a = a; cand_b = bb; } ++c; }
  }
  const int ngroups = ntok / 16, G = gridDim.x, g0 = opaque_bid();
  __syncthreads();
  if (g0 < ngroups && wave >= 4) {
    const int sw = wave - 4;
    peer_select_head(p, layer, smem, g0 * 16, 2 * sw, sw, 0, lane, cand_a, cand_b);
    peer_select_head(p, layer, smem, g0 * 16, 2 * sw + 1, sw, 0, lane, cand_a, cand_b);
  }
  __syncthreads();
  int it = 0;
  for (int grp = g0; grp < ngroups; grp += G, ++it) {
    const int buf = it & 1;
    if (wave < 4) {
#pragma unroll 1
      for (int tt = 0; tt < 4; ++tt) peer_gather_token(p, layer, smem, grp * 16 + wave * 4 + tt, wave * 4 + tt, buf, lane, dowrite);
    } else if (grp + G < ngroups) {
      const int sw = wave - 4;
      peer_select_head(p, layer, smem, (grp + G) * 16, 2 * sw, sw, buf ^ 1, lane, cand_a, cand_b);
      peer_select_head(p, layer, smem, (grp + G) * 16, 2 * sw + 1, sw, buf ^ 1, lane, cand_a, cand_b);
    }
    __syncthreads();
  }
}

template <int layer>
__device__ __forceinline__ void layer_body(const Params& p, char* smem, const XcdBarrier& xb) {
  constexpr bool nc = layer == 0;
  const float* xin = layer == 0 ? p.x : (const float*)p.out;
  if (layer == 0) {
    phase_norm(p, layer, 0, xin, NTOK);
    xcd_barrier(xb);
  }
#if REP_GEMM
  gemm_phase2<EPI_INPROJ>(p, layer, smem, (const bf16_t*)(p.ws + OFF_ACT), (const bf16_t*)(p.ws + OFF_WIN) + (size_t)layer * 3072 * 1024, NTOK, 3072, nullptr);
  xcd_barrier(xb);
#endif
  gemm_phase2<EPI_INPROJ>(p, layer, smem, (const bf16_t*)(p.ws + OFF_ACT), (const bf16_t*)(p.ws + OFF_WIN) + (size_t)layer * 3072 * 1024, NTOK, 3072, nullptr);
  xcd_barrier(xb);
#if REP_MIX1
  phase_mix1(p, layer, smem, 2);
  xcd_barrier(xb);
#endif
  phase_mix1(p, layer, smem);
  xcd_barrier(xb);
  phase_ret_scan(p, layer);
  xcd_barrier(xb);
#if REP_MIX2
  phase_mix2(p, layer, smem, 3);
  xcd_barrier(xb);
#endif
  phase_mix2(p, layer, smem);
  xcd_barrier(xb);
  gemm_phase2<EPI_OUTPROJ>(p, layer, smem, (const bf16_t*)(p.ws + OFF_ACT), (const bf16_t*)(p.ws + OFF_WOUT) + (size_t)layer * 1024 * 1024, nc ? NTOK : NLAT, 1024, xin);
  xcd_barrier(xb);
  phase_norm(p, layer, 1, (const float*)p.out, nc ? NTOK : NLAT);
  xcd_barrier(xb);
  gemm_phase2<EPI_PLAIN>(p, layer, smem, (const bf16_t*)(p.ws + OFF_ACT), (const bf16_t*)(p.ws + OFF_WQ) + (size_t)layer * 2048 * 1024, nc ? NTOK : NLAT, 2048, nullptr);
  xcd_barrier(xb);
#if REP_PEER
  phase_peer(p, layer, smem, nc ? NTOK : NLAT, false);
  xcd_barrier(xb);
#endif
  phase_peer(p, layer, smem, nc ? NTOK : NLAT);
  if (layer == 0) xcd_barrier(xb);
}

__global__ void __launch_bounds__(512) fwd_megakernel(Params p) {
  cg::grid_group grid = cg::this_grid();
  extern __shared__ __attribute__((aligned(16))) char smem[];
  volatile LAS3 unsigned* xst = (volatile LAS3 unsigned*)(smem + LDS_BCAST + 8);
  if (threadIdx.x == 0) { xst[0] = 0u; xst[1] = 0u; }
  phase_prep(p, smem);
  grid.sync();
  const XcdBarrier xb = xcd_barrier_post((unsigned*)(p.ws + OFF_XBAR), xst);
  layer_body<0>(p, smem, xb);
  layer_body<1>(p, smem, xb);
}

extern "C" void kernel_launch(void* const* d_in, const int* in_sizes, int n_in, void* d_out,
                              int out_size, void* d_ws, size_t ws_size, hipStream_t stream) {
  constexpr size_t kDynLds = LDS_BYTES;
  static int grid_blocks = 0;
  if (!grid_blocks) {
    int dev = 0, cus = 0, per_cu = 0;
    (void)hipGetDevice(&dev);
    (void)hipDeviceGetAttribute(&cus, hipDeviceAttributeMultiprocessorCount, dev);
    (void)hipFuncSetAttribute((const void*)fwd_megakernel, hipFuncAttributeMaxDynamicSharedMemorySize, (int)kDynLds);
    (void)hipOccupancyMaxActiveBlocksPerMultiprocessor(&per_cu, fwd_megakernel, 512, kDynLds);
    if (per_cu < 1) { fprintf(stderr, "occupancy query says %d blocks/CU\n", per_cu); per_cu = 1; }
    grid_blocks = cus;
    if (ws_size < WS_END) fprintf(stderr, "workspace too small: %zu < %zu\n", ws_size, (size_t)WS_END);
  }
  Params p{};
  p.x = (const float*)d_in[0]; p.c = (const float*)d_in[1]; p.ctx = (const float*)d_in[2]; p.c_ctx = (const float*)d_in[3];
  p.w_ada = (const float*)d_in[4]; p.b_ada = (const float*)d_in[5]; p.norm1_g = (const float*)d_in[6]; p.w_in = (const float*)d_in[7];
  p.na_rpb = (const float*)d_in[8]; p.diff_lambda = (const float*)d_in[9]; p.diff_subln_g = (const float*)d_in[10];
  p.ret_decay_logit = (const float*)d_in[11]; p.w_out = (const float*)d_in[12]; p.norm2_g = (const float*)d_in[13];
  p.peer_wq = (const float*)d_in[14]; p.peer_subkeys = (const float*)d_in[15]; p.peer_u = (const float*)d_in[16];
  p.peer_v = (const float*)d_in[17]; p.final_g = (const float*)d_in[18];
  p.out = (float*)d_out; p.ws = (char*)d_ws;
  void* args[] = {&p};
  hipError_t e = hipLaunchCooperativeKernel((void*)fwd_megakernel, dim3(grid_blocks), dim3(512), args, kDynLds, stream);
  if (e != hipSuccess) fprintf(stderr, "cooperative launch failed: %s (grid %d)\n", hipGetErrorString(e), grid_blocks);
}
```

```cpp
#include <hip/hip_runtime.h>
#include <hip/hip_cooperative_groups.h>
#include <cstdio>
#include <cstdint>
namespace cg = cooperative_groups;

typedef unsigned short bf16_t;
typedef short bf16x8 __attribute__((ext_vector_type(8)));
typedef float f32x4 __attribute__((ext_vector_type(4)));

constexpr int DM = 1024, BATCH = 8, SEQ = 4096, LCTX = 256;
constexpr int NLAT = BATCH * SEQ;
constexpr int NCTX = BATCH * LCTX;
constexpr int NTOK = NLAT + NCTX;
constexpr int INC = 3072;
constexpr int C_NAQ = 0, C_NAK = 256, C_NAV = 512, C_DFQ = 768, C_DFK = 1024, C_DFV = 1280,
              C_RTQ = 1536, C_RTK = 1792, C_RTV = 2048, C_RTG = 2560;
constexpr int Y_NA = 0, Y_DF = 256, Y_RT = 512;
constexpr int NEXP = 16384;
constexpr float EPS = 1e-6f;

constexpr size_t OFF_CTL  = 0;
constexpr size_t OFF_MISC = 4096;
constexpr size_t OFF_ROPE = 8192;
constexpr size_t OFF_MOD  = OFF_ROPE + 12288;
constexpr size_t SZ_MOD   = 2ull * 9 * 6144 * 4;
constexpr size_t OFF_WIN  = OFF_MOD + SZ_MOD;
constexpr size_t SZ_WIN   = 2ull * 3072 * 1024 * 2;
constexpr size_t OFF_WOUT = OFF_WIN + SZ_WIN;
constexpr size_t SZ_WOUT  = 2ull * 1024 * 1024 * 2;
constexpr size_t OFF_WQ   = OFF_WOUT + SZ_WOUT;
constexpr size_t SZ_WQ    = 2ull * 2048 * 1024 * 2;
constexpr size_t OFF_SUBK = OFF_WQ + SZ_WQ;
constexpr size_t SZ_SUBK  = 2ull * 262144 * 2;
constexpr size_t OFF_U    = OFF_SUBK + SZ_SUBK;
constexpr int    ROWB     = 768;
constexpr int    RECB     = 2 * ROWB;
constexpr size_t SZ_UV    = 2ull * NEXP * ROWB;
constexpr size_t OFF_V    = OFF_U + SZ_UV;
constexpr size_t OFF_USC  = OFF_V + SZ_UV;
constexpr size_t OFF_VSC  = OFF_USC + 2ull * NEXP * 4;
constexpr size_t OFF_ACT  = OFF_VSC + 2ull * NEXP * 4;
constexpr size_t SZ_ACT   = (size_t)NTOK * 1024 * 2;
constexpr size_t OFF_P    = OFF_ACT + SZ_ACT;
constexpr size_t SZ_P     = (size_t)NTOK * 3072 * 2;
constexpr size_t OFF_CTXB = OFF_P + SZ_P;
constexpr size_t SZ_CTXB  = (size_t)NCTX * 1024 * 4;
constexpr size_t OFF_RKV  = OFF_CTXB + SZ_CTXB;
constexpr size_t SZ_RKV   = 64ull * 32 * 8192 * 4;
constexpr size_t OFF_RS   = OFF_RKV + SZ_RKV;
constexpr size_t SZ_RS    = 64ull * 8192 * 4;
constexpr size_t OFF_XBAR = OFF_RS + SZ_RS;
constexpr size_t WS_END   = OFF_XBAR + 16384;

#ifndef REP_MIX1
#define REP_MIX1 0
#endif
#ifndef REP_MIX2
#define REP_MIX2 0
#endif
#ifndef REP_PEER
#define REP_PEER 0
#endif
#ifndef REP_GEMM
#define REP_GEMM 0
#endif
constexpr int LDS_BYTES = 144 * 1024;
constexpr int LDS_BCAST = LDS_BYTES - 16;

struct Params {
  const float *x, *c, *ctx, *c_ctx, *w_ada, *b_ada, *norm1_g, *w_in, *na_rpb, *diff_lambda, *diff_subln_g,
              *ret_decay_logit, *w_out, *norm2_g, *peer_wq, *peer_subkeys, *peer_u, *peer_v, *final_g;
  float* out;
  char* ws;
};

__device__ __forceinline__ float bf2f(bf16_t v) { return __uint_as_float(((unsigned)v) << 16); }
__device__ __forceinline__ bf16_t f2bf(float f) {
  unsigned u = __float_as_uint(f);
  u += 0x7fffu + ((u >> 16) & 1u);
  return (bf16_t)(u >> 16);
}
__device__ __forceinline__ unsigned pack2(float a, float b) { return (unsigned)f2bf(a) | ((unsigned)f2bf(b) << 16); }
__device__ __forceinline__ unsigned pack2h(float a, float b) {
  unsigned r;
  asm("v_cvt_pk_bf16_f32 %0, %1, %2" : "=v"(r) : "v"(a), "v"(b));
  return r;
}
__device__ __forceinline__ float lo16(unsigned w) { return __uint_as_float(w << 16); }
__device__ __forceinline__ float hi16(unsigned w) { return __uint_as_float(w & 0xffff0000u); }
#define DPP_ADD(v, CTRL) ((v) + __int_as_float(__builtin_amdgcn_update_dpp(0, __float_as_int(v), (CTRL), 0xf, 0xf, true)))
__device__ __forceinline__ float row16_sum(float v) {
  v = DPP_ADD(v, 0xB1);
  v = DPP_ADD(v, 0x4E);
  v = DPP_ADD(v, 0x141);
  v = DPP_ADD(v, 0x140);
  return v;
}
__device__ __forceinline__ float wave_sum(float v) {
  v = row16_sum(v);
  const int iv = __float_as_int(v);
  const float a = __int_as_float(__builtin_amdgcn_readlane(iv, 0)), b = __int_as_float(__builtin_amdgcn_readlane(iv, 16));
  const float c = __int_as_float(__builtin_amdgcn_readlane(iv, 32)), d = __int_as_float(__builtin_amdgcn_readlane(iv, 48));
  return (a + b) + (c + d);
}
__device__ __forceinline__ float siluf(float x) { return x / (1.f + __expf(-x)); }

__device__ __forceinline__ int opaque_tid() { int t = threadIdx.x; asm volatile("" : "+v"(t)); return t; }
__device__ __forceinline__ int opaque_bid() { int t = blockIdx.x; asm volatile("" : "+s"(t)); return t; }

#define DOT8(acc, Q, off, U)                                                              \
  acc = fmaf(Q[(off) + 0], lo16((U).x), acc); acc = fmaf(Q[(off) + 1], hi16((U).x), acc); \
  acc = fmaf(Q[(off) + 2], lo16((U).y), acc); acc = fmaf(Q[(off) + 3], hi16((U).y), acc); \
  acc = fmaf(Q[(off) + 4], lo16((U).z), acc); acc = fmaf(Q[(off) + 5], hi16((U).z), acc); \
  acc = fmaf(Q[(off) + 6], lo16((U).w), acc); acc = fmaf(Q[(off) + 7], hi16((U).w), acc);
#define AXPY8(O, off, P, U)                                                                   \
  O[(off) + 0] = fmaf(P, lo16((U).x), O[(off) + 0]); O[(off) + 1] = fmaf(P, hi16((U).x), O[(off) + 1]); \
  O[(off) + 2] = fmaf(P, lo16((U).y), O[(off) + 2]); O[(off) + 3] = fmaf(P, hi16((U).y), O[(off) + 3]); \
  O[(off) + 4] = fmaf(P, lo16((U).z), O[(off) + 4]); O[(off) + 5] = fmaf(P, hi16((U).z), O[(off) + 5]); \
  O[(off) + 6] = fmaf(P, lo16((U).w), O[(off) + 6]); O[(off) + 7] = fmaf(P, hi16((U).w), O[(off) + 7]);
#define UNPACK8(Q, off, U)                                                  \
  Q[(off) + 0] = lo16((U).x); Q[(off) + 1] = hi16((U).x); Q[(off) + 2] = lo16((U).y); Q[(off) + 3] = hi16((U).y); \
  Q[(off) + 4] = lo16((U).z); Q[(off) + 5] = hi16((U).z); Q[(off) + 6] = lo16((U).w); Q[(off) + 7] = hi16((U).w);

__device__ __forceinline__ int next_item(unsigned* counter, char* smem) {
  volatile int* bc = (volatile int*)(smem + LDS_BCAST);
  __syncthreads();
  if (threadIdx.x == 0) *bc = (int)atomicAdd(counter, 1u);
  __syncthreads();
  return *bc;
}

#define XB_TMO      128
#define XB_XCNT(j)  (256  + 64 * (j))
#define XB_XSUB(j)  (1280 + 64 * (j))
#define XB_XGEN(j)  (2304 + 64 * (j))
#define XB_TOP      3328
#define XB_TOPGEN   3392
#define XCD_BAR_WORDS 3456
#define XB_SPIN_CAP (1u << 18)
#define LAS3 __attribute__((address_space(3)))
__device__ __forceinline__ unsigned xb_ld(unsigned* p)              { return __hip_atomic_load(p, __ATOMIC_RELAXED, __HIP_MEMORY_SCOPE_AGENT); }
__device__ __forceinline__ unsigned xb_add(unsigned* p, unsigned v) { return __hip_atomic_fetch_add(p, v, __ATOMIC_RELAXED, __HIP_MEMORY_SCOPE_AGENT); }
__device__ __forceinline__ unsigned xb_xcc_id() { return (unsigned)__builtin_amdgcn_s_getreg((3 << 11) | 20) & 0xFu; }
#define XB_SPIN(cond, bar) do { unsigned _sp = 0; while (cond) { __builtin_amdgcn_s_sleep(1); \
    if ((++_sp & 255u) == 0u) { if (xb_ld(&(bar)[XB_TMO])) break; if (_sp > XB_SPIN_CAP) { atomicAdd(&(bar)[XB_TMO], 1u); break; } } } } while (0)
struct XcdBarrier { unsigned* bar; unsigned x; volatile LAS3 unsigned* st; };
__device__ __forceinline__ XcdBarrier xcd_barrier_post(unsigned* bar, volatile LAS3 unsigned* st) {
  XcdBarrier b; b.bar = bar; b.x = xb_xcc_id(); b.st = st;
  if (threadIdx.x == 0) (void)xb_add(&bar[XB_XCNT(b.x)], 1u);
  return b;
}
__device__ __forceinline__ void xcd_barrier_complete(unsigned* bar, unsigned x, unsigned& nloc, unsigned& nx) {
  const unsigned G = gridDim.x * gridDim.y * gridDim.z;
  unsigned sum, cnt, mine, sp = 0u;
  for (;;) {
    sum = 0u; cnt = 0u; mine = 0u;
#pragma unroll
    for (unsigned j = 0; j < 16; ++j) { const unsigned c = xb_ld(&bar[XB_XCNT(j)]); sum += c; cnt += (c > 0u) ? 1u : 0u; mine = (j == x) ? c : mine; }
    if (sum == G) break;
    __builtin_amdgcn_s_sleep(1);
    if ((++sp & 255u) == 0u) { if (xb_ld(&bar[XB_TMO])) break; if (sp > XB_SPIN_CAP) { atomicAdd(&bar[XB_TMO], 1u); break; } }
  }
  nloc = mine > 0u ? mine : 1u; nx = cnt > 0u ? cnt : 1u;
}
__device__ __forceinline__ void xcd_barrier(const XcdBarrier& b) {
  asm volatile("s_waitcnt vmcnt(0)" ::: "memory");
  __syncthreads();
  if (threadIdx.x == 0) {
    unsigned* bar = b.bar;
    __builtin_amdgcn_s_waitcnt(0);
    unsigned nloc = b.st[0], nx = b.st[1];
    if (nloc == 0u) { xcd_barrier_complete(bar, b.x, nloc, nx); b.st[0] = nloc; b.st[1] = nx; }
    const unsigned old = xb_add(&bar[XB_XSUB(b.x)], 1u);
    const unsigned gen = old / nloc;
    if (old + 1u == (gen + 1u) * nloc) {
      __builtin_amdgcn_fence(__ATOMIC_RELEASE, "agent");
      asm volatile("s_waitcnt vmcnt(0)" ::: "memory");
      const unsigned og = xb_add(&bar[XB_TOP], 1u);
      const unsigned tg = og / nx;
      if (og + 1u == (tg + 1u) * nx) xb_add(&bar[XB_TOPGEN], 1u);
      else XB_SPIN(xb_ld(&bar[XB_TOPGEN]) == tg, bar);
      __builtin_amdgcn_fence(__ATOMIC_ACQUIRE, "agent");
      xb_add(&bar[XB_XGEN(b.x)], 1u);
      asm volatile("s_waitcnt vmcnt(0)" ::: "memory");
    } else {
      XB_SPIN(xb_ld(&bar[XB_XGEN(b.x)]) == gen, bar);
      __builtin_amdgcn_fence(__ATOMIC_ACQUIRE, "agent");
      asm volatile("s_waitcnt vmcnt(0)" ::: "memory");
    }
  }
  __syncthreads();
}

__device__ __forceinline__ void transpose_item(const float* src, bf16_t* dst, int K, int N, int item, char* smem) {
  float* t = (float*)smem;
  const int nb = N / 64;
  const int k0 = (item / nb) * 64, n0 = (item % nb) * 64;
  const int tid = opaque_tid();
  __syncthreads();
#pragma unroll
  for (int i = 0; i < 8; ++i) {
    const int k = (tid >> 6) + 8 * i, n = tid & 63;
    t[k * 65 + n] = src[(size_t)(k0 + k) * N + n0 + n];
  }
  __syncthreads();
#pragma unroll
  for (int i = 0; i < 8; ++i) {
    const int n = (tid >> 6) + 8 * i, k = tid & 63;
    dst[(size_t)(n0 + n) * K + k0 + k] = f2bf(t[k * 65 + n]);
  }
}

__device__ __forceinline__ void convert_flat(const float* src, bf16_t* dst, size_t n4) {
  const size_t gt = (size_t)opaque_bid() * blockDim.x + opaque_tid(), gs = (size_t)gridDim.x * blockDim.x;
  for (size_t i = gt; i < n4; i += gs) {
    const float4 v = ((const float4*)src)[i];
    uint2 o; o.x = pack2h(v.x, v.y); o.y = pack2h(v.z, v.w);
    ((uint2*)dst)[i] = o;
  }
}

__device__ __forceinline__ void phase_prep(const Params& p, char* smem) {
  const int tid = opaque_tid();
  char* ws = p.ws;
  if (opaque_bid() == 0) {
    unsigned* ctl = (unsigned*)(ws + OFF_CTL);
    if (tid < 64) ctl[tid] = 0u;
    unsigned* xbar = (unsigned*)(ws + OFF_XBAR);
    for (int i = tid; i < XCD_BAR_WORDS; i += 512) xbar[i] = 0u;
    float* misc = (float*)(ws + OFF_MISC);
    if (tid < 2) {
      const float* lp = p.diff_lambda + tid * 128;
      float s01 = 0.f, s23 = 0.f;
      for (int i = 0; i < 32; ++i) { s01 += lp[i] * lp[32 + i]; s23 += lp[64 + i] * lp[96 + i]; }
      const float lam_init = 0.8f - 0.6f * expf(-0.3f * (float)tid);
      misc[tid] = expf(s01) - expf(s23) + lam_init;
      misc[2 + tid] = lam_init;
    }
    if (tid >= 128 && tid < 256) misc[64 + tid - 128] = 0.f;
    if (tid >= 64 && tid < 80) {
      const int i = tid - 64;
      const float xv = p.ret_decay_logit[i];
      misc[16 + i] = -log1pf(expf(-xv));
    }
    float2* ropeD = (float2*)(ws + OFF_ROPE);
    float2* ropeR = (float2*)(ws + OFF_ROPE + 4096);
    for (int i = tid; i < 64 * 8; i += 512) {
      const int v = i >> 3, f = i & 7;
      const float inv = powf(10000.0f, -(float)(2 * f) / 16.0f);
      const float ang = (float)v * inv;
      ropeD[i] = make_float2(cosf(ang), sinf(ang));
    }
    for (int i = tid; i < 64 * 16; i += 512) {
      const int v = i >> 4, f = i & 15;
      const float inv = powf(10000.0f, -(float)(2 * f) / 32.0f);
      const float ang = (float)v * inv;
      ropeR[i] = make_float2(cosf(ang), sinf(ang));
    }
  }
  {
    float* sc = (float*)smem;
    float* red = (float*)(smem + 9 * 1024 * 4);
    float* mod = (float*)(ws + OFF_MOD);
    for (int item = opaque_bid(); item < 192; item += gridDim.x) {
      const int l = item / 96, cb = item % 96;
      __syncthreads();
      for (int i = tid; i < 9 * 1024; i += 512) {
        const int r = i >> 10, k = i & 1023;
        const float cv = (r < 8) ? p.c[r * 1024 + k] : p.c_ctx[k];
        sc[i] = siluf(cv);
      }
      __syncthreads();
      const int col = tid & 63, ks = tid >> 6;
      float acc[9];
#pragma unroll
      for (int r = 0; r < 9; ++r) acc[r] = 0.f;
      const float* w = p.w_ada + (size_t)l * 1024 * 6144 + cb * 64 + col;
#pragma unroll 1
      for (int k0 = ks * 128; k0 < ks * 128 + 128; k0 += 16) {
        float wv[16];
#pragma unroll
        for (int i = 0; i < 16; ++i) wv[i] = w[(size_t)(k0 + i) * 6144];
#pragma unroll
        for (int i = 0; i < 16; ++i)
#pragma unroll
          for (int r = 0; r < 9; ++r) acc[r] = fmaf(sc[r * 1024 + k0 + i], wv[i], acc[r]);
      }
#pragma unroll
      for (int r = 0; r < 9; ++r) red[(ks * 9 + r) * 64 + col] = acc[r];
      __syncthreads();
      for (int i = tid; i < 576; i += 512) {
        const int r = i >> 6, cc = i & 63;
        float s = 0.f;
#pragma unroll
        for (int k8 = 0; k8 < 8; ++k8) s += red[(k8 * 9 + r) * 64 + cc];
        mod[((size_t)l * 9 + r) * 6144 + cb * 64 + cc] = s + p.b_ada[l * 6144 + cb * 64 + cc];
      }
    }
    __syncthreads();
  }
  for (int item = opaque_bid(); item < 3072; item += gridDim.x) {
    const int l = item / 1536;
    int r = item % 1536;
    if (r < 768) transpose_item(p.w_in + (size_t)l * 1024 * 3072, (bf16_t*)(ws + OFF_WIN) + (size_t)l * 3072 * 1024, 1024, 3072, r, smem);
    else if (r < 1024) transpose_item(p.w_out + (size_t)l * 1024 * 1024, (bf16_t*)(ws + OFF_WOUT) + (size_t)l * 1024 * 1024, 1024, 1024, r - 768, smem);
    else transpose_item(p.peer_wq + (size_t)l * 1024 * 2048, (bf16_t*)(ws + OFF_WQ) + (size_t)l * 2048 * 1024, 1024, 2048, r - 1024, smem);
  }
  convert_flat(p.peer_subkeys, (bf16_t*)(ws + OFF_SUBK), 2ull * 262144 / 4);
  {
    const size_t gt = (size_t)opaque_bid() * blockDim.x + tid, gs = (size_t)gridDim.x * blockDim.x;
    float4* dst = (float4*)(ws + OFF_CTXB);
    for (size_t i = gt; i < (size_t)NCTX * 1024 / 4; i += gs) dst[i] = ((const float4*)p.ctx)[i];
  }
}

__device__ __forceinline__ void phase_norm(const Params& p, int layer, int which, const float* xlat, int nrows) {
  const int lane = opaque_tid() & 63;
  const int gw = opaque_bid() * 8 + (opaque_tid() >> 6), nw = gridDim.x * 8;
  const float* g = (which == 0 ? p.norm1_g : p.norm2_g) + layer * 1024;
  const float* mod = (const float*)(p.ws + OFF_MOD) + (size_t)layer * 9 * 6144;
  const float* ctxb = (const float*)(p.ws + OFF_CTXB);
  bf16_t* act = (bf16_t*)(p.ws + OFF_ACT);
  const int sh_off = which == 0 ? 0 : 3 * 1024, sc_off = which == 0 ? 1024 : 4 * 1024;
  for (int row = gw; row < nrows; row += nw) {
    const float* src = row < NLAT ? xlat + (size_t)row * 1024 : ctxb + (size_t)(row - NLAT) * 1024;
    const int b = row < NLAT ? (row >> 12) : 8;
    const float* mrow = mod + (size_t)b * 6144;
    float4 v[4];
    float ss = 0.f;
#pragma unroll
    for (int j = 0; j < 4; ++j) {
      v[j] = ((const float4*)src)[lane + 64 * j];
      ss += v[j].x * v[j].x + v[j].y * v[j].y + v[j].z * v[j].z + v[j].w * v[j].w;
    }
    ss = wave_sum(ss);
    const float r = rsqrtf(ss * (1.f / 1024.f) + EPS);
#pragma unroll
    for (int j = 0; j < 4; ++j) {
      const int c = (lane + 64 * j) * 4;
      const float4 gg = *(const float4*)(g + c);
      const float4 sh = *(const float4*)(mrow + sh_off + c);
      const float4 sc = *(const float4*)(mrow + sc_off + c);
      const float o0 = v[j].x * r * gg.x * (1.f + sc.x) + sh.x;
      const float o1 = v[j].y * r * gg.y * (1.f + sc.y) + sh.y;
      const float o2 = v[j].z * r * gg.z * (1.f + sc.z) + sh.z;
      const float o3 = v[j].w * r * gg.w * (1.f + sc.w) + sh.w;
      uint2 o; o.x = pack2h(o0, o1); o.y = pack2h(o2, o3);
      *(uint2*)(act + (size_t)row * 1024 + c) = o;
    }
  }
}

__device__ __forceinline__ void phase_final(const Params& p) {
  const int lane = opaque_tid() & 63;
  const int gw = opaque_bid() * 8 + (opaque_tid() >> 6), nw = gridDim.x * 8;
  for (int row = gw; row < NLAT; row += nw) {
    float* src = p.out + (size_t)row * 1024;
    float4 v[4];
    float ss = 0.f;
#pragma unroll
    for (int j = 0; j < 4; ++j) {
      v[j] = ((const float4*)src)[lane + 64 * j];
      ss += v[j].x * v[j].x + v[j].y * v[j].y + v[j].z * v[j].z + v[j].w * v[j].w;
    }
    ss = wave_sum(ss);
    const float r = rsqrtf(ss * (1.f / 1024.f) + EPS);
#pragma unroll
    for (int j = 0; j < 4; ++j) {
      const int c = (lane + 64 * j) * 4;
      const float4 gg = *(const float4*)(p.final_g + c);
      float4 o;
      o.x = v[j].x * r * gg.x; o.y = v[j].y * r * gg.y; o.z = v[j].z * r * gg.z; o.w = v[j].w * r * gg.w;
      ((float4*)src)[lane + 64 * j] = o;
    }
  }
}

constexpr int EPI_INPROJ = 0, EPI_OUTPROJ = 1, EPI_PLAIN = 2;
constexpr int GS = 72;
constexpr int G_ASTAGE = 256 * GS * 2;
constexpr int G_BSTAGE = 128 * GS * 2;
constexpr int G_STAGE = G_ASTAGE + G_BSTAGE;

namespace g8 {
constexpr int BM = 256, BK = 64, HALF = 128, NXCD = 8, WGM = 8, HT = HALF * BK;
__device__ __forceinline__ int lds_byte(int r, int c) {
  const int st = (r >> 4) * 2 + (c >> 5), rr = r & 15, cc = c & 31, ob = rr * 64 + cc * 2;
  return st * 1024 + (ob ^ (((ob >> 9) & 1) << 5));
}
__device__ __forceinline__ void stage_rc(int b, int& R, int& C) {
  const int st = b / 1024, sb = b % 1024, swz = sb ^ (((sb >> 9) & 1) << 5);
  R = (st >> 1) * 16 + swz / 64; C = (st & 1) * 32 + (swz % 64) / 2;
}
}

constexpr int G8_ROPE_LDS = 8 * 16384;
template <int EPI>
__device__ __forceinline__ void epi_store8(const Params& p, int layer, char* smem, int m, int n, f32x4 lo, f32x4 hi, const float* xin_lat) {
  float v[8] = {lo[0], lo[1], lo[2], lo[3], hi[0], hi[1], hi[2], hi[3]};
  if constexpr (EPI == EPI_INPROJ) {
    const bool ropeD = (n >= C_DFQ && n < C_DFV), ropeR = (n >= C_RTQ && n < C_RTV);
    if ((ropeD || ropeR) && m < NLAT) {
      const int t = m & 4095, gr = t >> 6, gc = t & 63;
      const float2* tabD = (const float2*)(smem + G8_ROPE_LDS);
      const float2* tabR = (const float2*)(smem + G8_ROPE_LDS + 4096);
      const float2* tb;
      if (ropeD) { const int i0 = (n & 31) >> 1; tb = i0 < 8 ? tabD + gr * 8 + i0 : tabD + gc * 8 + i0 - 8; }
      else { const int i0 = (n & 63) >> 1; tb = i0 < 16 ? tabR + gr * 16 + i0 : tabR + gc * 16 + i0 - 16; }
#pragma unroll
      for (int q = 0; q < 4; ++q) {
        const float2 cs = tb[q];
        const float a0 = v[2 * q] * cs.x - v[2 * q + 1] * cs.y, a1 = v[2 * q] * cs.y + v[2 * q + 1] * cs.x;
        v[2 * q] = a0; v[2 * q + 1] = a1;
      }
    }
    float sc = 1.f;
    if (n < C_NAK) sc = 0.125f * 1.4426950408889634f;
    else if (n >= C_DFQ && n < C_DFK) sc = 0.17677669529663687f * 1.4426950408889634f;
    else if (n >= C_RTK && n < C_RTV) sc = 0.125f;
    uint4 o;
    o.x = pack2h(v[0] * sc, v[1] * sc); o.y = pack2h(v[2] * sc, v[3] * sc); o.z = pack2h(v[4] * sc, v[5] * sc); o.w = pack2h(v[6] * sc, v[7] * sc);
    *(uint4*)((bf16_t*)(p.ws + OFF_P) + (size_t)m * INC + n) = o;
  } else if constexpr (EPI == EPI_OUTPROJ) {
    const float* mod = (const float*)(p.ws + OFF_MOD) + (size_t)layer * 9 * 6144;
    const int b = m < NLAT ? (m >> 12) : 8;
    const float* gp = mod + (size_t)b * 6144 + 2 * 1024 + n;
    const float4 g0 = *(const float4*)gp, g1 = *(const float4*)(gp + 4);
    const float* xi; float* xo;
    if (m < NLAT) { xi = xin_lat + (size_t)m * 1024 + n; xo = p.out + (size_t)m * 1024 + n; }
    else { xo = (float*)(p.ws + OFF_CTXB) + (size_t)(m - NLAT) * 1024 + n; xi = xo; }
    const float4 x0 = *(const float4*)xi, x1 = *(const float4*)(xi + 4);
    float4 o0, o1;
    o0.x = x0.x + g0.x * v[0]; o0.y = x0.y + g0.y * v[1]; o0.z = x0.z + g0.z * v[2]; o0.w = x0.w + g0.w * v[3];
    o1.x = x1.x + g1.x * v[4]; o1.y = x1.y + g1.y * v[5]; o1.z = x1.z + g1.z * v[6]; o1.w = x1.w + g1.w * v[7];
    *(float4*)xo = o0; *(float4*)(xo + 4) = o1;
  } else if constexpr (EPI == EPI_PLAIN) {
    uint4 o;
    o.x = pack2h(v[0], v[1]); o.y = pack2h(v[2], v[3]); o.z = pack2h(v[4], v[5]); o.w = pack2h(v[6], v[7]);
    *(uint4*)((bf16_t*)(p.ws + OFF_P) + (size_t)m * 2048 + n) = o;
  } else {
    asm volatile("" :: "v"(v[0]), "v"(v[1]), "v"(v[2]), "v"(v[3]), "v"(v[4]), "v"(v[5]), "v"(v[6]), "v"(v[7]));
  }
}

#define G8_LAS __attribute__((address_space(3)))
__device__ __forceinline__ bool g8_next(int i, int nM, int nN, int G, int c, int& pm, int& pn) {
  using namespace g8;
  const int nwg = nM * nN;
  const long Lx = (long)i * G + c;
  if (Lx >= nwg) return false;
  int wgid = (int)Lx;
  { const int q = nwg / NXCD, r = nwg % NXCD, xcd = wgid % NXCD, off = wgid / NXCD; wgid = (xcd < r ? xcd * (q + 1) : r * (q + 1) + (xcd - r) * q) + off; }
  const int nig = WGM * nN, gid = wgid / nig, fm = gid * WGM, gsz = (nM - fm) < WGM ? (nM - fm) : WGM;
  pm = fm + ((wgid % nig) % gsz); pn = (wgid % nig) / gsz;
  return true;
}

template <int EPI>
__device__ __forceinline__ void gemm_phase2(const Params& p, int layer, char* smem, const bf16_t* A, const bf16_t* Bt,
                                            int M, int N, const float* xin_lat) {
  using namespace g8;
  constexpr int K = 1024, nt = K / BK, HTB = HALF * BK * 2;
  G8_LAS unsigned char* lds = (G8_LAS unsigned char*)smem;
  const int tid = opaque_tid();
  const int wid = __builtin_amdgcn_readfirstlane(tid >> 6), lane = tid & 63, wr = wid >> 2, wc = wid & 3, fr = lane & 15, fq = lane >> 4;
  unsigned voff[2], voffB[2];
#pragma unroll
  for (int i = 0; i < 2; ++i) {
    int R, C; stage_rc(tid * 16 + i * 8192, R, C);
    const int rho = R & 31, Rb = (R & ~31) + 8 * ((rho & 15) >> 2) + 4 * (rho >> 4) + (rho & 3);
    voff[i] = (unsigned)(R * K + C) * 2u; voffB[i] = (unsigned)(Rb * K + C) * 2u;
  }
  if constexpr (EPI == EPI_INPROJ) {
    __syncthreads();
    const float4* gsrc = (const float4*)(p.ws + OFF_ROPE);
    float4* ldst = (float4*)(smem + G8_ROPE_LDS);
    for (int i = tid; i < 12288 / 16; i += 512) ldst[i] = gsrc[i];
  }
  constexpr size_t kstep = (size_t)(BK * 2);
  constexpr size_t hstep = (size_t)HALF * K * 2;
  constexpr size_t tstep = 2 * hstep;
  const unsigned ldsw = (unsigned)wid * 1024u;
  const int aoff = lds_byte(wr * 64 + fr, fq * 8), boff = lds_byte(wc * 32 + fr, fq * 8);
#define G8_SA(b, h) (((b) * 2 + (h)) * HTB)
#define G8_SB(b, h) ((4 + (b) * 2 + (h)) * HTB)
#define G8_STAGE_V(bufoff, gbase, VO) do { _Pragma("unroll") for (int _i = 0; _i < 2; ++_i)                                  \
    __builtin_amdgcn_global_load_lds((const unsigned*)((const char*)(gbase) + VO[_i]), (G8_LAS unsigned*)(lds + (bufoff) + ldsw + _i * 8192), 16, 0, 0); } while (0)
#define G8_LDA(dst, b, h) do { _Pragma("unroll") for (int m = 0; m < 4; ++m) _Pragma("unroll") for (int k = 0; k < 2; ++k) dst[m][k] = *(const G8_LAS bf16x8*)(lds + G8_SA(b, h) + aoff + m * 2048 + k * 1024); } while (0)
#define G8_LDB(dst, b, h) do { _Pragma("unroll") for (int n = 0; n < 2; ++n) _Pragma("unroll") for (int k = 0; k < 2; ++k) dst[n][k] = *(const G8_LAS bf16x8*)(lds + G8_SB(b, h) + boff + n * 2048 + k * 1024); } while (0)
#define G8_MMA(ai, bj, At_, Bt_) do { __builtin_amdgcn_s_setprio(1);                                                          \
    _Pragma("unroll") for (int m = 0; m < 4; ++m) _Pragma("unroll") for (int n = 0; n < 2; ++n) _Pragma("unroll") for (int k = 0; k < 2; ++k) \
      acc[ai][bj][m][n] = __builtin_amdgcn_mfma_f32_16x16x32_bf16(Bt_[n][k], At_[m][k], acc[ai][bj][m][n], 0, 0, 0);          \
    __builtin_amdgcn_s_setprio(0); } while (0)
#define G8_WAIT_V(n) asm volatile("s_waitcnt vmcnt(" #n ")" ::: "memory")
#define G8_WAIT_L(n) asm volatile("s_waitcnt lgkmcnt(" #n ")" ::: "memory")
#define G8_BAR __builtin_amdgcn_s_barrier()
#define G8_SCHED __builtin_amdgcn_sched_barrier(0)
  const int nM = M / BM, nN = N / BM, G = gridDim.x, cu = opaque_bid();
  int cpm, cpn, npm = 0, npn = 0, ui = 0;
  __syncthreads();
  if (g8_next(0, nM, nN, G, cu, cpm, cpn)) {
    f32x4 acc[2][2][4][2];
#pragma unroll
    for (int a = 0; a < 2; ++a)
#pragma unroll
      for (int b2 = 0; b2 < 2; ++b2)
#pragma unroll
        for (int m = 0; m < 4; ++m)
#pragma unroll
          for (int n = 0; n < 2; ++n) acc[a][b2][m][n] = (f32x4){0.f, 0.f, 0.f, 0.f};
    bf16x8 At[4][2], B0[2][2], B1[2][2];
    const char* cA = (const char*)A + (size_t)cpm * tstep;
    const char* cB = (const char*)Bt + (size_t)cpn * tstep;
    G8_STAGE_V(G8_SB(0, 0), cB, voffB); G8_STAGE_V(G8_SA(0, 0), cA, voff); G8_STAGE_V(G8_SB(0, 1), cB + hstep, voffB); G8_STAGE_V(G8_SA(0, 1), cA + hstep, voff);
    if (wr == 1) G8_BAR;
    G8_WAIT_V(4); G8_BAR;
    G8_STAGE_V(G8_SB(1, 0), cB + kstep, voffB); G8_STAGE_V(G8_SA(1, 0), cA + kstep, voff); G8_STAGE_V(G8_SB(1, 1), cB + hstep + kstep, voffB);
    G8_WAIT_V(6); G8_BAR;
    for (;;) {
      const bool has_next = g8_next(ui + 1, nM, nN, G, cu, npm, npn);
      const char* nA = has_next ? (const char*)A + (size_t)npm * tstep : cA;
      const char* nB = has_next ? (const char*)Bt + (size_t)npn * tstep : cB;
#pragma unroll 1
      for (int t = 0; t < nt; t += 2) {
        const bool last = (t == nt - 2);
        const char* a1 = cA + (size_t)(t + 1) * kstep;
        const char* a2 = last ? nA : cA + (size_t)(t + 2) * kstep; const char* b2 = last ? nB : cB + (size_t)(t + 2) * kstep;
        const char* a3 = a2 + kstep; const char* b3 = b2 + kstep;
        G8_LDB(B0, 0, 0); G8_SCHED; G8_LDA(At, 0, 0); G8_STAGE_V(G8_SA(1, 1), a1 + hstep, voff);
        G8_WAIT_L(8); G8_BAR; G8_WAIT_L(0); G8_MMA(0, 0, At, B0); G8_BAR; G8_SCHED;
        G8_LDB(B1, 0, 1); G8_STAGE_V(G8_SB(0, 0), b2, voffB);
        G8_BAR; G8_WAIT_L(0); G8_MMA(0, 1, At, B1); G8_BAR;
        G8_LDA(At, 0, 1); G8_STAGE_V(G8_SA(0, 0), a2, voff);
        G8_BAR; G8_WAIT_L(0); G8_MMA(1, 0, At, B0); G8_BAR; G8_SCHED;
        G8_STAGE_V(G8_SB(0, 1), b2 + hstep, voffB);
        G8_WAIT_V(6); G8_BAR; G8_MMA(1, 1, At, B1); G8_BAR;
        G8_LDB(B0, 1, 0); G8_SCHED; G8_LDA(At, 1, 0); G8_STAGE_V(G8_SA(0, 1), a2 + hstep, voff);
        G8_WAIT_L(8); G8_BAR; G8_WAIT_L(0); G8_MMA(0, 0, At, B0); G8_BAR; G8_SCHED;
        G8_LDB(B1, 1, 1); G8_STAGE_V(G8_SB(1, 0), b3, voffB);
        G8_BAR; G8_WAIT_L(0); G8_MMA(0, 1, At, B1); G8_BAR;
        G8_LDA(At, 1, 1); G8_STAGE_V(G8_SA(1, 0), a3, voff);
        G8_BAR; G8_WAIT_L(0); G8_MMA(1, 0, At, B0); G8_BAR; G8_SCHED;
        G8_STAGE_V(G8_SB(1, 1), b3 + hstep, voffB);
        G8_WAIT_V(6); G8_BAR; G8_MMA(1, 1, At, B1); G8_BAR;
      }
      {
        const int brow = cpm * BM, bcol = cpn * BM;
        if constexpr (EPI == EPI_INPROJ) {
          if (bcol == C_DFK) {
#pragma unroll
            for (int bj = 0; bj < 2; ++bj) {
              float mx = 0.f;
#pragma unroll
              for (int ai = 0; ai < 2; ++ai)
#pragma unroll
                for (int m = 0; m < 4; ++m) {
                  float s = 0.f;
#pragma unroll
                  for (int n = 0; n < 2; ++n)
#pragma unroll
                    for (int j = 0; j < 4; ++j) s = fmaf(acc[ai][bj][m][n][j], acc[ai][bj][m][n][j], s);
                  s += __shfl_xor(s, 16); s += __shfl_xor(s, 32);
                  mx = fmaxf(mx, s);
                }
#pragma unroll
              for (int o = 1; o < 16; o <<= 1) mx = fmaxf(mx, __shfl_xor(mx, o));
              if (lane == 0) {
                const int bb = brow < NLAT ? (brow >> 12) : ((brow - NLAT) >> 8);
                unsigned* km = (unsigned*)(p.ws + OFF_MISC) + 64 + layer * 64 + (bb * 4 + bj * 2 + (wc >> 1)) * 2 + (wc & 1);
                atomicMax(km, __float_as_uint(mx));
              }
            }
          }
        }
#pragma unroll
        for (int ai = 0; ai < 2; ++ai)
#pragma unroll
          for (int bj = 0; bj < 2; ++bj)
#pragma unroll
            for (int m = 0; m < 4; ++m)
              epi_store8<EPI>(p, layer, smem, brow + ai * HALF + wr * 64 + m * 16 + fr, bcol + bj * HALF + wc * 32 + fq * 8,
                              acc[ai][bj][m][0], acc[ai][bj][m][1], xin_lat);
      }
      if (!has_next) break;
#pragma unroll
      for (int a = 0; a < 2; ++a)
#pragma unroll
        for (int b2 = 0; b2 < 2; ++b2)
#pragma unroll
          for (int m = 0; m < 4; ++m)
#pragma unroll
            for (int n = 0; n < 2; ++n) acc[a][b2][m][n] = (f32x4){0.f, 0.f, 0.f, 0.f};
      cpm = npm; cpn = npn; cA = nA; cB = nB; ++ui;
    }
    G8_WAIT_V(0);
    if (wr == 0) G8_BAR;
    G8_BAR;
  }
}

__device__ __forceinline__ unsigned cvt_pk_bf16(float lo, float hi) {
  unsigned r;
  asm volatile("v_cvt_pk_bf16_f32 %0, %1, %2" : "=v"(r) : "v"(lo), "v"(hi));
  return r;
}
__device__ __forceinline__ void vt_store8(bf16_t* vt, int stride, int d0, int key, uint4 uv) {
  bf16_t* vd = vt + d0 * stride + key;
  vd[0 * stride] = (bf16_t)(uv.x & 0xffffu); vd[1 * stride] = (bf16_t)(uv.x >> 16);
  vd[2 * stride] = (bf16_t)(uv.y & 0xffffu); vd[3 * stride] = (bf16_t)(uv.y >> 16);
  vd[4 * stride] = (bf16_t)(uv.z & 0xffffu); vd[5 * stride] = (bf16_t)(uv.z >> 16);
  vd[6 * stride] = (bf16_t)(uv.w & 0xffffu); vd[7 * stride] = (bf16_t)(uv.w >> 16);
}

constexpr int DKS = 72;
__device__ __forceinline__ void diff_item(const Params& p, int layer, bool ctxq, int item, char* smem) {
  const bf16_t* P = (const bf16_t*)(p.ws + OFF_P);
  bf16_t* Y = (bf16_t*)(p.ws + OFF_ACT);
  const float* misc = (const float*)(p.ws + OFF_MISC);
  const float lam = misc[layer], lam_init = misc[2 + layer];
  const int tid = opaque_tid(), lane = tid & 63, wave = tid >> 6, lr = lane & 15, lq = lane >> 4;
  int b, h, mbase, nkeys;
  if (!ctxq) { b = item >> 6; h = (item >> 4) & 3; mbase = b * 4096 + (item & 15) * 256; nkeys = 256 + 4096; }
  else { b = item >> 2; h = item & 3; mbase = NLAT + b * 256; nkeys = 256; }
  const float kmax0 = sqrtf(misc[64 + layer * 64 + (b * 4 + h) * 2 + 0]), kmax1 = sqrtf(misc[64 + layer * 64 + (b * 4 + h) * 2 + 1]);
  bf16x8 qf[2][2];
  f32x4 C0[2], C1[2];
#pragma unroll
  for (int qt = 0; qt < 2; ++qt) {
    const bf16_t* qr = P + (size_t)(mbase + wave * 32 + qt * 16 + lr) * INC + C_DFQ + h * 64 + lq * 8;
    const uint4 u0 = *(const uint4*)(qr), u1 = *(const uint4*)(qr + 32);
    float s0 = 0.f, s1 = 0.f;
    { float t[8]; UNPACK8(t, 0, u0) _Pragma("unroll") for (int i = 0; i < 8; ++i) s0 = fmaf(t[i], t[i], s0); }
    { float t[8]; UNPACK8(t, 0, u1) _Pragma("unroll") for (int i = 0; i < 8; ++i) s1 = fmaf(t[i], t[i], s1); }
    s0 += __shfl_xor(s0, 16); s0 += __shfl_xor(s0, 32);
    s1 += __shfl_xor(s1, 16); s1 += __shfl_xor(s1, 32);
    const float nm0 = -sqrtf(s0) * kmax0, nm1 = -sqrtf(s1) * kmax1;
    C0[qt] = (f32x4){nm0, nm0, nm0, nm0};
    C1[qt] = (f32x4){nm1, nm1, nm1, nm1};
    union { uint4 u; bf16x8 v; } c0, c1; c0.u = u0; c1.u = u1;
    qf[qt][0] = c0.v; qf[qt][1] = c1.v;
  }
  f32x4 O0[2][4], O1[2][4];
#pragma unroll
  for (int qt = 0; qt < 2; ++qt)
#pragma unroll
    for (int i = 0; i < 4; ++i) { O0[qt][i] = (f32x4){0.f, 0.f, 0.f, 0.f}; O1[qt][i] = (f32x4){0.f, 0.f, 0.f, 0.f}; }
  float l0[2] = {0.f, 0.f}, l1[2] = {0.f, 0.f};
  const int lkey = tid >> 3, lch = tid & 7;
  constexpr int DBUF = 2 * 128 * DKS * 2;
  uint4 ukA0, ukA1, uvA0, uvA1;
#define DF_GLOAD1(UK, UV, T, I)                                                                     \
  {                                                                                                 \
    const int kk = (T) * 128 + (I) * 64 + lkey;                                                     \
    const size_t row = kk < 256 ? (size_t)(NLAT + b * 256 + kk) : (size_t)(b * 4096 + kk - 256);    \
    UK = *(const uint4*)(P + row * INC + C_DFK + h * 64 + lch * 8);                                 \
    UV = *(const uint4*)(P + row * INC + C_DFV + h * 64 + lch * 8);                                 \
  }
#define DF_LSTORE1(UK, UV, BUF, I)                                                                  \
  {                                                                                                 \
    bf16_t* Ks_ = (bf16_t*)(smem + (BUF) * DBUF) + (I) * 64 * DKS;                                  \
    bf16_t* Vt_ = (bf16_t*)(smem + (BUF) * DBUF) + 128 * DKS + (I) * 64 * DKS;                      \
    *(uint4*)(Ks_ + lkey * DKS + lch * 8) = UK;                                                     \
    vt_store8(Vt_, DKS, lch * 8, lkey, UV);                                                         \
  }
#define DF_GLOAD(S, T) DF_GLOAD1(uk##S##0, uv##S##0, T, 0) DF_GLOAD1(uk##S##1, uv##S##1, T, 1)
#define DF_LSTORE(S, BUF) DF_LSTORE1(uk##S##0, uv##S##0, BUF, 0) DF_LSTORE1(uk##S##1, uv##S##1, BUF, 1)
  const int ntile = nkeys >> 7;
  __syncthreads();
  DF_GLOAD(A, 0)
  DF_LSTORE(A, 0)
  __syncthreads();
#pragma unroll 1
  for (int t = 0; t < ntile; ++t) {
    const int cur = t & 1;
    if (t + 1 < ntile) { DF_GLOAD(A, t + 1) }
#pragma unroll 1
    for (int sub = 0; sub < 2; ++sub) {
    const bf16_t* Ks = (const bf16_t*)(smem + cur * DBUF) + sub * 64 * DKS;
    const bf16_t* Vt = (const bf16_t*)(smem + cur * DBUF) + 128 * DKS + sub * 64 * DKS;
    union PF { unsigned u[4]; bf16x8 v; };
    PF pf0[2][2], pf1[2][2];
#pragma unroll
    for (int c = 0; c < 2; ++c) {
      f32x4 S[2][4];
#pragma unroll
      for (int kt = 0; kt < 4; ++kt) {
        const bf16x8 kf = *(const bf16x8*)(Ks + (kt * 16 + lr) * DKS + c * 32 + lq * 8);
#pragma unroll
        for (int qt = 0; qt < 2; ++qt) S[qt][kt] = __builtin_amdgcn_mfma_f32_16x16x32_bf16(kf, qf[qt][c], c == 0 ? C0[qt] : C1[qt], 0, 0, 0);
      }
#pragma unroll
      for (int qt = 0; qt < 2; ++qt) {
        float ps = 0.f;
#pragma unroll
        for (int kt = 0; kt < 4; ++kt) {
#pragma unroll
          for (int r = 0; r < 4; ++r) { S[qt][kt][r] = __builtin_amdgcn_exp2f(S[qt][kt][r]); ps += S[qt][kt][r]; }
        }
        if (c == 0) l0[qt] += ps; else l1[qt] += ps;
#pragma unroll
        for (int g = 0; g < 2; ++g) {
          PF t;
          t.u[0] = cvt_pk_bf16(S[qt][2 * g][0], S[qt][2 * g][1]); t.u[1] = cvt_pk_bf16(S[qt][2 * g][2], S[qt][2 * g][3]);
          t.u[2] = cvt_pk_bf16(S[qt][2 * g + 1][0], S[qt][2 * g + 1][1]); t.u[3] = cvt_pk_bf16(S[qt][2 * g + 1][2], S[qt][2 * g + 1][3]);
          if (c == 0) pf0[qt][g] = t; else pf1[qt][g] = t;
        }
      }
    }
#pragma unroll
    for (int g = 0; g < 2; ++g) {
#pragma unroll
      for (int dt = 0; dt < 4; ++dt) {
        union { uint2 h2[2]; bf16x8 v; } vf;
        vf.h2[0] = *(const uint2*)(Vt + (dt * 16 + lr) * DKS + 32 * g + 4 * lq);
        vf.h2[1] = *(const uint2*)(Vt + (dt * 16 + lr) * DKS + 32 * g + 16 + 4 * lq);
#pragma unroll
        for (int qt = 0; qt < 2; ++qt) {
          O0[qt][dt] = __builtin_amdgcn_mfma_f32_16x16x32_bf16(vf.v, pf0[qt][g].v, O0[qt][dt], 0, 0, 0);
          O1[qt][dt] = __builtin_amdgcn_mfma_f32_16x16x32_bf16(vf.v, pf1[qt][g].v, O1[qt][dt], 0, 0, 0);
        }
      }
    }
    }
    if (t + 1 < ntile) { DF_LSTORE(A, cur ^ 1) }
    __syncthreads();
  }
  const float* sg = p.diff_subln_g + layer * 64;
#pragma unroll
  for (int qt = 0; qt < 2; ++qt) {
    float a0 = l0[qt], a1 = l1[qt];
    a0 += __shfl_xor(a0, 16); a0 += __shfl_xor(a0, 32);
    a1 += __shfl_xor(a1, 16); a1 += __shfl_xor(a1, 32);
    const float i0 = 1.f / a0, i1 = lam / a1;
    float ss = 0.f;
#pragma unroll
    for (int dt = 0; dt < 4; ++dt) {
#pragma unroll
      for (int r = 0; r < 4; ++r) { const float v = O0[qt][dt][r] * i0 - O1[qt][dt][r] * i1; O0[qt][dt][r] = v; ss = fmaf(v, v, ss); }
    }
    ss += __shfl_xor(ss, 16); ss += __shfl_xor(ss, 32);
    const float rr = rsqrtf(ss * (1.f / 64.f) + EPS) * (1.f - lam_init);
    bf16_t* dst = Y + (size_t)(mbase + wave * 32 + qt * 16 + lr) * 1024 + Y_DF + h * 64;
#pragma unroll
    for (int dt = 0; dt < 4; ++dt) {
      const int d = dt * 16 + 4 * lq;
      const float4 g4 = *(const float4*)(sg + d);
      uint2 ov;
      ov.x = pack2(O0[qt][dt][0] * rr * g4.x, O0[qt][dt][1] * rr * g4.y);
      ov.y = pack2(O0[qt][dt][2] * rr * g4.z, O0[qt][dt][3] * rr * g4.w);
      *(uint2*)(dst + d) = ov;
    }
  }
}

constexpr int NA_WS = 520;
constexpr int NA_CS = 264;
constexpr int NA_OFF_VTW = 0;
constexpr int NA_OFF_VTC = 64 * NA_WS * 2;
constexpr int NA_OFF_RPB = NA_OFF_VTC + 64 * NA_CS * 2;
constexpr int NA_OFF_MRG = NA_OFF_RPB + 2048;

#define NA_STEP(KPTR_EXPR, BIAS_EXPR, VT_PTR, VT_STRIDE, VT_KEY0_EXPR)                                           \
  {                                                                                                               \
    f32x4 S[4];                                                                                                   \
    _Pragma("unroll") for (int kt = 0; kt < 4; ++kt) {                                                            \
      const bf16_t* kp = (KPTR_EXPR);                                                                             \
      const bf16x8 ka = *(const bf16x8*)(kp + lq * 8);                                                            \
      const bf16x8 kb = *(const bf16x8*)(kp + 32 + lq * 8);                                                       \
      f32x4 a = __builtin_amdgcn_mfma_f32_16x16x32_bf16(ka, qf[0], (f32x4){0.f, 0.f, 0.f, 0.f}, 0, 0, 0);         \
      S[kt] = __builtin_amdgcn_mfma_f32_16x16x32_bf16(kb, qf[1], a, 0, 0, 0);                                      \
    }                                                                                                             \
    _Pragma("unroll") for (int kt = 0; kt < 4; ++kt) {                                                            \
      _Pragma("unroll") for (int r = 0; r < 4; ++r) { S[kt][r] += (BIAS_EXPR); }                                  \
    }                                                                                                             \
    float x = fmaxf(fmaxf(S[0][0], S[0][1]), fmaxf(S[0][2], S[0][3]));                                            \
    _Pragma("unroll") for (int kt = 1; kt < 4; ++kt) x = fmaxf(x, fmaxf(fmaxf(S[kt][0], S[kt][1]), fmaxf(S[kt][2], S[kt][3]))); \
    x = fmaxf(x, __shfl_xor(x, 16)); x = fmaxf(x, __shfl_xor(x, 32));                                             \
    const float mn = fmaxf(mrun, x);                                                                              \
    const float al = __builtin_amdgcn_exp2f(mrun - mn);                                                           \
    mrun = mn;                                                                                                    \
    float ps = 0.f;                                                                                               \
    _Pragma("unroll") for (int kt = 0; kt < 4; ++kt) {                                                            \
      _Pragma("unroll") for (int r = 0; r < 4; ++r) { S[kt][r] = __builtin_amdgcn_exp2f(S[kt][r] - mn); ps += S[kt][r]; } \
    }                                                                                                             \
    lrun = lrun * al + ps;                                                                                        \
    _Pragma("unroll") for (int dt = 0; dt < 4; ++dt) {                                                            \
      _Pragma("unroll") for (int r = 0; r < 4; ++r) O[dt][r] *= al;                                               \
    }                                                                                                             \
    _Pragma("unroll") for (int g = 0; g < 2; ++g) {                                                               \
      union { unsigned u[4]; bf16x8 v; } pf;                                                                      \
      pf.u[0] = cvt_pk_bf16(S[2 * g][0], S[2 * g][1]); pf.u[1] = cvt_pk_bf16(S[2 * g][2], S[2 * g][3]);           \
      pf.u[2] = cvt_pk_bf16(S[2 * g + 1][0], S[2 * g + 1][1]); pf.u[3] = cvt_pk_bf16(S[2 * g + 1][2], S[2 * g + 1][3]); \
      const int vk0 = (VT_KEY0_EXPR);                                                                             \
      _Pragma("unroll") for (int dt = 0; dt < 4; ++dt) {                                                          \
        union { uint2 h2[2]; bf16x8 v; } vf;                                                                      \
        vf.h2[0] = *(const uint2*)((VT_PTR) + (dt * 16 + lr) * (VT_STRIDE) + vk0 + 4 * lq);                       \
        vf.h2[1] = *(const uint2*)((VT_PTR) + (dt * 16 + lr) * (VT_STRIDE) + vk0 + 16 + 4 * lq);                  \
        O[dt] = __builtin_amdgcn_mfma_f32_16x16x32_bf16(vf.v, pf.v, O[dt], 0, 0, 0);                              \
      }                                                                                                           \
    }                                                                                                             \
  }

__device__ __forceinline__ void na_latent_item(const Params& p, int layer, int item, char* smem) {
  const bf16_t* P = (const bf16_t*)(p.ws + OFF_P);
  bf16_t* Y = (bf16_t*)(p.ws + OFF_ACT);
  const int b = item >> 8, h = (item >> 6) & 3, grow = item & 63;
  const int tid = opaque_tid(), lane = tid & 63, wave = tid >> 6, lr = lane & 15, lq = lane >> 4;
  const int jt = wave & 3, half = wave >> 2;
  bf16_t* VtW = (bf16_t*)(smem + NA_OFF_VTW);
  bf16_t* VtC = (bf16_t*)(smem + NA_OFF_VTC);
  float* RPB = (float*)(smem + NA_OFF_RPB);
  float* MRG = (float*)(smem + NA_OFF_MRG);
  const int rs = min(max(grow - 4, 0), 56);
  __syncthreads();
  {
    const int ch = tid & 7;
#pragma unroll
    for (int i = 0; i < 8; ++i) {
      const int key = (tid >> 3) + 64 * i;
      const uint4 uv = *(const uint4*)(P + (size_t)(b * 4096 + (rs + (key >> 6)) * 64 + (key & 63)) * INC + C_NAV + h * 64 + ch * 8);
      vt_store8(VtW, NA_WS, ch * 8, key, uv);
    }
#pragma unroll
    for (int i = 0; i < 4; ++i) {
      const int key = (tid >> 3) + 64 * i;
      const uint4 uv = *(const uint4*)(P + (size_t)(NLAT + b * 256 + key) * INC + C_NAV + h * 64 + ch * 8);
      vt_store8(VtC, NA_CS, ch * 8, key, uv);
    }
    if (tid < 465) RPB[tid] = p.na_rpb[(size_t)(layer * 4 + h) * 465 + tid] * 1.4426950408889634f;
  }
  const int qc = jt * 16 + lr;
  const int mq = b * 4096 + grow * 64 + qc;
  bf16x8 qf[2];
  {
    const bf16_t* qr = P + (size_t)mq * INC + C_NAQ + h * 64 + lq * 8;
    qf[0] = *(const bf16x8*)(qr);
    qf[1] = *(const bf16x8*)(qr + 32);
  }
  f32x4 O[4];
#pragma unroll
  for (int i = 0; i < 4; ++i) O[i] = (f32x4){0.f, 0.f, 0.f, 0.f};
  float mrun = -1e30f, lrun = 0.f;
  __syncthreads();
  if (half == 0) {
    const int k0 = min(max(jt * 16 - 8, 0), 32);
    const int cs = min(max(qc - 8, 0), 48);
#pragma unroll 1
    for (int s = 0; s < 4; ++s) {
      const int wr0 = 2 * s;
      NA_STEP(P + (size_t)(b * 4096 + (rs + wr0 + (kt >> 1)) * 64 + k0 + 16 * (kt & 1) + lr) * INC + C_NAK + h * 64,
              ((k0 + 16 * (kt & 1) + 4 * lq + r) >= cs && (k0 + 16 * (kt & 1) + 4 * lq + r) < cs + 16)
                  ? RPB[(rs + wr0 + (kt >> 1) - grow + 7) * 31 + (k0 + 16 * (kt & 1) + 4 * lq + r) - qc + 15] : -1e30f,
              VtW, NA_WS, (wr0 + g) * 64 + k0)
    }
  } else {
#pragma unroll 1
    for (int s = 0; s < 4; ++s) {
      NA_STEP(P + (size_t)(NLAT + b * 256 + s * 64 + kt * 16 + lr) * INC + C_NAK + h * 64, 0.f, VtC, NA_CS, s * 64 + 32 * g)
    }
  }
  lrun += __shfl_xor(lrun, 16); lrun += __shfl_xor(lrun, 32);
  float* mg = MRG + (jt * 64 + lane) * 18;
  if (half == 1) {
    mg[0] = mrun; mg[1] = lrun;
#pragma unroll
    for (int dt = 0; dt < 4; ++dt) { mg[2 + dt * 4 + 0] = O[dt][0]; mg[2 + dt * 4 + 1] = O[dt][1]; mg[2 + dt * 4 + 2] = O[dt][2]; mg[2 + dt * 4 + 3] = O[dt][3]; }
  }
  __syncthreads();
  if (half == 0) {
    const float m2 = mg[0], l2 = mg[1];
    const float M = fmaxf(mrun, m2);
    const float f1 = __builtin_amdgcn_exp2f(mrun - M), f2 = __builtin_amdgcn_exp2f(m2 - M);
    const float inv = 1.f / (lrun * f1 + l2 * f2);
    bf16_t* dst = Y + (size_t)mq * 1024 + Y_NA + h * 64;
#pragma unroll
    for (int dt = 0; dt < 4; ++dt) {
      const float o0 = (O[dt][0] * f1 + mg[2 + dt * 4 + 0] * f2) * inv, o1 = (O[dt][1] * f1 + mg[2 + dt * 4 + 1] * f2) * inv;
      const float o2 = (O[dt][2] * f1 + mg[2 + dt * 4 + 2] * f2) * inv, o3 = (O[dt][3] * f1 + mg[2 + dt * 4 + 3] * f2) * inv;
      uint2 ov; ov.x = pack2(o0, o1); ov.y = pack2(o2, o3);
      *(uint2*)(dst + dt * 16 + 4 * lq) = ov;
    }
  }
}

__device__ __forceinline__ void na_ctx_item(const Params& p, int item, char* smem) {
  const bf16_t* P = (const bf16_t*)(p.ws + OFF_P);
  bf16_t* Y = (bf16_t*)(p.ws + OFF_ACT);
  const int b = item >> 3, h = (item >> 1) & 3, qg = item & 1;
  const int tid = opaque_tid(), lane = tid & 63, wave = tid >> 6, lr = lane & 15, lq = lane >> 4;
  bf16_t* VtC = (bf16_t*)(smem + NA_OFF_VTC);
  __syncthreads();
  {
    const int ch = tid & 7;
#pragma unroll
    for (int i = 0; i < 4; ++i) {
      const int key = (tid >> 3) + 64 * i;
      const uint4 uv = *(const uint4*)(P + (size_t)(NLAT + b * 256 + key) * INC + C_NAV + h * 64 + ch * 8);
      vt_store8(VtC, NA_CS, ch * 8, key, uv);
    }
  }
  const int mq = NLAT + b * 256 + qg * 128 + wave * 16 + lr;
  bf16x8 qf[2];
  {
    const bf16_t* qr = P + (size_t)mq * INC + C_NAQ + h * 64 + lq * 8;
    qf[0] = *(const bf16x8*)(qr);
    qf[1] = *(const bf16x8*)(qr + 32);
  }
  f32x4 O[4];
#pragma unroll
  for (int i = 0; i < 4; ++i) O[i] = (f32x4){0.f, 0.f, 0.f, 0.f};
  float mrun = -1e30f, lrun = 0.f;
  __syncthreads();
#pragma unroll 1
  for (int s = 0; s < 4; ++s) {
    NA_STEP(P + (size_t)(NLAT + b * 256 + s * 64 + kt * 16 + lr) * INC + C_NAK + h * 64, 0.f, VtC, NA_CS, s * 64 + 32 * g)
  }
  lrun += __shfl_xor(lrun, 16); lrun += __shfl_xor(lrun, 32);
  const float inv = 1.f / lrun;
  bf16_t* dst = Y + (size_t)mq * 1024 + Y_NA + h * 64;
#pragma unroll
  for (int dt = 0; dt < 4; ++dt) {
    uint2 ov; ov.x = pack2(O[dt][0] * inv, O[dt][1] * inv); ov.y = pack2(O[dt][2] * inv, O[dt][3] * inv);
    *(uint2*)(dst + dt * 16 + 4 * lq) = ov;
  }
}

constexpr int KV_S = 136;
constexpr int KV_OFF_KF = 0, KV_OFF_KB = 64 * KV_S * 2, KV_OFF_VT = 2 * 64 * KV_S * 2;
__device__ __forceinline__ void ret_kv_item(const Params& p, int layer, int h, size_t row0, int cnt, float* dstF, float* dstB, char* smem) {
  const bf16_t* P = (const bf16_t*)(p.ws + OFF_P);
  const float* misc = (const float*)(p.ws + OFF_MISC);
  const float lgF2 = misc[16 + layer * 8 + 0 * 4 + h] * 1.4426950408889634f, lgB2 = misc[16 + layer * 8 + 1 * 4 + h] * 1.4426950408889634f;
  const int tid = opaque_tid(), lane = tid & 63, wave = tid >> 6, lr = lane & 15, lq = lane >> 4;
  bf16_t* KFt = (bf16_t*)(smem + KV_OFF_KF);
  bf16_t* KBt = (bf16_t*)(smem + KV_OFF_KB);
  bf16_t* Vt = (bf16_t*)(smem + KV_OFF_VT);
  const int dir = wave >> 2, dt = wave & 3;
  f32x4 acc[8];
#pragma unroll
  for (int i = 0; i < 8; ++i) acc[i] = (f32x4){0.f, 0.f, 0.f, 0.f};
#pragma unroll 1
  for (int kc = 0; kc < (cnt >> 7); ++kc) {
    __syncthreads();
    {
      const int tok = tid >> 2, c = tid & 3;
      const int j = kc * 128 + tok;
      const float wF = __builtin_amdgcn_exp2f(lgF2 * (float)(cnt - 1 - j)), wB = __builtin_amdgcn_exp2f(lgB2 * (float)j);
      const bf16_t* rowp = P + (row0 + j) * INC;
#pragma unroll
      for (int c8 = 0; c8 < 2; ++c8) {
        const uint4 u = *(const uint4*)(rowp + C_RTK + h * 64 + c * 16 + c8 * 8);
        float kv[8];
        UNPACK8(kv, 0, u)
#pragma unroll
        for (int i = 0; i < 8; ++i) {
          KFt[(c * 16 + c8 * 8 + i) * KV_S + tok] = f2bf(kv[i] * wF);
          KBt[(c * 16 + c8 * 8 + i) * KV_S + tok] = f2bf(kv[i] * wB);
        }
      }
#pragma unroll
      for (int c8 = 0; c8 < 4; ++c8) {
        const uint4 uv = *(const uint4*)(rowp + C_RTV + h * 128 + c * 32 + c8 * 8);
        vt_store8(Vt, KV_S, c * 32 + c8 * 8, tok, uv);
      }
    }
    __syncthreads();
    const bf16_t* Kt = dir == 0 ? KFt : KBt;
    bf16x8 af[4];
#pragma unroll
    for (int ks = 0; ks < 4; ++ks) af[ks] = *(const bf16x8*)(Kt + (dt * 16 + lr) * KV_S + ks * 32 + lq * 8);
#pragma unroll
    for (int et = 0; et < 8; ++et) {
#pragma unroll
      for (int ks = 0; ks < 4; ++ks) {
        const bf16x8 bfr = *(const bf16x8*)(Vt + (et * 16 + lr) * KV_S + ks * 32 + lq * 8);
        acc[et] = __builtin_amdgcn_mfma_f32_16x16x32_bf16(af[ks], bfr, acc[et], 0, 0, 0);
      }
    }
  }
  float* dst = dir == 0 ? dstF : dstB;
#pragma unroll
  for (int et = 0; et < 8; ++et) {
#pragma unroll
    for (int r = 0; r < 4; ++r) dst[(dt * 16 + 4 * lq + r) * 128 + et * 16 + lr] = acc[et][r];
  }
}

__device__ __forceinline__ void phase_ret_scan(const Params& p, int layer) {
  const float* misc = (const float*)(p.ws + OFF_MISC);
  float* rkv = (float*)(p.ws + OFF_RKV);
  const float* rs = (const float*)(p.ws + OFF_RS);
  const int gt = opaque_bid() * 512 + opaque_tid(), gs = gridDim.x * 512;
  for (int idx = gt; idx < 64 * 2048; idx += gs) {
    const int seq = idx >> 11, e4 = (idx & 2047) * 4;
    const int dir = seq & 1, h = (seq >> 1) & 3;
    const float cdec = __expf(misc[16 + layer * 8 + dir * 4 + h] * 128.f);
    float4* base = (float4*)(rkv + (size_t)seq * 32 * 8192 + e4);
    float4 v[32];
#pragma unroll
    for (int s = 0; s < 32; ++s) v[s] = base[(size_t)s * 2048];
    float4 st = *(const float4*)(rs + (size_t)seq * 8192 + e4);
    if (dir == 0) {
#pragma unroll
      for (int s = 0; s < 32; ++s) {
        const float4 t = v[s];
        base[(size_t)s * 2048] = st;
        st.x = fmaf(cdec, st.x, t.x); st.y = fmaf(cdec, st.y, t.y); st.z = fmaf(cdec, st.z, t.z); st.w = fmaf(cdec, st.w, t.w);
      }
    } else {
#pragma unroll
      for (int s = 31; s >= 0; --s) {
        const float4 t = v[s];
        base[(size_t)s * 2048] = st;
        st.x = fmaf(cdec, st.x, t.x); st.y = fmaf(cdec, st.y, t.y); st.z = fmaf(cdec, st.z, t.z); st.w = fmaf(cdec, st.w, t.w);
      }
    }
  }
}

constexpr int RT_KS = 72, RT_VS = 136;
constexpr int RT_OFF_K = 0, RT_OFF_VT = 128 * RT_KS * 2, RT_OFF_SF = RT_OFF_VT + 128 * RT_VS * 2, RT_OFF_SB = RT_OFF_SF + 128 * RT_KS * 2;
__device__ __forceinline__ void ret_out_item(const Params& p, int layer, int h, size_t krow0, int nkc, int iq0,
                                             const float* SF, const float* SB, int clen, char* smem) {
  const bf16_t* P = (const bf16_t*)(p.ws + OFF_P);
  bf16_t* Y = (bf16_t*)(p.ws + OFF_ACT);
  const float* misc = (const float*)(p.ws + OFF_MISC);
  const float lgF2 = misc[16 + layer * 8 + 0 * 4 + h] * 1.4426950408889634f, lgB2 = misc[16 + layer * 8 + 1 * 4 + h] * 1.4426950408889634f;
  const int tid = opaque_tid(), lane = tid & 63, wave = tid >> 6, lr = lane & 15, lq = lane >> 4;
  bf16_t* Ks = (bf16_t*)(smem + RT_OFF_K);
  bf16_t* Vt = (bf16_t*)(smem + RT_OFF_VT);
  bf16_t* SFt = (bf16_t*)(smem + RT_OFF_SF);
  bf16_t* SBt = (bf16_t*)(smem + RT_OFF_SB);
  const int iq = iq0 + wave * 16 + lr;
  const size_t mq = krow0 + iq;
  bf16x8 qf[2];
  {
    const bf16_t* qr = P + mq * INC + C_RTQ + h * 64 + lq * 8;
    qf[0] = *(const bf16x8*)(qr);
    qf[1] = *(const bf16x8*)(qr + 32);
  }
  f32x4 O[8];
#pragma unroll
  for (int i = 0; i < 8; ++i) O[i] = (f32x4){0.f, 0.f, 0.f, 0.f};
  if (SF != nullptr) {
    __syncthreads();
    {
      const int d = tid >> 3, e0 = (tid & 7) * 16;
#pragma unroll
      for (int c4 = 0; c4 < 4; ++c4) {
        const float4 a = *(const float4*)(SF + d * 128 + e0 + c4 * 4);
        const float4 bb = *(const float4*)(SB + d * 128 + e0 + c4 * 4);
        SFt[(e0 + c4 * 4 + 0) * RT_KS + d] = f2bf(a.x); SFt[(e0 + c4 * 4 + 1) * RT_KS + d] = f2bf(a.y);
        SFt[(e0 + c4 * 4 + 2) * RT_KS + d] = f2bf(a.z); SFt[(e0 + c4 * 4 + 3) * RT_KS + d] = f2bf(a.w);
        SBt[(e0 + c4 * 4 + 0) * RT_KS + d] = f2bf(bb.x); SBt[(e0 + c4 * 4 + 1) * RT_KS + d] = f2bf(bb.y);
        SBt[(e0 + c4 * 4 + 2) * RT_KS + d] = f2bf(bb.z); SBt[(e0 + c4 * 4 + 3) * RT_KS + d] = f2bf(bb.w);
      }
    }
    __syncthreads();
    const float cF = __builtin_amdgcn_exp2f(lgF2 * (float)(iq + 1)), cB = __builtin_amdgcn_exp2f(lgB2 * (float)(clen - iq));
#pragma unroll
    for (int ks = 0; ks < 2; ++ks)
#pragma unroll
      for (int et = 0; et < 8; ++et) {
        const bf16x8 sf = *(const bf16x8*)(SFt + (et * 16 + lr) * RT_KS + ks * 32 + lq * 8);
        O[et] = __builtin_amdgcn_mfma_f32_16x16x32_bf16(sf, qf[ks], O[et], 0, 0, 0);
      }
    const float ratio = cF / cB;
#pragma unroll
    for (int et = 0; et < 8; ++et) { O[et][0] *= ratio; O[et][1] *= ratio; O[et][2] *= ratio; O[et][3] *= ratio; }
#pragma unroll
    for (int ks = 0; ks < 2; ++ks)
#pragma unroll
      for (int et = 0; et < 8; ++et) {
        const bf16x8 sb = *(const bf16x8*)(SBt + (et * 16 + lr) * RT_KS + ks * 32 + lq * 8);
        O[et] = __builtin_amdgcn_mfma_f32_16x16x32_bf16(sb, qf[ks], O[et], 0, 0, 0);
      }
#pragma unroll
    for (int et = 0; et < 8; ++et) { O[et][0] *= cB; O[et][1] *= cB; O[et][2] *= cB; O[et][3] *= cB; }
  }
#pragma unroll 1
  for (int kc = 0; kc < nkc; ++kc) {
    __syncthreads();
    {
      const int key = tid >> 2, c = tid & 3;
      const bf16_t* rowp = P + (krow0 + kc * 128 + key) * INC;
      const uint4 k0 = *(const uint4*)(rowp + C_RTK + h * 64 + c * 16), k1 = *(const uint4*)(rowp + C_RTK + h * 64 + c * 16 + 8);
      *(uint4*)(Ks + key * RT_KS + c * 16) = k0;
      *(uint4*)(Ks + key * RT_KS + c * 16 + 8) = k1;
#pragma unroll
      for (int c8 = 0; c8 < 4; ++c8) {
        const uint4 uv = *(const uint4*)(rowp + C_RTV + h * 128 + c * 32 + c8 * 8);
        vt_store8(Vt, RT_VS, c * 32 + c8 * 8, key, uv);
      }
    }
    __syncthreads();
    f32x4 S[8];
#pragma unroll
    for (int kt = 0; kt < 8; ++kt) {
      const bf16x8 ka = *(const bf16x8*)(Ks + (kt * 16 + lr) * RT_KS + lq * 8);
      const bf16x8 kb = *(const bf16x8*)(Ks + (kt * 16 + lr) * RT_KS + 32 + lq * 8);
      const f32x4 a = __builtin_amdgcn_mfma_f32_16x16x32_bf16(ka, qf[0], (f32x4){0.f, 0.f, 0.f, 0.f}, 0, 0, 0);
      S[kt] = __builtin_amdgcn_mfma_f32_16x16x32_bf16(kb, qf[1], a, 0, 0, 0);
    }
#pragma unroll
    for (int kt = 0; kt < 8; ++kt) {
#pragma unroll
      for (int r = 0; r < 4; ++r) {
        const int df = iq - (kc * 128 + kt * 16 + 4 * lq + r);
        const float fdf = (float)df;
        float coef = 0.f;
        if (df >= 0) coef += __builtin_amdgcn_exp2f(lgF2 * fdf);
        if (df <= 0) coef += __builtin_amdgcn_exp2f(-lgB2 * fdf);
        S[kt][r] *= coef;
      }
    }
#pragma unroll
    for (int g = 0; g < 4; ++g) {
      union { unsigned u[4]; bf16x8 v; } pf;
      pf.u[0] = cvt_pk_bf16(S[2 * g][0], S[2 * g][1]); pf.u[1] = cvt_pk_bf16(S[2 * g][2], S[2 * g][3]);
      pf.u[2] = cvt_pk_bf16(S[2 * g + 1][0], S[2 * g + 1][1]); pf.u[3] = cvt_pk_bf16(S[2 * g + 1][2], S[2 * g + 1][3]);
#pragma unroll
      for (int et = 0; et < 8; ++et) {
        union { uint2 h2[2]; bf16x8 v; } vf;
        vf.h2[0] = *(const uint2*)(Vt + (et * 16 + lr) * RT_VS + 32 * g + 4 * lq);
        vf.h2[1] = *(const uint2*)(Vt + (et * 16 + lr) * RT_VS + 32 * g + 16 + 4 * lq);
        O[et] = __builtin_amdgcn_mfma_f32_16x16x32_bf16(vf.v, pf.v, O[et], 0, 0, 0);
      }
    }
  }
  float ss = 0.f;
#pragma unroll
  for (int et = 0; et < 8; ++et) { ss = fmaf(O[et][0], O[et][0], ss); ss = fmaf(O[et][1], O[et][1], ss); ss = fmaf(O[et][2], O[et][2], ss); ss = fmaf(O[et][3], O[et][3], ss); }
  ss += __shfl_xor(ss, 16); ss += __shfl_xor(ss, 32);
  const float rr = rsqrtf(ss * (1.f / 128.f) + EPS);
  const bf16_t* gp = P + mq * INC + C_RTG + h * 128;
  bf16_t* dst = Y + mq * 1024 + Y_RT + h * 128;
#pragma unroll
  for (int et = 0; et < 8; ++et) {
    const int e = et * 16 + 4 * lq;
    const uint2 gu = *(const uint2*)(gp + e);
    uint2 ov;
    ov.x = pack2(O[et][0] * rr * siluf(lo16(gu.x)), O[et][1] * rr * siluf(hi16(gu.x)));
    ov.y = pack2(O[et][2] * rr * siluf(lo16(gu.y)), O[et][3] * rr * siluf(hi16(gu.y)));
    *(uint2*)(dst + e) = ov;
  }
}

__device__ __forceinline__ void uv_convert_item(const Params& p, int item) {
  char* ws = p.ws;
  const int tid = opaque_tid();
  const int lane = tid & 63, l = lane & 31, half = lane >> 5, wave = tid >> 6;
#pragma unroll 1
  for (int it = 0; it < 16; ++it) {
    const int row = item * 256 + (wave * 16 + it) * 2 + half;
    const bool isv = row >= 2 * NEXP;
    const int rr = isv ? row - 2 * NEXP : row;
    const float* srow = (isv ? p.peer_v : p.peer_u) + (size_t)rr * 1024;
    float4 v[8];
    float mx = 0.f;
#pragma unroll
    for (int j = 0; j < 8; ++j) {
      v[j] = ((const float4*)srow)[l + 32 * j];
      mx = fmaxf(mx, fmaxf(fmaxf(fabsf(v[j].x), fabsf(v[j].y)), fmaxf(fabsf(v[j].z), fabsf(v[j].w))));
    }
#pragma unroll
    for (int o = 1; o < 32; o <<= 1) mx = fmaxf(mx, __shfl_xor(mx, o));
    const float scale = mx > 0.f ? mx * (1.f / 7.5f) : 1.f;
    const float inv = 1.f / scale;
    unsigned w[6] = {0u, 0u, 0u, 0u, 0u, 0u};
#pragma unroll
    for (int k = 0; k < 32; ++k) {
      const float xv = (k & 3) == 0 ? v[k >> 2].x : (k & 3) == 1 ? v[k >> 2].y : (k & 3) == 2 ? v[k >> 2].z : v[k >> 2].w;
      const float a = fminf(fabsf(xv) * inv, 7.5f);
      float c;
      if (a < 2.f) c = rintf(a * 8.f);
      else if (a < 4.f) c = 16.f + rintf((a - 2.f) * 4.f);
      else c = 24.f + rintf((a - 4.f) * 2.f);
      unsigned code = (unsigned)c;
      code = code > 31u ? 31u : code;
      code |= (xv < 0.f) ? 32u : 0u;
      const int bit = 6 * k, wd = bit >> 5, sh = bit & 31;
      w[wd] |= code << sh;
      if (sh > 26) w[wd + 1] |= code >> (32 - sh);
    }
    char* drow = ws + OFF_U + (size_t)rr * RECB + (isv ? ROWB : 0) + l * 24;
    *(uint2*)(drow) = make_uint2(w[0], w[1]);
    *(uint2*)(drow + 8) = make_uint2(w[2], w[3]);
    *(uint2*)(drow + 16) = make_uint2(w[4], w[5]);
    if (l == 0) ((float*)(ws + (isv ? OFF_VSC : OFF_USC)))[rr] = scale;
  }
}

__device__ __forceinline__ void phase_mix1(const Params& p, int layer, char* smem, int slot = 0) {
  unsigned* ctr = (unsigned*)(p.ws + OFF_CTL) + (layer * 4 + slot);
  const bool nc = layer == 0;
  const int n_dl = 512, n_dc = nc ? 32 : 0, n_uv = nc ? 256 : 0, n_nl = 2048, n_ncx = nc ? 64 : 0, n_kv = 1024, n_cs = 32;
  const int total = n_dl + n_dc + n_uv + n_nl + n_ncx + n_kv + n_cs;
  float* rkv = (float*)(p.ws + OFF_RKV);
  float* rs = (float*)(p.ws + OFF_RS);
  for (;;) {
    int it = next_item(ctr, smem);
    if (it >= total) break;
    if (it < n_dl) { diff_item(p, layer, false, it, smem); continue; } it -= n_dl;
    if (it < n_dc) { diff_item(p, layer, true, it, smem); continue; } it -= n_dc;
    if (it < n_uv) { uv_convert_item(p, it); continue; } it -= n_uv;
    if (it < n_nl) { na_latent_item(p, layer, it, smem); continue; } it -= n_nl;
    if (it < n_ncx) { na_ctx_item(p, it, smem); continue; } it -= n_ncx;
    if (it < n_kv) {
      const int bh = it >> 5, n = it & 31, b = bh >> 2, h = bh & 3;
      ret_kv_item(p, layer, h, (size_t)b * 4096 + n * 128, 128,
                  rkv + ((size_t)(bh * 2 + 0) * 32 + n) * 8192, rkv + ((size_t)(bh * 2 + 1) * 32 + n) * 8192, smem);
      continue;
    }
    it -= n_kv;
    {
      const int bh = it, b = bh >> 2, h = bh & 3;
      ret_kv_item(p, layer, h, (size_t)NLAT + b * 256, 256, rs + (size_t)(bh * 2 + 0) * 8192, rs + (size_t)(bh * 2 + 1) * 8192, smem);
    }
  }
}

__device__ __forceinline__ void phase_mix2(const Params& p, int layer, char* smem, int slot = 1) {
  unsigned* ctr = (unsigned*)(p.ws + OFF_CTL) + (layer * 4 + slot);
  const int n_l = 1024, n_c = layer == 0 ? 64 : 0;
  const float* rkv = (const float*)(p.ws + OFF_RKV);
  for (;;) {
    int it = next_item(ctr, smem);
    if (it >= n_l + n_c) break;
    if (it < n_l) {
      const int bh = it >> 5, n = it & 31, b = bh >> 2, h = bh & 3;
      ret_out_item(p, layer, h, (size_t)b * 4096 + n * 128, 1, 0,
                   rkv + ((size_t)(bh * 2 + 0) * 32 + n) * 8192, rkv + ((size_t)(bh * 2 + 1) * 32 + n) * 8192, 128, smem);
    } else {
      it -= n_l;
      const int bh = it >> 1, half = it & 1, b = bh >> 2, h = bh & 3;
      ret_out_item(p, layer, h, (size_t)NLAT + b * 256, 2, half * 128, nullptr, nullptr, 256, smem);
    }
  }
}

typedef float f32x2 __attribute__((ext_vector_type(2)));
__device__ __forceinline__ unsigned sortable_key(float f, int idx) {
  const unsigned b = __float_as_uint(f);
  const unsigned k = b ^ ((unsigned)((int)b >> 31) | 0x80000000u);
  return (k & ~127u) | (unsigned)(127 - idx);
}
__device__ __forceinline__ float key_value(unsigned k) {
  k &= ~127u;
  const unsigned b = (k & 0x80000000u) ? (k ^ 0x80000000u) : ~k;
  return __uint_as_float(b);
}
#define FP8DOT(acc, H, off, W) { const f32x2 _a = __builtin_amdgcn_cvt_pk_f32_fp8((int)(W), false), _b = __builtin_amdgcn_cvt_pk_f32_fp8((int)(W), true); \
  acc = fmaf(H[(off) + 0], _a.x, acc); acc = fmaf(H[(off) + 1], _a.y, acc); acc = fmaf(H[(off) + 2], _b.x, acc); acc = fmaf(H[(off) + 3], _b.y, acc); }
#define FP8AXPY(O, off, P, W) { const f32x2 _a = __builtin_amdgcn_cvt_pk_f32_fp8((int)(W), false), _b = __builtin_amdgcn_cvt_pk_f32_fp8((int)(W), true); \
  O[(off) + 0] = fmaf(P, _a.x, O[(off) + 0]); O[(off) + 1] = fmaf(P, _a.y, O[(off) + 1]); O[(off) + 2] = fmaf(P, _b.x, O[(off) + 2]); O[(off) + 3] = fmaf(P, _b.y, O[(off) + 3]); }

__device__ __forceinline__ float gelu_erf(float a) {
  const float x = fabsf(a) * 0.70710678118654752f;
  const float t = __builtin_amdgcn_rcpf(fmaf(0.3275911f, x, 1.f));
  float pl = fmaf(1.061405429f, t, -1.453152027f);
  pl = fmaf(pl, t, 1.421413741f); pl = fmaf(pl, t, -0.284496736f); pl = fmaf(pl, t, 0.254829592f);
  const float y = 1.f - pl * t * __builtin_amdgcn_exp2f(-x * x * 1.4426950408889634f);
  const float er = a < 0.f ? -y : y;
  return 0.5f * a * (1.f + er);
}
constexpr int PE_SVS = 132;
constexpr int PE_OFF_SV = 0;
constexpr int PE_OFF_TV = 8 * 16 * PE_SVS * 4;
constexpr int PE_OFF_TI = PE_OFF_TV + 16 * 16 * 16 * 4;
constexpr int PE_OFF_EX = PE_OFF_TI + 16 * 16 * 16 * 4;
constexpr int PE_OFF_GT = PE_OFF_EX + 1 * 16 * 128 * 4;
constexpr int PE_OFF_SU = PE_OFF_GT + 1 * 16 * 128 * 4;
constexpr int PE_OFF_CN = PE_OFF_SU + 1 * 16 * 128 * 4;
constexpr int PE_OFF_CT = PE_OFF_CN + 8 * 16 * 4;
#define WAVE_LDS_FENCE() asm volatile("s_waitcnt lgkmcnt(0)" ::: "memory")

__device__ __forceinline__ void peer_select_head(const Params& p, int layer, char* smem, int tok0, int hd, int sw, int buf,
                                                 int lane) {
  const bf16_t* Q = (const bf16_t*)(p.ws + OFF_P);
  const bf16_t* SK = (const bf16_t*)(p.ws + OFF_SUBK) + (size_t)layer * 262144;
  const int lr = lane & 15, lq = lane >> 4;
  unsigned* SV = (unsigned*)(smem + PE_OFF_SV) + sw * 16 * PE_SVS;
  float* TV = (float*)(smem + PE_OFF_TV);
  int* TI = (int*)(smem + PE_OFF_TI);
  int* EX = (int*)(smem + PE_OFF_EX) + buf * 16 * 128;
  float* GT = (float*)(smem + PE_OFF_GT) + buf * 16 * 128;
  int* CN = (int*)(smem + PE_OFF_CN) + sw * 16;
  float* SU = (float*)(smem + PE_OFF_SU) + buf * 16 * 128;
  const float* USC = (const float*)(p.ws + OFF_USC) + layer * NEXP;
  const float* VSC = (const float*)(p.ws + OFF_VSC) + layer * NEXP;
#pragma unroll 1
  for (int pp = 0; pp < 2; ++pp) {
    bf16x8 af[4];
    const bf16_t* qrow = Q + (size_t)(tok0 + lr) * 2048 + hd * 256 + pp * 128;
#pragma unroll
    for (int ks = 0; ks < 4; ++ks) af[ks] = *(const bf16x8*)(qrow + ks * 32 + lq * 8);
    const bf16_t* skb = SK + (size_t)((hd * 2 + pp) * 128) * 128;
    f32x4 acc[8];
    {
      bf16x8 bfr[8][4];
#pragma unroll
      for (int nt = 0; nt < 8; ++nt)
#pragma unroll
        for (int ks = 0; ks < 4; ++ks)
          bfr[nt][ks] = *(const bf16x8*)(skb + (size_t)(nt * 16 + lr) * 128 + ks * 32 + lq * 8);
#pragma unroll
      for (int nt = 0; nt < 8; ++nt) {
        f32x4 a = (f32x4){0.f, 0.f, 0.f, 0.f};
#pragma unroll
        for (int ks = 0; ks < 4; ++ks) a = __builtin_amdgcn_mfma_f32_16x16x32_bf16(af[ks], bfr[nt][ks], a, 0, 0, 0);
        acc[nt] = a;
      }
    }
#pragma unroll
    for (int i = 0; i < 9; ++i) { const int q4 = lane + 64 * i; if (q4 < 16 * PE_SVS / 4) ((uint4*)SV)[q4] = make_uint4(0u, 0u, 0u, 0u); }
    WAVE_LDS_FENCE();
#pragma unroll
    for (int r = 0; r < 4; ++r) {
      const int tk = 4 * lq + r;
      unsigned k[8];
#pragma unroll
      for (int nt = 0; nt < 8; ++nt) k[nt] = sortable_key(acc[nt][r], nt * 16 + lr);
      unsigned gm = k[0];
#pragma unroll
      for (int nt = 1; nt < 8; ++nt) gm = max(gm, k[nt]);
      unsigned T = gm;
      T = min(T, (unsigned)__shfl_xor((int)T, 1)); T = min(T, (unsigned)__shfl_xor((int)T, 2));
      T = min(T, (unsigned)__shfl_xor((int)T, 4)); T = min(T, (unsigned)__shfl_xor((int)T, 8));
      int pos = 0;
#pragma unroll
      for (int nt = 0; nt < 8; ++nt) {
        const bool sel = k[nt] >= T;
        const unsigned long long bal = __ballot(sel);
        const unsigned grp16 = (unsigned)(bal >> (16 * lq)) & 0xffffu;
        const int below = __popc(grp16 & ((1u << lr) - 1u));
        if (sel) SV[tk * PE_SVS + pos + below] = k[nt];
        pos += __popc(grp16);
      }
      if (lr == 0) CN[tk] = pos;
    }
    WAVE_LDS_FENCE();
#pragma unroll 1
    for (int pass = 0; pass < 4; ++pass) {
      const int tk = pass * 4 + lq;
      const int cnt = CN[tk];
      const unsigned* row = SV + tk * PE_SVS;
      int cm = cnt;
      cm = max(cm, __shfl_xor(cm, 16)); cm = max(cm, __shfl_xor(cm, 32));
      const int cmax = __builtin_amdgcn_readfirstlane(cm);
      const int nblk = (cmax + 15) >> 4;
#pragma unroll 1
      for (int rd = 0; rd < nblk; ++rd) {
        const int j = rd * 16 + lr;
        const unsigned my = row[j];
        int rank = 0;
#pragma unroll 1
        for (int b4 = 0; b4 < nblk; ++b4) {
          const uint4 v0 = *(const uint4*)(row + b4 * 16), v1 = *(const uint4*)(row + b4 * 16 + 4);
          const uint4 v2 = *(const uint4*)(row + b4 * 16 + 8), v3 = *(const uint4*)(row + b4 * 16 + 12);
          rank += (v0.x > my) ? 1 : 0; rank += (v0.y > my) ? 1 : 0; rank += (v0.z > my) ? 1 : 0; rank += (v0.w > my) ? 1 : 0;
          rank += (v1.x > my) ? 1 : 0; rank += (v1.y > my) ? 1 : 0; rank += (v1.z > my) ? 1 : 0; rank += (v1.w > my) ? 1 : 0;
          rank += (v2.x > my) ? 1 : 0; rank += (v2.y > my) ? 1 : 0; rank += (v2.z > my) ? 1 : 0; rank += (v2.w > my) ? 1 : 0;
          rank += (v3.x > my) ? 1 : 0; rank += (v3.y > my) ? 1 : 0; rank += (v3.z > my) ? 1 : 0; rank += (v3.w > my) ? 1 : 0;
        }
        if (j < cnt && rank < 16) {
          TV[(tk * 16 + hd * 2 + pp) * 16 + rank] = key_value(my);
          TI[(tk * 16 + hd * 2 + pp) * 16 + rank] = 127 - (int)(my & 127u);
        }
      }
    }
    WAVE_LDS_FENCE();
  }
  {
    const int cab = ((const int*)(smem + PE_OFF_CT))[lane];
    const int cand_a = cab >> 4, cand_b = cab & 15;
    unsigned* CWt = SV;
    float vals[16];
#pragma unroll
    for (int tk = 0; tk < 16; ++tk) {
      float val = 0.f;
      unsigned key = 0u;
      if (cand_a >= 0) {
        val = TV[(tk * 16 + hd * 2 + 0) * 16 + cand_a] + TV[(tk * 16 + hd * 2 + 1) * 16 + cand_b];
        const unsigned bb = __float_as_uint(val);
        key = ((bb ^ ((unsigned)((int)bb >> 31) | 0x80000000u)) & ~63u) | (unsigned)(63 - lane);
      }
      vals[tk] = val;
      CWt[tk * 64 + lane] = key;
    }
    WAVE_LDS_FENCE();
#pragma unroll
    for (int tk = 0; tk < 16; ++tk) {
      const unsigned key = CWt[tk * 64 + lane];
      int rank = 0;
#pragma unroll
      for (int i4 = 0; i4 < 13; ++i4) {
        const uint4 v = *(const uint4*)(CWt + tk * 64 + i4 * 4);
        rank += (v.x > key) ? 1 : 0; rank += (v.y > key) ? 1 : 0; rank += (v.z > key) ? 1 : 0; rank += (v.w > key) ? 1 : 0;
      }
      if (cand_a >= 0 && rank < 16) {
        GT[tk * 128 + hd * 16 + rank] = vals[tk];
        EX[tk * 128 + hd * 16 + rank] = TI[(tk * 16 + hd * 2 + 0) * 16 + cand_a] * 128 + TI[(tk * 16 + hd * 2 + 1) * 16 + cand_b];
      }
    }
    WAVE_LDS_FENCE();
#pragma unroll
    for (int pass = 0; pass < 4; ++pass) {
      const int tk = pass * 4 + lq;
      const float g = GT[tk * 128 + hd * 16 + lr];
      const float mx = GT[tk * 128 + hd * 16];
      const float ev = __expf(g - mx);
      float s = ev;
      s += __shfl_xor(s, 1); s += __shfl_xor(s, 2); s += __shfl_xor(s, 4); s += __shfl_xor(s, 8);
      const int ex = EX[tk * 128 + hd * 16 + lr];
      GT[tk * 128 + hd * 16 + lr] = (ev / s) * VSC[ex];
      SU[tk * 128 + hd * 16 + lr] = USC[ex];
    }
    WAVE_LDS_FENCE();
  }
}

typedef float f32x32 __attribute__((ext_vector_type(32)));
typedef unsigned u32x6 __attribute__((ext_vector_type(6)));
struct Fp6Row { uint4 a; uint2 b; };
__device__ __forceinline__ f32x32 fp6_decode(const Fp6Row& r) {
  u32x6 w; w[0] = r.a.x; w[1] = r.a.y; w[2] = r.a.z; w[3] = r.a.w; w[4] = r.b.x; w[5] = r.b.y;
  return __builtin_amdgcn_cvt_scalef32_pk32_f32_fp6(w, 1.0f);
}
__device__ __forceinline__ void peer_gather_token(const Params& p, int layer, char* smem, int tok, int tl, int buf, int lane, bool dowrite) {
  const bf16_t* H2 = (const bf16_t*)(p.ws + OFF_ACT);
  const char* U6 = p.ws + OFF_U + (size_t)layer * NEXP * RECB;
  const char* V6 = U6 + ROWB;
  const float* mod = (const float*)(p.ws + OFF_MOD) + (size_t)layer * 9 * 6144;
  const int* EX = (const int*)(smem + PE_OFF_EX) + buf * 16 * 128 + tl * 128;
  const float* GT = (const float*)(smem + PE_OFF_GT) + buf * 16 * 128 + tl * 128;
  const float* SU = (const float*)(smem + PE_OFF_SU) + buf * 16 * 128 + tl * 128;
  const int l = lane & 31, hf = lane >> 5;
  float hv[32], acc[32];
  {
    const bf16_t* hr = H2 + (size_t)tok * 1024;
#pragma unroll
    for (int j = 0; j < 8; ++j) {
      const uint2 u = *(const uint2*)(hr + (l + 32 * j) * 4);
      hv[4 * j + 0] = lo16(u.x); hv[4 * j + 1] = hi16(u.x); hv[4 * j + 2] = lo16(u.y); hv[4 * j + 3] = hi16(u.y);
    }
  }
#pragma unroll
  for (int i = 0; i < 32; ++i) acc[i] = 0.f;
  Fp6Row ua[2], va[2], ub[2], vb[2];
  int one = 1;
  asm volatile("" : "+s"(one));
#define PE_LOAD_SET(UU, VV, E0)                                                       \
  _Pragma("unroll") for (int j = 0; j < 2; ++j) {                                     \
    const int ex = EX[(E0) + 2 * j + hf];                                             \
    const char* up = U6 + (size_t)ex * RECB + l * 24;                                 \
    UU[j].a = *(const uint4*)up; UU[j].b = *(const uint2*)(up + 16);                  \
    VV[j].a = *(const uint4*)(up + ROWB); VV[j].b = *(const uint2*)(up + ROWB + 16);  \
  }
#define PE_USE_SET(UU, VV, E0)                                                        \
  _Pragma("unroll 1") for (int rep_ = 0; rep_ < one; ++rep_) {                        \
  _Pragma("unroll") for (int j = 0; j < 2; ++j) {                                     \
    const f32x32 du = fp6_decode(UU[j]);                                              \
    float d0 = 0.f, d1 = 0.f, d2 = 0.f, d3 = 0.f;                                     \
    _Pragma("unroll") for (int k = 0; k < 32; k += 4) {                               \
      d0 = fmaf(hv[k], du[k], d0); d1 = fmaf(hv[k + 1], du[k + 1], d1); d2 = fmaf(hv[k + 2], du[k + 2], d2); d3 = fmaf(hv[k + 3], du[k + 3], d3); \
    }                                                                                 \
    const float r16 = row16_sum((d0 + d1) + (d2 + d3));                               \
    const int ir = __float_as_int(r16);                                               \
    const float s0 = __int_as_float(__builtin_amdgcn_readlane(ir, 0)) + __int_as_float(__builtin_amdgcn_readlane(ir, 16));  \
    const float s1 = __int_as_float(__builtin_amdgcn_readlane(ir, 32)) + __int_as_float(__builtin_amdgcn_readlane(ir, 48)); \
    const float d = (hf ? s1 : s0) * SU[(E0) + 2 * j + hf];                           \
    const float w = GT[(E0) + 2 * j + hf] * gelu_erf(d);                              \
    const f32x32 dv = fp6_decode(VV[j]);                                              \
    _Pragma("unroll") for (int k = 0; k < 32; ++k) acc[k] = fmaf(w, dv[k], acc[k]);   \
  } }
  PE_LOAD_SET(ua, va, 0)
#pragma unroll 1
  for (int e0 = 0; e0 < 120; e0 += 8) {
    PE_LOAD_SET(ub, vb, e0 + 4)
    PE_USE_SET(ua, va, e0)
    PE_LOAD_SET(ua, va, e0 + 8)
    PE_USE_SET(ub, vb, e0 + 4)
  }
  PE_LOAD_SET(ub, vb, 124)
  PE_USE_SET(ua, va, 120)
  PE_USE_SET(ub, vb, 124)
#pragma unroll
  for (int k = 0; k < 32; ++k) acc[k] += __shfl_xor(acc[k], 32);
  const int b = tok < NLAT ? (tok >> 12) : 8;
  float* xr = tok < NLAT ? p.out + (size_t)tok * 1024 : (float*)(p.ws + OFF_CTXB) + (size_t)(tok - NLAT) * 1024;
  const float* gate = mod + (size_t)b * 6144 + 5 * 1024;
  float4 xn[4];
  float ss = 0.f;
#pragma unroll
  for (int jj = 0; jj < 4; ++jj) {
    const int c = (l + 32 * (4 * hf + jj)) * 4;
    const float4 xv = *(const float4*)(xr + c);
    const float4 gv = *(const float4*)(gate + c);
    const float a0 = hf ? acc[16 + 4 * jj + 0] : acc[4 * jj + 0], a1 = hf ? acc[16 + 4 * jj + 1] : acc[4 * jj + 1];
    const float a2 = hf ? acc[16 + 4 * jj + 2] : acc[4 * jj + 2], a3 = hf ? acc[16 + 4 * jj + 3] : acc[4 * jj + 3];
    xn[jj].x = xv.x + gv.x * a0; xn[jj].y = xv.y + gv.y * a1; xn[jj].z = xv.z + gv.z * a2; xn[jj].w = xv.w + gv.w * a3;
    ss += xn[jj].x * xn[jj].x + xn[jj].y * xn[jj].y + xn[jj].z * xn[jj].z + xn[jj].w * xn[jj].w;
  }
  ss = wave_sum(ss);
  const float rinv = rsqrtf(ss * (1.f / 1024.f) + EPS);
  if (layer == 0) {
    const float* mod1 = (const float*)(p.ws + OFF_MOD) + (size_t)9 * 6144 + (size_t)b * 6144;
    const float* g1 = p.norm1_g + 1024;
    bf16_t* act = (bf16_t*)(p.ws + OFF_ACT) + (size_t)tok * 1024;
#pragma unroll
    for (int jj = 0; jj < 4; ++jj) {
      const int c = (l + 32 * (4 * hf + jj)) * 4;
      if (dowrite) *(float4*)(xr + c) = xn[jj]; else asm volatile("" :: "v"(xn[jj].x), "v"(xn[jj].y), "v"(xn[jj].z), "v"(xn[jj].w));
      const float4 gg4 = *(const float4*)(g1 + c);
      const float4 sh = *(const float4*)(mod1 + c);
      const float4 sc = *(const float4*)(mod1 + 1024 + c);
      uint2 o;
      o.x = pack2h(xn[jj].x * rinv * gg4.x * (1.f + sc.x) + sh.x, xn[jj].y * rinv * gg4.y * (1.f + sc.y) + sh.y);
      o.y = pack2h(xn[jj].z * rinv * gg4.z * (1.f + sc.z) + sh.z, xn[jj].w * rinv * gg4.w * (1.f + sc.w) + sh.w);
      if (dowrite) *(uint2*)(act + c) = o; else asm volatile("" :: "v"(o.x), "v"(o.y));
    }
  } else {
#pragma unroll
    for (int jj = 0; jj < 4; ++jj) {
      const int c = (l + 32 * (4 * hf + jj)) * 4;
      const float4 gg4 = *(const float4*)(p.final_g + c);
      float4 o;
      o.x = xn[jj].x * rinv * gg4.x; o.y = xn[jj].y * rinv * gg4.y; o.z = xn[jj].z * rinv * gg4.z; o.w = xn[jj].w * rinv * gg4.w;
      if (dowrite) *(float4*)(xr + c) = o; else asm volatile("" :: "v"(o.x), "v"(o.y), "v"(o.z), "v"(o.w));
    }
  }
}

__device__ __forceinline__ void phase_peer(const Params& p, int layer, char* smem, int ntok, bool dowrite = true) {
  const int tid = opaque_tid(), lane = tid & 63, wave = __builtin_amdgcn_readfirstlane(tid >> 6);
  __syncthreads();
  if (tid < 64) {
    int cab = -1, c = 0;
    for (int a = 0; a < 16; ++a)
      for (int bb = 0; bb < 16; ++bb)
        if ((a + 1) * (bb + 1) <= 16) { if (c == tid) cab = a * 16 + bb; ++c; }
    ((int*)(smem + PE_OFF_CT))[tid] = cab;
  }
  const int ngroups = ntok / 16, G = gridDim.x, g0 = opaque_bid();
  __syncthreads();
  for (int grp = g0; grp < ngroups; grp += G) {
    peer_select_head(p, layer, smem, grp * 16, wave, wave, 0, lane);
    __syncthreads();
#pragma unroll 1
    for (int tt = 0; tt < 2; ++tt) peer_gather_token(p, layer, smem, grp * 16 + wave * 2 + tt, wave * 2 + tt, 0, lane, dowrite);
    __syncthreads();
  }
}

template <int layer>
__device__ __forceinline__ void layer_body(const Params& p, char* smem, const XcdBarrier& xb) {
  constexpr bool nc = layer == 0;
  const float* xin = layer == 0 ? p.x : (const float*)p.out;
  if (layer == 0) {
    phase_norm(p, layer, 0, xin, NTOK);
    xcd_barrier(xb);
  }
#if REP_GEMM
  gemm_phase2<EPI_INPROJ>(p, layer, smem, (const bf16_t*)(p.ws + OFF_ACT), (const bf16_t*)(p.ws + OFF_WIN) + (size_t)layer * 3072 * 1024, NTOK, 3072, nullptr);
  xcd_barrier(xb);
#endif
  gemm_phase2<EPI_INPROJ>(p, layer, smem, (const bf16_t*)(p.ws + OFF_ACT), (const bf16_t*)(p.ws + OFF_WIN) + (size_t)layer * 3072 * 1024, NTOK, 3072, nullptr);
  xcd_barrier(xb);
#if REP_MIX1
  phase_mix1(p, layer, smem, 2);
  xcd_barrier(xb);
#endif
  phase_mix1(p, layer, smem);
  xcd_barrier(xb);
  phase_ret_scan(p, layer);
  xcd_barrier(xb);
#if REP_MIX2
  phase_mix2(p, layer, smem, 3);
  xcd_barrier(xb);
#endif
  phase_mix2(p, layer, smem);
  xcd_barrier(xb);
  gemm_phase2<EPI_OUTPROJ>(p, layer, smem, (const bf16_t*)(p.ws + OFF_ACT), (const bf16_t*)(p.ws + OFF_WOUT) + (size_t)layer * 1024 * 1024, nc ? NTOK : NLAT, 1024, xin);
  xcd_barrier(xb);
  phase_norm(p, layer, 1, (const float*)p.out, nc ? NTOK : NLAT);
  xcd_barrier(xb);
  gemm_phase2<EPI_PLAIN>(p, layer, smem, (const bf16_t*)(p.ws + OFF_ACT), (const bf16_t*)(p.ws + OFF_WQ) + (size_t)layer * 2048 * 1024, nc ? NTOK : NLAT, 2048, nullptr);
  xcd_barrier(xb);
#if REP_PEER
  phase_peer(p, layer, smem, nc ? NTOK : NLAT, false);
  xcd_barrier(xb);
#endif
  phase_peer(p, layer, smem, nc ? NTOK : NLAT);
  if (layer == 0) xcd_barrier(xb);
}

__global__ void __launch_bounds__(512) fwd_megakernel(Params p) {
  cg::grid_group grid = cg::this_grid();
  extern __shared__ __attribute__((aligned(16))) char smem[];
  volatile LAS3 unsigned* xst = (volatile LAS3 unsigned*)(smem + LDS_BCAST + 8);
  if (threadIdx.x == 0) { xst[0] = 0u; xst[1] = 0u; }
  phase_prep(p, smem);
  grid.sync();
  const XcdBarrier xb = xcd_barrier_post((unsigned*)(p.ws + OFF_XBAR), xst);
  layer_body<0>(p, smem, xb);
  layer_body<1>(p, smem, xb);
}

extern "C" void kernel_launch(void* const* d_in, const int* in_sizes, int n_in, void* d_out,
                              int out_size, void* d_ws, size_t ws_size, hipStream_t stream) {
  constexpr size_t kDynLds = LDS_BYTES;
  static int grid_blocks = 0;
  if (!grid_blocks) {
    int dev = 0, cus = 0, per_cu = 0;
    (void)hipGetDevice(&dev);
    (void)hipDeviceGetAttribute(&cus, hipDeviceAttributeMultiprocessorCount, dev);
    (void)hipFuncSetAttribute((const void*)fwd_megakernel, hipFuncAttributeMaxDynamicSharedMemorySize, (int)kDynLds);
    (void)hipOccupancyMaxActiveBlocksPerMultiprocessor(&per_cu, fwd_megakernel, 512, kDynLds);
    if (per_cu < 1) { fprintf(stderr, "occupancy query says %d blocks/CU\n", per_cu); per_cu = 1; }
    grid_blocks = cus;
    if (ws_size < WS_END) fprintf(stderr, "workspace too small: %zu < %zu\n", ws_size, (size_t)WS_END);
  }
  Params p{};
  p.x = (const float*)d_in[0]; p.c = (const float*)d_in[1]; p.ctx = (const float*)d_in[2]; p.c_ctx = (const float*)d_in[3];
  p.w_ada = (const float*)d_in[4]; p.b_ada = (const float*)d_in[5]; p.norm1_g = (const float*)d_in[6]; p.w_in = (const float*)d_in[7];
  p.na_rpb = (const float*)d_in[8]; p.diff_lambda = (const float*)d_in[9]; p.diff_subln_g = (const float*)d_in[10];
  p.ret_decay_logit = (const float*)d_in[11]; p.w_out = (const float*)d_in[12]; p.norm2_g = (const float*)d_in[13];
  p.peer_wq = (const float*)d_in[14]; p.peer_subkeys = (const float*)d_in[15]; p.peer_u = (const float*)d_in[16];
  p.peer_v = (const float*)d_in[17]; p.final_g = (const float*)d_in[18];
  p.out = (float*)d_out; p.ws = (char*)d_ws;
  void* args[] = {&p};
  hipError_t e = hipLaunchCooperativeKernel((void*)fwd_megakernel, dim3(grid_blocks), dim3(512), args, kDynLds, stream);
  if (e != hipSuccess) fprintf(stderr, "cooperative launch failed: %s (grid %d)\n", hipGetErrorString(e), grid_blocks);
}
```

```cpp
#include <hip/hip_runtime.h>
#include <hip/hip_cooperative_groups.h>
#include <cstdio>
#include <cstdint>
namespace cg = cooperative_groups;

typedef unsigned short bf16_t;
typedef short bf16x8 __attribute__((ext_vector_type(8)));
typedef float f32x4 __attribute__((ext_vector_type(4)));

constexpr int DM = 1024, BATCH = 8, SEQ = 4096, LCTX = 256;
constexpr int NLAT = BATCH * SEQ;
constexpr int NCTX = BATCH * LCTX;
constexpr int NTOK = NLAT + NCTX;
constexpr int INC = 3072;
constexpr int C_NAQ = 0, C_NAK = 256, C_NAV = 512, C_DFQ = 768, C_DFK = 1024, C_DFV = 1280,
              C_RTQ = 1536, C_RTK = 1792, C_RTV = 2048, C_RTG = 2560;
constexpr int Y_NA = 0, Y_DF = 256, Y_RT = 512;
constexpr int NEXP = 16384;
constexpr float EPS = 1e-6f;

constexpr size_t OFF_CTL  = 0;
constexpr size_t OFF_MISC = 4096;
constexpr size_t OFF_ROPE = 8192;
constexpr size_t OFF_MOD  = OFF_ROPE + 12288;
constexpr size_t SZ_MOD   = 2ull * 9 * 6144 * 4;
constexpr size_t OFF_WIN  = OFF_MOD + SZ_MOD;
constexpr size_t SZ_WIN   = 2ull * 3072 * 1024 * 2;
constexpr size_t OFF_WOUT = OFF_WIN + SZ_WIN;
constexpr size_t SZ_WOUT  = 2ull * 1024 * 1024 * 2;
constexpr size_t OFF_WQ   = OFF_WOUT + SZ_WOUT;
constexpr size_t SZ_WQ    = 2ull * 2048 * 1024 * 2;
constexpr size_t OFF_SUBK = OFF_WQ + SZ_WQ;
constexpr size_t SZ_SUBK  = 2ull * 262144 * 2;
constexpr size_t OFF_U    = OFF_SUBK + SZ_SUBK;
constexpr int    ROWB     = 768;
constexpr int    RECB     = 2 * ROWB;
constexpr size_t SZ_UV    = 2ull * NEXP * ROWB;
constexpr size_t OFF_V    = OFF_U + SZ_UV;
constexpr size_t OFF_USC  = OFF_V + SZ_UV;
constexpr size_t OFF_VSC  = OFF_USC + 2ull * NEXP * 4;
constexpr size_t OFF_ACT  = OFF_VSC + 2ull * NEXP * 4;
constexpr size_t SZ_ACT   = (size_t)NTOK * 1024 * 2;
constexpr size_t OFF_P    = OFF_ACT + SZ_ACT;
constexpr size_t SZ_P     = (size_t)NTOK * 3072 * 2;
constexpr size_t OFF_CTXB = OFF_P + SZ_P;
constexpr size_t SZ_CTXB  = (size_t)NCTX * 1024 * 4;
constexpr size_t OFF_RKV  = OFF_CTXB + SZ_CTXB;
constexpr size_t SZ_RKV   = 64ull * 32 * 8192 * 4;
constexpr size_t OFF_RS   = OFF_RKV + SZ_RKV;
constexpr size_t SZ_RS    = 64ull * 8192 * 4;
constexpr size_t OFF_XBAR = OFF_RS + SZ_RS;
constexpr size_t WS_END   = OFF_XBAR + 16384;

#ifndef REP_MIX1
#define REP_MIX1 0
#endif
#ifndef REP_MIX2
#define REP_MIX2 0
#endif
#ifndef REP_PEER
#define REP_PEER 0
#endif
#ifndef REP_GEMM
#define REP_GEMM 0
#endif
constexpr int LDS_BYTES = 144 * 1024;
constexpr int LDS_BCAST = LDS_BYTES - 16;

struct Params {
  const float *x, *c, *ctx, *c_ctx, *w_ada, *b_ada, *norm1_g, *w_in, *na_rpb, *diff_lambda, *diff_subln_g,
              *ret_decay_logit, *w_out, *norm2_g, *peer_wq, *peer_subkeys, *peer_u, *peer_v, *final_g;
  float* out;
  char* ws;
};

__device__ __forceinline__ float bf2f(bf16_t v) { return __uint_as_float(((unsigned)v) << 16); }
__device__ __forceinline__ bf16_t f2bf(float f) {
  unsigned u = __float_as_uint(f);
  u += 0x7fffu + ((u >> 16) & 1u);
  return (bf16_t)(u >> 16);
}
__device__ __forceinline__ unsigned pack2(float a, float b) { return (unsigned)f2bf(a) | ((unsigned)f2bf(b) << 16); }
__device__ __forceinline__ unsigned pack2h(float a, float b) {
  unsigned r;
  asm("v_cvt_pk_bf16_f32 %0, %1, %2" : "=v"(r) : "v"(a), "v"(b));
  return r;
}
__device__ __forceinline__ float lo16(unsigned w) { return __uint_as_float(w << 16); }
__device__ __forceinline__ float hi16(unsigned w) { return __uint_as_float(w & 0xffff0000u); }
#define DPP_ADD(v, CTRL) ((v) + __int_as_float(__builtin_amdgcn_update_dpp(0, __float_as_int(v), (CTRL), 0xf, 0xf, true)))
__device__ __forceinline__ float row16_sum(float v) {
  v = DPP_ADD(v, 0xB1);
  v = DPP_ADD(v, 0x4E);
  v = DPP_ADD(v, 0x141);
  v = DPP_ADD(v, 0x140);
  return v;
}
#define DPP_MOVU(v, CTRL) ((unsigned)__builtin_amdgcn_update_dpp(0, (int)(v), (CTRL), 0xf, 0xf, true))
__device__ __forceinline__ unsigned row16_max_u32(unsigned v) {
  v = max(v, DPP_MOVU(v, 0xB1)); v = max(v, DPP_MOVU(v, 0x4E)); v = max(v, DPP_MOVU(v, 0x141)); v = max(v, DPP_MOVU(v, 0x140));
  return v;
}
__device__ __forceinline__ unsigned row16_min_u32(unsigned v) {
  v = min(v, DPP_MOVU(v, 0xB1)); v = min(v, DPP_MOVU(v, 0x4E)); v = min(v, DPP_MOVU(v, 0x141)); v = min(v, DPP_MOVU(v, 0x140));
  return v;
}
template <int KTH>
__device__ __forceinline__ unsigned row16_kth_largest(unsigned v) {
  int cnt = 0;
#define R8_STEP(N) { const unsigned o = DPP_MOVU(v, 0x120 + (N)); cnt += (o > v) ? 1 : 0; }
  R8_STEP(1) R8_STEP(2) R8_STEP(3) R8_STEP(4) R8_STEP(5) R8_STEP(6) R8_STEP(7) R8_STEP(8)
  R8_STEP(9) R8_STEP(10) R8_STEP(11) R8_STEP(12) R8_STEP(13) R8_STEP(14) R8_STEP(15)
#undef R8_STEP
  return row16_max_u32(cnt >= KTH - 1 ? v : 0u);
}
__device__ __forceinline__ float wave_sum(float v) {
  v = row16_sum(v);
  const int iv = __float_as_int(v);
  const float a = __int_as_float(__builtin_amdgcn_readlane(iv, 0)), b = __int_as_float(__builtin_amdgcn_readlane(iv, 16));
  const float c = __int_as_float(__builtin_amdgcn_readlane(iv, 32)), d = __int_as_float(__builtin_amdgcn_readlane(iv, 48));
  return (a + b) + (c + d);
}
__device__ __forceinline__ float siluf(float x) { return x / (1.f + __expf(-x)); }

__device__ __forceinline__ int opaque_tid() { int t = threadIdx.x; asm volatile("" : "+v"(t)); return t; }
__device__ __forceinline__ int opaque_bid() { int t = blockIdx.x; asm volatile("" : "+s"(t)); return t; }

#define DOT8(acc, Q, off, U)                                                              \
  acc = fmaf(Q[(off) + 0], lo16((U).x), acc); acc = fmaf(Q[(off) + 1], hi16((U).x), acc); \
  acc = fmaf(Q[(off) + 2], lo16((U).y), acc); acc = fmaf(Q[(off) + 3], hi16((U).y), acc); \
  acc = fmaf(Q[(off) + 4], lo16((U).z), acc); acc = fmaf(Q[(off) + 5], hi16((U).z), acc); \
  acc = fmaf(Q[(off) + 6], lo16((U).w), acc); acc = fmaf(Q[(off) + 7], hi16((U).w), acc);
#define AXPY8(O, off, P, U)                                                                   \
  O[(off) + 0] = fmaf(P, lo16((U).x), O[(off) + 0]); O[(off) + 1] = fmaf(P, hi16((U).x), O[(off) + 1]); \
  O[(off) + 2] = fmaf(P, lo16((U).y), O[(off) + 2]); O[(off) + 3] = fmaf(P, hi16((U).y), O[(off) + 3]); \
  O[(off) + 4] = fmaf(P, lo16((U).z), O[(off) + 4]); O[(off) + 5] = fmaf(P, hi16((U).z), O[(off) + 5]); \
  O[(off) + 6] = fmaf(P, lo16((U).w), O[(off) + 6]); O[(off) + 7] = fmaf(P, hi16((U).w), O[(off) + 7]);
#define UNPACK8(Q, off, U)                                                  \
  Q[(off) + 0] = lo16((U).x); Q[(off) + 1] = hi16((U).x); Q[(off) + 2] = lo16((U).y); Q[(off) + 3] = hi16((U).y); \
  Q[(off) + 4] = lo16((U).z); Q[(off) + 5] = hi16((U).z); Q[(off) + 6] = lo16((U).w); Q[(off) + 7] = hi16((U).w);

__device__ __forceinline__ int next_item(unsigned* counter, char* smem) {
  volatile int* bc = (volatile int*)(smem + LDS_BCAST);
  __syncthreads();
  if (threadIdx.x == 0) *bc = (int)atomicAdd(counter, 1u);
  __syncthreads();
  return *bc;
}

#define XB_TMO      128
#define XB_XCNT(j)  (256  + 64 * (j))
#define XB_XSUB(j)  (1280 + 64 * (j))
#define XB_XGEN(j)  (2304 + 64 * (j))
#define XB_TOP      3328
#define XB_TOPGEN   3392
#define XCD_BAR_WORDS 3456
#define XB_SPIN_CAP (1u << 18)
#define LAS3 __attribute__((address_space(3)))
__device__ __forceinline__ unsigned xb_ld(unsigned* p)              { return __hip_atomic_load(p, __ATOMIC_RELAXED, __HIP_MEMORY_SCOPE_AGENT); }
__device__ __forceinline__ unsigned xb_add(unsigned* p, unsigned v) { return __hip_atomic_fetch_add(p, v, __ATOMIC_RELAXED, __HIP_MEMORY_SCOPE_AGENT); }
__device__ __forceinline__ unsigned xb_xcc_id() { return (unsigned)__builtin_amdgcn_s_getreg((3 << 11) | 20) & 0xFu; }
#define XB_SPIN(cond, bar) do { unsigned _sp = 0; while (cond) { __builtin_amdgcn_s_sleep(1); \
    if ((++_sp & 255u) == 0u) { if (xb_ld(&(bar)[XB_TMO])) break; if (_sp > XB_SPIN_CAP) { atomicAdd(&(bar)[XB_TMO], 1u); break; } } } } while (0)
struct XcdBarrier { unsigned* bar; unsigned x; volatile LAS3 unsigned* st; };
__device__ __forceinline__ XcdBarrier xcd_barrier_post(unsigned* bar, volatile LAS3 unsigned* st) {
  XcdBarrier b; b.bar = bar; b.x = xb_xcc_id(); b.st = st;
  if (threadIdx.x == 0) (void)xb_add(&bar[XB_XCNT(b.x)], 1u);
  return b;
}
__device__ __forceinline__ void xcd_barrier_complete(unsigned* bar, unsigned x, unsigned& nloc, unsigned& nx) {
  const unsigned G = gridDim.x * gridDim.y * gridDim.z;
  unsigned sum, cnt, mine, sp = 0u;
  for (;;) {
    sum = 0u; cnt = 0u; mine = 0u;
#pragma unroll
    for (unsigned j = 0; j < 16; ++j) { const unsigned c = xb_ld(&bar[XB_XCNT(j)]); sum += c; cnt += (c > 0u) ? 1u : 0u; mine = (j == x) ? c : mine; }
    if (sum == G) break;
    __builtin_amdgcn_s_sleep(1);
    if ((++sp & 255u) == 0u) { if (xb_ld(&bar[XB_TMO])) break; if (sp > XB_SPIN_CAP) { atomicAdd(&bar[XB_TMO], 1u); break; } }
  }
  nloc = mine > 0u ? mine : 1u; nx = cnt > 0u ? cnt : 1u;
}
__device__ __forceinline__ void xcd_barrier(const XcdBarrier& b) {
  asm volatile("s_waitcnt vmcnt(0)" ::: "memory");
  __syncthreads();
  if (threadIdx.x == 0) {
    unsigned* bar = b.bar;
    __builtin_amdgcn_s_waitcnt(0);
    unsigned nloc = b.st[0], nx = b.st[1];
    if (nloc == 0u) { xcd_barrier_complete(bar, b.x, nloc, nx); b.st[0] = nloc; b.st[1] = nx; }
    const unsigned old = xb_add(&bar[XB_XSUB(b.x)], 1u);
    const unsigned gen = old / nloc;
    if (old + 1u == (gen + 1u) * nloc) {
      __builtin_amdgcn_fence(__ATOMIC_RELEASE, "agent");
      asm volatile("s_waitcnt vmcnt(0)" ::: "memory");
      const unsigned og = xb_add(&bar[XB_TOP], 1u);
      const unsigned tg = og / nx;
      if (og + 1u == (tg + 1u) * nx) xb_add(&bar[XB_TOPGEN], 1u);
      else XB_SPIN(xb_ld(&bar[XB_TOPGEN]) == tg, bar);
      __builtin_amdgcn_fence(__ATOMIC_ACQUIRE, "agent");
      xb_add(&bar[XB_XGEN(b.x)], 1u);
      asm volatile("s_waitcnt vmcnt(0)" ::: "memory");
    } else {
      XB_SPIN(xb_ld(&bar[XB_XGEN(b.x)]) == gen, bar);
      __builtin_amdgcn_fence(__ATOMIC_ACQUIRE, "agent");
      asm volatile("s_waitcnt vmcnt(0)" ::: "memory");
    }
  }
  __syncthreads();
}

__device__ __forceinline__ void transpose_item(const float* src, bf16_t* dst, int K, int N, int item, char* smem) {
  float* t = (float*)smem;
  const int nb = N / 64;
  const int k0 = (item / nb) * 64, n0 = (item % nb) * 64;
  const int tid = opaque_tid();
  __syncthreads();
#pragma unroll
  for (int i = 0; i < 8; ++i) {
    const int k = (tid >> 6) + 8 * i, n = tid & 63;
    t[k * 65 + n] = src[(size_t)(k0 + k) * N + n0 + n];
  }
  __syncthreads();
#pragma unroll
  for (int i = 0; i < 8; ++i) {
    const int n = (tid >> 6) + 8 * i, k = tid & 63;
    dst[(size_t)(n0 + n) * K + k0 + k] = f2bf(t[k * 65 + n]);
  }
}

__device__ __forceinline__ void convert_flat(const float* src, bf16_t* dst, size_t n4) {
  const size_t gt = (size_t)opaque_bid() * blockDim.x + opaque_tid(), gs = (size_t)gridDim.x * blockDim.x;
  for (size_t i = gt; i < n4; i += gs) {
    const float4 v = ((const float4*)src)[i];
    uint2 o; o.x = pack2h(v.x, v.y); o.y = pack2h(v.z, v.w);
    ((uint2*)dst)[i] = o;
  }
}

__device__ __forceinline__ void phase_prep(const Params& p, char* smem) {
  const int tid = opaque_tid();
  char* ws = p.ws;
  if (opaque_bid() == 0) {
    unsigned* ctl = (unsigned*)(ws + OFF_CTL);
    if (tid < 64) ctl[tid] = 0u;
    unsigned* xbar = (unsigned*)(ws + OFF_XBAR);
    for (int i = tid; i < XCD_BAR_WORDS; i += 512) xbar[i] = 0u;
    float* misc = (float*)(ws + OFF_MISC);
    if (tid < 2) {
      const float* lp = p.diff_lambda + tid * 128;
      float s01 = 0.f, s23 = 0.f;
      for (int i = 0; i < 32; ++i) { s01 += lp[i] * lp[32 + i]; s23 += lp[64 + i] * lp[96 + i]; }
      const float lam_init = 0.8f - 0.6f * expf(-0.3f * (float)tid);
      misc[tid] = expf(s01) - expf(s23) + lam_init;
      misc[2 + tid] = lam_init;
    }
    if (tid >= 128 && tid < 256) misc[64 + tid - 128] = 0.f;
    if (tid >= 64 && tid < 80) {
      const int i = tid - 64;
      const float xv = p.ret_decay_logit[i];
      misc[16 + i] = -log1pf(expf(-xv));
    }
    float2* ropeD = (float2*)(ws + OFF_ROPE);
    float2* ropeR = (float2*)(ws + OFF_ROPE + 4096);
    for (int i = tid; i < 64 * 8; i += 512) {
      const int v = i >> 3, f = i & 7;
      const float inv = powf(10000.0f, -(float)(2 * f) / 16.0f);
      const float ang = (float)v * inv;
      ropeD[i] = make_float2(cosf(ang), sinf(ang));
    }
    for (int i = tid; i < 64 * 16; i += 512) {
      const int v = i >> 4, f = i & 15;
      const float inv = powf(10000.0f, -(float)(2 * f) / 32.0f);
      const float ang = (float)v * inv;
      ropeR[i] = make_float2(cosf(ang), sinf(ang));
    }
  }
  {
    float* sc = (float*)smem;
    float* red = (float*)(smem + 9 * 1024 * 4);
    float* mod = (float*)(ws + OFF_MOD);
    for (int item = opaque_bid(); item < 192; item += gridDim.x) {
      const int l = item / 96, cb = item % 96;
      __syncthreads();
      for (int i = tid; i < 9 * 1024; i += 512) {
        const int r = i >> 10, k = i & 1023;
        const float cv = (r < 8) ? p.c[r * 1024 + k] : p.c_ctx[k];
        sc[i] = siluf(cv);
      }
      __syncthreads();
      const int col = tid & 63, ks = tid >> 6;
      float acc[9];
#pragma unroll
      for (int r = 0; r < 9; ++r) acc[r] = 0.f;
      const float* w = p.w_ada + (size_t)l * 1024 * 6144 + cb * 64 + col;
#pragma unroll 1
      for (int k0 = ks * 128; k0 < ks * 128 + 128; k0 += 16) {
        float wv[16];
#pragma unroll
        for (int i = 0; i < 16; ++i) wv[i] = w[(size_t)(k0 + i) * 6144];
#pragma unroll
        for (int i = 0; i < 16; ++i)
#pragma unroll
          for (int r = 0; r < 9; ++r) acc[r] = fmaf(sc[r * 1024 + k0 + i], wv[i], acc[r]);
      }
#pragma unroll
      for (int r = 0; r < 9; ++r) red[(ks * 9 + r) * 64 + col] = acc[r];
      __syncthreads();
      for (int i = tid; i < 576; i += 512) {
        const int r = i >> 6, cc = i & 63;
        float s = 0.f;
#pragma unroll
        for (int k8 = 0; k8 < 8; ++k8) s += red[(k8 * 9 + r) * 64 + cc];
        mod[((size_t)l * 9 + r) * 6144 + cb * 64 + cc] = s + p.b_ada[l * 6144 + cb * 64 + cc];
      }
    }
    __syncthreads();
  }
  for (int item = opaque_bid(); item < 3072; item += gridDim.x) {
    const int l = item / 1536;
    int r = item % 1536;
    if (r < 768) transpose_item(p.w_in + (size_t)l * 1024 * 3072, (bf16_t*)(ws + OFF_WIN) + (size_t)l * 3072 * 1024, 1024, 3072, r, smem);
    else if (r < 1024) transpose_item(p.w_out + (size_t)l * 1024 * 1024, (bf16_t*)(ws + OFF_WOUT) + (size_t)l * 1024 * 1024, 1024, 1024, r - 768, smem);
    else transpose_item(p.peer_wq + (size_t)l * 1024 * 2048, (bf16_t*)(ws + OFF_WQ) + (size_t)l * 2048 * 1024, 1024, 2048, r - 1024, smem);
  }
  convert_flat(p.peer_subkeys, (bf16_t*)(ws + OFF_SUBK), 2ull * 262144 / 4);
  {
    const size_t gt = (size_t)opaque_bid() * blockDim.x + tid, gs = (size_t)gridDim.x * blockDim.x;
    float4* dst = (float4*)(ws + OFF_CTXB);
    for (size_t i = gt; i < (size_t)NCTX * 1024 / 4; i += gs) dst[i] = ((const float4*)p.ctx)[i];
  }
}

__device__ __forceinline__ void phase_norm(const Params& p, int layer, int which, const float* xlat, int nrows) {
  const int lane = opaque_tid() & 63;
  const int gw = opaque_bid() * 8 + (opaque_tid() >> 6), nw = gridDim.x * 8;
  const float* g = (which == 0 ? p.norm1_g : p.norm2_g) + layer * 1024;
  const float* mod = (const float*)(p.ws + OFF_MOD) + (size_t)layer * 9 * 6144;
  const float* ctxb = (const float*)(p.ws + OFF_CTXB);
  bf16_t* act = (bf16_t*)(p.ws + OFF_ACT);
  const int sh_off = which == 0 ? 0 : 3 * 1024, sc_off = which == 0 ? 1024 : 4 * 1024;
  for (int row = gw; row < nrows; row += nw) {
    const float* src = row < NLAT ? xlat + (size_t)row * 1024 : ctxb + (size_t)(row - NLAT) * 1024;
    const int b = row < NLAT ? (row >> 12) : 8;
    const float* mrow = mod + (size_t)b * 6144;
    float4 v[4];
    float ss = 0.f;
#pragma unroll
    for (int j = 0; j < 4; ++j) {
      v[j] = ((const float4*)src)[lane + 64 * j];
      ss += v[j].x * v[j].x + v[j].y * v[j].y + v[j].z * v[j].z + v[j].w * v[j].w;
    }
    ss = wave_sum(ss);
    const float r = rsqrtf(ss * (1.f / 1024.f) + EPS);
#pragma unroll
    for (int j = 0; j < 4; ++j) {
      const int c = (lane + 64 * j) * 4;
      const float4 gg = *(const float4*)(g + c);
      const float4 sh = *(const float4*)(mrow + sh_off + c);
      const float4 sc = *(const float4*)(mrow + sc_off + c);
      const float o0 = v[j].x * r * gg.x * (1.f + sc.x) + sh.x;
      const float o1 = v[j].y * r * gg.y * (1.f + sc.y) + sh.y;
      const float o2 = v[j].z * r * gg.z * (1.f + sc.z) + sh.z;
      const float o3 = v[j].w * r * gg.w * (1.f + sc.w) + sh.w;
      uint2 o; o.x = pack2h(o0, o1); o.y = pack2h(o2, o3);
      *(uint2*)(act + (size_t)row * 1024 + c) = o;
    }
  }
}

__device__ __forceinline__ void phase_final(const Params& p) {
  const int lane = opaque_tid() & 63;
  const int gw = opaque_bid() * 8 + (opaque_tid() >> 6), nw = gridDim.x * 8;
  for (int row = gw; row < NLAT; row += nw) {
    float* src = p.out + (size_t)row * 1024;
    float4 v[4];
    float ss = 0.f;
#pragma unroll
    for (int j = 0; j < 4; ++j) {
      v[j] = ((const float4*)src)[lane + 64 * j];
      ss += v[j].x * v[j].x + v[j].y * v[j].y + v[j].z * v[j].z + v[j].w * v[j].w;
    }
    ss = wave_sum(ss);
    const float r = rsqrtf(ss * (1.f / 1024.f) + EPS);
#pragma unroll
    for (int j = 0; j < 4; ++j) {
      const int c = (lane + 64 * j) * 4;
      const float4 gg = *(const float4*)(p.final_g + c);
      float4 o;
      o.x = v[j].x * r * gg.x; o.y = v[j].y * r * gg.y; o.z = v[j].z * r * gg.z; o.w = v[j].w * r * gg.w;
      ((float4*)src)[lane + 64 * j] = o;
    }
  }
}

constexpr int EPI_INPROJ = 0, EPI_OUTPROJ = 1, EPI_PLAIN = 2;
constexpr int GS = 72;
constexpr int G_ASTAGE = 256 * GS * 2;
constexpr int G_BSTAGE = 128 * GS * 2;
constexpr int G_STAGE = G_ASTAGE + G_BSTAGE;

namespace g8 {
constexpr int BM = 256, BK = 64, HALF = 128, NXCD = 8, WGM = 8, HT = HALF * BK;
__device__ __forceinline__ int lds_byte(int r, int c) {
  const int st = (r >> 4) * 2 + (c >> 5), rr = r & 15, cc = c & 31, ob = rr * 64 + cc * 2;
  return st * 1024 + (ob ^ (((ob >> 9) & 1) << 5));
}
__device__ __forceinline__ void stage_rc(int b, int& R, int& C) {
  const int st = b / 1024, sb = b % 1024, swz = sb ^ (((sb >> 9) & 1) << 5);
  R = (st >> 1) * 16 + swz / 64; C = (st & 1) * 32 + (swz % 64) / 2;
}
}

constexpr int G8_ROPE_LDS = 8 * 16384;
template <int EPI>
__device__ __forceinline__ void epi_store8(const Params& p, int layer, char* smem, int m, int n, f32x4 lo, f32x4 hi, const float* xin_lat) {
  float v[8] = {lo[0], lo[1], lo[2], lo[3], hi[0], hi[1], hi[2], hi[3]};
  if constexpr (EPI == EPI_INPROJ) {
    const bool ropeD = (n >= C_DFQ && n < C_DFV), ropeR = (n >= C_RTQ && n < C_RTV);
    if ((ropeD || ropeR) && m < NLAT) {
      const int t = m & 4095, gr = t >> 6, gc = t & 63;
      const float2* tabD = (const float2*)(smem + G8_ROPE_LDS);
      const float2* tabR = (const float2*)(smem + G8_ROPE_LDS + 4096);
      const float2* tb;
      if (ropeD) { const int i0 = (n & 31) >> 1; tb = i0 < 8 ? tabD + gr * 8 + i0 : tabD + gc * 8 + i0 - 8; }
      else { const int i0 = (n & 63) >> 1; tb = i0 < 16 ? tabR + gr * 16 + i0 : tabR + gc * 16 + i0 - 16; }
#pragma unroll
      for (int q = 0; q < 4; ++q) {
        const float2 cs = tb[q];
        const float a0 = v[2 * q] * cs.x - v[2 * q + 1] * cs.y, a1 = v[2 * q] * cs.y + v[2 * q + 1] * cs.x;
        v[2 * q] = a0; v[2 * q + 1] = a1;
      }
    }
    float sc = 1.f;
    if (n < C_NAK) sc = 0.125f * 1.4426950408889634f;
    else if (n >= C_DFQ && n < C_DFK) sc = 0.17677669529663687f * 1.4426950408889634f;
    else if (n >= C_RTK && n < C_RTV) sc = 0.125f;
    uint4 o;
    o.x = pack2h(v[0] * sc, v[1] * sc); o.y = pack2h(v[2] * sc, v[3] * sc); o.z = pack2h(v[4] * sc, v[5] * sc); o.w = pack2h(v[6] * sc, v[7] * sc);
    *(uint4*)((bf16_t*)(p.ws + OFF_P) + (size_t)m * INC + n) = o;
  } else if constexpr (EPI == EPI_OUTPROJ) {
    const float* mod = (const float*)(p.ws + OFF_MOD) + (size_t)layer * 9 * 6144;
    const int b = m < NLAT ? (m >> 12) : 8;
    const float* gp = mod + (size_t)b * 6144 + 2 * 1024 + n;
    const float4 g0 = *(const float4*)gp, g1 = *(const float4*)(gp + 4);
    const float* xi; float* xo;
    if (m < NLAT) { xi = xin_lat + (size_t)m * 1024 + n; xo = p.out + (size_t)m * 1024 + n; }
    else { xo = (float*)(p.ws + OFF_CTXB) + (size_t)(m - NLAT) * 1024 + n; xi = xo; }
    const float4 x0 = *(const float4*)xi, x1 = *(const float4*)(xi + 4);
    float4 o0, o1;
    o0.x = x0.x + g0.x * v[0]; o0.y = x0.y + g0.y * v[1]; o0.z = x0.z + g0.z * v[2]; o0.w = x0.w + g0.w * v[3];
    o1.x = x1.x + g1.x * v[4]; o1.y = x1.y + g1.y * v[5]; o1.z = x1.z + g1.z * v[6]; o1.w = x1.w + g1.w * v[7];
    *(float4*)xo = o0; *(float4*)(xo + 4) = o1;
  } else if constexpr (EPI == EPI_PLAIN) {
    uint4 o;
    o.x = pack2h(v[0], v[1]); o.y = pack2h(v[2], v[3]); o.z = pack2h(v[4], v[5]); o.w = pack2h(v[6], v[7]);
    *(uint4*)((bf16_t*)(p.ws + OFF_P) + (size_t)m * 2048 + n) = o;
  } else {
    asm volatile("" :: "v"(v[0]), "v"(v[1]), "v"(v[2]), "v"(v[3]), "v"(v[4]), "v"(v[5]), "v"(v[6]), "v"(v[7]));
  }
}

#define G8_LAS __attribute__((address_space(3)))
__device__ __forceinline__ bool g8_next(int i, int nM, int nN, int G, int c, int& pm, int& pn) {
  using namespace g8;
  const int nwg = nM * nN;
  const long Lx = (long)i * G + c;
  if (Lx >= nwg) return false;
  int wgid = (int)Lx;
  { const int q = nwg / NXCD, r = nwg % NXCD, xcd = wgid % NXCD, off = wgid / NXCD; wgid = (xcd < r ? xcd * (q + 1) : r * (q + 1) + (xcd - r) * q) + off; }
  const int nig = WGM * nN, gid = wgid / nig, fm = gid * WGM, gsz = (nM - fm) < WGM ? (nM - fm) : WGM;
  pm = fm + ((wgid % nig) % gsz); pn = (wgid % nig) / gsz;
  return true;
}

template <int EPI>
__device__ __forceinline__ void gemm_phase2(const Params& p, int layer, char* smem, const bf16_t* A, const bf16_t* Bt,
                                            int M, int N, const float* xin_lat) {
  using namespace g8;
  constexpr int K = 1024, nt = K / BK, HTB = HALF * BK * 2;
  G8_LAS unsigned char* lds = (G8_LAS unsigned char*)smem;
  const int tid = opaque_tid();
  const int wid = __builtin_amdgcn_readfirstlane(tid >> 6), lane = tid & 63, wr = wid >> 2, wc = wid & 3, fr = lane & 15, fq = lane >> 4;
  unsigned voff[2], voffB[2];
#pragma unroll
  for (int i = 0; i < 2; ++i) {
    int R, C; stage_rc(tid * 16 + i * 8192, R, C);
    const int rho = R & 31, Rb = (R & ~31) + 8 * ((rho & 15) >> 2) + 4 * (rho >> 4) + (rho & 3);
    voff[i] = (unsigned)(R * K + C) * 2u; voffB[i] = (unsigned)(Rb * K + C) * 2u;
  }
  if constexpr (EPI == EPI_INPROJ) {
    __syncthreads();
    const float4* gsrc = (const float4*)(p.ws + OFF_ROPE);
    float4* ldst = (float4*)(smem + G8_ROPE_LDS);
    for (int i = tid; i < 12288 / 16; i += 512) ldst[i] = gsrc[i];
  }
  constexpr size_t kstep = (size_t)(BK * 2);
  constexpr size_t hstep = (size_t)HALF * K * 2;
  constexpr size_t tstep = 2 * hstep;
  const unsigned ldsw = (unsigned)wid * 1024u;
  const int aoff = lds_byte(wr * 64 + fr, fq * 8), boff = lds_byte(wc * 32 + fr, fq * 8);
#define G8_SA(b, h) (((b) * 2 + (h)) * HTB)
#define G8_SB(b, h) ((4 + (b) * 2 + (h)) * HTB)
#define G8_STAGE_V(bufoff, gbase, VO) do { _Pragma("unroll") for (int _i = 0; _i < 2; ++_i)                                  \
    __builtin_amdgcn_global_load_lds((const unsigned*)((const char*)(gbase) + VO[_i]), (G8_LAS unsigned*)(lds + (bufoff) + ldsw + _i * 8192), 16, 0, 0); } while (0)
#define G8_LDA(dst, b, h) do { _Pragma("unroll") for (int m = 0; m < 4; ++m) _Pragma("unroll") for (int k = 0; k < 2; ++k) dst[m][k] = *(const G8_LAS bf16x8*)(lds + G8_SA(b, h) + aoff + m * 2048 + k * 1024); } while (0)
#define G8_LDB(dst, b, h) do { _Pragma("unroll") for (int n = 0; n < 2; ++n) _Pragma("unroll") for (int k = 0; k < 2; ++k) dst[n][k] = *(const G8_LAS bf16x8*)(lds + G8_SB(b, h) + boff + n * 2048 + k * 1024); } while (0)
#define G8_MMA(ai, bj, At_, Bt_) do { __builtin_amdgcn_s_setprio(1);                                                          \
    _Pragma("unroll") for (int m = 0; m < 4; ++m) _Pragma("unroll") for (int n = 0; n < 2; ++n) _Pragma("unroll") for (int k = 0; k < 2; ++k) \
      acc[ai][bj][m][n] = __builtin_amdgcn_mfma_f32_16x16x32_bf16(Bt_[n][k], At_[m][k], acc[ai][bj][m][n], 0, 0, 0);          \
    __builtin_amdgcn_s_setprio(0); } while (0)
#define G8_WAIT_V(n) asm volatile("s_waitcnt vmcnt(" #n ")" ::: "memory")
#define G8_WAIT_L(n) asm volatile("s_waitcnt lgkmcnt(" #n ")" ::: "memory")
#define G8_BAR __builtin_amdgcn_s_barrier()
#define G8_SCHED __builtin_amdgcn_sched_barrier(0)
  const int nM = M / BM, nN = N / BM, G = gridDim.x, cu = opaque_bid();
  int cpm, cpn, npm = 0, npn = 0, ui = 0;
  __syncthreads();
  if (g8_next(0, nM, nN, G, cu, cpm, cpn)) {
    f32x4 acc[2][2][4][2];
#pragma unroll
    for (int a = 0; a < 2; ++a)
#pragma unroll
      for (int b2 = 0; b2 < 2; ++b2)
#pragma unroll
        for (int m = 0; m < 4; ++m)
#pragma unroll
          for (int n = 0; n < 2; ++n) acc[a][b2][m][n] = (f32x4){0.f, 0.f, 0.f, 0.f};
    bf16x8 At[4][2], B0[2][2], B1[2][2];
    const char* cA = (const char*)A + (size_t)cpm * tstep;
    const char* cB = (const char*)Bt + (size_t)cpn * tstep;
    G8_STAGE_V(G8_SB(0, 0), cB, voffB); G8_STAGE_V(G8_SA(0, 0), cA, voff); G8_STAGE_V(G8_SB(0, 1), cB + hstep, voffB); G8_STAGE_V(G8_SA(0, 1), cA + hstep, voff);
    if (wr == 1) G8_BAR;
    G8_WAIT_V(4); G8_BAR;
    G8_STAGE_V(G8_SB(1, 0), cB + kstep, voffB); G8_STAGE_V(G8_SA(1, 0), cA + kstep, voff); G8_STAGE_V(G8_SB(1, 1), cB + hstep + kstep, voffB);
    G8_WAIT_V(6); G8_BAR;
    for (;;) {
      const bool has_next = g8_next(ui + 1, nM, nN, G, cu, npm, npn);
      const char* nA = has_next ? (const char*)A + (size_t)npm * tstep : cA;
      const char* nB = has_next ? (const char*)Bt + (size_t)npn * tstep : cB;
#pragma unroll 1
      for (int t = 0; t < nt; t += 2) {
        const bool last = (t == nt - 2);
        const char* a1 = cA + (size_t)(t + 1) * kstep;
        const char* a2 = last ? nA : cA + (size_t)(t + 2) * kstep; const char* b2 = last ? nB : cB + (size_t)(t + 2) * kstep;
        const char* a3 = a2 + kstep; const char* b3 = b2 + kstep;
        G8_LDB(B0, 0, 0); G8_SCHED; G8_LDA(At, 0, 0); G8_STAGE_V(G8_SA(1, 1), a1 + hstep, voff);
        G8_WAIT_L(8); G8_BAR; G8_WAIT_L(0); G8_MMA(0, 0, At, B0); G8_BAR; G8_SCHED;
        G8_LDB(B1, 0, 1); G8_STAGE_V(G8_SB(0, 0), b2, voffB);
        G8_BAR; G8_WAIT_L(0); G8_MMA(0, 1, At, B1); G8_BAR;
        G8_LDA(At, 0, 1); G8_STAGE_V(G8_SA(0, 0), a2, voff);
        G8_BAR; G8_WAIT_L(0); G8_MMA(1, 0, At, B0); G8_BAR; G8_SCHED;
        G8_STAGE_V(G8_SB(0, 1), b2 + hstep, voffB);
        G8_WAIT_V(6); G8_BAR; G8_MMA(1, 1, At, B1); G8_BAR;
        G8_LDB(B0, 1, 0); G8_SCHED; G8_LDA(At, 1, 0); G8_STAGE_V(G8_SA(0, 1), a2 + hstep, voff);
        G8_WAIT_L(8); G8_BAR; G8_WAIT_L(0); G8_MMA(0, 0, At, B0); G8_BAR; G8_SCHED;
        G8_LDB(B1, 1, 1); G8_STAGE_V(G8_SB(1, 0), b3, voffB);
        G8_BAR; G8_WAIT_L(0); G8_MMA(0, 1, At, B1); G8_BAR;
        G8_LDA(At, 1, 1); G8_STAGE_V(G8_SA(1, 0), a3, voff);
        G8_BAR; G8_WAIT_L(0); G8_MMA(1, 0, At, B0); G8_BAR; G8_SCHED;
        G8_STAGE_V(G8_SB(1, 1), b3 + hstep, voffB);
        G8_WAIT_V(6); G8_BAR; G8_MMA(1, 1, At, B1); G8_BAR;
      }
      {
        const int brow = cpm * BM, bcol = cpn * BM;
        if constexpr (EPI == EPI_INPROJ) {
          if (bcol == C_DFK) {
#pragma unroll
            for (int bj = 0; bj < 2; ++bj) {
              float mx = 0.f;
#pragma unroll
              for (int ai = 0; ai < 2; ++ai)
#pragma unroll
                for (int m = 0; m < 4; ++m) {
                  float s = 0.f;
#pragma unroll
                  for (int n = 0; n < 2; ++n)
#pragma unroll
                    for (int j = 0; j < 4; ++j) s = fmaf(acc[ai][bj][m][n][j], acc[ai][bj][m][n][j], s);
                  s += __shfl_xor(s, 16); s += __shfl_xor(s, 32);
                  mx = fmaxf(mx, s);
                }
#pragma unroll
              for (int o = 1; o < 16; o <<= 1) mx = fmaxf(mx, __shfl_xor(mx, o));
              if (lane == 0) {
                const int bb = brow < NLAT ? (brow >> 12) : ((brow - NLAT) >> 8);
                unsigned* km = (unsigned*)(p.ws + OFF_MISC) + 64 + layer * 64 + (bb * 4 + bj * 2 + (wc >> 1)) * 2 + (wc & 1);
                atomicMax(km, __float_as_uint(mx));
              }
            }
          }
        }
#pragma unroll
        for (int ai = 0; ai < 2; ++ai)
#pragma unroll
          for (int bj = 0; bj < 2; ++bj)
#pragma unroll
            for (int m = 0; m < 4; ++m)
              epi_store8<EPI>(p, layer, smem, brow + ai * HALF + wr * 64 + m * 16 + fr, bcol + bj * HALF + wc * 32 + fq * 8,
                              acc[ai][bj][m][0], acc[ai][bj][m][1], xin_lat);
      }
      if (!has_next) break;
#pragma unroll
      for (int a = 0; a < 2; ++a)
#pragma unroll
        for (int b2 = 0; b2 < 2; ++b2)
#pragma unroll
          for (int m = 0; m < 4; ++m)
#pragma unroll
            for (int n = 0; n < 2; ++n) acc[a][b2][m][n] = (f32x4){0.f, 0.f, 0.f, 0.f};
      cpm = npm; cpn = npn; cA = nA; cB = nB; ++ui;
    }
    G8_WAIT_V(0);
    if (wr == 0) G8_BAR;
    G8_BAR;
  }
}

__device__ __forceinline__ unsigned cvt_pk_bf16(float lo, float hi) {
  unsigned r;
  asm volatile("v_cvt_pk_bf16_f32 %0, %1, %2" : "=v"(r) : "v"(lo), "v"(hi));
  return r;
}
__device__ __forceinline__ void vt_store8(bf16_t* vt, int stride, int d0, int key, uint4 uv) {
  bf16_t* vd = vt + d0 * stride + key;
  vd[0 * stride] = (bf16_t)(uv.x & 0xffffu); vd[1 * stride] = (bf16_t)(uv.x >> 16);
  vd[2 * stride] = (bf16_t)(uv.y & 0xffffu); vd[3 * stride] = (bf16_t)(uv.y >> 16);
  vd[4 * stride] = (bf16_t)(uv.z & 0xffffu); vd[5 * stride] = (bf16_t)(uv.z >> 16);
  vd[6 * stride] = (bf16_t)(uv.w & 0xffffu); vd[7 * stride] = (bf16_t)(uv.w >> 16);
}

constexpr int DKS = 72;
__device__ __forceinline__ void diff_item(const Params& p, int layer, bool ctxq, int item, char* smem) {
  const bf16_t* P = (const bf16_t*)(p.ws + OFF_P);
  bf16_t* Y = (bf16_t*)(p.ws + OFF_ACT);
  const float* misc = (const float*)(p.ws + OFF_MISC);
  const float lam = misc[layer], lam_init = misc[2 + layer];
  const int tid = opaque_tid(), lane = tid & 63, wave = tid >> 6, lr = lane & 15, lq = lane >> 4;
  int b, h, mbase, nkeys;
  if (!ctxq) { b = item >> 6; h = (item >> 4) & 3; mbase = b * 4096 + (item & 15) * 256; nkeys = 256 + 4096; }
  else { b = item >> 2; h = item & 3; mbase = NLAT + b * 256; nkeys = 256; }
  const float kmax0 = sqrtf(misc[64 + layer * 64 + (b * 4 + h) * 2 + 0]), kmax1 = sqrtf(misc[64 + layer * 64 + (b * 4 + h) * 2 + 1]);
  bf16x8 qf[2][2];
  f32x4 C0[2], C1[2];
#pragma unroll
  for (int qt = 0; qt < 2; ++qt) {
    const bf16_t* qr = P + (size_t)(mbase + wave * 32 + qt * 16 + lr) * INC + C_DFQ + h * 64 + lq * 8;
    const uint4 u0 = *(const uint4*)(qr), u1 = *(const uint4*)(qr + 32);
    float s0 = 0.f, s1 = 0.f;
    { float t[8]; UNPACK8(t, 0, u0) _Pragma("unroll") for (int i = 0; i < 8; ++i) s0 = fmaf(t[i], t[i], s0); }
    { float t[8]; UNPACK8(t, 0, u1) _Pragma("unroll") for (int i = 0; i < 8; ++i) s1 = fmaf(t[i], t[i], s1); }
    s0 += __shfl_xor(s0, 16); s0 += __shfl_xor(s0, 32);
    s1 += __shfl_xor(s1, 16); s1 += __shfl_xor(s1, 32);
    const float nm0 = -sqrtf(s0) * kmax0, nm1 = -sqrtf(s1) * kmax1;
    C0[qt] = (f32x4){nm0, nm0, nm0, nm0};
    C1[qt] = (f32x4){nm1, nm1, nm1, nm1};
    union { uint4 u; bf16x8 v; } c0, c1; c0.u = u0; c1.u = u1;
    qf[qt][0] = c0.v; qf[qt][1] = c1.v;
  }
  f32x4 O0[2][4], O1[2][4];
#pragma unroll
  for (int qt = 0; qt < 2; ++qt)
#pragma unroll
    for (int i = 0; i < 4; ++i) { O0[qt][i] = (f32x4){0.f, 0.f, 0.f, 0.f}; O1[qt][i] = (f32x4){0.f, 0.f, 0.f, 0.f}; }
  float l0[2] = {0.f, 0.f}, l1[2] = {0.f, 0.f};
  const int lkey = tid >> 3, lch = tid & 7;
  constexpr int DBUF = 2 * 128 * DKS * 2;
  uint4 ukA0, ukA1, uvA0, uvA1;
#define DF_GLOAD1(UK, UV, T, I)                                                                     \
  {                                                                                                 \
    const int kk = (T) * 128 + (I) * 64 + lkey;                                                     \
    const size_t row = kk < 256 ? (size_t)(NLAT + b * 256 + kk) : (size_t)(b * 4096 + kk - 256);    \
    UK = *(const uint4*)(P + row * INC + C_DFK + h * 64 + lch * 8);                                 \
    UV = *(const uint4*)(P + row * INC + C_DFV + h * 64 + lch * 8);                                 \
  }
#define DF_LSTORE1(UK, UV, BUF, I)                                                                  \
  {                                                                                                 \
    bf16_t* Ks_ = (bf16_t*)(smem + (BUF) * DBUF) + (I) * 64 * DKS;                                  \
    bf16_t* Vt_ = (bf16_t*)(smem + (BUF) * DBUF) + 128 * DKS + (I) * 64 * DKS;                      \
    *(uint4*)(Ks_ + lkey * DKS + lch * 8) = UK;                                                     \
    vt_store8(Vt_, DKS, lch * 8, lkey, UV);                                                         \
  }
#define DF_GLOAD(S, T) DF_GLOAD1(uk##S##0, uv##S##0, T, 0) DF_GLOAD1(uk##S##1, uv##S##1, T, 1)
#define DF_LSTORE(S, BUF) DF_LSTORE1(uk##S##0, uv##S##0, BUF, 0) DF_LSTORE1(uk##S##1, uv##S##1, BUF, 1)
  const int ntile = nkeys >> 7;
  __syncthreads();
  DF_GLOAD(A, 0)
  DF_LSTORE(A, 0)
  __syncthreads();
#pragma unroll 1
  for (int t = 0; t < ntile; ++t) {
    const int cur = t & 1;
    if (t + 1 < ntile) { DF_GLOAD(A, t + 1) }
#pragma unroll 1
    for (int sub = 0; sub < 2; ++sub) {
    const bf16_t* Ks = (const bf16_t*)(smem + cur * DBUF) + sub * 64 * DKS;
    const bf16_t* Vt = (const bf16_t*)(smem + cur * DBUF) + 128 * DKS + sub * 64 * DKS;
    union PF { unsigned u[4]; bf16x8 v; };
    PF pf0[2][2], pf1[2][2];
#pragma unroll
    for (int c = 0; c < 2; ++c) {
      f32x4 S[2][4];
#pragma unroll
      for (int kt = 0; kt < 4; ++kt) {
        const bf16x8 kf = *(const bf16x8*)(Ks + (kt * 16 + lr) * DKS + c * 32 + lq * 8);
#pragma unroll
        for (int qt = 0; qt < 2; ++qt) S[qt][kt] = __builtin_amdgcn_mfma_f32_16x16x32_bf16(kf, qf[qt][c], c == 0 ? C0[qt] : C1[qt], 0, 0, 0);
      }
#pragma unroll
      for (int qt = 0; qt < 2; ++qt) {
        float ps = 0.f;
#pragma unroll
        for (int kt = 0; kt < 4; ++kt) {
#pragma unroll
          for (int r = 0; r < 4; ++r) { S[qt][kt][r] = __builtin_amdgcn_exp2f(S[qt][kt][r]); ps += S[qt][kt][r]; }
        }
        if (c == 0) l0[qt] += ps; else l1[qt] += ps;
#pragma unroll
        for (int g = 0; g < 2; ++g) {
          PF t;
          t.u[0] = cvt_pk_bf16(S[qt][2 * g][0], S[qt][2 * g][1]); t.u[1] = cvt_pk_bf16(S[qt][2 * g][2], S[qt][2 * g][3]);
          t.u[2] = cvt_pk_bf16(S[qt][2 * g + 1][0], S[qt][2 * g + 1][1]); t.u[3] = cvt_pk_bf16(S[qt][2 * g + 1][2], S[qt][2 * g + 1][3]);
          if (c == 0) pf0[qt][g] = t; else pf1[qt][g] = t;
        }
      }
    }
#pragma unroll
    for (int g = 0; g < 2; ++g) {
#pragma unroll
      for (int dt = 0; dt < 4; ++dt) {
        union { uint2 h2[2]; bf16x8 v; } vf;
        vf.h2[0] = *(const uint2*)(Vt + (dt * 16 + lr) * DKS + 32 * g + 4 * lq);
        vf.h2[1] = *(const uint2*)(Vt + (dt * 16 + lr) * DKS + 32 * g + 16 + 4 * lq);
#pragma unroll
        for (int qt = 0; qt < 2; ++qt) {
          O0[qt][dt] = __builtin_amdgcn_mfma_f32_16x16x32_bf16(vf.v, pf0[qt][g].v, O0[qt][dt], 0, 0, 0);
          O1[qt][dt] = __builtin_amdgcn_mfma_f32_16x16x32_bf16(vf.v, pf1[qt][g].v, O1[qt][dt], 0, 0, 0);
        }
      }
    }
    }
    if (t + 1 < ntile) { DF_LSTORE(A, cur ^ 1) }
    __syncthreads();
  }
  const float* sg = p.diff_subln_g + layer * 64;
#pragma unroll
  for (int qt = 0; qt < 2; ++qt) {
    float a0 = l0[qt], a1 = l1[qt];
    a0 += __shfl_xor(a0, 16); a0 += __shfl_xor(a0, 32);
    a1 += __shfl_xor(a1, 16); a1 += __shfl_xor(a1, 32);
    const float i0 = 1.f / a0, i1 = lam / a1;
    float ss = 0.f;
#pragma unroll
    for (int dt = 0; dt < 4; ++dt) {
#pragma unroll
      for (int r = 0; r < 4; ++r) { const float v = O0[qt][dt][r] * i0 - O1[qt][dt][r] * i1; O0[qt][dt][r] = v; ss = fmaf(v, v, ss); }
    }
    ss += __shfl_xor(ss, 16); ss += __shfl_xor(ss, 32);
    const float rr = rsqrtf(ss * (1.f / 64.f) + EPS) * (1.f - lam_init);
    bf16_t* dst = Y + (size_t)(mbase + wave * 32 + qt * 16 + lr) * 1024 + Y_DF + h * 64;
#pragma unroll
    for (int dt = 0; dt < 4; ++dt) {
      const int d = dt * 16 + 4 * lq;
      const float4 g4 = *(const float4*)(sg + d);
      uint2 ov;
      ov.x = pack2(O0[qt][dt][0] * rr * g4.x, O0[qt][dt][1] * rr * g4.y);
      ov.y = pack2(O0[qt][dt][2] * rr * g4.z, O0[qt][dt][3] * rr * g4.w);
      *(uint2*)(dst + d) = ov;
    }
  }
}

constexpr int NA_WS = 520;
constexpr int NA_CS = 264;
constexpr int NA_OFF_VTW = 0;
constexpr int NA_OFF_VTC = 64 * NA_WS * 2;
constexpr int NA_OFF_RPB = NA_OFF_VTC + 64 * NA_CS * 2;
constexpr int NA_OFF_MRG = NA_OFF_RPB + 2048;

#define NA_STEP(KPTR_EXPR, BIAS_EXPR, VT_PTR, VT_STRIDE, VT_KEY0_EXPR)                                           \
  {                                                                                                               \
    f32x4 S[4];                                                                                                   \
    _Pragma("unroll") for (int kt = 0; kt < 4; ++kt) {                                                            \
      const bf16_t* kp = (KPTR_EXPR);                                                                             \
      const bf16x8 ka = *(const bf16x8*)(kp + lq * 8);                                                            \
      const bf16x8 kb = *(const bf16x8*)(kp + 32 + lq * 8);                                                       \
      f32x4 a = __builtin_amdgcn_mfma_f32_16x16x32_bf16(ka, qf[0], (f32x4){0.f, 0.f, 0.f, 0.f}, 0, 0, 0);         \
      S[kt] = __builtin_amdgcn_mfma_f32_16x16x32_bf16(kb, qf[1], a, 0, 0, 0);                                      \
    }                                                                                                             \
    _Pragma("unroll") for (int kt = 0; kt < 4; ++kt) {                                                            \
      _Pragma("unroll") for (int r = 0; r < 4; ++r) { S[kt][r] += (BIAS_EXPR); }                                  \
    }                                                                                                             \
    float x = fmaxf(fmaxf(S[0][0], S[0][1]), fmaxf(S[0][2], S[0][3]));                                            \
    _Pragma("unroll") for (int kt = 1; kt < 4; ++kt) x = fmaxf(x, fmaxf(fmaxf(S[kt][0], S[kt][1]), fmaxf(S[kt][2], S[kt][3]))); \
    x = fmaxf(x, __shfl_xor(x, 16)); x = fmaxf(x, __shfl_xor(x, 32));                                             \
    const float mn = fmaxf(mrun, x);                                                                              \
    const float al = __builtin_amdgcn_exp2f(mrun - mn);                                                           \
    mrun = mn;                                                                                                    \
    float ps = 0.f;                                                                                               \
    _Pragma("unroll") for (int kt = 0; kt < 4; ++kt) {                                                            \
      _Pragma("unroll") for (int r = 0; r < 4; ++r) { S[kt][r] = __builtin_amdgcn_exp2f(S[kt][r] - mn); ps += S[kt][r]; } \
    }                                                                                                             \
    lrun = lrun * al + ps;                                                                                        \
    _Pragma("unroll") for (int dt = 0; dt < 4; ++dt) {                                                            \
      _Pragma("unroll") for (int r = 0; r < 4; ++r) O[dt][r] *= al;                                               \
    }                                                                                                             \
    _Pragma("unroll") for (int g = 0; g < 2; ++g) {                                                               \
      union { unsigned u[4]; bf16x8 v; } pf;                                                                      \
      pf.u[0] = cvt_pk_bf16(S[2 * g][0], S[2 * g][1]); pf.u[1] = cvt_pk_bf16(S[2 * g][2], S[2 * g][3]);           \
      pf.u[2] = cvt_pk_bf16(S[2 * g + 1][0], S[2 * g + 1][1]); pf.u[3] = cvt_pk_bf16(S[2 * g + 1][2], S[2 * g + 1][3]); \
      const int vk0 = (VT_KEY0_EXPR);                                                                             \
      _Pragma("unroll") for (int dt = 0; dt < 4; ++dt) {                                                          \
        union { uint2 h2[2]; bf16x8 v; } vf;                                                                      \
        vf.h2[0] = *(const uint2*)((VT_PTR) + (dt * 16 + lr) * (VT_STRIDE) + vk0 + 4 * lq);                       \
        vf.h2[1] = *(const uint2*)((VT_PTR) + (dt * 16 + lr) * (VT_STRIDE) + vk0 + 16 + 4 * lq);                  \
        O[dt] = __builtin_amdgcn_mfma_f32_16x16x32_bf16(vf.v, pf.v, O[dt], 0, 0, 0);                              \
      }                                                                                                           \
    }                                                                                                             \
  }

__device__ __forceinline__ void na_latent_item(const Params& p, int layer, int item, char* smem) {
  const bf16_t* P = (const bf16_t*)(p.ws + OFF_P);
  bf16_t* Y = (bf16_t*)(p.ws + OFF_ACT);
  const int b = item >> 8, h = (item >> 6) & 3, grow = item & 63;
  const int tid = opaque_tid(), lane = tid & 63, wave = tid >> 6, lr = lane & 15, lq = lane >> 4;
  const int jt = wave & 3, half = wave >> 2;
  bf16_t* VtW = (bf16_t*)(smem + NA_OFF_VTW);
  bf16_t* VtC = (bf16_t*)(smem + NA_OFF_VTC);
  float* RPB = (float*)(smem + NA_OFF_RPB);
  float* MRG = (float*)(smem + NA_OFF_MRG);
  const int rs = min(max(grow - 4, 0), 56);
  __syncthreads();
  {
    const int ch = tid & 7;
#pragma unroll
    for (int i = 0; i < 8; ++i) {
      const int key = (tid >> 3) + 64 * i;
      const uint4 uv = *(const uint4*)(P + (size_t)(b * 4096 + (rs + (key >> 6)) * 64 + (key & 63)) * INC + C_NAV + h * 64 + ch * 8);
      vt_store8(VtW, NA_WS, ch * 8, key, uv);
    }
#pragma unroll
    for (int i = 0; i < 4; ++i) {
      const int key = (tid >> 3) + 64 * i;
      const uint4 uv = *(const uint4*)(P + (size_t)(NLAT + b * 256 + key) * INC + C_NAV + h * 64 + ch * 8);
      vt_store8(VtC, NA_CS, ch * 8, key, uv);
    }
    if (tid < 465) RPB[tid] = p.na_rpb[(size_t)(layer * 4 + h) * 465 + tid] * 1.4426950408889634f;
  }
  const int qc = jt * 16 + lr;
  const int mq = b * 4096 + grow * 64 + qc;
  bf16x8 qf[2];
  {
    const bf16_t* qr = P + (size_t)mq * INC + C_NAQ + h * 64 + lq * 8;
    qf[0] = *(const bf16x8*)(qr);
    qf[1] = *(const bf16x8*)(qr + 32);
  }
  f32x4 O[4];
#pragma unroll
  for (int i = 0; i < 4; ++i) O[i] = (f32x4){0.f, 0.f, 0.f, 0.f};
  float mrun = -1e30f, lrun = 0.f;
  __syncthreads();
  if (half == 0) {
    const int k0 = min(max(jt * 16 - 8, 0), 32);
    const int cs = min(max(qc - 8, 0), 48);
#pragma unroll 1
    for (int s = 0; s < 4; ++s) {
      const int wr0 = 2 * s;
      NA_STEP(P + (size_t)(b * 4096 + (rs + wr0 + (kt >> 1)) * 64 + k0 + 16 * (kt & 1) + lr) * INC + C_NAK + h * 64,
              ((k0 + 16 * (kt & 1) + 4 * lq + r) >= cs && (k0 + 16 * (kt & 1) + 4 * lq + r) < cs + 16)
                  ? RPB[(rs + wr0 + (kt >> 1) - grow + 7) * 31 + (k0 + 16 * (kt & 1) + 4 * lq + r) - qc + 15] : -1e30f,
              VtW, NA_WS, (wr0 + g) * 64 + k0)
    }
  } else {
#pragma unroll 1
    for (int s = 0; s < 4; ++s) {
      NA_STEP(P + (size_t)(NLAT + b * 256 + s * 64 + kt * 16 + lr) * INC + C_NAK + h * 64, 0.f, VtC, NA_CS, s * 64 + 32 * g)
    }
  }
  lrun += __shfl_xor(lrun, 16); lrun += __shfl_xor(lrun, 32);
  float* mg = MRG + (jt * 64 + lane) * 18;
  if (half == 1) {
    mg[0] = mrun; mg[1] = lrun;
#pragma unroll
    for (int dt = 0; dt < 4; ++dt) { mg[2 + dt * 4 + 0] = O[dt][0]; mg[2 + dt * 4 + 1] = O[dt][1]; mg[2 + dt * 4 + 2] = O[dt][2]; mg[2 + dt * 4 + 3] = O[dt][3]; }
  }
  __syncthreads();
  if (half == 0) {
    const float m2 = mg[0], l2 = mg[1];
    const float M = fmaxf(mrun, m2);
    const float f1 = __builtin_amdgcn_exp2f(mrun - M), f2 = __builtin_amdgcn_exp2f(m2 - M);
    const float inv = 1.f / (lrun * f1 + l2 * f2);
    bf16_t* dst = Y + (size_t)mq * 1024 + Y_NA + h * 64;
#pragma unroll
    for (int dt = 0; dt < 4; ++dt) {
      const float o0 = (O[dt][0] * f1 + mg[2 + dt * 4 + 0] * f2) * inv, o1 = (O[dt][1] * f1 + mg[2 + dt * 4 + 1] * f2) * inv;
      const float o2 = (O[dt][2] * f1 + mg[2 + dt * 4 + 2] * f2) * inv, o3 = (O[dt][3] * f1 + mg[2 + dt * 4 + 3] * f2) * inv;
      uint2 ov; ov.x = pack2(o0, o1); ov.y = pack2(o2, o3);
      *(uint2*)(dst + dt * 16 + 4 * lq) = ov;
    }
  }
}

__device__ __forceinline__ void na_ctx_item(const Params& p, int item, char* smem) {
  const bf16_t* P = (const bf16_t*)(p.ws + OFF_P);
  bf16_t* Y = (bf16_t*)(p.ws + OFF_ACT);
  const int b = item >> 3, h = (item >> 1) & 3, qg = item & 1;
  const int tid = opaque_tid(), lane = tid & 63, wave = tid >> 6, lr = lane & 15, lq = lane >> 4;
  bf16_t* VtC = (bf16_t*)(smem + NA_OFF_VTC);
  __syncthreads();
  {
    const int ch = tid & 7;
#pragma unroll
    for (int i = 0; i < 4; ++i) {
      const int key = (tid >> 3) + 64 * i;
      const uint4 uv = *(const uint4*)(P + (size_t)(NLAT + b * 256 + key) * INC + C_NAV + h * 64 + ch * 8);
      vt_store8(VtC, NA_CS, ch * 8, key, uv);
    }
  }
  const int mq = NLAT + b * 256 + qg * 128 + wave * 16 + lr;
  bf16x8 qf[2];
  {
    const bf16_t* qr = P + (size_t)mq * INC + C_NAQ + h * 64 + lq * 8;
    qf[0] = *(const bf16x8*)(qr);
    qf[1] = *(const bf16x8*)(qr + 32);
  }
  f32x4 O[4];
#pragma unroll
  for (int i = 0; i < 4; ++i) O[i] = (f32x4){0.f, 0.f, 0.f, 0.f};
  float mrun = -1e30f, lrun = 0.f;
  __syncthreads();
#pragma unroll 1
  for (int s = 0; s < 4; ++s) {
    NA_STEP(P + (size_t)(NLAT + b * 256 + s * 64 + kt * 16 + lr) * INC + C_NAK + h * 64, 0.f, VtC, NA_CS, s * 64 + 32 * g)
  }
  lrun += __shfl_xor(lrun, 16); lrun += __shfl_xor(lrun, 32);
  const float inv = 1.f / lrun;
  bf16_t* dst = Y + (size_t)mq * 1024 + Y_NA + h * 64;
#pragma unroll
  for (int dt = 0; dt < 4; ++dt) {
    uint2 ov; ov.x = pack2(O[dt][0] * inv, O[dt][1] * inv); ov.y = pack2(O[dt][2] * inv, O[dt][3] * inv);
    *(uint2*)(dst + dt * 16 + 4 * lq) = ov;
  }
}

constexpr int KV_S = 136;
constexpr int KV_OFF_KF = 0, KV_OFF_KB = 64 * KV_S * 2, KV_OFF_VT = 2 * 64 * KV_S * 2;
__device__ __forceinline__ void ret_kv_item(const Params& p, int layer, int h, size_t row0, int cnt, float* dstF, float* dstB, char* smem) {
  const bf16_t* P = (const bf16_t*)(p.ws + OFF_P);
  const float* misc = (const float*)(p.ws + OFF_MISC);
  const float lgF2 = misc[16 + layer * 8 + 0 * 4 + h] * 1.4426950408889634f, lgB2 = misc[16 + layer * 8 + 1 * 4 + h] * 1.4426950408889634f;
  const int tid = opaque_tid(), lane = tid & 63, wave = tid >> 6, lr = lane & 15, lq = lane >> 4;
  bf16_t* KFt = (bf16_t*)(smem + KV_OFF_KF);
  bf16_t* KBt = (bf16_t*)(smem + KV_OFF_KB);
  bf16_t* Vt = (bf16_t*)(smem + KV_OFF_VT);
  const int dir = wave >> 2, dt = wave & 3;
  f32x4 acc[8];
#pragma unroll
  for (int i = 0; i < 8; ++i) acc[i] = (f32x4){0.f, 0.f, 0.f, 0.f};
#pragma unroll 1
  for (int kc = 0; kc < (cnt >> 7); ++kc) {
    __syncthreads();
    {
      const int tok = tid >> 2, c = tid & 3;
      const int j = kc * 128 + tok;
      const float wF = __builtin_amdgcn_exp2f(lgF2 * (float)(cnt - 1 - j)), wB = __builtin_amdgcn_exp2f(lgB2 * (float)j);
      const bf16_t* rowp = P + (row0 + j) * INC;
#pragma unroll
      for (int c8 = 0; c8 < 2; ++c8) {
        const uint4 u = *(const uint4*)(rowp + C_RTK + h * 64 + c * 16 + c8 * 8);
        float kv[8];
        UNPACK8(kv, 0, u)
#pragma unroll
        for (int i = 0; i < 8; ++i) {
          KFt[(c * 16 + c8 * 8 + i) * KV_S + tok] = f2bf(kv[i] * wF);
          KBt[(c * 16 + c8 * 8 + i) * KV_S + tok] = f2bf(kv[i] * wB);
        }
      }
#pragma unroll
      for (int c8 = 0; c8 < 4; ++c8) {
        const uint4 uv = *(const uint4*)(rowp + C_RTV + h * 128 + c * 32 + c8 * 8);
        vt_store8(Vt, KV_S, c * 32 + c8 * 8, tok, uv);
      }
    }
    __syncthreads();
    const bf16_t* Kt = dir == 0 ? KFt : KBt;
    bf16x8 af[4];
#pragma unroll
    for (int ks = 0; ks < 4; ++ks) af[ks] = *(const bf16x8*)(Kt + (dt * 16 + lr) * KV_S + ks * 32 + lq * 8);
#pragma unroll
    for (int et = 0; et < 8; ++et) {
#pragma unroll
      for (int ks = 0; ks < 4; ++ks) {
        const bf16x8 bfr = *(const bf16x8*)(Vt + (et * 16 + lr) * KV_S + ks * 32 + lq * 8);
        acc[et] = __builtin_amdgcn_mfma_f32_16x16x32_bf16(af[ks], bfr, acc[et], 0, 0, 0);
      }
    }
  }
  float* dst = dir == 0 ? dstF : dstB;
#pragma unroll
  for (int et = 0; et < 8; ++et) {
#pragma unroll
    for (int r = 0; r < 4; ++r) dst[(dt * 16 + 4 * lq + r) * 128 + et * 16 + lr] = acc[et][r];
  }
}

__device__ __forceinline__ void phase_ret_scan(const Params& p, int layer) {
  const float* misc = (const float*)(p.ws + OFF_MISC);
  float* rkv = (float*)(p.ws + OFF_RKV);
  const float* rs = (const float*)(p.ws + OFF_RS);
  const int gt = opaque_bid() * 512 + opaque_tid(), gs = gridDim.x * 512;
  for (int idx = gt; idx < 64 * 2048; idx += gs) {
    const int seq = idx >> 11, e4 = (idx & 2047) * 4;
    const int dir = seq & 1, h = (seq >> 1) & 3;
    const float cdec = __expf(misc[16 + layer * 8 + dir * 4 + h] * 128.f);
    float4* base = (float4*)(rkv + (size_t)seq * 32 * 8192 + e4);
    float4 v[32];
#pragma unroll
    for (int s = 0; s < 32; ++s) v[s] = base[(size_t)s * 2048];
    float4 st = *(const float4*)(rs + (size_t)seq * 8192 + e4);
    if (dir == 0) {
#pragma unroll
      for (int s = 0; s < 32; ++s) {
        const float4 t = v[s];
        base[(size_t)s * 2048] = st;
        st.x = fmaf(cdec, st.x, t.x); st.y = fmaf(cdec, st.y, t.y); st.z = fmaf(cdec, st.z, t.z); st.w = fmaf(cdec, st.w, t.w);
      }
    } else {
#pragma unroll
      for (int s = 31; s >= 0; --s) {
        const float4 t = v[s];
        base[(size_t)s * 2048] = st;
        st.x = fmaf(cdec, st.x, t.x); st.y = fmaf(cdec, st.y, t.y); st.z = fmaf(cdec, st.z, t.z); st.w = fmaf(cdec, st.w, t.w);
      }
    }
  }
}

constexpr int RT_KS = 72, RT_VS = 136;
constexpr int RT_OFF_K = 0, RT_OFF_VT = 128 * RT_KS * 2, RT_OFF_SF = RT_OFF_VT + 128 * RT_VS * 2, RT_OFF_SB = RT_OFF_SF + 128 * RT_KS * 2;
__device__ __forceinline__ void ret_out_item(const Params& p, int layer, int h, size_t krow0, int nkc, int iq0,
                                             const float* SF, const float* SB, int clen, char* smem) {
  const bf16_t* P = (const bf16_t*)(p.ws + OFF_P);
  bf16_t* Y = (bf16_t*)(p.ws + OFF_ACT);
  const float* misc = (const float*)(p.ws + OFF_MISC);
  const float lgF2 = misc[16 + layer * 8 + 0 * 4 + h] * 1.4426950408889634f, lgB2 = misc[16 + layer * 8 + 1 * 4 + h] * 1.4426950408889634f;
  const int tid = opaque_tid(), lane = tid & 63, wave = tid >> 6, lr = lane & 15, lq = lane >> 4;
  bf16_t* Ks = (bf16_t*)(smem + RT_OFF_K);
  bf16_t* Vt = (bf16_t*)(smem + RT_OFF_VT);
  bf16_t* SFt = (bf16_t*)(smem + RT_OFF_SF);
  bf16_t* SBt = (bf16_t*)(smem + RT_OFF_SB);
  const int iq = iq0 + wave * 16 + lr;
  const size_t mq = krow0 + iq;
  bf16x8 qf[2];
  {
    const bf16_t* qr = P + mq * INC + C_RTQ + h * 64 + lq * 8;
    qf[0] = *(const bf16x8*)(qr);
    qf[1] = *(const bf16x8*)(qr + 32);
  }
  f32x4 O[8];
#pragma unroll
  for (int i = 0; i < 8; ++i) O[i] = (f32x4){0.f, 0.f, 0.f, 0.f};
  if (SF != nullptr) {
    __syncthreads();
    {
      const int d = tid >> 3, e0 = (tid & 7) * 16;
#pragma unroll
      for (int c4 = 0; c4 < 4; ++c4) {
        const float4 a = *(const float4*)(SF + d * 128 + e0 + c4 * 4);
        const float4 bb = *(const float4*)(SB + d * 128 + e0 + c4 * 4);
        SFt[(e0 + c4 * 4 + 0) * RT_KS + d] = f2bf(a.x); SFt[(e0 + c4 * 4 + 1) * RT_KS + d] = f2bf(a.y);
        SFt[(e0 + c4 * 4 + 2) * RT_KS + d] = f2bf(a.z); SFt[(e0 + c4 * 4 + 3) * RT_KS + d] = f2bf(a.w);
        SBt[(e0 + c4 * 4 + 0) * RT_KS + d] = f2bf(bb.x); SBt[(e0 + c4 * 4 + 1) * RT_KS + d] = f2bf(bb.y);
        SBt[(e0 + c4 * 4 + 2) * RT_KS + d] = f2bf(bb.z); SBt[(e0 + c4 * 4 + 3) * RT_KS + d] = f2bf(bb.w);
      }
    }
    __syncthreads();
    const float cF = __builtin_amdgcn_exp2f(lgF2 * (float)(iq + 1)), cB = __builtin_amdgcn_exp2f(lgB2 * (float)(clen - iq));
#pragma unroll
    for (int ks = 0; ks < 2; ++ks)
#pragma unroll
      for (int et = 0; et < 8; ++et) {
        const bf16x8 sf = *(const bf16x8*)(SFt + (et * 16 + lr) * RT_KS + ks * 32 + lq * 8);
        O[et] = __builtin_amdgcn_mfma_f32_16x16x32_bf16(sf, qf[ks], O[et], 0, 0, 0);
      }
    const float ratio = cF / cB;
#pragma unroll
    for (int et = 0; et < 8; ++et) { O[et][0] *= ratio; O[et][1] *= ratio; O[et][2] *= ratio; O[et][3] *= ratio; }
#pragma unroll
    for (int ks = 0; ks < 2; ++ks)
#pragma unroll
      for (int et = 0; et < 8; ++et) {
        const bf16x8 sb = *(const bf16x8*)(SBt + (et * 16 + lr) * RT_KS + ks * 32 + lq * 8);
        O[et] = __builtin_amdgcn_mfma_f32_16x16x32_bf16(sb, qf[ks], O[et], 0, 0, 0);
      }
#pragma unroll
    for (int et = 0; et < 8; ++et) { O[et][0] *= cB; O[et][1] *= cB; O[et][2] *= cB; O[et][3] *= cB; }
  }
#pragma unroll 1
  for (int kc = 0; kc < nkc; ++kc) {
    __syncthreads();
    {
      const int key = tid >> 2, c = tid & 3;
      const bf16_t* rowp = P + (krow0 + kc * 128 + key) * INC;
      const uint4 k0 = *(const uint4*)(rowp + C_RTK + h * 64 + c * 16), k1 = *(const uint4*)(rowp + C_RTK + h * 64 + c * 16 + 8);
      *(uint4*)(Ks + key * RT_KS + c * 16) = k0;
      *(uint4*)(Ks + key * RT_KS + c * 16 + 8) = k1;
#pragma unroll
      for (int c8 = 0; c8 < 4; ++c8) {
        const uint4 uv = *(const uint4*)(rowp + C_RTV + h * 128 + c * 32 + c8 * 8);
        vt_store8(Vt, RT_VS, c * 32 + c8 * 8, key, uv);
      }
    }
    __syncthreads();
    f32x4 S[8];
#pragma unroll
    for (int kt = 0; kt < 8; ++kt) {
      const bf16x8 ka = *(const bf16x8*)(Ks + (kt * 16 + lr) * RT_KS + lq * 8);
      const bf16x8 kb = *(const bf16x8*)(Ks + (kt * 16 + lr) * RT_KS + 32 + lq * 8);
      const f32x4 a = __builtin_amdgcn_mfma_f32_16x16x32_bf16(ka, qf[0], (f32x4){0.f, 0.f, 0.f, 0.f}, 0, 0, 0);
      S[kt] = __builtin_amdgcn_mfma_f32_16x16x32_bf16(kb, qf[1], a, 0, 0, 0);
    }
#pragma unroll
    for (int kt = 0; kt < 8; ++kt) {
#pragma unroll
      for (int r = 0; r < 4; ++r) {
        const int df = iq - (kc * 128 + kt * 16 + 4 * lq + r);
        const float fdf = (float)df;
        float coef = 0.f;
        if (df >= 0) coef += __builtin_amdgcn_exp2f(lgF2 * fdf);
        if (df <= 0) coef += __builtin_amdgcn_exp2f(-lgB2 * fdf);
        S[kt][r] *= coef;
      }
    }
#pragma unroll
    for (int g = 0; g < 4; ++g) {
      union { unsigned u[4]; bf16x8 v; } pf;
      pf.u[0] = cvt_pk_bf16(S[2 * g][0], S[2 * g][1]); pf.u[1] = cvt_pk_bf16(S[2 * g][2], S[2 * g][3]);
      pf.u[2] = cvt_pk_bf16(S[2 * g + 1][0], S[2 * g + 1][1]); pf.u[3] = cvt_pk_bf16(S[2 * g + 1][2], S[2 * g + 1][3]);
#pragma unroll
      for (int et = 0; et < 8; ++et) {
        union { uint2 h2[2]; bf16x8 v; } vf;
        vf.h2[0] = *(const uint2*)(Vt + (et * 16 + lr) * RT_VS + 32 * g + 4 * lq);
        vf.h2[1] = *(const uint2*)(Vt + (et * 16 + lr) * RT_VS + 32 * g + 16 + 4 * lq);
        O[et] = __builtin_amdgcn_mfma_f32_16x16x32_bf16(vf.v, pf.v, O[et], 0, 0, 0);
      }
    }
  }
  float ss = 0.f;
#pragma unroll
  for (int et = 0; et < 8; ++et) { ss = fmaf(O[et][0], O[et][0], ss); ss = fmaf(O[et][1], O[et][1], ss); ss = fmaf(O[et][2], O[et][2], ss); ss = fmaf(O[et][3], O[et][3], ss); }
  ss += __shfl_xor(ss, 16); ss += __shfl_xor(ss, 32);
  const float rr = rsqrtf(ss * (1.f / 128.f) + EPS);
  const bf16_t* gp = P + mq * INC + C_RTG + h * 128;
  bf16_t* dst = Y + mq * 1024 + Y_RT + h * 128;
#pragma unroll
  for (int et = 0; et < 8; ++et) {
    const int e = et * 16 + 4 * lq;
    const uint2 gu = *(const uint2*)(gp + e);
    uint2 ov;
    ov.x = pack2(O[et][0] * rr * siluf(lo16(gu.x)), O[et][1] * rr * siluf(hi16(gu.x)));
    ov.y = pack2(O[et][2] * rr * siluf(lo16(gu.y)), O[et][3] * rr * siluf(hi16(gu.y)));
    *(uint2*)(dst + e) = ov;
  }
}

__device__ __forceinline__ void uv_convert_item(const Params& p, int item) {
  char* ws = p.ws;
  const int tid = opaque_tid();
  const int lane = tid & 63, l = lane & 31, half = lane >> 5, wave = tid >> 6;
#pragma unroll 1
  for (int it = 0; it < 16; ++it) {
    const int row = item * 256 + (wave * 16 + it) * 2 + half;
    const bool isv = row >= 2 * NEXP;
    const int rr = isv ? row - 2 * NEXP : row;
    const float* srow = (isv ? p.peer_v : p.peer_u) + (size_t)rr * 1024;
    float4 v[8];
    float mx = 0.f;
#pragma unroll
    for (int j = 0; j < 8; ++j) {
      v[j] = ((const float4*)srow)[l + 32 * j];
      mx = fmaxf(mx, fmaxf(fmaxf(fabsf(v[j].x), fabsf(v[j].y)), fmaxf(fabsf(v[j].z), fabsf(v[j].w))));
    }
#pragma unroll
    for (int o = 1; o < 32; o <<= 1) mx = fmaxf(mx, __shfl_xor(mx, o));
    const float scale = mx > 0.f ? mx * (1.f / 7.5f) : 1.f;
    const float inv = 1.f / scale;
    unsigned w[6] = {0u, 0u, 0u, 0u, 0u, 0u};
#pragma unroll
    for (int k = 0; k < 32; ++k) {
      const float xv = (k & 3) == 0 ? v[k >> 2].x : (k & 3) == 1 ? v[k >> 2].y : (k & 3) == 2 ? v[k >> 2].z : v[k >> 2].w;
      const float a = fminf(fabsf(xv) * inv, 7.5f);
      float c;
      if (a < 2.f) c = rintf(a * 8.f);
      else if (a < 4.f) c = 16.f + rintf((a - 2.f) * 4.f);
      else c = 24.f + rintf((a - 4.f) * 2.f);
      unsigned code = (unsigned)c;
      code = code > 31u ? 31u : code;
      code |= (xv < 0.f) ? 32u : 0u;
      const int bit = 6 * k, wd = bit >> 5, sh = bit & 31;
      w[wd] |= code << sh;
      if (sh > 26) w[wd + 1] |= code >> (32 - sh);
    }
    char* drow = ws + OFF_U + (size_t)rr * RECB + (isv ? ROWB : 0) + l * 24;
    *(uint2*)(drow) = make_uint2(w[0], w[1]);
    *(uint2*)(drow + 8) = make_uint2(w[2], w[3]);
    *(uint2*)(drow + 16) = make_uint2(w[4], w[5]);
    if (l == 0) ((float*)(ws + (isv ? OFF_VSC : OFF_USC)))[rr] = scale;
  }
}

__device__ __forceinline__ void phase_mix1(const Params& p, int layer, char* smem, int slot = 0) {
  unsigned* ctr = (unsigned*)(p.ws + OFF_CTL) + (layer * 4 + slot);
  const bool nc = layer == 0;
  const int n_dl = 512, n_dc = nc ? 32 : 0, n_uv = nc ? 256 : 0, n_nl = 2048, n_ncx = nc ? 64 : 0, n_kv = 1024, n_cs = 32;
  const int total = n_dl + n_dc + n_uv + n_nl + n_ncx + n_kv + n_cs;
  float* rkv = (float*)(p.ws + OFF_RKV);
  float* rs = (float*)(p.ws + OFF_RS);
  for (;;) {
    int it = next_item(ctr, smem);
    if (it >= total) break;
    if (it < n_dl) { diff_item(p, layer, false, it, smem); continue; } it -= n_dl;
    if (it < n_dc) { diff_item(p, layer, true, it, smem); continue; } it -= n_dc;
    if (it < n_uv) { uv_convert_item(p, it); continue; } it -= n_uv;
    if (it < n_nl) { na_latent_item(p, layer, it, smem); continue; } it -= n_nl;
    if (it < n_ncx) { na_ctx_item(p, it, smem); continue; } it -= n_ncx;
    if (it < n_kv) {
      const int bh = it >> 5, n = it & 31, b = bh >> 2, h = bh & 3;
      ret_kv_item(p, layer, h, (size_t)b * 4096 + n * 128, 128,
                  rkv + ((size_t)(bh * 2 + 0) * 32 + n) * 8192, rkv + ((size_t)(bh * 2 + 1) * 32 + n) * 8192, smem);
      continue;
    }
    it -= n_kv;
    {
      const int bh = it, b = bh >> 2, h = bh & 3;
      ret_kv_item(p, layer, h, (size_t)NLAT + b * 256, 256, rs + (size_t)(bh * 2 + 0) * 8192, rs + (size_t)(bh * 2 + 1) * 8192, smem);
    }
  }
}

__device__ __forceinline__ void phase_mix2(const Params& p, int layer, char* smem, int slot = 1) {
  unsigned* ctr = (unsigned*)(p.ws + OFF_CTL) + (layer * 4 + slot);
  const int n_l = 1024, n_c = layer == 0 ? 64 : 0;
  const float* rkv = (const float*)(p.ws + OFF_RKV);
  for (;;) {
    int it = next_item(ctr, smem);
    if (it >= n_l + n_c) break;
    if (it < n_l) {
      const int bh = it >> 5, n = it & 31, b = bh >> 2, h = bh & 3;
      ret_out_item(p, layer, h, (size_t)b * 4096 + n * 128, 1, 0,
                   rkv + ((size_t)(bh * 2 + 0) * 32 + n) * 8192, rkv + ((size_t)(bh * 2 + 1) * 32 + n) * 8192, 128, smem);
    } else {
      it -= n_l;
      const int bh = it >> 1, half = it & 1, b = bh >> 2, h = bh & 3;
      ret_out_item(p, layer, h, (size_t)NLAT + b * 256, 2, half * 128, nullptr, nullptr, 256, smem);
    }
  }
}

typedef float f32x2 __attribute__((ext_vector_type(2)));
__device__ __forceinline__ unsigned sortable_key(float f, int idx) {
  const unsigned b = __float_as_uint(f);
  const unsigned k = b ^ ((unsigned)((int)b >> 31) | 0x80000000u);
  return (k & ~127u) | (unsigned)(127 - idx);
}
__device__ __forceinline__ float key_value(unsigned k) {
  k &= ~127u;
  const unsigned b = (k & 0x80000000u) ? (k ^ 0x80000000u) : ~k;
  return __uint_as_float(b);
}
#define FP8DOT(acc, H, off, W) { const f32x2 _a = __builtin_amdgcn_cvt_pk_f32_fp8((int)(W), false), _b = __builtin_amdgcn_cvt_pk_f32_fp8((int)(W), true); \
  acc = fmaf(H[(off) + 0], _a.x, acc); acc = fmaf(H[(off) + 1], _a.y, acc); acc = fmaf(H[(off) + 2], _b.x, acc); acc = fmaf(H[(off) + 3], _b.y, acc); }
#define FP8AXPY(O, off, P, W) { const f32x2 _a = __builtin_amdgcn_cvt_pk_f32_fp8((int)(W), false), _b = __builtin_amdgcn_cvt_pk_f32_fp8((int)(W), true); \
  O[(off) + 0] = fmaf(P, _a.x, O[(off) + 0]); O[(off) + 1] = fmaf(P, _a.y, O[(off) + 1]); O[(off) + 2] = fmaf(P, _b.x, O[(off) + 2]); O[(off) + 3] = fmaf(P, _b.y, O[(off) + 3]); }

__device__ __forceinline__ float gelu_erf(float a) {
  const float x = fabsf(a) * 0.70710678118654752f;
  const float t = __builtin_amdgcn_rcpf(fmaf(0.3275911f, x, 1.f));
  float pl = fmaf(1.061405429f, t, -1.453152027f);
  pl = fmaf(pl, t, 1.421413741f); pl = fmaf(pl, t, -0.284496736f); pl = fmaf(pl, t, 0.254829592f);
  const float y = 1.f - pl * t * __builtin_amdgcn_exp2f(-x * x * 1.4426950408889634f);
  const float er = a < 0.f ? -y : y;
  return 0.5f * a * (1.f + er);
}
constexpr int PE_SVS = 132;
constexpr int PE_OFF_SV = 0;
constexpr int PE_OFF_TV = 8 * 16 * PE_SVS * 4;
constexpr int PE_OFF_TI = PE_OFF_TV + 16 * 16 * 16 * 4;
constexpr int PE_OFF_EX = PE_OFF_TI + 16 * 16 * 16 * 4;
constexpr int PE_OFF_GT = PE_OFF_EX + 1 * 16 * 128 * 4;
constexpr int PE_OFF_SU = PE_OFF_GT + 1 * 16 * 128 * 4;
constexpr int PE_OFF_CN = PE_OFF_SU + 1 * 16 * 128 * 4;
constexpr int PE_OFF_CT = PE_OFF_CN + 8 * 16 * 4;
#define WAVE_LDS_FENCE() asm volatile("s_waitcnt lgkmcnt(0)" ::: "memory")

__device__ __forceinline__ void peer_select_head(const Params& p, int layer, char* smem, int tok0, int hd, int sw, int buf,
                                                 int lane) {
  const bf16_t* Q = (const bf16_t*)(p.ws + OFF_P);
  const bf16_t* SK = (const bf16_t*)(p.ws + OFF_SUBK) + (size_t)layer * 262144;
  const int lr = lane & 15, lq = lane >> 4;
  unsigned* SV = (unsigned*)(smem + PE_OFF_SV) + sw * 16 * PE_SVS;
  float* TV = (float*)(smem + PE_OFF_TV);
  int* TI = (int*)(smem + PE_OFF_TI);
  int* EX = (int*)(smem + PE_OFF_EX) + buf * 16 * 128;
  float* GT = (float*)(smem + PE_OFF_GT) + buf * 16 * 128;
  int* CN = (int*)(smem + PE_OFF_CN) + sw * 16;
  float* SU = (float*)(smem + PE_OFF_SU) + buf * 16 * 128;
  const float* USC = (const float*)(p.ws + OFF_USC) + layer * NEXP;
  const float* VSC = (const float*)(p.ws + OFF_VSC) + layer * NEXP;
#pragma unroll 1
  for (int pp = 0; pp < 2; ++pp) {
    bf16x8 af[4];
    const bf16_t* qrow = Q + (size_t)(tok0 + lr) * 2048 + hd * 256 + pp * 128;
#pragma unroll
    for (int ks = 0; ks < 4; ++ks) af[ks] = *(const bf16x8*)(qrow + ks * 32 + lq * 8);
    const bf16_t* skb = SK + (size_t)((hd * 2 + pp) * 128) * 128;
    f32x4 acc[8];
    {
      bf16x8 bfr[8][4];
#pragma unroll
      for (int nt = 0; nt < 8; ++nt)
#pragma unroll
        for (int ks = 0; ks < 4; ++ks)
          bfr[nt][ks] = *(const bf16x8*)(skb + (size_t)(nt * 16 + lr) * 128 + ks * 32 + lq * 8);
#pragma unroll
      for (int nt = 0; nt < 8; ++nt) {
        f32x4 a = (f32x4){0.f, 0.f, 0.f, 0.f};
#pragma unroll
        for (int ks = 0; ks < 4; ++ks) a = __builtin_amdgcn_mfma_f32_16x16x32_bf16(af[ks], bfr[nt][ks], a, 0, 0, 0);
        acc[nt] = a;
      }
    }
#pragma unroll
    for (int i = 0; i < 9; ++i) { const int q4 = lane + 64 * i; if (q4 < 16 * PE_SVS / 4) ((uint4*)SV)[q4] = make_uint4(0u, 0u, 0u, 0u); }
    WAVE_LDS_FENCE();
#pragma unroll
    for (int r = 0; r < 4; ++r) {
      const int tk = 4 * lq + r;
      unsigned k[8];
#pragma unroll
      for (int nt = 0; nt < 8; ++nt) k[nt] = sortable_key(acc[nt][r], nt * 16 + lr);
      unsigned m1 = max(k[0], k[1]), m2 = min(k[0], k[1]);
#pragma unroll
      for (int nt = 2; nt < 8; ++nt) { m2 = max(m2, min(m1, k[nt])); m1 = max(m1, k[nt]); }
      const unsigned Ta = row16_min_u32(m1);
      const unsigned Tb = min(row16_kth_largest<11>(m1), row16_kth_largest<5>(m2));
      const unsigned T = max(Ta, Tb);
      int pos = 0;
#pragma unroll
      for (int nt = 0; nt < 8; ++nt) {
        const bool sel = k[nt] >= T;
        const unsigned long long bal = __ballot(sel);
        const unsigned grp16 = (unsigned)(bal >> (16 * lq)) & 0xffffu;
        const int below = __popc(grp16 & ((1u << lr) - 1u));
        if (sel) SV[tk * PE_SVS + pos + below] = k[nt];
        pos += __popc(grp16);
      }
      if (lr == 0) CN[tk] = pos;
    }
    WAVE_LDS_FENCE();
#pragma unroll 1
    for (int pass = 0; pass < 4; ++pass) {
      const int tk = pass * 4 + lq;
      const int cnt = CN[tk];
      const unsigned* row = SV + tk * PE_SVS;
      int cm = cnt;
      cm = max(cm, __shfl_xor(cm, 16)); cm = max(cm, __shfl_xor(cm, 32));
      const int cmax = __builtin_amdgcn_readfirstlane(cm);
      const int nblk = (cmax + 15) >> 4;
#pragma unroll 1
      for (int rd = 0; rd < nblk; ++rd) {
        const int j = rd * 16 + lr;
        const unsigned my = row[j];
        int rank = 0;
#pragma unroll 1
        for (int b4 = 0; b4 < nblk; ++b4) {
          const uint4 v0 = *(const uint4*)(row + b4 * 16), v1 = *(const uint4*)(row + b4 * 16 + 4);
          const uint4 v2 = *(const uint4*)(row + b4 * 16 + 8), v3 = *(const uint4*)(row + b4 * 16 + 12);
          rank += (v0.x > my) ? 1 : 0; rank += (v0.y > my) ? 1 : 0; rank += (v0.z > my) ? 1 : 0; rank += (v0.w > my) ? 1 : 0;
          rank += (v1.x > my) ? 1 : 0; rank += (v1.y > my) ? 1 : 0; rank += (v1.z > my) ? 1 : 0; rank += (v1.w > my) ? 1 : 0;
          rank += (v2.x > my) ? 1 : 0; rank += (v2.y > my) ? 1 : 0; rank += (v2.z > my) ? 1 : 0; rank += (v2.w > my) ? 1 : 0;
          rank += (v3.x > my) ? 1 : 0; rank += (v3.y > my) ? 1 : 0; rank += (v3.z > my) ? 1 : 0; rank += (v3.w > my) ? 1 : 0;
        }
        if (j < cnt && rank < 16) {
          TV[(tk * 16 + hd * 2 + pp) * 16 + rank] = key_value(my);
          TI[(tk * 16 + hd * 2 + pp) * 16 + rank] = 127 - (int)(my & 127u);
        }
      }
    }
    WAVE_LDS_FENCE();
  }
  {
    const int cab = ((const int*)(smem + PE_OFF_CT))[lane];
    const int cand_a = cab >> 4, cand_b = cab & 15;
    unsigned* CWt = SV;
    float vals[16];
#pragma unroll
    for (int tk = 0; tk < 16; ++tk) {
      float val = 0.f;
      unsigned key = 0u;
      if (cand_a >= 0) {
        val = TV[(tk * 16 + hd * 2 + 0) * 16 + cand_a] + TV[(tk * 16 + hd * 2 + 1) * 16 + cand_b];
        const unsigned bb = __float_as_uint(val);
        key = ((bb ^ ((unsigned)((int)bb >> 31) | 0x80000000u)) & ~63u) | (unsigned)(63 - lane);
      }
      vals[tk] = val;
      CWt[tk * 64 + lane] = key;
    }
    WAVE_LDS_FENCE();
#pragma unroll
    for (int tk = 0; tk < 16; ++tk) {
      const unsigned key = CWt[tk * 64 + lane];
      int rank = 0;
#pragma unroll
      for (int i4 = 0; i4 < 13; ++i4) {
        const uint4 v = *(const uint4*)(CWt + tk * 64 + i4 * 4);
        rank += (v.x > key) ? 1 : 0; rank += (v.y > key) ? 1 : 0; rank += (v.z > key) ? 1 : 0; rank += (v.w > key) ? 1 : 0;
      }
      if (cand_a >= 0 && rank < 16) {
        GT[tk * 128 + hd * 16 + rank] = vals[tk];
        EX[tk * 128 + hd * 16 + rank] = TI[(tk * 16 + hd * 2 + 0) * 16 + cand_a] * 128 + TI[(tk * 16 + hd * 2 + 1) * 16 + cand_b];
      }
    }
    WAVE_LDS_FENCE();
#pragma unroll
    for (int pass = 0; pass < 4; ++pass) {
      const int tk = pass * 4 + lq;
      const float g = GT[tk * 128 + hd * 16 + lr];
      const float mx = GT[tk * 128 + hd * 16];
      const float ev = __expf(g - mx);
      float s = ev;
      s += __shfl_xor(s, 1); s += __shfl_xor(s, 2); s += __shfl_xor(s, 4); s += __shfl_xor(s, 8);
      const int ex = EX[tk * 128 + hd * 16 + lr];
      GT[tk * 128 + hd * 16 + lr] = (ev / s) * VSC[ex];
      SU[tk * 128 + hd * 16 + lr] = USC[ex];
    }
    WAVE_LDS_FENCE();
  }
}

typedef float f32x32 __attribute__((ext_vector_type(32)));
typedef unsigned u32x6 __attribute__((ext_vector_type(6)));
struct Fp6Row { uint4 a; uint2 b; };
__device__ __forceinline__ f32x32 fp6_decode(const Fp6Row& r) {
  u32x6 w; w[0] = r.a.x; w[1] = r.a.y; w[2] = r.a.z; w[3] = r.a.w; w[4] = r.b.x; w[5] = r.b.y;
  return __builtin_amdgcn_cvt_scalef32_pk32_f32_fp6(w, 1.0f);
}
__device__ __forceinline__ void peer_gather_token(const Params& p, int layer, char* smem, int tok, int tl, int buf, int lane, bool dowrite) {
  const bf16_t* H2 = (const bf16_t*)(p.ws + OFF_ACT);
  const char* U6 = p.ws + OFF_U + (size_t)layer * NEXP * RECB;
  const char* V6 = U6 + ROWB;
  const float* mod = (const float*)(p.ws + OFF_MOD) + (size_t)layer * 9 * 6144;
  const int* EX = (const int*)(smem + PE_OFF_EX) + buf * 16 * 128 + tl * 128;
  const float* GT = (const float*)(smem + PE_OFF_GT) + buf * 16 * 128 + tl * 128;
  const float* SU = (const float*)(smem + PE_OFF_SU) + buf * 16 * 128 + tl * 128;
  const int l = lane & 31, hf = lane >> 5;
  float hv[32], acc[32];
  {
    const bf16_t* hr = H2 + (size_t)tok * 1024;
#pragma unroll
    for (int j = 0; j < 8; ++j) {
      const uint2 u = *(const uint2*)(hr + (l + 32 * j) * 4);
      hv[4 * j + 0] = lo16(u.x); hv[4 * j + 1] = hi16(u.x); hv[4 * j + 2] = lo16(u.y); hv[4 * j + 3] = hi16(u.y);
    }
  }
#pragma unroll
  for (int i = 0; i < 32; ++i) acc[i] = 0.f;
  Fp6Row ua[2], va[2], ub[2], vb[2];
  int one = 1;
  asm volatile("" : "+s"(one));
#define PE_LOAD_SET(UU, VV, E0)                                                       \
  _Pragma("unroll") for (int j = 0; j < 2; ++j) {                                     \
    const int ex = EX[(E0) + 2 * j + hf];                                             \
    const char* up = U6 + (size_t)ex * RECB + l * 24;                                 \
    UU[j].a = *(const uint4*)up; UU[j].b = *(const uint2*)(up + 16);                  \
    VV[j].a = *(const uint4*)(up + ROWB); VV[j].b = *(const uint2*)(up + ROWB + 16);  \
  }
#define PE_USE_SET(UU, VV, E0)                                                        \
  _Pragma("unroll 1") for (int rep_ = 0; rep_ < one; ++rep_) {                        \
  _Pragma("unroll") for (int j = 0; j < 2; ++j) {                                     \
    const f32x32 du = fp6_decode(UU[j]);                                              \
    float d0 = 0.f, d1 = 0.f, d2 = 0.f, d3 = 0.f;                                     \
    _Pragma("unroll") for (int k = 0; k < 32; k += 4) {                               \
      d0 = fmaf(hv[k], du[k], d0); d1 = fmaf(hv[k + 1], du[k + 1], d1); d2 = fmaf(hv[k + 2], du[k + 2], d2); d3 = fmaf(hv[k + 3], du[k + 3], d3); \
    }                                                                                 \
    const float r16 = row16_sum((d0 + d1) + (d2 + d3));                               \
    const int ir = __float_as_int(r16);                                               \
    const float s0 = __int_as_float(__builtin_amdgcn_readlane(ir, 0)) + __int_as_float(__builtin_amdgcn_readlane(ir, 16));  \
    const float s1 = __int_as_float(__builtin_amdgcn_readlane(ir, 32)) + __int_as_float(__builtin_amdgcn_readlane(ir, 48)); \
    const float d = (hf ? s1 : s0) * SU[(E0) + 2 * j + hf];                           \
    const float w = GT[(E0) + 2 * j + hf] * gelu_erf(d);                              \
    const f32x32 dv = fp6_decode(VV[j]);                                              \
    _Pragma("unroll") for (int k = 0; k < 32; ++k) acc[k] = fmaf(w, dv[k], acc[k]);   \
  } }
  PE_LOAD_SET(ua, va, 0)
#pragma unroll 1
  for (int e0 = 0; e0 < 120; e0 += 8) {
    PE_LOAD_SET(ub, vb, e0 + 4)
    PE_USE_SET(ua, va, e0)
    PE_LOAD_SET(ua, va, e0 + 8)
    PE_USE_SET(ub, vb, e0 + 4)
  }
  PE_LOAD_SET(ub, vb, 124)
  PE_USE_SET(ua, va, 120)
  PE_USE_SET(ub, vb, 124)
#pragma unroll
  for (int k = 0; k < 32; ++k) acc[k] += __shfl_xor(acc[k], 32);
  const int b = tok < NLAT ? (tok >> 12) : 8;
  float* xr = tok < NLAT ? p.out + (size_t)tok * 1024 : (float*)(p.ws + OFF_CTXB) + (size_t)(tok - NLAT) * 1024;
  const float* gate = mod + (size_t)b * 6144 + 5 * 1024;
  float4 xn[4];
  float ss = 0.f;
#pragma unroll
  for (int jj = 0; jj < 4; ++jj) {
    const int c = (l + 32 * (4 * hf + jj)) * 4;
    const float4 xv = *(const float4*)(xr + c);
    const float4 gv = *(const float4*)(gate + c);
    const float a0 = hf ? acc[16 + 4 * jj + 0] : acc[4 * jj + 0], a1 = hf ? acc[16 + 4 * jj + 1] : acc[4 * jj + 1];
    const float a2 = hf ? acc[16 + 4 * jj + 2] : acc[4 * jj + 2], a3 = hf ? acc[16 + 4 * jj + 3] : acc[4 * jj + 3];
    xn[jj].x = xv.x + gv.x * a0; xn[jj].y = xv.y + gv.y * a1; xn[jj].z = xv.z + gv.z * a2; xn[jj].w = xv.w + gv.w * a3;
    ss += xn[jj].x * xn[jj].x + xn[jj].y * xn[jj].y + xn[jj].z * xn[jj].z + xn[jj].w * xn[jj].w;
  }
  ss = wave_sum(ss);
  const float rinv = rsqrtf(ss * (1.f / 1024.f) + EPS);
  if (layer == 0) {
    const float* mod1 = (const float*)(p.ws + OFF_MOD) + (size_t)9 * 6144 + (size_t)b * 6144;
    const float* g1 = p.norm1_g + 1024;
    bf16_t* act = (bf16_t*)(p.ws + OFF_ACT) + (size_t)tok * 1024;
#pragma unroll
    for (int jj = 0; jj < 4; ++jj) {
      const int c = (l + 32 * (4 * hf + jj)) * 4;
      if (dowrite) *(float4*)(xr + c) = xn[jj]; else asm volatile("" :: "v"(xn[jj].x), "v"(xn[jj].y), "v"(xn[jj].z), "v"(xn[jj].w));
      const float4 gg4 = *(const float4*)(g1 + c);
      const float4 sh = *(const float4*)(mod1 + c);
      const float4 sc = *(const float4*)(mod1 + 1024 + c);
      uint2 o;
      o.x = pack2h(xn[jj].x * rinv * gg4.x * (1.f + sc.x) + sh.x, xn[jj].y * rinv * gg4.y * (1.f + sc.y) + sh.y);
      o.y = pack2h(xn[jj].z * rinv * gg4.z * (1.f + sc.z) + sh.z, xn[jj].w * rinv * gg4.w * (1.f + sc.w) + sh.w);
      if (dowrite) *(uint2*)(act + c) = o; else asm volatile("" :: "v"(o.x), "v"(o.y));
    }
  } else {
#pragma unroll
    for (int jj = 0; jj < 4; ++jj) {
      const int c = (l + 32 * (4 * hf + jj)) * 4;
      const float4 gg4 = *(const float4*)(p.final_g + c);
      float4 o;
      o.x = xn[jj].x * rinv * gg4.x; o.y = xn[jj].y * rinv * gg4.y; o.z = xn[jj].z * rinv * gg4.z; o.w = xn[jj].w * rinv * gg4.w;
      if (dowrite) *(float4*)(xr + c) = o; else asm volatile("" :: "v"(o.x), "v"(o.y), "v"(o.z), "v"(o.w));
    }
  }
}

__device__ __forceinline__ void phase_peer(const Params& p, int layer, char* smem, int ntok, bool dowrite = true) {
  const int tid = opaque_tid(), lane = tid & 63, wave = __builtin_amdgcn_readfirstlane(tid >> 6);
  __syncthreads();
  if (tid < 64) {
    int cab = -1, c = 0;
    for (int a = 0; a < 16; ++a)
      for (int bb = 0; bb < 16; ++bb)
        if ((a + 1) * (bb + 1) <= 16) { if (c == tid) cab = a * 16 + bb; ++c; }
    ((int*)(smem + PE_OFF_CT))[tid] = cab;
  }
  const int ngroups = ntok / 16, G = gridDim.x, g0 = opaque_bid();
  __syncthreads();
  for (int grp = g0; grp < ngroups; grp += G) {
    peer_select_head(p, layer, smem, grp * 16, wave, wave, 0, lane);
    __syncthreads();
#pragma unroll 1
    for (int tt = 0; tt < 2; ++tt) peer_gather_token(p, layer, smem, grp * 16 + wave * 2 + tt, wave * 2 + tt, 0, lane, dowrite);
    __syncthreads();
  }
}

template <int layer>
__device__ __forceinline__ void layer_body(const Params& p, char* smem, const XcdBarrier& xb) {
  constexpr bool nc = layer == 0;
  const float* xin = layer == 0 ? p.x : (const float*)p.out;
  if (layer == 0) {
    phase_norm(p, layer, 0, xin, NTOK);
    xcd_barrier(xb);
  }
#if REP_GEMM
  gemm_phase2<EPI_INPROJ>(p, layer, smem, (const bf16_t*)(p.ws + OFF_ACT), (const bf16_t*)(p.ws + OFF_WIN) + (size_t)layer * 3072 * 1024, NTOK, 3072, nullptr);
  xcd_barrier(xb);
#endif
  gemm_phase2<EPI_INPROJ>(p, layer, smem, (const bf16_t*)(p.ws + OFF_ACT), (const bf16_t*)(p.ws + OFF_WIN) + (size_t)layer * 3072 * 1024, NTOK, 3072, nullptr);
  xcd_barrier(xb);
#if REP_MIX1
  phase_mix1(p, layer, smem, 2);
  xcd_barrier(xb);
#endif
  phase_mix1(p, layer, smem);
  xcd_barrier(xb);
  phase_ret_scan(p, layer);
  xcd_barrier(xb);
#if REP_MIX2
  phase_mix2(p, layer, smem, 3);
  xcd_barrier(xb);
#endif
  phase_mix2(p, layer, smem);
  xcd_barrier(xb);
  gemm_phase2<EPI_OUTPROJ>(p, layer, smem, (const bf16_t*)(p.ws + OFF_ACT), (const bf16_t*)(p.ws + OFF_WOUT) + (size_t)layer * 1024 * 1024, nc ? NTOK : NLAT, 1024, xin);
  xcd_barrier(xb);
  phase_norm(p, layer, 1, (const float*)p.out, nc ? NTOK : NLAT);
  xcd_barrier(xb);
  gemm_phase2<EPI_PLAIN>(p, layer, smem, (const bf16_t*)(p.ws + OFF_ACT), (const bf16_t*)(p.ws + OFF_WQ) + (size_t)layer * 2048 * 1024, nc ? NTOK : NLAT, 2048, nullptr);
  xcd_barrier(xb);
#if REP_PEER
  phase_peer(p, layer, smem, nc ? NTOK : NLAT, false);
  xcd_barrier(xb);
#endif
  phase_peer(p, layer, smem, nc ? NTOK : NLAT);
  if (layer == 0) xcd_barrier(xb);
}

__global__ void __launch_bounds__(512) fwd_megakernel(Params p) {
  cg::grid_group grid = cg::this_grid();
  extern __shared__ __attribute__((aligned(16))) char smem[];
  volatile LAS3 unsigned* xst = (volatile LAS3 unsigned*)(smem + LDS_BCAST + 8);
  if (threadIdx.x == 0) { xst[0] = 0u; xst[1] = 0u; }
  phase_prep(p, smem);
  grid.sync();
  const XcdBarrier xb = xcd_barrier_post((unsigned*)(p.ws + OFF_XBAR), xst);
  layer_body<0>(p, smem, xb);
  layer_body<1>(p, smem, xb);
}

extern "C" void kernel_launch(void* const* d_in, const int* in_sizes, int n_in, void* d_out,
                              int out_size, void* d_ws, size_t ws_size, hipStream_t stream) {
  constexpr size_t kDynLds = LDS_BYTES;
  static int grid_blocks = 0;
  if (!grid_blocks) {
    int dev = 0, cus = 0, per_cu = 0;
    (void)hipGetDevice(&dev);
    (void)hipDeviceGetAttribute(&cus, hipDeviceAttributeMultiprocessorCount, dev);
    (void)hipFuncSetAttribute((const void*)fwd_megakernel, hipFuncAttributeMaxDynamicSharedMemorySize, (int)kDynLds);
    (void)hipOccupancyMaxActiveBlocksPerMultiprocessor(&per_cu, fwd_megakernel, 512, kDynLds);
    if (per_cu < 1) { fprintf(stderr, "occupancy query says %d blocks/CU\n", per_cu); per_cu = 1; }
    grid_blocks = cus;
    if (ws_size < WS_END) fprintf(stderr, "workspace too small: %zu < %zu\n", ws_size, (size_t)WS_END);
  }
  Params p{};
  p.x = (const float*)d_in[0]; p.c = (const float*)d_in[1]; p.ctx = (const float*)d_in[2]; p.c_ctx = (const float*)d_in[3];
  p.w_ada = (const float*)d_in[4]; p.b_ada = (const float*)d_in[5]; p.norm1_g = (const float*)d_in[6]; p.w_in = (const float*)d_in[7];
  p.na_rpb = (const float*)d_in[8]; p.diff_lambda = (const float*)d_in[9]; p.diff_subln_g = (const float*)d_in[10];
  p.ret_decay_logit = (const float*)d_in[11]; p.w_out = (const float*)d_in[12]; p.norm2_g = (const float*)d_in[13];
  p.peer_wq = (const float*)d_in[14]; p.peer_subkeys = (const float*)d_in[15]; p.peer_u = (const float*)d_in[16];
  p.peer_v = (const float*)d_in[17]; p.final_g = (const float*)d_in[18];
  p.out = (float*)d_out; p.ws = (char*)d_ws;
  void* args[] = {&p};
  hipError_t e = hipLaunchCooperativeKernel((void*)fwd_megakernel, dim3(grid_blocks), dim3(512), args, kDynLds, stream);
  if (e != hipSuccess) fprintf(stderr, "cooperative launch failed: %s (grid %d)\n", hipGetErrorString(e), grid_blocks);
}
```

```cpp
#include <hip/hip_runtime.h>
#include <hip/hip_cooperative_groups.h>
#include <cstdio>
#include <cstdint>
namespace cg = cooperative_groups;

typedef unsigned short bf16_t;
typedef short bf16x8 __attribute__((ext_vector_type(8)));
typedef float f32x4 __attribute__((ext_vector_type(4)));

constexpr int DM = 1024, BATCH = 8, SEQ = 4096, LCTX = 256;
constexpr int NLAT = BATCH * SEQ;
constexpr int NCTX = BATCH * LCTX;
constexpr int NTOK = NLAT + NCTX;
constexpr int INC = 3072;
constexpr int C_NAQ = 0, C_NAK = 256, C_NAV = 512, C_DFQ = 768, C_DFK = 1024, C_DFV = 1280,
              C_RTQ = 1536, C_RTK = 1792, C_RTV = 2048, C_RTG = 2560;
constexpr int Y_NA = 0, Y_DF = 256, Y_RT = 512;
constexpr int NEXP = 16384;
constexpr float EPS = 1e-6f;

constexpr size_t OFF_CTL  = 0;
constexpr size_t OFF_MISC = 4096;
constexpr size_t OFF_ROPE = 8192;
constexpr size_t OFF_MOD  = OFF_ROPE + 12288;
constexpr size_t SZ_MOD   = 2ull * 9 * 6144 * 4;
constexpr size_t OFF_WIN  = OFF_MOD + SZ_MOD;
constexpr size_t SZ_WIN   = 2ull * 3072 * 1024 * 2;
constexpr size_t OFF_WOUT = OFF_WIN + SZ_WIN;
constexpr size_t SZ_WOUT  = 2ull * 1024 * 1024 * 2;
constexpr size_t OFF_WQ   = OFF_WOUT + SZ_WOUT;
constexpr size_t SZ_WQ    = 2ull * 2048 * 1024 * 2;
constexpr size_t OFF_SUBK = OFF_WQ + SZ_WQ;
constexpr size_t SZ_SUBK  = 2ull * 262144 * 2;
constexpr size_t OFF_U    = OFF_SUBK + SZ_SUBK;
constexpr int    ROWB     = 768;
constexpr int    RECB     = 2 * ROWB;
constexpr size_t SZ_UV    = 2ull * NEXP * ROWB;
constexpr size_t OFF_V    = OFF_U + SZ_UV;
constexpr size_t OFF_USC  = OFF_V + SZ_UV;
constexpr size_t OFF_VSC  = OFF_USC + 2ull * NEXP * 4;
constexpr size_t OFF_ACT  = OFF_VSC + 2ull * NEXP * 4;
constexpr size_t SZ_ACT   = (size_t)NTOK * 1024 * 2;
constexpr size_t OFF_P    = OFF_ACT + SZ_ACT;
constexpr size_t SZ_P     = (size_t)NTOK * 3072 * 2;
constexpr size_t OFF_CTXB = OFF_P + SZ_P;
constexpr size_t SZ_CTXB  = (size_t)NCTX * 1024 * 4;
constexpr size_t OFF_RKV  = OFF_CTXB + SZ_CTXB;
constexpr size_t SZ_RKV   = 64ull * 32 * 8192 * 4;
constexpr size_t OFF_RS   = OFF_RKV + SZ_RKV;
constexpr size_t SZ_RS    = 64ull * 8192 * 4;
constexpr size_t OFF_XBAR = OFF_RS + SZ_RS;
constexpr size_t WS_END   = OFF_XBAR + 16384;

#ifndef REP_MIX1
#define REP_MIX1 0
#endif
#ifndef REP_MIX2
#define REP_MIX2 0
#endif
#ifndef REP_PEER
#define REP_PEER 0
#endif
#ifndef REP_GEMM
#define REP_GEMM 0
#endif
constexpr int LDS_BYTES = 144 * 1024;
constexpr int LDS_BCAST = LDS_BYTES - 16;

struct Params {
  const float *x, *c, *ctx, *c_ctx, *w_ada, *b_ada, *norm1_g, *w_in, *na_rpb, *diff_lambda, *diff_subln_g,
              *ret_decay_logit, *w_out, *norm2_g, *peer_wq, *peer_subkeys, *peer_u, *peer_v, *final_g;
  float* out;
  char* ws;
};

__device__ __forceinline__ float bf2f(bf16_t v) { return __uint_as_float(((unsigned)v) << 16); }
__device__ __forceinline__ bf16_t f2bf(float f) {
  unsigned u = __float_as_uint(f);
  u += 0x7fffu + ((u >> 16) & 1u);
  return (bf16_t)(u >> 16);
}
__device__ __forceinline__ unsigned pack2(float a, float b) { return (unsigned)f2bf(a) | ((unsigned)f2bf(b) << 16); }
__device__ __forceinline__ unsigned pack2h(float a, float b) {
  unsigned r;
  asm("v_cvt_pk_bf16_f32 %0, %1, %2" : "=v"(r) : "v"(a), "v"(b));
  return r;
}
__device__ __forceinline__ float lo16(unsigned w) { return __uint_as_float(w << 16); }
__device__ __forceinline__ float hi16(unsigned w) { return __uint_as_float(w & 0xffff0000u); }
#define DPP_ADD(v, CTRL) ((v) + __int_as_float(__builtin_amdgcn_update_dpp(0, __float_as_int(v), (CTRL), 0xf, 0xf, true)))
__device__ __forceinline__ float row16_sum(float v) {
  v = DPP_ADD(v, 0xB1);
  v = DPP_ADD(v, 0x4E);
  v = DPP_ADD(v, 0x141);
  v = DPP_ADD(v, 0x140);
  return v;
}
#define DPP_MOVU(v, CTRL) ((unsigned)__builtin_amdgcn_update_dpp(0, (int)(v), (CTRL), 0xf, 0xf, true))
__device__ __forceinline__ unsigned row16_max_u32(unsigned v) {
  v = max(v, DPP_MOVU(v, 0xB1)); v = max(v, DPP_MOVU(v, 0x4E)); v = max(v, DPP_MOVU(v, 0x141)); v = max(v, DPP_MOVU(v, 0x140));
  return v;
}
__device__ __forceinline__ unsigned row16_min_u32(unsigned v) {
  v = min(v, DPP_MOVU(v, 0xB1)); v = min(v, DPP_MOVU(v, 0x4E)); v = min(v, DPP_MOVU(v, 0x141)); v = min(v, DPP_MOVU(v, 0x140));
  return v;
}
template <int KTH>
__device__ __forceinline__ unsigned row16_kth_largest(unsigned v) {
  int cnt = 0;
#define R8_STEP(N) { const unsigned o = DPP_MOVU(v, 0x120 + (N)); cnt += (o > v) ? 1 : 0; }
  R8_STEP(1) R8_STEP(2) R8_STEP(3) R8_STEP(4) R8_STEP(5) R8_STEP(6) R8_STEP(7) R8_STEP(8)
  R8_STEP(9) R8_STEP(10) R8_STEP(11) R8_STEP(12) R8_STEP(13) R8_STEP(14) R8_STEP(15)
#undef R8_STEP
  return row16_max_u32(cnt >= KTH - 1 ? v : 0u);
}
__device__ __forceinline__ float wave_sum(float v) {
  v = row16_sum(v);
  const int iv = __float_as_int(v);
  const float a = __int_as_float(__builtin_amdgcn_readlane(iv, 0)), b = __int_as_float(__builtin_amdgcn_readlane(iv, 16));
  const float c = __int_as_float(__builtin_amdgcn_readlane(iv, 32)), d = __int_as_float(__builtin_amdgcn_readlane(iv, 48));
  return (a + b) + (c + d);
}
__device__ __forceinline__ float siluf(float x) { return x / (1.f + __expf(-x)); }

__device__ __forceinline__ int opaque_tid() { int t = threadIdx.x; asm volatile("" : "+v"(t)); return t; }
__device__ __forceinline__ int opaque_bid() { int t = blockIdx.x; asm volatile("" : "+s"(t)); return t; }

#define DOT8(acc, Q, off, U)                                                              \
  acc = fmaf(Q[(off) + 0], lo16((U).x), acc); acc = fmaf(Q[(off) + 1], hi16((U).x), acc); \
  acc = fmaf(Q[(off) + 2], lo16((U).y), acc); acc = fmaf(Q[(off) + 3], hi16((U).y), acc); \
  acc = fmaf(Q[(off) + 4], lo16((U).z), acc); acc = fmaf(Q[(off) + 5], hi16((U).z), acc); \
  acc = fmaf(Q[(off) + 6], lo16((U).w), acc); acc = fmaf(Q[(off) + 7], hi16((U).w), acc);
#define AXPY8(O, off, P, U)                                                                   \
  O[(off) + 0] = fmaf(P, lo16((U).x), O[(off) + 0]); O[(off) + 1] = fmaf(P, hi16((U).x), O[(off) + 1]); \
  O[(off) + 2] = fmaf(P, lo16((U).y), O[(off) + 2]); O[(off) + 3] = fmaf(P, hi16((U).y), O[(off) + 3]); \
  O[(off) + 4] = fmaf(P, lo16((U).z), O[(off) + 4]); O[(off) + 5] = fmaf(P, hi16((U).z), O[(off) + 5]); \
  O[(off) + 6] = fmaf(P, lo16((U).w), O[(off) + 6]); O[(off) + 7] = fmaf(P, hi16((U).w), O[(off) + 7]);
#define UNPACK8(Q, off, U)                                                  \
  Q[(off) + 0] = lo16((U).x); Q[(off) + 1] = hi16((U).x); Q[(off) + 2] = lo16((U).y); Q[(off) + 3] = hi16((U).y); \
  Q[(off) + 4] = lo16((U).z); Q[(off) + 5] = hi16((U).z); Q[(off) + 6] = lo16((U).w); Q[(off) + 7] = hi16((U).w);

__device__ __forceinline__ int next_item(unsigned* counter, char* smem) {
  volatile int* bc = (volatile int*)(smem + LDS_BCAST);
  __syncthreads();
  if (threadIdx.x == 0) *bc = (int)atomicAdd(counter, 1u);
  __syncthreads();
  return *bc;
}

#define XB_TMO      128
#define XB_XCNT(j)  (256  + 64 * (j))
#define XB_XSUB(j)  (1280 + 64 * (j))
#define XB_XGEN(j)  (2304 + 64 * (j))
#define XB_TOP      3328
#define XB_TOPGEN   3392
#define XCD_BAR_WORDS 3456
#define XB_SPIN_CAP (1u << 18)
#define LAS3 __attribute__((address_space(3)))
__device__ __forceinline__ unsigned xb_ld(unsigned* p)              { return __hip_atomic_load(p, __ATOMIC_RELAXED, __HIP_MEMORY_SCOPE_AGENT); }
__device__ __forceinline__ unsigned xb_add(unsigned* p, unsigned v) { return __hip_atomic_fetch_add(p, v, __ATOMIC_RELAXED, __HIP_MEMORY_SCOPE_AGENT); }
__device__ __forceinline__ unsigned xb_xcc_id() { return (unsigned)__builtin_amdgcn_s_getreg((3 << 11) | 20) & 0xFu; }
#define XB_SPIN(cond, bar) do { unsigned _sp = 0; while (cond) { __builtin_amdgcn_s_sleep(1); \
    if ((++_sp & 255u) == 0u) { if (xb_ld(&(bar)[XB_TMO])) break; if (_sp > XB_SPIN_CAP) { atomicAdd(&(bar)[XB_TMO], 1u); break; } } } } while (0)
struct XcdBarrier { unsigned* bar; unsigned x; volatile LAS3 unsigned* st; };
__device__ __forceinline__ XcdBarrier xcd_barrier_post(unsigned* bar, volatile LAS3 unsigned* st) {
  XcdBarrier b; b.bar = bar; b.x = xb_xcc_id(); b.st = st;
  if (threadIdx.x == 0) (void)xb_add(&bar[XB_XCNT(b.x)], 1u);
  return b;
}
__device__ __forceinline__ void xcd_barrier_complete(unsigned* bar, unsigned x, unsigned& nloc, unsigned& nx) {
  const unsigned G = gridDim.x * gridDim.y * gridDim.z;
  unsigned sum, cnt, mine, sp = 0u;
  for (;;) {
    sum = 0u; cnt = 0u; mine = 0u;
#pragma unroll
    for (unsigned j = 0; j < 16; ++j) { const unsigned c = xb_ld(&bar[XB_XCNT(j)]); sum += c; cnt += (c > 0u) ? 1u : 0u; mine = (j == x) ? c : mine; }
    if (sum == G) break;
    __builtin_amdgcn_s_sleep(1);
    if ((++sp & 255u) == 0u) { if (xb_ld(&bar[XB_TMO])) break; if (sp > XB_SPIN_CAP) { atomicAdd(&bar[XB_TMO], 1u); break; } }
  }
  nloc = mine > 0u ? mine : 1u; nx = cnt > 0u ? cnt : 1u;
}
__device__ __forceinline__ void xcd_barrier(const XcdBarrier& b) {
  asm volatile("s_waitcnt vmcnt(0)" ::: "memory");
  __syncthreads();
  if (threadIdx.x == 0) {
    unsigned* bar = b.bar;
    __builtin_amdgcn_s_waitcnt(0);
    unsigned nloc = b.st[0], nx = b.st[1];
    if (nloc == 0u) { xcd_barrier_complete(bar, b.x, nloc, nx); b.st[0] = nloc; b.st[1] = nx; }
    const unsigned old = xb_add(&bar[XB_XSUB(b.x)], 1u);
    const unsigned gen = old / nloc;
    if (old + 1u == (gen + 1u) * nloc) {
      __builtin_amdgcn_fence(__ATOMIC_RELEASE, "agent");
      asm volatile("s_waitcnt vmcnt(0)" ::: "memory");
      const unsigned og = xb_add(&bar[XB_TOP], 1u);
      const unsigned tg = og / nx;
      if (og + 1u == (tg + 1u) * nx) xb_add(&bar[XB_TOPGEN], 1u);
      else XB_SPIN(xb_ld(&bar[XB_TOPGEN]) == tg, bar);
      __builtin_amdgcn_fence(__ATOMIC_ACQUIRE, "agent");
      xb_add(&bar[XB_XGEN(b.x)], 1u);
      asm volatile("s_waitcnt vmcnt(0)" ::: "memory");
    } else {
      XB_SPIN(xb_ld(&bar[XB_XGEN(b.x)]) == gen, bar);
      __builtin_amdgcn_fence(__ATOMIC_ACQUIRE, "agent");
      asm volatile("s_waitcnt vmcnt(0)" ::: "memory");
    }
  }
  __syncthreads();
}

__device__ __forceinline__ void transpose_item(const float* src, bf16_t* dst, int K, int N, int item, char* smem) {
  float* t = (float*)smem;
  const int nb = N / 64;
  const int k0 = (item / nb) * 64, n0 = (item % nb) * 64;
  const int tid = opaque_tid();
  __syncthreads();
#pragma unroll
  for (int i = 0; i < 8; ++i) {
    const int k = (tid >> 6) + 8 * i, n = tid & 63;
    t[k * 65 + n] = src[(size_t)(k0 + k) * N + n0 + n];
  }
  __syncthreads();
#pragma unroll
  for (int i = 0; i < 8; ++i) {
    const int n = (tid >> 6) + 8 * i, k = tid & 63;
    dst[(size_t)(n0 + n) * K + k0 + k] = f2bf(t[k * 65 + n]);
  }
}

__device__ __forceinline__ void convert_flat(const float* src, bf16_t* dst, size_t n4) {
  const size_t gt = (size_t)opaque_bid() * blockDim.x + opaque_tid(), gs = (size_t)gridDim.x * blockDim.x;
  for (size_t i = gt; i < n4; i += gs) {
    const float4 v = ((const float4*)src)[i];
    uint2 o; o.x = pack2h(v.x, v.y); o.y = pack2h(v.z, v.w);
    ((uint2*)dst)[i] = o;
  }
}

__device__ __forceinline__ void phase_prep(const Params& p, char* smem) {
  const int tid = opaque_tid();
  char* ws = p.ws;
  if (opaque_bid() == 0) {
    unsigned* ctl = (unsigned*)(ws + OFF_CTL);
    if (tid < 64) ctl[tid] = 0u;
    unsigned* xbar = (unsigned*)(ws + OFF_XBAR);
    for (int i = tid; i < XCD_BAR_WORDS; i += 512) xbar[i] = 0u;
    float* misc = (float*)(ws + OFF_MISC);
    if (tid < 2) {
      const float* lp = p.diff_lambda + tid * 128;
      float s01 = 0.f, s23 = 0.f;
      for (int i = 0; i < 32; ++i) { s01 += lp[i] * lp[32 + i]; s23 += lp[64 + i] * lp[96 + i]; }
      const float lam_init = 0.8f - 0.6f * expf(-0.3f * (float)tid);
      misc[tid] = expf(s01) - expf(s23) + lam_init;
      misc[2 + tid] = lam_init;
    }
    if (tid >= 128 && tid < 256) misc[64 + tid - 128] = 0.f;
    if (tid >= 64 && tid < 80) {
      const int i = tid - 64;
      const float xv = p.ret_decay_logit[i];
      misc[16 + i] = -log1pf(expf(-xv));
    }
    float2* ropeD = (float2*)(ws + OFF_ROPE);
    float2* ropeR = (float2*)(ws + OFF_ROPE + 4096);
    for (int i = tid; i < 64 * 8; i += 512) {
      const int v = i >> 3, f = i & 7;
      const float inv = powf(10000.0f, -(float)(2 * f) / 16.0f);
      const float ang = (float)v * inv;
      ropeD[i] = make_float2(cosf(ang), sinf(ang));
    }
    for (int i = tid; i < 64 * 16; i += 512) {
      const int v = i >> 4, f = i & 15;
      const float inv = powf(10000.0f, -(float)(2 * f) / 32.0f);
      const float ang = (float)v * inv;
      ropeR[i] = make_float2(cosf(ang), sinf(ang));
    }
  }
  {
    float* sc = (float*)smem;
    float* red = (float*)(smem + 9 * 1024 * 4);
    float* mod = (float*)(ws + OFF_MOD);
    for (int item = opaque_bid(); item < 192; item += gridDim.x) {
      const int l = item / 96, cb = item % 96;
      __syncthreads();
      for (int i = tid; i < 9 * 1024; i += 512) {
        const int r = i >> 10, k = i & 1023;
        const float cv = (r < 8) ? p.c[r * 1024 + k] : p.c_ctx[k];
        sc[i] = siluf(cv);
      }
      __syncthreads();
      const int col = tid & 63, ks = tid >> 6;
      float acc[9];
#pragma unroll
      for (int r = 0; r < 9; ++r) acc[r] = 0.f;
      const float* w = p.w_ada + (size_t)l * 1024 * 6144 + cb * 64 + col;
#pragma unroll 1
      for (int k0 = ks * 128; k0 < ks * 128 + 128; k0 += 16) {
        float wv[16];
#pragma unroll
        for (int i = 0; i < 16; ++i) wv[i] = w[(size_t)(k0 + i) * 6144];
#pragma unroll
        for (int i = 0; i < 16; ++i)
#pragma unroll
          for (int r = 0; r < 9; ++r) acc[r] = fmaf(sc[r * 1024 + k0 + i], wv[i], acc[r]);
      }
#pragma unroll
      for (int r = 0; r < 9; ++r) red[(ks * 9 + r) * 64 + col] = acc[r];
      __syncthreads();
      for (int i = tid; i < 576; i += 512) {
        const int r = i >> 6, cc = i & 63;
        float s = 0.f;
#pragma unroll
        for (int k8 = 0; k8 < 8; ++k8) s += red[(k8 * 9 + r) * 64 + cc];
        mod[((size_t)l * 9 + r) * 6144 + cb * 64 + cc] = s + p.b_ada[l * 6144 + cb * 64 + cc];
      }
    }
    __syncthreads();
  }
  for (int item = opaque_bid(); item < 3072; item += gridDim.x) {
    const int l = item / 1536;
    int r = item % 1536;
    if (r < 768) transpose_item(p.w_in + (size_t)l * 1024 * 3072, (bf16_t*)(ws + OFF_WIN) + (size_t)l * 3072 * 1024, 1024, 3072, r, smem);
    else if (r < 1024) transpose_item(p.w_out + (size_t)l * 1024 * 1024, (bf16_t*)(ws + OFF_WOUT) + (size_t)l * 1024 * 1024, 1024, 1024, r - 768, smem);
    else transpose_item(p.peer_wq + (size_t)l * 1024 * 2048, (bf16_t*)(ws + OFF_WQ) + (size_t)l * 2048 * 1024, 1024, 2048, r - 1024, smem);
  }
  convert_flat(p.peer_subkeys, (bf16_t*)(ws + OFF_SUBK), 2ull * 262144 / 4);
  {
    const size_t gt = (size_t)opaque_bid() * blockDim.x + tid, gs = (size_t)gridDim.x * blockDim.x;
    float4* dst = (float4*)(ws + OFF_CTXB);
    for (size_t i = gt; i < (size_t)NCTX * 1024 / 4; i += gs) dst[i] = ((const float4*)p.ctx)[i];
  }
}

__device__ __forceinline__ void phase_norm(const Params& p, int layer, int which, const float* xlat, int nrows) {
  const int lane = opaque_tid() & 63;
  const int gw = opaque_bid() * 8 + (opaque_tid() >> 6), nw = gridDim.x * 8;
  const float* g = (which == 0 ? p.norm1_g : p.norm2_g) + layer * 1024;
  const float* mod = (const float*)(p.ws + OFF_MOD) + (size_t)layer * 9 * 6144;
  const float* ctxb = (const float*)(p.ws + OFF_CTXB);
  bf16_t* act = (bf16_t*)(p.ws + OFF_ACT);
  const int sh_off = which == 0 ? 0 : 3 * 1024, sc_off = which == 0 ? 1024 : 4 * 1024;
  for (int row = gw; row < nrows; row += nw) {
    const float* src = row < NLAT ? xlat + (size_t)row * 1024 : ctxb + (size_t)(row - NLAT) * 1024;
    const int b = row < NLAT ? (row >> 12) : 8;
    const float* mrow = mod + (size_t)b * 6144;
    float4 v[4];
    float ss = 0.f;
#pragma unroll
    for (int j = 0; j < 4; ++j) {
      v[j] = ((const float4*)src)[lane + 64 * j];
      ss += v[j].x * v[j].x + v[j].y * v[j].y + v[j].z * v[j].z + v[j].w * v[j].w;
    }
    ss = wave_sum(ss);
    const float r = rsqrtf(ss * (1.f / 1024.f) + EPS);
#pragma unroll
    for (int j = 0; j < 4; ++j) {
      const int c = (lane + 64 * j) * 4;
      const float4 gg = *(const float4*)(g + c);
      const float4 sh = *(const float4*)(mrow + sh_off + c);
      const float4 sc = *(const float4*)(mrow + sc_off + c);
      const float o0 = v[j].x * r * gg.x * (1.f + sc.x) + sh.x;
      const float o1 = v[j].y * r * gg.y * (1.f + sc.y) + sh.y;
      const float o2 = v[j].z * r * gg.z * (1.f + sc.z) + sh.z;
      const float o3 = v[j].w * r * gg.w * (1.f + sc.w) + sh.w;
      uint2 o; o.x = pack2h(o0, o1); o.y = pack2h(o2, o3);
      *(uint2*)(act + (size_t)row * 1024 + c) = o;
    }
  }
}

__device__ __forceinline__ void phase_final(const Params& p) {
  const int lane = opaque_tid() & 63;
  const int gw = opaque_bid() * 8 + (opaque_tid() >> 6), nw = gridDim.x * 8;
  for (int row = gw; row < NLAT; row += nw) {
    float* src = p.out + (size_t)row * 1024;
    float4 v[4];
    float ss = 0.f;
#pragma unroll
    for (int j = 0; j < 4; ++j) {
      v[j] = ((const float4*)src)[lane + 64 * j];
      ss += v[j].x * v[j].x + v[j].y * v[j].y + v[j].z * v[j].z + v[j].w * v[j].w;
    }
    ss = wave_sum(ss);
    const float r = rsqrtf(ss * (1.f / 1024.f) + EPS);
#pragma unroll
    for (int j = 0; j < 4; ++j) {
      const int c = (lane + 64 * j) * 4;
      const float4 gg = *(const float4*)(p.final_g + c);
      float4 o;
      o.x = v[j].x * r * gg.x; o.y = v[j].y * r * gg.y; o.z = v[j].z * r * gg.z; o.w = v[j].w * r * gg.w;
      ((float4*)src)[lane + 64 * j] = o;
    }
  }
}

constexpr int EPI_INPROJ = 0, EPI_OUTPROJ = 1, EPI_PLAIN = 2;
constexpr int GS = 72;
constexpr int G_ASTAGE = 256 * GS * 2;
constexpr int G_BSTAGE = 128 * GS * 2;
constexpr int G_STAGE = G_ASTAGE + G_BSTAGE;

namespace g8 {
constexpr int BM = 256, BK = 64, HALF = 128, NXCD = 8, WGM = 8, HT = HALF * BK;
__device__ __forceinline__ int lds_byte(int r, int c) {
  const int st = (r >> 4) * 2 + (c >> 5), rr = r & 15, cc = c & 31, ob = rr * 64 + cc * 2;
  return st * 1024 + (ob ^ (((ob >> 9) & 1) << 5));
}
__device__ __forceinline__ void stage_rc(int b, int& R, int& C) {
  const int st = b / 1024, sb = b % 1024, swz = sb ^ (((sb >> 9) & 1) << 5);
  R = (st >> 1) * 16 + swz / 64; C = (st & 1) * 32 + (swz % 64) / 2;
}
}

constexpr int G8_ROPE_LDS = 8 * 16384;
template <int EPI>
__device__ __forceinline__ void epi_store8(const Params& p, int layer, char* smem, int m, int n, f32x4 lo, f32x4 hi, const float* xin_lat) {
  float v[8] = {lo[0], lo[1], lo[2], lo[3], hi[0], hi[1], hi[2], hi[3]};
  if constexpr (EPI == EPI_INPROJ) {
    const bool ropeD = (n >= C_DFQ && n < C_DFV), ropeR = (n >= C_RTQ && n < C_RTV);
    if ((ropeD || ropeR) && m < NLAT) {
      const int t = m & 4095, gr = t >> 6, gc = t & 63;
      const float2* tabD = (const float2*)(smem + G8_ROPE_LDS);
      const float2* tabR = (const float2*)(smem + G8_ROPE_LDS + 4096);
      const float2* tb;
      if (ropeD) { const int i0 = (n & 31) >> 1; tb = i0 < 8 ? tabD + gr * 8 + i0 : tabD + gc * 8 + i0 - 8; }
      else { const int i0 = (n & 63) >> 1; tb = i0 < 16 ? tabR + gr * 16 + i0 : tabR + gc * 16 + i0 - 16; }
#pragma unroll
      for (int q = 0; q < 4; ++q) {
        const float2 cs = tb[q];
        const float a0 = v[2 * q] * cs.x - v[2 * q + 1] * cs.y, a1 = v[2 * q] * cs.y + v[2 * q + 1] * cs.x;
        v[2 * q] = a0; v[2 * q + 1] = a1;
      }
    }
    float sc = 1.f;
    if (n < C_NAK) sc = 0.125f * 1.4426950408889634f;
    else if (n >= C_DFQ && n < C_DFK) sc = 0.17677669529663687f * 1.4426950408889634f;
    else if (n >= C_RTK && n < C_RTV) sc = 0.125f;
    uint4 o;
    o.x = pack2h(v[0] * sc, v[1] * sc); o.y = pack2h(v[2] * sc, v[3] * sc); o.z = pack2h(v[4] * sc, v[5] * sc); o.w = pack2h(v[6] * sc, v[7] * sc);
    *(uint4*)((bf16_t*)(p.ws + OFF_P) + (size_t)m * INC + n) = o;
  } else if constexpr (EPI == EPI_OUTPROJ) {
    const float* mod = (const float*)(p.ws + OFF_MOD) + (size_t)layer * 9 * 6144;
    const int b = m < NLAT ? (m >> 12) : 8;
    const float* gp = mod + (size_t)b * 6144 + 2 * 1024 + n;
    const float4 g0 = *(const float4*)gp, g1 = *(const float4*)(gp + 4);
    const float* xi; float* xo;
    if (m < NLAT) { xi = xin_lat + (size_t)m * 1024 + n; xo = p.out + (size_t)m * 1024 + n; }
    else { xo = (float*)(p.ws + OFF_CTXB) + (size_t)(m - NLAT) * 1024 + n; xi = xo; }
    const float4 x0 = *(const float4*)xi, x1 = *(const float4*)(xi + 4);
    float4 o0, o1;
    o0.x = x0.x + g0.x * v[0]; o0.y = x0.y + g0.y * v[1]; o0.z = x0.z + g0.z * v[2]; o0.w = x0.w + g0.w * v[3];
    o1.x = x1.x + g1.x * v[4]; o1.y = x1.y + g1.y * v[5]; o1.z = x1.z + g1.z * v[6]; o1.w = x1.w + g1.w * v[7];
    *(float4*)xo = o0; *(float4*)(xo + 4) = o1;
  } else if constexpr (EPI == EPI_PLAIN) {
    uint4 o;
    o.x = pack2h(v[0], v[1]); o.y = pack2h(v[2], v[3]); o.z = pack2h(v[4], v[5]); o.w = pack2h(v[6], v[7]);
    *(uint4*)((bf16_t*)(p.ws + OFF_P) + (size_t)m * 2048 + n) = o;
  } else {
    asm volatile("" :: "v"(v[0]), "v"(v[1]), "v"(v[2]), "v"(v[3]), "v"(v[4]), "v"(v[5]), "v"(v[6]), "v"(v[7]));
  }
}

#define G8_LAS __attribute__((address_space(3)))
__device__ __forceinline__ bool g8_next(int i, int nM, int nN, int G, int c, int& pm, int& pn) {
  using namespace g8;
  const int nwg = nM * nN;
  const long Lx = (long)i * G + c;
  if (Lx >= nwg) return false;
  int wgid = (int)Lx;
  { const int q = nwg / NXCD, r = nwg % NXCD, xcd = wgid % NXCD, off = wgid / NXCD; wgid = (xcd < r ? xcd * (q + 1) : r * (q + 1) + (xcd - r) * q) + off; }
  const int nig = WGM * nN, gid = wgid / nig, fm = gid * WGM, gsz = (nM - fm) < WGM ? (nM - fm) : WGM;
  pm = fm + ((wgid % nig) % gsz); pn = (wgid % nig) / gsz;
  return true;
}

template <int EPI>
__device__ __forceinline__ void gemm_phase2(const Params& p, int layer, char* smem, const bf16_t* A, const bf16_t* Bt,
                                            int M, int N, const float* xin_lat) {
  using namespace g8;
  constexpr int K = 1024, nt = K / BK, HTB = HALF * BK * 2;
  G8_LAS unsigned char* lds = (G8_LAS unsigned char*)smem;
  const int tid = opaque_tid();
  const int wid = __builtin_amdgcn_readfirstlane(tid >> 6), lane = tid & 63, wr = wid >> 2, wc = wid & 3, fr = lane & 15, fq = lane >> 4;
  unsigned voff[2], voffB[2];
#pragma unroll
  for (int i = 0; i < 2; ++i) {
    int R, C; stage_rc(tid * 16 + i * 8192, R, C);
    const int rho = R & 31, Rb = (R & ~31) + 8 * ((rho & 15) >> 2) + 4 * (rho >> 4) + (rho & 3);
    voff[i] = (unsigned)(R * K + C) * 2u; voffB[i] = (unsigned)(Rb * K + C) * 2u;
  }
  if constexpr (EPI == EPI_INPROJ) {
    __syncthreads();
    const float4* gsrc = (const float4*)(p.ws + OFF_ROPE);
    float4* ldst = (float4*)(smem + G8_ROPE_LDS);
    for (int i = tid; i < 12288 / 16; i += 512) ldst[i] = gsrc[i];
  }
  constexpr size_t kstep = (size_t)(BK * 2);
  constexpr size_t hstep = (size_t)HALF * K * 2;
  constexpr size_t tstep = 2 * hstep;
  const unsigned ldsw = (unsigned)wid * 1024u;
  const int aoff = lds_byte(wr * 64 + fr, fq * 8), boff = lds_byte(wc * 32 + fr, fq * 8);
#define G8_SA(b, h) (((b) * 2 + (h)) * HTB)
#define G8_SB(b, h) ((4 + (b) * 2 + (h)) * HTB)
#define G8_STAGE_V(bufoff, gbase, VO) do { _Pragma("unroll") for (int _i = 0; _i < 2; ++_i)                                  \
    __builtin_amdgcn_global_load_lds((const unsigned*)((const char*)(gbase) + VO[_i]), (G8_LAS unsigned*)(lds + (bufoff) + ldsw + _i * 8192), 16, 0, 0); } while (0)
#define G8_LDA(dst, b, h) do { _Pragma("unroll") for (int m = 0; m < 4; ++m) _Pragma("unroll") for (int k = 0; k < 2; ++k) dst[m][k] = *(const G8_LAS bf16x8*)(lds + G8_SA(b, h) + aoff + m * 2048 + k * 1024); } while (0)
#define G8_LDB(dst, b, h) do { _Pragma("unroll") for (int n = 0; n < 2; ++n) _Pragma("unroll") for (int k = 0; k < 2; ++k) dst[n][k] = *(const G8_LAS bf16x8*)(lds + G8_SB(b, h) + boff + n * 2048 + k * 1024); } while (0)
#define G8_MMA(ai, bj, At_, Bt_) do { __builtin_amdgcn_s_setprio(1);                                                          \
    _Pragma("unroll") for (int m = 0; m < 4; ++m) _Pragma("unroll") for (int n = 0; n < 2; ++n) _Pragma("unroll") for (int k = 0; k < 2; ++k) \
      acc[ai][bj][m][n] = __builtin_amdgcn_mfma_f32_16x16x32_bf16(Bt_[n][k], At_[m][k], acc[ai][bj][m][n], 0, 0, 0);          \
    __builtin_amdgcn_s_setprio(0); } while (0)
#define G8_WAIT_V(n) asm volatile("s_waitcnt vmcnt(" #n ")" ::: "memory")
#define G8_WAIT_L(n) asm volatile("s_waitcnt lgkmcnt(" #n ")" ::: "memory")
#define G8_BAR __builtin_amdgcn_s_barrier()
#define G8_SCHED __builtin_amdgcn_sched_barrier(0)
  const int nM = M / BM, nN = N / BM, G = gridDim.x, cu = opaque_bid();
  int cpm, cpn, npm = 0, npn = 0, ui = 0;
  __syncthreads();
  if (g8_next(0, nM, nN, G, cu, cpm, cpn)) {
    f32x4 acc[2][2][4][2];
#pragma unroll
    for (int a = 0; a < 2; ++a)
#pragma unroll
      for (int b2 = 0; b2 < 2; ++b2)
#pragma unroll
        for (int m = 0; m < 4; ++m)
#pragma unroll
          for (int n = 0; n < 2; ++n) acc[a][b2][m][n] = (f32x4){0.f, 0.f, 0.f, 0.f};
    bf16x8 At[4][2], B0[2][2], B1[2][2];
    const char* cA = (const char*)A + (size_t)cpm * tstep;
    const char* cB = (const char*)Bt + (size_t)cpn * tstep;
    G8_STAGE_V(G8_SB(0, 0), cB, voffB); G8_STAGE_V(G8_SA(0, 0), cA, voff); G8_STAGE_V(G8_SB(0, 1), cB + hstep, voffB); G8_STAGE_V(G8_SA(0, 1), cA + hstep, voff);
    if (wr == 1) G8_BAR;
    G8_WAIT_V(4); G8_BAR;
    G8_STAGE_V(G8_SB(1, 0), cB + kstep, voffB); G8_STAGE_V(G8_SA(1, 0), cA + kstep, voff); G8_STAGE_V(G8_SB(1, 1), cB + hstep + kstep, voffB);
    G8_WAIT_V(6); G8_BAR;
    for (;;) {
      const bool has_next = g8_next(ui + 1, nM, nN, G, cu, npm, npn);
      const char* nA = has_next ? (const char*)A + (size_t)npm * tstep : cA;
      const char* nB = has_next ? (const char*)Bt + (size_t)npn * tstep : cB;
#pragma unroll 1
      for (int t = 0; t < nt; t += 2) {
        const bool last = (t == nt - 2);
        const char* a1 = cA + (size_t)(t + 1) * kstep;
        const char* a2 = last ? nA : cA + (size_t)(t + 2) * kstep; const char* b2 = last ? nB : cB + (size_t)(t + 2) * kstep;
        const char* a3 = a2 + kstep; const char* b3 = b2 + kstep;
        G8_LDB(B0, 0, 0); G8_SCHED; G8_LDA(At, 0, 0); G8_STAGE_V(G8_SA(1, 1), a1 + hstep, voff);
        G8_WAIT_L(8); G8_BAR; G8_WAIT_L(0); G8_MMA(0, 0, At, B0); G8_BAR; G8_SCHED;
        G8_LDB(B1, 0, 1); G8_STAGE_V(G8_SB(0, 0), b2, voffB);
        G8_BAR; G8_WAIT_L(0); G8_MMA(0, 1, At, B1); G8_BAR;
        G8_LDA(At, 0, 1); G8_STAGE_V(G8_SA(0, 0), a2, voff);
        G8_BAR; G8_WAIT_L(0); G8_MMA(1, 0, At, B0); G8_BAR; G8_SCHED;
        G8_STAGE_V(G8_SB(0, 1), b2 + hstep, voffB);
        G8_WAIT_V(6); G8_BAR; G8_MMA(1, 1, At, B1); G8_BAR;
        G8_LDB(B0, 1, 0); G8_SCHED; G8_LDA(At, 1, 0); G8_STAGE_V(G8_SA(0, 1), a2 + hstep, voff);
        G8_WAIT_L(8); G8_BAR; G8_WAIT_L(0); G8_MMA(0, 0, At, B0); G8_BAR; G8_SCHED;
        G8_LDB(B1, 1, 1); G8_STAGE_V(G8_SB(1, 0), b3, voffB);
        G8_BAR; G8_WAIT_L(0); G8_MMA(0, 1, At, B1); G8_BAR;
        G8_LDA(At, 1, 1); G8_STAGE_V(G8_SA(1, 0), a3, voff);
        G8_BAR; G8_WAIT_L(0); G8_MMA(1, 0, At, B0); G8_BAR; G8_SCHED;
        G8_STAGE_V(G8_SB(1, 1), b3 + hstep, voffB);
        G8_WAIT_V(6); G8_BAR; G8_MMA(1, 1, At, B1); G8_BAR;
      }
      {
        const int brow = cpm * BM, bcol = cpn * BM;
        if constexpr (EPI == EPI_INPROJ) {
          if (bcol == C_DFK) {
#pragma unroll
            for (int bj = 0; bj < 2; ++bj) {
              float mx = 0.f;
#pragma unroll
              for (int ai = 0; ai < 2; ++ai)
#pragma unroll
                for (int m = 0; m < 4; ++m) {
                  float s = 0.f;
#pragma unroll
                  for (int n = 0; n < 2; ++n)
#pragma unroll
                    for (int j = 0; j < 4; ++j) s = fmaf(acc[ai][bj][m][n][j], acc[ai][bj][m][n][j], s);
                  s += __shfl_xor(s, 16); s += __shfl_xor(s, 32);
                  mx = fmaxf(mx, s);
                }
#pragma unroll
              for (int o = 1; o < 16; o <<= 1) mx = fmaxf(mx, __shfl_xor(mx, o));
              if (lane == 0) {
                const int bb = brow < NLAT ? (brow >> 12) : ((brow - NLAT) >> 8);
                unsigned* km = (unsigned*)(p.ws + OFF_MISC) + 64 + layer * 64 + (bb * 4 + bj * 2 + (wc >> 1)) * 2 + (wc & 1);
                atomicMax(km, __float_as_uint(mx));
              }
            }
          }
        }
#pragma unroll
        for (int ai = 0; ai < 2; ++ai)
#pragma unroll
          for (int bj = 0; bj < 2; ++bj)
#pragma unroll
            for (int m = 0; m < 4; ++m)
              epi_store8<EPI>(p, layer, smem, brow + ai * HALF + wr * 64 + m * 16 + fr, bcol + bj * HALF + wc * 32 + fq * 8,
                              acc[ai][bj][m][0], acc[ai][bj][m][1], xin_lat);
      }
      if (!has_next) break;
#pragma unroll
      for (int a = 0; a < 2; ++a)
#pragma unroll
        for (int b2 = 0; b2 < 2; ++b2)
#pragma unroll
          for (int m = 0; m < 4; ++m)
#pragma unroll
            for (int n = 0; n < 2; ++n) acc[a][b2][m][n] = (f32x4){0.f, 0.f, 0.f, 0.f};
      cpm = npm; cpn = npn; cA = nA; cB = nB; ++ui;
    }
    G8_WAIT_V(0);
    if (wr == 0) G8_BAR;
    G8_BAR;
  }
}

__device__ __forceinline__ unsigned cvt_pk_bf16(float lo, float hi) {
  unsigned r;
  asm volatile("v_cvt_pk_bf16_f32 %0, %1, %2" : "=v"(r) : "v"(lo), "v"(hi));
  return r;
}
__device__ __forceinline__ void vt_store8(bf16_t* vt, int stride, int d0, int key, uint4 uv) {
  bf16_t* vd = vt + d0 * stride + key;
  vd[0 * stride] = (bf16_t)(uv.x & 0xffffu); vd[1 * stride] = (bf16_t)(uv.x >> 16);
  vd[2 * stride] = (bf16_t)(uv.y & 0xffffu); vd[3 * stride] = (bf16_t)(uv.y >> 16);
  vd[4 * stride] = (bf16_t)(uv.z & 0xffffu); vd[5 * stride] = (bf16_t)(uv.z >> 16);
  vd[6 * stride] = (bf16_t)(uv.w & 0xffffu); vd[7 * stride] = (bf16_t)(uv.w >> 16);
}

constexpr int DKS = 72;
__device__ __forceinline__ void diff_item(const Params& p, int layer, bool ctxq, int item, char* smem) {
  const bf16_t* P = (const bf16_t*)(p.ws + OFF_P);
  bf16_t* Y = (bf16_t*)(p.ws + OFF_ACT);
  const float* misc = (const float*)(p.ws + OFF_MISC);
  const float lam = misc[layer], lam_init = misc[2 + layer];
  const int tid = opaque_tid(), lane = tid & 63, wave = tid >> 6, lr = lane & 15, lq = lane >> 4;
  int b, h, mbase, nkeys;
  if (!ctxq) { b = item >> 6; h = (item >> 4) & 3; mbase = b * 4096 + (item & 15) * 256; nkeys = 256 + 4096; }
  else { b = item >> 2; h = item & 3; mbase = NLAT + b * 256; nkeys = 256; }
  const float kmax0 = sqrtf(misc[64 + layer * 64 + (b * 4 + h) * 2 + 0]), kmax1 = sqrtf(misc[64 + layer * 64 + (b * 4 + h) * 2 + 1]);
  bf16x8 qf[2][2];
  f32x4 C0[2], C1[2];
#pragma unroll
  for (int qt = 0; qt < 2; ++qt) {
    const bf16_t* qr = P + (size_t)(mbase + wave * 32 + qt * 16 + lr) * INC + C_DFQ + h * 64 + lq * 8;
    const uint4 u0 = *(const uint4*)(qr), u1 = *(const uint4*)(qr + 32);
    float s0 = 0.f, s1 = 0.f;
    { float t[8]; UNPACK8(t, 0, u0) _Pragma("unroll") for (int i = 0; i < 8; ++i) s0 = fmaf(t[i], t[i], s0); }
    { float t[8]; UNPACK8(t, 0, u1) _Pragma("unroll") for (int i = 0; i < 8; ++i) s1 = fmaf(t[i], t[i], s1); }
    s0 += __shfl_xor(s0, 16); s0 += __shfl_xor(s0, 32);
    s1 += __shfl_xor(s1, 16); s1 += __shfl_xor(s1, 32);
    const float nm0 = -sqrtf(s0) * kmax0, nm1 = -sqrtf(s1) * kmax1;
    C0[qt] = (f32x4){nm0, nm0, nm0, nm0};
    C1[qt] = (f32x4){nm1, nm1, nm1, nm1};
    union { uint4 u; bf16x8 v; } c0, c1; c0.u = u0; c1.u = u1;
    qf[qt][0] = c0.v; qf[qt][1] = c1.v;
  }
  f32x4 O0[2][4], O1[2][4];
#pragma unroll
  for (int qt = 0; qt < 2; ++qt)
#pragma unroll
    for (int i = 0; i < 4; ++i) { O0[qt][i] = (f32x4){0.f, 0.f, 0.f, 0.f}; O1[qt][i] = (f32x4){0.f, 0.f, 0.f, 0.f}; }
  float l0[2] = {0.f, 0.f}, l1[2] = {0.f, 0.f};
  const int lkey = tid >> 3, lch = tid & 7;
  constexpr int DBUF = 2 * 128 * DKS * 2;
  uint4 ukA0, ukA1, uvA0, uvA1;
#define DF_GLOAD1(UK, UV, T, I)                                                                     \
  {                                                                                                 \
    const int kk = (T) * 128 + (I) * 64 + lkey;                                                     \
    const size_t row = kk < 256 ? (size_t)(NLAT + b * 256 + kk) : (size_t)(b * 4096 + kk - 256);    \
    UK = *(const uint4*)(P + row * INC + C_DFK + h * 64 + lch * 8);                                 \
    UV = *(const uint4*)(P + row * INC + C_DFV + h * 64 + lch * 8);                                 \
  }
#define DF_LSTORE1(UK, UV, BUF, I)                                                                  \
  {                                                                                                 \
    bf16_t* Ks_ = (bf16_t*)(smem + (BUF) * DBUF) + (I) * 64 * DKS;                                  \
    bf16_t* Vt_ = (bf16_t*)(smem + (BUF) * DBUF) + 128 * DKS + (I) * 64 * DKS;                      \
    *(uint4*)(Ks_ + lkey * DKS + lch * 8) = UK;                                                     \
    vt_store8(Vt_, DKS, lch * 8, lkey, UV);                                                         \
  }
#define DF_GLOAD(S, T) DF_GLOAD1(uk##S##0, uv##S##0, T, 0) DF_GLOAD1(uk##S##1, uv##S##1, T, 1)
#define DF_LSTORE(S, BUF) DF_LSTORE1(uk##S##0, uv##S##0, BUF, 0) DF_LSTORE1(uk##S##1, uv##S##1, BUF, 1)
  const int ntile = nkeys >> 7;
  __syncthreads();
  DF_GLOAD(A, 0)
  DF_LSTORE(A, 0)
  __syncthreads();
#pragma unroll 1
  for (int t = 0; t < ntile; ++t) {
    const int cur = t & 1;
    if (t + 1 < ntile) { DF_GLOAD(A, t + 1) }
#pragma unroll 1
    for (int sub = 0; sub < 2; ++sub) {
    const bf16_t* Ks = (const bf16_t*)(smem + cur * DBUF) + sub * 64 * DKS;
    const bf16_t* Vt = (const bf16_t*)(smem + cur * DBUF) + 128 * DKS + sub * 64 * DKS;
    union PF { unsigned u[4]; bf16x8 v; };
    PF pf0[2][2], pf1[2][2];
#pragma unroll
    for (int c = 0; c < 2; ++c) {
      f32x4 S[2][4];
#pragma unroll
      for (int kt = 0; kt < 4; ++kt) {
        const bf16x8 kf = *(const bf16x8*)(Ks + (kt * 16 + lr) * DKS + c * 32 + lq * 8);
#pragma unroll
        for (int qt = 0; qt < 2; ++qt) S[qt][kt] = __builtin_amdgcn_mfma_f32_16x16x32_bf16(kf, qf[qt][c], c == 0 ? C0[qt] : C1[qt], 0, 0, 0);
      }
#pragma unroll
      for (int qt = 0; qt < 2; ++qt) {
        float ps = 0.f;
#pragma unroll
        for (int kt = 0; kt < 4; ++kt) {
#pragma unroll
          for (int r = 0; r < 4; ++r) { S[qt][kt][r] = __builtin_amdgcn_exp2f(S[qt][kt][r]); ps += S[qt][kt][r]; }
        }
        if (c == 0) l0[qt] += ps; else l1[qt] += ps;
#pragma unroll
        for (int g = 0; g < 2; ++g) {
          PF t;
          t.u[0] = cvt_pk_bf16(S[qt][2 * g][0], S[qt][2 * g][1]); t.u[1] = cvt_pk_bf16(S[qt][2 * g][2], S[qt][2 * g][3]);
          t.u[2] = cvt_pk_bf16(S[qt][2 * g + 1][0], S[qt][2 * g + 1][1]); t.u[3] = cvt_pk_bf16(S[qt][2 * g + 1][2], S[qt][2 * g + 1][3]);
          if (c == 0) pf0[qt][g] = t; else pf1[qt][g] = t;
        }
      }
    }
#pragma unroll
    for (int g = 0; g < 2; ++g) {
#pragma unroll
      for (int dt = 0; dt < 4; ++dt) {
        union { uint2 h2[2]; bf16x8 v; } vf;
        vf.h2[0] = *(const uint2*)(Vt + (dt * 16 + lr) * DKS + 32 * g + 4 * lq);
        vf.h2[1] = *(const uint2*)(Vt + (dt * 16 + lr) * DKS + 32 * g + 16 + 4 * lq);
#pragma unroll
        for (int qt = 0; qt < 2; ++qt) {
          O0[qt][dt] = __builtin_amdgcn_mfma_f32_16x16x32_bf16(vf.v, pf0[qt][g].v, O0[qt][dt], 0, 0, 0);
          O1[qt][dt] = __builtin_amdgcn_mfma_f32_16x16x32_bf16(vf.v, pf1[qt][g].v, O1[qt][dt], 0, 0, 0);
        }
      }
    }
    }
    if (t + 1 < ntile) { DF_LSTORE(A, cur ^ 1) }
    __syncthreads();
  }
  const float* sg = p.diff_subln_g + layer * 64;
#pragma unroll
  for (int qt = 0; qt < 2; ++qt) {
    float a0 = l0[qt], a1 = l1[qt];
    a0 += __shfl_xor(a0, 16); a0 += __shfl_xor(a0, 32);
    a1 += __shfl_xor(a1, 16); a1 += __shfl_xor(a1, 32);
    const float i0 = 1.f / a0, i1 = lam / a1;
    float ss = 0.f;
#pragma unroll
    for (int dt = 0; dt < 4; ++dt) {
#pragma unroll
      for (int r = 0; r < 4; ++r) { const float v = O0[qt][dt][r] * i0 - O1[qt][dt][r] * i1; O0[qt][dt][r] = v; ss = fmaf(v, v, ss); }
    }
    ss += __shfl_xor(ss, 16); ss += __shfl_xor(ss, 32);
    const float rr = rsqrtf(ss * (1.f / 64.f) + EPS) * (1.f - lam_init);
    bf16_t* dst = Y + (size_t)(mbase + wave * 32 + qt * 16 + lr) * 1024 + Y_DF + h * 64;
#pragma unroll
    for (int dt = 0; dt < 4; ++dt) {
      const int d = dt * 16 + 4 * lq;
      const float4 g4 = *(const float4*)(sg + d);
      uint2 ov;
      ov.x = pack2(O0[qt][dt][0] * rr * g4.x, O0[qt][dt][1] * rr * g4.y);
      ov.y = pack2(O0[qt][dt][2] * rr * g4.z, O0[qt][dt][3] * rr * g4.w);
      *(uint2*)(dst + d) = ov;
    }
  }
}

constexpr int NA_WS = 520;
constexpr int NA_CS = 264;
constexpr int NA_OFF_VTW = 0;
constexpr int NA_OFF_VTC = 64 * NA_WS * 2;
constexpr int NA_OFF_RPB = NA_OFF_VTC + 64 * NA_CS * 2;
constexpr int NA_OFF_MRG = NA_OFF_RPB + 2048;

#define NA_STEP(KA_EXPR, KB_EXPR, BIAS_EXPR, VT_PTR, VT_STRIDE, VT_KEY0_EXPR)                                    \
  {                                                                                                               \
    f32x4 S[4];                                                                                                   \
    _Pragma("unroll") for (int kt = 0; kt < 4; ++kt) {                                                            \
      f32x4 a = __builtin_amdgcn_mfma_f32_16x16x32_bf16((KA_EXPR), qf[0], (f32x4){0.f, 0.f, 0.f, 0.f}, 0, 0, 0);  \
      S[kt] = __builtin_amdgcn_mfma_f32_16x16x32_bf16((KB_EXPR), qf[1], a, 0, 0, 0);                               \
    }                                                                                                             \
    _Pragma("unroll") for (int kt = 0; kt < 4; ++kt) {                                                            \
      _Pragma("unroll") for (int r = 0; r < 4; ++r) { S[kt][r] += (BIAS_EXPR); }                                  \
    }                                                                                                             \
    float x = fmaxf(fmaxf(S[0][0], S[0][1]), fmaxf(S[0][2], S[0][3]));                                            \
    _Pragma("unroll") for (int kt = 1; kt < 4; ++kt) x = fmaxf(x, fmaxf(fmaxf(S[kt][0], S[kt][1]), fmaxf(S[kt][2], S[kt][3]))); \
    x = fmaxf(x, __shfl_xor(x, 16)); x = fmaxf(x, __shfl_xor(x, 32));                                             \
    const float mn = fmaxf(mrun, x);                                                                              \
    const float al = __builtin_amdgcn_exp2f(mrun - mn);                                                           \
    mrun = mn;                                                                                                    \
    float ps = 0.f;                                                                                               \
    _Pragma("unroll") for (int kt = 0; kt < 4; ++kt) {                                                            \
      _Pragma("unroll") for (int r = 0; r < 4; ++r) { S[kt][r] = __builtin_amdgcn_exp2f(S[kt][r] - mn); ps += S[kt][r]; } \
    }                                                                                                             \
    lrun = lrun * al + ps;                                                                                        \
    _Pragma("unroll") for (int dt = 0; dt < 4; ++dt) {                                                            \
      _Pragma("unroll") for (int r = 0; r < 4; ++r) O[dt][r] *= al;                                               \
    }                                                                                                             \
    _Pragma("unroll") for (int g = 0; g < 2; ++g) {                                                               \
      union { unsigned u[4]; bf16x8 v; } pf;                                                                      \
      pf.u[0] = cvt_pk_bf16(S[2 * g][0], S[2 * g][1]); pf.u[1] = cvt_pk_bf16(S[2 * g][2], S[2 * g][3]);           \
      pf.u[2] = cvt_pk_bf16(S[2 * g + 1][0], S[2 * g + 1][1]); pf.u[3] = cvt_pk_bf16(S[2 * g + 1][2], S[2 * g + 1][3]); \
      const int vk0 = (VT_KEY0_EXPR);                                                                             \
      _Pragma("unroll") for (int dt = 0; dt < 4; ++dt) {                                                          \
        union { uint2 h2[2]; bf16x8 v; } vf;                                                                      \
        vf.h2[0] = *(const uint2*)((VT_PTR) + (dt * 16 + lr) * (VT_STRIDE) + vk0 + 4 * lq);                       \
        vf.h2[1] = *(const uint2*)((VT_PTR) + (dt * 16 + lr) * (VT_STRIDE) + vk0 + 16 + 4 * lq);                  \
        O[dt] = __builtin_amdgcn_mfma_f32_16x16x32_bf16(vf.v, pf.v, O[dt], 0, 0, 0);                              \
      }                                                                                                           \
    }                                                                                                             \
  }

__device__ __forceinline__ void na_latent_item(const Params& p, int layer, int item, char* smem) {
  const bf16_t* P = (const bf16_t*)(p.ws + OFF_P);
  bf16_t* Y = (bf16_t*)(p.ws + OFF_ACT);
  const int b = item >> 8, h = (item >> 6) & 3, grow = item & 63;
  const int tid = opaque_tid(), lane = tid & 63, wave = tid >> 6, lr = lane & 15, lq = lane >> 4;
  const int jt = wave & 3, half = wave >> 2;
  bf16_t* VtW = (bf16_t*)(smem + NA_OFF_VTW);
  bf16_t* VtC = (bf16_t*)(smem + NA_OFF_VTC);
  float* RPB = (float*)(smem + NA_OFF_RPB);
  float* MRG = (float*)(smem + NA_OFF_MRG);
  const int rs = min(max(grow - 4, 0), 56);
  __syncthreads();
  {
    const int ch = tid & 7;
#pragma unroll
    for (int i = 0; i < 8; ++i) {
      const int key = (tid >> 3) + 64 * i;
      const uint4 uv = *(const uint4*)(P + (size_t)(b * 4096 + (rs + (key >> 6)) * 64 + (key & 63)) * INC + C_NAV + h * 64 + ch * 8);
      vt_store8(VtW, NA_WS, ch * 8, key, uv);
    }
#pragma unroll
    for (int i = 0; i < 4; ++i) {
      const int key = (tid >> 3) + 64 * i;
      const uint4 uv = *(const uint4*)(P + (size_t)(NLAT + b * 256 + key) * INC + C_NAV + h * 64 + ch * 8);
      vt_store8(VtC, NA_CS, ch * 8, key, uv);
    }
    if (tid < 465) RPB[tid] = p.na_rpb[(size_t)(layer * 4 + h) * 465 + tid] * 1.4426950408889634f;
  }
  const int qc = jt * 16 + lr;
  const int mq = b * 4096 + grow * 64 + qc;
  bf16x8 qf[2];
  {
    const bf16_t* qr = P + (size_t)mq * INC + C_NAQ + h * 64 + lq * 8;
    qf[0] = *(const bf16x8*)(qr);
    qf[1] = *(const bf16x8*)(qr + 32);
  }
  f32x4 O[4];
#pragma unroll
  for (int i = 0; i < 4; ++i) O[i] = (f32x4){0.f, 0.f, 0.f, 0.f};
  float mrun = -1e30f, lrun = 0.f;
  const int k0 = min(max(jt * 16 - 8, 0), 32);
  const int cs = min(max(qc - 8, 0), 48);
  bf16x8 kfa[2][4], kfb[2][4];
#define NA_LOADK(SET, S_)                                                                                        \
  _Pragma("unroll") for (int kt = 0; kt < 4; ++kt) {                                                             \
    const int t_ = 4 * (S_) + kt;                                                                                \
    const size_t krow = half == 0 ? (size_t)(b * 4096 + (rs + (t_ >> 1)) * 64 + k0 + 16 * (t_ & 1) + lr) : (size_t)(NLAT + b * 256 + 16 * t_ + lr); \
    const bf16_t* kp = P + krow * INC + C_NAK + h * 64 + lq * 8;                                                 \
    kfa[SET][kt] = *(const bf16x8*)(kp); kfb[SET][kt] = *(const bf16x8*)(kp + 32);                               \
  }
  NA_LOADK(0, 0)
  __syncthreads();
#pragma unroll
  for (int s = 0; s < 4; ++s) {
    if (s + 1 < 4) { NA_LOADK((s + 1) & 1, s + 1) }
    if (half == 0) {
      const int wr0 = 2 * s;
      NA_STEP(kfa[s & 1][kt], kfb[s & 1][kt],
              ((k0 + 16 * (kt & 1) + 4 * lq + r) >= cs && (k0 + 16 * (kt & 1) + 4 * lq + r) < cs + 16)
                  ? RPB[(rs + wr0 + (kt >> 1) - grow + 7) * 31 + (k0 + 16 * (kt & 1) + 4 * lq + r) - qc + 15] : -1e30f,
              VtW, NA_WS, (wr0 + g) * 64 + k0)
    } else {
      NA_STEP(kfa[s & 1][kt], kfb[s & 1][kt], 0.f, VtC, NA_CS, s * 64 + 32 * g)
    }
  }
  lrun += __shfl_xor(lrun, 16); lrun += __shfl_xor(lrun, 32);
  float* mg = MRG + (jt * 64 + lane) * 18;
  if (half == 1) {
    mg[0] = mrun; mg[1] = lrun;
#pragma unroll
    for (int dt = 0; dt < 4; ++dt) { mg[2 + dt * 4 + 0] = O[dt][0]; mg[2 + dt * 4 + 1] = O[dt][1]; mg[2 + dt * 4 + 2] = O[dt][2]; mg[2 + dt * 4 + 3] = O[dt][3]; }
  }
  __syncthreads();
  if (half == 0) {
    const float m2 = mg[0], l2 = mg[1];
    const float M = fmaxf(mrun, m2);
    const float f1 = __builtin_amdgcn_exp2f(mrun - M), f2 = __builtin_amdgcn_exp2f(m2 - M);
    const float inv = 1.f / (lrun * f1 + l2 * f2);
    bf16_t* dst = Y + (size_t)mq * 1024 + Y_NA + h * 64;
#pragma unroll
    for (int dt = 0; dt < 4; ++dt) {
      const float o0 = (O[dt][0] * f1 + mg[2 + dt * 4 + 0] * f2) * inv, o1 = (O[dt][1] * f1 + mg[2 + dt * 4 + 1] * f2) * inv;
      const float o2 = (O[dt][2] * f1 + mg[2 + dt * 4 + 2] * f2) * inv, o3 = (O[dt][3] * f1 + mg[2 + dt * 4 + 3] * f2) * inv;
      uint2 ov; ov.x = pack2(o0, o1); ov.y = pack2(o2, o3);
      *(uint2*)(dst + dt * 16 + 4 * lq) = ov;
    }
  }
}

__device__ __forceinline__ void na_ctx_item(const Params& p, int item, char* smem) {
  const bf16_t* P = (const bf16_t*)(p.ws + OFF_P);
  bf16_t* Y = (bf16_t*)(p.ws + OFF_ACT);
  const int b = item >> 3, h = (item >> 1) & 3, qg = item & 1;
  const int tid = opaque_tid(), lane = tid & 63, wave = tid >> 6, lr = lane & 15, lq = lane >> 4;
  bf16_t* VtC = (bf16_t*)(smem + NA_OFF_VTC);
  __syncthreads();
  {
    const int ch = tid & 7;
#pragma unroll
    for (int i = 0; i < 4; ++i) {
      const int key = (tid >> 3) + 64 * i;
      const uint4 uv = *(const uint4*)(P + (size_t)(NLAT + b * 256 + key) * INC + C_NAV + h * 64 + ch * 8);
      vt_store8(VtC, NA_CS, ch * 8, key, uv);
    }
  }
  const int mq = NLAT + b * 256 + qg * 128 + wave * 16 + lr;
  bf16x8 qf[2];
  {
    const bf16_t* qr = P + (size_t)mq * INC + C_NAQ + h * 64 + lq * 8;
    qf[0] = *(const bf16x8*)(qr);
    qf[1] = *(const bf16x8*)(qr + 32);
  }
  f32x4 O[4];
#pragma unroll
  for (int i = 0; i < 4; ++i) O[i] = (f32x4){0.f, 0.f, 0.f, 0.f};
  float mrun = -1e30f, lrun = 0.f;
  __syncthreads();
#pragma unroll 1
  for (int s = 0; s < 4; ++s) {
    NA_STEP(*(const bf16x8*)(P + (size_t)(NLAT + b * 256 + s * 64 + kt * 16 + lr) * INC + C_NAK + h * 64 + lq * 8),
            *(const bf16x8*)(P + (size_t)(NLAT + b * 256 + s * 64 + kt * 16 + lr) * INC + C_NAK + h * 64 + 32 + lq * 8), 0.f, VtC, NA_CS, s * 64 + 32 * g)
  }
  lrun += __shfl_xor(lrun, 16); lrun += __shfl_xor(lrun, 32);
  const float inv = 1.f / lrun;
  bf16_t* dst = Y + (size_t)mq * 1024 + Y_NA + h * 64;
#pragma unroll
  for (int dt = 0; dt < 4; ++dt) {
    uint2 ov; ov.x = pack2(O[dt][0] * inv, O[dt][1] * inv); ov.y = pack2(O[dt][2] * inv, O[dt][3] * inv);
    *(uint2*)(dst + dt * 16 + 4 * lq) = ov;
  }
}

constexpr int KV_S = 136;
constexpr int KV_OFF_KF = 0, KV_OFF_KB = 64 * KV_S * 2, KV_OFF_VT = 2 * 64 * KV_S * 2;
__device__ __forceinline__ void ret_kv_item(const Params& p, int layer, int h, size_t row0, int cnt, float* dstF, float* dstB, char* smem) {
  const bf16_t* P = (const bf16_t*)(p.ws + OFF_P);
  const float* misc = (const float*)(p.ws + OFF_MISC);
  const float lgF2 = misc[16 + layer * 8 + 0 * 4 + h] * 1.4426950408889634f, lgB2 = misc[16 + layer * 8 + 1 * 4 + h] * 1.4426950408889634f;
  const int tid = opaque_tid(), lane = tid & 63, wave = tid >> 6, lr = lane & 15, lq = lane >> 4;
  bf16_t* KFt = (bf16_t*)(smem + KV_OFF_KF);
  bf16_t* KBt = (bf16_t*)(smem + KV_OFF_KB);
  bf16_t* Vt = (bf16_t*)(smem + KV_OFF_VT);
  const int dir = wave >> 2, dt = wave & 3;
  f32x4 acc[8];
#pragma unroll
  for (int i = 0; i < 8; ++i) acc[i] = (f32x4){0.f, 0.f, 0.f, 0.f};
#pragma unroll 1
  for (int kc = 0; kc < (cnt >> 7); ++kc) {
    __syncthreads();
    {
      const int tok = tid >> 2, c = tid & 3;
      const int j = kc * 128 + tok;
      const float wF = __builtin_amdgcn_exp2f(lgF2 * (float)(cnt - 1 - j)), wB = __builtin_amdgcn_exp2f(lgB2 * (float)j);
      const bf16_t* rowp = P + (row0 + j) * INC;
#pragma unroll
      for (int c8 = 0; c8 < 2; ++c8) {
        const uint4 u = *(const uint4*)(rowp + C_RTK + h * 64 + c * 16 + c8 * 8);
        float kv[8];
        UNPACK8(kv, 0, u)
#pragma unroll
        for (int i = 0; i < 8; ++i) {
          KFt[(c * 16 + c8 * 8 + i) * KV_S + tok] = f2bf(kv[i] * wF);
          KBt[(c * 16 + c8 * 8 + i) * KV_S + tok] = f2bf(kv[i] * wB);
        }
      }
#pragma unroll
      for (int c8 = 0; c8 < 4; ++c8) {
        const uint4 uv = *(const uint4*)(rowp + C_RTV + h * 128 + c * 32 + c8 * 8);
        vt_store8(Vt, KV_S, c * 32 + c8 * 8, tok, uv);
      }
    }
    __syncthreads();
    const bf16_t* Kt = dir == 0 ? KFt : KBt;
    bf16x8 af[4];
#pragma unroll
    for (int ks = 0; ks < 4; ++ks) af[ks] = *(const bf16x8*)(Kt + (dt * 16 + lr) * KV_S + ks * 32 + lq * 8);
#pragma unroll
    for (int et = 0; et < 8; ++et) {
#pragma unroll
      for (int ks = 0; ks < 4; ++ks) {
        const bf16x8 bfr = *(const bf16x8*)(Vt + (et * 16 + lr) * KV_S + ks * 32 + lq * 8);
        acc[et] = __builtin_amdgcn_mfma_f32_16x16x32_bf16(af[ks], bfr, acc[et], 0, 0, 0);
      }
    }
  }
  float* dst = dir == 0 ? dstF : dstB;
#pragma unroll
  for (int et = 0; et < 8; ++et) {
#pragma unroll
    for (int r = 0; r < 4; ++r) dst[(dt * 16 + 4 * lq + r) * 128 + et * 16 + lr] = acc[et][r];
  }
}

__device__ __forceinline__ void phase_ret_scan(const Params& p, int layer) {
  const float* misc = (const float*)(p.ws + OFF_MISC);
  float* rkv = (float*)(p.ws + OFF_RKV);
  const float* rs = (const float*)(p.ws + OFF_RS);
  const int gt = opaque_bid() * 512 + opaque_tid(), gs = gridDim.x * 512;
  for (int idx = gt; idx < 64 * 2048; idx += gs) {
    const int seq = idx >> 11, e4 = (idx & 2047) * 4;
    const int dir = seq & 1, h = (seq >> 1) & 3;
    const float cdec = __expf(misc[16 + layer * 8 + dir * 4 + h] * 128.f);
    float4* base = (float4*)(rkv + (size_t)seq * 32 * 8192 + e4);
    float4 v[32];
#pragma unroll
    for (int s = 0; s < 32; ++s) v[s] = base[(size_t)s * 2048];
    float4 st = *(const float4*)(rs + (size_t)seq * 8192 + e4);
    if (dir == 0) {
#pragma unroll
      for (int s = 0; s < 32; ++s) {
        const float4 t = v[s];
        base[(size_t)s * 2048] = st;
        st.x = fmaf(cdec, st.x, t.x); st.y = fmaf(cdec, st.y, t.y); st.z = fmaf(cdec, st.z, t.z); st.w = fmaf(cdec, st.w, t.w);
      }
    } else {
#pragma unroll
      for (int s = 31; s >= 0; --s) {
        const float4 t = v[s];
        base[(size_t)s * 2048] = st;
        st.x = fmaf(cdec, st.x, t.x); st.y = fmaf(cdec, st.y, t.y); st.z = fmaf(cdec, st.z, t.z); st.w = fmaf(cdec, st.w, t.w);
      }
    }
  }
}

constexpr int RT_KS = 72, RT_VS = 136;
constexpr int RT_OFF_K = 0, RT_OFF_VT = 128 * RT_KS * 2, RT_OFF_SF = RT_OFF_VT + 128 * RT_VS * 2, RT_OFF_SB = RT_OFF_SF + 128 * RT_KS * 2;
__device__ __forceinline__ void ret_out_item(const Params& p, int layer, int h, size_t krow0, int nkc, int iq0,
                                             const float* SF, const float* SB, int clen, char* smem) {
  const bf16_t* P = (const bf16_t*)(p.ws + OFF_P);
  bf16_t* Y = (bf16_t*)(p.ws + OFF_ACT);
  const float* misc = (const float*)(p.ws + OFF_MISC);
  const float lgF2 = misc[16 + layer * 8 + 0 * 4 + h] * 1.4426950408889634f, lgB2 = misc[16 + layer * 8 + 1 * 4 + h] * 1.4426950408889634f;
  const int tid = opaque_tid(), lane = tid & 63, wave = tid >> 6, lr = lane & 15, lq = lane >> 4;
  bf16_t* Ks = (bf16_t*)(smem + RT_OFF_K);
  bf16_t* Vt = (bf16_t*)(smem + RT_OFF_VT);
  bf16_t* SFt = (bf16_t*)(smem + RT_OFF_SF);
  bf16_t* SBt = (bf16_t*)(smem + RT_OFF_SB);
  const int iq = iq0 + wave * 16 + lr;
  const size_t mq = krow0 + iq;
  bf16x8 qf[2];
  {
    const bf16_t* qr = P + mq * INC + C_RTQ + h * 64 + lq * 8;
    qf[0] = *(const bf16x8*)(qr);
    qf[1] = *(const bf16x8*)(qr + 32);
  }
  f32x4 O[8];
#pragma unroll
  for (int i = 0; i < 8; ++i) O[i] = (f32x4){0.f, 0.f, 0.f, 0.f};
  if (SF != nullptr) {
    __syncthreads();
    {
      const int d = tid >> 3, e0 = (tid & 7) * 16;
#pragma unroll
      for (int c4 = 0; c4 < 4; ++c4) {
        const float4 a = *(const float4*)(SF + d * 128 + e0 + c4 * 4);
        const float4 bb = *(const float4*)(SB + d * 128 + e0 + c4 * 4);
        SFt[(e0 + c4 * 4 + 0) * RT_KS + d] = f2bf(a.x); SFt[(e0 + c4 * 4 + 1) * RT_KS + d] = f2bf(a.y);
        SFt[(e0 + c4 * 4 + 2) * RT_KS + d] = f2bf(a.z); SFt[(e0 + c4 * 4 + 3) * RT_KS + d] = f2bf(a.w);
        SBt[(e0 + c4 * 4 + 0) * RT_KS + d] = f2bf(bb.x); SBt[(e0 + c4 * 4 + 1) * RT_KS + d] = f2bf(bb.y);
        SBt[(e0 + c4 * 4 + 2) * RT_KS + d] = f2bf(bb.z); SBt[(e0 + c4 * 4 + 3) * RT_KS + d] = f2bf(bb.w);
      }
    }
    __syncthreads();
    const float cF = __builtin_amdgcn_exp2f(lgF2 * (float)(iq + 1)), cB = __builtin_amdgcn_exp2f(lgB2 * (float)(clen - iq));
#pragma unroll
    for (int ks = 0; ks < 2; ++ks)
#pragma unroll
      for (int et = 0; et < 8; ++et) {
        const bf16x8 sf = *(const bf16x8*)(SFt + (et * 16 + lr) * RT_KS + ks * 32 + lq * 8);
        O[et] = __builtin_amdgcn_mfma_f32_16x16x32_bf16(sf, qf[ks], O[et], 0, 0, 0);
      }
    const float ratio = cF / cB;
#pragma unroll
    for (int et = 0; et < 8; ++et) { O[et][0] *= ratio; O[et][1] *= ratio; O[et][2] *= ratio; O[et][3] *= ratio; }
#pragma unroll
    for (int ks = 0; ks < 2; ++ks)
#pragma unroll
      for (int et = 0; et < 8; ++et) {
        const bf16x8 sb = *(const bf16x8*)(SBt + (et * 16 + lr) * RT_KS + ks * 32 + lq * 8);
        O[et] = __builtin_amdgcn_mfma_f32_16x16x32_bf16(sb, qf[ks], O[et], 0, 0, 0);
      }
#pragma unroll
    for (int et = 0; et < 8; ++et) { O[et][0] *= cB; O[et][1] *= cB; O[et][2] *= cB; O[et][3] *= cB; }
  }
#pragma unroll 1
  for (int kc = 0; kc < nkc; ++kc) {
    __syncthreads();
    {
      const int key = tid >> 2, c = tid & 3;
      const bf16_t* rowp = P + (krow0 + kc * 128 + key) * INC;
      const uint4 k0 = *(const uint4*)(rowp + C_RTK + h * 64 + c * 16), k1 = *(const uint4*)(rowp + C_RTK + h * 64 + c * 16 + 8);
      *(uint4*)(Ks + key * RT_KS + c * 16) = k0;
      *(uint4*)(Ks + key * RT_KS + c * 16 + 8) = k1;
#pragma unroll
      for (int c8 = 0; c8 < 4; ++c8) {
        const uint4 uv = *(const uint4*)(rowp + C_RTV + h * 128 + c * 32 + c8 * 8);
        vt_store8(Vt, RT_VS, c * 32 + c8 * 8, key, uv);
      }
    }
    __syncthreads();
    f32x4 S[8];
#pragma unroll
    for (int kt = 0; kt < 8; ++kt) {
      const bf16x8 ka = *(const bf16x8*)(Ks + (kt * 16 + lr) * RT_KS + lq * 8);
      const bf16x8 kb = *(const bf16x8*)(Ks + (kt * 16 + lr) * RT_KS + 32 + lq * 8);
      const f32x4 a = __builtin_amdgcn_mfma_f32_16x16x32_bf16(ka, qf[0], (f32x4){0.f, 0.f, 0.f, 0.f}, 0, 0, 0);
      S[kt] = __builtin_amdgcn_mfma_f32_16x16x32_bf16(kb, qf[1], a, 0, 0, 0);
    }
#pragma unroll
    for (int kt = 0; kt < 8; ++kt) {
#pragma unroll
      for (int r = 0; r < 4; ++r) {
        const int df = iq - (kc * 128 + kt * 16 + 4 * lq + r);
        const float fdf = (float)df;
        float coef = 0.f;
        if (df >= 0) coef += __builtin_amdgcn_exp2f(lgF2 * fdf);
        if (df <= 0) coef += __builtin_amdgcn_exp2f(-lgB2 * fdf);
        S[kt][r] *= coef;
      }
    }
#pragma unroll
    for (int g = 0; g < 4; ++g) {
      union { unsigned u[4]; bf16x8 v; } pf;
      pf.u[0] = cvt_pk_bf16(S[2 * g][0], S[2 * g][1]); pf.u[1] = cvt_pk_bf16(S[2 * g][2], S[2 * g][3]);
      pf.u[2] = cvt_pk_bf16(S[2 * g + 1][0], S[2 * g + 1][1]); pf.u[3] = cvt_pk_bf16(S[2 * g + 1][2], S[2 * g + 1][3]);
#pragma unroll
      for (int et = 0; et < 8; ++et) {
        union { uint2 h2[2]; bf16x8 v; } vf;
        vf.h2[0] = *(const uint2*)(Vt + (et * 16 + lr) * RT_VS + 32 * g + 4 * lq);
        vf.h2[1] = *(const uint2*)(Vt + (et * 16 + lr) * RT_VS + 32 * g + 16 + 4 * lq);
        O[et] = __builtin_amdgcn_mfma_f32_16x16x32_bf16(vf.v, pf.v, O[et], 0, 0, 0);
      }
    }
  }
  float ss = 0.f;
#pragma unroll
  for (int et = 0; et < 8; ++et) { ss = fmaf(O[et][0], O[et][0], ss); ss = fmaf(O[et][1], O[et][1], ss); ss = fmaf(O[et][2], O[et][2], ss); ss = fmaf(O[et][3], O[et][3], ss); }
  ss += __shfl_xor(ss, 16); ss += __shfl_xor(ss, 32);
  const float rr = rsqrtf(ss * (1.f / 128.f) + EPS);
  const bf16_t* gp = P + mq * INC + C_RTG + h * 128;
  bf16_t* dst = Y + mq * 1024 + Y_RT + h * 128;
#pragma unroll
  for (int et = 0; et < 8; ++et) {
    const int e = et * 16 + 4 * lq;
    const uint2 gu = *(const uint2*)(gp + e);
    uint2 ov;
    ov.x = pack2(O[et][0] * rr * siluf(lo16(gu.x)), O[et][1] * rr * siluf(hi16(gu.x)));
    ov.y = pack2(O[et][2] * rr * siluf(lo16(gu.y)), O[et][3] * rr * siluf(hi16(gu.y)));
    *(uint2*)(dst + e) = ov;
  }
}

__device__ __forceinline__ void uv_convert_item(const Params& p, int item) {
  char* ws = p.ws;
  const int tid = opaque_tid();
  const int lane = tid & 63, l = lane & 31, half = lane >> 5, wave = tid >> 6;
#pragma unroll 1
  for (int it = 0; it < 16; ++it) {
    const int row = item * 256 + (wave * 16 + it) * 2 + half;
    const bool isv = row >= 2 * NEXP;
    const int rr = isv ? row - 2 * NEXP : row;
    const float* srow = (isv ? p.peer_v : p.peer_u) + (size_t)rr * 1024;
    float4 v[8];
    float mx = 0.f;
#pragma unroll
    for (int j = 0; j < 8; ++j) {
      v[j] = ((const float4*)srow)[l + 32 * j];
      mx = fmaxf(mx, fmaxf(fmaxf(fabsf(v[j].x), fabsf(v[j].y)), fmaxf(fabsf(v[j].z), fabsf(v[j].w))));
    }
#pragma unroll
    for (int o = 1; o < 32; o <<= 1) mx = fmaxf(mx, __shfl_xor(mx, o));
    const float scale = mx > 0.f ? mx * (1.f / 7.5f) : 1.f;
    const float inv = 1.f / scale;
    unsigned w[6] = {0u, 0u, 0u, 0u, 0u, 0u};
#pragma unroll
    for (int k = 0; k < 32; ++k) {
      const float xv = (k & 3) == 0 ? v[k >> 2].x : (k & 3) == 1 ? v[k >> 2].y : (k & 3) == 2 ? v[k >> 2].z : v[k >> 2].w;
      const float a = fminf(fabsf(xv) * inv, 7.5f);
      float c;
      if (a < 2.f) c = rintf(a * 8.f);
      else if (a < 4.f) c = 16.f + rintf((a - 2.f) * 4.f);
      else c = 24.f + rintf((a - 4.f) * 2.f);
      unsigned code = (unsigned)c;
      code = code > 31u ? 31u : code;
      code |= (xv < 0.f) ? 32u : 0u;
      const int bit = 6 * k, wd = bit >> 5, sh = bit & 31;
      w[wd] |= code << sh;
      if (sh > 26) w[wd + 1] |= code >> (32 - sh);
    }
    char* drow = ws + OFF_U + (size_t)rr * RECB + (isv ? ROWB : 0) + l * 24;
    *(uint2*)(drow) = make_uint2(w[0], w[1]);
    *(uint2*)(drow + 8) = make_uint2(w[2], w[3]);
    *(uint2*)(drow + 16) = make_uint2(w[4], w[5]);
    if (l == 0) ((float*)(ws + (isv ? OFF_VSC : OFF_USC)))[rr] = scale;
  }
}

__device__ __forceinline__ void phase_mix1(const Params& p, int layer, char* smem, int slot = 0) {
  unsigned* ctr = (unsigned*)(p.ws + OFF_CTL) + (layer * 4 + slot);
  const bool nc = layer == 0;
  const int n_dl = 512, n_dc = nc ? 32 : 0, n_uv = nc ? 256 : 0, n_nl = 2048, n_ncx = nc ? 64 : 0, n_kv = 1024, n_cs = 32;
  const int total = n_dl + n_dc + n_uv + n_nl + n_ncx + n_kv + n_cs;
  float* rkv = (float*)(p.ws + OFF_RKV);
  float* rs = (float*)(p.ws + OFF_RS);
  for (;;) {
    int it = next_item(ctr, smem);
    if (it >= total) break;
    if (it < n_dl) { diff_item(p, layer, false, it, smem); continue; } it -= n_dl;
    if (it < n_dc) { diff_item(p, layer, true, it, smem); continue; } it -= n_dc;
    if (it < n_uv) { uv_convert_item(p, it); continue; } it -= n_uv;
    if (it < n_nl) { na_latent_item(p, layer, it, smem); continue; } it -= n_nl;
    if (it < n_ncx) { na_ctx_item(p, it, smem); continue; } it -= n_ncx;
    if (it < n_kv) {
      const int bh = it >> 5, n = it & 31, b = bh >> 2, h = bh & 3;
      ret_kv_item(p, layer, h, (size_t)b * 4096 + n * 128, 128,
                  rkv + ((size_t)(bh * 2 + 0) * 32 + n) * 8192, rkv + ((size_t)(bh * 2 + 1) * 32 + n) * 8192, smem);
      continue;
    }
    it -= n_kv;
    {
      const int bh = it, b = bh >> 2, h = bh & 3;
      ret_kv_item(p, layer, h, (size_t)NLAT + b * 256, 256, rs + (size_t)(bh * 2 + 0) * 8192, rs + (size_t)(bh * 2 + 1) * 8192, smem);
    }
  }
}

__device__ __forceinline__ void phase_mix2(const Params& p, int layer, char* smem, int slot = 1) {
  unsigned* ctr = (unsigned*)(p.ws + OFF_CTL) + (layer * 4 + slot);
  const int n_l = 1024, n_c = layer == 0 ? 64 : 0;
  const float* rkv = (const float*)(p.ws + OFF_RKV);
  for (;;) {
    int it = next_item(ctr, smem);
    if (it >= n_l + n_c) break;
    if (it < n_l) {
      const int bh = it >> 5, n = it & 31, b = bh >> 2, h = bh & 3;
      ret_out_item(p, layer, h, (size_t)b * 4096 + n * 128, 1, 0,
                   rkv + ((size_t)(bh * 2 + 0) * 32 + n) * 8192, rkv + ((size_t)(bh * 2 + 1) * 32 + n) * 8192, 128, smem);
    } else {
      it -= n_l;
      const int bh = it >> 1, half = it & 1, b = bh >> 2, h = bh & 3;
      ret_out_item(p, layer, h, (size_t)NLAT + b * 256, 2, half * 128, nullptr, nullptr, 256, smem);
    }
  }
}

typedef float f32x2 __attribute__((ext_vector_type(2)));
__device__ __forceinline__ unsigned sortable_key(float f, int idx) {
  const unsigned b = __float_as_uint(f);
  const unsigned k = b ^ ((unsigned)((int)b >> 31) | 0x80000000u);
  return (k & ~127u) | (unsigned)(127 - idx);
}
__device__ __forceinline__ float key_value(unsigned k) {
  k &= ~127u;
  const unsigned b = (k & 0x80000000u) ? (k ^ 0x80000000u) : ~k;
  return __uint_as_float(b);
}
#define FP8DOT(acc, H, off, W) { const f32x2 _a = __builtin_amdgcn_cvt_pk_f32_fp8((int)(W), false), _b = __builtin_amdgcn_cvt_pk_f32_fp8((int)(W), true); \
  acc = fmaf(H[(off) + 0], _a.x, acc); acc = fmaf(H[(off) + 1], _a.y, acc); acc = fmaf(H[(off) + 2], _b.x, acc); acc = fmaf(H[(off) + 3], _b.y, acc); }
#define FP8AXPY(O, off, P, W) { const f32x2 _a = __builtin_amdgcn_cvt_pk_f32_fp8((int)(W), false), _b = __builtin_amdgcn_cvt_pk_f32_fp8((int)(W), true); \
  O[(off) + 0] = fmaf(P, _a.x, O[(off) + 0]); O[(off) + 1] = fmaf(P, _a.y, O[(off) + 1]); O[(off) + 2] = fmaf(P, _b.x, O[(off) + 2]); O[(off) + 3] = fmaf(P, _b.y, O[(off) + 3]); }

__device__ __forceinline__ float gelu_erf(float a) {
  const float x = fabsf(a) * 0.70710678118654752f;
  const float t = __builtin_amdgcn_rcpf(fmaf(0.3275911f, x, 1.f));
  float pl = fmaf(1.061405429f, t, -1.453152027f);
  pl = fmaf(pl, t, 1.421413741f); pl = fmaf(pl, t, -0.284496736f); pl = fmaf(pl, t, 0.254829592f);
  const float y = 1.f - pl * t * __builtin_amdgcn_exp2f(-x * x * 1.4426950408889634f);
  const float er = a < 0.f ? -y : y;
  return 0.5f * a * (1.f + er);
}
constexpr int PE_SVS = 132;
constexpr int PE_OFF_SV = 0;
constexpr int PE_OFF_TV = 8 * 16 * PE_SVS * 4;
constexpr int PE_OFF_TI = PE_OFF_TV + 16 * 16 * 16 * 4;
constexpr int PE_OFF_EX = PE_OFF_TI + 16 * 16 * 16 * 4;
constexpr int PE_OFF_GT = PE_OFF_EX + 1 * 16 * 128 * 4;
constexpr int PE_OFF_SU = PE_OFF_GT + 1 * 16 * 128 * 4;
constexpr int PE_OFF_CN = PE_OFF_SU + 1 * 16 * 128 * 4;
constexpr int PE_OFF_CT = PE_OFF_CN + 8 * 16 * 4;
#define WAVE_LDS_FENCE() asm volatile("s_waitcnt lgkmcnt(0)" ::: "memory")

__device__ __forceinline__ void peer_select_head(const Params& p, int layer, char* smem, int tok0, int hd, int sw, int buf,
                                                 int lane) {
  const bf16_t* Q = (const bf16_t*)(p.ws + OFF_P);
  const bf16_t* SK = (const bf16_t*)(p.ws + OFF_SUBK) + (size_t)layer * 262144;
  const int lr = lane & 15, lq = lane >> 4;
  unsigned* SV = (unsigned*)(smem + PE_OFF_SV) + sw * 16 * PE_SVS;
  float* TV = (float*)(smem + PE_OFF_TV);
  int* TI = (int*)(smem + PE_OFF_TI);
  int* EX = (int*)(smem + PE_OFF_EX) + buf * 16 * 128;
  float* GT = (float*)(smem + PE_OFF_GT) + buf * 16 * 128;
  int* CN = (int*)(smem + PE_OFF_CN) + sw * 16;
  float* SU = (float*)(smem + PE_OFF_SU) + buf * 16 * 128;
  const float* USC = (const float*)(p.ws + OFF_USC) + layer * NEXP;
  const float* VSC = (const float*)(p.ws + OFF_VSC) + layer * NEXP;
#pragma unroll 1
  for (int pp = 0; pp < 2; ++pp) {
    bf16x8 af[4];
    const bf16_t* qrow = Q + (size_t)(tok0 + lr) * 2048 + hd * 256 + pp * 128;
#pragma unroll
    for (int ks = 0; ks < 4; ++ks) af[ks] = *(const bf16x8*)(qrow + ks * 32 + lq * 8);
    const bf16_t* skb = SK + (size_t)((hd * 2 + pp) * 128) * 128;
    f32x4 acc[8];
    {
      bf16x8 bfr[8][4];
#pragma unroll
      for (int nt = 0; nt < 8; ++nt)
#pragma unroll
        for (int ks = 0; ks < 4; ++ks)
          bfr[nt][ks] = *(const bf16x8*)(skb + (size_t)(nt * 16 + lr) * 128 + ks * 32 + lq * 8);
#pragma unroll
      for (int nt = 0; nt < 8; ++nt) {
        f32x4 a = (f32x4){0.f, 0.f, 0.f, 0.f};
#pragma unroll
        for (int ks = 0; ks < 4; ++ks) a = __builtin_amdgcn_mfma_f32_16x16x32_bf16(af[ks], bfr[nt][ks], a, 0, 0, 0);
        acc[nt] = a;
      }
    }
#pragma unroll
    for (int i = 0; i < 9; ++i) { const int q4 = lane + 64 * i; if (q4 < 16 * PE_SVS / 4) ((uint4*)SV)[q4] = make_uint4(0u, 0u, 0u, 0u); }
    WAVE_LDS_FENCE();
#pragma unroll
    for (int r = 0; r < 4; ++r) {
      const int tk = 4 * lq + r;
      unsigned k[8];
#pragma unroll
      for (int nt = 0; nt < 8; ++nt) k[nt] = sortable_key(acc[nt][r], nt * 16 + lr);
      unsigned m1 = max(k[0], k[1]), m2 = min(k[0], k[1]);
#pragma unroll
      for (int nt = 2; nt < 8; ++nt) { m2 = max(m2, min(m1, k[nt])); m1 = max(m1, k[nt]); }
      const unsigned Ta = row16_min_u32(m1);
      const unsigned Tb = min(row16_kth_largest<11>(m1), row16_kth_largest<5>(m2));
      const unsigned T = max(Ta, Tb);
      int pos = 0;
#pragma unroll
      for (int nt = 0; nt < 8; ++nt) {
        const bool sel = k[nt] >= T;
        const unsigned long long bal = __ballot(sel);
        const unsigned grp16 = (unsigned)(bal >> (16 * lq)) & 0xffffu;
        const int below = __popc(grp16 & ((1u << lr) - 1u));
        if (sel) SV[tk * PE_SVS + pos + below] = k[nt];
        pos += __popc(grp16);
      }
      if (lr == 0) CN[tk] = pos;
    }
    WAVE_LDS_FENCE();
#pragma unroll 1
    for (int pass = 0; pass < 4; ++pass) {
      const int tk = pass * 4 + lq;
      const int cnt = CN[tk];
      const unsigned* row = SV + tk * PE_SVS;
      int cm = cnt;
      cm = max(cm, __shfl_xor(cm, 16)); cm = max(cm, __shfl_xor(cm, 32));
      const int cmax = __builtin_amdgcn_readfirstlane(cm);
      const int nblk = (cmax + 15) >> 4;
#pragma unroll 1
      for (int rd = 0; rd < nblk; ++rd) {
        const int j = rd * 16 + lr;
        const unsigned my = row[j];
        int rank = 0;
#pragma unroll 1
        for (int b4 = 0; b4 < nblk; ++b4) {
          const uint4 v0 = *(const uint4*)(row + b4 * 16), v1 = *(const uint4*)(row + b4 * 16 + 4);
          const uint4 v2 = *(const uint4*)(row + b4 * 16 + 8), v3 = *(const uint4*)(row + b4 * 16 + 12);
          rank += (v0.x > my) ? 1 : 0; rank += (v0.y > my) ? 1 : 0; rank += (v0.z > my) ? 1 : 0; rank += (v0.w > my) ? 1 : 0;
          rank += (v1.x > my) ? 1 : 0; rank += (v1.y > my) ? 1 : 0; rank += (v1.z > my) ? 1 : 0; rank += (v1.w > my) ? 1 : 0;
          rank += (v2.x > my) ? 1 : 0; rank += (v2.y > my) ? 1 : 0; rank += (v2.z > my) ? 1 : 0; rank += (v2.w > my) ? 1 : 0;
          rank += (v3.x > my) ? 1 : 0; rank += (v3.y > my) ? 1 : 0; rank += (v3.z > my) ? 1 : 0; rank += (v3.w > my) ? 1 : 0;
        }
        if (j < cnt && rank < 16) {
          TV[(tk * 16 + hd * 2 + pp) * 16 + rank] = key_value(my);
          TI[(tk * 16 + hd * 2 + pp) * 16 + rank] = 127 - (int)(my & 127u);
        }
      }
    }
    WAVE_LDS_FENCE();
  }
  {
    const int cab = ((const int*)(smem + PE_OFF_CT))[lane];
    const int cand_a = cab >> 4, cand_b = cab & 15;
    unsigned* CWt = SV;
    float vals[16];
#pragma unroll
    for (int tk = 0; tk < 16; ++tk) {
      float val = 0.f;
      unsigned key = 0u;
      if (cand_a >= 0) {
        val = TV[(tk * 16 + hd * 2 + 0) * 16 + cand_a] + TV[(tk * 16 + hd * 2 + 1) * 16 + cand_b];
        const unsigned bb = __float_as_uint(val);
        key = ((bb ^ ((unsigned)((int)bb >> 31) | 0x80000000u)) & ~63u) | (unsigned)(63 - lane);
      }
      vals[tk] = val;
      CWt[tk * 64 + lane] = key;
    }
    WAVE_LDS_FENCE();
#pragma unroll
    for (int tk = 0; tk < 16; ++tk) {
      const unsigned key = CWt[tk * 64 + lane];
      int rank = 0;
#pragma unroll
      for (int i4 = 0; i4 < 13; ++i4) {
        const uint4 v = *(const uint4*)(CWt + tk * 64 + i4 * 4);
        rank += (v.x > key) ? 1 : 0; rank += (v.y > key) ? 1 : 0; rank += (v.z > key) ? 1 : 0; rank += (v.w > key) ? 1 : 0;
      }
      if (cand_a >= 0 && rank < 16) {
        GT[tk * 128 + hd * 16 + rank] = vals[tk];
        EX[tk * 128 + hd * 16 + rank] = TI[(tk * 16 + hd * 2 + 0) * 16 + cand_a] * 128 + TI[(tk * 16 + hd * 2 + 1) * 16 + cand_b];
      }
    }
    WAVE_LDS_FENCE();
#pragma unroll
    for (int pass = 0; pass < 4; ++pass) {
      const int tk = pass * 4 + lq;
      const float g = GT[tk * 128 + hd * 16 + lr];
      const float mx = GT[tk * 128 + hd * 16];
      const float ev = __expf(g - mx);
      float s = ev;
      s += __shfl_xor(s, 1); s += __shfl_xor(s, 2); s += __shfl_xor(s, 4); s += __shfl_xor(s, 8);
      const int ex = EX[tk * 128 + hd * 16 + lr];
      GT[tk * 128 + hd * 16 + lr] = (ev / s) * VSC[ex];
      SU[tk * 128 + hd * 16 + lr] = USC[ex];
    }
    WAVE_LDS_FENCE();
  }
}

typedef float f32x32 __attribute__((ext_vector_type(32)));
typedef unsigned u32x6 __attribute__((ext_vector_type(6)));
struct Fp6Row { uint4 a; uint2 b; };
__device__ __forceinline__ f32x32 fp6_decode(const Fp6Row& r) {
  u32x6 w; w[0] = r.a.x; w[1] = r.a.y; w[2] = r.a.z; w[3] = r.a.w; w[4] = r.b.x; w[5] = r.b.y;
  return __builtin_amdgcn_cvt_scalef32_pk32_f32_fp6(w, 1.0f);
}
__device__ __forceinline__ void peer_gather_token(const Params& p, int layer, char* smem, int tok, int tl, int buf, int lane, bool dowrite) {
  const bf16_t* H2 = (const bf16_t*)(p.ws + OFF_ACT);
  const char* U6 = p.ws + OFF_U + (size_t)layer * NEXP * RECB;
  const char* V6 = U6 + ROWB;
  const float* mod = (const float*)(p.ws + OFF_MOD) + (size_t)layer * 9 * 6144;
  const int* EX = (const int*)(smem + PE_OFF_EX) + buf * 16 * 128 + tl * 128;
  const float* GT = (const float*)(smem + PE_OFF_GT) + buf * 16 * 128 + tl * 128;
  const float* SU = (const float*)(smem + PE_OFF_SU) + buf * 16 * 128 + tl * 128;
  const int l = lane & 31, hf = lane >> 5;
  float hv[32], acc[32];
  {
    const bf16_t* hr = H2 + (size_t)tok * 1024;
#pragma unroll
    for (int j = 0; j < 8; ++j) {
      const uint2 u = *(const uint2*)(hr + (l + 32 * j) * 4);
      hv[4 * j + 0] = lo16(u.x); hv[4 * j + 1] = hi16(u.x); hv[4 * j + 2] = lo16(u.y); hv[4 * j + 3] = hi16(u.y);
    }
  }
#pragma unroll
  for (int i = 0; i < 32; ++i) acc[i] = 0.f;
  Fp6Row ua[2], va[2], ub[2], vb[2];
  int one = 1;
  asm volatile("" : "+s"(one));
#define PE_LOAD_SET(UU, VV, E0)                                                       \
  _Pragma("unroll") for (int j = 0; j < 2; ++j) {                                     \
    const int ex = EX[(E0) + 2 * j + hf];                                             \
    const char* up = U6 + (size_t)ex * RECB + l * 24;                                 \
    UU[j].a = *(const uint4*)up; UU[j].b = *(const uint2*)(up + 16);                  \
    VV[j].a = *(const uint4*)(up + ROWB); VV[j].b = *(const uint2*)(up + ROWB + 16);  \
  }
#define PE_USE_SET(UU, VV, E0)                                                        \
  _Pragma("unroll 1") for (int rep_ = 0; rep_ < one; ++rep_) {                        \
  _Pragma("unroll") for (int j = 0; j < 2; ++j) {                                     \
    const f32x32 du = fp6_decode(UU[j]);                                              \
    float d0 = 0.f, d1 = 0.f, d2 = 0.f, d3 = 0.f;                                     \
    _Pragma("unroll") for (int k = 0; k < 32; k += 4) {                               \
      d0 = fmaf(hv[k], du[k], d0); d1 = fmaf(hv[k + 1], du[k + 1], d1); d2 = fmaf(hv[k + 2], du[k + 2], d2); d3 = fmaf(hv[k + 3], du[k + 3], d3); \
    }                                                                                 \
    const float r16 = row16_sum((d0 + d1) + (d2 + d3));                               \
    const int ir = __float_as_int(r16);                                               \
    const float s0 = __int_as_float(__builtin_amdgcn_readlane(ir, 0)) + __int_as_float(__builtin_amdgcn_readlane(ir, 16));  \
    const float s1 = __int_as_float(__builtin_amdgcn_readlane(ir, 32)) + __int_as_float(__builtin_amdgcn_readlane(ir, 48)); \
    const float d = (hf ? s1 : s0) * SU[(E0) + 2 * j + hf];                           \
    const float w = GT[(E0) + 2 * j + hf] * gelu_erf(d);                              \
    const f32x32 dv = fp6_decode(VV[j]);                                              \
    _Pragma("unroll") for (int k = 0; k < 32; ++k) acc[k] = fmaf(w, dv[k], acc[k]);   \
  } }
  PE_LOAD_SET(ua, va, 0)
#pragma unroll 1
  for (int e0 = 0; e0 < 120; e0 += 8) {
    PE_LOAD_SET(ub, vb, e0 + 4)
    PE_USE_SET(ua, va, e0)
    PE_LOAD_SET(ua, va, e0 + 8)
    PE_USE_SET(ub, vb, e0 + 4)
  }
  PE_LOAD_SET(ub, vb, 124)
  PE_USE_SET(ua, va, 120)
  PE_USE_SET(ub, vb, 124)
#pragma unroll
  for (int k = 0; k < 32; ++k) acc[k] += __shfl_xor(acc[k], 32);
  const int b = tok < NLAT ? (tok >> 12) : 8;
  float* xr = tok < NLAT ? p.out + (size_t)tok * 1024 : (float*)(p.ws + OFF_CTXB) + (size_t)(tok - NLAT) * 1024;
  const float* gate = mod + (size_t)b * 6144 + 5 * 1024;
  float4 xn[4];
  float ss = 0.f;
#pragma unroll
  for (int jj = 0; jj < 4; ++jj) {
    const int c = (l + 32 * (4 * hf + jj)) * 4;
    const float4 xv = *(const float4*)(xr + c);
    const float4 gv = *(const float4*)(gate + c);
    const float a0 = hf ? acc[16 + 4 * jj + 0] : acc[4 * jj + 0], a1 = hf ? acc[16 + 4 * jj + 1] : acc[4 * jj + 1];
    const float a2 = hf ? acc[16 + 4 * jj + 2] : acc[4 * jj + 2], a3 = hf ? acc[16 + 4 * jj + 3] : acc[4 * jj + 3];
    xn[jj].x = xv.x + gv.x * a0; xn[jj].y = xv.y + gv.y * a1; xn[jj].z = xv.z + gv.z * a2; xn[jj].w = xv.w + gv.w * a3;
    ss += xn[jj].x * xn[jj].x + xn[jj].y * xn[jj].y + xn[jj].z * xn[jj].z + xn[jj].w * xn[jj].w;
  }
  ss = wave_sum(ss);
  const float rinv = rsqrtf(ss * (1.f / 1024.f) + EPS);
  if (layer == 0) {
    const float* mod1 = (const float*)(p.ws + OFF_MOD) + (size_t)9 * 6144 + (size_t)b * 6144;
    const float* g1 = p.norm1_g + 1024;
    bf16_t* act = (bf16_t*)(p.ws + OFF_ACT) + (size_t)tok * 1024;
#pragma unroll
    for (int jj = 0; jj < 4; ++jj) {
      const int c = (l + 32 * (4 * hf + jj)) * 4;
      if (dowrite) *(float4*)(xr + c) = xn[jj]; else asm volatile("" :: "v"(xn[jj].x), "v"(xn[jj].y), "v"(xn[jj].z), "v"(xn[jj].w));
      const float4 gg4 = *(const float4*)(g1 + c);
      const float4 sh = *(const float4*)(mod1 + c);
      const float4 sc = *(const float4*)(mod1 + 1024 + c);
      uint2 o;
      o.x = pack2h(xn[jj].x * rinv * gg4.x * (1.f + sc.x) + sh.x, xn[jj].y * rinv * gg4.y * (1.f + sc.y) + sh.y);
      o.y = pack2h(xn[jj].z * rinv * gg4.z * (1.f + sc.z) + sh.z, xn[jj].w * rinv * gg4.w * (1.f + sc.w) + sh.w);
      if (dowrite) *(uint2*)(act + c) = o; else asm volatile("" :: "v"(o.x), "v"(o.y));
    }
  } else {
#pragma unroll
    for (int jj = 0; jj < 4; ++jj) {
      const int c = (l + 32 * (4 * hf + jj)) * 4;
      const float4 gg4 = *(const float4*)(p.final_g + c);
      float4 o;
      o.x = xn[jj].x * rinv * gg4.x; o.y = xn[jj].y * rinv * gg4.y; o.z = xn[jj].z * rinv * gg4.z; o.w = xn[jj].w * rinv * gg4.w;
      if (dowrite) *(float4*)(xr + c) = o; else asm volatile("" :: "v"(o.x), "v"(o.y), "v"(o.z), "v"(o.w));
    }
  }
}

__device__ __forceinline__ void phase_peer(const Params& p, int layer, char* smem, int ntok, bool dowrite = true) {
  const int tid = opaque_tid(), lane = tid & 63, wave = __builtin_amdgcn_readfirstlane(tid >> 6);
  __syncthreads();
  if (tid < 64) {
    int cab = -1, c = 0;
    for (int a = 0; a < 16; ++a)
      for (int bb = 0; bb < 16; ++bb)
        if ((a + 1) * (bb + 1) <= 16) { if (c == tid) cab = a * 16 + bb; ++c; }
    ((int*)(smem + PE_OFF_CT))[tid] = cab;
  }
  const int ngroups = ntok / 16, G = gridDim.x, g0 = opaque_bid();
  __syncthreads();
  for (int grp = g0; grp < ngroups; grp += G) {
    peer_select_head(p, layer, smem, grp * 16, wave, wave, 0, lane);
    __syncthreads();
#pragma unroll 1
    for (int tt = 0; tt < 2; ++tt) peer_gather_token(p, layer, smem, grp * 16 + wave * 2 + tt, wave * 2 + tt, 0, lane, dowrite);
    __syncthreads();
  }
}

template <int layer>
__device__ __forceinline__ void layer_body(const Params& p, char* smem, const XcdBarrier& xb) {
  constexpr bool nc = layer == 0;
  const float* xin = layer == 0 ? p.x : (const float*)p.out;
  if (layer == 0) {
    phase_norm(p, layer, 0, xin, NTOK);
    xcd_barrier(xb);
  }
#if REP_GEMM
  gemm_phase2<EPI_INPROJ>(p, layer, smem, (const bf16_t*)(p.ws + OFF_ACT), (const bf16_t*)(p.ws + OFF_WIN) + (size_t)layer * 3072 * 1024, NTOK, 3072, nullptr);
  xcd_barrier(xb);
#endif
  gemm_phase2<EPI_INPROJ>(p, layer, smem, (const bf16_t*)(p.ws + OFF_ACT), (const bf16_t*)(p.ws + OFF_WIN) + (size_t)layer * 3072 * 1024, NTOK, 3072, nullptr);
  xcd_barrier(xb);
#if REP_MIX1
  phase_mix1(p, layer, smem, 2);
  xcd_barrier(xb);
#endif
  phase_mix1(p, layer, smem);
  xcd_barrier(xb);
  phase_ret_scan(p, layer);
  xcd_barrier(xb);
#if REP_MIX2
  phase_mix2(p, layer, smem, 3);
  xcd_barrier(xb);
#endif
  phase_mix2(p, layer, smem);
  xcd_barrier(xb);
  gemm_phase2<EPI_OUTPROJ>(p, layer, smem, (const bf16_t*)(p.ws + OFF_ACT), (const bf16_t*)(p.ws + OFF_WOUT) + (size_t)layer * 1024 * 1024, nc ? NTOK : NLAT, 1024, xin);
  xcd_barrier(xb);
  phase_norm(p, layer, 1, (const float*)p.out, nc ? NTOK : NLAT);
  xcd_barrier(xb);
  gemm_phase2<EPI_PLAIN>(p, layer, smem, (const bf16_t*)(p.ws + OFF_ACT), (const bf16_t*)(p.ws + OFF_WQ) + (size_t)layer * 2048 * 1024, nc ? NTOK : NLAT, 2048, nullptr);
  xcd_barrier(xb);
#if REP_PEER
  phase_peer(p, layer, smem, nc ? NTOK : NLAT, false);
  xcd_barrier(xb);
#endif
  phase_peer(p, layer, smem, nc ? NTOK : NLAT);
  if (layer == 0) xcd_barrier(xb);
}

__global__ void __launch_bounds__(512) fwd_megakernel(Params p) {
  cg::grid_group grid = cg::this_grid();
  extern __shared__ __attribute__((aligned(16))) char smem[];
  volatile LAS3 unsigned* xst = (volatile LAS3 unsigned*)(smem + LDS_BCAST + 8);
  if (threadIdx.x == 0) { xst[0] = 0u; xst[1] = 0u; }
  phase_prep(p, smem);
  grid.sync();
  const XcdBarrier xb = xcd_barrier_post((unsigned*)(p.ws + OFF_XBAR), xst);
  layer_body<0>(p, smem, xb);
  layer_body<1>(p, smem, xb);
}

extern "C" void kernel_launch(void* const* d_in, const int* in_sizes, int n_in, void* d_out,
                              int out_size, void* d_ws, size_t ws_size, hipStream_t stream) {
  constexpr size_t kDynLds = LDS_BYTES;
  static int grid_blocks = 0;
  if (!grid_blocks) {
    int dev = 0, cus = 0, per_cu = 0;
    (void)hipGetDevice(&dev);
    (void)hipDeviceGetAttribute(&cus, hipDeviceAttributeMultiprocessorCount, dev);
    (void)hipFuncSetAttribute((const void*)fwd_megakernel, hipFuncAttributeMaxDynamicSharedMemorySize, (int)kDynLds);
    (void)hipOccupancyMaxActiveBlocksPerMultiprocessor(&per_cu, fwd_megakernel, 512, kDynLds);
    if (per_cu < 1) { fprintf(stderr, "occupancy query says %d blocks/CU\n", per_cu); per_cu = 1; }
    grid_blocks = cus;
    if (ws_size < WS_END) fprintf(stderr, "workspace too small: %zu < %zu\n", ws_size, (size_t)WS_END);
  }
  Params p{};
  p.x = (const float*)d_in[0]; p.c = (const float*)d_in[1]; p.ctx = (const float*)d_in[2]; p.c_ctx = (const float*)d_in[3];
  p.w_ada = (const float*)d_in[4]; p.b_ada = (const float*)d_in[5]; p.norm1_g = (const float*)d_in[6]; p.w_in = (const float*)d_in[7];
  p.na_rpb = (const float*)d_in[8]; p.diff_lambda = (const float*)d_in[9]; p.diff_subln_g = (const float*)d_in[10];
  p.ret_decay_logit = (const float*)d_in[11]; p.w_out = (const float*)d_in[12]; p.norm2_g = (const float*)d_in[13];
  p.peer_wq = (const float*)d_in[14]; p.peer_subkeys = (const float*)d_in[15]; p.peer_u = (const float*)d_in[16];
  p.peer_v = (const float*)d_in[17]; p.final_g = (const float*)d_in[18];
  p.out = (float*)d_out; p.ws = (char*)d_ws;
  void* args[] = {&p};
  hipError_t e = hipLaunchCooperativeKernel((void*)fwd_megakernel, dim3(grid_blocks), dim3(512), args, kDynLds, stream);
  if (e != hipSuccess) fprintf(stderr, "cooperative launch failed: %s (grid %d)\n", hipGetErrorString(e), grid_blocks);
}
```

```cpp
#include <hip/hip_runtime.h>
#include <hip/hip_cooperative_groups.h>
#include <cstdio>
#include <cstdint>
namespace cg = cooperative_groups;

typedef unsigned short bf16_t;
typedef short bf16x8 __attribute__((ext_vector_type(8)));
typedef float f32x4 __attribute__((ext_vector_type(4)));

constexpr int DM = 1024, BATCH = 8, SEQ = 4096, LCTX = 256;
constexpr int NLAT = BATCH * SEQ;
constexpr int NCTX = BATCH * LCTX;
constexpr int NTOK = NLAT + NCTX;
constexpr int INC = 3072;
constexpr int C_NAQ = 0, C_NAK = 256, C_NAV = 512, C_DFQ = 768, C_DFK = 1024, C_DFV = 1280,
              C_RTQ = 1536, C_RTK = 1792, C_RTV = 2048, C_RTG = 2560;
constexpr int Y_NA = 0, Y_DF = 256, Y_RT = 512;
constexpr int NEXP = 16384;
constexpr float EPS = 1e-6f;

constexpr size_t OFF_CTL  = 0;
constexpr size_t OFF_MISC = 4096;
constexpr size_t OFF_ROPE = 8192;
constexpr size_t OFF_MOD  = OFF_ROPE + 12288;
constexpr size_t SZ_MOD   = 2ull * 9 * 6144 * 4;
constexpr size_t OFF_WIN  = OFF_MOD + SZ_MOD;
constexpr size_t SZ_WIN   = 2ull * 3072 * 1024 * 2;
constexpr size_t OFF_WOUT = OFF_WIN + SZ_WIN;
constexpr size_t SZ_WOUT  = 2ull * 1024 * 1024 * 2;
constexpr size_t OFF_WQ   = OFF_WOUT + SZ_WOUT;
constexpr size_t SZ_WQ    = 2ull * 2048 * 1024 * 2;
constexpr size_t OFF_SUBK = OFF_WQ + SZ_WQ;
constexpr size_t SZ_SUBK  = 2ull * 262144 * 2;
constexpr size_t OFF_U    = OFF_SUBK + SZ_SUBK;
constexpr int    ROWB     = 768;
constexpr int    ROWV     = 512;
constexpr int    RECB     = ROWB + ROWV;
constexpr size_t SZ_UV    = 2ull * NEXP * ROWB;
constexpr size_t OFF_V    = OFF_U + SZ_UV;
constexpr size_t OFF_USC  = OFF_V + SZ_UV;
constexpr size_t OFF_VSC  = OFF_USC + 2ull * NEXP * 4;
constexpr size_t OFF_ACT  = OFF_VSC + 2ull * NEXP * 4;
constexpr size_t SZ_ACT   = (size_t)NTOK * 1024 * 2;
constexpr size_t OFF_P    = OFF_ACT + SZ_ACT;
constexpr size_t SZ_P     = (size_t)NTOK * 3072 * 2;
constexpr size_t OFF_CTXB = OFF_P + SZ_P;
constexpr size_t SZ_CTXB  = (size_t)NCTX * 1024 * 4;
constexpr size_t OFF_RKV  = OFF_CTXB + SZ_CTXB;
constexpr size_t SZ_RKV   = 64ull * 32 * 8192 * 4;
constexpr size_t OFF_RS   = OFF_RKV + SZ_RKV;
constexpr size_t SZ_RS    = 64ull * 8192 * 4;
constexpr size_t OFF_XBAR = OFF_RS + SZ_RS;
constexpr size_t WS_END   = OFF_XBAR + 16384;

#ifndef REP_MIX1
#define REP_MIX1 0
#endif
#ifndef REP_MIX2
#define REP_MIX2 0
#endif
#ifndef REP_PEER
#define REP_PEER 0
#endif
#ifndef REP_GEMM
#define REP_GEMM 0
#endif
constexpr int LDS_BYTES = 144 * 1024;
constexpr int LDS_BCAST = LDS_BYTES - 16;

struct Params {
  const float *x, *c, *ctx, *c_ctx, *w_ada, *b_ada, *norm1_g, *w_in, *na_rpb, *diff_lambda, *diff_subln_g,
              *ret_decay_logit, *w_out, *norm2_g, *peer_wq, *peer_subkeys, *peer_u, *peer_v, *final_g;
  float* out;
  char* ws;
};

__device__ __forceinline__ float bf2f(bf16_t v) { return __uint_as_float(((unsigned)v) << 16); }
__device__ __forceinline__ bf16_t f2bf(float f) {
  unsigned u = __float_as_uint(f);
  u += 0x7fffu + ((u >> 16) & 1u);
  return (bf16_t)(u >> 16);
}
__device__ __forceinline__ unsigned pack2(float a, float b) { return (unsigned)f2bf(a) | ((unsigned)f2bf(b) << 16); }
typedef __bf16 bf16x2_t __attribute__((ext_vector_type(2)));
typedef float f32x2_t __attribute__((ext_vector_type(2)));
__device__ __forceinline__ unsigned pack2h(float a, float b) {
  const f32x2_t v = {a, b};
  return __builtin_bit_cast(unsigned, __builtin_convertvector(v, bf16x2_t));
}
__device__ __forceinline__ float lo16(unsigned w) { return __uint_as_float(w << 16); }
__device__ __forceinline__ float hi16(unsigned w) { return __uint_as_float(w & 0xffff0000u); }
#define DPP_ADD(v, CTRL) ((v) + __int_as_float(__builtin_amdgcn_update_dpp(0, __float_as_int(v), (CTRL), 0xf, 0xf, true)))
__device__ __forceinline__ float row16_sum(float v) {
  v = DPP_ADD(v, 0xB1);
  v = DPP_ADD(v, 0x4E);
  v = DPP_ADD(v, 0x141);
  v = DPP_ADD(v, 0x140);
  return v;
}
#define DPP_MOVU(v, CTRL) ((unsigned)__builtin_amdgcn_update_dpp(0, (int)(v), (CTRL), 0xf, 0xf, true))
__device__ __forceinline__ unsigned row16_max_u32(unsigned v) {
  v = max(v, DPP_MOVU(v, 0xB1)); v = max(v, DPP_MOVU(v, 0x4E)); v = max(v, DPP_MOVU(v, 0x141)); v = max(v, DPP_MOVU(v, 0x140));
  return v;
}
__device__ __forceinline__ unsigned row16_min_u32(unsigned v) {
  v = min(v, DPP_MOVU(v, 0xB1)); v = min(v, DPP_MOVU(v, 0x4E)); v = min(v, DPP_MOVU(v, 0x141)); v = min(v, DPP_MOVU(v, 0x140));
  return v;
}
template <int KTH>
__device__ __forceinline__ unsigned row16_kth_largest(unsigned v) {
  int cnt = 0;
#define R8_STEP(N) { const unsigned o = DPP_MOVU(v, 0x120 + (N)); cnt += (o > v) ? 1 : 0; }
  R8_STEP(1) R8_STEP(2) R8_STEP(3) R8_STEP(4) R8_STEP(5) R8_STEP(6) R8_STEP(7) R8_STEP(8)
  R8_STEP(9) R8_STEP(10) R8_STEP(11) R8_STEP(12) R8_STEP(13) R8_STEP(14) R8_STEP(15)
#undef R8_STEP
  return row16_max_u32(cnt >= KTH - 1 ? v : 0u);
}
__device__ __forceinline__ float wave_sum(float v) {
  v = row16_sum(v);
  const int iv = __float_as_int(v);
  const float a = __int_as_float(__builtin_amdgcn_readlane(iv, 0)), b = __int_as_float(__builtin_amdgcn_readlane(iv, 16));
  const float c = __int_as_float(__builtin_amdgcn_readlane(iv, 32)), d = __int_as_float(__builtin_amdgcn_readlane(iv, 48));
  return (a + b) + (c + d);
}
__device__ __forceinline__ float siluf(float x) { return x / (1.f + __expf(-x)); }

__device__ __forceinline__ int opaque_tid() { int t = threadIdx.x; asm volatile("" : "+v"(t)); return t; }
__device__ __forceinline__ int opaque_bid() { int t = blockIdx.x; asm volatile("" : "+s"(t)); return t; }

#define DOT8(acc, Q, off, U)                                                              \
  acc = fmaf(Q[(off) + 0], lo16((U).x), acc); acc = fmaf(Q[(off) + 1], hi16((U).x), acc); \
  acc = fmaf(Q[(off) + 2], lo16((U).y), acc); acc = fmaf(Q[(off) + 3], hi16((U).y), acc); \
  acc = fmaf(Q[(off) + 4], lo16((U).z), acc); acc = fmaf(Q[(off) + 5], hi16((U).z), acc); \
  acc = fmaf(Q[(off) + 6], lo16((U).w), acc); acc = fmaf(Q[(off) + 7], hi16((U).w), acc);
#define AXPY8(O, off, P, U)                                                                   \
  O[(off) + 0] = fmaf(P, lo16((U).x), O[(off) + 0]); O[(off) + 1] = fmaf(P, hi16((U).x), O[(off) + 1]); \
  O[(off) + 2] = fmaf(P, lo16((U).y), O[(off) + 2]); O[(off) + 3] = fmaf(P, hi16((U).y), O[(off) + 3]); \
  O[(off) + 4] = fmaf(P, lo16((U).z), O[(off) + 4]); O[(off) + 5] = fmaf(P, hi16((U).z), O[(off) + 5]); \
  O[(off) + 6] = fmaf(P, lo16((U).w), O[(off) + 6]); O[(off) + 7] = fmaf(P, hi16((U).w), O[(off) + 7]);
#define UNPACK8(Q, off, U)                                                  \
  Q[(off) + 0] = lo16((U).x); Q[(off) + 1] = hi16((U).x); Q[(off) + 2] = lo16((U).y); Q[(off) + 3] = hi16((U).y); \
  Q[(off) + 4] = lo16((U).z); Q[(off) + 5] = hi16((U).z); Q[(off) + 6] = lo16((U).w); Q[(off) + 7] = hi16((U).w);

__device__ __forceinline__ int next_item(unsigned* counter, char* smem) {
  volatile int* bc = (volatile int*)(smem + LDS_BCAST);
  __syncthreads();
  if (threadIdx.x == 0) *bc = (int)atomicAdd(counter, 1u);
  __syncthreads();
  return *bc;
}

#define XB_TMO      128
#define XB_XCNT(j)  (256  + 64 * (j))
#define XB_XSUB(j)  (1280 + 64 * (j))
#define XB_XGEN(j)  (2304 + 64 * (j))
#define XB_TOP      3328
#define XB_TOPGEN   3392
#define XCD_BAR_WORDS 3456
#define XB_SPIN_CAP (1u << 18)
#define LAS3 __attribute__((address_space(3)))
__device__ __forceinline__ unsigned xb_ld(unsigned* p)              { return __hip_atomic_load(p, __ATOMIC_RELAXED, __HIP_MEMORY_SCOPE_AGENT); }
__device__ __forceinline__ unsigned xb_add(unsigned* p, unsigned v) { return __hip_atomic_fetch_add(p, v, __ATOMIC_RELAXED, __HIP_MEMORY_SCOPE_AGENT); }
__device__ __forceinline__ unsigned xb_xcc_id() { return (unsigned)__builtin_amdgcn_s_getreg((3 << 11) | 20) & 0xFu; }
#define XB_SPIN(cond, bar) do { unsigned _sp = 0; while (cond) { __builtin_amdgcn_s_sleep(1); \
    if ((++_sp & 255u) == 0u) { if (xb_ld(&(bar)[XB_TMO])) break; if (_sp > XB_SPIN_CAP) { atomicAdd(&(bar)[XB_TMO], 1u); break; } } } } while (0)
struct XcdBarrier { unsigned* bar; unsigned x; volatile LAS3 unsigned* st; };
__device__ __forceinline__ XcdBarrier xcd_barrier_post(unsigned* bar, volatile LAS3 unsigned* st) {
  XcdBarrier b; b.bar = bar; b.x = xb_xcc_id(); b.st = st;
  if (threadIdx.x == 0) (void)xb_add(&bar[XB_XCNT(b.x)], 1u);
  return b;
}
__device__ __forceinline__ void xcd_barrier_complete(unsigned* bar, unsigned x, unsigned& nloc, unsigned& nx) {
  const unsigned G = gridDim.x * gridDim.y * gridDim.z;
  unsigned sum, cnt, mine, sp = 0u;
  for (;;) {
    sum = 0u; cnt = 0u; mine = 0u;
#pragma unroll
    for (unsigned j = 0; j < 16; ++j) { const unsigned c = xb_ld(&bar[XB_XCNT(j)]); sum += c; cnt += (c > 0u) ? 1u : 0u; mine = (j == x) ? c : mine; }
    if (sum == G) break;
    __builtin_amdgcn_s_sleep(1);
    if ((++sp & 255u) == 0u) { if (xb_ld(&bar[XB_TMO])) break; if (sp > XB_SPIN_CAP) { atomicAdd(&bar[XB_TMO], 1u); break; } }
  }
  nloc = mine > 0u ? mine : 1u; nx = cnt > 0u ? cnt : 1u;
}
__device__ __forceinline__ void xcd_barrier(const XcdBarrier& b) {
  asm volatile("s_waitcnt vmcnt(0)" ::: "memory");
  __syncthreads();
  if (threadIdx.x == 0) {
    unsigned* bar = b.bar;
    __builtin_amdgcn_s_waitcnt(0);
    unsigned nloc = b.st[0], nx = b.st[1];
    if (nloc == 0u) { xcd_barrier_complete(bar, b.x, nloc, nx); b.st[0] = nloc; b.st[1] = nx; }
    const unsigned old = xb_add(&bar[XB_XSUB(b.x)], 1u);
    const unsigned gen = old / nloc;
    if (old + 1u == (gen + 1u) * nloc) {
      __builtin_amdgcn_fence(__ATOMIC_RELEASE, "agent");
      asm volatile("s_waitcnt vmcnt(0)" ::: "memory");
      const unsigned og = xb_add(&bar[XB_TOP], 1u);
      const unsigned tg = og / nx;
      if (og + 1u == (tg + 1u) * nx) xb_add(&bar[XB_TOPGEN], 1u);
      else XB_SPIN(xb_ld(&bar[XB_TOPGEN]) == tg, bar);
      __builtin_amdgcn_fence(__ATOMIC_ACQUIRE, "agent");
      xb_add(&bar[XB_XGEN(b.x)], 1u);
      asm volatile("s_waitcnt vmcnt(0)" ::: "memory");
    } else {
      XB_SPIN(xb_ld(&bar[XB_XGEN(b.x)]) == gen, bar);
      __builtin_amdgcn_fence(__ATOMIC_ACQUIRE, "agent");
      asm volatile("s_waitcnt vmcnt(0)" ::: "memory");
    }
  }
  __syncthreads();
}

__device__ __forceinline__ void transpose_item(const float* src, bf16_t* dst, int K, int N, int item, char* smem) {
  float* t = (float*)smem;
  const int nb = N / 64;
  const int k0 = (item / nb) * 64, n0 = (item % nb) * 64;
  const int tid = opaque_tid();
  __syncthreads();
#pragma unroll
  for (int i = 0; i < 8; ++i) {
    const int k = (tid >> 6) + 8 * i, n = tid & 63;
    t[k * 65 + n] = src[(size_t)(k0 + k) * N + n0 + n];
  }
  __syncthreads();
#pragma unroll
  for (int i = 0; i < 8; ++i) {
    const int n = (tid >> 6) + 8 * i, k = tid & 63;
    dst[(size_t)(n0 + n) * K + k0 + k] = f2bf(t[k * 65 + n]);
  }
}

__device__ __forceinline__ void convert_flat(const float* src, bf16_t* dst, size_t n4) {
  const size_t gt = (size_t)opaque_bid() * blockDim.x + opaque_tid(), gs = (size_t)gridDim.x * blockDim.x;
  for (size_t i = gt; i < n4; i += gs) {
    const float4 v = ((const float4*)src)[i];
    uint2 o; o.x = pack2h(v.x, v.y); o.y = pack2h(v.z, v.w);
    ((uint2*)dst)[i] = o;
  }
}

__device__ __forceinline__ void phase_prep(const Params& p, char* smem) {
  const int tid = opaque_tid();
  char* ws = p.ws;
  if (opaque_bid() == 0) {
    unsigned* ctl = (unsigned*)(ws + OFF_CTL);
    if (tid < 64) ctl[tid] = 0u;
    unsigned* xbar = (unsigned*)(ws + OFF_XBAR);
    for (int i = tid; i < XCD_BAR_WORDS; i += 512) xbar[i] = 0u;
    float* misc = (float*)(ws + OFF_MISC);
    if (tid < 2) {
      const float* lp = p.diff_lambda + tid * 128;
      float s01 = 0.f, s23 = 0.f;
      for (int i = 0; i < 32; ++i) { s01 += lp[i] * lp[32 + i]; s23 += lp[64 + i] * lp[96 + i]; }
      const float lam_init = 0.8f - 0.6f * expf(-0.3f * (float)tid);
      misc[tid] = expf(s01) - expf(s23) + lam_init;
      misc[2 + tid] = lam_init;
    }
    if (tid >= 128 && tid < 256) misc[64 + tid - 128] = 0.f;
    if (tid >= 64 && tid < 80) {
      const int i = tid - 64;
      const float xv = p.ret_decay_logit[i];
      misc[16 + i] = -log1pf(expf(-xv));
    }
    float2* ropeD = (float2*)(ws + OFF_ROPE);
    float2* ropeR = (float2*)(ws + OFF_ROPE + 4096);
    for (int i = tid; i < 64 * 8; i += 512) {
      const int v = i >> 3, f = i & 7;
      const float inv = powf(10000.0f, -(float)(2 * f) / 16.0f);
      const float ang = (float)v * inv;
      ropeD[i] = make_float2(cosf(ang), sinf(ang));
    }
    for (int i = tid; i < 64 * 16; i += 512) {
      const int v = i >> 4, f = i & 15;
      const float inv = powf(10000.0f, -(float)(2 * f) / 32.0f);
      const float ang = (float)v * inv;
      ropeR[i] = make_float2(cosf(ang), sinf(ang));
    }
  }
  {
    float* sc = (float*)smem;
    float* red = (float*)(smem + 9 * 1024 * 4);
    float* mod = (float*)(ws + OFF_MOD);
    for (int item = opaque_bid(); item < 192; item += gridDim.x) {
      const int l = item / 96, cb = item % 96;
      __syncthreads();
      for (int i = tid; i < 9 * 1024; i += 512) {
        const int r = i >> 10, k = i & 1023;
        const float cv = (r < 8) ? p.c[r * 1024 + k] : p.c_ctx[k];
        sc[i] = siluf(cv);
      }
      __syncthreads();
      const int col = tid & 63, ks = tid >> 6;
      float acc[9];
#pragma unroll
      for (int r = 0; r < 9; ++r) acc[r] = 0.f;
      const float* w = p.w_ada + (size_t)l * 1024 * 6144 + cb * 64 + col;
#pragma unroll 1
      for (int k0 = ks * 128; k0 < ks * 128 + 128; k0 += 16) {
        float wv[16];
#pragma unroll
        for (int i = 0; i < 16; ++i) wv[i] = w[(size_t)(k0 + i) * 6144];
#pragma unroll
        for (int i = 0; i < 16; ++i)
#pragma unroll
          for (int r = 0; r < 9; ++r) acc[r] = fmaf(sc[r * 1024 + k0 + i], wv[i], acc[r]);
      }
#pragma unroll
      for (int r = 0; r < 9; ++r) red[(ks * 9 + r) * 64 + col] = acc[r];
      __syncthreads();
      for (int i = tid; i < 576; i += 512) {
        const int r = i >> 6, cc = i & 63;
        float s = 0.f;
#pragma unroll
        for (int k8 = 0; k8 < 8; ++k8) s += red[(k8 * 9 + r) * 64 + cc];
        mod[((size_t)l * 9 + r) * 6144 + cb * 64 + cc] = s + p.b_ada[l * 6144 + cb * 64 + cc];
      }
    }
    __syncthreads();
  }
  for (int item = opaque_bid(); item < 3072; item += gridDim.x) {
    const int l = item / 1536;
    int r = item % 1536;
    if (r < 768) transpose_item(p.w_in + (size_t)l * 1024 * 3072, (bf16_t*)(ws + OFF_WIN) + (size_t)l * 3072 * 1024, 1024, 3072, r, smem);
    else if (r < 1024) transpose_item(p.w_out + (size_t)l * 1024 * 1024, (bf16_t*)(ws + OFF_WOUT) + (size_t)l * 1024 * 1024, 1024, 1024, r - 768, smem);
    else transpose_item(p.peer_wq + (size_t)l * 1024 * 2048, (bf16_t*)(ws + OFF_WQ) + (size_t)l * 2048 * 1024, 1024, 2048, r - 1024, smem);
  }
  convert_flat(p.peer_subkeys, (bf16_t*)(ws + OFF_SUBK), 2ull * 262144 / 4);
  {
    const size_t gt = (size_t)opaque_bid() * blockDim.x + tid, gs = (size_t)gridDim.x * blockDim.x;
    float4* dst = (float4*)(ws + OFF_CTXB);
    for (size_t i = gt; i < (size_t)NCTX * 1024 / 4; i += gs) dst[i] = ((const float4*)p.ctx)[i];
  }
}

__device__ __forceinline__ void phase_norm(const Params& p, int layer, int which, const float* xlat, int nrows) {
  const int lane = opaque_tid() & 63;
  const int gw = opaque_bid() * 8 + (opaque_tid() >> 6), nw = gridDim.x * 8;
  const float* g = (which == 0 ? p.norm1_g : p.norm2_g) + layer * 1024;
  const float* mod = (const float*)(p.ws + OFF_MOD) + (size_t)layer * 9 * 6144;
  const float* ctxb = (const float*)(p.ws + OFF_CTXB);
  bf16_t* act = (bf16_t*)(p.ws + OFF_ACT);
  const int sh_off = which == 0 ? 0 : 3 * 1024, sc_off = which == 0 ? 1024 : 4 * 1024;
  for (int row = gw; row < nrows; row += nw) {
    const float* src = row < NLAT ? xlat + (size_t)row * 1024 : ctxb + (size_t)(row - NLAT) * 1024;
    const int b = row < NLAT ? (row >> 12) : 8;
    const float* mrow = mod + (size_t)b * 6144;
    float4 v[4];
    float ss = 0.f;
#pragma unroll
    for (int j = 0; j < 4; ++j) {
      v[j] = ((const float4*)src)[lane + 64 * j];
      ss += v[j].x * v[j].x + v[j].y * v[j].y + v[j].z * v[j].z + v[j].w * v[j].w;
    }
    ss = wave_sum(ss);
    const float r = rsqrtf(ss * (1.f / 1024.f) + EPS);
#pragma unroll
    for (int j = 0; j < 4; ++j) {
      const int c = (lane + 64 * j) * 4;
      const float4 gg = *(const float4*)(g + c);
      const float4 sh = *(const float4*)(mrow + sh_off + c);
      const float4 sc = *(const float4*)(mrow + sc_off + c);
      const float o0 = v[j].x * r * gg.x * (1.f + sc.x) + sh.x;
      const float o1 = v[j].y * r * gg.y * (1.f + sc.y) + sh.y;
      const float o2 = v[j].z * r * gg.z * (1.f + sc.z) + sh.z;
      const float o3 = v[j].w * r * gg.w * (1.f + sc.w) + sh.w;
      uint2 o; o.x = pack2h(o0, o1); o.y = pack2h(o2, o3);
      *(uint2*)(act + (size_t)row * 1024 + c) = o;
    }
  }
}

__device__ __forceinline__ void phase_final(const Params& p) {
  const int lane = opaque_tid() & 63;
  const int gw = opaque_bid() * 8 + (opaque_tid() >> 6), nw = gridDim.x * 8;
  for (int row = gw; row < NLAT; row += nw) {
    float* src = p.out + (size_t)row * 1024;
    float4 v[4];
    float ss = 0.f;
#pragma unroll
    for (int j = 0; j < 4; ++j) {
      v[j] = ((const float4*)src)[lane + 64 * j];
      ss += v[j].x * v[j].x + v[j].y * v[j].y + v[j].z * v[j].z + v[j].w * v[j].w;
    }
    ss = wave_sum(ss);
    const float r = rsqrtf(ss * (1.f / 1024.f) + EPS);
#pragma unroll
    for (int j = 0; j < 4; ++j) {
      const int c = (lane + 64 * j) * 4;
      const float4 gg = *(const float4*)(p.final_g + c);
      float4 o;
      o.x = v[j].x * r * gg.x; o.y = v[j].y * r * gg.y; o.z = v[j].z * r * gg.z; o.w = v[j].w * r * gg.w;
      ((float4*)src)[lane + 64 * j] = o;
    }
  }
}

constexpr int EPI_INPROJ = 0, EPI_OUTPROJ = 1, EPI_PLAIN = 2;
constexpr int GS = 72;
constexpr int G_ASTAGE = 256 * GS * 2;
constexpr int G_BSTAGE = 128 * GS * 2;
constexpr int G_STAGE = G_ASTAGE + G_BSTAGE;

namespace g8 {
constexpr int BM = 256, BK = 64, HALF = 128, NXCD = 8, WGM = 8, HT = HALF * BK;
__device__ __forceinline__ int lds_byte(int r, int c) {
  const int st = (r >> 4) * 2 + (c >> 5), rr = r & 15, cc = c & 31, ob = rr * 64 + cc * 2;
  return st * 1024 + (ob ^ (((ob >> 9) & 1) << 5));
}
__device__ __forceinline__ void stage_rc(int b, int& R, int& C) {
  const int st = b / 1024, sb = b % 1024, swz = sb ^ (((sb >> 9) & 1) << 5);
  R = (st >> 1) * 16 + swz / 64; C = (st & 1) * 32 + (swz % 64) / 2;
}
}

constexpr int G8_ROPE_LDS = 8 * 16384;
template <int EPI>
__device__ __forceinline__ void epi_store8(const Params& p, int layer, char* smem, int m, int n, f32x4 lo, f32x4 hi, const float* xin_lat) {
  float v[8] = {lo[0], lo[1], lo[2], lo[3], hi[0], hi[1], hi[2], hi[3]};
  if constexpr (EPI == EPI_INPROJ) {
    const bool ropeD = (n >= C_DFQ && n < C_DFV), ropeR = (n >= C_RTQ && n < C_RTV);
    if ((ropeD || ropeR) && m < NLAT) {
      const int t = m & 4095, gr = t >> 6, gc = t & 63;
      const float2* tabD = (const float2*)(smem + G8_ROPE_LDS);
      const float2* tabR = (const float2*)(smem + G8_ROPE_LDS + 4096);
      const float2* tb;
      if (ropeD) { const int i0 = (n & 31) >> 1; tb = i0 < 8 ? tabD + gr * 8 + i0 : tabD + gc * 8 + i0 - 8; }
      else { const int i0 = (n & 63) >> 1; tb = i0 < 16 ? tabR + gr * 16 + i0 : tabR + gc * 16 + i0 - 16; }
#pragma unroll
      for (int q = 0; q < 4; ++q) {
        const float2 cs = tb[q];
        const float a0 = v[2 * q] * cs.x - v[2 * q + 1] * cs.y, a1 = v[2 * q] * cs.y + v[2 * q + 1] * cs.x;
        v[2 * q] = a0; v[2 * q + 1] = a1;
      }
    }
    float sc = 1.f;
    if (n < C_NAK) sc = 0.125f * 1.4426950408889634f;
    else if (n >= C_DFQ && n < C_DFK) sc = 0.17677669529663687f * 1.4426950408889634f;
    else if (n >= C_RTK && n < C_RTV) sc = 0.125f;
    uint4 o;
    o.x = pack2h(v[0] * sc, v[1] * sc); o.y = pack2h(v[2] * sc, v[3] * sc); o.z = pack2h(v[4] * sc, v[5] * sc); o.w = pack2h(v[6] * sc, v[7] * sc);
    *(uint4*)((bf16_t*)(p.ws + OFF_P) + (size_t)m * INC + n) = o;
  } else if constexpr (EPI == EPI_OUTPROJ) {
    const float* mod = (const float*)(p.ws + OFF_MOD) + (size_t)layer * 9 * 6144;
    const int b = m < NLAT ? (m >> 12) : 8;
    const float* gp = mod + (size_t)b * 6144 + 2 * 1024 + n;
    const float4 g0 = *(const float4*)gp, g1 = *(const float4*)(gp + 4);
    const float* xi; float* xo;
    if (m < NLAT) { xi = xin_lat + (size_t)m * 1024 + n; xo = p.out + (size_t)m * 1024 + n; }
    else { xo = (float*)(p.ws + OFF_CTXB) + (size_t)(m - NLAT) * 1024 + n; xi = xo; }
    const float4 x0 = *(const float4*)xi, x1 = *(const float4*)(xi + 4);
    float4 o0, o1;
    o0.x = x0.x + g0.x * v[0]; o0.y = x0.y + g0.y * v[1]; o0.z = x0.z + g0.z * v[2]; o0.w = x0.w + g0.w * v[3];
    o1.x = x1.x + g1.x * v[4]; o1.y = x1.y + g1.y * v[5]; o1.z = x1.z + g1.z * v[6]; o1.w = x1.w + g1.w * v[7];
    *(float4*)xo = o0; *(float4*)(xo + 4) = o1;
  } else if constexpr (EPI == EPI_PLAIN) {
    uint4 o;
    o.x = pack2h(v[0], v[1]); o.y = pack2h(v[2], v[3]); o.z = pack2h(v[4], v[5]); o.w = pack2h(v[6], v[7]);
    *(uint4*)((bf16_t*)(p.ws + OFF_P) + (size_t)m * 2048 + n) = o;
  } else {
    asm volatile("" :: "v"(v[0]), "v"(v[1]), "v"(v[2]), "v"(v[3]), "v"(v[4]), "v"(v[5]), "v"(v[6]), "v"(v[7]));
  }
}

#define G8_LAS __attribute__((address_space(3)))
__device__ __forceinline__ bool g8_next(int i, int nM, int nN, int G, int c, int& pm, int& pn) {
  using namespace g8;
  const int nwg = nM * nN;
  const long Lx = (long)i * G + c;
  if (Lx >= nwg) return false;
  int wgid = (int)Lx;
  { const int q = nwg / NXCD, r = nwg % NXCD, xcd = wgid % NXCD, off = wgid / NXCD; wgid = (xcd < r ? xcd * (q + 1) : r * (q + 1) + (xcd - r) * q) + off; }
  const int nig = WGM * nN, gid = wgid / nig, fm = gid * WGM, gsz = (nM - fm) < WGM ? (nM - fm) : WGM;
  pm = fm + ((wgid % nig) % gsz); pn = (wgid % nig) / gsz;
  return true;
}

template <int EPI>
__device__ __forceinline__ void gemm_phase2(const Params& p, int layer, char* smem, const bf16_t* A, const bf16_t* Bt,
                                            int M, int N, const float* xin_lat) {
  using namespace g8;
  constexpr int K = 1024, nt = K / BK, HTB = HALF * BK * 2;
  G8_LAS unsigned char* lds = (G8_LAS unsigned char*)smem;
  const int tid = opaque_tid();
  const int wid = __builtin_amdgcn_readfirstlane(tid >> 6), lane = tid & 63, wr = wid >> 2, wc = wid & 3, fr = lane & 15, fq = lane >> 4;
  unsigned voff[2], voffB[2];
#pragma unroll
  for (int i = 0; i < 2; ++i) {
    int R, C; stage_rc(tid * 16 + i * 8192, R, C);
    const int rho = R & 31, Rb = (R & ~31) + 8 * ((rho & 15) >> 2) + 4 * (rho >> 4) + (rho & 3);
    voff[i] = (unsigned)(R * K + C) * 2u; voffB[i] = (unsigned)(Rb * K + C) * 2u;
  }
  if constexpr (EPI == EPI_INPROJ) {
    __syncthreads();
    const float4* gsrc = (const float4*)(p.ws + OFF_ROPE);
    float4* ldst = (float4*)(smem + G8_ROPE_LDS);
    for (int i = tid; i < 12288 / 16; i += 512) ldst[i] = gsrc[i];
  }
  constexpr size_t kstep = (size_t)(BK * 2);
  constexpr size_t hstep = (size_t)HALF * K * 2;
  constexpr size_t tstep = 2 * hstep;
  const unsigned ldsw = (unsigned)wid * 1024u;
  const int aoff = lds_byte(wr * 64 + fr, fq * 8), boff = lds_byte(wc * 32 + fr, fq * 8);
#define G8_SA(b, h) (((b) * 2 + (h)) * HTB)
#define G8_SB(b, h) ((4 + (b) * 2 + (h)) * HTB)
#define G8_STAGE_V(bufoff, gbase, VO) do { _Pragma("unroll") for (int _i = 0; _i < 2; ++_i)                                  \
    __builtin_amdgcn_global_load_lds((const unsigned*)((const char*)(gbase) + VO[_i]), (G8_LAS unsigned*)(lds + (bufoff) + ldsw + _i * 8192), 16, 0, 0); } while (0)
#define G8_LDA(dst, b, h) do { _Pragma("unroll") for (int m = 0; m < 4; ++m) _Pragma("unroll") for (int k = 0; k < 2; ++k) dst[m][k] = *(const G8_LAS bf16x8*)(lds + G8_SA(b, h) + aoff + m * 2048 + k * 1024); } while (0)
#define G8_LDB(dst, b, h) do { _Pragma("unroll") for (int n = 0; n < 2; ++n) _Pragma("unroll") for (int k = 0; k < 2; ++k) dst[n][k] = *(const G8_LAS bf16x8*)(lds + G8_SB(b, h) + boff + n * 2048 + k * 1024); } while (0)
#define G8_MMA(ai, bj, At_, Bt_) do { __builtin_amdgcn_s_setprio(1);                                                          \
    _Pragma("unroll") for (int m = 0; m < 4; ++m) _Pragma("unroll") for (int n = 0; n < 2; ++n) _Pragma("unroll") for (int k = 0; k < 2; ++k) \
      acc[ai][bj][m][n] = __builtin_amdgcn_mfma_f32_16x16x32_bf16(Bt_[n][k], At_[m][k], acc[ai][bj][m][n], 0, 0, 0);          \
    __builtin_amdgcn_s_setprio(0); } while (0)
#define G8_WAIT_V(n) asm volatile("s_waitcnt vmcnt(" #n ")" ::: "memory")
#define G8_WAIT_L(n) asm volatile("s_waitcnt lgkmcnt(" #n ")" ::: "memory")
#define G8_BAR __builtin_amdgcn_s_barrier()
#define G8_SCHED __builtin_amdgcn_sched_barrier(0)
  const int nM = M / BM, nN = N / BM, G = gridDim.x, cu = opaque_bid();
  int cpm, cpn, npm = 0, npn = 0, ui = 0;
  __syncthreads();
  if (g8_next(0, nM, nN, G, cu, cpm, cpn)) {
    f32x4 acc[2][2][4][2];
#pragma unroll
    for (int a = 0; a < 2; ++a)
#pragma unroll
      for (int b2 = 0; b2 < 2; ++b2)
#pragma unroll
        for (int m = 0; m < 4; ++m)
#pragma unroll
          for (int n = 0; n < 2; ++n) acc[a][b2][m][n] = (f32x4){0.f, 0.f, 0.f, 0.f};
    bf16x8 At[4][2], B0[2][2], B1[2][2];
    const char* cA = (const char*)A + (size_t)cpm * tstep;
    const char* cB = (const char*)Bt + (size_t)cpn * tstep;
    G8_STAGE_V(G8_SB(0, 0), cB, voffB); G8_STAGE_V(G8_SA(0, 0), cA, voff); G8_STAGE_V(G8_SB(0, 1), cB + hstep, voffB); G8_STAGE_V(G8_SA(0, 1), cA + hstep, voff);
    if (wr == 1) G8_BAR;
    G8_WAIT_V(4); G8_BAR;
    G8_STAGE_V(G8_SB(1, 0), cB + kstep, voffB); G8_STAGE_V(G8_SA(1, 0), cA + kstep, voff); G8_STAGE_V(G8_SB(1, 1), cB + hstep + kstep, voffB);
    G8_WAIT_V(6); G8_BAR;
    for (;;) {
      const bool has_next = g8_next(ui + 1, nM, nN, G, cu, npm, npn);
      const char* nA = has_next ? (const char*)A + (size_t)npm * tstep : cA;
      const char* nB = has_next ? (const char*)Bt + (size_t)npn * tstep : cB;
#pragma unroll 1
      for (int t = 0; t < nt; t += 2) {
        const bool last = (t == nt - 2);
        const char* a1 = cA + (size_t)(t + 1) * kstep;
        const char* a2 = last ? nA : cA + (size_t)(t + 2) * kstep; const char* b2 = last ? nB : cB + (size_t)(t + 2) * kstep;
        const char* a3 = a2 + kstep; const char* b3 = b2 + kstep;
        G8_LDB(B0, 0, 0); G8_SCHED; G8_LDA(At, 0, 0); G8_STAGE_V(G8_SA(1, 1), a1 + hstep, voff);
        G8_WAIT_L(8); G8_BAR; G8_WAIT_L(0); G8_MMA(0, 0, At, B0); G8_BAR; G8_SCHED;
        G8_LDB(B1, 0, 1); G8_STAGE_V(G8_SB(0, 0), b2, voffB);
        G8_BAR; G8_WAIT_L(0); G8_MMA(0, 1, At, B1); G8_BAR;
        G8_LDA(At, 0, 1); G8_STAGE_V(G8_SA(0, 0), a2, voff);
        G8_BAR; G8_WAIT_L(0); G8_MMA(1, 0, At, B0); G8_BAR; G8_SCHED;
        G8_STAGE_V(G8_SB(0, 1), b2 + hstep, voffB);
        G8_WAIT_V(6); G8_BAR; G8_MMA(1, 1, At, B1); G8_BAR;
        G8_LDB(B0, 1, 0); G8_SCHED; G8_LDA(At, 1, 0); G8_STAGE_V(G8_SA(0, 1), a2 + hstep, voff);
        G8_WAIT_L(8); G8_BAR; G8_WAIT_L(0); G8_MMA(0, 0, At, B0); G8_BAR; G8_SCHED;
        G8_LDB(B1, 1, 1); G8_STAGE_V(G8_SB(1, 0), b3, voffB);
        G8_BAR; G8_WAIT_L(0); G8_MMA(0, 1, At, B1); G8_BAR;
        G8_LDA(At, 1, 1); G8_STAGE_V(G8_SA(1, 0), a3, voff);
        G8_BAR; G8_WAIT_L(0); G8_MMA(1, 0, At, B0); G8_BAR; G8_SCHED;
        G8_STAGE_V(G8_SB(1, 1), b3 + hstep, voffB);
        G8_WAIT_V(6); G8_BAR; G8_MMA(1, 1, At, B1); G8_BAR;
      }
      {
        const int brow = cpm * BM, bcol = cpn * BM;
        if constexpr (EPI == EPI_INPROJ) {
          if (bcol == C_DFK) {
#pragma unroll
            for (int bj = 0; bj < 2; ++bj) {
              float mx = 0.f;
#pragma unroll
              for (int ai = 0; ai < 2; ++ai)
#pragma unroll
                for (int m = 0; m < 4; ++m) {
                  float s = 0.f;
#pragma unroll
                  for (int n = 0; n < 2; ++n)
#pragma unroll
                    for (int j = 0; j < 4; ++j) s = fmaf(acc[ai][bj][m][n][j], acc[ai][bj][m][n][j], s);
                  s += __shfl_xor(s, 16); s += __shfl_xor(s, 32);
                  mx = fmaxf(mx, s);
                }
#pragma unroll
              for (int o = 1; o < 16; o <<= 1) mx = fmaxf(mx, __shfl_xor(mx, o));
              if (lane == 0) {
                const int bb = brow < NLAT ? (brow >> 12) : ((brow - NLAT) >> 8);
                unsigned* km = (unsigned*)(p.ws + OFF_MISC) + 64 + layer * 64 + (bb * 4 + bj * 2 + (wc >> 1)) * 2 + (wc & 1);
                atomicMax(km, __float_as_uint(mx));
              }
            }
          }
        }
#pragma unroll
        for (int ai = 0; ai < 2; ++ai)
#pragma unroll
          for (int bj = 0; bj < 2; ++bj)
#pragma unroll
            for (int m = 0; m < 4; ++m)
              epi_store8<EPI>(p, layer, smem, brow + ai * HALF + wr * 64 + m * 16 + fr, bcol + bj * HALF + wc * 32 + fq * 8,
                              acc[ai][bj][m][0], acc[ai][bj][m][1], xin_lat);
      }
      if (!has_next) break;
#pragma unroll
      for (int a = 0; a < 2; ++a)
#pragma unroll
        for (int b2 = 0; b2 < 2; ++b2)
#pragma unroll
          for (int m = 0; m < 4; ++m)
#pragma unroll
            for (int n = 0; n < 2; ++n) acc[a][b2][m][n] = (f32x4){0.f, 0.f, 0.f, 0.f};
      cpm = npm; cpn = npn; cA = nA; cB = nB; ++ui;
    }
    G8_WAIT_V(0);
    if (wr == 0) G8_BAR;
    G8_BAR;
  }
}

__device__ __forceinline__ unsigned cvt_pk_bf16(float lo, float hi) { return pack2h(lo, hi); }
__device__ __forceinline__ void vt_store8(bf16_t* vt, int stride, int d0, int key, uint4 uv) {
  bf16_t* vd = vt + d0 * stride + key;
  vd[0 * stride] = (bf16_t)(uv.x & 0xffffu); vd[1 * stride] = (bf16_t)(uv.x >> 16);
  vd[2 * stride] = (bf16_t)(uv.y & 0xffffu); vd[3 * stride] = (bf16_t)(uv.y >> 16);
  vd[4 * stride] = (bf16_t)(uv.z & 0xffffu); vd[5 * stride] = (bf16_t)(uv.z >> 16);
  vd[6 * stride] = (bf16_t)(uv.w & 0xffffu); vd[7 * stride] = (bf16_t)(uv.w >> 16);
}

constexpr int DKS = 72;
__device__ __forceinline__ void diff_item(const Params& p, int layer, bool ctxq, int item, char* smem) {
  const bf16_t* P = (const bf16_t*)(p.ws + OFF_P);
  bf16_t* Y = (bf16_t*)(p.ws + OFF_ACT);
  const float* misc = (const float*)(p.ws + OFF_MISC);
  const float lam = misc[layer], lam_init = misc[2 + layer];
  const int tid = opaque_tid(), lane = tid & 63, wave = tid >> 6, lr = lane & 15, lq = lane >> 4;
  int b, h, mbase, nkeys;
  if (!ctxq) { b = item >> 6; h = (item >> 4) & 3; mbase = b * 4096 + (item & 15) * 256; nkeys = 256 + 4096; }
  else { b = item >> 2; h = item & 3; mbase = NLAT + b * 256; nkeys = 256; }
  const float kmax0 = sqrtf(misc[64 + layer * 64 + (b * 4 + h) * 2 + 0]), kmax1 = sqrtf(misc[64 + layer * 64 + (b * 4 + h) * 2 + 1]);
  bf16x8 qf[2][2];
  f32x4 C0[2], C1[2];
#pragma unroll
  for (int qt = 0; qt < 2; ++qt) {
    const bf16_t* qr = P + (size_t)(mbase + wave * 32 + qt * 16 + lr) * INC + C_DFQ + h * 64 + lq * 8;
    const uint4 u0 = *(const uint4*)(qr), u1 = *(const uint4*)(qr + 32);
    float s0 = 0.f, s1 = 0.f;
    { float t[8]; UNPACK8(t, 0, u0) _Pragma("unroll") for (int i = 0; i < 8; ++i) s0 = fmaf(t[i], t[i], s0); }
    { float t[8]; UNPACK8(t, 0, u1) _Pragma("unroll") for (int i = 0; i < 8; ++i) s1 = fmaf(t[i], t[i], s1); }
    s0 += __shfl_xor(s0, 16); s0 += __shfl_xor(s0, 32);
    s1 += __shfl_xor(s1, 16); s1 += __shfl_xor(s1, 32);
    const float nm0 = -sqrtf(s0) * kmax0, nm1 = -sqrtf(s1) * kmax1;
    C0[qt] = (f32x4){nm0, nm0, nm0, nm0};
    C1[qt] = (f32x4){nm1, nm1, nm1, nm1};
    union { uint4 u; bf16x8 v; } c0, c1; c0.u = u0; c1.u = u1;
    qf[qt][0] = c0.v; qf[qt][1] = c1.v;
  }
  f32x4 O0[2][4], O1[2][4];
#pragma unroll
  for (int qt = 0; qt < 2; ++qt)
#pragma unroll
    for (int i = 0; i < 4; ++i) { O0[qt][i] = (f32x4){0.f, 0.f, 0.f, 0.f}; O1[qt][i] = (f32x4){0.f, 0.f, 0.f, 0.f}; }
  f32x4 L0[2], L1[2];
#pragma unroll
  for (int qt = 0; qt < 2; ++qt) { L0[qt] = (f32x4){0.f, 0.f, 0.f, 0.f}; L1[qt] = (f32x4){0.f, 0.f, 0.f, 0.f}; }
  const bf16x8 ones8 = {(short)0x3F80, (short)0x3F80, (short)0x3F80, (short)0x3F80, (short)0x3F80, (short)0x3F80, (short)0x3F80, (short)0x3F80};
  const int lkey = tid >> 3, lch = tid & 7;
  constexpr int DBUF = 2 * 128 * DKS * 2;
  uint4 ukA0, ukA1, uvA0, uvA1;
#define DF_GLOAD1(UK, UV, T, I)                                                                     \
  {                                                                                                 \
    const int kk = (T) * 128 + (I) * 64 + lkey;                                                     \
    const size_t row = kk < 256 ? (size_t)(NLAT + b * 256 + kk) : (size_t)(b * 4096 + kk - 256);    \
    UK = *(const uint4*)(P + row * INC + C_DFK + h * 64 + lch * 8);                                 \
    UV = *(const uint4*)(P + row * INC + C_DFV + h * 64 + lch * 8);                                 \
  }
#define DF_LSTORE1(UK, UV, BUF, I)                                                                  \
  {                                                                                                 \
    bf16_t* Ks_ = (bf16_t*)(smem + (BUF) * DBUF) + (I) * 64 * DKS;                                  \
    bf16_t* Vt_ = (bf16_t*)(smem + (BUF) * DBUF) + 128 * DKS + (I) * 64 * DKS;                      \
    *(uint4*)(Ks_ + lkey * DKS + lch * 8) = UK;                                                     \
    vt_store8(Vt_, DKS, lch * 8, lkey, UV);                                                         \
  }
#define DF_GLOAD(S, T) DF_GLOAD1(uk##S##0, uv##S##0, T, 0) DF_GLOAD1(uk##S##1, uv##S##1, T, 1)
#define DF_LSTORE(S, BUF) DF_LSTORE1(uk##S##0, uv##S##0, BUF, 0) DF_LSTORE1(uk##S##1, uv##S##1, BUF, 1)
  const int ntile = nkeys >> 7;
  __syncthreads();
  DF_GLOAD(A, 0)
  DF_LSTORE(A, 0)
  __syncthreads();
#pragma unroll 1
  for (int t = 0; t < ntile; ++t) {
    const int cur = t & 1;
    if (t + 1 < ntile) { DF_GLOAD(A, t + 1) }
#pragma unroll 1
    for (int sub = 0; sub < 2; ++sub) {
    const bf16_t* Ks = (const bf16_t*)(smem + cur * DBUF) + sub * 64 * DKS;
    const bf16_t* Vt = (const bf16_t*)(smem + cur * DBUF) + 128 * DKS + sub * 64 * DKS;
    union PF { unsigned u[4]; bf16x8 v; };
    PF pf0[2][2], pf1[2][2];
#pragma unroll
    for (int c = 0; c < 2; ++c) {
      f32x4 S[2][4];
#pragma unroll
      for (int kt = 0; kt < 4; ++kt) {
        const bf16x8 kf = *(const bf16x8*)(Ks + (kt * 16 + lr) * DKS + c * 32 + lq * 8);
#pragma unroll
        for (int qt = 0; qt < 2; ++qt) S[qt][kt] = __builtin_amdgcn_mfma_f32_16x16x32_bf16(kf, qf[qt][c], c == 0 ? C0[qt] : C1[qt], 0, 0, 0);
      }
#pragma unroll
      for (int qt = 0; qt < 2; ++qt) {
#pragma unroll
        for (int kt = 0; kt < 4; ++kt) {
#pragma unroll
          for (int r = 0; r < 4; ++r) S[qt][kt][r] = __builtin_amdgcn_exp2f(S[qt][kt][r]);
        }
#pragma unroll
        for (int g = 0; g < 2; ++g) {
          PF t;
          t.u[0] = cvt_pk_bf16(S[qt][2 * g][0], S[qt][2 * g][1]); t.u[1] = cvt_pk_bf16(S[qt][2 * g][2], S[qt][2 * g][3]);
          t.u[2] = cvt_pk_bf16(S[qt][2 * g + 1][0], S[qt][2 * g + 1][1]); t.u[3] = cvt_pk_bf16(S[qt][2 * g + 1][2], S[qt][2 * g + 1][3]);
          if (c == 0) pf0[qt][g] = t; else pf1[qt][g] = t;
        }
      }
    }
#pragma unroll
    for (int g = 0; g < 2; ++g) {
#pragma unroll
      for (int qt = 0; qt < 2; ++qt) {
        L0[qt] = __builtin_amdgcn_mfma_f32_16x16x32_bf16(ones8, pf0[qt][g].v, L0[qt], 0, 0, 0);
        L1[qt] = __builtin_amdgcn_mfma_f32_16x16x32_bf16(ones8, pf1[qt][g].v, L1[qt], 0, 0, 0);
      }
#pragma unroll
      for (int dt = 0; dt < 4; ++dt) {
        union { uint2 h2[2]; bf16x8 v; } vf;
        vf.h2[0] = *(const uint2*)(Vt + (dt * 16 + lr) * DKS + 32 * g + 4 * lq);
        vf.h2[1] = *(const uint2*)(Vt + (dt * 16 + lr) * DKS + 32 * g + 16 + 4 * lq);
#pragma unroll
        for (int qt = 0; qt < 2; ++qt) {
          O0[qt][dt] = __builtin_amdgcn_mfma_f32_16x16x32_bf16(vf.v, pf0[qt][g].v, O0[qt][dt], 0, 0, 0);
          O1[qt][dt] = __builtin_amdgcn_mfma_f32_16x16x32_bf16(vf.v, pf1[qt][g].v, O1[qt][dt], 0, 0, 0);
        }
      }
    }
    }
    if (t + 1 < ntile) { DF_LSTORE(A, cur ^ 1) }
    __syncthreads();
  }
  const float* sg = p.diff_subln_g + layer * 64;
#pragma unroll
  for (int qt = 0; qt < 2; ++qt) {
    const float a0 = L0[qt][0], a1 = L1[qt][0];
    const float i0 = 1.f / a0, i1 = lam / a1;
    float ss = 0.f;
#pragma unroll
    for (int dt = 0; dt < 4; ++dt) {
#pragma unroll
      for (int r = 0; r < 4; ++r) { const float v = O0[qt][dt][r] * i0 - O1[qt][dt][r] * i1; O0[qt][dt][r] = v; ss = fmaf(v, v, ss); }
    }
    ss += __shfl_xor(ss, 16); ss += __shfl_xor(ss, 32);
    const float rr = rsqrtf(ss * (1.f / 64.f) + EPS) * (1.f - lam_init);
    bf16_t* dst = Y + (size_t)(mbase + wave * 32 + qt * 16 + lr) * 1024 + Y_DF + h * 64;
#pragma unroll
    for (int dt = 0; dt < 4; ++dt) {
      const int d = dt * 16 + 4 * lq;
      const float4 g4 = *(const float4*)(sg + d);
      uint2 ov;
      ov.x = pack2(O0[qt][dt][0] * rr * g4.x, O0[qt][dt][1] * rr * g4.y);
      ov.y = pack2(O0[qt][dt][2] * rr * g4.z, O0[qt][dt][3] * rr * g4.w);
      *(uint2*)(dst + d) = ov;
    }
  }
}

constexpr int NA_WS = 520;
constexpr int NA_CS = 264;
constexpr int NA_OFF_VTW = 0;
constexpr int NA_OFF_VTC = 64 * NA_WS * 2;
constexpr int NA_OFF_RPB = NA_OFF_VTC + 64 * NA_CS * 2;
constexpr int NA_OFF_MRG = NA_OFF_RPB + 2048;

#define NA_STEP(KA_EXPR, KB_EXPR, BIAS_EXPR, VT_PTR, VT_STRIDE, VT_KEY0_EXPR)                                    \
  {                                                                                                               \
    f32x4 S[4];                                                                                                   \
    _Pragma("unroll") for (int kt = 0; kt < 4; ++kt) {                                                            \
      f32x4 a = __builtin_amdgcn_mfma_f32_16x16x32_bf16((KA_EXPR), qf[0], (f32x4){0.f, 0.f, 0.f, 0.f}, 0, 0, 0);  \
      S[kt] = __builtin_amdgcn_mfma_f32_16x16x32_bf16((KB_EXPR), qf[1], a, 0, 0, 0);                               \
    }                                                                                                             \
    _Pragma("unroll") for (int kt = 0; kt < 4; ++kt) {                                                            \
      _Pragma("unroll") for (int r = 0; r < 4; ++r) { S[kt][r] += (BIAS_EXPR); }                                  \
    }                                                                                                             \
    float x = fmaxf(fmaxf(S[0][0], S[0][1]), fmaxf(S[0][2], S[0][3]));                                            \
    _Pragma("unroll") for (int kt = 1; kt < 4; ++kt) x = fmaxf(x, fmaxf(fmaxf(S[kt][0], S[kt][1]), fmaxf(S[kt][2], S[kt][3]))); \
    x = fmaxf(x, __shfl_xor(x, 16)); x = fmaxf(x, __shfl_xor(x, 32));                                             \
    const float mn = fmaxf(mrun, x);                                                                              \
    const float al = __builtin_amdgcn_exp2f(mrun - mn);                                                           \
    mrun = mn;                                                                                                    \
    float ps = 0.f;                                                                                               \
    _Pragma("unroll") for (int kt = 0; kt < 4; ++kt) {                                                            \
      _Pragma("unroll") for (int r = 0; r < 4; ++r) { S[kt][r] = __builtin_amdgcn_exp2f(S[kt][r] - mn); ps += S[kt][r]; } \
    }                                                                                                             \
    lrun = lrun * al + ps;                                                                                        \
    _Pragma("unroll") for (int dt = 0; dt < 4; ++dt) {                                                            \
      _Pragma("unroll") for (int r = 0; r < 4; ++r) O[dt][r] *= al;                                               \
    }                                                                                                             \
    _Pragma("unroll") for (int g = 0; g < 2; ++g) {                                                               \
      union { unsigned u[4]; bf16x8 v; } pf;                                                                      \
      pf.u[0] = cvt_pk_bf16(S[2 * g][0], S[2 * g][1]); pf.u[1] = cvt_pk_bf16(S[2 * g][2], S[2 * g][3]);           \
      pf.u[2] = cvt_pk_bf16(S[2 * g + 1][0], S[2 * g + 1][1]); pf.u[3] = cvt_pk_bf16(S[2 * g + 1][2], S[2 * g + 1][3]); \
      const int vk0 = (VT_KEY0_EXPR);                                                                             \
      _Pragma("unroll") for (int dt = 0; dt < 4; ++dt) {                                                          \
        union { uint2 h2[2]; bf16x8 v; } vf;                                                                      \
        vf.h2[0] = *(const uint2*)((VT_PTR) + (dt * 16 + lr) * (VT_STRIDE) + vk0 + 4 * lq);                       \
        vf.h2[1] = *(const uint2*)((VT_PTR) + (dt * 16 + lr) * (VT_STRIDE) + vk0 + 16 + 4 * lq);                  \
        O[dt] = __builtin_amdgcn_mfma_f32_16x16x32_bf16(vf.v, pf.v, O[dt], 0, 0, 0);                              \
      }                                                                                                           \
    }                                                                                                             \
  }

__device__ __forceinline__ void na_latent_item(const Params& p, int layer, int item, char* smem) {
  const bf16_t* P = (const bf16_t*)(p.ws + OFF_P);
  bf16_t* Y = (bf16_t*)(p.ws + OFF_ACT);
  const int b = item >> 8, h = (item >> 6) & 3, grow = item & 63;
  const int tid = opaque_tid(), lane = tid & 63, wave = tid >> 6, lr = lane & 15, lq = lane >> 4;
  const int jt = wave & 3, half = wave >> 2;
  bf16_t* VtW = (bf16_t*)(smem + NA_OFF_VTW);
  bf16_t* VtC = (bf16_t*)(smem + NA_OFF_VTC);
  float* RPB = (float*)(smem + NA_OFF_RPB);
  float* MRG = (float*)(smem + NA_OFF_MRG);
  const int rs = min(max(grow - 4, 0), 56);
  __syncthreads();
  {
    const int ch = tid & 7;
#pragma unroll
    for (int i = 0; i < 8; ++i) {
      const int key = (tid >> 3) + 64 * i;
      const uint4 uv = *(const uint4*)(P + (size_t)(b * 4096 + (rs + (key >> 6)) * 64 + (key & 63)) * INC + C_NAV + h * 64 + ch * 8);
      vt_store8(VtW, NA_WS, ch * 8, key, uv);
    }
#pragma unroll
    for (int i = 0; i < 4; ++i) {
      const int key = (tid >> 3) + 64 * i;
      const uint4 uv = *(const uint4*)(P + (size_t)(NLAT + b * 256 + key) * INC + C_NAV + h * 64 + ch * 8);
      vt_store8(VtC, NA_CS, ch * 8, key, uv);
    }
    if (tid < 465) RPB[tid] = p.na_rpb[(size_t)(layer * 4 + h) * 465 + tid] * 1.4426950408889634f;
  }
  const int qc = jt * 16 + lr;
  const int mq = b * 4096 + grow * 64 + qc;
  bf16x8 qf[2];
  {
    const bf16_t* qr = P + (size_t)mq * INC + C_NAQ + h * 64 + lq * 8;
    qf[0] = *(const bf16x8*)(qr);
    qf[1] = *(const bf16x8*)(qr + 32);
  }
  f32x4 O[4];
#pragma unroll
  for (int i = 0; i < 4; ++i) O[i] = (f32x4){0.f, 0.f, 0.f, 0.f};
  float mrun = -1e30f, lrun = 0.f;
  const int k0 = min(max(jt * 16 - 8, 0), 32);
  const int cs = min(max(qc - 8, 0), 48);
  bf16x8 kfa[2][4], kfb[2][4];
#define NA_LOADK(SET, S_)                                                                                        \
  _Pragma("unroll") for (int kt = 0; kt < 4; ++kt) {                                                             \
    const int t_ = 4 * (S_) + kt;                                                                                \
    const size_t krow = half == 0 ? (size_t)(b * 4096 + (rs + (t_ >> 1)) * 64 + k0 + 16 * (t_ & 1) + lr) : (size_t)(NLAT + b * 256 + 16 * t_ + lr); \
    const bf16_t* kp = P + krow * INC + C_NAK + h * 64 + lq * 8;                                                 \
    kfa[SET][kt] = *(const bf16x8*)(kp); kfb[SET][kt] = *(const bf16x8*)(kp + 32);                               \
  }
  NA_LOADK(0, 0)
  __syncthreads();
#pragma unroll
  for (int s = 0; s < 4; ++s) {
    if (s + 1 < 4) { NA_LOADK((s + 1) & 1, s + 1) }
    if (half == 0) {
      const int wr0 = 2 * s;
      NA_STEP(kfa[s & 1][kt], kfb[s & 1][kt],
              ((k0 + 16 * (kt & 1) + 4 * lq + r) >= cs && (k0 + 16 * (kt & 1) + 4 * lq + r) < cs + 16)
                  ? RPB[(rs + wr0 + (kt >> 1) - grow + 7) * 31 + (k0 + 16 * (kt & 1) + 4 * lq + r) - qc + 15] : -1e30f,
              VtW, NA_WS, (wr0 + g) * 64 + k0)
    } else {
      NA_STEP(kfa[s & 1][kt], kfb[s & 1][kt], 0.f, VtC, NA_CS, s * 64 + 32 * g)
    }
  }
  lrun += __shfl_xor(lrun, 16); lrun += __shfl_xor(lrun, 32);
  float* mg = MRG + (jt * 64 + lane) * 18;
  if (half == 1) {
    mg[0] = mrun; mg[1] = lrun;
#pragma unroll
    for (int dt = 0; dt < 4; ++dt) { mg[2 + dt * 4 + 0] = O[dt][0]; mg[2 + dt * 4 + 1] = O[dt][1]; mg[2 + dt * 4 + 2] = O[dt][2]; mg[2 + dt * 4 + 3] = O[dt][3]; }
  }
  __syncthreads();
  if (half == 0) {
    const float m2 = mg[0], l2 = mg[1];
    const float M = fmaxf(mrun, m2);
    const float f1 = __builtin_amdgcn_exp2f(mrun - M), f2 = __builtin_amdgcn_exp2f(m2 - M);
    const float inv = 1.f / (lrun * f1 + l2 * f2);
    bf16_t* dst = Y + (size_t)mq * 1024 + Y_NA + h * 64;
#pragma unroll
    for (int dt = 0; dt < 4; ++dt) {
      const float o0 = (O[dt][0] * f1 + mg[2 + dt * 4 + 0] * f2) * inv, o1 = (O[dt][1] * f1 + mg[2 + dt * 4 + 1] * f2) * inv;
      const float o2 = (O[dt][2] * f1 + mg[2 + dt * 4 + 2] * f2) * inv, o3 = (O[dt][3] * f1 + mg[2 + dt * 4 + 3] * f2) * inv;
      uint2 ov; ov.x = pack2(o0, o1); ov.y = pack2(o2, o3);
      *(uint2*)(dst + dt * 16 + 4 * lq) = ov;
    }
  }
}

__device__ __forceinline__ void na_ctx_item(const Params& p, int item, char* smem) {
  const bf16_t* P = (const bf16_t*)(p.ws + OFF_P);
  bf16_t* Y = (bf16_t*)(p.ws + OFF_ACT);
  const int b = item >> 3, h = (item >> 1) & 3, qg = item & 1;
  const int tid = opaque_tid(), lane = tid & 63, wave = tid >> 6, lr = lane & 15, lq = lane >> 4;
  bf16_t* VtC = (bf16_t*)(smem + NA_OFF_VTC);
  __syncthreads();
  {
    const int ch = tid & 7;
#pragma unroll
    for (int i = 0; i < 4; ++i) {
      const int key = (tid >> 3) + 64 * i;
      const uint4 uv = *(const uint4*)(P + (size_t)(NLAT + b * 256 + key) * INC + C_NAV + h * 64 + ch * 8);
      vt_store8(VtC, NA_CS, ch * 8, key, uv);
    }
  }
  const int mq = NLAT + b * 256 + qg * 128 + wave * 16 + lr;
  bf16x8 qf[2];
  {
    const bf16_t* qr = P + (size_t)mq * INC + C_NAQ + h * 64 + lq * 8;
    qf[0] = *(const bf16x8*)(qr);
    qf[1] = *(const bf16x8*)(qr + 32);
  }
  f32x4 O[4];
#pragma unroll
  for (int i = 0; i < 4; ++i) O[i] = (f32x4){0.f, 0.f, 0.f, 0.f};
  float mrun = -1e30f, lrun = 0.f;
  __syncthreads();
#pragma unroll 1
  for (int s = 0; s < 4; ++s) {
    NA_STEP(*(const bf16x8*)(P + (size_t)(NLAT + b * 256 + s * 64 + kt * 16 + lr) * INC + C_NAK + h * 64 + lq * 8),
            *(const bf16x8*)(P + (size_t)(NLAT + b * 256 + s * 64 + kt * 16 + lr) * INC + C_NAK + h * 64 + 32 + lq * 8), 0.f, VtC, NA_CS, s * 64 + 32 * g)
  }
  lrun += __shfl_xor(lrun, 16); lrun += __shfl_xor(lrun, 32);
  const float inv = 1.f / lrun;
  bf16_t* dst = Y + (size_t)mq * 1024 + Y_NA + h * 64;
#pragma unroll
  for (int dt = 0; dt < 4; ++dt) {
    uint2 ov; ov.x = pack2(O[dt][0] * inv, O[dt][1] * inv); ov.y = pack2(O[dt][2] * inv, O[dt][3] * inv);
    *(uint2*)(dst + dt * 16 + 4 * lq) = ov;
  }
}

constexpr int KV_S = 136;
constexpr int KV_OFF_KF = 0, KV_OFF_KB = 64 * KV_S * 2, KV_OFF_VT = 2 * 64 * KV_S * 2;
__device__ __forceinline__ void ret_kv_item(const Params& p, int layer, int h, size_t row0, int cnt, float* dstF, float* dstB, char* smem) {
  const bf16_t* P = (const bf16_t*)(p.ws + OFF_P);
  const float* misc = (const float*)(p.ws + OFF_MISC);
  const float lgF2 = misc[16 + layer * 8 + 0 * 4 + h] * 1.4426950408889634f, lgB2 = misc[16 + layer * 8 + 1 * 4 + h] * 1.4426950408889634f;
  const int tid = opaque_tid(), lane = tid & 63, wave = tid >> 6, lr = lane & 15, lq = lane >> 4;
  bf16_t* KFt = (bf16_t*)(smem + KV_OFF_KF);
  bf16_t* KBt = (bf16_t*)(smem + KV_OFF_KB);
  bf16_t* Vt = (bf16_t*)(smem + KV_OFF_VT);
  const int dir = wave >> 2, dt = wave & 3;
  f32x4 acc[8];
#pragma unroll
  for (int i = 0; i < 8; ++i) acc[i] = (f32x4){0.f, 0.f, 0.f, 0.f};
#pragma unroll 1
  for (int kc = 0; kc < (cnt >> 7); ++kc) {
    __syncthreads();
    {
      const int tok = tid >> 2, c = tid & 3;
      const int j = kc * 128 + tok;
      const float wF = __builtin_amdgcn_exp2f(lgF2 * (float)(cnt - 1 - j)), wB = __builtin_amdgcn_exp2f(lgB2 * (float)j);
      const bf16_t* rowp = P + (row0 + j) * INC;
#pragma unroll
      for (int c8 = 0; c8 < 2; ++c8) {
        const uint4 u = *(const uint4*)(rowp + C_RTK + h * 64 + c * 16 + c8 * 8);
        float kv[8];
        UNPACK8(kv, 0, u)
#pragma unroll
        for (int i = 0; i < 8; ++i) {
          KFt[(c * 16 + c8 * 8 + i) * KV_S + tok] = f2bf(kv[i] * wF);
          KBt[(c * 16 + c8 * 8 + i) * KV_S + tok] = f2bf(kv[i] * wB);
        }
      }
#pragma unroll
      for (int c8 = 0; c8 < 4; ++c8) {
        const uint4 uv = *(const uint4*)(rowp + C_RTV + h * 128 + c * 32 + c8 * 8);
        vt_store8(Vt, KV_S, c * 32 + c8 * 8, tok, uv);
      }
    }
    __syncthreads();
    const bf16_t* Kt = dir == 0 ? KFt : KBt;
    bf16x8 af[4];
#pragma unroll
    for (int ks = 0; ks < 4; ++ks) af[ks] = *(const bf16x8*)(Kt + (dt * 16 + lr) * KV_S + ks * 32 + lq * 8);
#pragma unroll
    for (int et = 0; et < 8; ++et) {
#pragma unroll
      for (int ks = 0; ks < 4; ++ks) {
        const bf16x8 bfr = *(const bf16x8*)(Vt + (et * 16 + lr) * KV_S + ks * 32 + lq * 8);
        acc[et] = __builtin_amdgcn_mfma_f32_16x16x32_bf16(af[ks], bfr, acc[et], 0, 0, 0);
      }
    }
  }
  float* dst = dir == 0 ? dstF : dstB;
#pragma unroll
  for (int et = 0; et < 8; ++et) {
#pragma unroll
    for (int r = 0; r < 4; ++r) dst[(dt * 16 + 4 * lq + r) * 128 + et * 16 + lr] = acc[et][r];
  }
}

__device__ __forceinline__ void phase_ret_scan(const Params& p, int layer) {
  const float* misc = (const float*)(p.ws + OFF_MISC);
  float* rkv = (float*)(p.ws + OFF_RKV);
  const float* rs = (const float*)(p.ws + OFF_RS);
  const int gt = opaque_bid() * 512 + opaque_tid(), gs = gridDim.x * 512;
  for (int idx = gt; idx < 64 * 2048; idx += gs) {
    const int seq = idx >> 11, e4 = (idx & 2047) * 4;
    const int dir = seq & 1, h = (seq >> 1) & 3;
    const float cdec = __expf(misc[16 + layer * 8 + dir * 4 + h] * 128.f);
    float4* base = (float4*)(rkv + (size_t)seq * 32 * 8192 + e4);
    float4 v[32];
#pragma unroll
    for (int s = 0; s < 32; ++s) v[s] = base[(size_t)s * 2048];
    float4 st = *(const float4*)(rs + (size_t)seq * 8192 + e4);
    if (dir == 0) {
#pragma unroll
      for (int s = 0; s < 32; ++s) {
        const float4 t = v[s];
        base[(size_t)s * 2048] = st;
        st.x = fmaf(cdec, st.x, t.x); st.y = fmaf(cdec, st.y, t.y); st.z = fmaf(cdec, st.z, t.z); st.w = fmaf(cdec, st.w, t.w);
      }
    } else {
#pragma unroll
      for (int s = 31; s >= 0; --s) {
        const float4 t = v[s];
        base[(size_t)s * 2048] = st;
        st.x = fmaf(cdec, st.x, t.x); st.y = fmaf(cdec, st.y, t.y); st.z = fmaf(cdec, st.z, t.z); st.w = fmaf(cdec, st.w, t.w);
      }
    }
  }
}

constexpr int RT_KS = 72, RT_VS = 136;
constexpr int RT_OFF_K = 0, RT_OFF_VT = 128 * RT_KS * 2, RT_OFF_SF = RT_OFF_VT + 128 * RT_VS * 2, RT_OFF_SB = RT_OFF_SF + 128 * RT_KS * 2;
__device__ __forceinline__ void ret_out_item(const Params& p, int layer, int h, size_t krow0, int nkc, int iq0,
                                             const float* SF, const float* SB, int clen, char* smem) {
  const bf16_t* P = (const bf16_t*)(p.ws + OFF_P);
  bf16_t* Y = (bf16_t*)(p.ws + OFF_ACT);
  const float* misc = (const float*)(p.ws + OFF_MISC);
  const float lgF2 = misc[16 + layer * 8 + 0 * 4 + h] * 1.4426950408889634f, lgB2 = misc[16 + layer * 8 + 1 * 4 + h] * 1.4426950408889634f;
  const int tid = opaque_tid(), lane = tid & 63, wave = tid >> 6, lr = lane & 15, lq = lane >> 4;
  bf16_t* Ks = (bf16_t*)(smem + RT_OFF_K);
  bf16_t* Vt = (bf16_t*)(smem + RT_OFF_VT);
  bf16_t* SFt = (bf16_t*)(smem + RT_OFF_SF);
  bf16_t* SBt = (bf16_t*)(smem + RT_OFF_SB);
  const int iq = iq0 + wave * 16 + lr;
  const size_t mq = krow0 + iq;
  bf16x8 qf[2];
  {
    const bf16_t* qr = P + mq * INC + C_RTQ + h * 64 + lq * 8;
    qf[0] = *(const bf16x8*)(qr);
    qf[1] = *(const bf16x8*)(qr + 32);
  }
  f32x4 O[8];
#pragma unroll
  for (int i = 0; i < 8; ++i) O[i] = (f32x4){0.f, 0.f, 0.f, 0.f};
  if (SF != nullptr) {
    __syncthreads();
    {
      const int d = tid >> 3, e0 = (tid & 7) * 16;
#pragma unroll
      for (int c4 = 0; c4 < 4; ++c4) {
        const float4 a = *(const float4*)(SF + d * 128 + e0 + c4 * 4);
        const float4 bb = *(const float4*)(SB + d * 128 + e0 + c4 * 4);
        SFt[(e0 + c4 * 4 + 0) * RT_KS + d] = f2bf(a.x); SFt[(e0 + c4 * 4 + 1) * RT_KS + d] = f2bf(a.y);
        SFt[(e0 + c4 * 4 + 2) * RT_KS + d] = f2bf(a.z); SFt[(e0 + c4 * 4 + 3) * RT_KS + d] = f2bf(a.w);
        SBt[(e0 + c4 * 4 + 0) * RT_KS + d] = f2bf(bb.x); SBt[(e0 + c4 * 4 + 1) * RT_KS + d] = f2bf(bb.y);
        SBt[(e0 + c4 * 4 + 2) * RT_KS + d] = f2bf(bb.z); SBt[(e0 + c4 * 4 + 3) * RT_KS + d] = f2bf(bb.w);
      }
    }
    __syncthreads();
    const float cF = __builtin_amdgcn_exp2f(lgF2 * (float)(iq + 1)), cB = __builtin_amdgcn_exp2f(lgB2 * (float)(clen - iq));
#pragma unroll
    for (int ks = 0; ks < 2; ++ks)
#pragma unroll
      for (int et = 0; et < 8; ++et) {
        const bf16x8 sf = *(const bf16x8*)(SFt + (et * 16 + lr) * RT_KS + ks * 32 + lq * 8);
        O[et] = __builtin_amdgcn_mfma_f32_16x16x32_bf16(sf, qf[ks], O[et], 0, 0, 0);
      }
    const float ratio = cF / cB;
#pragma unroll
    for (int et = 0; et < 8; ++et) { O[et][0] *= ratio; O[et][1] *= ratio; O[et][2] *= ratio; O[et][3] *= ratio; }
#pragma unroll
    for (int ks = 0; ks < 2; ++ks)
#pragma unroll
      for (int et = 0; et < 8; ++et) {
        const bf16x8 sb = *(const bf16x8*)(SBt + (et * 16 + lr) * RT_KS + ks * 32 + lq * 8);
        O[et] = __builtin_amdgcn_mfma_f32_16x16x32_bf16(sb, qf[ks], O[et], 0, 0, 0);
      }
#pragma unroll
    for (int et = 0; et < 8; ++et) { O[et][0] *= cB; O[et][1] *= cB; O[et][2] *= cB; O[et][3] *= cB; }
  }
#pragma unroll 1
  for (int kc = 0; kc < nkc; ++kc) {
    __syncthreads();
    {
      const int key = tid >> 2, c = tid & 3;
      const bf16_t* rowp = P + (krow0 + kc * 128 + key) * INC;
      const uint4 k0 = *(const uint4*)(rowp + C_RTK + h * 64 + c * 16), k1 = *(const uint4*)(rowp + C_RTK + h * 64 + c * 16 + 8);
      *(uint4*)(Ks + key * RT_KS + c * 16) = k0;
      *(uint4*)(Ks + key * RT_KS + c * 16 + 8) = k1;
#pragma unroll
      for (int c8 = 0; c8 < 4; ++c8) {
        const uint4 uv = *(const uint4*)(rowp + C_RTV + h * 128 + c * 32 + c8 * 8);
        vt_store8(Vt, RT_VS, c * 32 + c8 * 8, key, uv);
      }
    }
    __syncthreads();
    f32x4 S[8];
#pragma unroll
    for (int kt = 0; kt < 8; ++kt) {
      const bf16x8 ka = *(const bf16x8*)(Ks + (kt * 16 + lr) * RT_KS + lq * 8);
      const bf16x8 kb = *(const bf16x8*)(Ks + (kt * 16 + lr) * RT_KS + 32 + lq * 8);
      const f32x4 a = __builtin_amdgcn_mfma_f32_16x16x32_bf16(ka, qf[0], (f32x4){0.f, 0.f, 0.f, 0.f}, 0, 0, 0);
      S[kt] = __builtin_amdgcn_mfma_f32_16x16x32_bf16(kb, qf[1], a, 0, 0, 0);
    }
#pragma unroll
    for (int kt = 0; kt < 8; ++kt) {
#pragma unroll
      for (int r = 0; r < 4; ++r) {
        const int df = iq - (kc * 128 + kt * 16 + 4 * lq + r);
        const float fdf = (float)df;
        float coef = 0.f;
        if (df >= 0) coef += __builtin_amdgcn_exp2f(lgF2 * fdf);
        if (df <= 0) coef += __builtin_amdgcn_exp2f(-lgB2 * fdf);
        S[kt][r] *= coef;
      }
    }
#pragma unroll
    for (int g = 0; g < 4; ++g) {
      union { unsigned u[4]; bf16x8 v; } pf;
      pf.u[0] = cvt_pk_bf16(S[2 * g][0], S[2 * g][1]); pf.u[1] = cvt_pk_bf16(S[2 * g][2], S[2 * g][3]);
      pf.u[2] = cvt_pk_bf16(S[2 * g + 1][0], S[2 * g + 1][1]); pf.u[3] = cvt_pk_bf16(S[2 * g + 1][2], S[2 * g + 1][3]);
#pragma unroll
      for (int et = 0; et < 8; ++et) {
        union { uint2 h2[2]; bf16x8 v; } vf;
        vf.h2[0] = *(const uint2*)(Vt + (et * 16 + lr) * RT_VS + 32 * g + 4 * lq);
        vf.h2[1] = *(const uint2*)(Vt + (et * 16 + lr) * RT_VS + 32 * g + 16 + 4 * lq);
        O[et] = __builtin_amdgcn_mfma_f32_16x16x32_bf16(vf.v, pf.v, O[et], 0, 0, 0);
      }
    }
  }
  float ss = 0.f;
#pragma unroll
  for (int et = 0; et < 8; ++et) { ss = fmaf(O[et][0], O[et][0], ss); ss = fmaf(O[et][1], O[et][1], ss); ss = fmaf(O[et][2], O[et][2], ss); ss = fmaf(O[et][3], O[et][3], ss); }
  ss += __shfl_xor(ss, 16); ss += __shfl_xor(ss, 32);
  const float rr = rsqrtf(ss * (1.f / 128.f) + EPS);
  const bf16_t* gp = P + mq * INC + C_RTG + h * 128;
  bf16_t* dst = Y + mq * 1024 + Y_RT + h * 128;
#pragma unroll
  for (int et = 0; et < 8; ++et) {
    const int e = et * 16 + 4 * lq;
    const uint2 gu = *(const uint2*)(gp + e);
    uint2 ov;
    ov.x = pack2(O[et][0] * rr * siluf(lo16(gu.x)), O[et][1] * rr * siluf(hi16(gu.x)));
    ov.y = pack2(O[et][2] * rr * siluf(lo16(gu.y)), O[et][3] * rr * siluf(hi16(gu.y)));
    *(uint2*)(dst + e) = ov;
  }
}

__device__ __forceinline__ void uv_convert_item(const Params& p, int item) {
  char* ws = p.ws;
  const int tid = opaque_tid();
  const int lane = tid & 63, l = lane & 31, half = lane >> 5, wave = tid >> 6;
#pragma unroll 1
  for (int it = 0; it < 16; ++it) {
    const int row = item * 256 + (wave * 16 + it) * 2 + half;
    const bool isv = row >= 2 * NEXP;
    const int rr = isv ? row - 2 * NEXP : row;
    const float* srow = (isv ? p.peer_v : p.peer_u) + (size_t)rr * 1024;
    float4 v[8];
    float mx = 0.f;
#pragma unroll
    for (int j = 0; j < 8; ++j) {
      v[j] = ((const float4*)srow)[l + 32 * j];
      mx = fmaxf(mx, fmaxf(fmaxf(fabsf(v[j].x), fabsf(v[j].y)), fmaxf(fabsf(v[j].z), fabsf(v[j].w))));
    }
#pragma unroll
    for (int o = 1; o < 32; o <<= 1) mx = fmaxf(mx, __shfl_xor(mx, o));
    const float scale = mx > 0.f ? mx * (1.f / 7.5f) : 1.f;
    const float inv = 1.f / scale;
    if (!isv) {
      unsigned w[6] = {0u, 0u, 0u, 0u, 0u, 0u};
#pragma unroll
      for (int k = 0; k < 32; ++k) {
        const float xv = (k & 3) == 0 ? v[k >> 2].x : (k & 3) == 1 ? v[k >> 2].y : (k & 3) == 2 ? v[k >> 2].z : v[k >> 2].w;
        const float a = fminf(fabsf(xv) * inv, 7.5f);
        float c;
        if (a < 2.f) c = rintf(a * 8.f);
        else if (a < 4.f) c = 16.f + rintf((a - 2.f) * 4.f);
        else c = 24.f + rintf((a - 4.f) * 2.f);
        unsigned code = (unsigned)c;
        code = code > 31u ? 31u : code;
        code |= (xv < 0.f) ? 32u : 0u;
        const int bit = 6 * k, wd = bit >> 5, sh = bit & 31;
        w[wd] |= code << sh;
        if (sh > 26) w[wd + 1] |= code >> (32 - sh);
      }
      char* drow = ws + OFF_U + (size_t)rr * RECB + l * 24;
      *(uint2*)(drow) = make_uint2(w[0], w[1]);
      *(uint2*)(drow + 8) = make_uint2(w[2], w[3]);
      *(uint2*)(drow + 16) = make_uint2(w[4], w[5]);
      if (l == 0) ((float*)(ws + OFF_USC))[rr] = scale;
    } else {
      const float scale4 = mx > 0.f ? mx * (1.f / 6.f) : 1.f;
      const float inv4 = 1.f / scale4;
      unsigned w[4] = {0u, 0u, 0u, 0u};
#pragma unroll
      for (int k = 0; k < 32; ++k) {
        const float xv = (k & 3) == 0 ? v[k >> 2].x : (k & 3) == 1 ? v[k >> 2].y : (k & 3) == 2 ? v[k >> 2].z : v[k >> 2].w;
        const float a = fminf(fabsf(xv) * inv4, 6.f);
        float c;
        if (a < 2.f) c = rintf(a * 2.f);
        else if (a < 4.f) c = 4.f + rintf(a - 2.f);
        else c = 6.f + rintf((a - 4.f) * 0.5f);
        unsigned code = (unsigned)c;
        code = code > 7u ? 7u : code;
        code |= (xv < 0.f) ? 8u : 0u;
        w[k >> 3] |= code << (4 * (k & 7));
      }
      char* drow = ws + OFF_U + (size_t)rr * RECB + ROWB + l * 16;
      *(uint4*)(drow) = make_uint4(w[0], w[1], w[2], w[3]);
      if (l == 0) ((float*)(ws + OFF_VSC))[rr] = scale4;
    }
  }
}

__device__ __forceinline__ void phase_mix1(const Params& p, int layer, char* smem, int slot = 0) {
  unsigned* ctr = (unsigned*)(p.ws + OFF_CTL) + (layer * 4 + slot);
  const bool nc = layer == 0;
  const int n_dl = 512, n_dc = nc ? 32 : 0, n_nl = 2048, n_ncx = nc ? 64 : 0, n_kv = 1024, n_cs = 32;
  const int total = n_dl + n_dc + n_nl + n_ncx + n_kv + n_cs;
  float* rkv = (float*)(p.ws + OFF_RKV);
  float* rs = (float*)(p.ws + OFF_RS);
  for (;;) {
    int it = next_item(ctr, smem);
    if (it >= total) break;
    if (it < n_dl) { diff_item(p, layer, false, it, smem); continue; } it -= n_dl;
    if (it < n_dc) { diff_item(p, layer, true, it, smem); continue; } it -= n_dc;
    if (it < n_nl) { na_latent_item(p, layer, it, smem); continue; } it -= n_nl;
    if (it < n_ncx) { na_ctx_item(p, it, smem); continue; } it -= n_ncx;
    if (it < n_kv) {
      const int bh = it >> 5, n = it & 31, b = bh >> 2, h = bh & 3;
      ret_kv_item(p, layer, h, (size_t)b * 4096 + n * 128, 128,
                  rkv + ((size_t)(bh * 2 + 0) * 32 + n) * 8192, rkv + ((size_t)(bh * 2 + 1) * 32 + n) * 8192, smem);
      continue;
    }
    it -= n_kv;
    {
      const int bh = it, b = bh >> 2, h = bh & 3;
      ret_kv_item(p, layer, h, (size_t)NLAT + b * 256, 256, rs + (size_t)(bh * 2 + 0) * 8192, rs + (size_t)(bh * 2 + 1) * 8192, smem);
    }
  }
}

__device__ __forceinline__ void phase_mix2(const Params& p, int layer, char* smem, int slot = 1) {
  unsigned* ctr = (unsigned*)(p.ws + OFF_CTL) + (layer * 4 + slot);
  const int n_l = 1024, n_c = layer == 0 ? 64 : 0;
  const float* rkv = (const float*)(p.ws + OFF_RKV);
  for (;;) {
    int it = next_item(ctr, smem);
    if (it >= n_l + n_c) break;
    if (it < n_l) {
      const int bh = it >> 5, n = it & 31, b = bh >> 2, h = bh & 3;
      ret_out_item(p, layer, h, (size_t)b * 4096 + n * 128, 1, 0,
                   rkv + ((size_t)(bh * 2 + 0) * 32 + n) * 8192, rkv + ((size_t)(bh * 2 + 1) * 32 + n) * 8192, 128, smem);
    } else {
      it -= n_l;
      const int bh = it >> 1, half = it & 1, b = bh >> 2, h = bh & 3;
      ret_out_item(p, layer, h, (size_t)NLAT + b * 256, 2, half * 128, nullptr, nullptr, 256, smem);
    }
  }
}

typedef float f32x2 __attribute__((ext_vector_type(2)));
__device__ __forceinline__ unsigned sortable_key(float f, int idx) {
  const unsigned b = __float_as_uint(f);
  const unsigned k = b ^ ((unsigned)((int)b >> 31) | 0x80000000u);
  return (k & ~127u) | (unsigned)(127 - idx);
}
__device__ __forceinline__ float key_value(unsigned k) {
  k &= ~127u;
  const unsigned b = (k & 0x80000000u) ? (k ^ 0x80000000u) : ~k;
  return __uint_as_float(b);
}
#define FP8DOT(acc, H, off, W) { const f32x2 _a = __builtin_amdgcn_cvt_pk_f32_fp8((int)(W), false), _b = __builtin_amdgcn_cvt_pk_f32_fp8((int)(W), true); \
  acc = fmaf(H[(off) + 0], _a.x, acc); acc = fmaf(H[(off) + 1], _a.y, acc); acc = fmaf(H[(off) + 2], _b.x, acc); acc = fmaf(H[(off) + 3], _b.y, acc); }
#define FP8AXPY(O, off, P, W) { const f32x2 _a = __builtin_amdgcn_cvt_pk_f32_fp8((int)(W), false), _b = __builtin_amdgcn_cvt_pk_f32_fp8((int)(W), true); \
  O[(off) + 0] = fmaf(P, _a.x, O[(off) + 0]); O[(off) + 1] = fmaf(P, _a.y, O[(off) + 1]); O[(off) + 2] = fmaf(P, _b.x, O[(off) + 2]); O[(off) + 3] = fmaf(P, _b.y, O[(off) + 3]); }

__device__ __forceinline__ float gelu_erf(float a) {
  const float x = fabsf(a) * 0.70710678118654752f;
  const float t = __builtin_amdgcn_rcpf(fmaf(0.3275911f, x, 1.f));
  float pl = fmaf(1.061405429f, t, -1.453152027f);
  pl = fmaf(pl, t, 1.421413741f); pl = fmaf(pl, t, -0.284496736f); pl = fmaf(pl, t, 0.254829592f);
  const float y = 1.f - pl * t * __builtin_amdgcn_exp2f(-x * x * 1.4426950408889634f);
  const float er = a < 0.f ? -y : y;
  return 0.5f * a * (1.f + er);
}
constexpr int PE_SVS = 132;
constexpr int PE_OFF_SV = 0;
constexpr int PE_OFF_TV = 8 * 16 * PE_SVS * 4;
constexpr int PE_OFF_TI = PE_OFF_TV + 16 * 16 * 16 * 4;
constexpr int PE_OFF_EX = PE_OFF_TI + 16 * 16 * 16 * 4;
constexpr int PE_OFF_GT = PE_OFF_EX + 1 * 16 * 128 * 4;
constexpr int PE_OFF_SU = PE_OFF_GT + 1 * 16 * 128 * 4;
constexpr int PE_OFF_CN = PE_OFF_SU + 1 * 16 * 128 * 4;
constexpr int PE_OFF_CT = PE_OFF_CN + 8 * 16 * 4;
#define WAVE_LDS_FENCE() asm volatile("s_waitcnt lgkmcnt(0)" ::: "memory")

__device__ __forceinline__ void peer_select_head(const Params& p, int layer, char* smem, int tok0, int hd, int sw, int buf,
                                                 int lane) {
  const bf16_t* Q = (const bf16_t*)(p.ws + OFF_P);
  const bf16_t* SK = (const bf16_t*)(p.ws + OFF_SUBK) + (size_t)layer * 262144;
  const int lr = lane & 15, lq = lane >> 4;
  unsigned* SV = (unsigned*)(smem + PE_OFF_SV) + sw * 16 * PE_SVS;
  float* TV = (float*)(smem + PE_OFF_TV);
  int* TI = (int*)(smem + PE_OFF_TI);
  int* EX = (int*)(smem + PE_OFF_EX) + buf * 16 * 128;
  float* GT = (float*)(smem + PE_OFF_GT) + buf * 16 * 128;
  int* CN = (int*)(smem + PE_OFF_CN) + sw * 16;
  float* SU = (float*)(smem + PE_OFF_SU) + buf * 16 * 128;
  const float* USC = (const float*)(p.ws + OFF_USC) + layer * NEXP;
  const float* VSC = (const float*)(p.ws + OFF_VSC) + layer * NEXP;
#pragma unroll 1
  for (int pp = 0; pp < 2; ++pp) {
    bf16x8 af[4];
    const bf16_t* qrow = Q + (size_t)(tok0 + lr) * 2048 + hd * 256 + pp * 128;
#pragma unroll
    for (int ks = 0; ks < 4; ++ks) af[ks] = *(const bf16x8*)(qrow + ks * 32 + lq * 8);
    const bf16_t* skb = SK + (size_t)((hd * 2 + pp) * 128) * 128;
    f32x4 acc[8];
    {
      bf16x8 bfr[8][4];
#pragma unroll
      for (int nt = 0; nt < 8; ++nt)
#pragma unroll
        for (int ks = 0; ks < 4; ++ks)
          bfr[nt][ks] = *(const bf16x8*)(skb + (size_t)(nt * 16 + lr) * 128 + ks * 32 + lq * 8);
#pragma unroll
      for (int nt = 0; nt < 8; ++nt) {
        f32x4 a = (f32x4){0.f, 0.f, 0.f, 0.f};
#pragma unroll
        for (int ks = 0; ks < 4; ++ks) a = __builtin_amdgcn_mfma_f32_16x16x32_bf16(af[ks], bfr[nt][ks], a, 0, 0, 0);
        acc[nt] = a;
      }
    }
#pragma unroll
    for (int i = 0; i < 9; ++i) { const int q4 = lane + 64 * i; if (q4 < 16 * PE_SVS / 4) ((uint4*)SV)[q4] = make_uint4(0u, 0u, 0u, 0u); }
    WAVE_LDS_FENCE();
#pragma unroll
    for (int r = 0; r < 4; ++r) {
      const int tk = 4 * lq + r;
      unsigned k[8];
#pragma unroll
      for (int nt = 0; nt < 8; ++nt) k[nt] = sortable_key(acc[nt][r], nt * 16 + lr);
      unsigned m1 = max(k[0], k[1]), m2 = min(k[0], k[1]);
#pragma unroll
      for (int nt = 2; nt < 8; ++nt) { m2 = max(m2, min(m1, k[nt])); m1 = max(m1, k[nt]); }
      const unsigned Ta = row16_min_u32(m1);
      const unsigned Tb = min(row16_kth_largest<11>(m1), row16_kth_largest<5>(m2));
      const unsigned T = max(Ta, Tb);
      int pos = 0;
#pragma unroll
      for (int nt = 0; nt < 8; ++nt) {
        const bool sel = k[nt] >= T;
        const unsigned long long bal = __ballot(sel);
        const unsigned grp16 = (unsigned)(bal >> (16 * lq)) & 0xffffu;
        const int below = __popc(grp16 & ((1u << lr) - 1u));
        if (sel) SV[tk * PE_SVS + pos + below] = k[nt];
        pos += __popc(grp16);
      }
      if (lr == 0) CN[tk] = pos;
    }
    WAVE_LDS_FENCE();
#pragma unroll 1
    for (int pass = 0; pass < 4; ++pass) {
      const int tk = pass * 4 + lq;
      const int cnt = CN[tk];
      const unsigned* row = SV + tk * PE_SVS;
      int cm = cnt;
      cm = max(cm, __shfl_xor(cm, 16)); cm = max(cm, __shfl_xor(cm, 32));
      const int cmax = __builtin_amdgcn_readfirstlane(cm);
      const int nblk = (cmax + 15) >> 4;
#pragma unroll 1
      for (int rd = 0; rd < nblk; ++rd) {
        const int j = rd * 16 + lr;
        const unsigned my = row[j];
        int rank = 0;
#pragma unroll 1
        for (int b4 = 0; b4 < nblk; ++b4) {
          const uint4 v0 = *(const uint4*)(row + b4 * 16), v1 = *(const uint4*)(row + b4 * 16 + 4);
          const uint4 v2 = *(const uint4*)(row + b4 * 16 + 8), v3 = *(const uint4*)(row + b4 * 16 + 12);
          rank += (v0.x > my) ? 1 : 0; rank += (v0.y > my) ? 1 : 0; rank += (v0.z > my) ? 1 : 0; rank += (v0.w > my) ? 1 : 0;
          rank += (v1.x > my) ? 1 : 0; rank += (v1.y > my) ? 1 : 0; rank += (v1.z > my) ? 1 : 0; rank += (v1.w > my) ? 1 : 0;
          rank += (v2.x > my) ? 1 : 0; rank += (v2.y > my) ? 1 : 0; rank += (v2.z > my) ? 1 : 0; rank += (v2.w > my) ? 1 : 0;
          rank += (v3.x > my) ? 1 : 0; rank += (v3.y > my) ? 1 : 0; rank += (v3.z > my) ? 1 : 0; rank += (v3.w > my) ? 1 : 0;
        }
        if (j < cnt && rank < 16) {
          TV[(tk * 16 + hd * 2 + pp) * 16 + rank] = key_value(my);
          TI[(tk * 16 + hd * 2 + pp) * 16 + rank] = 127 - (int)(my & 127u);
        }
      }
    }
    WAVE_LDS_FENCE();
  }
  {
    const int cab = ((const int*)(smem + PE_OFF_CT))[lane];
    const int cand_a = cab >> 4, cand_b = cab & 15;
    unsigned* CWt = SV;
    float vals[16];
#pragma unroll
    for (int tk = 0; tk < 16; ++tk) {
      float val = 0.f;
      unsigned key = 0u;
      if (cand_a >= 0) {
        val = TV[(tk * 16 + hd * 2 + 0) * 16 + cand_a] + TV[(tk * 16 + hd * 2 + 1) * 16 + cand_b];
        const unsigned bb = __float_as_uint(val);
        key = ((bb ^ ((unsigned)((int)bb >> 31) | 0x80000000u)) & ~63u) | (unsigned)(63 - lane);
      }
      vals[tk] = val;
      CWt[tk * 64 + lane] = key;
    }
    WAVE_LDS_FENCE();
#pragma unroll
    for (int tk = 0; tk < 16; ++tk) {
      const unsigned key = CWt[tk * 64 + lane];
      int rank = 0;
#pragma unroll
      for (int i4 = 0; i4 < 13; ++i4) {
        const uint4 v = *(const uint4*)(CWt + tk * 64 + i4 * 4);
        rank += (v.x > key) ? 1 : 0; rank += (v.y > key) ? 1 : 0; rank += (v.z > key) ? 1 : 0; rank += (v.w > key) ? 1 : 0;
      }
      if (cand_a >= 0 && rank < 16) {
        GT[tk * 128 + hd * 16 + rank] = vals[tk];
        EX[tk * 128 + hd * 16 + rank] = TI[(tk * 16 + hd * 2 + 0) * 16 + cand_a] * 128 + TI[(tk * 16 + hd * 2 + 1) * 16 + cand_b];
      }
    }
    WAVE_LDS_FENCE();
#pragma unroll
    for (int pass = 0; pass < 4; ++pass) {
      const int tk = pass * 4 + lq;
      const float g = GT[tk * 128 + hd * 16 + lr];
      const float mx = GT[tk * 128 + hd * 16];
      const float ev = __expf(g - mx);
      float s = ev;
      s += __shfl_xor(s, 1); s += __shfl_xor(s, 2); s += __shfl_xor(s, 4); s += __shfl_xor(s, 8);
      const int ex = EX[tk * 128 + hd * 16 + lr];
      GT[tk * 128 + hd * 16 + lr] = (ev / s) * VSC[ex];
      SU[tk * 128 + hd * 16 + lr] = USC[ex];
    }
    WAVE_LDS_FENCE();
  }
}

typedef float f32x32 __attribute__((ext_vector_type(32)));
typedef unsigned u32x6 __attribute__((ext_vector_type(6)));
#define FP4_AXPY8(O, off, P, W) {                                                                    \
  const f32x2 _q0 = __builtin_amdgcn_cvt_scalef32_pk_f32_fp4((W), 1.0f, 0), _q1 = __builtin_amdgcn_cvt_scalef32_pk_f32_fp4((W), 1.0f, 1); \
  const f32x2 _q2 = __builtin_amdgcn_cvt_scalef32_pk_f32_fp4((W), 1.0f, 2), _q3 = __builtin_amdgcn_cvt_scalef32_pk_f32_fp4((W), 1.0f, 3); \
  O[(off) + 0] = fmaf(P, _q0.x, O[(off) + 0]); O[(off) + 1] = fmaf(P, _q0.y, O[(off) + 1]);          \
  O[(off) + 2] = fmaf(P, _q1.x, O[(off) + 2]); O[(off) + 3] = fmaf(P, _q1.y, O[(off) + 3]);          \
  O[(off) + 4] = fmaf(P, _q2.x, O[(off) + 4]); O[(off) + 5] = fmaf(P, _q2.y, O[(off) + 5]);          \
  O[(off) + 6] = fmaf(P, _q3.x, O[(off) + 6]); O[(off) + 7] = fmaf(P, _q3.y, O[(off) + 7]); }
struct Fp6Row { uint4 a; uint2 b; };
__device__ __forceinline__ f32x32 fp6_decode(const Fp6Row& r) {
  u32x6 w; w[0] = r.a.x; w[1] = r.a.y; w[2] = r.a.z; w[3] = r.a.w; w[4] = r.b.x; w[5] = r.b.y;
  return __builtin_amdgcn_cvt_scalef32_pk32_f32_fp6(w, 1.0f);
}
__device__ __forceinline__ void peer_gather_token(const Params& p, int layer, char* smem, int tok, int tl, int buf, int lane, bool dowrite) {
  const bf16_t* H2 = (const bf16_t*)(p.ws + OFF_ACT);
  const char* U6 = p.ws + OFF_U + (size_t)layer * NEXP * RECB;
  const float* mod = (const float*)(p.ws + OFF_MOD) + (size_t)layer * 9 * 6144;
  const int* EX = (const int*)(smem + PE_OFF_EX) + buf * 16 * 128 + tl * 128;
  const float* GT = (const float*)(smem + PE_OFF_GT) + buf * 16 * 128 + tl * 128;
  const float* SU = (const float*)(smem + PE_OFF_SU) + buf * 16 * 128 + tl * 128;
  const int l = lane & 31, hf = lane >> 5;
  float hv[32], acc[32];
  {
    const bf16_t* hr = H2 + (size_t)tok * 1024;
#pragma unroll
    for (int j = 0; j < 8; ++j) {
      const uint2 u = *(const uint2*)(hr + (l + 32 * j) * 4);
      hv[4 * j + 0] = lo16(u.x); hv[4 * j + 1] = hi16(u.x); hv[4 * j + 2] = lo16(u.y); hv[4 * j + 3] = hi16(u.y);
    }
  }
#pragma unroll
  for (int i = 0; i < 32; ++i) acc[i] = 0.f;
  Fp6Row ua[2], ub[2];
  uint4 va[2], vb[2];
  int one = 1;
  asm volatile("" : "+s"(one));
#define PE_LOAD_SET(UU, VV, E0)                                                       \
  _Pragma("unroll") for (int j = 0; j < 2; ++j) {                                     \
    const int ex = EX[(E0) + 2 * j + hf];                                             \
    const char* up = U6 + (size_t)ex * RECB + l * 24;                                 \
    UU[j].a = *(const uint4*)up; UU[j].b = *(const uint2*)(up + 16);                  \
    VV[j] = *(const uint4*)(U6 + (size_t)ex * RECB + ROWB + l * 16);                  \
  }
#define PE_USE_SET(UU, VV, E0)                                                        \
  _Pragma("unroll 1") for (int rep_ = 0; rep_ < one; ++rep_) {                        \
  _Pragma("unroll") for (int j = 0; j < 2; ++j) {                                     \
    const f32x32 du = fp6_decode(UU[j]);                                              \
    float d0 = 0.f, d1 = 0.f, d2 = 0.f, d3 = 0.f;                                     \
    _Pragma("unroll") for (int k = 0; k < 32; k += 4) {                               \
      d0 = fmaf(hv[k], du[k], d0); d1 = fmaf(hv[k + 1], du[k + 1], d1); d2 = fmaf(hv[k + 2], du[k + 2], d2); d3 = fmaf(hv[k + 3], du[k + 3], d3); \
    }                                                                                 \
    const float r16 = row16_sum((d0 + d1) + (d2 + d3));                               \
    const int ir = __float_as_int(r16);                                               \
    const float s0 = __int_as_float(__builtin_amdgcn_readlane(ir, 0)) + __int_as_float(__builtin_amdgcn_readlane(ir, 16));  \
    const float s1 = __int_as_float(__builtin_amdgcn_readlane(ir, 32)) + __int_as_float(__builtin_amdgcn_readlane(ir, 48)); \
    const float d = (hf ? s1 : s0) * SU[(E0) + 2 * j + hf];                           \
    const float w = GT[(E0) + 2 * j + hf] * gelu_erf(d);                              \
    FP4_AXPY8(acc, 0, w, VV[j].x) FP4_AXPY8(acc, 8, w, VV[j].y) FP4_AXPY8(acc, 16, w, VV[j].z) FP4_AXPY8(acc, 24, w, VV[j].w) \
  } }
  PE_LOAD_SET(ua, va, 0)
#pragma unroll 1
  for (int e0 = 0; e0 < 120; e0 += 8) {
    PE_LOAD_SET(ub, vb, e0 + 4)
    PE_USE_SET(ua, va, e0)
    PE_LOAD_SET(ua, va, e0 + 8)
    PE_USE_SET(ub, vb, e0 + 4)
  }
  PE_LOAD_SET(ub, vb, 124)
  PE_USE_SET(ua, va, 120)
  PE_USE_SET(ub, vb, 124)
#pragma unroll
  for (int k = 0; k < 32; ++k) acc[k] += __shfl_xor(acc[k], 32);
  const int b = tok < NLAT ? (tok >> 12) : 8;
  float* xr = tok < NLAT ? p.out + (size_t)tok * 1024 : (float*)(p.ws + OFF_CTXB) + (size_t)(tok - NLAT) * 1024;
  const float* gate = mod + (size_t)b * 6144 + 5 * 1024;
  float4 xn[4];
  float ss = 0.f;
#pragma unroll
  for (int jj = 0; jj < 4; ++jj) {
    const int c = (l + 32 * (4 * hf + jj)) * 4;
    const float4 xv = *(const float4*)(xr + c);
    const float4 gv = *(const float4*)(gate + c);
    const float a0 = hf ? acc[16 + 4 * jj + 0] : acc[4 * jj + 0], a1 = hf ? acc[16 + 4 * jj + 1] : acc[4 * jj + 1];
    const float a2 = hf ? acc[16 + 4 * jj + 2] : acc[4 * jj + 2], a3 = hf ? acc[16 + 4 * jj + 3] : acc[4 * jj + 3];
    xn[jj].x = xv.x + gv.x * a0; xn[jj].y = xv.y + gv.y * a1; xn[jj].z = xv.z + gv.z * a2; xn[jj].w = xv.w + gv.w * a3;
    ss += xn[jj].x * xn[jj].x + xn[jj].y * xn[jj].y + xn[jj].z * xn[jj].z + xn[jj].w * xn[jj].w;
  }
  ss = wave_sum(ss);
  const float rinv = rsqrtf(ss * (1.f / 1024.f) + EPS);
  if (layer == 0) {
    const float* mod1 = (const float*)(p.ws + OFF_MOD) + (size_t)9 * 6144 + (size_t)b * 6144;
    const float* g1 = p.norm1_g + 1024;
    bf16_t* act = (bf16_t*)(p.ws + OFF_ACT) + (size_t)tok * 1024;
#pragma unroll
    for (int jj = 0; jj < 4; ++jj) {
      const int c = (l + 32 * (4 * hf + jj)) * 4;
      if (dowrite) *(float4*)(xr + c) = xn[jj]; else asm volatile("" :: "v"(xn[jj].x), "v"(xn[jj].y), "v"(xn[jj].z), "v"(xn[jj].w));
      const float4 gg4 = *(const float4*)(g1 + c);
      const float4 sh = *(const float4*)(mod1 + c);
      const float4 sc = *(const float4*)(mod1 + 1024 + c);
      uint2 o;
      o.x = pack2h(xn[jj].x * rinv * gg4.x * (1.f + sc.x) + sh.x, xn[jj].y * rinv * gg4.y * (1.f + sc.y) + sh.y);
      o.y = pack2h(xn[jj].z * rinv * gg4.z * (1.f + sc.z) + sh.z, xn[jj].w * rinv * gg4.w * (1.f + sc.w) + sh.w);
      if (dowrite) *(uint2*)(act + c) = o; else asm volatile("" :: "v"(o.x), "v"(o.y));
    }
  } else {
#pragma unroll
    for (int jj = 0; jj < 4; ++jj) {
      const int c = (l + 32 * (4 * hf + jj)) * 4;
      const float4 gg4 = *(const float4*)(p.final_g + c);
      float4 o;
      o.x = xn[jj].x * rinv * gg4.x; o.y = xn[jj].y * rinv * gg4.y; o.z = xn[jj].z * rinv * gg4.z; o.w = xn[jj].w * rinv * gg4.w;
      if (dowrite) *(float4*)(xr + c) = o; else asm volatile("" :: "v"(o.x), "v"(o.y), "v"(o.z), "v"(o.w));
    }
  }
}

__device__ __forceinline__ void phase_peer(const Params& p, int layer, char* smem, int ntok, bool dowrite = true) {
  const int tid = opaque_tid(), lane = tid & 63, wave = __builtin_amdgcn_readfirstlane(tid >> 6);
  __syncthreads();
  if (tid < 64) {
    int cab = -1, c = 0;
    for (int a = 0; a < 16; ++a)
      for (int bb = 0; bb < 16; ++bb)
        if ((a + 1) * (bb + 1) <= 16) { if (c == tid) cab = a * 16 + bb; ++c; }
    ((int*)(smem + PE_OFF_CT))[tid] = cab;
  }
  const int ngroups = ntok / 16, G = gridDim.x, g0 = opaque_bid();
  __syncthreads();
  for (int grp = g0; grp < ngroups; grp += G) {
    peer_select_head(p, layer, smem, grp * 16, wave, wave, 0, lane);
    __syncthreads();
#pragma unroll 1
    for (int tt = 0; tt < 2; ++tt) peer_gather_token(p, layer, smem, grp * 16 + wave * 2 + tt, wave * 2 + tt, 0, lane, dowrite);
    __syncthreads();
  }
}

template <int layer>
__device__ __forceinline__ void layer_body(const Params& p, char* smem, const XcdBarrier& xb) {
  constexpr bool nc = layer == 0;
  const float* xin = layer == 0 ? p.x : (const float*)p.out;
  if (layer == 0) {
    phase_norm(p, layer, 0, xin, NTOK);
    xcd_barrier(xb);
  }
#if REP_GEMM
  gemm_phase2<EPI_INPROJ>(p, layer, smem, (const bf16_t*)(p.ws + OFF_ACT), (const bf16_t*)(p.ws + OFF_WIN) + (size_t)layer * 3072 * 1024, NTOK, 3072, nullptr);
  xcd_barrier(xb);
#endif
  gemm_phase2<EPI_INPROJ>(p, layer, smem, (const bf16_t*)(p.ws + OFF_ACT), (const bf16_t*)(p.ws + OFF_WIN) + (size_t)layer * 3072 * 1024, NTOK, 3072, nullptr);
  xcd_barrier(xb);
#if REP_MIX1
  phase_mix1(p, layer, smem, 2);
  xcd_barrier(xb);
#endif
  phase_mix1(p, layer, smem);
  xcd_barrier(xb);
  phase_ret_scan(p, layer);
  xcd_barrier(xb);
#if REP_MIX2
  phase_mix2(p, layer, smem, 3);
  xcd_barrier(xb);
#endif
  phase_mix2(p, layer, smem);
  xcd_barrier(xb);
  gemm_phase2<EPI_OUTPROJ>(p, layer, smem, (const bf16_t*)(p.ws + OFF_ACT), (const bf16_t*)(p.ws + OFF_WOUT) + (size_t)layer * 1024 * 1024, nc ? NTOK : NLAT, 1024, xin);
  xcd_barrier(xb);
  phase_norm(p, layer, 1, (const float*)p.out, nc ? NTOK : NLAT);
  xcd_barrier(xb);
  gemm_phase2<EPI_PLAIN>(p, layer, smem, (const bf16_t*)(p.ws + OFF_ACT), (const bf16_t*)(p.ws + OFF_WQ) + (size_t)layer * 2048 * 1024, nc ? NTOK : NLAT, 2048, nullptr);
  xcd_barrier(xb);
#if REP_PEER
  phase_peer(p, layer, smem, nc ? NTOK : NLAT, false);
  xcd_barrier(xb);
#endif
  phase_peer(p, layer, smem, nc ? NTOK : NLAT);
  if (layer == 0) xcd_barrier(xb);
}

__global__ void __launch_bounds__(512) fwd_megakernel(Params p) {
  cg::grid_group grid = cg::this_grid();
  extern __shared__ __attribute__((aligned(16))) char smem[];
  volatile LAS3 unsigned* xst = (volatile LAS3 unsigned*)(smem + LDS_BCAST + 8);
  if (threadIdx.x == 0) { xst[0] = 0u; xst[1] = 0u; }
  phase_prep(p, smem);
  for (int it = blockIdx.x; it < 256; it += gridDim.x) uv_convert_item(p, it);
  grid.sync();
  const XcdBarrier xb = xcd_barrier_post((unsigned*)(p.ws + OFF_XBAR), xst);
  layer_body<0>(p, smem, xb);
  layer_body<1>(p, smem, xb);
}

extern "C" void kernel_launch(void* const* d_in, const int* in_sizes, int n_in, void* d_out,
                              int out_size, void* d_ws, size_t ws_size, hipStream_t stream) {
  constexpr size_t kDynLds = LDS_BYTES;
  static int grid_blocks = 0;
  if (!grid_blocks) {
    int dev = 0, cus = 0, per_cu = 0;
    (void)hipGetDevice(&dev);
    (void)hipDeviceGetAttribute(&cus, hipDeviceAttributeMultiprocessorCount, dev);
    (void)hipFuncSetAttribute((const void*)fwd_megakernel, hipFuncAttributeMaxDynamicSharedMemorySize, (int)kDynLds);
    (void)hipOccupancyMaxActiveBlocksPerMultiprocessor(&per_cu, fwd_megakernel, 512, kDynLds);
    if (per_cu < 1) { fprintf(stderr, "occupancy query says %d blocks/CU\n", per_cu); per_cu = 1; }
    grid_blocks = cus;
    if (ws_size < WS_END) fprintf(stderr, "workspace too small: %zu < %zu\n", ws_size, (size_t)WS_END);
  }
  Params p{};
  p.x = (const float*)d_in[0]; p.c = (const float*)d_in[1]; p.ctx = (const float*)d_in[2]; p.c_ctx = (const float*)d_in[3];
  p.w_ada = (const float*)d_in[4]; p.b_ada = (const float*)d_in[5]; p.norm1_g = (const float*)d_in[6]; p.w_in = (const float*)d_in[7];
  p.na_rpb = (const float*)d_in[8]; p.diff_lambda = (const float*)d_in[9]; p.diff_subln_g = (const float*)d_in[10];
  p.ret_decay_logit = (const float*)d_in[11]; p.w_out = (const float*)d_in[12]; p.norm2_g = (const float*)d_in[13];
  p.peer_wq = (const float*)d_in[14]; p.peer_subkeys = (const float*)d_in[15]; p.peer_u = (const float*)d_in[16];
  p.peer_v = (const float*)d_in[17]; p.final_g = (const float*)d_in[18];
  p.out = (float*)d_out; p.ws = (char*)d_ws;
  void* args[] = {&p};
  hipError_t e = hipLaunchCooperativeKernel((void*)fwd_megakernel, dim3(grid_blocks), dim3(512), args, kDynLds, stream);
  if (e != hipSuccess) fprintf(stderr, "cooperative launch failed: %s (grid %d)\n", hipGetErrorString(e), grid_blocks);
}
```

```cpp
#include <hip/hip_runtime.h>
#include <hip/hip_cooperative_groups.h>
#include <cstdio>
#include <cstdint>
namespace cg = cooperative_groups;

typedef unsigned short bf16_t;
typedef short bf16x8 __attribute__((ext_vector_type(8)));
typedef float f32x4 __attribute__((ext_vector_type(4)));

constexpr int DM = 1024, BATCH = 8, SEQ = 4096, LCTX = 256;
constexpr int NLAT = BATCH * SEQ;
constexpr int NCTX = BATCH * LCTX;
constexpr int NTOK = NLAT + NCTX;
constexpr int INC = 3072;
constexpr int C_NAQ = 0, C_NAK = 256, C_NAV = 512, C_DFQ = 768, C_DFK = 1024, C_DFV = 1280,
              C_RTQ = 1536, C_RTK = 1792, C_RTV = 2048, C_RTG = 2560;
constexpr int Y_NA = 0, Y_DF = 256, Y_RT = 512;
constexpr int NEXP = 16384;
constexpr float EPS = 1e-6f;

constexpr size_t OFF_CTL  = 0;
constexpr size_t OFF_MISC = 4096;
constexpr size_t OFF_ROPE = 8192;
constexpr size_t OFF_MOD  = OFF_ROPE + 12288;
constexpr size_t SZ_MOD   = 2ull * 9 * 6144 * 4;
constexpr size_t OFF_WIN  = OFF_MOD + SZ_MOD;
constexpr size_t SZ_WIN   = 2ull * 3072 * 1024 * 2;
constexpr size_t OFF_WOUT = OFF_WIN + SZ_WIN;
constexpr size_t SZ_WOUT  = 2ull * 1024 * 1024 * 2;
constexpr size_t OFF_WQ   = OFF_WOUT + SZ_WOUT;
constexpr size_t SZ_WQ    = 2ull * 2048 * 1024 * 2;
constexpr size_t OFF_SUBK = OFF_WQ + SZ_WQ;
constexpr size_t SZ_SUBK  = 2ull * 262144 * 2;
constexpr size_t OFF_U    = OFF_SUBK + SZ_SUBK;
constexpr int    ROWB     = 768;
constexpr int    ROWV     = 512;
constexpr int    RECB     = ROWB + ROWV;
constexpr size_t SZ_UV    = 2ull * NEXP * ROWB;
constexpr size_t OFF_V    = OFF_U + SZ_UV;
constexpr size_t OFF_USC  = OFF_V + SZ_UV;
constexpr size_t OFF_VSC  = OFF_USC + 2ull * NEXP * 4;
constexpr size_t OFF_ACT  = OFF_VSC + 2ull * NEXP * 4;
constexpr size_t SZ_ACT   = (size_t)NTOK * 1024 * 2;
constexpr size_t OFF_P    = OFF_ACT + SZ_ACT;
constexpr size_t SZ_P     = (size_t)NTOK * 3072 * 2;
constexpr size_t OFF_CTXB = OFF_P + SZ_P;
constexpr size_t SZ_CTXB  = (size_t)NCTX * 1024 * 4;
constexpr size_t OFF_RKV  = OFF_CTXB + SZ_CTXB;
constexpr size_t SZ_RKV   = 64ull * 32 * 8192 * 4;
constexpr size_t OFF_RS   = OFF_RKV + SZ_RKV;
constexpr size_t SZ_RS    = 64ull * 8192 * 4;
constexpr size_t OFF_XBAR = OFF_RS + SZ_RS;
constexpr size_t WS_END   = OFF_XBAR + 16384;

#ifndef REP_MIX1
#define REP_MIX1 0
#endif
#ifndef REP_MIX2
#define REP_MIX2 0
#endif
#ifndef REP_PEER
#define REP_PEER 0
#endif
#ifndef REP_GEMM
#define REP_GEMM 0
#endif
constexpr int LDS_BYTES = 144 * 1024;
constexpr int LDS_BCAST = LDS_BYTES - 16;

struct Params {
  const float *x, *c, *ctx, *c_ctx, *w_ada, *b_ada, *norm1_g, *w_in, *na_rpb, *diff_lambda, *diff_subln_g,
              *ret_decay_logit, *w_out, *norm2_g, *peer_wq, *peer_subkeys, *peer_u, *peer_v, *final_g;
  float* out;
  char* ws;
};

__device__ __forceinline__ float bf2f(bf16_t v) { return __uint_as_float(((unsigned)v) << 16); }
__device__ __forceinline__ bf16_t f2bf(float f) {
  unsigned u = __float_as_uint(f);
  u += 0x7fffu + ((u >> 16) & 1u);
  return (bf16_t)(u >> 16);
}
__device__ __forceinline__ unsigned pack2(float a, float b) { return (unsigned)f2bf(a) | ((unsigned)f2bf(b) << 16); }
typedef __bf16 bf16x2_t __attribute__((ext_vector_type(2)));
typedef float f32x2_t __attribute__((ext_vector_type(2)));
__device__ __forceinline__ unsigned pack2h(float a, float b) {
  const f32x2_t v = {a, b};
  return __builtin_bit_cast(unsigned, __builtin_convertvector(v, bf16x2_t));
}
__device__ __forceinline__ float lo16(unsigned w) { return __uint_as_float(w << 16); }
__device__ __forceinline__ float hi16(unsigned w) { return __uint_as_float(w & 0xffff0000u); }
#define DPP_ADD(v, CTRL) ((v) + __int_as_float(__builtin_amdgcn_update_dpp(0, __float_as_int(v), (CTRL), 0xf, 0xf, true)))
__device__ __forceinline__ float row16_sum(float v) {
  v = DPP_ADD(v, 0xB1);
  v = DPP_ADD(v, 0x4E);
  v = DPP_ADD(v, 0x141);
  v = DPP_ADD(v, 0x140);
  return v;
}
#define DPP_MOVU(v, CTRL) ((unsigned)__builtin_amdgcn_update_dpp(0, (int)(v), (CTRL), 0xf, 0xf, true))
__device__ __forceinline__ unsigned row16_max_u32(unsigned v) {
  v = max(v, DPP_MOVU(v, 0xB1)); v = max(v, DPP_MOVU(v, 0x4E)); v = max(v, DPP_MOVU(v, 0x141)); v = max(v, DPP_MOVU(v, 0x140));
  return v;
}
__device__ __forceinline__ unsigned row16_min_u32(unsigned v) {
  v = min(v, DPP_MOVU(v, 0xB1)); v = min(v, DPP_MOVU(v, 0x4E)); v = min(v, DPP_MOVU(v, 0x141)); v = min(v, DPP_MOVU(v, 0x140));
  return v;
}
template <int KTH>
__device__ __forceinline__ unsigned row16_kth_largest(unsigned v) {
  int cnt = 0;
#define R8_STEP(N) { const unsigned o = DPP_MOVU(v, 0x120 + (N)); cnt += (o > v) ? 1 : 0; }
  R8_STEP(1) R8_STEP(2) R8_STEP(3) R8_STEP(4) R8_STEP(5) R8_STEP(6) R8_STEP(7) R8_STEP(8)
  R8_STEP(9) R8_STEP(10) R8_STEP(11) R8_STEP(12) R8_STEP(13) R8_STEP(14) R8_STEP(15)
#undef R8_STEP
  return row16_max_u32(cnt >= KTH - 1 ? v : 0u);
}
__device__ __forceinline__ float wave_sum(float v) {
  v = row16_sum(v);
  const int iv = __float_as_int(v);
  const float a = __int_as_float(__builtin_amdgcn_readlane(iv, 0)), b = __int_as_float(__builtin_amdgcn_readlane(iv, 16));
  const float c = __int_as_float(__builtin_amdgcn_readlane(iv, 32)), d = __int_as_float(__builtin_amdgcn_readlane(iv, 48));
  return (a + b) + (c + d);
}
__device__ __forceinline__ float siluf(float x) { return x / (1.f + __expf(-x)); }

__device__ __forceinline__ int opaque_tid() { int t = threadIdx.x; asm volatile("" : "+v"(t)); return t; }
__device__ __forceinline__ int opaque_bid() { int t = blockIdx.x; asm volatile("" : "+s"(t)); return t; }

#define DOT8(acc, Q, off, U)                                                              \
  acc = fmaf(Q[(off) + 0], lo16((U).x), acc); acc = fmaf(Q[(off) + 1], hi16((U).x), acc); \
  acc = fmaf(Q[(off) + 2], lo16((U).y), acc); acc = fmaf(Q[(off) + 3], hi16((U).y), acc); \
  acc = fmaf(Q[(off) + 4], lo16((U).z), acc); acc = fmaf(Q[(off) + 5], hi16((U).z), acc); \
  acc = fmaf(Q[(off) + 6], lo16((U).w), acc); acc = fmaf(Q[(off) + 7], hi16((U).w), acc);
#define AXPY8(O, off, P, U)                                                                   \
  O[(off) + 0] = fmaf(P, lo16((U).x), O[(off) + 0]); O[(off) + 1] = fmaf(P, hi16((U).x), O[(off) + 1]); \
  O[(off) + 2] = fmaf(P, lo16((U).y), O[(off) + 2]); O[(off) + 3] = fmaf(P, hi16((U).y), O[(off) + 3]); \
  O[(off) + 4] = fmaf(P, lo16((U).z), O[(off) + 4]); O[(off) + 5] = fmaf(P, hi16((U).z), O[(off) + 5]); \
  O[(off) + 6] = fmaf(P, lo16((U).w), O[(off) + 6]); O[(off) + 7] = fmaf(P, hi16((U).w), O[(off) + 7]);
#define UNPACK8(Q, off, U)                                                  \
  Q[(off) + 0] = lo16((U).x); Q[(off) + 1] = hi16((U).x); Q[(off) + 2] = lo16((U).y); Q[(off) + 3] = hi16((U).y); \
  Q[(off) + 4] = lo16((U).z); Q[(off) + 5] = hi16((U).z); Q[(off) + 6] = lo16((U).w); Q[(off) + 7] = hi16((U).w);

__device__ __forceinline__ int next_item(unsigned* counter, char* smem) {
  volatile int* bc = (volatile int*)(smem + LDS_BCAST);
  __syncthreads();
  if (threadIdx.x == 0) *bc = (int)atomicAdd(counter, 1u);
  __syncthreads();
  return *bc;
}

#define XB_TMO      128
#define XB_XCNT(j)  (256  + 64 * (j))
#define XB_XSUB(j)  (1280 + 64 * (j))
#define XB_XGEN(j)  (2304 + 64 * (j))
#define XB_TOP      3328
#define XB_TOPGEN   3392
#define XCD_BAR_WORDS 3456
#define XB_SPIN_CAP (1u << 18)
#define LAS3 __attribute__((address_space(3)))
__device__ __forceinline__ unsigned xb_ld(unsigned* p)              { return __hip_atomic_load(p, __ATOMIC_RELAXED, __HIP_MEMORY_SCOPE_AGENT); }
__device__ __forceinline__ unsigned xb_add(unsigned* p, unsigned v) { return __hip_atomic_fetch_add(p, v, __ATOMIC_RELAXED, __HIP_MEMORY_SCOPE_AGENT); }
__device__ __forceinline__ unsigned xb_xcc_id() { return (unsigned)__builtin_amdgcn_s_getreg((3 << 11) | 20) & 0xFu; }
#define XB_SPIN(cond, bar) do { unsigned _sp = 0; while (cond) { __builtin_amdgcn_s_sleep(1); \
    if ((++_sp & 255u) == 0u) { if (xb_ld(&(bar)[XB_TMO])) break; if (_sp > XB_SPIN_CAP) { atomicAdd(&(bar)[XB_TMO], 1u); break; } } } } while (0)
struct XcdBarrier { unsigned* bar; unsigned x; volatile LAS3 unsigned* st; };
__device__ __forceinline__ XcdBarrier xcd_barrier_post(unsigned* bar, volatile LAS3 unsigned* st) {
  XcdBarrier b; b.bar = bar; b.x = xb_xcc_id(); b.st = st;
  if (threadIdx.x == 0) (void)xb_add(&bar[XB_XCNT(b.x)], 1u);
  return b;
}
__device__ __forceinline__ void xcd_barrier_complete(unsigned* bar, unsigned x, unsigned& nloc, unsigned& nx) {
  const unsigned G = gridDim.x * gridDim.y * gridDim.z;
  unsigned sum, cnt, mine, sp = 0u;
  for (;;) {
    sum = 0u; cnt = 0u; mine = 0u;
#pragma unroll
    for (unsigned j = 0; j < 16; ++j) { const unsigned c = xb_ld(&bar[XB_XCNT(j)]); sum += c; cnt += (c > 0u) ? 1u : 0u; mine = (j == x) ? c : mine; }
    if (sum == G) break;
    __builtin_amdgcn_s_sleep(1);
    if ((++sp & 255u) == 0u) { if (xb_ld(&bar[XB_TMO])) break; if (sp > XB_SPIN_CAP) { atomicAdd(&bar[XB_TMO], 1u); break; } }
  }
  nloc = mine > 0u ? mine : 1u; nx = cnt > 0u ? cnt : 1u;
}
__device__ __forceinline__ void xcd_barrier(const XcdBarrier& b) {
  asm volatile("s_waitcnt vmcnt(0)" ::: "memory");
  __syncthreads();
  if (threadIdx.x == 0) {
    unsigned* bar = b.bar;
    __builtin_amdgcn_s_waitcnt(0);
    unsigned nloc = b.st[0], nx = b.st[1];
    if (nloc == 0u) { xcd_barrier_complete(bar, b.x, nloc, nx); b.st[0] = nloc; b.st[1] = nx; }
    const unsigned old = xb_add(&bar[XB_XSUB(b.x)], 1u);
    const unsigned gen = old / nloc;
    if (old + 1u == (gen + 1u) * nloc) {
      __builtin_amdgcn_fence(__ATOMIC_RELEASE, "agent");
      asm volatile("s_waitcnt vmcnt(0)" ::: "memory");
      const unsigned og = xb_add(&bar[XB_TOP], 1u);
      const unsigned tg = og / nx;
      if (og + 1u == (tg + 1u) * nx) xb_add(&bar[XB_TOPGEN], 1u);
      else XB_SPIN(xb_ld(&bar[XB_TOPGEN]) == tg, bar);
      __builtin_amdgcn_fence(__ATOMIC_ACQUIRE, "agent");
      xb_add(&bar[XB_XGEN(b.x)], 1u);
      asm volatile("s_waitcnt vmcnt(0)" ::: "memory");
    } else {
      XB_SPIN(xb_ld(&bar[XB_XGEN(b.x)]) == gen, bar);
      __builtin_amdgcn_fence(__ATOMIC_ACQUIRE, "agent");
      asm volatile("s_waitcnt vmcnt(0)" ::: "memory");
    }
  }
  __syncthreads();
}

__device__ __forceinline__ void transpose_item(const float* src, bf16_t* dst, int K, int N, int item, char* smem) {
  float* t = (float*)smem;
  const int nb = N / 64;
  const int k0 = (item / nb) * 64, n0 = (item % nb) * 64;
  const int tid = opaque_tid();
  __syncthreads();
#pragma unroll
  for (int i = 0; i < 8; ++i) {
    const int k = (tid >> 6) + 8 * i, n = tid & 63;
    t[k * 65 + n] = src[(size_t)(k0 + k) * N + n0 + n];
  }
  __syncthreads();
#pragma unroll
  for (int i = 0; i < 8; ++i) {
    const int n = (tid >> 6) + 8 * i, k = tid & 63;
    dst[(size_t)(n0 + n) * K + k0 + k] = f2bf(t[k * 65 + n]);
  }
}

__device__ __forceinline__ void convert_flat(const float* src, bf16_t* dst, size_t n4) {
  const size_t gt = (size_t)opaque_bid() * blockDim.x + opaque_tid(), gs = (size_t)gridDim.x * blockDim.x;
  for (size_t i = gt; i < n4; i += gs) {
    const float4 v = ((const float4*)src)[i];
    uint2 o; o.x = pack2h(v.x, v.y); o.y = pack2h(v.z, v.w);
    ((uint2*)dst)[i] = o;
  }
}

__device__ __forceinline__ void phase_prep(const Params& p, char* smem) {
  const int tid = opaque_tid();
  char* ws = p.ws;
  if (opaque_bid() == 0) {
    unsigned* ctl = (unsigned*)(ws + OFF_CTL);
    if (tid < 64) ctl[tid] = 0u;
    unsigned* xbar = (unsigned*)(ws + OFF_XBAR);
    for (int i = tid; i < XCD_BAR_WORDS; i += 512) xbar[i] = 0u;
    float* misc = (float*)(ws + OFF_MISC);
    if (tid < 2) {
      const float* lp = p.diff_lambda + tid * 128;
      float s01 = 0.f, s23 = 0.f;
      for (int i = 0; i < 32; ++i) { s01 += lp[i] * lp[32 + i]; s23 += lp[64 + i] * lp[96 + i]; }
      const float lam_init = 0.8f - 0.6f * expf(-0.3f * (float)tid);
      misc[tid] = expf(s01) - expf(s23) + lam_init;
      misc[2 + tid] = lam_init;
    }
    if (tid >= 128 && tid < 256) misc[64 + tid - 128] = 0.f;
    if (tid >= 64 && tid < 80) {
      const int i = tid - 64;
      const float xv = p.ret_decay_logit[i];
      misc[16 + i] = -log1pf(expf(-xv));
    }
    float2* ropeD = (float2*)(ws + OFF_ROPE);
    float2* ropeR = (float2*)(ws + OFF_ROPE + 4096);
    for (int i = tid; i < 64 * 8; i += 512) {
      const int v = i >> 3, f = i & 7;
      const float inv = powf(10000.0f, -(float)(2 * f) / 16.0f);
      const float ang = (float)v * inv;
      ropeD[i] = make_float2(cosf(ang), sinf(ang));
    }
    for (int i = tid; i < 64 * 16; i += 512) {
      const int v = i >> 4, f = i & 15;
      const float inv = powf(10000.0f, -(float)(2 * f) / 32.0f);
      const float ang = (float)v * inv;
      ropeR[i] = make_float2(cosf(ang), sinf(ang));
    }
  }
  {
    float* sc = (float*)smem;
    float* red = (float*)(smem + 9 * 1024 * 4);
    float* mod = (float*)(ws + OFF_MOD);
    for (int item = opaque_bid(); item < 192; item += gridDim.x) {
      const int l = item / 96, cb = item % 96;
      __syncthreads();
      for (int i = tid; i < 9 * 1024; i += 512) {
        const int r = i >> 10, k = i & 1023;
        const float cv = (r < 8) ? p.c[r * 1024 + k] : p.c_ctx[k];
        sc[i] = siluf(cv);
      }
      __syncthreads();
      const int col = tid & 63, ks = tid >> 6;
      float acc[9];
#pragma unroll
      for (int r = 0; r < 9; ++r) acc[r] = 0.f;
      const float* w = p.w_ada + (size_t)l * 1024 * 6144 + cb * 64 + col;
#pragma unroll 1
      for (int k0 = ks * 128; k0 < ks * 128 + 128; k0 += 16) {
        float wv[16];
#pragma unroll
        for (int i = 0; i < 16; ++i) wv[i] = w[(size_t)(k0 + i) * 6144];
#pragma unroll
        for (int i = 0; i < 16; ++i)
#pragma unroll
          for (int r = 0; r < 9; ++r) acc[r] = fmaf(sc[r * 1024 + k0 + i], wv[i], acc[r]);
      }
#pragma unroll
      for (int r = 0; r < 9; ++r) red[(ks * 9 + r) * 64 + col] = acc[r];
      __syncthreads();
      for (int i = tid; i < 576; i += 512) {
        const int r = i >> 6, cc = i & 63;
        float s = 0.f;
#pragma unroll
        for (int k8 = 0; k8 < 8; ++k8) s += red[(k8 * 9 + r) * 64 + cc];
        mod[((size_t)l * 9 + r) * 6144 + cb * 64 + cc] = s + p.b_ada[l * 6144 + cb * 64 + cc];
      }
    }
    __syncthreads();
  }
  for (int item = opaque_bid(); item < 3072; item += gridDim.x) {
    const int l = item / 1536;
    int r = item % 1536;
    if (r < 768) transpose_item(p.w_in + (size_t)l * 1024 * 3072, (bf16_t*)(ws + OFF_WIN) + (size_t)l * 3072 * 1024, 1024, 3072, r, smem);
    else if (r < 1024) transpose_item(p.w_out + (size_t)l * 1024 * 1024, (bf16_t*)(ws + OFF_WOUT) + (size_t)l * 1024 * 1024, 1024, 1024, r - 768, smem);
    else transpose_item(p.peer_wq + (size_t)l * 1024 * 2048, (bf16_t*)(ws + OFF_WQ) + (size_t)l * 2048 * 1024, 1024, 2048, r - 1024, smem);
  }
  convert_flat(p.peer_subkeys, (bf16_t*)(ws + OFF_SUBK), 2ull * 262144 / 4);
  {
    const size_t gt = (size_t)opaque_bid() * blockDim.x + tid, gs = (size_t)gridDim.x * blockDim.x;
    float4* dst = (float4*)(ws + OFF_CTXB);
    for (size_t i = gt; i < (size_t)NCTX * 1024 / 4; i += gs) dst[i] = ((const float4*)p.ctx)[i];
  }
}

__device__ __forceinline__ void phase_norm(const Params& p, int layer, int which, const float* xlat, int nrows) {
  const int lane = opaque_tid() & 63;
  const int gw = opaque_bid() * 8 + (opaque_tid() >> 6), nw = gridDim.x * 8;
  const float* g = (which == 0 ? p.norm1_g : p.norm2_g) + layer * 1024;
  const float* mod = (const float*)(p.ws + OFF_MOD) + (size_t)layer * 9 * 6144;
  const float* ctxb = (const float*)(p.ws + OFF_CTXB);
  bf16_t* act = (bf16_t*)(p.ws + OFF_ACT);
  const int sh_off = which == 0 ? 0 : 3 * 1024, sc_off = which == 0 ? 1024 : 4 * 1024;
  for (int row = gw; row < nrows; row += nw) {
    const float* src = row < NLAT ? xlat + (size_t)row * 1024 : ctxb + (size_t)(row - NLAT) * 1024;
    const int b = row < NLAT ? (row >> 12) : 8;
    const float* mrow = mod + (size_t)b * 6144;
    float4 v[4];
    float ss = 0.f;
#pragma unroll
    for (int j = 0; j < 4; ++j) {
      v[j] = ((const float4*)src)[lane + 64 * j];
      ss += v[j].x * v[j].x + v[j].y * v[j].y + v[j].z * v[j].z + v[j].w * v[j].w;
    }
    ss = wave_sum(ss);
    const float r = rsqrtf(ss * (1.f / 1024.f) + EPS);
#pragma unroll
    for (int j = 0; j < 4; ++j) {
      const int c = (lane + 64 * j) * 4;
      const float4 gg = *(const float4*)(g + c);
      const float4 sh = *(const float4*)(mrow + sh_off + c);
      const float4 sc = *(const float4*)(mrow + sc_off + c);
      const float o0 = v[j].x * r * gg.x * (1.f + sc.x) + sh.x;
      const float o1 = v[j].y * r * gg.y * (1.f + sc.y) + sh.y;
      const float o2 = v[j].z * r * gg.z * (1.f + sc.z) + sh.z;
      const float o3 = v[j].w * r * gg.w * (1.f + sc.w) + sh.w;
      uint2 o; o.x = pack2h(o0, o1); o.y = pack2h(o2, o3);
      *(uint2*)(act + (size_t)row * 1024 + c) = o;
    }
  }
}

__device__ __forceinline__ void phase_final(const Params& p) {
  const int lane = opaque_tid() & 63;
  const int gw = opaque_bid() * 8 + (opaque_tid() >> 6), nw = gridDim.x * 8;
  for (int row = gw; row < NLAT; row += nw) {
    float* src = p.out + (size_t)row * 1024;
    float4 v[4];
    float ss = 0.f;
#pragma unroll
    for (int j = 0; j < 4; ++j) {
      v[j] = ((const float4*)src)[lane + 64 * j];
      ss += v[j].x * v[j].x + v[j].y * v[j].y + v[j].z * v[j].z + v[j].w * v[j].w;
    }
    ss = wave_sum(ss);
    const float r = rsqrtf(ss * (1.f / 1024.f) + EPS);
#pragma unroll
    for (int j = 0; j < 4; ++j) {
      const int c = (lane + 64 * j) * 4;
      const float4 gg = *(const float4*)(p.final_g + c);
      float4 o;
      o.x = v[j].x * r * gg.x; o.y = v[j].y * r * gg.y; o.z = v[j].z * r * gg.z; o.w = v[j].w * r * gg.w;
      ((float4*)src)[lane + 64 * j] = o;
    }
  }
}

constexpr int EPI_INPROJ = 0, EPI_OUTPROJ = 1, EPI_PLAIN = 2;
constexpr int GS = 72;
constexpr int G_ASTAGE = 256 * GS * 2;
constexpr int G_BSTAGE = 128 * GS * 2;
constexpr int G_STAGE = G_ASTAGE + G_BSTAGE;

namespace g8 {
constexpr int BM = 256, BK = 64, HALF = 128, NXCD = 8, WGM = 8, HT = HALF * BK;
__device__ __forceinline__ int lds_byte(int r, int c) {
  const int st = (r >> 4) * 2 + (c >> 5), rr = r & 15, cc = c & 31, ob = rr * 64 + cc * 2;
  return st * 1024 + (ob ^ (((ob >> 9) & 1) << 5));
}
__device__ __forceinline__ void stage_rc(int b, int& R, int& C) {
  const int st = b / 1024, sb = b % 1024, swz = sb ^ (((sb >> 9) & 1) << 5);
  R = (st >> 1) * 16 + swz / 64; C = (st & 1) * 32 + (swz % 64) / 2;
}
}

constexpr int G8_ROPE_LDS = 8 * 16384;
template <int EPI>
__device__ __forceinline__ void epi_store8(const Params& p, int layer, char* smem, int m, int n, f32x4 lo, f32x4 hi, const float* xin_lat) {
  float v[8] = {lo[0], lo[1], lo[2], lo[3], hi[0], hi[1], hi[2], hi[3]};
  if constexpr (EPI == EPI_INPROJ) {
    const bool ropeD = (n >= C_DFQ && n < C_DFV), ropeR = (n >= C_RTQ && n < C_RTV);
    if ((ropeD || ropeR) && m < NLAT) {
      const int t = m & 4095, gr = t >> 6, gc = t & 63;
      const float2* tabD = (const float2*)(smem + G8_ROPE_LDS);
      const float2* tabR = (const float2*)(smem + G8_ROPE_LDS + 4096);
      const float2* tb;
      if (ropeD) { const int i0 = (n & 31) >> 1; tb = i0 < 8 ? tabD + gr * 8 + i0 : tabD + gc * 8 + i0 - 8; }
      else { const int i0 = (n & 63) >> 1; tb = i0 < 16 ? tabR + gr * 16 + i0 : tabR + gc * 16 + i0 - 16; }
#pragma unroll
      for (int q = 0; q < 4; ++q) {
        const float2 cs = tb[q];
        const float a0 = v[2 * q] * cs.x - v[2 * q + 1] * cs.y, a1 = v[2 * q] * cs.y + v[2 * q + 1] * cs.x;
        v[2 * q] = a0; v[2 * q + 1] = a1;
      }
    }
    float sc = 1.f;
    if (n < C_NAK) sc = 0.125f * 1.4426950408889634f;
    else if (n >= C_DFQ && n < C_DFK) sc = 0.17677669529663687f * 1.4426950408889634f;
    else if (n >= C_RTK && n < C_RTV) sc = 0.125f;
    uint4 o;
    o.x = pack2h(v[0] * sc, v[1] * sc); o.y = pack2h(v[2] * sc, v[3] * sc); o.z = pack2h(v[4] * sc, v[5] * sc); o.w = pack2h(v[6] * sc, v[7] * sc);
    *(uint4*)((bf16_t*)(p.ws + OFF_P) + (size_t)m * INC + n) = o;
  } else if constexpr (EPI == EPI_OUTPROJ) {
    const float* mod = (const float*)(p.ws + OFF_MOD) + (size_t)layer * 9 * 6144;
    const int b = m < NLAT ? (m >> 12) : 8;
    const float* gp = mod + (size_t)b * 6144 + 2 * 1024 + n;
    const float4 g0 = *(const float4*)gp, g1 = *(const float4*)(gp + 4);
    const float* xi; float* xo;
    if (m < NLAT) { xi = xin_lat + (size_t)m * 1024 + n; xo = p.out + (size_t)m * 1024 + n; }
    else { xo = (float*)(p.ws + OFF_CTXB) + (size_t)(m - NLAT) * 1024 + n; xi = xo; }
    const float4 x0 = *(const float4*)xi, x1 = *(const float4*)(xi + 4);
    float4 o0, o1;
    o0.x = x0.x + g0.x * v[0]; o0.y = x0.y + g0.y * v[1]; o0.z = x0.z + g0.z * v[2]; o0.w = x0.w + g0.w * v[3];
    o1.x = x1.x + g1.x * v[4]; o1.y = x1.y + g1.y * v[5]; o1.z = x1.z + g1.z * v[6]; o1.w = x1.w + g1.w * v[7];
    *(float4*)xo = o0; *(float4*)(xo + 4) = o1;
  } else if constexpr (EPI == EPI_PLAIN) {
    uint4 o;
    o.x = pack2h(v[0], v[1]); o.y = pack2h(v[2], v[3]); o.z = pack2h(v[4], v[5]); o.w = pack2h(v[6], v[7]);
    *(uint4*)((bf16_t*)(p.ws + OFF_P) + (size_t)m * 2048 + n) = o;
  } else {
    asm volatile("" :: "v"(v[0]), "v"(v[1]), "v"(v[2]), "v"(v[3]), "v"(v[4]), "v"(v[5]), "v"(v[6]), "v"(v[7]));
  }
}

#define G8_LAS __attribute__((address_space(3)))
__device__ __forceinline__ bool g8_next(int i, int nM, int nN, int G, int c, int& pm, int& pn) {
  using namespace g8;
  const int nwg = nM * nN;
  const long Lx = (long)i * G + c;
  if (Lx >= nwg) return false;
  int wgid = (int)Lx;
  { const int q = nwg / NXCD, r = nwg % NXCD, xcd = wgid % NXCD, off = wgid / NXCD; wgid = (xcd < r ? xcd * (q + 1) : r * (q + 1) + (xcd - r) * q) + off; }
  const int nig = WGM * nN, gid = wgid / nig, fm = gid * WGM, gsz = (nM - fm) < WGM ? (nM - fm) : WGM;
  pm = fm + ((wgid % nig) % gsz); pn = (wgid % nig) / gsz;
  return true;
}

template <int EPI>
__device__ __forceinline__ void gemm_phase2(const Params& p, int layer, char* smem, const bf16_t* A, const bf16_t* Bt,
                                            int M, int N, const float* xin_lat) {
  using namespace g8;
  constexpr int K = 1024, nt = K / BK, HTB = HALF * BK * 2;
  G8_LAS unsigned char* lds = (G8_LAS unsigned char*)smem;
  const int tid = opaque_tid();
  const int wid = __builtin_amdgcn_readfirstlane(tid >> 6), lane = tid & 63, wr = wid >> 2, wc = wid & 3, fr = lane & 15, fq = lane >> 4;
  unsigned voff[2], voffB[2];
#pragma unroll
  for (int i = 0; i < 2; ++i) {
    int R, C; stage_rc(tid * 16 + i * 8192, R, C);
    const int rho = R & 31, Rb = (R & ~31) + 8 * ((rho & 15) >> 2) + 4 * (rho >> 4) + (rho & 3);
    voff[i] = (unsigned)(R * K + C) * 2u; voffB[i] = (unsigned)(Rb * K + C) * 2u;
  }
  if constexpr (EPI == EPI_INPROJ) {
    __syncthreads();
    const float4* gsrc = (const float4*)(p.ws + OFF_ROPE);
    float4* ldst = (float4*)(smem + G8_ROPE_LDS);
    for (int i = tid; i < 12288 / 16; i += 512) ldst[i] = gsrc[i];
  }
  constexpr size_t kstep = (size_t)(BK * 2);
  constexpr size_t hstep = (size_t)HALF * K * 2;
  constexpr size_t tstep = 2 * hstep;
  const unsigned ldsw = (unsigned)wid * 1024u;
  const int aoff = lds_byte(wr * 64 + fr, fq * 8), boff = lds_byte(wc * 32 + fr, fq * 8);
#define G8_SA(b, h) (((b) * 2 + (h)) * HTB)
#define G8_SB(b, h) ((4 + (b) * 2 + (h)) * HTB)
#define G8_STAGE_V(bufoff, gbase, VO) do { _Pragma("unroll") for (int _i = 0; _i < 2; ++_i)                                  \
    __builtin_amdgcn_global_load_lds((const unsigned*)((const char*)(gbase) + VO[_i]), (G8_LAS unsigned*)(lds + (bufoff) + ldsw + _i * 8192), 16, 0, 0); } while (0)
#define G8_LDA(dst, b, h) do { _Pragma("unroll") for (int m = 0; m < 4; ++m) _Pragma("unroll") for (int k = 0; k < 2; ++k) dst[m][k] = *(const G8_LAS bf16x8*)(lds + G8_SA(b, h) + aoff + m * 2048 + k * 1024); } while (0)
#define G8_LDB(dst, b, h) do { _Pragma("unroll") for (int n = 0; n < 2; ++n) _Pragma("unroll") for (int k = 0; k < 2; ++k) dst[n][k] = *(const G8_LAS bf16x8*)(lds + G8_SB(b, h) + boff + n * 2048 + k * 1024); } while (0)
#define G8_MMA(ai, bj, At_, Bt_) do { __builtin_amdgcn_s_setprio(1);                                                          \
    _Pragma("unroll") for (int m = 0; m < 4; ++m) _Pragma("unroll") for (int n = 0; n < 2; ++n) _Pragma("unroll") for (int k = 0; k < 2; ++k) \
      acc[ai][bj][m][n] = __builtin_amdgcn_mfma_f32_16x16x32_bf16(Bt_[n][k], At_[m][k], acc[ai][bj][m][n], 0, 0, 0);          \
    __builtin_amdgcn_s_setprio(0); } while (0)
#define G8_WAIT_V(n) asm volatile("s_waitcnt vmcnt(" #n ")" ::: "memory")
#define G8_WAIT_L(n) asm volatile("s_waitcnt lgkmcnt(" #n ")" ::: "memory")
#define G8_BAR __builtin_amdgcn_s_barrier()
#define G8_SCHED __builtin_amdgcn_sched_barrier(0)
  const int nM = M / BM, nN = N / BM, G = gridDim.x, cu = opaque_bid();
  int cpm, cpn, npm = 0, npn = 0, ui = 0;
  __syncthreads();
  if (g8_next(0, nM, nN, G, cu, cpm, cpn)) {
    f32x4 acc[2][2][4][2];
#pragma unroll
    for (int a = 0; a < 2; ++a)
#pragma unroll
      for (int b2 = 0; b2 < 2; ++b2)
#pragma unroll
        for (int m = 0; m < 4; ++m)
#pragma unroll
          for (int n = 0; n < 2; ++n) acc[a][b2][m][n] = (f32x4){0.f, 0.f, 0.f, 0.f};
    bf16x8 At[4][2], B0[2][2], B1[2][2];
    const char* cA = (const char*)A + (size_t)cpm * tstep;
    const char* cB = (const char*)Bt + (size_t)cpn * tstep;
    G8_STAGE_V(G8_SB(0, 0), cB, voffB); G8_STAGE_V(G8_SA(0, 0), cA, voff); G8_STAGE_V(G8_SB(0, 1), cB + hstep, voffB); G8_STAGE_V(G8_SA(0, 1), cA + hstep, voff);
    if (wr == 1) G8_BAR;
    G8_WAIT_V(4); G8_BAR;
    G8_STAGE_V(G8_SB(1, 0), cB + kstep, voffB); G8_STAGE_V(G8_SA(1, 0), cA + kstep, voff); G8_STAGE_V(G8_SB(1, 1), cB + hstep + kstep, voffB);
    G8_WAIT_V(6); G8_BAR;
    for (;;) {
      const bool has_next = g8_next(ui + 1, nM, nN, G, cu, npm, npn);
      const char* nA = has_next ? (const char*)A + (size_t)npm * tstep : cA;
      const char* nB = has_next ? (const char*)Bt + (size_t)npn * tstep : cB;
#pragma unroll 1
      for (int t = 0; t < nt; t += 2) {
        const bool last = (t == nt - 2);
        const char* a1 = cA + (size_t)(t + 1) * kstep;
        const char* a2 = last ? nA : cA + (size_t)(t + 2) * kstep; const char* b2 = last ? nB : cB + (size_t)(t + 2) * kstep;
        const char* a3 = a2 + kstep; const char* b3 = b2 + kstep;
        G8_LDB(B0, 0, 0); G8_SCHED; G8_LDA(At, 0, 0); G8_STAGE_V(G8_SA(1, 1), a1 + hstep, voff);
        G8_WAIT_L(8); G8_BAR; G8_WAIT_L(0); G8_MMA(0, 0, At, B0); G8_BAR; G8_SCHED;
        G8_LDB(B1, 0, 1); G8_STAGE_V(G8_SB(0, 0), b2, voffB);
        G8_BAR; G8_WAIT_L(0); G8_MMA(0, 1, At, B1); G8_BAR;
        G8_LDA(At, 0, 1); G8_STAGE_V(G8_SA(0, 0), a2, voff);
        G8_BAR; G8_WAIT_L(0); G8_MMA(1, 0, At, B0); G8_BAR; G8_SCHED;
        G8_STAGE_V(G8_SB(0, 1), b2 + hstep, voffB);
        G8_WAIT_V(6); G8_BAR; G8_MMA(1, 1, At, B1); G8_BAR;
        G8_LDB(B0, 1, 0); G8_SCHED; G8_LDA(At, 1, 0); G8_STAGE_V(G8_SA(0, 1), a2 + hstep, voff);
        G8_WAIT_L(8); G8_BAR; G8_WAIT_L(0); G8_MMA(0, 0, At, B0); G8_BAR; G8_SCHED;
        G8_LDB(B1, 1, 1); G8_STAGE_V(G8_SB(1, 0), b3, voffB);
        G8_BAR; G8_WAIT_L(0); G8_MMA(0, 1, At, B1); G8_BAR;
        G8_LDA(At, 1, 1); G8_STAGE_V(G8_SA(1, 0), a3, voff);
        G8_BAR; G8_WAIT_L(0); G8_MMA(1, 0, At, B0); G8_BAR; G8_SCHED;
        G8_STAGE_V(G8_SB(1, 1), b3 + hstep, voffB);
        G8_WAIT_V(6); G8_BAR; G8_MMA(1, 1, At, B1); G8_BAR;
      }
      {
        const int brow = cpm * BM, bcol = cpn * BM;
        if constexpr (EPI == EPI_INPROJ) {
          if (bcol == C_DFK) {
#pragma unroll
            for (int bj = 0; bj < 2; ++bj) {
              float mx = 0.f;
#pragma unroll
              for (int ai = 0; ai < 2; ++ai)
#pragma unroll
                for (int m = 0; m < 4; ++m) {
                  float s = 0.f;
#pragma unroll
                  for (int n = 0; n < 2; ++n)
#pragma unroll
                    for (int j = 0; j < 4; ++j) s = fmaf(acc[ai][bj][m][n][j], acc[ai][bj][m][n][j], s);
                  s += __shfl_xor(s, 16); s += __shfl_xor(s, 32);
                  mx = fmaxf(mx, s);
                }
#pragma unroll
              for (int o = 1; o < 16; o <<= 1) mx = fmaxf(mx, __shfl_xor(mx, o));
              if (lane == 0) {
                const int bb = brow < NLAT ? (brow >> 12) : ((brow - NLAT) >> 8);
                unsigned* km = (unsigned*)(p.ws + OFF_MISC) + 64 + layer * 64 + (bb * 4 + bj * 2 + (wc >> 1)) * 2 + (wc & 1);
                atomicMax(km, __float_as_uint(mx));
              }
            }
          }
        }
#pragma unroll
        for (int ai = 0; ai < 2; ++ai)
#pragma unroll
          for (int bj = 0; bj < 2; ++bj)
#pragma unroll
            for (int m = 0; m < 4; ++m)
              epi_store8<EPI>(p, layer, smem, brow + ai * HALF + wr * 64 + m * 16 + fr, bcol + bj * HALF + wc * 32 + fq * 8,
                              acc[ai][bj][m][0], acc[ai][bj][m][1], xin_lat);
      }
      if (!has_next) break;
#pragma unroll
      for (int a = 0; a < 2; ++a)
#pragma unroll
        for (int b2 = 0; b2 < 2; ++b2)
#pragma unroll
          for (int m = 0; m < 4; ++m)
#pragma unroll
            for (int n = 0; n < 2; ++n) acc[a][b2][m][n] = (f32x4){0.f, 0.f, 0.f, 0.f};
      cpm = npm; cpn = npn; cA = nA; cB = nB; ++ui;
    }
    G8_WAIT_V(0);
    if (wr == 0) G8_BAR;
    G8_BAR;
  }
}

__device__ __forceinline__ unsigned cvt_pk_bf16(float lo, float hi) { return pack2h(lo, hi); }
__device__ __forceinline__ void vt_store8(bf16_t* vt, int stride, int d0, int key, uint4 uv) {
  bf16_t* vd = vt + d0 * stride + key;
  vd[0 * stride] = (bf16_t)(uv.x & 0xffffu); vd[1 * stride] = (bf16_t)(uv.x >> 16);
  vd[2 * stride] = (bf16_t)(uv.y & 0xffffu); vd[3 * stride] = (bf16_t)(uv.y >> 16);
  vd[4 * stride] = (bf16_t)(uv.z & 0xffffu); vd[5 * stride] = (bf16_t)(uv.z >> 16);
  vd[6 * stride] = (bf16_t)(uv.w & 0xffffu); vd[7 * stride] = (bf16_t)(uv.w >> 16);
}

constexpr int DKS = 72;
__device__ __forceinline__ void diff_item(const Params& p, int layer, bool ctxq, int item, char* smem) {
  const bf16_t* P = (const bf16_t*)(p.ws + OFF_P);
  bf16_t* Y = (bf16_t*)(p.ws + OFF_ACT);
  const float* misc = (const float*)(p.ws + OFF_MISC);
  const float lam = misc[layer], lam_init = misc[2 + layer];
  const int tid = opaque_tid(), lane = tid & 63, wave = tid >> 6, lr = lane & 15, lq = lane >> 4;
  int b, h, mbase, nkeys;
  if (!ctxq) { b = item >> 6; h = (item >> 4) & 3; mbase = b * 4096 + (item & 15) * 256; nkeys = 256 + 4096; }
  else { b = item >> 2; h = item & 3; mbase = NLAT + b * 256; nkeys = 256; }
  const float kmax0 = sqrtf(misc[64 + layer * 64 + (b * 4 + h) * 2 + 0]), kmax1 = sqrtf(misc[64 + layer * 64 + (b * 4 + h) * 2 + 1]);
  bf16x8 qf[2][2];
  f32x4 C0[2], C1[2];
#pragma unroll
  for (int qt = 0; qt < 2; ++qt) {
    const bf16_t* qr = P + (size_t)(mbase + wave * 32 + qt * 16 + lr) * INC + C_DFQ + h * 64 + lq * 8;
    const uint4 u0 = *(const uint4*)(qr), u1 = *(const uint4*)(qr + 32);
    float s0 = 0.f, s1 = 0.f;
    { float t[8]; UNPACK8(t, 0, u0) _Pragma("unroll") for (int i = 0; i < 8; ++i) s0 = fmaf(t[i], t[i], s0); }
    { float t[8]; UNPACK8(t, 0, u1) _Pragma("unroll") for (int i = 0; i < 8; ++i) s1 = fmaf(t[i], t[i], s1); }
    s0 += __shfl_xor(s0, 16); s0 += __shfl_xor(s0, 32);
    s1 += __shfl_xor(s1, 16); s1 += __shfl_xor(s1, 32);
    const float nm0 = -sqrtf(s0) * kmax0, nm1 = -sqrtf(s1) * kmax1;
    C0[qt] = (f32x4){nm0, nm0, nm0, nm0};
    C1[qt] = (f32x4){nm1, nm1, nm1, nm1};
    union { uint4 u; bf16x8 v; } c0, c1; c0.u = u0; c1.u = u1;
    qf[qt][0] = c0.v; qf[qt][1] = c1.v;
  }
  f32x4 O0[2][4], O1[2][4];
#pragma unroll
  for (int qt = 0; qt < 2; ++qt)
#pragma unroll
    for (int i = 0; i < 4; ++i) { O0[qt][i] = (f32x4){0.f, 0.f, 0.f, 0.f}; O1[qt][i] = (f32x4){0.f, 0.f, 0.f, 0.f}; }
  f32x4 L0[2], L1[2];
#pragma unroll
  for (int qt = 0; qt < 2; ++qt) { L0[qt] = (f32x4){0.f, 0.f, 0.f, 0.f}; L1[qt] = (f32x4){0.f, 0.f, 0.f, 0.f}; }
  const bf16x8 ones8 = {(short)0x3F80, (short)0x3F80, (short)0x3F80, (short)0x3F80, (short)0x3F80, (short)0x3F80, (short)0x3F80, (short)0x3F80};
  const int lkey = tid >> 3, lch = tid & 7;
  constexpr int DBUF = 2 * 128 * DKS * 2;
  uint4 ukA0, ukA1, uvA0, uvA1;
#define DF_GLOAD1(UK, UV, T, I)                                                                     \
  {                                                                                                 \
    const int kk = (T) * 128 + (I) * 64 + lkey;                                                     \
    const size_t row = kk < 256 ? (size_t)(NLAT + b * 256 + kk) : (size_t)(b * 4096 + kk - 256);    \
    UK = *(const uint4*)(P + row * INC + C_DFK + h * 64 + lch * 8);                                 \
    UV = *(const uint4*)(P + row * INC + C_DFV + h * 64 + lch * 8);                                 \
  }
#define DF_LSTORE1(UK, UV, BUF, I)                                                                  \
  {                                                                                                 \
    bf16_t* Ks_ = (bf16_t*)(smem + (BUF) * DBUF) + (I) * 64 * DKS;                                  \
    bf16_t* Vt_ = (bf16_t*)(smem + (BUF) * DBUF) + 128 * DKS + (I) * 64 * DKS;                      \
    *(uint4*)(Ks_ + lkey * DKS + lch * 8) = UK;                                                     \
    vt_store8(Vt_, DKS, lch * 8, lkey, UV);                                                         \
  }
#define DF_GLOAD(S, T) DF_GLOAD1(uk##S##0, uv##S##0, T, 0) DF_GLOAD1(uk##S##1, uv##S##1, T, 1)
#define DF_LSTORE(S, BUF) DF_LSTORE1(uk##S##0, uv##S##0, BUF, 0) DF_LSTORE1(uk##S##1, uv##S##1, BUF, 1)
  const int ntile = nkeys >> 7;
  __syncthreads();
  DF_GLOAD(A, 0)
  DF_LSTORE(A, 0)
  __syncthreads();
#pragma unroll 1
  for (int t = 0; t < ntile; ++t) {
    const int cur = t & 1;
    if (t + 1 < ntile) { DF_GLOAD(A, t + 1) }
#pragma unroll 1
    for (int sub = 0; sub < 2; ++sub) {
    const bf16_t* Ks = (const bf16_t*)(smem + cur * DBUF) + sub * 64 * DKS;
    const bf16_t* Vt = (const bf16_t*)(smem + cur * DBUF) + 128 * DKS + sub * 64 * DKS;
    union PF { unsigned u[4]; bf16x8 v; };
    PF pf0[2][2], pf1[2][2];
#pragma unroll
    for (int c = 0; c < 2; ++c) {
      f32x4 S[2][4];
#pragma unroll
      for (int kt = 0; kt < 4; ++kt) {
        const bf16x8 kf = *(const bf16x8*)(Ks + (kt * 16 + lr) * DKS + c * 32 + lq * 8);
#pragma unroll
        for (int qt = 0; qt < 2; ++qt) S[qt][kt] = __builtin_amdgcn_mfma_f32_16x16x32_bf16(kf, qf[qt][c], c == 0 ? C0[qt] : C1[qt], 0, 0, 0);
      }
#pragma unroll
      for (int qt = 0; qt < 2; ++qt) {
#pragma unroll
        for (int kt = 0; kt < 4; ++kt) {
#pragma unroll
          for (int r = 0; r < 4; ++r) S[qt][kt][r] = __builtin_amdgcn_exp2f(S[qt][kt][r]);
        }
#pragma unroll
        for (int g = 0; g < 2; ++g) {
          PF t;
          t.u[0] = cvt_pk_bf16(S[qt][2 * g][0], S[qt][2 * g][1]); t.u[1] = cvt_pk_bf16(S[qt][2 * g][2], S[qt][2 * g][3]);
          t.u[2] = cvt_pk_bf16(S[qt][2 * g + 1][0], S[qt][2 * g + 1][1]); t.u[3] = cvt_pk_bf16(S[qt][2 * g + 1][2], S[qt][2 * g + 1][3]);
          if (c == 0) pf0[qt][g] = t; else pf1[qt][g] = t;
        }
      }
    }
#pragma unroll
    for (int g = 0; g < 2; ++g) {
#pragma unroll
      for (int qt = 0; qt < 2; ++qt) {
        L0[qt] = __builtin_amdgcn_mfma_f32_16x16x32_bf16(ones8, pf0[qt][g].v, L0[qt], 0, 0, 0);
        L1[qt] = __builtin_amdgcn_mfma_f32_16x16x32_bf16(ones8, pf1[qt][g].v, L1[qt], 0, 0, 0);
      }
#pragma unroll
      for (int dt = 0; dt < 4; ++dt) {
        union { uint2 h2[2]; bf16x8 v; } vf;
        vf.h2[0] = *(const uint2*)(Vt + (dt * 16 + lr) * DKS + 32 * g + 4 * lq);
        vf.h2[1] = *(const uint2*)(Vt + (dt * 16 + lr) * DKS + 32 * g + 16 + 4 * lq);
#pragma unroll
        for (int qt = 0; qt < 2; ++qt) {
          O0[qt][dt] = __builtin_amdgcn_mfma_f32_16x16x32_bf16(vf.v, pf0[qt][g].v, O0[qt][dt], 0, 0, 0);
          O1[qt][dt] = __builtin_amdgcn_mfma_f32_16x16x32_bf16(vf.v, pf1[qt][g].v, O1[qt][dt], 0, 0, 0);
        }
      }
    }
    }
    if (t + 1 < ntile) { DF_LSTORE(A, cur ^ 1) }
    __syncthreads();
  }
  const float* sg = p.diff_subln_g + layer * 64;
#pragma unroll
  for (int qt = 0; qt < 2; ++qt) {
    const float a0 = L0[qt][0], a1 = L1[qt][0];
    const float i0 = 1.f / a0, i1 = lam / a1;
    float ss = 0.f;
#pragma unroll
    for (int dt = 0; dt < 4; ++dt) {
#pragma unroll
      for (int r = 0; r < 4; ++r) { const float v = O0[qt][dt][r] * i0 - O1[qt][dt][r] * i1; O0[qt][dt][r] = v; ss = fmaf(v, v, ss); }
    }
    ss += __shfl_xor(ss, 16); ss += __shfl_xor(ss, 32);
    const float rr = rsqrtf(ss * (1.f / 64.f) + EPS) * (1.f - lam_init);
    bf16_t* dst = Y + (size_t)(mbase + wave * 32 + qt * 16 + lr) * 1024 + Y_DF + h * 64;
#pragma unroll
    for (int dt = 0; dt < 4; ++dt) {
      const int d = dt * 16 + 4 * lq;
      const float4 g4 = *(const float4*)(sg + d);
      uint2 ov;
      ov.x = pack2(O0[qt][dt][0] * rr * g4.x, O0[qt][dt][1] * rr * g4.y);
      ov.y = pack2(O0[qt][dt][2] * rr * g4.z, O0[qt][dt][3] * rr * g4.w);
      *(uint2*)(dst + d) = ov;
    }
  }
}

constexpr int NA_WS = 520;
constexpr int NA_CS = 264;
constexpr int NA_OFF_VTW = 0;
constexpr int NA_OFF_VTC = 64 * NA_WS * 2;
constexpr int NA_OFF_RPB = NA_OFF_VTC + 64 * NA_CS * 2;
constexpr int NA_OFF_MRG = NA_OFF_RPB + 2048;

#define NA_STEP(KA_EXPR, KB_EXPR, BIAS_EXPR, VT_PTR, VT_STRIDE, VT_KEY0_EXPR)                                    \
  {                                                                                                               \
    f32x4 S[4];                                                                                                   \
    _Pragma("unroll") for (int kt = 0; kt < 4; ++kt) {                                                            \
      f32x4 a = __builtin_amdgcn_mfma_f32_16x16x32_bf16((KA_EXPR), qf[0], (f32x4){0.f, 0.f, 0.f, 0.f}, 0, 0, 0);  \
      S[kt] = __builtin_amdgcn_mfma_f32_16x16x32_bf16((KB_EXPR), qf[1], a, 0, 0, 0);                               \
    }                                                                                                             \
    _Pragma("unroll") for (int kt = 0; kt < 4; ++kt) {                                                            \
      _Pragma("unroll") for (int r = 0; r < 4; ++r) { S[kt][r] += (BIAS_EXPR); }                                  \
    }                                                                                                             \
    float x = fmaxf(fmaxf(S[0][0], S[0][1]), fmaxf(S[0][2], S[0][3]));                                            \
    _Pragma("unroll") for (int kt = 1; kt < 4; ++kt) x = fmaxf(x, fmaxf(fmaxf(S[kt][0], S[kt][1]), fmaxf(S[kt][2], S[kt][3]))); \
    x = fmaxf(x, __shfl_xor(x, 16)); x = fmaxf(x, __shfl_xor(x, 32));                                             \
    const float mn = fmaxf(mrun, x);                                                                              \
    const float al = __builtin_amdgcn_exp2f(mrun - mn);                                                           \
    mrun = mn;                                                                                                    \
    float ps = 0.f;                                                                                               \
    _Pragma("unroll") for (int kt = 0; kt < 4; ++kt) {                                                            \
      _Pragma("unroll") for (int r = 0; r < 4; ++r) { S[kt][r] = __builtin_amdgcn_exp2f(S[kt][r] - mn); ps += S[kt][r]; } \
    }                                                                                                             \
    lrun = lrun * al + ps;                                                                                        \
    _Pragma("unroll") for (int dt = 0; dt < 4; ++dt) {                                                            \
      _Pragma("unroll") for (int r = 0; r < 4; ++r) O[dt][r] *= al;                                               \
    }                                                                                                             \
    _Pragma("unroll") for (int g = 0; g < 2; ++g) {                                                               \
      union { unsigned u[4]; bf16x8 v; } pf;                                                                      \
      pf.u[0] = cvt_pk_bf16(S[2 * g][0], S[2 * g][1]); pf.u[1] = cvt_pk_bf16(S[2 * g][2], S[2 * g][3]);           \
      pf.u[2] = cvt_pk_bf16(S[2 * g + 1][0], S[2 * g + 1][1]); pf.u[3] = cvt_pk_bf16(S[2 * g + 1][2], S[2 * g + 1][3]); \
      const int vk0 = (VT_KEY0_EXPR);                                                                             \
      _Pragma("unroll") for (int dt = 0; dt < 4; ++dt) {                                                          \
        union { uint2 h2[2]; bf16x8 v; } vf;                                                                      \
        vf.h2[0] = *(const uint2*)((VT_PTR) + (dt * 16 + lr) * (VT_STRIDE) + vk0 + 4 * lq);                       \
        vf.h2[1] = *(const uint2*)((VT_PTR) + (dt * 16 + lr) * (VT_STRIDE) + vk0 + 16 + 4 * lq);                  \
        O[dt] = __builtin_amdgcn_mfma_f32_16x16x32_bf16(vf.v, pf.v, O[dt], 0, 0, 0);                              \
      }                                                                                                           \
    }                                                                                                             \
  }

__device__ __forceinline__ void na_latent_item(const Params& p, int layer, int item, char* smem) {
  const bf16_t* P = (const bf16_t*)(p.ws + OFF_P);
  bf16_t* Y = (bf16_t*)(p.ws + OFF_ACT);
  const int b = item >> 8, h = (item >> 6) & 3, grow = item & 63;
  const int tid = opaque_tid(), lane = tid & 63, wave = tid >> 6, lr = lane & 15, lq = lane >> 4;
  const int jt = wave & 3, half = wave >> 2;
  bf16_t* VtW = (bf16_t*)(smem + NA_OFF_VTW);
  bf16_t* VtC = (bf16_t*)(smem + NA_OFF_VTC);
  float* RPB = (float*)(smem + NA_OFF_RPB);
  float* MRG = (float*)(smem + NA_OFF_MRG);
  const int rs = min(max(grow - 4, 0), 56);
  __syncthreads();
  {
    const int ch = tid & 7;
#pragma unroll
    for (int i = 0; i < 8; ++i) {
      const int key = (tid >> 3) + 64 * i;
      const uint4 uv = *(const uint4*)(P + (size_t)(b * 4096 + (rs + (key >> 6)) * 64 + (key & 63)) * INC + C_NAV + h * 64 + ch * 8);
      vt_store8(VtW, NA_WS, ch * 8, key, uv);
    }
#pragma unroll
    for (int i = 0; i < 4; ++i) {
      const int key = (tid >> 3) + 64 * i;
      const uint4 uv = *(const uint4*)(P + (size_t)(NLAT + b * 256 + key) * INC + C_NAV + h * 64 + ch * 8);
      vt_store8(VtC, NA_CS, ch * 8, key, uv);
    }
    if (tid < 465) RPB[tid] = p.na_rpb[(size_t)(layer * 4 + h) * 465 + tid] * 1.4426950408889634f;
  }
  const int qc = jt * 16 + lr;
  const int mq = b * 4096 + grow * 64 + qc;
  bf16x8 qf[2];
  {
    const bf16_t* qr = P + (size_t)mq * INC + C_NAQ + h * 64 + lq * 8;
    qf[0] = *(const bf16x8*)(qr);
    qf[1] = *(const bf16x8*)(qr + 32);
  }
  f32x4 O[4];
#pragma unroll
  for (int i = 0; i < 4; ++i) O[i] = (f32x4){0.f, 0.f, 0.f, 0.f};
  float mrun = -1e30f, lrun = 0.f;
  const int k0 = min(max(jt * 16 - 8, 0), 32);
  const int cs = min(max(qc - 8, 0), 48);
  bf16x8 kfa[2][4], kfb[2][4];
#define NA_LOADK(SET, S_)                                                                                        \
  _Pragma("unroll") for (int kt = 0; kt < 4; ++kt) {                                                             \
    const int t_ = 4 * (S_) + kt;                                                                                \
    const size_t krow = half == 0 ? (size_t)(b * 4096 + (rs + (t_ >> 1)) * 64 + k0 + 16 * (t_ & 1) + lr) : (size_t)(NLAT + b * 256 + 16 * t_ + lr); \
    const bf16_t* kp = P + krow * INC + C_NAK + h * 64 + lq * 8;                                                 \
    kfa[SET][kt] = *(const bf16x8*)(kp); kfb[SET][kt] = *(const bf16x8*)(kp + 32);                               \
  }
  NA_LOADK(0, 0)
  __syncthreads();
#pragma unroll
  for (int s = 0; s < 4; ++s) {
    if (s + 1 < 4) { NA_LOADK((s + 1) & 1, s + 1) }
    if (half == 0) {
      const int wr0 = 2 * s;
      NA_STEP(kfa[s & 1][kt], kfb[s & 1][kt],
              ((k0 + 16 * (kt & 1) + 4 * lq + r) >= cs && (k0 + 16 * (kt & 1) + 4 * lq + r) < cs + 16)
                  ? RPB[(rs + wr0 + (kt >> 1) - grow + 7) * 31 + (k0 + 16 * (kt & 1) + 4 * lq + r) - qc + 15] : -1e30f,
              VtW, NA_WS, (wr0 + g) * 64 + k0)
    } else {
      NA_STEP(kfa[s & 1][kt], kfb[s & 1][kt], 0.f, VtC, NA_CS, s * 64 + 32 * g)
    }
  }
  lrun += __shfl_xor(lrun, 16); lrun += __shfl_xor(lrun, 32);
  float* mg = MRG + (jt * 64 + lane) * 18;
  if (half == 1) {
    mg[0] = mrun; mg[1] = lrun;
#pragma unroll
    for (int dt = 0; dt < 4; ++dt) { mg[2 + dt * 4 + 0] = O[dt][0]; mg[2 + dt * 4 + 1] = O[dt][1]; mg[2 + dt * 4 + 2] = O[dt][2]; mg[2 + dt * 4 + 3] = O[dt][3]; }
  }
  __syncthreads();
  if (half == 0) {
    const float m2 = mg[0], l2 = mg[1];
    const float M = fmaxf(mrun, m2);
    const float f1 = __builtin_amdgcn_exp2f(mrun - M), f2 = __builtin_amdgcn_exp2f(m2 - M);
    const float inv = 1.f / (lrun * f1 + l2 * f2);
    bf16_t* dst = Y + (size_t)mq * 1024 + Y_NA + h * 64;
#pragma unroll
    for (int dt = 0; dt < 4; ++dt) {
      const float o0 = (O[dt][0] * f1 + mg[2 + dt * 4 + 0] * f2) * inv, o1 = (O[dt][1] * f1 + mg[2 + dt * 4 + 1] * f2) * inv;
      const float o2 = (O[dt][2] * f1 + mg[2 + dt * 4 + 2] * f2) * inv, o3 = (O[dt][3] * f1 + mg[2 + dt * 4 + 3] * f2) * inv;
      uint2 ov; ov.x = pack2(o0, o1); ov.y = pack2(o2, o3);
      *(uint2*)(dst + dt * 16 + 4 * lq) = ov;
    }
  }
}

__device__ __forceinline__ void na_ctx_item(const Params& p, int item, char* smem) {
  const bf16_t* P = (const bf16_t*)(p.ws + OFF_P);
  bf16_t* Y = (bf16_t*)(p.ws + OFF_ACT);
  const int b = item >> 3, h = (item >> 1) & 3, qg = item & 1;
  const int tid = opaque_tid(), lane = tid & 63, wave = tid >> 6, lr = lane & 15, lq = lane >> 4;
  bf16_t* VtC = (bf16_t*)(smem + NA_OFF_VTC);
  __syncthreads();
  {
    const int ch = tid & 7;
#pragma unroll
    for (int i = 0; i < 4; ++i) {
      const int key = (tid >> 3) + 64 * i;
      const uint4 uv = *(const uint4*)(P + (size_t)(NLAT + b * 256 + key) * INC + C_NAV + h * 64 + ch * 8);
      vt_store8(VtC, NA_CS, ch * 8, key, uv);
    }
  }
  const int mq = NLAT + b * 256 + qg * 128 + wave * 16 + lr;
  bf16x8 qf[2];
  {
    const bf16_t* qr = P + (size_t)mq * INC + C_NAQ + h * 64 + lq * 8;
    qf[0] = *(const bf16x8*)(qr);
    qf[1] = *(const bf16x8*)(qr + 32);
  }
  f32x4 O[4];
#pragma unroll
  for (int i = 0; i < 4; ++i) O[i] = (f32x4){0.f, 0.f, 0.f, 0.f};
  float mrun = -1e30f, lrun = 0.f;
  __syncthreads();
#pragma unroll 1
  for (int s = 0; s < 4; ++s) {
    NA_STEP(*(const bf16x8*)(P + (size_t)(NLAT + b * 256 + s * 64 + kt * 16 + lr) * INC + C_NAK + h * 64 + lq * 8),
            *(const bf16x8*)(P + (size_t)(NLAT + b * 256 + s * 64 + kt * 16 + lr) * INC + C_NAK + h * 64 + 32 + lq * 8), 0.f, VtC, NA_CS, s * 64 + 32 * g)
  }
  lrun += __shfl_xor(lrun, 16); lrun += __shfl_xor(lrun, 32);
  const float inv = 1.f / lrun;
  bf16_t* dst = Y + (size_t)mq * 1024 + Y_NA + h * 64;
#pragma unroll
  for (int dt = 0; dt < 4; ++dt) {
    uint2 ov; ov.x = pack2(O[dt][0] * inv, O[dt][1] * inv); ov.y = pack2(O[dt][2] * inv, O[dt][3] * inv);
    *(uint2*)(dst + dt * 16 + 4 * lq) = ov;
  }
}

constexpr int KV_S = 136;
constexpr int KV_OFF_KF = 0, KV_OFF_KB = 64 * KV_S * 2, KV_OFF_VT = 2 * 64 * KV_S * 2;
__device__ __forceinline__ void ret_kv_item(const Params& p, int layer, int h, size_t row0, int cnt, float* dstF, float* dstB, char* smem) {
  const bf16_t* P = (const bf16_t*)(p.ws + OFF_P);
  const float* misc = (const float*)(p.ws + OFF_MISC);
  const float lgF2 = misc[16 + layer * 8 + 0 * 4 + h] * 1.4426950408889634f, lgB2 = misc[16 + layer * 8 + 1 * 4 + h] * 1.4426950408889634f;
  const int tid = opaque_tid(), lane = tid & 63, wave = tid >> 6, lr = lane & 15, lq = lane >> 4;
  bf16_t* KFt = (bf16_t*)(smem + KV_OFF_KF);
  bf16_t* KBt = (bf16_t*)(smem + KV_OFF_KB);
  bf16_t* Vt = (bf16_t*)(smem + KV_OFF_VT);
  const int dir = wave >> 2, dt = wave & 3;
  f32x4 acc[8];
#pragma unroll
  for (int i = 0; i < 8; ++i) acc[i] = (f32x4){0.f, 0.f, 0.f, 0.f};
#pragma unroll 1
  for (int kc = 0; kc < (cnt >> 7); ++kc) {
    __syncthreads();
    {
      const int tok = tid >> 2, c = tid & 3;
      const int j = kc * 128 + tok;
      const float wF = __builtin_amdgcn_exp2f(lgF2 * (float)(cnt - 1 - j)), wB = __builtin_amdgcn_exp2f(lgB2 * (float)j);
      const bf16_t* rowp = P + (row0 + j) * INC;
#pragma unroll
      for (int c8 = 0; c8 < 2; ++c8) {
        const uint4 u = *(const uint4*)(rowp + C_RTK + h * 64 + c * 16 + c8 * 8);
        float kv[8];
        UNPACK8(kv, 0, u)
#pragma unroll
        for (int i = 0; i < 8; ++i) {
          KFt[(c * 16 + c8 * 8 + i) * KV_S + tok] = f2bf(kv[i] * wF);
          KBt[(c * 16 + c8 * 8 + i) * KV_S + tok] = f2bf(kv[i] * wB);
        }
      }
#pragma unroll
      for (int c8 = 0; c8 < 4; ++c8) {
        const uint4 uv = *(const uint4*)(rowp + C_RTV + h * 128 + c * 32 + c8 * 8);
        vt_store8(Vt, KV_S, c * 32 + c8 * 8, tok, uv);
      }
    }
    __syncthreads();
    const bf16_t* Kt = dir == 0 ? KFt : KBt;
    bf16x8 af[4];
#pragma unroll
    for (int ks = 0; ks < 4; ++ks) af[ks] = *(const bf16x8*)(Kt + (dt * 16 + lr) * KV_S + ks * 32 + lq * 8);
#pragma unroll
    for (int et = 0; et < 8; ++et) {
#pragma unroll
      for (int ks = 0; ks < 4; ++ks) {
        const bf16x8 bfr = *(const bf16x8*)(Vt + (et * 16 + lr) * KV_S + ks * 32 + lq * 8);
        acc[et] = __builtin_amdgcn_mfma_f32_16x16x32_bf16(af[ks], bfr, acc[et], 0, 0, 0);
      }
    }
  }
  float* dst = dir == 0 ? dstF : dstB;
#pragma unroll
  for (int et = 0; et < 8; ++et) {
#pragma unroll
    for (int r = 0; r < 4; ++r) dst[(dt * 16 + 4 * lq + r) * 128 + et * 16 + lr] = acc[et][r];
  }
}

__device__ __forceinline__ void phase_ret_scan(const Params& p, int layer) {
  const float* misc = (const float*)(p.ws + OFF_MISC);
  float* rkv = (float*)(p.ws + OFF_RKV);
  const float* rs = (const float*)(p.ws + OFF_RS);
  const int gt = opaque_bid() * 512 + opaque_tid(), gs = gridDim.x * 512;
  for (int idx = gt; idx < 64 * 2048; idx += gs) {
    const int seq = idx >> 11, e4 = (idx & 2047) * 4;
    const int dir = seq & 1, h = (seq >> 1) & 3;
    const float cdec = __expf(misc[16 + layer * 8 + dir * 4 + h] * 128.f);
    float4* base = (float4*)(rkv + (size_t)seq * 32 * 8192 + e4);
    float4 v[32];
#pragma unroll
    for (int s = 0; s < 32; ++s) v[s] = base[(size_t)s * 2048];
    float4 st = *(const float4*)(rs + (size_t)seq * 8192 + e4);
    if (dir == 0) {
#pragma unroll
      for (int s = 0; s < 32; ++s) {
        const float4 t = v[s];
        base[(size_t)s * 2048] = st;
        st.x = fmaf(cdec, st.x, t.x); st.y = fmaf(cdec, st.y, t.y); st.z = fmaf(cdec, st.z, t.z); st.w = fmaf(cdec, st.w, t.w);
      }
    } else {
#pragma unroll
      for (int s = 31; s >= 0; --s) {
        const float4 t = v[s];
        base[(size_t)s * 2048] = st;
        st.x = fmaf(cdec, st.x, t.x); st.y = fmaf(cdec, st.y, t.y); st.z = fmaf(cdec, st.z, t.z); st.w = fmaf(cdec, st.w, t.w);
      }
    }
  }
}

constexpr int RT_KS = 72, RT_VS = 136;
constexpr int RT_OFF_K = 0, RT_OFF_VT = 128 * RT_KS * 2, RT_OFF_SF = RT_OFF_VT + 128 * RT_VS * 2, RT_OFF_SB = RT_OFF_SF + 128 * RT_KS * 2;
__device__ __forceinline__ void ret_out_item(const Params& p, int layer, int h, size_t krow0, int nkc, int iq0,
                                             const float* SF, const float* SB, int clen, char* smem) {
  const bf16_t* P = (const bf16_t*)(p.ws + OFF_P);
  bf16_t* Y = (bf16_t*)(p.ws + OFF_ACT);
  const float* misc = (const float*)(p.ws + OFF_MISC);
  const float lgF2 = misc[16 + layer * 8 + 0 * 4 + h] * 1.4426950408889634f, lgB2 = misc[16 + layer * 8 + 1 * 4 + h] * 1.4426950408889634f;
  const int tid = opaque_tid(), lane = tid & 63, wave = tid >> 6, lr = lane & 15, lq = lane >> 4;
  bf16_t* Ks = (bf16_t*)(smem + RT_OFF_K);
  bf16_t* Vt = (bf16_t*)(smem + RT_OFF_VT);
  bf16_t* SFt = (bf16_t*)(smem + RT_OFF_SF);
  bf16_t* SBt = (bf16_t*)(smem + RT_OFF_SB);
  const int iq = iq0 + wave * 16 + lr;
  const size_t mq = krow0 + iq;
  bf16x8 qf[2];
  {
    const bf16_t* qr = P + mq * INC + C_RTQ + h * 64 + lq * 8;
    qf[0] = *(const bf16x8*)(qr);
    qf[1] = *(const bf16x8*)(qr + 32);
  }
  f32x4 O[8];
#pragma unroll
  for (int i = 0; i < 8; ++i) O[i] = (f32x4){0.f, 0.f, 0.f, 0.f};
  if (SF != nullptr) {
    __syncthreads();
    {
      const int d = tid >> 3, e0 = (tid & 7) * 16;
#pragma unroll
      for (int c4 = 0; c4 < 4; ++c4) {
        const float4 a = *(const float4*)(SF + d * 128 + e0 + c4 * 4);
        const float4 bb = *(const float4*)(SB + d * 128 + e0 + c4 * 4);
        SFt[(e0 + c4 * 4 + 0) * RT_KS + d] = f2bf(a.x); SFt[(e0 + c4 * 4 + 1) * RT_KS + d] = f2bf(a.y);
        SFt[(e0 + c4 * 4 + 2) * RT_KS + d] = f2bf(a.z); SFt[(e0 + c4 * 4 + 3) * RT_KS + d] = f2bf(a.w);
        SBt[(e0 + c4 * 4 + 0) * RT_KS + d] = f2bf(bb.x); SBt[(e0 + c4 * 4 + 1) * RT_KS + d] = f2bf(bb.y);
        SBt[(e0 + c4 * 4 + 2) * RT_KS + d] = f2bf(bb.z); SBt[(e0 + c4 * 4 + 3) * RT_KS + d] = f2bf(bb.w);
      }
    }
    __syncthreads();
    const float cF = __builtin_amdgcn_exp2f(lgF2 * (float)(iq + 1)), cB = __builtin_amdgcn_exp2f(lgB2 * (float)(clen - iq));
#pragma unroll
    for (int ks = 0; ks < 2; ++ks)
#pragma unroll
      for (int et = 0; et < 8; ++et) {
        const bf16x8 sf = *(const bf16x8*)(SFt + (et * 16 + lr) * RT_KS + ks * 32 + lq * 8);
        O[et] = __builtin_amdgcn_mfma_f32_16x16x32_bf16(sf, qf[ks], O[et], 0, 0, 0);
      }
    const float ratio = cF / cB;
#pragma unroll
    for (int et = 0; et < 8; ++et) { O[et][0] *= ratio; O[et][1] *= ratio; O[et][2] *= ratio; O[et][3] *= ratio; }
#pragma unroll
    for (int ks = 0; ks < 2; ++ks)
#pragma unroll
      for (int et = 0; et < 8; ++et) {
        const bf16x8 sb = *(const bf16x8*)(SBt + (et * 16 + lr) * RT_KS + ks * 32 + lq * 8);
        O[et] = __builtin_amdgcn_mfma_f32_16x16x32_bf16(sb, qf[ks], O[et], 0, 0, 0);
      }
#pragma unroll
    for (int et = 0; et < 8; ++et) { O[et][0] *= cB; O[et][1] *= cB; O[et][2] *= cB; O[et][3] *= cB; }
  }
#pragma unroll 1
  for (int kc = 0; kc < nkc; ++kc) {
    __syncthreads();
    {
      const int key = tid >> 2, c = tid & 3;
      const bf16_t* rowp = P + (krow0 + kc * 128 + key) * INC;
      const uint4 k0 = *(const uint4*)(rowp + C_RTK + h * 64 + c * 16), k1 = *(const uint4*)(rowp + C_RTK + h * 64 + c * 16 + 8);
      *(uint4*)(Ks + key * RT_KS + c * 16) = k0;
      *(uint4*)(Ks + key * RT_KS + c * 16 + 8) = k1;
#pragma unroll
      for (int c8 = 0; c8 < 4; ++c8) {
        const uint4 uv = *(const uint4*)(rowp + C_RTV + h * 128 + c * 32 + c8 * 8);
        vt_store8(Vt, RT_VS, c * 32 + c8 * 8, key, uv);
      }
    }
    __syncthreads();
    f32x4 S[8];
#pragma unroll
    for (int kt = 0; kt < 8; ++kt) {
      const bf16x8 ka = *(const bf16x8*)(Ks + (kt * 16 + lr) * RT_KS + lq * 8);
      const bf16x8 kb = *(const bf16x8*)(Ks + (kt * 16 + lr) * RT_KS + 32 + lq * 8);
      const f32x4 a = __builtin_amdgcn_mfma_f32_16x16x32_bf16(ka, qf[0], (f32x4){0.f, 0.f, 0.f, 0.f}, 0, 0, 0);
      S[kt] = __builtin_amdgcn_mfma_f32_16x16x32_bf16(kb, qf[1], a, 0, 0, 0);
    }
#pragma unroll
    for (int kt = 0; kt < 8; ++kt) {
#pragma unroll
      for (int r = 0; r < 4; ++r) {
        const int df = iq - (kc * 128 + kt * 16 + 4 * lq + r);
        const float fdf = (float)df;
        float coef = 0.f;
        if (df >= 0) coef += __builtin_amdgcn_exp2f(lgF2 * fdf);
        if (df <= 0) coef += __builtin_amdgcn_exp2f(-lgB2 * fdf);
        S[kt][r] *= coef;
      }
    }
#pragma unroll
    for (int g = 0; g < 4; ++g) {
      union { unsigned u[4]; bf16x8 v; } pf;
      pf.u[0] = cvt_pk_bf16(S[2 * g][0], S[2 * g][1]); pf.u[1] = cvt_pk_bf16(S[2 * g][2], S[2 * g][3]);
      pf.u[2] = cvt_pk_bf16(S[2 * g + 1][0], S[2 * g + 1][1]); pf.u[3] = cvt_pk_bf16(S[2 * g + 1][2], S[2 * g + 1][3]);
#pragma unroll
      for (int et = 0; et < 8; ++et) {
        union { uint2 h2[2]; bf16x8 v; } vf;
        vf.h2[0] = *(const uint2*)(Vt + (et * 16 + lr) * RT_VS + 32 * g + 4 * lq);
        vf.h2[1] = *(const uint2*)(Vt + (et * 16 + lr) * RT_VS + 32 * g + 16 + 4 * lq);
        O[et] = __builtin_amdgcn_mfma_f32_16x16x32_bf16(vf.v, pf.v, O[et], 0, 0, 0);
      }
    }
  }
  float ss = 0.f;
#pragma unroll
  for (int et = 0; et < 8; ++et) { ss = fmaf(O[et][0], O[et][0], ss); ss = fmaf(O[et][1], O[et][1], ss); ss = fmaf(O[et][2], O[et][2], ss); ss = fmaf(O[et][3], O[et][3], ss); }
  ss += __shfl_xor(ss, 16); ss += __shfl_xor(ss, 32);
  const float rr = rsqrtf(ss * (1.f / 128.f) + EPS);
  const bf16_t* gp = P + mq * INC + C_RTG + h * 128;
  bf16_t* dst = Y + mq * 1024 + Y_RT + h * 128;
#pragma unroll
  for (int et = 0; et < 8; ++et) {
    const int e = et * 16 + 4 * lq;
    const uint2 gu = *(const uint2*)(gp + e);
    uint2 ov;
    ov.x = pack2(O[et][0] * rr * siluf(lo16(gu.x)), O[et][1] * rr * siluf(hi16(gu.x)));
    ov.y = pack2(O[et][2] * rr * siluf(lo16(gu.y)), O[et][3] * rr * siluf(hi16(gu.y)));
    *(uint2*)(dst + e) = ov;
  }
}

__device__ __forceinline__ void uv_convert_item(const Params& p, int item) {
  char* ws = p.ws;
  const int tid = opaque_tid();
  const int lane = tid & 63, l = lane & 31, half = lane >> 5, wave = tid >> 6;
#pragma unroll 1
  for (int it = 0; it < 16; ++it) {
    const int row = item * 256 + (wave * 16 + it) * 2 + half;
    const bool isv = row >= 2 * NEXP;
    const int rr = isv ? row - 2 * NEXP : row;
    const float* srow = (isv ? p.peer_v : p.peer_u) + (size_t)rr * 1024;
    float4 v[8];
    float mx = 0.f;
#pragma unroll
    for (int j = 0; j < 8; ++j) {
      v[j] = ((const float4*)srow)[l + 32 * j];
      mx = fmaxf(mx, fmaxf(fmaxf(fabsf(v[j].x), fabsf(v[j].y)), fmaxf(fabsf(v[j].z), fabsf(v[j].w))));
    }
#pragma unroll
    for (int o = 1; o < 32; o <<= 1) mx = fmaxf(mx, __shfl_xor(mx, o));
    const float scale = mx > 0.f ? mx * (1.f / 7.5f) : 1.f;
    const float inv = 1.f / scale;
    if (!isv) {
      unsigned w[6] = {0u, 0u, 0u, 0u, 0u, 0u};
#pragma unroll
      for (int k = 0; k < 32; ++k) {
        const float xv = (k & 3) == 0 ? v[k >> 2].x : (k & 3) == 1 ? v[k >> 2].y : (k & 3) == 2 ? v[k >> 2].z : v[k >> 2].w;
        const float a = fminf(fabsf(xv) * inv, 7.5f);
        float c;
        if (a < 2.f) c = rintf(a * 8.f);
        else if (a < 4.f) c = 16.f + rintf((a - 2.f) * 4.f);
        else c = 24.f + rintf((a - 4.f) * 2.f);
        unsigned code = (unsigned)c;
        code = code > 31u ? 31u : code;
        code |= (xv < 0.f) ? 32u : 0u;
        const int bit = 6 * k, wd = bit >> 5, sh = bit & 31;
        w[wd] |= code << sh;
        if (sh > 26) w[wd + 1] |= code >> (32 - sh);
      }
      char* drow = ws + OFF_U + (size_t)rr * RECB + l * 24;
      *(uint2*)(drow) = make_uint2(w[0], w[1]);
      *(uint2*)(drow + 8) = make_uint2(w[2], w[3]);
      *(uint2*)(drow + 16) = make_uint2(w[4], w[5]);
      if (l == 0) ((float*)(ws + OFF_USC))[rr] = scale;
    } else {
      const float scale4 = mx > 0.f ? mx * (1.f / 6.f) : 1.f;
      const float inv4 = 1.f / scale4;
      unsigned w[4] = {0u, 0u, 0u, 0u};
#pragma unroll
      for (int k = 0; k < 32; ++k) {
        const float xv = (k & 3) == 0 ? v[k >> 2].x : (k & 3) == 1 ? v[k >> 2].y : (k & 3) == 2 ? v[k >> 2].z : v[k >> 2].w;
        const float a = fminf(fabsf(xv) * inv4, 6.f);
        float c;
        if (a < 2.f) c = rintf(a * 2.f);
        else if (a < 4.f) c = 4.f + rintf(a - 2.f);
        else c = 6.f + rintf((a - 4.f) * 0.5f);
        unsigned code = (unsigned)c;
        code = code > 7u ? 7u : code;
        code |= (xv < 0.f) ? 8u : 0u;
        w[k >> 3] |= code << (4 * (k & 7));
      }
      char* drow = ws + OFF_U + (size_t)rr * RECB + ROWB + l * 16;
      *(uint4*)(drow) = make_uint4(w[0], w[1], w[2], w[3]);
      if (l == 0) ((float*)(ws + OFF_VSC))[rr] = scale4;
    }
  }
}

__device__ __forceinline__ void phase_mix1(const Params& p, int layer, char* smem, int slot = 0) {
  unsigned* ctr = (unsigned*)(p.ws + OFF_CTL) + (layer * 4 + slot);
  const bool nc = layer == 0;
  const int n_dl = 512, n_dc = nc ? 32 : 0, n_nl = 2048, n_ncx = nc ? 64 : 0, n_kv = 1024, n_cs = 32;
  const int total = n_dl + n_dc + n_nl + n_ncx + n_kv + n_cs;
  float* rkv = (float*)(p.ws + OFF_RKV);
  float* rs = (float*)(p.ws + OFF_RS);
  for (;;) {
    int it = next_item(ctr, smem);
    if (it >= total) break;
    if (it < n_dl) { diff_item(p, layer, false, it, smem); continue; } it -= n_dl;
    if (it < n_dc) { diff_item(p, layer, true, it, smem); continue; } it -= n_dc;
    if (it < n_nl) { na_latent_item(p, layer, it, smem); continue; } it -= n_nl;
    if (it < n_ncx) { na_ctx_item(p, it, smem); continue; } it -= n_ncx;
    if (it < n_kv) {
      const int bh = it >> 5, n = it & 31, b = bh >> 2, h = bh & 3;
      ret_kv_item(p, layer, h, (size_t)b * 4096 + n * 128, 128,
                  rkv + ((size_t)(bh * 2 + 0) * 32 + n) * 8192, rkv + ((size_t)(bh * 2 + 1) * 32 + n) * 8192, smem);
      continue;
    }
    it -= n_kv;
    {
      const int bh = it, b = bh >> 2, h = bh & 3;
      ret_kv_item(p, layer, h, (size_t)NLAT + b * 256, 256, rs + (size_t)(bh * 2 + 0) * 8192, rs + (size_t)(bh * 2 + 1) * 8192, smem);
    }
  }
}

__device__ __forceinline__ void phase_mix2(const Params& p, int layer, char* smem, int slot = 1) {
  unsigned* ctr = (unsigned*)(p.ws + OFF_CTL) + (layer * 4 + slot);
  const int n_l = 1024, n_c = layer == 0 ? 64 : 0;
  const float* rkv = (const float*)(p.ws + OFF_RKV);
  for (;;) {
    int it = next_item(ctr, smem);
    if (it >= n_l + n_c) break;
    if (it < n_l) {
      const int bh = it >> 5, n = it & 31, b = bh >> 2, h = bh & 3;
      ret_out_item(p, layer, h, (size_t)b * 4096 + n * 128, 1, 0,
                   rkv + ((size_t)(bh * 2 + 0) * 32 + n) * 8192, rkv + ((size_t)(bh * 2 + 1) * 32 + n) * 8192, 128, smem);
    } else {
      it -= n_l;
      const int bh = it >> 1, half = it & 1, b = bh >> 2, h = bh & 3;
      ret_out_item(p, layer, h, (size_t)NLAT + b * 256, 2, half * 128, nullptr, nullptr, 256, smem);
    }
  }
}

typedef float f32x2 __attribute__((ext_vector_type(2)));
__device__ __forceinline__ unsigned sortable_key(float f, int idx) {
  const unsigned b = __float_as_uint(f);
  const unsigned k = b ^ ((unsigned)((int)b >> 31) | 0x80000000u);
  return (k & ~127u) | (unsigned)(127 - idx);
}
__device__ __forceinline__ float key_value(unsigned k) {
  k &= ~127u;
  const unsigned b = (k & 0x80000000u) ? (k ^ 0x80000000u) : ~k;
  return __uint_as_float(b);
}
#define FP8DOT(acc, H, off, W) { const f32x2 _a = __builtin_amdgcn_cvt_pk_f32_fp8((int)(W), false), _b = __builtin_amdgcn_cvt_pk_f32_fp8((int)(W), true); \
  acc = fmaf(H[(off) + 0], _a.x, acc); acc = fmaf(H[(off) + 1], _a.y, acc); acc = fmaf(H[(off) + 2], _b.x, acc); acc = fmaf(H[(off) + 3], _b.y, acc); }
#define FP8AXPY(O, off, P, W) { const f32x2 _a = __builtin_amdgcn_cvt_pk_f32_fp8((int)(W), false), _b = __builtin_amdgcn_cvt_pk_f32_fp8((int)(W), true); \
  O[(off) + 0] = fmaf(P, _a.x, O[(off) + 0]); O[(off) + 1] = fmaf(P, _a.y, O[(off) + 1]); O[(off) + 2] = fmaf(P, _b.x, O[(off) + 2]); O[(off) + 3] = fmaf(P, _b.y, O[(off) + 3]); }

__device__ __forceinline__ float gelu_erf(float a) {
  const float x = fabsf(a) * 0.70710678118654752f;
  const float t = __builtin_amdgcn_rcpf(fmaf(0.3275911f, x, 1.f));
  float pl = fmaf(1.061405429f, t, -1.453152027f);
  pl = fmaf(pl, t, 1.421413741f); pl = fmaf(pl, t, -0.284496736f); pl = fmaf(pl, t, 0.254829592f);
  const float y = 1.f - pl * t * __builtin_amdgcn_exp2f(-x * x * 1.4426950408889634f);
  const float er = a < 0.f ? -y : y;
  return 0.5f * a * (1.f + er);
}
constexpr int PE_SVS = 132;
constexpr int PE_OFF_SV = 0;
constexpr int PE_OFF_TV = 8 * 16 * PE_SVS * 4;
constexpr int PE_OFF_TI = PE_OFF_TV + 16 * 16 * 16 * 4;
constexpr int PE_OFF_EX = PE_OFF_TI + 16 * 16 * 16 * 4;
constexpr int PE_OFF_GT = PE_OFF_EX + 1 * 16 * 128 * 4;
constexpr int PE_OFF_SU = PE_OFF_GT + 1 * 16 * 128 * 4;
constexpr int PE_OFF_CN = PE_OFF_SU + 1 * 16 * 128 * 4;
constexpr int PE_OFF_CT = PE_OFF_CN + 8 * 16 * 4;
#define WAVE_LDS_FENCE() asm volatile("s_waitcnt lgkmcnt(0)" ::: "memory")

__device__ __forceinline__ void peer_select_head(const Params& p, int layer, char* smem, int tok0, int hd, int sw, int buf,
                                                 int lane) {
  const bf16_t* Q = (const bf16_t*)(p.ws + OFF_P);
  const bf16_t* SK = (const bf16_t*)(p.ws + OFF_SUBK) + (size_t)layer * 262144;
  const int lr = lane & 15, lq = lane >> 4;
  unsigned* SV = (unsigned*)(smem + PE_OFF_SV) + sw * 16 * PE_SVS;
  float* TV = (float*)(smem + PE_OFF_TV);
  int* TI = (int*)(smem + PE_OFF_TI);
  int* EX = (int*)(smem + PE_OFF_EX) + buf * 16 * 128;
  float* GT = (float*)(smem + PE_OFF_GT) + buf * 16 * 128;
  int* CN = (int*)(smem + PE_OFF_CN) + sw * 16;
  float* SU = (float*)(smem + PE_OFF_SU) + buf * 16 * 128;
  const float* USC = (const float*)(p.ws + OFF_USC) + layer * NEXP;
  const float* VSC = (const float*)(p.ws + OFF_VSC) + layer * NEXP;
#pragma unroll 1
  for (int pp = 0; pp < 2; ++pp) {
    bf16x8 af[4];
    const bf16_t* qrow = Q + (size_t)(tok0 + lr) * 2048 + hd * 256 + pp * 128;
#pragma unroll
    for (int ks = 0; ks < 4; ++ks) af[ks] = *(const bf16x8*)(qrow + ks * 32 + lq * 8);
    const bf16_t* skb = SK + (size_t)((hd * 2 + pp) * 128) * 128;
    f32x4 acc[8];
    {
      bf16x8 bfr[8][4];
#pragma unroll
      for (int nt = 0; nt < 8; ++nt)
#pragma unroll
        for (int ks = 0; ks < 4; ++ks)
          bfr[nt][ks] = *(const bf16x8*)(skb + (size_t)(nt * 16 + lr) * 128 + ks * 32 + lq * 8);
#pragma unroll
      for (int nt = 0; nt < 8; ++nt) {
        f32x4 a = (f32x4){0.f, 0.f, 0.f, 0.f};
#pragma unroll
        for (int ks = 0; ks < 4; ++ks) a = __builtin_amdgcn_mfma_f32_16x16x32_bf16(af[ks], bfr[nt][ks], a, 0, 0, 0);
        acc[nt] = a;
      }
    }
#pragma unroll
    for (int i = 0; i < 9; ++i) { const int q4 = lane + 64 * i; if (q4 < 16 * PE_SVS / 4) ((uint4*)SV)[q4] = make_uint4(0u, 0u, 0u, 0u); }
    WAVE_LDS_FENCE();
#pragma unroll
    for (int r = 0; r < 4; ++r) {
      const int tk = 4 * lq + r;
      unsigned k[8];
#pragma unroll
      for (int nt = 0; nt < 8; ++nt) k[nt] = sortable_key(acc[nt][r], nt * 16 + lr);
      unsigned m1 = max(k[0], k[1]), m2 = min(k[0], k[1]);
#pragma unroll
      for (int nt = 2; nt < 8; ++nt) { m2 = max(m2, min(m1, k[nt])); m1 = max(m1, k[nt]); }
      const unsigned Ta = row16_min_u32(m1);
      const unsigned Tb = min(row16_kth_largest<11>(m1), row16_kth_largest<5>(m2));
      const unsigned T = max(Ta, Tb);
      int pos = 0;
#pragma unroll
      for (int nt = 0; nt < 8; ++nt) {
        const bool sel = k[nt] >= T;
        const unsigned long long bal = __ballot(sel);
        const unsigned grp16 = (unsigned)(bal >> (16 * lq)) & 0xffffu;
        const int below = __popc(grp16 & ((1u << lr) - 1u));
        if (sel) SV[tk * PE_SVS + pos + below] = k[nt];
        pos += __popc(grp16);
      }
      if (lr == 0) CN[tk] = pos;
    }
    WAVE_LDS_FENCE();
#pragma unroll 1
    for (int pass = 0; pass < 4; ++pass) {
      const int tk = pass * 4 + lq;
      const int cnt = CN[tk];
      const unsigned* row = SV + tk * PE_SVS;
      int cm = cnt;
      cm = max(cm, __shfl_xor(cm, 16)); cm = max(cm, __shfl_xor(cm, 32));
      const int cmax = __builtin_amdgcn_readfirstlane(cm);
      const int nblk = (cmax + 15) >> 4;
#pragma unroll 1
      for (int rd = 0; rd < nblk; ++rd) {
        const int j = rd * 16 + lr;
        const unsigned my = row[j];
        int rank = 0;
#pragma unroll 1
        for (int b4 = 0; b4 < nblk; ++b4) {
          const uint4 v0 = *(const uint4*)(row + b4 * 16), v1 = *(const uint4*)(row + b4 * 16 + 4);
          const uint4 v2 = *(const uint4*)(row + b4 * 16 + 8), v3 = *(const uint4*)(row + b4 * 16 + 12);
          rank += (v0.x > my) ? 1 : 0; rank += (v0.y > my) ? 1 : 0; rank += (v0.z > my) ? 1 : 0; rank += (v0.w > my) ? 1 : 0;
          rank += (v1.x > my) ? 1 : 0; rank += (v1.y > my) ? 1 : 0; rank += (v1.z > my) ? 1 : 0; rank += (v1.w > my) ? 1 : 0;
          rank += (v2.x > my) ? 1 : 0; rank += (v2.y > my) ? 1 : 0; rank += (v2.z > my) ? 1 : 0; rank += (v2.w > my) ? 1 : 0;
          rank += (v3.x > my) ? 1 : 0; rank += (v3.y > my) ? 1 : 0; rank += (v3.z > my) ? 1 : 0; rank += (v3.w > my) ? 1 : 0;
        }
        if (j < cnt && rank < 16) {
          TV[(tk * 16 + hd * 2 + pp) * 16 + rank] = key_value(my);
          TI[(tk * 16 + hd * 2 + pp) * 16 + rank] = 127 - (int)(my & 127u);
        }
      }
    }
    WAVE_LDS_FENCE();
  }
  {
    const int cab = ((const int*)(smem + PE_OFF_CT))[lane];
    const int cand_a = cab >> 4, cand_b = cab & 15;
    unsigned* CWt = SV;
    float vals[16];
#pragma unroll
    for (int tk = 0; tk < 16; ++tk) {
      float val = 0.f;
      unsigned key = 0u;
      if (cand_a >= 0) {
        val = TV[(tk * 16 + hd * 2 + 0) * 16 + cand_a] + TV[(tk * 16 + hd * 2 + 1) * 16 + cand_b];
        const unsigned bb = __float_as_uint(val);
        key = ((bb ^ ((unsigned)((int)bb >> 31) | 0x80000000u)) & ~63u) | (unsigned)(63 - lane);
      }
      vals[tk] = val;
      CWt[tk * 64 + lane] = key;
    }
    WAVE_LDS_FENCE();
#pragma unroll
    for (int tk = 0; tk < 16; ++tk) {
      const unsigned key = CWt[tk * 64 + lane];
      int rank = 0;
#pragma unroll
      for (int i4 = 0; i4 < 13; ++i4) {
        const uint4 v = *(const uint4*)(CWt + tk * 64 + i4 * 4);
        rank += (v.x > key) ? 1 : 0; rank += (v.y > key) ? 1 : 0; rank += (v.z > key) ? 1 : 0; rank += (v.w > key) ? 1 : 0;
      }
      if (cand_a >= 0 && rank < 16) {
        GT[tk * 128 + hd * 16 + rank] = vals[tk];
        EX[tk * 128 + hd * 16 + rank] = TI[(tk * 16 + hd * 2 + 0) * 16 + cand_a] * 128 + TI[(tk * 16 + hd * 2 + 1) * 16 + cand_b];
      }
    }
    WAVE_LDS_FENCE();
#pragma unroll
    for (int pass = 0; pass < 4; ++pass) {
      const int tk = pass * 4 + lq;
      const float g = GT[tk * 128 + hd * 16 + lr];
      const float mx = GT[tk * 128 + hd * 16];
      const float ev = __expf(g - mx);
      float s = ev;
      s += __shfl_xor(s, 1); s += __shfl_xor(s, 2); s += __shfl_xor(s, 4); s += __shfl_xor(s, 8);
      const int ex = EX[tk * 128 + hd * 16 + lr];
      GT[tk * 128 + hd * 16 + lr] = (ev / s) * VSC[ex];
      SU[tk * 128 + hd * 16 + lr] = USC[ex];
    }
    WAVE_LDS_FENCE();
  }
}

typedef float f32x32 __attribute__((ext_vector_type(32)));
typedef unsigned u32x6 __attribute__((ext_vector_type(6)));
#define FP4_AXPY8(O, off, P, W) {                                                                    \
  const f32x2 _q0 = __builtin_amdgcn_cvt_scalef32_pk_f32_fp4((W), 1.0f, 0), _q1 = __builtin_amdgcn_cvt_scalef32_pk_f32_fp4((W), 1.0f, 1); \
  const f32x2 _q2 = __builtin_amdgcn_cvt_scalef32_pk_f32_fp4((W), 1.0f, 2), _q3 = __builtin_amdgcn_cvt_scalef32_pk_f32_fp4((W), 1.0f, 3); \
  O[(off) + 0] = fmaf(P, _q0.x, O[(off) + 0]); O[(off) + 1] = fmaf(P, _q0.y, O[(off) + 1]);          \
  O[(off) + 2] = fmaf(P, _q1.x, O[(off) + 2]); O[(off) + 3] = fmaf(P, _q1.y, O[(off) + 3]);          \
  O[(off) + 4] = fmaf(P, _q2.x, O[(off) + 4]); O[(off) + 5] = fmaf(P, _q2.y, O[(off) + 5]);          \
  O[(off) + 6] = fmaf(P, _q3.x, O[(off) + 6]); O[(off) + 7] = fmaf(P, _q3.y, O[(off) + 7]); }
struct Fp6Row { uint4 a; uint2 b; };
typedef __bf16 bf16x32_t __attribute__((ext_vector_type(32)));
__device__ __forceinline__ bf16x32_t fp6_decode_bf16(const Fp6Row& r) {
  u32x6 w; w[0] = r.a.x; w[1] = r.a.y; w[2] = r.a.z; w[3] = r.a.w; w[4] = r.b.x; w[5] = r.b.y;
  return __builtin_amdgcn_cvt_scalef32_pk32_bf16_fp6(w, 1.0f);
}
__device__ __forceinline__ f32x32 fp6_decode(const Fp6Row& r) {
  u32x6 w; w[0] = r.a.x; w[1] = r.a.y; w[2] = r.a.z; w[3] = r.a.w; w[4] = r.b.x; w[5] = r.b.y;
  return __builtin_amdgcn_cvt_scalef32_pk32_f32_fp6(w, 1.0f);
}
__device__ __forceinline__ void peer_gather_token(const Params& p, int layer, char* smem, int tok, int tl, int buf, int lane, bool dowrite) {
  const bf16_t* H2 = (const bf16_t*)(p.ws + OFF_ACT);
  const char* U6 = p.ws + OFF_U + (size_t)layer * NEXP * RECB;
  const float* mod = (const float*)(p.ws + OFF_MOD) + (size_t)layer * 9 * 6144;
  const int* EX = (const int*)(smem + PE_OFF_EX) + buf * 16 * 128 + tl * 128;
  const float* GT = (const float*)(smem + PE_OFF_GT) + buf * 16 * 128 + tl * 128;
  const float* SU = (const float*)(smem + PE_OFF_SU) + buf * 16 * 128 + tl * 128;
  const int l = lane & 31, hf = lane >> 5;
  float acc[32];
  bf16x2_t hvp[16];
  {
    const bf16_t* hr = H2 + (size_t)tok * 1024;
#pragma unroll
    for (int j = 0; j < 8; ++j) {
      const uint2 u = *(const uint2*)(hr + (l + 32 * j) * 4);
      hvp[2 * j] = __builtin_bit_cast(bf16x2_t, u.x); hvp[2 * j + 1] = __builtin_bit_cast(bf16x2_t, u.y);
    }
  }
#pragma unroll
  for (int i = 0; i < 32; ++i) acc[i] = 0.f;
  int one = 1;
  asm volatile("" : "+s"(one));
#define PE_LOAD(UU, VV, PI)                                                           \
  {                                                                                   \
    const int ex = EX[2 * (PI) + hf];                                                 \
    const char* up = U6 + (size_t)ex * RECB + l * 24;                                 \
    UU.a = *(const uint4*)up; UU.b = *(const uint2*)(up + 16);                        \
    VV = *(const uint4*)(U6 + (size_t)ex * RECB + ROWB + l * 16);                     \
  }
#define PE_USE(UU, VV, PI)                                                            \
  _Pragma("unroll 1") for (int rep_ = 0; rep_ < one; ++rep_) {                        \
    const bf16x32_t du = fp6_decode_bf16(UU);                                         \
    float d0 = 0.f, d1 = 0.f, d2 = 0.f, d3 = 0.f;                                     \
    _Pragma("unroll") for (int k = 0; k < 16; k += 4) {                               \
      d0 = __builtin_amdgcn_fdot2_f32_bf16((bf16x2_t){du[2 * k], du[2 * k + 1]}, hvp[k], d0, false);             \
      d1 = __builtin_amdgcn_fdot2_f32_bf16((bf16x2_t){du[2 * k + 2], du[2 * k + 3]}, hvp[k + 1], d1, false);     \
      d2 = __builtin_amdgcn_fdot2_f32_bf16((bf16x2_t){du[2 * k + 4], du[2 * k + 5]}, hvp[k + 2], d2, false);     \
      d3 = __builtin_amdgcn_fdot2_f32_bf16((bf16x2_t){du[2 * k + 6], du[2 * k + 7]}, hvp[k + 3], d3, false);     \
    }                                                                                 \
    const float r16 = row16_sum((d0 + d1) + (d2 + d3));                               \
    const int ir = __float_as_int(r16);                                               \
    const float s0 = __int_as_float(__builtin_amdgcn_readlane(ir, 0)) + __int_as_float(__builtin_amdgcn_readlane(ir, 16));  \
    const float s1 = __int_as_float(__builtin_amdgcn_readlane(ir, 32)) + __int_as_float(__builtin_amdgcn_readlane(ir, 48)); \
    const float d = (hf ? s1 : s0) * SU[2 * (PI) + hf];                               \
    const float w = GT[2 * (PI) + hf] * gelu_erf(d);                                  \
    FP4_AXPY8(acc, 0, w, VV.x) FP4_AXPY8(acc, 8, w, VV.y) FP4_AXPY8(acc, 16, w, VV.z) FP4_AXPY8(acc, 24, w, VV.w) \
  }
  Fp6Row u0, u1, u2, u3, u4;
  uint4 v0, v1, v2, v3, v4;
  PE_LOAD(u0, v0, 0) PE_LOAD(u1, v1, 1) PE_LOAD(u2, v2, 2) PE_LOAD(u3, v3, 3) PE_LOAD(u4, v4, 4)
#pragma unroll 1
  for (int pi = 0; pi < 55; pi += 5) {
    PE_USE(u0, v0, pi) PE_LOAD(u0, v0, pi + 5)
    PE_USE(u1, v1, pi + 1) PE_LOAD(u1, v1, pi + 6)
    PE_USE(u2, v2, pi + 2) PE_LOAD(u2, v2, pi + 7)
    PE_USE(u3, v3, pi + 3) PE_LOAD(u3, v3, pi + 8)
    PE_USE(u4, v4, pi + 4) PE_LOAD(u4, v4, pi + 9)
  }
  PE_USE(u0, v0, 55) PE_LOAD(u0, v0, 60)
  PE_USE(u1, v1, 56) PE_LOAD(u1, v1, 61)
  PE_USE(u2, v2, 57) PE_LOAD(u2, v2, 62)
  PE_USE(u3, v3, 58) PE_LOAD(u3, v3, 63)
  PE_USE(u4, v4, 59)
  PE_USE(u0, v0, 60) PE_USE(u1, v1, 61) PE_USE(u2, v2, 62) PE_USE(u3, v3, 63)
#pragma unroll
  for (int k = 0; k < 32; ++k) acc[k] += __shfl_xor(acc[k], 32);
  const int b = tok < NLAT ? (tok >> 12) : 8;
  float* xr = tok < NLAT ? p.out + (size_t)tok * 1024 : (float*)(p.ws + OFF_CTXB) + (size_t)(tok - NLAT) * 1024;
  const float* gate = mod + (size_t)b * 6144 + 5 * 1024;
  float4 xn[4];
  float ss = 0.f;
#pragma unroll
  for (int jj = 0; jj < 4; ++jj) {
    const int c = (l + 32 * (4 * hf + jj)) * 4;
    const float4 xv = *(const float4*)(xr + c);
    const float4 gv = *(const float4*)(gate + c);
    const float a0 = hf ? acc[16 + 4 * jj + 0] : acc[4 * jj + 0], a1 = hf ? acc[16 + 4 * jj + 1] : acc[4 * jj + 1];
    const float a2 = hf ? acc[16 + 4 * jj + 2] : acc[4 * jj + 2], a3 = hf ? acc[16 + 4 * jj + 3] : acc[4 * jj + 3];
    xn[jj].x = xv.x + gv.x * a0; xn[jj].y = xv.y + gv.y * a1; xn[jj].z = xv.z + gv.z * a2; xn[jj].w = xv.w + gv.w * a3;
    ss += xn[jj].x * xn[jj].x + xn[jj].y * xn[jj].y + xn[jj].z * xn[jj].z + xn[jj].w * xn[jj].w;
  }
  ss = wave_sum(ss);
  const float rinv = rsqrtf(ss * (1.f / 1024.f) + EPS);
  if (layer == 0) {
    const float* mod1 = (const float*)(p.ws + OFF_MOD) + (size_t)9 * 6144 + (size_t)b * 6144;
    const float* g1 = p.norm1_g + 1024;
    bf16_t* act = (bf16_t*)(p.ws + OFF_ACT) + (size_t)tok * 1024;
#pragma unroll
    for (int jj = 0; jj < 4; ++jj) {
      const int c = (l + 32 * (4 * hf + jj)) * 4;
      if (dowrite) *(float4*)(xr + c) = xn[jj]; else asm volatile("" :: "v"(xn[jj].x), "v"(xn[jj].y), "v"(xn[jj].z), "v"(xn[jj].w));
      const float4 gg4 = *(const float4*)(g1 + c);
      const float4 sh = *(const float4*)(mod1 + c);
      const float4 sc = *(const float4*)(mod1 + 1024 + c);
      uint2 o;
      o.x = pack2h(xn[jj].x * rinv * gg4.x * (1.f + sc.x) + sh.x, xn[jj].y * rinv * gg4.y * (1.f + sc.y) + sh.y);
      o.y = pack2h(xn[jj].z * rinv * gg4.z * (1.f + sc.z) + sh.z, xn[jj].w * rinv * gg4.w * (1.f + sc.w) + sh.w);
      if (dowrite) *(uint2*)(act + c) = o; else asm volatile("" :: "v"(o.x), "v"(o.y));
    }
  } else {
#pragma unroll
    for (int jj = 0; jj < 4; ++jj) {
      const int c = (l + 32 * (4 * hf + jj)) * 4;
      const float4 gg4 = *(const float4*)(p.final_g + c);
      float4 o;
      o.x = xn[jj].x * rinv * gg4.x; o.y = xn[jj].y * rinv * gg4.y; o.z = xn[jj].z * rinv * gg4.z; o.w = xn[jj].w * rinv * gg4.w;
      if (dowrite) *(float4*)(xr + c) = o; else asm volatile("" :: "v"(o.x), "v"(o.y), "v"(o.z), "v"(o.w));
    }
  }
}

__device__ __forceinline__ void phase_peer(const Params& p, int layer, char* smem, int ntok, bool dowrite = true) {
  const int tid = opaque_tid(), lane = tid & 63, wave = __builtin_amdgcn_readfirstlane(tid >> 6);
  __syncthreads();
  if (tid < 64) {
    int cab = -1, c = 0;
    for (int a = 0; a < 16; ++a)
      for (int bb = 0; bb < 16; ++bb)
        if ((a + 1) * (bb + 1) <= 16) { if (c == tid) cab = a * 16 + bb; ++c; }
    ((int*)(smem + PE_OFF_CT))[tid] = cab;
  }
  const int ngroups = ntok / 16, G = gridDim.x, g0 = opaque_bid();
  __syncthreads();
  for (int grp = g0; grp < ngroups; grp += G) {
    peer_select_head(p, layer, smem, grp * 16, wave, wave, 0, lane);
    __syncthreads();
#pragma unroll 1
    for (int tt = 0; tt < 2; ++tt) peer_gather_token(p, layer, smem, grp * 16 + wave * 2 + tt, wave * 2 + tt, 0, lane, dowrite);
    __syncthreads();
  }
}

template <int layer>
__device__ __forceinline__ void layer_body(const Params& p, char* smem, const XcdBarrier& xb) {
  constexpr bool nc = layer == 0;
  const float* xin = layer == 0 ? p.x : (const float*)p.out;
  if (layer == 0) {
    phase_norm(p, layer, 0, xin, NTOK);
    xcd_barrier(xb);
  }
#if REP_GEMM
  gemm_phase2<EPI_INPROJ>(p, layer, smem, (const bf16_t*)(p.ws + OFF_ACT), (const bf16_t*)(p.ws + OFF_WIN) + (size_t)layer * 3072 * 1024, NTOK, 3072, nullptr);
  xcd_barrier(xb);
#endif
  gemm_phase2<EPI_INPROJ>(p, layer, smem, (const bf16_t*)(p.ws + OFF_ACT), (const bf16_t*)(p.ws + OFF_WIN) + (size_t)layer * 3072 * 1024, NTOK, 3072, nullptr);
  xcd_barrier(xb);
#if REP_MIX1
  phase_mix1(p, layer, smem, 2);
  xcd_barrier(xb);
#endif
  phase_mix1(p, layer, smem);
  xcd_barrier(xb);
  phase_ret_scan(p, layer);
  xcd_barrier(xb);
#if REP_MIX2
  phase_mix2(p, layer, smem, 3);
  xcd_barrier(xb);
#endif
  phase_mix2(p, layer, smem);
  xcd_barrier(xb);
  gemm_phase2<EPI_OUTPROJ>(p, layer, smem, (const bf16_t*)(p.ws + OFF_ACT), (const bf16_t*)(p.ws + OFF_WOUT) + (size_t)layer * 1024 * 1024, nc ? NTOK : NLAT, 1024, xin);
  xcd_barrier(xb);
  phase_norm(p, layer, 1, (const float*)p.out, nc ? NTOK : NLAT);
  xcd_barrier(xb);
  gemm_phase2<EPI_PLAIN>(p, layer, smem, (const bf16_t*)(p.ws + OFF_ACT), (const bf16_t*)(p.ws + OFF_WQ) + (size_t)layer * 2048 * 1024, nc ? NTOK : NLAT, 2048, nullptr);
  xcd_barrier(xb);
#if REP_PEER
  phase_peer(p, layer, smem, nc ? NTOK : NLAT, false);
  xcd_barrier(xb);
#endif
  phase_peer(p, layer, smem, nc ? NTOK : NLAT);
  if (layer == 0) xcd_barrier(xb);
}

__global__ void __launch_bounds__(512) fwd_megakernel(Params p) {
  cg::grid_group grid = cg::this_grid();
  extern __shared__ __attribute__((aligned(16))) char smem[];
  volatile LAS3 unsigned* xst = (volatile LAS3 unsigned*)(smem + LDS_BCAST + 8);
  if (threadIdx.x == 0) { xst[0] = 0u; xst[1] = 0u; }
  phase_prep(p, smem);
  for (int it = blockIdx.x; it < 256; it += gridDim.x) uv_convert_item(p, it);
  grid.sync();
  const XcdBarrier xb = xcd_barrier_post((unsigned*)(p.ws + OFF_XBAR), xst);
  layer_body<0>(p, smem, xb);
  layer_body<1>(p, smem, xb);
}

extern "C" void kernel_launch(void* const* d_in, const int* in_sizes, int n_in, void* d_out,
                              int out_size, void* d_ws, size_t ws_size, hipStream_t stream) {
  constexpr size_t kDynLds = LDS_BYTES;
  static int grid_blocks = 0;
  if (!grid_blocks) {
    int dev = 0, cus = 0, per_cu = 0;
    (void)hipGetDevice(&dev);
    (void)hipDeviceGetAttribute(&cus, hipDeviceAttributeMultiprocessorCount, dev);
    (void)hipFuncSetAttribute((const void*)fwd_megakernel, hipFuncAttributeMaxDynamicSharedMemorySize, (int)kDynLds);
    (void)hipOccupancyMaxActiveBlocksPerMultiprocessor(&per_cu, fwd_megakernel, 512, kDynLds);
    if (per_cu < 1) { fprintf(stderr, "occupancy query says %d blocks/CU\n", per_cu); per_cu = 1; }
    grid_blocks = cus;
    if (ws_size < WS_END) fprintf(stderr, "workspace too small: %zu < %zu\n", ws_size, (size_t)WS_END);
  }
  Params p{};
  p.x = (const float*)d_in[0]; p.c = (const float*)d_in[1]; p.ctx = (const float*)d_in[2]; p.c_ctx = (const float*)d_in[3];
  p.w_ada = (const float*)d_in[4]; p.b_ada = (const float*)d_in[5]; p.norm1_g = (const float*)d_in[6]; p.w_in = (const float*)d_in[7];
  p.na_rpb = (const float*)d_in[8]; p.diff_lambda = (const float*)d_in[9]; p.diff_subln_g = (const float*)d_in[10];
  p.ret_decay_logit = (const float*)d_in[11]; p.w_out = (const float*)d_in[12]; p.norm2_g = (const float*)d_in[13];
  p.peer_wq = (const float*)d_in[14]; p.peer_subkeys = (const float*)d_in[15]; p.peer_u = (const float*)d_in[16];
  p.peer_v = (const float*)d_in[17]; p.final_g = (const float*)d_in[18];
  p.out = (float*)d_out; p.ws = (char*)d_ws;
  void* args[] = {&p};
  hipError_t e = hipLaunchCooperativeKernel((void*)fwd_megakernel, dim3(grid_blocks), dim3(512), args, kDynLds, stream);
  if (e != hipSuccess) fprintf(stderr, "cooperative launch failed: %s (grid %d)\n", hipGetErrorString(e), grid_blocks);
}
```

```cpp
#include <hip/hip_runtime.h>
#include <hip/hip_cooperative_groups.h>
#include <cstdio>
#include <cstdint>
namespace cg = cooperative_groups;

typedef unsigned short bf16_t;
typedef short bf16x8 __attribute__((ext_vector_type(8)));
typedef float f32x4 __attribute__((ext_vector_type(4)));

constexpr int DM = 1024, BATCH = 8, SEQ = 4096, LCTX = 256;
constexpr int NLAT = BATCH * SEQ;
constexpr int NCTX = BATCH * LCTX;
constexpr int NTOK = NLAT + NCTX;
constexpr int INC = 3072;
constexpr int C_NAQ = 0, C_NAK = 256, C_NAV = 512, C_DFQ = 768, C_DFK = 1024, C_DFV = 1280,
              C_RTQ = 1536, C_RTK = 1792, C_RTV = 2048, C_RTG = 2560;
constexpr int Y_NA = 0, Y_DF = 256, Y_RT = 512;
constexpr int NEXP = 16384;
constexpr float EPS = 1e-6f;

constexpr size_t OFF_CTL  = 0;
constexpr size_t OFF_MISC = 4096;
constexpr size_t OFF_ROPE = 8192;
constexpr size_t OFF_MOD  = OFF_ROPE + 12288;
constexpr size_t SZ_MOD   = 2ull * 9 * 6144 * 4;
constexpr size_t OFF_WIN  = OFF_MOD + SZ_MOD;
constexpr size_t SZ_WIN   = 2ull * 3072 * 1024 * 2;
constexpr size_t OFF_WOUT = OFF_WIN + SZ_WIN;
constexpr size_t SZ_WOUT  = 2ull * 1024 * 1024 * 2;
constexpr size_t OFF_WQ   = OFF_WOUT + SZ_WOUT;
constexpr size_t SZ_WQ    = 2ull * 2048 * 1024 * 2;
constexpr size_t OFF_SUBK = OFF_WQ + SZ_WQ;
constexpr size_t SZ_SUBK  = 2ull * 262144 * 2;
constexpr size_t OFF_U    = OFF_SUBK + SZ_SUBK;
constexpr int    ROWB     = 768;
constexpr int    ROWV     = 512;
constexpr int    RECB     = ROWB + ROWV;
constexpr size_t SZ_UV    = 2ull * NEXP * ROWB;
constexpr size_t OFF_V    = OFF_U + SZ_UV;
constexpr size_t OFF_USC  = OFF_V + SZ_UV;
constexpr size_t OFF_VSC  = OFF_USC + 2ull * NEXP * 4;
constexpr size_t OFF_ACT  = OFF_VSC + 2ull * NEXP * 4;
constexpr size_t SZ_ACT   = (size_t)NTOK * 1024 * 2;
constexpr size_t OFF_P    = OFF_ACT + SZ_ACT;
constexpr size_t SZ_P     = (size_t)NTOK * 3072 * 2;
constexpr size_t OFF_CTXB = OFF_P + SZ_P;
constexpr size_t SZ_CTXB  = (size_t)NCTX * 1024 * 4;
constexpr size_t OFF_RKV  = OFF_CTXB + SZ_CTXB;
constexpr size_t SZ_RKV   = 64ull * 32 * 8192 * 4;
constexpr size_t OFF_RS   = OFF_RKV + SZ_RKV;
constexpr size_t SZ_RS    = 64ull * 8192 * 4;
constexpr size_t OFF_XBAR = OFF_RS + SZ_RS;
constexpr size_t WS_END   = OFF_XBAR + 16384;

#ifndef REP_MIX1
#define REP_MIX1 0
#endif
#ifndef REP_MIX2
#define REP_MIX2 0
#endif
#ifndef REP_PEER
#define REP_PEER 0
#endif
#ifndef REP_GEMM
#define REP_GEMM 0
#endif
constexpr int LDS_BYTES = 152 * 1024;
constexpr int LDS_BCAST = LDS_BYTES - 16;

struct Params {
  const float *x, *c, *ctx, *c_ctx, *w_ada, *b_ada, *norm1_g, *w_in, *na_rpb, *diff_lambda, *diff_subln_g,
              *ret_decay_logit, *w_out, *norm2_g, *peer_wq, *peer_subkeys, *peer_u, *peer_v, *final_g;
  float* out;
  char* ws;
};

__device__ __forceinline__ float bf2f(bf16_t v) { return __uint_as_float(((unsigned)v) << 16); }
__device__ __forceinline__ bf16_t f2bf(float f) {
  unsigned u = __float_as_uint(f);
  u += 0x7fffu + ((u >> 16) & 1u);
  return (bf16_t)(u >> 16);
}
__device__ __forceinline__ unsigned pack2(float a, float b) { return (unsigned)f2bf(a) | ((unsigned)f2bf(b) << 16); }
typedef __bf16 bf16x2_t __attribute__((ext_vector_type(2)));
typedef float f32x2_t __attribute__((ext_vector_type(2)));
__device__ __forceinline__ unsigned pack2h(float a, float b) {
  const f32x2_t v = {a, b};
  return __builtin_bit_cast(unsigned, __builtin_convertvector(v, bf16x2_t));
}
__device__ __forceinline__ float lo16(unsigned w) { return __uint_as_float(w << 16); }
__device__ __forceinline__ float hi16(unsigned w) { return __uint_as_float(w & 0xffff0000u); }
#define DPP_ADD(v, CTRL) ((v) + __int_as_float(__builtin_amdgcn_update_dpp(0, __float_as_int(v), (CTRL), 0xf, 0xf, true)))
__device__ __forceinline__ float row16_sum(float v) {
  v = DPP_ADD(v, 0xB1);
  v = DPP_ADD(v, 0x4E);
  v = DPP_ADD(v, 0x141);
  v = DPP_ADD(v, 0x140);
  return v;
}
#define DPP_MOVU(v, CTRL) ((unsigned)__builtin_amdgcn_update_dpp(0, (int)(v), (CTRL), 0xf, 0xf, true))
__device__ __forceinline__ unsigned row16_max_u32(unsigned v) {
  v = max(v, DPP_MOVU(v, 0xB1)); v = max(v, DPP_MOVU(v, 0x4E)); v = max(v, DPP_MOVU(v, 0x141)); v = max(v, DPP_MOVU(v, 0x140));
  return v;
}
__device__ __forceinline__ unsigned row16_min_u32(unsigned v) {
  v = min(v, DPP_MOVU(v, 0xB1)); v = min(v, DPP_MOVU(v, 0x4E)); v = min(v, DPP_MOVU(v, 0x141)); v = min(v, DPP_MOVU(v, 0x140));
  return v;
}
template <int KTH>
__device__ __forceinline__ unsigned row16_kth_largest(unsigned v) {
  int cnt = 0;
#define R8_STEP(N) { const unsigned o = DPP_MOVU(v, 0x120 + (N)); cnt += (o > v) ? 1 : 0; }
  R8_STEP(1) R8_STEP(2) R8_STEP(3) R8_STEP(4) R8_STEP(5) R8_STEP(6) R8_STEP(7) R8_STEP(8)
  R8_STEP(9) R8_STEP(10) R8_STEP(11) R8_STEP(12) R8_STEP(13) R8_STEP(14) R8_STEP(15)
#undef R8_STEP
  return row16_max_u32(cnt >= KTH - 1 ? v : 0u);
}
__device__ __forceinline__ float wave_sum(float v) {
  v = row16_sum(v);
  const int iv = __float_as_int(v);
  const float a = __int_as_float(__builtin_amdgcn_readlane(iv, 0)), b = __int_as_float(__builtin_amdgcn_readlane(iv, 16));
  const float c = __int_as_float(__builtin_amdgcn_readlane(iv, 32)), d = __int_as_float(__builtin_amdgcn_readlane(iv, 48));
  return (a + b) + (c + d);
}
__device__ __forceinline__ float siluf(float x) { return x / (1.f + __expf(-x)); }

__device__ __forceinline__ int opaque_tid() { int t = threadIdx.x; asm volatile("" : "+v"(t)); return t; }
__device__ __forceinline__ int opaque_bid() { int t = blockIdx.x; asm volatile("" : "+s"(t)); return t; }

#define DOT8(acc, Q, off, U)                                                              \
  acc = fmaf(Q[(off) + 0], lo16((U).x), acc); acc = fmaf(Q[(off) + 1], hi16((U).x), acc); \
  acc = fmaf(Q[(off) + 2], lo16((U).y), acc); acc = fmaf(Q[(off) + 3], hi16((U).y), acc); \
  acc = fmaf(Q[(off) + 4], lo16((U).z), acc); acc = fmaf(Q[(off) + 5], hi16((U).z), acc); \
  acc = fmaf(Q[(off) + 6], lo16((U).w), acc); acc = fmaf(Q[(off) + 7], hi16((U).w), acc);
#define AXPY8(O, off, P, U)                                                                   \
  O[(off) + 0] = fmaf(P, lo16((U).x), O[(off) + 0]); O[(off) + 1] = fmaf(P, hi16((U).x), O[(off) + 1]); \
  O[(off) + 2] = fmaf(P, lo16((U).y), O[(off) + 2]); O[(off) + 3] = fmaf(P, hi16((U).y), O[(off) + 3]); \
  O[(off) + 4] = fmaf(P, lo16((U).z), O[(off) + 4]); O[(off) + 5] = fmaf(P, hi16((U).z), O[(off) + 5]); \
  O[(off) + 6] = fmaf(P, lo16((U).w), O[(off) + 6]); O[(off) + 7] = fmaf(P, hi16((U).w), O[(off) + 7]);
#define UNPACK8(Q, off, U)                                                  \
  Q[(off) + 0] = lo16((U).x); Q[(off) + 1] = hi16((U).x); Q[(off) + 2] = lo16((U).y); Q[(off) + 3] = hi16((U).y); \
  Q[(off) + 4] = lo16((U).z); Q[(off) + 5] = hi16((U).z); Q[(off) + 6] = lo16((U).w); Q[(off) + 7] = hi16((U).w);

__device__ __forceinline__ int next_item(unsigned* counter, char* smem) {
  volatile int* bc = (volatile int*)(smem + LDS_BCAST);
  __syncthreads();
  if (threadIdx.x == 0) *bc = (int)atomicAdd(counter, 1u);
  __syncthreads();
  return *bc;
}

#define XB_TMO      128
#define XB_XCNT(j)  (256  + 64 * (j))
#define XB_XSUB(j)  (1280 + 64 * (j))
#define XB_XGEN(j)  (2304 + 64 * (j))
#define XB_TOP      3328
#define XB_TOPGEN   3392
#define XCD_BAR_WORDS 3456
#define XB_SPIN_CAP (1u << 18)
#define LAS3 __attribute__((address_space(3)))
__device__ __forceinline__ unsigned xb_ld(unsigned* p)              { return __hip_atomic_load(p, __ATOMIC_RELAXED, __HIP_MEMORY_SCOPE_AGENT); }
__device__ __forceinline__ unsigned xb_add(unsigned* p, unsigned v) { return __hip_atomic_fetch_add(p, v, __ATOMIC_RELAXED, __HIP_MEMORY_SCOPE_AGENT); }
__device__ __forceinline__ unsigned xb_xcc_id() { return (unsigned)__builtin_amdgcn_s_getreg((3 << 11) | 20) & 0xFu; }
#define XB_SPIN(cond, bar) do { unsigned _sp = 0; while (cond) { __builtin_amdgcn_s_sleep(1); \
    if ((++_sp & 255u) == 0u) { if (xb_ld(&(bar)[XB_TMO])) break; if (_sp > XB_SPIN_CAP) { atomicAdd(&(bar)[XB_TMO], 1u); break; } } } } while (0)
struct XcdBarrier { unsigned* bar; unsigned x; volatile LAS3 unsigned* st; };
__device__ __forceinline__ XcdBarrier xcd_barrier_post(unsigned* bar, volatile LAS3 unsigned* st) {
  XcdBarrier b; b.bar = bar; b.x = xb_xcc_id(); b.st = st;
  if (threadIdx.x == 0) (void)xb_add(&bar[XB_XCNT(b.x)], 1u);
  return b;
}
__device__ __forceinline__ void xcd_barrier_complete(unsigned* bar, unsigned x, unsigned& nloc, unsigned& nx) {
  const unsigned G = gridDim.x * gridDim.y * gridDim.z;
  unsigned sum, cnt, mine, sp = 0u;
  for (;;) {
    sum = 0u; cnt = 0u; mine = 0u;
#pragma unroll
    for (unsigned j = 0; j < 16; ++j) { const unsigned c = xb_ld(&bar[XB_XCNT(j)]); sum += c; cnt += (c > 0u) ? 1u : 0u; mine = (j == x) ? c : mine; }
    if (sum == G) break;
    __builtin_amdgcn_s_sleep(1);
    if ((++sp & 255u) == 0u) { if (xb_ld(&bar[XB_TMO])) break; if (sp > XB_SPIN_CAP) { atomicAdd(&bar[XB_TMO], 1u); break; } }
  }
  nloc = mine > 0u ? mine : 1u; nx = cnt > 0u ? cnt : 1u;
}
__device__ __forceinline__ void xcd_barrier(const XcdBarrier& b) {
  asm volatile("s_waitcnt vmcnt(0)" ::: "memory");
  __syncthreads();
  if (threadIdx.x == 0) {
    unsigned* bar = b.bar;
    __builtin_amdgcn_s_waitcnt(0);
    unsigned nloc = b.st[0], nx = b.st[1];
    if (nloc == 0u) { xcd_barrier_complete(bar, b.x, nloc, nx); b.st[0] = nloc; b.st[1] = nx; }
    const unsigned old = xb_add(&bar[XB_XSUB(b.x)], 1u);
    const unsigned gen = old / nloc;
    if (old + 1u == (gen + 1u) * nloc) {
      __builtin_amdgcn_fence(__ATOMIC_RELEASE, "agent");
      asm volatile("s_waitcnt vmcnt(0)" ::: "memory");
      const unsigned og = xb_add(&bar[XB_TOP], 1u);
      const unsigned tg = og / nx;
      if (og + 1u == (tg + 1u) * nx) xb_add(&bar[XB_TOPGEN], 1u);
      else XB_SPIN(xb_ld(&bar[XB_TOPGEN]) == tg, bar);
      __builtin_amdgcn_fence(__ATOMIC_ACQUIRE, "agent");
      xb_add(&bar[XB_XGEN(b.x)], 1u);
      asm volatile("s_waitcnt vmcnt(0)" ::: "memory");
    } else {
      XB_SPIN(xb_ld(&bar[XB_XGEN(b.x)]) == gen, bar);
      __builtin_amdgcn_fence(__ATOMIC_ACQUIRE, "agent");
      asm volatile("s_waitcnt vmcnt(0)" ::: "memory");
    }
  }
  __syncthreads();
}

__device__ __forceinline__ void transpose_item(const float* src, bf16_t* dst, int K, int N, int item, char* smem) {
  float* t = (float*)smem;
  const int nb = N / 64;
  const int k0 = (item / nb) * 64, n0 = (item % nb) * 64;
  const int tid = opaque_tid();
  __syncthreads();
#pragma unroll
  for (int i = 0; i < 8; ++i) {
    const int k = (tid >> 6) + 8 * i, n = tid & 63;
    t[k * 65 + n] = src[(size_t)(k0 + k) * N + n0 + n];
  }
  __syncthreads();
#pragma unroll
  for (int i = 0; i < 8; ++i) {
    const int n = (tid >> 6) + 8 * i, k = tid & 63;
    dst[(size_t)(n0 + n) * K + k0 + k] = f2bf(t[k * 65 + n]);
  }
}

__device__ __forceinline__ void convert_flat(const float* src, bf16_t* dst, size_t n4) {
  const size_t gt = (size_t)opaque_bid() * blockDim.x + opaque_tid(), gs = (size_t)gridDim.x * blockDim.x;
  for (size_t i = gt; i < n4; i += gs) {
    const float4 v = ((const float4*)src)[i];
    uint2 o; o.x = pack2h(v.x, v.y); o.y = pack2h(v.z, v.w);
    ((uint2*)dst)[i] = o;
  }
}

__device__ __forceinline__ void phase_prep(const Params& p, char* smem) {
  const int tid = opaque_tid();
  char* ws = p.ws;
  if (opaque_bid() == 0) {
    unsigned* ctl = (unsigned*)(ws + OFF_CTL);
    if (tid < 64) ctl[tid] = 0u;
    unsigned* xbar = (unsigned*)(ws + OFF_XBAR);
    for (int i = tid; i < XCD_BAR_WORDS; i += 512) xbar[i] = 0u;
    float* misc = (float*)(ws + OFF_MISC);
    if (tid < 2) {
      const float* lp = p.diff_lambda + tid * 128;
      float s01 = 0.f, s23 = 0.f;
      for (int i = 0; i < 32; ++i) { s01 += lp[i] * lp[32 + i]; s23 += lp[64 + i] * lp[96 + i]; }
      const float lam_init = 0.8f - 0.6f * expf(-0.3f * (float)tid);
      misc[tid] = expf(s01) - expf(s23) + lam_init;
      misc[2 + tid] = lam_init;
    }
    if (tid >= 128 && tid < 256) misc[64 + tid - 128] = 0.f;
    if (tid >= 64 && tid < 80) {
      const int i = tid - 64;
      const float xv = p.ret_decay_logit[i];
      misc[16 + i] = -log1pf(expf(-xv));
    }
    float2* ropeD = (float2*)(ws + OFF_ROPE);
    float2* ropeR = (float2*)(ws + OFF_ROPE + 4096);
    for (int i = tid; i < 64 * 8; i += 512) {
      const int v = i >> 3, f = i & 7;
      const float inv = powf(10000.0f, -(float)(2 * f) / 16.0f);
      const float ang = (float)v * inv;
      ropeD[i] = make_float2(cosf(ang), sinf(ang));
    }
    for (int i = tid; i < 64 * 16; i += 512) {
      const int v = i >> 4, f = i & 15;
      const float inv = powf(10000.0f, -(float)(2 * f) / 32.0f);
      const float ang = (float)v * inv;
      ropeR[i] = make_float2(cosf(ang), sinf(ang));
    }
  }
  {
    float* sc = (float*)smem;
    float* red = (float*)(smem + 9 * 1024 * 4);
    float* mod = (float*)(ws + OFF_MOD);
    for (int item = opaque_bid(); item < 192; item += gridDim.x) {
      const int l = item / 96, cb = item % 96;
      __syncthreads();
      for (int i = tid; i < 9 * 1024; i += 512) {
        const int r = i >> 10, k = i & 1023;
        const float cv = (r < 8) ? p.c[r * 1024 + k] : p.c_ctx[k];
        sc[i] = siluf(cv);
      }
      __syncthreads();
      const int col = tid & 63, ks = tid >> 6;
      float acc[9];
#pragma unroll
      for (int r = 0; r < 9; ++r) acc[r] = 0.f;
      const float* w = p.w_ada + (size_t)l * 1024 * 6144 + cb * 64 + col;
#pragma unroll 1
      for (int k0 = ks * 128; k0 < ks * 128 + 128; k0 += 16) {
        float wv[16];
#pragma unroll
        for (int i = 0; i < 16; ++i) wv[i] = w[(size_t)(k0 + i) * 6144];
#pragma unroll
        for (int i = 0; i < 16; ++i)
#pragma unroll
          for (int r = 0; r < 9; ++r) acc[r] = fmaf(sc[r * 1024 + k0 + i], wv[i], acc[r]);
      }
#pragma unroll
      for (int r = 0; r < 9; ++r) red[(ks * 9 + r) * 64 + col] = acc[r];
      __syncthreads();
      for (int i = tid; i < 576; i += 512) {
        const int r = i >> 6, cc = i & 63;
        float s = 0.f;
#pragma unroll
        for (int k8 = 0; k8 < 8; ++k8) s += red[(k8 * 9 + r) * 64 + cc];
        mod[((size_t)l * 9 + r) * 6144 + cb * 64 + cc] = s + p.b_ada[l * 6144 + cb * 64 + cc];
      }
    }
    __syncthreads();
  }
  for (int item = opaque_bid(); item < 3072; item += gridDim.x) {
    const int l = item / 1536;
    int r = item % 1536;
    if (r < 768) transpose_item(p.w_in + (size_t)l * 1024 * 3072, (bf16_t*)(ws + OFF_WIN) + (size_t)l * 3072 * 1024, 1024, 3072, r, smem);
    else if (r < 1024) transpose_item(p.w_out + (size_t)l * 1024 * 1024, (bf16_t*)(ws + OFF_WOUT) + (size_t)l * 1024 * 1024, 1024, 1024, r - 768, smem);
    else transpose_item(p.peer_wq + (size_t)l * 1024 * 2048, (bf16_t*)(ws + OFF_WQ) + (size_t)l * 2048 * 1024, 1024, 2048, r - 1024, smem);
  }
  convert_flat(p.peer_subkeys, (bf16_t*)(ws + OFF_SUBK), 2ull * 262144 / 4);
  {
    const size_t gt = (size_t)opaque_bid() * blockDim.x + tid, gs = (size_t)gridDim.x * blockDim.x;
    float4* dst = (float4*)(ws + OFF_CTXB);
    for (size_t i = gt; i < (size_t)NCTX * 1024 / 4; i += gs) dst[i] = ((const float4*)p.ctx)[i];
  }
}

__device__ __forceinline__ void phase_norm(const Params& p, int layer, int which, const float* xlat, int nrows) {
  const int lane = opaque_tid() & 63;
  const int gw = opaque_bid() * 8 + (opaque_tid() >> 6), nw = gridDim.x * 8;
  const float* g = (which == 0 ? p.norm1_g : p.norm2_g) + layer * 1024;
  const float* mod = (const float*)(p.ws + OFF_MOD) + (size_t)layer * 9 * 6144;
  const float* ctxb = (const float*)(p.ws + OFF_CTXB);
  bf16_t* act = (bf16_t*)(p.ws + OFF_ACT);
  const int sh_off = which == 0 ? 0 : 3 * 1024, sc_off = which == 0 ? 1024 : 4 * 1024;
  for (int row = gw; row < nrows; row += nw) {
    const float* src = row < NLAT ? xlat + (size_t)row * 1024 : ctxb + (size_t)(row - NLAT) * 1024;
    const int b = row < NLAT ? (row >> 12) : 8;
    const float* mrow = mod + (size_t)b * 6144;
    float4 v[4];
    float ss = 0.f;
#pragma unroll
    for (int j = 0; j < 4; ++j) {
      v[j] = ((const float4*)src)[lane + 64 * j];
      ss += v[j].x * v[j].x + v[j].y * v[j].y + v[j].z * v[j].z + v[j].w * v[j].w;
    }
    ss = wave_sum(ss);
    const float r = rsqrtf(ss * (1.f / 1024.f) + EPS);
#pragma unroll
    for (int j = 0; j < 4; ++j) {
      const int c = (lane + 64 * j) * 4;
      const float4 gg = *(const float4*)(g + c);
      const float4 sh = *(const float4*)(mrow + sh_off + c);
      const float4 sc = *(const float4*)(mrow + sc_off + c);
      const float o0 = v[j].x * r * gg.x * (1.f + sc.x) + sh.x;
      const float o1 = v[j].y * r * gg.y * (1.f + sc.y) + sh.y;
      const float o2 = v[j].z * r * gg.z * (1.f + sc.z) + sh.z;
      const float o3 = v[j].w * r * gg.w * (1.f + sc.w) + sh.w;
      uint2 o; o.x = pack2h(o0, o1); o.y = pack2h(o2, o3);
      *(uint2*)(act + (size_t)row * 1024 + c) = o;
    }
  }
}

__device__ __forceinline__ void phase_final(const Params& p) {
  const int lane = opaque_tid() & 63;
  const int gw = opaque_bid() * 8 + (opaque_tid() >> 6), nw = gridDim.x * 8;
  for (int row = gw; row < NLAT; row += nw) {
    float* src = p.out + (size_t)row * 1024;
    float4 v[4];
    float ss = 0.f;
#pragma unroll
    for (int j = 0; j < 4; ++j) {
      v[j] = ((const float4*)src)[lane + 64 * j];
      ss += v[j].x * v[j].x + v[j].y * v[j].y + v[j].z * v[j].z + v[j].w * v[j].w;
    }
    ss = wave_sum(ss);
    const float r = rsqrtf(ss * (1.f / 1024.f) + EPS);
#pragma unroll
    for (int j = 0; j < 4; ++j) {
      const int c = (lane + 64 * j) * 4;
      const float4 gg = *(const float4*)(p.final_g + c);
      float4 o;
      o.x = v[j].x * r * gg.x; o.y = v[j].y * r * gg.y; o.z = v[j].z * r * gg.z; o.w = v[j].w * r * gg.w;
      ((float4*)src)[lane + 64 * j] = o;
    }
  }
}

constexpr int EPI_INPROJ = 0, EPI_OUTPROJ = 1, EPI_PLAIN = 2;
constexpr int GS = 72;
constexpr int G_ASTAGE = 256 * GS * 2;
constexpr int G_BSTAGE = 128 * GS * 2;
constexpr int G_STAGE = G_ASTAGE + G_BSTAGE;

namespace g8 {
constexpr int BM = 256, BK = 64, HALF = 128, NXCD = 8, WGM = 8, HT = HALF * BK;
__device__ __forceinline__ int lds_byte(int r, int c) {
  const int st = (r >> 4) * 2 + (c >> 5), rr = r & 15, cc = c & 31, ob = rr * 64 + cc * 2;
  return st * 1024 + (ob ^ (((ob >> 9) & 1) << 5));
}
__device__ __forceinline__ void stage_rc(int b, int& R, int& C) {
  const int st = b / 1024, sb = b % 1024, swz = sb ^ (((sb >> 9) & 1) << 5);
  R = (st >> 1) * 16 + swz / 64; C = (st & 1) * 32 + (swz % 64) / 2;
}
}

constexpr int G8_ROPE_LDS = 8 * 16384;
template <int EPI>
__device__ __forceinline__ void epi_store8(const Params& p, int layer, char* smem, int m, int n, f32x4 lo, f32x4 hi, const float* xin_lat) {
  float v[8] = {lo[0], lo[1], lo[2], lo[3], hi[0], hi[1], hi[2], hi[3]};
  if constexpr (EPI == EPI_INPROJ) {
    const bool ropeD = (n >= C_DFQ && n < C_DFV), ropeR = (n >= C_RTQ && n < C_RTV);
    if ((ropeD || ropeR) && m < NLAT) {
      const int t = m & 4095, gr = t >> 6, gc = t & 63;
      const float2* tabD = (const float2*)(smem + G8_ROPE_LDS);
      const float2* tabR = (const float2*)(smem + G8_ROPE_LDS + 4096);
      const float2* tb;
      if (ropeD) { const int i0 = (n & 31) >> 1; tb = i0 < 8 ? tabD + gr * 8 + i0 : tabD + gc * 8 + i0 - 8; }
      else { const int i0 = (n & 63) >> 1; tb = i0 < 16 ? tabR + gr * 16 + i0 : tabR + gc * 16 + i0 - 16; }
#pragma unroll
      for (int q = 0; q < 4; ++q) {
        const float2 cs = tb[q];
        const float a0 = v[2 * q] * cs.x - v[2 * q + 1] * cs.y, a1 = v[2 * q] * cs.y + v[2 * q + 1] * cs.x;
        v[2 * q] = a0; v[2 * q + 1] = a1;
      }
    }
    float sc = 1.f;
    if (n < C_NAK) sc = 0.125f * 1.4426950408889634f;
    else if (n >= C_DFQ && n < C_DFK) sc = 0.17677669529663687f * 1.4426950408889634f;
    else if (n >= C_RTK && n < C_RTV) sc = 0.125f;
    uint4 o;
    o.x = pack2h(v[0] * sc, v[1] * sc); o.y = pack2h(v[2] * sc, v[3] * sc); o.z = pack2h(v[4] * sc, v[5] * sc); o.w = pack2h(v[6] * sc, v[7] * sc);
    *(uint4*)((bf16_t*)(p.ws + OFF_P) + (size_t)m * INC + n) = o;
  } else if constexpr (EPI == EPI_OUTPROJ) {
    const float* mod = (const float*)(p.ws + OFF_MOD) + (size_t)layer * 9 * 6144;
    const int b = m < NLAT ? (m >> 12) : 8;
    const float* gp = mod + (size_t)b * 6144 + 2 * 1024 + n;
    const float4 g0 = *(const float4*)gp, g1 = *(const float4*)(gp + 4);
    const float* xi; float* xo;
    if (m < NLAT) { xi = xin_lat + (size_t)m * 1024 + n; xo = p.out + (size_t)m * 1024 + n; }
    else { xo = (float*)(p.ws + OFF_CTXB) + (size_t)(m - NLAT) * 1024 + n; xi = xo; }
    const float4 x0 = *(const float4*)xi, x1 = *(const float4*)(xi + 4);
    float4 o0, o1;
    o0.x = x0.x + g0.x * v[0]; o0.y = x0.y + g0.y * v[1]; o0.z = x0.z + g0.z * v[2]; o0.w = x0.w + g0.w * v[3];
    o1.x = x1.x + g1.x * v[4]; o1.y = x1.y + g1.y * v[5]; o1.z = x1.z + g1.z * v[6]; o1.w = x1.w + g1.w * v[7];
    *(float4*)xo = o0; *(float4*)(xo + 4) = o1;
  } else if constexpr (EPI == EPI_PLAIN) {
    uint4 o;
    o.x = pack2h(v[0], v[1]); o.y = pack2h(v[2], v[3]); o.z = pack2h(v[4], v[5]); o.w = pack2h(v[6], v[7]);
    *(uint4*)((bf16_t*)(p.ws + OFF_P) + (size_t)m * 2048 + n) = o;
  } else {
    asm volatile("" :: "v"(v[0]), "v"(v[1]), "v"(v[2]), "v"(v[3]), "v"(v[4]), "v"(v[5]), "v"(v[6]), "v"(v[7]));
  }
}

#define G8_LAS __attribute__((address_space(3)))
__device__ __forceinline__ bool g8_next(int i, int nM, int nN, int G, int c, int& pm, int& pn) {
  using namespace g8;
  const int nwg = nM * nN;
  const long Lx = (long)i * G + c;
  if (Lx >= nwg) return false;
  int wgid = (int)Lx;
  { const int q = nwg / NXCD, r = nwg % NXCD, xcd = wgid % NXCD, off = wgid / NXCD; wgid = (xcd < r ? xcd * (q + 1) : r * (q + 1) + (xcd - r) * q) + off; }
  const int nig = WGM * nN, gid = wgid / nig, fm = gid * WGM, gsz = (nM - fm) < WGM ? (nM - fm) : WGM;
  pm = fm + ((wgid % nig) % gsz); pn = (wgid % nig) / gsz;
  return true;
}

template <int EPI>
__device__ __forceinline__ void gemm_phase2(const Params& p, int layer, char* smem, const bf16_t* A, const bf16_t* Bt,
                                            int M, int N, const float* xin_lat) {
  using namespace g8;
  constexpr int K = 1024, nt = K / BK, HTB = HALF * BK * 2;
  G8_LAS unsigned char* lds = (G8_LAS unsigned char*)smem;
  const int tid = opaque_tid();
  const int wid = __builtin_amdgcn_readfirstlane(tid >> 6), lane = tid & 63, wr = wid >> 2, wc = wid & 3, fr = lane & 15, fq = lane >> 4;
  unsigned voff[2], voffB[2];
#pragma unroll
  for (int i = 0; i < 2; ++i) {
    int R, C; stage_rc(tid * 16 + i * 8192, R, C);
    const int rho = R & 31, Rb = (R & ~31) + 8 * ((rho & 15) >> 2) + 4 * (rho >> 4) + (rho & 3);
    voff[i] = (unsigned)(R * K + C) * 2u; voffB[i] = (unsigned)(Rb * K + C) * 2u;
  }
  if constexpr (EPI == EPI_INPROJ) {
    __syncthreads();
    const float4* gsrc = (const float4*)(p.ws + OFF_ROPE);
    float4* ldst = (float4*)(smem + G8_ROPE_LDS);
    for (int i = tid; i < 12288 / 16; i += 512) ldst[i] = gsrc[i];
  }
  constexpr size_t kstep = (size_t)(BK * 2);
  constexpr size_t hstep = (size_t)HALF * K * 2;
  constexpr size_t tstep = 2 * hstep;
  const unsigned ldsw = (unsigned)wid * 1024u;
  const int aoff = lds_byte(wr * 64 + fr, fq * 8), boff = lds_byte(wc * 32 + fr, fq * 8);
#define G8_SA(b, h) (((b) * 2 + (h)) * HTB)
#define G8_SB(b, h) ((4 + (b) * 2 + (h)) * HTB)
#define G8_STAGE_V(bufoff, gbase, VO) do { _Pragma("unroll") for (int _i = 0; _i < 2; ++_i)                                  \
    __builtin_amdgcn_global_load_lds((const unsigned*)((const char*)(gbase) + VO[_i]), (G8_LAS unsigned*)(lds + (bufoff) + ldsw + _i * 8192), 16, 0, 0); } while (0)
#define G8_LDA(dst, b, h) do { _Pragma("unroll") for (int m = 0; m < 4; ++m) _Pragma("unroll") for (int k = 0; k < 2; ++k) dst[m][k] = *(const G8_LAS bf16x8*)(lds + G8_SA(b, h) + aoff + m * 2048 + k * 1024); } while (0)
#define G8_LDB(dst, b, h) do { _Pragma("unroll") for (int n = 0; n < 2; ++n) _Pragma("unroll") for (int k = 0; k < 2; ++k) dst[n][k] = *(const G8_LAS bf16x8*)(lds + G8_SB(b, h) + boff + n * 2048 + k * 1024); } while (0)
#define G8_MMA(ai, bj, At_, Bt_) do { __builtin_amdgcn_s_setprio(1);                                                          \
    _Pragma("unroll") for (int m = 0; m < 4; ++m) _Pragma("unroll") for (int n = 0; n < 2; ++n) _Pragma("unroll") for (int k = 0; k < 2; ++k) \
      acc[ai][bj][m][n] = __builtin_amdgcn_mfma_f32_16x16x32_bf16(Bt_[n][k], At_[m][k], acc[ai][bj][m][n], 0, 0, 0);          \
    __builtin_amdgcn_s_setprio(0); } while (0)
#define G8_WAIT_V(n) asm volatile("s_waitcnt vmcnt(" #n ")" ::: "memory")
#define G8_WAIT_L(n) asm volatile("s_waitcnt lgkmcnt(" #n ")" ::: "memory")
#define G8_BAR __builtin_amdgcn_s_barrier()
#define G8_SCHED __builtin_amdgcn_sched_barrier(0)
  const int nM = M / BM, nN = N / BM, G = gridDim.x, cu = opaque_bid();
  int cpm, cpn, npm = 0, npn = 0, ui = 0;
  __syncthreads();
  if (g8_next(0, nM, nN, G, cu, cpm, cpn)) {
    f32x4 acc[2][2][4][2];
#pragma unroll
    for (int a = 0; a < 2; ++a)
#pragma unroll
      for (int b2 = 0; b2 < 2; ++b2)
#pragma unroll
        for (int m = 0; m < 4; ++m)
#pragma unroll
          for (int n = 0; n < 2; ++n) acc[a][b2][m][n] = (f32x4){0.f, 0.f, 0.f, 0.f};
    bf16x8 At[4][2], B0[2][2], B1[2][2];
    const char* cA = (const char*)A + (size_t)cpm * tstep;
    const char* cB = (const char*)Bt + (size_t)cpn * tstep;
    G8_STAGE_V(G8_SB(0, 0), cB, voffB); G8_STAGE_V(G8_SA(0, 0), cA, voff); G8_STAGE_V(G8_SB(0, 1), cB + hstep, voffB); G8_STAGE_V(G8_SA(0, 1), cA + hstep, voff);
    if (wr == 1) G8_BAR;
    G8_WAIT_V(4); G8_BAR;
    G8_STAGE_V(G8_SB(1, 0), cB + kstep, voffB); G8_STAGE_V(G8_SA(1, 0), cA + kstep, voff); G8_STAGE_V(G8_SB(1, 1), cB + hstep + kstep, voffB);
    G8_WAIT_V(6); G8_BAR;
    for (;;) {
      const bool has_next = g8_next(ui + 1, nM, nN, G, cu, npm, npn);
      const char* nA = has_next ? (const char*)A + (size_t)npm * tstep : cA;
      const char* nB = has_next ? (const char*)Bt + (size_t)npn * tstep : cB;
#pragma unroll 1
      for (int t = 0; t < nt; t += 2) {
        const bool last = (t == nt - 2);
        const char* a1 = cA + (size_t)(t + 1) * kstep;
        const char* a2 = last ? nA : cA + (size_t)(t + 2) * kstep; const char* b2 = last ? nB : cB + (size_t)(t + 2) * kstep;
        const char* a3 = a2 + kstep; const char* b3 = b2 + kstep;
        G8_LDB(B0, 0, 0); G8_SCHED; G8_LDA(At, 0, 0); G8_STAGE_V(G8_SA(1, 1), a1 + hstep, voff);
        G8_WAIT_L(8); G8_BAR; G8_WAIT_L(0); G8_MMA(0, 0, At, B0); G8_BAR; G8_SCHED;
        G8_LDB(B1, 0, 1); G8_STAGE_V(G8_SB(0, 0), b2, voffB);
        G8_BAR; G8_WAIT_L(0); G8_MMA(0, 1, At, B1); G8_BAR;
        G8_LDA(At, 0, 1); G8_STAGE_V(G8_SA(0, 0), a2, voff);
        G8_BAR; G8_WAIT_L(0); G8_MMA(1, 0, At, B0); G8_BAR; G8_SCHED;
        G8_STAGE_V(G8_SB(0, 1), b2 + hstep, voffB);
        G8_WAIT_V(6); G8_BAR; G8_MMA(1, 1, At, B1); G8_BAR;
        G8_LDB(B0, 1, 0); G8_SCHED; G8_LDA(At, 1, 0); G8_STAGE_V(G8_SA(0, 1), a2 + hstep, voff);
        G8_WAIT_L(8); G8_BAR; G8_WAIT_L(0); G8_MMA(0, 0, At, B0); G8_BAR; G8_SCHED;
        G8_LDB(B1, 1, 1); G8_STAGE_V(G8_SB(1, 0), b3, voffB);
        G8_BAR; G8_WAIT_L(0); G8_MMA(0, 1, At, B1); G8_BAR;
        G8_LDA(At, 1, 1); G8_STAGE_V(G8_SA(1, 0), a3, voff);
        G8_BAR; G8_WAIT_L(0); G8_MMA(1, 0, At, B0); G8_BAR; G8_SCHED;
        G8_STAGE_V(G8_SB(1, 1), b3 + hstep, voffB);
        G8_WAIT_V(6); G8_BAR; G8_MMA(1, 1, At, B1); G8_BAR;
      }
      {
        const int brow = cpm * BM, bcol = cpn * BM;
        if constexpr (EPI == EPI_INPROJ) {
          if (bcol == C_DFK) {
#pragma unroll
            for (int bj = 0; bj < 2; ++bj) {
              float mx = 0.f;
#pragma unroll
              for (int ai = 0; ai < 2; ++ai)
#pragma unroll
                for (int m = 0; m < 4; ++m) {
                  float s = 0.f;
#pragma unroll
                  for (int n = 0; n < 2; ++n)
#pragma unroll
                    for (int j = 0; j < 4; ++j) s = fmaf(acc[ai][bj][m][n][j], acc[ai][bj][m][n][j], s);
                  s += __shfl_xor(s, 16); s += __shfl_xor(s, 32);
                  mx = fmaxf(mx, s);
                }
#pragma unroll
              for (int o = 1; o < 16; o <<= 1) mx = fmaxf(mx, __shfl_xor(mx, o));
              if (lane == 0) {
                const int bb = brow < NLAT ? (brow >> 12) : ((brow - NLAT) >> 8);
                unsigned* km = (unsigned*)(p.ws + OFF_MISC) + 64 + layer * 64 + (bb * 4 + bj * 2 + (wc >> 1)) * 2 + (wc & 1);
                atomicMax(km, __float_as_uint(mx));
              }
            }
          }
        }
#pragma unroll
        for (int ai = 0; ai < 2; ++ai)
#pragma unroll
          for (int bj = 0; bj < 2; ++bj)
#pragma unroll
            for (int m = 0; m < 4; ++m)
              epi_store8<EPI>(p, layer, smem, brow + ai * HALF + wr * 64 + m * 16 + fr, bcol + bj * HALF + wc * 32 + fq * 8,
                              acc[ai][bj][m][0], acc[ai][bj][m][1], xin_lat);
      }
      if (!has_next) break;
#pragma unroll
      for (int a = 0; a < 2; ++a)
#pragma unroll
        for (int b2 = 0; b2 < 2; ++b2)
#pragma unroll
          for (int m = 0; m < 4; ++m)
#pragma unroll
            for (int n = 0; n < 2; ++n) acc[a][b2][m][n] = (f32x4){0.f, 0.f, 0.f, 0.f};
      cpm = npm; cpn = npn; cA = nA; cB = nB; ++ui;
    }
    G8_WAIT_V(0);
    if (wr == 0) G8_BAR;
    G8_BAR;
  }
}

__device__ __forceinline__ unsigned cvt_pk_bf16(float lo, float hi) { return pack2h(lo, hi); }
__device__ __forceinline__ void vt_store8(bf16_t* vt, int stride, int d0, int key, uint4 uv) {
  bf16_t* vd = vt + d0 * stride + key;
  vd[0 * stride] = (bf16_t)(uv.x & 0xffffu); vd[1 * stride] = (bf16_t)(uv.x >> 16);
  vd[2 * stride] = (bf16_t)(uv.y & 0xffffu); vd[3 * stride] = (bf16_t)(uv.y >> 16);
  vd[4 * stride] = (bf16_t)(uv.z & 0xffffu); vd[5 * stride] = (bf16_t)(uv.z >> 16);
  vd[6 * stride] = (bf16_t)(uv.w & 0xffffu); vd[7 * stride] = (bf16_t)(uv.w >> 16);
}

constexpr int DKS = 72;
__device__ __forceinline__ void diff_item(const Params& p, int layer, bool ctxq, int item, char* smem) {
  const bf16_t* P = (const bf16_t*)(p.ws + OFF_P);
  bf16_t* Y = (bf16_t*)(p.ws + OFF_ACT);
  const float* misc = (const float*)(p.ws + OFF_MISC);
  const float lam = misc[layer], lam_init = misc[2 + layer];
  const int tid = opaque_tid(), lane = tid & 63, wave = tid >> 6, lr = lane & 15, lq = lane >> 4;
  int b, h, mbase, nkeys;
  if (!ctxq) { b = item >> 6; h = (item >> 4) & 3; mbase = b * 4096 + (item & 15) * 256; nkeys = 256 + 4096; }
  else { b = item >> 2; h = item & 3; mbase = NLAT + b * 256; nkeys = 256; }
  const float kmax0 = sqrtf(misc[64 + layer * 64 + (b * 4 + h) * 2 + 0]), kmax1 = sqrtf(misc[64 + layer * 64 + (b * 4 + h) * 2 + 1]);
  bf16x8 qf[2][2];
  f32x4 C0[2], C1[2];
#pragma unroll
  for (int qt = 0; qt < 2; ++qt) {
    const bf16_t* qr = P + (size_t)(mbase + wave * 32 + qt * 16 + lr) * INC + C_DFQ + h * 64 + lq * 8;
    const uint4 u0 = *(const uint4*)(qr), u1 = *(const uint4*)(qr + 32);
    float s0 = 0.f, s1 = 0.f;
    { float t[8]; UNPACK8(t, 0, u0) _Pragma("unroll") for (int i = 0; i < 8; ++i) s0 = fmaf(t[i], t[i], s0); }
    { float t[8]; UNPACK8(t, 0, u1) _Pragma("unroll") for (int i = 0; i < 8; ++i) s1 = fmaf(t[i], t[i], s1); }
    s0 += __shfl_xor(s0, 16); s0 += __shfl_xor(s0, 32);
    s1 += __shfl_xor(s1, 16); s1 += __shfl_xor(s1, 32);
    const float nm0 = -sqrtf(s0) * kmax0, nm1 = -sqrtf(s1) * kmax1;
    C0[qt] = (f32x4){nm0, nm0, nm0, nm0};
    C1[qt] = (f32x4){nm1, nm1, nm1, nm1};
    union { uint4 u; bf16x8 v; } c0, c1; c0.u = u0; c1.u = u1;
    qf[qt][0] = c0.v; qf[qt][1] = c1.v;
  }
  f32x4 O0[2][4], O1[2][4];
#pragma unroll
  for (int qt = 0; qt < 2; ++qt)
#pragma unroll
    for (int i = 0; i < 4; ++i) { O0[qt][i] = (f32x4){0.f, 0.f, 0.f, 0.f}; O1[qt][i] = (f32x4){0.f, 0.f, 0.f, 0.f}; }
  f32x4 L0[2], L1[2];
#pragma unroll
  for (int qt = 0; qt < 2; ++qt) { L0[qt] = (f32x4){0.f, 0.f, 0.f, 0.f}; L1[qt] = (f32x4){0.f, 0.f, 0.f, 0.f}; }
  const bf16x8 ones8 = {(short)0x3F80, (short)0x3F80, (short)0x3F80, (short)0x3F80, (short)0x3F80, (short)0x3F80, (short)0x3F80, (short)0x3F80};
  const int lkey = tid >> 3, lch = tid & 7;
  constexpr int DBUF = 2 * 128 * DKS * 2;
  uint4 ukA0, ukA1, uvA0, uvA1;
#define DF_GLOAD1(UK, UV, T, I)                                                                     \
  {                                                                                                 \
    const int kk = (T) * 128 + (I) * 64 + lkey;                                                     \
    const size_t row = kk < 256 ? (size_t)(NLAT + b * 256 + kk) : (size_t)(b * 4096 + kk - 256);    \
    UK = *(const uint4*)(P + row * INC + C_DFK + h * 64 + lch * 8);                                 \
    UV = *(const uint4*)(P + row * INC + C_DFV + h * 64 + lch * 8);                                 \
  }
#define DF_LSTORE1(UK, UV, BUF, I)                                                                  \
  {                                                                                                 \
    bf16_t* Ks_ = (bf16_t*)(smem + (BUF) * DBUF) + (I) * 64 * DKS;                                  \
    bf16_t* Vt_ = (bf16_t*)(smem + (BUF) * DBUF) + 128 * DKS + (I) * 64 * DKS;                      \
    *(uint4*)(Ks_ + lkey * DKS + lch * 8) = UK;                                                     \
    vt_store8(Vt_, DKS, lch * 8, lkey, UV);                                                         \
  }
#define DF_GLOAD(S, T) DF_GLOAD1(uk##S##0, uv##S##0, T, 0) DF_GLOAD1(uk##S##1, uv##S##1, T, 1)
#define DF_LSTORE(S, BUF) DF_LSTORE1(uk##S##0, uv##S##0, BUF, 0) DF_LSTORE1(uk##S##1, uv##S##1, BUF, 1)
  const int ntile = nkeys >> 7;
  __syncthreads();
  DF_GLOAD(A, 0)
  DF_LSTORE(A, 0)
  __syncthreads();
#pragma unroll 1
  for (int t = 0; t < ntile; ++t) {
    const int cur = t & 1;
    if (t + 1 < ntile) { DF_GLOAD(A, t + 1) }
#pragma unroll 1
    for (int sub = 0; sub < 2; ++sub) {
    const bf16_t* Ks = (const bf16_t*)(smem + cur * DBUF) + sub * 64 * DKS;
    const bf16_t* Vt = (const bf16_t*)(smem + cur * DBUF) + 128 * DKS + sub * 64 * DKS;
    union PF { unsigned u[4]; bf16x8 v; };
    PF pf0[2][2], pf1[2][2];
#pragma unroll
    for (int c = 0; c < 2; ++c) {
      f32x4 S[2][4];
#pragma unroll
      for (int kt = 0; kt < 4; ++kt) {
        const bf16x8 kf = *(const bf16x8*)(Ks + (kt * 16 + lr) * DKS + c * 32 + lq * 8);
#pragma unroll
        for (int qt = 0; qt < 2; ++qt) S[qt][kt] = __builtin_amdgcn_mfma_f32_16x16x32_bf16(kf, qf[qt][c], c == 0 ? C0[qt] : C1[qt], 0, 0, 0);
      }
#pragma unroll
      for (int qt = 0; qt < 2; ++qt) {
#pragma unroll
        for (int kt = 0; kt < 4; ++kt) {
#pragma unroll
          for (int r = 0; r < 4; ++r) S[qt][kt][r] = __builtin_amdgcn_exp2f(S[qt][kt][r]);
        }
#pragma unroll
        for (int g = 0; g < 2; ++g) {
          PF t;
          t.u[0] = cvt_pk_bf16(S[qt][2 * g][0], S[qt][2 * g][1]); t.u[1] = cvt_pk_bf16(S[qt][2 * g][2], S[qt][2 * g][3]);
          t.u[2] = cvt_pk_bf16(S[qt][2 * g + 1][0], S[qt][2 * g + 1][1]); t.u[3] = cvt_pk_bf16(S[qt][2 * g + 1][2], S[qt][2 * g + 1][3]);
          if (c == 0) pf0[qt][g] = t; else pf1[qt][g] = t;
        }
      }
    }
#pragma unroll
    for (int g = 0; g < 2; ++g) {
#pragma unroll
      for (int qt = 0; qt < 2; ++qt) {
        L0[qt] = __builtin_amdgcn_mfma_f32_16x16x32_bf16(ones8, pf0[qt][g].v, L0[qt], 0, 0, 0);
        L1[qt] = __builtin_amdgcn_mfma_f32_16x16x32_bf16(ones8, pf1[qt][g].v, L1[qt], 0, 0, 0);
      }
#pragma unroll
      for (int dt = 0; dt < 4; ++dt) {
        union { uint2 h2[2]; bf16x8 v; } vf;
        vf.h2[0] = *(const uint2*)(Vt + (dt * 16 + lr) * DKS + 32 * g + 4 * lq);
        vf.h2[1] = *(const uint2*)(Vt + (dt * 16 + lr) * DKS + 32 * g + 16 + 4 * lq);
#pragma unroll
        for (int qt = 0; qt < 2; ++qt) {
          O0[qt][dt] = __builtin_amdgcn_mfma_f32_16x16x32_bf16(vf.v, pf0[qt][g].v, O0[qt][dt], 0, 0, 0);
          O1[qt][dt] = __builtin_amdgcn_mfma_f32_16x16x32_bf16(vf.v, pf1[qt][g].v, O1[qt][dt], 0, 0, 0);
        }
      }
    }
    }
    if (t + 1 < ntile) { DF_LSTORE(A, cur ^ 1) }
    __syncthreads();
  }
  const float* sg = p.diff_subln_g + layer * 64;
#pragma unroll
  for (int qt = 0; qt < 2; ++qt) {
    const float a0 = L0[qt][0], a1 = L1[qt][0];
    const float i0 = 1.f / a0, i1 = lam / a1;
    float ss = 0.f;
#pragma unroll
    for (int dt = 0; dt < 4; ++dt) {
#pragma unroll
      for (int r = 0; r < 4; ++r) { const float v = O0[qt][dt][r] * i0 - O1[qt][dt][r] * i1; O0[qt][dt][r] = v; ss = fmaf(v, v, ss); }
    }
    ss += __shfl_xor(ss, 16); ss += __shfl_xor(ss, 32);
    const float rr = rsqrtf(ss * (1.f / 64.f) + EPS) * (1.f - lam_init);
    bf16_t* dst = Y + (size_t)(mbase + wave * 32 + qt * 16 + lr) * 1024 + Y_DF + h * 64;
#pragma unroll
    for (int dt = 0; dt < 4; ++dt) {
      const int d = dt * 16 + 4 * lq;
      const float4 g4 = *(const float4*)(sg + d);
      uint2 ov;
      ov.x = pack2(O0[qt][dt][0] * rr * g4.x, O0[qt][dt][1] * rr * g4.y);
      ov.y = pack2(O0[qt][dt][2] * rr * g4.z, O0[qt][dt][3] * rr * g4.w);
      *(uint2*)(dst + d) = ov;
    }
  }
}

constexpr int NA_WS = 520;
constexpr int NA_CS = 264;
constexpr int NA_OFF_VTW = 0;
constexpr int NA_OFF_VTC = 64 * NA_WS * 2;
constexpr int NA_OFF_RPB = NA_OFF_VTC + 64 * NA_CS * 2;
constexpr int NA_OFF_MRG = NA_OFF_RPB + 2048;

#define NA_STEP(KA_EXPR, KB_EXPR, BIAS_EXPR, VT_PTR, VT_STRIDE, VT_KEY0_EXPR)                                    \
  {                                                                                                               \
    f32x4 S[4];                                                                                                   \
    _Pragma("unroll") for (int kt = 0; kt < 4; ++kt) {                                                            \
      f32x4 a = __builtin_amdgcn_mfma_f32_16x16x32_bf16((KA_EXPR), qf[0], (f32x4){0.f, 0.f, 0.f, 0.f}, 0, 0, 0);  \
      S[kt] = __builtin_amdgcn_mfma_f32_16x16x32_bf16((KB_EXPR), qf[1], a, 0, 0, 0);                               \
    }                                                                                                             \
    _Pragma("unroll") for (int kt = 0; kt < 4; ++kt) {                                                            \
      _Pragma("unroll") for (int r = 0; r < 4; ++r) { S[kt][r] += (BIAS_EXPR); }                                  \
    }                                                                                                             \
    float x = fmaxf(fmaxf(S[0][0], S[0][1]), fmaxf(S[0][2], S[0][3]));                                            \
    _Pragma("unroll") for (int kt = 1; kt < 4; ++kt) x = fmaxf(x, fmaxf(fmaxf(S[kt][0], S[kt][1]), fmaxf(S[kt][2], S[kt][3]))); \
    x = fmaxf(x, __shfl_xor(x, 16)); x = fmaxf(x, __shfl_xor(x, 32));                                             \
    const float mn = fmaxf(mrun, x);                                                                              \
    const float al = __builtin_amdgcn_exp2f(mrun - mn);                                                           \
    mrun = mn;                                                                                                    \
    float ps = 0.f;                                                                                               \
    _Pragma("unroll") for (int kt = 0; kt < 4; ++kt) {                                                            \
      _Pragma("unroll") for (int r = 0; r < 4; ++r) { S[kt][r] = __builtin_amdgcn_exp2f(S[kt][r] - mn); ps += S[kt][r]; } \
    }                                                                                                             \
    lrun = lrun * al + ps;                                                                                        \
    _Pragma("unroll") for (int dt = 0; dt < 4; ++dt) {                                                            \
      _Pragma("unroll") for (int r = 0; r < 4; ++r) O[dt][r] *= al;                                               \
    }                                                                                                             \
    _Pragma("unroll") for (int g = 0; g < 2; ++g) {                                                               \
      union { unsigned u[4]; bf16x8 v; } pf;                                                                      \
      pf.u[0] = cvt_pk_bf16(S[2 * g][0], S[2 * g][1]); pf.u[1] = cvt_pk_bf16(S[2 * g][2], S[2 * g][3]);           \
      pf.u[2] = cvt_pk_bf16(S[2 * g + 1][0], S[2 * g + 1][1]); pf.u[3] = cvt_pk_bf16(S[2 * g + 1][2], S[2 * g + 1][3]); \
      const int vk0 = (VT_KEY0_EXPR);                                                                             \
      _Pragma("unroll") for (int dt = 0; dt < 4; ++dt) {                                                          \
        union { uint2 h2[2]; bf16x8 v; } vf;                                                                      \
        vf.h2[0] = *(const uint2*)((VT_PTR) + (dt * 16 + lr) * (VT_STRIDE) + vk0 + 4 * lq);                       \
        vf.h2[1] = *(const uint2*)((VT_PTR) + (dt * 16 + lr) * (VT_STRIDE) + vk0 + 16 + 4 * lq);                  \
        O[dt] = __builtin_amdgcn_mfma_f32_16x16x32_bf16(vf.v, pf.v, O[dt], 0, 0, 0);                              \
      }                                                                                                           \
    }                                                                                                             \
  }

__device__ __forceinline__ void na_latent_item(const Params& p, int layer, int item, char* smem) {
  const bf16_t* P = (const bf16_t*)(p.ws + OFF_P);
  bf16_t* Y = (bf16_t*)(p.ws + OFF_ACT);
  const int b = item >> 8, h = (item >> 6) & 3, grow = item & 63;
  const int tid = opaque_tid(), lane = tid & 63, wave = tid >> 6, lr = lane & 15, lq = lane >> 4;
  const int jt = wave & 3, half = wave >> 2;
  bf16_t* VtW = (bf16_t*)(smem + NA_OFF_VTW);
  bf16_t* VtC = (bf16_t*)(smem + NA_OFF_VTC);
  float* RPB = (float*)(smem + NA_OFF_RPB);
  float* MRG = (float*)(smem + NA_OFF_MRG);
  const int rs = min(max(grow - 4, 0), 56);
  __syncthreads();
  {
    const int ch = tid & 7;
#pragma unroll
    for (int i = 0; i < 8; ++i) {
      const int key = (tid >> 3) + 64 * i;
      const uint4 uv = *(const uint4*)(P + (size_t)(b * 4096 + (rs + (key >> 6)) * 64 + (key & 63)) * INC + C_NAV + h * 64 + ch * 8);
      vt_store8(VtW, NA_WS, ch * 8, key, uv);
    }
#pragma unroll
    for (int i = 0; i < 4; ++i) {
      const int key = (tid >> 3) + 64 * i;
      const uint4 uv = *(const uint4*)(P + (size_t)(NLAT + b * 256 + key) * INC + C_NAV + h * 64 + ch * 8);
      vt_store8(VtC, NA_CS, ch * 8, key, uv);
    }
    if (tid < 465) RPB[tid] = p.na_rpb[(size_t)(layer * 4 + h) * 465 + tid] * 1.4426950408889634f;
  }
  const int qc = jt * 16 + lr;
  const int mq = b * 4096 + grow * 64 + qc;
  bf16x8 qf[2];
  {
    const bf16_t* qr = P + (size_t)mq * INC + C_NAQ + h * 64 + lq * 8;
    qf[0] = *(const bf16x8*)(qr);
    qf[1] = *(const bf16x8*)(qr + 32);
  }
  f32x4 O[4];
#pragma unroll
  for (int i = 0; i < 4; ++i) O[i] = (f32x4){0.f, 0.f, 0.f, 0.f};
  float mrun = -1e30f, lrun = 0.f;
  const int k0 = min(max(jt * 16 - 8, 0), 32);
  const int cs = min(max(qc - 8, 0), 48);
  bf16x8 kfa[2][4], kfb[2][4];
#define NA_LOADK(SET, S_)                                                                                        \
  _Pragma("unroll") for (int kt = 0; kt < 4; ++kt) {                                                             \
    const int t_ = 4 * (S_) + kt;                                                                                \
    const size_t krow = half == 0 ? (size_t)(b * 4096 + (rs + (t_ >> 1)) * 64 + k0 + 16 * (t_ & 1) + lr) : (size_t)(NLAT + b * 256 + 16 * t_ + lr); \
    const bf16_t* kp = P + krow * INC + C_NAK + h * 64 + lq * 8;                                                 \
    kfa[SET][kt] = *(const bf16x8*)(kp); kfb[SET][kt] = *(const bf16x8*)(kp + 32);                               \
  }
  NA_LOADK(0, 0)
  __syncthreads();
#pragma unroll
  for (int s = 0; s < 4; ++s) {
    if (s + 1 < 4) { NA_LOADK((s + 1) & 1, s + 1) }
    if (half == 0) {
      const int wr0 = 2 * s;
      NA_STEP(kfa[s & 1][kt], kfb[s & 1][kt],
              ((k0 + 16 * (kt & 1) + 4 * lq + r) >= cs && (k0 + 16 * (kt & 1) + 4 * lq + r) < cs + 16)
                  ? RPB[(rs + wr0 + (kt >> 1) - grow + 7) * 31 + (k0 + 16 * (kt & 1) + 4 * lq + r) - qc + 15] : -1e30f,
              VtW, NA_WS, (wr0 + g) * 64 + k0)
    } else {
      NA_STEP(kfa[s & 1][kt], kfb[s & 1][kt], 0.f, VtC, NA_CS, s * 64 + 32 * g)
    }
  }
  lrun += __shfl_xor(lrun, 16); lrun += __shfl_xor(lrun, 32);
  float* mg = MRG + (jt * 64 + lane) * 18;
  if (half == 1) {
    mg[0] = mrun; mg[1] = lrun;
#pragma unroll
    for (int dt = 0; dt < 4; ++dt) { mg[2 + dt * 4 + 0] = O[dt][0]; mg[2 + dt * 4 + 1] = O[dt][1]; mg[2 + dt * 4 + 2] = O[dt][2]; mg[2 + dt * 4 + 3] = O[dt][3]; }
  }
  __syncthreads();
  if (half == 0) {
    const float m2 = mg[0], l2 = mg[1];
    const float M = fmaxf(mrun, m2);
    const float f1 = __builtin_amdgcn_exp2f(mrun - M), f2 = __builtin_amdgcn_exp2f(m2 - M);
    const float inv = 1.f / (lrun * f1 + l2 * f2);
    bf16_t* dst = Y + (size_t)mq * 1024 + Y_NA + h * 64;
#pragma unroll
    for (int dt = 0; dt < 4; ++dt) {
      const float o0 = (O[dt][0] * f1 + mg[2 + dt * 4 + 0] * f2) * inv, o1 = (O[dt][1] * f1 + mg[2 + dt * 4 + 1] * f2) * inv;
      const float o2 = (O[dt][2] * f1 + mg[2 + dt * 4 + 2] * f2) * inv, o3 = (O[dt][3] * f1 + mg[2 + dt * 4 + 3] * f2) * inv;
      uint2 ov; ov.x = pack2(o0, o1); ov.y = pack2(o2, o3);
      *(uint2*)(dst + dt * 16 + 4 * lq) = ov;
    }
  }
}

__device__ __forceinline__ void na_ctx_item(const Params& p, int item, char* smem) {
  const bf16_t* P = (const bf16_t*)(p.ws + OFF_P);
  bf16_t* Y = (bf16_t*)(p.ws + OFF_ACT);
  const int b = item >> 3, h = (item >> 1) & 3, qg = item & 1;
  const int tid = opaque_tid(), lane = tid & 63, wave = tid >> 6, lr = lane & 15, lq = lane >> 4;
  bf16_t* VtC = (bf16_t*)(smem + NA_OFF_VTC);
  __syncthreads();
  {
    const int ch = tid & 7;
#pragma unroll
    for (int i = 0; i < 4; ++i) {
      const int key = (tid >> 3) + 64 * i;
      const uint4 uv = *(const uint4*)(P + (size_t)(NLAT + b * 256 + key) * INC + C_NAV + h * 64 + ch * 8);
      vt_store8(VtC, NA_CS, ch * 8, key, uv);
    }
  }
  const int mq = NLAT + b * 256 + qg * 128 + wave * 16 + lr;
  bf16x8 qf[2];
  {
    const bf16_t* qr = P + (size_t)mq * INC + C_NAQ + h * 64 + lq * 8;
    qf[0] = *(const bf16x8*)(qr);
    qf[1] = *(const bf16x8*)(qr + 32);
  }
  f32x4 O[4];
#pragma unroll
  for (int i = 0; i < 4; ++i) O[i] = (f32x4){0.f, 0.f, 0.f, 0.f};
  float mrun = -1e30f, lrun = 0.f;
  __syncthreads();
#pragma unroll 1
  for (int s = 0; s < 4; ++s) {
    NA_STEP(*(const bf16x8*)(P + (size_t)(NLAT + b * 256 + s * 64 + kt * 16 + lr) * INC + C_NAK + h * 64 + lq * 8),
            *(const bf16x8*)(P + (size_t)(NLAT + b * 256 + s * 64 + kt * 16 + lr) * INC + C_NAK + h * 64 + 32 + lq * 8), 0.f, VtC, NA_CS, s * 64 + 32 * g)
  }
  lrun += __shfl_xor(lrun, 16); lrun += __shfl_xor(lrun, 32);
  const float inv = 1.f / lrun;
  bf16_t* dst = Y + (size_t)mq * 1024 + Y_NA + h * 64;
#pragma unroll
  for (int dt = 0; dt < 4; ++dt) {
    uint2 ov; ov.x = pack2(O[dt][0] * inv, O[dt][1] * inv); ov.y = pack2(O[dt][2] * inv, O[dt][3] * inv);
    *(uint2*)(dst + dt * 16 + 4 * lq) = ov;
  }
}

constexpr int KV_S = 136;
constexpr int KV_OFF_KF = 0, KV_OFF_KB = 64 * KV_S * 2, KV_OFF_VT = 2 * 64 * KV_S * 2;
__device__ __forceinline__ void ret_kv_item(const Params& p, int layer, int h, size_t row0, int cnt, float* dstF, float* dstB, char* smem) {
  const bf16_t* P = (const bf16_t*)(p.ws + OFF_P);
  const float* misc = (const float*)(p.ws + OFF_MISC);
  const float lgF2 = misc[16 + layer * 8 + 0 * 4 + h] * 1.4426950408889634f, lgB2 = misc[16 + layer * 8 + 1 * 4 + h] * 1.4426950408889634f;
  const int tid = opaque_tid(), lane = tid & 63, wave = tid >> 6, lr = lane & 15, lq = lane >> 4;
  bf16_t* KFt = (bf16_t*)(smem + KV_OFF_KF);
  bf16_t* KBt = (bf16_t*)(smem + KV_OFF_KB);
  bf16_t* Vt = (bf16_t*)(smem + KV_OFF_VT);
  const int dir = wave >> 2, dt = wave & 3;
  f32x4 acc[8];
#pragma unroll
  for (int i = 0; i < 8; ++i) acc[i] = (f32x4){0.f, 0.f, 0.f, 0.f};
#pragma unroll 1
  for (int kc = 0; kc < (cnt >> 7); ++kc) {
    __syncthreads();
    {
      const int tok = tid >> 2, c = tid & 3;
      const int j = kc * 128 + tok;
      const float wF = __builtin_amdgcn_exp2f(lgF2 * (float)(cnt - 1 - j)), wB = __builtin_amdgcn_exp2f(lgB2 * (float)j);
      const bf16_t* rowp = P + (row0 + j) * INC;
#pragma unroll
      for (int c8 = 0; c8 < 2; ++c8) {
        const uint4 u = *(const uint4*)(rowp + C_RTK + h * 64 + c * 16 + c8 * 8);
        float kv[8];
        UNPACK8(kv, 0, u)
#pragma unroll
        for (int i = 0; i < 8; ++i) {
          KFt[(c * 16 + c8 * 8 + i) * KV_S + tok] = f2bf(kv[i] * wF);
          KBt[(c * 16 + c8 * 8 + i) * KV_S + tok] = f2bf(kv[i] * wB);
        }
      }
#pragma unroll
      for (int c8 = 0; c8 < 4; ++c8) {
        const uint4 uv = *(const uint4*)(rowp + C_RTV + h * 128 + c * 32 + c8 * 8);
        vt_store8(Vt, KV_S, c * 32 + c8 * 8, tok, uv);
      }
    }
    __syncthreads();
    const bf16_t* Kt = dir == 0 ? KFt : KBt;
    bf16x8 af[4];
#pragma unroll
    for (int ks = 0; ks < 4; ++ks) af[ks] = *(const bf16x8*)(Kt + (dt * 16 + lr) * KV_S + ks * 32 + lq * 8);
#pragma unroll
    for (int et = 0; et < 8; ++et) {
#pragma unroll
      for (int ks = 0; ks < 4; ++ks) {
        const bf16x8 bfr = *(const bf16x8*)(Vt + (et * 16 + lr) * KV_S + ks * 32 + lq * 8);
        acc[et] = __builtin_amdgcn_mfma_f32_16x16x32_bf16(af[ks], bfr, acc[et], 0, 0, 0);
      }
    }
  }
  float* dst = dir == 0 ? dstF : dstB;
#pragma unroll
  for (int et = 0; et < 8; ++et) {
#pragma unroll
    for (int r = 0; r < 4; ++r) dst[(dt * 16 + 4 * lq + r) * 128 + et * 16 + lr] = acc[et][r];
  }
}

__device__ __forceinline__ void phase_ret_scan(const Params& p, int layer) {
  const float* misc = (const float*)(p.ws + OFF_MISC);
  float* rkv = (float*)(p.ws + OFF_RKV);
  const float* rs = (const float*)(p.ws + OFF_RS);
  const int gt = opaque_bid() * 512 + opaque_tid(), gs = gridDim.x * 512;
  for (int idx = gt; idx < 64 * 2048; idx += gs) {
    const int seq = idx >> 11, e4 = (idx & 2047) * 4;
    const int dir = seq & 1, h = (seq >> 1) & 3;
    const float cdec = __expf(misc[16 + layer * 8 + dir * 4 + h] * 128.f);
    float4* base = (float4*)(rkv + (size_t)seq * 32 * 8192 + e4);
    float4 v[32];
#pragma unroll
    for (int s = 0; s < 32; ++s) v[s] = base[(size_t)s * 2048];
    float4 st = *(const float4*)(rs + (size_t)seq * 8192 + e4);
    if (dir == 0) {
#pragma unroll
      for (int s = 0; s < 32; ++s) {
        const float4 t = v[s];
        base[(size_t)s * 2048] = st;
        st.x = fmaf(cdec, st.x, t.x); st.y = fmaf(cdec, st.y, t.y); st.z = fmaf(cdec, st.z, t.z); st.w = fmaf(cdec, st.w, t.w);
      }
    } else {
#pragma unroll
      for (int s = 31; s >= 0; --s) {
        const float4 t = v[s];
        base[(size_t)s * 2048] = st;
        st.x = fmaf(cdec, st.x, t.x); st.y = fmaf(cdec, st.y, t.y); st.z = fmaf(cdec, st.z, t.z); st.w = fmaf(cdec, st.w, t.w);
      }
    }
  }
}

constexpr int RT_KS = 72, RT_VS = 136;
constexpr int RT_OFF_K = 0, RT_OFF_VT = 128 * RT_KS * 2, RT_OFF_SF = RT_OFF_VT + 128 * RT_VS * 2, RT_OFF_SB = RT_OFF_SF + 128 * RT_KS * 2;
__device__ __forceinline__ void ret_out_item(const Params& p, int layer, int h, size_t krow0, int nkc, int iq0,
                                             const float* SF, const float* SB, int clen, char* smem) {
  const bf16_t* P = (const bf16_t*)(p.ws + OFF_P);
  bf16_t* Y = (bf16_t*)(p.ws + OFF_ACT);
  const float* misc = (const float*)(p.ws + OFF_MISC);
  const float lgF2 = misc[16 + layer * 8 + 0 * 4 + h] * 1.4426950408889634f, lgB2 = misc[16 + layer * 8 + 1 * 4 + h] * 1.4426950408889634f;
  const int tid = opaque_tid(), lane = tid & 63, wave = tid >> 6, lr = lane & 15, lq = lane >> 4;
  bf16_t* Ks = (bf16_t*)(smem + RT_OFF_K);
  bf16_t* Vt = (bf16_t*)(smem + RT_OFF_VT);
  bf16_t* SFt = (bf16_t*)(smem + RT_OFF_SF);
  bf16_t* SBt = (bf16_t*)(smem + RT_OFF_SB);
  const int iq = iq0 + wave * 16 + lr;
  const size_t mq = krow0 + iq;
  bf16x8 qf[2];
  {
    const bf16_t* qr = P + mq * INC + C_RTQ + h * 64 + lq * 8;
    qf[0] = *(const bf16x8*)(qr);
    qf[1] = *(const bf16x8*)(qr + 32);
  }
  f32x4 O[8];
#pragma unroll
  for (int i = 0; i < 8; ++i) O[i] = (f32x4){0.f, 0.f, 0.f, 0.f};
  if (SF != nullptr) {
    __syncthreads();
    {
      const int d = tid >> 3, e0 = (tid & 7) * 16;
#pragma unroll
      for (int c4 = 0; c4 < 4; ++c4) {
        const float4 a = *(const float4*)(SF + d * 128 + e0 + c4 * 4);
        const float4 bb = *(const float4*)(SB + d * 128 + e0 + c4 * 4);
        SFt[(e0 + c4 * 4 + 0) * RT_KS + d] = f2bf(a.x); SFt[(e0 + c4 * 4 + 1) * RT_KS + d] = f2bf(a.y);
        SFt[(e0 + c4 * 4 + 2) * RT_KS + d] = f2bf(a.z); SFt[(e0 + c4 * 4 + 3) * RT_KS + d] = f2bf(a.w);
        SBt[(e0 + c4 * 4 + 0) * RT_KS + d] = f2bf(bb.x); SBt[(e0 + c4 * 4 + 1) * RT_KS + d] = f2bf(bb.y);
        SBt[(e0 + c4 * 4 + 2) * RT_KS + d] = f2bf(bb.z); SBt[(e0 + c4 * 4 + 3) * RT_KS + d] = f2bf(bb.w);
      }
    }
    __syncthreads();
    const float cF = __builtin_amdgcn_exp2f(lgF2 * (float)(iq + 1)), cB = __builtin_amdgcn_exp2f(lgB2 * (float)(clen - iq));
#pragma unroll
    for (int ks = 0; ks < 2; ++ks)
#pragma unroll
      for (int et = 0; et < 8; ++et) {
        const bf16x8 sf = *(const bf16x8*)(SFt + (et * 16 + lr) * RT_KS + ks * 32 + lq * 8);
        O[et] = __builtin_amdgcn_mfma_f32_16x16x32_bf16(sf, qf[ks], O[et], 0, 0, 0);
      }
    const float ratio = cF / cB;
#pragma unroll
    for (int et = 0; et < 8; ++et) { O[et][0] *= ratio; O[et][1] *= ratio; O[et][2] *= ratio; O[et][3] *= ratio; }
#pragma unroll
    for (int ks = 0; ks < 2; ++ks)
#pragma unroll
      for (int et = 0; et < 8; ++et) {
        const bf16x8 sb = *(const bf16x8*)(SBt + (et * 16 + lr) * RT_KS + ks * 32 + lq * 8);
        O[et] = __builtin_amdgcn_mfma_f32_16x16x32_bf16(sb, qf[ks], O[et], 0, 0, 0);
      }
#pragma unroll
    for (int et = 0; et < 8; ++et) { O[et][0] *= cB; O[et][1] *= cB; O[et][2] *= cB; O[et][3] *= cB; }
  }
#pragma unroll 1
  for (int kc = 0; kc < nkc; ++kc) {
    __syncthreads();
    {
      const int key = tid >> 2, c = tid & 3;
      const bf16_t* rowp = P + (krow0 + kc * 128 + key) * INC;
      const uint4 k0 = *(const uint4*)(rowp + C_RTK + h * 64 + c * 16), k1 = *(const uint4*)(rowp + C_RTK + h * 64 + c * 16 + 8);
      *(uint4*)(Ks + key * RT_KS + c * 16) = k0;
      *(uint4*)(Ks + key * RT_KS + c * 16 + 8) = k1;
#pragma unroll
      for (int c8 = 0; c8 < 4; ++c8) {
        const uint4 uv = *(const uint4*)(rowp + C_RTV + h * 128 + c * 32 + c8 * 8);
        vt_store8(Vt, RT_VS, c * 32 + c8 * 8, key, uv);
      }
    }
    __syncthreads();
    f32x4 S[8];
#pragma unroll
    for (int kt = 0; kt < 8; ++kt) {
      const bf16x8 ka = *(const bf16x8*)(Ks + (kt * 16 + lr) * RT_KS + lq * 8);
      const bf16x8 kb = *(const bf16x8*)(Ks + (kt * 16 + lr) * RT_KS + 32 + lq * 8);
      const f32x4 a = __builtin_amdgcn_mfma_f32_16x16x32_bf16(ka, qf[0], (f32x4){0.f, 0.f, 0.f, 0.f}, 0, 0, 0);
      S[kt] = __builtin_amdgcn_mfma_f32_16x16x32_bf16(kb, qf[1], a, 0, 0, 0);
    }
#pragma unroll
    for (int kt = 0; kt < 8; ++kt) {
#pragma unroll
      for (int r = 0; r < 4; ++r) {
        const int df = iq - (kc * 128 + kt * 16 + 4 * lq + r);
        const float fdf = (float)df;
        float coef = 0.f;
        if (df >= 0) coef += __builtin_amdgcn_exp2f(lgF2 * fdf);
        if (df <= 0) coef += __builtin_amdgcn_exp2f(-lgB2 * fdf);
        S[kt][r] *= coef;
      }
    }
#pragma unroll
    for (int g = 0; g < 4; ++g) {
      union { unsigned u[4]; bf16x8 v; } pf;
      pf.u[0] = cvt_pk_bf16(S[2 * g][0], S[2 * g][1]); pf.u[1] = cvt_pk_bf16(S[2 * g][2], S[2 * g][3]);
      pf.u[2] = cvt_pk_bf16(S[2 * g + 1][0], S[2 * g + 1][1]); pf.u[3] = cvt_pk_bf16(S[2 * g + 1][2], S[2 * g + 1][3]);
#pragma unroll
      for (int et = 0; et < 8; ++et) {
        union { uint2 h2[2]; bf16x8 v; } vf;
        vf.h2[0] = *(const uint2*)(Vt + (et * 16 + lr) * RT_VS + 32 * g + 4 * lq);
        vf.h2[1] = *(const uint2*)(Vt + (et * 16 + lr) * RT_VS + 32 * g + 16 + 4 * lq);
        O[et] = __builtin_amdgcn_mfma_f32_16x16x32_bf16(vf.v, pf.v, O[et], 0, 0, 0);
      }
    }
  }
  float ss = 0.f;
#pragma unroll
  for (int et = 0; et < 8; ++et) { ss = fmaf(O[et][0], O[et][0], ss); ss = fmaf(O[et][1], O[et][1], ss); ss = fmaf(O[et][2], O[et][2], ss); ss = fmaf(O[et][3], O[et][3], ss); }
  ss += __shfl_xor(ss, 16); ss += __shfl_xor(ss, 32);
  const float rr = rsqrtf(ss * (1.f / 128.f) + EPS);
  const bf16_t* gp = P + mq * INC + C_RTG + h * 128;
  bf16_t* dst = Y + mq * 1024 + Y_RT + h * 128;
#pragma unroll
  for (int et = 0; et < 8; ++et) {
    const int e = et * 16 + 4 * lq;
    const uint2 gu = *(const uint2*)(gp + e);
    uint2 ov;
    ov.x = pack2(O[et][0] * rr * siluf(lo16(gu.x)), O[et][1] * rr * siluf(hi16(gu.x)));
    ov.y = pack2(O[et][2] * rr * siluf(lo16(gu.y)), O[et][3] * rr * siluf(hi16(gu.y)));
    *(uint2*)(dst + e) = ov;
  }
}

__device__ __forceinline__ void uv_convert_item(const Params& p, int item) {
  char* ws = p.ws;
  const int tid = opaque_tid();
  const int lane = tid & 63, l = lane & 31, half = lane >> 5, wave = tid >> 6;
#pragma unroll 1
  for (int it = 0; it < 16; ++it) {
    const int row = item * 256 + (wave * 16 + it) * 2 + half;
    const bool isv = row >= 2 * NEXP;
    const int rr = isv ? row - 2 * NEXP : row;
    const float* srow = (isv ? p.peer_v : p.peer_u) + (size_t)rr * 1024;
    float4 v[8];
    float mx = 0.f;
#pragma unroll
    for (int j = 0; j < 8; ++j) {
      v[j] = ((const float4*)srow)[l + 32 * j];
      mx = fmaxf(mx, fmaxf(fmaxf(fabsf(v[j].x), fabsf(v[j].y)), fmaxf(fabsf(v[j].z), fabsf(v[j].w))));
    }
#pragma unroll
    for (int o = 1; o < 32; o <<= 1) mx = fmaxf(mx, __shfl_xor(mx, o));
    const float scale = mx > 0.f ? mx * (1.f / 7.5f) : 1.f;
    const float inv = 1.f / scale;
    if (!isv) {
      unsigned w[6] = {0u, 0u, 0u, 0u, 0u, 0u};
#pragma unroll
      for (int k = 0; k < 32; ++k) {
        const float xv = (k & 3) == 0 ? v[k >> 2].x : (k & 3) == 1 ? v[k >> 2].y : (k & 3) == 2 ? v[k >> 2].z : v[k >> 2].w;
        const float a = fminf(fabsf(xv) * inv, 7.5f);
        float c;
        if (a < 2.f) c = rintf(a * 8.f);
        else if (a < 4.f) c = 16.f + rintf((a - 2.f) * 4.f);
        else c = 24.f + rintf((a - 4.f) * 2.f);
        unsigned code = (unsigned)c;
        code = code > 31u ? 31u : code;
        code |= (xv < 0.f) ? 32u : 0u;
        const int bit = 6 * k, wd = bit >> 5, sh = bit & 31;
        w[wd] |= code << sh;
        if (sh > 26) w[wd + 1] |= code >> (32 - sh);
      }
      char* drow = ws + OFF_U + (size_t)rr * RECB + l * 24;
      *(uint2*)(drow) = make_uint2(w[0], w[1]);
      *(uint2*)(drow + 8) = make_uint2(w[2], w[3]);
      *(uint2*)(drow + 16) = make_uint2(w[4], w[5]);
      if (l == 0) ((float*)(ws + OFF_USC))[rr] = scale;
    } else {
      const float scale4 = mx > 0.f ? mx * (1.f / 6.f) : 1.f;
      const float inv4 = 1.f / scale4;
      unsigned w[4] = {0u, 0u, 0u, 0u};
#pragma unroll
      for (int k = 0; k < 32; ++k) {
        const float xv = (k & 3) == 0 ? v[k >> 2].x : (k & 3) == 1 ? v[k >> 2].y : (k & 3) == 2 ? v[k >> 2].z : v[k >> 2].w;
        const float a = fminf(fabsf(xv) * inv4, 6.f);
        float c;
        if (a < 2.f) c = rintf(a * 2.f);
        else if (a < 4.f) c = 4.f + rintf(a - 2.f);
        else c = 6.f + rintf((a - 4.f) * 0.5f);
        unsigned code = (unsigned)c;
        code = code > 7u ? 7u : code;
        code |= (xv < 0.f) ? 8u : 0u;
        w[k >> 3] |= code << (4 * (k & 7));
      }
      char* drow = ws + OFF_U + (size_t)rr * RECB + ROWB + l * 16;
      *(uint4*)(drow) = make_uint4(w[0], w[1], w[2], w[3]);
      if (l == 0) ((float*)(ws + OFF_VSC))[rr] = scale4;
    }
  }
}

__device__ __forceinline__ void phase_mix1(const Params& p, int layer, char* smem, int slot = 0) {
  unsigned* ctr = (unsigned*)(p.ws + OFF_CTL) + (layer * 4 + slot);
  const bool nc = layer == 0;
  const int n_dl = 512, n_dc = nc ? 32 : 0, n_nl = 2048, n_ncx = nc ? 64 : 0, n_kv = 1024, n_cs = 32;
  const int total = n_dl + n_dc + n_nl + n_ncx + n_kv + n_cs;
  float* rkv = (float*)(p.ws + OFF_RKV);
  float* rs = (float*)(p.ws + OFF_RS);
  for (;;) {
    int it = next_item(ctr, smem);
    if (it >= total) break;
    if (it < n_dl) { diff_item(p, layer, false, it, smem); continue; } it -= n_dl;
    if (it < n_dc) { diff_item(p, layer, true, it, smem); continue; } it -= n_dc;
    if (it < n_nl) { na_latent_item(p, layer, it, smem); continue; } it -= n_nl;
    if (it < n_ncx) { na_ctx_item(p, it, smem); continue; } it -= n_ncx;
    if (it < n_kv) {
      const int bh = it >> 5, n = it & 31, b = bh >> 2, h = bh & 3;
      ret_kv_item(p, layer, h, (size_t)b * 4096 + n * 128, 128,
                  rkv + ((size_t)(bh * 2 + 0) * 32 + n) * 8192, rkv + ((size_t)(bh * 2 + 1) * 32 + n) * 8192, smem);
      continue;
    }
    it -= n_kv;
    {
      const int bh = it, b = bh >> 2, h = bh & 3;
      ret_kv_item(p, layer, h, (size_t)NLAT + b * 256, 256, rs + (size_t)(bh * 2 + 0) * 8192, rs + (size_t)(bh * 2 + 1) * 8192, smem);
    }
  }
}

__device__ __forceinline__ void phase_mix2(const Params& p, int layer, char* smem, int slot = 1) {
  unsigned* ctr = (unsigned*)(p.ws + OFF_CTL) + (layer * 4 + slot);
  const int n_l = 1024, n_c = layer == 0 ? 64 : 0;
  const float* rkv = (const float*)(p.ws + OFF_RKV);
  for (;;) {
    int it = next_item(ctr, smem);
    if (it >= n_l + n_c) break;
    if (it < n_l) {
      const int bh = it >> 5, n = it & 31, b = bh >> 2, h = bh & 3;
      ret_out_item(p, layer, h, (size_t)b * 4096 + n * 128, 1, 0,
                   rkv + ((size_t)(bh * 2 + 0) * 32 + n) * 8192, rkv + ((size_t)(bh * 2 + 1) * 32 + n) * 8192, 128, smem);
    } else {
      it -= n_l;
      const int bh = it >> 1, half = it & 1, b = bh >> 2, h = bh & 3;
      ret_out_item(p, layer, h, (size_t)NLAT + b * 256, 2, half * 128, nullptr, nullptr, 256, smem);
    }
  }
}

typedef float f32x2 __attribute__((ext_vector_type(2)));
__device__ __forceinline__ unsigned sortable_key(float f, int idx) {
  const unsigned b = __float_as_uint(f);
  const unsigned k = b ^ ((unsigned)((int)b >> 31) | 0x80000000u);
  return (k & ~127u) | (unsigned)(127 - idx);
}
__device__ __forceinline__ float key_value(unsigned k) {
  k &= ~127u;
  const unsigned b = (k & 0x80000000u) ? (k ^ 0x80000000u) : ~k;
  return __uint_as_float(b);
}
#define FP8DOT(acc, H, off, W) { const f32x2 _a = __builtin_amdgcn_cvt_pk_f32_fp8((int)(W), false), _b = __builtin_amdgcn_cvt_pk_f32_fp8((int)(W), true); \
  acc = fmaf(H[(off) + 0], _a.x, acc); acc = fmaf(H[(off) + 1], _a.y, acc); acc = fmaf(H[(off) + 2], _b.x, acc); acc = fmaf(H[(off) + 3], _b.y, acc); }
#define FP8AXPY(O, off, P, W) { const f32x2 _a = __builtin_amdgcn_cvt_pk_f32_fp8((int)(W), false), _b = __builtin_amdgcn_cvt_pk_f32_fp8((int)(W), true); \
  O[(off) + 0] = fmaf(P, _a.x, O[(off) + 0]); O[(off) + 1] = fmaf(P, _a.y, O[(off) + 1]); O[(off) + 2] = fmaf(P, _b.x, O[(off) + 2]); O[(off) + 3] = fmaf(P, _b.y, O[(off) + 3]); }

__device__ __forceinline__ float gelu_erf(float a) {
  const float x = fabsf(a) * 0.70710678118654752f;
  const float t = __builtin_amdgcn_rcpf(fmaf(0.3275911f, x, 1.f));
  float pl = fmaf(1.061405429f, t, -1.453152027f);
  pl = fmaf(pl, t, 1.421413741f); pl = fmaf(pl, t, -0.284496736f); pl = fmaf(pl, t, 0.254829592f);
  const float y = 1.f - pl * t * __builtin_amdgcn_exp2f(-x * x * 1.4426950408889634f);
  const float er = a < 0.f ? -y : y;
  return 0.5f * a * (1.f + er);
}
constexpr int PE_SVS = 132;
constexpr int PE_OFF_SV = 0;
constexpr int PE_OFF_TV = 8 * 16 * PE_SVS * 4;
constexpr int PE_OFF_TI = PE_OFF_TV + 16 * 16 * 16 * 4;
constexpr int PE_OFF_EX = PE_OFF_TI + 16 * 16 * 16 * 4;
constexpr int PE_OFF_GT = PE_OFF_EX + 2 * 16 * 128 * 4;
constexpr int PE_OFF_SU = PE_OFF_GT + 2 * 16 * 128 * 4;
constexpr int PE_OFF_CN = PE_OFF_SU + 2 * 16 * 128 * 4;
constexpr int PE_OFF_CT = PE_OFF_CN + 8 * 16 * 4;
constexpr int PE_OFF_TQ = PE_OFF_CT + 64 * 4;
static_assert(PE_OFF_TQ + 16 <= LDS_BCAST, "PEER LDS map overflows");
#define WAVE_LDS_FENCE() asm volatile("s_waitcnt lgkmcnt(0)" ::: "memory")

__device__ __forceinline__ void peer_select_head(const Params& p, int layer, char* smem, int tok0, int hd, int sw, int buf,
                                                 int lane) {
  const bf16_t* Q = (const bf16_t*)(p.ws + OFF_P);
  const bf16_t* SK = (const bf16_t*)(p.ws + OFF_SUBK) + (size_t)layer * 262144;
  const int lr = lane & 15, lq = lane >> 4;
  unsigned* SV = (unsigned*)(smem + PE_OFF_SV) + sw * 16 * PE_SVS;
  float* TV = (float*)(smem + PE_OFF_TV);
  int* TI = (int*)(smem + PE_OFF_TI);
  int* EX = (int*)(smem + PE_OFF_EX) + buf * 16 * 128;
  float* GT = (float*)(smem + PE_OFF_GT) + buf * 16 * 128;
  int* CN = (int*)(smem + PE_OFF_CN) + sw * 16;
  float* SU = (float*)(smem + PE_OFF_SU) + buf * 16 * 128;
  const float* USC = (const float*)(p.ws + OFF_USC) + layer * NEXP;
  const float* VSC = (const float*)(p.ws + OFF_VSC) + layer * NEXP;
#pragma unroll 1
  for (int pp = 0; pp < 2; ++pp) {
    bf16x8 af[4];
    const bf16_t* qrow = Q + (size_t)(tok0 + lr) * 2048 + hd * 256 + pp * 128;
#pragma unroll
    for (int ks = 0; ks < 4; ++ks) af[ks] = *(const bf16x8*)(qrow + ks * 32 + lq * 8);
    const bf16_t* skb = SK + (size_t)((hd * 2 + pp) * 128) * 128;
    f32x4 acc[8];
    {
      bf16x8 bfr[8][4];
#pragma unroll
      for (int nt = 0; nt < 8; ++nt)
#pragma unroll
        for (int ks = 0; ks < 4; ++ks)
          bfr[nt][ks] = *(const bf16x8*)(skb + (size_t)(nt * 16 + lr) * 128 + ks * 32 + lq * 8);
#pragma unroll
      for (int nt = 0; nt < 8; ++nt) {
        f32x4 a = (f32x4){0.f, 0.f, 0.f, 0.f};
#pragma unroll
        for (int ks = 0; ks < 4; ++ks) a = __builtin_amdgcn_mfma_f32_16x16x32_bf16(af[ks], bfr[nt][ks], a, 0, 0, 0);
        acc[nt] = a;
      }
    }
#pragma unroll
    for (int i = 0; i < 9; ++i) { const int q4 = lane + 64 * i; if (q4 < 16 * PE_SVS / 4) ((uint4*)SV)[q4] = make_uint4(0u, 0u, 0u, 0u); }
    WAVE_LDS_FENCE();
#pragma unroll
    for (int r = 0; r < 4; ++r) {
      const int tk = 4 * lq + r;
      unsigned k[8];
#pragma unroll
      for (int nt = 0; nt < 8; ++nt) k[nt] = sortable_key(acc[nt][r], nt * 16 + lr);
      unsigned m1 = max(k[0], k[1]), m2 = min(k[0], k[1]);
#pragma unroll
      for (int nt = 2; nt < 8; ++nt) { m2 = max(m2, min(m1, k[nt])); m1 = max(m1, k[nt]); }
      const unsigned Ta = row16_min_u32(m1);
      const unsigned Tb = min(row16_kth_largest<11>(m1), row16_kth_largest<5>(m2));
      const unsigned T = max(Ta, Tb);
      int pos = 0;
#pragma unroll
      for (int nt = 0; nt < 8; ++nt) {
        const bool sel = k[nt] >= T;
        const unsigned long long bal = __ballot(sel);
        const unsigned grp16 = (unsigned)(bal >> (16 * lq)) & 0xffffu;
        const int below = __popc(grp16 & ((1u << lr) - 1u));
        if (sel) SV[tk * PE_SVS + pos + below] = k[nt];
        pos += __popc(grp16);
      }
      if (lr == 0) CN[tk] = pos;
    }
    WAVE_LDS_FENCE();
#pragma unroll 1
    for (int pass = 0; pass < 4; ++pass) {
      const int tk = pass * 4 + lq;
      const int cnt = CN[tk];
      const unsigned* row = SV + tk * PE_SVS;
      int cm = cnt;
      cm = max(cm, __shfl_xor(cm, 16)); cm = max(cm, __shfl_xor(cm, 32));
      const int cmax = __builtin_amdgcn_readfirstlane(cm);
      const int nblk = (cmax + 15) >> 4;
#pragma unroll 1
      for (int rd = 0; rd < nblk; ++rd) {
        const int j = rd * 16 + lr;
        const unsigned my = row[j];
        int rank = 0;
#pragma unroll 1
        for (int b4 = 0; b4 < nblk; ++b4) {
          const uint4 v0 = *(const uint4*)(row + b4 * 16), v1 = *(const uint4*)(row + b4 * 16 + 4);
          const uint4 v2 = *(const uint4*)(row + b4 * 16 + 8), v3 = *(const uint4*)(row + b4 * 16 + 12);
          rank += (v0.x > my) ? 1 : 0; rank += (v0.y > my) ? 1 : 0; rank += (v0.z > my) ? 1 : 0; rank += (v0.w > my) ? 1 : 0;
          rank += (v1.x > my) ? 1 : 0; rank += (v1.y > my) ? 1 : 0; rank += (v1.z > my) ? 1 : 0; rank += (v1.w > my) ? 1 : 0;
          rank += (v2.x > my) ? 1 : 0; rank += (v2.y > my) ? 1 : 0; rank += (v2.z > my) ? 1 : 0; rank += (v2.w > my) ? 1 : 0;
          rank += (v3.x > my) ? 1 : 0; rank += (v3.y > my) ? 1 : 0; rank += (v3.z > my) ? 1 : 0; rank += (v3.w > my) ? 1 : 0;
        }
        if (j < cnt && rank < 16) {
          TV[(tk * 16 + hd * 2 + pp) * 16 + rank] = key_value(my);
          TI[(tk * 16 + hd * 2 + pp) * 16 + rank] = 127 - (int)(my & 127u);
        }
      }
    }
    WAVE_LDS_FENCE();
  }
  {
    const int cab = ((const int*)(smem + PE_OFF_CT))[lane];
    const int cand_a = cab >> 4, cand_b = cab & 15;
    unsigned* CWt = SV;
    float vals[16];
#pragma unroll
    for (int tk = 0; tk < 16; ++tk) {
      float val = 0.f;
      unsigned key = 0u;
      if (cand_a >= 0) {
        val = TV[(tk * 16 + hd * 2 + 0) * 16 + cand_a] + TV[(tk * 16 + hd * 2 + 1) * 16 + cand_b];
        const unsigned bb = __float_as_uint(val);
        key = ((bb ^ ((unsigned)((int)bb >> 31) | 0x80000000u)) & ~63u) | (unsigned)(63 - lane);
      }
      vals[tk] = val;
      CWt[tk * 64 + lane] = key;
    }
    WAVE_LDS_FENCE();
#pragma unroll
    for (int tk = 0; tk < 16; ++tk) {
      const unsigned key = CWt[tk * 64 + lane];
      int rank = 0;
#pragma unroll
      for (int i4 = 0; i4 < 13; ++i4) {
        const uint4 v = *(const uint4*)(CWt + tk * 64 + i4 * 4);
        rank += (v.x > key) ? 1 : 0; rank += (v.y > key) ? 1 : 0; rank += (v.z > key) ? 1 : 0; rank += (v.w > key) ? 1 : 0;
      }
      if (cand_a >= 0 && rank < 16) {
        GT[tk * 128 + hd * 16 + rank] = vals[tk];
        EX[tk * 128 + hd * 16 + rank] = TI[(tk * 16 + hd * 2 + 0) * 16 + cand_a] * 128 + TI[(tk * 16 + hd * 2 + 1) * 16 + cand_b];
      }
    }
    WAVE_LDS_FENCE();
#pragma unroll
    for (int pass = 0; pass < 4; ++pass) {
      const int tk = pass * 4 + lq;
      const float g = GT[tk * 128 + hd * 16 + lr];
      const float mx = GT[tk * 128 + hd * 16];
      const float ev = __expf(g - mx);
      float s = ev;
      s += __shfl_xor(s, 1); s += __shfl_xor(s, 2); s += __shfl_xor(s, 4); s += __shfl_xor(s, 8);
      const int ex = EX[tk * 128 + hd * 16 + lr];
      GT[tk * 128 + hd * 16 + lr] = (ev / s) * VSC[ex];
      SU[tk * 128 + hd * 16 + lr] = USC[ex];
    }
    WAVE_LDS_FENCE();
  }
}

typedef float f32x32 __attribute__((ext_vector_type(32)));
typedef unsigned u32x6 __attribute__((ext_vector_type(6)));
#define FP4_AXPY8(O, off, P, W) {                                                                    \
  const f32x2 _q0 = __builtin_amdgcn_cvt_scalef32_pk_f32_fp4((W), 1.0f, 0), _q1 = __builtin_amdgcn_cvt_scalef32_pk_f32_fp4((W), 1.0f, 1); \
  const f32x2 _q2 = __builtin_amdgcn_cvt_scalef32_pk_f32_fp4((W), 1.0f, 2), _q3 = __builtin_amdgcn_cvt_scalef32_pk_f32_fp4((W), 1.0f, 3); \
  O[(off) + 0] = fmaf(P, _q0.x, O[(off) + 0]); O[(off) + 1] = fmaf(P, _q0.y, O[(off) + 1]);          \
  O[(off) + 2] = fmaf(P, _q1.x, O[(off) + 2]); O[(off) + 3] = fmaf(P, _q1.y, O[(off) + 3]);          \
  O[(off) + 4] = fmaf(P, _q2.x, O[(off) + 4]); O[(off) + 5] = fmaf(P, _q2.y, O[(off) + 5]);          \
  O[(off) + 6] = fmaf(P, _q3.x, O[(off) + 6]); O[(off) + 7] = fmaf(P, _q3.y, O[(off) + 7]); }
struct Fp6Row { uint4 a; uint2 b; };
typedef __bf16 bf16x32_t __attribute__((ext_vector_type(32)));
__device__ __forceinline__ bf16x32_t fp6_decode_bf16(const Fp6Row& r) {
  u32x6 w; w[0] = r.a.x; w[1] = r.a.y; w[2] = r.a.z; w[3] = r.a.w; w[4] = r.b.x; w[5] = r.b.y;
  return __builtin_amdgcn_cvt_scalef32_pk32_bf16_fp6(w, 1.0f);
}
__device__ __forceinline__ f32x32 fp6_decode(const Fp6Row& r) {
  u32x6 w; w[0] = r.a.x; w[1] = r.a.y; w[2] = r.a.z; w[3] = r.a.w; w[4] = r.b.x; w[5] = r.b.y;
  return __builtin_amdgcn_cvt_scalef32_pk32_f32_fp6(w, 1.0f);
}
__device__ __forceinline__ void peer_gather_token(const Params& p, int layer, char* smem, int tok, int tl, int buf, int lane, bool dowrite) {
  const bf16_t* H2 = (const bf16_t*)(p.ws + OFF_ACT);
  const char* U6 = p.ws + OFF_U + (size_t)layer * NEXP * RECB;
  const float* mod = (const float*)(p.ws + OFF_MOD) + (size_t)layer * 9 * 6144;
  const int* EX = (const int*)(smem + PE_OFF_EX) + buf * 16 * 128 + tl * 128;
  const float* GT = (const float*)(smem + PE_OFF_GT) + buf * 16 * 128 + tl * 128;
  const float* SU = (const float*)(smem + PE_OFF_SU) + buf * 16 * 128 + tl * 128;
  const int l = lane & 31, hf = lane >> 5;
  float acc[32];
  bf16x2_t hvp[16];
  {
    const bf16_t* hr = H2 + (size_t)tok * 1024;
#pragma unroll
    for (int j = 0; j < 8; ++j) {
      const uint2 u = *(const uint2*)(hr + (l + 32 * j) * 4);
      hvp[2 * j] = __builtin_bit_cast(bf16x2_t, u.x); hvp[2 * j + 1] = __builtin_bit_cast(bf16x2_t, u.y);
    }
  }
#pragma unroll
  for (int i = 0; i < 32; ++i) acc[i] = 0.f;
  int one = 1;
  asm volatile("" : "+s"(one));
#define PE_LOAD(UU, VV, PI)                                                           \
  {                                                                                   \
    const int ex = EX[2 * (PI) + hf];                                                 \
    const char* up = U6 + (size_t)ex * RECB + l * 24;                                 \
    UU.a = *(const uint4*)up; UU.b = *(const uint2*)(up + 16);                        \
    VV = *(const uint4*)(U6 + (size_t)ex * RECB + ROWB + l * 16);                     \
  }
#define PE_USE(UU, VV, PI)                                                            \
  _Pragma("unroll 1") for (int rep_ = 0; rep_ < one; ++rep_) {                        \
    const bf16x32_t du = fp6_decode_bf16(UU);                                         \
    float d0 = 0.f, d1 = 0.f, d2 = 0.f, d3 = 0.f;                                     \
    _Pragma("unroll") for (int k = 0; k < 16; k += 4) {                               \
      d0 = __builtin_amdgcn_fdot2_f32_bf16((bf16x2_t){du[2 * k], du[2 * k + 1]}, hvp[k], d0, false);             \
      d1 = __builtin_amdgcn_fdot2_f32_bf16((bf16x2_t){du[2 * k + 2], du[2 * k + 3]}, hvp[k + 1], d1, false);     \
      d2 = __builtin_amdgcn_fdot2_f32_bf16((bf16x2_t){du[2 * k + 4], du[2 * k + 5]}, hvp[k + 2], d2, false);     \
      d3 = __builtin_amdgcn_fdot2_f32_bf16((bf16x2_t){du[2 * k + 6], du[2 * k + 7]}, hvp[k + 3], d3, false);     \
    }                                                                                 \
    const float r16 = row16_sum((d0 + d1) + (d2 + d3));                               \
    const int ir = __float_as_int(r16);                                               \
    const float s0 = __int_as_float(__builtin_amdgcn_readlane(ir, 0)) + __int_as_float(__builtin_amdgcn_readlane(ir, 16));  \
    const float s1 = __int_as_float(__builtin_amdgcn_readlane(ir, 32)) + __int_as_float(__builtin_amdgcn_readlane(ir, 48)); \
    const float d = (hf ? s1 : s0) * SU[2 * (PI) + hf];                               \
    const float w = GT[2 * (PI) + hf] * gelu_erf(d);                                  \
    FP4_AXPY8(acc, 0, w, VV.x) FP4_AXPY8(acc, 8, w, VV.y) FP4_AXPY8(acc, 16, w, VV.z) FP4_AXPY8(acc, 24, w, VV.w) \
  }
  Fp6Row u0, u1, u2, u3, u4;
  uint4 v0, v1, v2, v3, v4;
  PE_LOAD(u0, v0, 0) PE_LOAD(u1, v1, 1) PE_LOAD(u2, v2, 2) PE_LOAD(u3, v3, 3) PE_LOAD(u4, v4, 4)
#pragma unroll 1
  for (int pi = 0; pi < 55; pi += 5) {
    PE_USE(u0, v0, pi) PE_LOAD(u0, v0, pi + 5)
    PE_USE(u1, v1, pi + 1) PE_LOAD(u1, v1, pi + 6)
    PE_USE(u2, v2, pi + 2) PE_LOAD(u2, v2, pi + 7)
    PE_USE(u3, v3, pi + 3) PE_LOAD(u3, v3, pi + 8)
    PE_USE(u4, v4, pi + 4) PE_LOAD(u4, v4, pi + 9)
  }
  PE_USE(u0, v0, 55) PE_LOAD(u0, v0, 60)
  PE_USE(u1, v1, 56) PE_LOAD(u1, v1, 61)
  PE_USE(u2, v2, 57) PE_LOAD(u2, v2, 62)
  PE_USE(u3, v3, 58) PE_LOAD(u3, v3, 63)
  PE_USE(u4, v4, 59)
  PE_USE(u0, v0, 60) PE_USE(u1, v1, 61) PE_USE(u2, v2, 62) PE_USE(u3, v3, 63)
#pragma unroll
  for (int k = 0; k < 32; ++k) acc[k] += __shfl_xor(acc[k], 32);
  const int b = tok < NLAT ? (tok >> 12) : 8;
  float* xr = tok < NLAT ? p.out + (size_t)tok * 1024 : (float*)(p.ws + OFF_CTXB) + (size_t)(tok - NLAT) * 1024;
  const float* gate = mod + (size_t)b * 6144 + 5 * 1024;
  float4 xn[4];
  float ss = 0.f;
#pragma unroll
  for (int jj = 0; jj < 4; ++jj) {
    const int c = (l + 32 * (4 * hf + jj)) * 4;
    const float4 xv = *(const float4*)(xr + c);
    const float4 gv = *(const float4*)(gate + c);
    const float a0 = hf ? acc[16 + 4 * jj + 0] : acc[4 * jj + 0], a1 = hf ? acc[16 + 4 * jj + 1] : acc[4 * jj + 1];
    const float a2 = hf ? acc[16 + 4 * jj + 2] : acc[4 * jj + 2], a3 = hf ? acc[16 + 4 * jj + 3] : acc[4 * jj + 3];
    xn[jj].x = xv.x + gv.x * a0; xn[jj].y = xv.y + gv.y * a1; xn[jj].z = xv.z + gv.z * a2; xn[jj].w = xv.w + gv.w * a3;
    ss += xn[jj].x * xn[jj].x + xn[jj].y * xn[jj].y + xn[jj].z * xn[jj].z + xn[jj].w * xn[jj].w;
  }
  ss = wave_sum(ss);
  const float rinv = rsqrtf(ss * (1.f / 1024.f) + EPS);
  if (layer == 0) {
    const float* mod1 = (const float*)(p.ws + OFF_MOD) + (size_t)9 * 6144 + (size_t)b * 6144;
    const float* g1 = p.norm1_g + 1024;
    bf16_t* act = (bf16_t*)(p.ws + OFF_ACT) + (size_t)tok * 1024;
#pragma unroll
    for (int jj = 0; jj < 4; ++jj) {
      const int c = (l + 32 * (4 * hf + jj)) * 4;
      if (dowrite) *(float4*)(xr + c) = xn[jj]; else asm volatile("" :: "v"(xn[jj].x), "v"(xn[jj].y), "v"(xn[jj].z), "v"(xn[jj].w));
      const float4 gg4 = *(const float4*)(g1 + c);
      const float4 sh = *(const float4*)(mod1 + c);
      const float4 sc = *(const float4*)(mod1 + 1024 + c);
      uint2 o;
      o.x = pack2h(xn[jj].x * rinv * gg4.x * (1.f + sc.x) + sh.x, xn[jj].y * rinv * gg4.y * (1.f + sc.y) + sh.y);
      o.y = pack2h(xn[jj].z * rinv * gg4.z * (1.f + sc.z) + sh.z, xn[jj].w * rinv * gg4.w * (1.f + sc.w) + sh.w);
      if (dowrite) *(uint2*)(act + c) = o; else asm volatile("" :: "v"(o.x), "v"(o.y));
    }
  } else {
#pragma unroll
    for (int jj = 0; jj < 4; ++jj) {
      const int c = (l + 32 * (4 * hf + jj)) * 4;
      const float4 gg4 = *(const float4*)(p.final_g + c);
      float4 o;
      o.x = xn[jj].x * rinv * gg4.x; o.y = xn[jj].y * rinv * gg4.y; o.z = xn[jj].z * rinv * gg4.z; o.w = xn[jj].w * rinv * gg4.w;
      if (dowrite) *(float4*)(xr + c) = o; else asm volatile("" :: "v"(o.x), "v"(o.y), "v"(o.z), "v"(o.w));
    }
  }
}

__device__ __forceinline__ void phase_peer(const Params& p, int layer, char* smem, int ntok, bool dowrite = true) {
  const int tid = opaque_tid(), lane = tid & 63, wave = __builtin_amdgcn_readfirstlane(tid >> 6);
  __syncthreads();
  if (tid < 64) {
    int cab = -1, c = 0;
    for (int a = 0; a < 16; ++a)
      for (int bb = 0; bb < 16; ++bb)
        if ((a + 1) * (bb + 1) <= 16) { if (c == tid) cab = a * 16 + bb; ++c; }
    ((int*)(smem + PE_OFF_CT))[tid] = cab;
  }
  const int ngroups = ntok / 16, G = gridDim.x, g0 = opaque_bid();
  if (tid == 0) { ((int*)(smem + PE_OFF_TQ))[0] = 0; ((int*)(smem + PE_OFF_TQ))[1] = 0; }
  __syncthreads();
#pragma unroll 1
  for (int r = -1;; ++r) {
    const int cur = g0 + r * G, nxt = cur + G;
    const int ngat = (r >= 0 && cur < ngroups) ? 16 : 0, nsel = nxt < ngroups ? 8 : 0;
    if (ngat + nsel == 0) break;
    int* ctr = (int*)(smem + PE_OFF_TQ) + (r & 1);
    const int b = r & 1, m = min(ngat, nsel);
#pragma unroll 1
    for (;;) {
      int t = 0;
      if (lane == 0) t = atomicAdd(ctr, 1);
      t = __builtin_amdgcn_readfirstlane(t);
      if (t >= ngat + nsel) break;
      int kind, idx;
      if (t < 2 * m) { kind = t & 1; idx = t >> 1; }
      else { kind = nsel > m ? 0 : 1; idx = t - m; }
      if (kind == 0) peer_select_head(p, layer, smem, nxt * 16, idx, wave, b ^ 1, lane);
      else peer_gather_token(p, layer, smem, cur * 16 + idx, idx, b, lane, dowrite);
    }
    if (tid == 0) ((int*)(smem + PE_OFF_TQ))[(r + 1) & 1] = 0;
    __syncthreads();
  }
}

template <int layer>
__device__ __forceinline__ void layer_body(const Params& p, char* smem, const XcdBarrier& xb) {
  constexpr bool nc = layer == 0;
  const float* xin = layer == 0 ? p.x : (const float*)p.out;
  if (layer == 0) {
    phase_norm(p, layer, 0, xin, NTOK);
    xcd_barrier(xb);
  }
#if REP_GEMM
  gemm_phase2<EPI_INPROJ>(p, layer, smem, (const bf16_t*)(p.ws + OFF_ACT), (const bf16_t*)(p.ws + OFF_WIN) + (size_t)layer * 3072 * 1024, NTOK, 3072, nullptr);
  xcd_barrier(xb);
#endif
  gemm_phase2<EPI_INPROJ>(p, layer, smem, (const bf16_t*)(p.ws + OFF_ACT), (const bf16_t*)(p.ws + OFF_WIN) + (size_t)layer * 3072 * 1024, NTOK, 3072, nullptr);
  xcd_barrier(xb);
#if REP_MIX1
  phase_mix1(p, layer, smem, 2);
  xcd_barrier(xb);
#endif
  phase_mix1(p, layer, smem);
  xcd_barrier(xb);
  phase_ret_scan(p, layer);
  xcd_barrier(xb);
#if REP_MIX2
  phase_mix2(p, layer, smem, 3);
  xcd_barrier(xb);
#endif
  phase_mix2(p, layer, smem);
  xcd_barrier(xb);
  gemm_phase2<EPI_OUTPROJ>(p, layer, smem, (const bf16_t*)(p.ws + OFF_ACT), (const bf16_t*)(p.ws + OFF_WOUT) + (size_t)layer * 1024 * 1024, nc ? NTOK : NLAT, 1024, xin);
  xcd_barrier(xb);
  phase_norm(p, layer, 1, (const float*)p.out, nc ? NTOK : NLAT);
  xcd_barrier(xb);
  gemm_phase2<EPI_PLAIN>(p, layer, smem, (const bf16_t*)(p.ws + OFF_ACT), (const bf16_t*)(p.ws + OFF_WQ) + (size_t)layer * 2048 * 1024, nc ? NTOK : NLAT, 2048, nullptr);
  xcd_barrier(xb);
#if REP_PEER
  phase_peer(p, layer, smem, nc ? NTOK : NLAT, false);
  xcd_barrier(xb);
#endif
  phase_peer(p, layer, smem, nc ? NTOK : NLAT);
  if (layer == 0) xcd_barrier(xb);
}

__global__ void __launch_bounds__(512) fwd_megakernel(Params p) {
  cg::grid_group grid = cg::this_grid();
  extern __shared__ __attribute__((aligned(16))) char smem[];
  volatile LAS3 unsigned* xst = (volatile LAS3 unsigned*)(smem + LDS_BCAST + 8);
  if (threadIdx.x == 0) { xst[0] = 0u; xst[1] = 0u; }
  phase_prep(p, smem);
  for (int it = blockIdx.x; it < 256; it += gridDim.x) uv_convert_item(p, it);
  grid.sync();
  const XcdBarrier xb = xcd_barrier_post((unsigned*)(p.ws + OFF_XBAR), xst);
  layer_body<0>(p, smem, xb);
  layer_body<1>(p, smem, xb);
}

extern "C" void kernel_launch(void* const* d_in, const int* in_sizes, int n_in, void* d_out,
                              int out_size, void* d_ws, size_t ws_size, hipStream_t stream) {
  constexpr size_t kDynLds = LDS_BYTES;
  static int grid_blocks = 0;
  if (!grid_blocks) {
    int dev = 0, cus = 0, per_cu = 0;
    (void)hipGetDevice(&dev);
    (void)hipDeviceGetAttribute(&cus, hipDeviceAttributeMultiprocessorCount, dev);
    (void)hipFuncSetAttribute((const void*)fwd_megakernel, hipFuncAttributeMaxDynamicSharedMemorySize, (int)kDynLds);
    (void)hipOccupancyMaxActiveBlocksPerMultiprocessor(&per_cu, fwd_megakernel, 512, kDynLds);
    if (per_cu < 1) { fprintf(stderr, "occupancy query says %d blocks/CU\n", per_cu); per_cu = 1; }
    grid_blocks = cus;
    if (ws_size < WS_END) fprintf(stderr, "workspace too small: %zu < %zu\n", ws_size, (size_t)WS_END);
  }
  Params p{};
  p.x = (const float*)d_in[0]; p.c = (const float*)d_in[1]; p.ctx = (const float*)d_in[2]; p.c_ctx = (const float*)d_in[3];
  p.w_ada = (const float*)d_in[4]; p.b_ada = (const float*)d_in[5]; p.norm1_g = (const float*)d_in[6]; p.w_in = (const float*)d_in[7];
  p.na_rpb = (const float*)d_in[8]; p.diff_lambda = (const float*)d_in[9]; p.diff_subln_g = (const float*)d_in[10];
  p.ret_decay_logit = (const float*)d_in[11]; p.w_out = (const float*)d_in[12]; p.norm2_g = (const float*)d_in[13];
  p.peer_wq = (const float*)d_in[14]; p.peer_subkeys = (const float*)d_in[15]; p.peer_u = (const float*)d_in[16];
  p.peer_v = (const float*)d_in[17]; p.final_g = (const float*)d_in[18];
  p.out = (float*)d_out; p.ws = (char*)d_ws;
  void* args[] = {&p};
  hipError_t e = hipLaunchCooperativeKernel((void*)fwd_megakernel, dim3(grid_blocks), dim3(512), args, kDynLds, stream);
  if (e != hipSuccess) fprintf(stderr, "cooperative launch failed: %s (grid %d)\n", hipGetErrorString(e), grid_blocks);
}
```

```cpp
#include <hip/hip_runtime.h>
#include <hip/hip_cooperative_groups.h>
#include <cstdio>
#include <cstdint>
namespace cg = cooperative_groups;

typedef unsigned short bf16_t;
typedef short bf16x8 __attribute__((ext_vector_type(8)));
typedef float f32x4 __attribute__((ext_vector_type(4)));

constexpr int DM = 1024, BATCH = 8, SEQ = 4096, LCTX = 256;
constexpr int NLAT = BATCH * SEQ;
constexpr int NCTX = BATCH * LCTX;
constexpr int NTOK = NLAT + NCTX;
constexpr int INC = 3072;
constexpr int C_NAQ = 0, C_NAK = 256, C_NAV = 512, C_DFQ = 768, C_DFK = 1024, C_DFV = 1280,
              C_RTQ = 1536, C_RTK = 1792, C_RTV = 2048, C_RTG = 2560;
constexpr int Y_NA = 0, Y_DF = 256, Y_RT = 512;
constexpr int NEXP = 16384;
constexpr float EPS = 1e-6f;

constexpr size_t OFF_CTL  = 0;
constexpr size_t OFF_MISC = 4096;
constexpr size_t OFF_ROPE = 8192;
constexpr size_t OFF_MOD  = OFF_ROPE + 12288;
constexpr size_t SZ_MOD   = 2ull * 9 * 6144 * 4;
constexpr size_t OFF_WIN  = OFF_MOD + SZ_MOD;
constexpr size_t SZ_WIN   = 2ull * 3072 * 1024 * 2;
constexpr size_t OFF_WOUT = OFF_WIN + SZ_WIN;
constexpr size_t SZ_WOUT  = 2ull * 1024 * 1024 * 2;
constexpr size_t OFF_WQ   = OFF_WOUT + SZ_WOUT;
constexpr size_t SZ_WQ    = 2ull * 2048 * 1024 * 2;
constexpr size_t OFF_SUBK = OFF_WQ + SZ_WQ;
constexpr size_t SZ_SUBK  = 2ull * 262144 * 2;
constexpr size_t OFF_U    = OFF_SUBK + SZ_SUBK;
constexpr int    ROWB     = 768;
constexpr int    ROWV     = 512;
constexpr int    RECB     = ROWB + ROWV;
constexpr size_t SZ_UV    = 2ull * NEXP * ROWB;
constexpr size_t OFF_V    = OFF_U + SZ_UV;
constexpr size_t OFF_USC  = OFF_V + SZ_UV;
constexpr size_t OFF_VSC  = OFF_USC + 2ull * NEXP * 4;
constexpr size_t OFF_ACT  = OFF_VSC + 2ull * NEXP * 4;
constexpr size_t SZ_ACT   = (size_t)NTOK * 1024 * 2;
constexpr size_t OFF_P    = OFF_ACT + SZ_ACT;
constexpr size_t SZ_P     = (size_t)NTOK * 3072 * 2;
constexpr size_t OFF_CTXB = OFF_P + SZ_P;
constexpr size_t SZ_CTXB  = (size_t)NCTX * 1024 * 4;
constexpr size_t OFF_RKV  = OFF_CTXB + SZ_CTXB;
constexpr size_t SZ_RKV   = 64ull * 32 * 8192 * 4;
constexpr size_t OFF_RS   = OFF_RKV + SZ_RKV;
constexpr size_t SZ_RS    = 64ull * 8192 * 4;
constexpr size_t OFF_XBAR = OFF_RS + SZ_RS;
constexpr size_t WS_END   = OFF_XBAR + 16384;

#ifndef REP_MIX1
#define REP_MIX1 0
#endif
#ifndef REP_MIX2
#define REP_MIX2 0
#endif
#ifndef REP_PEER
#define REP_PEER 0
#endif
#ifndef REP_GEMM
#define REP_GEMM 0
#endif
constexpr int LDS_BYTES = 152 * 1024;
constexpr int LDS_BCAST = LDS_BYTES - 16;

struct Params {
  const float *x, *c, *ctx, *c_ctx, *w_ada, *b_ada, *norm1_g, *w_in, *na_rpb, *diff_lambda, *diff_subln_g,
              *ret_decay_logit, *w_out, *norm2_g, *peer_wq, *peer_subkeys, *peer_u, *peer_v, *final_g;
  float* out;
  char* ws;
};

__device__ __forceinline__ float bf2f(bf16_t v) { return __uint_as_float(((unsigned)v) << 16); }
__device__ __forceinline__ bf16_t f2bf(float f) {
  unsigned u = __float_as_uint(f);
  u += 0x7fffu + ((u >> 16) & 1u);
  return (bf16_t)(u >> 16);
}
__device__ __forceinline__ unsigned pack2(float a, float b) { return (unsigned)f2bf(a) | ((unsigned)f2bf(b) << 16); }
typedef __bf16 bf16x2_t __attribute__((ext_vector_type(2)));
typedef float f32x2_t __attribute__((ext_vector_type(2)));
__device__ __forceinline__ unsigned pack2h(float a, float b) {
  const f32x2_t v = {a, b};
  return __builtin_bit_cast(unsigned, __builtin_convertvector(v, bf16x2_t));
}
__device__ __forceinline__ float lo16(unsigned w) { return __uint_as_float(w << 16); }
__device__ __forceinline__ float hi16(unsigned w) { return __uint_as_float(w & 0xffff0000u); }
#define DPP_ADD(v, CTRL) ((v) + __int_as_float(__builtin_amdgcn_update_dpp(0, __float_as_int(v), (CTRL), 0xf, 0xf, true)))
__device__ __forceinline__ float row16_sum(float v) {
  v = DPP_ADD(v, 0xB1);
  v = DPP_ADD(v, 0x4E);
  v = DPP_ADD(v, 0x141);
  v = DPP_ADD(v, 0x140);
  return v;
}
#define DPP_MOVU(v, CTRL) ((unsigned)__builtin_amdgcn_update_dpp(0, (int)(v), (CTRL), 0xf, 0xf, true))
__device__ __forceinline__ unsigned row16_max_u32(unsigned v) {
  v = max(v, DPP_MOVU(v, 0xB1)); v = max(v, DPP_MOVU(v, 0x4E)); v = max(v, DPP_MOVU(v, 0x141)); v = max(v, DPP_MOVU(v, 0x140));
  return v;
}
__device__ __forceinline__ unsigned row16_min_u32(unsigned v) {
  v = min(v, DPP_MOVU(v, 0xB1)); v = min(v, DPP_MOVU(v, 0x4E)); v = min(v, DPP_MOVU(v, 0x141)); v = min(v, DPP_MOVU(v, 0x140));
  return v;
}
template <int KTH>
__device__ __forceinline__ unsigned row16_kth_largest(unsigned v) {
  int cnt = 0;
#define R8_STEP(N) { const unsigned o = DPP_MOVU(v, 0x120 + (N)); cnt += (o > v) ? 1 : 0; }
  R8_STEP(1) R8_STEP(2) R8_STEP(3) R8_STEP(4) R8_STEP(5) R8_STEP(6) R8_STEP(7) R8_STEP(8)
  R8_STEP(9) R8_STEP(10) R8_STEP(11) R8_STEP(12) R8_STEP(13) R8_STEP(14) R8_STEP(15)
#undef R8_STEP
  return row16_max_u32(cnt >= KTH - 1 ? v : 0u);
}
__device__ __forceinline__ float wave_sum(float v) {
  v = row16_sum(v);
  const int iv = __float_as_int(v);
  const float a = __int_as_float(__builtin_amdgcn_readlane(iv, 0)), b = __int_as_float(__builtin_amdgcn_readlane(iv, 16));
  const float c = __int_as_float(__builtin_amdgcn_readlane(iv, 32)), d = __int_as_float(__builtin_amdgcn_readlane(iv, 48));
  return (a + b) + (c + d);
}
__device__ __forceinline__ float siluf(float x) { return x / (1.f + __expf(-x)); }

__device__ __forceinline__ int opaque_tid() { int t = threadIdx.x; asm volatile("" : "+v"(t)); return t; }
__device__ __forceinline__ int opaque_bid() { int t = blockIdx.x; asm volatile("" : "+s"(t)); return t; }

#define DOT8(acc, Q, off, U)                                                              \
  acc = fmaf(Q[(off) + 0], lo16((U).x), acc); acc = fmaf(Q[(off) + 1], hi16((U).x), acc); \
  acc = fmaf(Q[(off) + 2], lo16((U).y), acc); acc = fmaf(Q[(off) + 3], hi16((U).y), acc); \
  acc = fmaf(Q[(off) + 4], lo16((U).z), acc); acc = fmaf(Q[(off) + 5], hi16((U).z), acc); \
  acc = fmaf(Q[(off) + 6], lo16((U).w), acc); acc = fmaf(Q[(off) + 7], hi16((U).w), acc);
#define AXPY8(O, off, P, U)                                                                   \
  O[(off) + 0] = fmaf(P, lo16((U).x), O[(off) + 0]); O[(off) + 1] = fmaf(P, hi16((U).x), O[(off) + 1]); \
  O[(off) + 2] = fmaf(P, lo16((U).y), O[(off) + 2]); O[(off) + 3] = fmaf(P, hi16((U).y), O[(off) + 3]); \
  O[(off) + 4] = fmaf(P, lo16((U).z), O[(off) + 4]); O[(off) + 5] = fmaf(P, hi16((U).z), O[(off) + 5]); \
  O[(off) + 6] = fmaf(P, lo16((U).w), O[(off) + 6]); O[(off) + 7] = fmaf(P, hi16((U).w), O[(off) + 7]);
#define UNPACK8(Q, off, U)                                                  \
  Q[(off) + 0] = lo16((U).x); Q[(off) + 1] = hi16((U).x); Q[(off) + 2] = lo16((U).y); Q[(off) + 3] = hi16((U).y); \
  Q[(off) + 4] = lo16((U).z); Q[(off) + 5] = hi16((U).z); Q[(off) + 6] = lo16((U).w); Q[(off) + 7] = hi16((U).w);

__device__ __forceinline__ int next_item(unsigned* counter, char* smem) {
  volatile int* bc = (volatile int*)(smem + LDS_BCAST);
  __syncthreads();
  if (threadIdx.x == 0) *bc = (int)atomicAdd(counter, 1u);
  __syncthreads();
  return *bc;
}

#define XB_TMO      128
#define XB_XCNT(j)  (256  + 64 * (j))
#define XB_XSUB(j)  (1280 + 64 * (j))
#define XB_XGEN(j)  (2304 + 64 * (j))
#define XB_TOP      3328
#define XB_TOPGEN   3392
#define XCD_BAR_WORDS 3456
#define XB_SPIN_CAP (1u << 18)
#define LAS3 __attribute__((address_space(3)))
__device__ __forceinline__ unsigned xb_ld(unsigned* p)              { return __hip_atomic_load(p, __ATOMIC_RELAXED, __HIP_MEMORY_SCOPE_AGENT); }
__device__ __forceinline__ unsigned xb_add(unsigned* p, unsigned v) { return __hip_atomic_fetch_add(p, v, __ATOMIC_RELAXED, __HIP_MEMORY_SCOPE_AGENT); }
__device__ __forceinline__ unsigned xb_xcc_id() { return (unsigned)__builtin_amdgcn_s_getreg((3 << 11) | 20) & 0xFu; }
#define XB_SPIN(cond, bar) do { unsigned _sp = 0; while (cond) { __builtin_amdgcn_s_sleep(1); \
    if ((++_sp & 255u) == 0u) { if (xb_ld(&(bar)[XB_TMO])) break; if (_sp > XB_SPIN_CAP) { atomicAdd(&(bar)[XB_TMO], 1u); break; } } } } while (0)
struct XcdBarrier { unsigned* bar; unsigned x; volatile LAS3 unsigned* st; };
__device__ __forceinline__ XcdBarrier xcd_barrier_post(unsigned* bar, volatile LAS3 unsigned* st) {
  XcdBarrier b; b.bar = bar; b.x = xb_xcc_id(); b.st = st;
  if (threadIdx.x == 0) (void)xb_add(&bar[XB_XCNT(b.x)], 1u);
  return b;
}
__device__ __forceinline__ void xcd_barrier_complete(unsigned* bar, unsigned x, unsigned& nloc, unsigned& nx) {
  const unsigned G = gridDim.x * gridDim.y * gridDim.z;
  unsigned sum, cnt, mine, sp = 0u;
  for (;;) {
    sum = 0u; cnt = 0u; mine = 0u;
#pragma unroll
    for (unsigned j = 0; j < 16; ++j) { const unsigned c = xb_ld(&bar[XB_XCNT(j)]); sum += c; cnt += (c > 0u) ? 1u : 0u; mine = (j == x) ? c : mine; }
    if (sum == G) break;
    __builtin_amdgcn_s_sleep(1);
    if ((++sp & 255u) == 0u) { if (xb_ld(&bar[XB_TMO])) break; if (sp > XB_SPIN_CAP) { atomicAdd(&bar[XB_TMO], 1u); break; } }
  }
  nloc = mine > 0u ? mine : 1u; nx = cnt > 0u ? cnt : 1u;
}
__device__ __forceinline__ void xcd_barrier(const XcdBarrier& b) {
  asm volatile("s_waitcnt vmcnt(0)" ::: "memory");
  __syncthreads();
  if (threadIdx.x == 0) {
    unsigned* bar = b.bar;
    __builtin_amdgcn_s_waitcnt(0);
    unsigned nloc = b.st[0], nx = b.st[1];
    if (nloc == 0u) { xcd_barrier_complete(bar, b.x, nloc, nx); b.st[0] = nloc; b.st[1] = nx; }
    const unsigned old = xb_add(&bar[XB_XSUB(b.x)], 1u);
    const unsigned gen = old / nloc;
    if (old + 1u == (gen + 1u) * nloc) {
      __builtin_amdgcn_fence(__ATOMIC_RELEASE, "agent");
      asm volatile("s_waitcnt vmcnt(0)" ::: "memory");
      const unsigned og = xb_add(&bar[XB_TOP], 1u);
      const unsigned tg = og / nx;
      if (og + 1u == (tg + 1u) * nx) xb_add(&bar[XB_TOPGEN], 1u);
      else XB_SPIN(xb_ld(&bar[XB_TOPGEN]) == tg, bar);
      __builtin_amdgcn_fence(__ATOMIC_ACQUIRE, "agent");
      xb_add(&bar[XB_XGEN(b.x)], 1u);
      asm volatile("s_waitcnt vmcnt(0)" ::: "memory");
    } else {
      XB_SPIN(xb_ld(&bar[XB_XGEN(b.x)]) == gen, bar);
      __builtin_amdgcn_fence(__ATOMIC_ACQUIRE, "agent");
      asm volatile("s_waitcnt vmcnt(0)" ::: "memory");
    }
  }
  __syncthreads();
}

__device__ __forceinline__ void transpose_item(const float* src, bf16_t* dst, int K, int N, int item, char* smem) {
  float* t = (float*)smem;
  const int nb = N / 64;
  const int k0 = (item / nb) * 64, n0 = (item % nb) * 64;
  const int tid = opaque_tid();
  __syncthreads();
#pragma unroll
  for (int i = 0; i < 8; ++i) {
    const int k = (tid >> 6) + 8 * i, n = tid & 63;
    t[k * 65 + n] = src[(size_t)(k0 + k) * N + n0 + n];
  }
  __syncthreads();
#pragma unroll
  for (int i = 0; i < 8; ++i) {
    const int n = (tid >> 6) + 8 * i, k = tid & 63;
    dst[(size_t)(n0 + n) * K + k0 + k] = f2bf(t[k * 65 + n]);
  }
}

__device__ __forceinline__ void convert_flat(const float* src, bf16_t* dst, size_t n4) {
  const size_t gt = (size_t)opaque_bid() * blockDim.x + opaque_tid(), gs = (size_t)gridDim.x * blockDim.x;
  for (size_t i = gt; i < n4; i += gs) {
    const float4 v = ((const float4*)src)[i];
    uint2 o; o.x = pack2h(v.x, v.y); o.y = pack2h(v.z, v.w);
    ((uint2*)dst)[i] = o;
  }
}

__device__ __forceinline__ void phase_prep(const Params& p, char* smem) {
  const int tid = opaque_tid();
  char* ws = p.ws;
  if (opaque_bid() == 0) {
    unsigned* ctl = (unsigned*)(ws + OFF_CTL);
    if (tid < 64) ctl[tid] = 0u;
    unsigned* xbar = (unsigned*)(ws + OFF_XBAR);
    for (int i = tid; i < XCD_BAR_WORDS; i += 512) xbar[i] = 0u;
    float* misc = (float*)(ws + OFF_MISC);
    if (tid < 2) {
      const float* lp = p.diff_lambda + tid * 128;
      float s01 = 0.f, s23 = 0.f;
      for (int i = 0; i < 32; ++i) { s01 += lp[i] * lp[32 + i]; s23 += lp[64 + i] * lp[96 + i]; }
      const float lam_init = 0.8f - 0.6f * expf(-0.3f * (float)tid);
      misc[tid] = expf(s01) - expf(s23) + lam_init;
      misc[2 + tid] = lam_init;
    }
    if (tid >= 128 && tid < 256) misc[64 + tid - 128] = 0.f;
    if (tid >= 64 && tid < 80) {
      const int i = tid - 64;
      const float xv = p.ret_decay_logit[i];
      misc[16 + i] = -log1pf(expf(-xv));
    }
    float2* ropeD = (float2*)(ws + OFF_ROPE);
    float2* ropeR = (float2*)(ws + OFF_ROPE + 4096);
    for (int i = tid; i < 64 * 8; i += 512) {
      const int v = i >> 3, f = i & 7;
      const float inv = powf(10000.0f, -(float)(2 * f) / 16.0f);
      const float ang = (float)v * inv;
      ropeD[i] = make_float2(cosf(ang), sinf(ang));
    }
    for (int i = tid; i < 64 * 16; i += 512) {
      const int v = i >> 4, f = i & 15;
      const float inv = powf(10000.0f, -(float)(2 * f) / 32.0f);
      const float ang = (float)v * inv;
      ropeR[i] = make_float2(cosf(ang), sinf(ang));
    }
  }
  {
    float* sc = (float*)smem;
    float* red = (float*)(smem + 9 * 1024 * 4);
    float* mod = (float*)(ws + OFF_MOD);
    for (int item = opaque_bid(); item < 192; item += gridDim.x) {
      const int l = item / 96, cb = item % 96;
      __syncthreads();
      for (int i = tid; i < 9 * 1024; i += 512) {
        const int r = i >> 10, k = i & 1023;
        const float cv = (r < 8) ? p.c[r * 1024 + k] : p.c_ctx[k];
        sc[i] = siluf(cv);
      }
      __syncthreads();
      const int col = tid & 63, ks = tid >> 6;
      float acc[9];
#pragma unroll
      for (int r = 0; r < 9; ++r) acc[r] = 0.f;
      const float* w = p.w_ada + (size_t)l * 1024 * 6144 + cb * 64 + col;
#pragma unroll 1
      for (int k0 = ks * 128; k0 < ks * 128 + 128; k0 += 16) {
        float wv[16];
#pragma unroll
        for (int i = 0; i < 16; ++i) wv[i] = w[(size_t)(k0 + i) * 6144];
#pragma unroll
        for (int i = 0; i < 16; ++i)
#pragma unroll
          for (int r = 0; r < 9; ++r) acc[r] = fmaf(sc[r * 1024 + k0 + i], wv[i], acc[r]);
      }
#pragma unroll
      for (int r = 0; r < 9; ++r) red[(ks * 9 + r) * 64 + col] = acc[r];
      __syncthreads();
      for (int i = tid; i < 576; i += 512) {
        const int r = i >> 6, cc = i & 63;
        float s = 0.f;
#pragma unroll
        for (int k8 = 0; k8 < 8; ++k8) s += red[(k8 * 9 + r) * 64 + cc];
        mod[((size_t)l * 9 + r) * 6144 + cb * 64 + cc] = s + p.b_ada[l * 6144 + cb * 64 + cc];
      }
    }
    __syncthreads();
  }
  for (int item = opaque_bid(); item < 3072; item += gridDim.x) {
    const int l = item / 1536;
    int r = item % 1536;
    if (r < 768) transpose_item(p.w_in + (size_t)l * 1024 * 3072, (bf16_t*)(ws + OFF_WIN) + (size_t)l * 3072 * 1024, 1024, 3072, r, smem);
    else if (r < 1024) transpose_item(p.w_out + (size_t)l * 1024 * 1024, (bf16_t*)(ws + OFF_WOUT) + (size_t)l * 1024 * 1024, 1024, 1024, r - 768, smem);
    else transpose_item(p.peer_wq + (size_t)l * 1024 * 2048, (bf16_t*)(ws + OFF_WQ) + (size_t)l * 2048 * 1024, 1024, 2048, r - 1024, smem);
  }
  convert_flat(p.peer_subkeys, (bf16_t*)(ws + OFF_SUBK), 2ull * 262144 / 4);
  {
    const size_t gt = (size_t)opaque_bid() * blockDim.x + tid, gs = (size_t)gridDim.x * blockDim.x;
    float4* dst = (float4*)(ws + OFF_CTXB);
    for (size_t i = gt; i < (size_t)NCTX * 1024 / 4; i += gs) dst[i] = ((const float4*)p.ctx)[i];
  }
}

__device__ __forceinline__ void phase_norm(const Params& p, int layer, int which, const float* xlat, int nrows) {
  const int lane = opaque_tid() & 63;
  const int gw = opaque_bid() * 8 + (opaque_tid() >> 6), nw = gridDim.x * 8;
  const float* g = (which == 0 ? p.norm1_g : p.norm2_g) + layer * 1024;
  const float* mod = (const float*)(p.ws + OFF_MOD) + (size_t)layer * 9 * 6144;
  const float* ctxb = (const float*)(p.ws + OFF_CTXB);
  bf16_t* act = (bf16_t*)(p.ws + OFF_ACT);
  const int sh_off = which == 0 ? 0 : 3 * 1024, sc_off = which == 0 ? 1024 : 4 * 1024;
  for (int row = gw; row < nrows; row += nw) {
    const float* src = row < NLAT ? xlat + (size_t)row * 1024 : ctxb + (size_t)(row - NLAT) * 1024;
    const int b = row < NLAT ? (row >> 12) : 8;
    const float* mrow = mod + (size_t)b * 6144;
    float4 v[4];
    float ss = 0.f;
#pragma unroll
    for (int j = 0; j < 4; ++j) {
      v[j] = ((const float4*)src)[lane + 64 * j];
      ss += v[j].x * v[j].x + v[j].y * v[j].y + v[j].z * v[j].z + v[j].w * v[j].w;
    }
    ss = wave_sum(ss);
    const float r = rsqrtf(ss * (1.f / 1024.f) + EPS);
#pragma unroll
    for (int j = 0; j < 4; ++j) {
      const int c = (lane + 64 * j) * 4;
      const float4 gg = *(const float4*)(g + c);
      const float4 sh = *(const float4*)(mrow + sh_off + c);
      const float4 sc = *(const float4*)(mrow + sc_off + c);
      const float o0 = v[j].x * r * gg.x * (1.f + sc.x) + sh.x;
      const float o1 = v[j].y * r * gg.y * (1.f + sc.y) + sh.y;
      const float o2 = v[j].z * r * gg.z * (1.f + sc.z) + sh.z;
      const float o3 = v[j].w * r * gg.w * (1.f + sc.w) + sh.w;
      uint2 o; o.x = pack2h(o0, o1); o.y = pack2h(o2, o3);
      *(uint2*)(act + (size_t)row * 1024 + c) = o;
    }
  }
}

__device__ __forceinline__ void phase_final(const Params& p) {
  const int lane = opaque_tid() & 63;
  const int gw = opaque_bid() * 8 + (opaque_tid() >> 6), nw = gridDim.x * 8;
  for (int row = gw; row < NLAT; row += nw) {
    float* src = p.out + (size_t)row * 1024;
    float4 v[4];
    float ss = 0.f;
#pragma unroll
    for (int j = 0; j < 4; ++j) {
      v[j] = ((const float4*)src)[lane + 64 * j];
      ss += v[j].x * v[j].x + v[j].y * v[j].y + v[j].z * v[j].z + v[j].w * v[j].w;
    }
    ss = wave_sum(ss);
    const float r = rsqrtf(ss * (1.f / 1024.f) + EPS);
#pragma unroll
    for (int j = 0; j < 4; ++j) {
      const int c = (lane + 64 * j) * 4;
      const float4 gg = *(const float4*)(p.final_g + c);
      float4 o;
      o.x = v[j].x * r * gg.x; o.y = v[j].y * r * gg.y; o.z = v[j].z * r * gg.z; o.w = v[j].w * r * gg.w;
      ((float4*)src)[lane + 64 * j] = o;
    }
  }
}

constexpr int EPI_INPROJ = 0, EPI_OUTPROJ = 1, EPI_PLAIN = 2;
constexpr int GS = 72;
constexpr int G_ASTAGE = 256 * GS * 2;
constexpr int G_BSTAGE = 128 * GS * 2;
constexpr int G_STAGE = G_ASTAGE + G_BSTAGE;

namespace g8 {
constexpr int BM = 256, BK = 64, HALF = 128, NXCD = 8, WGM = 8, HT = HALF * BK;
__device__ __forceinline__ int lds_byte(int r, int c) {
  const int st = (r >> 4) * 2 + (c >> 5), rr = r & 15, cc = c & 31, ob = rr * 64 + cc * 2;
  return st * 1024 + (ob ^ (((ob >> 9) & 1) << 5));
}
__device__ __forceinline__ void stage_rc(int b, int& R, int& C) {
  const int st = b / 1024, sb = b % 1024, swz = sb ^ (((sb >> 9) & 1) << 5);
  R = (st >> 1) * 16 + swz / 64; C = (st & 1) * 32 + (swz % 64) / 2;
}
}

constexpr int G8_ROPE_LDS = 8 * 16384;
template <int EPI>
__device__ __forceinline__ void epi_store8(const Params& p, int layer, char* smem, int m, int n, f32x4 lo, f32x4 hi, const float* xin_lat) {
  float v[8] = {lo[0], lo[1], lo[2], lo[3], hi[0], hi[1], hi[2], hi[3]};
  if constexpr (EPI == EPI_INPROJ) {
    const bool ropeD = (n >= C_DFQ && n < C_DFV), ropeR = (n >= C_RTQ && n < C_RTV);
    if ((ropeD || ropeR) && m < NLAT) {
      const int t = m & 4095, gr = t >> 6, gc = t & 63;
      const float2* tabD = (const float2*)(smem + G8_ROPE_LDS);
      const float2* tabR = (const float2*)(smem + G8_ROPE_LDS + 4096);
      const float2* tb;
      if (ropeD) { const int i0 = (n & 31) >> 1; tb = i0 < 8 ? tabD + gr * 8 + i0 : tabD + gc * 8 + i0 - 8; }
      else { const int i0 = (n & 63) >> 1; tb = i0 < 16 ? tabR + gr * 16 + i0 : tabR + gc * 16 + i0 - 16; }
#pragma unroll
      for (int q = 0; q < 4; ++q) {
        const float2 cs = tb[q];
        const float a0 = v[2 * q] * cs.x - v[2 * q + 1] * cs.y, a1 = v[2 * q] * cs.y + v[2 * q + 1] * cs.x;
        v[2 * q] = a0; v[2 * q + 1] = a1;
      }
    }
    float sc = 1.f;
    if (n < C_NAK) sc = 0.125f * 1.4426950408889634f;
    else if (n >= C_DFQ && n < C_DFK) sc = 0.17677669529663687f * 1.4426950408889634f;
    else if (n >= C_RTK && n < C_RTV) sc = 0.125f;
    uint4 o;
    o.x = pack2h(v[0] * sc, v[1] * sc); o.y = pack2h(v[2] * sc, v[3] * sc); o.z = pack2h(v[4] * sc, v[5] * sc); o.w = pack2h(v[6] * sc, v[7] * sc);
    *(uint4*)((bf16_t*)(p.ws + OFF_P) + (size_t)m * INC + n) = o;
  } else if constexpr (EPI == EPI_OUTPROJ) {
    const float* mod = (const float*)(p.ws + OFF_MOD) + (size_t)layer * 9 * 6144;
    const int b = m < NLAT ? (m >> 12) : 8;
    const float* gp = mod + (size_t)b * 6144 + 2 * 1024 + n;
    const float4 g0 = *(const float4*)gp, g1 = *(const float4*)(gp + 4);
    const float* xi; float* xo;
    if (m < NLAT) { xi = xin_lat + (size_t)m * 1024 + n; xo = p.out + (size_t)m * 1024 + n; }
    else { xo = (float*)(p.ws + OFF_CTXB) + (size_t)(m - NLAT) * 1024 + n; xi = xo; }
    const float4 x0 = *(const float4*)xi, x1 = *(const float4*)(xi + 4);
    float4 o0, o1;
    o0.x = x0.x + g0.x * v[0]; o0.y = x0.y + g0.y * v[1]; o0.z = x0.z + g0.z * v[2]; o0.w = x0.w + g0.w * v[3];
    o1.x = x1.x + g1.x * v[4]; o1.y = x1.y + g1.y * v[5]; o1.z = x1.z + g1.z * v[6]; o1.w = x1.w + g1.w * v[7];
    *(float4*)xo = o0; *(float4*)(xo + 4) = o1;
  } else if constexpr (EPI == EPI_PLAIN) {
    uint4 o;
    o.x = pack2h(v[0], v[1]); o.y = pack2h(v[2], v[3]); o.z = pack2h(v[4], v[5]); o.w = pack2h(v[6], v[7]);
    *(uint4*)((bf16_t*)(p.ws + OFF_P) + (size_t)m * 2048 + n) = o;
  } else {
    asm volatile("" :: "v"(v[0]), "v"(v[1]), "v"(v[2]), "v"(v[3]), "v"(v[4]), "v"(v[5]), "v"(v[6]), "v"(v[7]));
  }
}

#define G8_LAS __attribute__((address_space(3)))
__device__ __forceinline__ bool g8_next(int i, int nM, int nN, int G, int c, int& pm, int& pn) {
  using namespace g8;
  const int nwg = nM * nN;
  const long Lx = (long)i * G + c;
  if (Lx >= nwg) return false;
  int wgid = (int)Lx;
  { const int q = nwg / NXCD, r = nwg % NXCD, xcd = wgid % NXCD, off = wgid / NXCD; wgid = (xcd < r ? xcd * (q + 1) : r * (q + 1) + (xcd - r) * q) + off; }
  const int nig = WGM * nN, gid = wgid / nig, fm = gid * WGM, gsz = (nM - fm) < WGM ? (nM - fm) : WGM;
  pm = fm + ((wgid % nig) % gsz); pn = (wgid % nig) / gsz;
  return true;
}

template <int EPI>
__device__ __forceinline__ void gemm_phase2(const Params& p, int layer, char* smem, const bf16_t* A, const bf16_t* Bt,
                                            int M, int N, const float* xin_lat) {
  using namespace g8;
  constexpr int K = 1024, nt = K / BK, HTB = HALF * BK * 2;
  G8_LAS unsigned char* lds = (G8_LAS unsigned char*)smem;
  const int tid = opaque_tid();
  const int wid = __builtin_amdgcn_readfirstlane(tid >> 6), lane = tid & 63, wr = wid >> 2, wc = wid & 3, fr = lane & 15, fq = lane >> 4;
  unsigned voff[2], voffB[2];
#pragma unroll
  for (int i = 0; i < 2; ++i) {
    int R, C; stage_rc(tid * 16 + i * 8192, R, C);
    const int rho = R & 31, Rb = (R & ~31) + 8 * ((rho & 15) >> 2) + 4 * (rho >> 4) + (rho & 3);
    voff[i] = (unsigned)(R * K + C) * 2u; voffB[i] = (unsigned)(Rb * K + C) * 2u;
  }
  if constexpr (EPI == EPI_INPROJ) {
    __syncthreads();
    const float4* gsrc = (const float4*)(p.ws + OFF_ROPE);
    float4* ldst = (float4*)(smem + G8_ROPE_LDS);
    for (int i = tid; i < 12288 / 16; i += 512) ldst[i] = gsrc[i];
  }
  constexpr size_t kstep = (size_t)(BK * 2);
  constexpr size_t hstep = (size_t)HALF * K * 2;
  constexpr size_t tstep = 2 * hstep;
  const unsigned ldsw = (unsigned)wid * 1024u;
  const int aoff = lds_byte(wr * 64 + fr, fq * 8), boff = lds_byte(wc * 32 + fr, fq * 8);
#define G8_SA(b, h) (((b) * 2 + (h)) * HTB)
#define G8_SB(b, h) ((4 + (b) * 2 + (h)) * HTB)
#define G8_STAGE_V(bufoff, gbase, VO) do { _Pragma("unroll") for (int _i = 0; _i < 2; ++_i)                                  \
    __builtin_amdgcn_global_load_lds((const unsigned*)((const char*)(gbase) + VO[_i]), (G8_LAS unsigned*)(lds + (bufoff) + ldsw + _i * 8192), 16, 0, 0); } while (0)
#define G8_LDA(dst, b, h) do { _Pragma("unroll") for (int m = 0; m < 4; ++m) _Pragma("unroll") for (int k = 0; k < 2; ++k) dst[m][k] = *(const G8_LAS bf16x8*)(lds + G8_SA(b, h) + aoff + m * 2048 + k * 1024); } while (0)
#define G8_LDB(dst, b, h) do { _Pragma("unroll") for (int n = 0; n < 2; ++n) _Pragma("unroll") for (int k = 0; k < 2; ++k) dst[n][k] = *(const G8_LAS bf16x8*)(lds + G8_SB(b, h) + boff + n * 2048 + k * 1024); } while (0)
#define G8_MMA(ai, bj, At_, Bt_) do { __builtin_amdgcn_s_setprio(1);                                                          \
    _Pragma("unroll") for (int m = 0; m < 4; ++m) _Pragma("unroll") for (int n = 0; n < 2; ++n) _Pragma("unroll") for (int k = 0; k < 2; ++k) \
      acc[ai][bj][m][n] = __builtin_amdgcn_mfma_f32_16x16x32_bf16(Bt_[n][k], At_[m][k], acc[ai][bj][m][n], 0, 0, 0);          \
    __builtin_amdgcn_s_setprio(0); } while (0)
#define G8_WAIT_V(n) asm volatile("s_waitcnt vmcnt(" #n ")" ::: "memory")
#define G8_WAIT_L(n) asm volatile("s_waitcnt lgkmcnt(" #n ")" ::: "memory")
#define G8_BAR __builtin_amdgcn_s_barrier()
#define G8_SCHED __builtin_amdgcn_sched_barrier(0)
  const int nM = M / BM, nN = N / BM, G = gridDim.x, cu = opaque_bid();
  int cpm, cpn, npm = 0, npn = 0, ui = 0;
  __syncthreads();
  if (g8_next(0, nM, nN, G, cu, cpm, cpn)) {
    f32x4 acc[2][2][4][2];
#pragma unroll
    for (int a = 0; a < 2; ++a)
#pragma unroll
      for (int b2 = 0; b2 < 2; ++b2)
#pragma unroll
        for (int m = 0; m < 4; ++m)
#pragma unroll
          for (int n = 0; n < 2; ++n) acc[a][b2][m][n] = (f32x4){0.f, 0.f, 0.f, 0.f};
    bf16x8 At[4][2], B0[2][2], B1[2][2];
    const char* cA = (const char*)A + (size_t)cpm * tstep;
    const char* cB = (const char*)Bt + (size_t)cpn * tstep;
    G8_STAGE_V(G8_SB(0, 0), cB, voffB); G8_STAGE_V(G8_SA(0, 0), cA, voff); G8_STAGE_V(G8_SB(0, 1), cB + hstep, voffB); G8_STAGE_V(G8_SA(0, 1), cA + hstep, voff);
    if (wr == 1) G8_BAR;
    G8_WAIT_V(4); G8_BAR;
    G8_STAGE_V(G8_SB(1, 0), cB + kstep, voffB); G8_STAGE_V(G8_SA(1, 0), cA + kstep, voff); G8_STAGE_V(G8_SB(1, 1), cB + hstep + kstep, voffB);
    G8_WAIT_V(6); G8_BAR;
    for (;;) {
      const bool has_next = g8_next(ui + 1, nM, nN, G, cu, npm, npn);
      const char* nA = has_next ? (const char*)A + (size_t)npm * tstep : cA;
      const char* nB = has_next ? (const char*)Bt + (size_t)npn * tstep : cB;
#pragma unroll 1
      for (int t = 0; t < nt; t += 2) {
        const bool last = (t == nt - 2);
        const char* a1 = cA + (size_t)(t + 1) * kstep;
        const char* a2 = last ? nA : cA + (size_t)(t + 2) * kstep; const char* b2 = last ? nB : cB + (size_t)(t + 2) * kstep;
        const char* a3 = a2 + kstep; const char* b3 = b2 + kstep;
        G8_LDB(B0, 0, 0); G8_SCHED; G8_LDA(At, 0, 0); G8_STAGE_V(G8_SA(1, 1), a1 + hstep, voff);
        G8_WAIT_L(8); G8_BAR; G8_WAIT_L(0); G8_MMA(0, 0, At, B0); G8_BAR; G8_SCHED;
        G8_LDB(B1, 0, 1); G8_STAGE_V(G8_SB(0, 0), b2, voffB);
        G8_BAR; G8_WAIT_L(0); G8_MMA(0, 1, At, B1); G8_BAR;
        G8_LDA(At, 0, 1); G8_STAGE_V(G8_SA(0, 0), a2, voff);
        G8_BAR; G8_WAIT_L(0); G8_MMA(1, 0, At, B0); G8_BAR; G8_SCHED;
        G8_STAGE_V(G8_SB(0, 1), b2 + hstep, voffB);
        G8_WAIT_V(6); G8_BAR; G8_MMA(1, 1, At, B1); G8_BAR;
        G8_LDB(B0, 1, 0); G8_SCHED; G8_LDA(At, 1, 0); G8_STAGE_V(G8_SA(0, 1), a2 + hstep, voff);
        G8_WAIT_L(8); G8_BAR; G8_WAIT_L(0); G8_MMA(0, 0, At, B0); G8_BAR; G8_SCHED;
        G8_LDB(B1, 1, 1); G8_STAGE_V(G8_SB(1, 0), b3, voffB);
        G8_BAR; G8_WAIT_L(0); G8_MMA(0, 1, At, B1); G8_BAR;
        G8_LDA(At, 1, 1); G8_STAGE_V(G8_SA(1, 0), a3, voff);
        G8_BAR; G8_WAIT_L(0); G8_MMA(1, 0, At, B0); G8_BAR; G8_SCHED;
        G8_STAGE_V(G8_SB(1, 1), b3 + hstep, voffB);
        G8_WAIT_V(6); G8_BAR; G8_MMA(1, 1, At, B1); G8_BAR;
      }
      {
        const int brow = cpm * BM, bcol = cpn * BM;
        if constexpr (EPI == EPI_INPROJ) {
          if (bcol == C_DFK) {
#pragma unroll
            for (int bj = 0; bj < 2; ++bj) {
              float mx = 0.f;
#pragma unroll
              for (int ai = 0; ai < 2; ++ai)
#pragma unroll
                for (int m = 0; m < 4; ++m) {
                  float s = 0.f;
#pragma unroll
                  for (int n = 0; n < 2; ++n)
#pragma unroll
                    for (int j = 0; j < 4; ++j) s = fmaf(acc[ai][bj][m][n][j], acc[ai][bj][m][n][j], s);
                  s += __shfl_xor(s, 16); s += __shfl_xor(s, 32);
                  mx = fmaxf(mx, s);
                }
#pragma unroll
              for (int o = 1; o < 16; o <<= 1) mx = fmaxf(mx, __shfl_xor(mx, o));
              if (lane == 0) {
                const int bb = brow < NLAT ? (brow >> 12) : ((brow - NLAT) >> 8);
                unsigned* km = (unsigned*)(p.ws + OFF_MISC) + 64 + layer * 64 + (bb * 4 + bj * 2 + (wc >> 1)) * 2 + (wc & 1);
                atomicMax(km, __float_as_uint(mx));
              }
            }
          }
        }
#pragma unroll
        for (int ai = 0; ai < 2; ++ai)
#pragma unroll
          for (int bj = 0; bj < 2; ++bj)
#pragma unroll
            for (int m = 0; m < 4; ++m)
              epi_store8<EPI>(p, layer, smem, brow + ai * HALF + wr * 64 + m * 16 + fr, bcol + bj * HALF + wc * 32 + fq * 8,
                              acc[ai][bj][m][0], acc[ai][bj][m][1], xin_lat);
      }
      if (!has_next) break;
#pragma unroll
      for (int a = 0; a < 2; ++a)
#pragma unroll
        for (int b2 = 0; b2 < 2; ++b2)
#pragma unroll
          for (int m = 0; m < 4; ++m)
#pragma unroll
            for (int n = 0; n < 2; ++n) acc[a][b2][m][n] = (f32x4){0.f, 0.f, 0.f, 0.f};
      cpm = npm; cpn = npn; cA = nA; cB = nB; ++ui;
    }
    G8_WAIT_V(0);
    if (wr == 0) G8_BAR;
    G8_BAR;
  }
}

__device__ __forceinline__ unsigned cvt_pk_bf16(float lo, float hi) { return pack2h(lo, hi); }
__device__ __forceinline__ void vt_store8(bf16_t* vt, int stride, int d0, int key, uint4 uv) {
  bf16_t* vd = vt + d0 * stride + key;
  vd[0 * stride] = (bf16_t)(uv.x & 0xffffu); vd[1 * stride] = (bf16_t)(uv.x >> 16);
  vd[2 * stride] = (bf16_t)(uv.y & 0xffffu); vd[3 * stride] = (bf16_t)(uv.y >> 16);
  vd[4 * stride] = (bf16_t)(uv.z & 0xffffu); vd[5 * stride] = (bf16_t)(uv.z >> 16);
  vd[6 * stride] = (bf16_t)(uv.w & 0xffffu); vd[7 * stride] = (bf16_t)(uv.w >> 16);
}

constexpr int DKS = 72;
__device__ __forceinline__ void diff_item(const Params& p, int layer, bool ctxq, int item, char* smem) {
  const bf16_t* P = (const bf16_t*)(p.ws + OFF_P);
  bf16_t* Y = (bf16_t*)(p.ws + OFF_ACT);
  const float* misc = (const float*)(p.ws + OFF_MISC);
  const float lam = misc[layer], lam_init = misc[2 + layer];
  const int tid = opaque_tid(), lane = tid & 63, wave = tid >> 6, lr = lane & 15, lq = lane >> 4;
  int b, h, mbase, nkeys;
  if (!ctxq) { b = item >> 6; h = (item >> 4) & 3; mbase = b * 4096 + (item & 15) * 256; nkeys = 256 + 4096; }
  else { b = item >> 2; h = item & 3; mbase = NLAT + b * 256; nkeys = 256; }
  const float kmax0 = sqrtf(misc[64 + layer * 64 + (b * 4 + h) * 2 + 0]), kmax1 = sqrtf(misc[64 + layer * 64 + (b * 4 + h) * 2 + 1]);
  bf16x8 qf[2][2];
  f32x4 C0[2], C1[2];
#pragma unroll
  for (int qt = 0; qt < 2; ++qt) {
    const bf16_t* qr = P + (size_t)(mbase + wave * 32 + qt * 16 + lr) * INC + C_DFQ + h * 64 + lq * 8;
    const uint4 u0 = *(const uint4*)(qr), u1 = *(const uint4*)(qr + 32);
    float s0 = 0.f, s1 = 0.f;
    { float t[8]; UNPACK8(t, 0, u0) _Pragma("unroll") for (int i = 0; i < 8; ++i) s0 = fmaf(t[i], t[i], s0); }
    { float t[8]; UNPACK8(t, 0, u1) _Pragma("unroll") for (int i = 0; i < 8; ++i) s1 = fmaf(t[i], t[i], s1); }
    s0 += __shfl_xor(s0, 16); s0 += __shfl_xor(s0, 32);
    s1 += __shfl_xor(s1, 16); s1 += __shfl_xor(s1, 32);
    const float nm0 = -sqrtf(s0) * kmax0, nm1 = -sqrtf(s1) * kmax1;
    C0[qt] = (f32x4){nm0, nm0, nm0, nm0};
    C1[qt] = (f32x4){nm1, nm1, nm1, nm1};
    union { uint4 u; bf16x8 v; } c0, c1; c0.u = u0; c1.u = u1;
    qf[qt][0] = c0.v; qf[qt][1] = c1.v;
  }
  f32x4 O0[2][4], O1[2][4];
#pragma unroll
  for (int qt = 0; qt < 2; ++qt)
#pragma unroll
    for (int i = 0; i < 4; ++i) { O0[qt][i] = (f32x4){0.f, 0.f, 0.f, 0.f}; O1[qt][i] = (f32x4){0.f, 0.f, 0.f, 0.f}; }
  f32x4 L0[2], L1[2];
#pragma unroll
  for (int qt = 0; qt < 2; ++qt) { L0[qt] = (f32x4){0.f, 0.f, 0.f, 0.f}; L1[qt] = (f32x4){0.f, 0.f, 0.f, 0.f}; }
  const bf16x8 ones8 = {(short)0x3F80, (short)0x3F80, (short)0x3F80, (short)0x3F80, (short)0x3F80, (short)0x3F80, (short)0x3F80, (short)0x3F80};
  const int lkey = tid >> 3, lch = tid & 7;
  constexpr int DBUF = 2 * 128 * DKS * 2;
  uint4 ukA0, ukA1, uvA0, uvA1;
#define DF_GLOAD1(UK, UV, T, I)                                                                     \
  {                                                                                                 \
    const int kk = (T) * 128 + (I) * 64 + lkey;                                                     \
    const size_t row = kk < 256 ? (size_t)(NLAT + b * 256 + kk) : (size_t)(b * 4096 + kk - 256);    \
    UK = *(const uint4*)(P + row * INC + C_DFK + h * 64 + lch * 8);                                 \
    UV = *(const uint4*)(P + row * INC + C_DFV + h * 64 + lch * 8);                                 \
  }
#define DF_LSTORE1(UK, UV, BUF, I)                                                                  \
  {                                                                                                 \
    bf16_t* Ks_ = (bf16_t*)(smem + (BUF) * DBUF) + (I) * 64 * DKS;                                  \
    bf16_t* Vt_ = (bf16_t*)(smem + (BUF) * DBUF) + 128 * DKS + (I) * 64 * DKS;                      \
    *(uint4*)(Ks_ + lkey * DKS + lch * 8) = UK;                                                     \
    vt_store8(Vt_, DKS, lch * 8, lkey, UV);                                                         \
  }
#define DF_GLOAD(S, T) DF_GLOAD1(uk##S##0, uv##S##0, T, 0) DF_GLOAD1(uk##S##1, uv##S##1, T, 1)
#define DF_LSTORE(S, BUF) DF_LSTORE1(uk##S##0, uv##S##0, BUF, 0) DF_LSTORE1(uk##S##1, uv##S##1, BUF, 1)
  const int ntile = nkeys >> 7;
  __syncthreads();
  DF_GLOAD(A, 0)
  DF_LSTORE(A, 0)
  __syncthreads();
#pragma unroll 1
  for (int t = 0; t < ntile; ++t) {
    const int cur = t & 1;
    if (t + 1 < ntile) { DF_GLOAD(A, t + 1) }
#pragma unroll 1
    for (int sub = 0; sub < 2; ++sub) {
    const bf16_t* Ks = (const bf16_t*)(smem + cur * DBUF) + sub * 64 * DKS;
    const bf16_t* Vt = (const bf16_t*)(smem + cur * DBUF) + 128 * DKS + sub * 64 * DKS;
    union PF { unsigned u[4]; bf16x8 v; };
    PF pf0[2][2], pf1[2][2];
#pragma unroll
    for (int c = 0; c < 2; ++c) {
      f32x4 S[2][4];
#pragma unroll
      for (int kt = 0; kt < 4; ++kt) {
        const bf16x8 kf = *(const bf16x8*)(Ks + (kt * 16 + lr) * DKS + c * 32 + lq * 8);
#pragma unroll
        for (int qt = 0; qt < 2; ++qt) S[qt][kt] = __builtin_amdgcn_mfma_f32_16x16x32_bf16(kf, qf[qt][c], c == 0 ? C0[qt] : C1[qt], 0, 0, 0);
      }
#pragma unroll
      for (int qt = 0; qt < 2; ++qt) {
#pragma unroll
        for (int kt = 0; kt < 4; ++kt) {
#pragma unroll
          for (int r = 0; r < 4; ++r) S[qt][kt][r] = __builtin_amdgcn_exp2f(S[qt][kt][r]);
        }
#pragma unroll
        for (int g = 0; g < 2; ++g) {
          PF t;
          t.u[0] = cvt_pk_bf16(S[qt][2 * g][0], S[qt][2 * g][1]); t.u[1] = cvt_pk_bf16(S[qt][2 * g][2], S[qt][2 * g][3]);
          t.u[2] = cvt_pk_bf16(S[qt][2 * g + 1][0], S[qt][2 * g + 1][1]); t.u[3] = cvt_pk_bf16(S[qt][2 * g + 1][2], S[qt][2 * g + 1][3]);
          if (c == 0) pf0[qt][g] = t; else pf1[qt][g] = t;
        }
      }
    }
#pragma unroll
    for (int g = 0; g < 2; ++g) {
#pragma unroll
      for (int qt = 0; qt < 2; ++qt) {
        L0[qt] = __builtin_amdgcn_mfma_f32_16x16x32_bf16(ones8, pf0[qt][g].v, L0[qt], 0, 0, 0);
        L1[qt] = __builtin_amdgcn_mfma_f32_16x16x32_bf16(ones8, pf1[qt][g].v, L1[qt], 0, 0, 0);
      }
#pragma unroll
      for (int dt = 0; dt < 4; ++dt) {
        union { uint2 h2[2]; bf16x8 v; } vf;
        vf.h2[0] = *(const uint2*)(Vt + (dt * 16 + lr) * DKS + 32 * g + 4 * lq);
        vf.h2[1] = *(const uint2*)(Vt + (dt * 16 + lr) * DKS + 32 * g + 16 + 4 * lq);
#pragma unroll
        for (int qt = 0; qt < 2; ++qt) {
          O0[qt][dt] = __builtin_amdgcn_mfma_f32_16x16x32_bf16(vf.v, pf0[qt][g].v, O0[qt][dt], 0, 0, 0);
          O1[qt][dt] = __builtin_amdgcn_mfma_f32_16x16x32_bf16(vf.v, pf1[qt][g].v, O1[qt][dt], 0, 0, 0);
        }
      }
    }
    }
    if (t + 1 < ntile) { DF_LSTORE(A, cur ^ 1) }
    __syncthreads();
  }
  const float* sg = p.diff_subln_g + layer * 64;
#pragma unroll
  for (int qt = 0; qt < 2; ++qt) {
    const float a0 = L0[qt][0], a1 = L1[qt][0];
    const float i0 = 1.f / a0, i1 = lam / a1;
    float ss = 0.f;
#pragma unroll
    for (int dt = 0; dt < 4; ++dt) {
#pragma unroll
      for (int r = 0; r < 4; ++r) { const float v = O0[qt][dt][r] * i0 - O1[qt][dt][r] * i1; O0[qt][dt][r] = v; ss = fmaf(v, v, ss); }
    }
    ss += __shfl_xor(ss, 16); ss += __shfl_xor(ss, 32);
    const float rr = rsqrtf(ss * (1.f / 64.f) + EPS) * (1.f - lam_init);
    bf16_t* dst = Y + (size_t)(mbase + wave * 32 + qt * 16 + lr) * 1024 + Y_DF + h * 64;
#pragma unroll
    for (int dt = 0; dt < 4; ++dt) {
      const int d = dt * 16 + 4 * lq;
      const float4 g4 = *(const float4*)(sg + d);
      uint2 ov;
      ov.x = pack2(O0[qt][dt][0] * rr * g4.x, O0[qt][dt][1] * rr * g4.y);
      ov.y = pack2(O0[qt][dt][2] * rr * g4.z, O0[qt][dt][3] * rr * g4.w);
      *(uint2*)(dst + d) = ov;
    }
  }
}

constexpr int NA_WS = 520;
constexpr int NA_CS = 264;
constexpr int NA_OFF_VTW = 0;
constexpr int NA_OFF_VTC = 64 * NA_WS * 2;
constexpr int NA_OFF_RPB = NA_OFF_VTC + 64 * NA_CS * 2;
constexpr int NA_OFF_MRG = NA_OFF_RPB + 2048;

#define NA_STEP(KA_EXPR, KB_EXPR, BIAS_EXPR, VT_PTR, VT_STRIDE, VT_KEY0_EXPR)                                    \
  {                                                                                                               \
    f32x4 S[4];                                                                                                   \
    _Pragma("unroll") for (int kt = 0; kt < 4; ++kt) {                                                            \
      f32x4 a = __builtin_amdgcn_mfma_f32_16x16x32_bf16((KA_EXPR), qf[0], (f32x4){0.f, 0.f, 0.f, 0.f}, 0, 0, 0);  \
      S[kt] = __builtin_amdgcn_mfma_f32_16x16x32_bf16((KB_EXPR), qf[1], a, 0, 0, 0);                               \
    }                                                                                                             \
    _Pragma("unroll") for (int kt = 0; kt < 4; ++kt) {                                                            \
      _Pragma("unroll") for (int r = 0; r < 4; ++r) { S[kt][r] += (BIAS_EXPR); }                                  \
    }                                                                                                             \
    float x = fmaxf(fmaxf(S[0][0], S[0][1]), fmaxf(S[0][2], S[0][3]));                                            \
    _Pragma("unroll") for (int kt = 1; kt < 4; ++kt) x = fmaxf(x, fmaxf(fmaxf(S[kt][0], S[kt][1]), fmaxf(S[kt][2], S[kt][3]))); \
    x = fmaxf(x, __shfl_xor(x, 16)); x = fmaxf(x, __shfl_xor(x, 32));                                             \
    const float mn = fmaxf(mrun, x);                                                                              \
    const float al = __builtin_amdgcn_exp2f(mrun - mn);                                                           \
    mrun = mn;                                                                                                    \
    float ps = 0.f;                                                                                               \
    _Pragma("unroll") for (int kt = 0; kt < 4; ++kt) {                                                            \
      _Pragma("unroll") for (int r = 0; r < 4; ++r) { S[kt][r] = __builtin_amdgcn_exp2f(S[kt][r] - mn); ps += S[kt][r]; } \
    }                                                                                                             \
    lrun = lrun * al + ps;                                                                                        \
    _Pragma("unroll") for (int dt = 0; dt < 4; ++dt) {                                                            \
      _Pragma("unroll") for (int r = 0; r < 4; ++r) O[dt][r] *= al;                                               \
    }                                                                                                             \
    _Pragma("unroll") for (int g = 0; g < 2; ++g) {                                                               \
      union { unsigned u[4]; bf16x8 v; } pf;                                                                      \
      pf.u[0] = cvt_pk_bf16(S[2 * g][0], S[2 * g][1]); pf.u[1] = cvt_pk_bf16(S[2 * g][2], S[2 * g][3]);           \
      pf.u[2] = cvt_pk_bf16(S[2 * g + 1][0], S[2 * g + 1][1]); pf.u[3] = cvt_pk_bf16(S[2 * g + 1][2], S[2 * g + 1][3]); \
      const int vk0 = (VT_KEY0_EXPR);                                                                             \
      _Pragma("unroll") for (int dt = 0; dt < 4; ++dt) {                                                          \
        union { uint2 h2[2]; bf16x8 v; } vf;                                                                      \
        vf.h2[0] = *(const uint2*)((VT_PTR) + (dt * 16 + lr) * (VT_STRIDE) + vk0 + 4 * lq);                       \
        vf.h2[1] = *(const uint2*)((VT_PTR) + (dt * 16 + lr) * (VT_STRIDE) + vk0 + 16 + 4 * lq);                  \
        O[dt] = __builtin_amdgcn_mfma_f32_16x16x32_bf16(vf.v, pf.v, O[dt], 0, 0, 0);                              \
      }                                                                                                           \
    }                                                                                                             \
  }

__device__ __forceinline__ void na_latent_item(const Params& p, int layer, int item, char* smem) {
  const bf16_t* P = (const bf16_t*)(p.ws + OFF_P);
  bf16_t* Y = (bf16_t*)(p.ws + OFF_ACT);
  const int b = item >> 8, h = (item >> 6) & 3, grow = item & 63;
  const int tid = opaque_tid(), lane = tid & 63, wave = tid >> 6, lr = lane & 15, lq = lane >> 4;
  const int jt = wave & 3, half = wave >> 2;
  bf16_t* VtW = (bf16_t*)(smem + NA_OFF_VTW);
  bf16_t* VtC = (bf16_t*)(smem + NA_OFF_VTC);
  float* RPB = (float*)(smem + NA_OFF_RPB);
  float* MRG = (float*)(smem + NA_OFF_MRG);
  const int rs = min(max(grow - 4, 0), 56);
  __syncthreads();
  {
    const int ch = tid & 7;
#pragma unroll
    for (int i = 0; i < 8; ++i) {
      const int key = (tid >> 3) + 64 * i;
      const uint4 uv = *(const uint4*)(P + (size_t)(b * 4096 + (rs + (key >> 6)) * 64 + (key & 63)) * INC + C_NAV + h * 64 + ch * 8);
      vt_store8(VtW, NA_WS, ch * 8, key, uv);
    }
#pragma unroll
    for (int i = 0; i < 4; ++i) {
      const int key = (tid >> 3) + 64 * i;
      const uint4 uv = *(const uint4*)(P + (size_t)(NLAT + b * 256 + key) * INC + C_NAV + h * 64 + ch * 8);
      vt_store8(VtC, NA_CS, ch * 8, key, uv);
    }
    if (tid < 465) RPB[tid] = p.na_rpb[(size_t)(layer * 4 + h) * 465 + tid] * 1.4426950408889634f;
  }
  const int qc = jt * 16 + lr;
  const int mq = b * 4096 + grow * 64 + qc;
  bf16x8 qf[2];
  {
    const bf16_t* qr = P + (size_t)mq * INC + C_NAQ + h * 64 + lq * 8;
    qf[0] = *(const bf16x8*)(qr);
    qf[1] = *(const bf16x8*)(qr + 32);
  }
  f32x4 O[4];
#pragma unroll
  for (int i = 0; i < 4; ++i) O[i] = (f32x4){0.f, 0.f, 0.f, 0.f};
  float mrun = -1e30f, lrun = 0.f;
  const int k0 = min(max(jt * 16 - 8, 0), 32);
  const int cs = min(max(qc - 8, 0), 48);
  bf16x8 kfa[2][4], kfb[2][4];
#define NA_LOADK(SET, S_)                                                                                        \
  _Pragma("unroll") for (int kt = 0; kt < 4; ++kt) {                                                             \
    const int t_ = 4 * (S_) + kt;                                                                                \
    const size_t krow = half == 0 ? (size_t)(b * 4096 + (rs + (t_ >> 1)) * 64 + k0 + 16 * (t_ & 1) + lr) : (size_t)(NLAT + b * 256 + 16 * t_ + lr); \
    const bf16_t* kp = P + krow * INC + C_NAK + h * 64 + lq * 8;                                                 \
    kfa[SET][kt] = *(const bf16x8*)(kp); kfb[SET][kt] = *(const bf16x8*)(kp + 32);                               \
  }
  NA_LOADK(0, 0)
  __syncthreads();
#pragma unroll
  for (int s = 0; s < 4; ++s) {
    if (s + 1 < 4) { NA_LOADK((s + 1) & 1, s + 1) }
    if (half == 0) {
      const int wr0 = 2 * s;
      NA_STEP(kfa[s & 1][kt], kfb[s & 1][kt],
              ((k0 + 16 * (kt & 1) + 4 * lq + r) >= cs && (k0 + 16 * (kt & 1) + 4 * lq + r) < cs + 16)
                  ? RPB[(rs + wr0 + (kt >> 1) - grow + 7) * 31 + (k0 + 16 * (kt & 1) + 4 * lq + r) - qc + 15] : -1e30f,
              VtW, NA_WS, (wr0 + g) * 64 + k0)
    } else {
      NA_STEP(kfa[s & 1][kt], kfb[s & 1][kt], 0.f, VtC, NA_CS, s * 64 + 32 * g)
    }
  }
  lrun += __shfl_xor(lrun, 16); lrun += __shfl_xor(lrun, 32);
  float* mg = MRG + (jt * 64 + lane) * 18;
  if (half == 1) {
    mg[0] = mrun; mg[1] = lrun;
#pragma unroll
    for (int dt = 0; dt < 4; ++dt) { mg[2 + dt * 4 + 0] = O[dt][0]; mg[2 + dt * 4 + 1] = O[dt][1]; mg[2 + dt * 4 + 2] = O[dt][2]; mg[2 + dt * 4 + 3] = O[dt][3]; }
  }
  __syncthreads();
  if (half == 0) {
    const float m2 = mg[0], l2 = mg[1];
    const float M = fmaxf(mrun, m2);
    const float f1 = __builtin_amdgcn_exp2f(mrun - M), f2 = __builtin_amdgcn_exp2f(m2 - M);
    const float inv = 1.f / (lrun * f1 + l2 * f2);
    bf16_t* dst = Y + (size_t)mq * 1024 + Y_NA + h * 64;
#pragma unroll
    for (int dt = 0; dt < 4; ++dt) {
      const float o0 = (O[dt][0] * f1 + mg[2 + dt * 4 + 0] * f2) * inv, o1 = (O[dt][1] * f1 + mg[2 + dt * 4 + 1] * f2) * inv;
      const float o2 = (O[dt][2] * f1 + mg[2 + dt * 4 + 2] * f2) * inv, o3 = (O[dt][3] * f1 + mg[2 + dt * 4 + 3] * f2) * inv;
      uint2 ov; ov.x = pack2(o0, o1); ov.y = pack2(o2, o3);
      *(uint2*)(dst + dt * 16 + 4 * lq) = ov;
    }
  }
}

__device__ __forceinline__ void na_ctx_item(const Params& p, int item, char* smem) {
  const bf16_t* P = (const bf16_t*)(p.ws + OFF_P);
  bf16_t* Y = (bf16_t*)(p.ws + OFF_ACT);
  const int b = item >> 3, h = (item >> 1) & 3, qg = item & 1;
  const int tid = opaque_tid(), lane = tid & 63, wave = tid >> 6, lr = lane & 15, lq = lane >> 4;
  bf16_t* VtC = (bf16_t*)(smem + NA_OFF_VTC);
  __syncthreads();
  {
    const int ch = tid & 7;
#pragma unroll
    for (int i = 0; i < 4; ++i) {
      const int key = (tid >> 3) + 64 * i;
      const uint4 uv = *(const uint4*)(P + (size_t)(NLAT + b * 256 + key) * INC + C_NAV + h * 64 + ch * 8);
      vt_store8(VtC, NA_CS, ch * 8, key, uv);
    }
  }
  const int mq = NLAT + b * 256 + qg * 128 + wave * 16 + lr;
  bf16x8 qf[2];
  {
    const bf16_t* qr = P + (size_t)mq * INC + C_NAQ + h * 64 + lq * 8;
    qf[0] = *(const bf16x8*)(qr);
    qf[1] = *(const bf16x8*)(qr + 32);
  }
  f32x4 O[4];
#pragma unroll
  for (int i = 0; i < 4; ++i) O[i] = (f32x4){0.f, 0.f, 0.f, 0.f};
  float mrun = -1e30f, lrun = 0.f;
  __syncthreads();
#pragma unroll 1
  for (int s = 0; s < 4; ++s) {
    NA_STEP(*(const bf16x8*)(P + (size_t)(NLAT + b * 256 + s * 64 + kt * 16 + lr) * INC + C_NAK + h * 64 + lq * 8),
            *(const bf16x8*)(P + (size_t)(NLAT + b * 256 + s * 64 + kt * 16 + lr) * INC + C_NAK + h * 64 + 32 + lq * 8), 0.f, VtC, NA_CS, s * 64 + 32 * g)
  }
  lrun += __shfl_xor(lrun, 16); lrun += __shfl_xor(lrun, 32);
  const float inv = 1.f / lrun;
  bf16_t* dst = Y + (size_t)mq * 1024 + Y_NA + h * 64;
#pragma unroll
  for (int dt = 0; dt < 4; ++dt) {
    uint2 ov; ov.x = pack2(O[dt][0] * inv, O[dt][1] * inv); ov.y = pack2(O[dt][2] * inv, O[dt][3] * inv);
    *(uint2*)(dst + dt * 16 + 4 * lq) = ov;
  }
}

constexpr int KV_S = 136;
constexpr int KV_OFF_KF = 0, KV_OFF_KB = 64 * KV_S * 2, KV_OFF_VT = 2 * 64 * KV_S * 2;
__device__ __forceinline__ void ret_kv_item(const Params& p, int layer, int h, size_t row0, int cnt, float* dstF, float* dstB, char* smem) {
  const bf16_t* P = (const bf16_t*)(p.ws + OFF_P);
  const float* misc = (const float*)(p.ws + OFF_MISC);
  const float lgF2 = misc[16 + layer * 8 + 0 * 4 + h] * 1.4426950408889634f, lgB2 = misc[16 + layer * 8 + 1 * 4 + h] * 1.4426950408889634f;
  const int tid = opaque_tid(), lane = tid & 63, wave = tid >> 6, lr = lane & 15, lq = lane >> 4;
  bf16_t* KFt = (bf16_t*)(smem + KV_OFF_KF);
  bf16_t* KBt = (bf16_t*)(smem + KV_OFF_KB);
  bf16_t* Vt = (bf16_t*)(smem + KV_OFF_VT);
  const int dir = wave >> 2, dt = wave & 3;
  f32x4 acc[8];
#pragma unroll
  for (int i = 0; i < 8; ++i) acc[i] = (f32x4){0.f, 0.f, 0.f, 0.f};
#pragma unroll 1
  for (int kc = 0; kc < (cnt >> 7); ++kc) {
    __syncthreads();
    {
      const int tok = tid >> 2, c = tid & 3;
      const int j = kc * 128 + tok;
      const float wF = __builtin_amdgcn_exp2f(lgF2 * (float)(cnt - 1 - j)), wB = __builtin_amdgcn_exp2f(lgB2 * (float)j);
      const bf16_t* rowp = P + (row0 + j) * INC;
#pragma unroll
      for (int c8 = 0; c8 < 2; ++c8) {
        const uint4 u = *(const uint4*)(rowp + C_RTK + h * 64 + c * 16 + c8 * 8);
        float kv[8];
        UNPACK8(kv, 0, u)
#pragma unroll
        for (int i = 0; i < 8; ++i) {
          KFt[(c * 16 + c8 * 8 + i) * KV_S + tok] = f2bf(kv[i] * wF);
          KBt[(c * 16 + c8 * 8 + i) * KV_S + tok] = f2bf(kv[i] * wB);
        }
      }
#pragma unroll
      for (int c8 = 0; c8 < 4; ++c8) {
        const uint4 uv = *(const uint4*)(rowp + C_RTV + h * 128 + c * 32 + c8 * 8);
        vt_store8(Vt, KV_S, c * 32 + c8 * 8, tok, uv);
      }
    }
    __syncthreads();
    const bf16_t* Kt = dir == 0 ? KFt : KBt;
    bf16x8 af[4];
#pragma unroll
    for (int ks = 0; ks < 4; ++ks) af[ks] = *(const bf16x8*)(Kt + (dt * 16 + lr) * KV_S + ks * 32 + lq * 8);
#pragma unroll
    for (int et = 0; et < 8; ++et) {
#pragma unroll
      for (int ks = 0; ks < 4; ++ks) {
        const bf16x8 bfr = *(const bf16x8*)(Vt + (et * 16 + lr) * KV_S + ks * 32 + lq * 8);
        acc[et] = __builtin_amdgcn_mfma_f32_16x16x32_bf16(af[ks], bfr, acc[et], 0, 0, 0);
      }
    }
  }
  float* dst = dir == 0 ? dstF : dstB;
#pragma unroll
  for (int et = 0; et < 8; ++et) {
#pragma unroll
    for (int r = 0; r < 4; ++r) dst[(dt * 16 + 4 * lq + r) * 128 + et * 16 + lr] = acc[et][r];
  }
}

__device__ __forceinline__ void phase_ret_scan(const Params& p, int layer) {
  const float* misc = (const float*)(p.ws + OFF_MISC);
  float* rkv = (float*)(p.ws + OFF_RKV);
  const float* rs = (const float*)(p.ws + OFF_RS);
  const int gt = opaque_bid() * 512 + opaque_tid(), gs = gridDim.x * 512;
  for (int idx = gt; idx < 64 * 2048; idx += gs) {
    const int seq = idx >> 11, e4 = (idx & 2047) * 4;
    const int dir = seq & 1, h = (seq >> 1) & 3;
    const float cdec = __expf(misc[16 + layer * 8 + dir * 4 + h] * 128.f);
    float4* base = (float4*)(rkv + (size_t)seq * 32 * 8192 + e4);
    float4 v[32];
#pragma unroll
    for (int s = 0; s < 32; ++s) v[s] = base[(size_t)s * 2048];
    float4 st = *(const float4*)(rs + (size_t)seq * 8192 + e4);
    if (dir == 0) {
#pragma unroll
      for (int s = 0; s < 32; ++s) {
        const float4 t = v[s];
        base[(size_t)s * 2048] = st;
        st.x = fmaf(cdec, st.x, t.x); st.y = fmaf(cdec, st.y, t.y); st.z = fmaf(cdec, st.z, t.z); st.w = fmaf(cdec, st.w, t.w);
      }
    } else {
#pragma unroll
      for (int s = 31; s >= 0; --s) {
        const float4 t = v[s];
        base[(size_t)s * 2048] = st;
        st.x = fmaf(cdec, st.x, t.x); st.y = fmaf(cdec, st.y, t.y); st.z = fmaf(cdec, st.z, t.z); st.w = fmaf(cdec, st.w, t.w);
      }
    }
  }
}

constexpr int RT_KS = 72, RT_VS = 136;
constexpr int RT_OFF_K = 0, RT_OFF_VT = 128 * RT_KS * 2, RT_OFF_SF = RT_OFF_VT + 128 * RT_VS * 2, RT_OFF_SB = RT_OFF_SF + 128 * RT_KS * 2;
__device__ __forceinline__ void ret_out_item(const Params& p, int layer, int h, size_t krow0, int nkc, int iq0,
                                             const float* SF, const float* SB, int clen, char* smem) {
  const bf16_t* P = (const bf16_t*)(p.ws + OFF_P);
  bf16_t* Y = (bf16_t*)(p.ws + OFF_ACT);
  const float* misc = (const float*)(p.ws + OFF_MISC);
  const float lgF2 = misc[16 + layer * 8 + 0 * 4 + h] * 1.4426950408889634f, lgB2 = misc[16 + layer * 8 + 1 * 4 + h] * 1.4426950408889634f;
  const int tid = opaque_tid(), lane = tid & 63, wave = tid >> 6, lr = lane & 15, lq = lane >> 4;
  bf16_t* Ks = (bf16_t*)(smem + RT_OFF_K);
  bf16_t* Vt = (bf16_t*)(smem + RT_OFF_VT);
  bf16_t* SFt = (bf16_t*)(smem + RT_OFF_SF);
  bf16_t* SBt = (bf16_t*)(smem + RT_OFF_SB);
  const int iq = iq0 + wave * 16 + lr;
  const size_t mq = krow0 + iq;
  bf16x8 qf[2];
  {
    const bf16_t* qr = P + mq * INC + C_RTQ + h * 64 + lq * 8;
    qf[0] = *(const bf16x8*)(qr);
    qf[1] = *(const bf16x8*)(qr + 32);
  }
  f32x4 O[8];
#pragma unroll
  for (int i = 0; i < 8; ++i) O[i] = (f32x4){0.f, 0.f, 0.f, 0.f};
  if (SF != nullptr) {
    __syncthreads();
    {
      const int d = tid >> 3, e0 = (tid & 7) * 16;
#pragma unroll
      for (int c4 = 0; c4 < 4; ++c4) {
        const float4 a = *(const float4*)(SF + d * 128 + e0 + c4 * 4);
        const float4 bb = *(const float4*)(SB + d * 128 + e0 + c4 * 4);
        SFt[(e0 + c4 * 4 + 0) * RT_KS + d] = f2bf(a.x); SFt[(e0 + c4 * 4 + 1) * RT_KS + d] = f2bf(a.y);
        SFt[(e0 + c4 * 4 + 2) * RT_KS + d] = f2bf(a.z); SFt[(e0 + c4 * 4 + 3) * RT_KS + d] = f2bf(a.w);
        SBt[(e0 + c4 * 4 + 0) * RT_KS + d] = f2bf(bb.x); SBt[(e0 + c4 * 4 + 1) * RT_KS + d] = f2bf(bb.y);
        SBt[(e0 + c4 * 4 + 2) * RT_KS + d] = f2bf(bb.z); SBt[(e0 + c4 * 4 + 3) * RT_KS + d] = f2bf(bb.w);
      }
    }
    __syncthreads();
    const float cF = __builtin_amdgcn_exp2f(lgF2 * (float)(iq + 1)), cB = __builtin_amdgcn_exp2f(lgB2 * (float)(clen - iq));
#pragma unroll
    for (int ks = 0; ks < 2; ++ks)
#pragma unroll
      for (int et = 0; et < 8; ++et) {
        const bf16x8 sf = *(const bf16x8*)(SFt + (et * 16 + lr) * RT_KS + ks * 32 + lq * 8);
        O[et] = __builtin_amdgcn_mfma_f32_16x16x32_bf16(sf, qf[ks], O[et], 0, 0, 0);
      }
    const float ratio = cF / cB;
#pragma unroll
    for (int et = 0; et < 8; ++et) { O[et][0] *= ratio; O[et][1] *= ratio; O[et][2] *= ratio; O[et][3] *= ratio; }
#pragma unroll
    for (int ks = 0; ks < 2; ++ks)
#pragma unroll
      for (int et = 0; et < 8; ++et) {
        const bf16x8 sb = *(const bf16x8*)(SBt + (et * 16 + lr) * RT_KS + ks * 32 + lq * 8);
        O[et] = __builtin_amdgcn_mfma_f32_16x16x32_bf16(sb, qf[ks], O[et], 0, 0, 0);
      }
#pragma unroll
    for (int et = 0; et < 8; ++et) { O[et][0] *= cB; O[et][1] *= cB; O[et][2] *= cB; O[et][3] *= cB; }
  }
#pragma unroll 1
  for (int kc = 0; kc < nkc; ++kc) {
    __syncthreads();
    {
      const int key = tid >> 2, c = tid & 3;
      const bf16_t* rowp = P + (krow0 + kc * 128 + key) * INC;
      const uint4 k0 = *(const uint4*)(rowp + C_RTK + h * 64 + c * 16), k1 = *(const uint4*)(rowp + C_RTK + h * 64 + c * 16 + 8);
      *(uint4*)(Ks + key * RT_KS + c * 16) = k0;
      *(uint4*)(Ks + key * RT_KS + c * 16 + 8) = k1;
#pragma unroll
      for (int c8 = 0; c8 < 4; ++c8) {
        const uint4 uv = *(const uint4*)(rowp + C_RTV + h * 128 + c * 32 + c8 * 8);
        vt_store8(Vt, RT_VS, c * 32 + c8 * 8, key, uv);
      }
    }
    __syncthreads();
    f32x4 S[8];
#pragma unroll
    for (int kt = 0; kt < 8; ++kt) {
      const bf16x8 ka = *(const bf16x8*)(Ks + (kt * 16 + lr) * RT_KS + lq * 8);
      const bf16x8 kb = *(const bf16x8*)(Ks + (kt * 16 + lr) * RT_KS + 32 + lq * 8);
      const f32x4 a = __builtin_amdgcn_mfma_f32_16x16x32_bf16(ka, qf[0], (f32x4){0.f, 0.f, 0.f, 0.f}, 0, 0, 0);
      S[kt] = __builtin_amdgcn_mfma_f32_16x16x32_bf16(kb, qf[1], a, 0, 0, 0);
    }
#pragma unroll
    for (int kt = 0; kt < 8; ++kt) {
#pragma unroll
      for (int r = 0; r < 4; ++r) {
        const int df = iq - (kc * 128 + kt * 16 + 4 * lq + r);
        const float fdf = (float)df;
        float coef = 0.f;
        if (df >= 0) coef += __builtin_amdgcn_exp2f(lgF2 * fdf);
        if (df <= 0) coef += __builtin_amdgcn_exp2f(-lgB2 * fdf);
        S[kt][r] *= coef;
      }
    }
#pragma unroll
    for (int g = 0; g < 4; ++g) {
      union { unsigned u[4]; bf16x8 v; } pf;
      pf.u[0] = cvt_pk_bf16(S[2 * g][0], S[2 * g][1]); pf.u[1] = cvt_pk_bf16(S[2 * g][2], S[2 * g][3]);
      pf.u[2] = cvt_pk_bf16(S[2 * g + 1][0], S[2 * g + 1][1]); pf.u[3] = cvt_pk_bf16(S[2 * g + 1][2], S[2 * g + 1][3]);
#pragma unroll
      for (int et = 0; et < 8; ++et) {
        union { uint2 h2[2]; bf16x8 v; } vf;
        vf.h2[0] = *(const uint2*)(Vt + (et * 16 + lr) * RT_VS + 32 * g + 4 * lq);
        vf.h2[1] = *(const uint2*)(Vt + (et * 16 + lr) * RT_VS + 32 * g + 16 + 4 * lq);
        O[et] = __builtin_amdgcn_mfma_f32_16x16x32_bf16(vf.v, pf.v, O[et], 0, 0, 0);
      }
    }
  }
  float ss = 0.f;
#pragma unroll
  for (int et = 0; et < 8; ++et) { ss = fmaf(O[et][0], O[et][0], ss); ss = fmaf(O[et][1], O[et][1], ss); ss = fmaf(O[et][2], O[et][2], ss); ss = fmaf(O[et][3], O[et][3], ss); }
  ss += __shfl_xor(ss, 16); ss += __shfl_xor(ss, 32);
  const float rr = rsqrtf(ss * (1.f / 128.f) + EPS);
  const bf16_t* gp = P + mq * INC + C_RTG + h * 128;
  bf16_t* dst = Y + mq * 1024 + Y_RT + h * 128;
#pragma unroll
  for (int et = 0; et < 8; ++et) {
    const int e = et * 16 + 4 * lq;
    const uint2 gu = *(const uint2*)(gp + e);
    uint2 ov;
    ov.x = pack2(O[et][0] * rr * siluf(lo16(gu.x)), O[et][1] * rr * siluf(hi16(gu.x)));
    ov.y = pack2(O[et][2] * rr * siluf(lo16(gu.y)), O[et][3] * rr * siluf(hi16(gu.y)));
    *(uint2*)(dst + e) = ov;
  }
}

__device__ __forceinline__ void uv_convert_item(const Params& p, int item) {
  char* ws = p.ws;
  const int tid = opaque_tid();
  const int lane = tid & 63, l = lane & 31, half = lane >> 5, wave = tid >> 6;
#pragma unroll 1
  for (int it = 0; it < 16; ++it) {
    const int row = item * 256 + (wave * 16 + it) * 2 + half;
    const bool isv = row >= 2 * NEXP;
    const int rr = isv ? row - 2 * NEXP : row;
    const float* srow = (isv ? p.peer_v : p.peer_u) + (size_t)rr * 1024;
    float4 v[8];
    float mx = 0.f;
#pragma unroll
    for (int j = 0; j < 8; ++j) {
      v[j] = ((const float4*)srow)[l + 32 * j];
      mx = fmaxf(mx, fmaxf(fmaxf(fabsf(v[j].x), fabsf(v[j].y)), fmaxf(fabsf(v[j].z), fabsf(v[j].w))));
    }
#pragma unroll
    for (int o = 1; o < 32; o <<= 1) mx = fmaxf(mx, __shfl_xor(mx, o));
    const float scale = mx > 0.f ? mx * (1.f / 7.5f) : 1.f;
    const float inv = 1.f / scale;
    if (!isv) {
      unsigned w[6] = {0u, 0u, 0u, 0u, 0u, 0u};
#pragma unroll
      for (int k = 0; k < 32; ++k) {
        const float xv = (k & 3) == 0 ? v[k >> 2].x : (k & 3) == 1 ? v[k >> 2].y : (k & 3) == 2 ? v[k >> 2].z : v[k >> 2].w;
        const float a = fminf(fabsf(xv) * inv, 7.5f);
        float c;
        if (a < 2.f) c = rintf(a * 8.f);
        else if (a < 4.f) c = 16.f + rintf((a - 2.f) * 4.f);
        else c = 24.f + rintf((a - 4.f) * 2.f);
        unsigned code = (unsigned)c;
        code = code > 31u ? 31u : code;
        code |= (xv < 0.f) ? 32u : 0u;
        const int bit = 6 * k, wd = bit >> 5, sh = bit & 31;
        w[wd] |= code << sh;
        if (sh > 26) w[wd + 1] |= code >> (32 - sh);
      }
      char* drow = ws + OFF_U + (size_t)rr * RECB + l * 24;
      *(uint2*)(drow) = make_uint2(w[0], w[1]);
      *(uint2*)(drow + 8) = make_uint2(w[2], w[3]);
      *(uint2*)(drow + 16) = make_uint2(w[4], w[5]);
      if (l == 0) ((float*)(ws + OFF_USC))[rr] = scale;
    } else {
      const float scale4 = mx > 0.f ? mx * (1.f / 6.f) : 1.f;
      const float inv4 = 1.f / scale4;
      unsigned w[4] = {0u, 0u, 0u, 0u};
#pragma unroll
      for (int k = 0; k < 32; ++k) {
        const float xv = (k & 3) == 0 ? v[k >> 2].x : (k & 3) == 1 ? v[k >> 2].y : (k & 3) == 2 ? v[k >> 2].z : v[k >> 2].w;
        const float a = fminf(fabsf(xv) * inv4, 6.f);
        float c;
        if (a < 2.f) c = rintf(a * 2.f);
        else if (a < 4.f) c = 4.f + rintf(a - 2.f);
        else c = 6.f + rintf((a - 4.f) * 0.5f);
        unsigned code = (unsigned)c;
        code = code > 7u ? 7u : code;
        code |= (xv < 0.f) ? 8u : 0u;
        w[k >> 3] |= code << (4 * (k & 7));
      }
      char* drow = ws + OFF_U + (size_t)rr * RECB + ROWB + l * 16;
      *(uint4*)(drow) = make_uint4(w[0], w[1], w[2], w[3]);
      if (l == 0) ((float*)(ws + OFF_VSC))[rr] = scale4;
    }
  }
}

__device__ __forceinline__ void phase_mix1(const Params& p, int layer, char* smem, int slot = 0) {
  unsigned* ctr = (unsigned*)(p.ws + OFF_CTL) + (layer * 4 + slot);
  const bool nc = layer == 0;
  const int n_dl = 512, n_dc = nc ? 32 : 0, n_nl = 2048, n_ncx = nc ? 64 : 0, n_kv = 1024, n_cs = 32;
  const int total = n_dl + n_dc + n_nl + n_ncx + n_kv + n_cs;
  float* rkv = (float*)(p.ws + OFF_RKV);
  float* rs = (float*)(p.ws + OFF_RS);
  for (;;) {
    int it = next_item(ctr, smem);
    if (it >= total) break;
    if (it < n_dl) { diff_item(p, layer, false, it, smem); continue; } it -= n_dl;
    if (it < n_dc) { diff_item(p, layer, true, it, smem); continue; } it -= n_dc;
    if (it < n_nl) { na_latent_item(p, layer, it, smem); continue; } it -= n_nl;
    if (it < n_ncx) { na_ctx_item(p, it, smem); continue; } it -= n_ncx;
    if (it < n_kv) {
      const int bh = it >> 5, n = it & 31, b = bh >> 2, h = bh & 3;
      ret_kv_item(p, layer, h, (size_t)b * 4096 + n * 128, 128,
                  rkv + ((size_t)(bh * 2 + 0) * 32 + n) * 8192, rkv + ((size_t)(bh * 2 + 1) * 32 + n) * 8192, smem);
      continue;
    }
    it -= n_kv;
    {
      const int bh = it, b = bh >> 2, h = bh & 3;
      ret_kv_item(p, layer, h, (size_t)NLAT + b * 256, 256, rs + (size_t)(bh * 2 + 0) * 8192, rs + (size_t)(bh * 2 + 1) * 8192, smem);
    }
  }
}

__device__ __forceinline__ void phase_mix2(const Params& p, int layer, char* smem, int slot = 1) {
  unsigned* ctr = (unsigned*)(p.ws + OFF_CTL) + (layer * 4 + slot);
  const int n_l = 1024, n_c = layer == 0 ? 64 : 0;
  const float* rkv = (const float*)(p.ws + OFF_RKV);
  for (;;) {
    int it = next_item(ctr, smem);
    if (it >= n_l + n_c) break;
    if (it < n_l) {
      const int bh = it >> 5, n = it & 31, b = bh >> 2, h = bh & 3;
      ret_out_item(p, layer, h, (size_t)b * 4096 + n * 128, 1, 0,
                   rkv + ((size_t)(bh * 2 + 0) * 32 + n) * 8192, rkv + ((size_t)(bh * 2 + 1) * 32 + n) * 8192, 128, smem);
    } else {
      it -= n_l;
      const int bh = it >> 1, half = it & 1, b = bh >> 2, h = bh & 3;
      ret_out_item(p, layer, h, (size_t)NLAT + b * 256, 2, half * 128, nullptr, nullptr, 256, smem);
    }
  }
}

typedef float f32x2 __attribute__((ext_vector_type(2)));
__device__ __forceinline__ unsigned sortable_key(float f, int idx) {
  const unsigned b = __float_as_uint(f);
  const unsigned k = b ^ ((unsigned)((int)b >> 31) | 0x80000000u);
  return (k & ~127u) | (unsigned)(127 - idx);
}
__device__ __forceinline__ float key_value(unsigned k) {
  k &= ~127u;
  const unsigned b = (k & 0x80000000u) ? (k ^ 0x80000000u) : ~k;
  return __uint_as_float(b);
}
#define FP8DOT(acc, H, off, W) { const f32x2 _a = __builtin_amdgcn_cvt_pk_f32_fp8((int)(W), false), _b = __builtin_amdgcn_cvt_pk_f32_fp8((int)(W), true); \
  acc = fmaf(H[(off) + 0], _a.x, acc); acc = fmaf(H[(off) + 1], _a.y, acc); acc = fmaf(H[(off) + 2], _b.x, acc); acc = fmaf(H[(off) + 3], _b.y, acc); }
#define FP8AXPY(O, off, P, W) { const f32x2 _a = __builtin_amdgcn_cvt_pk_f32_fp8((int)(W), false), _b = __builtin_amdgcn_cvt_pk_f32_fp8((int)(W), true); \
  O[(off) + 0] = fmaf(P, _a.x, O[(off) + 0]); O[(off) + 1] = fmaf(P, _a.y, O[(off) + 1]); O[(off) + 2] = fmaf(P, _b.x, O[(off) + 2]); O[(off) + 3] = fmaf(P, _b.y, O[(off) + 3]); }

__device__ __forceinline__ float gelu_erf(float a) {
  const float x = fabsf(a) * 0.70710678118654752f;
  const float t = __builtin_amdgcn_rcpf(fmaf(0.3275911f, x, 1.f));
  float pl = fmaf(1.061405429f, t, -1.453152027f);
  pl = fmaf(pl, t, 1.421413741f); pl = fmaf(pl, t, -0.284496736f); pl = fmaf(pl, t, 0.254829592f);
  const float y = 1.f - pl * t * __builtin_amdgcn_exp2f(-x * x * 1.4426950408889634f);
  const float er = a < 0.f ? -y : y;
  return 0.5f * a * (1.f + er);
}
constexpr int PE_SVS = 132;
constexpr int PE_OFF_SV = 0;
constexpr int PE_OFF_TV = 8 * 16 * PE_SVS * 4;
constexpr int PE_OFF_TI = PE_OFF_TV + 16 * 16 * 16 * 4;
constexpr int PE_OFF_EX = PE_OFF_TI + 16 * 16 * 16 * 4;
constexpr int PE_OFF_GT = PE_OFF_EX + 2 * 16 * 128 * 4;
constexpr int PE_OFF_SU = PE_OFF_GT + 2 * 16 * 128 * 4;
constexpr int PE_OFF_CN = PE_OFF_SU + 2 * 16 * 128 * 4;
constexpr int PE_OFF_CT = PE_OFF_CN + 8 * 16 * 4;
constexpr int PE_OFF_TQ = PE_OFF_CT + 64 * 4;
static_assert(PE_OFF_TQ + 16 <= LDS_BCAST, "PEER LDS map overflows");
#define WAVE_LDS_FENCE() asm volatile("s_waitcnt lgkmcnt(0)" ::: "memory")

__device__ __forceinline__ void peer_select_head(const Params& p, int layer, char* smem, int tok0, int hd, int sw, int buf,
                                                 int lane) {
  const bf16_t* Q = (const bf16_t*)(p.ws + OFF_P);
  const bf16_t* SK = (const bf16_t*)(p.ws + OFF_SUBK) + (size_t)layer * 262144;
  const int lr = lane & 15, lq = lane >> 4;
  unsigned* SV = (unsigned*)(smem + PE_OFF_SV) + sw * 16 * PE_SVS;
  float* TV = (float*)(smem + PE_OFF_TV);
  int* TI = (int*)(smem + PE_OFF_TI);
  int* EX = (int*)(smem + PE_OFF_EX) + buf * 16 * 128;
  float* GT = (float*)(smem + PE_OFF_GT) + buf * 16 * 128;
  int* CN = (int*)(smem + PE_OFF_CN) + sw * 16;
  float* SU = (float*)(smem + PE_OFF_SU) + buf * 16 * 128;
  const float* USC = (const float*)(p.ws + OFF_USC) + layer * NEXP;
  const float* VSC = (const float*)(p.ws + OFF_VSC) + layer * NEXP;
#pragma unroll 1
  for (int pp = 0; pp < 2; ++pp) {
    bf16x8 af[4];
    const bf16_t* qrow = Q + (size_t)(tok0 + lr) * 2048 + hd * 256 + pp * 128;
#pragma unroll
    for (int ks = 0; ks < 4; ++ks) af[ks] = *(const bf16x8*)(qrow + ks * 32 + lq * 8);
    const bf16_t* skb = SK + (size_t)((hd * 2 + pp) * 128) * 128;
    f32x4 acc[8];
    {
      bf16x8 bfr[8][4];
#pragma unroll
      for (int nt = 0; nt < 8; ++nt)
#pragma unroll
        for (int ks = 0; ks < 4; ++ks)
          bfr[nt][ks] = *(const bf16x8*)(skb + (size_t)(nt * 16 + lr) * 128 + ks * 32 + lq * 8);
#pragma unroll
      for (int nt = 0; nt < 8; ++nt) {
        f32x4 a = (f32x4){0.f, 0.f, 0.f, 0.f};
#pragma unroll
        for (int ks = 0; ks < 4; ++ks) a = __builtin_amdgcn_mfma_f32_16x16x32_bf16(af[ks], bfr[nt][ks], a, 0, 0, 0);
        acc[nt] = a;
      }
    }
#pragma unroll
    for (int i = 0; i < 9; ++i) { const int q4 = lane + 64 * i; if (q4 < 16 * PE_SVS / 4) ((uint4*)SV)[q4] = make_uint4(0u, 0u, 0u, 0u); }
    WAVE_LDS_FENCE();
#pragma unroll
    for (int r = 0; r < 4; ++r) {
      const int tk = 4 * lq + r;
      unsigned k[8];
#pragma unroll
      for (int nt = 0; nt < 8; ++nt) k[nt] = sortable_key(acc[nt][r], nt * 16 + lr);
      unsigned m1 = max(k[0], k[1]), m2 = min(k[0], k[1]);
#pragma unroll
      for (int nt = 2; nt < 8; ++nt) { m2 = max(m2, min(m1, k[nt])); m1 = max(m1, k[nt]); }
      const unsigned Ta = row16_min_u32(m1);
      const unsigned Tb = min(row16_kth_largest<11>(m1), row16_kth_largest<5>(m2));
      const unsigned T = max(Ta, Tb);
      int pos = 0;
#pragma unroll
      for (int nt = 0; nt < 8; ++nt) {
        const bool sel = k[nt] >= T;
        const unsigned long long bal = __ballot(sel);
        const unsigned grp16 = (unsigned)(bal >> (16 * lq)) & 0xffffu;
        const int below = __popc(grp16 & ((1u << lr) - 1u));
        if (sel) SV[tk * PE_SVS + pos + below] = k[nt];
        pos += __popc(grp16);
      }
      if (lr == 0) CN[tk] = pos;
    }
    WAVE_LDS_FENCE();
#pragma unroll 1
    for (int pass = 0; pass < 4; ++pass) {
      const int tk = pass * 4 + lq;
      const int cnt = CN[tk];
      const unsigned* row = SV + tk * PE_SVS;
      int cm = cnt;
      cm = max(cm, __shfl_xor(cm, 16)); cm = max(cm, __shfl_xor(cm, 32));
      const int cmax = __builtin_amdgcn_readfirstlane(cm);
      const int nblk = (cmax + 15) >> 4;
#pragma unroll 1
      for (int rd = 0; rd < nblk; ++rd) {
        const int j = rd * 16 + lr;
        const unsigned my = row[j];
        int rank = 0;
#pragma unroll 1
        for (int b4 = 0; b4 < nblk; ++b4) {
          const uint4 v0 = *(const uint4*)(row + b4 * 16), v1 = *(const uint4*)(row + b4 * 16 + 4);
          const uint4 v2 = *(const uint4*)(row + b4 * 16 + 8), v3 = *(const uint4*)(row + b4 * 16 + 12);
          rank += (v0.x > my) ? 1 : 0; rank += (v0.y > my) ? 1 : 0; rank += (v0.z > my) ? 1 : 0; rank += (v0.w > my) ? 1 : 0;
          rank += (v1.x > my) ? 1 : 0; rank += (v1.y > my) ? 1 : 0; rank += (v1.z > my) ? 1 : 0; rank += (v1.w > my) ? 1 : 0;
          rank += (v2.x > my) ? 1 : 0; rank += (v2.y > my) ? 1 : 0; rank += (v2.z > my) ? 1 : 0; rank += (v2.w > my) ? 1 : 0;
          rank += (v3.x > my) ? 1 : 0; rank += (v3.y > my) ? 1 : 0; rank += (v3.z > my) ? 1 : 0; rank += (v3.w > my) ? 1 : 0;
        }
        if (j < cnt && rank < 16) {
          TV[(tk * 16 + hd * 2 + pp) * 16 + rank] = key_value(my);
          TI[(tk * 16 + hd * 2 + pp) * 16 + rank] = 127 - (int)(my & 127u);
        }
      }
    }
    WAVE_LDS_FENCE();
  }
  {
    const int cab = ((const int*)(smem + PE_OFF_CT))[lane];
    const int cand_a = cab >> 4, cand_b = cab & 15;
    unsigned* CWt = SV;
    float vals[16];
#pragma unroll
    for (int tk = 0; tk < 16; ++tk) {
      float val = 0.f;
      unsigned key = 0u;
      if (cand_a >= 0) {
        val = TV[(tk * 16 + hd * 2 + 0) * 16 + cand_a] + TV[(tk * 16 + hd * 2 + 1) * 16 + cand_b];
        const unsigned bb = __float_as_uint(val);
        key = ((bb ^ ((unsigned)((int)bb >> 31) | 0x80000000u)) & ~63u) | (unsigned)(63 - lane);
      }
      vals[tk] = val;
      CWt[tk * 64 + lane] = key;
    }
    WAVE_LDS_FENCE();
#pragma unroll
    for (int tk = 0; tk < 16; ++tk) {
      const unsigned key = CWt[tk * 64 + lane];
      int rank = 0;
#pragma unroll
      for (int i4 = 0; i4 < 13; ++i4) {
        const uint4 v = *(const uint4*)(CWt + tk * 64 + i4 * 4);
        rank += (v.x > key) ? 1 : 0; rank += (v.y > key) ? 1 : 0; rank += (v.z > key) ? 1 : 0; rank += (v.w > key) ? 1 : 0;
      }
      if (cand_a >= 0 && rank < 16) {
        GT[tk * 128 + hd * 16 + rank] = vals[tk];
        EX[tk * 128 + hd * 16 + rank] = TI[(tk * 16 + hd * 2 + 0) * 16 + cand_a] * 128 + TI[(tk * 16 + hd * 2 + 1) * 16 + cand_b];
      }
    }
    WAVE_LDS_FENCE();
#pragma unroll
    for (int pass = 0; pass < 4; ++pass) {
      const int tk = pass * 4 + lq;
      const float g = GT[tk * 128 + hd * 16 + lr];
      const float mx = GT[tk * 128 + hd * 16];
      const float ev = __expf(g - mx);
      float s = ev;
      s += __shfl_xor(s, 1); s += __shfl_xor(s, 2); s += __shfl_xor(s, 4); s += __shfl_xor(s, 8);
      const int ex = EX[tk * 128 + hd * 16 + lr];
      GT[tk * 128 + hd * 16 + lr] = (ev / s) * VSC[ex];
      SU[tk * 128 + hd * 16 + lr] = USC[ex];
    }
    WAVE_LDS_FENCE();
  }
}

typedef float f32x32 __attribute__((ext_vector_type(32)));
typedef unsigned u32x6 __attribute__((ext_vector_type(6)));
#define FP4_AXPY8(O, off, P, W) {                                                                    \
  const f32x2 _q0 = __builtin_amdgcn_cvt_scalef32_pk_f32_fp4((W), 1.0f, 0), _q1 = __builtin_amdgcn_cvt_scalef32_pk_f32_fp4((W), 1.0f, 1); \
  const f32x2 _q2 = __builtin_amdgcn_cvt_scalef32_pk_f32_fp4((W), 1.0f, 2), _q3 = __builtin_amdgcn_cvt_scalef32_pk_f32_fp4((W), 1.0f, 3); \
  O[(off) + 0] = fmaf(P, _q0.x, O[(off) + 0]); O[(off) + 1] = fmaf(P, _q0.y, O[(off) + 1]);          \
  O[(off) + 2] = fmaf(P, _q1.x, O[(off) + 2]); O[(off) + 3] = fmaf(P, _q1.y, O[(off) + 3]);          \
  O[(off) + 4] = fmaf(P, _q2.x, O[(off) + 4]); O[(off) + 5] = fmaf(P, _q2.y, O[(off) + 5]);          \
  O[(off) + 6] = fmaf(P, _q3.x, O[(off) + 6]); O[(off) + 7] = fmaf(P, _q3.y, O[(off) + 7]); }
struct Fp6Row { uint4 a; uint2 b; };
typedef __bf16 bf16x32_t __attribute__((ext_vector_type(32)));
__device__ __forceinline__ bf16x32_t fp6_decode_bf16(const Fp6Row& r) {
  u32x6 w; w[0] = r.a.x; w[1] = r.a.y; w[2] = r.a.z; w[3] = r.a.w; w[4] = r.b.x; w[5] = r.b.y;
  return __builtin_amdgcn_cvt_scalef32_pk32_bf16_fp6(w, 1.0f);
}
__device__ __forceinline__ f32x32 fp6_decode(const Fp6Row& r) {
  u32x6 w; w[0] = r.a.x; w[1] = r.a.y; w[2] = r.a.z; w[3] = r.a.w; w[4] = r.b.x; w[5] = r.b.y;
  return __builtin_amdgcn_cvt_scalef32_pk32_f32_fp6(w, 1.0f);
}
__device__ __forceinline__ void peer_gather_token(const Params& p, int layer, char* smem, int tok, int tl, int buf, int lane, bool dowrite) {
  const bf16_t* H2 = (const bf16_t*)(p.ws + OFF_ACT);
  const char* U6 = p.ws + OFF_U + (size_t)layer * NEXP * RECB;
  const float* mod = (const float*)(p.ws + OFF_MOD) + (size_t)layer * 9 * 6144;
  const int* EX = (const int*)(smem + PE_OFF_EX) + buf * 16 * 128 + tl * 128;
  const float* GT = (const float*)(smem + PE_OFF_GT) + buf * 16 * 128 + tl * 128;
  const float* SU = (const float*)(smem + PE_OFF_SU) + buf * 16 * 128 + tl * 128;
  const int l = lane & 31, hf = lane >> 5;
  float acc[32];
  bf16x2_t hvp[16];
  {
    const bf16_t* hr = H2 + (size_t)tok * 1024;
#pragma unroll
    for (int j = 0; j < 8; ++j) {
      const uint2 u = *(const uint2*)(hr + (l + 32 * j) * 4);
      hvp[2 * j] = __builtin_bit_cast(bf16x2_t, u.x); hvp[2 * j + 1] = __builtin_bit_cast(bf16x2_t, u.y);
    }
  }
#pragma unroll
  for (int i = 0; i < 32; ++i) acc[i] = 0.f;
  int one = 1;
  asm volatile("" : "+s"(one));
#define PE_LOAD(UU, VV, PI)                                                           \
  {                                                                                   \
    const int ex = EX[2 * (PI) + hf];                                                 \
    const char* up = U6 + (size_t)ex * RECB + l * 24;                                 \
    UU.a = *(const uint4*)up; UU.b = *(const uint2*)(up + 16);                        \
    VV = *(const uint4*)(U6 + (size_t)ex * RECB + ROWB + l * 16);                     \
  }
#define PE_USE(UU, VV, PI)                                                            \
  _Pragma("unroll 1") for (int rep_ = 0; rep_ < one; ++rep_) {                        \
    const bf16x32_t du = fp6_decode_bf16(UU);                                         \
    float d0 = 0.f, d1 = 0.f, d2 = 0.f, d3 = 0.f;                                     \
    _Pragma("unroll") for (int k = 0; k < 16; k += 4) {                               \
      d0 = __builtin_amdgcn_fdot2_f32_bf16((bf16x2_t){du[2 * k], du[2 * k + 1]}, hvp[k], d0, false);             \
      d1 = __builtin_amdgcn_fdot2_f32_bf16((bf16x2_t){du[2 * k + 2], du[2 * k + 3]}, hvp[k + 1], d1, false);     \
      d2 = __builtin_amdgcn_fdot2_f32_bf16((bf16x2_t){du[2 * k + 4], du[2 * k + 5]}, hvp[k + 2], d2, false);     \
      d3 = __builtin_amdgcn_fdot2_f32_bf16((bf16x2_t){du[2 * k + 6], du[2 * k + 7]}, hvp[k + 3], d3, false);     \
    }                                                                                 \
    const float r16 = row16_sum((d0 + d1) + (d2 + d3));                               \
    const int ir = __float_as_int(r16);                                               \
    const float s0 = __int_as_float(__builtin_amdgcn_readlane(ir, 0)) + __int_as_float(__builtin_amdgcn_readlane(ir, 16));  \
    const float s1 = __int_as_float(__builtin_amdgcn_readlane(ir, 32)) + __int_as_float(__builtin_amdgcn_readlane(ir, 48)); \
    const float d = (hf ? s1 : s0) * SU[2 * (PI) + hf];                               \
    const float w = GT[2 * (PI) + hf] * gelu_erf(d);                                  \
    FP4_AXPY8(acc, 0, w, VV.x) FP4_AXPY8(acc, 8, w, VV.y) FP4_AXPY8(acc, 16, w, VV.z) FP4_AXPY8(acc, 24, w, VV.w) \
  }
  Fp6Row u0, u1, u2, u3, u4;
  uint4 v0, v1, v2, v3, v4;
  PE_LOAD(u0, v0, 0) PE_LOAD(u1, v1, 1) PE_LOAD(u2, v2, 2) PE_LOAD(u3, v3, 3) PE_LOAD(u4, v4, 4)
#pragma unroll 1
  for (int pi = 0; pi < 55; pi += 5) {
    PE_USE(u0, v0, pi) PE_LOAD(u0, v0, pi + 5)
    PE_USE(u1, v1, pi + 1) PE_LOAD(u1, v1, pi + 6)
    PE_USE(u2, v2, pi + 2) PE_LOAD(u2, v2, pi + 7)
    PE_USE(u3, v3, pi + 3) PE_LOAD(u3, v3, pi + 8)
    PE_USE(u4, v4, pi + 4) PE_LOAD(u4, v4, pi + 9)
  }
  PE_USE(u0, v0, 55) PE_LOAD(u0, v0, 60)
  PE_USE(u1, v1, 56) PE_LOAD(u1, v1, 61)
  PE_USE(u2, v2, 57) PE_LOAD(u2, v2, 62)
  PE_USE(u3, v3, 58) PE_LOAD(u3, v3, 63)
  PE_USE(u4, v4, 59)
  PE_USE(u0, v0, 60) PE_USE(u1, v1, 61) PE_USE(u2, v2, 62) PE_USE(u3, v3, 63)
#pragma unroll
  for (int k = 0; k < 32; ++k) acc[k] += __shfl_xor(acc[k], 32);
  const int b = tok < NLAT ? (tok >> 12) : 8;
  float* xr = tok < NLAT ? p.out + (size_t)tok * 1024 : (float*)(p.ws + OFF_CTXB) + (size_t)(tok - NLAT) * 1024;
  const float* gate = mod + (size_t)b * 6144 + 5 * 1024;
  float4 xn[4];
  float ss = 0.f;
#pragma unroll
  for (int jj = 0; jj < 4; ++jj) {
    const int c = (l + 32 * (4 * hf + jj)) * 4;
    const float4 xv = *(const float4*)(xr + c);
    const float4 gv = *(const float4*)(gate + c);
    const float a0 = hf ? acc[16 + 4 * jj + 0] : acc[4 * jj + 0], a1 = hf ? acc[16 + 4 * jj + 1] : acc[4 * jj + 1];
    const float a2 = hf ? acc[16 + 4 * jj + 2] : acc[4 * jj + 2], a3 = hf ? acc[16 + 4 * jj + 3] : acc[4 * jj + 3];
    xn[jj].x = xv.x + gv.x * a0; xn[jj].y = xv.y + gv.y * a1; xn[jj].z = xv.z + gv.z * a2; xn[jj].w = xv.w + gv.w * a3;
    ss += xn[jj].x * xn[jj].x + xn[jj].y * xn[jj].y + xn[jj].z * xn[jj].z + xn[jj].w * xn[jj].w;
  }
  ss = wave_sum(ss);
  const float rinv = rsqrtf(ss * (1.f / 1024.f) + EPS);
  if (layer == 0) {
    const float* mod1 = (const float*)(p.ws + OFF_MOD) + (size_t)9 * 6144 + (size_t)b * 6144;
    const float* g1 = p.norm1_g + 1024;
    bf16_t* act = (bf16_t*)(p.ws + OFF_ACT) + (size_t)tok * 1024;
#pragma unroll
    for (int jj = 0; jj < 4; ++jj) {
      const int c = (l + 32 * (4 * hf + jj)) * 4;
      if (dowrite) *(float4*)(xr + c) = xn[jj]; else asm volatile("" :: "v"(xn[jj].x), "v"(xn[jj].y), "v"(xn[jj].z), "v"(xn[jj].w));
      const float4 gg4 = *(const float4*)(g1 + c);
      const float4 sh = *(const float4*)(mod1 + c);
      const float4 sc = *(const float4*)(mod1 + 1024 + c);
      uint2 o;
      o.x = pack2h(xn[jj].x * rinv * gg4.x * (1.f + sc.x) + sh.x, xn[jj].y * rinv * gg4.y * (1.f + sc.y) + sh.y);
      o.y = pack2h(xn[jj].z * rinv * gg4.z * (1.f + sc.z) + sh.z, xn[jj].w * rinv * gg4.w * (1.f + sc.w) + sh.w);
      if (dowrite) *(uint2*)(act + c) = o; else asm volatile("" :: "v"(o.x), "v"(o.y));
    }
  } else {
#pragma unroll
    for (int jj = 0; jj < 4; ++jj) {
      const int c = (l + 32 * (4 * hf + jj)) * 4;
      const float4 gg4 = *(const float4*)(p.final_g + c);
      float4 o;
      o.x = xn[jj].x * rinv * gg4.x; o.y = xn[jj].y * rinv * gg4.y; o.z = xn[jj].z * rinv * gg4.z; o.w = xn[jj].w * rinv * gg4.w;
      if (dowrite) *(float4*)(xr + c) = o; else asm volatile("" :: "v"(o.x), "v"(o.y), "v"(o.z), "v"(o.w));
    }
  }
}

__device__ __forceinline__ void phase_peer(const Params& p, int layer, char* smem, int ntok, bool dowrite = true) {
  const int tid = opaque_tid(), lane = tid & 63, wave = __builtin_amdgcn_readfirstlane(tid >> 6);
  __syncthreads();
  if (tid < 64) {
    int cab = -1, c = 0;
    for (int a = 0; a < 16; ++a)
      for (int bb = 0; bb < 16; ++bb)
        if ((a + 1) * (bb + 1) <= 16) { if (c == tid) cab = a * 16 + bb; ++c; }
    ((int*)(smem + PE_OFF_CT))[tid] = cab;
  }
  const int ngroups = ntok / 16, G = gridDim.x, g0 = opaque_bid();
  if (tid == 0) { ((int*)(smem + PE_OFF_TQ))[0] = 0; ((int*)(smem + PE_OFF_TQ))[1] = 0; }
  __syncthreads();
  const int R = ngroups / G, rem = ngroups % G;
  const bool split = rem > 0 && 2 * rem <= G;
#define PE_ITEM(r_, grp_, off_, cnt_)                                                                  \
  { grp_ = 0; off_ = 0; cnt_ = 0;                                                                      \
    if ((r_) >= 0 && (r_) < R) { grp_ = g0 + (r_) * G; cnt_ = 16; }                                    \
    else if ((r_) == R) {                                                                              \
      if (split) { if (g0 < 2 * rem) { grp_ = R * G + (g0 >> 1); off_ = (g0 & 1) * 8; cnt_ = 8; } }    \
      else if (g0 < rem) { grp_ = R * G + g0; cnt_ = 16; }                                             \
    } }
#pragma unroll 1
  for (int r = -1;; ++r) {
    int cur, coff, ngat, nxt, noff, ncnt;
    PE_ITEM(r, cur, coff, ngat)
    PE_ITEM(r + 1, nxt, noff, ncnt)
    const int nsel = ncnt > 0 ? 8 : 0;
    if (ngat + nsel == 0) break;
    int* ctr = (int*)(smem + PE_OFF_TQ) + (r & 1);
    const int b = r & 1, m = min(ngat, nsel);
#pragma unroll 1
    for (;;) {
      int t = 0;
      if (lane == 0) t = atomicAdd(ctr, 1);
      t = __builtin_amdgcn_readfirstlane(t);
      if (t >= ngat + nsel) break;
      int kind, idx;
      if (t < 2 * m) { kind = t & 1; idx = t >> 1; }
      else { kind = nsel > m ? 0 : 1; idx = t - m; }
      if (kind == 0) peer_select_head(p, layer, smem, nxt * 16, idx, wave, b ^ 1, lane);
      else peer_gather_token(p, layer, smem, cur * 16 + coff + idx, coff + idx, b, lane, dowrite);
    }
    if (tid == 0) ((int*)(smem + PE_OFF_TQ))[(r + 1) & 1] = 0;
    __syncthreads();
  }
}

template <int layer>
__device__ __forceinline__ void layer_body(const Params& p, char* smem, const XcdBarrier& xb) {
  constexpr bool nc = layer == 0;
  const float* xin = layer == 0 ? p.x : (const float*)p.out;
  if (layer == 0) {
    phase_norm(p, layer, 0, xin, NTOK);
    xcd_barrier(xb);
  }
#if REP_GEMM
  gemm_phase2<EPI_INPROJ>(p, layer, smem, (const bf16_t*)(p.ws + OFF_ACT), (const bf16_t*)(p.ws + OFF_WIN) + (size_t)layer * 3072 * 1024, NTOK, 3072, nullptr);
  xcd_barrier(xb);
#endif
  gemm_phase2<EPI_INPROJ>(p, layer, smem, (const bf16_t*)(p.ws + OFF_ACT), (const bf16_t*)(p.ws + OFF_WIN) + (size_t)layer * 3072 * 1024, NTOK, 3072, nullptr);
  xcd_barrier(xb);
#if REP_MIX1
  phase_mix1(p, layer, smem, 2);
  xcd_barrier(xb);
#endif
  phase_mix1(p, layer, smem);
  xcd_barrier(xb);
  phase_ret_scan(p, layer);
  xcd_barrier(xb);
#if REP_MIX2
  phase_mix2(p, layer, smem, 3);
  xcd_barrier(xb);
#endif
  phase_mix2(p, layer, smem);
  xcd_barrier(xb);
  gemm_phase2<EPI_OUTPROJ>(p, layer, smem, (const bf16_t*)(p.ws + OFF_ACT), (const bf16_t*)(p.ws + OFF_WOUT) + (size_t)layer * 1024 * 1024, nc ? NTOK : NLAT, 1024, xin);
  xcd_barrier(xb);
  phase_norm(p, layer, 1, (const float*)p.out, nc ? NTOK : NLAT);
  xcd_barrier(xb);
  gemm_phase2<EPI_PLAIN>(p, layer, smem, (const bf16_t*)(p.ws + OFF_ACT), (const bf16_t*)(p.ws + OFF_WQ) + (size_t)layer * 2048 * 1024, nc ? NTOK : NLAT, 2048, nullptr);
  xcd_barrier(xb);
#if REP_PEER
  phase_peer(p, layer, smem, nc ? NTOK : NLAT, false);
  xcd_barrier(xb);
#endif
  phase_peer(p, layer, smem, nc ? NTOK : NLAT);
  if (layer == 0) xcd_barrier(xb);
}

__global__ void __launch_bounds__(512) fwd_megakernel(Params p) {
  cg::grid_group grid = cg::this_grid();
  extern __shared__ __attribute__((aligned(16))) char smem[];
  volatile LAS3 unsigned* xst = (volatile LAS3 unsigned*)(smem + LDS_BCAST + 8);
  if (threadIdx.x == 0) { xst[0] = 0u; xst[1] = 0u; }
  phase_prep(p, smem);
  for (int it = blockIdx.x; it < 256; it += gridDim.x) uv_convert_item(p, it);
  grid.sync();
  const XcdBarrier xb = xcd_barrier_post((unsigned*)(p.ws + OFF_XBAR), xst);
  layer_body<0>(p, smem, xb);
  layer_body<1>(p, smem, xb);
}

extern "C" void kernel_launch(void* const* d_in, const int* in_sizes, int n_in, void* d_out,
                              int out_size, void* d_ws, size_t ws_size, hipStream_t stream) {
  constexpr size_t kDynLds = LDS_BYTES;
  static int grid_blocks = 0;
  if (!grid_blocks) {
    int dev = 0, cus = 0, per_cu = 0;
    (void)hipGetDevice(&dev);
    (void)hipDeviceGetAttribute(&cus, hipDeviceAttributeMultiprocessorCount, dev);
    (void)hipFuncSetAttribute((const void*)fwd_megakernel, hipFuncAttributeMaxDynamicSharedMemorySize, (int)kDynLds);
    (void)hipOccupancyMaxActiveBlocksPerMultiprocessor(&per_cu, fwd_megakernel, 512, kDynLds);
    if (per_cu < 1) { fprintf(stderr, "occupancy query says %d blocks/CU\n", per_cu); per_cu = 1; }
    grid_blocks = cus;
    if (ws_size < WS_END) fprintf(stderr, "workspace too small: %zu < %zu\n", ws_size, (size_t)WS_END);
  }
  Params p{};
  p.x = (const float*)d_in[0]; p.c = (const float*)d_in[1]; p.ctx = (const float*)d_in[2]; p.c_ctx = (const float*)d_in[3];
  p.w_ada = (const float*)d_in[4]; p.b_ada = (const float*)d_in[5]; p.norm1_g = (const float*)d_in[6]; p.w_in = (const float*)d_in[7];
  p.na_rpb = (const float*)d_in[8]; p.diff_lambda = (const float*)d_in[9]; p.diff_subln_g = (const float*)d_in[10];
  p.ret_decay_logit = (const float*)d_in[11]; p.w_out = (const float*)d_in[12]; p.norm2_g = (const float*)d_in[13];
  p.peer_wq = (const float*)d_in[14]; p.peer_subkeys = (const float*)d_in[15]; p.peer_u = (const float*)d_in[16];
  p.peer_v = (const float*)d_in[17]; p.final_g = (const float*)d_in[18];
  p.out = (float*)d_out; p.ws = (char*)d_ws;
  void* args[] = {&p};
  hipError_t e = hipLaunchCooperativeKernel((void*)fwd_megakernel, dim3(grid_blocks), dim3(512), args, kDynLds, stream);
  if (e != hipSuccess) fprintf(stderr, "cooperative launch failed: %s (grid %d)\n", hipGetErrorString(e), grid_blocks);
}
```

```cpp
#include <hip/hip_runtime.h>
#include <hip/hip_cooperative_groups.h>
#include <cstdio>
#include <cstdint>
namespace cg = cooperative_groups;

typedef unsigned short bf16_t;
typedef short bf16x8 __attribute__((ext_vector_type(8)));
typedef float f32x4 __attribute__((ext_vector_type(4)));

constexpr int DM = 1024, BATCH = 8, SEQ = 4096, LCTX = 256;
constexpr int NLAT = BATCH * SEQ;
constexpr int NCTX = BATCH * LCTX;
constexpr int NTOK = NLAT + NCTX;
constexpr int INC = 3072;
constexpr int C_NAQ = 0, C_NAK = 256, C_NAV = 512, C_DFQ = 768, C_DFK = 1024, C_DFV = 1280,
              C_RTQ = 1536, C_RTK = 1792, C_RTV = 2048, C_RTG = 2560;
constexpr int Y_NA = 0, Y_DF = 256, Y_RT = 512;
constexpr int NEXP = 16384;
constexpr float EPS = 1e-6f;

constexpr size_t OFF_CTL  = 0;
constexpr size_t OFF_MISC = 4096;
constexpr size_t OFF_ROPE = 8192;
constexpr size_t OFF_MOD  = OFF_ROPE + 12288;
constexpr size_t SZ_MOD   = 2ull * 9 * 6144 * 4;
constexpr size_t OFF_WIN  = OFF_MOD + SZ_MOD;
constexpr size_t SZ_WIN   = 2ull * 3072 * 1024 * 2;
constexpr size_t OFF_WOUT = OFF_WIN + SZ_WIN;
constexpr size_t SZ_WOUT  = 2ull * 1024 * 1024 * 2;
constexpr size_t OFF_WQ   = OFF_WOUT + SZ_WOUT;
constexpr size_t SZ_WQ    = 2ull * 2048 * 1024 * 2;
constexpr size_t OFF_SUBK = OFF_WQ + SZ_WQ;
constexpr size_t SZ_SUBK  = 2ull * 262144 * 2;
constexpr size_t OFF_U    = OFF_SUBK + SZ_SUBK;
constexpr int    ROWB     = 768;
constexpr int    ROWV     = 512;
constexpr int    RECB     = ROWB + ROWV;
constexpr size_t SZ_UV    = 2ull * NEXP * ROWB;
constexpr size_t OFF_V    = OFF_U + SZ_UV;
constexpr size_t OFF_USC  = OFF_V + SZ_UV;
constexpr size_t OFF_VSC  = OFF_USC + 2ull * NEXP * 4;
constexpr size_t OFF_ACT  = OFF_VSC + 2ull * NEXP * 4;
constexpr size_t SZ_ACT   = (size_t)NTOK * 1024 * 2;
constexpr size_t OFF_P    = OFF_ACT + SZ_ACT;
constexpr size_t SZ_P     = (size_t)NTOK * 3072 * 2;
constexpr size_t OFF_CTXB = OFF_P + SZ_P;
constexpr size_t SZ_CTXB  = (size_t)NCTX * 1024 * 4;
constexpr size_t OFF_RKV  = OFF_CTXB + SZ_CTXB;
constexpr size_t SZ_RKV   = 64ull * 32 * 8192 * 4;
constexpr size_t OFF_RS   = OFF_RKV + SZ_RKV;
constexpr size_t SZ_RS    = 64ull * 8192 * 4;
constexpr size_t OFF_XBAR = OFF_RS + SZ_RS;
constexpr size_t WS_END   = OFF_XBAR + 16384;

#ifndef REP_MIX1
#define REP_MIX1 0
#endif
#ifndef REP_MIX2
#define REP_MIX2 0
#endif
#ifndef REP_PEER
#define REP_PEER 0
#endif
#ifndef REP_GEMM
#define REP_GEMM 0
#endif
constexpr int LDS_BYTES = 152 * 1024;
constexpr int LDS_BCAST = LDS_BYTES - 16;

struct Params {
  const float *x, *c, *ctx, *c_ctx, *w_ada, *b_ada, *norm1_g, *w_in, *na_rpb, *diff_lambda, *diff_subln_g,
              *ret_decay_logit, *w_out, *norm2_g, *peer_wq, *peer_subkeys, *peer_u, *peer_v, *final_g;
  float* out;
  char* ws;
};

__device__ __forceinline__ float bf2f(bf16_t v) { return __uint_as_float(((unsigned)v) << 16); }
__device__ __forceinline__ bf16_t f2bf(float f) {
  unsigned u = __float_as_uint(f);
  u += 0x7fffu + ((u >> 16) & 1u);
  return (bf16_t)(u >> 16);
}
__device__ __forceinline__ unsigned pack2(float a, float b) { return (unsigned)f2bf(a) | ((unsigned)f2bf(b) << 16); }
typedef __bf16 bf16x2_t __attribute__((ext_vector_type(2)));
typedef float f32x2_t __attribute__((ext_vector_type(2)));
__device__ __forceinline__ unsigned pack2h(float a, float b) {
  const f32x2_t v = {a, b};
  return __builtin_bit_cast(unsigned, __builtin_convertvector(v, bf16x2_t));
}
__device__ __forceinline__ float lo16(unsigned w) { return __uint_as_float(w << 16); }
__device__ __forceinline__ float hi16(unsigned w) { return __uint_as_float(w & 0xffff0000u); }
#define DPP_ADD(v, CTRL) ((v) + __int_as_float(__builtin_amdgcn_update_dpp(0, __float_as_int(v), (CTRL), 0xf, 0xf, true)))
__device__ __forceinline__ float row16_sum(float v) {
  v = DPP_ADD(v, 0xB1);
  v = DPP_ADD(v, 0x4E);
  v = DPP_ADD(v, 0x141);
  v = DPP_ADD(v, 0x140);
  return v;
}
#define DPP_MOVU(v, CTRL) ((unsigned)__builtin_amdgcn_update_dpp(0, (int)(v), (CTRL), 0xf, 0xf, true))
__device__ __forceinline__ unsigned row16_max_u32(unsigned v) {
  v = max(v, DPP_MOVU(v, 0xB1)); v = max(v, DPP_MOVU(v, 0x4E)); v = max(v, DPP_MOVU(v, 0x141)); v = max(v, DPP_MOVU(v, 0x140));
  return v;
}
__device__ __forceinline__ unsigned row16_min_u32(unsigned v) {
  v = min(v, DPP_MOVU(v, 0xB1)); v = min(v, DPP_MOVU(v, 0x4E)); v = min(v, DPP_MOVU(v, 0x141)); v = min(v, DPP_MOVU(v, 0x140));
  return v;
}
template <int KTH>
__device__ __forceinline__ unsigned row16_kth_largest(unsigned v) {
  int cnt = 0;
#define R8_STEP(N) { const unsigned o = DPP_MOVU(v, 0x120 + (N)); cnt += (o > v) ? 1 : 0; }
  R8_STEP(1) R8_STEP(2) R8_STEP(3) R8_STEP(4) R8_STEP(5) R8_STEP(6) R8_STEP(7) R8_STEP(8)
  R8_STEP(9) R8_STEP(10) R8_STEP(11) R8_STEP(12) R8_STEP(13) R8_STEP(14) R8_STEP(15)
#undef R8_STEP
  return row16_max_u32(cnt >= KTH - 1 ? v : 0u);
}
__device__ __forceinline__ float wave_sum(float v) {
  v = row16_sum(v);
  const int iv = __float_as_int(v);
  const float a = __int_as_float(__builtin_amdgcn_readlane(iv, 0)), b = __int_as_float(__builtin_amdgcn_readlane(iv, 16));
  const float c = __int_as_float(__builtin_amdgcn_readlane(iv, 32)), d = __int_as_float(__builtin_amdgcn_readlane(iv, 48));
  return (a + b) + (c + d);
}
__device__ __forceinline__ float siluf(float x) { return x / (1.f + __expf(-x)); }

__device__ __forceinline__ int opaque_tid() { int t = threadIdx.x; asm volatile("" : "+v"(t)); return t; }
__device__ __forceinline__ int opaque_bid() { int t = blockIdx.x; asm volatile("" : "+s"(t)); return t; }

#define DOT8(acc, Q, off, U)                                                              \
  acc = fmaf(Q[(off) + 0], lo16((U).x), acc); acc = fmaf(Q[(off) + 1], hi16((U).x), acc); \
  acc = fmaf(Q[(off) + 2], lo16((U).y), acc); acc = fmaf(Q[(off) + 3], hi16((U).y), acc); \
  acc = fmaf(Q[(off) + 4], lo16((U).z), acc); acc = fmaf(Q[(off) + 5], hi16((U).z), acc); \
  acc = fmaf(Q[(off) + 6], lo16((U).w), acc); acc = fmaf(Q[(off) + 7], hi16((U).w), acc);
#define AXPY8(O, off, P, U)                                                                   \
  O[(off) + 0] = fmaf(P, lo16((U).x), O[(off) + 0]); O[(off) + 1] = fmaf(P, hi16((U).x), O[(off) + 1]); \
  O[(off) + 2] = fmaf(P, lo16((U).y), O[(off) + 2]); O[(off) + 3] = fmaf(P, hi16((U).y), O[(off) + 3]); \
  O[(off) + 4] = fmaf(P, lo16((U).z), O[(off) + 4]); O[(off) + 5] = fmaf(P, hi16((U).z), O[(off) + 5]); \
  O[(off) + 6] = fmaf(P, lo16((U).w), O[(off) + 6]); O[(off) + 7] = fmaf(P, hi16((U).w), O[(off) + 7]);
#define UNPACK8(Q, off, U)                                                  \
  Q[(off) + 0] = lo16((U).x); Q[(off) + 1] = hi16((U).x); Q[(off) + 2] = lo16((U).y); Q[(off) + 3] = hi16((U).y); \
  Q[(off) + 4] = lo16((U).z); Q[(off) + 5] = hi16((U).z); Q[(off) + 6] = lo16((U).w); Q[(off) + 7] = hi16((U).w);

__device__ __forceinline__ int next_item(unsigned* counter, char* smem) {
  volatile int* bc = (volatile int*)(smem + LDS_BCAST);
  __syncthreads();
  if (threadIdx.x == 0) *bc = (int)atomicAdd(counter, 1u);
  __syncthreads();
  return *bc;
}

#define XB_TMO      128
#define XB_XCNT(j)  (256  + 64 * (j))
#define XB_XSUB(j)  (1280 + 64 * (j))
#define XB_XGEN(j)  (2304 + 64 * (j))
#define XB_TOP      3328
#define XB_TOPGEN   3392
#define XCD_BAR_WORDS 3456
#define XB_SPIN_CAP (1u << 18)
#define LAS3 __attribute__((address_space(3)))
__device__ __forceinline__ unsigned xb_ld(unsigned* p)              { return __hip_atomic_load(p, __ATOMIC_RELAXED, __HIP_MEMORY_SCOPE_AGENT); }
__device__ __forceinline__ unsigned xb_add(unsigned* p, unsigned v) { return __hip_atomic_fetch_add(p, v, __ATOMIC_RELAXED, __HIP_MEMORY_SCOPE_AGENT); }
__device__ __forceinline__ unsigned xb_xcc_id() { return (unsigned)__builtin_amdgcn_s_getreg((3 << 11) | 20) & 0xFu; }
#define XB_SPIN(cond, bar) do { unsigned _sp = 0; while (cond) { __builtin_amdgcn_s_sleep(1); \
    if ((++_sp & 255u) == 0u) { if (xb_ld(&(bar)[XB_TMO])) break; if (_sp > XB_SPIN_CAP) { atomicAdd(&(bar)[XB_TMO], 1u); break; } } } } while (0)
struct XcdBarrier { unsigned* bar; unsigned x; volatile LAS3 unsigned* st; };
__device__ __forceinline__ XcdBarrier xcd_barrier_post(unsigned* bar, volatile LAS3 unsigned* st) {
  XcdBarrier b; b.bar = bar; b.x = xb_xcc_id(); b.st = st;
  if (threadIdx.x == 0) (void)xb_add(&bar[XB_XCNT(b.x)], 1u);
  return b;
}
__device__ __forceinline__ void xcd_barrier_complete(unsigned* bar, unsigned x, unsigned& nloc, unsigned& nx) {
  const unsigned G = gridDim.x * gridDim.y * gridDim.z;
  unsigned sum, cnt, mine, sp = 0u;
  for (;;) {
    sum = 0u; cnt = 0u; mine = 0u;
#pragma unroll
    for (unsigned j = 0; j < 16; ++j) { const unsigned c = xb_ld(&bar[XB_XCNT(j)]); sum += c; cnt += (c > 0u) ? 1u : 0u; mine = (j == x) ? c : mine; }
    if (sum == G) break;
    __builtin_amdgcn_s_sleep(1);
    if ((++sp & 255u) == 0u) { if (xb_ld(&bar[XB_TMO])) break; if (sp > XB_SPIN_CAP) { atomicAdd(&bar[XB_TMO], 1u); break; } }
  }
  nloc = mine > 0u ? mine : 1u; nx = cnt > 0u ? cnt : 1u;
}
__device__ __forceinline__ void xcd_barrier(const XcdBarrier& b) {
  asm volatile("s_waitcnt vmcnt(0)" ::: "memory");
  __syncthreads();
  if (threadIdx.x == 0) {
    unsigned* bar = b.bar;
    __builtin_amdgcn_s_waitcnt(0);
    unsigned nloc = b.st[0], nx = b.st[1];
    if (nloc == 0u) { xcd_barrier_complete(bar, b.x, nloc, nx); b.st[0] = nloc; b.st[1] = nx; }
    const unsigned old = xb_add(&bar[XB_XSUB(b.x)], 1u);
    const unsigned gen = old / nloc;
    if (old + 1u == (gen + 1u) * nloc) {
      __builtin_amdgcn_fence(__ATOMIC_RELEASE, "agent");
      asm volatile("s_waitcnt vmcnt(0)" ::: "memory");
      const unsigned og = xb_add(&bar[XB_TOP], 1u);
      const unsigned tg = og / nx;
      if (og + 1u == (tg + 1u) * nx) xb_add(&bar[XB_TOPGEN], 1u);
      else XB_SPIN(xb_ld(&bar[XB_TOPGEN]) == tg, bar);
      __builtin_amdgcn_fence(__ATOMIC_ACQUIRE, "agent");
      xb_add(&bar[XB_XGEN(b.x)], 1u);
      asm volatile("s_waitcnt vmcnt(0)" ::: "memory");
    } else {
      XB_SPIN(xb_ld(&bar[XB_XGEN(b.x)]) == gen, bar);
      __builtin_amdgcn_fence(__ATOMIC_ACQUIRE, "agent");
      asm volatile("s_waitcnt vmcnt(0)" ::: "memory");
    }
  }
  __syncthreads();
}

__device__ __forceinline__ void transpose_item(const float* src, bf16_t* dst, int K, int N, int item, char* smem) {
  float* t = (float*)smem;
  const int nb = N / 64;
  const int k0 = (item / nb) * 64, n0 = (item % nb) * 64;
  const int tid = opaque_tid();
  __syncthreads();
#pragma unroll
  for (int i = 0; i < 8; ++i) {
    const int k = (tid >> 6) + 8 * i, n = tid & 63;
    t[k * 65 + n] = src[(size_t)(k0 + k) * N + n0 + n];
  }
  __syncthreads();
#pragma unroll
  for (int i = 0; i < 8; ++i) {
    const int n = (tid >> 6) + 8 * i, k = tid & 63;
    dst[(size_t)(n0 + n) * K + k0 + k] = f2bf(t[k * 65 + n]);
  }
}

__device__ __forceinline__ void convert_flat(const float* src, bf16_t* dst, size_t n4) {
  const size_t gt = (size_t)opaque_bid() * blockDim.x + opaque_tid(), gs = (size_t)gridDim.x * blockDim.x;
  for (size_t i = gt; i < n4; i += gs) {
    const float4 v = ((const float4*)src)[i];
    uint2 o; o.x = pack2h(v.x, v.y); o.y = pack2h(v.z, v.w);
    ((uint2*)dst)[i] = o;
  }
}

__device__ __forceinline__ void phase_prep(const Params& p, char* smem) {
  const int tid = opaque_tid();
  char* ws = p.ws;
  if (opaque_bid() == 0) {
    unsigned* ctl = (unsigned*)(ws + OFF_CTL);
    if (tid < 64) ctl[tid] = 0u;
    unsigned* xbar = (unsigned*)(ws + OFF_XBAR);
    for (int i = tid; i < XCD_BAR_WORDS; i += 512) xbar[i] = 0u;
    float* misc = (float*)(ws + OFF_MISC);
    if (tid < 2) {
      const float* lp = p.diff_lambda + tid * 128;
      float s01 = 0.f, s23 = 0.f;
      for (int i = 0; i < 32; ++i) { s01 += lp[i] * lp[32 + i]; s23 += lp[64 + i] * lp[96 + i]; }
      const float lam_init = 0.8f - 0.6f * expf(-0.3f * (float)tid);
      misc[tid] = expf(s01) - expf(s23) + lam_init;
      misc[2 + tid] = lam_init;
    }
    if (tid >= 128 && tid < 256) misc[64 + tid - 128] = 0.f;
    if (tid >= 64 && tid < 80) {
      const int i = tid - 64;
      const float xv = p.ret_decay_logit[i];
      misc[16 + i] = -log1pf(expf(-xv));
    }
    float2* ropeD = (float2*)(ws + OFF_ROPE);
    float2* ropeR = (float2*)(ws + OFF_ROPE + 4096);
    for (int i = tid; i < 64 * 8; i += 512) {
      const int v = i >> 3, f = i & 7;
      const float inv = powf(10000.0f, -(float)(2 * f) / 16.0f);
      const float ang = (float)v * inv;
      ropeD[i] = make_float2(cosf(ang), sinf(ang));
    }
    for (int i = tid; i < 64 * 16; i += 512) {
      const int v = i >> 4, f = i & 15;
      const float inv = powf(10000.0f, -(float)(2 * f) / 32.0f);
      const float ang = (float)v * inv;
      ropeR[i] = make_float2(cosf(ang), sinf(ang));
    }
  }
  {
    float* sc = (float*)smem;
    float* red = (float*)(smem + 9 * 1024 * 4);
    float* mod = (float*)(ws + OFF_MOD);
    for (int item = opaque_bid(); item < 192; item += gridDim.x) {
      const int l = item / 96, cb = item % 96;
      __syncthreads();
      for (int i = tid; i < 9 * 1024; i += 512) {
        const int r = i >> 10, k = i & 1023;
        const float cv = (r < 8) ? p.c[r * 1024 + k] : p.c_ctx[k];
        sc[i] = siluf(cv);
      }
      __syncthreads();
      const int col = tid & 63, ks = tid >> 6;
      float acc[9];
#pragma unroll
      for (int r = 0; r < 9; ++r) acc[r] = 0.f;
      const float* w = p.w_ada + (size_t)l * 1024 * 6144 + cb * 64 + col;
#pragma unroll 1
      for (int k0 = ks * 128; k0 < ks * 128 + 128; k0 += 16) {
        float wv[16];
#pragma unroll
        for (int i = 0; i < 16; ++i) wv[i] = w[(size_t)(k0 + i) * 6144];
#pragma unroll
        for (int i = 0; i < 16; ++i)
#pragma unroll
          for (int r = 0; r < 9; ++r) acc[r] = fmaf(sc[r * 1024 + k0 + i], wv[i], acc[r]);
      }
#pragma unroll
      for (int r = 0; r < 9; ++r) red[(ks * 9 + r) * 64 + col] = acc[r];
      __syncthreads();
      for (int i = tid; i < 576; i += 512) {
        const int r = i >> 6, cc = i & 63;
        float s = 0.f;
#pragma unroll
        for (int k8 = 0; k8 < 8; ++k8) s += red[(k8 * 9 + r) * 64 + cc];
        mod[((size_t)l * 9 + r) * 6144 + cb * 64 + cc] = s + p.b_ada[l * 6144 + cb * 64 + cc];
      }
    }
    __syncthreads();
  }
  for (int item = opaque_bid(); item < 3072; item += gridDim.x) {
    const int l = item / 1536;
    int r = item % 1536;
    if (r < 768) transpose_item(p.w_in + (size_t)l * 1024 * 3072, (bf16_t*)(ws + OFF_WIN) + (size_t)l * 3072 * 1024, 1024, 3072, r, smem);
    else if (r < 1024) transpose_item(p.w_out + (size_t)l * 1024 * 1024, (bf16_t*)(ws + OFF_WOUT) + (size_t)l * 1024 * 1024, 1024, 1024, r - 768, smem);
    else transpose_item(p.peer_wq + (size_t)l * 1024 * 2048, (bf16_t*)(ws + OFF_WQ) + (size_t)l * 2048 * 1024, 1024, 2048, r - 1024, smem);
  }
  convert_flat(p.peer_subkeys, (bf16_t*)(ws + OFF_SUBK), 2ull * 262144 / 4);
  {
    const size_t gt = (size_t)opaque_bid() * blockDim.x + tid, gs = (size_t)gridDim.x * blockDim.x;
    float4* dst = (float4*)(ws + OFF_CTXB);
    for (size_t i = gt; i < (size_t)NCTX * 1024 / 4; i += gs) dst[i] = ((const float4*)p.ctx)[i];
  }
}

__device__ __forceinline__ void phase_norm(const Params& p, int layer, int which, const float* xlat, int nrows) {
  const int lane = opaque_tid() & 63;
  const int gw = opaque_bid() * 8 + (opaque_tid() >> 6), nw = gridDim.x * 8;
  const float* g = (which == 0 ? p.norm1_g : p.norm2_g) + layer * 1024;
  const float* mod = (const float*)(p.ws + OFF_MOD) + (size_t)layer * 9 * 6144;
  const float* ctxb = (const float*)(p.ws + OFF_CTXB);
  bf16_t* act = (bf16_t*)(p.ws + OFF_ACT);
  const int sh_off = which == 0 ? 0 : 3 * 1024, sc_off = which == 0 ? 1024 : 4 * 1024;
  for (int row = gw; row < nrows; row += nw) {
    const float* src = row < NLAT ? xlat + (size_t)row * 1024 : ctxb + (size_t)(row - NLAT) * 1024;
    const int b = row < NLAT ? (row >> 12) : 8;
    const float* mrow = mod + (size_t)b * 6144;
    float4 v[4];
    float ss = 0.f;
#pragma unroll
    for (int j = 0; j < 4; ++j) {
      v[j] = ((const float4*)src)[lane + 64 * j];
      ss += v[j].x * v[j].x + v[j].y * v[j].y + v[j].z * v[j].z + v[j].w * v[j].w;
    }
    ss = wave_sum(ss);
    const float r = rsqrtf(ss * (1.f / 1024.f) + EPS);
#pragma unroll
    for (int j = 0; j < 4; ++j) {
      const int c = (lane + 64 * j) * 4;
      const float4 gg = *(const float4*)(g + c);
      const float4 sh = *(const float4*)(mrow + sh_off + c);
      const float4 sc = *(const float4*)(mrow + sc_off + c);
      const float o0 = v[j].x * r * gg.x * (1.f + sc.x) + sh.x;
      const float o1 = v[j].y * r * gg.y * (1.f + sc.y) + sh.y;
      const float o2 = v[j].z * r * gg.z * (1.f + sc.z) + sh.z;
      const float o3 = v[j].w * r * gg.w * (1.f + sc.w) + sh.w;
      uint2 o; o.x = pack2h(o0, o1); o.y = pack2h(o2, o3);
      *(uint2*)(act + (size_t)row * 1024 + c) = o;
    }
  }
}

__device__ __forceinline__ void phase_final(const Params& p) {
  const int lane = opaque_tid() & 63;
  const int gw = opaque_bid() * 8 + (opaque_tid() >> 6), nw = gridDim.x * 8;
  for (int row = gw; row < NLAT; row += nw) {
    float* src = p.out + (size_t)row * 1024;
    float4 v[4];
    float ss = 0.f;
#pragma unroll
    for (int j = 0; j < 4; ++j) {
      v[j] = ((const float4*)src)[lane + 64 * j];
      ss += v[j].x * v[j].x + v[j].y * v[j].y + v[j].z * v[j].z + v[j].w * v[j].w;
    }
    ss = wave_sum(ss);
    const float r = rsqrtf(ss * (1.f / 1024.f) + EPS);
#pragma unroll
    for (int j = 0; j < 4; ++j) {
      const int c = (lane + 64 * j) * 4;
      const float4 gg = *(const float4*)(p.final_g + c);
      float4 o;
      o.x = v[j].x * r * gg.x; o.y = v[j].y * r * gg.y; o.z = v[j].z * r * gg.z; o.w = v[j].w * r * gg.w;
      ((float4*)src)[lane + 64 * j] = o;
    }
  }
}

constexpr int EPI_INPROJ = 0, EPI_OUTPROJ = 1, EPI_PLAIN = 2;
constexpr int GS = 72;
constexpr int G_ASTAGE = 256 * GS * 2;
constexpr int G_BSTAGE = 128 * GS * 2;
constexpr int G_STAGE = G_ASTAGE + G_BSTAGE;

namespace g8 {
constexpr int BM = 256, BK = 64, HALF = 128, NXCD = 8, WGM = 8, HT = HALF * BK;
__device__ __forceinline__ int lds_byte(int r, int c) {
  const int st = (r >> 4) * 2 + (c >> 5), rr = r & 15, cc = c & 31, ob = rr * 64 + cc * 2;
  return st * 1024 + (ob ^ (((ob >> 9) & 1) << 5));
}
__device__ __forceinline__ void stage_rc(int b, int& R, int& C) {
  const int st = b / 1024, sb = b % 1024, swz = sb ^ (((sb >> 9) & 1) << 5);
  R = (st >> 1) * 16 + swz / 64; C = (st & 1) * 32 + (swz % 64) / 2;
}
}

constexpr int G8_ROPE_LDS = 8 * 16384;
template <int EPI>
__device__ __forceinline__ void epi_store8(const Params& p, int layer, char* smem, int m, int n, f32x4 lo, f32x4 hi, const float* xin_lat) {
  float v[8] = {lo[0], lo[1], lo[2], lo[3], hi[0], hi[1], hi[2], hi[3]};
  if constexpr (EPI == EPI_INPROJ) {
    const bool ropeD = (n >= C_DFQ && n < C_DFV), ropeR = (n >= C_RTQ && n < C_RTV);
    if ((ropeD || ropeR) && m < NLAT) {
      const int t = m & 4095, gr = t >> 6, gc = t & 63;
      const float2* tabD = (const float2*)(smem + G8_ROPE_LDS);
      const float2* tabR = (const float2*)(smem + G8_ROPE_LDS + 4096);
      const float2* tb;
      if (ropeD) { const int i0 = (n & 31) >> 1; tb = i0 < 8 ? tabD + gr * 8 + i0 : tabD + gc * 8 + i0 - 8; }
      else { const int i0 = (n & 63) >> 1; tb = i0 < 16 ? tabR + gr * 16 + i0 : tabR + gc * 16 + i0 - 16; }
#pragma unroll
      for (int q = 0; q < 4; ++q) {
        const float2 cs = tb[q];
        const float a0 = v[2 * q] * cs.x - v[2 * q + 1] * cs.y, a1 = v[2 * q] * cs.y + v[2 * q + 1] * cs.x;
        v[2 * q] = a0; v[2 * q + 1] = a1;
      }
    }
    float sc = 1.f;
    if (n < C_NAK) sc = 0.125f * 1.4426950408889634f;
    else if (n >= C_DFQ && n < C_DFK) sc = 0.17677669529663687f * 1.4426950408889634f;
    else if (n >= C_RTK && n < C_RTV) sc = 0.125f;
    uint4 o;
    o.x = pack2h(v[0] * sc, v[1] * sc); o.y = pack2h(v[2] * sc, v[3] * sc); o.z = pack2h(v[4] * sc, v[5] * sc); o.w = pack2h(v[6] * sc, v[7] * sc);
    *(uint4*)((bf16_t*)(p.ws + OFF_P) + (size_t)m * INC + n) = o;
  } else if constexpr (EPI == EPI_OUTPROJ) {
    const float* mod = (const float*)(p.ws + OFF_MOD) + (size_t)layer * 9 * 6144;
    const int b = m < NLAT ? (m >> 12) : 8;
    const float* gp = mod + (size_t)b * 6144 + 2 * 1024 + n;
    const float4 g0 = *(const float4*)gp, g1 = *(const float4*)(gp + 4);
    const float* xi; float* xo;
    if (m < NLAT) { xi = xin_lat + (size_t)m * 1024 + n; xo = p.out + (size_t)m * 1024 + n; }
    else { xo = (float*)(p.ws + OFF_CTXB) + (size_t)(m - NLAT) * 1024 + n; xi = xo; }
    const float4 x0 = *(const float4*)xi, x1 = *(const float4*)(xi + 4);
    float4 o0, o1;
    o0.x = x0.x + g0.x * v[0]; o0.y = x0.y + g0.y * v[1]; o0.z = x0.z + g0.z * v[2]; o0.w = x0.w + g0.w * v[3];
    o1.x = x1.x + g1.x * v[4]; o1.y = x1.y + g1.y * v[5]; o1.z = x1.z + g1.z * v[6]; o1.w = x1.w + g1.w * v[7];
    *(float4*)xo = o0; *(float4*)(xo + 4) = o1;
  } else if constexpr (EPI == EPI_PLAIN) {
    uint4 o;
    o.x = pack2h(v[0], v[1]); o.y = pack2h(v[2], v[3]); o.z = pack2h(v[4], v[5]); o.w = pack2h(v[6], v[7]);
    *(uint4*)((bf16_t*)(p.ws + OFF_P) + (size_t)m * 2048 + n) = o;
  } else {
    asm volatile("" :: "v"(v[0]), "v"(v[1]), "v"(v[2]), "v"(v[3]), "v"(v[4]), "v"(v[5]), "v"(v[6]), "v"(v[7]));
  }
}

#define G8_LAS __attribute__((address_space(3)))
__device__ __forceinline__ bool g8_next(int i, int nM, int nN, int G, int c, int& pm, int& pn) {
  using namespace g8;
  const int nwg = nM * nN;
  const long Lx = (long)i * G + c;
  if (Lx >= nwg) return false;
  int wgid = (int)Lx;
  { const int q = nwg / NXCD, r = nwg % NXCD, xcd = wgid % NXCD, off = wgid / NXCD; wgid = (xcd < r ? xcd * (q + 1) : r * (q + 1) + (xcd - r) * q) + off; }
  const int nig = WGM * nN, gid = wgid / nig, fm = gid * WGM, gsz = (nM - fm) < WGM ? (nM - fm) : WGM;
  pm = fm + ((wgid % nig) % gsz); pn = (wgid % nig) / gsz;
  return true;
}

template <int EPI>
__device__ __forceinline__ void gemm_phase2(const Params& p, int layer, char* smem, const bf16_t* A, const bf16_t* Bt,
                                            int M, int N, const float* xin_lat) {
  using namespace g8;
  constexpr int K = 1024, nt = K / BK, HTB = HALF * BK * 2;
  G8_LAS unsigned char* lds = (G8_LAS unsigned char*)smem;
  const int tid = opaque_tid();
  const int wid = __builtin_amdgcn_readfirstlane(tid >> 6), lane = tid & 63, wr = wid >> 2, wc = wid & 3, fr = lane & 15, fq = lane >> 4;
  unsigned voff[2], voffB[2];
#pragma unroll
  for (int i = 0; i < 2; ++i) {
    int R, C; stage_rc(tid * 16 + i * 8192, R, C);
    const int rho = R & 31, Rb = (R & ~31) + 8 * ((rho & 15) >> 2) + 4 * (rho >> 4) + (rho & 3);
    voff[i] = (unsigned)(R * K + C) * 2u; voffB[i] = (unsigned)(Rb * K + C) * 2u;
  }
  if constexpr (EPI == EPI_INPROJ) {
    __syncthreads();
    const float4* gsrc = (const float4*)(p.ws + OFF_ROPE);
    float4* ldst = (float4*)(smem + G8_ROPE_LDS);
    for (int i = tid; i < 12288 / 16; i += 512) ldst[i] = gsrc[i];
  }
  constexpr size_t kstep = (size_t)(BK * 2);
  constexpr size_t hstep = (size_t)HALF * K * 2;
  constexpr size_t tstep = 2 * hstep;
  const unsigned ldsw = (unsigned)wid * 1024u;
  const int aoff = lds_byte(wr * 64 + fr, fq * 8), boff = lds_byte(wc * 32 + fr, fq * 8);
#define G8_SA(b, h) (((b) * 2 + (h)) * HTB)
#define G8_SB(b, h) ((4 + (b) * 2 + (h)) * HTB)
#define G8_STAGE_V(bufoff, gbase, VO) do { _Pragma("unroll") for (int _i = 0; _i < 2; ++_i)                                  \
    __builtin_amdgcn_global_load_lds((const unsigned*)((const char*)(gbase) + VO[_i]), (G8_LAS unsigned*)(lds + (bufoff) + ldsw + _i * 8192), 16, 0, 0); } while (0)
#define G8_LDA(dst, b, h) do { _Pragma("unroll") for (int m = 0; m < 4; ++m) _Pragma("unroll") for (int k = 0; k < 2; ++k) dst[m][k] = *(const G8_LAS bf16x8*)(lds + G8_SA(b, h) + aoff + m * 2048 + k * 1024); } while (0)
#define G8_LDB(dst, b, h) do { _Pragma("unroll") for (int n = 0; n < 2; ++n) _Pragma("unroll") for (int k = 0; k < 2; ++k) dst[n][k] = *(const G8_LAS bf16x8*)(lds + G8_SB(b, h) + boff + n * 2048 + k * 1024); } while (0)
#define G8_MMA(ai, bj, At_, Bt_) do { __builtin_amdgcn_s_setprio(1);                                                          \
    _Pragma("unroll") for (int m = 0; m < 4; ++m) _Pragma("unroll") for (int n = 0; n < 2; ++n) _Pragma("unroll") for (int k = 0; k < 2; ++k) \
      acc[ai][bj][m][n] = __builtin_amdgcn_mfma_f32_16x16x32_bf16(Bt_[n][k], At_[m][k], acc[ai][bj][m][n], 0, 0, 0);          \
    __builtin_amdgcn_s_setprio(0); } while (0)
#define G8_WAIT_V(n) asm volatile("s_waitcnt vmcnt(" #n ")" ::: "memory")
#define G8_WAIT_L(n) asm volatile("s_waitcnt lgkmcnt(" #n ")" ::: "memory")
#define G8_BAR __builtin_amdgcn_s_barrier()
#define G8_SCHED __builtin_amdgcn_sched_barrier(0)
  const int nM = M / BM, nN = N / BM, G = gridDim.x, cu = opaque_bid();
  int cpm, cpn, npm = 0, npn = 0, ui = 0;
  __syncthreads();
  if (g8_next(0, nM, nN, G, cu, cpm, cpn)) {
    f32x4 acc[2][2][4][2];
#pragma unroll
    for (int a = 0; a < 2; ++a)
#pragma unroll
      for (int b2 = 0; b2 < 2; ++b2)
#pragma unroll
        for (int m = 0; m < 4; ++m)
#pragma unroll
          for (int n = 0; n < 2; ++n) acc[a][b2][m][n] = (f32x4){0.f, 0.f, 0.f, 0.f};
    bf16x8 At[4][2], B0[2][2], B1[2][2];
    const char* cA = (const char*)A + (size_t)cpm * tstep;
    const char* cB = (const char*)Bt + (size_t)cpn * tstep;
    G8_STAGE_V(G8_SB(0, 0), cB, voffB); G8_STAGE_V(G8_SA(0, 0), cA, voff); G8_STAGE_V(G8_SB(0, 1), cB + hstep, voffB); G8_STAGE_V(G8_SA(0, 1), cA + hstep, voff);
    if (wr == 1) G8_BAR;
    G8_WAIT_V(4); G8_BAR;
    G8_STAGE_V(G8_SB(1, 0), cB + kstep, voffB); G8_STAGE_V(G8_SA(1, 0), cA + kstep, voff); G8_STAGE_V(G8_SB(1, 1), cB + hstep + kstep, voffB);
    G8_WAIT_V(6); G8_BAR;
    for (;;) {
      const bool has_next = g8_next(ui + 1, nM, nN, G, cu, npm, npn);
      const char* nA = has_next ? (const char*)A + (size_t)npm * tstep : cA;
      const char* nB = has_next ? (const char*)Bt + (size_t)npn * tstep : cB;
#pragma unroll 1
      for (int t = 0; t < nt; t += 2) {
        const bool last = (t == nt - 2);
        const char* a1 = cA + (size_t)(t + 1) * kstep;
        const char* a2 = last ? nA : cA + (size_t)(t + 2) * kstep; const char* b2 = last ? nB : cB + (size_t)(t + 2) * kstep;
        const char* a3 = a2 + kstep; const char* b3 = b2 + kstep;
        G8_LDB(B0, 0, 0); G8_SCHED; G8_LDA(At, 0, 0); G8_STAGE_V(G8_SA(1, 1), a1 + hstep, voff);
        G8_WAIT_L(8); G8_BAR; G8_WAIT_L(0); G8_MMA(0, 0, At, B0); G8_BAR; G8_SCHED;
        G8_LDB(B1, 0, 1); G8_STAGE_V(G8_SB(0, 0), b2, voffB);
        G8_BAR; G8_WAIT_L(0); G8_MMA(0, 1, At, B1); G8_BAR;
        G8_LDA(At, 0, 1); G8_STAGE_V(G8_SA(0, 0), a2, voff);
        G8_BAR; G8_WAIT_L(0); G8_MMA(1, 0, At, B0); G8_BAR; G8_SCHED;
        G8_STAGE_V(G8_SB(0, 1), b2 + hstep, voffB);
        G8_WAIT_V(6); G8_BAR; G8_MMA(1, 1, At, B1); G8_BAR;
        G8_LDB(B0, 1, 0); G8_SCHED; G8_LDA(At, 1, 0); G8_STAGE_V(G8_SA(0, 1), a2 + hstep, voff);
        G8_WAIT_L(8); G8_BAR; G8_WAIT_L(0); G8_MMA(0, 0, At, B0); G8_BAR; G8_SCHED;
        G8_LDB(B1, 1, 1); G8_STAGE_V(G8_SB(1, 0), b3, voffB);
        G8_BAR; G8_WAIT_L(0); G8_MMA(0, 1, At, B1); G8_BAR;
        G8_LDA(At, 1, 1); G8_STAGE_V(G8_SA(1, 0), a3, voff);
        G8_BAR; G8_WAIT_L(0); G8_MMA(1, 0, At, B0); G8_BAR; G8_SCHED;
        G8_STAGE_V(G8_SB(1, 1), b3 + hstep, voffB);
        G8_WAIT_V(6); G8_BAR; G8_MMA(1, 1, At, B1); G8_BAR;
      }
      {
        const int brow = cpm * BM, bcol = cpn * BM;
        if constexpr (EPI == EPI_INPROJ) {
          if (bcol == C_DFK) {
#pragma unroll
            for (int bj = 0; bj < 2; ++bj) {
              float mx = 0.f;
#pragma unroll
              for (int ai = 0; ai < 2; ++ai)
#pragma unroll
                for (int m = 0; m < 4; ++m) {
                  float s = 0.f;
#pragma unroll
                  for (int n = 0; n < 2; ++n)
#pragma unroll
                    for (int j = 0; j < 4; ++j) s = fmaf(acc[ai][bj][m][n][j], acc[ai][bj][m][n][j], s);
                  s += __shfl_xor(s, 16); s += __shfl_xor(s, 32);
                  mx = fmaxf(mx, s);
                }
#pragma unroll
              for (int o = 1; o < 16; o <<= 1) mx = fmaxf(mx, __shfl_xor(mx, o));
              if (lane == 0) {
                const int bb = brow < NLAT ? (brow >> 12) : ((brow - NLAT) >> 8);
                unsigned* km = (unsigned*)(p.ws + OFF_MISC) + 64 + layer * 64 + (bb * 4 + bj * 2 + (wc >> 1)) * 2 + (wc & 1);
                atomicMax(km, __float_as_uint(mx));
              }
            }
          }
        }
#pragma unroll
        for (int ai = 0; ai < 2; ++ai)
#pragma unroll
          for (int bj = 0; bj < 2; ++bj)
#pragma unroll
            for (int m = 0; m < 4; ++m)
              epi_store8<EPI>(p, layer, smem, brow + ai * HALF + wr * 64 + m * 16 + fr, bcol + bj * HALF + wc * 32 + fq * 8,
                              acc[ai][bj][m][0], acc[ai][bj][m][1], xin_lat);
      }
      if (!has_next) break;
#pragma unroll
      for (int a = 0; a < 2; ++a)
#pragma unroll
        for (int b2 = 0; b2 < 2; ++b2)
#pragma unroll
          for (int m = 0; m < 4; ++m)
#pragma unroll
            for (int n = 0; n < 2; ++n) acc[a][b2][m][n] = (f32x4){0.f, 0.f, 0.f, 0.f};
      cpm = npm; cpn = npn; cA = nA; cB = nB; ++ui;
    }
    G8_WAIT_V(0);
    if (wr == 0) G8_BAR;
    G8_BAR;
  }
}

__device__ __forceinline__ unsigned cvt_pk_bf16(float lo, float hi) { return pack2h(lo, hi); }
__device__ __forceinline__ void vt_store8(bf16_t* vt, int stride, int d0, int key, uint4 uv) {
  bf16_t* vd = vt + d0 * stride + key;
  vd[0 * stride] = (bf16_t)(uv.x & 0xffffu); vd[1 * stride] = (bf16_t)(uv.x >> 16);
  vd[2 * stride] = (bf16_t)(uv.y & 0xffffu); vd[3 * stride] = (bf16_t)(uv.y >> 16);
  vd[4 * stride] = (bf16_t)(uv.z & 0xffffu); vd[5 * stride] = (bf16_t)(uv.z >> 16);
  vd[6 * stride] = (bf16_t)(uv.w & 0xffffu); vd[7 * stride] = (bf16_t)(uv.w >> 16);
}

constexpr int DKS = 72;
__device__ __forceinline__ void diff_item(const Params& p, int layer, bool ctxq, int item, char* smem) {
  const bf16_t* P = (const bf16_t*)(p.ws + OFF_P);
  bf16_t* Y = (bf16_t*)(p.ws + OFF_ACT);
  const float* misc = (const float*)(p.ws + OFF_MISC);
  const float lam = misc[layer], lam_init = misc[2 + layer];
  const int tid = opaque_tid(), lane = tid & 63, wave = tid >> 6, lr = lane & 15, lq = lane >> 4;
  int b, h, mbase, nkeys;
  if (!ctxq) { b = item >> 6; h = (item >> 4) & 3; mbase = b * 4096 + (item & 15) * 256; nkeys = 256 + 4096; }
  else { b = item >> 2; h = item & 3; mbase = NLAT + b * 256; nkeys = 256; }
  const float kmax0 = sqrtf(misc[64 + layer * 64 + (b * 4 + h) * 2 + 0]), kmax1 = sqrtf(misc[64 + layer * 64 + (b * 4 + h) * 2 + 1]);
  bf16x8 qf[2][2];
  f32x4 C0[2], C1[2];
#pragma unroll
  for (int qt = 0; qt < 2; ++qt) {
    const bf16_t* qr = P + (size_t)(mbase + wave * 32 + qt * 16 + lr) * INC + C_DFQ + h * 64 + lq * 8;
    const uint4 u0 = *(const uint4*)(qr), u1 = *(const uint4*)(qr + 32);
    float s0 = 0.f, s1 = 0.f;
    { float t[8]; UNPACK8(t, 0, u0) _Pragma("unroll") for (int i = 0; i < 8; ++i) s0 = fmaf(t[i], t[i], s0); }
    { float t[8]; UNPACK8(t, 0, u1) _Pragma("unroll") for (int i = 0; i < 8; ++i) s1 = fmaf(t[i], t[i], s1); }
    s0 += __shfl_xor(s0, 16); s0 += __shfl_xor(s0, 32);
    s1 += __shfl_xor(s1, 16); s1 += __shfl_xor(s1, 32);
    const float nm0 = -sqrtf(s0) * kmax0, nm1 = -sqrtf(s1) * kmax1;
    C0[qt] = (f32x4){nm0, nm0, nm0, nm0};
    C1[qt] = (f32x4){nm1, nm1, nm1, nm1};
    union { uint4 u; bf16x8 v; } c0, c1; c0.u = u0; c1.u = u1;
    qf[qt][0] = c0.v; qf[qt][1] = c1.v;
  }
  f32x4 O0[2][4], O1[2][4];
#pragma unroll
  for (int qt = 0; qt < 2; ++qt)
#pragma unroll
    for (int i = 0; i < 4; ++i) { O0[qt][i] = (f32x4){0.f, 0.f, 0.f, 0.f}; O1[qt][i] = (f32x4){0.f, 0.f, 0.f, 0.f}; }
  f32x4 L0[2], L1[2];
#pragma unroll
  for (int qt = 0; qt < 2; ++qt) { L0[qt] = (f32x4){0.f, 0.f, 0.f, 0.f}; L1[qt] = (f32x4){0.f, 0.f, 0.f, 0.f}; }
  const bf16x8 ones8 = {(short)0x3F80, (short)0x3F80, (short)0x3F80, (short)0x3F80, (short)0x3F80, (short)0x3F80, (short)0x3F80, (short)0x3F80};
  const int lkey = tid >> 3, lch = tid & 7;
  constexpr int DBUF = 2 * 128 * DKS * 2;
  uint4 ukA0, ukA1, uvA0, uvA1;
#define DF_GLOAD1(UK, UV, T, I)                                                                     \
  {                                                                                                 \
    const int kk = (T) * 128 + (I) * 64 + lkey;                                                     \
    const size_t row = kk < 256 ? (size_t)(NLAT + b * 256 + kk) : (size_t)(b * 4096 + kk - 256);    \
    UK = *(const uint4*)(P + row * INC + C_DFK + h * 64 + lch * 8);                                 \
    UV = *(const uint4*)(P + row * INC + C_DFV + h * 64 + lch * 8);                                 \
  }
#define DF_LSTORE1(UK, UV, BUF, I)                                                                  \
  {                                                                                                 \
    bf16_t* Ks_ = (bf16_t*)(smem + (BUF) * DBUF) + (I) * 64 * DKS;                                  \
    bf16_t* Vt_ = (bf16_t*)(smem + (BUF) * DBUF) + 128 * DKS + (I) * 64 * DKS;                      \
    *(uint4*)(Ks_ + lkey * DKS + lch * 8) = UK;                                                     \
    vt_store8(Vt_, DKS, lch * 8, lkey, UV);                                                         \
  }
#define DF_GLOAD(S, T) DF_GLOAD1(uk##S##0, uv##S##0, T, 0) DF_GLOAD1(uk##S##1, uv##S##1, T, 1)
#define DF_LSTORE(S, BUF) DF_LSTORE1(uk##S##0, uv##S##0, BUF, 0) DF_LSTORE1(uk##S##1, uv##S##1, BUF, 1)
  const int ntile = nkeys >> 7;
  __syncthreads();
  DF_GLOAD(A, 0)
  DF_LSTORE(A, 0)
  __syncthreads();
#pragma unroll 1
  for (int t = 0; t < ntile; ++t) {
    const int cur = t & 1;
    if (t + 1 < ntile) { DF_GLOAD(A, t + 1) }
#pragma unroll 1
    for (int sub = 0; sub < 2; ++sub) {
    const bf16_t* Ks = (const bf16_t*)(smem + cur * DBUF) + sub * 64 * DKS;
    const bf16_t* Vt = (const bf16_t*)(smem + cur * DBUF) + 128 * DKS + sub * 64 * DKS;
    union PF { unsigned u[4]; bf16x8 v; };
    PF pf0[2][2], pf1[2][2];
#pragma unroll
    for (int c = 0; c < 2; ++c) {
      f32x4 S[2][4];
#pragma unroll
      for (int kt = 0; kt < 4; ++kt) {
        const bf16x8 kf = *(const bf16x8*)(Ks + (kt * 16 + lr) * DKS + c * 32 + lq * 8);
#pragma unroll
        for (int qt = 0; qt < 2; ++qt) S[qt][kt] = __builtin_amdgcn_mfma_f32_16x16x32_bf16(kf, qf[qt][c], c == 0 ? C0[qt] : C1[qt], 0, 0, 0);
      }
#pragma unroll
      for (int qt = 0; qt < 2; ++qt) {
#pragma unroll
        for (int kt = 0; kt < 4; ++kt) {
#pragma unroll
          for (int r = 0; r < 4; ++r) S[qt][kt][r] = __builtin_amdgcn_exp2f(S[qt][kt][r]);
        }
#pragma unroll
        for (int g = 0; g < 2; ++g) {
          PF t;
          t.u[0] = cvt_pk_bf16(S[qt][2 * g][0], S[qt][2 * g][1]); t.u[1] = cvt_pk_bf16(S[qt][2 * g][2], S[qt][2 * g][3]);
          t.u[2] = cvt_pk_bf16(S[qt][2 * g + 1][0], S[qt][2 * g + 1][1]); t.u[3] = cvt_pk_bf16(S[qt][2 * g + 1][2], S[qt][2 * g + 1][3]);
          if (c == 0) pf0[qt][g] = t; else pf1[qt][g] = t;
        }
      }
    }
#pragma unroll
    for (int g = 0; g < 2; ++g) {
#pragma unroll
      for (int qt = 0; qt < 2; ++qt) {
        L0[qt] = __builtin_amdgcn_mfma_f32_16x16x32_bf16(ones8, pf0[qt][g].v, L0[qt], 0, 0, 0);
        L1[qt] = __builtin_amdgcn_mfma_f32_16x16x32_bf16(ones8, pf1[qt][g].v, L1[qt], 0, 0, 0);
      }
#pragma unroll
      for (int dt = 0; dt < 4; ++dt) {
        union { uint2 h2[2]; bf16x8 v; } vf;
        vf.h2[0] = *(const uint2*)(Vt + (dt * 16 + lr) * DKS + 32 * g + 4 * lq);
        vf.h2[1] = *(const uint2*)(Vt + (dt * 16 + lr) * DKS + 32 * g + 16 + 4 * lq);
#pragma unroll
        for (int qt = 0; qt < 2; ++qt) {
          O0[qt][dt] = __builtin_amdgcn_mfma_f32_16x16x32_bf16(vf.v, pf0[qt][g].v, O0[qt][dt], 0, 0, 0);
          O1[qt][dt] = __builtin_amdgcn_mfma_f32_16x16x32_bf16(vf.v, pf1[qt][g].v, O1[qt][dt], 0, 0, 0);
        }
      }
    }
    }
    if (t + 1 < ntile) { DF_LSTORE(A, cur ^ 1) }
    __syncthreads();
  }
  const float* sg = p.diff_subln_g + layer * 64;
#pragma unroll
  for (int qt = 0; qt < 2; ++qt) {
    const float a0 = L0[qt][0], a1 = L1[qt][0];
    const float i0 = 1.f / a0, i1 = lam / a1;
    float ss = 0.f;
#pragma unroll
    for (int dt = 0; dt < 4; ++dt) {
#pragma unroll
      for (int r = 0; r < 4; ++r) { const float v = O0[qt][dt][r] * i0 - O1[qt][dt][r] * i1; O0[qt][dt][r] = v; ss = fmaf(v, v, ss); }
    }
    ss += __shfl_xor(ss, 16); ss += __shfl_xor(ss, 32);
    const float rr = rsqrtf(ss * (1.f / 64.f) + EPS) * (1.f - lam_init);
    bf16_t* dst = Y + (size_t)(mbase + wave * 32 + qt * 16 + lr) * 1024 + Y_DF + h * 64;
#pragma unroll
    for (int dt = 0; dt < 4; ++dt) {
      const int d = dt * 16 + 4 * lq;
      const float4 g4 = *(const float4*)(sg + d);
      uint2 ov;
      ov.x = pack2(O0[qt][dt][0] * rr * g4.x, O0[qt][dt][1] * rr * g4.y);
      ov.y = pack2(O0[qt][dt][2] * rr * g4.z, O0[qt][dt][3] * rr * g4.w);
      *(uint2*)(dst + d) = ov;
    }
  }
}

constexpr int NA_WS = 520;
constexpr int NA_CS = 264;
constexpr int NA_OFF_VTW = 0;
constexpr int NA_OFF_VTC = 64 * NA_WS * 2;
constexpr int NA_OFF_RPB = NA_OFF_VTC + 64 * NA_CS * 2;
constexpr int NA_OFF_MRG = NA_OFF_RPB + 2048;

#define NA_STEP(KA_EXPR, KB_EXPR, BIAS_EXPR, VT_PTR, VT_STRIDE, VT_KEY0_EXPR)                                    \
  {                                                                                                               \
    f32x4 S[4];                                                                                                   \
    _Pragma("unroll") for (int kt = 0; kt < 4; ++kt) {                                                            \
      f32x4 a = __builtin_amdgcn_mfma_f32_16x16x32_bf16((KA_EXPR), qf[0], (f32x4){0.f, 0.f, 0.f, 0.f}, 0, 0, 0);  \
      S[kt] = __builtin_amdgcn_mfma_f32_16x16x32_bf16((KB_EXPR), qf[1], a, 0, 0, 0);                               \
    }                                                                                                             \
    _Pragma("unroll") for (int kt = 0; kt < 4; ++kt) {                                                            \
      _Pragma("unroll") for (int r = 0; r < 4; ++r) { S[kt][r] += (BIAS_EXPR); }                                  \
    }                                                                                                             \
    float x = fmaxf(fmaxf(S[0][0], S[0][1]), fmaxf(S[0][2], S[0][3]));                                            \
    _Pragma("unroll") for (int kt = 1; kt < 4; ++kt) x = fmaxf(x, fmaxf(fmaxf(S[kt][0], S[kt][1]), fmaxf(S[kt][2], S[kt][3]))); \
    x = fmaxf(x, __shfl_xor(x, 16)); x = fmaxf(x, __shfl_xor(x, 32));                                             \
    const float mn = fmaxf(mrun, x);                                                                              \
    const float al = __builtin_amdgcn_exp2f(mrun - mn);                                                           \
    mrun = mn;                                                                                                    \
    float ps = 0.f;                                                                                               \
    _Pragma("unroll") for (int kt = 0; kt < 4; ++kt) {                                                            \
      _Pragma("unroll") for (int r = 0; r < 4; ++r) { S[kt][r] = __builtin_amdgcn_exp2f(S[kt][r] - mn); ps += S[kt][r]; } \
    }                                                                                                             \
    lrun = lrun * al + ps;                                                                                        \
    _Pragma("unroll") for (int dt = 0; dt < 4; ++dt) {                                                            \
      _Pragma("unroll") for (int r = 0; r < 4; ++r) O[dt][r] *= al;                                               \
    }                                                                                                             \
    _Pragma("unroll") for (int g = 0; g < 2; ++g) {                                                               \
      union { unsigned u[4]; bf16x8 v; } pf;                                                                      \
      pf.u[0] = cvt_pk_bf16(S[2 * g][0], S[2 * g][1]); pf.u[1] = cvt_pk_bf16(S[2 * g][2], S[2 * g][3]);           \
      pf.u[2] = cvt_pk_bf16(S[2 * g + 1][0], S[2 * g + 1][1]); pf.u[3] = cvt_pk_bf16(S[2 * g + 1][2], S[2 * g + 1][3]); \
      const int vk0 = (VT_KEY0_EXPR);                                                                             \
      _Pragma("unroll") for (int dt = 0; dt < 4; ++dt) {                                                          \
        union { uint2 h2[2]; bf16x8 v; } vf;                                                                      \
        vf.h2[0] = *(const uint2*)((VT_PTR) + (dt * 16 + lr) * (VT_STRIDE) + vk0 + 4 * lq);                       \
        vf.h2[1] = *(const uint2*)((VT_PTR) + (dt * 16 + lr) * (VT_STRIDE) + vk0 + 16 + 4 * lq);                  \
        O[dt] = __builtin_amdgcn_mfma_f32_16x16x32_bf16(vf.v, pf.v, O[dt], 0, 0, 0);                              \
      }                                                                                                           \
    }                                                                                                             \
  }

__device__ __forceinline__ void na_latent_item(const Params& p, int layer, int item, char* smem) {
  const bf16_t* P = (const bf16_t*)(p.ws + OFF_P);
  bf16_t* Y = (bf16_t*)(p.ws + OFF_ACT);
  const int b = item >> 8, h = (item >> 6) & 3, grow = item & 63;
  const int tid = opaque_tid(), lane = tid & 63, wave = tid >> 6, lr = lane & 15, lq = lane >> 4;
  const int jt = wave & 3, half = wave >> 2;
  bf16_t* VtW = (bf16_t*)(smem + NA_OFF_VTW);
  bf16_t* VtC = (bf16_t*)(smem + NA_OFF_VTC);
  float* RPB = (float*)(smem + NA_OFF_RPB);
  float* MRG = (float*)(smem + NA_OFF_MRG);
  const int rs = min(max(grow - 4, 0), 56);
  __syncthreads();
  {
    const int ch = tid & 7;
#pragma unroll
    for (int i = 0; i < 8; ++i) {
      const int key = (tid >> 3) + 64 * i;
      const uint4 uv = *(const uint4*)(P + (size_t)(b * 4096 + (rs + (key >> 6)) * 64 + (key & 63)) * INC + C_NAV + h * 64 + ch * 8);
      vt_store8(VtW, NA_WS, ch * 8, key, uv);
    }
#pragma unroll
    for (int i = 0; i < 4; ++i) {
      const int key = (tid >> 3) + 64 * i;
      const uint4 uv = *(const uint4*)(P + (size_t)(NLAT + b * 256 + key) * INC + C_NAV + h * 64 + ch * 8);
      vt_store8(VtC, NA_CS, ch * 8, key, uv);
    }
    if (tid < 465) RPB[tid] = p.na_rpb[(size_t)(layer * 4 + h) * 465 + tid] * 1.4426950408889634f;
  }
  const int qc = jt * 16 + lr;
  const int mq = b * 4096 + grow * 64 + qc;
  bf16x8 qf[2];
  {
    const bf16_t* qr = P + (size_t)mq * INC + C_NAQ + h * 64 + lq * 8;
    qf[0] = *(const bf16x8*)(qr);
    qf[1] = *(const bf16x8*)(qr + 32);
  }
  f32x4 O[4];
#pragma unroll
  for (int i = 0; i < 4; ++i) O[i] = (f32x4){0.f, 0.f, 0.f, 0.f};
  float mrun = -1e30f, lrun = 0.f;
  const int k0 = min(max(jt * 16 - 8, 0), 32);
  const int cs = min(max(qc - 8, 0), 48);
  bf16x8 kfa[2][4], kfb[2][4];
#define NA_LOADK(SET, S_)                                                                                        \
  _Pragma("unroll") for (int kt = 0; kt < 4; ++kt) {                                                             \
    const int t_ = 4 * (S_) + kt;                                                                                \
    const size_t krow = half == 0 ? (size_t)(b * 4096 + (rs + (t_ >> 1)) * 64 + k0 + 16 * (t_ & 1) + lr) : (size_t)(NLAT + b * 256 + 16 * t_ + lr); \
    const bf16_t* kp = P + krow * INC + C_NAK + h * 64 + lq * 8;                                                 \
    kfa[SET][kt] = *(const bf16x8*)(kp); kfb[SET][kt] = *(const bf16x8*)(kp + 32);                               \
  }
  NA_LOADK(0, 0)
  __syncthreads();
#pragma unroll
  for (int s = 0; s < 4; ++s) {
    if (s + 1 < 4) { NA_LOADK((s + 1) & 1, s + 1) }
    if (half == 0) {
      const int wr0 = 2 * s;
      NA_STEP(kfa[s & 1][kt], kfb[s & 1][kt],
              ((k0 + 16 * (kt & 1) + 4 * lq + r) >= cs && (k0 + 16 * (kt & 1) + 4 * lq + r) < cs + 16)
                  ? RPB[(rs + wr0 + (kt >> 1) - grow + 7) * 31 + (k0 + 16 * (kt & 1) + 4 * lq + r) - qc + 15] : -1e30f,
              VtW, NA_WS, (wr0 + g) * 64 + k0)
    } else {
      NA_STEP(kfa[s & 1][kt], kfb[s & 1][kt], 0.f, VtC, NA_CS, s * 64 + 32 * g)
    }
  }
  lrun += __shfl_xor(lrun, 16); lrun += __shfl_xor(lrun, 32);
  float* mg = MRG + (jt * 64 + lane) * 18;
  if (half == 1) {
    mg[0] = mrun; mg[1] = lrun;
#pragma unroll
    for (int dt = 0; dt < 4; ++dt) { mg[2 + dt * 4 + 0] = O[dt][0]; mg[2 + dt * 4 + 1] = O[dt][1]; mg[2 + dt * 4 + 2] = O[dt][2]; mg[2 + dt * 4 + 3] = O[dt][3]; }
  }
  __syncthreads();
  if (half == 0) {
    const float m2 = mg[0], l2 = mg[1];
    const float M = fmaxf(mrun, m2);
    const float f1 = __builtin_amdgcn_exp2f(mrun - M), f2 = __builtin_amdgcn_exp2f(m2 - M);
    const float inv = 1.f / (lrun * f1 + l2 * f2);
    bf16_t* dst = Y + (size_t)mq * 1024 + Y_NA + h * 64;
#pragma unroll
    for (int dt = 0; dt < 4; ++dt) {
      const float o0 = (O[dt][0] * f1 + mg[2 + dt * 4 + 0] * f2) * inv, o1 = (O[dt][1] * f1 + mg[2 + dt * 4 + 1] * f2) * inv;
      const float o2 = (O[dt][2] * f1 + mg[2 + dt * 4 + 2] * f2) * inv, o3 = (O[dt][3] * f1 + mg[2 + dt * 4 + 3] * f2) * inv;
      uint2 ov; ov.x = pack2(o0, o1); ov.y = pack2(o2, o3);
      *(uint2*)(dst + dt * 16 + 4 * lq) = ov;
    }
  }
}

__device__ __forceinline__ void na_ctx_item(const Params& p, int item, char* smem) {
  const bf16_t* P = (const bf16_t*)(p.ws + OFF_P);
  bf16_t* Y = (bf16_t*)(p.ws + OFF_ACT);
  const int b = item >> 3, h = (item >> 1) & 3, qg = item & 1;
  const int tid = opaque_tid(), lane = tid & 63, wave = tid >> 6, lr = lane & 15, lq = lane >> 4;
  bf16_t* VtC = (bf16_t*)(smem + NA_OFF_VTC);
  __syncthreads();
  {
    const int ch = tid & 7;
#pragma unroll
    for (int i = 0; i < 4; ++i) {
      const int key = (tid >> 3) + 64 * i;
      const uint4 uv = *(const uint4*)(P + (size_t)(NLAT + b * 256 + key) * INC + C_NAV + h * 64 + ch * 8);
      vt_store8(VtC, NA_CS, ch * 8, key, uv);
    }
  }
  const int mq = NLAT + b * 256 + qg * 128 + wave * 16 + lr;
  bf16x8 qf[2];
  {
    const bf16_t* qr = P + (size_t)mq * INC + C_NAQ + h * 64 + lq * 8;
    qf[0] = *(const bf16x8*)(qr);
    qf[1] = *(const bf16x8*)(qr + 32);
  }
  f32x4 O[4];
#pragma unroll
  for (int i = 0; i < 4; ++i) O[i] = (f32x4){0.f, 0.f, 0.f, 0.f};
  float mrun = -1e30f, lrun = 0.f;
  __syncthreads();
#pragma unroll 1
  for (int s = 0; s < 4; ++s) {
    NA_STEP(*(const bf16x8*)(P + (size_t)(NLAT + b * 256 + s * 64 + kt * 16 + lr) * INC + C_NAK + h * 64 + lq * 8),
            *(const bf16x8*)(P + (size_t)(NLAT + b * 256 + s * 64 + kt * 16 + lr) * INC + C_NAK + h * 64 + 32 + lq * 8), 0.f, VtC, NA_CS, s * 64 + 32 * g)
  }
  lrun += __shfl_xor(lrun, 16); lrun += __shfl_xor(lrun, 32);
  const float inv = 1.f / lrun;
  bf16_t* dst = Y + (size_t)mq * 1024 + Y_NA + h * 64;
#pragma unroll
  for (int dt = 0; dt < 4; ++dt) {
    uint2 ov; ov.x = pack2(O[dt][0] * inv, O[dt][1] * inv); ov.y = pack2(O[dt][2] * inv, O[dt][3] * inv);
    *(uint2*)(dst + dt * 16 + 4 * lq) = ov;
  }
}

constexpr int KV_S = 136;
constexpr int KV_OFF_KF = 0, KV_OFF_KB = 64 * KV_S * 2, KV_OFF_VT = 2 * 64 * KV_S * 2;
__device__ __forceinline__ void ret_kv_item(const Params& p, int layer, int h, size_t row0, int cnt, float* dstF, float* dstB, char* smem) {
  const bf16_t* P = (const bf16_t*)(p.ws + OFF_P);
  const float* misc = (const float*)(p.ws + OFF_MISC);
  const float lgF2 = misc[16 + layer * 8 + 0 * 4 + h] * 1.4426950408889634f, lgB2 = misc[16 + layer * 8 + 1 * 4 + h] * 1.4426950408889634f;
  const int tid = opaque_tid(), lane = tid & 63, wave = tid >> 6, lr = lane & 15, lq = lane >> 4;
  bf16_t* KFt = (bf16_t*)(smem + KV_OFF_KF);
  bf16_t* KBt = (bf16_t*)(smem + KV_OFF_KB);
  bf16_t* Vt = (bf16_t*)(smem + KV_OFF_VT);
  const int dir = wave >> 2, dt = wave & 3;
  f32x4 acc[8];
#pragma unroll
  for (int i = 0; i < 8; ++i) acc[i] = (f32x4){0.f, 0.f, 0.f, 0.f};
#pragma unroll 1
  for (int kc = 0; kc < (cnt >> 7); ++kc) {
    __syncthreads();
    {
      const int tok = tid >> 2, c = tid & 3;
      const int j = kc * 128 + tok;
      const float wF = __builtin_amdgcn_exp2f(lgF2 * (float)(cnt - 1 - j)), wB = __builtin_amdgcn_exp2f(lgB2 * (float)j);
      const bf16_t* rowp = P + (row0 + j) * INC;
#pragma unroll
      for (int c8 = 0; c8 < 2; ++c8) {
        const uint4 u = *(const uint4*)(rowp + C_RTK + h * 64 + c * 16 + c8 * 8);
        float kv[8];
        UNPACK8(kv, 0, u)
#pragma unroll
        for (int i = 0; i < 8; ++i) {
          KFt[(c * 16 + c8 * 8 + i) * KV_S + tok] = f2bf(kv[i] * wF);
          KBt[(c * 16 + c8 * 8 + i) * KV_S + tok] = f2bf(kv[i] * wB);
        }
      }
#pragma unroll
      for (int c8 = 0; c8 < 4; ++c8) {
        const uint4 uv = *(const uint4*)(rowp + C_RTV + h * 128 + c * 32 + c8 * 8);
        vt_store8(Vt, KV_S, c * 32 + c8 * 8, tok, uv);
      }
    }
    __syncthreads();
    const bf16_t* Kt = dir == 0 ? KFt : KBt;
    bf16x8 af[4];
#pragma unroll
    for (int ks = 0; ks < 4; ++ks) af[ks] = *(const bf16x8*)(Kt + (dt * 16 + lr) * KV_S + ks * 32 + lq * 8);
#pragma unroll
    for (int et = 0; et < 8; ++et) {
#pragma unroll
      for (int ks = 0; ks < 4; ++ks) {
        const bf16x8 bfr = *(const bf16x8*)(Vt + (et * 16 + lr) * KV_S + ks * 32 + lq * 8);
        acc[et] = __builtin_amdgcn_mfma_f32_16x16x32_bf16(af[ks], bfr, acc[et], 0, 0, 0);
      }
    }
  }
  float* dst = dir == 0 ? dstF : dstB;
#pragma unroll
  for (int et = 0; et < 8; ++et) {
#pragma unroll
    for (int r = 0; r < 4; ++r) dst[(dt * 16 + 4 * lq + r) * 128 + et * 16 + lr] = acc[et][r];
  }
}

__device__ __forceinline__ void phase_ret_scan(const Params& p, int layer) {
  const float* misc = (const float*)(p.ws + OFF_MISC);
  float* rkv = (float*)(p.ws + OFF_RKV);
  const float* rs = (const float*)(p.ws + OFF_RS);
  const int gt = opaque_bid() * 512 + opaque_tid(), gs = gridDim.x * 512;
  for (int idx = gt; idx < 64 * 2048; idx += gs) {
    const int seq = idx >> 11, e4 = (idx & 2047) * 4;
    const int dir = seq & 1, h = (seq >> 1) & 3;
    const float cdec = __expf(misc[16 + layer * 8 + dir * 4 + h] * 128.f);
    float4* base = (float4*)(rkv + (size_t)seq * 32 * 8192 + e4);
    float4 v[32];
#pragma unroll
    for (int s = 0; s < 32; ++s) v[s] = base[(size_t)s * 2048];
    float4 st = *(const float4*)(rs + (size_t)seq * 8192 + e4);
    if (dir == 0) {
#pragma unroll
      for (int s = 0; s < 32; ++s) {
        const float4 t = v[s];
        base[(size_t)s * 2048] = st;
        st.x = fmaf(cdec, st.x, t.x); st.y = fmaf(cdec, st.y, t.y); st.z = fmaf(cdec, st.z, t.z); st.w = fmaf(cdec, st.w, t.w);
      }
    } else {
#pragma unroll
      for (int s = 31; s >= 0; --s) {
        const float4 t = v[s];
        base[(size_t)s * 2048] = st;
        st.x = fmaf(cdec, st.x, t.x); st.y = fmaf(cdec, st.y, t.y); st.z = fmaf(cdec, st.z, t.z); st.w = fmaf(cdec, st.w, t.w);
      }
    }
  }
}

constexpr int RT_KS = 72, RT_VS = 136;
constexpr int RT_OFF_K = 0, RT_OFF_VT = 128 * RT_KS * 2, RT_OFF_SF = RT_OFF_VT + 128 * RT_VS * 2, RT_OFF_SB = RT_OFF_SF + 128 * RT_KS * 2;
__device__ __forceinline__ void ret_out_item(const Params& p, int layer, int h, size_t krow0, int nkc, int iq0,
                                             const float* SF, const float* SB, int clen, char* smem) {
  const bf16_t* P = (const bf16_t*)(p.ws + OFF_P);
  bf16_t* Y = (bf16_t*)(p.ws + OFF_ACT);
  const float* misc = (const float*)(p.ws + OFF_MISC);
  const float lgF2 = misc[16 + layer * 8 + 0 * 4 + h] * 1.4426950408889634f, lgB2 = misc[16 + layer * 8 + 1 * 4 + h] * 1.4426950408889634f;
  const int tid = opaque_tid(), lane = tid & 63, wave = tid >> 6, lr = lane & 15, lq = lane >> 4;
  bf16_t* Ks = (bf16_t*)(smem + RT_OFF_K);
  bf16_t* Vt = (bf16_t*)(smem + RT_OFF_VT);
  bf16_t* SFt = (bf16_t*)(smem + RT_OFF_SF);
  bf16_t* SBt = (bf16_t*)(smem + RT_OFF_SB);
  const int iq = iq0 + wave * 16 + lr;
  const size_t mq = krow0 + iq;
  bf16x8 qf[2];
  {
    const bf16_t* qr = P + mq * INC + C_RTQ + h * 64 + lq * 8;
    qf[0] = *(const bf16x8*)(qr);
    qf[1] = *(const bf16x8*)(qr + 32);
  }
  f32x4 O[8];
#pragma unroll
  for (int i = 0; i < 8; ++i) O[i] = (f32x4){0.f, 0.f, 0.f, 0.f};
  if (SF != nullptr) {
    __syncthreads();
    {
      const int d = tid >> 3, e0 = (tid & 7) * 16;
#pragma unroll
      for (int c4 = 0; c4 < 4; ++c4) {
        const float4 a = *(const float4*)(SF + d * 128 + e0 + c4 * 4);
        const float4 bb = *(const float4*)(SB + d * 128 + e0 + c4 * 4);
        SFt[(e0 + c4 * 4 + 0) * RT_KS + d] = f2bf(a.x); SFt[(e0 + c4 * 4 + 1) * RT_KS + d] = f2bf(a.y);
        SFt[(e0 + c4 * 4 + 2) * RT_KS + d] = f2bf(a.z); SFt[(e0 + c4 * 4 + 3) * RT_KS + d] = f2bf(a.w);
        SBt[(e0 + c4 * 4 + 0) * RT_KS + d] = f2bf(bb.x); SBt[(e0 + c4 * 4 + 1) * RT_KS + d] = f2bf(bb.y);
        SBt[(e0 + c4 * 4 + 2) * RT_KS + d] = f2bf(bb.z); SBt[(e0 + c4 * 4 + 3) * RT_KS + d] = f2bf(bb.w);
      }
    }
    __syncthreads();
    const float cF = __builtin_amdgcn_exp2f(lgF2 * (float)(iq + 1)), cB = __builtin_amdgcn_exp2f(lgB2 * (float)(clen - iq));
#pragma unroll
    for (int ks = 0; ks < 2; ++ks)
#pragma unroll
      for (int et = 0; et < 8; ++et) {
        const bf16x8 sf = *(const bf16x8*)(SFt + (et * 16 + lr) * RT_KS + ks * 32 + lq * 8);
        O[et] = __builtin_amdgcn_mfma_f32_16x16x32_bf16(sf, qf[ks], O[et], 0, 0, 0);
      }
    const float ratio = cF / cB;
#pragma unroll
    for (int et = 0; et < 8; ++et) { O[et][0] *= ratio; O[et][1] *= ratio; O[et][2] *= ratio; O[et][3] *= ratio; }
#pragma unroll
    for (int ks = 0; ks < 2; ++ks)
#pragma unroll
      for (int et = 0; et < 8; ++et) {
        const bf16x8 sb = *(const bf16x8*)(SBt + (et * 16 + lr) * RT_KS + ks * 32 + lq * 8);
        O[et] = __builtin_amdgcn_mfma_f32_16x16x32_bf16(sb, qf[ks], O[et], 0, 0, 0);
      }
#pragma unroll
    for (int et = 0; et < 8; ++et) { O[et][0] *= cB; O[et][1] *= cB; O[et][2] *= cB; O[et][3] *= cB; }
  }
#pragma unroll 1
  for (int kc = 0; kc < nkc; ++kc) {
    __syncthreads();
    {
      const int key = tid >> 2, c = tid & 3;
      const bf16_t* rowp = P + (krow0 + kc * 128 + key) * INC;
      const uint4 k0 = *(const uint4*)(rowp + C_RTK + h * 64 + c * 16), k1 = *(const uint4*)(rowp + C_RTK + h * 64 + c * 16 + 8);
      *(uint4*)(Ks + key * RT_KS + c * 16) = k0;
      *(uint4*)(Ks + key * RT_KS + c * 16 + 8) = k1;
#pragma unroll
      for (int c8 = 0; c8 < 4; ++c8) {
        const uint4 uv = *(const uint4*)(rowp + C_RTV + h * 128 + c * 32 + c8 * 8);
        vt_store8(Vt, RT_VS, c * 32 + c8 * 8, key, uv);
      }
    }
    __syncthreads();
    f32x4 S[8];
#pragma unroll
    for (int kt = 0; kt < 8; ++kt) {
      const bf16x8 ka = *(const bf16x8*)(Ks + (kt * 16 + lr) * RT_KS + lq * 8);
      const bf16x8 kb = *(const bf16x8*)(Ks + (kt * 16 + lr) * RT_KS + 32 + lq * 8);
      const f32x4 a = __builtin_amdgcn_mfma_f32_16x16x32_bf16(ka, qf[0], (f32x4){0.f, 0.f, 0.f, 0.f}, 0, 0, 0);
      S[kt] = __builtin_amdgcn_mfma_f32_16x16x32_bf16(kb, qf[1], a, 0, 0, 0);
    }
#pragma unroll
    for (int kt = 0; kt < 8; ++kt) {
#pragma unroll
      for (int r = 0; r < 4; ++r) {
        const int df = iq - (kc * 128 + kt * 16 + 4 * lq + r);
        const float fdf = (float)df;
        float coef = 0.f;
        if (df >= 0) coef += __builtin_amdgcn_exp2f(lgF2 * fdf);
        if (df <= 0) coef += __builtin_amdgcn_exp2f(-lgB2 * fdf);
        S[kt][r] *= coef;
      }
    }
#pragma unroll
    for (int g = 0; g < 4; ++g) {
      union { unsigned u[4]; bf16x8 v; } pf;
      pf.u[0] = cvt_pk_bf16(S[2 * g][0], S[2 * g][1]); pf.u[1] = cvt_pk_bf16(S[2 * g][2], S[2 * g][3]);
      pf.u[2] = cvt_pk_bf16(S[2 * g + 1][0], S[2 * g + 1][1]); pf.u[3] = cvt_pk_bf16(S[2 * g + 1][2], S[2 * g + 1][3]);
#pragma unroll
      for (int et = 0; et < 8; ++et) {
        union { uint2 h2[2]; bf16x8 v; } vf;
        vf.h2[0] = *(const uint2*)(Vt + (et * 16 + lr) * RT_VS + 32 * g + 4 * lq);
        vf.h2[1] = *(const uint2*)(Vt + (et * 16 + lr) * RT_VS + 32 * g + 16 + 4 * lq);
        O[et] = __builtin_amdgcn_mfma_f32_16x16x32_bf16(vf.v, pf.v, O[et], 0, 0, 0);
      }
    }
  }
  float ss = 0.f;
#pragma unroll
  for (int et = 0; et < 8; ++et) { ss = fmaf(O[et][0], O[et][0], ss); ss = fmaf(O[et][1], O[et][1], ss); ss = fmaf(O[et][2], O[et][2], ss); ss = fmaf(O[et][3], O[et][3], ss); }
  ss += __shfl_xor(ss, 16); ss += __shfl_xor(ss, 32);
  const float rr = rsqrtf(ss * (1.f / 128.f) + EPS);
  const bf16_t* gp = P + mq * INC + C_RTG + h * 128;
  bf16_t* dst = Y + mq * 1024 + Y_RT + h * 128;
#pragma unroll
  for (int et = 0; et < 8; ++et) {
    const int e = et * 16 + 4 * lq;
    const uint2 gu = *(const uint2*)(gp + e);
    uint2 ov;
    ov.x = pack2(O[et][0] * rr * siluf(lo16(gu.x)), O[et][1] * rr * siluf(hi16(gu.x)));
    ov.y = pack2(O[et][2] * rr * siluf(lo16(gu.y)), O[et][3] * rr * siluf(hi16(gu.y)));
    *(uint2*)(dst + e) = ov;
  }
}

__device__ __forceinline__ void uv_convert_item(const Params& p, int item) {
  char* ws = p.ws;
  const int tid = opaque_tid();
  const int lane = tid & 63, l = lane & 31, half = lane >> 5, wave = tid >> 6;
#pragma unroll 1
  for (int it = 0; it < 16; ++it) {
    const int row = item * 256 + (wave * 16 + it) * 2 + half;
    const bool isv = row >= 2 * NEXP;
    const int rr = isv ? row - 2 * NEXP : row;
    const float* srow = (isv ? p.peer_v : p.peer_u) + (size_t)rr * 1024;
    float4 v[8];
    float mx = 0.f;
#pragma unroll
    for (int j = 0; j < 8; ++j) {
      v[j] = ((const float4*)srow)[l + 32 * j];
      mx = fmaxf(mx, fmaxf(fmaxf(fabsf(v[j].x), fabsf(v[j].y)), fmaxf(fabsf(v[j].z), fabsf(v[j].w))));
    }
#pragma unroll
    for (int o = 1; o < 32; o <<= 1) mx = fmaxf(mx, __shfl_xor(mx, o));
    const float scale = mx > 0.f ? mx * (1.f / 7.5f) : 1.f;
    const float inv = 1.f / scale;
    if (!isv) {
      unsigned w[6] = {0u, 0u, 0u, 0u, 0u, 0u};
#pragma unroll
      for (int k = 0; k < 32; ++k) {
        const float xv = (k & 3) == 0 ? v[k >> 2].x : (k & 3) == 1 ? v[k >> 2].y : (k & 3) == 2 ? v[k >> 2].z : v[k >> 2].w;
        const float a = fminf(fabsf(xv) * inv, 7.5f);
        float c;
        if (a < 2.f) c = rintf(a * 8.f);
        else if (a < 4.f) c = 16.f + rintf((a - 2.f) * 4.f);
        else c = 24.f + rintf((a - 4.f) * 2.f);
        unsigned code = (unsigned)c;
        code = code > 31u ? 31u : code;
        code |= (xv < 0.f) ? 32u : 0u;
        const int bit = 6 * k, wd = bit >> 5, sh = bit & 31;
        w[wd] |= code << sh;
        if (sh > 26) w[wd + 1] |= code >> (32 - sh);
      }
      char* drow = ws + OFF_U + (size_t)rr * RECB + l * 24;
      *(uint2*)(drow) = make_uint2(w[0], w[1]);
      *(uint2*)(drow + 8) = make_uint2(w[2], w[3]);
      *(uint2*)(drow + 16) = make_uint2(w[4], w[5]);
      if (l == 0) ((float*)(ws + OFF_USC))[rr] = scale;
    } else {
      const float scale4 = mx > 0.f ? mx * (1.f / 6.f) : 1.f;
      const float inv4 = 1.f / scale4;
      unsigned w[4] = {0u, 0u, 0u, 0u};
#pragma unroll
      for (int k = 0; k < 32; ++k) {
        const float xv = (k & 3) == 0 ? v[k >> 2].x : (k & 3) == 1 ? v[k >> 2].y : (k & 3) == 2 ? v[k >> 2].z : v[k >> 2].w;
        const float a = fminf(fabsf(xv) * inv4, 6.f);
        float c;
        if (a < 2.f) c = rintf(a * 2.f);
        else if (a < 4.f) c = 4.f + rintf(a - 2.f);
        else c = 6.f + rintf((a - 4.f) * 0.5f);
        unsigned code = (unsigned)c;
        code = code > 7u ? 7u : code;
        code |= (xv < 0.f) ? 8u : 0u;
        w[k >> 3] |= code << (4 * (k & 7));
      }
      char* drow = ws + OFF_U + (size_t)rr * RECB + ROWB + l * 16;
      *(uint4*)(drow) = make_uint4(w[0], w[1], w[2], w[3]);
      if (l == 0) ((float*)(ws + OFF_VSC))[rr] = scale4;
    }
  }
}

__device__ __forceinline__ void phase_mix1(const Params& p, int layer, char* smem, int slot = 0) {
  unsigned* ctr = (unsigned*)(p.ws + OFF_CTL) + (layer * 4 + slot);
  const bool nc = layer == 0;
  const int n_dl = 512, n_dc = nc ? 32 : 0, n_nl = 2048, n_ncx = nc ? 64 : 0, n_kv = 1024, n_cs = 32;
  const int total = n_dl + n_dc + n_nl + n_ncx + n_kv + n_cs;
  float* rkv = (float*)(p.ws + OFF_RKV);
  float* rs = (float*)(p.ws + OFF_RS);
  for (;;) {
    int it = next_item(ctr, smem);
    if (it >= total) break;
    if (it < n_dl) { diff_item(p, layer, false, it, smem); continue; } it -= n_dl;
    if (it < n_dc) { diff_item(p, layer, true, it, smem); continue; } it -= n_dc;
    if (it < n_nl) { na_latent_item(p, layer, it, smem); continue; } it -= n_nl;
    if (it < n_ncx) { na_ctx_item(p, it, smem); continue; } it -= n_ncx;
    if (it < n_kv) {
      const int bh = it >> 5, n = it & 31, b = bh >> 2, h = bh & 3;
      ret_kv_item(p, layer, h, (size_t)b * 4096 + n * 128, 128,
                  rkv + ((size_t)(bh * 2 + 0) * 32 + n) * 8192, rkv + ((size_t)(bh * 2 + 1) * 32 + n) * 8192, smem);
      continue;
    }
    it -= n_kv;
    {
      const int bh = it, b = bh >> 2, h = bh & 3;
      ret_kv_item(p, layer, h, (size_t)NLAT + b * 256, 256, rs + (size_t)(bh * 2 + 0) * 8192, rs + (size_t)(bh * 2 + 1) * 8192, smem);
    }
  }
}

__device__ __forceinline__ void phase_mix2(const Params& p, int layer, char* smem, int slot = 1) {
  unsigned* ctr = (unsigned*)(p.ws + OFF_CTL) + (layer * 4 + slot);
  const int n_l = 1024, n_c = layer == 0 ? 64 : 0;
  const float* rkv = (const float*)(p.ws + OFF_RKV);
  for (;;) {
    int it = next_item(ctr, smem);
    if (it >= n_l + n_c) break;
    if (it < n_l) {
      const int bh = it >> 5, n = it & 31, b = bh >> 2, h = bh & 3;
      ret_out_item(p, layer, h, (size_t)b * 4096 + n * 128, 1, 0,
                   rkv + ((size_t)(bh * 2 + 0) * 32 + n) * 8192, rkv + ((size_t)(bh * 2 + 1) * 32 + n) * 8192, 128, smem);
    } else {
      it -= n_l;
      const int bh = it >> 1, half = it & 1, b = bh >> 2, h = bh & 3;
      ret_out_item(p, layer, h, (size_t)NLAT + b * 256, 2, half * 128, nullptr, nullptr, 256, smem);
    }
  }
}

typedef float f32x2 __attribute__((ext_vector_type(2)));
__device__ __forceinline__ unsigned sortable_key(float f, int idx) {
  const unsigned b = __float_as_uint(f);
  const unsigned k = b ^ ((unsigned)((int)b >> 31) | 0x80000000u);
  return (k & ~127u) | (unsigned)(127 - idx);
}
__device__ __forceinline__ float key_value(unsigned k) {
  k &= ~127u;
  const unsigned b = (k & 0x80000000u) ? (k ^ 0x80000000u) : ~k;
  return __uint_as_float(b);
}
#define FP8DOT(acc, H, off, W) { const f32x2 _a = __builtin_amdgcn_cvt_pk_f32_fp8((int)(W), false), _b = __builtin_amdgcn_cvt_pk_f32_fp8((int)(W), true); \
  acc = fmaf(H[(off) + 0], _a.x, acc); acc = fmaf(H[(off) + 1], _a.y, acc); acc = fmaf(H[(off) + 2], _b.x, acc); acc = fmaf(H[(off) + 3], _b.y, acc); }
#define FP8AXPY(O, off, P, W) { const f32x2 _a = __builtin_amdgcn_cvt_pk_f32_fp8((int)(W), false), _b = __builtin_amdgcn_cvt_pk_f32_fp8((int)(W), true); \
  O[(off) + 0] = fmaf(P, _a.x, O[(off) + 0]); O[(off) + 1] = fmaf(P, _a.y, O[(off) + 1]); O[(off) + 2] = fmaf(P, _b.x, O[(off) + 2]); O[(off) + 3] = fmaf(P, _b.y, O[(off) + 3]); }

__device__ __forceinline__ float gelu_erf(float a) {
  const float x = fabsf(a) * 0.70710678118654752f;
  const float t = __builtin_amdgcn_rcpf(fmaf(0.3275911f, x, 1.f));
  float pl = fmaf(1.061405429f, t, -1.453152027f);
  pl = fmaf(pl, t, 1.421413741f); pl = fmaf(pl, t, -0.284496736f); pl = fmaf(pl, t, 0.254829592f);
  const float y = 1.f - pl * t * __builtin_amdgcn_exp2f(-x * x * 1.4426950408889634f);
  const float er = a < 0.f ? -y : y;
  return 0.5f * a * (1.f + er);
}
constexpr int PE_SVS = 132;
constexpr int PE_OFF_SV = 0;
constexpr int PE_OFF_TV = 8 * 16 * PE_SVS * 4;
constexpr int PE_OFF_TI = PE_OFF_TV + 16 * 16 * 16 * 4;
constexpr int PE_OFF_EX = PE_OFF_TI + 16 * 16 * 16 * 4;
constexpr int PE_OFF_GT = PE_OFF_EX + 2 * 16 * 128 * 4;
constexpr int PE_OFF_SU = PE_OFF_GT + 2 * 16 * 128 * 4;
constexpr int PE_OFF_CN = PE_OFF_SU + 2 * 16 * 128 * 4;
constexpr int PE_OFF_CT = PE_OFF_CN + 8 * 16 * 4;
constexpr int PE_OFF_TQ = PE_OFF_CT + 64 * 4;
static_assert(PE_OFF_TQ + 16 <= LDS_BCAST, "PEER LDS map overflows");
#define WAVE_LDS_FENCE() asm volatile("s_waitcnt lgkmcnt(0)" ::: "memory")

__device__ __forceinline__ void peer_select_head(const Params& p, int layer, char* smem, int tok0, int hd, int sw, int buf,
                                                 int lane) {
  const bf16_t* Q = (const bf16_t*)(p.ws + OFF_P);
  const bf16_t* SK = (const bf16_t*)(p.ws + OFF_SUBK) + (size_t)layer * 262144;
  const int lr = lane & 15, lq = lane >> 4;
  unsigned* SV = (unsigned*)(smem + PE_OFF_SV) + sw * 16 * PE_SVS;
  float* TV = (float*)(smem + PE_OFF_TV);
  int* TI = (int*)(smem + PE_OFF_TI);
  int* EX = (int*)(smem + PE_OFF_EX) + buf * 16 * 128;
  float* GT = (float*)(smem + PE_OFF_GT) + buf * 16 * 128;
  int* CN = (int*)(smem + PE_OFF_CN) + sw * 16;
  float* SU = (float*)(smem + PE_OFF_SU) + buf * 16 * 128;
  const float* USC = (const float*)(p.ws + OFF_USC) + layer * NEXP;
  const float* VSC = (const float*)(p.ws + OFF_VSC) + layer * NEXP;
#pragma unroll 1
  for (int pp = 0; pp < 2; ++pp) {
    bf16x8 af[4];
    const bf16_t* qrow = Q + (size_t)(tok0 + lr) * 2048 + hd * 256 + pp * 128;
#pragma unroll
    for (int ks = 0; ks < 4; ++ks) af[ks] = *(const bf16x8*)(qrow + ks * 32 + lq * 8);
    const bf16_t* skb = SK + (size_t)((hd * 2 + pp) * 128) * 128;
    f32x4 acc[8];
    {
      bf16x8 bfr[8][4];
#pragma unroll
      for (int nt = 0; nt < 8; ++nt)
#pragma unroll
        for (int ks = 0; ks < 4; ++ks)
          bfr[nt][ks] = *(const bf16x8*)(skb + (size_t)(nt * 16 + lr) * 128 + ks * 32 + lq * 8);
#pragma unroll
      for (int nt = 0; nt < 8; ++nt) {
        f32x4 a = (f32x4){0.f, 0.f, 0.f, 0.f};
#pragma unroll
        for (int ks = 0; ks < 4; ++ks) a = __builtin_amdgcn_mfma_f32_16x16x32_bf16(af[ks], bfr[nt][ks], a, 0, 0, 0);
        acc[nt] = a;
      }
    }
#pragma unroll
    for (int i = 0; i < 9; ++i) { const int q4 = lane + 64 * i; if (q4 < 16 * PE_SVS / 4) ((uint4*)SV)[q4] = make_uint4(0u, 0u, 0u, 0u); }
    WAVE_LDS_FENCE();
#pragma unroll
    for (int r = 0; r < 4; ++r) {
      const int tk = 4 * lq + r;
      unsigned k[8];
#pragma unroll
      for (int nt = 0; nt < 8; ++nt) k[nt] = sortable_key(acc[nt][r], nt * 16 + lr);
      unsigned m1 = max(k[0], k[1]), m2 = min(k[0], k[1]);
#pragma unroll
      for (int nt = 2; nt < 8; ++nt) { m2 = max(m2, min(m1, k[nt])); m1 = max(m1, k[nt]); }
      const unsigned Ta = row16_min_u32(m1);
      const unsigned Tb = min(row16_kth_largest<11>(m1), row16_kth_largest<5>(m2));
      const unsigned T = max(Ta, Tb);
      int pos = 0;
#pragma unroll
      for (int nt = 0; nt < 8; ++nt) {
        const bool sel = k[nt] >= T;
        const unsigned long long bal = __ballot(sel);
        const unsigned grp16 = (unsigned)(bal >> (16 * lq)) & 0xffffu;
        const int below = __popc(grp16 & ((1u << lr) - 1u));
        if (sel) SV[tk * PE_SVS + pos + below] = k[nt];
        pos += __popc(grp16);
      }
      if (lr == 0) CN[tk] = pos;
    }
    WAVE_LDS_FENCE();
#pragma unroll 1
    for (int pass = 0; pass < 4; ++pass) {
      const int tk = pass * 4 + lq;
      const int cnt = CN[tk];
      const unsigned* row = SV + tk * PE_SVS;
      int cm = cnt;
      cm = max(cm, __shfl_xor(cm, 16)); cm = max(cm, __shfl_xor(cm, 32));
      const int cmax = __builtin_amdgcn_readfirstlane(cm);
      const int nblk = (cmax + 15) >> 4;
#pragma unroll 1
      for (int rd = 0; rd < nblk; ++rd) {
        const int j = rd * 16 + lr;
        const unsigned my = row[j];
        int rank = 0;
#pragma unroll 1
        for (int b4 = 0; b4 < nblk; ++b4) {
          const uint4 v0 = *(const uint4*)(row + b4 * 16), v1 = *(const uint4*)(row + b4 * 16 + 4);
          const uint4 v2 = *(const uint4*)(row + b4 * 16 + 8), v3 = *(const uint4*)(row + b4 * 16 + 12);
          rank += (v0.x > my) ? 1 : 0; rank += (v0.y > my) ? 1 : 0; rank += (v0.z > my) ? 1 : 0; rank += (v0.w > my) ? 1 : 0;
          rank += (v1.x > my) ? 1 : 0; rank += (v1.y > my) ? 1 : 0; rank += (v1.z > my) ? 1 : 0; rank += (v1.w > my) ? 1 : 0;
          rank += (v2.x > my) ? 1 : 0; rank += (v2.y > my) ? 1 : 0; rank += (v2.z > my) ? 1 : 0; rank += (v2.w > my) ? 1 : 0;
          rank += (v3.x > my) ? 1 : 0; rank += (v3.y > my) ? 1 : 0; rank += (v3.z > my) ? 1 : 0; rank += (v3.w > my) ? 1 : 0;
        }
        if (j < cnt && rank < 16) {
          TV[(tk * 16 + hd * 2 + pp) * 16 + rank] = key_value(my);
          TI[(tk * 16 + hd * 2 + pp) * 16 + rank] = 127 - (int)(my & 127u);
        }
      }
    }
    WAVE_LDS_FENCE();
  }
  {
    const int cab = ((const int*)(smem + PE_OFF_CT))[lane];
    const int cand_a = cab >> 4, cand_b = cab & 15;
    unsigned* CWt = SV;
    float vals[16];
#pragma unroll
    for (int tk = 0; tk < 16; ++tk) {
      float val = 0.f;
      unsigned key = 0u;
      if (cand_a >= 0) {
        val = TV[(tk * 16 + hd * 2 + 0) * 16 + cand_a] + TV[(tk * 16 + hd * 2 + 1) * 16 + cand_b];
        const unsigned bb = __float_as_uint(val);
        key = ((bb ^ ((unsigned)((int)bb >> 31) | 0x80000000u)) & ~63u) | (unsigned)(63 - lane);
      }
      vals[tk] = val;
      CWt[tk * 64 + lane] = key;
    }
    WAVE_LDS_FENCE();
#pragma unroll
    for (int tk = 0; tk < 16; ++tk) {
      const unsigned key = CWt[tk * 64 + lane];
      int rank = 0;
#pragma unroll
      for (int i4 = 0; i4 < 13; ++i4) {
        const uint4 v = *(const uint4*)(CWt + tk * 64 + i4 * 4);
        rank += (v.x > key) ? 1 : 0; rank += (v.y > key) ? 1 : 0; rank += (v.z > key) ? 1 : 0; rank += (v.w > key) ? 1 : 0;
      }
      if (cand_a >= 0 && rank < 16) {
        GT[tk * 128 + hd * 16 + rank] = vals[tk];
        EX[tk * 128 + hd * 16 + rank] = TI[(tk * 16 + hd * 2 + 0) * 16 + cand_a] * 128 + TI[(tk * 16 + hd * 2 + 1) * 16 + cand_b];
      }
    }
    WAVE_LDS_FENCE();
#pragma unroll
    for (int pass = 0; pass < 4; ++pass) {
      const int tk = pass * 4 + lq;
      const float g = GT[tk * 128 + hd * 16 + lr];
      const float mx = GT[tk * 128 + hd * 16];
      const float ev = __expf(g - mx);
      float s = ev;
      s += __shfl_xor(s, 1); s += __shfl_xor(s, 2); s += __shfl_xor(s, 4); s += __shfl_xor(s, 8);
      const int ex = EX[tk * 128 + hd * 16 + lr];
      GT[tk * 128 + hd * 16 + lr] = (ev / s) * VSC[ex];
      SU[tk * 128 + hd * 16 + lr] = USC[ex];
    }
    WAVE_LDS_FENCE();
  }
}

typedef float f32x32 __attribute__((ext_vector_type(32)));
typedef unsigned u32x6 __attribute__((ext_vector_type(6)));
#define FP4_AXPY8(O, off, P, W) {                                                                    \
  const f32x2 _q0 = __builtin_amdgcn_cvt_scalef32_pk_f32_fp4((W), 1.0f, 0), _q1 = __builtin_amdgcn_cvt_scalef32_pk_f32_fp4((W), 1.0f, 1); \
  const f32x2 _q2 = __builtin_amdgcn_cvt_scalef32_pk_f32_fp4((W), 1.0f, 2), _q3 = __builtin_amdgcn_cvt_scalef32_pk_f32_fp4((W), 1.0f, 3); \
  O[(off) + 0] = fmaf(P, _q0.x, O[(off) + 0]); O[(off) + 1] = fmaf(P, _q0.y, O[(off) + 1]);          \
  O[(off) + 2] = fmaf(P, _q1.x, O[(off) + 2]); O[(off) + 3] = fmaf(P, _q1.y, O[(off) + 3]);          \
  O[(off) + 4] = fmaf(P, _q2.x, O[(off) + 4]); O[(off) + 5] = fmaf(P, _q2.y, O[(off) + 5]);          \
  O[(off) + 6] = fmaf(P, _q3.x, O[(off) + 6]); O[(off) + 7] = fmaf(P, _q3.y, O[(off) + 7]); }
struct Fp6Row { uint4 a; uint2 b; };
typedef __bf16 bf16x32_t __attribute__((ext_vector_type(32)));
__device__ __forceinline__ bf16x32_t fp6_decode_bf16(const Fp6Row& r) {
  u32x6 w; w[0] = r.a.x; w[1] = r.a.y; w[2] = r.a.z; w[3] = r.a.w; w[4] = r.b.x; w[5] = r.b.y;
  return __builtin_amdgcn_cvt_scalef32_pk32_bf16_fp6(w, 1.0f);
}
__device__ __forceinline__ f32x32 fp6_decode(const Fp6Row& r) {
  u32x6 w; w[0] = r.a.x; w[1] = r.a.y; w[2] = r.a.z; w[3] = r.a.w; w[4] = r.b.x; w[5] = r.b.y;
  return __builtin_amdgcn_cvt_scalef32_pk32_f32_fp6(w, 1.0f);
}
__device__ __forceinline__ void peer_gather_token(const Params& p, int layer, char* smem, int tok, int tl, int buf, int lane, bool dowrite) {
  const bf16_t* H2 = (const bf16_t*)(p.ws + OFF_ACT);
  const char* U6 = p.ws + OFF_U + (size_t)layer * NEXP * RECB;
  const float* mod = (const float*)(p.ws + OFF_MOD) + (size_t)layer * 9 * 6144;
  const int* EX = (const int*)(smem + PE_OFF_EX) + buf * 16 * 128 + tl * 128;
  const float* GT = (const float*)(smem + PE_OFF_GT) + buf * 16 * 128 + tl * 128;
  const float* SU = (const float*)(smem + PE_OFF_SU) + buf * 16 * 128 + tl * 128;
  const int l = lane & 31, hf = lane >> 5;
  float acc[32];
  bf16x2_t hvp[16];
  {
    const bf16_t* hr = H2 + (size_t)tok * 1024;
#pragma unroll
    for (int j = 0; j < 8; ++j) {
      const uint2 u = *(const uint2*)(hr + (l + 32 * j) * 4);
      hvp[2 * j] = __builtin_bit_cast(bf16x2_t, u.x); hvp[2 * j + 1] = __builtin_bit_cast(bf16x2_t, u.y);
    }
  }
#pragma unroll
  for (int i = 0; i < 32; ++i) acc[i] = 0.f;
  int one = 1;
  asm volatile("" : "+s"(one));
#define PE_LOAD(UU, VV, PI)                                                           \
  {                                                                                   \
    const int ex = EX[2 * (PI) + hf];                                                 \
    const char* up = U6 + (size_t)ex * RECB + l * 24;                                 \
    UU.a = *(const uint4*)up; UU.b = *(const uint2*)(up + 16);                        \
    VV = *(const uint4*)(U6 + (size_t)ex * RECB + ROWB + l * 16);                     \
  }
#define PE_USE(UU, VV, PI)                                                            \
  _Pragma("unroll 1") for (int rep_ = 0; rep_ < one; ++rep_) {                        \
    const bf16x32_t du = fp6_decode_bf16(UU);                                         \
    float d0 = 0.f, d1 = 0.f, d2 = 0.f, d3 = 0.f;                                     \
    _Pragma("unroll") for (int k = 0; k < 16; k += 4) {                               \
      d0 = __builtin_amdgcn_fdot2_f32_bf16((bf16x2_t){du[2 * k], du[2 * k + 1]}, hvp[k], d0, false);             \
      d1 = __builtin_amdgcn_fdot2_f32_bf16((bf16x2_t){du[2 * k + 2], du[2 * k + 3]}, hvp[k + 1], d1, false);     \
      d2 = __builtin_amdgcn_fdot2_f32_bf16((bf16x2_t){du[2 * k + 4], du[2 * k + 5]}, hvp[k + 2], d2, false);     \
      d3 = __builtin_amdgcn_fdot2_f32_bf16((bf16x2_t){du[2 * k + 6], du[2 * k + 7]}, hvp[k + 3], d3, false);     \
    }                                                                                 \
    const unsigned ir = __float_as_uint(row16_sum((d0 + d1) + (d2 + d3)));            \
    const auto sw_ = __builtin_amdgcn_permlane16_swap(ir, ir, false, false);            \
    const float d = (__uint_as_float(sw_[0]) + __uint_as_float(sw_[1])) * SU[2 * (PI) + hf];     \
    const float w = GT[2 * (PI) + hf] * gelu_erf(d);                                  \
    FP4_AXPY8(acc, 0, w, VV.x) FP4_AXPY8(acc, 8, w, VV.y) FP4_AXPY8(acc, 16, w, VV.z) FP4_AXPY8(acc, 24, w, VV.w) \
  }
  Fp6Row u0, u1, u2, u3, u4;
  uint4 v0, v1, v2, v3, v4;
  PE_LOAD(u0, v0, 0) PE_LOAD(u1, v1, 1) PE_LOAD(u2, v2, 2) PE_LOAD(u3, v3, 3) PE_LOAD(u4, v4, 4)
#pragma unroll 1
  for (int pi = 0; pi < 55; pi += 5) {
    PE_USE(u0, v0, pi) PE_LOAD(u0, v0, pi + 5)
    PE_USE(u1, v1, pi + 1) PE_LOAD(u1, v1, pi + 6)
    PE_USE(u2, v2, pi + 2) PE_LOAD(u2, v2, pi + 7)
    PE_USE(u3, v3, pi + 3) PE_LOAD(u3, v3, pi + 8)
    PE_USE(u4, v4, pi + 4) PE_LOAD(u4, v4, pi + 9)
  }
  PE_USE(u0, v0, 55) PE_LOAD(u0, v0, 60)
  PE_USE(u1, v1, 56) PE_LOAD(u1, v1, 61)
  PE_USE(u2, v2, 57) PE_LOAD(u2, v2, 62)
  PE_USE(u3, v3, 58) PE_LOAD(u3, v3, 63)
  PE_USE(u4, v4, 59)
  PE_USE(u0, v0, 60) PE_USE(u1, v1, 61) PE_USE(u2, v2, 62) PE_USE(u3, v3, 63)
#pragma unroll
  for (int k = 0; k < 32; ++k) acc[k] += __shfl_xor(acc[k], 32);
  const int b = tok < NLAT ? (tok >> 12) : 8;
  float* xr = tok < NLAT ? p.out + (size_t)tok * 1024 : (float*)(p.ws + OFF_CTXB) + (size_t)(tok - NLAT) * 1024;
  const float* gate = mod + (size_t)b * 6144 + 5 * 1024;
  float4 xn[4];
  float ss = 0.f;
#pragma unroll
  for (int jj = 0; jj < 4; ++jj) {
    const int c = (l + 32 * (4 * hf + jj)) * 4;
    const float4 xv = *(const float4*)(xr + c);
    const float4 gv = *(const float4*)(gate + c);
    const float a0 = hf ? acc[16 + 4 * jj + 0] : acc[4 * jj + 0], a1 = hf ? acc[16 + 4 * jj + 1] : acc[4 * jj + 1];
    const float a2 = hf ? acc[16 + 4 * jj + 2] : acc[4 * jj + 2], a3 = hf ? acc[16 + 4 * jj + 3] : acc[4 * jj + 3];
    xn[jj].x = xv.x + gv.x * a0; xn[jj].y = xv.y + gv.y * a1; xn[jj].z = xv.z + gv.z * a2; xn[jj].w = xv.w + gv.w * a3;
    ss += xn[jj].x * xn[jj].x + xn[jj].y * xn[jj].y + xn[jj].z * xn[jj].z + xn[jj].w * xn[jj].w;
  }
  ss = wave_sum(ss);
  const float rinv = rsqrtf(ss * (1.f / 1024.f) + EPS);
  if (layer == 0) {
    const float* mod1 = (const float*)(p.ws + OFF_MOD) + (size_t)9 * 6144 + (size_t)b * 6144;
    const float* g1 = p.norm1_g + 1024;
    bf16_t* act = (bf16_t*)(p.ws + OFF_ACT) + (size_t)tok * 1024;
#pragma unroll
    for (int jj = 0; jj < 4; ++jj) {
      const int c = (l + 32 * (4 * hf + jj)) * 4;
      if (dowrite) *(float4*)(xr + c) = xn[jj]; else asm volatile("" :: "v"(xn[jj].x), "v"(xn[jj].y), "v"(xn[jj].z), "v"(xn[jj].w));
      const float4 gg4 = *(const float4*)(g1 + c);
      const float4 sh = *(const float4*)(mod1 + c);
      const float4 sc = *(const float4*)(mod1 + 1024 + c);
      uint2 o;
      o.x = pack2h(xn[jj].x * rinv * gg4.x * (1.f + sc.x) + sh.x, xn[jj].y * rinv * gg4.y * (1.f + sc.y) + sh.y);
      o.y = pack2h(xn[jj].z * rinv * gg4.z * (1.f + sc.z) + sh.z, xn[jj].w * rinv * gg4.w * (1.f + sc.w) + sh.w);
      if (dowrite) *(uint2*)(act + c) = o; else asm volatile("" :: "v"(o.x), "v"(o.y));
    }
  } else {
#pragma unroll
    for (int jj = 0; jj < 4; ++jj) {
      const int c = (l + 32 * (4 * hf + jj)) * 4;
      const float4 gg4 = *(const float4*)(p.final_g + c);
      float4 o;
      o.x = xn[jj].x * rinv * gg4.x; o.y = xn[jj].y * rinv * gg4.y; o.z = xn[jj].z * rinv * gg4.z; o.w = xn[jj].w * rinv * gg4.w;
      if (dowrite) *(float4*)(xr + c) = o; else asm volatile("" :: "v"(o.x), "v"(o.y), "v"(o.z), "v"(o.w));
    }
  }
}

__device__ __forceinline__ void phase_peer(const Params& p, int layer, char* smem, int ntok, bool dowrite = true) {
  const int tid = opaque_tid(), lane = tid & 63, wave = __builtin_amdgcn_readfirstlane(tid >> 6);
  __syncthreads();
  if (tid < 64) {
    int cab = -1, c = 0;
    for (int a = 0; a < 16; ++a)
      for (int bb = 0; bb < 16; ++bb)
        if ((a + 1) * (bb + 1) <= 16) { if (c == tid) cab = a * 16 + bb; ++c; }
    ((int*)(smem + PE_OFF_CT))[tid] = cab;
  }
  const int ngroups = ntok / 16, G = gridDim.x, g0 = opaque_bid();
  if (tid == 0) { ((int*)(smem + PE_OFF_TQ))[0] = 0; ((int*)(smem + PE_OFF_TQ))[1] = 0; }
  __syncthreads();
  const int R = ngroups / G, rem = ngroups % G;
  const bool split = rem > 0 && 2 * rem <= G;
#define PE_ITEM(r_, grp_, off_, cnt_)                                                                  \
  { grp_ = 0; off_ = 0; cnt_ = 0;                                                                      \
    if ((r_) >= 0 && (r_) < R) { grp_ = g0 + (r_) * G; cnt_ = 16; }                                    \
    else if ((r_) == R) {                                                                              \
      if (split) { if (g0 < 2 * rem) { grp_ = R * G + (g0 >> 1); off_ = (g0 & 1) * 8; cnt_ = 8; } }    \
      else if (g0 < rem) { grp_ = R * G + g0; cnt_ = 16; }                                             \
    } }
#pragma unroll 1
  for (int r = -1;; ++r) {
    int cur, coff, ngat, nxt, noff, ncnt;
    PE_ITEM(r, cur, coff, ngat)
    PE_ITEM(r + 1, nxt, noff, ncnt)
    const int nsel = ncnt > 0 ? 8 : 0;
    if (ngat + nsel == 0) break;
    const int b = r & 1, gper = ngat >> 3, sfirst = (wave & 1) == 0;
#pragma unroll 1
    for (int st = 0; st < 3; ++st) {
      const int slot = sfirst ? st : (st + 1) % 3;
      if (slot == 0) { if (nsel) peer_select_head(p, layer, smem, nxt * 16, wave, wave, b ^ 1, lane); }
      else if (slot - 1 < gper) {
        const int idx = wave * gper + slot - 1;
        peer_gather_token(p, layer, smem, cur * 16 + coff + idx, coff + idx, b, lane, dowrite);
      }
    }
    __syncthreads();
  }
}

template <int layer>
__device__ __forceinline__ void layer_body(const Params& p, char* smem, const XcdBarrier& xb) {
  constexpr bool nc = layer == 0;
  const float* xin = layer == 0 ? p.x : (const float*)p.out;
  if (layer == 0) {
    phase_norm(p, layer, 0, xin, NTOK);
    xcd_barrier(xb);
  }
#if REP_GEMM
  gemm_phase2<EPI_INPROJ>(p, layer, smem, (const bf16_t*)(p.ws + OFF_ACT), (const bf16_t*)(p.ws + OFF_WIN) + (size_t)layer * 3072 * 1024, NTOK, 3072, nullptr);
  xcd_barrier(xb);
#endif
  gemm_phase2<EPI_INPROJ>(p, layer, smem, (const bf16_t*)(p.ws + OFF_ACT), (const bf16_t*)(p.ws + OFF_WIN) + (size_t)layer * 3072 * 1024, NTOK, 3072, nullptr);
  xcd_barrier(xb);
#if REP_MIX1
  phase_mix1(p, layer, smem, 2);
  xcd_barrier(xb);
#endif
  phase_mix1(p, layer, smem);
  xcd_barrier(xb);
  phase_ret_scan(p, layer);
  xcd_barrier(xb);
#if REP_MIX2
  phase_mix2(p, layer, smem, 3);
  xcd_barrier(xb);
#endif
  phase_mix2(p, layer, smem);
  xcd_barrier(xb);
  gemm_phase2<EPI_OUTPROJ>(p, layer, smem, (const bf16_t*)(p.ws + OFF_ACT), (const bf16_t*)(p.ws + OFF_WOUT) + (size_t)layer * 1024 * 1024, nc ? NTOK : NLAT, 1024, xin);
  xcd_barrier(xb);
  phase_norm(p, layer, 1, (const float*)p.out, nc ? NTOK : NLAT);
  xcd_barrier(xb);
  gemm_phase2<EPI_PLAIN>(p, layer, smem, (const bf16_t*)(p.ws + OFF_ACT), (const bf16_t*)(p.ws + OFF_WQ) + (size_t)layer * 2048 * 1024, nc ? NTOK : NLAT, 2048, nullptr);
  xcd_barrier(xb);
#if REP_PEER
  phase_peer(p, layer, smem, nc ? NTOK : NLAT, false);
  xcd_barrier(xb);
#endif
  phase_peer(p, layer, smem, nc ? NTOK : NLAT);
  if (layer == 0) xcd_barrier(xb);
}

__global__ void __launch_bounds__(512) fwd_megakernel(Params p) {
  cg::grid_group grid = cg::this_grid();
  extern __shared__ __attribute__((aligned(16))) char smem[];
  volatile LAS3 unsigned* xst = (volatile LAS3 unsigned*)(smem + LDS_BCAST + 8);
  if (threadIdx.x == 0) { xst[0] = 0u; xst[1] = 0u; }
  phase_prep(p, smem);
  for (int it = blockIdx.x; it < 256; it += gridDim.x) uv_convert_item(p, it);
  grid.sync();
  const XcdBarrier xb = xcd_barrier_post((unsigned*)(p.ws + OFF_XBAR), xst);
  layer_body<0>(p, smem, xb);
  layer_body<1>(p, smem, xb);
}

extern "C" void kernel_launch(void* const* d_in, const int* in_sizes, int n_in, void* d_out,
                              int out_size, void* d_ws, size_t ws_size, hipStream_t stream) {
  constexpr size_t kDynLds = LDS_BYTES;
  static int grid_blocks = 0;
  if (!grid_blocks) {
    int dev = 0, cus = 0, per_cu = 0;
    (void)hipGetDevice(&dev);
    (void)hipDeviceGetAttribute(&cus, hipDeviceAttributeMultiprocessorCount, dev);
    (void)hipFuncSetAttribute((const void*)fwd_megakernel, hipFuncAttributeMaxDynamicSharedMemorySize, (int)kDynLds);
    (void)hipOccupancyMaxActiveBlocksPerMultiprocessor(&per_cu, fwd_megakernel, 512, kDynLds);
    if (per_cu < 1) { fprintf(stderr, "occupancy query says %d blocks/CU\n", per_cu); per_cu = 1; }
    grid_blocks = cus;
    if (ws_size < WS_END) fprintf(stderr, "workspace too small: %zu < %zu\n", ws_size, (size_t)WS_END);
  }
  Params p{};
  p.x = (const float*)d_in[0]; p.c = (const float*)d_in[1]; p.ctx = (const float*)d_in[2]; p.c_ctx = (const float*)d_in[3];
  p.w_ada = (const float*)d_in[4]; p.b_ada = (const float*)d_in[5]; p.norm1_g = (const float*)d_in[6]; p.w_in = (const float*)d_in[7];
  p.na_rpb = (const float*)d_in[8]; p.diff_lambda = (const float*)d_in[9]; p.diff_subln_g = (const float*)d_in[10];
  p.ret_decay_logit = (const float*)d_in[11]; p.w_out = (const float*)d_in[12]; p.norm2_g = (const float*)d_in[13];
  p.peer_wq = (const float*)d_in[14]; p.peer_subkeys = (const float*)d_in[15]; p.peer_u = (const float*)d_in[16];
  p.peer_v = (const float*)d_in[17]; p.final_g = (const float*)d_in[18];
  p.out = (float*)d_out; p.ws = (char*)d_ws;
  void* args[] = {&p};
  hipError_t e = hipLaunchCooperativeKernel((void*)fwd_megakernel, dim3(grid_blocks), dim3(512), args, kDynLds, stream);
  if (e != hipSuccess) fprintf(stderr, "cooperative launch failed: %s (grid %d)\n", hipGetErrorString(e), grid_blocks);
}
```

```cpp
#include <hip/hip_runtime.h>
#include <hip/hip_cooperative_groups.h>
#include <cstdio>
#include <cstdint>
namespace cg = cooperative_groups;

typedef unsigned short bf16_t;
typedef short bf16x8 __attribute__((ext_vector_type(8)));
typedef float f32x4 __attribute__((ext_vector_type(4)));

constexpr int DM = 1024, BATCH = 8, SEQ = 4096, LCTX = 256;
constexpr int NLAT = BATCH * SEQ;
constexpr int NCTX = BATCH * LCTX;
constexpr int NTOK = NLAT + NCTX;
constexpr int INC = 3072;
constexpr int C_NAQ = 0, C_NAK = 256, C_NAV = 512, C_DFQ = 768, C_DFK = 1024, C_DFV = 1280,
              C_RTQ = 1536, C_RTK = 1792, C_RTV = 2048, C_RTG = 2560;
constexpr int Y_NA = 0, Y_DF = 256, Y_RT = 512;
constexpr int NEXP = 16384;
constexpr float EPS = 1e-6f;

constexpr size_t OFF_CTL  = 0;
constexpr size_t OFF_MISC = 4096;
constexpr size_t OFF_ROPE = 8192;
constexpr size_t OFF_MOD  = OFF_ROPE + 12288;
constexpr size_t SZ_MOD   = 2ull * 9 * 6144 * 4;
constexpr size_t OFF_WIN  = OFF_MOD + SZ_MOD;
constexpr size_t SZ_WIN   = 2ull * 3072 * 1024 * 2;
constexpr size_t OFF_WOUT = OFF_WIN + SZ_WIN;
constexpr size_t SZ_WOUT  = 2ull * 1024 * 1024 * 2;
constexpr size_t OFF_WQ   = OFF_WOUT + SZ_WOUT;
constexpr size_t SZ_WQ    = 2ull * 2048 * 1024 * 2;
constexpr size_t OFF_SUBK = OFF_WQ + SZ_WQ;
constexpr size_t SZ_SUBK  = 2ull * 262144 * 2;
constexpr size_t OFF_U    = OFF_SUBK + SZ_SUBK;
constexpr int    ROWB     = 512;
constexpr int    ROWV     = 512;
constexpr int    RECB     = ROWB + ROWV;
constexpr size_t SZ_UV    = 2ull * NEXP * ROWB;
constexpr size_t OFF_V    = OFF_U + SZ_UV;
constexpr size_t OFF_USC  = OFF_V + SZ_UV;
constexpr size_t OFF_VSC  = OFF_USC + 2ull * NEXP * 4;
constexpr size_t OFF_ACT  = OFF_VSC + 2ull * NEXP * 4;
constexpr size_t SZ_ACT   = (size_t)NTOK * 1024 * 2;
constexpr size_t OFF_P    = OFF_ACT + SZ_ACT;
constexpr size_t SZ_P     = (size_t)NTOK * 3072 * 2;
constexpr size_t OFF_CTXB = OFF_P + SZ_P;
constexpr size_t SZ_CTXB  = (size_t)NCTX * 1024 * 4;
constexpr size_t OFF_RKV  = OFF_CTXB + SZ_CTXB;
constexpr size_t SZ_RKV   = 64ull * 32 * 8192 * 4;
constexpr size_t OFF_RS   = OFF_RKV + SZ_RKV;
constexpr size_t SZ_RS    = 64ull * 8192 * 4;
constexpr size_t OFF_XBAR = OFF_RS + SZ_RS;
constexpr size_t WS_END   = OFF_XBAR + 16384;

#ifndef REP_MIX1
#define REP_MIX1 0
#endif
#ifndef REP_MIX2
#define REP_MIX2 0
#endif
#ifndef REP_PEER
#define REP_PEER 0
#endif
#ifndef REP_GEMM
#define REP_GEMM 0
#endif
constexpr int LDS_BYTES = 152 * 1024;
constexpr int LDS_BCAST = LDS_BYTES - 16;

struct Params {
  const float *x, *c, *ctx, *c_ctx, *w_ada, *b_ada, *norm1_g, *w_in, *na_rpb, *diff_lambda, *diff_subln_g,
              *ret_decay_logit, *w_out, *norm2_g, *peer_wq, *peer_subkeys, *peer_u, *peer_v, *final_g;
  float* out;
  char* ws;
};

__device__ __forceinline__ float bf2f(bf16_t v) { return __uint_as_float(((unsigned)v) << 16); }
__device__ __forceinline__ bf16_t f2bf(float f) {
  unsigned u = __float_as_uint(f);
  u += 0x7fffu + ((u >> 16) & 1u);
  return (bf16_t)(u >> 16);
}
__device__ __forceinline__ unsigned pack2(float a, float b) { return (unsigned)f2bf(a) | ((unsigned)f2bf(b) << 16); }
typedef __bf16 bf16x2_t __attribute__((ext_vector_type(2)));
typedef float f32x2_t __attribute__((ext_vector_type(2)));
__device__ __forceinline__ unsigned pack2h(float a, float b) {
  const f32x2_t v = {a, b};
  return __builtin_bit_cast(unsigned, __builtin_convertvector(v, bf16x2_t));
}
__device__ __forceinline__ float lo16(unsigned w) { return __uint_as_float(w << 16); }
__device__ __forceinline__ float hi16(unsigned w) { return __uint_as_float(w & 0xffff0000u); }
#define DPP_ADD(v, CTRL) ((v) + __int_as_float(__builtin_amdgcn_update_dpp(0, __float_as_int(v), (CTRL), 0xf, 0xf, true)))
__device__ __forceinline__ float row16_sum(float v) {
  v = DPP_ADD(v, 0xB1);
  v = DPP_ADD(v, 0x4E);
  v = DPP_ADD(v, 0x141);
  v = DPP_ADD(v, 0x140);
  return v;
}
#define DPP_MOVU(v, CTRL) ((unsigned)__builtin_amdgcn_update_dpp(0, (int)(v), (CTRL), 0xf, 0xf, true))
__device__ __forceinline__ unsigned row16_max_u32(unsigned v) {
  v = max(v, DPP_MOVU(v, 0xB1)); v = max(v, DPP_MOVU(v, 0x4E)); v = max(v, DPP_MOVU(v, 0x141)); v = max(v, DPP_MOVU(v, 0x140));
  return v;
}
__device__ __forceinline__ unsigned row16_min_u32(unsigned v) {
  v = min(v, DPP_MOVU(v, 0xB1)); v = min(v, DPP_MOVU(v, 0x4E)); v = min(v, DPP_MOVU(v, 0x141)); v = min(v, DPP_MOVU(v, 0x140));
  return v;
}
template <int KTH>
__device__ __forceinline__ unsigned row16_kth_largest(unsigned v) {
  int cnt = 0;
#define R8_STEP(N) { const unsigned o = DPP_MOVU(v, 0x120 + (N)); cnt += (o > v) ? 1 : 0; }
  R8_STEP(1) R8_STEP(2) R8_STEP(3) R8_STEP(4) R8_STEP(5) R8_STEP(6) R8_STEP(7) R8_STEP(8)
  R8_STEP(9) R8_STEP(10) R8_STEP(11) R8_STEP(12) R8_STEP(13) R8_STEP(14) R8_STEP(15)
#undef R8_STEP
  return row16_max_u32(cnt >= KTH - 1 ? v : 0u);
}
__device__ __forceinline__ float wave_sum(float v) {
  v = row16_sum(v);
  const int iv = __float_as_int(v);
  const float a = __int_as_float(__builtin_amdgcn_readlane(iv, 0)), b = __int_as_float(__builtin_amdgcn_readlane(iv, 16));
  const float c = __int_as_float(__builtin_amdgcn_readlane(iv, 32)), d = __int_as_float(__builtin_amdgcn_readlane(iv, 48));
  return (a + b) + (c + d);
}
__device__ __forceinline__ float siluf(float x) { return x / (1.f + __expf(-x)); }

__device__ __forceinline__ int opaque_tid() { int t = threadIdx.x; asm volatile("" : "+v"(t)); return t; }
__device__ __forceinline__ int opaque_bid() { int t = blockIdx.x; asm volatile("" : "+s"(t)); return t; }

#define DOT8(acc, Q, off, U)                                                              \
  acc = fmaf(Q[(off) + 0], lo16((U).x), acc); acc = fmaf(Q[(off) + 1], hi16((U).x), acc); \
  acc = fmaf(Q[(off) + 2], lo16((U).y), acc); acc = fmaf(Q[(off) + 3], hi16((U).y), acc); \
  acc = fmaf(Q[(off) + 4], lo16((U).z), acc); acc = fmaf(Q[(off) + 5], hi16((U).z), acc); \
  acc = fmaf(Q[(off) + 6], lo16((U).w), acc); acc = fmaf(Q[(off) + 7], hi16((U).w), acc);
#define AXPY8(O, off, P, U)                                                                   \
  O[(off) + 0] = fmaf(P, lo16((U).x), O[(off) + 0]); O[(off) + 1] = fmaf(P, hi16((U).x), O[(off) + 1]); \
  O[(off) + 2] = fmaf(P, lo16((U).y), O[(off) + 2]); O[(off) + 3] = fmaf(P, hi16((U).y), O[(off) + 3]); \
  O[(off) + 4] = fmaf(P, lo16((U).z), O[(off) + 4]); O[(off) + 5] = fmaf(P, hi16((U).z), O[(off) + 5]); \
  O[(off) + 6] = fmaf(P, lo16((U).w), O[(off) + 6]); O[(off) + 7] = fmaf(P, hi16((U).w), O[(off) + 7]);
#define UNPACK8(Q, off, U)                                                  \
  Q[(off) + 0] = lo16((U).x); Q[(off) + 1] = hi16((U).x); Q[(off) + 2] = lo16((U).y); Q[(off) + 3] = hi16((U).y); \
  Q[(off) + 4] = lo16((U).z); Q[(off) + 5] = hi16((U).z); Q[(off) + 6] = lo16((U).w); Q[(off) + 7] = hi16((U).w);

__device__ __forceinline__ int next_item(unsigned* counter, char* smem) {
  volatile int* bc = (volatile int*)(smem + LDS_BCAST);
  __syncthreads();
  if (threadIdx.x == 0) *bc = (int)atomicAdd(counter, 1u);
  __syncthreads();
  return *bc;
}

#define XB_TMO      128
#define XB_XCNT(j)  (256  + 64 * (j))
#define XB_XSUB(j)  (1280 + 64 * (j))
#define XB_XGEN(j)  (2304 + 64 * (j))
#define XB_TOP      3328
#define XB_TOPGEN   3392
#define XCD_BAR_WORDS 3456
#define XB_SPIN_CAP (1u << 18)
#define LAS3 __attribute__((address_space(3)))
__device__ __forceinline__ unsigned xb_ld(unsigned* p)              { return __hip_atomic_load(p, __ATOMIC_RELAXED, __HIP_MEMORY_SCOPE_AGENT); }
__device__ __forceinline__ unsigned xb_add(unsigned* p, unsigned v) { return __hip_atomic_fetch_add(p, v, __ATOMIC_RELAXED, __HIP_MEMORY_SCOPE_AGENT); }
__device__ __forceinline__ unsigned xb_xcc_id() { return (unsigned)__builtin_amdgcn_s_getreg((3 << 11) | 20) & 0xFu; }
#define XB_SPIN(cond, bar) do { unsigned _sp = 0; while (cond) { __builtin_amdgcn_s_sleep(1); \
    if ((++_sp & 255u) == 0u) { if (xb_ld(&(bar)[XB_TMO])) break; if (_sp > XB_SPIN_CAP) { atomicAdd(&(bar)[XB_TMO], 1u); break; } } } } while (0)
struct XcdBarrier { unsigned* bar; unsigned x; volatile LAS3 unsigned* st; };
__device__ __forceinline__ XcdBarrier xcd_barrier_post(unsigned* bar, volatile LAS3 unsigned* st) {
  XcdBarrier b; b.bar = bar; b.x = xb_xcc_id(); b.st = st;
  if (threadIdx.x == 0) (void)xb_add(&bar[XB_XCNT(b.x)], 1u);
  return b;
}
__device__ __forceinline__ void xcd_barrier_complete(unsigned* bar, unsigned x, unsigned& nloc, unsigned& nx) {
  const unsigned G = gridDim.x * gridDim.y * gridDim.z;
  unsigned sum, cnt, mine, sp = 0u;
  for (;;) {
    sum = 0u; cnt = 0u; mine = 0u;
#pragma unroll
    for (unsigned j = 0; j < 16; ++j) { const unsigned c = xb_ld(&bar[XB_XCNT(j)]); sum += c; cnt += (c > 0u) ? 1u : 0u; mine = (j == x) ? c : mine; }
    if (sum == G) break;
    __builtin_amdgcn_s_sleep(1);
    if ((++sp & 255u) == 0u) { if (xb_ld(&bar[XB_TMO])) break; if (sp > XB_SPIN_CAP) { atomicAdd(&bar[XB_TMO], 1u); break; } }
  }
  nloc = mine > 0u ? mine : 1u; nx = cnt > 0u ? cnt : 1u;
}
__device__ __forceinline__ void xcd_barrier(const XcdBarrier& b) {
  asm volatile("s_waitcnt vmcnt(0)" ::: "memory");
  __syncthreads();
  if (threadIdx.x == 0) {
    unsigned* bar = b.bar;
    __builtin_amdgcn_s_waitcnt(0);
    unsigned nloc = b.st[0], nx = b.st[1];
    if (nloc == 0u) { xcd_barrier_complete(bar, b.x, nloc, nx); b.st[0] = nloc; b.st[1] = nx; }
    const unsigned old = xb_add(&bar[XB_XSUB(b.x)], 1u);
    const unsigned gen = old / nloc;
    if (old + 1u == (gen + 1u) * nloc) {
      __builtin_amdgcn_fence(__ATOMIC_RELEASE, "agent");
      asm volatile("s_waitcnt vmcnt(0)" ::: "memory");
      const unsigned og = xb_add(&bar[XB_TOP], 1u);
      const unsigned tg = og / nx;
      if (og + 1u == (tg + 1u) * nx) xb_add(&bar[XB_TOPGEN], 1u);
      else XB_SPIN(xb_ld(&bar[XB_TOPGEN]) == tg, bar);
      __builtin_amdgcn_fence(__ATOMIC_ACQUIRE, "agent");
      xb_add(&bar[XB_XGEN(b.x)], 1u);
      asm volatile("s_waitcnt vmcnt(0)" ::: "memory");
    } else {
      XB_SPIN(xb_ld(&bar[XB_XGEN(b.x)]) == gen, bar);
      __builtin_amdgcn_fence(__ATOMIC_ACQUIRE, "agent");
      asm volatile("s_waitcnt vmcnt(0)" ::: "memory");
    }
  }
  __syncthreads();
}

__device__ __forceinline__ void transpose_item(const float* src, bf16_t* dst, int K, int N, int item, char* smem) {
  float* t = (float*)smem;
  const int nb = N / 64;
  const int k0 = (item / nb) * 64, n0 = (item % nb) * 64;
  const int tid = opaque_tid();
  __syncthreads();
#pragma unroll
  for (int i = 0; i < 8; ++i) {
    const int k = (tid >> 6) + 8 * i, n = tid & 63;
    t[k * 65 + n] = src[(size_t)(k0 + k) * N + n0 + n];
  }
  __syncthreads();
#pragma unroll
  for (int i = 0; i < 8; ++i) {
    const int n = (tid >> 6) + 8 * i, k = tid & 63;
    dst[(size_t)(n0 + n) * K + k0 + k] = f2bf(t[k * 65 + n]);
  }
}

__device__ __forceinline__ void convert_flat(const float* src, bf16_t* dst, size_t n4) {
  const size_t gt = (size_t)opaque_bid() * blockDim.x + opaque_tid(), gs = (size_t)gridDim.x * blockDim.x;
  for (size_t i = gt; i < n4; i += gs) {
    const float4 v = ((const float4*)src)[i];
    uint2 o; o.x = pack2h(v.x, v.y); o.y = pack2h(v.z, v.w);
    ((uint2*)dst)[i] = o;
  }
}

__device__ __forceinline__ void phase_prep(const Params& p, char* smem) {
  const int tid = opaque_tid();
  char* ws = p.ws;
  if (opaque_bid() == 0) {
    unsigned* ctl = (unsigned*)(ws + OFF_CTL);
    if (tid < 64) ctl[tid] = 0u;
    unsigned* xbar = (unsigned*)(ws + OFF_XBAR);
    for (int i = tid; i < XCD_BAR_WORDS; i += 512) xbar[i] = 0u;
    float* misc = (float*)(ws + OFF_MISC);
    if (tid < 2) {
      const float* lp = p.diff_lambda + tid * 128;
      float s01 = 0.f, s23 = 0.f;
      for (int i = 0; i < 32; ++i) { s01 += lp[i] * lp[32 + i]; s23 += lp[64 + i] * lp[96 + i]; }
      const float lam_init = 0.8f - 0.6f * expf(-0.3f * (float)tid);
      misc[tid] = expf(s01) - expf(s23) + lam_init;
      misc[2 + tid] = lam_init;
    }
    if (tid >= 128 && tid < 256) misc[64 + tid - 128] = 0.f;
    if (tid >= 64 && tid < 80) {
      const int i = tid - 64;
      const float xv = p.ret_decay_logit[i];
      misc[16 + i] = -log1pf(expf(-xv));
    }
    float2* ropeD = (float2*)(ws + OFF_ROPE);
    float2* ropeR = (float2*)(ws + OFF_ROPE + 4096);
    for (int i = tid; i < 64 * 8; i += 512) {
      const int v = i >> 3, f = i & 7;
      const float inv = powf(10000.0f, -(float)(2 * f) / 16.0f);
      const float ang = (float)v * inv;
      ropeD[i] = make_float2(cosf(ang), sinf(ang));
    }
    for (int i = tid; i < 64 * 16; i += 512) {
      const int v = i >> 4, f = i & 15;
      const float inv = powf(10000.0f, -(float)(2 * f) / 32.0f);
      const float ang = (float)v * inv;
      ropeR[i] = make_float2(cosf(ang), sinf(ang));
    }
  }
  {
    float* sc = (float*)smem;
    float* red = (float*)(smem + 9 * 1024 * 4);
    float* mod = (float*)(ws + OFF_MOD);
    for (int item = opaque_bid(); item < 192; item += gridDim.x) {
      const int l = item / 96, cb = item % 96;
      __syncthreads();
      for (int i = tid; i < 9 * 1024; i += 512) {
        const int r = i >> 10, k = i & 1023;
        const float cv = (r < 8) ? p.c[r * 1024 + k] : p.c_ctx[k];
        sc[i] = siluf(cv);
      }
      __syncthreads();
      const int col = tid & 63, ks = tid >> 6;
      float acc[9];
#pragma unroll
      for (int r = 0; r < 9; ++r) acc[r] = 0.f;
      const float* w = p.w_ada + (size_t)l * 1024 * 6144 + cb * 64 + col;
#pragma unroll 1
      for (int k0 = ks * 128; k0 < ks * 128 + 128; k0 += 16) {
        float wv[16];
#pragma unroll
        for (int i = 0; i < 16; ++i) wv[i] = w[(size_t)(k0 + i) * 6144];
#pragma unroll
        for (int i = 0; i < 16; ++i)
#pragma unroll
          for (int r = 0; r < 9; ++r) acc[r] = fmaf(sc[r * 1024 + k0 + i], wv[i], acc[r]);
      }
#pragma unroll
      for (int r = 0; r < 9; ++r) red[(ks * 9 + r) * 64 + col] = acc[r];
      __syncthreads();
      for (int i = tid; i < 576; i += 512) {
        const int r = i >> 6, cc = i & 63;
        float s = 0.f;
#pragma unroll
        for (int k8 = 0; k8 < 8; ++k8) s += red[(k8 * 9 + r) * 64 + cc];
        mod[((size_t)l * 9 + r) * 6144 + cb * 64 + cc] = s + p.b_ada[l * 6144 + cb * 64 + cc];
      }
    }
    __syncthreads();
  }
  for (int item = opaque_bid(); item < 3072; item += gridDim.x) {
    const int l = item / 1536;
    int r = item % 1536;
    if (r < 768) transpose_item(p.w_in + (size_t)l * 1024 * 3072, (bf16_t*)(ws + OFF_WIN) + (size_t)l * 3072 * 1024, 1024, 3072, r, smem);
    else if (r < 1024) transpose_item(p.w_out + (size_t)l * 1024 * 1024, (bf16_t*)(ws + OFF_WOUT) + (size_t)l * 1024 * 1024, 1024, 1024, r - 768, smem);
    else transpose_item(p.peer_wq + (size_t)l * 1024 * 2048, (bf16_t*)(ws + OFF_WQ) + (size_t)l * 2048 * 1024, 1024, 2048, r - 1024, smem);
  }
  convert_flat(p.peer_subkeys, (bf16_t*)(ws + OFF_SUBK), 2ull * 262144 / 4);
  {
    const size_t gt = (size_t)opaque_bid() * blockDim.x + tid, gs = (size_t)gridDim.x * blockDim.x;
    float4* dst = (float4*)(ws + OFF_CTXB);
    for (size_t i = gt; i < (size_t)NCTX * 1024 / 4; i += gs) dst[i] = ((const float4*)p.ctx)[i];
  }
}

__device__ __forceinline__ void phase_norm(const Params& p, int layer, int which, const float* xlat, int nrows) {
  const int lane = opaque_tid() & 63;
  const int gw = opaque_bid() * 8 + (opaque_tid() >> 6), nw = gridDim.x * 8;
  const float* g = (which == 0 ? p.norm1_g : p.norm2_g) + layer * 1024;
  const float* mod = (const float*)(p.ws + OFF_MOD) + (size_t)layer * 9 * 6144;
  const float* ctxb = (const float*)(p.ws + OFF_CTXB);
  bf16_t* act = (bf16_t*)(p.ws + OFF_ACT);
  const int sh_off = which == 0 ? 0 : 3 * 1024, sc_off = which == 0 ? 1024 : 4 * 1024;
  for (int row = gw; row < nrows; row += nw) {
    const float* src = row < NLAT ? xlat + (size_t)row * 1024 : ctxb + (size_t)(row - NLAT) * 1024;
    const int b = row < NLAT ? (row >> 12) : 8;
    const float* mrow = mod + (size_t)b * 6144;
    float4 v[4];
    float ss = 0.f;
#pragma unroll
    for (int j = 0; j < 4; ++j) {
      v[j] = ((const float4*)src)[lane + 64 * j];
      ss += v[j].x * v[j].x + v[j].y * v[j].y + v[j].z * v[j].z + v[j].w * v[j].w;
    }
    ss = wave_sum(ss);
    const float r = rsqrtf(ss * (1.f / 1024.f) + EPS);
#pragma unroll
    for (int j = 0; j < 4; ++j) {
      const int c = (lane + 64 * j) * 4;
      const float4 gg = *(const float4*)(g + c);
      const float4 sh = *(const float4*)(mrow + sh_off + c);
      const float4 sc = *(const float4*)(mrow + sc_off + c);
      const float o0 = v[j].x * r * gg.x * (1.f + sc.x) + sh.x;
      const float o1 = v[j].y * r * gg.y * (1.f + sc.y) + sh.y;
      const float o2 = v[j].z * r * gg.z * (1.f + sc.z) + sh.z;
      const float o3 = v[j].w * r * gg.w * (1.f + sc.w) + sh.w;
      uint2 o; o.x = pack2h(o0, o1); o.y = pack2h(o2, o3);
      *(uint2*)(act + (size_t)row * 1024 + c) = o;
    }
  }
}

__device__ __forceinline__ void phase_final(const Params& p) {
  const int lane = opaque_tid() & 63;
  const int gw = opaque_bid() * 8 + (opaque_tid() >> 6), nw = gridDim.x * 8;
  for (int row = gw; row < NLAT; row += nw) {
    float* src = p.out + (size_t)row * 1024;
    float4 v[4];
    float ss = 0.f;
#pragma unroll
    for (int j = 0; j < 4; ++j) {
      v[j] = ((const float4*)src)[lane + 64 * j];
      ss += v[j].x * v[j].x + v[j].y * v[j].y + v[j].z * v[j].z + v[j].w * v[j].w;
    }
    ss = wave_sum(ss);
    const float r = rsqrtf(ss * (1.f / 1024.f) + EPS);
#pragma unroll
    for (int j = 0; j < 4; ++j) {
      const int c = (lane + 64 * j) * 4;
      const float4 gg = *(const float4*)(p.final_g + c);
      float4 o;
      o.x = v[j].x * r * gg.x; o.y = v[j].y * r * gg.y; o.z = v[j].z * r * gg.z; o.w = v[j].w * r * gg.w;
      ((float4*)src)[lane + 64 * j] = o;
    }
  }
}

constexpr int EPI_INPROJ = 0, EPI_OUTPROJ = 1, EPI_PLAIN = 2;
constexpr int GS = 72;
constexpr int G_ASTAGE = 256 * GS * 2;
constexpr int G_BSTAGE = 128 * GS * 2;
constexpr int G_STAGE = G_ASTAGE + G_BSTAGE;

namespace g8 {
constexpr int BM = 256, BK = 64, HALF = 128, NXCD = 8, WGM = 8, HT = HALF * BK;
__device__ __forceinline__ int lds_byte(int r, int c) {
  const int st = (r >> 4) * 2 + (c >> 5), rr = r & 15, cc = c & 31, ob = rr * 64 + cc * 2;
  return st * 1024 + (ob ^ (((ob >> 9) & 1) << 5));
}
__device__ __forceinline__ void stage_rc(int b, int& R, int& C) {
  const int st = b / 1024, sb = b % 1024, swz = sb ^ (((sb >> 9) & 1) << 5);
  R = (st >> 1) * 16 + swz / 64; C = (st & 1) * 32 + (swz % 64) / 2;
}
}

constexpr int G8_ROPE_LDS = 8 * 16384;
template <int EPI>
__device__ __forceinline__ void epi_store8(const Params& p, int layer, char* smem, int m, int n, f32x4 lo, f32x4 hi, const float* xin_lat) {
  float v[8] = {lo[0], lo[1], lo[2], lo[3], hi[0], hi[1], hi[2], hi[3]};
  if constexpr (EPI == EPI_INPROJ) {
    const bool ropeD = (n >= C_DFQ && n < C_DFV), ropeR = (n >= C_RTQ && n < C_RTV);
    if ((ropeD || ropeR) && m < NLAT) {
      const int t = m & 4095, gr = t >> 6, gc = t & 63;
      const float2* tabD = (const float2*)(smem + G8_ROPE_LDS);
      const float2* tabR = (const float2*)(smem + G8_ROPE_LDS + 4096);
      const float2* tb;
      if (ropeD) { const int i0 = (n & 31) >> 1; tb = i0 < 8 ? tabD + gr * 8 + i0 : tabD + gc * 8 + i0 - 8; }
      else { const int i0 = (n & 63) >> 1; tb = i0 < 16 ? tabR + gr * 16 + i0 : tabR + gc * 16 + i0 - 16; }
#pragma unroll
      for (int q = 0; q < 4; ++q) {
        const float2 cs = tb[q];
        const float a0 = v[2 * q] * cs.x - v[2 * q + 1] * cs.y, a1 = v[2 * q] * cs.y + v[2 * q + 1] * cs.x;
        v[2 * q] = a0; v[2 * q + 1] = a1;
      }
    }
    float sc = 1.f;
    if (n < C_NAK) sc = 0.125f * 1.4426950408889634f;
    else if (n >= C_DFQ && n < C_DFK) sc = 0.17677669529663687f * 1.4426950408889634f;
    else if (n >= C_RTK && n < C_RTV) sc = 0.125f;
    uint4 o;
    o.x = pack2h(v[0] * sc, v[1] * sc); o.y = pack2h(v[2] * sc, v[3] * sc); o.z = pack2h(v[4] * sc, v[5] * sc); o.w = pack2h(v[6] * sc, v[7] * sc);
    *(uint4*)((bf16_t*)(p.ws + OFF_P) + (size_t)m * INC + n) = o;
  } else if constexpr (EPI == EPI_OUTPROJ) {
    const float* mod = (const float*)(p.ws + OFF_MOD) + (size_t)layer * 9 * 6144;
    const int b = m < NLAT ? (m >> 12) : 8;
    const float* gp = mod + (size_t)b * 6144 + 2 * 1024 + n;
    const float4 g0 = *(const float4*)gp, g1 = *(const float4*)(gp + 4);
    const float* xi; float* xo;
    if (m < NLAT) { xi = xin_lat + (size_t)m * 1024 + n; xo = p.out + (size_t)m * 1024 + n; }
    else { xo = (float*)(p.ws + OFF_CTXB) + (size_t)(m - NLAT) * 1024 + n; xi = xo; }
    const float4 x0 = *(const float4*)xi, x1 = *(const float4*)(xi + 4);
    float4 o0, o1;
    o0.x = x0.x + g0.x * v[0]; o0.y = x0.y + g0.y * v[1]; o0.z = x0.z + g0.z * v[2]; o0.w = x0.w + g0.w * v[3];
    o1.x = x1.x + g1.x * v[4]; o1.y = x1.y + g1.y * v[5]; o1.z = x1.z + g1.z * v[6]; o1.w = x1.w + g1.w * v[7];
    *(float4*)xo = o0; *(float4*)(xo + 4) = o1;
  } else if constexpr (EPI == EPI_PLAIN) {
    uint4 o;
    o.x = pack2h(v[0], v[1]); o.y = pack2h(v[2], v[3]); o.z = pack2h(v[4], v[5]); o.w = pack2h(v[6], v[7]);
    *(uint4*)((bf16_t*)(p.ws + OFF_P) + (size_t)m * 2048 + n) = o;
  } else {
    asm volatile("" :: "v"(v[0]), "v"(v[1]), "v"(v[2]), "v"(v[3]), "v"(v[4]), "v"(v[5]), "v"(v[6]), "v"(v[7]));
  }
}

#define G8_LAS __attribute__((address_space(3)))
__device__ __forceinline__ bool g8_next(int i, int nM, int nN, int G, int c, int& pm, int& pn) {
  using namespace g8;
  const int nwg = nM * nN;
  const long Lx = (long)i * G + c;
  if (Lx >= nwg) return false;
  int wgid = (int)Lx;
  { const int q = nwg / NXCD, r = nwg % NXCD, xcd = wgid % NXCD, off = wgid / NXCD; wgid = (xcd < r ? xcd * (q + 1) : r * (q + 1) + (xcd - r) * q) + off; }
  const int nig = WGM * nN, gid = wgid / nig, fm = gid * WGM, gsz = (nM - fm) < WGM ? (nM - fm) : WGM;
  pm = fm + ((wgid % nig) % gsz); pn = (wgid % nig) / gsz;
  return true;
}

template <int EPI>
__device__ __forceinline__ void gemm_phase2(const Params& p, int layer, char* smem, const bf16_t* A, const bf16_t* Bt,
                                            int M, int N, const float* xin_lat) {
  using namespace g8;
  constexpr int K = 1024, nt = K / BK, HTB = HALF * BK * 2;
  G8_LAS unsigned char* lds = (G8_LAS unsigned char*)smem;
  const int tid = opaque_tid();
  const int wid = __builtin_amdgcn_readfirstlane(tid >> 6), lane = tid & 63, wr = wid >> 2, wc = wid & 3, fr = lane & 15, fq = lane >> 4;
  unsigned voff[2], voffB[2];
#pragma unroll
  for (int i = 0; i < 2; ++i) {
    int R, C; stage_rc(tid * 16 + i * 8192, R, C);
    const int rho = R & 31, Rb = (R & ~31) + 8 * ((rho & 15) >> 2) + 4 * (rho >> 4) + (rho & 3);
    voff[i] = (unsigned)(R * K + C) * 2u; voffB[i] = (unsigned)(Rb * K + C) * 2u;
  }
  if constexpr (EPI == EPI_INPROJ) {
    __syncthreads();
    const float4* gsrc = (const float4*)(p.ws + OFF_ROPE);
    float4* ldst = (float4*)(smem + G8_ROPE_LDS);
    for (int i = tid; i < 12288 / 16; i += 512) ldst[i] = gsrc[i];
  }
  constexpr size_t kstep = (size_t)(BK * 2);
  constexpr size_t hstep = (size_t)HALF * K * 2;
  constexpr size_t tstep = 2 * hstep;
  const unsigned ldsw = (unsigned)wid * 1024u;
  const int aoff = lds_byte(wr * 64 + fr, fq * 8), boff = lds_byte(wc * 32 + fr, fq * 8);
#define G8_SA(b, h) (((b) * 2 + (h)) * HTB)
#define G8_SB(b, h) ((4 + (b) * 2 + (h)) * HTB)
#define G8_STAGE_V(bufoff, gbase, VO) do { _Pragma("unroll") for (int _i = 0; _i < 2; ++_i)                                  \
    __builtin_amdgcn_global_load_lds((const unsigned*)((const char*)(gbase) + VO[_i]), (G8_LAS unsigned*)(lds + (bufoff) + ldsw + _i * 8192), 16, 0, 0); } while (0)
#define G8_LDA(dst, b, h) do { _Pragma("unroll") for (int m = 0; m < 4; ++m) _Pragma("unroll") for (int k = 0; k < 2; ++k) dst[m][k] = *(const G8_LAS bf16x8*)(lds + G8_SA(b, h) + aoff + m * 2048 + k * 1024); } while (0)
#define G8_LDB(dst, b, h) do { _Pragma("unroll") for (int n = 0; n < 2; ++n) _Pragma("unroll") for (int k = 0; k < 2; ++k) dst[n][k] = *(const G8_LAS bf16x8*)(lds + G8_SB(b, h) + boff + n * 2048 + k * 1024); } while (0)
#define G8_MMA(ai, bj, At_, Bt_) do { __builtin_amdgcn_s_setprio(1);                                                          \
    _Pragma("unroll") for (int m = 0; m < 4; ++m) _Pragma("unroll") for (int n = 0; n < 2; ++n) _Pragma("unroll") for (int k = 0; k < 2; ++k) \
      acc[ai][bj][m][n] = __builtin_amdgcn_mfma_f32_16x16x32_bf16(Bt_[n][k], At_[m][k], acc[ai][bj][m][n], 0, 0, 0);          \
    __builtin_amdgcn_s_setprio(0); } while (0)
#define G8_WAIT_V(n) asm volatile("s_waitcnt vmcnt(" #n ")" ::: "memory")
#define G8_WAIT_L(n) asm volatile("s_waitcnt lgkmcnt(" #n ")" ::: "memory")
#define G8_BAR __builtin_amdgcn_s_barrier()
#define G8_SCHED __builtin_amdgcn_sched_barrier(0)
  const int nM = M / BM, nN = N / BM, G = gridDim.x, cu = opaque_bid();
  int cpm, cpn, npm = 0, npn = 0, ui = 0;
  __syncthreads();
  if (g8_next(0, nM, nN, G, cu, cpm, cpn)) {
    f32x4 acc[2][2][4][2];
#pragma unroll
    for (int a = 0; a < 2; ++a)
#pragma unroll
      for (int b2 = 0; b2 < 2; ++b2)
#pragma unroll
        for (int m = 0; m < 4; ++m)
#pragma unroll
          for (int n = 0; n < 2; ++n) acc[a][b2][m][n] = (f32x4){0.f, 0.f, 0.f, 0.f};
    bf16x8 At[4][2], B0[2][2], B1[2][2];
    const char* cA = (const char*)A + (size_t)cpm * tstep;
    const char* cB = (const char*)Bt + (size_t)cpn * tstep;
    G8_STAGE_V(G8_SB(0, 0), cB, voffB); G8_STAGE_V(G8_SA(0, 0), cA, voff); G8_STAGE_V(G8_SB(0, 1), cB + hstep, voffB); G8_STAGE_V(G8_SA(0, 1), cA + hstep, voff);
    if (wr == 1) G8_BAR;
    G8_WAIT_V(4); G8_BAR;
    G8_STAGE_V(G8_SB(1, 0), cB + kstep, voffB); G8_STAGE_V(G8_SA(1, 0), cA + kstep, voff); G8_STAGE_V(G8_SB(1, 1), cB + hstep + kstep, voffB);
    G8_WAIT_V(6); G8_BAR;
    for (;;) {
      const bool has_next = g8_next(ui + 1, nM, nN, G, cu, npm, npn);
      const char* nA = has_next ? (const char*)A + (size_t)npm * tstep : cA;
      const char* nB = has_next ? (const char*)Bt + (size_t)npn * tstep : cB;
#pragma unroll 1
      for (int t = 0; t < nt; t += 2) {
        const bool last = (t == nt - 2);
        const char* a1 = cA + (size_t)(t + 1) * kstep;
        const char* a2 = last ? nA : cA + (size_t)(t + 2) * kstep; const char* b2 = last ? nB : cB + (size_t)(t + 2) * kstep;
        const char* a3 = a2 + kstep; const char* b3 = b2 + kstep;
        G8_LDB(B0, 0, 0); G8_SCHED; G8_LDA(At, 0, 0); G8_STAGE_V(G8_SA(1, 1), a1 + hstep, voff);
        G8_WAIT_L(8); G8_BAR; G8_WAIT_L(0); G8_MMA(0, 0, At, B0); G8_BAR; G8_SCHED;
        G8_LDB(B1, 0, 1); G8_STAGE_V(G8_SB(0, 0), b2, voffB);
        G8_BAR; G8_WAIT_L(0); G8_MMA(0, 1, At, B1); G8_BAR;
        G8_LDA(At, 0, 1); G8_STAGE_V(G8_SA(0, 0), a2, voff);
        G8_BAR; G8_WAIT_L(0); G8_MMA(1, 0, At, B0); G8_BAR; G8_SCHED;
        G8_STAGE_V(G8_SB(0, 1), b2 + hstep, voffB);
        G8_WAIT_V(6); G8_BAR; G8_MMA(1, 1, At, B1); G8_BAR;
        G8_LDB(B0, 1, 0); G8_SCHED; G8_LDA(At, 1, 0); G8_STAGE_V(G8_SA(0, 1), a2 + hstep, voff);
        G8_WAIT_L(8); G8_BAR; G8_WAIT_L(0); G8_MMA(0, 0, At, B0); G8_BAR; G8_SCHED;
        G8_LDB(B1, 1, 1); G8_STAGE_V(G8_SB(1, 0), b3, voffB);
        G8_BAR; G8_WAIT_L(0); G8_MMA(0, 1, At, B1); G8_BAR;
        G8_LDA(At, 1, 1); G8_STAGE_V(G8_SA(1, 0), a3, voff);
        G8_BAR; G8_WAIT_L(0); G8_MMA(1, 0, At, B0); G8_BAR; G8_SCHED;
        G8_STAGE_V(G8_SB(1, 1), b3 + hstep, voffB);
        G8_WAIT_V(6); G8_BAR; G8_MMA(1, 1, At, B1); G8_BAR;
      }
      {
        const int brow = cpm * BM, bcol = cpn * BM;
        if constexpr (EPI == EPI_INPROJ) {
          if (bcol == C_DFK) {
#pragma unroll
            for (int bj = 0; bj < 2; ++bj) {
              float mx = 0.f;
#pragma unroll
              for (int ai = 0; ai < 2; ++ai)
#pragma unroll
                for (int m = 0; m < 4; ++m) {
                  float s = 0.f;
#pragma unroll
                  for (int n = 0; n < 2; ++n)
#pragma unroll
                    for (int j = 0; j < 4; ++j) s = fmaf(acc[ai][bj][m][n][j], acc[ai][bj][m][n][j], s);
                  s += __shfl_xor(s, 16); s += __shfl_xor(s, 32);
                  mx = fmaxf(mx, s);
                }
#pragma unroll
              for (int o = 1; o < 16; o <<= 1) mx = fmaxf(mx, __shfl_xor(mx, o));
              if (lane == 0) {
                const int bb = brow < NLAT ? (brow >> 12) : ((brow - NLAT) >> 8);
                unsigned* km = (unsigned*)(p.ws + OFF_MISC) + 64 + layer * 64 + (bb * 4 + bj * 2 + (wc >> 1)) * 2 + (wc & 1);
                atomicMax(km, __float_as_uint(mx));
              }
            }
          }
        }
#pragma unroll
        for (int ai = 0; ai < 2; ++ai)
#pragma unroll
          for (int bj = 0; bj < 2; ++bj)
#pragma unroll
            for (int m = 0; m < 4; ++m)
              epi_store8<EPI>(p, layer, smem, brow + ai * HALF + wr * 64 + m * 16 + fr, bcol + bj * HALF + wc * 32 + fq * 8,
                              acc[ai][bj][m][0], acc[ai][bj][m][1], xin_lat);
      }
      if (!has_next) break;
#pragma unroll
      for (int a = 0; a < 2; ++a)
#pragma unroll
        for (int b2 = 0; b2 < 2; ++b2)
#pragma unroll
          for (int m = 0; m < 4; ++m)
#pragma unroll
            for (int n = 0; n < 2; ++n) acc[a][b2][m][n] = (f32x4){0.f, 0.f, 0.f, 0.f};
      cpm = npm; cpn = npn; cA = nA; cB = nB; ++ui;
    }
    G8_WAIT_V(0);
    if (wr == 0) G8_BAR;
    G8_BAR;
  }
}

__device__ __forceinline__ unsigned cvt_pk_bf16(float lo, float hi) { return pack2h(lo, hi); }
__device__ __forceinline__ void vt_store8(bf16_t* vt, int stride, int d0, int key, uint4 uv) {
  bf16_t* vd = vt + d0 * stride + key;
  vd[0 * stride] = (bf16_t)(uv.x & 0xffffu); vd[1 * stride] = (bf16_t)(uv.x >> 16);
  vd[2 * stride] = (bf16_t)(uv.y & 0xffffu); vd[3 * stride] = (bf16_t)(uv.y >> 16);
  vd[4 * stride] = (bf16_t)(uv.z & 0xffffu); vd[5 * stride] = (bf16_t)(uv.z >> 16);
  vd[6 * stride] = (bf16_t)(uv.w & 0xffffu); vd[7 * stride] = (bf16_t)(uv.w >> 16);
}

constexpr int DKS = 72;
__device__ __forceinline__ void diff_item(const Params& p, int layer, bool ctxq, int item, char* smem) {
  const bf16_t* P = (const bf16_t*)(p.ws + OFF_P);
  bf16_t* Y = (bf16_t*)(p.ws + OFF_ACT);
  const float* misc = (const float*)(p.ws + OFF_MISC);
  const float lam = misc[layer], lam_init = misc[2 + layer];
  const int tid = opaque_tid(), lane = tid & 63, wave = tid >> 6, lr = lane & 15, lq = lane >> 4;
  int b, h, mbase, nkeys;
  if (!ctxq) { b = item >> 6; h = (item >> 4) & 3; mbase = b * 4096 + (item & 15) * 256; nkeys = 256 + 4096; }
  else { b = item >> 2; h = item & 3; mbase = NLAT + b * 256; nkeys = 256; }
  const float kmax0 = sqrtf(misc[64 + layer * 64 + (b * 4 + h) * 2 + 0]), kmax1 = sqrtf(misc[64 + layer * 64 + (b * 4 + h) * 2 + 1]);
  bf16x8 qf[2][2];
  f32x4 C0[2], C1[2];
#pragma unroll
  for (int qt = 0; qt < 2; ++qt) {
    const bf16_t* qr = P + (size_t)(mbase + wave * 32 + qt * 16 + lr) * INC + C_DFQ + h * 64 + lq * 8;
    const uint4 u0 = *(const uint4*)(qr), u1 = *(const uint4*)(qr + 32);
    float s0 = 0.f, s1 = 0.f;
    { float t[8]; UNPACK8(t, 0, u0) _Pragma("unroll") for (int i = 0; i < 8; ++i) s0 = fmaf(t[i], t[i], s0); }
    { float t[8]; UNPACK8(t, 0, u1) _Pragma("unroll") for (int i = 0; i < 8; ++i) s1 = fmaf(t[i], t[i], s1); }
    s0 += __shfl_xor(s0, 16); s0 += __shfl_xor(s0, 32);
    s1 += __shfl_xor(s1, 16); s1 += __shfl_xor(s1, 32);
    const float nm0 = -sqrtf(s0) * kmax0, nm1 = -sqrtf(s1) * kmax1;
    C0[qt] = (f32x4){nm0, nm0, nm0, nm0};
    C1[qt] = (f32x4){nm1, nm1, nm1, nm1};
    union { uint4 u; bf16x8 v; } c0, c1; c0.u = u0; c1.u = u1;
    qf[qt][0] = c0.v; qf[qt][1] = c1.v;
  }
  f32x4 O0[2][4], O1[2][4];
#pragma unroll
  for (int qt = 0; qt < 2; ++qt)
#pragma unroll
    for (int i = 0; i < 4; ++i) { O0[qt][i] = (f32x4){0.f, 0.f, 0.f, 0.f}; O1[qt][i] = (f32x4){0.f, 0.f, 0.f, 0.f}; }
  f32x4 L0[2], L1[2];
#pragma unroll
  for (int qt = 0; qt < 2; ++qt) { L0[qt] = (f32x4){0.f, 0.f, 0.f, 0.f}; L1[qt] = (f32x4){0.f, 0.f, 0.f, 0.f}; }
  const bf16x8 ones8 = {(short)0x3F80, (short)0x3F80, (short)0x3F80, (short)0x3F80, (short)0x3F80, (short)0x3F80, (short)0x3F80, (short)0x3F80};
  const int lkey = tid >> 3, lch = tid & 7;
  constexpr int DBUF = 2 * 128 * DKS * 2;
  uint4 ukA0, ukA1, uvA0, uvA1;
#define DF_GLOAD1(UK, UV, T, I)                                                                     \
  {                                                                                                 \
    const int kk = (T) * 128 + (I) * 64 + lkey;                                                     \
    const size_t row = kk < 256 ? (size_t)(NLAT + b * 256 + kk) : (size_t)(b * 4096 + kk - 256);    \
    UK = *(const uint4*)(P + row * INC + C_DFK + h * 64 + lch * 8);                                 \
    UV = *(const uint4*)(P + row * INC + C_DFV + h * 64 + lch * 8);                                 \
  }
#define DF_LSTORE1(UK, UV, BUF, I)                                                                  \
  {                                                                                                 \
    bf16_t* Ks_ = (bf16_t*)(smem + (BUF) * DBUF) + (I) * 64 * DKS;                                  \
    bf16_t* Vt_ = (bf16_t*)(smem + (BUF) * DBUF) + 128 * DKS + (I) * 64 * DKS;                      \
    *(uint4*)(Ks_ + lkey * DKS + lch * 8) = UK;                                                     \
    vt_store8(Vt_, DKS, lch * 8, lkey, UV);                                                         \
  }
#define DF_GLOAD(S, T) DF_GLOAD1(uk##S##0, uv##S##0, T, 0) DF_GLOAD1(uk##S##1, uv##S##1, T, 1)
#define DF_LSTORE(S, BUF) DF_LSTORE1(uk##S##0, uv##S##0, BUF, 0) DF_LSTORE1(uk##S##1, uv##S##1, BUF, 1)
  const int ntile = nkeys >> 7;
  __syncthreads();
  DF_GLOAD(A, 0)
  DF_LSTORE(A, 0)
  __syncthreads();
#pragma unroll 1
  for (int t = 0; t < ntile; ++t) {
    const int cur = t & 1;
    if (t + 1 < ntile) { DF_GLOAD(A, t + 1) }
#pragma unroll 1
    for (int sub = 0; sub < 2; ++sub) {
    const bf16_t* Ks = (const bf16_t*)(smem + cur * DBUF) + sub * 64 * DKS;
    const bf16_t* Vt = (const bf16_t*)(smem + cur * DBUF) + 128 * DKS + sub * 64 * DKS;
    union PF { unsigned u[4]; bf16x8 v; };
    PF pf0[2][2], pf1[2][2];
#pragma unroll
    for (int c = 0; c < 2; ++c) {
      f32x4 S[2][4];
#pragma unroll
      for (int kt = 0; kt < 4; ++kt) {
        const bf16x8 kf = *(const bf16x8*)(Ks + (kt * 16 + lr) * DKS + c * 32 + lq * 8);
#pragma unroll
        for (int qt = 0; qt < 2; ++qt) S[qt][kt] = __builtin_amdgcn_mfma_f32_16x16x32_bf16(kf, qf[qt][c], c == 0 ? C0[qt] : C1[qt], 0, 0, 0);
      }
#pragma unroll
      for (int qt = 0; qt < 2; ++qt) {
#pragma unroll
        for (int kt = 0; kt < 4; ++kt) {
#pragma unroll
          for (int r = 0; r < 4; ++r) S[qt][kt][r] = __builtin_amdgcn_exp2f(S[qt][kt][r]);
        }
#pragma unroll
        for (int g = 0; g < 2; ++g) {
          PF t;
          t.u[0] = cvt_pk_bf16(S[qt][2 * g][0], S[qt][2 * g][1]); t.u[1] = cvt_pk_bf16(S[qt][2 * g][2], S[qt][2 * g][3]);
          t.u[2] = cvt_pk_bf16(S[qt][2 * g + 1][0], S[qt][2 * g + 1][1]); t.u[3] = cvt_pk_bf16(S[qt][2 * g + 1][2], S[qt][2 * g + 1][3]);
          if (c == 0) pf0[qt][g] = t; else pf1[qt][g] = t;
        }
      }
    }
#pragma unroll
    for (int g = 0; g < 2; ++g) {
#pragma unroll
      for (int qt = 0; qt < 2; ++qt) {
        L0[qt] = __builtin_amdgcn_mfma_f32_16x16x32_bf16(ones8, pf0[qt][g].v, L0[qt], 0, 0, 0);
        L1[qt] = __builtin_amdgcn_mfma_f32_16x16x32_bf16(ones8, pf1[qt][g].v, L1[qt], 0, 0, 0);
      }
#pragma unroll
      for (int dt = 0; dt < 4; ++dt) {
        union { uint2 h2[2]; bf16x8 v; } vf;
        vf.h2[0] = *(const uint2*)(Vt + (dt * 16 + lr) * DKS + 32 * g + 4 * lq);
        vf.h2[1] = *(const uint2*)(Vt + (dt * 16 + lr) * DKS + 32 * g + 16 + 4 * lq);
#pragma unroll
        for (int qt = 0; qt < 2; ++qt) {
          O0[qt][dt] = __builtin_amdgcn_mfma_f32_16x16x32_bf16(vf.v, pf0[qt][g].v, O0[qt][dt], 0, 0, 0);
          O1[qt][dt] = __builtin_amdgcn_mfma_f32_16x16x32_bf16(vf.v, pf1[qt][g].v, O1[qt][dt], 0, 0, 0);
        }
      }
    }
    }
    if (t + 1 < ntile) { DF_LSTORE(A, cur ^ 1) }
    __syncthreads();
  }
  const float* sg = p.diff_subln_g + layer * 64;
#pragma unroll
  for (int qt = 0; qt < 2; ++qt) {
    const float a0 = L0[qt][0], a1 = L1[qt][0];
    const float i0 = 1.f / a0, i1 = lam / a1;
    float ss = 0.f;
#pragma unroll
    for (int dt = 0; dt < 4; ++dt) {
#pragma unroll
      for (int r = 0; r < 4; ++r) { const float v = O0[qt][dt][r] * i0 - O1[qt][dt][r] * i1; O0[qt][dt][r] = v; ss = fmaf(v, v, ss); }
    }
    ss += __shfl_xor(ss, 16); ss += __shfl_xor(ss, 32);
    const float rr = rsqrtf(ss * (1.f / 64.f) + EPS) * (1.f - lam_init);
    bf16_t* dst = Y + (size_t)(mbase + wave * 32 + qt * 16 + lr) * 1024 + Y_DF + h * 64;
#pragma unroll
    for (int dt = 0; dt < 4; ++dt) {
      const int d = dt * 16 + 4 * lq;
      const float4 g4 = *(const float4*)(sg + d);
      uint2 ov;
      ov.x = pack2(O0[qt][dt][0] * rr * g4.x, O0[qt][dt][1] * rr * g4.y);
      ov.y = pack2(O0[qt][dt][2] * rr * g4.z, O0[qt][dt][3] * rr * g4.w);
      *(uint2*)(dst + d) = ov;
    }
  }
}

constexpr int NA_WS = 520;
constexpr int NA_CS = 264;
constexpr int NA_OFF_VTW = 0;
constexpr int NA_OFF_VTC = 64 * NA_WS * 2;
constexpr int NA_OFF_RPB = NA_OFF_VTC + 64 * NA_CS * 2;
constexpr int NA_OFF_MRG = NA_OFF_RPB + 2048;

#define NA_STEP(KA_EXPR, KB_EXPR, BIAS_EXPR, VT_PTR, VT_STRIDE, VT_KEY0_EXPR)                                    \
  {                                                                                                               \
    f32x4 S[4];                                                                                                   \
    _Pragma("unroll") for (int kt = 0; kt < 4; ++kt) {                                                            \
      f32x4 a = __builtin_amdgcn_mfma_f32_16x16x32_bf16((KA_EXPR), qf[0], (f32x4){0.f, 0.f, 0.f, 0.f}, 0, 0, 0);  \
      S[kt] = __builtin_amdgcn_mfma_f32_16x16x32_bf16((KB_EXPR), qf[1], a, 0, 0, 0);                               \
    }                                                                                                             \
    _Pragma("unroll") for (int kt = 0; kt < 4; ++kt) {                                                            \
      _Pragma("unroll") for (int r = 0; r < 4; ++r) { S[kt][r] += (BIAS_EXPR); }                                  \
    }                                                                                                             \
    float x = fmaxf(fmaxf(S[0][0], S[0][1]), fmaxf(S[0][2], S[0][3]));                                            \
    _Pragma("unroll") for (int kt = 1; kt < 4; ++kt) x = fmaxf(x, fmaxf(fmaxf(S[kt][0], S[kt][1]), fmaxf(S[kt][2], S[kt][3]))); \
    x = fmaxf(x, __shfl_xor(x, 16)); x = fmaxf(x, __shfl_xor(x, 32));                                             \
    const float mn = fmaxf(mrun, x);                                                                              \
    const float al = __builtin_amdgcn_exp2f(mrun - mn);                                                           \
    mrun = mn;                                                                                                    \
    float ps = 0.f;                                                                                               \
    _Pragma("unroll") for (int kt = 0; kt < 4; ++kt) {                                                            \
      _Pragma("unroll") for (int r = 0; r < 4; ++r) { S[kt][r] = __builtin_amdgcn_exp2f(S[kt][r] - mn); ps += S[kt][r]; } \
    }                                                                                                             \
    lrun = lrun * al + ps;                                                                                        \
    _Pragma("unroll") for (int dt = 0; dt < 4; ++dt) {                                                            \
      _Pragma("unroll") for (int r = 0; r < 4; ++r) O[dt][r] *= al;                                               \
    }                                                                                                             \
    _Pragma("unroll") for (int g = 0; g < 2; ++g) {                                                               \
      union { unsigned u[4]; bf16x8 v; } pf;                                                                      \
      pf.u[0] = cvt_pk_bf16(S[2 * g][0], S[2 * g][1]); pf.u[1] = cvt_pk_bf16(S[2 * g][2], S[2 * g][3]);           \
      pf.u[2] = cvt_pk_bf16(S[2 * g + 1][0], S[2 * g + 1][1]); pf.u[3] = cvt_pk_bf16(S[2 * g + 1][2], S[2 * g + 1][3]); \
      const int vk0 = (VT_KEY0_EXPR);                                                                             \
      _Pragma("unroll") for (int dt = 0; dt < 4; ++dt) {                                                          \
        union { uint2 h2[2]; bf16x8 v; } vf;                                                                      \
        vf.h2[0] = *(const uint2*)((VT_PTR) + (dt * 16 + lr) * (VT_STRIDE) + vk0 + 4 * lq);                       \
        vf.h2[1] = *(const uint2*)((VT_PTR) + (dt * 16 + lr) * (VT_STRIDE) + vk0 + 16 + 4 * lq);                  \
        O[dt] = __builtin_amdgcn_mfma_f32_16x16x32_bf16(vf.v, pf.v, O[dt], 0, 0, 0);                              \
      }                                                                                                           \
    }                                                                                                             \
  }

__device__ __forceinline__ void na_latent_item(const Params& p, int layer, int item, char* smem) {
  const bf16_t* P = (const bf16_t*)(p.ws + OFF_P);
  bf16_t* Y = (bf16_t*)(p.ws + OFF_ACT);
  const int b = item >> 8, h = (item >> 6) & 3, grow = item & 63;
  const int tid = opaque_tid(), lane = tid & 63, wave = tid >> 6, lr = lane & 15, lq = lane >> 4;
  const int jt = wave & 3, half = wave >> 2;
  bf16_t* VtW = (bf16_t*)(smem + NA_OFF_VTW);
  bf16_t* VtC = (bf16_t*)(smem + NA_OFF_VTC);
  float* RPB = (float*)(smem + NA_OFF_RPB);
  float* MRG = (float*)(smem + NA_OFF_MRG);
  const int rs = min(max(grow - 4, 0), 56);
  __syncthreads();
  {
    const int ch = tid & 7;
#pragma unroll
    for (int i = 0; i < 8; ++i) {
      const int key = (tid >> 3) + 64 * i;
      const uint4 uv = *(const uint4*)(P + (size_t)(b * 4096 + (rs + (key >> 6)) * 64 + (key & 63)) * INC + C_NAV + h * 64 + ch * 8);
      vt_store8(VtW, NA_WS, ch * 8, key, uv);
    }
#pragma unroll
    for (int i = 0; i < 4; ++i) {
      const int key = (tid >> 3) + 64 * i;
      const uint4 uv = *(const uint4*)(P + (size_t)(NLAT + b * 256 + key) * INC + C_NAV + h * 64 + ch * 8);
      vt_store8(VtC, NA_CS, ch * 8, key, uv);
    }
    if (tid < 465) RPB[tid] = p.na_rpb[(size_t)(layer * 4 + h) * 465 + tid] * 1.4426950408889634f;
  }
  const int qc = jt * 16 + lr;
  const int mq = b * 4096 + grow * 64 + qc;
  bf16x8 qf[2];
  {
    const bf16_t* qr = P + (size_t)mq * INC + C_NAQ + h * 64 + lq * 8;
    qf[0] = *(const bf16x8*)(qr);
    qf[1] = *(const bf16x8*)(qr + 32);
  }
  f32x4 O[4];
#pragma unroll
  for (int i = 0; i < 4; ++i) O[i] = (f32x4){0.f, 0.f, 0.f, 0.f};
  float mrun = -1e30f, lrun = 0.f;
  const int k0 = min(max(jt * 16 - 8, 0), 32);
  const int cs = min(max(qc - 8, 0), 48);
  bf16x8 kfa[2][4], kfb[2][4];
#define NA_LOADK(SET, S_)                                                                                        \
  _Pragma("unroll") for (int kt = 0; kt < 4; ++kt) {                                                             \
    const int t_ = 4 * (S_) + kt;                                                                                \
    const size_t krow = half == 0 ? (size_t)(b * 4096 + (rs + (t_ >> 1)) * 64 + k0 + 16 * (t_ & 1) + lr) : (size_t)(NLAT + b * 256 + 16 * t_ + lr); \
    const bf16_t* kp = P + krow * INC + C_NAK + h * 64 + lq * 8;                                                 \
    kfa[SET][kt] = *(const bf16x8*)(kp); kfb[SET][kt] = *(const bf16x8*)(kp + 32);                               \
  }
  NA_LOADK(0, 0)
  __syncthreads();
#pragma unroll
  for (int s = 0; s < 4; ++s) {
    if (s + 1 < 4) { NA_LOADK((s + 1) & 1, s + 1) }
    if (half == 0) {
      const int wr0 = 2 * s;
      NA_STEP(kfa[s & 1][kt], kfb[s & 1][kt],
              ((k0 + 16 * (kt & 1) + 4 * lq + r) >= cs && (k0 + 16 * (kt & 1) + 4 * lq + r) < cs + 16)
                  ? RPB[(rs + wr0 + (kt >> 1) - grow + 7) * 31 + (k0 + 16 * (kt & 1) + 4 * lq + r) - qc + 15] : -1e30f,
              VtW, NA_WS, (wr0 + g) * 64 + k0)
    } else {
      NA_STEP(kfa[s & 1][kt], kfb[s & 1][kt], 0.f, VtC, NA_CS, s * 64 + 32 * g)
    }
  }
  lrun += __shfl_xor(lrun, 16); lrun += __shfl_xor(lrun, 32);
  float* mg = MRG + (jt * 64 + lane) * 18;
  if (half == 1) {
    mg[0] = mrun; mg[1] = lrun;
#pragma unroll
    for (int dt = 0; dt < 4; ++dt) { mg[2 + dt * 4 + 0] = O[dt][0]; mg[2 + dt * 4 + 1] = O[dt][1]; mg[2 + dt * 4 + 2] = O[dt][2]; mg[2 + dt * 4 + 3] = O[dt][3]; }
  }
  __syncthreads();
  if (half == 0) {
    const float m2 = mg[0], l2 = mg[1];
    const float M = fmaxf(mrun, m2);
    const float f1 = __builtin_amdgcn_exp2f(mrun - M), f2 = __builtin_amdgcn_exp2f(m2 - M);
    const float inv = 1.f / (lrun * f1 + l2 * f2);
    bf16_t* dst = Y + (size_t)mq * 1024 + Y_NA + h * 64;
#pragma unroll
    for (int dt = 0; dt < 4; ++dt) {
      const float o0 = (O[dt][0] * f1 + mg[2 + dt * 4 + 0] * f2) * inv, o1 = (O[dt][1] * f1 + mg[2 + dt * 4 + 1] * f2) * inv;
      const float o2 = (O[dt][2] * f1 + mg[2 + dt * 4 + 2] * f2) * inv, o3 = (O[dt][3] * f1 + mg[2 + dt * 4 + 3] * f2) * inv;
      uint2 ov; ov.x = pack2(o0, o1); ov.y = pack2(o2, o3);
      *(uint2*)(dst + dt * 16 + 4 * lq) = ov;
    }
  }
}

__device__ __forceinline__ void na_ctx_item(const Params& p, int item, char* smem) {
  const bf16_t* P = (const bf16_t*)(p.ws + OFF_P);
  bf16_t* Y = (bf16_t*)(p.ws + OFF_ACT);
  const int b = item >> 3, h = (item >> 1) & 3, qg = item & 1;
  const int tid = opaque_tid(), lane = tid & 63, wave = tid >> 6, lr = lane & 15, lq = lane >> 4;
  bf16_t* VtC = (bf16_t*)(smem + NA_OFF_VTC);
  __syncthreads();
  {
    const int ch = tid & 7;
#pragma unroll
    for (int i = 0; i < 4; ++i) {
      const int key = (tid >> 3) + 64 * i;
      const uint4 uv = *(const uint4*)(P + (size_t)(NLAT + b * 256 + key) * INC + C_NAV + h * 64 + ch * 8);
      vt_store8(VtC, NA_CS, ch * 8, key, uv);
    }
  }
  const int mq = NLAT + b * 256 + qg * 128 + wave * 16 + lr;
  bf16x8 qf[2];
  {
    const bf16_t* qr = P + (size_t)mq * INC + C_NAQ + h * 64 + lq * 8;
    qf[0] = *(const bf16x8*)(qr);
    qf[1] = *(const bf16x8*)(qr + 32);
  }
  f32x4 O[4];
#pragma unroll
  for (int i = 0; i < 4; ++i) O[i] = (f32x4){0.f, 0.f, 0.f, 0.f};
  float mrun = -1e30f, lrun = 0.f;
  __syncthreads();
#pragma unroll 1
  for (int s = 0; s < 4; ++s) {
    NA_STEP(*(const bf16x8*)(P + (size_t)(NLAT + b * 256 + s * 64 + kt * 16 + lr) * INC + C_NAK + h * 64 + lq * 8),
            *(const bf16x8*)(P + (size_t)(NLAT + b * 256 + s * 64 + kt * 16 + lr) * INC + C_NAK + h * 64 + 32 + lq * 8), 0.f, VtC, NA_CS, s * 64 + 32 * g)
  }
  lrun += __shfl_xor(lrun, 16); lrun += __shfl_xor(lrun, 32);
  const float inv = 1.f / lrun;
  bf16_t* dst = Y + (size_t)mq * 1024 + Y_NA + h * 64;
#pragma unroll
  for (int dt = 0; dt < 4; ++dt) {
    uint2 ov; ov.x = pack2(O[dt][0] * inv, O[dt][1] * inv); ov.y = pack2(O[dt][2] * inv, O[dt][3] * inv);
    *(uint2*)(dst + dt * 16 + 4 * lq) = ov;
  }
}

constexpr int KV_S = 136;
constexpr int KV_OFF_KF = 0, KV_OFF_KB = 64 * KV_S * 2, KV_OFF_VT = 2 * 64 * KV_S * 2;
__device__ __forceinline__ void ret_kv_item(const Params& p, int layer, int h, size_t row0, int cnt, float* dstF, float* dstB, char* smem) {
  const bf16_t* P = (const bf16_t*)(p.ws + OFF_P);
  const float* misc = (const float*)(p.ws + OFF_MISC);
  const float lgF2 = misc[16 + layer * 8 + 0 * 4 + h] * 1.4426950408889634f, lgB2 = misc[16 + layer * 8 + 1 * 4 + h] * 1.4426950408889634f;
  const int tid = opaque_tid(), lane = tid & 63, wave = tid >> 6, lr = lane & 15, lq = lane >> 4;
  bf16_t* KFt = (bf16_t*)(smem + KV_OFF_KF);
  bf16_t* KBt = (bf16_t*)(smem + KV_OFF_KB);
  bf16_t* Vt = (bf16_t*)(smem + KV_OFF_VT);
  const int dir = wave >> 2, dt = wave & 3;
  f32x4 acc[8];
#pragma unroll
  for (int i = 0; i < 8; ++i) acc[i] = (f32x4){0.f, 0.f, 0.f, 0.f};
#pragma unroll 1
  for (int kc = 0; kc < (cnt >> 7); ++kc) {
    __syncthreads();
    {
      const int tok = tid >> 2, c = tid & 3;
      const int j = kc * 128 + tok;
      const float wF = __builtin_amdgcn_exp2f(lgF2 * (float)(cnt - 1 - j)), wB = __builtin_amdgcn_exp2f(lgB2 * (float)j);
      const bf16_t* rowp = P + (row0 + j) * INC;
#pragma unroll
      for (int c8 = 0; c8 < 2; ++c8) {
        const uint4 u = *(const uint4*)(rowp + C_RTK + h * 64 + c * 16 + c8 * 8);
        float kv[8];
        UNPACK8(kv, 0, u)
#pragma unroll
        for (int i = 0; i < 8; ++i) {
          KFt[(c * 16 + c8 * 8 + i) * KV_S + tok] = f2bf(kv[i] * wF);
          KBt[(c * 16 + c8 * 8 + i) * KV_S + tok] = f2bf(kv[i] * wB);
        }
      }
#pragma unroll
      for (int c8 = 0; c8 < 4; ++c8) {
        const uint4 uv = *(const uint4*)(rowp + C_RTV + h * 128 + c * 32 + c8 * 8);
        vt_store8(Vt, KV_S, c * 32 + c8 * 8, tok, uv);
      }
    }
    __syncthreads();
    const bf16_t* Kt = dir == 0 ? KFt : KBt;
    bf16x8 af[4];
#pragma unroll
    for (int ks = 0; ks < 4; ++ks) af[ks] = *(const bf16x8*)(Kt + (dt * 16 + lr) * KV_S + ks * 32 + lq * 8);
#pragma unroll
    for (int et = 0; et < 8; ++et) {
#pragma unroll
      for (int ks = 0; ks < 4; ++ks) {
        const bf16x8 bfr = *(const bf16x8*)(Vt + (et * 16 + lr) * KV_S + ks * 32 + lq * 8);
        acc[et] = __builtin_amdgcn_mfma_f32_16x16x32_bf16(af[ks], bfr, acc[et], 0, 0, 0);
      }
    }
  }
  float* dst = dir == 0 ? dstF : dstB;
#pragma unroll
  for (int et = 0; et < 8; ++et) {
#pragma unroll
    for (int r = 0; r < 4; ++r) dst[(dt * 16 + 4 * lq + r) * 128 + et * 16 + lr] = acc[et][r];
  }
}

__device__ __forceinline__ void phase_ret_scan(const Params& p, int layer) {
  const float* misc = (const float*)(p.ws + OFF_MISC);
  float* rkv = (float*)(p.ws + OFF_RKV);
  const float* rs = (const float*)(p.ws + OFF_RS);
  const int gt = opaque_bid() * 512 + opaque_tid(), gs = gridDim.x * 512;
  for (int idx = gt; idx < 64 * 2048; idx += gs) {
    const int seq = idx >> 11, e4 = (idx & 2047) * 4;
    const int dir = seq & 1, h = (seq >> 1) & 3;
    const float cdec = __expf(misc[16 + layer * 8 + dir * 4 + h] * 128.f);
    float4* base = (float4*)(rkv + (size_t)seq * 32 * 8192 + e4);
    float4 v[32];
#pragma unroll
    for (int s = 0; s < 32; ++s) v[s] = base[(size_t)s * 2048];
    float4 st = *(const float4*)(rs + (size_t)seq * 8192 + e4);
    if (dir == 0) {
#pragma unroll
      for (int s = 0; s < 32; ++s) {
        const float4 t = v[s];
        base[(size_t)s * 2048] = st;
        st.x = fmaf(cdec, st.x, t.x); st.y = fmaf(cdec, st.y, t.y); st.z = fmaf(cdec, st.z, t.z); st.w = fmaf(cdec, st.w, t.w);
      }
    } else {
#pragma unroll
      for (int s = 31; s >= 0; --s) {
        const float4 t = v[s];
        base[(size_t)s * 2048] = st;
        st.x = fmaf(cdec, st.x, t.x); st.y = fmaf(cdec, st.y, t.y); st.z = fmaf(cdec, st.z, t.z); st.w = fmaf(cdec, st.w, t.w);
      }
    }
  }
}

constexpr int RT_KS = 72, RT_VS = 136;
constexpr int RT_OFF_K = 0, RT_OFF_VT = 128 * RT_KS * 2, RT_OFF_SF = RT_OFF_VT + 128 * RT_VS * 2, RT_OFF_SB = RT_OFF_SF + 128 * RT_KS * 2;
__device__ __forceinline__ void ret_out_item(const Params& p, int layer, int h, size_t krow0, int nkc, int iq0,
                                             const float* SF, const float* SB, int clen, char* smem) {
  const bf16_t* P = (const bf16_t*)(p.ws + OFF_P);
  bf16_t* Y = (bf16_t*)(p.ws + OFF_ACT);
  const float* misc = (const float*)(p.ws + OFF_MISC);
  const float lgF2 = misc[16 + layer * 8 + 0 * 4 + h] * 1.4426950408889634f, lgB2 = misc[16 + layer * 8 + 1 * 4 + h] * 1.4426950408889634f;
  const int tid = opaque_tid(), lane = tid & 63, wave = tid >> 6, lr = lane & 15, lq = lane >> 4;
  bf16_t* Ks = (bf16_t*)(smem + RT_OFF_K);
  bf16_t* Vt = (bf16_t*)(smem + RT_OFF_VT);
  bf16_t* SFt = (bf16_t*)(smem + RT_OFF_SF);
  bf16_t* SBt = (bf16_t*)(smem + RT_OFF_SB);
  const int iq = iq0 + wave * 16 + lr;
  const size_t mq = krow0 + iq;
  bf16x8 qf[2];
  {
    const bf16_t* qr = P + mq * INC + C_RTQ + h * 64 + lq * 8;
    qf[0] = *(const bf16x8*)(qr);
    qf[1] = *(const bf16x8*)(qr + 32);
  }
  f32x4 O[8];
#pragma unroll
  for (int i = 0; i < 8; ++i) O[i] = (f32x4){0.f, 0.f, 0.f, 0.f};
  if (SF != nullptr) {
    __syncthreads();
    {
      const int d = tid >> 3, e0 = (tid & 7) * 16;
#pragma unroll
      for (int c4 = 0; c4 < 4; ++c4) {
        const float4 a = *(const float4*)(SF + d * 128 + e0 + c4 * 4);
        const float4 bb = *(const float4*)(SB + d * 128 + e0 + c4 * 4);
        SFt[(e0 + c4 * 4 + 0) * RT_KS + d] = f2bf(a.x); SFt[(e0 + c4 * 4 + 1) * RT_KS + d] = f2bf(a.y);
        SFt[(e0 + c4 * 4 + 2) * RT_KS + d] = f2bf(a.z); SFt[(e0 + c4 * 4 + 3) * RT_KS + d] = f2bf(a.w);
        SBt[(e0 + c4 * 4 + 0) * RT_KS + d] = f2bf(bb.x); SBt[(e0 + c4 * 4 + 1) * RT_KS + d] = f2bf(bb.y);
        SBt[(e0 + c4 * 4 + 2) * RT_KS + d] = f2bf(bb.z); SBt[(e0 + c4 * 4 + 3) * RT_KS + d] = f2bf(bb.w);
      }
    }
    __syncthreads();
    const float cF = __builtin_amdgcn_exp2f(lgF2 * (float)(iq + 1)), cB = __builtin_amdgcn_exp2f(lgB2 * (float)(clen - iq));
#pragma unroll
    for (int ks = 0; ks < 2; ++ks)
#pragma unroll
      for (int et = 0; et < 8; ++et) {
        const bf16x8 sf = *(const bf16x8*)(SFt + (et * 16 + lr) * RT_KS + ks * 32 + lq * 8);
        O[et] = __builtin_amdgcn_mfma_f32_16x16x32_bf16(sf, qf[ks], O[et], 0, 0, 0);
      }
    const float ratio = cF / cB;
#pragma unroll
    for (int et = 0; et < 8; ++et) { O[et][0] *= ratio; O[et][1] *= ratio; O[et][2] *= ratio; O[et][3] *= ratio; }
#pragma unroll
    for (int ks = 0; ks < 2; ++ks)
#pragma unroll
      for (int et = 0; et < 8; ++et) {
        const bf16x8 sb = *(const bf16x8*)(SBt + (et * 16 + lr) * RT_KS + ks * 32 + lq * 8);
        O[et] = __builtin_amdgcn_mfma_f32_16x16x32_bf16(sb, qf[ks], O[et], 0, 0, 0);
      }
#pragma unroll
    for (int et = 0; et < 8; ++et) { O[et][0] *= cB; O[et][1] *= cB; O[et][2] *= cB; O[et][3] *= cB; }
  }
#pragma unroll 1
  for (int kc = 0; kc < nkc; ++kc) {
    __syncthreads();
    {
      const int key = tid >> 2, c = tid & 3;
      const bf16_t* rowp = P + (krow0 + kc * 128 + key) * INC;
      const uint4 k0 = *(const uint4*)(rowp + C_RTK + h * 64 + c * 16), k1 = *(const uint4*)(rowp + C_RTK + h * 64 + c * 16 + 8);
      *(uint4*)(Ks + key * RT_KS + c * 16) = k0;
      *(uint4*)(Ks + key * RT_KS + c * 16 + 8) = k1;
#pragma unroll
      for (int c8 = 0; c8 < 4; ++c8) {
        const uint4 uv = *(const uint4*)(rowp + C_RTV + h * 128 + c * 32 + c8 * 8);
        vt_store8(Vt, RT_VS, c * 32 + c8 * 8, key, uv);
      }
    }
    __syncthreads();
    f32x4 S[8];
#pragma unroll
    for (int kt = 0; kt < 8; ++kt) {
      const bf16x8 ka = *(const bf16x8*)(Ks + (kt * 16 + lr) * RT_KS + lq * 8);
      const bf16x8 kb = *(const bf16x8*)(Ks + (kt * 16 + lr) * RT_KS + 32 + lq * 8);
      const f32x4 a = __builtin_amdgcn_mfma_f32_16x16x32_bf16(ka, qf[0], (f32x4){0.f, 0.f, 0.f, 0.f}, 0, 0, 0);
      S[kt] = __builtin_amdgcn_mfma_f32_16x16x32_bf16(kb, qf[1], a, 0, 0, 0);
    }
#pragma unroll
    for (int kt = 0; kt < 8; ++kt) {
#pragma unroll
      for (int r = 0; r < 4; ++r) {
        const int df = iq - (kc * 128 + kt * 16 + 4 * lq + r);
        const float fdf = (float)df;
        float coef = 0.f;
        if (df >= 0) coef += __builtin_amdgcn_exp2f(lgF2 * fdf);
        if (df <= 0) coef += __builtin_amdgcn_exp2f(-lgB2 * fdf);
        S[kt][r] *= coef;
      }
    }
#pragma unroll
    for (int g = 0; g < 4; ++g) {
      union { unsigned u[4]; bf16x8 v; } pf;
      pf.u[0] = cvt_pk_bf16(S[2 * g][0], S[2 * g][1]); pf.u[1] = cvt_pk_bf16(S[2 * g][2], S[2 * g][3]);
      pf.u[2] = cvt_pk_bf16(S[2 * g + 1][0], S[2 * g + 1][1]); pf.u[3] = cvt_pk_bf16(S[2 * g + 1][2], S[2 * g + 1][3]);
#pragma unroll
      for (int et = 0; et < 8; ++et) {
        union { uint2 h2[2]; bf16x8 v; } vf;
        vf.h2[0] = *(const uint2*)(Vt + (et * 16 + lr) * RT_VS + 32 * g + 4 * lq);
        vf.h2[1] = *(const uint2*)(Vt + (et * 16 + lr) * RT_VS + 32 * g + 16 + 4 * lq);
        O[et] = __builtin_amdgcn_mfma_f32_16x16x32_bf16(vf.v, pf.v, O[et], 0, 0, 0);
      }
    }
  }
  float ss = 0.f;
#pragma unroll
  for (int et = 0; et < 8; ++et) { ss = fmaf(O[et][0], O[et][0], ss); ss = fmaf(O[et][1], O[et][1], ss); ss = fmaf(O[et][2], O[et][2], ss); ss = fmaf(O[et][3], O[et][3], ss); }
  ss += __shfl_xor(ss, 16); ss += __shfl_xor(ss, 32);
  const float rr = rsqrtf(ss * (1.f / 128.f) + EPS);
  const bf16_t* gp = P + mq * INC + C_RTG + h * 128;
  bf16_t* dst = Y + mq * 1024 + Y_RT + h * 128;
#pragma unroll
  for (int et = 0; et < 8; ++et) {
    const int e = et * 16 + 4 * lq;
    const uint2 gu = *(const uint2*)(gp + e);
    uint2 ov;
    ov.x = pack2(O[et][0] * rr * siluf(lo16(gu.x)), O[et][1] * rr * siluf(hi16(gu.x)));
    ov.y = pack2(O[et][2] * rr * siluf(lo16(gu.y)), O[et][3] * rr * siluf(hi16(gu.y)));
    *(uint2*)(dst + e) = ov;
  }
}

__device__ __forceinline__ void uv_convert_item(const Params& p, int item) {
  char* ws = p.ws;
  const int tid = opaque_tid();
  const int lane = tid & 63, l = lane & 31, half = lane >> 5, wave = tid >> 6;
#pragma unroll 1
  for (int it = 0; it < 16; ++it) {
    const int row = item * 256 + (wave * 16 + it) * 2 + half;
    const bool isv = row >= 2 * NEXP;
    const int rr = isv ? row - 2 * NEXP : row;
    const float* srow = (isv ? p.peer_v : p.peer_u) + (size_t)rr * 1024;
    float4 v[8];
    float mx = 0.f;
#pragma unroll
    for (int j = 0; j < 8; ++j) {
      v[j] = ((const float4*)srow)[isv ? (l + 32 * j) : (l * 8 + j)];
      mx = fmaxf(mx, fmaxf(fmaxf(fabsf(v[j].x), fabsf(v[j].y)), fmaxf(fabsf(v[j].z), fabsf(v[j].w))));
    }
#pragma unroll
    for (int o = 1; o < 32; o <<= 1) mx = fmaxf(mx, __shfl_xor(mx, o));
    const float scale4 = mx > 0.f ? mx * (1.f / 6.f) : 1.f;
    const float inv4 = 1.f / scale4;
    unsigned w[4] = {0u, 0u, 0u, 0u};
#pragma unroll
    for (int k = 0; k < 32; ++k) {
      const float xv = (k & 3) == 0 ? v[k >> 2].x : (k & 3) == 1 ? v[k >> 2].y : (k & 3) == 2 ? v[k >> 2].z : v[k >> 2].w;
      const float a = fminf(fabsf(xv) * inv4, 6.f);
      float c;
      if (a < 2.f) c = rintf(a * 2.f);
      else if (a < 4.f) c = 4.f + rintf(a - 2.f);
      else c = 6.f + rintf((a - 4.f) * 0.5f);
      unsigned code = (unsigned)c;
      code = code > 7u ? 7u : code;
      code |= (xv < 0.f) ? 8u : 0u;
      w[k >> 3] |= code << (4 * (k & 7));
    }
    char* drow = ws + OFF_U + (size_t)rr * RECB + (isv ? ROWB + l * 16 : 64 * (l & 7) + 16 * (l >> 3));
    *(uint4*)(drow) = make_uint4(w[0], w[1], w[2], w[3]);
    if (l == 0) ((float*)(ws + (isv ? OFF_VSC : OFF_USC)))[rr] = scale4;
  }
}

__device__ __forceinline__ void phase_mix1(const Params& p, int layer, char* smem, int slot = 0) {
  unsigned* ctr = (unsigned*)(p.ws + OFF_CTL) + (layer * 4 + slot);
  const bool nc = layer == 0;
  const int n_dl = 512, n_dc = nc ? 32 : 0, n_nl = 2048, n_ncx = nc ? 64 : 0, n_kv = 1024, n_cs = 32;
  const int total = n_dl + n_dc + n_nl + n_ncx + n_kv + n_cs;
  float* rkv = (float*)(p.ws + OFF_RKV);
  float* rs = (float*)(p.ws + OFF_RS);
  for (;;) {
    int it = next_item(ctr, smem);
    if (it >= total) break;
    if (it < n_dl) { diff_item(p, layer, false, it, smem); continue; } it -= n_dl;
    if (it < n_dc) { diff_item(p, layer, true, it, smem); continue; } it -= n_dc;
    if (it < n_nl) { na_latent_item(p, layer, it, smem); continue; } it -= n_nl;
    if (it < n_ncx) { na_ctx_item(p, it, smem); continue; } it -= n_ncx;
    if (it < n_kv) {
      const int bh = it >> 5, n = it & 31, b = bh >> 2, h = bh & 3;
      ret_kv_item(p, layer, h, (size_t)b * 4096 + n * 128, 128,
                  rkv + ((size_t)(bh * 2 + 0) * 32 + n) * 8192, rkv + ((size_t)(bh * 2 + 1) * 32 + n) * 8192, smem);
      continue;
    }
    it -= n_kv;
    {
      const int bh = it, b = bh >> 2, h = bh & 3;
      ret_kv_item(p, layer, h, (size_t)NLAT + b * 256, 256, rs + (size_t)(bh * 2 + 0) * 8192, rs + (size_t)(bh * 2 + 1) * 8192, smem);
    }
  }
}

__device__ __forceinline__ void phase_mix2(const Params& p, int layer, char* smem, int slot = 1) {
  unsigned* ctr = (unsigned*)(p.ws + OFF_CTL) + (layer * 4 + slot);
  const int n_l = 1024, n_c = layer == 0 ? 64 : 0;
  const float* rkv = (const float*)(p.ws + OFF_RKV);
  for (;;) {
    int it = next_item(ctr, smem);
    if (it >= n_l + n_c) break;
    if (it < n_l) {
      const int bh = it >> 5, n = it & 31, b = bh >> 2, h = bh & 3;
      ret_out_item(p, layer, h, (size_t)b * 4096 + n * 128, 1, 0,
                   rkv + ((size_t)(bh * 2 + 0) * 32 + n) * 8192, rkv + ((size_t)(bh * 2 + 1) * 32 + n) * 8192, 128, smem);
    } else {
      it -= n_l;
      const int bh = it >> 1, half = it & 1, b = bh >> 2, h = bh & 3;
      ret_out_item(p, layer, h, (size_t)NLAT + b * 256, 2, half * 128, nullptr, nullptr, 256, smem);
    }
  }
}

typedef float f32x2 __attribute__((ext_vector_type(2)));
__device__ __forceinline__ unsigned sortable_key(float f, int idx) {
  const unsigned b = __float_as_uint(f);
  const unsigned k = b ^ ((unsigned)((int)b >> 31) | 0x80000000u);
  return (k & ~127u) | (unsigned)(127 - idx);
}
__device__ __forceinline__ float key_value(unsigned k) {
  k &= ~127u;
  const unsigned b = (k & 0x80000000u) ? (k ^ 0x80000000u) : ~k;
  return __uint_as_float(b);
}
#define FP8DOT(acc, H, off, W) { const f32x2 _a = __builtin_amdgcn_cvt_pk_f32_fp8((int)(W), false), _b = __builtin_amdgcn_cvt_pk_f32_fp8((int)(W), true); \
  acc = fmaf(H[(off) + 0], _a.x, acc); acc = fmaf(H[(off) + 1], _a.y, acc); acc = fmaf(H[(off) + 2], _b.x, acc); acc = fmaf(H[(off) + 3], _b.y, acc); }
#define FP8AXPY(O, off, P, W) { const f32x2 _a = __builtin_amdgcn_cvt_pk_f32_fp8((int)(W), false), _b = __builtin_amdgcn_cvt_pk_f32_fp8((int)(W), true); \
  O[(off) + 0] = fmaf(P, _a.x, O[(off) + 0]); O[(off) + 1] = fmaf(P, _a.y, O[(off) + 1]); O[(off) + 2] = fmaf(P, _b.x, O[(off) + 2]); O[(off) + 3] = fmaf(P, _b.y, O[(off) + 3]); }

__device__ __forceinline__ float gelu_erf(float a) {
  const float x = fabsf(a) * 0.70710678118654752f;
  const float t = __builtin_amdgcn_rcpf(fmaf(0.3275911f, x, 1.f));
  float pl = fmaf(1.061405429f, t, -1.453152027f);
  pl = fmaf(pl, t, 1.421413741f); pl = fmaf(pl, t, -0.284496736f); pl = fmaf(pl, t, 0.254829592f);
  const float y = 1.f - pl * t * __builtin_amdgcn_exp2f(-x * x * 1.4426950408889634f);
  const float er = a < 0.f ? -y : y;
  return 0.5f * a * (1.f + er);
}
constexpr int PE_SVS = 132;
constexpr int PE_OFF_SV = 0;
constexpr int PE_OFF_TV = 8 * 16 * PE_SVS * 4;
constexpr int PE_OFF_TI = PE_OFF_TV + 16 * 16 * 16 * 4;
constexpr int PE_OFF_EX = PE_OFF_TI + 16 * 16 * 16 * 4;
constexpr int PE_OFF_GT = PE_OFF_EX + 2 * 16 * 128 * 4;
constexpr int PE_OFF_SU = PE_OFF_GT + 2 * 16 * 128 * 4;
constexpr int PE_OFF_CN = PE_OFF_SU + 2 * 16 * 128 * 4;
constexpr int PE_OFF_CT = PE_OFF_CN + 8 * 16 * 4;
constexpr int PE_OFF_TQ = PE_OFF_CT + 64 * 4;
static_assert(PE_OFF_TQ + 16 <= LDS_BCAST, "PEER LDS map overflows");
#define WAVE_LDS_FENCE() asm volatile("s_waitcnt lgkmcnt(0)" ::: "memory")

__device__ __forceinline__ void peer_select_head(const Params& p, int layer, char* smem, int tok0, int hd, int sw, int buf,
                                                 int lane) {
  const bf16_t* Q = (const bf16_t*)(p.ws + OFF_P);
  const bf16_t* SK = (const bf16_t*)(p.ws + OFF_SUBK) + (size_t)layer * 262144;
  const int lr = lane & 15, lq = lane >> 4;
  unsigned* SV = (unsigned*)(smem + PE_OFF_SV) + sw * 16 * PE_SVS;
  float* TV = (float*)(smem + PE_OFF_TV);
  int* TI = (int*)(smem + PE_OFF_TI);
  int* EX = (int*)(smem + PE_OFF_EX) + buf * 16 * 128;
  float* GT = (float*)(smem + PE_OFF_GT) + buf * 16 * 128;
  int* CN = (int*)(smem + PE_OFF_CN) + sw * 16;
  float* SU = (float*)(smem + PE_OFF_SU) + buf * 16 * 128;
  const float* USC = (const float*)(p.ws + OFF_USC) + layer * NEXP;
  const float* VSC = (const float*)(p.ws + OFF_VSC) + layer * NEXP;
#pragma unroll 1
  for (int pp = 0; pp < 2; ++pp) {
    bf16x8 af[4];
    const bf16_t* qrow = Q + (size_t)(tok0 + lr) * 2048 + hd * 256 + pp * 128;
#pragma unroll
    for (int ks = 0; ks < 4; ++ks) af[ks] = *(const bf16x8*)(qrow + ks * 32 + lq * 8);
    const bf16_t* skb = SK + (size_t)((hd * 2 + pp) * 128) * 128;
    f32x4 acc[8];
    {
      bf16x8 bfr[8][4];
#pragma unroll
      for (int nt = 0; nt < 8; ++nt)
#pragma unroll
        for (int ks = 0; ks < 4; ++ks)
          bfr[nt][ks] = *(const bf16x8*)(skb + (size_t)(nt * 16 + lr) * 128 + ks * 32 + lq * 8);
#pragma unroll
      for (int nt = 0; nt < 8; ++nt) {
        f32x4 a = (f32x4){0.f, 0.f, 0.f, 0.f};
#pragma unroll
        for (int ks = 0; ks < 4; ++ks) a = __builtin_amdgcn_mfma_f32_16x16x32_bf16(af[ks], bfr[nt][ks], a, 0, 0, 0);
        acc[nt] = a;
      }
    }
#pragma unroll
    for (int i = 0; i < 9; ++i) { const int q4 = lane + 64 * i; if (q4 < 16 * PE_SVS / 4) ((uint4*)SV)[q4] = make_uint4(0u, 0u, 0u, 0u); }
    WAVE_LDS_FENCE();
#pragma unroll
    for (int r = 0; r < 4; ++r) {
      const int tk = 4 * lq + r;
      unsigned k[8];
#pragma unroll
      for (int nt = 0; nt < 8; ++nt) k[nt] = sortable_key(acc[nt][r], nt * 16 + lr);
      unsigned m1 = max(k[0], k[1]), m2 = min(k[0], k[1]);
#pragma unroll
      for (int nt = 2; nt < 8; ++nt) { m2 = max(m2, min(m1, k[nt])); m1 = max(m1, k[nt]); }
      const unsigned Ta = row16_min_u32(m1);
      const unsigned Tb = min(row16_kth_largest<11>(m1), row16_kth_largest<5>(m2));
      const unsigned T = max(Ta, Tb);
      int pos = 0;
#pragma unroll
      for (int nt = 0; nt < 8; ++nt) {
        const bool sel = k[nt] >= T;
        const unsigned long long bal = __ballot(sel);
        const unsigned grp16 = (unsigned)(bal >> (16 * lq)) & 0xffffu;
        const int below = __popc(grp16 & ((1u << lr) - 1u));
        if (sel) SV[tk * PE_SVS + pos + below] = k[nt];
        pos += __popc(grp16);
      }
      if (lr == 0) CN[tk] = pos;
    }
    WAVE_LDS_FENCE();
#pragma unroll 1
    for (int pass = 0; pass < 4; ++pass) {
      const int tk = pass * 4 + lq;
      const int cnt = CN[tk];
      const unsigned* row = SV + tk * PE_SVS;
      int cm = cnt;
      cm = max(cm, __shfl_xor(cm, 16)); cm = max(cm, __shfl_xor(cm, 32));
      const int cmax = __builtin_amdgcn_readfirstlane(cm);
      const int nblk = (cmax + 15) >> 4;
#pragma unroll 1
      for (int rd = 0; rd < nblk; ++rd) {
        const int j = rd * 16 + lr;
        const unsigned my = row[j];
        int rank = 0;
#pragma unroll 1
        for (int b4 = 0; b4 < nblk; ++b4) {
          const uint4 v0 = *(const uint4*)(row + b4 * 16), v1 = *(const uint4*)(row + b4 * 16 + 4);
          const uint4 v2 = *(const uint4*)(row + b4 * 16 + 8), v3 = *(const uint4*)(row + b4 * 16 + 12);
          rank += (v0.x > my) ? 1 : 0; rank += (v0.y > my) ? 1 : 0; rank += (v0.z > my) ? 1 : 0; rank += (v0.w > my) ? 1 : 0;
          rank += (v1.x > my) ? 1 : 0; rank += (v1.y > my) ? 1 : 0; rank += (v1.z > my) ? 1 : 0; rank += (v1.w > my) ? 1 : 0;
          rank += (v2.x > my) ? 1 : 0; rank += (v2.y > my) ? 1 : 0; rank += (v2.z > my) ? 1 : 0; rank += (v2.w > my) ? 1 : 0;
          rank += (v3.x > my) ? 1 : 0; rank += (v3.y > my) ? 1 : 0; rank += (v3.z > my) ? 1 : 0; rank += (v3.w > my) ? 1 : 0;
        }
        if (j < cnt && rank < 16) {
          TV[(tk * 16 + hd * 2 + pp) * 16 + rank] = key_value(my);
          TI[(tk * 16 + hd * 2 + pp) * 16 + rank] = 127 - (int)(my & 127u);
        }
      }
    }
    WAVE_LDS_FENCE();
  }
  {
    const int cab = ((const int*)(smem + PE_OFF_CT))[lane];
    const int cand_a = cab >> 4, cand_b = cab & 15;
    unsigned* CWt = SV;
    float vals[16];
#pragma unroll
    for (int tk = 0; tk < 16; ++tk) {
      float val = 0.f;
      unsigned key = 0u;
      if (cand_a >= 0) {
        val = TV[(tk * 16 + hd * 2 + 0) * 16 + cand_a] + TV[(tk * 16 + hd * 2 + 1) * 16 + cand_b];
        const unsigned bb = __float_as_uint(val);
        key = ((bb ^ ((unsigned)((int)bb >> 31) | 0x80000000u)) & ~63u) | (unsigned)(63 - lane);
      }
      vals[tk] = val;
      CWt[tk * 64 + lane] = key;
    }
    WAVE_LDS_FENCE();
#pragma unroll
    for (int tk = 0; tk < 16; ++tk) {
      const unsigned key = CWt[tk * 64 + lane];
      int rank = 0;
#pragma unroll
      for (int i4 = 0; i4 < 13; ++i4) {
        const uint4 v = *(const uint4*)(CWt + tk * 64 + i4 * 4);
        rank += (v.x > key) ? 1 : 0; rank += (v.y > key) ? 1 : 0; rank += (v.z > key) ? 1 : 0; rank += (v.w > key) ? 1 : 0;
      }
      if (cand_a >= 0 && rank < 16) {
        GT[tk * 128 + hd * 16 + rank] = vals[tk];
        EX[tk * 128 + hd * 16 + rank] = TI[(tk * 16 + hd * 2 + 0) * 16 + cand_a] * 128 + TI[(tk * 16 + hd * 2 + 1) * 16 + cand_b];
      }
    }
    WAVE_LDS_FENCE();
#pragma unroll
    for (int pass = 0; pass < 4; ++pass) {
      const int tk = pass * 4 + lq;
      const float g = GT[tk * 128 + hd * 16 + lr];
      const float mx = GT[tk * 128 + hd * 16];
      const float ev = __expf(g - mx);
      float s = ev;
      s += __shfl_xor(s, 1); s += __shfl_xor(s, 2); s += __shfl_xor(s, 4); s += __shfl_xor(s, 8);
      const int ex = EX[tk * 128 + hd * 16 + lr];
      GT[tk * 128 + hd * 16 + lr] = (ev / s) * VSC[ex];
      SU[tk * 128 + hd * 16 + lr] = USC[ex];
    }
    WAVE_LDS_FENCE();
  }
}

typedef float f32x32 __attribute__((ext_vector_type(32)));
typedef int i32x8 __attribute__((ext_vector_type(8)));
typedef int i32x6 __attribute__((ext_vector_type(6)));
typedef unsigned u32x6 __attribute__((ext_vector_type(6)));
#define FP4_AXPY8(O, off, P, W) {                                                                    \
  const f32x2 _q0 = __builtin_amdgcn_cvt_scalef32_pk_f32_fp4((W), 1.0f, 0), _q1 = __builtin_amdgcn_cvt_scalef32_pk_f32_fp4((W), 1.0f, 1); \
  const f32x2 _q2 = __builtin_amdgcn_cvt_scalef32_pk_f32_fp4((W), 1.0f, 2), _q3 = __builtin_amdgcn_cvt_scalef32_pk_f32_fp4((W), 1.0f, 3); \
  O[(off) + 0] = fmaf(P, _q0.x, O[(off) + 0]); O[(off) + 1] = fmaf(P, _q0.y, O[(off) + 1]);          \
  O[(off) + 2] = fmaf(P, _q1.x, O[(off) + 2]); O[(off) + 3] = fmaf(P, _q1.y, O[(off) + 3]);          \
  O[(off) + 4] = fmaf(P, _q2.x, O[(off) + 4]); O[(off) + 5] = fmaf(P, _q2.y, O[(off) + 5]);          \
  O[(off) + 6] = fmaf(P, _q3.x, O[(off) + 6]); O[(off) + 7] = fmaf(P, _q3.y, O[(off) + 7]); }
struct Fp6Row { uint4 a; uint2 b; };
typedef __bf16 bf16x32_t __attribute__((ext_vector_type(32)));
__device__ __forceinline__ bf16x32_t fp6_decode_bf16(const Fp6Row& r) {
  u32x6 w; w[0] = r.a.x; w[1] = r.a.y; w[2] = r.a.z; w[3] = r.a.w; w[4] = r.b.x; w[5] = r.b.y;
  return __builtin_amdgcn_cvt_scalef32_pk32_bf16_fp6(w, 1.0f);
}
__device__ __forceinline__ f32x32 fp6_decode(const Fp6Row& r) {
  u32x6 w; w[0] = r.a.x; w[1] = r.a.y; w[2] = r.a.z; w[3] = r.a.w; w[4] = r.b.x; w[5] = r.b.y;
  return __builtin_amdgcn_cvt_scalef32_pk32_f32_fp6(w, 1.0f);
}
__device__ __forceinline__ void peer_gather_token(const Params& p, int layer, char* smem, int tok, int tl, int buf, int lane, bool dowrite) {
  const bf16_t* H2 = (const bf16_t*)(p.ws + OFF_ACT);
  const char* U6 = p.ws + OFF_U + (size_t)layer * NEXP * RECB;
  const float* mod = (const float*)(p.ws + OFF_MOD) + (size_t)layer * 9 * 6144;
  const int* EX = (const int*)(smem + PE_OFF_EX) + buf * 16 * 128 + tl * 128;
  const float* GT = (const float*)(smem + PE_OFF_GT) + buf * 16 * 128 + tl * 128;
  const float* SU = (const float*)(smem + PE_OFF_SU) + buf * 16 * 128 + tl * 128;
  const int l = lane & 31, hf = lane >> 5;
  float acc[32];
  const int wv = __builtin_amdgcn_readfirstlane(threadIdx.x >> 6);
  unsigned char* XB = (unsigned char*)(smem + PE_OFF_SV) + wv * 16 * PE_SVS * 4;
  float* WD = (float*)(XB + 1024);
#define PE_LOADV(VV, PI) VV = *(const uint4*)(U6 + (size_t)EX[2 * (PI) + hf] * RECB + ROWB + l * 16);
  uint4 v0, v1, v2, v3, v4, v5, v6, v7;
  PE_LOADV(v0, 0) PE_LOADV(v1, 1) PE_LOADV(v2, 2) PE_LOADV(v3, 3) PE_LOADV(v4, 4) PE_LOADV(v5, 5) PE_LOADV(v6, 6) PE_LOADV(v7, 7)
  float xscale;
  {
    const bf16_t* hr = H2 + (size_t)tok * 1024 + lane * 16;
    const uint4 a = *(const uint4*)hr, b2 = *(const uint4*)(hr + 8);
    float xv[16];
    UNPACK8(xv, 0, a) UNPACK8(xv, 8, b2)
    float mx = 0.f;
#pragma unroll
    for (int i = 0; i < 16; ++i) mx = fmaxf(mx, fabsf(xv[i]));
#pragma unroll
    for (int o = 1; o < 64; o <<= 1) mx = fmaxf(mx, __shfl_xor(mx, o));
    xscale = mx > 0.f ? mx * (1.f / 7.5f) : 1.f;
    const float inv = 1.f / xscale;
    unsigned w0 = 0u, w1 = 0u, w2 = 0u;
#pragma unroll
    for (int i = 0; i < 16; ++i) {
      const float av = fminf(fabsf(xv[i]) * inv, 7.5f);
      float c;
      if (av < 2.f) c = rintf(av * 8.f);
      else if (av < 4.f) c = 16.f + rintf((av - 2.f) * 4.f);
      else c = 24.f + rintf((av - 4.f) * 2.f);
      unsigned code = (unsigned)c;
      code = code > 31u ? 31u : code;
      code |= (xv[i] < 0.f) ? 32u : 0u;
      const int bit = 6 * i, wd = bit >> 5, sh = bit & 31;
      if (wd == 0) w0 |= code << sh; else if (wd == 1) w1 |= code << sh; else w2 |= code << sh;
      if (sh > 26) { if (wd == 0) w1 |= code >> (32 - sh); else if (wd == 1) w2 |= code >> (32 - sh); }
    }
    unsigned* xo = (unsigned*)(XB + lane * 12);
    xo[0] = w0; xo[1] = w1; xo[2] = w2;
  }
  WAVE_LDS_FENCE();
  {
    const int e16 = lane & 15, kg = lane >> 4;
    i32x8 Bx[8];
#pragma unroll
    for (int kb = 0; kb < 8; ++kb) {
      const uint2* bp = (const uint2*)(XB + 192 * kg + 24 * kb);
      const uint2 b0 = bp[0], b1 = bp[1], b2 = bp[2];
      Bx[kb] = (i32x8){(int)b0.x, (int)b0.y, (int)b1.x, (int)b1.y, (int)b2.x, (int)b2.y, 0, 0};
    }
    uint4 qa[8], qb[8], qc[8];
#define PE_LOADA(Q, EB) { const char* up = U6 + (size_t)EX[(EB) * 16 + e16] * RECB + 16 * kg;              \
    _Pragma("unroll") for (int i = 0; i < 8; ++i) Q[i] = *(const uint4*)(up + 64 * i); }
#define PE_MMAU(Q, EB) {                                                                                     \
    f32x4 dacc = {0.f, 0.f, 0.f, 0.f};                                                                       \
    _Pragma("unroll") for (int kb = 0; kb < 8; ++kb) {                                                       \
      const i32x8 av = {(int)Q[kb].x, (int)Q[kb].y, (int)Q[kb].z, (int)Q[kb].w, 0, 0, 0, 0};                 \
      dacc = __builtin_amdgcn_mfma_scale_f32_16x16x128_f8f6f4(av, Bx[kb], dacc, 4, 2, 0, 0x7f7f7f7f, 0, 0x7f7f7f7f); \
    }                                                                                                        \
    asm volatile("" : "+v"(dacc));        \
    if (e16 == 0) *(float4*)(WD + (EB) * 16 + 4 * kg) = (float4){dacc[0], dacc[1], dacc[2], dacc[3]};        \
  }
    PE_LOADA(qa, 0) PE_LOADA(qb, 1)
    PE_LOADA(qc, 2) PE_MMAU(qa, 0)
    PE_LOADA(qa, 3) PE_MMAU(qb, 1)
    PE_LOADA(qb, 4) PE_MMAU(qc, 2)
    PE_LOADA(qc, 5) PE_MMAU(qa, 3)
    PE_LOADA(qa, 6) PE_MMAU(qb, 4)
    PE_LOADA(qb, 7) PE_MMAU(qc, 5)
    PE_MMAU(qa, 6)
    PE_MMAU(qb, 7)
  }
  WAVE_LDS_FENCE();
#pragma unroll
  for (int q = 0; q < 2; ++q) {
    const int e = lane + 64 * q;
    WD[e] = GT[e] * gelu_erf(WD[e] * SU[e] * xscale);
  }
  WAVE_LDS_FENCE();
#pragma unroll
  for (int i = 0; i < 32; ++i) acc[i] = 0.f;
  int one = 1;
  asm volatile("" : "+s"(one));
#define PE_USEV(VV, PI)                                                               \
  _Pragma("unroll 1") for (int rep_ = 0; rep_ < one; ++rep_) {                        \
    const float w = WD[2 * (PI) + hf];                                                \
    FP4_AXPY8(acc, 0, w, VV.x) FP4_AXPY8(acc, 8, w, VV.y) FP4_AXPY8(acc, 16, w, VV.z) FP4_AXPY8(acc, 24, w, VV.w) \
  }
#pragma unroll 1
  for (int pi = 0; pi < 56; pi += 8) {
    PE_USEV(v0, pi) PE_LOADV(v0, pi + 8)
    PE_USEV(v1, pi + 1) PE_LOADV(v1, pi + 9)
    PE_USEV(v2, pi + 2) PE_LOADV(v2, pi + 10)
    PE_USEV(v3, pi + 3) PE_LOADV(v3, pi + 11)
    PE_USEV(v4, pi + 4) PE_LOADV(v4, pi + 12)
    PE_USEV(v5, pi + 5) PE_LOADV(v5, pi + 13)
    PE_USEV(v6, pi + 6) PE_LOADV(v6, pi + 14)
    PE_USEV(v7, pi + 7) PE_LOADV(v7, pi + 15)
  }
  PE_USEV(v0, 56) PE_USEV(v1, 57) PE_USEV(v2, 58) PE_USEV(v3, 59) PE_USEV(v4, 60) PE_USEV(v5, 61) PE_USEV(v6, 62) PE_USEV(v7, 63)
#pragma unroll
  for (int k = 0; k < 32; ++k) acc[k] += __shfl_xor(acc[k], 32);
  const int b = tok < NLAT ? (tok >> 12) : 8;
  float* xr = tok < NLAT ? p.out + (size_t)tok * 1024 : (float*)(p.ws + OFF_CTXB) + (size_t)(tok - NLAT) * 1024;
  const float* gate = mod + (size_t)b * 6144 + 5 * 1024;
  float4 xn[4];
  float ss = 0.f;
#pragma unroll
  for (int jj = 0; jj < 4; ++jj) {
    const int c = (l + 32 * (4 * hf + jj)) * 4;
    const float4 xv = *(const float4*)(xr + c);
    const float4 gv = *(const float4*)(gate + c);
    const float a0 = hf ? acc[16 + 4 * jj + 0] : acc[4 * jj + 0], a1 = hf ? acc[16 + 4 * jj + 1] : acc[4 * jj + 1];
    const float a2 = hf ? acc[16 + 4 * jj + 2] : acc[4 * jj + 2], a3 = hf ? acc[16 + 4 * jj + 3] : acc[4 * jj + 3];
    xn[jj].x = xv.x + gv.x * a0; xn[jj].y = xv.y + gv.y * a1; xn[jj].z = xv.z + gv.z * a2; xn[jj].w = xv.w + gv.w * a3;
    ss += xn[jj].x * xn[jj].x + xn[jj].y * xn[jj].y + xn[jj].z * xn[jj].z + xn[jj].w * xn[jj].w;
  }
  ss = wave_sum(ss);
  const float rinv = rsqrtf(ss * (1.f / 1024.f) + EPS);
  if (layer == 0) {
    const float* mod1 = (const float*)(p.ws + OFF_MOD) + (size_t)9 * 6144 + (size_t)b * 6144;
    const float* g1 = p.norm1_g + 1024;
    bf16_t* act = (bf16_t*)(p.ws + OFF_ACT) + (size_t)tok * 1024;
#pragma unroll
    for (int jj = 0; jj < 4; ++jj) {
      const int c = (l + 32 * (4 * hf + jj)) * 4;
      if (dowrite) *(float4*)(xr + c) = xn[jj]; else asm volatile("" :: "v"(xn[jj].x), "v"(xn[jj].y), "v"(xn[jj].z), "v"(xn[jj].w));
      const float4 gg4 = *(const float4*)(g1 + c);
      const float4 sh = *(const float4*)(mod1 + c);
      const float4 sc = *(const float4*)(mod1 + 1024 + c);
      uint2 o;
      o.x = pack2h(xn[jj].x * rinv * gg4.x * (1.f + sc.x) + sh.x, xn[jj].y * rinv * gg4.y * (1.f + sc.y) + sh.y);
      o.y = pack2h(xn[jj].z * rinv * gg4.z * (1.f + sc.z) + sh.z, xn[jj].w * rinv * gg4.w * (1.f + sc.w) + sh.w);
      if (dowrite) *(uint2*)(act + c) = o; else asm volatile("" :: "v"(o.x), "v"(o.y));
    }
  } else {
#pragma unroll
    for (int jj = 0; jj < 4; ++jj) {
      const int c = (l + 32 * (4 * hf + jj)) * 4;
      const float4 gg4 = *(const float4*)(p.final_g + c);
      float4 o;
      o.x = xn[jj].x * rinv * gg4.x; o.y = xn[jj].y * rinv * gg4.y; o.z = xn[jj].z * rinv * gg4.z; o.w = xn[jj].w * rinv * gg4.w;
      if (dowrite) *(float4*)(xr + c) = o; else asm volatile("" :: "v"(o.x), "v"(o.y), "v"(o.z), "v"(o.w));
    }
  }
}

__device__ __forceinline__ void phase_peer(const Params& p, int layer, char* smem, int ntok, bool dowrite = true) {
  const int tid = opaque_tid(), lane = tid & 63, wave = __builtin_amdgcn_readfirstlane(tid >> 6);
  __syncthreads();
  if (tid < 64) {
    int cab = -1, c = 0;
    for (int a = 0; a < 16; ++a)
      for (int bb = 0; bb < 16; ++bb)
        if ((a + 1) * (bb + 1) <= 16) { if (c == tid) cab = a * 16 + bb; ++c; }
    ((int*)(smem + PE_OFF_CT))[tid] = cab;
  }
  const int ngroups = ntok / 16, G = gridDim.x, g0 = opaque_bid();
  if (tid == 0) { ((int*)(smem + PE_OFF_TQ))[0] = 0; ((int*)(smem + PE_OFF_TQ))[1] = 0; }
  __syncthreads();
  const int R = ngroups / G, rem = ngroups % G;
  const bool split = rem > 0 && 2 * rem <= G;
#define PE_ITEM(r_, grp_, off_, cnt_)                                                                  \
  { grp_ = 0; off_ = 0; cnt_ = 0;                                                                      \
    if ((r_) >= 0 && (r_) < R) { grp_ = g0 + (r_) * G; cnt_ = 16; }                                    \
    else if ((r_) == R) {                                                                              \
      if (split) { if (g0 < 2 * rem) { grp_ = R * G + (g0 >> 1); off_ = (g0 & 1) * 8; cnt_ = 8; } }    \
      else if (g0 < rem) { grp_ = R * G + g0; cnt_ = 16; }                                             \
    } }
#pragma unroll 1
  for (int r = -1;; ++r) {
    int cur, coff, ngat, nxt, noff, ncnt;
    PE_ITEM(r, cur, coff, ngat)
    PE_ITEM(r + 1, nxt, noff, ncnt)
    const int nsel = ncnt > 0 ? 8 : 0;
    if (ngat + nsel == 0) break;
    const int b = r & 1, gper = ngat >> 3, sfirst = (wave & 1) == 0;
#pragma unroll 1
    for (int st = 0; st < 3; ++st) {
      const int slot = sfirst ? st : (st + 1) % 3;
      if (slot == 0) { if (nsel) peer_select_head(p, layer, smem, nxt * 16, wave, wave, b ^ 1, lane); }
      else if (slot - 1 < gper) {
        const int idx = wave * gper + slot - 1;
        peer_gather_token(p, layer, smem, cur * 16 + coff + idx, coff + idx, b, lane, dowrite);
      }
    }
    __syncthreads();
  }
}

template <int layer>
__device__ __forceinline__ void layer_body(const Params& p, char* smem, const XcdBarrier& xb) {
  constexpr bool nc = layer == 0;
  const float* xin = layer == 0 ? p.x : (const float*)p.out;
  if (layer == 0) {
    phase_norm(p, layer, 0, xin, NTOK);
    xcd_barrier(xb);
  }
#if REP_GEMM
  gemm_phase2<EPI_INPROJ>(p, layer, smem, (const bf16_t*)(p.ws + OFF_ACT), (const bf16_t*)(p.ws + OFF_WIN) + (size_t)layer * 3072 * 1024, NTOK, 3072, nullptr);
  xcd_barrier(xb);
#endif
  gemm_phase2<EPI_INPROJ>(p, layer, smem, (const bf16_t*)(p.ws + OFF_ACT), (const bf16_t*)(p.ws + OFF_WIN) + (size_t)layer * 3072 * 1024, NTOK, 3072, nullptr);
  xcd_barrier(xb);
#if REP_MIX1
  phase_mix1(p, layer, smem, 2);
  xcd_barrier(xb);
#endif
  phase_mix1(p, layer, smem);
  xcd_barrier(xb);
  phase_ret_scan(p, layer);
  xcd_barrier(xb);
#if REP_MIX2
  phase_mix2(p, layer, smem, 3);
  xcd_barrier(xb);
#endif
  phase_mix2(p, layer, smem);
  xcd_barrier(xb);
  gemm_phase2<EPI_OUTPROJ>(p, layer, smem, (const bf16_t*)(p.ws + OFF_ACT), (const bf16_t*)(p.ws + OFF_WOUT) + (size_t)layer * 1024 * 1024, nc ? NTOK : NLAT, 1024, xin);
  xcd_barrier(xb);
  phase_norm(p, layer, 1, (const float*)p.out, nc ? NTOK : NLAT);
  xcd_barrier(xb);
  gemm_phase2<EPI_PLAIN>(p, layer, smem, (const bf16_t*)(p.ws + OFF_ACT), (const bf16_t*)(p.ws + OFF_WQ) + (size_t)layer * 2048 * 1024, nc ? NTOK : NLAT, 2048, nullptr);
  xcd_barrier(xb);
#if REP_PEER
  phase_peer(p, layer, smem, nc ? NTOK : NLAT, false);
  xcd_barrier(xb);
#endif
  phase_peer(p, layer, smem, nc ? NTOK : NLAT);
  if (layer == 0) xcd_barrier(xb);
}

__global__ void __launch_bounds__(512) fwd_megakernel(Params p) {
  cg::grid_group grid = cg::this_grid();
  extern __shared__ __attribute__((aligned(16))) char smem[];
  volatile LAS3 unsigned* xst = (volatile LAS3 unsigned*)(smem + LDS_BCAST + 8);
  if (threadIdx.x == 0) { xst[0] = 0u; xst[1] = 0u; }
  phase_prep(p, smem);
  for (int it = blockIdx.x; it < 256; it += gridDim.x) uv_convert_item(p, it);
  grid.sync();
  const XcdBarrier xb = xcd_barrier_post((unsigned*)(p.ws + OFF_XBAR), xst);
  layer_body<0>(p, smem, xb);
  layer_body<1>(p, smem, xb);
}

extern "C" void kernel_launch(void* const* d_in, const int* in_sizes, int n_in, void* d_out,
                              int out_size, void* d_ws, size_t ws_size, hipStream_t stream) {
  constexpr size_t kDynLds = LDS_BYTES;
  static int grid_blocks = 0;
  if (!grid_blocks) {
    int dev = 0, cus = 0, per_cu = 0;
    (void)hipGetDevice(&dev);
    (void)hipDeviceGetAttribute(&cus, hipDeviceAttributeMultiprocessorCount, dev);
    (void)hipFuncSetAttribute((const void*)fwd_megakernel, hipFuncAttributeMaxDynamicSharedMemorySize, (int)kDynLds);
    (void)hipOccupancyMaxActiveBlocksPerMultiprocessor(&per_cu, fwd_megakernel, 512, kDynLds);
    if (per_cu < 1) { fprintf(stderr, "occupancy query says %d blocks/CU\n", per_cu); per_cu = 1; }
    grid_blocks = cus;
    if (ws_size < WS_END) fprintf(stderr, "workspace too small: %zu < %zu\n", ws_size, (size_t)WS_END);
  }
  Params p{};
  p.x = (const float*)d_in[0]; p.c = (const float*)d_in[1]; p.ctx = (const float*)d_in[2]; p.c_ctx = (const float*)d_in[3];
  p.w_ada = (const float*)d_in[4]; p.b_ada = (const float*)d_in[5]; p.norm1_g = (const float*)d_in[6]; p.w_in = (const float*)d_in[7];
  p.na_rpb = (const float*)d_in[8]; p.diff_lambda = (const float*)d_in[9]; p.diff_subln_g = (const float*)d_in[10];
  p.ret_decay_logit = (const float*)d_in[11]; p.w_out = (const float*)d_in[12]; p.norm2_g = (const float*)d_in[13];
  p.peer_wq = (const float*)d_in[14]; p.peer_subkeys = (const float*)d_in[15]; p.peer_u = (const float*)d_in[16];
  p.peer_v = (const float*)d_in[17]; p.final_g = (const float*)d_in[18];
  p.out = (float*)d_out; p.ws = (char*)d_ws;
  void* args[] = {&p};
  hipError_t e = hipLaunchCooperativeKernel((void*)fwd_megakernel, dim3(grid_blocks), dim3(512), args, kDynLds, stream);
  if (e != hipSuccess) fprintf(stderr, "cooperative launch failed: %s (grid %d)\n", hipGetErrorString(e), grid_blocks);
}
```

```cpp
#include <hip/hip_runtime.h>
#include <hip/hip_cooperative_groups.h>
#include <cstdio>
#include <cstdint>
namespace cg = cooperative_groups;

typedef unsigned short bf16_t;
typedef short bf16x8 __attribute__((ext_vector_type(8)));
typedef float f32x4 __attribute__((ext_vector_type(4)));

constexpr int DM = 1024, BATCH = 8, SEQ = 4096, LCTX = 256;
constexpr int NLAT = BATCH * SEQ;
constexpr int NCTX = BATCH * LCTX;
constexpr int NTOK = NLAT + NCTX;
constexpr int INC = 3072;
constexpr int C_NAQ = 0, C_NAK = 256, C_NAV = 512, C_DFQ = 768, C_DFK = 1024, C_DFV = 1280,
              C_RTQ = 1536, C_RTK = 1792, C_RTV = 2048, C_RTG = 2560;
constexpr int Y_NA = 0, Y_DF = 256, Y_RT = 512;
constexpr int NEXP = 16384;
constexpr float EPS = 1e-6f;

constexpr size_t OFF_CTL  = 0;
constexpr size_t OFF_MISC = 4096;
constexpr size_t OFF_ROPE = 8192;
constexpr size_t OFF_MOD  = OFF_ROPE + 12288;
constexpr size_t SZ_MOD   = 2ull * 9 * 6144 * 4;
constexpr size_t OFF_WIN  = OFF_MOD + SZ_MOD;
constexpr size_t SZ_WIN   = 2ull * 3072 * 1024 * 2;
constexpr size_t OFF_WOUT = OFF_WIN + SZ_WIN;
constexpr size_t SZ_WOUT  = 2ull * 1024 * 1024 * 2;
constexpr size_t OFF_WQ   = OFF_WOUT + SZ_WOUT;
constexpr size_t SZ_WQ    = 2ull * 2048 * 1024 * 2;
constexpr size_t OFF_SUBK = OFF_WQ + SZ_WQ;
constexpr size_t SZ_SUBK  = 2ull * 262144 * 2;
constexpr size_t OFF_U    = OFF_SUBK + SZ_SUBK;
constexpr int    ROWB     = 512;
constexpr int    ROWV     = 512;
constexpr int    RECB     = ROWB + ROWV;
constexpr size_t SZ_UV    = 2ull * NEXP * ROWB;
constexpr size_t OFF_V    = OFF_U + SZ_UV;
constexpr size_t OFF_USC  = OFF_V + SZ_UV;
constexpr size_t OFF_VSC  = OFF_USC + 2ull * NEXP * 4;
constexpr size_t OFF_ACT  = OFF_VSC + 2ull * NEXP * 4;
constexpr size_t SZ_ACT   = (size_t)NTOK * 1024 * 2;
constexpr size_t OFF_P    = OFF_ACT + SZ_ACT;
constexpr size_t SZ_P     = (size_t)NTOK * 3072 * 2;
constexpr size_t OFF_CTXB = OFF_P + SZ_P;
constexpr size_t SZ_CTXB  = (size_t)NCTX * 1024 * 4;
constexpr size_t OFF_RKV  = OFF_CTXB + SZ_CTXB;
constexpr size_t SZ_RKV   = 64ull * 32 * 8192 * 4;
constexpr size_t OFF_RS   = OFF_RKV + SZ_RKV;
constexpr size_t SZ_RS    = 64ull * 8192 * 4;
constexpr size_t OFF_XBAR = OFF_RS + SZ_RS;
constexpr size_t WS_END   = OFF_XBAR + 16384;

#ifndef REP_MIX1
#define REP_MIX1 0
#endif
#ifndef REP_MIX2
#define REP_MIX2 0
#endif
#ifndef REP_PEER
#define REP_PEER 0
#endif
#ifndef REP_GEMM
#define REP_GEMM 0
#endif
constexpr int LDS_BYTES = 152 * 1024;
constexpr int LDS_BCAST = LDS_BYTES - 16;

struct Params {
  const float *x, *c, *ctx, *c_ctx, *w_ada, *b_ada, *norm1_g, *w_in, *na_rpb, *diff_lambda, *diff_subln_g,
              *ret_decay_logit, *w_out, *norm2_g, *peer_wq, *peer_subkeys, *peer_u, *peer_v, *final_g;
  float* out;
  char* ws;
};

__device__ __forceinline__ float bf2f(bf16_t v) { return __uint_as_float(((unsigned)v) << 16); }
__device__ __forceinline__ bf16_t f2bf(float f) {
  unsigned u = __float_as_uint(f);
  u += 0x7fffu + ((u >> 16) & 1u);
  return (bf16_t)(u >> 16);
}
__device__ __forceinline__ unsigned pack2(float a, float b) { return (unsigned)f2bf(a) | ((unsigned)f2bf(b) << 16); }
typedef __bf16 bf16x2_t __attribute__((ext_vector_type(2)));
typedef float f32x2_t __attribute__((ext_vector_type(2)));
__device__ __forceinline__ unsigned pack2h(float a, float b) {
  const f32x2_t v = {a, b};
  return __builtin_bit_cast(unsigned, __builtin_convertvector(v, bf16x2_t));
}
__device__ __forceinline__ float lo16(unsigned w) { return __uint_as_float(w << 16); }
__device__ __forceinline__ float hi16(unsigned w) { return __uint_as_float(w & 0xffff0000u); }
#define DPP_ADD(v, CTRL) ((v) + __int_as_float(__builtin_amdgcn_update_dpp(0, __float_as_int(v), (CTRL), 0xf, 0xf, true)))
__device__ __forceinline__ float row16_sum(float v) {
  v = DPP_ADD(v, 0xB1);
  v = DPP_ADD(v, 0x4E);
  v = DPP_ADD(v, 0x141);
  v = DPP_ADD(v, 0x140);
  return v;
}
#define DPP_MOVU(v, CTRL) ((unsigned)__builtin_amdgcn_update_dpp(0, (int)(v), (CTRL), 0xf, 0xf, true))
__device__ __forceinline__ unsigned row16_max_u32(unsigned v) {
  v = max(v, DPP_MOVU(v, 0xB1)); v = max(v, DPP_MOVU(v, 0x4E)); v = max(v, DPP_MOVU(v, 0x141)); v = max(v, DPP_MOVU(v, 0x140));
  return v;
}
__device__ __forceinline__ unsigned row16_min_u32(unsigned v) {
  v = min(v, DPP_MOVU(v, 0xB1)); v = min(v, DPP_MOVU(v, 0x4E)); v = min(v, DPP_MOVU(v, 0x141)); v = min(v, DPP_MOVU(v, 0x140));
  return v;
}
template <int KTH>
__device__ __forceinline__ unsigned row16_kth_largest(unsigned v) {
  int cnt = 0;
#define R8_STEP(N) { const unsigned o = DPP_MOVU(v, 0x120 + (N)); cnt += (o > v) ? 1 : 0; }
  R8_STEP(1) R8_STEP(2) R8_STEP(3) R8_STEP(4) R8_STEP(5) R8_STEP(6) R8_STEP(7) R8_STEP(8)
  R8_STEP(9) R8_STEP(10) R8_STEP(11) R8_STEP(12) R8_STEP(13) R8_STEP(14) R8_STEP(15)
#undef R8_STEP
  return row16_max_u32(cnt >= KTH - 1 ? v : 0u);
}
__device__ __forceinline__ float wave_sum(float v) {
  v = row16_sum(v);
  const int iv = __float_as_int(v);
  const float a = __int_as_float(__builtin_amdgcn_readlane(iv, 0)), b = __int_as_float(__builtin_amdgcn_readlane(iv, 16));
  const float c = __int_as_float(__builtin_amdgcn_readlane(iv, 32)), d = __int_as_float(__builtin_amdgcn_readlane(iv, 48));
  return (a + b) + (c + d);
}
__device__ __forceinline__ float siluf(float x) { return x / (1.f + __expf(-x)); }

__device__ __forceinline__ int opaque_tid() { int t = threadIdx.x; asm volatile("" : "+v"(t)); return t; }
__device__ __forceinline__ int opaque_bid() { int t = blockIdx.x; asm volatile("" : "+s"(t)); return t; }

#define DOT8(acc, Q, off, U)                                                              \
  acc = fmaf(Q[(off) + 0], lo16((U).x), acc); acc = fmaf(Q[(off) + 1], hi16((U).x), acc); \
  acc = fmaf(Q[(off) + 2], lo16((U).y), acc); acc = fmaf(Q[(off) + 3], hi16((U).y), acc); \
  acc = fmaf(Q[(off) + 4], lo16((U).z), acc); acc = fmaf(Q[(off) + 5], hi16((U).z), acc); \
  acc = fmaf(Q[(off) + 6], lo16((U).w), acc); acc = fmaf(Q[(off) + 7], hi16((U).w), acc);
#define AXPY8(O, off, P, U)                                                                   \
  O[(off) + 0] = fmaf(P, lo16((U).x), O[(off) + 0]); O[(off) + 1] = fmaf(P, hi16((U).x), O[(off) + 1]); \
  O[(off) + 2] = fmaf(P, lo16((U).y), O[(off) + 2]); O[(off) + 3] = fmaf(P, hi16((U).y), O[(off) + 3]); \
  O[(off) + 4] = fmaf(P, lo16((U).z), O[(off) + 4]); O[(off) + 5] = fmaf(P, hi16((U).z), O[(off) + 5]); \
  O[(off) + 6] = fmaf(P, lo16((U).w), O[(off) + 6]); O[(off) + 7] = fmaf(P, hi16((U).w), O[(off) + 7]);
#define UNPACK8(Q, off, U)                                                  \
  Q[(off) + 0] = lo16((U).x); Q[(off) + 1] = hi16((U).x); Q[(off) + 2] = lo16((U).y); Q[(off) + 3] = hi16((U).y); \
  Q[(off) + 4] = lo16((U).z); Q[(off) + 5] = hi16((U).z); Q[(off) + 6] = lo16((U).w); Q[(off) + 7] = hi16((U).w);

__device__ __forceinline__ int next_item(unsigned* counter, char* smem) {
  volatile int* bc = (volatile int*)(smem + LDS_BCAST);
  __syncthreads();
  if (threadIdx.x == 0) *bc = (int)atomicAdd(counter, 1u);
  __syncthreads();
  return *bc;
}

#define XB_TMO      128
#define XB_XCNT(j)  (256  + 64 * (j))
#define XB_XSUB(j)  (1280 + 64 * (j))
#define XB_XGEN(j)  (2304 + 64 * (j))
#define XB_TOP      3328
#define XB_TOPGEN   3392
#define XCD_BAR_WORDS 3456
#define XB_SPIN_CAP (1u << 18)
#define LAS3 __attribute__((address_space(3)))
__device__ __forceinline__ unsigned xb_ld(unsigned* p)              { return __hip_atomic_load(p, __ATOMIC_RELAXED, __HIP_MEMORY_SCOPE_AGENT); }
__device__ __forceinline__ unsigned xb_add(unsigned* p, unsigned v) { return __hip_atomic_fetch_add(p, v, __ATOMIC_RELAXED, __HIP_MEMORY_SCOPE_AGENT); }
__device__ __forceinline__ unsigned xb_xcc_id() { return (unsigned)__builtin_amdgcn_s_getreg((3 << 11) | 20) & 0xFu; }
#define XB_SPIN(cond, bar) do { unsigned _sp = 0; while (cond) { __builtin_amdgcn_s_sleep(1); \
    if ((++_sp & 255u) == 0u) { if (xb_ld(&(bar)[XB_TMO])) break; if (_sp > XB_SPIN_CAP) { atomicAdd(&(bar)[XB_TMO], 1u); break; } } } } while (0)
struct XcdBarrier { unsigned* bar; unsigned x; volatile LAS3 unsigned* st; };
__device__ __forceinline__ XcdBarrier xcd_barrier_post(unsigned* bar, volatile LAS3 unsigned* st) {
  XcdBarrier b; b.bar = bar; b.x = xb_xcc_id(); b.st = st;
  if (threadIdx.x == 0) (void)xb_add(&bar[XB_XCNT(b.x)], 1u);
  return b;
}
__device__ __forceinline__ void xcd_barrier_complete(unsigned* bar, unsigned x, unsigned& nloc, unsigned& nx) {
  const unsigned G = gridDim.x * gridDim.y * gridDim.z;
  unsigned sum, cnt, mine, sp = 0u;
  for (;;) {
    sum = 0u; cnt = 0u; mine = 0u;
#pragma unroll
    for (unsigned j = 0; j < 16; ++j) { const unsigned c = xb_ld(&bar[XB_XCNT(j)]); sum += c; cnt += (c > 0u) ? 1u : 0u; mine = (j == x) ? c : mine; }
    if (sum == G) break;
    __builtin_amdgcn_s_sleep(1);
    if ((++sp & 255u) == 0u) { if (xb_ld(&bar[XB_TMO])) break; if (sp > XB_SPIN_CAP) { atomicAdd(&bar[XB_TMO], 1u); break; } }
  }
  nloc = mine > 0u ? mine : 1u; nx = cnt > 0u ? cnt : 1u;
}
__device__ __forceinline__ void xcd_barrier(const XcdBarrier& b) {
  asm volatile("s_waitcnt vmcnt(0)" ::: "memory");
  __syncthreads();
  if (threadIdx.x == 0) {
    unsigned* bar = b.bar;
    __builtin_amdgcn_s_waitcnt(0);
    unsigned nloc = b.st[0], nx = b.st[1];
    if (nloc == 0u) { xcd_barrier_complete(bar, b.x, nloc, nx); b.st[0] = nloc; b.st[1] = nx; }
    const unsigned old = xb_add(&bar[XB_XSUB(b.x)], 1u);
    const unsigned gen = old / nloc;
    if (old + 1u == (gen + 1u) * nloc) {
      __builtin_amdgcn_fence(__ATOMIC_RELEASE, "agent");
      asm volatile("s_waitcnt vmcnt(0)" ::: "memory");
      const unsigned og = xb_add(&bar[XB_TOP], 1u);
      const unsigned tg = og / nx;
      if (og + 1u == (tg + 1u) * nx) xb_add(&bar[XB_TOPGEN], 1u);
      else XB_SPIN(xb_ld(&bar[XB_TOPGEN]) == tg, bar);
      __builtin_amdgcn_fence(__ATOMIC_ACQUIRE, "agent");
      xb_add(&bar[XB_XGEN(b.x)], 1u);
      asm volatile("s_waitcnt vmcnt(0)" ::: "memory");
    } else {
      XB_SPIN(xb_ld(&bar[XB_XGEN(b.x)]) == gen, bar);
      __builtin_amdgcn_fence(__ATOMIC_ACQUIRE, "agent");
      asm volatile("s_waitcnt vmcnt(0)" ::: "memory");
    }
  }
  __syncthreads();
}

__device__ __forceinline__ void transpose_item(const float* src, bf16_t* dst, int K, int N, int item, char* smem) {
  float* t = (float*)smem;
  const int nb = N / 64;
  const int k0 = (item / nb) * 64, n0 = (item % nb) * 64;
  const int tid = opaque_tid();
  __syncthreads();
#pragma unroll
  for (int i = 0; i < 8; ++i) {
    const int k = (tid >> 6) + 8 * i, n = tid & 63;
    t[k * 65 + n] = src[(size_t)(k0 + k) * N + n0 + n];
  }
  __syncthreads();
#pragma unroll
  for (int i = 0; i < 8; ++i) {
    const int n = (tid >> 6) + 8 * i, k = tid & 63;
    dst[(size_t)(n0 + n) * K + k0 + k] = f2bf(t[k * 65 + n]);
  }
}

__device__ __forceinline__ void convert_flat(const float* src, bf16_t* dst, size_t n4) {
  const size_t gt = (size_t)opaque_bid() * blockDim.x + opaque_tid(), gs = (size_t)gridDim.x * blockDim.x;
  for (size_t i = gt; i < n4; i += gs) {
    const float4 v = ((const float4*)src)[i];
    uint2 o; o.x = pack2h(v.x, v.y); o.y = pack2h(v.z, v.w);
    ((uint2*)dst)[i] = o;
  }
}

__device__ __forceinline__ void phase_prep(const Params& p, char* smem) {
  const int tid = opaque_tid();
  char* ws = p.ws;
  if (opaque_bid() == 0) {
    unsigned* ctl = (unsigned*)(ws + OFF_CTL);
    if (tid < 64) ctl[tid] = 0u;
    unsigned* xbar = (unsigned*)(ws + OFF_XBAR);
    for (int i = tid; i < XCD_BAR_WORDS; i += 512) xbar[i] = 0u;
    float* misc = (float*)(ws + OFF_MISC);
    if (tid < 2) {
      const float* lp = p.diff_lambda + tid * 128;
      float s01 = 0.f, s23 = 0.f;
      for (int i = 0; i < 32; ++i) { s01 += lp[i] * lp[32 + i]; s23 += lp[64 + i] * lp[96 + i]; }
      const float lam_init = 0.8f - 0.6f * expf(-0.3f * (float)tid);
      misc[tid] = expf(s01) - expf(s23) + lam_init;
      misc[2 + tid] = lam_init;
    }
    if (tid >= 128 && tid < 256) misc[64 + tid - 128] = 0.f;
    if (tid >= 64 && tid < 80) {
      const int i = tid - 64;
      const float xv = p.ret_decay_logit[i];
      misc[16 + i] = -log1pf(expf(-xv));
    }
    float2* ropeD = (float2*)(ws + OFF_ROPE);
    float2* ropeR = (float2*)(ws + OFF_ROPE + 4096);
    for (int i = tid; i < 64 * 8; i += 512) {
      const int v = i >> 3, f = i & 7;
      const float inv = powf(10000.0f, -(float)(2 * f) / 16.0f);
      const float ang = (float)v * inv;
      ropeD[i] = make_float2(cosf(ang), sinf(ang));
    }
    for (int i = tid; i < 64 * 16; i += 512) {
      const int v = i >> 4, f = i & 15;
      const float inv = powf(10000.0f, -(float)(2 * f) / 32.0f);
      const float ang = (float)v * inv;
      ropeR[i] = make_float2(cosf(ang), sinf(ang));
    }
  }
  {
    float* sc = (float*)smem;
    float* red = (float*)(smem + 9 * 1024 * 4);
    float* mod = (float*)(ws + OFF_MOD);
    for (int item = opaque_bid(); item < 192; item += gridDim.x) {
      const int l = item / 96, cb = item % 96;
      __syncthreads();
      for (int i = tid; i < 9 * 1024; i += 512) {
        const int r = i >> 10, k = i & 1023;
        const float cv = (r < 8) ? p.c[r * 1024 + k] : p.c_ctx[k];
        sc[i] = siluf(cv);
      }
      __syncthreads();
      const int col = tid & 63, ks = tid >> 6;
      float acc[9];
#pragma unroll
      for (int r = 0; r < 9; ++r) acc[r] = 0.f;
      const float* w = p.w_ada + (size_t)l * 1024 * 6144 + cb * 64 + col;
#pragma unroll 1
      for (int k0 = ks * 128; k0 < ks * 128 + 128; k0 += 16) {
        float wv[16];
#pragma unroll
        for (int i = 0; i < 16; ++i) wv[i] = w[(size_t)(k0 + i) * 6144];
#pragma unroll
        for (int i = 0; i < 16; ++i)
#pragma unroll
          for (int r = 0; r < 9; ++r) acc[r] = fmaf(sc[r * 1024 + k0 + i], wv[i], acc[r]);
      }
#pragma unroll
      for (int r = 0; r < 9; ++r) red[(ks * 9 + r) * 64 + col] = acc[r];
      __syncthreads();
      for (int i = tid; i < 576; i += 512) {
        const int r = i >> 6, cc = i & 63;
        float s = 0.f;
#pragma unroll
        for (int k8 = 0; k8 < 8; ++k8) s += red[(k8 * 9 + r) * 64 + cc];
        mod[((size_t)l * 9 + r) * 6144 + cb * 64 + cc] = s + p.b_ada[l * 6144 + cb * 64 + cc];
      }
    }
    __syncthreads();
  }
  for (int item = opaque_bid(); item < 3072; item += gridDim.x) {
    const int l = item / 1536;
    int r = item % 1536;
    if (r < 768) transpose_item(p.w_in + (size_t)l * 1024 * 3072, (bf16_t*)(ws + OFF_WIN) + (size_t)l * 3072 * 1024, 1024, 3072, r, smem);
    else if (r < 1024) transpose_item(p.w_out + (size_t)l * 1024 * 1024, (bf16_t*)(ws + OFF_WOUT) + (size_t)l * 1024 * 1024, 1024, 1024, r - 768, smem);
    else transpose_item(p.peer_wq + (size_t)l * 1024 * 2048, (bf16_t*)(ws + OFF_WQ) + (size_t)l * 2048 * 1024, 1024, 2048, r - 1024, smem);
  }
  convert_flat(p.peer_subkeys, (bf16_t*)(ws + OFF_SUBK), 2ull * 262144 / 4);
  {
    const size_t gt = (size_t)opaque_bid() * blockDim.x + tid, gs = (size_t)gridDim.x * blockDim.x;
    float4* dst = (float4*)(ws + OFF_CTXB);
    for (size_t i = gt; i < (size_t)NCTX * 1024 / 4; i += gs) dst[i] = ((const float4*)p.ctx)[i];
  }
}

__device__ __forceinline__ void phase_norm(const Params& p, int layer, int which, const float* xlat, int nrows) {
  const int lane = opaque_tid() & 63;
  const int gw = opaque_bid() * 8 + (opaque_tid() >> 6), nw = gridDim.x * 8;
  const float* g = (which == 0 ? p.norm1_g : p.norm2_g) + layer * 1024;
  const float* mod = (const float*)(p.ws + OFF_MOD) + (size_t)layer * 9 * 6144;
  const float* ctxb = (const float*)(p.ws + OFF_CTXB);
  bf16_t* act = (bf16_t*)(p.ws + OFF_ACT);
  const int sh_off = which == 0 ? 0 : 3 * 1024, sc_off = which == 0 ? 1024 : 4 * 1024;
  for (int row = gw; row < nrows; row += nw) {
    const float* src = row < NLAT ? xlat + (size_t)row * 1024 : ctxb + (size_t)(row - NLAT) * 1024;
    const int b = row < NLAT ? (row >> 12) : 8;
    const float* mrow = mod + (size_t)b * 6144;
    float4 v[4];
    float ss = 0.f;
#pragma unroll
    for (int j = 0; j < 4; ++j) {
      v[j] = ((const float4*)src)[lane + 64 * j];
      ss += v[j].x * v[j].x + v[j].y * v[j].y + v[j].z * v[j].z + v[j].w * v[j].w;
    }
    ss = wave_sum(ss);
    const float r = rsqrtf(ss * (1.f / 1024.f) + EPS);
#pragma unroll
    for (int j = 0; j < 4; ++j) {
      const int c = (lane + 64 * j) * 4;
      const float4 gg = *(const float4*)(g + c);
      const float4 sh = *(const float4*)(mrow + sh_off + c);
      const float4 sc = *(const float4*)(mrow + sc_off + c);
      const float o0 = v[j].x * r * gg.x * (1.f + sc.x) + sh.x;
      const float o1 = v[j].y * r * gg.y * (1.f + sc.y) + sh.y;
      const float o2 = v[j].z * r * gg.z * (1.f + sc.z) + sh.z;
      const float o3 = v[j].w * r * gg.w * (1.f + sc.w) + sh.w;
      uint2 o; o.x = pack2h(o0, o1); o.y = pack2h(o2, o3);
      *(uint2*)(act + (size_t)row * 1024 + c) = o;
    }
  }
}

__device__ __forceinline__ void phase_final(const Params& p) {
  const int lane = opaque_tid() & 63;
  const int gw = opaque_bid() * 8 + (opaque_tid() >> 6), nw = gridDim.x * 8;
  for (int row = gw; row < NLAT; row += nw) {
    float* src = p.out + (size_t)row * 1024;
    float4 v[4];
    float ss = 0.f;
#pragma unroll
    for (int j = 0; j < 4; ++j) {
      v[j] = ((const float4*)src)[lane + 64 * j];
      ss += v[j].x * v[j].x + v[j].y * v[j].y + v[j].z * v[j].z + v[j].w * v[j].w;
    }
    ss = wave_sum(ss);
    const float r = rsqrtf(ss * (1.f / 1024.f) + EPS);
#pragma unroll
    for (int j = 0; j < 4; ++j) {
      const int c = (lane + 64 * j) * 4;
      const float4 gg = *(const float4*)(p.final_g + c);
      float4 o;
      o.x = v[j].x * r * gg.x; o.y = v[j].y * r * gg.y; o.z = v[j].z * r * gg.z; o.w = v[j].w * r * gg.w;
      ((float4*)src)[lane + 64 * j] = o;
    }
  }
}

constexpr int EPI_INPROJ = 0, EPI_OUTPROJ = 1, EPI_PLAIN = 2;
constexpr int GS = 72;
constexpr int G_ASTAGE = 256 * GS * 2;
constexpr int G_BSTAGE = 128 * GS * 2;
constexpr int G_STAGE = G_ASTAGE + G_BSTAGE;

namespace g8 {
constexpr int BM = 256, BK = 64, HALF = 128, NXCD = 8, WGM = 8, HT = HALF * BK;
__device__ __forceinline__ int lds_byte(int r, int c) {
  const int st = (r >> 4) * 2 + (c >> 5), rr = r & 15, cc = c & 31, ob = rr * 64 + cc * 2;
  return st * 1024 + (ob ^ (((ob >> 9) & 1) << 5));
}
__device__ __forceinline__ void stage_rc(int b, int& R, int& C) {
  const int st = b / 1024, sb = b % 1024, swz = sb ^ (((sb >> 9) & 1) << 5);
  R = (st >> 1) * 16 + swz / 64; C = (st & 1) * 32 + (swz % 64) / 2;
}
}

constexpr int G8_ROPE_LDS = 8 * 16384;
template <int EPI>
__device__ __forceinline__ void epi_store8(const Params& p, int layer, char* smem, int m, int n, f32x4 lo, f32x4 hi, const float* xin_lat) {
  float v[8] = {lo[0], lo[1], lo[2], lo[3], hi[0], hi[1], hi[2], hi[3]};
  if constexpr (EPI == EPI_INPROJ) {
    const bool ropeD = (n >= C_DFQ && n < C_DFV), ropeR = (n >= C_RTQ && n < C_RTV);
    if ((ropeD || ropeR) && m < NLAT) {
      const int t = m & 4095, gr = t >> 6, gc = t & 63;
      const float2* tabD = (const float2*)(smem + G8_ROPE_LDS);
      const float2* tabR = (const float2*)(smem + G8_ROPE_LDS + 4096);
      const float2* tb;
      if (ropeD) { const int i0 = (n & 31) >> 1; tb = i0 < 8 ? tabD + gr * 8 + i0 : tabD + gc * 8 + i0 - 8; }
      else { const int i0 = (n & 63) >> 1; tb = i0 < 16 ? tabR + gr * 16 + i0 : tabR + gc * 16 + i0 - 16; }
#pragma unroll
      for (int q = 0; q < 4; ++q) {
        const float2 cs = tb[q];
        const float a0 = v[2 * q] * cs.x - v[2 * q + 1] * cs.y, a1 = v[2 * q] * cs.y + v[2 * q + 1] * cs.x;
        v[2 * q] = a0; v[2 * q + 1] = a1;
      }
    }
    float sc = 1.f;
    if (n < C_NAK) sc = 0.125f * 1.4426950408889634f;
    else if (n >= C_DFQ && n < C_DFK) sc = 0.17677669529663687f * 1.4426950408889634f;
    else if (n >= C_RTK && n < C_RTV) sc = 0.125f;
    uint4 o;
    o.x = pack2h(v[0] * sc, v[1] * sc); o.y = pack2h(v[2] * sc, v[3] * sc); o.z = pack2h(v[4] * sc, v[5] * sc); o.w = pack2h(v[6] * sc, v[7] * sc);
    *(uint4*)((bf16_t*)(p.ws + OFF_P) + (size_t)m * INC + n) = o;
  } else if constexpr (EPI == EPI_OUTPROJ) {
    const float* mod = (const float*)(p.ws + OFF_MOD) + (size_t)layer * 9 * 6144;
    const int b = m < NLAT ? (m >> 12) : 8;
    const float* gp = mod + (size_t)b * 6144 + 2 * 1024 + n;
    const float4 g0 = *(const float4*)gp, g1 = *(const float4*)(gp + 4);
    const float* xi; float* xo;
    if (m < NLAT) { xi = xin_lat + (size_t)m * 1024 + n; xo = p.out + (size_t)m * 1024 + n; }
    else { xo = (float*)(p.ws + OFF_CTXB) + (size_t)(m - NLAT) * 1024 + n; xi = xo; }
    const float4 x0 = *(const float4*)xi, x1 = *(const float4*)(xi + 4);
    float4 o0, o1;
    o0.x = x0.x + g0.x * v[0]; o0.y = x0.y + g0.y * v[1]; o0.z = x0.z + g0.z * v[2]; o0.w = x0.w + g0.w * v[3];
    o1.x = x1.x + g1.x * v[4]; o1.y = x1.y + g1.y * v[5]; o1.z = x1.z + g1.z * v[6]; o1.w = x1.w + g1.w * v[7];
    *(float4*)xo = o0; *(float4*)(xo + 4) = o1;
  } else if constexpr (EPI == EPI_PLAIN) {
    uint4 o;
    o.x = pack2h(v[0], v[1]); o.y = pack2h(v[2], v[3]); o.z = pack2h(v[4], v[5]); o.w = pack2h(v[6], v[7]);
    *(uint4*)((bf16_t*)(p.ws + OFF_P) + (size_t)m * 2048 + n) = o;
  } else {
    asm volatile("" :: "v"(v[0]), "v"(v[1]), "v"(v[2]), "v"(v[3]), "v"(v[4]), "v"(v[5]), "v"(v[6]), "v"(v[7]));
  }
}

#define G8_LAS __attribute__((address_space(3)))
__device__ __forceinline__ bool g8_next(int i, int nM, int nN, int G, int c, int& pm, int& pn) {
  using namespace g8;
  const int nwg = nM * nN;
  const long Lx = (long)i * G + c;
  if (Lx >= nwg) return false;
  int wgid = (int)Lx;
  { const int q = nwg / NXCD, r = nwg % NXCD, xcd = wgid % NXCD, off = wgid / NXCD; wgid = (xcd < r ? xcd * (q + 1) : r * (q + 1) + (xcd - r) * q) + off; }
  const int nig = WGM * nN, gid = wgid / nig, fm = gid * WGM, gsz = (nM - fm) < WGM ? (nM - fm) : WGM;
  pm = fm + ((wgid % nig) % gsz); pn = (wgid % nig) / gsz;
  return true;
}

template <int EPI>
__device__ __forceinline__ void gemm_phase2(const Params& p, int layer, char* smem, const bf16_t* A, const bf16_t* Bt,
                                            int M, int N, const float* xin_lat) {
  using namespace g8;
  constexpr int K = 1024, nt = K / BK, HTB = HALF * BK * 2;
  G8_LAS unsigned char* lds = (G8_LAS unsigned char*)smem;
  const int tid = opaque_tid();
  const int wid = __builtin_amdgcn_readfirstlane(tid >> 6), lane = tid & 63, wr = wid >> 2, wc = wid & 3, fr = lane & 15, fq = lane >> 4;
  unsigned voff[2], voffB[2];
#pragma unroll
  for (int i = 0; i < 2; ++i) {
    int R, C; stage_rc(tid * 16 + i * 8192, R, C);
    const int rho = R & 31, Rb = (R & ~31) + 8 * ((rho & 15) >> 2) + 4 * (rho >> 4) + (rho & 3);
    voff[i] = (unsigned)(R * K + C) * 2u; voffB[i] = (unsigned)(Rb * K + C) * 2u;
  }
  if constexpr (EPI == EPI_INPROJ) {
    __syncthreads();
    const float4* gsrc = (const float4*)(p.ws + OFF_ROPE);
    float4* ldst = (float4*)(smem + G8_ROPE_LDS);
    for (int i = tid; i < 12288 / 16; i += 512) ldst[i] = gsrc[i];
  }
  constexpr size_t kstep = (size_t)(BK * 2);
  constexpr size_t hstep = (size_t)HALF * K * 2;
  constexpr size_t tstep = 2 * hstep;
  const unsigned ldsw = (unsigned)wid * 1024u;
  const int aoff = lds_byte(wr * 64 + fr, fq * 8), boff = lds_byte(wc * 32 + fr, fq * 8);
#define G8_SA(b, h) (((b) * 2 + (h)) * HTB)
#define G8_SB(b, h) ((4 + (b) * 2 + (h)) * HTB)
#define G8_STAGE_V(bufoff, gbase, VO) do { _Pragma("unroll") for (int _i = 0; _i < 2; ++_i)                                  \
    __builtin_amdgcn_global_load_lds((const unsigned*)((const char*)(gbase) + VO[_i]), (G8_LAS unsigned*)(lds + (bufoff) + ldsw + _i * 8192), 16, 0, 0); } while (0)
#define G8_LDA(dst, b, h) do { _Pragma("unroll") for (int m = 0; m < 4; ++m) _Pragma("unroll") for (int k = 0; k < 2; ++k) dst[m][k] = *(const G8_LAS bf16x8*)(lds + G8_SA(b, h) + aoff + m * 2048 + k * 1024); } while (0)
#define G8_LDB(dst, b, h) do { _Pragma("unroll") for (int n = 0; n < 2; ++n) _Pragma("unroll") for (int k = 0; k < 2; ++k) dst[n][k] = *(const G8_LAS bf16x8*)(lds + G8_SB(b, h) + boff + n * 2048 + k * 1024); } while (0)
#define G8_MMA(ai, bj, At_, Bt_) do { __builtin_amdgcn_s_setprio(1);                                                          \
    _Pragma("unroll") for (int m = 0; m < 4; ++m) _Pragma("unroll") for (int n = 0; n < 2; ++n) _Pragma("unroll") for (int k = 0; k < 2; ++k) \
      acc[ai][bj][m][n] = __builtin_amdgcn_mfma_f32_16x16x32_bf16(Bt_[n][k], At_[m][k], acc[ai][bj][m][n], 0, 0, 0);          \
    __builtin_amdgcn_s_setprio(0); } while (0)
#define G8_WAIT_V(n) asm volatile("s_waitcnt vmcnt(" #n ")" ::: "memory")
#define G8_WAIT_L(n) asm volatile("s_waitcnt lgkmcnt(" #n ")" ::: "memory")
#define G8_BAR __builtin_amdgcn_s_barrier()
#define G8_SCHED __builtin_amdgcn_sched_barrier(0)
  const int nM = M / BM, nN = N / BM, G = gridDim.x, cu = opaque_bid();
  int cpm, cpn, npm = 0, npn = 0, ui = 0;
  __syncthreads();
  if (g8_next(0, nM, nN, G, cu, cpm, cpn)) {
    f32x4 acc[2][2][4][2];
#pragma unroll
    for (int a = 0; a < 2; ++a)
#pragma unroll
      for (int b2 = 0; b2 < 2; ++b2)
#pragma unroll
        for (int m = 0; m < 4; ++m)
#pragma unroll
          for (int n = 0; n < 2; ++n) acc[a][b2][m][n] = (f32x4){0.f, 0.f, 0.f, 0.f};
    bf16x8 At[4][2], B0[2][2], B1[2][2];
    const char* cA = (const char*)A + (size_t)cpm * tstep;
    const char* cB = (const char*)Bt + (size_t)cpn * tstep;
    G8_STAGE_V(G8_SB(0, 0), cB, voffB); G8_STAGE_V(G8_SA(0, 0), cA, voff); G8_STAGE_V(G8_SB(0, 1), cB + hstep, voffB); G8_STAGE_V(G8_SA(0, 1), cA + hstep, voff);
    if (wr == 1) G8_BAR;
    G8_WAIT_V(4); G8_BAR;
    G8_STAGE_V(G8_SB(1, 0), cB + kstep, voffB); G8_STAGE_V(G8_SA(1, 0), cA + kstep, voff); G8_STAGE_V(G8_SB(1, 1), cB + hstep + kstep, voffB);
    G8_WAIT_V(6); G8_BAR;
    for (;;) {
      const bool has_next = g8_next(ui + 1, nM, nN, G, cu, npm, npn);
      const char* nA = has_next ? (const char*)A + (size_t)npm * tstep : cA;
      const char* nB = has_next ? (const char*)Bt + (size_t)npn * tstep : cB;
#pragma unroll 1
      for (int t = 0; t < nt; t += 2) {
        const bool last = (t == nt - 2);
        const char* a1 = cA + (size_t)(t + 1) * kstep;
        const char* a2 = last ? nA : cA + (size_t)(t + 2) * kstep; const char* b2 = last ? nB : cB + (size_t)(t + 2) * kstep;
        const char* a3 = a2 + kstep; const char* b3 = b2 + kstep;
        G8_LDB(B0, 0, 0); G8_SCHED; G8_LDA(At, 0, 0); G8_STAGE_V(G8_SA(1, 1), a1 + hstep, voff);
        G8_WAIT_L(8); G8_BAR; G8_WAIT_L(0); G8_MMA(0, 0, At, B0); G8_BAR; G8_SCHED;
        G8_LDB(B1, 0, 1); G8_STAGE_V(G8_SB(0, 0), b2, voffB);
        G8_BAR; G8_WAIT_L(0); G8_MMA(0, 1, At, B1); G8_BAR;
        G8_LDA(At, 0, 1); G8_STAGE_V(G8_SA(0, 0), a2, voff);
        G8_BAR; G8_WAIT_L(0); G8_MMA(1, 0, At, B0); G8_BAR; G8_SCHED;
        G8_STAGE_V(G8_SB(0, 1), b2 + hstep, voffB);
        G8_WAIT_V(6); G8_BAR; G8_MMA(1, 1, At, B1); G8_BAR;
        G8_LDB(B0, 1, 0); G8_SCHED; G8_LDA(At, 1, 0); G8_STAGE_V(G8_SA(0, 1), a2 + hstep, voff);
        G8_WAIT_L(8); G8_BAR; G8_WAIT_L(0); G8_MMA(0, 0, At, B0); G8_BAR; G8_SCHED;
        G8_LDB(B1, 1, 1); G8_STAGE_V(G8_SB(1, 0), b3, voffB);
        G8_BAR; G8_WAIT_L(0); G8_MMA(0, 1, At, B1); G8_BAR;
        G8_LDA(At, 1, 1); G8_STAGE_V(G8_SA(1, 0), a3, voff);
        G8_BAR; G8_WAIT_L(0); G8_MMA(1, 0, At, B0); G8_BAR; G8_SCHED;
        G8_STAGE_V(G8_SB(1, 1), b3 + hstep, voffB);
        G8_WAIT_V(6); G8_BAR; G8_MMA(1, 1, At, B1); G8_BAR;
      }
      {
        const int brow = cpm * BM, bcol = cpn * BM;
        if constexpr (EPI == EPI_INPROJ) {
          if (bcol == C_DFK) {
#pragma unroll
            for (int bj = 0; bj < 2; ++bj) {
              float mx = 0.f;
#pragma unroll
              for (int ai = 0; ai < 2; ++ai)
#pragma unroll
                for (int m = 0; m < 4; ++m) {
                  float s = 0.f;
#pragma unroll
                  for (int n = 0; n < 2; ++n)
#pragma unroll
                    for (int j = 0; j < 4; ++j) s = fmaf(acc[ai][bj][m][n][j], acc[ai][bj][m][n][j], s);
                  s += __shfl_xor(s, 16); s += __shfl_xor(s, 32);
                  mx = fmaxf(mx, s);
                }
#pragma unroll
              for (int o = 1; o < 16; o <<= 1) mx = fmaxf(mx, __shfl_xor(mx, o));
              if (lane == 0) {
                const int bb = brow < NLAT ? (brow >> 12) : ((brow - NLAT) >> 8);
                unsigned* km = (unsigned*)(p.ws + OFF_MISC) + 64 + layer * 64 + (bb * 4 + bj * 2 + (wc >> 1)) * 2 + (wc & 1);
                atomicMax(km, __float_as_uint(mx));
              }
            }
          }
        }
#pragma unroll
        for (int ai = 0; ai < 2; ++ai)
#pragma unroll
          for (int bj = 0; bj < 2; ++bj)
#pragma unroll
            for (int m = 0; m < 4; ++m)
              epi_store8<EPI>(p, layer, smem, brow + ai * HALF + wr * 64 + m * 16 + fr, bcol + bj * HALF + wc * 32 + fq * 8,
                              acc[ai][bj][m][0], acc[ai][bj][m][1], xin_lat);
      }
      if (!has_next) break;
#pragma unroll
      for (int a = 0; a < 2; ++a)
#pragma unroll
        for (int b2 = 0; b2 < 2; ++b2)
#pragma unroll
          for (int m = 0; m < 4; ++m)
#pragma unroll
            for (int n = 0; n < 2; ++n) acc[a][b2][m][n] = (f32x4){0.f, 0.f, 0.f, 0.f};
      cpm = npm; cpn = npn; cA = nA; cB = nB; ++ui;
    }
    G8_WAIT_V(0);
    if (wr == 0) G8_BAR;
    G8_BAR;
  }
}

__device__ __forceinline__ unsigned cvt_pk_bf16(float lo, float hi) { return pack2h(lo, hi); }
__device__ __forceinline__ void vt_store8(bf16_t* vt, int stride, int d0, int key, uint4 uv) {
  bf16_t* vd = vt + d0 * stride + key;
  vd[0 * stride] = (bf16_t)(uv.x & 0xffffu); vd[1 * stride] = (bf16_t)(uv.x >> 16);
  vd[2 * stride] = (bf16_t)(uv.y & 0xffffu); vd[3 * stride] = (bf16_t)(uv.y >> 16);
  vd[4 * stride] = (bf16_t)(uv.z & 0xffffu); vd[5 * stride] = (bf16_t)(uv.z >> 16);
  vd[6 * stride] = (bf16_t)(uv.w & 0xffffu); vd[7 * stride] = (bf16_t)(uv.w >> 16);
}

constexpr int DKS = 72;
__device__ __forceinline__ void diff_item(const Params& p, int layer, bool ctxq, int item, char* smem) {
  const bf16_t* P = (const bf16_t*)(p.ws + OFF_P);
  bf16_t* Y = (bf16_t*)(p.ws + OFF_ACT);
  const float* misc = (const float*)(p.ws + OFF_MISC);
  const float lam = misc[layer], lam_init = misc[2 + layer];
  const int tid = opaque_tid(), lane = tid & 63, wave = tid >> 6, lr = lane & 15, lq = lane >> 4;
  int b, h, mbase, nkeys;
  if (!ctxq) { b = item >> 6; h = (item >> 4) & 3; mbase = b * 4096 + (item & 15) * 256; nkeys = 256 + 4096; }
  else { b = item >> 2; h = item & 3; mbase = NLAT + b * 256; nkeys = 256; }
  const float kmax0 = sqrtf(misc[64 + layer * 64 + (b * 4 + h) * 2 + 0]), kmax1 = sqrtf(misc[64 + layer * 64 + (b * 4 + h) * 2 + 1]);
  bf16x8 qf[2][2];
  f32x4 C0[2], C1[2];
#pragma unroll
  for (int qt = 0; qt < 2; ++qt) {
    const bf16_t* qr = P + (size_t)(mbase + wave * 32 + qt * 16 + lr) * INC + C_DFQ + h * 64 + lq * 8;
    const uint4 u0 = *(const uint4*)(qr), u1 = *(const uint4*)(qr + 32);
    float s0 = 0.f, s1 = 0.f;
    { float t[8]; UNPACK8(t, 0, u0) _Pragma("unroll") for (int i = 0; i < 8; ++i) s0 = fmaf(t[i], t[i], s0); }
    { float t[8]; UNPACK8(t, 0, u1) _Pragma("unroll") for (int i = 0; i < 8; ++i) s1 = fmaf(t[i], t[i], s1); }
    s0 += __shfl_xor(s0, 16); s0 += __shfl_xor(s0, 32);
    s1 += __shfl_xor(s1, 16); s1 += __shfl_xor(s1, 32);
    const float nm0 = -sqrtf(s0) * kmax0, nm1 = -sqrtf(s1) * kmax1;
    C0[qt] = (f32x4){nm0, nm0, nm0, nm0};
    C1[qt] = (f32x4){nm1, nm1, nm1, nm1};
    union { uint4 u; bf16x8 v; } c0, c1; c0.u = u0; c1.u = u1;
    qf[qt][0] = c0.v; qf[qt][1] = c1.v;
  }
  f32x4 O0[2][4], O1[2][4];
#pragma unroll
  for (int qt = 0; qt < 2; ++qt)
#pragma unroll
    for (int i = 0; i < 4; ++i) { O0[qt][i] = (f32x4){0.f, 0.f, 0.f, 0.f}; O1[qt][i] = (f32x4){0.f, 0.f, 0.f, 0.f}; }
  f32x4 L0[2], L1[2];
#pragma unroll
  for (int qt = 0; qt < 2; ++qt) { L0[qt] = (f32x4){0.f, 0.f, 0.f, 0.f}; L1[qt] = (f32x4){0.f, 0.f, 0.f, 0.f}; }
  const bf16x8 ones8 = {(short)0x3F80, (short)0x3F80, (short)0x3F80, (short)0x3F80, (short)0x3F80, (short)0x3F80, (short)0x3F80, (short)0x3F80};
  const int lkey = tid >> 3, lch = tid & 7;
  constexpr int DBUF = 2 * 128 * DKS * 2;
  uint4 ukA0, ukA1, uvA0, uvA1;
#define DF_GLOAD1(UK, UV, T, I)                                                                     \
  {                                                                                                 \
    const int kk = (T) * 128 + (I) * 64 + lkey;                                                     \
    const size_t row = kk < 256 ? (size_t)(NLAT + b * 256 + kk) : (size_t)(b * 4096 + kk - 256);    \
    UK = *(const uint4*)(P + row * INC + C_DFK + h * 64 + lch * 8);                                 \
    UV = *(const uint4*)(P + row * INC + C_DFV + h * 64 + lch * 8);                                 \
  }
#define DF_LSTORE1(UK, UV, BUF, I)                                                                  \
  {                                                                                                 \
    bf16_t* Ks_ = (bf16_t*)(smem + (BUF) * DBUF) + (I) * 64 * DKS;                                  \
    bf16_t* Vt_ = (bf16_t*)(smem + (BUF) * DBUF) + 128 * DKS + (I) * 64 * DKS;                      \
    *(uint4*)(Ks_ + lkey * DKS + lch * 8) = UK;                                                     \
    vt_store8(Vt_, DKS, lch * 8, lkey, UV);                                                         \
  }
#define DF_GLOAD(S, T) DF_GLOAD1(uk##S##0, uv##S##0, T, 0) DF_GLOAD1(uk##S##1, uv##S##1, T, 1)
#define DF_LSTORE(S, BUF) DF_LSTORE1(uk##S##0, uv##S##0, BUF, 0) DF_LSTORE1(uk##S##1, uv##S##1, BUF, 1)
  const int ntile = nkeys >> 7;
  __syncthreads();
  DF_GLOAD(A, 0)
  DF_LSTORE(A, 0)
  __syncthreads();
#pragma unroll 1
  for (int t = 0; t < ntile; ++t) {
    const int cur = t & 1;
    if (t + 1 < ntile) { DF_GLOAD(A, t + 1) }
#pragma unroll 1
    for (int sub = 0; sub < 2; ++sub) {
    const bf16_t* Ks = (const bf16_t*)(smem + cur * DBUF) + sub * 64 * DKS;
    const bf16_t* Vt = (const bf16_t*)(smem + cur * DBUF) + 128 * DKS + sub * 64 * DKS;
    union PF { unsigned u[4]; bf16x8 v; };
    PF pf0[2][2], pf1[2][2];
#pragma unroll
    for (int c = 0; c < 2; ++c) {
      f32x4 S[2][4];
#pragma unroll
      for (int kt = 0; kt < 4; ++kt) {
        const bf16x8 kf = *(const bf16x8*)(Ks + (kt * 16 + lr) * DKS + c * 32 + lq * 8);
#pragma unroll
        for (int qt = 0; qt < 2; ++qt) S[qt][kt] = __builtin_amdgcn_mfma_f32_16x16x32_bf16(kf, qf[qt][c], c == 0 ? C0[qt] : C1[qt], 0, 0, 0);
      }
#pragma unroll
      for (int qt = 0; qt < 2; ++qt) {
#pragma unroll
        for (int kt = 0; kt < 4; ++kt) {
#pragma unroll
          for (int r = 0; r < 4; ++r) S[qt][kt][r] = __builtin_amdgcn_exp2f(S[qt][kt][r]);
        }
#pragma unroll
        for (int g = 0; g < 2; ++g) {
          PF t;
          t.u[0] = cvt_pk_bf16(S[qt][2 * g][0], S[qt][2 * g][1]); t.u[1] = cvt_pk_bf16(S[qt][2 * g][2], S[qt][2 * g][3]);
          t.u[2] = cvt_pk_bf16(S[qt][2 * g + 1][0], S[qt][2 * g + 1][1]); t.u[3] = cvt_pk_bf16(S[qt][2 * g + 1][2], S[qt][2 * g + 1][3]);
          if (c == 0) pf0[qt][g] = t; else pf1[qt][g] = t;
        }
      }
    }
#pragma unroll
    for (int g = 0; g < 2; ++g) {
#pragma unroll
      for (int qt = 0; qt < 2; ++qt) {
        L0[qt] = __builtin_amdgcn_mfma_f32_16x16x32_bf16(ones8, pf0[qt][g].v, L0[qt], 0, 0, 0);
        L1[qt] = __builtin_amdgcn_mfma_f32_16x16x32_bf16(ones8, pf1[qt][g].v, L1[qt], 0, 0, 0);
      }
#pragma unroll
      for (int dt = 0; dt < 4; ++dt) {
        union { uint2 h2[2]; bf16x8 v; } vf;
        vf.h2[0] = *(const uint2*)(Vt + (dt * 16 + lr) * DKS + 32 * g + 4 * lq);
        vf.h2[1] = *(const uint2*)(Vt + (dt * 16 + lr) * DKS + 32 * g + 16 + 4 * lq);
#pragma unroll
        for (int qt = 0; qt < 2; ++qt) {
          O0[qt][dt] = __builtin_amdgcn_mfma_f32_16x16x32_bf16(vf.v, pf0[qt][g].v, O0[qt][dt], 0, 0, 0);
          O1[qt][dt] = __builtin_amdgcn_mfma_f32_16x16x32_bf16(vf.v, pf1[qt][g].v, O1[qt][dt], 0, 0, 0);
        }
      }
    }
    }
    if (t + 1 < ntile) { DF_LSTORE(A, cur ^ 1) }
    __syncthreads();
  }
  const float* sg = p.diff_subln_g + layer * 64;
#pragma unroll
  for (int qt = 0; qt < 2; ++qt) {
    const float a0 = L0[qt][0], a1 = L1[qt][0];
    const float i0 = 1.f / a0, i1 = lam / a1;
    float ss = 0.f;
#pragma unroll
    for (int dt = 0; dt < 4; ++dt) {
#pragma unroll
      for (int r = 0; r < 4; ++r) { const float v = O0[qt][dt][r] * i0 - O1[qt][dt][r] * i1; O0[qt][dt][r] = v; ss = fmaf(v, v, ss); }
    }
    ss += __shfl_xor(ss, 16); ss += __shfl_xor(ss, 32);
    const float rr = rsqrtf(ss * (1.f / 64.f) + EPS) * (1.f - lam_init);
    bf16_t* dst = Y + (size_t)(mbase + wave * 32 + qt * 16 + lr) * 1024 + Y_DF + h * 64;
#pragma unroll
    for (int dt = 0; dt < 4; ++dt) {
      const int d = dt * 16 + 4 * lq;
      const float4 g4 = *(const float4*)(sg + d);
      uint2 ov;
      ov.x = pack2(O0[qt][dt][0] * rr * g4.x, O0[qt][dt][1] * rr * g4.y);
      ov.y = pack2(O0[qt][dt][2] * rr * g4.z, O0[qt][dt][3] * rr * g4.w);
      *(uint2*)(dst + d) = ov;
    }
  }
}

constexpr int NA_WS = 520;
constexpr int NA_CS = 264;
constexpr int NA_OFF_VTW = 0;
constexpr int NA_OFF_VTC = 64 * NA_WS * 2;
constexpr int NA_OFF_RPB = NA_OFF_VTC + 64 * NA_CS * 2;
constexpr int NA_OFF_MRG = NA_OFF_RPB + 2048;

#define NA_STEP(KA_EXPR, KB_EXPR, BIAS_EXPR, VT_PTR, VT_STRIDE, VT_KEY0_EXPR)                                    \
  {                                                                                                               \
    f32x4 S[4];                                                                                                   \
    _Pragma("unroll") for (int kt = 0; kt < 4; ++kt) {                                                            \
      f32x4 a = __builtin_amdgcn_mfma_f32_16x16x32_bf16((KA_EXPR), qf[0], (f32x4){0.f, 0.f, 0.f, 0.f}, 0, 0, 0);  \
      S[kt] = __builtin_amdgcn_mfma_f32_16x16x32_bf16((KB_EXPR), qf[1], a, 0, 0, 0);                               \
    }                                                                                                             \
    _Pragma("unroll") for (int kt = 0; kt < 4; ++kt) {                                                            \
      _Pragma("unroll") for (int r = 0; r < 4; ++r) { S[kt][r] += (BIAS_EXPR); }                                  \
    }                                                                                                             \
    float x = fmaxf(fmaxf(S[0][0], S[0][1]), fmaxf(S[0][2], S[0][3]));                                            \
    _Pragma("unroll") for (int kt = 1; kt < 4; ++kt) x = fmaxf(x, fmaxf(fmaxf(S[kt][0], S[kt][1]), fmaxf(S[kt][2], S[kt][3]))); \
    x = fmaxf(x, __shfl_xor(x, 16)); x = fmaxf(x, __shfl_xor(x, 32));                                             \
    const float mn = fmaxf(mrun, x);                                                                              \
    const float al = __builtin_amdgcn_exp2f(mrun - mn);                                                           \
    mrun = mn;                                                                                                    \
    float ps = 0.f;                                                                                               \
    _Pragma("unroll") for (int kt = 0; kt < 4; ++kt) {                                                            \
      _Pragma("unroll") for (int r = 0; r < 4; ++r) { S[kt][r] = __builtin_amdgcn_exp2f(S[kt][r] - mn); ps += S[kt][r]; } \
    }                                                                                                             \
    lrun = lrun * al + ps;                                                                                        \
    _Pragma("unroll") for (int dt = 0; dt < 4; ++dt) {                                                            \
      _Pragma("unroll") for (int r = 0; r < 4; ++r) O[dt][r] *= al;                                               \
    }                                                                                                             \
    _Pragma("unroll") for (int g = 0; g < 2; ++g) {                                                               \
      union { unsigned u[4]; bf16x8 v; } pf;                                                                      \
      pf.u[0] = cvt_pk_bf16(S[2 * g][0], S[2 * g][1]); pf.u[1] = cvt_pk_bf16(S[2 * g][2], S[2 * g][3]);           \
      pf.u[2] = cvt_pk_bf16(S[2 * g + 1][0], S[2 * g + 1][1]); pf.u[3] = cvt_pk_bf16(S[2 * g + 1][2], S[2 * g + 1][3]); \
      const int vk0 = (VT_KEY0_EXPR);                                                                             \
      _Pragma("unroll") for (int dt = 0; dt < 4; ++dt) {                                                          \
        union { uint2 h2[2]; bf16x8 v; } vf;                                                                      \
        vf.h2[0] = *(const uint2*)((VT_PTR) + (dt * 16 + lr) * (VT_STRIDE) + vk0 + 4 * lq);                       \
        vf.h2[1] = *(const uint2*)((VT_PTR) + (dt * 16 + lr) * (VT_STRIDE) + vk0 + 16 + 4 * lq);                  \
        O[dt] = __builtin_amdgcn_mfma_f32_16x16x32_bf16(vf.v, pf.v, O[dt], 0, 0, 0);                              \
      }                                                                                                           \
    }                                                                                                             \
  }

__device__ __forceinline__ void na_latent_item(const Params& p, int layer, int item, char* smem) {
  const bf16_t* P = (const bf16_t*)(p.ws + OFF_P);
  bf16_t* Y = (bf16_t*)(p.ws + OFF_ACT);
  const int b = item >> 8, h = (item >> 6) & 3, grow = item & 63;
  const int tid = opaque_tid(), lane = tid & 63, wave = tid >> 6, lr = lane & 15, lq = lane >> 4;
  const int jt = wave & 3, half = wave >> 2;
  bf16_t* VtW = (bf16_t*)(smem + NA_OFF_VTW);
  bf16_t* VtC = (bf16_t*)(smem + NA_OFF_VTC);
  float* RPB = (float*)(smem + NA_OFF_RPB);
  float* MRG = (float*)(smem + NA_OFF_MRG);
  const int rs = min(max(grow - 4, 0), 56);
  __syncthreads();
  {
    const int ch = tid & 7;
#pragma unroll
    for (int i = 0; i < 8; ++i) {
      const int key = (tid >> 3) + 64 * i;
      const uint4 uv = *(const uint4*)(P + (size_t)(b * 4096 + (rs + (key >> 6)) * 64 + (key & 63)) * INC + C_NAV + h * 64 + ch * 8);
      vt_store8(VtW, NA_WS, ch * 8, key, uv);
    }
#pragma unroll
    for (int i = 0; i < 4; ++i) {
      const int key = (tid >> 3) + 64 * i;
      const uint4 uv = *(const uint4*)(P + (size_t)(NLAT + b * 256 + key) * INC + C_NAV + h * 64 + ch * 8);
      vt_store8(VtC, NA_CS, ch * 8, key, uv);
    }
    if (tid < 465) RPB[tid] = p.na_rpb[(size_t)(layer * 4 + h) * 465 + tid] * 1.4426950408889634f;
  }
  const int qc = jt * 16 + lr;
  const int mq = b * 4096 + grow * 64 + qc;
  bf16x8 qf[2];
  {
    const bf16_t* qr = P + (size_t)mq * INC + C_NAQ + h * 64 + lq * 8;
    qf[0] = *(const bf16x8*)(qr);
    qf[1] = *(const bf16x8*)(qr + 32);
  }
  f32x4 O[4];
#pragma unroll
  for (int i = 0; i < 4; ++i) O[i] = (f32x4){0.f, 0.f, 0.f, 0.f};
  float mrun = -1e30f, lrun = 0.f;
  const int k0 = min(max(jt * 16 - 8, 0), 32);
  const int cs = min(max(qc - 8, 0), 48);
  bf16x8 kfa[2][4], kfb[2][4];
#define NA_LOADK(SET, S_)                                                                                        \
  _Pragma("unroll") for (int kt = 0; kt < 4; ++kt) {                                                             \
    const int t_ = 4 * (S_) + kt;                                                                                \
    const size_t krow = half == 0 ? (size_t)(b * 4096 + (rs + (t_ >> 1)) * 64 + k0 + 16 * (t_ & 1) + lr) : (size_t)(NLAT + b * 256 + 16 * t_ + lr); \
    const bf16_t* kp = P + krow * INC + C_NAK + h * 64 + lq * 8;                                                 \
    kfa[SET][kt] = *(const bf16x8*)(kp); kfb[SET][kt] = *(const bf16x8*)(kp + 32);                               \
  }
  NA_LOADK(0, 0)
  __syncthreads();
#pragma unroll
  for (int s = 0; s < 4; ++s) {
    if (s + 1 < 4) { NA_LOADK((s + 1) & 1, s + 1) }
    if (half == 0) {
      const int wr0 = 2 * s;
      NA_STEP(kfa[s & 1][kt], kfb[s & 1][kt],
              ((k0 + 16 * (kt & 1) + 4 * lq + r) >= cs && (k0 + 16 * (kt & 1) + 4 * lq + r) < cs + 16)
                  ? RPB[(rs + wr0 + (kt >> 1) - grow + 7) * 31 + (k0 + 16 * (kt & 1) + 4 * lq + r) - qc + 15] : -1e30f,
              VtW, NA_WS, (wr0 + g) * 64 + k0)
    } else {
      NA_STEP(kfa[s & 1][kt], kfb[s & 1][kt], 0.f, VtC, NA_CS, s * 64 + 32 * g)
    }
  }
  lrun += __shfl_xor(lrun, 16); lrun += __shfl_xor(lrun, 32);
  float* mg = MRG + (jt * 64 + lane) * 18;
  if (half == 1) {
    mg[0] = mrun; mg[1] = lrun;
#pragma unroll
    for (int dt = 0; dt < 4; ++dt) { mg[2 + dt * 4 + 0] = O[dt][0]; mg[2 + dt * 4 + 1] = O[dt][1]; mg[2 + dt * 4 + 2] = O[dt][2]; mg[2 + dt * 4 + 3] = O[dt][3]; }
  }
  __syncthreads();
  if (half == 0) {
    const float m2 = mg[0], l2 = mg[1];
    const float M = fmaxf(mrun, m2);
    const float f1 = __builtin_amdgcn_exp2f(mrun - M), f2 = __builtin_amdgcn_exp2f(m2 - M);
    const float inv = 1.f / (lrun * f1 + l2 * f2);
    bf16_t* dst = Y + (size_t)mq * 1024 + Y_NA + h * 64;
#pragma unroll
    for (int dt = 0; dt < 4; ++dt) {
      const float o0 = (O[dt][0] * f1 + mg[2 + dt * 4 + 0] * f2) * inv, o1 = (O[dt][1] * f1 + mg[2 + dt * 4 + 1] * f2) * inv;
      const float o2 = (O[dt][2] * f1 + mg[2 + dt * 4 + 2] * f2) * inv, o3 = (O[dt][3] * f1 + mg[2 + dt * 4 + 3] * f2) * inv;
      uint2 ov; ov.x = pack2(o0, o1); ov.y = pack2(o2, o3);
      *(uint2*)(dst + dt * 16 + 4 * lq) = ov;
    }
  }
}

__device__ __forceinline__ void na_ctx_item(const Params& p, int item, char* smem) {
  const bf16_t* P = (const bf16_t*)(p.ws + OFF_P);
  bf16_t* Y = (bf16_t*)(p.ws + OFF_ACT);
  const int b = item >> 3, h = (item >> 1) & 3, qg = item & 1;
  const int tid = opaque_tid(), lane = tid & 63, wave = tid >> 6, lr = lane & 15, lq = lane >> 4;
  bf16_t* VtC = (bf16_t*)(smem + NA_OFF_VTC);
  __syncthreads();
  {
    const int ch = tid & 7;
#pragma unroll
    for (int i = 0; i < 4; ++i) {
      const int key = (tid >> 3) + 64 * i;
      const uint4 uv = *(const uint4*)(P + (size_t)(NLAT + b * 256 + key) * INC + C_NAV + h * 64 + ch * 8);
      vt_store8(VtC, NA_CS, ch * 8, key, uv);
    }
  }
  const int mq = NLAT + b * 256 + qg * 128 + wave * 16 + lr;
  bf16x8 qf[2];
  {
    const bf16_t* qr = P + (size_t)mq * INC + C_NAQ + h * 64 + lq * 8;
    qf[0] = *(const bf16x8*)(qr);
    qf[1] = *(const bf16x8*)(qr + 32);
  }
  f32x4 O[4];
#pragma unroll
  for (int i = 0; i < 4; ++i) O[i] = (f32x4){0.f, 0.f, 0.f, 0.f};
  float mrun = -1e30f, lrun = 0.f;
  __syncthreads();
#pragma unroll 1
  for (int s = 0; s < 4; ++s) {
    NA_STEP(*(const bf16x8*)(P + (size_t)(NLAT + b * 256 + s * 64 + kt * 16 + lr) * INC + C_NAK + h * 64 + lq * 8),
            *(const bf16x8*)(P + (size_t)(NLAT + b * 256 + s * 64 + kt * 16 + lr) * INC + C_NAK + h * 64 + 32 + lq * 8), 0.f, VtC, NA_CS, s * 64 + 32 * g)
  }
  lrun += __shfl_xor(lrun, 16); lrun += __shfl_xor(lrun, 32);
  const float inv = 1.f / lrun;
  bf16_t* dst = Y + (size_t)mq * 1024 + Y_NA + h * 64;
#pragma unroll
  for (int dt = 0; dt < 4; ++dt) {
    uint2 ov; ov.x = pack2(O[dt][0] * inv, O[dt][1] * inv); ov.y = pack2(O[dt][2] * inv, O[dt][3] * inv);
    *(uint2*)(dst + dt * 16 + 4 * lq) = ov;
  }
}

constexpr int KV_S = 136;
constexpr int KV_OFF_KF = 0, KV_OFF_KB = 64 * KV_S * 2, KV_OFF_VT = 2 * 64 * KV_S * 2;
__device__ __forceinline__ void ret_kv_item(const Params& p, int layer, int h, size_t row0, int cnt, float* dstF, float* dstB, char* smem) {
  const bf16_t* P = (const bf16_t*)(p.ws + OFF_P);
  const float* misc = (const float*)(p.ws + OFF_MISC);
  const float lgF2 = misc[16 + layer * 8 + 0 * 4 + h] * 1.4426950408889634f, lgB2 = misc[16 + layer * 8 + 1 * 4 + h] * 1.4426950408889634f;
  const int tid = opaque_tid(), lane = tid & 63, wave = tid >> 6, lr = lane & 15, lq = lane >> 4;
  bf16_t* KFt = (bf16_t*)(smem + KV_OFF_KF);
  bf16_t* KBt = (bf16_t*)(smem + KV_OFF_KB);
  bf16_t* Vt = (bf16_t*)(smem + KV_OFF_VT);
  const int dir = wave >> 2, dt = wave & 3;
  f32x4 acc[8];
#pragma unroll
  for (int i = 0; i < 8; ++i) acc[i] = (f32x4){0.f, 0.f, 0.f, 0.f};
#pragma unroll 1
  for (int kc = 0; kc < (cnt >> 7); ++kc) {
    __syncthreads();
    {
      const int tok = tid >> 2, c = tid & 3;
      const int j = kc * 128 + tok;
      const float wF = __builtin_amdgcn_exp2f(lgF2 * (float)(cnt - 1 - j)), wB = __builtin_amdgcn_exp2f(lgB2 * (float)j);
      const bf16_t* rowp = P + (row0 + j) * INC;
#pragma unroll
      for (int c8 = 0; c8 < 2; ++c8) {
        const uint4 u = *(const uint4*)(rowp + C_RTK + h * 64 + c * 16 + c8 * 8);
        float kv[8];
        UNPACK8(kv, 0, u)
#pragma unroll
        for (int i = 0; i < 8; ++i) {
          KFt[(c * 16 + c8 * 8 + i) * KV_S + tok] = f2bf(kv[i] * wF);
          KBt[(c * 16 + c8 * 8 + i) * KV_S + tok] = f2bf(kv[i] * wB);
        }
      }
#pragma unroll
      for (int c8 = 0; c8 < 4; ++c8) {
        const uint4 uv = *(const uint4*)(rowp + C_RTV + h * 128 + c * 32 + c8 * 8);
        vt_store8(Vt, KV_S, c * 32 + c8 * 8, tok, uv);
      }
    }
    __syncthreads();
    const bf16_t* Kt = dir == 0 ? KFt : KBt;
    bf16x8 af[4];
#pragma unroll
    for (int ks = 0; ks < 4; ++ks) af[ks] = *(const bf16x8*)(Kt + (dt * 16 + lr) * KV_S + ks * 32 + lq * 8);
#pragma unroll
    for (int et = 0; et < 8; ++et) {
#pragma unroll
      for (int ks = 0; ks < 4; ++ks) {
        const bf16x8 bfr = *(const bf16x8*)(Vt + (et * 16 + lr) * KV_S + ks * 32 + lq * 8);
        acc[et] = __builtin_amdgcn_mfma_f32_16x16x32_bf16(af[ks], bfr, acc[et], 0, 0, 0);
      }
    }
  }
  float* dst = dir == 0 ? dstF : dstB;
#pragma unroll
  for (int et = 0; et < 8; ++et) {
#pragma unroll
    for (int r = 0; r < 4; ++r) dst[(dt * 16 + 4 * lq + r) * 128 + et * 16 + lr] = acc[et][r];
  }
}

__device__ __forceinline__ void phase_ret_scan(const Params& p, int layer) {
  const float* misc = (const float*)(p.ws + OFF_MISC);
  float* rkv = (float*)(p.ws + OFF_RKV);
  const float* rs = (const float*)(p.ws + OFF_RS);
  const int gt = opaque_bid() * 512 + opaque_tid(), gs = gridDim.x * 512;
  for (int idx = gt; idx < 64 * 2048; idx += gs) {
    const int seq = idx >> 11, e4 = (idx & 2047) * 4;
    const int dir = seq & 1, h = (seq >> 1) & 3;
    const float cdec = __expf(misc[16 + layer * 8 + dir * 4 + h] * 128.f);
    float4* base = (float4*)(rkv + (size_t)seq * 32 * 8192 + e4);
    float4 v[32];
#pragma unroll
    for (int s = 0; s < 32; ++s) v[s] = base[(size_t)s * 2048];
    float4 st = *(const float4*)(rs + (size_t)seq * 8192 + e4);
    if (dir == 0) {
#pragma unroll
      for (int s = 0; s < 32; ++s) {
        const float4 t = v[s];
        base[(size_t)s * 2048] = st;
        st.x = fmaf(cdec, st.x, t.x); st.y = fmaf(cdec, st.y, t.y); st.z = fmaf(cdec, st.z, t.z); st.w = fmaf(cdec, st.w, t.w);
      }
    } else {
#pragma unroll
      for (int s = 31; s >= 0; --s) {
        const float4 t = v[s];
        base[(size_t)s * 2048] = st;
        st.x = fmaf(cdec, st.x, t.x); st.y = fmaf(cdec, st.y, t.y); st.z = fmaf(cdec, st.z, t.z); st.w = fmaf(cdec, st.w, t.w);
      }
    }
  }
}

constexpr int RT_KS = 72, RT_VS = 136;
constexpr int RT_OFF_K = 0, RT_OFF_VT = 128 * RT_KS * 2, RT_OFF_SF = RT_OFF_VT + 128 * RT_VS * 2, RT_OFF_SB = RT_OFF_SF + 128 * RT_KS * 2;
__device__ __forceinline__ void ret_out_item(const Params& p, int layer, int h, size_t krow0, int nkc, int iq0,
                                             const float* SF, const float* SB, int clen, char* smem) {
  const bf16_t* P = (const bf16_t*)(p.ws + OFF_P);
  bf16_t* Y = (bf16_t*)(p.ws + OFF_ACT);
  const float* misc = (const float*)(p.ws + OFF_MISC);
  const float lgF2 = misc[16 + layer * 8 + 0 * 4 + h] * 1.4426950408889634f, lgB2 = misc[16 + layer * 8 + 1 * 4 + h] * 1.4426950408889634f;
  const int tid = opaque_tid(), lane = tid & 63, wave = tid >> 6, lr = lane & 15, lq = lane >> 4;
  bf16_t* Ks = (bf16_t*)(smem + RT_OFF_K);
  bf16_t* Vt = (bf16_t*)(smem + RT_OFF_VT);
  bf16_t* SFt = (bf16_t*)(smem + RT_OFF_SF);
  bf16_t* SBt = (bf16_t*)(smem + RT_OFF_SB);
  const int iq = iq0 + wave * 16 + lr;
  const size_t mq = krow0 + iq;
  bf16x8 qf[2];
  {
    const bf16_t* qr = P + mq * INC + C_RTQ + h * 64 + lq * 8;
    qf[0] = *(const bf16x8*)(qr);
    qf[1] = *(const bf16x8*)(qr + 32);
  }
  f32x4 O[8];
#pragma unroll
  for (int i = 0; i < 8; ++i) O[i] = (f32x4){0.f, 0.f, 0.f, 0.f};
  if (SF != nullptr) {
    __syncthreads();
    {
      const int d = tid >> 3, e0 = (tid & 7) * 16;
#pragma unroll
      for (int c4 = 0; c4 < 4; ++c4) {
        const float4 a = *(const float4*)(SF + d * 128 + e0 + c4 * 4);
        const float4 bb = *(const float4*)(SB + d * 128 + e0 + c4 * 4);
        SFt[(e0 + c4 * 4 + 0) * RT_KS + d] = f2bf(a.x); SFt[(e0 + c4 * 4 + 1) * RT_KS + d] = f2bf(a.y);
        SFt[(e0 + c4 * 4 + 2) * RT_KS + d] = f2bf(a.z); SFt[(e0 + c4 * 4 + 3) * RT_KS + d] = f2bf(a.w);
        SBt[(e0 + c4 * 4 + 0) * RT_KS + d] = f2bf(bb.x); SBt[(e0 + c4 * 4 + 1) * RT_KS + d] = f2bf(bb.y);
        SBt[(e0 + c4 * 4 + 2) * RT_KS + d] = f2bf(bb.z); SBt[(e0 + c4 * 4 + 3) * RT_KS + d] = f2bf(bb.w);
      }
    }
    __syncthreads();
    const float cF = __builtin_amdgcn_exp2f(lgF2 * (float)(iq + 1)), cB = __builtin_amdgcn_exp2f(lgB2 * (float)(clen - iq));
#pragma unroll
    for (int ks = 0; ks < 2; ++ks)
#pragma unroll
      for (int et = 0; et < 8; ++et) {
        const bf16x8 sf = *(const bf16x8*)(SFt + (et * 16 + lr) * RT_KS + ks * 32 + lq * 8);
        O[et] = __builtin_amdgcn_mfma_f32_16x16x32_bf16(sf, qf[ks], O[et], 0, 0, 0);
      }
    const float ratio = cF / cB;
#pragma unroll
    for (int et = 0; et < 8; ++et) { O[et][0] *= ratio; O[et][1] *= ratio; O[et][2] *= ratio; O[et][3] *= ratio; }
#pragma unroll
    for (int ks = 0; ks < 2; ++ks)
#pragma unroll
      for (int et = 0; et < 8; ++et) {
        const bf16x8 sb = *(const bf16x8*)(SBt + (et * 16 + lr) * RT_KS + ks * 32 + lq * 8);
        O[et] = __builtin_amdgcn_mfma_f32_16x16x32_bf16(sb, qf[ks], O[et], 0, 0, 0);
      }
#pragma unroll
    for (int et = 0; et < 8; ++et) { O[et][0] *= cB; O[et][1] *= cB; O[et][2] *= cB; O[et][3] *= cB; }
  }
#pragma unroll 1
  for (int kc = 0; kc < nkc; ++kc) {
    __syncthreads();
    {
      const int key = tid >> 2, c = tid & 3;
      const bf16_t* rowp = P + (krow0 + kc * 128 + key) * INC;
      const uint4 k0 = *(const uint4*)(rowp + C_RTK + h * 64 + c * 16), k1 = *(const uint4*)(rowp + C_RTK + h * 64 + c * 16 + 8);
      *(uint4*)(Ks + key * RT_KS + c * 16) = k0;
      *(uint4*)(Ks + key * RT_KS + c * 16 + 8) = k1;
#pragma unroll
      for (int c8 = 0; c8 < 4; ++c8) {
        const uint4 uv = *(const uint4*)(rowp + C_RTV + h * 128 + c * 32 + c8 * 8);
        vt_store8(Vt, RT_VS, c * 32 + c8 * 8, key, uv);
      }
    }
    __syncthreads();
    f32x4 S[8];
#pragma unroll
    for (int kt = 0; kt < 8; ++kt) {
      const bf16x8 ka = *(const bf16x8*)(Ks + (kt * 16 + lr) * RT_KS + lq * 8);
      const bf16x8 kb = *(const bf16x8*)(Ks + (kt * 16 + lr) * RT_KS + 32 + lq * 8);
      const f32x4 a = __builtin_amdgcn_mfma_f32_16x16x32_bf16(ka, qf[0], (f32x4){0.f, 0.f, 0.f, 0.f}, 0, 0, 0);
      S[kt] = __builtin_amdgcn_mfma_f32_16x16x32_bf16(kb, qf[1], a, 0, 0, 0);
    }
#pragma unroll
    for (int kt = 0; kt < 8; ++kt) {
#pragma unroll
      for (int r = 0; r < 4; ++r) {
        const int df = iq - (kc * 128 + kt * 16 + 4 * lq + r);
        const float fdf = (float)df;
        float coef = 0.f;
        if (df >= 0) coef += __builtin_amdgcn_exp2f(lgF2 * fdf);
        if (df <= 0) coef += __builtin_amdgcn_exp2f(-lgB2 * fdf);
        S[kt][r] *= coef;
      }
    }
#pragma unroll
    for (int g = 0; g < 4; ++g) {
      union { unsigned u[4]; bf16x8 v; } pf;
      pf.u[0] = cvt_pk_bf16(S[2 * g][0], S[2 * g][1]); pf.u[1] = cvt_pk_bf16(S[2 * g][2], S[2 * g][3]);
      pf.u[2] = cvt_pk_bf16(S[2 * g + 1][0], S[2 * g + 1][1]); pf.u[3] = cvt_pk_bf16(S[2 * g + 1][2], S[2 * g + 1][3]);
#pragma unroll
      for (int et = 0; et < 8; ++et) {
        union { uint2 h2[2]; bf16x8 v; } vf;
        vf.h2[0] = *(const uint2*)(Vt + (et * 16 + lr) * RT_VS + 32 * g + 4 * lq);
        vf.h2[1] = *(const uint2*)(Vt + (et * 16 + lr) * RT_VS + 32 * g + 16 + 4 * lq);
        O[et] = __builtin_amdgcn_mfma_f32_16x16x32_bf16(vf.v, pf.v, O[et], 0, 0, 0);
      }
    }
  }
  float ss = 0.f;
#pragma unroll
  for (int et = 0; et < 8; ++et) { ss = fmaf(O[et][0], O[et][0], ss); ss = fmaf(O[et][1], O[et][1], ss); ss = fmaf(O[et][2], O[et][2], ss); ss = fmaf(O[et][3], O[et][3], ss); }
  ss += __shfl_xor(ss, 16); ss += __shfl_xor(ss, 32);
  const float rr = rsqrtf(ss * (1.f / 128.f) + EPS);
  const bf16_t* gp = P + mq * INC + C_RTG + h * 128;
  bf16_t* dst = Y + mq * 1024 + Y_RT + h * 128;
#pragma unroll
  for (int et = 0; et < 8; ++et) {
    const int e = et * 16 + 4 * lq;
    const uint2 gu = *(const uint2*)(gp + e);
    uint2 ov;
    ov.x = pack2(O[et][0] * rr * siluf(lo16(gu.x)), O[et][1] * rr * siluf(hi16(gu.x)));
    ov.y = pack2(O[et][2] * rr * siluf(lo16(gu.y)), O[et][3] * rr * siluf(hi16(gu.y)));
    *(uint2*)(dst + e) = ov;
  }
}

__device__ __forceinline__ void uv_convert_item(const Params& p, int item) {
  char* ws = p.ws;
  const int tid = opaque_tid();
  const int lane = tid & 63, l = lane & 31, half = lane >> 5, wave = tid >> 6;
#pragma unroll 1
  for (int it = 0; it < 16; ++it) {
    const int row = item * 256 + (wave * 16 + it) * 2 + half;
    const bool isv = row >= 2 * NEXP;
    const int rr = isv ? row - 2 * NEXP : row;
    const float* srow = (isv ? p.peer_v : p.peer_u) + (size_t)rr * 1024;
    float4 v[8];
    float mx = 0.f;
#pragma unroll
    for (int j = 0; j < 8; ++j) {
      v[j] = ((const float4*)srow)[isv ? (l + 32 * j) : (l * 8 + j)];
      mx = fmaxf(mx, fmaxf(fmaxf(fabsf(v[j].x), fabsf(v[j].y)), fmaxf(fabsf(v[j].z), fabsf(v[j].w))));
    }
#pragma unroll
    for (int o = 1; o < 32; o <<= 1) mx = fmaxf(mx, __shfl_xor(mx, o));
    const float scale4 = mx > 0.f ? mx * (1.f / 6.f) : 1.f;
    const float inv4 = 1.f / scale4;
    unsigned w[4] = {0u, 0u, 0u, 0u};
#pragma unroll
    for (int k = 0; k < 32; ++k) {
      const float xv = (k & 3) == 0 ? v[k >> 2].x : (k & 3) == 1 ? v[k >> 2].y : (k & 3) == 2 ? v[k >> 2].z : v[k >> 2].w;
      const float a = fminf(fabsf(xv) * inv4, 6.f);
      float c;
      if (a < 2.f) c = rintf(a * 2.f);
      else if (a < 4.f) c = 4.f + rintf(a - 2.f);
      else c = 6.f + rintf((a - 4.f) * 0.5f);
      unsigned code = (unsigned)c;
      code = code > 7u ? 7u : code;
      code |= (xv < 0.f) ? 8u : 0u;
      w[k >> 3] |= code << (4 * (k & 7));
    }
    char* drow = ws + OFF_U + (size_t)rr * RECB + (isv ? ROWB + l * 16 : 64 * (l & 7) + 16 * (l >> 3));
    *(uint4*)(drow) = make_uint4(w[0], w[1], w[2], w[3]);
    if (l == 0) ((float*)(ws + (isv ? OFF_VSC : OFF_USC)))[rr] = scale4;
  }
}

__device__ __forceinline__ void phase_mix1(const Params& p, int layer, char* smem, int slot = 0) {
  unsigned* ctr = (unsigned*)(p.ws + OFF_CTL) + (layer * 4 + slot);
  const bool nc = layer == 0;
  const int n_dl = 512, n_dc = nc ? 32 : 0, n_nl = 2048, n_ncx = nc ? 64 : 0, n_kv = 1024, n_cs = 32;
  const int total = n_dl + n_dc + n_nl + n_ncx + n_kv + n_cs;
  float* rkv = (float*)(p.ws + OFF_RKV);
  float* rs = (float*)(p.ws + OFF_RS);
  for (;;) {
    int it = next_item(ctr, smem);
    if (it >= total) break;
    if (it < n_dl) { diff_item(p, layer, false, it, smem); continue; } it -= n_dl;
    if (it < n_dc) { diff_item(p, layer, true, it, smem); continue; } it -= n_dc;
    if (it < n_nl) { na_latent_item(p, layer, it, smem); continue; } it -= n_nl;
    if (it < n_ncx) { na_ctx_item(p, it, smem); continue; } it -= n_ncx;
    if (it < n_kv) {
      const int bh = it >> 5, n = it & 31, b = bh >> 2, h = bh & 3;
      ret_kv_item(p, layer, h, (size_t)b * 4096 + n * 128, 128,
                  rkv + ((size_t)(bh * 2 + 0) * 32 + n) * 8192, rkv + ((size_t)(bh * 2 + 1) * 32 + n) * 8192, smem);
      continue;
    }
    it -= n_kv;
    {
      const int bh = it, b = bh >> 2, h = bh & 3;
      ret_kv_item(p, layer, h, (size_t)NLAT + b * 256, 256, rs + (size_t)(bh * 2 + 0) * 8192, rs + (size_t)(bh * 2 + 1) * 8192, smem);
    }
  }
}

__device__ __forceinline__ void phase_mix2(const Params& p, int layer, char* smem, int slot = 1) {
  unsigned* ctr = (unsigned*)(p.ws + OFF_CTL) + (layer * 4 + slot);
  const int n_l = 1024, n_c = layer == 0 ? 64 : 0;
  const float* rkv = (const float*)(p.ws + OFF_RKV);
  for (;;) {
    int it = next_item(ctr, smem);
    if (it >= n_l + n_c) break;
    if (it < n_l) {
      const int bh = it >> 5, n = it & 31, b = bh >> 2, h = bh & 3;
      ret_out_item(p, layer, h, (size_t)b * 4096 + n * 128, 1, 0,
                   rkv + ((size_t)(bh * 2 + 0) * 32 + n) * 8192, rkv + ((size_t)(bh * 2 + 1) * 32 + n) * 8192, 128, smem);
    } else {
      it -= n_l;
      const int bh = it >> 1, half = it & 1, b = bh >> 2, h = bh & 3;
      ret_out_item(p, layer, h, (size_t)NLAT + b * 256, 2, half * 128, nullptr, nullptr, 256, smem);
    }
  }
}

typedef float f32x2 __attribute__((ext_vector_type(2)));
__device__ __forceinline__ unsigned sortable_key(float f, int idx) {
  const unsigned b = __float_as_uint(f);
  const unsigned k = b ^ ((unsigned)((int)b >> 31) | 0x80000000u);
  return (k & ~127u) | (unsigned)(127 - idx);
}
__device__ __forceinline__ float key_value(unsigned k) {
  k &= ~127u;
  const unsigned b = (k & 0x80000000u) ? (k ^ 0x80000000u) : ~k;
  return __uint_as_float(b);
}
#define FP8DOT(acc, H, off, W) { const f32x2 _a = __builtin_amdgcn_cvt_pk_f32_fp8((int)(W), false), _b = __builtin_amdgcn_cvt_pk_f32_fp8((int)(W), true); \
  acc = fmaf(H[(off) + 0], _a.x, acc); acc = fmaf(H[(off) + 1], _a.y, acc); acc = fmaf(H[(off) + 2], _b.x, acc); acc = fmaf(H[(off) + 3], _b.y, acc); }
#define FP8AXPY(O, off, P, W) { const f32x2 _a = __builtin_amdgcn_cvt_pk_f32_fp8((int)(W), false), _b = __builtin_amdgcn_cvt_pk_f32_fp8((int)(W), true); \
  O[(off) + 0] = fmaf(P, _a.x, O[(off) + 0]); O[(off) + 1] = fmaf(P, _a.y, O[(off) + 1]); O[(off) + 2] = fmaf(P, _b.x, O[(off) + 2]); O[(off) + 3] = fmaf(P, _b.y, O[(off) + 3]); }

__device__ __forceinline__ float gelu_erf(float a) {
  const float x = fabsf(a) * 0.70710678118654752f;
  const float t = __builtin_amdgcn_rcpf(fmaf(0.3275911f, x, 1.f));
  float pl = fmaf(1.061405429f, t, -1.453152027f);
  pl = fmaf(pl, t, 1.421413741f); pl = fmaf(pl, t, -0.284496736f); pl = fmaf(pl, t, 0.254829592f);
  const float y = 1.f - pl * t * __builtin_amdgcn_exp2f(-x * x * 1.4426950408889634f);
  const float er = a < 0.f ? -y : y;
  return 0.5f * a * (1.f + er);
}
constexpr int PE_SVS = 132;
constexpr int PE_OFF_SV = 0;
constexpr int PE_OFF_TV = 8 * 16 * PE_SVS * 4;
constexpr int PE_OFF_TI = PE_OFF_TV + 16 * 16 * 16 * 4;
constexpr int PE_OFF_EX = PE_OFF_TI + 16 * 16 * 16 * 4;
constexpr int PE_OFF_GT = PE_OFF_EX + 2 * 16 * 128 * 4;
constexpr int PE_OFF_SU = PE_OFF_GT + 2 * 16 * 128 * 4;
constexpr int PE_OFF_CN = PE_OFF_SU + 2 * 16 * 128 * 4;
constexpr int PE_OFF_CT = PE_OFF_CN + 8 * 16 * 4;
constexpr int PE_OFF_TQ = PE_OFF_CT + 64 * 4;
static_assert(PE_OFF_TQ + 16 <= LDS_BCAST, "PEER LDS map overflows");
#define WAVE_LDS_FENCE() asm volatile("s_waitcnt lgkmcnt(0)" ::: "memory")

__device__ __forceinline__ void peer_select_head(const Params& p, int layer, char* smem, int tok0, int hd, int sw, int buf,
                                                 int lane) {
  const bf16_t* Q = (const bf16_t*)(p.ws + OFF_P);
  const bf16_t* SK = (const bf16_t*)(p.ws + OFF_SUBK) + (size_t)layer * 262144;
  const int lr = lane & 15, lq = lane >> 4;
  unsigned* SV = (unsigned*)(smem + PE_OFF_SV) + sw * 16 * PE_SVS;
  float* TV = (float*)(smem + PE_OFF_TV);
  int* TI = (int*)(smem + PE_OFF_TI);
  int* EX = (int*)(smem + PE_OFF_EX) + buf * 16 * 128;
  float* GT = (float*)(smem + PE_OFF_GT) + buf * 16 * 128;
  int* CN = (int*)(smem + PE_OFF_CN) + sw * 16;
  float* SU = (float*)(smem + PE_OFF_SU) + buf * 16 * 128;
  const float* USC = (const float*)(p.ws + OFF_USC) + layer * NEXP;
  const float* VSC = (const float*)(p.ws + OFF_VSC) + layer * NEXP;
#pragma unroll 1
  for (int pp = 0; pp < 2; ++pp) {
    bf16x8 af[4];
    const bf16_t* qrow = Q + (size_t)(tok0 + lr) * 2048 + hd * 256 + pp * 128;
#pragma unroll
    for (int ks = 0; ks < 4; ++ks) af[ks] = *(const bf16x8*)(qrow + ks * 32 + lq * 8);
    const bf16_t* skb = SK + (size_t)((hd * 2 + pp) * 128) * 128;
    f32x4 acc[8];
    {
      bf16x8 bfr[8][4];
#pragma unroll
      for (int nt = 0; nt < 8; ++nt)
#pragma unroll
        for (int ks = 0; ks < 4; ++ks)
          bfr[nt][ks] = *(const bf16x8*)(skb + (size_t)(nt * 16 + lr) * 128 + ks * 32 + lq * 8);
#pragma unroll
      for (int nt = 0; nt < 8; ++nt) {
        f32x4 a = (f32x4){0.f, 0.f, 0.f, 0.f};
#pragma unroll
        for (int ks = 0; ks < 4; ++ks) a = __builtin_amdgcn_mfma_f32_16x16x32_bf16(af[ks], bfr[nt][ks], a, 0, 0, 0);
        acc[nt] = a;
      }
    }
#pragma unroll
    for (int i = 0; i < 9; ++i) { const int q4 = lane + 64 * i; if (q4 < 16 * PE_SVS / 4) ((uint4*)SV)[q4] = make_uint4(0u, 0u, 0u, 0u); }
    WAVE_LDS_FENCE();
#pragma unroll
    for (int r = 0; r < 4; ++r) {
      const int tk = 4 * lq + r;
      unsigned k[8];
#pragma unroll
      for (int nt = 0; nt < 8; ++nt) k[nt] = sortable_key(acc[nt][r], nt * 16 + lr);
      unsigned m1 = max(k[0], k[1]), m2 = min(k[0], k[1]);
#pragma unroll
      for (int nt = 2; nt < 8; ++nt) { m2 = max(m2, min(m1, k[nt])); m1 = max(m1, k[nt]); }
      const unsigned Ta = row16_min_u32(m1);
      const unsigned Tb = min(row16_kth_largest<11>(m1), row16_kth_largest<5>(m2));
      const unsigned T = max(Ta, Tb);
      int pos = 0;
#pragma unroll
      for (int nt = 0; nt < 8; ++nt) {
        const bool sel = k[nt] >= T;
        const unsigned long long bal = __ballot(sel);
        const unsigned grp16 = (unsigned)(bal >> (16 * lq)) & 0xffffu;
        const int below = __popc(grp16 & ((1u << lr) - 1u));
        if (sel) SV[tk * PE_SVS + pos + below] = k[nt];
        pos += __popc(grp16);
      }
      if (lr == 0) CN[tk] = pos;
    }
    WAVE_LDS_FENCE();
#pragma unroll 1
    for (int pass = 0; pass < 4; ++pass) {
      const int tk = pass * 4 + lq;
      const int cnt = CN[tk];
      const unsigned* row = SV + tk * PE_SVS;
      int cm = cnt;
      cm = max(cm, __shfl_xor(cm, 16)); cm = max(cm, __shfl_xor(cm, 32));
      const int cmax = __builtin_amdgcn_readfirstlane(cm);
      const int nblk = (cmax + 15) >> 4;
#pragma unroll 1
      for (int rd = 0; rd < nblk; ++rd) {
        const int j = rd * 16 + lr;
        const unsigned my = row[j];
        int rank = 0;
#pragma unroll 1
        for (int b4 = 0; b4 < nblk; ++b4) {
          const uint4 v0 = *(const uint4*)(row + b4 * 16), v1 = *(const uint4*)(row + b4 * 16 + 4);
          const uint4 v2 = *(const uint4*)(row + b4 * 16 + 8), v3 = *(const uint4*)(row + b4 * 16 + 12);
          rank += (v0.x > my) ? 1 : 0; rank += (v0.y > my) ? 1 : 0; rank += (v0.z > my) ? 1 : 0; rank += (v0.w > my) ? 1 : 0;
          rank += (v1.x > my) ? 1 : 0; rank += (v1.y > my) ? 1 : 0; rank += (v1.z > my) ? 1 : 0; rank += (v1.w > my) ? 1 : 0;
          rank += (v2.x > my) ? 1 : 0; rank += (v2.y > my) ? 1 : 0; rank += (v2.z > my) ? 1 : 0; rank += (v2.w > my) ? 1 : 0;
          rank += (v3.x > my) ? 1 : 0; rank += (v3.y > my) ? 1 : 0; rank += (v3.z > my) ? 1 : 0; rank += (v3.w > my) ? 1 : 0;
        }
        if (j < cnt && rank < 16) {
          TV[(tk * 16 + hd * 2 + pp) * 16 + rank] = key_value(my);
          TI[(tk * 16 + hd * 2 + pp) * 16 + rank] = 127 - (int)(my & 127u);
        }
      }
    }
    WAVE_LDS_FENCE();
  }
  {
    const int cab = ((const int*)(smem + PE_OFF_CT))[lane];
    const int cand_a = cab >> 4, cand_b = cab & 15;
    unsigned* CWt = SV;
    float vals[16];
#pragma unroll
    for (int tk = 0; tk < 16; ++tk) {
      float val = 0.f;
      unsigned key = 0u;
      if (cand_a >= 0) {
        val = TV[(tk * 16 + hd * 2 + 0) * 16 + cand_a] + TV[(tk * 16 + hd * 2 + 1) * 16 + cand_b];
        const unsigned bb = __float_as_uint(val);
        key = ((bb ^ ((unsigned)((int)bb >> 31) | 0x80000000u)) & ~63u) | (unsigned)(63 - lane);
      }
      vals[tk] = val;
      CWt[tk * 64 + lane] = key;
    }
    WAVE_LDS_FENCE();
#pragma unroll
    for (int tk = 0; tk < 16; ++tk) {
      const unsigned key = CWt[tk * 64 + lane];
      int rank = 0;
#pragma unroll
      for (int i4 = 0; i4 < 13; ++i4) {
        const uint4 v = *(const uint4*)(CWt + tk * 64 + i4 * 4);
        rank += (v.x > key) ? 1 : 0; rank += (v.y > key) ? 1 : 0; rank += (v.z > key) ? 1 : 0; rank += (v.w > key) ? 1 : 0;
      }
      if (cand_a >= 0 && rank < 16) {
        GT[tk * 128 + hd * 16 + rank] = vals[tk];
        EX[tk * 128 + hd * 16 + rank] = TI[(tk * 16 + hd * 2 + 0) * 16 + cand_a] * 128 + TI[(tk * 16 + hd * 2 + 1) * 16 + cand_b];
      }
    }
    WAVE_LDS_FENCE();
#pragma unroll
    for (int pass = 0; pass < 4; ++pass) {
      const int tk = pass * 4 + lq;
      const float g = GT[tk * 128 + hd * 16 + lr];
      const float mx = GT[tk * 128 + hd * 16];
      const float ev = __expf(g - mx);
      float s = ev;
      s += __shfl_xor(s, 1); s += __shfl_xor(s, 2); s += __shfl_xor(s, 4); s += __shfl_xor(s, 8);
      const int ex = EX[tk * 128 + hd * 16 + lr];
      GT[tk * 128 + hd * 16 + lr] = (ev / s) * VSC[ex];
      SU[tk * 128 + hd * 16 + lr] = USC[ex];
    }
    WAVE_LDS_FENCE();
  }
}

typedef float f32x32 __attribute__((ext_vector_type(32)));
typedef int i32x8 __attribute__((ext_vector_type(8)));
typedef int i32x6 __attribute__((ext_vector_type(6)));
typedef unsigned u32x6 __attribute__((ext_vector_type(6)));
#define FP4_AXPY8(O, off, P, W) {                                                                    \
  const f32x2 _q0 = __builtin_amdgcn_cvt_scalef32_pk_f32_fp4((W), 1.0f, 0), _q1 = __builtin_amdgcn_cvt_scalef32_pk_f32_fp4((W), 1.0f, 1); \
  const f32x2 _q2 = __builtin_amdgcn_cvt_scalef32_pk_f32_fp4((W), 1.0f, 2), _q3 = __builtin_amdgcn_cvt_scalef32_pk_f32_fp4((W), 1.0f, 3); \
  O[(off) + 0] = fmaf(P, _q0.x, O[(off) + 0]); O[(off) + 1] = fmaf(P, _q0.y, O[(off) + 1]);          \
  O[(off) + 2] = fmaf(P, _q1.x, O[(off) + 2]); O[(off) + 3] = fmaf(P, _q1.y, O[(off) + 3]);          \
  O[(off) + 4] = fmaf(P, _q2.x, O[(off) + 4]); O[(off) + 5] = fmaf(P, _q2.y, O[(off) + 5]);          \
  O[(off) + 6] = fmaf(P, _q3.x, O[(off) + 6]); O[(off) + 7] = fmaf(P, _q3.y, O[(off) + 7]); }
struct Fp6Row { uint4 a; uint2 b; };
typedef __bf16 bf16x32_t __attribute__((ext_vector_type(32)));
__device__ __forceinline__ bf16x32_t fp6_decode_bf16(const Fp6Row& r) {
  u32x6 w; w[0] = r.a.x; w[1] = r.a.y; w[2] = r.a.z; w[3] = r.a.w; w[4] = r.b.x; w[5] = r.b.y;
  return __builtin_amdgcn_cvt_scalef32_pk32_bf16_fp6(w, 1.0f);
}
__device__ __forceinline__ f32x32 fp6_decode(const Fp6Row& r) {
  u32x6 w; w[0] = r.a.x; w[1] = r.a.y; w[2] = r.a.z; w[3] = r.a.w; w[4] = r.b.x; w[5] = r.b.y;
  return __builtin_amdgcn_cvt_scalef32_pk32_f32_fp6(w, 1.0f);
}
__device__ __forceinline__ void peer_gather_token(const Params& p, int layer, char* smem, int tok, int tl, int buf, int lane, bool dowrite) {
  const bf16_t* H2 = (const bf16_t*)(p.ws + OFF_ACT);
  const char* U6 = p.ws + OFF_U + (size_t)layer * NEXP * RECB;
  const float* mod = (const float*)(p.ws + OFF_MOD) + (size_t)layer * 9 * 6144;
  const int* EX = (const int*)(smem + PE_OFF_EX) + buf * 16 * 128 + tl * 128;
  const float* GT = (const float*)(smem + PE_OFF_GT) + buf * 16 * 128 + tl * 128;
  const float* SU = (const float*)(smem + PE_OFF_SU) + buf * 16 * 128 + tl * 128;
  const int l = lane & 31, hf = lane >> 5;
  float acc[32];
  const int wv = __builtin_amdgcn_readfirstlane(threadIdx.x >> 6);
  unsigned char* XB = (unsigned char*)(smem + PE_OFF_SV) + wv * 16 * PE_SVS * 4;
  float* WD = (float*)(XB + 1024);
#define PE_LOADV(VV, PI) VV = *(const uint4*)(U6 + (size_t)EX[2 * (PI) + hf] * RECB + ROWB + l * 16);
  uint4 v0, v1, v2, v3, v4, v5, v6, v7, v8, v9, v10, v11, v12, v13, v14, v15;
  const int e16 = lane & 15, kg = lane >> 4;
  uint4 qa[8], qb[8], qc[8];
#define PE_LOADA(Q, EB) { const char* up = U6 + (size_t)EX[(EB) * 16 + e16] * RECB + 16 * kg;              \
    _Pragma("unroll") for (int i = 0; i < 8; ++i) Q[i] = *(const uint4*)(up + 64 * i); }
  PE_LOADA(qa, 0) PE_LOADA(qb, 1)
  float xscale;
  {
    const bf16_t* hr = H2 + (size_t)tok * 1024 + lane * 16;
    const uint4 a = *(const uint4*)hr, b2 = *(const uint4*)(hr + 8);
    float xv[16];
    UNPACK8(xv, 0, a) UNPACK8(xv, 8, b2)
    float mx = 0.f;
#pragma unroll
    for (int i = 0; i < 16; ++i) mx = fmaxf(mx, fabsf(xv[i]));
#pragma unroll
    for (int o = 1; o < 64; o <<= 1) mx = fmaxf(mx, __shfl_xor(mx, o));
    xscale = mx > 0.f ? mx * (1.f / 7.5f) : 1.f;
    const float inv = 1.f / xscale;
    unsigned w0 = 0u, w1 = 0u, w2 = 0u;
#pragma unroll
    for (int i = 0; i < 16; ++i) {
      const float av = fminf(fabsf(xv[i]) * inv, 7.5f);
      float c;
      if (av < 2.f) c = rintf(av * 8.f);
      else if (av < 4.f) c = 16.f + rintf((av - 2.f) * 4.f);
      else c = 24.f + rintf((av - 4.f) * 2.f);
      unsigned code = (unsigned)c;
      code = code > 31u ? 31u : code;
      code |= (xv[i] < 0.f) ? 32u : 0u;
      const int bit = 6 * i, wd = bit >> 5, sh = bit & 31;
      if (wd == 0) w0 |= code << sh; else if (wd == 1) w1 |= code << sh; else w2 |= code << sh;
      if (sh > 26) { if (wd == 0) w1 |= code >> (32 - sh); else if (wd == 1) w2 |= code >> (32 - sh); }
    }
    unsigned* xo = (unsigned*)(XB + lane * 12);
    xo[0] = w0; xo[1] = w1; xo[2] = w2;
  }
  WAVE_LDS_FENCE();
  {
    i32x8 Bx[8];
#pragma unroll
    for (int kb = 0; kb < 8; ++kb) {
      const uint2* bp = (const uint2*)(XB + 192 * kg + 24 * kb);
      const uint2 b0 = bp[0], b1 = bp[1], b2 = bp[2];
      Bx[kb] = (i32x8){(int)b0.x, (int)b0.y, (int)b1.x, (int)b1.y, (int)b2.x, (int)b2.y, 0, 0};
    }
#define PE_MMAU(Q, EB) {                                                                                     \
    f32x4 dacc = {0.f, 0.f, 0.f, 0.f};                                                                       \
    _Pragma("unroll") for (int kb = 0; kb < 8; ++kb) {                                                       \
      const i32x8 av = {(int)Q[kb].x, (int)Q[kb].y, (int)Q[kb].z, (int)Q[kb].w, 0, 0, 0, 0};                 \
      dacc = __builtin_amdgcn_mfma_scale_f32_16x16x128_f8f6f4(av, Bx[kb], dacc, 4, 2, 0, 0x7f7f7f7f, 0, 0x7f7f7f7f); \
    }                                                                                                        \
    asm volatile("" : "+v"(dacc));        \
    if (e16 == 0) *(float4*)(WD + (EB) * 16 + 4 * kg) = (float4){dacc[0], dacc[1], dacc[2], dacc[3]};        \
  }
    PE_LOADA(qc, 2) PE_MMAU(qa, 0)
    PE_LOADA(qa, 3) PE_MMAU(qb, 1)
    PE_LOADA(qb, 4) PE_MMAU(qc, 2)
    PE_LOADA(qc, 5) PE_MMAU(qa, 3)
    PE_LOADA(qa, 6) PE_MMAU(qb, 4)
    PE_LOADA(qb, 7) PE_MMAU(qc, 5)
    PE_LOADV(v0, 0) PE_LOADV(v1, 1) PE_LOADV(v2, 2) PE_LOADV(v3, 3) PE_LOADV(v4, 4) PE_LOADV(v5, 5) PE_MMAU(qa, 6)
    PE_LOADV(v6, 6) PE_LOADV(v7, 7) PE_LOADV(v8, 8) PE_LOADV(v9, 9) PE_LOADV(v10, 10) PE_LOADV(v11, 11) PE_MMAU(qb, 7)
    PE_LOADV(v12, 12) PE_LOADV(v13, 13) PE_LOADV(v14, 14) PE_LOADV(v15, 15)
  }
  WAVE_LDS_FENCE();
#pragma unroll
  for (int q = 0; q < 2; ++q) {
    const int e = lane + 64 * q;
    WD[e] = GT[e] * gelu_erf(WD[e] * SU[e] * xscale);
  }
  WAVE_LDS_FENCE();
#pragma unroll
  for (int i = 0; i < 32; ++i) acc[i] = 0.f;
  int one = 1;
  asm volatile("" : "+s"(one));
  const int b = tok < NLAT ? (tok >> 12) : 8;
  float* xr = tok < NLAT ? p.out + (size_t)tok * 1024 : (float*)(p.ws + OFF_CTXB) + (size_t)(tok - NLAT) * 1024;
  const float* gate = mod + (size_t)b * 6144 + 5 * 1024;
  float4 xv4[4], gv4[4];
#pragma unroll
  for (int jj = 0; jj < 4; ++jj) {
    const int c = (l + 32 * (4 * hf + jj)) * 4;
    xv4[jj] = *(const float4*)(xr + c);
    gv4[jj] = *(const float4*)(gate + c);
  }
#define PE_USEV(VV, PI)                                                               \
  _Pragma("unroll 1") for (int rep_ = 0; rep_ < one; ++rep_) {                        \
    const float w = WD[2 * (PI) + hf];                                                \
    FP4_AXPY8(acc, 0, w, VV.x) FP4_AXPY8(acc, 8, w, VV.y) FP4_AXPY8(acc, 16, w, VV.z) FP4_AXPY8(acc, 24, w, VV.w) \
  }
#pragma unroll 1
  for (int pi = 0; pi < 48; pi += 16) {
    PE_USEV(v0, pi + 0) PE_LOADV(v0, pi + 16)
    PE_USEV(v1, pi + 1) PE_LOADV(v1, pi + 17)
    PE_USEV(v2, pi + 2) PE_LOADV(v2, pi + 18)
    PE_USEV(v3, pi + 3) PE_LOADV(v3, pi + 19)
    PE_USEV(v4, pi + 4) PE_LOADV(v4, pi + 20)
    PE_USEV(v5, pi + 5) PE_LOADV(v5, pi + 21)
    PE_USEV(v6, pi + 6) PE_LOADV(v6, pi + 22)
    PE_USEV(v7, pi + 7) PE_LOADV(v7, pi + 23)
    PE_USEV(v8, pi + 8) PE_LOADV(v8, pi + 24)
    PE_USEV(v9, pi + 9) PE_LOADV(v9, pi + 25)
    PE_USEV(v10, pi + 10) PE_LOADV(v10, pi + 26)
    PE_USEV(v11, pi + 11) PE_LOADV(v11, pi + 27)
    PE_USEV(v12, pi + 12) PE_LOADV(v12, pi + 28)
    PE_USEV(v13, pi + 13) PE_LOADV(v13, pi + 29)
    PE_USEV(v14, pi + 14) PE_LOADV(v14, pi + 30)
    PE_USEV(v15, pi + 15) PE_LOADV(v15, pi + 31)
  }
  PE_USEV(v0, 48) PE_USEV(v1, 49) PE_USEV(v2, 50) PE_USEV(v3, 51) PE_USEV(v4, 52) PE_USEV(v5, 53) PE_USEV(v6, 54) PE_USEV(v7, 55) PE_USEV(v8, 56) PE_USEV(v9, 57) PE_USEV(v10, 58) PE_USEV(v11, 59) PE_USEV(v12, 60) PE_USEV(v13, 61) PE_USEV(v14, 62) PE_USEV(v15, 63)
#pragma unroll
  for (int k = 0; k < 32; ++k) acc[k] += __shfl_xor(acc[k], 32);
  float4 xn[4];
  float ss = 0.f;
#pragma unroll
  for (int jj = 0; jj < 4; ++jj) {
    const int c = (l + 32 * (4 * hf + jj)) * 4;
    const float4 xv = xv4[jj];
    const float4 gv = gv4[jj];
    const float a0 = hf ? acc[16 + 4 * jj + 0] : acc[4 * jj + 0], a1 = hf ? acc[16 + 4 * jj + 1] : acc[4 * jj + 1];
    const float a2 = hf ? acc[16 + 4 * jj + 2] : acc[4 * jj + 2], a3 = hf ? acc[16 + 4 * jj + 3] : acc[4 * jj + 3];
    xn[jj].x = xv.x + gv.x * a0; xn[jj].y = xv.y + gv.y * a1; xn[jj].z = xv.z + gv.z * a2; xn[jj].w = xv.w + gv.w * a3;
    ss += xn[jj].x * xn[jj].x + xn[jj].y * xn[jj].y + xn[jj].z * xn[jj].z + xn[jj].w * xn[jj].w;
  }
  ss = wave_sum(ss);
  const float rinv = rsqrtf(ss * (1.f / 1024.f) + EPS);
  if (layer == 0) {
    const float* mod1 = (const float*)(p.ws + OFF_MOD) + (size_t)9 * 6144 + (size_t)b * 6144;
    const float* g1 = p.norm1_g + 1024;
    bf16_t* act = (bf16_t*)(p.ws + OFF_ACT) + (size_t)tok * 1024;
#pragma unroll
    for (int jj = 0; jj < 4; ++jj) {
      const int c = (l + 32 * (4 * hf + jj)) * 4;
      if (dowrite) *(float4*)(xr + c) = xn[jj]; else asm volatile("" :: "v"(xn[jj].x), "v"(xn[jj].y), "v"(xn[jj].z), "v"(xn[jj].w));
      const float4 gg4 = *(const float4*)(g1 + c);
      const float4 sh = *(const float4*)(mod1 + c);
      const float4 sc = *(const float4*)(mod1 + 1024 + c);
      uint2 o;
      o.x = pack2h(xn[jj].x * rinv * gg4.x * (1.f + sc.x) + sh.x, xn[jj].y * rinv * gg4.y * (1.f + sc.y) + sh.y);
      o.y = pack2h(xn[jj].z * rinv * gg4.z * (1.f + sc.z) + sh.z, xn[jj].w * rinv * gg4.w * (1.f + sc.w) + sh.w);
      if (dowrite) *(uint2*)(act + c) = o; else asm volatile("" :: "v"(o.x), "v"(o.y));
    }
  } else {
#pragma unroll
    for (int jj = 0; jj < 4; ++jj) {
      const int c = (l + 32 * (4 * hf + jj)) * 4;
      const float4 gg4 = *(const float4*)(p.final_g + c);
      float4 o;
      o.x = xn[jj].x * rinv * gg4.x; o.y = xn[jj].y * rinv * gg4.y; o.z = xn[jj].z * rinv * gg4.z; o.w = xn[jj].w * rinv * gg4.w;
      if (dowrite) *(float4*)(xr + c) = o; else asm volatile("" :: "v"(o.x), "v"(o.y), "v"(o.z), "v"(o.w));
    }
  }
}

__device__ __forceinline__ void phase_peer(const Params& p, int layer, char* smem, int ntok, bool dowrite = true) {
  const int tid = opaque_tid(), lane = tid & 63, wave = __builtin_amdgcn_readfirstlane(tid >> 6);
  __syncthreads();
  if (tid < 64) {
    int cab = -1, c = 0;
    for (int a = 0; a < 16; ++a)
      for (int bb = 0; bb < 16; ++bb)
        if ((a + 1) * (bb + 1) <= 16) { if (c == tid) cab = a * 16 + bb; ++c; }
    ((int*)(smem + PE_OFF_CT))[tid] = cab;
  }
  const int ngroups = ntok / 16, G = gridDim.x, g0 = opaque_bid();
  if (tid == 0) { ((int*)(smem + PE_OFF_TQ))[0] = 0; ((int*)(smem + PE_OFF_TQ))[1] = 0; }
  __syncthreads();
  const int R = ngroups / G, rem = ngroups % G;
  const bool split = rem > 0 && 2 * rem <= G;
#define PE_ITEM(r_, grp_, off_, cnt_)                                                                  \
  { grp_ = 0; off_ = 0; cnt_ = 0;                                                                      \
    if ((r_) >= 0 && (r_) < R) { grp_ = g0 + (r_) * G; cnt_ = 16; }                                    \
    else if ((r_) == R) {                                                                              \
      if (split) { if (g0 < 2 * rem) { grp_ = R * G + (g0 >> 1); off_ = (g0 & 1) * 8; cnt_ = 8; } }    \
      else if (g0 < rem) { grp_ = R * G + g0; cnt_ = 16; }                                             \
    } }
#pragma unroll 1
  for (int r = -1;; ++r) {
    int cur, coff, ngat, nxt, noff, ncnt;
    PE_ITEM(r, cur, coff, ngat)
    PE_ITEM(r + 1, nxt, noff, ncnt)
    const int nsel = ncnt > 0 ? 8 : 0;
    if (ngat + nsel == 0) break;
    const int b = r & 1, gper = ngat >> 3, sfirst = (wave & 1) == 0;
#pragma unroll 1
    for (int st = 0; st < 3; ++st) {
      const int slot = sfirst ? st : (st + 1) % 3;
      if (slot == 0) { if (nsel) peer_select_head(p, layer, smem, nxt * 16, wave, wave, b ^ 1, lane); }
      else if (slot - 1 < gper) {
        const int idx = wave * gper + slot - 1;
        peer_gather_token(p, layer, smem, cur * 16 + coff + idx, coff + idx, b, lane, dowrite);
      }
    }
    __syncthreads();
  }
}

template <int layer>
__device__ __forceinline__ void layer_body(const Params& p, char* smem, const XcdBarrier& xb) {
  constexpr bool nc = layer == 0;
  const float* xin = layer == 0 ? p.x : (const float*)p.out;
  if (layer == 0) {
    phase_norm(p, layer, 0, xin, NTOK);
    xcd_barrier(xb);
  }
#if REP_GEMM
  gemm_phase2<EPI_INPROJ>(p, layer, smem, (const bf16_t*)(p.ws + OFF_ACT), (const bf16_t*)(p.ws + OFF_WIN) + (size_t)layer * 3072 * 1024, NTOK, 3072, nullptr);
  xcd_barrier(xb);
#endif
  gemm_phase2<EPI_INPROJ>(p, layer, smem, (const bf16_t*)(p.ws + OFF_ACT), (const bf16_t*)(p.ws + OFF_WIN) + (size_t)layer * 3072 * 1024, NTOK, 3072, nullptr);
  xcd_barrier(xb);
#if REP_MIX1
  phase_mix1(p, layer, smem, 2);
  xcd_barrier(xb);
#endif
  phase_mix1(p, layer, smem);
  xcd_barrier(xb);
  phase_ret_scan(p, layer);
  xcd_barrier(xb);
#if REP_MIX2
  phase_mix2(p, layer, smem, 3);
  xcd_barrier(xb);
#endif
  phase_mix2(p, layer, smem);
  xcd_barrier(xb);
  gemm_phase2<EPI_OUTPROJ>(p, layer, smem, (const bf16_t*)(p.ws + OFF_ACT), (const bf16_t*)(p.ws + OFF_WOUT) + (size_t)layer * 1024 * 1024, nc ? NTOK : NLAT, 1024, xin);
  xcd_barrier(xb);
  phase_norm(p, layer, 1, (const float*)p.out, nc ? NTOK : NLAT);
  xcd_barrier(xb);
  gemm_phase2<EPI_PLAIN>(p, layer, smem, (const bf16_t*)(p.ws + OFF_ACT), (const bf16_t*)(p.ws + OFF_WQ) + (size_t)layer * 2048 * 1024, nc ? NTOK : NLAT, 2048, nullptr);
  xcd_barrier(xb);
#if REP_PEER
  phase_peer(p, layer, smem, nc ? NTOK : NLAT, false);
  xcd_barrier(xb);
#endif
  phase_peer(p, layer, smem, nc ? NTOK : NLAT);
  if (layer == 0) xcd_barrier(xb);
}

__global__ void __launch_bounds__(512) fwd_megakernel(Params p) {
  cg::grid_group grid = cg::this_grid();
  extern __shared__ __attribute__((aligned(16))) char smem[];
  volatile LAS3 unsigned* xst = (volatile LAS3 unsigned*)(smem + LDS_BCAST + 8);
  if (threadIdx.x == 0) { xst[0] = 0u; xst[1] = 0u; }
  phase_prep(p, smem);
  for (int it = blockIdx.x; it < 256; it += gridDim.x) uv_convert_item(p, it);
  grid.sync();
  const XcdBarrier xb = xcd_barrier_post((unsigned*)(p.ws + OFF_XBAR), xst);
  layer_body<0>(p, smem, xb);
  layer_body<1>(p, smem, xb);
}

extern "C" void kernel_launch(void* const* d_in, const int* in_sizes, int n_in, void* d_out,
                              int out_size, void* d_ws, size_t ws_size, hipStream_t stream) {
  constexpr size_t kDynLds = LDS_BYTES;
  static int grid_blocks = 0;
  if (!grid_blocks) {
    int dev = 0, cus = 0, per_cu = 0;
    (void)hipGetDevice(&dev);
    (void)hipDeviceGetAttribute(&cus, hipDeviceAttributeMultiprocessorCount, dev);
    (void)hipFuncSetAttribute((const void*)fwd_megakernel, hipFuncAttributeMaxDynamicSharedMemorySize, (int)kDynLds);
    (void)hipOccupancyMaxActiveBlocksPerMultiprocessor(&per_cu, fwd_megakernel, 512, kDynLds);
    if (per_cu < 1) { fprintf(stderr, "occupancy query says %d blocks/CU\n", per_cu); per_cu = 1; }
    grid_blocks = cus;
    if (ws_size < WS_END) fprintf(stderr, "workspace too small: %zu < %zu\n", ws_size, (size_t)WS_END);
  }
  Params p{};
  p.x = (const float*)d_in[0]; p.c = (const float*)d_in[1]; p.ctx = (const float*)d_in[2]; p.c_ctx = (const float*)d_in[3];
  p.w_ada = (const float*)d_in[4]; p.b_ada = (const float*)d_in[5]; p.norm1_g = (const float*)d_in[6]; p.w_in = (const float*)d_in[7];
  p.na_rpb = (const float*)d_in[8]; p.diff_lambda = (const float*)d_in[9]; p.diff_subln_g = (const float*)d_in[10];
  p.ret_decay_logit = (const float*)d_in[11]; p.w_out = (const float*)d_in[12]; p.norm2_g = (const float*)d_in[13];
  p.peer_wq = (const float*)d_in[14]; p.peer_subkeys = (const float*)d_in[15]; p.peer_u = (const float*)d_in[16];
  p.peer_v = (const float*)d_in[17]; p.final_g = (const float*)d_in[18];
  p.out = (float*)d_out; p.ws = (char*)d_ws;
  void* args[] = {&p};
  hipError_t e = hipLaunchCooperativeKernel((void*)fwd_megakernel, dim3(grid_blocks), dim3(512), args, kDynLds, stream);
  if (e != hipSuccess) fprintf(stderr, "cooperative launch failed: %s (grid %d)\n", hipGetErrorString(e), grid_blocks);
}
```

```cpp
#include <hip/hip_runtime.h>
#include <hip/hip_cooperative_groups.h>
#include <cstdio>
#include <cstdint>
namespace cg = cooperative_groups;

typedef unsigned short bf16_t;
typedef short bf16x8 __attribute__((ext_vector_type(8)));
typedef float f32x4 __attribute__((ext_vector_type(4)));

constexpr int DM = 1024, BATCH = 8, SEQ = 4096, LCTX = 256;
constexpr int NLAT = BATCH * SEQ;
constexpr int NCTX = BATCH * LCTX;
constexpr int NTOK = NLAT + NCTX;
constexpr int INC = 3072;
constexpr int C_NAQ = 0, C_NAK = 256, C_NAV = 512, C_DFQ = 768, C_DFK = 1024, C_DFV = 1280,
              C_RTQ = 1536, C_RTK = 1792, C_RTV = 2048, C_RTG = 2560;
constexpr int Y_NA = 0, Y_DF = 256, Y_RT = 512;
constexpr int NEXP = 16384;
constexpr float EPS = 1e-6f;

constexpr size_t OFF_CTL  = 0;
constexpr size_t OFF_MISC = 4096;
constexpr size_t OFF_ROPE = 8192;
constexpr size_t OFF_MOD  = OFF_ROPE + 12288;
constexpr size_t SZ_MOD   = 2ull * 9 * 6144 * 4;
constexpr size_t OFF_WIN  = OFF_MOD + SZ_MOD;
constexpr size_t SZ_WIN   = 2ull * 3072 * 1024 * 2;
constexpr size_t OFF_WOUT = OFF_WIN + SZ_WIN;
constexpr size_t SZ_WOUT  = 2ull * 1024 * 1024 * 2;
constexpr size_t OFF_WQ   = OFF_WOUT + SZ_WOUT;
constexpr size_t SZ_WQ    = 2ull * 2048 * 1024 * 2;
constexpr size_t OFF_SUBK = OFF_WQ + SZ_WQ;
constexpr size_t SZ_SUBK  = 2ull * 262144 * 2;
constexpr size_t OFF_U    = OFF_SUBK + SZ_SUBK;
constexpr int    ROWB     = 512;
constexpr int    ROWV     = 512;
constexpr int    RECB     = ROWB + ROWV;
constexpr size_t SZ_UV    = 2ull * NEXP * ROWB;
constexpr size_t OFF_V    = OFF_U + SZ_UV;
constexpr size_t OFF_USC  = OFF_V + SZ_UV;
constexpr size_t OFF_VSC  = OFF_USC + 2ull * NEXP * 4;
constexpr size_t OFF_ACT  = OFF_VSC + 2ull * NEXP * 4;
constexpr size_t SZ_ACT   = (size_t)NTOK * 1024 * 2;
constexpr size_t OFF_P    = OFF_ACT + SZ_ACT;
constexpr size_t SZ_P     = (size_t)NTOK * 3072 * 2;
constexpr size_t OFF_CTXB = OFF_P + SZ_P;
constexpr size_t SZ_CTXB  = (size_t)NCTX * 1024 * 4;
constexpr size_t OFF_RKV  = OFF_CTXB + SZ_CTXB;
constexpr size_t SZ_RKV   = 64ull * 32 * 8192 * 4;
constexpr size_t OFF_RS   = OFF_RKV + SZ_RKV;
constexpr size_t SZ_RS    = 64ull * 8192 * 4;
constexpr size_t OFF_XBAR = OFF_RS + SZ_RS;
constexpr size_t WS_END   = OFF_XBAR + 16384;

#ifndef REP_MIX1
#define REP_MIX1 0
#endif
#ifndef REP_MIX2
#define REP_MIX2 0
#endif
#ifndef REP_PEER
#define REP_PEER 0
#endif
#ifndef REP_GEMM
#define REP_GEMM 0
#endif
constexpr int LDS_BYTES = 152 * 1024;
constexpr int LDS_BCAST = LDS_BYTES - 16;

struct Params {
  const float *x, *c, *ctx, *c_ctx, *w_ada, *b_ada, *norm1_g, *w_in, *na_rpb, *diff_lambda, *diff_subln_g,
              *ret_decay_logit, *w_out, *norm2_g, *peer_wq, *peer_subkeys, *peer_u, *peer_v, *final_g;
  float* out;
  char* ws;
};

__device__ __forceinline__ float bf2f(bf16_t v) { return __uint_as_float(((unsigned)v) << 16); }
__device__ __forceinline__ bf16_t f2bf(float f) {
  unsigned u = __float_as_uint(f);
  u += 0x7fffu + ((u >> 16) & 1u);
  return (bf16_t)(u >> 16);
}
__device__ __forceinline__ unsigned pack2(float a, float b) { return (unsigned)f2bf(a) | ((unsigned)f2bf(b) << 16); }
typedef __bf16 bf16x2_t __attribute__((ext_vector_type(2)));
typedef float f32x2_t __attribute__((ext_vector_type(2)));
__device__ __forceinline__ unsigned pack2h(float a, float b) {
  const f32x2_t v = {a, b};
  return __builtin_bit_cast(unsigned, __builtin_convertvector(v, bf16x2_t));
}
__device__ __forceinline__ float lo16(unsigned w) { return __uint_as_float(w << 16); }
__device__ __forceinline__ float hi16(unsigned w) { return __uint_as_float(w & 0xffff0000u); }
#define DPP_ADD(v, CTRL) ((v) + __int_as_float(__builtin_amdgcn_update_dpp(0, __float_as_int(v), (CTRL), 0xf, 0xf, true)))
__device__ __forceinline__ float row16_sum(float v) {
  v = DPP_ADD(v, 0xB1);
  v = DPP_ADD(v, 0x4E);
  v = DPP_ADD(v, 0x141);
  v = DPP_ADD(v, 0x140);
  return v;
}
#define DPP_MOVU(v, CTRL) ((unsigned)__builtin_amdgcn_update_dpp(0, (int)(v), (CTRL), 0xf, 0xf, true))
__device__ __forceinline__ unsigned row16_max_u32(unsigned v) {
  v = max(v, DPP_MOVU(v, 0xB1)); v = max(v, DPP_MOVU(v, 0x4E)); v = max(v, DPP_MOVU(v, 0x141)); v = max(v, DPP_MOVU(v, 0x140));
  return v;
}
__device__ __forceinline__ unsigned row16_min_u32(unsigned v) {
  v = min(v, DPP_MOVU(v, 0xB1)); v = min(v, DPP_MOVU(v, 0x4E)); v = min(v, DPP_MOVU(v, 0x141)); v = min(v, DPP_MOVU(v, 0x140));
  return v;
}
template <int KTH>
__device__ __forceinline__ unsigned row16_kth_largest(unsigned v) {
  int cnt = 0;
#define R8_STEP(N) { const unsigned o = DPP_MOVU(v, 0x120 + (N)); cnt += (o > v) ? 1 : 0; }
  R8_STEP(1) R8_STEP(2) R8_STEP(3) R8_STEP(4) R8_STEP(5) R8_STEP(6) R8_STEP(7) R8_STEP(8)
  R8_STEP(9) R8_STEP(10) R8_STEP(11) R8_STEP(12) R8_STEP(13) R8_STEP(14) R8_STEP(15)
#undef R8_STEP
  return row16_max_u32(cnt >= KTH - 1 ? v : 0u);
}
__device__ __forceinline__ float wave_sum(float v) {
  v = row16_sum(v);
  const int iv = __float_as_int(v);
  const float a = __int_as_float(__builtin_amdgcn_readlane(iv, 0)), b = __int_as_float(__builtin_amdgcn_readlane(iv, 16));
  const float c = __int_as_float(__builtin_amdgcn_readlane(iv, 32)), d = __int_as_float(__builtin_amdgcn_readlane(iv, 48));
  return (a + b) + (c + d);
}
__device__ __forceinline__ float siluf(float x) { return x / (1.f + __expf(-x)); }

__device__ __forceinline__ int opaque_tid() { int t = threadIdx.x; asm volatile("" : "+v"(t)); return t; }
__device__ __forceinline__ int opaque_bid() { int t = blockIdx.x; asm volatile("" : "+s"(t)); return t; }

#define DOT8(acc, Q, off, U)                                                              \
  acc = fmaf(Q[(off) + 0], lo16((U).x), acc); acc = fmaf(Q[(off) + 1], hi16((U).x), acc); \
  acc = fmaf(Q[(off) + 2], lo16((U).y), acc); acc = fmaf(Q[(off) + 3], hi16((U).y), acc); \
  acc = fmaf(Q[(off) + 4], lo16((U).z), acc); acc = fmaf(Q[(off) + 5], hi16((U).z), acc); \
  acc = fmaf(Q[(off) + 6], lo16((U).w), acc); acc = fmaf(Q[(off) + 7], hi16((U).w), acc);
#define AXPY8(O, off, P, U)                                                                   \
  O[(off) + 0] = fmaf(P, lo16((U).x), O[(off) + 0]); O[(off) + 1] = fmaf(P, hi16((U).x), O[(off) + 1]); \
  O[(off) + 2] = fmaf(P, lo16((U).y), O[(off) + 2]); O[(off) + 3] = fmaf(P, hi16((U).y), O[(off) + 3]); \
  O[(off) + 4] = fmaf(P, lo16((U).z), O[(off) + 4]); O[(off) + 5] = fmaf(P, hi16((U).z), O[(off) + 5]); \
  O[(off) + 6] = fmaf(P, lo16((U).w), O[(off) + 6]); O[(off) + 7] = fmaf(P, hi16((U).w), O[(off) + 7]);
#define UNPACK8(Q, off, U)                                                  \
  Q[(off) + 0] = lo16((U).x); Q[(off) + 1] = hi16((U).x); Q[(off) + 2] = lo16((U).y); Q[(off) + 3] = hi16((U).y); \
  Q[(off) + 4] = lo16((U).z); Q[(off) + 5] = hi16((U).z); Q[(off) + 6] = lo16((U).w); Q[(off) + 7] = hi16((U).w);

__device__ __forceinline__ int next_item(unsigned* counter, char* smem) {
  volatile int* bc = (volatile int*)(smem + LDS_BCAST);
  __syncthreads();
  if (threadIdx.x == 0) *bc = (int)atomicAdd(counter, 1u);
  __syncthreads();
  return *bc;
}

#define XB_TMO      128
#define XB_XCNT(j)  (256  + 64 * (j))
#define XB_XSUB(j)  (1280 + 64 * (j))
#define XB_XGEN(j)  (2304 + 64 * (j))
#define XB_TOP      3328
#define XB_TOPGEN   3392
#define XCD_BAR_WORDS 3456
#define XB_SPIN_CAP (1u << 18)
#define LAS3 __attribute__((address_space(3)))
__device__ __forceinline__ unsigned xb_ld(unsigned* p)              { return __hip_atomic_load(p, __ATOMIC_RELAXED, __HIP_MEMORY_SCOPE_AGENT); }
__device__ __forceinline__ unsigned xb_add(unsigned* p, unsigned v) { return __hip_atomic_fetch_add(p, v, __ATOMIC_RELAXED, __HIP_MEMORY_SCOPE_AGENT); }
__device__ __forceinline__ unsigned xb_xcc_id() { return (unsigned)__builtin_amdgcn_s_getreg((3 << 11) | 20) & 0xFu; }
#define XB_SPIN(cond, bar) do { unsigned _sp = 0; while (cond) { __builtin_amdgcn_s_sleep(1); \
    if ((++_sp & 255u) == 0u) { if (xb_ld(&(bar)[XB_TMO])) break; if (_sp > XB_SPIN_CAP) { atomicAdd(&(bar)[XB_TMO], 1u); break; } } } } while (0)
struct XcdBarrier { unsigned* bar; unsigned x; volatile LAS3 unsigned* st; };
__device__ __forceinline__ XcdBarrier xcd_barrier_post(unsigned* bar, volatile LAS3 unsigned* st) {
  XcdBarrier b; b.bar = bar; b.x = xb_xcc_id(); b.st = st;
  if (threadIdx.x == 0) (void)xb_add(&bar[XB_XCNT(b.x)], 1u);
  return b;
}
__device__ __forceinline__ void xcd_barrier_complete(unsigned* bar, unsigned x, unsigned& nloc, unsigned& nx) {
  const unsigned G = gridDim.x * gridDim.y * gridDim.z;
  unsigned sum, cnt, mine, sp = 0u;
  for (;;) {
    sum = 0u; cnt = 0u; mine = 0u;
#pragma unroll
    for (unsigned j = 0; j < 16; ++j) { const unsigned c = xb_ld(&bar[XB_XCNT(j)]); sum += c; cnt += (c > 0u) ? 1u : 0u; mine = (j == x) ? c : mine; }
    if (sum == G) break;
    __builtin_amdgcn_s_sleep(1);
    if ((++sp & 255u) == 0u) { if (xb_ld(&bar[XB_TMO])) break; if (sp > XB_SPIN_CAP) { atomicAdd(&bar[XB_TMO], 1u); break; } }
  }
  nloc = mine > 0u ? mine : 1u; nx = cnt > 0u ? cnt : 1u;
}
__device__ __forceinline__ void xcd_barrier(const XcdBarrier& b) {
  asm volatile("s_waitcnt vmcnt(0)" ::: "memory");
  __syncthreads();
  if (threadIdx.x == 0) {
    unsigned* bar = b.bar;
    __builtin_amdgcn_s_waitcnt(0);
    unsigned nloc = b.st[0], nx = b.st[1];
    if (nloc == 0u) { xcd_barrier_complete(bar, b.x, nloc, nx); b.st[0] = nloc; b.st[1] = nx; }
    const unsigned old = xb_add(&bar[XB_XSUB(b.x)], 1u);
    const unsigned gen = old / nloc;
    if (old + 1u == (gen + 1u) * nloc) {
      __builtin_amdgcn_fence(__ATOMIC_RELEASE, "agent");
      asm volatile("s_waitcnt vmcnt(0)" ::: "memory");
      const unsigned og = xb_add(&bar[XB_TOP], 1u);
      const unsigned tg = og / nx;
      if (og + 1u == (tg + 1u) * nx) xb_add(&bar[XB_TOPGEN], 1u);
      else XB_SPIN(xb_ld(&bar[XB_TOPGEN]) == tg, bar);
      __builtin_amdgcn_fence(__ATOMIC_ACQUIRE, "agent");
      xb_add(&bar[XB_XGEN(b.x)], 1u);
      asm volatile("s_waitcnt vmcnt(0)" ::: "memory");
    } else {
      XB_SPIN(xb_ld(&bar[XB_XGEN(b.x)]) == gen, bar);
      __builtin_amdgcn_fence(__ATOMIC_ACQUIRE, "agent");
      asm volatile("s_waitcnt vmcnt(0)" ::: "memory");
    }
  }
  __syncthreads();
}

__device__ __forceinline__ void transpose_item(const float* src, bf16_t* dst, int K, int N, int item, char* smem) {
  float* t = (float*)smem;
  const int nb = N / 64;
  const int k0 = (item / nb) * 64, n0 = (item % nb) * 64;
  const int tid = opaque_tid();
  __syncthreads();
#pragma unroll
  for (int i = 0; i < 8; ++i) {
    const int k = (tid >> 6) + 8 * i, n = tid & 63;
    t[k * 65 + n] = src[(size_t)(k0 + k) * N + n0 + n];
  }
  __syncthreads();
#pragma unroll
  for (int i = 0; i < 8; ++i) {
    const int n = (tid >> 6) + 8 * i, k = tid & 63;
    dst[(size_t)(n0 + n) * K + k0 + k] = f2bf(t[k * 65 + n]);
  }
}

__device__ __forceinline__ void convert_flat(const float* src, bf16_t* dst, size_t n4) {
  const size_t gt = (size_t)opaque_bid() * blockDim.x + opaque_tid(), gs = (size_t)gridDim.x * blockDim.x;
  for (size_t i = gt; i < n4; i += gs) {
    const float4 v = ((const float4*)src)[i];
    uint2 o; o.x = pack2h(v.x, v.y); o.y = pack2h(v.z, v.w);
    ((uint2*)dst)[i] = o;
  }
}

__device__ __forceinline__ void phase_prep(const Params& p, char* smem) {
  const int tid = opaque_tid();
  char* ws = p.ws;
  if (opaque_bid() == 0) {
    unsigned* ctl = (unsigned*)(ws + OFF_CTL);
    if (tid < 64) ctl[tid] = 0u;
    unsigned* xbar = (unsigned*)(ws + OFF_XBAR);
    for (int i = tid; i < XCD_BAR_WORDS; i += 512) xbar[i] = 0u;
    float* misc = (float*)(ws + OFF_MISC);
    if (tid < 2) {
      const float* lp = p.diff_lambda + tid * 128;
      float s01 = 0.f, s23 = 0.f;
      for (int i = 0; i < 32; ++i) { s01 += lp[i] * lp[32 + i]; s23 += lp[64 + i] * lp[96 + i]; }
      const float lam_init = 0.8f - 0.6f * expf(-0.3f * (float)tid);
      misc[tid] = expf(s01) - expf(s23) + lam_init;
      misc[2 + tid] = lam_init;
    }
    if (tid >= 128 && tid < 256) misc[64 + tid - 128] = 0.f;
    if (tid >= 64 && tid < 80) {
      const int i = tid - 64;
      const float xv = p.ret_decay_logit[i];
      misc[16 + i] = -log1pf(expf(-xv));
    }
    float2* ropeD = (float2*)(ws + OFF_ROPE);
    float2* ropeR = (float2*)(ws + OFF_ROPE + 4096);
    for (int i = tid; i < 64 * 8; i += 512) {
      const int v = i >> 3, f = i & 7;
      const float inv = powf(10000.0f, -(float)(2 * f) / 16.0f);
      const float ang = (float)v * inv;
      ropeD[i] = make_float2(cosf(ang), sinf(ang));
    }
    for (int i = tid; i < 64 * 16; i += 512) {
      const int v = i >> 4, f = i & 15;
      const float inv = powf(10000.0f, -(float)(2 * f) / 32.0f);
      const float ang = (float)v * inv;
      ropeR[i] = make_float2(cosf(ang), sinf(ang));
    }
  }
  {
    float* sc = (float*)smem;
    float* red = (float*)(smem + 9 * 1024 * 4);
    float* mod = (float*)(ws + OFF_MOD);
    for (int item = opaque_bid(); item < 192; item += gridDim.x) {
      const int l = item / 96, cb = item % 96;
      __syncthreads();
      for (int i = tid; i < 9 * 1024; i += 512) {
        const int r = i >> 10, k = i & 1023;
        const float cv = (r < 8) ? p.c[r * 1024 + k] : p.c_ctx[k];
        sc[i] = siluf(cv);
      }
      __syncthreads();
      const int col = tid & 63, ks = tid >> 6;
      float acc[9];
#pragma unroll
      for (int r = 0; r < 9; ++r) acc[r] = 0.f;
      const float* w = p.w_ada + (size_t)l * 1024 * 6144 + cb * 64 + col;
#pragma unroll 1
      for (int k0 = ks * 128; k0 < ks * 128 + 128; k0 += 16) {
        float wv[16];
#pragma unroll
        for (int i = 0; i < 16; ++i) wv[i] = w[(size_t)(k0 + i) * 6144];
#pragma unroll
        for (int i = 0; i < 16; ++i)
#pragma unroll
          for (int r = 0; r < 9; ++r) acc[r] = fmaf(sc[r * 1024 + k0 + i], wv[i], acc[r]);
      }
#pragma unroll
      for (int r = 0; r < 9; ++r) red[(ks * 9 + r) * 64 + col] = acc[r];
      __syncthreads();
      for (int i = tid; i < 576; i += 512) {
        const int r = i >> 6, cc = i & 63;
        float s = 0.f;
#pragma unroll
        for (int k8 = 0; k8 < 8; ++k8) s += red[(k8 * 9 + r) * 64 + cc];
        mod[((size_t)l * 9 + r) * 6144 + cb * 64 + cc] = s + p.b_ada[l * 6144 + cb * 64 + cc];
      }
    }
    __syncthreads();
  }
  for (int item = opaque_bid(); item < 3072; item += gridDim.x) {
    const int l = item / 1536;
    int r = item % 1536;
    if (r < 768) transpose_item(p.w_in + (size_t)l * 1024 * 3072, (bf16_t*)(ws + OFF_WIN) + (size_t)l * 3072 * 1024, 1024, 3072, r, smem);
    else if (r < 1024) transpose_item(p.w_out + (size_t)l * 1024 * 1024, (bf16_t*)(ws + OFF_WOUT) + (size_t)l * 1024 * 1024, 1024, 1024, r - 768, smem);
    else transpose_item(p.peer_wq + (size_t)l * 1024 * 2048, (bf16_t*)(ws + OFF_WQ) + (size_t)l * 2048 * 1024, 1024, 2048, r - 1024, smem);
  }
  convert_flat(p.peer_subkeys, (bf16_t*)(ws + OFF_SUBK), 2ull * 262144 / 4);
  {
    const size_t gt = (size_t)opaque_bid() * blockDim.x + tid, gs = (size_t)gridDim.x * blockDim.x;
    float4* dst = (float4*)(ws + OFF_CTXB);
    for (size_t i = gt; i < (size_t)NCTX * 1024 / 4; i += gs) dst[i] = ((const float4*)p.ctx)[i];
  }
}

__device__ __forceinline__ void phase_norm(const Params& p, int layer, int which, const float* xlat, int nrows) {
  const int lane = opaque_tid() & 63;
  const int gw = opaque_bid() * 8 + (opaque_tid() >> 6), nw = gridDim.x * 8;
  const float* g = (which == 0 ? p.norm1_g : p.norm2_g) + layer * 1024;
  const float* mod = (const float*)(p.ws + OFF_MOD) + (size_t)layer * 9 * 6144;
  const float* ctxb = (const float*)(p.ws + OFF_CTXB);
  bf16_t* act = (bf16_t*)(p.ws + OFF_ACT);
  const int sh_off = which == 0 ? 0 : 3 * 1024, sc_off = which == 0 ? 1024 : 4 * 1024;
  for (int row = gw; row < nrows; row += nw) {
    const float* src = row < NLAT ? xlat + (size_t)row * 1024 : ctxb + (size_t)(row - NLAT) * 1024;
    const int b = row < NLAT ? (row >> 12) : 8;
    const float* mrow = mod + (size_t)b * 6144;
    float4 v[4];
    float ss = 0.f;
#pragma unroll
    for (int j = 0; j < 4; ++j) {
      v[j] = ((const float4*)src)[lane + 64 * j];
      ss += v[j].x * v[j].x + v[j].y * v[j].y + v[j].z * v[j].z + v[j].w * v[j].w;
    }
    ss = wave_sum(ss);
    const float r = rsqrtf(ss * (1.f / 1024.f) + EPS);
#pragma unroll
    for (int j = 0; j < 4; ++j) {
      const int c = (lane + 64 * j) * 4;
      const float4 gg = *(const float4*)(g + c);
      const float4 sh = *(const float4*)(mrow + sh_off + c);
      const float4 sc = *(const float4*)(mrow + sc_off + c);
      const float o0 = v[j].x * r * gg.x * (1.f + sc.x) + sh.x;
      const float o1 = v[j].y * r * gg.y * (1.f + sc.y) + sh.y;
      const float o2 = v[j].z * r * gg.z * (1.f + sc.z) + sh.z;
      const float o3 = v[j].w * r * gg.w * (1.f + sc.w) + sh.w;
      uint2 o; o.x = pack2h(o0, o1); o.y = pack2h(o2, o3);
      *(uint2*)(act + (size_t)row * 1024 + c) = o;
    }
  }
}

__device__ __forceinline__ void phase_final(const Params& p) {
  const int lane = opaque_tid() & 63;
  const int gw = opaque_bid() * 8 + (opaque_tid() >> 6), nw = gridDim.x * 8;
  for (int row = gw; row < NLAT; row += nw) {
    float* src = p.out + (size_t)row * 1024;
    float4 v[4];
    float ss = 0.f;
#pragma unroll
    for (int j = 0; j < 4; ++j) {
      v[j] = ((const float4*)src)[lane + 64 * j];
      ss += v[j].x * v[j].x + v[j].y * v[j].y + v[j].z * v[j].z + v[j].w * v[j].w;
    }
    ss = wave_sum(ss);
    const float r = rsqrtf(ss * (1.f / 1024.f) + EPS);
#pragma unroll
    for (int j = 0; j < 4; ++j) {
      const int c = (lane + 64 * j) * 4;
      const float4 gg = *(const float4*)(p.final_g + c);
      float4 o;
      o.x = v[j].x * r * gg.x; o.y = v[j].y * r * gg.y; o.z = v[j].z * r * gg.z; o.w = v[j].w * r * gg.w;
      ((float4*)src)[lane + 64 * j] = o;
    }
  }
}

constexpr int EPI_INPROJ = 0, EPI_OUTPROJ = 1, EPI_PLAIN = 2;
constexpr int GS = 72;
constexpr int G_ASTAGE = 256 * GS * 2;
constexpr int G_BSTAGE = 128 * GS * 2;
constexpr int G_STAGE = G_ASTAGE + G_BSTAGE;

namespace g8 {
constexpr int BM = 256, BK = 64, HALF = 128, NXCD = 8, WGM = 8, HT = HALF * BK;
__device__ __forceinline__ int lds_byte(int r, int c) {
  const int st = (r >> 4) * 2 + (c >> 5), rr = r & 15, cc = c & 31, ob = rr * 64 + cc * 2;
  return st * 1024 + (ob ^ (((ob >> 9) & 1) << 5));
}
__device__ __forceinline__ void stage_rc(int b, int& R, int& C) {
  const int st = b / 1024, sb = b % 1024, swz = sb ^ (((sb >> 9) & 1) << 5);
  R = (st >> 1) * 16 + swz / 64; C = (st & 1) * 32 + (swz % 64) / 2;
}
}

constexpr int G8_ROPE_LDS = 8 * 16384;
template <int EPI>
__device__ __forceinline__ void epi_store8(const Params& p, int layer, char* smem, int m, int n, f32x4 lo, f32x4 hi, const float* xin_lat) {
  float v[8] = {lo[0], lo[1], lo[2], lo[3], hi[0], hi[1], hi[2], hi[3]};
  if constexpr (EPI == EPI_INPROJ) {
    const bool ropeD = (n >= C_DFQ && n < C_DFV), ropeR = (n >= C_RTQ && n < C_RTV);
    if ((ropeD || ropeR) && m < NLAT) {
      const int t = m & 4095, gr = t >> 6, gc = t & 63;
      const float2* tabD = (const float2*)(smem + G8_ROPE_LDS);
      const float2* tabR = (const float2*)(smem + G8_ROPE_LDS + 4096);
      const float2* tb;
      if (ropeD) { const int i0 = (n & 31) >> 1; tb = i0 < 8 ? tabD + gr * 8 + i0 : tabD + gc * 8 + i0 - 8; }
      else { const int i0 = (n & 63) >> 1; tb = i0 < 16 ? tabR + gr * 16 + i0 : tabR + gc * 16 + i0 - 16; }
#pragma unroll
      for (int q = 0; q < 4; ++q) {
        const float2 cs = tb[q];
        const float a0 = v[2 * q] * cs.x - v[2 * q + 1] * cs.y, a1 = v[2 * q] * cs.y + v[2 * q + 1] * cs.x;
        v[2 * q] = a0; v[2 * q + 1] = a1;
      }
    }
    float sc = 1.f;
    if (n < C_NAK) sc = 0.125f * 1.4426950408889634f;
    else if (n >= C_DFQ && n < C_DFK) sc = 0.17677669529663687f * 1.4426950408889634f;
    else if (n >= C_RTK && n < C_RTV) sc = 0.125f;
    uint4 o;
    o.x = pack2h(v[0] * sc, v[1] * sc); o.y = pack2h(v[2] * sc, v[3] * sc); o.z = pack2h(v[4] * sc, v[5] * sc); o.w = pack2h(v[6] * sc, v[7] * sc);
    *(uint4*)((bf16_t*)(p.ws + OFF_P) + (size_t)m * INC + n) = o;
  } else if constexpr (EPI == EPI_OUTPROJ) {
    const float* mod = (const float*)(p.ws + OFF_MOD) + (size_t)layer * 9 * 6144;
    const int b = m < NLAT ? (m >> 12) : 8;
    const float* gp = mod + (size_t)b * 6144 + 2 * 1024 + n;
    const float4 g0 = *(const float4*)gp, g1 = *(const float4*)(gp + 4);
    const float* xi; float* xo;
    if (m < NLAT) { xi = xin_lat + (size_t)m * 1024 + n; xo = p.out + (size_t)m * 1024 + n; }
    else { xo = (float*)(p.ws + OFF_CTXB) + (size_t)(m - NLAT) * 1024 + n; xi = xo; }
    const float4 x0 = *(const float4*)xi, x1 = *(const float4*)(xi + 4);
    float4 o0, o1;
    o0.x = x0.x + g0.x * v[0]; o0.y = x0.y + g0.y * v[1]; o0.z = x0.z + g0.z * v[2]; o0.w = x0.w + g0.w * v[3];
    o1.x = x1.x + g1.x * v[4]; o1.y = x1.y + g1.y * v[5]; o1.z = x1.z + g1.z * v[6]; o1.w = x1.w + g1.w * v[7];
    *(float4*)xo = o0; *(float4*)(xo + 4) = o1;
  } else if constexpr (EPI == EPI_PLAIN) {
    uint4 o;
    o.x = pack2h(v[0], v[1]); o.y = pack2h(v[2], v[3]); o.z = pack2h(v[4], v[5]); o.w = pack2h(v[6], v[7]);
    *(uint4*)((bf16_t*)(p.ws + OFF_P) + (size_t)m * 2048 + n) = o;
  } else {
    asm volatile("" :: "v"(v[0]), "v"(v[1]), "v"(v[2]), "v"(v[3]), "v"(v[4]), "v"(v[5]), "v"(v[6]), "v"(v[7]));
  }
}

#define G8_LAS __attribute__((address_space(3)))
__device__ __forceinline__ bool g8_next(int i, int nM, int nN, int G, int c, int& pm, int& pn) {
  using namespace g8;
  const int nwg = nM * nN;
  const long Lx = (long)i * G + c;
  if (Lx >= nwg) return false;
  int wgid = (int)Lx;
  { const int q = nwg / NXCD, r = nwg % NXCD, xcd = wgid % NXCD, off = wgid / NXCD; wgid = (xcd < r ? xcd * (q + 1) : r * (q + 1) + (xcd - r) * q) + off; }
  const int nig = WGM * nN, gid = wgid / nig, fm = gid * WGM, gsz = (nM - fm) < WGM ? (nM - fm) : WGM;
  pm = fm + ((wgid % nig) % gsz); pn = (wgid % nig) / gsz;
  return true;
}

template <int EPI>
__device__ __forceinline__ void gemm_phase2(const Params& p, int layer, char* smem, const bf16_t* A, const bf16_t* Bt,
                                            int M, int N, const float* xin_lat) {
  using namespace g8;
  constexpr int K = 1024, nt = K / BK, HTB = HALF * BK * 2;
  G8_LAS unsigned char* lds = (G8_LAS unsigned char*)smem;
  const int tid = opaque_tid();
  const int wid = __builtin_amdgcn_readfirstlane(tid >> 6), lane = tid & 63, wr = wid >> 2, wc = wid & 3, fr = lane & 15, fq = lane >> 4;
  unsigned voff[2], voffB[2];
#pragma unroll
  for (int i = 0; i < 2; ++i) {
    int R, C; stage_rc(tid * 16 + i * 8192, R, C);
    const int rho = R & 31, Rb = (R & ~31) + 8 * ((rho & 15) >> 2) + 4 * (rho >> 4) + (rho & 3);
    voff[i] = (unsigned)(R * K + C) * 2u; voffB[i] = (unsigned)(Rb * K + C) * 2u;
  }
  if constexpr (EPI == EPI_INPROJ) {
    __syncthreads();
    const float4* gsrc = (const float4*)(p.ws + OFF_ROPE);
    float4* ldst = (float4*)(smem + G8_ROPE_LDS);
    for (int i = tid; i < 12288 / 16; i += 512) ldst[i] = gsrc[i];
  }
  constexpr size_t kstep = (size_t)(BK * 2);
  constexpr size_t hstep = (size_t)HALF * K * 2;
  constexpr size_t tstep = 2 * hstep;
  const unsigned ldsw = (unsigned)wid * 1024u;
  const int aoff = lds_byte(wr * 64 + fr, fq * 8), boff = lds_byte(wc * 32 + fr, fq * 8);
#define G8_SA(b, h) (((b) * 2 + (h)) * HTB)
#define G8_SB(b, h) ((4 + (b) * 2 + (h)) * HTB)
#define G8_STAGE_V(bufoff, gbase, VO) do { _Pragma("unroll") for (int _i = 0; _i < 2; ++_i)                                  \
    __builtin_amdgcn_global_load_lds((const unsigned*)((const char*)(gbase) + VO[_i]), (G8_LAS unsigned*)(lds + (bufoff) + ldsw + _i * 8192), 16, 0, 0); } while (0)
#define G8_LDA(dst, b, h) do { _Pragma("unroll") for (int m = 0; m < 4; ++m) _Pragma("unroll") for (int k = 0; k < 2; ++k) dst[m][k] = *(const G8_LAS bf16x8*)(lds + G8_SA(b, h) + aoff + m * 2048 + k * 1024); } while (0)
#define G8_LDB(dst, b, h) do { _Pragma("unroll") for (int n = 0; n < 2; ++n) _Pragma("unroll") for (int k = 0; k < 2; ++k) dst[n][k] = *(const G8_LAS bf16x8*)(lds + G8_SB(b, h) + boff + n * 2048 + k * 1024); } while (0)
#define G8_MMA(ai, bj, At_, Bt_) do { __builtin_amdgcn_s_setprio(1);                                                          \
    _Pragma("unroll") for (int m = 0; m < 4; ++m) _Pragma("unroll") for (int n = 0; n < 2; ++n) _Pragma("unroll") for (int k = 0; k < 2; ++k) \
      acc[ai][bj][m][n] = __builtin_amdgcn_mfma_f32_16x16x32_bf16(Bt_[n][k], At_[m][k], acc[ai][bj][m][n], 0, 0, 0);          \
    __builtin_amdgcn_s_setprio(0); } while (0)
#define G8_WAIT_V(n) asm volatile("s_waitcnt vmcnt(" #n ")" ::: "memory")
#define G8_WAIT_L(n) asm volatile("s_waitcnt lgkmcnt(" #n ")" ::: "memory")
#define G8_BAR __builtin_amdgcn_s_barrier()
#define G8_SCHED __builtin_amdgcn_sched_barrier(0)
  const int nM = M / BM, nN = N / BM, G = gridDim.x, cu = opaque_bid();
  int cpm, cpn, npm = 0, npn = 0, ui = 0;
  __syncthreads();
  if (g8_next(0, nM, nN, G, cu, cpm, cpn)) {
    f32x4 acc[2][2][4][2];
#pragma unroll
    for (int a = 0; a < 2; ++a)
#pragma unroll
      for (int b2 = 0; b2 < 2; ++b2)
#pragma unroll
        for (int m = 0; m < 4; ++m)
#pragma unroll
          for (int n = 0; n < 2; ++n) acc[a][b2][m][n] = (f32x4){0.f, 0.f, 0.f, 0.f};
    bf16x8 At[4][2], B0[2][2], B1[2][2];
    const char* cA = (const char*)A + (size_t)cpm * tstep;
    const char* cB = (const char*)Bt + (size_t)cpn * tstep;
    G8_STAGE_V(G8_SB(0, 0), cB, voffB); G8_STAGE_V(G8_SA(0, 0), cA, voff); G8_STAGE_V(G8_SB(0, 1), cB + hstep, voffB); G8_STAGE_V(G8_SA(0, 1), cA + hstep, voff);
    if (wr == 1) G8_BAR;
    G8_WAIT_V(4); G8_BAR;
    G8_STAGE_V(G8_SB(1, 0), cB + kstep, voffB); G8_STAGE_V(G8_SA(1, 0), cA + kstep, voff); G8_STAGE_V(G8_SB(1, 1), cB + hstep + kstep, voffB);
    G8_WAIT_V(6); G8_BAR;
    for (;;) {
      const bool has_next = g8_next(ui + 1, nM, nN, G, cu, npm, npn);
      const char* nA = has_next ? (const char*)A + (size_t)npm * tstep : cA;
      const char* nB = has_next ? (const char*)Bt + (size_t)npn * tstep : cB;
#pragma unroll 1
      for (int t = 0; t < nt; t += 2) {
        const bool last = (t == nt - 2);
        const char* a1 = cA + (size_t)(t + 1) * kstep;
        const char* a2 = last ? nA : cA + (size_t)(t + 2) * kstep; const char* b2 = last ? nB : cB + (size_t)(t + 2) * kstep;
        const char* a3 = a2 + kstep; const char* b3 = b2 + kstep;
        G8_LDB(B0, 0, 0); G8_SCHED; G8_LDA(At, 0, 0); G8_STAGE_V(G8_SA(1, 1), a1 + hstep, voff);
        G8_WAIT_L(8); G8_BAR; G8_WAIT_L(0); G8_MMA(0, 0, At, B0); G8_BAR; G8_SCHED;
        G8_LDB(B1, 0, 1); G8_STAGE_V(G8_SB(0, 0), b2, voffB);
        G8_BAR; G8_WAIT_L(0); G8_MMA(0, 1, At, B1); G8_BAR;
        G8_LDA(At, 0, 1); G8_STAGE_V(G8_SA(0, 0), a2, voff);
        G8_BAR; G8_WAIT_L(0); G8_MMA(1, 0, At, B0); G8_BAR; G8_SCHED;
        G8_STAGE_V(G8_SB(0, 1), b2 + hstep, voffB);
        G8_WAIT_V(6); G8_BAR; G8_MMA(1, 1, At, B1); G8_BAR;
        G8_LDB(B0, 1, 0); G8_SCHED; G8_LDA(At, 1, 0); G8_STAGE_V(G8_SA(0, 1), a2 + hstep, voff);
        G8_WAIT_L(8); G8_BAR; G8_WAIT_L(0); G8_MMA(0, 0, At, B0); G8_BAR; G8_SCHED;
        G8_LDB(B1, 1, 1); G8_STAGE_V(G8_SB(1, 0), b3, voffB);
        G8_BAR; G8_WAIT_L(0); G8_MMA(0, 1, At, B1); G8_BAR;
        G8_LDA(At, 1, 1); G8_STAGE_V(G8_SA(1, 0), a3, voff);
        G8_BAR; G8_WAIT_L(0); G8_MMA(1, 0, At, B0); G8_BAR; G8_SCHED;
        G8_STAGE_V(G8_SB(1, 1), b3 + hstep, voffB);
        G8_WAIT_V(6); G8_BAR; G8_MMA(1, 1, At, B1); G8_BAR;
      }
      {
        const int brow = cpm * BM, bcol = cpn * BM;
        if constexpr (EPI == EPI_INPROJ) {
          if (bcol == C_DFK) {
#pragma unroll
            for (int bj = 0; bj < 2; ++bj) {
              float mx = 0.f;
#pragma unroll
              for (int ai = 0; ai < 2; ++ai)
#pragma unroll
                for (int m = 0; m < 4; ++m) {
                  float s = 0.f;
#pragma unroll
                  for (int n = 0; n < 2; ++n)
#pragma unroll
                    for (int j = 0; j < 4; ++j) s = fmaf(acc[ai][bj][m][n][j], acc[ai][bj][m][n][j], s);
                  s += __shfl_xor(s, 16); s += __shfl_xor(s, 32);
                  mx = fmaxf(mx, s);
                }
#pragma unroll
              for (int o = 1; o < 16; o <<= 1) mx = fmaxf(mx, __shfl_xor(mx, o));
              if (lane == 0) {
                const int bb = brow < NLAT ? (brow >> 12) : ((brow - NLAT) >> 8);
                unsigned* km = (unsigned*)(p.ws + OFF_MISC) + 64 + layer * 64 + (bb * 4 + bj * 2 + (wc >> 1)) * 2 + (wc & 1);
                atomicMax(km, __float_as_uint(mx));
              }
            }
          }
        }
#pragma unroll
        for (int ai = 0; ai < 2; ++ai)
#pragma unroll
          for (int bj = 0; bj < 2; ++bj)
#pragma unroll
            for (int m = 0; m < 4; ++m)
              epi_store8<EPI>(p, layer, smem, brow + ai * HALF + wr * 64 + m * 16 + fr, bcol + bj * HALF + wc * 32 + fq * 8,
                              acc[ai][bj][m][0], acc[ai][bj][m][1], xin_lat);
      }
      if (!has_next) break;
#pragma unroll
      for (int a = 0; a < 2; ++a)
#pragma unroll
        for (int b2 = 0; b2 < 2; ++b2)
#pragma unroll
          for (int m = 0; m < 4; ++m)
#pragma unroll
            for (int n = 0; n < 2; ++n) acc[a][b2][m][n] = (f32x4){0.f, 0.f, 0.f, 0.f};
      cpm = npm; cpn = npn; cA = nA; cB = nB; ++ui;
    }
    G8_WAIT_V(0);
    if (wr == 0) G8_BAR;
    G8_BAR;
  }
}

__device__ __forceinline__ unsigned cvt_pk_bf16(float lo, float hi) { return pack2h(lo, hi); }
__device__ __forceinline__ void vt_store8(bf16_t* vt, int stride, int d0, int key, uint4 uv) {
  bf16_t* vd = vt + d0 * stride + key;
  vd[0 * stride] = (bf16_t)(uv.x & 0xffffu); vd[1 * stride] = (bf16_t)(uv.x >> 16);
  vd[2 * stride] = (bf16_t)(uv.y & 0xffffu); vd[3 * stride] = (bf16_t)(uv.y >> 16);
  vd[4 * stride] = (bf16_t)(uv.z & 0xffffu); vd[5 * stride] = (bf16_t)(uv.z >> 16);
  vd[6 * stride] = (bf16_t)(uv.w & 0xffffu); vd[7 * stride] = (bf16_t)(uv.w >> 16);
}

constexpr int DKS = 72;
__device__ __forceinline__ void diff_item(const Params& p, int layer, bool ctxq, int item, char* smem) {
  const bf16_t* P = (const bf16_t*)(p.ws + OFF_P);
  bf16_t* Y = (bf16_t*)(p.ws + OFF_ACT);
  const float* misc = (const float*)(p.ws + OFF_MISC);
  const float lam = misc[layer], lam_init = misc[2 + layer];
  const int tid = opaque_tid(), lane = tid & 63, wave = tid >> 6, lr = lane & 15, lq = lane >> 4;
  int b, h, mbase, nkeys;
  if (!ctxq) { b = item >> 6; h = (item >> 4) & 3; mbase = b * 4096 + (item & 15) * 256; nkeys = 256 + 4096; }
  else { b = item >> 2; h = item & 3; mbase = NLAT + b * 256; nkeys = 256; }
  const float kmax0 = sqrtf(misc[64 + layer * 64 + (b * 4 + h) * 2 + 0]), kmax1 = sqrtf(misc[64 + layer * 64 + (b * 4 + h) * 2 + 1]);
  bf16x8 qf[2][2];
  f32x4 C0[2], C1[2];
#pragma unroll
  for (int qt = 0; qt < 2; ++qt) {
    const bf16_t* qr = P + (size_t)(mbase + wave * 32 + qt * 16 + lr) * INC + C_DFQ + h * 64 + lq * 8;
    const uint4 u0 = *(const uint4*)(qr), u1 = *(const uint4*)(qr + 32);
    float s0 = 0.f, s1 = 0.f;
    { float t[8]; UNPACK8(t, 0, u0) _Pragma("unroll") for (int i = 0; i < 8; ++i) s0 = fmaf(t[i], t[i], s0); }
    { float t[8]; UNPACK8(t, 0, u1) _Pragma("unroll") for (int i = 0; i < 8; ++i) s1 = fmaf(t[i], t[i], s1); }
    s0 += __shfl_xor(s0, 16); s0 += __shfl_xor(s0, 32);
    s1 += __shfl_xor(s1, 16); s1 += __shfl_xor(s1, 32);
    const float nm0 = -sqrtf(s0) * kmax0, nm1 = -sqrtf(s1) * kmax1;
    C0[qt] = (f32x4){nm0, nm0, nm0, nm0};
    C1[qt] = (f32x4){nm1, nm1, nm1, nm1};
    union { uint4 u; bf16x8 v; } c0, c1; c0.u = u0; c1.u = u1;
    qf[qt][0] = c0.v; qf[qt][1] = c1.v;
  }
  f32x4 O0[2][4], O1[2][4];
#pragma unroll
  for (int qt = 0; qt < 2; ++qt)
#pragma unroll
    for (int i = 0; i < 4; ++i) { O0[qt][i] = (f32x4){0.f, 0.f, 0.f, 0.f}; O1[qt][i] = (f32x4){0.f, 0.f, 0.f, 0.f}; }
  f32x4 L0[2], L1[2];
#pragma unroll
  for (int qt = 0; qt < 2; ++qt) { L0[qt] = (f32x4){0.f, 0.f, 0.f, 0.f}; L1[qt] = (f32x4){0.f, 0.f, 0.f, 0.f}; }
  const bf16x8 ones8 = {(short)0x3F80, (short)0x3F80, (short)0x3F80, (short)0x3F80, (short)0x3F80, (short)0x3F80, (short)0x3F80, (short)0x3F80};
  const int lkey = tid >> 3, lch = tid & 7;
  constexpr int DBUF = 2 * 128 * DKS * 2;
  uint4 ukA0, ukA1, uvA0, uvA1;
#define DF_GLOAD1(UK, UV, T, I)                                                                     \
  {                                                                                                 \
    const int kk = (T) * 128 + (I) * 64 + lkey;                                                     \
    const size_t row = kk < 256 ? (size_t)(NLAT + b * 256 + kk) : (size_t)(b * 4096 + kk - 256);    \
    UK = *(const uint4*)(P + row * INC + C_DFK + h * 64 + lch * 8);                                 \
    UV = *(const uint4*)(P + row * INC + C_DFV + h * 64 + lch * 8);                                 \
  }
#define DF_LSTORE1(UK, UV, BUF, I)                                                                  \
  {                                                                                                 \
    bf16_t* Ks_ = (bf16_t*)(smem + (BUF) * DBUF) + (I) * 64 * DKS;                                  \
    bf16_t* Vt_ = (bf16_t*)(smem + (BUF) * DBUF) + 128 * DKS + (I) * 64 * DKS;                      \
    *(uint4*)(Ks_ + lkey * DKS + lch * 8) = UK;                                                     \
    vt_store8(Vt_, DKS, lch * 8, lkey, UV);                                                         \
  }
#define DF_GLOAD(S, T) DF_GLOAD1(uk##S##0, uv##S##0, T, 0) DF_GLOAD1(uk##S##1, uv##S##1, T, 1)
#define DF_LSTORE(S, BUF) DF_LSTORE1(uk##S##0, uv##S##0, BUF, 0) DF_LSTORE1(uk##S##1, uv##S##1, BUF, 1)
  const int ntile = nkeys >> 7;
  __syncthreads();
  DF_GLOAD(A, 0)
  DF_LSTORE(A, 0)
  __syncthreads();
#pragma unroll 1
  for (int t = 0; t < ntile; ++t) {
    const int cur = t & 1;
    if (t + 1 < ntile) { DF_GLOAD(A, t + 1) }
#pragma unroll
    for (int sub = 0; sub < 2; ++sub) {
    const bf16_t* Ks = (const bf16_t*)(smem + cur * DBUF) + sub * 64 * DKS;
    const bf16_t* Vt = (const bf16_t*)(smem + cur * DBUF) + 128 * DKS + sub * 64 * DKS;
    union PF { unsigned u[4]; bf16x8 v; };
    PF pf0[2][2], pf1[2][2];
#pragma unroll
    for (int c = 0; c < 2; ++c) {
      f32x4 S[2][4];
#pragma unroll
      for (int kt = 0; kt < 4; ++kt) {
        const bf16x8 kf = *(const bf16x8*)(Ks + (kt * 16 + lr) * DKS + c * 32 + lq * 8);
#pragma unroll
        for (int qt = 0; qt < 2; ++qt) S[qt][kt] = __builtin_amdgcn_mfma_f32_16x16x32_bf16(kf, qf[qt][c], c == 0 ? C0[qt] : C1[qt], 0, 0, 0);
      }
#pragma unroll
      for (int qt = 0; qt < 2; ++qt) {
#pragma unroll
        for (int kt = 0; kt < 4; ++kt) {
#pragma unroll
          for (int r = 0; r < 4; ++r) S[qt][kt][r] = __builtin_amdgcn_exp2f(S[qt][kt][r]);
        }
#pragma unroll
        for (int g = 0; g < 2; ++g) {
          PF t;
          t.u[0] = cvt_pk_bf16(S[qt][2 * g][0], S[qt][2 * g][1]); t.u[1] = cvt_pk_bf16(S[qt][2 * g][2], S[qt][2 * g][3]);
          t.u[2] = cvt_pk_bf16(S[qt][2 * g + 1][0], S[qt][2 * g + 1][1]); t.u[3] = cvt_pk_bf16(S[qt][2 * g + 1][2], S[qt][2 * g + 1][3]);
          if (c == 0) pf0[qt][g] = t; else pf1[qt][g] = t;
        }
      }
    }
#pragma unroll
    for (int g = 0; g < 2; ++g) {
#pragma unroll
      for (int qt = 0; qt < 2; ++qt) {
        L0[qt] = __builtin_amdgcn_mfma_f32_16x16x32_bf16(ones8, pf0[qt][g].v, L0[qt], 0, 0, 0);
        L1[qt] = __builtin_amdgcn_mfma_f32_16x16x32_bf16(ones8, pf1[qt][g].v, L1[qt], 0, 0, 0);
      }
#pragma unroll
      for (int dt = 0; dt < 4; ++dt) {
        union { uint2 h2[2]; bf16x8 v; } vf;
        vf.h2[0] = *(const uint2*)(Vt + (dt * 16 + lr) * DKS + 32 * g + 4 * lq);
        vf.h2[1] = *(const uint2*)(Vt + (dt * 16 + lr) * DKS + 32 * g + 16 + 4 * lq);
#pragma unroll
        for (int qt = 0; qt < 2; ++qt) {
          O0[qt][dt] = __builtin_amdgcn_mfma_f32_16x16x32_bf16(vf.v, pf0[qt][g].v, O0[qt][dt], 0, 0, 0);
          O1[qt][dt] = __builtin_amdgcn_mfma_f32_16x16x32_bf16(vf.v, pf1[qt][g].v, O1[qt][dt], 0, 0, 0);
        }
      }
    }
    }
    if (t + 1 < ntile) { DF_LSTORE(A, cur ^ 1) }
    __syncthreads();
  }
  const float* sg = p.diff_subln_g + layer * 64;
#pragma unroll
  for (int qt = 0; qt < 2; ++qt) {
    const float a0 = L0[qt][0], a1 = L1[qt][0];
    const float i0 = 1.f / a0, i1 = lam / a1;
    float ss = 0.f;
#pragma unroll
    for (int dt = 0; dt < 4; ++dt) {
#pragma unroll
      for (int r = 0; r < 4; ++r) { const float v = O0[qt][dt][r] * i0 - O1[qt][dt][r] * i1; O0[qt][dt][r] = v; ss = fmaf(v, v, ss); }
    }
    ss += __shfl_xor(ss, 16); ss += __shfl_xor(ss, 32);
    const float rr = rsqrtf(ss * (1.f / 64.f) + EPS) * (1.f - lam_init);
    bf16_t* dst = Y + (size_t)(mbase + wave * 32 + qt * 16 + lr) * 1024 + Y_DF + h * 64;
#pragma unroll
    for (int dt = 0; dt < 4; ++dt) {
      const int d = dt * 16 + 4 * lq;
      const float4 g4 = *(const float4*)(sg + d);
      uint2 ov;
      ov.x = pack2(O0[qt][dt][0] * rr * g4.x, O0[qt][dt][1] * rr * g4.y);
      ov.y = pack2(O0[qt][dt][2] * rr * g4.z, O0[qt][dt][3] * rr * g4.w);
      *(uint2*)(dst + d) = ov;
    }
  }
}

constexpr int NA_WS = 520;
constexpr int NA_CS = 264;
constexpr int NA_OFF_VTW = 0;
constexpr int NA_OFF_VTC = 64 * NA_WS * 2;
constexpr int NA_OFF_RPB = NA_OFF_VTC + 64 * NA_CS * 2;
constexpr int NA_OFF_MRG = NA_OFF_RPB + 2048;

#define NA_STEP(KA_EXPR, KB_EXPR, BIAS_EXPR, VT_PTR, VT_STRIDE, VT_KEY0_EXPR)                                    \
  {                                                                                                               \
    f32x4 S[4];                                                                                                   \
    _Pragma("unroll") for (int kt = 0; kt < 4; ++kt) {                                                            \
      f32x4 a = __builtin_amdgcn_mfma_f32_16x16x32_bf16((KA_EXPR), qf[0], (f32x4){0.f, 0.f, 0.f, 0.f}, 0, 0, 0);  \
      S[kt] = __builtin_amdgcn_mfma_f32_16x16x32_bf16((KB_EXPR), qf[1], a, 0, 0, 0);                               \
    }                                                                                                             \
    _Pragma("unroll") for (int kt = 0; kt < 4; ++kt) {                                                            \
      _Pragma("unroll") for (int r = 0; r < 4; ++r) { S[kt][r] += (BIAS_EXPR); }                                  \
    }                                                                                                             \
    float x = fmaxf(fmaxf(S[0][0], S[0][1]), fmaxf(S[0][2], S[0][3]));                                            \
    _Pragma("unroll") for (int kt = 1; kt < 4; ++kt) x = fmaxf(x, fmaxf(fmaxf(S[kt][0], S[kt][1]), fmaxf(S[kt][2], S[kt][3]))); \
    x = fmaxf(x, __shfl_xor(x, 16)); x = fmaxf(x, __shfl_xor(x, 32));                                             \
    const float mn = fmaxf(mrun, x);                                                                              \
    const float al = __builtin_amdgcn_exp2f(mrun - mn);                                                           \
    mrun = mn;                                                                                                    \
    float ps = 0.f;                                                                                               \
    _Pragma("unroll") for (int kt = 0; kt < 4; ++kt) {                                                            \
      _Pragma("unroll") for (int r = 0; r < 4; ++r) { S[kt][r] = __builtin_amdgcn_exp2f(S[kt][r] - mn); ps += S[kt][r]; } \
    }                                                                                                             \
    lrun = lrun * al + ps;                                                                                        \
    _Pragma("unroll") for (int dt = 0; dt < 4; ++dt) {                                                            \
      _Pragma("unroll") for (int r = 0; r < 4; ++r) O[dt][r] *= al;                                               \
    }                                                                                                             \
    _Pragma("unroll") for (int g = 0; g < 2; ++g) {                                                               \
      union { unsigned u[4]; bf16x8 v; } pf;                                                                      \
      pf.u[0] = cvt_pk_bf16(S[2 * g][0], S[2 * g][1]); pf.u[1] = cvt_pk_bf16(S[2 * g][2], S[2 * g][3]);           \
      pf.u[2] = cvt_pk_bf16(S[2 * g + 1][0], S[2 * g + 1][1]); pf.u[3] = cvt_pk_bf16(S[2 * g + 1][2], S[2 * g + 1][3]); \
      const int vk0 = (VT_KEY0_EXPR);                                                                             \
      _Pragma("unroll") for (int dt = 0; dt < 4; ++dt) {                                                          \
        union { uint2 h2[2]; bf16x8 v; } vf;                                                                      \
        vf.h2[0] = *(const uint2*)((VT_PTR) + (dt * 16 + lr) * (VT_STRIDE) + vk0 + 4 * lq);                       \
        vf.h2[1] = *(const uint2*)((VT_PTR) + (dt * 16 + lr) * (VT_STRIDE) + vk0 + 16 + 4 * lq);                  \
        O[dt] = __builtin_amdgcn_mfma_f32_16x16x32_bf16(vf.v, pf.v, O[dt], 0, 0, 0);                              \
      }                                                                                                           \
    }                                                                                                             \
  }

__device__ __forceinline__ void na_latent_item(const Params& p, int layer, int item, char* smem) {
  const bf16_t* P = (const bf16_t*)(p.ws + OFF_P);
  bf16_t* Y = (bf16_t*)(p.ws + OFF_ACT);
  const int b = item >> 8, h = (item >> 6) & 3, grow = item & 63;
  const int tid = opaque_tid(), lane = tid & 63, wave = tid >> 6, lr = lane & 15, lq = lane >> 4;
  const int jt = wave & 3, half = wave >> 2;
  bf16_t* VtW = (bf16_t*)(smem + NA_OFF_VTW);
  bf16_t* VtC = (bf16_t*)(smem + NA_OFF_VTC);
  float* RPB = (float*)(smem + NA_OFF_RPB);
  float* MRG = (float*)(smem + NA_OFF_MRG);
  const int rs = min(max(grow - 4, 0), 56);
  __syncthreads();
  {
    const int ch = tid & 7;
#pragma unroll
    for (int i = 0; i < 8; ++i) {
      const int key = (tid >> 3) + 64 * i;
      const uint4 uv = *(const uint4*)(P + (size_t)(b * 4096 + (rs + (key >> 6)) * 64 + (key & 63)) * INC + C_NAV + h * 64 + ch * 8);
      vt_store8(VtW, NA_WS, ch * 8, key, uv);
    }
#pragma unroll
    for (int i = 0; i < 4; ++i) {
      const int key = (tid >> 3) + 64 * i;
      const uint4 uv = *(const uint4*)(P + (size_t)(NLAT + b * 256 + key) * INC + C_NAV + h * 64 + ch * 8);
      vt_store8(VtC, NA_CS, ch * 8, key, uv);
    }
    if (tid < 465) RPB[tid] = p.na_rpb[(size_t)(layer * 4 + h) * 465 + tid] * 1.4426950408889634f;
  }
  const int qc = jt * 16 + lr;
  const int mq = b * 4096 + grow * 64 + qc;
  bf16x8 qf[2];
  {
    const bf16_t* qr = P + (size_t)mq * INC + C_NAQ + h * 64 + lq * 8;
    qf[0] = *(const bf16x8*)(qr);
    qf[1] = *(const bf16x8*)(qr + 32);
  }
  f32x4 O[4];
#pragma unroll
  for (int i = 0; i < 4; ++i) O[i] = (f32x4){0.f, 0.f, 0.f, 0.f};
  float mrun = -1e30f, lrun = 0.f;
  const int k0 = min(max(jt * 16 - 8, 0), 32);
  const int cs = min(max(qc - 8, 0), 48);
  bf16x8 kfa[2][4], kfb[2][4];
#define NA_LOADK(SET, S_)                                                                                        \
  _Pragma("unroll") for (int kt = 0; kt < 4; ++kt) {                                                             \
    const int t_ = 4 * (S_) + kt;                                                                                \
    const size_t krow = half == 0 ? (size_t)(b * 4096 + (rs + (t_ >> 1)) * 64 + k0 + 16 * (t_ & 1) + lr) : (size_t)(NLAT + b * 256 + 16 * t_ + lr); \
    const bf16_t* kp = P + krow * INC + C_NAK + h * 64 + lq * 8;                                                 \
    kfa[SET][kt] = *(const bf16x8*)(kp); kfb[SET][kt] = *(const bf16x8*)(kp + 32);                               \
  }
  NA_LOADK(0, 0)
  __syncthreads();
#pragma unroll
  for (int s = 0; s < 4; ++s) {
    if (s + 1 < 4) { NA_LOADK((s + 1) & 1, s + 1) }
    if (half == 0) {
      const int wr0 = 2 * s;
      NA_STEP(kfa[s & 1][kt], kfb[s & 1][kt],
              ((k0 + 16 * (kt & 1) + 4 * lq + r) >= cs && (k0 + 16 * (kt & 1) + 4 * lq + r) < cs + 16)
                  ? RPB[(rs + wr0 + (kt >> 1) - grow + 7) * 31 + (k0 + 16 * (kt & 1) + 4 * lq + r) - qc + 15] : -1e30f,
              VtW, NA_WS, (wr0 + g) * 64 + k0)
    } else {
      NA_STEP(kfa[s & 1][kt], kfb[s & 1][kt], 0.f, VtC, NA_CS, s * 64 + 32 * g)
    }
  }
  lrun += __shfl_xor(lrun, 16); lrun += __shfl_xor(lrun, 32);
  float* mg = MRG + (jt * 64 + lane) * 18;
  if (half == 1) {
    mg[0] = mrun; mg[1] = lrun;
#pragma unroll
    for (int dt = 0; dt < 4; ++dt) { mg[2 + dt * 4 + 0] = O[dt][0]; mg[2 + dt * 4 + 1] = O[dt][1]; mg[2 + dt * 4 + 2] = O[dt][2]; mg[2 + dt * 4 + 3] = O[dt][3]; }
  }
  __syncthreads();
  if (half == 0) {
    const float m2 = mg[0], l2 = mg[1];
    const float M = fmaxf(mrun, m2);
    const float f1 = __builtin_amdgcn_exp2f(mrun - M), f2 = __builtin_amdgcn_exp2f(m2 - M);
    const float inv = 1.f / (lrun * f1 + l2 * f2);
    bf16_t* dst = Y + (size_t)mq * 1024 + Y_NA + h * 64;
#pragma unroll
    for (int dt = 0; dt < 4; ++dt) {
      const float o0 = (O[dt][0] * f1 + mg[2 + dt * 4 + 0] * f2) * inv, o1 = (O[dt][1] * f1 + mg[2 + dt * 4 + 1] * f2) * inv;
      const float o2 = (O[dt][2] * f1 + mg[2 + dt * 4 + 2] * f2) * inv, o3 = (O[dt][3] * f1 + mg[2 + dt * 4 + 3] * f2) * inv;
      uint2 ov; ov.x = pack2(o0, o1); ov.y = pack2(o2, o3);
      *(uint2*)(dst + dt * 16 + 4 * lq) = ov;
    }
  }
}

__device__ __forceinline__ void na_ctx_item(const Params& p, int item, char* smem) {
  const bf16_t* P = (const bf16_t*)(p.ws + OFF_P);
  bf16_t* Y = (bf16_t*)(p.ws + OFF_ACT);
  const int b = item >> 3, h = (item >> 1) & 3, qg = item & 1;
  const int tid = opaque_tid(), lane = tid & 63, wave = tid >> 6, lr = lane & 15, lq = lane >> 4;
  bf16_t* VtC = (bf16_t*)(smem + NA_OFF_VTC);
  __syncthreads();
  {
    const int ch = tid & 7;
#pragma unroll
    for (int i = 0; i < 4; ++i) {
      const int key = (tid >> 3) + 64 * i;
      const uint4 uv = *(const uint4*)(P + (size_t)(NLAT + b * 256 + key) * INC + C_NAV + h * 64 + ch * 8);
      vt_store8(VtC, NA_CS, ch * 8, key, uv);
    }
  }
  const int mq = NLAT + b * 256 + qg * 128 + wave * 16 + lr;
  bf16x8 qf[2];
  {
    const bf16_t* qr = P + (size_t)mq * INC + C_NAQ + h * 64 + lq * 8;
    qf[0] = *(const bf16x8*)(qr);
    qf[1] = *(const bf16x8*)(qr + 32);
  }
  f32x4 O[4];
#pragma unroll
  for (int i = 0; i < 4; ++i) O[i] = (f32x4){0.f, 0.f, 0.f, 0.f};
  float mrun = -1e30f, lrun = 0.f;
  __syncthreads();
#pragma unroll 1
  for (int s = 0; s < 4; ++s) {
    NA_STEP(*(const bf16x8*)(P + (size_t)(NLAT + b * 256 + s * 64 + kt * 16 + lr) * INC + C_NAK + h * 64 + lq * 8),
            *(const bf16x8*)(P + (size_t)(NLAT + b * 256 + s * 64 + kt * 16 + lr) * INC + C_NAK + h * 64 + 32 + lq * 8), 0.f, VtC, NA_CS, s * 64 + 32 * g)
  }
  lrun += __shfl_xor(lrun, 16); lrun += __shfl_xor(lrun, 32);
  const float inv = 1.f / lrun;
  bf16_t* dst = Y + (size_t)mq * 1024 + Y_NA + h * 64;
#pragma unroll
  for (int dt = 0; dt < 4; ++dt) {
    uint2 ov; ov.x = pack2(O[dt][0] * inv, O[dt][1] * inv); ov.y = pack2(O[dt][2] * inv, O[dt][3] * inv);
    *(uint2*)(dst + dt * 16 + 4 * lq) = ov;
  }
}

constexpr int KV_S = 136;
constexpr int KV_OFF_KF = 0, KV_OFF_KB = 64 * KV_S * 2, KV_OFF_VT = 2 * 64 * KV_S * 2;
__device__ __forceinline__ void ret_kv_item(const Params& p, int layer, int h, size_t row0, int cnt, float* dstF, float* dstB, char* smem) {
  const bf16_t* P = (const bf16_t*)(p.ws + OFF_P);
  const float* misc = (const float*)(p.ws + OFF_MISC);
  const float lgF2 = misc[16 + layer * 8 + 0 * 4 + h] * 1.4426950408889634f, lgB2 = misc[16 + layer * 8 + 1 * 4 + h] * 1.4426950408889634f;
  const int tid = opaque_tid(), lane = tid & 63, wave = tid >> 6, lr = lane & 15, lq = lane >> 4;
  bf16_t* KFt = (bf16_t*)(smem + KV_OFF_KF);
  bf16_t* KBt = (bf16_t*)(smem + KV_OFF_KB);
  bf16_t* Vt = (bf16_t*)(smem + KV_OFF_VT);
  const int dir = wave >> 2, dt = wave & 3;
  f32x4 acc[8];
#pragma unroll
  for (int i = 0; i < 8; ++i) acc[i] = (f32x4){0.f, 0.f, 0.f, 0.f};
#pragma unroll 1
  for (int kc = 0; kc < (cnt >> 7); ++kc) {
    __syncthreads();
    {
      const int tok = tid >> 2, c = tid & 3;
      const int j = kc * 128 + tok;
      const float wF = __builtin_amdgcn_exp2f(lgF2 * (float)(cnt - 1 - j)), wB = __builtin_amdgcn_exp2f(lgB2 * (float)j);
      const bf16_t* rowp = P + (row0 + j) * INC;
#pragma unroll
      for (int c8 = 0; c8 < 2; ++c8) {
        const uint4 u = *(const uint4*)(rowp + C_RTK + h * 64 + c * 16 + c8 * 8);
        float kv[8];
        UNPACK8(kv, 0, u)
#pragma unroll
        for (int i = 0; i < 8; ++i) {
          KFt[(c * 16 + c8 * 8 + i) * KV_S + tok] = f2bf(kv[i] * wF);
          KBt[(c * 16 + c8 * 8 + i) * KV_S + tok] = f2bf(kv[i] * wB);
        }
      }
#pragma unroll
      for (int c8 = 0; c8 < 4; ++c8) {
        const uint4 uv = *(const uint4*)(rowp + C_RTV + h * 128 + c * 32 + c8 * 8);
        vt_store8(Vt, KV_S, c * 32 + c8 * 8, tok, uv);
      }
    }
    __syncthreads();
    const bf16_t* Kt = dir == 0 ? KFt : KBt;
    bf16x8 af[4];
#pragma unroll
    for (int ks = 0; ks < 4; ++ks) af[ks] = *(const bf16x8*)(Kt + (dt * 16 + lr) * KV_S + ks * 32 + lq * 8);
#pragma unroll
    for (int et = 0; et < 8; ++et) {
#pragma unroll
      for (int ks = 0; ks < 4; ++ks) {
        const bf16x8 bfr = *(const bf16x8*)(Vt + (et * 16 + lr) * KV_S + ks * 32 + lq * 8);
        acc[et] = __builtin_amdgcn_mfma_f32_16x16x32_bf16(af[ks], bfr, acc[et], 0, 0, 0);
      }
    }
  }
  float* dst = dir == 0 ? dstF : dstB;
#pragma unroll
  for (int et = 0; et < 8; ++et) {
#pragma unroll
    for (int r = 0; r < 4; ++r) dst[(dt * 16 + 4 * lq + r) * 128 + et * 16 + lr] = acc[et][r];
  }
}

__device__ __forceinline__ void phase_ret_scan(const Params& p, int layer) {
  const float* misc = (const float*)(p.ws + OFF_MISC);
  float* rkv = (float*)(p.ws + OFF_RKV);
  const float* rs = (const float*)(p.ws + OFF_RS);
  const int gt = opaque_bid() * 512 + opaque_tid(), gs = gridDim.x * 512;
  for (int idx = gt; idx < 64 * 2048; idx += gs) {
    const int seq = idx >> 11, e4 = (idx & 2047) * 4;
    const int dir = seq & 1, h = (seq >> 1) & 3;
    const float cdec = __expf(misc[16 + layer * 8 + dir * 4 + h] * 128.f);
    float4* base = (float4*)(rkv + (size_t)seq * 32 * 8192 + e4);
    float4 v[32];
#pragma unroll
    for (int s = 0; s < 32; ++s) v[s] = base[(size_t)s * 2048];
    float4 st = *(const float4*)(rs + (size_t)seq * 8192 + e4);
    if (dir == 0) {
#pragma unroll
      for (int s = 0; s < 32; ++s) {
        const float4 t = v[s];
        base[(size_t)s * 2048] = st;
        st.x = fmaf(cdec, st.x, t.x); st.y = fmaf(cdec, st.y, t.y); st.z = fmaf(cdec, st.z, t.z); st.w = fmaf(cdec, st.w, t.w);
      }
    } else {
#pragma unroll
      for (int s = 31; s >= 0; --s) {
        const float4 t = v[s];
        base[(size_t)s * 2048] = st;
        st.x = fmaf(cdec, st.x, t.x); st.y = fmaf(cdec, st.y, t.y); st.z = fmaf(cdec, st.z, t.z); st.w = fmaf(cdec, st.w, t.w);
      }
    }
  }
}

constexpr int RT_KS = 72, RT_VS = 136;
constexpr int RT_OFF_K = 0, RT_OFF_VT = 128 * RT_KS * 2, RT_OFF_SF = RT_OFF_VT + 128 * RT_VS * 2, RT_OFF_SB = RT_OFF_SF + 128 * RT_KS * 2;
__device__ __forceinline__ void ret_out_item(const Params& p, int layer, int h, size_t krow0, int nkc, int iq0,
                                             const float* SF, const float* SB, int clen, char* smem) {
  const bf16_t* P = (const bf16_t*)(p.ws + OFF_P);
  bf16_t* Y = (bf16_t*)(p.ws + OFF_ACT);
  const float* misc = (const float*)(p.ws + OFF_MISC);
  const float lgF2 = misc[16 + layer * 8 + 0 * 4 + h] * 1.4426950408889634f, lgB2 = misc[16 + layer * 8 + 1 * 4 + h] * 1.4426950408889634f;
  const int tid = opaque_tid(), lane = tid & 63, wave = tid >> 6, lr = lane & 15, lq = lane >> 4;
  bf16_t* Ks = (bf16_t*)(smem + RT_OFF_K);
  bf16_t* Vt = (bf16_t*)(smem + RT_OFF_VT);
  bf16_t* SFt = (bf16_t*)(smem + RT_OFF_SF);
  bf16_t* SBt = (bf16_t*)(smem + RT_OFF_SB);
  const int iq = iq0 + wave * 16 + lr;
  const size_t mq = krow0 + iq;
  bf16x8 qf[2];
  {
    const bf16_t* qr = P + mq * INC + C_RTQ + h * 64 + lq * 8;
    qf[0] = *(const bf16x8*)(qr);
    qf[1] = *(const bf16x8*)(qr + 32);
  }
  f32x4 O[8];
#pragma unroll
  for (int i = 0; i < 8; ++i) O[i] = (f32x4){0.f, 0.f, 0.f, 0.f};
  if (SF != nullptr) {
    __syncthreads();
    {
      const int d = tid >> 3, e0 = (tid & 7) * 16;
#pragma unroll
      for (int c4 = 0; c4 < 4; ++c4) {
        const float4 a = *(const float4*)(SF + d * 128 + e0 + c4 * 4);
        const float4 bb = *(const float4*)(SB + d * 128 + e0 + c4 * 4);
        SFt[(e0 + c4 * 4 + 0) * RT_KS + d] = f2bf(a.x); SFt[(e0 + c4 * 4 + 1) * RT_KS + d] = f2bf(a.y);
        SFt[(e0 + c4 * 4 + 2) * RT_KS + d] = f2bf(a.z); SFt[(e0 + c4 * 4 + 3) * RT_KS + d] = f2bf(a.w);
        SBt[(e0 + c4 * 4 + 0) * RT_KS + d] = f2bf(bb.x); SBt[(e0 + c4 * 4 + 1) * RT_KS + d] = f2bf(bb.y);
        SBt[(e0 + c4 * 4 + 2) * RT_KS + d] = f2bf(bb.z); SBt[(e0 + c4 * 4 + 3) * RT_KS + d] = f2bf(bb.w);
      }
    }
    __syncthreads();
    const float cF = __builtin_amdgcn_exp2f(lgF2 * (float)(iq + 1)), cB = __builtin_amdgcn_exp2f(lgB2 * (float)(clen - iq));
#pragma unroll
    for (int ks = 0; ks < 2; ++ks)
#pragma unroll
      for (int et = 0; et < 8; ++et) {
        const bf16x8 sf = *(const bf16x8*)(SFt + (et * 16 + lr) * RT_KS + ks * 32 + lq * 8);
        O[et] = __builtin_amdgcn_mfma_f32_16x16x32_bf16(sf, qf[ks], O[et], 0, 0, 0);
      }
    const float ratio = cF / cB;
#pragma unroll
    for (int et = 0; et < 8; ++et) { O[et][0] *= ratio; O[et][1] *= ratio; O[et][2] *= ratio; O[et][3] *= ratio; }
#pragma unroll
    for (int ks = 0; ks < 2; ++ks)
#pragma unroll
      for (int et = 0; et < 8; ++et) {
        const bf16x8 sb = *(const bf16x8*)(SBt + (et * 16 + lr) * RT_KS + ks * 32 + lq * 8);
        O[et] = __builtin_amdgcn_mfma_f32_16x16x32_bf16(sb, qf[ks], O[et], 0, 0, 0);
      }
#pragma unroll
    for (int et = 0; et < 8; ++et) { O[et][0] *= cB; O[et][1] *= cB; O[et][2] *= cB; O[et][3] *= cB; }
  }
#pragma unroll 1
  for (int kc = 0; kc < nkc; ++kc) {
    __syncthreads();
    {
      const int key = tid >> 2, c = tid & 3;
      const bf16_t* rowp = P + (krow0 + kc * 128 + key) * INC;
      const uint4 k0 = *(const uint4*)(rowp + C_RTK + h * 64 + c * 16), k1 = *(const uint4*)(rowp + C_RTK + h * 64 + c * 16 + 8);
      *(uint4*)(Ks + key * RT_KS + c * 16) = k0;
      *(uint4*)(Ks + key * RT_KS + c * 16 + 8) = k1;
#pragma unroll
      for (int c8 = 0; c8 < 4; ++c8) {
        const uint4 uv = *(const uint4*)(rowp + C_RTV + h * 128 + c * 32 + c8 * 8);
        vt_store8(Vt, RT_VS, c * 32 + c8 * 8, key, uv);
      }
    }
    __syncthreads();
    f32x4 S[8];
#pragma unroll
    for (int kt = 0; kt < 8; ++kt) {
      const bf16x8 ka = *(const bf16x8*)(Ks + (kt * 16 + lr) * RT_KS + lq * 8);
      const bf16x8 kb = *(const bf16x8*)(Ks + (kt * 16 + lr) * RT_KS + 32 + lq * 8);
      const f32x4 a = __builtin_amdgcn_mfma_f32_16x16x32_bf16(ka, qf[0], (f32x4){0.f, 0.f, 0.f, 0.f}, 0, 0, 0);
      S[kt] = __builtin_amdgcn_mfma_f32_16x16x32_bf16(kb, qf[1], a, 0, 0, 0);
    }
#pragma unroll
    for (int kt = 0; kt < 8; ++kt) {
#pragma unroll
      for (int r = 0; r < 4; ++r) {
        const int df = iq - (kc * 128 + kt * 16 + 4 * lq + r);
        const float fdf = (float)df;
        float coef = 0.f;
        if (df >= 0) coef += __builtin_amdgcn_exp2f(lgF2 * fdf);
        if (df <= 0) coef += __builtin_amdgcn_exp2f(-lgB2 * fdf);
        S[kt][r] *= coef;
      }
    }
#pragma unroll
    for (int g = 0; g < 4; ++g) {
      union { unsigned u[4]; bf16x8 v; } pf;
      pf.u[0] = cvt_pk_bf16(S[2 * g][0], S[2 * g][1]); pf.u[1] = cvt_pk_bf16(S[2 * g][2], S[2 * g][3]);
      pf.u[2] = cvt_pk_bf16(S[2 * g + 1][0], S[2 * g + 1][1]); pf.u[3] = cvt_pk_bf16(S[2 * g + 1][2], S[2 * g + 1][3]);
#pragma unroll
      for (int et = 0; et < 8; ++et) {
        union { uint2 h2[2]; bf16x8 v; } vf;
        vf.h2[0] = *(const uint2*)(Vt + (et * 16 + lr) * RT_VS + 32 * g + 4 * lq);
        vf.h2[1] = *(const uint2*)(Vt + (et * 16 + lr) * RT_VS + 32 * g + 16 + 4 * lq);
        O[et] = __builtin_amdgcn_mfma_f32_16x16x32_bf16(vf.v, pf.v, O[et], 0, 0, 0);
      }
    }
  }
  float ss = 0.f;
#pragma unroll
  for (int et = 0; et < 8; ++et) { ss = fmaf(O[et][0], O[et][0], ss); ss = fmaf(O[et][1], O[et][1], ss); ss = fmaf(O[et][2], O[et][2], ss); ss = fmaf(O[et][3], O[et][3], ss); }
  ss += __shfl_xor(ss, 16); ss += __shfl_xor(ss, 32);
  const float rr = rsqrtf(ss * (1.f / 128.f) + EPS);
  const bf16_t* gp = P + mq * INC + C_RTG + h * 128;
  bf16_t* dst = Y + mq * 1024 + Y_RT + h * 128;
#pragma unroll
  for (int et = 0; et < 8; ++et) {
    const int e = et * 16 + 4 * lq;
    const uint2 gu = *(const uint2*)(gp + e);
    uint2 ov;
    ov.x = pack2(O[et][0] * rr * siluf(lo16(gu.x)), O[et][1] * rr * siluf(hi16(gu.x)));
    ov.y = pack2(O[et][2] * rr * siluf(lo16(gu.y)), O[et][3] * rr * siluf(hi16(gu.y)));
    *(uint2*)(dst + e) = ov;
  }
}

__device__ __forceinline__ void uv_convert_item(const Params& p, int item) {
  char* ws = p.ws;
  const int tid = opaque_tid();
  const int lane = tid & 63, l = lane & 31, half = lane >> 5, wave = tid >> 6;
#pragma unroll 1
  for (int it = 0; it < 16; ++it) {
    const int row = item * 256 + (wave * 16 + it) * 2 + half;
    const bool isv = row >= 2 * NEXP;
    const int rr = isv ? row - 2 * NEXP : row;
    const float* srow = (isv ? p.peer_v : p.peer_u) + (size_t)rr * 1024;
    float4 v[8];
    float mx = 0.f;
#pragma unroll
    for (int j = 0; j < 8; ++j) {
      v[j] = ((const float4*)srow)[isv ? (l + 32 * j) : (l * 8 + j)];
      mx = fmaxf(mx, fmaxf(fmaxf(fabsf(v[j].x), fabsf(v[j].y)), fmaxf(fabsf(v[j].z), fabsf(v[j].w))));
    }
#pragma unroll
    for (int o = 1; o < 32; o <<= 1) mx = fmaxf(mx, __shfl_xor(mx, o));
    const float scale4 = mx > 0.f ? mx * (1.f / 6.f) : 1.f;
    const float inv4 = 1.f / scale4;
    unsigned w[4] = {0u, 0u, 0u, 0u};
#pragma unroll
    for (int k = 0; k < 32; ++k) {
      const float xv = (k & 3) == 0 ? v[k >> 2].x : (k & 3) == 1 ? v[k >> 2].y : (k & 3) == 2 ? v[k >> 2].z : v[k >> 2].w;
      const float a = fminf(fabsf(xv) * inv4, 6.f);
      float c;
      if (a < 2.f) c = rintf(a * 2.f);
      else if (a < 4.f) c = 4.f + rintf(a - 2.f);
      else c = 6.f + rintf((a - 4.f) * 0.5f);
      unsigned code = (unsigned)c;
      code = code > 7u ? 7u : code;
      code |= (xv < 0.f) ? 8u : 0u;
      w[k >> 3] |= code << (4 * (k & 7));
    }
    char* drow = ws + OFF_U + (size_t)rr * RECB + (isv ? ROWB + l * 16 : 64 * (l & 7) + 16 * (l >> 3));
    *(uint4*)(drow) = make_uint4(w[0], w[1], w[2], w[3]);
    if (l == 0) ((float*)(ws + (isv ? OFF_VSC : OFF_USC)))[rr] = scale4;
  }
}

__device__ __forceinline__ void phase_mix1(const Params& p, int layer, char* smem, int slot = 0) {
  unsigned* ctr = (unsigned*)(p.ws + OFF_CTL) + (layer * 4 + slot);
  const bool nc = layer == 0;
  const int n_dl = 512, n_dc = nc ? 32 : 0, n_nl = 2048, n_ncx = nc ? 64 : 0, n_kv = 1024, n_cs = 32;
  const int total = n_dl + n_dc + n_nl + n_ncx + n_kv + n_cs;
  float* rkv = (float*)(p.ws + OFF_RKV);
  float* rs = (float*)(p.ws + OFF_RS);
  for (;;) {
    int it = next_item(ctr, smem);
    if (it >= total) break;
    if (it < n_dl) { diff_item(p, layer, false, it, smem); continue; } it -= n_dl;
    if (it < n_dc) { diff_item(p, layer, true, it, smem); continue; } it -= n_dc;
    if (it < n_nl) { na_latent_item(p, layer, it, smem); continue; } it -= n_nl;
    if (it < n_ncx) { na_ctx_item(p, it, smem); continue; } it -= n_ncx;
    if (it < n_kv) {
      const int bh = it >> 5, n = it & 31, b = bh >> 2, h = bh & 3;
      ret_kv_item(p, layer, h, (size_t)b * 4096 + n * 128, 128,
                  rkv + ((size_t)(bh * 2 + 0) * 32 + n) * 8192, rkv + ((size_t)(bh * 2 + 1) * 32 + n) * 8192, smem);
      continue;
    }
    it -= n_kv;
    {
      const int bh = it, b = bh >> 2, h = bh & 3;
      ret_kv_item(p, layer, h, (size_t)NLAT + b * 256, 256, rs + (size_t)(bh * 2 + 0) * 8192, rs + (size_t)(bh * 2 + 1) * 8192, smem);
    }
  }
}

__device__ __forceinline__ void phase_mix2(const Params& p, int layer, char* smem, int slot = 1) {
  unsigned* ctr = (unsigned*)(p.ws + OFF_CTL) + (layer * 4 + slot);
  const int n_l = 1024, n_c = layer == 0 ? 64 : 0;
  const float* rkv = (const float*)(p.ws + OFF_RKV);
  for (;;) {
    int it = next_item(ctr, smem);
    if (it >= n_l + n_c) break;
    if (it < n_l) {
      const int bh = it >> 5, n = it & 31, b = bh >> 2, h = bh & 3;
      ret_out_item(p, layer, h, (size_t)b * 4096 + n * 128, 1, 0,
                   rkv + ((size_t)(bh * 2 + 0) * 32 + n) * 8192, rkv + ((size_t)(bh * 2 + 1) * 32 + n) * 8192, 128, smem);
    } else {
      it -= n_l;
      const int bh = it >> 1, half = it & 1, b = bh >> 2, h = bh & 3;
      ret_out_item(p, layer, h, (size_t)NLAT + b * 256, 2, half * 128, nullptr, nullptr, 256, smem);
    }
  }
}

typedef float f32x2 __attribute__((ext_vector_type(2)));
__device__ __forceinline__ unsigned sortable_key(float f, int idx) {
  const unsigned b = __float_as_uint(f);
  const unsigned k = b ^ ((unsigned)((int)b >> 31) | 0x80000000u);
  return (k & ~127u) | (unsigned)(127 - idx);
}
__device__ __forceinline__ float key_value(unsigned k) {
  k &= ~127u;
  const unsigned b = (k & 0x80000000u) ? (k ^ 0x80000000u) : ~k;
  return __uint_as_float(b);
}
#define FP8DOT(acc, H, off, W) { const f32x2 _a = __builtin_amdgcn_cvt_pk_f32_fp8((int)(W), false), _b = __builtin_amdgcn_cvt_pk_f32_fp8((int)(W), true); \
  acc = fmaf(H[(off) + 0], _a.x, acc); acc = fmaf(H[(off) + 1], _a.y, acc); acc = fmaf(H[(off) + 2], _b.x, acc); acc = fmaf(H[(off) + 3], _b.y, acc); }
#define FP8AXPY(O, off, P, W) { const f32x2 _a = __builtin_amdgcn_cvt_pk_f32_fp8((int)(W), false), _b = __builtin_amdgcn_cvt_pk_f32_fp8((int)(W), true); \
  O[(off) + 0] = fmaf(P, _a.x, O[(off) + 0]); O[(off) + 1] = fmaf(P, _a.y, O[(off) + 1]); O[(off) + 2] = fmaf(P, _b.x, O[(off) + 2]); O[(off) + 3] = fmaf(P, _b.y, O[(off) + 3]); }

__device__ __forceinline__ float gelu_erf(float a) {
  const float x = fabsf(a) * 0.70710678118654752f;
  const float t = __builtin_amdgcn_rcpf(fmaf(0.3275911f, x, 1.f));
  float pl = fmaf(1.061405429f, t, -1.453152027f);
  pl = fmaf(pl, t, 1.421413741f); pl = fmaf(pl, t, -0.284496736f); pl = fmaf(pl, t, 0.254829592f);
  const float y = 1.f - pl * t * __builtin_amdgcn_exp2f(-x * x * 1.4426950408889634f);
  const float er = a < 0.f ? -y : y;
  return 0.5f * a * (1.f + er);
}
constexpr int PE_SVS = 132;
constexpr int PE_OFF_SV = 0;
constexpr int PE_OFF_TV = 8 * 16 * PE_SVS * 4;
constexpr int PE_OFF_TI = PE_OFF_TV + 16 * 16 * 16 * 4;
constexpr int PE_OFF_EX = PE_OFF_TI + 16 * 16 * 16 * 4;
constexpr int PE_OFF_GT = PE_OFF_EX + 2 * 16 * 128 * 4;
constexpr int PE_OFF_SU = PE_OFF_GT + 2 * 16 * 128 * 4;
constexpr int PE_OFF_CN = PE_OFF_SU + 2 * 16 * 128 * 4;
constexpr int PE_OFF_CT = PE_OFF_CN + 8 * 16 * 4;
constexpr int PE_OFF_TQ = PE_OFF_CT + 64 * 4;
static_assert(PE_OFF_TQ + 16 <= LDS_BCAST, "PEER LDS map overflows");
#define WAVE_LDS_FENCE() asm volatile("s_waitcnt lgkmcnt(0)" ::: "memory")

__device__ __forceinline__ void peer_select_head(const Params& p, int layer, char* smem, int tok0, int hd, int sw, int buf,
                                                 int lane) {
  const bf16_t* Q = (const bf16_t*)(p.ws + OFF_P);
  const bf16_t* SK = (const bf16_t*)(p.ws + OFF_SUBK) + (size_t)layer * 262144;
  const int lr = lane & 15, lq = lane >> 4;
  unsigned* SV = (unsigned*)(smem + PE_OFF_SV) + sw * 16 * PE_SVS;
  float* TV = (float*)(smem + PE_OFF_TV);
  int* TI = (int*)(smem + PE_OFF_TI);
  int* EX = (int*)(smem + PE_OFF_EX) + buf * 16 * 128;
  float* GT = (float*)(smem + PE_OFF_GT) + buf * 16 * 128;
  int* CN = (int*)(smem + PE_OFF_CN) + sw * 16;
  float* SU = (float*)(smem + PE_OFF_SU) + buf * 16 * 128;
  const float* USC = (const float*)(p.ws + OFF_USC) + layer * NEXP;
  const float* VSC = (const float*)(p.ws + OFF_VSC) + layer * NEXP;
#pragma unroll 1
  for (int pp = 0; pp < 2; ++pp) {
    bf16x8 af[4];
    const bf16_t* qrow = Q + (size_t)(tok0 + lr) * 2048 + hd * 256 + pp * 128;
#pragma unroll
    for (int ks = 0; ks < 4; ++ks) af[ks] = *(const bf16x8*)(qrow + ks * 32 + lq * 8);
    const bf16_t* skb = SK + (size_t)((hd * 2 + pp) * 128) * 128;
    f32x4 acc[8];
    {
      bf16x8 bfr[8][4];
#pragma unroll
      for (int nt = 0; nt < 8; ++nt)
#pragma unroll
        for (int ks = 0; ks < 4; ++ks)
          bfr[nt][ks] = *(const bf16x8*)(skb + (size_t)(nt * 16 + lr) * 128 + ks * 32 + lq * 8);
#pragma unroll
      for (int nt = 0; nt < 8; ++nt) {
        f32x4 a = (f32x4){0.f, 0.f, 0.f, 0.f};
#pragma unroll
        for (int ks = 0; ks < 4; ++ks) a = __builtin_amdgcn_mfma_f32_16x16x32_bf16(af[ks], bfr[nt][ks], a, 0, 0, 0);
        acc[nt] = a;
      }
    }
#pragma unroll
    for (int i = 0; i < 9; ++i) { const int q4 = lane + 64 * i; if (q4 < 16 * PE_SVS / 4) ((uint4*)SV)[q4] = make_uint4(0u, 0u, 0u, 0u); }
    WAVE_LDS_FENCE();
#pragma unroll
    for (int r = 0; r < 4; ++r) {
      const int tk = 4 * lq + r;
      unsigned k[8];
#pragma unroll
      for (int nt = 0; nt < 8; ++nt) k[nt] = sortable_key(acc[nt][r], nt * 16 + lr);
      unsigned m1 = max(k[0], k[1]), m2 = min(k[0], k[1]);
#pragma unroll
      for (int nt = 2; nt < 8; ++nt) { m2 = max(m2, min(m1, k[nt])); m1 = max(m1, k[nt]); }
      const unsigned Ta = row16_min_u32(m1);
      const unsigned Tb = min(row16_kth_largest<11>(m1), row16_kth_largest<5>(m2));
      const unsigned T = max(Ta, Tb);
      int pos = 0;
#pragma unroll
      for (int nt = 0; nt < 8; ++nt) {
        const bool sel = k[nt] >= T;
        const unsigned long long bal = __ballot(sel);
        const unsigned grp16 = (unsigned)(bal >> (16 * lq)) & 0xffffu;
        const int below = __popc(grp16 & ((1u << lr) - 1u));
        if (sel) SV[tk * PE_SVS + pos + below] = k[nt];
        pos += __popc(grp16);
      }
      if (lr == 0) CN[tk] = pos;
    }
    WAVE_LDS_FENCE();
#pragma unroll 1
    for (int pass = 0; pass < 4; ++pass) {
      const int tk = pass * 4 + lq;
      const int cnt = CN[tk];
      const unsigned* row = SV + tk * PE_SVS;
      int cm = cnt;
      cm = max(cm, __shfl_xor(cm, 16)); cm = max(cm, __shfl_xor(cm, 32));
      const int cmax = __builtin_amdgcn_readfirstlane(cm);
      const int nblk = (cmax + 15) >> 4;
#pragma unroll 1
      for (int rd = 0; rd < nblk; ++rd) {
        const int j = rd * 16 + lr;
        const unsigned my = row[j];
        int rank = 0;
#pragma unroll 1
        for (int b4 = 0; b4 < nblk; ++b4) {
          const uint4 v0 = *(const uint4*)(row + b4 * 16), v1 = *(const uint4*)(row + b4 * 16 + 4);
          const uint4 v2 = *(const uint4*)(row + b4 * 16 + 8), v3 = *(const uint4*)(row + b4 * 16 + 12);
          rank += (v0.x > my) ? 1 : 0; rank += (v0.y > my) ? 1 : 0; rank += (v0.z > my) ? 1 : 0; rank += (v0.w > my) ? 1 : 0;
          rank += (v1.x > my) ? 1 : 0; rank += (v1.y > my) ? 1 : 0; rank += (v1.z > my) ? 1 : 0; rank += (v1.w > my) ? 1 : 0;
          rank += (v2.x > my) ? 1 : 0; rank += (v2.y > my) ? 1 : 0; rank += (v2.z > my) ? 1 : 0; rank += (v2.w > my) ? 1 : 0;
          rank += (v3.x > my) ? 1 : 0; rank += (v3.y > my) ? 1 : 0; rank += (v3.z > my) ? 1 : 0; rank += (v3.w > my) ? 1 : 0;
        }
        if (j < cnt && rank < 16) {
          TV[(tk * 16 + hd * 2 + pp) * 16 + rank] = key_value(my);
          TI[(tk * 16 + hd * 2 + pp) * 16 + rank] = 127 - (int)(my & 127u);
        }
      }
    }
    WAVE_LDS_FENCE();
  }
  {
    const int cab = ((const int*)(smem + PE_OFF_CT))[lane];
    const int cand_a = cab >> 4, cand_b = cab & 15;
    unsigned* CWt = SV;
    float vals[16];
#pragma unroll
    for (int tk = 0; tk < 16; ++tk) {
      float val = 0.f;
      unsigned key = 0u;
      if (cand_a >= 0) {
        val = TV[(tk * 16 + hd * 2 + 0) * 16 + cand_a] + TV[(tk * 16 + hd * 2 + 1) * 16 + cand_b];
        const unsigned bb = __float_as_uint(val);
        key = ((bb ^ ((unsigned)((int)bb >> 31) | 0x80000000u)) & ~63u) | (unsigned)(63 - lane);
      }
      vals[tk] = val;
      CWt[tk * 64 + lane] = key;
    }
    WAVE_LDS_FENCE();
#pragma unroll
    for (int tk = 0; tk < 16; ++tk) {
      const unsigned key = CWt[tk * 64 + lane];
      int rank = 0;
#pragma unroll
      for (int i4 = 0; i4 < 13; ++i4) {
        const uint4 v = *(const uint4*)(CWt + tk * 64 + i4 * 4);
        rank += (v.x > key) ? 1 : 0; rank += (v.y > key) ? 1 : 0; rank += (v.z > key) ? 1 : 0; rank += (v.w > key) ? 1 : 0;
      }
      if (cand_a >= 0 && rank < 16) {
        GT[tk * 128 + hd * 16 + rank] = vals[tk];
        EX[tk * 128 + hd * 16 + rank] = TI[(tk * 16 + hd * 2 + 0) * 16 + cand_a] * 128 + TI[(tk * 16 + hd * 2 + 1) * 16 + cand_b];
      }
    }
    WAVE_LDS_FENCE();
#pragma unroll
    for (int pass = 0; pass < 4; ++pass) {
      const int tk = pass * 4 + lq;
      const float g = GT[tk * 128 + hd * 16 + lr];
      const float mx = GT[tk * 128 + hd * 16];
      const float ev = __expf(g - mx);
      float s = ev;
      s += __shfl_xor(s, 1); s += __shfl_xor(s, 2); s += __shfl_xor(s, 4); s += __shfl_xor(s, 8);
      const int ex = EX[tk * 128 + hd * 16 + lr];
      GT[tk * 128 + hd * 16 + lr] = (ev / s) * VSC[ex];
      SU[tk * 128 + hd * 16 + lr] = USC[ex];
    }
    WAVE_LDS_FENCE();
  }
}

typedef float f32x32 __attribute__((ext_vector_type(32)));
typedef int i32x8 __attribute__((ext_vector_type(8)));
typedef int i32x6 __attribute__((ext_vector_type(6)));
typedef unsigned u32x6 __attribute__((ext_vector_type(6)));
#define FP4_AXPY8(O, off, P, W) {                                                                    \
  const f32x2 _q0 = __builtin_amdgcn_cvt_scalef32_pk_f32_fp4((W), 1.0f, 0), _q1 = __builtin_amdgcn_cvt_scalef32_pk_f32_fp4((W), 1.0f, 1); \
  const f32x2 _q2 = __builtin_amdgcn_cvt_scalef32_pk_f32_fp4((W), 1.0f, 2), _q3 = __builtin_amdgcn_cvt_scalef32_pk_f32_fp4((W), 1.0f, 3); \
  O[(off) + 0] = fmaf(P, _q0.x, O[(off) + 0]); O[(off) + 1] = fmaf(P, _q0.y, O[(off) + 1]);          \
  O[(off) + 2] = fmaf(P, _q1.x, O[(off) + 2]); O[(off) + 3] = fmaf(P, _q1.y, O[(off) + 3]);          \
  O[(off) + 4] = fmaf(P, _q2.x, O[(off) + 4]); O[(off) + 5] = fmaf(P, _q2.y, O[(off) + 5]);          \
  O[(off) + 6] = fmaf(P, _q3.x, O[(off) + 6]); O[(off) + 7] = fmaf(P, _q3.y, O[(off) + 7]); }
struct Fp6Row { uint4 a; uint2 b; };
typedef __bf16 bf16x32_t __attribute__((ext_vector_type(32)));
__device__ __forceinline__ bf16x32_t fp6_decode_bf16(const Fp6Row& r) {
  u32x6 w; w[0] = r.a.x; w[1] = r.a.y; w[2] = r.a.z; w[3] = r.a.w; w[4] = r.b.x; w[5] = r.b.y;
  return __builtin_amdgcn_cvt_scalef32_pk32_bf16_fp6(w, 1.0f);
}
__device__ __forceinline__ f32x32 fp6_decode(const Fp6Row& r) {
  u32x6 w; w[0] = r.a.x; w[1] = r.a.y; w[2] = r.a.z; w[3] = r.a.w; w[4] = r.b.x; w[5] = r.b.y;
  return __builtin_amdgcn_cvt_scalef32_pk32_f32_fp6(w, 1.0f);
}
__device__ __forceinline__ void peer_gather_token(const Params& p, int layer, char* smem, int tok, int tl, int buf, int lane, bool dowrite) {
  const bf16_t* H2 = (const bf16_t*)(p.ws + OFF_ACT);
  const char* U6 = p.ws + OFF_U + (size_t)layer * NEXP * RECB;
  const float* mod = (const float*)(p.ws + OFF_MOD) + (size_t)layer * 9 * 6144;
  const int* EX = (const int*)(smem + PE_OFF_EX) + buf * 16 * 128 + tl * 128;
  const float* GT = (const float*)(smem + PE_OFF_GT) + buf * 16 * 128 + tl * 128;
  const float* SU = (const float*)(smem + PE_OFF_SU) + buf * 16 * 128 + tl * 128;
  const int l = lane & 31, hf = lane >> 5;
  float acc[32];
  const int wv = __builtin_amdgcn_readfirstlane(threadIdx.x >> 6);
  unsigned char* XB = (unsigned char*)(smem + PE_OFF_SV) + wv * 16 * PE_SVS * 4;
  float* WD = (float*)(XB + 1024);
#define PE_LOADV(VV, PI) VV = *(const uint4*)(U6 + (size_t)EX[2 * (PI) + hf] * RECB + ROWB + l * 16);
  uint4 v0, v1, v2, v3, v4, v5, v6, v7, v8, v9, v10, v11, v12, v13, v14, v15;
  const int e16 = lane & 15, kg = lane >> 4;
  uint4 qa[8], qb[8], qc[8];
#define PE_LOADA(Q, EB) { const char* up = U6 + (size_t)EX[(EB) * 16 + e16] * RECB + 16 * kg;              \
    _Pragma("unroll") for (int i = 0; i < 8; ++i) Q[i] = *(const uint4*)(up + 64 * i); }
  PE_LOADA(qa, 0) PE_LOADA(qb, 1)
  float xscale;
  {
    const bf16_t* hr = H2 + (size_t)tok * 1024 + lane * 16;
    const uint4 a = *(const uint4*)hr, b2 = *(const uint4*)(hr + 8);
    float xv[16];
    UNPACK8(xv, 0, a) UNPACK8(xv, 8, b2)
    float mx = 0.f;
#pragma unroll
    for (int i = 0; i < 16; ++i) mx = fmaxf(mx, fabsf(xv[i]));
#pragma unroll
    for (int o = 1; o < 64; o <<= 1) mx = fmaxf(mx, __shfl_xor(mx, o));
    xscale = mx > 0.f ? mx * (1.f / 7.5f) : 1.f;
    const float inv = 1.f / xscale;
    unsigned w0 = 0u, w1 = 0u, w2 = 0u;
#pragma unroll
    for (int i = 0; i < 16; ++i) {
      const float av = fminf(fabsf(xv[i]) * inv, 7.5f);
      float c;
      if (av < 2.f) c = rintf(av * 8.f);
      else if (av < 4.f) c = 16.f + rintf((av - 2.f) * 4.f);
      else c = 24.f + rintf((av - 4.f) * 2.f);
      unsigned code = (unsigned)c;
      code = code > 31u ? 31u : code;
      code |= (xv[i] < 0.f) ? 32u : 0u;
      const int bit = 6 * i, wd = bit >> 5, sh = bit & 31;
      if (wd == 0) w0 |= code << sh; else if (wd == 1) w1 |= code << sh; else w2 |= code << sh;
      if (sh > 26) { if (wd == 0) w1 |= code >> (32 - sh); else if (wd == 1) w2 |= code >> (32 - sh); }
    }
    unsigned* xo = (unsigned*)(XB + lane * 12);
    xo[0] = w0; xo[1] = w1; xo[2] = w2;
  }
  WAVE_LDS_FENCE();
  {
    i32x8 Bx[8];
#pragma unroll
    for (int kb = 0; kb < 8; ++kb) {
      const uint2* bp = (const uint2*)(XB + 192 * kg + 24 * kb);
      const uint2 b0 = bp[0], b1 = bp[1], b2 = bp[2];
      Bx[kb] = (i32x8){(int)b0.x, (int)b0.y, (int)b1.x, (int)b1.y, (int)b2.x, (int)b2.y, 0, 0};
    }
#define PE_MMAU(Q, EB) {                                                                                     \
    f32x4 dacc = {0.f, 0.f, 0.f, 0.f};                                                                       \
    _Pragma("unroll") for (int kb = 0; kb < 8; ++kb) {                                                       \
      const i32x8 av = {(int)Q[kb].x, (int)Q[kb].y, (int)Q[kb].z, (int)Q[kb].w, 0, 0, 0, 0};                 \
      dacc = __builtin_amdgcn_mfma_scale_f32_16x16x128_f8f6f4(av, Bx[kb], dacc, 4, 2, 0, 0x7f7f7f7f, 0, 0x7f7f7f7f); \
    }                                                                                                        \
    asm volatile("" : "+v"(dacc));        \
    if (e16 == 0) *(float4*)(WD + (EB) * 16 + 4 * kg) = (float4){dacc[0], dacc[1], dacc[2], dacc[3]};        \
  }
    PE_LOADA(qc, 2) PE_MMAU(qa, 0)
    PE_LOADA(qa, 3) PE_MMAU(qb, 1)
    PE_LOADA(qb, 4) PE_MMAU(qc, 2)
    PE_LOADA(qc, 5) PE_MMAU(qa, 3)
    PE_LOADA(qa, 6) PE_MMAU(qb, 4)
    PE_LOADA(qb, 7) PE_MMAU(qc, 5)
    PE_LOADV(v0, 0) PE_LOADV(v1, 1) PE_LOADV(v2, 2) PE_LOADV(v3, 3) PE_LOADV(v4, 4) PE_LOADV(v5, 5) PE_MMAU(qa, 6)
    PE_LOADV(v6, 6) PE_LOADV(v7, 7) PE_LOADV(v8, 8) PE_LOADV(v9, 9) PE_LOADV(v10, 10) PE_LOADV(v11, 11) PE_MMAU(qb, 7)
    PE_LOADV(v12, 12) PE_LOADV(v13, 13) PE_LOADV(v14, 14) PE_LOADV(v15, 15)
  }
  WAVE_LDS_FENCE();
#pragma unroll
  for (int q = 0; q < 2; ++q) {
    const int e = lane + 64 * q;
    WD[e] = GT[e] * gelu_erf(WD[e] * SU[e] * xscale);
  }
  WAVE_LDS_FENCE();
#pragma unroll
  for (int i = 0; i < 32; ++i) acc[i] = 0.f;
  int one = 1;
  asm volatile("" : "+s"(one));
  const int b = tok < NLAT ? (tok >> 12) : 8;
  float* xr = tok < NLAT ? p.out + (size_t)tok * 1024 : (float*)(p.ws + OFF_CTXB) + (size_t)(tok - NLAT) * 1024;
  const float* gate = mod + (size_t)b * 6144 + 5 * 1024;
  float4 xv4[4], gv4[4];
#pragma unroll
  for (int jj = 0; jj < 4; ++jj) {
    const int c = (l + 32 * (4 * hf + jj)) * 4;
    xv4[jj] = *(const float4*)(xr + c);
    gv4[jj] = *(const float4*)(gate + c);
  }
#define PE_USEV(VV, PI)                                                               \
  _Pragma("unroll 1") for (int rep_ = 0; rep_ < one; ++rep_) {                        \
    const float w = WD[2 * (PI) + hf];                                                \
    FP4_AXPY8(acc, 0, w, VV.x) FP4_AXPY8(acc, 8, w, VV.y) FP4_AXPY8(acc, 16, w, VV.z) FP4_AXPY8(acc, 24, w, VV.w) \
  }
#pragma unroll 1
  for (int pi = 0; pi < 48; pi += 16) {
    PE_USEV(v0, pi + 0) PE_LOADV(v0, pi + 16)
    PE_USEV(v1, pi + 1) PE_LOADV(v1, pi + 17)
    PE_USEV(v2, pi + 2) PE_LOADV(v2, pi + 18)
    PE_USEV(v3, pi + 3) PE_LOADV(v3, pi + 19)
    PE_USEV(v4, pi + 4) PE_LOADV(v4, pi + 20)
    PE_USEV(v5, pi + 5) PE_LOADV(v5, pi + 21)
    PE_USEV(v6, pi + 6) PE_LOADV(v6, pi + 22)
    PE_USEV(v7, pi + 7) PE_LOADV(v7, pi + 23)
    PE_USEV(v8, pi + 8) PE_LOADV(v8, pi + 24)
    PE_USEV(v9, pi + 9) PE_LOADV(v9, pi + 25)
    PE_USEV(v10, pi + 10) PE_LOADV(v10, pi + 26)
    PE_USEV(v11, pi + 11) PE_LOADV(v11, pi + 27)
    PE_USEV(v12, pi + 12) PE_LOADV(v12, pi + 28)
    PE_USEV(v13, pi + 13) PE_LOADV(v13, pi + 29)
    PE_USEV(v14, pi + 14) PE_LOADV(v14, pi + 30)
    PE_USEV(v15, pi + 15) PE_LOADV(v15, pi + 31)
  }
  PE_USEV(v0, 48) PE_USEV(v1, 49) PE_USEV(v2, 50) PE_USEV(v3, 51) PE_USEV(v4, 52) PE_USEV(v5, 53) PE_USEV(v6, 54) PE_USEV(v7, 55) PE_USEV(v8, 56) PE_USEV(v9, 57) PE_USEV(v10, 58) PE_USEV(v11, 59) PE_USEV(v12, 60) PE_USEV(v13, 61) PE_USEV(v14, 62) PE_USEV(v15, 63)
#pragma unroll
  for (int k = 0; k < 32; ++k) acc[k] += __shfl_xor(acc[k], 32);
  float4 xn[4];
  float ss = 0.f;
#pragma unroll
  for (int jj = 0; jj < 4; ++jj) {
    const int c = (l + 32 * (4 * hf + jj)) * 4;
    const float4 xv = xv4[jj];
    const float4 gv = gv4[jj];
    const float a0 = hf ? acc[16 + 4 * jj + 0] : acc[4 * jj + 0], a1 = hf ? acc[16 + 4 * jj + 1] : acc[4 * jj + 1];
    const float a2 = hf ? acc[16 + 4 * jj + 2] : acc[4 * jj + 2], a3 = hf ? acc[16 + 4 * jj + 3] : acc[4 * jj + 3];
    xn[jj].x = xv.x + gv.x * a0; xn[jj].y = xv.y + gv.y * a1; xn[jj].z = xv.z + gv.z * a2; xn[jj].w = xv.w + gv.w * a3;
    ss += xn[jj].x * xn[jj].x + xn[jj].y * xn[jj].y + xn[jj].z * xn[jj].z + xn[jj].w * xn[jj].w;
  }
  ss = wave_sum(ss);
  const float rinv = rsqrtf(ss * (1.f / 1024.f) + EPS);
  if (layer == 0) {
    const float* mod1 = (const float*)(p.ws + OFF_MOD) + (size_t)9 * 6144 + (size_t)b * 6144;
    const float* g1 = p.norm1_g + 1024;
    bf16_t* act = (bf16_t*)(p.ws + OFF_ACT) + (size_t)tok * 1024;
#pragma unroll
    for (int jj = 0; jj < 4; ++jj) {
      const int c = (l + 32 * (4 * hf + jj)) * 4;
      if (dowrite) *(float4*)(xr + c) = xn[jj]; else asm volatile("" :: "v"(xn[jj].x), "v"(xn[jj].y), "v"(xn[jj].z), "v"(xn[jj].w));
      const float4 gg4 = *(const float4*)(g1 + c);
      const float4 sh = *(const float4*)(mod1 + c);
      const float4 sc = *(const float4*)(mod1 + 1024 + c);
      uint2 o;
      o.x = pack2h(xn[jj].x * rinv * gg4.x * (1.f + sc.x) + sh.x, xn[jj].y * rinv * gg4.y * (1.f + sc.y) + sh.y);
      o.y = pack2h(xn[jj].z * rinv * gg4.z * (1.f + sc.z) + sh.z, xn[jj].w * rinv * gg4.w * (1.f + sc.w) + sh.w);
      if (dowrite) *(uint2*)(act + c) = o; else asm volatile("" :: "v"(o.x), "v"(o.y));
    }
  } else {
#pragma unroll
    for (int jj = 0; jj < 4; ++jj) {
      const int c = (l + 32 * (4 * hf + jj)) * 4;
      const float4 gg4 = *(const float4*)(p.final_g + c);
      float4 o;
      o.x = xn[jj].x * rinv * gg4.x; o.y = xn[jj].y * rinv * gg4.y; o.z = xn[jj].z * rinv * gg4.z; o.w = xn[jj].w * rinv * gg4.w;
      if (dowrite) *(float4*)(xr + c) = o; else asm volatile("" :: "v"(o.x), "v"(o.y), "v"(o.z), "v"(o.w));
    }
  }
}

__device__ __forceinline__ void phase_peer(const Params& p, int layer, char* smem, int ntok, bool dowrite = true) {
  const int tid = opaque_tid(), lane = tid & 63, wave = __builtin_amdgcn_readfirstlane(tid >> 6);
  __syncthreads();
  if (tid < 64) {
    int cab = -1, c = 0;
    for (int a = 0; a < 16; ++a)
      for (int bb = 0; bb < 16; ++bb)
        if ((a + 1) * (bb + 1) <= 16) { if (c == tid) cab = a * 16 + bb; ++c; }
    ((int*)(smem + PE_OFF_CT))[tid] = cab;
  }
  const int ngroups = ntok / 16, G = gridDim.x, g0 = opaque_bid();
  if (tid == 0) { ((int*)(smem + PE_OFF_TQ))[0] = 0; ((int*)(smem + PE_OFF_TQ))[1] = 0; }
  __syncthreads();
  const int R = ngroups / G, rem = ngroups % G;
  const bool split = rem > 0 && 2 * rem <= G;
#define PE_ITEM(r_, grp_, off_, cnt_)                                                                  \
  { grp_ = 0; off_ = 0; cnt_ = 0;                                                                      \
    if ((r_) >= 0 && (r_) < R) { grp_ = g0 + (r_) * G; cnt_ = 16; }                                    \
    else if ((r_) == R) {                                                                              \
      if (split) { if (g0 < 2 * rem) { grp_ = R * G + (g0 >> 1); off_ = (g0 & 1) * 8; cnt_ = 8; } }    \
      else if (g0 < rem) { grp_ = R * G + g0; cnt_ = 16; }                                             \
    } }
#pragma unroll 1
  for (int r = -1;; ++r) {
    int cur, coff, ngat, nxt, noff, ncnt;
    PE_ITEM(r, cur, coff, ngat)
    PE_ITEM(r + 1, nxt, noff, ncnt)
    const int nsel = ncnt > 0 ? 8 : 0;
    if (ngat + nsel == 0) break;
    const int b = r & 1, gper = ngat >> 3, sfirst = (wave & 1) == 0;
#pragma unroll 1
    for (int st = 0; st < 3; ++st) {
      const int slot = sfirst ? st : (st + 1) % 3;
      if (slot == 0) { if (nsel) peer_select_head(p, layer, smem, nxt * 16, wave, wave, b ^ 1, lane); }
      else if (slot - 1 < gper) {
        const int idx = wave * gper + slot - 1;
        peer_gather_token(p, layer, smem, cur * 16 + coff + idx, coff + idx, b, lane, dowrite);
      }
    }
    __syncthreads();
  }
}

template <int layer>
__device__ __forceinline__ void layer_body(const Params& p, char* smem, const XcdBarrier& xb) {
  constexpr bool nc = layer == 0;
  const float* xin = layer == 0 ? p.x : (const float*)p.out;
  if (layer == 0) {
    phase_norm(p, layer, 0, xin, NTOK);
    xcd_barrier(xb);
  }
#if REP_GEMM
  gemm_phase2<EPI_INPROJ>(p, layer, smem, (const bf16_t*)(p.ws + OFF_ACT), (const bf16_t*)(p.ws + OFF_WIN) + (size_t)layer * 3072 * 1024, NTOK, 3072, nullptr);
  xcd_barrier(xb);
#endif
  gemm_phase2<EPI_INPROJ>(p, layer, smem, (const bf16_t*)(p.ws + OFF_ACT), (const bf16_t*)(p.ws + OFF_WIN) + (size_t)layer * 3072 * 1024, NTOK, 3072, nullptr);
  xcd_barrier(xb);
#if REP_MIX1
  phase_mix1(p, layer, smem, 2);
  xcd_barrier(xb);
#endif
  phase_mix1(p, layer, smem);
  xcd_barrier(xb);
  phase_ret_scan(p, layer);
  xcd_barrier(xb);
#if REP_MIX2
  phase_mix2(p, layer, smem, 3);
  xcd_barrier(xb);
#endif
  phase_mix2(p, layer, smem);
  xcd_barrier(xb);
  gemm_phase2<EPI_OUTPROJ>(p, layer, smem, (const bf16_t*)(p.ws + OFF_ACT), (const bf16_t*)(p.ws + OFF_WOUT) + (size_t)layer * 1024 * 1024, nc ? NTOK : NLAT, 1024, xin);
  xcd_barrier(xb);
  phase_norm(p, layer, 1, (const float*)p.out, nc ? NTOK : NLAT);
  xcd_barrier(xb);
  gemm_phase2<EPI_PLAIN>(p, layer, smem, (const bf16_t*)(p.ws + OFF_ACT), (const bf16_t*)(p.ws + OFF_WQ) + (size_t)layer * 2048 * 1024, nc ? NTOK : NLAT, 2048, nullptr);
  xcd_barrier(xb);
#if REP_PEER
  phase_peer(p, layer, smem, nc ? NTOK : NLAT, false);
  xcd_barrier(xb);
#endif
  phase_peer(p, layer, smem, nc ? NTOK : NLAT);
  if (layer == 0) xcd_barrier(xb);
}

__global__ void __launch_bounds__(512) fwd_megakernel(Params p) {
  cg::grid_group grid = cg::this_grid();
  extern __shared__ __attribute__((aligned(16))) char smem[];
  volatile LAS3 unsigned* xst = (volatile LAS3 unsigned*)(smem + LDS_BCAST + 8);
  if (threadIdx.x == 0) { xst[0] = 0u; xst[1] = 0u; }
  phase_prep(p, smem);
  for (int it = blockIdx.x; it < 256; it += gridDim.x) uv_convert_item(p, it);
  grid.sync();
  const XcdBarrier xb = xcd_barrier_post((unsigned*)(p.ws + OFF_XBAR), xst);
  layer_body<0>(p, smem, xb);
  layer_body<1>(p, smem, xb);
}

extern "C" void kernel_launch(void* const* d_in, const int* in_sizes, int n_in, void* d_out,
                              int out_size, void* d_ws, size_t ws_size, hipStream_t stream) {
  constexpr size_t kDynLds = LDS_BYTES;
  static int grid_blocks = 0;
  if (!grid_blocks) {
    int dev = 0, cus = 0, per_cu = 0;
    (void)hipGetDevice(&dev);
    (void)hipDeviceGetAttribute(&cus, hipDeviceAttributeMultiprocessorCount, dev);
    (void)hipFuncSetAttribute((const void*)fwd_megakernel, hipFuncAttributeMaxDynamicSharedMemorySize, (int)kDynLds);
    (void)hipOccupancyMaxActiveBlocksPerMultiprocessor(&per_cu, fwd_megakernel, 512, kDynLds);
    if (per_cu < 1) { fprintf(stderr, "occupancy query says %d blocks/CU\n", per_cu); per_cu = 1; }
    grid_blocks = cus;
    if (ws_size < WS_END) fprintf(stderr, "workspace too small: %zu < %zu\n", ws_size, (size_t)WS_END);
  }
  Params p{};
  p.x = (const float*)d_in[0]; p.c = (const float*)d_in[1]; p.ctx = (const float*)d_in[2]; p.c_ctx = (const float*)d_in[3];
  p.w_ada = (const float*)d_in[4]; p.b_ada = (const float*)d_in[5]; p.norm1_g = (const float*)d_in[6]; p.w_in = (const float*)d_in[7];
  p.na_rpb = (const float*)d_in[8]; p.diff_lambda = (const float*)d_in[9]; p.diff_subln_g = (const float*)d_in[10];
  p.ret_decay_logit = (const float*)d_in[11]; p.w_out = (const float*)d_in[12]; p.norm2_g = (const float*)d_in[13];
  p.peer_wq = (const float*)d_in[14]; p.peer_subkeys = (const float*)d_in[15]; p.peer_u = (const float*)d_in[16];
  p.peer_v = (const float*)d_in[17]; p.final_g = (const float*)d_in[18];
  p.out = (float*)d_out; p.ws = (char*)d_ws;
  void* args[] = {&p};
  hipError_t e = hipLaunchCooperativeKernel((void*)fwd_megakernel, dim3(grid_blocks), dim3(512), args, kDynLds, stream);
  if (e != hipSuccess) fprintf(stderr, "cooperative launch failed: %s (grid %d)\n", hipGetErrorString(e), grid_blocks);
}
```

```cpp
#include <hip/hip_runtime.h>
#include <hip/hip_cooperative_groups.h>
#include <cstdio>
#include <cstdint>
namespace cg = cooperative_groups;

typedef unsigned short bf16_t;
typedef short bf16x8 __attribute__((ext_vector_type(8)));
typedef float f32x4 __attribute__((ext_vector_type(4)));

constexpr int DM = 1024, BATCH = 8, SEQ = 4096, LCTX = 256;
constexpr int NLAT = BATCH * SEQ;
constexpr int NCTX = BATCH * LCTX;
constexpr int NTOK = NLAT + NCTX;
constexpr int INC = 3072;
constexpr int C_NAQ = 0, C_NAK = 256, C_NAV = 512, C_DFQ = 768, C_DFK = 1024, C_DFV = 1280,
              C_RTQ = 1536, C_RTK = 1792, C_RTV = 2048, C_RTG = 2560;
constexpr int Y_NA = 0, Y_DF = 256, Y_RT = 512;
constexpr int NEXP = 16384;
constexpr float EPS = 1e-6f;

constexpr size_t OFF_CTL  = 0;
constexpr size_t OFF_MISC = 4096;
constexpr size_t OFF_ROPE = 8192;
constexpr size_t OFF_MOD  = OFF_ROPE + 12288;
constexpr size_t SZ_MOD   = 2ull * 9 * 6144 * 4;
constexpr size_t OFF_WIN  = OFF_MOD + SZ_MOD;
constexpr size_t SZ_WIN   = 2ull * 3072 * 1024 * 2;
constexpr size_t OFF_WOUT = OFF_WIN + SZ_WIN;
constexpr size_t SZ_WOUT  = 2ull * 1024 * 1024 * 2;
constexpr size_t OFF_WQ   = OFF_WOUT + SZ_WOUT;
constexpr size_t SZ_WQ    = 2ull * 2048 * 1024 * 2;
constexpr size_t OFF_SUBK = OFF_WQ + SZ_WQ;
constexpr size_t SZ_SUBK  = 2ull * 262144 * 2;
constexpr size_t OFF_U    = OFF_SUBK + SZ_SUBK;
constexpr int    ROWB     = 512;
constexpr int    ROWV     = 512;
constexpr int    RECB     = ROWB + ROWV;
constexpr size_t SZ_UV    = 2ull * NEXP * ROWB;
constexpr size_t OFF_V    = OFF_U + SZ_UV;
constexpr size_t OFF_USC  = OFF_V + SZ_UV;
constexpr size_t OFF_VSC  = OFF_USC + 2ull * NEXP * 4;
constexpr size_t OFF_ACT  = OFF_VSC + 2ull * NEXP * 4;
constexpr size_t SZ_ACT   = (size_t)NTOK * 1024 * 2;
constexpr size_t OFF_P    = OFF_ACT + SZ_ACT;
constexpr size_t SZ_P     = (size_t)NTOK * 3072 * 2;
constexpr size_t OFF_CTXB = OFF_P + SZ_P;
constexpr size_t SZ_CTXB  = (size_t)NCTX * 1024 * 4;
constexpr size_t OFF_RKV  = OFF_CTXB + SZ_CTXB;
constexpr size_t SZ_RKV   = 64ull * 32 * 8192 * 4;
constexpr size_t OFF_RS   = OFF_RKV + SZ_RKV;
constexpr size_t SZ_RS    = 64ull * 8192 * 4;
constexpr size_t OFF_XBAR = OFF_RS + SZ_RS;
constexpr size_t WS_END   = OFF_XBAR + 16384;

#ifndef REP_MIX1
#define REP_MIX1 0
#endif
#ifndef REP_MIX2
#define REP_MIX2 0
#endif
#ifndef REP_PEER
#define REP_PEER 0
#endif
#ifndef REP_GEMM
#define REP_GEMM 0
#endif
constexpr int LDS_BYTES = 152 * 1024;
constexpr int LDS_BCAST = LDS_BYTES - 16;

struct Params {
  const float *x, *c, *ctx, *c_ctx, *w_ada, *b_ada, *norm1_g, *w_in, *na_rpb, *diff_lambda, *diff_subln_g,
              *ret_decay_logit, *w_out, *norm2_g, *peer_wq, *peer_subkeys, *peer_u, *peer_v, *final_g;
  float* out;
  char* ws;
};

__device__ __forceinline__ float bf2f(bf16_t v) { return __uint_as_float(((unsigned)v) << 16); }
__device__ __forceinline__ bf16_t f2bf(float f) {
  unsigned u = __float_as_uint(f);
  u += 0x7fffu + ((u >> 16) & 1u);
  return (bf16_t)(u >> 16);
}
__device__ __forceinline__ unsigned pack2(float a, float b) { return (unsigned)f2bf(a) | ((unsigned)f2bf(b) << 16); }
typedef __bf16 bf16x2_t __attribute__((ext_vector_type(2)));
typedef float f32x2_t __attribute__((ext_vector_type(2)));
__device__ __forceinline__ unsigned pack2h(float a, float b) {
  const f32x2_t v = {a, b};
  return __builtin_bit_cast(unsigned, __builtin_convertvector(v, bf16x2_t));
}
__device__ __forceinline__ float lo16(unsigned w) { return __uint_as_float(w << 16); }
__device__ __forceinline__ float hi16(unsigned w) { return __uint_as_float(w & 0xffff0000u); }
#define DPP_ADD(v, CTRL) ((v) + __int_as_float(__builtin_amdgcn_update_dpp(0, __float_as_int(v), (CTRL), 0xf, 0xf, true)))
__device__ __forceinline__ float row16_sum(float v) {
  v = DPP_ADD(v, 0xB1);
  v = DPP_ADD(v, 0x4E);
  v = DPP_ADD(v, 0x141);
  v = DPP_ADD(v, 0x140);
  return v;
}
#define DPP_MOVU(v, CTRL) ((unsigned)__builtin_amdgcn_update_dpp(0, (int)(v), (CTRL), 0xf, 0xf, true))
__device__ __forceinline__ unsigned row16_max_u32(unsigned v) {
  v = max(v, DPP_MOVU(v, 0xB1)); v = max(v, DPP_MOVU(v, 0x4E)); v = max(v, DPP_MOVU(v, 0x141)); v = max(v, DPP_MOVU(v, 0x140));
  return v;
}
__device__ __forceinline__ unsigned row16_min_u32(unsigned v) {
  v = min(v, DPP_MOVU(v, 0xB1)); v = min(v, DPP_MOVU(v, 0x4E)); v = min(v, DPP_MOVU(v, 0x141)); v = min(v, DPP_MOVU(v, 0x140));
  return v;
}
template <int KTH>
__device__ __forceinline__ unsigned row16_kth_largest(unsigned v) {
  int cnt = 0;
#define R8_STEP(N) { const unsigned o = DPP_MOVU(v, 0x120 + (N)); cnt += (o > v) ? 1 : 0; }
  R8_STEP(1) R8_STEP(2) R8_STEP(3) R8_STEP(4) R8_STEP(5) R8_STEP(6) R8_STEP(7) R8_STEP(8)
  R8_STEP(9) R8_STEP(10) R8_STEP(11) R8_STEP(12) R8_STEP(13) R8_STEP(14) R8_STEP(15)
#undef R8_STEP
  return row16_max_u32(cnt >= KTH - 1 ? v : 0u);
}
__device__ __forceinline__ float wave_sum(float v) {
  v = row16_sum(v);
  const int iv = __float_as_int(v);
  const float a = __int_as_float(__builtin_amdgcn_readlane(iv, 0)), b = __int_as_float(__builtin_amdgcn_readlane(iv, 16));
  const float c = __int_as_float(__builtin_amdgcn_readlane(iv, 32)), d = __int_as_float(__builtin_amdgcn_readlane(iv, 48));
  return (a + b) + (c + d);
}
__device__ __forceinline__ float siluf(float x) { return x / (1.f + __expf(-x)); }

__device__ __forceinline__ int opaque_tid() { int t = threadIdx.x; asm volatile("" : "+v"(t)); return t; }
__device__ __forceinline__ int opaque_bid() { int t = blockIdx.x; asm volatile("" : "+s"(t)); return t; }

#define DOT8(acc, Q, off, U)                                                              \
  acc = fmaf(Q[(off) + 0], lo16((U).x), acc); acc = fmaf(Q[(off) + 1], hi16((U).x), acc); \
  acc = fmaf(Q[(off) + 2], lo16((U).y), acc); acc = fmaf(Q[(off) + 3], hi16((U).y), acc); \
  acc = fmaf(Q[(off) + 4], lo16((U).z), acc); acc = fmaf(Q[(off) + 5], hi16((U).z), acc); \
  acc = fmaf(Q[(off) + 6], lo16((U).w), acc); acc = fmaf(Q[(off) + 7], hi16((U).w), acc);
#define AXPY8(O, off, P, U)                                                                   \
  O[(off) + 0] = fmaf(P, lo16((U).x), O[(off) + 0]); O[(off) + 1] = fmaf(P, hi16((U).x), O[(off) + 1]); \
  O[(off) + 2] = fmaf(P, lo16((U).y), O[(off) + 2]); O[(off) + 3] = fmaf(P, hi16((U).y), O[(off) + 3]); \
  O[(off) + 4] = fmaf(P, lo16((U).z), O[(off) + 4]); O[(off) + 5] = fmaf(P, hi16((U).z), O[(off) + 5]); \
  O[(off) + 6] = fmaf(P, lo16((U).w), O[(off) + 6]); O[(off) + 7] = fmaf(P, hi16((U).w), O[(off) + 7]);
#define UNPACK8(Q, off, U)                                                  \
  Q[(off) + 0] = lo16((U).x); Q[(off) + 1] = hi16((U).x); Q[(off) + 2] = lo16((U).y); Q[(off) + 3] = hi16((U).y); \
  Q[(off) + 4] = lo16((U).z); Q[(off) + 5] = hi16((U).z); Q[(off) + 6] = lo16((U).w); Q[(off) + 7] = hi16((U).w);

__device__ __forceinline__ int next_item(unsigned* counter, char* smem) {
  volatile int* bc = (volatile int*)(smem + LDS_BCAST);
  __syncthreads();
  if (threadIdx.x == 0) *bc = (int)atomicAdd(counter, 1u);
  __syncthreads();
  return *bc;
}

#define XB_TMO      128
#define XB_XCNT(j)  (256  + 64 * (j))
#define XB_XSUB(j)  (1280 + 64 * (j))
#define XB_XGEN(j)  (2304 + 64 * (j))
#define XB_TOP      3328
#define XB_TOPGEN   3392
#define XCD_BAR_WORDS 3456
#define XB_SPIN_CAP (1u << 18)
#define LAS3 __attribute__((address_space(3)))
__device__ __forceinline__ unsigned xb_ld(unsigned* p)              { return __hip_atomic_load(p, __ATOMIC_RELAXED, __HIP_MEMORY_SCOPE_AGENT); }
__device__ __forceinline__ unsigned xb_add(unsigned* p, unsigned v) { return __hip_atomic_fetch_add(p, v, __ATOMIC_RELAXED, __HIP_MEMORY_SCOPE_AGENT); }
__device__ __forceinline__ unsigned xb_xcc_id() { return (unsigned)__builtin_amdgcn_s_getreg((3 << 11) | 20) & 0xFu; }
#define XB_SPIN(cond, bar) do { unsigned _sp = 0; while (cond) { __builtin_amdgcn_s_sleep(1); \
    if ((++_sp & 255u) == 0u) { if (xb_ld(&(bar)[XB_TMO])) break; if (_sp > XB_SPIN_CAP) { atomicAdd(&(bar)[XB_TMO], 1u); break; } } } } while (0)
struct XcdBarrier { unsigned* bar; unsigned x; volatile LAS3 unsigned* st; };
__device__ __forceinline__ XcdBarrier xcd_barrier_post(unsigned* bar, volatile LAS3 unsigned* st) {
  XcdBarrier b; b.bar = bar; b.x = xb_xcc_id(); b.st = st;
  if (threadIdx.x == 0) (void)xb_add(&bar[XB_XCNT(b.x)], 1u);
  return b;
}
__device__ __forceinline__ void xcd_barrier_complete(unsigned* bar, unsigned x, unsigned& nloc, unsigned& nx) {
  const unsigned G = gridDim.x * gridDim.y * gridDim.z;
  unsigned sum, cnt, mine, sp = 0u;
  for (;;) {
    sum = 0u; cnt = 0u; mine = 0u;
#pragma unroll
    for (unsigned j = 0; j < 16; ++j) { const unsigned c = xb_ld(&bar[XB_XCNT(j)]); sum += c; cnt += (c > 0u) ? 1u : 0u; mine = (j == x) ? c : mine; }
    if (sum == G) break;
    __builtin_amdgcn_s_sleep(1);
    if ((++sp & 255u) == 0u) { if (xb_ld(&bar[XB_TMO])) break; if (sp > XB_SPIN_CAP) { atomicAdd(&bar[XB_TMO], 1u); break; } }
  }
  nloc = mine > 0u ? mine : 1u; nx = cnt > 0u ? cnt : 1u;
}
__device__ __forceinline__ void xcd_barrier(const XcdBarrier& b) {
  asm volatile("s_waitcnt vmcnt(0)" ::: "memory");
  __syncthreads();
  if (threadIdx.x == 0) {
    unsigned* bar = b.bar;
    __builtin_amdgcn_s_waitcnt(0);
    unsigned nloc = b.st[0], nx = b.st[1];
    if (nloc == 0u) { xcd_barrier_complete(bar, b.x, nloc, nx); b.st[0] = nloc; b.st[1] = nx; }
    const unsigned old = xb_add(&bar[XB_XSUB(b.x)], 1u);
    const unsigned gen = old / nloc;
    if (old + 1u == (gen + 1u) * nloc) {
      __builtin_amdgcn_fence(__ATOMIC_RELEASE, "agent");
      asm volatile("s_waitcnt vmcnt(0)" ::: "memory");
      const unsigned og = xb_add(&bar[XB_TOP], 1u);
      const unsigned tg = og / nx;
      if (og + 1u == (tg + 1u) * nx) xb_add(&bar[XB_TOPGEN], 1u);
      else XB_SPIN(xb_ld(&bar[XB_TOPGEN]) == tg, bar);
      __builtin_amdgcn_fence(__ATOMIC_ACQUIRE, "agent");
      xb_add(&bar[XB_XGEN(b.x)], 1u);
      asm volatile("s_waitcnt vmcnt(0)" ::: "memory");
    } else {
      XB_SPIN(xb_ld(&bar[XB_XGEN(b.x)]) == gen, bar);
      __builtin_amdgcn_fence(__ATOMIC_ACQUIRE, "agent");
      asm volatile("s_waitcnt vmcnt(0)" ::: "memory");
    }
  }
  __syncthreads();
}

__device__ __forceinline__ void transpose_item(const float* src, bf16_t* dst, int K, int N, int item, char* smem) {
  float* t = (float*)smem;
  const int nb = N / 64;
  const int k0 = (item / nb) * 64, n0 = (item % nb) * 64;
  const int tid = opaque_tid();
  __syncthreads();
#pragma unroll
  for (int i = 0; i < 8; ++i) {
    const int k = (tid >> 6) + 8 * i, n = tid & 63;
    t[k * 65 + n] = src[(size_t)(k0 + k) * N + n0 + n];
  }
  __syncthreads();
#pragma unroll
  for (int i = 0; i < 8; ++i) {
    const int n = (tid >> 6) + 8 * i, k = tid & 63;
    dst[(size_t)(n0 + n) * K + k0 + k] = f2bf(t[k * 65 + n]);
  }
}

__device__ __forceinline__ void convert_flat(const float* src, bf16_t* dst, size_t n4) {
  const size_t gt = (size_t)opaque_bid() * blockDim.x + opaque_tid(), gs = (size_t)gridDim.x * blockDim.x;
  for (size_t i = gt; i < n4; i += gs) {
    const float4 v = ((const float4*)src)[i];
    uint2 o; o.x = pack2h(v.x, v.y); o.y = pack2h(v.z, v.w);
    ((uint2*)dst)[i] = o;
  }
}

__device__ __forceinline__ void phase_prep(const Params& p, char* smem) {
  const int tid = opaque_tid();
  char* ws = p.ws;
  if (opaque_bid() == 0) {
    unsigned* ctl = (unsigned*)(ws + OFF_CTL);
    if (tid < 64) ctl[tid] = 0u;
    unsigned* xbar = (unsigned*)(ws + OFF_XBAR);
    for (int i = tid; i < XCD_BAR_WORDS; i += 512) xbar[i] = 0u;
    float* misc = (float*)(ws + OFF_MISC);
    if (tid < 2) {
      const float* lp = p.diff_lambda + tid * 128;
      float s01 = 0.f, s23 = 0.f;
      for (int i = 0; i < 32; ++i) { s01 += lp[i] * lp[32 + i]; s23 += lp[64 + i] * lp[96 + i]; }
      const float lam_init = 0.8f - 0.6f * expf(-0.3f * (float)tid);
      misc[tid] = expf(s01) - expf(s23) + lam_init;
      misc[2 + tid] = lam_init;
    }
    if (tid >= 128 && tid < 256) misc[64 + tid - 128] = 0.f;
    if (tid >= 64 && tid < 80) {
      const int i = tid - 64;
      const float xv = p.ret_decay_logit[i];
      misc[16 + i] = -log1pf(expf(-xv));
    }
    float2* ropeD = (float2*)(ws + OFF_ROPE);
    float2* ropeR = (float2*)(ws + OFF_ROPE + 4096);
    for (int i = tid; i < 64 * 8; i += 512) {
      const int v = i >> 3, f = i & 7;
      const float inv = powf(10000.0f, -(float)(2 * f) / 16.0f);
      const float ang = (float)v * inv;
      ropeD[i] = make_float2(cosf(ang), sinf(ang));
    }
    for (int i = tid; i < 64 * 16; i += 512) {
      const int v = i >> 4, f = i & 15;
      const float inv = powf(10000.0f, -(float)(2 * f) / 32.0f);
      const float ang = (float)v * inv;
      ropeR[i] = make_float2(cosf(ang), sinf(ang));
    }
  }
  {
    float* sc = (float*)smem;
    float* red = (float*)(smem + 9 * 1024 * 4);
    float* mod = (float*)(ws + OFF_MOD);
    for (int item = opaque_bid(); item < 192; item += gridDim.x) {
      const int l = item / 96, cb = item % 96;
      __syncthreads();
      for (int i = tid; i < 9 * 1024; i += 512) {
        const int r = i >> 10, k = i & 1023;
        const float cv = (r < 8) ? p.c[r * 1024 + k] : p.c_ctx[k];
        sc[i] = siluf(cv);
      }
      __syncthreads();
      const int col = tid & 63, ks = tid >> 6;
      float acc[9];
#pragma unroll
      for (int r = 0; r < 9; ++r) acc[r] = 0.f;
      const float* w = p.w_ada + (size_t)l * 1024 * 6144 + cb * 64 + col;
#pragma unroll 1
      for (int k0 = ks * 128; k0 < ks * 128 + 128; k0 += 16) {
        float wv[16];
#pragma unroll
        for (int i = 0; i < 16; ++i) wv[i] = w[(size_t)(k0 + i) * 6144];
#pragma unroll
        for (int i = 0; i < 16; ++i)
#pragma unroll
          for (int r = 0; r < 9; ++r) acc[r] = fmaf(sc[r * 1024 + k0 + i], wv[i], acc[r]);
      }
#pragma unroll
      for (int r = 0; r < 9; ++r) red[(ks * 9 + r) * 64 + col] = acc[r];
      __syncthreads();
      for (int i = tid; i < 576; i += 512) {
        const int r = i >> 6, cc = i & 63;
        float s = 0.f;
#pragma unroll
        for (int k8 = 0; k8 < 8; ++k8) s += red[(k8 * 9 + r) * 64 + cc];
        mod[((size_t)l * 9 + r) * 6144 + cb * 64 + cc] = s + p.b_ada[l * 6144 + cb * 64 + cc];
      }
    }
    __syncthreads();
  }
  for (int item = opaque_bid(); item < 3072; item += gridDim.x) {
    const int l = item / 1536;
    int r = item % 1536;
    if (r < 768) transpose_item(p.w_in + (size_t)l * 1024 * 3072, (bf16_t*)(ws + OFF_WIN) + (size_t)l * 3072 * 1024, 1024, 3072, r, smem);
    else if (r < 1024) transpose_item(p.w_out + (size_t)l * 1024 * 1024, (bf16_t*)(ws + OFF_WOUT) + (size_t)l * 1024 * 1024, 1024, 1024, r - 768, smem);
    else transpose_item(p.peer_wq + (size_t)l * 1024 * 2048, (bf16_t*)(ws + OFF_WQ) + (size_t)l * 2048 * 1024, 1024, 2048, r - 1024, smem);
  }
  convert_flat(p.peer_subkeys, (bf16_t*)(ws + OFF_SUBK), 2ull * 262144 / 4);
  {
    const size_t gt = (size_t)opaque_bid() * blockDim.x + tid, gs = (size_t)gridDim.x * blockDim.x;
    float4* dst = (float4*)(ws + OFF_CTXB);
    for (size_t i = gt; i < (size_t)NCTX * 1024 / 4; i += gs) dst[i] = ((const float4*)p.ctx)[i];
  }
}

__device__ __forceinline__ void phase_norm(const Params& p, int layer, int which, const float* xlat, int nrows) {
  const int lane = opaque_tid() & 63;
  const int gw = opaque_bid() * 8 + (opaque_tid() >> 6), nw = gridDim.x * 8;
  const float* g = (which == 0 ? p.norm1_g : p.norm2_g) + layer * 1024;
  const float* mod = (const float*)(p.ws + OFF_MOD) + (size_t)layer * 9 * 6144;
  const float* ctxb = (const float*)(p.ws + OFF_CTXB);
  bf16_t* act = (bf16_t*)(p.ws + OFF_ACT);
  const int sh_off = which == 0 ? 0 : 3 * 1024, sc_off = which == 0 ? 1024 : 4 * 1024;
  for (int row = gw; row < nrows; row += nw) {
    const float* src = row < NLAT ? xlat + (size_t)row * 1024 : ctxb + (size_t)(row - NLAT) * 1024;
    const int b = row < NLAT ? (row >> 12) : 8;
    const float* mrow = mod + (size_t)b * 6144;
    float4 v[4];
    float ss = 0.f;
#pragma unroll
    for (int j = 0; j < 4; ++j) {
      v[j] = ((const float4*)src)[lane + 64 * j];
      ss += v[j].x * v[j].x + v[j].y * v[j].y + v[j].z * v[j].z + v[j].w * v[j].w;
    }
    ss = wave_sum(ss);
    const float r = rsqrtf(ss * (1.f / 1024.f) + EPS);
#pragma unroll
    for (int j = 0; j < 4; ++j) {
      const int c = (lane + 64 * j) * 4;
      const float4 gg = *(const float4*)(g + c);
      const float4 sh = *(const float4*)(mrow + sh_off + c);
      const float4 sc = *(const float4*)(mrow + sc_off + c);
      const float o0 = v[j].x * r * gg.x * (1.f + sc.x) + sh.x;
      const float o1 = v[j].y * r * gg.y * (1.f + sc.y) + sh.y;
      const float o2 = v[j].z * r * gg.z * (1.f + sc.z) + sh.z;
      const float o3 = v[j].w * r * gg.w * (1.f + sc.w) + sh.w;
      uint2 o; o.x = pack2h(o0, o1); o.y = pack2h(o2, o3);
      *(uint2*)(act + (size_t)row * 1024 + c) = o;
    }
  }
}

__device__ __forceinline__ void phase_final(const Params& p) {
  const int lane = opaque_tid() & 63;
  const int gw = opaque_bid() * 8 + (opaque_tid() >> 6), nw = gridDim.x * 8;
  for (int row = gw; row < NLAT; row += nw) {
    float* src = p.out + (size_t)row * 1024;
    float4 v[4];
    float ss = 0.f;
#pragma unroll
    for (int j = 0; j < 4; ++j) {
      v[j] = ((const float4*)src)[lane + 64 * j];
      ss += v[j].x * v[j].x + v[j].y * v[j].y + v[j].z * v[j].z + v[j].w * v[j].w;
    }
    ss = wave_sum(ss);
    const float r = rsqrtf(ss * (1.f / 1024.f) + EPS);
#pragma unroll
    for (int j = 0; j < 4; ++j) {
      const int c = (lane + 64 * j) * 4;
      const float4 gg = *(const float4*)(p.final_g + c);
      float4 o;
      o.x = v[j].x * r * gg.x; o.y = v[j].y * r * gg.y; o.z = v[j].z * r * gg.z; o.w = v[j].w * r * gg.w;
      ((float4*)src)[lane + 64 * j] = o;
    }
  }
}

constexpr int EPI_INPROJ = 0, EPI_OUTPROJ = 1, EPI_PLAIN = 2;
constexpr int GS = 72;
constexpr int G_ASTAGE = 256 * GS * 2;
constexpr int G_BSTAGE = 128 * GS * 2;
constexpr int G_STAGE = G_ASTAGE + G_BSTAGE;

namespace g8 {
constexpr int BM = 256, BK = 64, HALF = 128, NXCD = 8, WGM = 8, HT = HALF * BK;
__device__ __forceinline__ int lds_byte(int r, int c) {
  const int st = (r >> 4) * 2 + (c >> 5), rr = r & 15, cc = c & 31, ob = rr * 64 + cc * 2;
  return st * 1024 + (ob ^ (((ob >> 9) & 1) << 5));
}
__device__ __forceinline__ void stage_rc(int b, int& R, int& C) {
  const int st = b / 1024, sb = b % 1024, swz = sb ^ (((sb >> 9) & 1) << 5);
  R = (st >> 1) * 16 + swz / 64; C = (st & 1) * 32 + (swz % 64) / 2;
}
}

constexpr int G8_ROPE_LDS = 8 * 16384;
template <int EPI>
__device__ __forceinline__ void epi_store8(const Params& p, int layer, char* smem, int m, int n, f32x4 lo, f32x4 hi, const float* xin_lat) {
  float v[8] = {lo[0], lo[1], lo[2], lo[3], hi[0], hi[1], hi[2], hi[3]};
  if constexpr (EPI == EPI_INPROJ) {
    const bool ropeD = (n >= C_DFQ && n < C_DFV), ropeR = (n >= C_RTQ && n < C_RTV);
    if ((ropeD || ropeR) && m < NLAT) {
      const int t = m & 4095, gr = t >> 6, gc = t & 63;
      const float2* tabD = (const float2*)(smem + G8_ROPE_LDS);
      const float2* tabR = (const float2*)(smem + G8_ROPE_LDS + 4096);
      const float2* tb;
      if (ropeD) { const int i0 = (n & 31) >> 1; tb = i0 < 8 ? tabD + gr * 8 + i0 : tabD + gc * 8 + i0 - 8; }
      else { const int i0 = (n & 63) >> 1; tb = i0 < 16 ? tabR + gr * 16 + i0 : tabR + gc * 16 + i0 - 16; }
#pragma unroll
      for (int q = 0; q < 4; ++q) {
        const float2 cs = tb[q];
        const float a0 = v[2 * q] * cs.x - v[2 * q + 1] * cs.y, a1 = v[2 * q] * cs.y + v[2 * q + 1] * cs.x;
        v[2 * q] = a0; v[2 * q + 1] = a1;
      }
    }
    float sc = 1.f;
    if (n < C_NAK) sc = 0.125f * 1.4426950408889634f;
    else if (n >= C_DFQ && n < C_DFK) sc = 0.17677669529663687f * 1.4426950408889634f;
    else if (n >= C_RTK && n < C_RTV) sc = 0.125f;
    uint4 o;
    o.x = pack2h(v[0] * sc, v[1] * sc); o.y = pack2h(v[2] * sc, v[3] * sc); o.z = pack2h(v[4] * sc, v[5] * sc); o.w = pack2h(v[6] * sc, v[7] * sc);
    *(uint4*)((bf16_t*)(p.ws + OFF_P) + (size_t)m * INC + n) = o;
  } else if constexpr (EPI == EPI_OUTPROJ) {
    const float* mod = (const float*)(p.ws + OFF_MOD) + (size_t)layer * 9 * 6144;
    const int b = m < NLAT ? (m >> 12) : 8;
    const float* gp = mod + (size_t)b * 6144 + 2 * 1024 + n;
    const float4 g0 = *(const float4*)gp, g1 = *(const float4*)(gp + 4);
    const float* xi; float* xo;
    if (m < NLAT) { xi = xin_lat + (size_t)m * 1024 + n; xo = p.out + (size_t)m * 1024 + n; }
    else { xo = (float*)(p.ws + OFF_CTXB) + (size_t)(m - NLAT) * 1024 + n; xi = xo; }
    const float4 x0 = *(const float4*)xi, x1 = *(const float4*)(xi + 4);
    float4 o0, o1;
    o0.x = x0.x + g0.x * v[0]; o0.y = x0.y + g0.y * v[1]; o0.z = x0.z + g0.z * v[2]; o0.w = x0.w + g0.w * v[3];
    o1.x = x1.x + g1.x * v[4]; o1.y = x1.y + g1.y * v[5]; o1.z = x1.z + g1.z * v[6]; o1.w = x1.w + g1.w * v[7];
    *(float4*)xo = o0; *(float4*)(xo + 4) = o1;
  } else if constexpr (EPI == EPI_PLAIN) {
    uint4 o;
    o.x = pack2h(v[0], v[1]); o.y = pack2h(v[2], v[3]); o.z = pack2h(v[4], v[5]); o.w = pack2h(v[6], v[7]);
    *(uint4*)((bf16_t*)(p.ws + OFF_P) + (size_t)m * 2048 + n) = o;
  } else {
    asm volatile("" :: "v"(v[0]), "v"(v[1]), "v"(v[2]), "v"(v[3]), "v"(v[4]), "v"(v[5]), "v"(v[6]), "v"(v[7]));
  }
}

#define G8_LAS __attribute__((address_space(3)))
__device__ __forceinline__ bool g8_next(int i, int nM, int nN, int G, int c, int& pm, int& pn) {
  using namespace g8;
  const int nwg = nM * nN;
  const long Lx = (long)i * G + c;
  if (Lx >= nwg) return false;
  int wgid = (int)Lx;
  { const int q = nwg / NXCD, r = nwg % NXCD, xcd = wgid % NXCD, off = wgid / NXCD; wgid = (xcd < r ? xcd * (q + 1) : r * (q + 1) + (xcd - r) * q) + off; }
  const int nig = WGM * nN, gid = wgid / nig, fm = gid * WGM, gsz = (nM - fm) < WGM ? (nM - fm) : WGM;
  pm = fm + ((wgid % nig) % gsz); pn = (wgid % nig) / gsz;
  return true;
}

template <int EPI>
__device__ __forceinline__ void gemm_phase2(const Params& p, int layer, char* smem, const bf16_t* A, const bf16_t* Bt,
                                            int M, int N, const float* xin_lat) {
  using namespace g8;
  constexpr int K = 1024, nt = K / BK, HTB = HALF * BK * 2;
  G8_LAS unsigned char* lds = (G8_LAS unsigned char*)smem;
  const int tid = opaque_tid();
  const int wid = __builtin_amdgcn_readfirstlane(tid >> 6), lane = tid & 63, wr = wid >> 2, wc = wid & 3, fr = lane & 15, fq = lane >> 4;
  unsigned voff[2], voffB[2];
#pragma unroll
  for (int i = 0; i < 2; ++i) {
    int R, C; stage_rc(tid * 16 + i * 8192, R, C);
    const int rho = R & 31, Rb = (R & ~31) + 8 * ((rho & 15) >> 2) + 4 * (rho >> 4) + (rho & 3);
    voff[i] = (unsigned)(R * K + C) * 2u; voffB[i] = (unsigned)(Rb * K + C) * 2u;
  }
  if constexpr (EPI == EPI_INPROJ) {
    __syncthreads();
    const float4* gsrc = (const float4*)(p.ws + OFF_ROPE);
    float4* ldst = (float4*)(smem + G8_ROPE_LDS);
    for (int i = tid; i < 12288 / 16; i += 512) ldst[i] = gsrc[i];
  }
  constexpr size_t kstep = (size_t)(BK * 2);
  constexpr size_t hstep = (size_t)HALF * K * 2;
  constexpr size_t tstep = 2 * hstep;
  const unsigned ldsw = (unsigned)wid * 1024u;
  const int aoff = lds_byte(wr * 64 + fr, fq * 8), boff = lds_byte(wc * 32 + fr, fq * 8);
#define G8_SA(b, h) (((b) * 2 + (h)) * HTB)
#define G8_SB(b, h) ((4 + (b) * 2 + (h)) * HTB)
#define G8_STAGE_V(bufoff, gbase, VO) do { _Pragma("unroll") for (int _i = 0; _i < 2; ++_i)                                  \
    __builtin_amdgcn_global_load_lds((const unsigned*)((const char*)(gbase) + VO[_i]), (G8_LAS unsigned*)(lds + (bufoff) + ldsw + _i * 8192), 16, 0, 0); } while (0)
#define G8_LDA(dst, b, h) do { _Pragma("unroll") for (int m = 0; m < 4; ++m) _Pragma("unroll") for (int k = 0; k < 2; ++k) dst[m][k] = *(const G8_LAS bf16x8*)(lds + G8_SA(b, h) + aoff + m * 2048 + k * 1024); } while (0)
#define G8_LDB(dst, b, h) do { _Pragma("unroll") for (int n = 0; n < 2; ++n) _Pragma("unroll") for (int k = 0; k < 2; ++k) dst[n][k] = *(const G8_LAS bf16x8*)(lds + G8_SB(b, h) + boff + n * 2048 + k * 1024); } while (0)
#define G8_MMA(ai, bj, At_, Bt_) do { __builtin_amdgcn_s_setprio(1);                                                          \
    _Pragma("unroll") for (int m = 0; m < 4; ++m) _Pragma("unroll") for (int n = 0; n < 2; ++n) _Pragma("unroll") for (int k = 0; k < 2; ++k) \
      acc[ai][bj][m][n] = __builtin_amdgcn_mfma_f32_16x16x32_bf16(Bt_[n][k], At_[m][k], acc[ai][bj][m][n], 0, 0, 0);          \
    __builtin_amdgcn_s_setprio(0); } while (0)
#define G8_WAIT_V(n) asm volatile("s_waitcnt vmcnt(" #n ")" ::: "memory")
#define G8_WAIT_L(n) asm volatile("s_waitcnt lgkmcnt(" #n ")" ::: "memory")
#define G8_BAR __builtin_amdgcn_s_barrier()
#define G8_SCHED __builtin_amdgcn_sched_barrier(0)
  const int nM = M / BM, nN = N / BM, G = gridDim.x, cu = opaque_bid();
  int cpm, cpn, npm = 0, npn = 0, ui = 0;
  __syncthreads();
  if (g8_next(0, nM, nN, G, cu, cpm, cpn)) {
    f32x4 acc[2][2][4][2];
#pragma unroll
    for (int a = 0; a < 2; ++a)
#pragma unroll
      for (int b2 = 0; b2 < 2; ++b2)
#pragma unroll
        for (int m = 0; m < 4; ++m)
#pragma unroll
          for (int n = 0; n < 2; ++n) acc[a][b2][m][n] = (f32x4){0.f, 0.f, 0.f, 0.f};
    bf16x8 At[4][2], B0[2][2], B1[2][2];
    const char* cA = (const char*)A + (size_t)cpm * tstep;
    const char* cB = (const char*)Bt + (size_t)cpn * tstep;
    G8_STAGE_V(G8_SB(0, 0), cB, voffB); G8_STAGE_V(G8_SA(0, 0), cA, voff); G8_STAGE_V(G8_SB(0, 1), cB + hstep, voffB); G8_STAGE_V(G8_SA(0, 1), cA + hstep, voff);
    if (wr == 1) G8_BAR;
    G8_WAIT_V(4); G8_BAR;
    G8_STAGE_V(G8_SB(1, 0), cB + kstep, voffB); G8_STAGE_V(G8_SA(1, 0), cA + kstep, voff); G8_STAGE_V(G8_SB(1, 1), cB + hstep + kstep, voffB);
    G8_WAIT_V(6); G8_BAR;
    for (;;) {
      const bool has_next = g8_next(ui + 1, nM, nN, G, cu, npm, npn);
      const char* nA = has_next ? (const char*)A + (size_t)npm * tstep : cA;
      const char* nB = has_next ? (const char*)Bt + (size_t)npn * tstep : cB;
#pragma unroll 1
      for (int t = 0; t < nt; t += 2) {
        const bool last = (t == nt - 2);
        const char* a1 = cA + (size_t)(t + 1) * kstep;
        const char* a2 = last ? nA : cA + (size_t)(t + 2) * kstep; const char* b2 = last ? nB : cB + (size_t)(t + 2) * kstep;
        const char* a3 = a2 + kstep; const char* b3 = b2 + kstep;
        G8_LDB(B0, 0, 0); G8_SCHED; G8_LDA(At, 0, 0); G8_STAGE_V(G8_SA(1, 1), a1 + hstep, voff);
        G8_WAIT_L(8); G8_BAR; G8_WAIT_L(0); G8_MMA(0, 0, At, B0); G8_BAR; G8_SCHED;
        G8_LDB(B1, 0, 1); G8_STAGE_V(G8_SB(0, 0), b2, voffB);
        G8_BAR; G8_WAIT_L(0); G8_MMA(0, 1, At, B1); G8_BAR;
        G8_LDA(At, 0, 1); G8_STAGE_V(G8_SA(0, 0), a2, voff);
        G8_BAR; G8_WAIT_L(0); G8_MMA(1, 0, At, B0); G8_BAR; G8_SCHED;
        G8_STAGE_V(G8_SB(0, 1), b2 + hstep, voffB);
        G8_WAIT_V(6); G8_BAR; G8_MMA(1, 1, At, B1); G8_BAR;
        G8_LDB(B0, 1, 0); G8_SCHED; G8_LDA(At, 1, 0); G8_STAGE_V(G8_SA(0, 1), a2 + hstep, voff);
        G8_WAIT_L(8); G8_BAR; G8_WAIT_L(0); G8_MMA(0, 0, At, B0); G8_BAR; G8_SCHED;
        G8_LDB(B1, 1, 1); G8_STAGE_V(G8_SB(1, 0), b3, voffB);
        G8_BAR; G8_WAIT_L(0); G8_MMA(0, 1, At, B1); G8_BAR;
        G8_LDA(At, 1, 1); G8_STAGE_V(G8_SA(1, 0), a3, voff);
        G8_BAR; G8_WAIT_L(0); G8_MMA(1, 0, At, B0); G8_BAR; G8_SCHED;
        G8_STAGE_V(G8_SB(1, 1), b3 + hstep, voffB);
        G8_WAIT_V(6); G8_BAR; G8_MMA(1, 1, At, B1); G8_BAR;
      }
      {
        const int brow = cpm * BM, bcol = cpn * BM;
        if constexpr (EPI == EPI_INPROJ) {
          if (bcol == C_DFK) {
#pragma unroll
            for (int bj = 0; bj < 2; ++bj) {
              float mx = 0.f;
#pragma unroll
              for (int ai = 0; ai < 2; ++ai)
#pragma unroll
                for (int m = 0; m < 4; ++m) {
                  float s = 0.f;
#pragma unroll
                  for (int n = 0; n < 2; ++n)
#pragma unroll
                    for (int j = 0; j < 4; ++j) s = fmaf(acc[ai][bj][m][n][j], acc[ai][bj][m][n][j], s);
                  s += __shfl_xor(s, 16); s += __shfl_xor(s, 32);
                  mx = fmaxf(mx, s);
                }
#pragma unroll
              for (int o = 1; o < 16; o <<= 1) mx = fmaxf(mx, __shfl_xor(mx, o));
              if (lane == 0) {
                const int bb = brow < NLAT ? (brow >> 12) : ((brow - NLAT) >> 8);
                unsigned* km = (unsigned*)(p.ws + OFF_MISC) + 64 + layer * 64 + (bb * 4 + bj * 2 + (wc >> 1)) * 2 + (wc & 1);
                atomicMax(km, __float_as_uint(mx));
              }
            }
          }
        }
#pragma unroll
        for (int ai = 0; ai < 2; ++ai)
#pragma unroll
          for (int bj = 0; bj < 2; ++bj)
#pragma unroll
            for (int m = 0; m < 4; ++m)
              epi_store8<EPI>(p, layer, smem, brow + ai * HALF + wr * 64 + m * 16 + fr, bcol + bj * HALF + wc * 32 + fq * 8,
                              acc[ai][bj][m][0], acc[ai][bj][m][1], xin_lat);
      }
      if (!has_next) break;
#pragma unroll
      for (int a = 0; a < 2; ++a)
#pragma unroll
        for (int b2 = 0; b2 < 2; ++b2)
#pragma unroll
          for (int m = 0; m < 4; ++m)
#pragma unroll
            for (int n = 0; n < 2; ++n) acc[a][b2][m][n] = (f32x4){0.f, 0.f, 0.f, 0.f};
      cpm = npm; cpn = npn; cA = nA; cB = nB; ++ui;
    }
    G8_WAIT_V(0);
    if (wr == 0) G8_BAR;
    G8_BAR;
  }
}

__device__ __forceinline__ unsigned cvt_pk_bf16(float lo, float hi) { return pack2h(lo, hi); }
__device__ __forceinline__ void vt_store8(bf16_t* vt, int stride, int d0, int key, uint4 uv) {
  bf16_t* vd = vt + d0 * stride + key;
  vd[0 * stride] = (bf16_t)(uv.x & 0xffffu); vd[1 * stride] = (bf16_t)(uv.x >> 16);
  vd[2 * stride] = (bf16_t)(uv.y & 0xffffu); vd[3 * stride] = (bf16_t)(uv.y >> 16);
  vd[4 * stride] = (bf16_t)(uv.z & 0xffffu); vd[5 * stride] = (bf16_t)(uv.z >> 16);
  vd[6 * stride] = (bf16_t)(uv.w & 0xffffu); vd[7 * stride] = (bf16_t)(uv.w >> 16);
}

constexpr int DKS = 72;
__device__ __forceinline__ void diff_item(const Params& p, int layer, bool ctxq, int item, char* smem) {
  const bf16_t* P = (const bf16_t*)(p.ws + OFF_P);
  bf16_t* Y = (bf16_t*)(p.ws + OFF_ACT);
  const float* misc = (const float*)(p.ws + OFF_MISC);
  const float lam = misc[layer], lam_init = misc[2 + layer];
  const int tid = opaque_tid(), lane = tid & 63, wave = tid >> 6, lr = lane & 15, lq = lane >> 4;
  int b, h, mbase, nkeys;
  if (!ctxq) { b = item >> 6; h = (item >> 4) & 3; mbase = b * 4096 + (item & 15) * 256; nkeys = 256 + 4096; }
  else { b = item >> 2; h = item & 3; mbase = NLAT + b * 256; nkeys = 256; }
  const float kmax0 = sqrtf(misc[64 + layer * 64 + (b * 4 + h) * 2 + 0]), kmax1 = sqrtf(misc[64 + layer * 64 + (b * 4 + h) * 2 + 1]);
  bf16x8 qf[2][2];
  f32x4 C0[2], C1[2];
#pragma unroll
  for (int qt = 0; qt < 2; ++qt) {
    const bf16_t* qr = P + (size_t)(mbase + wave * 32 + qt * 16 + lr) * INC + C_DFQ + h * 64 + lq * 8;
    const uint4 u0 = *(const uint4*)(qr), u1 = *(const uint4*)(qr + 32);
    float s0 = 0.f, s1 = 0.f;
    { float t[8]; UNPACK8(t, 0, u0) _Pragma("unroll") for (int i = 0; i < 8; ++i) s0 = fmaf(t[i], t[i], s0); }
    { float t[8]; UNPACK8(t, 0, u1) _Pragma("unroll") for (int i = 0; i < 8; ++i) s1 = fmaf(t[i], t[i], s1); }
    s0 += __shfl_xor(s0, 16); s0 += __shfl_xor(s0, 32);
    s1 += __shfl_xor(s1, 16); s1 += __shfl_xor(s1, 32);
    const float nm0 = -sqrtf(s0) * kmax0, nm1 = -sqrtf(s1) * kmax1;
    C0[qt] = (f32x4){nm0, nm0, nm0, nm0};
    C1[qt] = (f32x4){nm1, nm1, nm1, nm1};
    union { uint4 u; bf16x8 v; } c0, c1; c0.u = u0; c1.u = u1;
    qf[qt][0] = c0.v; qf[qt][1] = c1.v;
  }
  f32x4 O0[2][4], O1[2][4];
#pragma unroll
  for (int qt = 0; qt < 2; ++qt)
#pragma unroll
    for (int i = 0; i < 4; ++i) { O0[qt][i] = (f32x4){0.f, 0.f, 0.f, 0.f}; O1[qt][i] = (f32x4){0.f, 0.f, 0.f, 0.f}; }
  f32x4 L0[2], L1[2];
#pragma unroll
  for (int qt = 0; qt < 2; ++qt) { L0[qt] = (f32x4){0.f, 0.f, 0.f, 0.f}; L1[qt] = (f32x4){0.f, 0.f, 0.f, 0.f}; }
  const bf16x8 ones8 = {(short)0x3F80, (short)0x3F80, (short)0x3F80, (short)0x3F80, (short)0x3F80, (short)0x3F80, (short)0x3F80, (short)0x3F80};
  const int lkey = tid >> 3, lch = tid & 7;
  constexpr int DBUF = 2 * 128 * DKS * 2;
  uint4 ukA0, ukA1, uvA0, uvA1;
#define DF_GLOAD1(UK, UV, T, I)                                                                     \
  {                                                                                                 \
    const int kk = (T) * 128 + (I) * 64 + lkey;                                                     \
    const size_t row = kk < 256 ? (size_t)(NLAT + b * 256 + kk) : (size_t)(b * 4096 + kk - 256);    \
    UK = *(const uint4*)(P + row * INC + C_DFK + h * 64 + lch * 8);                                 \
    UV = *(const uint4*)(P + row * INC + C_DFV + h * 64 + lch * 8);                                 \
  }
#define DF_LSTORE1(UK, UV, BUF, I)                                                                  \
  {                                                                                                 \
    bf16_t* Ks_ = (bf16_t*)(smem + (BUF) * DBUF) + (I) * 64 * DKS;                                  \
    bf16_t* Vt_ = (bf16_t*)(smem + (BUF) * DBUF) + 128 * DKS + (I) * 64 * DKS;                      \
    *(uint4*)(Ks_ + lkey * DKS + lch * 8) = UK;                                                     \
    vt_store8(Vt_, DKS, lch * 8, lkey, UV);                                                         \
  }
#define DF_GLOAD(S, T) DF_GLOAD1(uk##S##0, uv##S##0, T, 0) DF_GLOAD1(uk##S##1, uv##S##1, T, 1)
#define DF_LSTORE(S, BUF) DF_LSTORE1(uk##S##0, uv##S##0, BUF, 0) DF_LSTORE1(uk##S##1, uv##S##1, BUF, 1)
  const int ntile = nkeys >> 7;
  __syncthreads();
  DF_GLOAD(A, 0)
  DF_LSTORE(A, 0)
  __syncthreads();
#pragma unroll 1
  for (int t = 0; t < ntile; ++t) {
    const int cur = t & 1;
    if (t + 1 < ntile) { DF_GLOAD(A, t + 1) }
#pragma unroll
    for (int sub = 0; sub < 2; ++sub) {
    const bf16_t* Ks = (const bf16_t*)(smem + cur * DBUF) + sub * 64 * DKS;
    const bf16_t* Vt = (const bf16_t*)(smem + cur * DBUF) + 128 * DKS + sub * 64 * DKS;
    union PF { unsigned u[4]; bf16x8 v; };
    PF pf0[2][2], pf1[2][2];
#pragma unroll
    for (int c = 0; c < 2; ++c) {
      f32x4 S[2][4];
#pragma unroll
      for (int kt = 0; kt < 4; ++kt) {
        const bf16x8 kf = *(const bf16x8*)(Ks + (kt * 16 + lr) * DKS + c * 32 + lq * 8);
#pragma unroll
        for (int qt = 0; qt < 2; ++qt) S[qt][kt] = __builtin_amdgcn_mfma_f32_16x16x32_bf16(kf, qf[qt][c], c == 0 ? C0[qt] : C1[qt], 0, 0, 0);
      }
#pragma unroll
      for (int qt = 0; qt < 2; ++qt) {
#pragma unroll
        for (int kt = 0; kt < 4; ++kt) {
#pragma unroll
          for (int r = 0; r < 4; ++r) S[qt][kt][r] = __builtin_amdgcn_exp2f(S[qt][kt][r]);
        }
#pragma unroll
        for (int g = 0; g < 2; ++g) {
          PF t;
          t.u[0] = cvt_pk_bf16(S[qt][2 * g][0], S[qt][2 * g][1]); t.u[1] = cvt_pk_bf16(S[qt][2 * g][2], S[qt][2 * g][3]);
          t.u[2] = cvt_pk_bf16(S[qt][2 * g + 1][0], S[qt][2 * g + 1][1]); t.u[3] = cvt_pk_bf16(S[qt][2 * g + 1][2], S[qt][2 * g + 1][3]);
          if (c == 0) pf0[qt][g] = t; else pf1[qt][g] = t;
        }
      }
    }
#pragma unroll
    for (int g = 0; g < 2; ++g) {
#pragma unroll
      for (int qt = 0; qt < 2; ++qt) {
        L0[qt] = __builtin_amdgcn_mfma_f32_16x16x32_bf16(ones8, pf0[qt][g].v, L0[qt], 0, 0, 0);
        L1[qt] = __builtin_amdgcn_mfma_f32_16x16x32_bf16(ones8, pf1[qt][g].v, L1[qt], 0, 0, 0);
      }
#pragma unroll
      for (int dt = 0; dt < 4; ++dt) {
        union { uint2 h2[2]; bf16x8 v; } vf;
        vf.h2[0] = *(const uint2*)(Vt + (dt * 16 + lr) * DKS + 32 * g + 4 * lq);
        vf.h2[1] = *(const uint2*)(Vt + (dt * 16 + lr) * DKS + 32 * g + 16 + 4 * lq);
#pragma unroll
        for (int qt = 0; qt < 2; ++qt) {
          O0[qt][dt] = __builtin_amdgcn_mfma_f32_16x16x32_bf16(vf.v, pf0[qt][g].v, O0[qt][dt], 0, 0, 0);
          O1[qt][dt] = __builtin_amdgcn_mfma_f32_16x16x32_bf16(vf.v, pf1[qt][g].v, O1[qt][dt], 0, 0, 0);
        }
      }
    }
    }
    if (t + 1 < ntile) { DF_LSTORE(A, cur ^ 1) }
    __syncthreads();
  }
  const float* sg = p.diff_subln_g + layer * 64;
#pragma unroll
  for (int qt = 0; qt < 2; ++qt) {
    const float a0 = L0[qt][0], a1 = L1[qt][0];
    const float i0 = 1.f / a0, i1 = lam / a1;
    float ss = 0.f;
#pragma unroll
    for (int dt = 0; dt < 4; ++dt) {
#pragma unroll
      for (int r = 0; r < 4; ++r) { const float v = O0[qt][dt][r] * i0 - O1[qt][dt][r] * i1; O0[qt][dt][r] = v; ss = fmaf(v, v, ss); }
    }
    ss += __shfl_xor(ss, 16); ss += __shfl_xor(ss, 32);
    const float rr = rsqrtf(ss * (1.f / 64.f) + EPS) * (1.f - lam_init);
    bf16_t* dst = Y + (size_t)(mbase + wave * 32 + qt * 16 + lr) * 1024 + Y_DF + h * 64;
#pragma unroll
    for (int dt = 0; dt < 4; ++dt) {
      const int d = dt * 16 + 4 * lq;
      const float4 g4 = *(const float4*)(sg + d);
      uint2 ov;
      ov.x = pack2(O0[qt][dt][0] * rr * g4.x, O0[qt][dt][1] * rr * g4.y);
      ov.y = pack2(O0[qt][dt][2] * rr * g4.z, O0[qt][dt][3] * rr * g4.w);
      *(uint2*)(dst + d) = ov;
    }
  }
}

constexpr int NA_WS = 520;
constexpr int NA_CS = 264;
constexpr int NA_OFF_VTW = 0;
constexpr int NA_OFF_VTC = 64 * NA_WS * 2;
constexpr int NA_OFF_RPB = NA_OFF_VTC + 64 * NA_CS * 2;
constexpr int NA_OFF_MRG = NA_OFF_RPB + 2048;

#define NA_STEP(KA_EXPR, KB_EXPR, BIAS_EXPR, VT_PTR, VT_STRIDE, VT_KEY0_EXPR)                                    \
  {                                                                                                               \
    f32x4 S[4];                                                                                                   \
    _Pragma("unroll") for (int kt = 0; kt < 4; ++kt) {                                                            \
      f32x4 a = __builtin_amdgcn_mfma_f32_16x16x32_bf16((KA_EXPR), qf[0], (f32x4){0.f, 0.f, 0.f, 0.f}, 0, 0, 0);  \
      S[kt] = __builtin_amdgcn_mfma_f32_16x16x32_bf16((KB_EXPR), qf[1], a, 0, 0, 0);                               \
    }                                                                                                             \
    _Pragma("unroll") for (int kt = 0; kt < 4; ++kt) {                                                            \
      _Pragma("unroll") for (int r = 0; r < 4; ++r) { S[kt][r] += (BIAS_EXPR); }                                  \
    }                                                                                                             \
    float x = fmaxf(fmaxf(S[0][0], S[0][1]), fmaxf(S[0][2], S[0][3]));                                            \
    _Pragma("unroll") for (int kt = 1; kt < 4; ++kt) x = fmaxf(x, fmaxf(fmaxf(S[kt][0], S[kt][1]), fmaxf(S[kt][2], S[kt][3]))); \
    x = fmaxf(x, __shfl_xor(x, 16)); x = fmaxf(x, __shfl_xor(x, 32));                                             \
    const float mn = fmaxf(mrun, x);                                                                              \
    const float al = __builtin_amdgcn_exp2f(mrun - mn);                                                           \
    mrun = mn;                                                                                                    \
    float ps = 0.f;                                                                                               \
    _Pragma("unroll") for (int kt = 0; kt < 4; ++kt) {                                                            \
      _Pragma("unroll") for (int r = 0; r < 4; ++r) { S[kt][r] = __builtin_amdgcn_exp2f(S[kt][r] - mn); ps += S[kt][r]; } \
    }                                                                                                             \
    lrun = lrun * al + ps;                                                                                        \
    _Pragma("unroll") for (int dt = 0; dt < 4; ++dt) {                                                            \
      _Pragma("unroll") for (int r = 0; r < 4; ++r) O[dt][r] *= al;                                               \
    }                                                                                                             \
    _Pragma("unroll") for (int g = 0; g < 2; ++g) {                                                               \
      union { unsigned u[4]; bf16x8 v; } pf;                                                                      \
      pf.u[0] = cvt_pk_bf16(S[2 * g][0], S[2 * g][1]); pf.u[1] = cvt_pk_bf16(S[2 * g][2], S[2 * g][3]);           \
      pf.u[2] = cvt_pk_bf16(S[2 * g + 1][0], S[2 * g + 1][1]); pf.u[3] = cvt_pk_bf16(S[2 * g + 1][2], S[2 * g + 1][3]); \
      const int vk0 = (VT_KEY0_EXPR);                                                                             \
      _Pragma("unroll") for (int dt = 0; dt < 4; ++dt) {                                                          \
        union { uint2 h2[2]; bf16x8 v; } vf;                                                                      \
        vf.h2[0] = *(const uint2*)((VT_PTR) + (dt * 16 + lr) * (VT_STRIDE) + vk0 + 4 * lq);                       \
        vf.h2[1] = *(const uint2*)((VT_PTR) + (dt * 16 + lr) * (VT_STRIDE) + vk0 + 16 + 4 * lq);                  \
        O[dt] = __builtin_amdgcn_mfma_f32_16x16x32_bf16(vf.v, pf.v, O[dt], 0, 0, 0);                              \
      }                                                                                                           \
    }                                                                                                             \
  }

__device__ __forceinline__ void na_latent_item(const Params& p, int layer, int item, char* smem) {
  const bf16_t* P = (const bf16_t*)(p.ws + OFF_P);
  bf16_t* Y = (bf16_t*)(p.ws + OFF_ACT);
  const int b = item >> 8, h = (item >> 6) & 3, grow = item & 63;
  const int tid = opaque_tid(), lane = tid & 63, wave = tid >> 6, lr = lane & 15, lq = lane >> 4;
  const int jt = wave & 3, half = wave >> 2;
  bf16_t* VtW = (bf16_t*)(smem + NA_OFF_VTW);
  bf16_t* VtC = (bf16_t*)(smem + NA_OFF_VTC);
  float* RPB = (float*)(smem + NA_OFF_RPB);
  float* MRG = (float*)(smem + NA_OFF_MRG);
  const int rs = min(max(grow - 4, 0), 56);
  __syncthreads();
  {
    const int ch = tid & 7;
#pragma unroll
    for (int i = 0; i < 8; ++i) {
      const int key = (tid >> 3) + 64 * i;
      const uint4 uv = *(const uint4*)(P + (size_t)(b * 4096 + (rs + (key >> 6)) * 64 + (key & 63)) * INC + C_NAV + h * 64 + ch * 8);
      vt_store8(VtW, NA_WS, ch * 8, key, uv);
    }
#pragma unroll
    for (int i = 0; i < 4; ++i) {
      const int key = (tid >> 3) + 64 * i;
      const uint4 uv = *(const uint4*)(P + (size_t)(NLAT + b * 256 + key) * INC + C_NAV + h * 64 + ch * 8);
      vt_store8(VtC, NA_CS, ch * 8, key, uv);
    }
    if (tid < 465) RPB[tid] = p.na_rpb[(size_t)(layer * 4 + h) * 465 + tid] * 1.4426950408889634f;
  }
  const int qc = jt * 16 + lr;
  const int mq = b * 4096 + grow * 64 + qc;
  bf16x8 qf[2];
  {
    const bf16_t* qr = P + (size_t)mq * INC + C_NAQ + h * 64 + lq * 8;
    qf[0] = *(const bf16x8*)(qr);
    qf[1] = *(const bf16x8*)(qr + 32);
  }
  f32x4 O[4];
#pragma unroll
  for (int i = 0; i < 4; ++i) O[i] = (f32x4){0.f, 0.f, 0.f, 0.f};
  float mrun = -1e30f, lrun = 0.f;
  const int k0 = min(max(jt * 16 - 8, 0), 32);
  const int cs = min(max(qc - 8, 0), 48);
  bf16x8 kfa[2][4], kfb[2][4];
#define NA_LOADK(SET, S_)                                                                                        \
  _Pragma("unroll") for (int kt = 0; kt < 4; ++kt) {                                                             \
    const int t_ = 4 * (S_) + kt;                                                                                \
    const size_t krow = half == 0 ? (size_t)(b * 4096 + (rs + (t_ >> 1)) * 64 + k0 + 16 * (t_ & 1) + lr) : (size_t)(NLAT + b * 256 + 16 * t_ + lr); \
    const bf16_t* kp = P + krow * INC + C_NAK + h * 64 + lq * 8;                                                 \
    kfa[SET][kt] = *(const bf16x8*)(kp); kfb[SET][kt] = *(const bf16x8*)(kp + 32);                               \
  }
  NA_LOADK(0, 0)
  __syncthreads();
#pragma unroll
  for (int s = 0; s < 4; ++s) {
    if (s + 1 < 4) { NA_LOADK((s + 1) & 1, s + 1) }
    if (half == 0) {
      const int wr0 = 2 * s;
      NA_STEP(kfa[s & 1][kt], kfb[s & 1][kt],
              ((k0 + 16 * (kt & 1) + 4 * lq + r) >= cs && (k0 + 16 * (kt & 1) + 4 * lq + r) < cs + 16)
                  ? RPB[(rs + wr0 + (kt >> 1) - grow + 7) * 31 + (k0 + 16 * (kt & 1) + 4 * lq + r) - qc + 15] : -1e30f,
              VtW, NA_WS, (wr0 + g) * 64 + k0)
    } else {
      NA_STEP(kfa[s & 1][kt], kfb[s & 1][kt], 0.f, VtC, NA_CS, s * 64 + 32 * g)
    }
  }
  lrun += __shfl_xor(lrun, 16); lrun += __shfl_xor(lrun, 32);
  float* mg = MRG + (jt * 64 + lane) * 18;
  if (half == 1) {
    mg[0] = mrun; mg[1] = lrun;
#pragma unroll
    for (int dt = 0; dt < 4; ++dt) { mg[2 + dt * 4 + 0] = O[dt][0]; mg[2 + dt * 4 + 1] = O[dt][1]; mg[2 + dt * 4 + 2] = O[dt][2]; mg[2 + dt * 4 + 3] = O[dt][3]; }
  }
  __syncthreads();
  if (half == 0) {
    const float m2 = mg[0], l2 = mg[1];
    const float M = fmaxf(mrun, m2);
    const float f1 = __builtin_amdgcn_exp2f(mrun - M), f2 = __builtin_amdgcn_exp2f(m2 - M);
    const float inv = 1.f / (lrun * f1 + l2 * f2);
    bf16_t* dst = Y + (size_t)mq * 1024 + Y_NA + h * 64;
#pragma unroll
    for (int dt = 0; dt < 4; ++dt) {
      const float o0 = (O[dt][0] * f1 + mg[2 + dt * 4 + 0] * f2) * inv, o1 = (O[dt][1] * f1 + mg[2 + dt * 4 + 1] * f2) * inv;
      const float o2 = (O[dt][2] * f1 + mg[2 + dt * 4 + 2] * f2) * inv, o3 = (O[dt][3] * f1 + mg[2 + dt * 4 + 3] * f2) * inv;
      uint2 ov; ov.x = pack2(o0, o1); ov.y = pack2(o2, o3);
      *(uint2*)(dst + dt * 16 + 4 * lq) = ov;
    }
  }
}

__device__ __forceinline__ void na_ctx_item(const Params& p, int item, char* smem) {
  const bf16_t* P = (const bf16_t*)(p.ws + OFF_P);
  bf16_t* Y = (bf16_t*)(p.ws + OFF_ACT);
  const int b = item >> 3, h = (item >> 1) & 3, qg = item & 1;
  const int tid = opaque_tid(), lane = tid & 63, wave = tid >> 6, lr = lane & 15, lq = lane >> 4;
  bf16_t* VtC = (bf16_t*)(smem + NA_OFF_VTC);
  __syncthreads();
  {
    const int ch = tid & 7;
#pragma unroll
    for (int i = 0; i < 4; ++i) {
      const int key = (tid >> 3) + 64 * i;
      const uint4 uv = *(const uint4*)(P + (size_t)(NLAT + b * 256 + key) * INC + C_NAV + h * 64 + ch * 8);
      vt_store8(VtC, NA_CS, ch * 8, key, uv);
    }
  }
  const int mq = NLAT + b * 256 + qg * 128 + wave * 16 + lr;
  bf16x8 qf[2];
  {
    const bf16_t* qr = P + (size_t)mq * INC + C_NAQ + h * 64 + lq * 8;
    qf[0] = *(const bf16x8*)(qr);
    qf[1] = *(const bf16x8*)(qr + 32);
  }
  f32x4 O[4];
#pragma unroll
  for (int i = 0; i < 4; ++i) O[i] = (f32x4){0.f, 0.f, 0.f, 0.f};
  float mrun = -1e30f, lrun = 0.f;
  __syncthreads();
#pragma unroll 1
  for (int s = 0; s < 4; ++s) {
    NA_STEP(*(const bf16x8*)(P + (size_t)(NLAT + b * 256 + s * 64 + kt * 16 + lr) * INC + C_NAK + h * 64 + lq * 8),
            *(const bf16x8*)(P + (size_t)(NLAT + b * 256 + s * 64 + kt * 16 + lr) * INC + C_NAK + h * 64 + 32 + lq * 8), 0.f, VtC, NA_CS, s * 64 + 32 * g)
  }
  lrun += __shfl_xor(lrun, 16); lrun += __shfl_xor(lrun, 32);
  const float inv = 1.f / lrun;
  bf16_t* dst = Y + (size_t)mq * 1024 + Y_NA + h * 64;
#pragma unroll
  for (int dt = 0; dt < 4; ++dt) {
    uint2 ov; ov.x = pack2(O[dt][0] * inv, O[dt][1] * inv); ov.y = pack2(O[dt][2] * inv, O[dt][3] * inv);
    *(uint2*)(dst + dt * 16 + 4 * lq) = ov;
  }
}

constexpr int KV_S = 136;
constexpr int KV_OFF_KF = 0, KV_OFF_KB = 64 * KV_S * 2, KV_OFF_VT = 2 * 64 * KV_S * 2;
__device__ __forceinline__ void ret_kv_item(const Params& p, int layer, int h, size_t row0, int cnt, float* dstF, float* dstB, char* smem) {
  const bf16_t* P = (const bf16_t*)(p.ws + OFF_P);
  const float* misc = (const float*)(p.ws + OFF_MISC);
  const float lgF2 = misc[16 + layer * 8 + 0 * 4 + h] * 1.4426950408889634f, lgB2 = misc[16 + layer * 8 + 1 * 4 + h] * 1.4426950408889634f;
  const int tid = opaque_tid(), lane = tid & 63, wave = tid >> 6, lr = lane & 15, lq = lane >> 4;
  bf16_t* KFt = (bf16_t*)(smem + KV_OFF_KF);
  bf16_t* KBt = (bf16_t*)(smem + KV_OFF_KB);
  bf16_t* Vt = (bf16_t*)(smem + KV_OFF_VT);
  const int dir = wave >> 2, dt = wave & 3;
  f32x4 acc[8];
#pragma unroll
  for (int i = 0; i < 8; ++i) acc[i] = (f32x4){0.f, 0.f, 0.f, 0.f};
#pragma unroll 1
  for (int kc = 0; kc < (cnt >> 7); ++kc) {
    __syncthreads();
    {
      const int tok = tid >> 2, c = tid & 3;
      const int j = kc * 128 + tok;
      const float wF = __builtin_amdgcn_exp2f(lgF2 * (float)(cnt - 1 - j)), wB = __builtin_amdgcn_exp2f(lgB2 * (float)j);
      const bf16_t* rowp = P + (row0 + j) * INC;
#pragma unroll
      for (int c8 = 0; c8 < 2; ++c8) {
        const uint4 u = *(const uint4*)(rowp + C_RTK + h * 64 + c * 16 + c8 * 8);
        float kv[8];
        UNPACK8(kv, 0, u)
#pragma unroll
        for (int i = 0; i < 8; ++i) {
          KFt[(c * 16 + c8 * 8 + i) * KV_S + tok] = f2bf(kv[i] * wF);
          KBt[(c * 16 + c8 * 8 + i) * KV_S + tok] = f2bf(kv[i] * wB);
        }
      }
#pragma unroll
      for (int c8 = 0; c8 < 4; ++c8) {
        const uint4 uv = *(const uint4*)(rowp + C_RTV + h * 128 + c * 32 + c8 * 8);
        vt_store8(Vt, KV_S, c * 32 + c8 * 8, tok, uv);
      }
    }
    __syncthreads();
    const bf16_t* Kt = dir == 0 ? KFt : KBt;
    bf16x8 af[4];
#pragma unroll
    for (int ks = 0; ks < 4; ++ks) af[ks] = *(const bf16x8*)(Kt + (dt * 16 + lr) * KV_S + ks * 32 + lq * 8);
#pragma unroll
    for (int et = 0; et < 8; ++et) {
#pragma unroll
      for (int ks = 0; ks < 4; ++ks) {
        const bf16x8 bfr = *(const bf16x8*)(Vt + (et * 16 + lr) * KV_S + ks * 32 + lq * 8);
        acc[et] = __builtin_amdgcn_mfma_f32_16x16x32_bf16(af[ks], bfr, acc[et], 0, 0, 0);
      }
    }
  }
  float* dst = dir == 0 ? dstF : dstB;
#pragma unroll
  for (int et = 0; et < 8; ++et) {
#pragma unroll
    for (int r = 0; r < 4; ++r) dst[(dt * 16 + 4 * lq + r) * 128 + et * 16 + lr] = acc[et][r];
  }
}

__device__ __forceinline__ void phase_ret_scan(const Params& p, int layer) {
  const float* misc = (const float*)(p.ws + OFF_MISC);
  float* rkv = (float*)(p.ws + OFF_RKV);
  const float* rs = (const float*)(p.ws + OFF_RS);
  const int gt = opaque_bid() * 512 + opaque_tid(), gs = gridDim.x * 512;
  for (int idx = gt; idx < 64 * 2048; idx += gs) {
    const int seq = idx >> 11, e4 = (idx & 2047) * 4;
    const int dir = seq & 1, h = (seq >> 1) & 3;
    const float cdec = __expf(misc[16 + layer * 8 + dir * 4 + h] * 128.f);
    float4* base = (float4*)(rkv + (size_t)seq * 32 * 8192 + e4);
    float4 v[32];
#pragma unroll
    for (int s = 0; s < 32; ++s) v[s] = base[(size_t)s * 2048];
    float4 st = *(const float4*)(rs + (size_t)seq * 8192 + e4);
    if (dir == 0) {
#pragma unroll
      for (int s = 0; s < 32; ++s) {
        const float4 t = v[s];
        base[(size_t)s * 2048] = st;
        st.x = fmaf(cdec, st.x, t.x); st.y = fmaf(cdec, st.y, t.y); st.z = fmaf(cdec, st.z, t.z); st.w = fmaf(cdec, st.w, t.w);
      }
    } else {
#pragma unroll
      for (int s = 31; s >= 0; --s) {
        const float4 t = v[s];
        base[(size_t)s * 2048] = st;
        st.x = fmaf(cdec, st.x, t.x); st.y = fmaf(cdec, st.y, t.y); st.z = fmaf(cdec, st.z, t.z); st.w = fmaf(cdec, st.w, t.w);
      }
    }
  }
}

constexpr int RT_KS = 72, RT_VS = 136;
constexpr int RT_OFF_K = 0, RT_OFF_VT = 128 * RT_KS * 2, RT_OFF_SF = RT_OFF_VT + 128 * RT_VS * 2, RT_OFF_SB = RT_OFF_SF + 128 * RT_KS * 2;
__device__ __forceinline__ void ret_out_item(const Params& p, int layer, int h, size_t krow0, int nkc, int iq0,
                                             const float* SF, const float* SB, int clen, char* smem) {
  const bf16_t* P = (const bf16_t*)(p.ws + OFF_P);
  bf16_t* Y = (bf16_t*)(p.ws + OFF_ACT);
  const float* misc = (const float*)(p.ws + OFF_MISC);
  const float lgF2 = misc[16 + layer * 8 + 0 * 4 + h] * 1.4426950408889634f, lgB2 = misc[16 + layer * 8 + 1 * 4 + h] * 1.4426950408889634f;
  const int tid = opaque_tid(), lane = tid & 63, wave = tid >> 6, lr = lane & 15, lq = lane >> 4;
  bf16_t* Ks = (bf16_t*)(smem + RT_OFF_K);
  bf16_t* Vt = (bf16_t*)(smem + RT_OFF_VT);
  bf16_t* SFt = (bf16_t*)(smem + RT_OFF_SF);
  bf16_t* SBt = (bf16_t*)(smem + RT_OFF_SB);
  const int iq = iq0 + wave * 16 + lr;
  const size_t mq = krow0 + iq;
  bf16x8 qf[2];
  {
    const bf16_t* qr = P + mq * INC + C_RTQ + h * 64 + lq * 8;
    qf[0] = *(const bf16x8*)(qr);
    qf[1] = *(const bf16x8*)(qr + 32);
  }
  f32x4 O[8];
#pragma unroll
  for (int i = 0; i < 8; ++i) O[i] = (f32x4){0.f, 0.f, 0.f, 0.f};
  if (SF != nullptr) {
    __syncthreads();
    {
      const int d = tid >> 3, e0 = (tid & 7) * 16;
#pragma unroll
      for (int c4 = 0; c4 < 4; ++c4) {
        const float4 a = *(const float4*)(SF + d * 128 + e0 + c4 * 4);
        const float4 bb = *(const float4*)(SB + d * 128 + e0 + c4 * 4);
        SFt[(e0 + c4 * 4 + 0) * RT_KS + d] = f2bf(a.x); SFt[(e0 + c4 * 4 + 1) * RT_KS + d] = f2bf(a.y);
        SFt[(e0 + c4 * 4 + 2) * RT_KS + d] = f2bf(a.z); SFt[(e0 + c4 * 4 + 3) * RT_KS + d] = f2bf(a.w);
        SBt[(e0 + c4 * 4 + 0) * RT_KS + d] = f2bf(bb.x); SBt[(e0 + c4 * 4 + 1) * RT_KS + d] = f2bf(bb.y);
        SBt[(e0 + c4 * 4 + 2) * RT_KS + d] = f2bf(bb.z); SBt[(e0 + c4 * 4 + 3) * RT_KS + d] = f2bf(bb.w);
      }
    }
    __syncthreads();
    const float cF = __builtin_amdgcn_exp2f(lgF2 * (float)(iq + 1)), cB = __builtin_amdgcn_exp2f(lgB2 * (float)(clen - iq));
#pragma unroll
    for (int ks = 0; ks < 2; ++ks)
#pragma unroll
      for (int et = 0; et < 8; ++et) {
        const bf16x8 sf = *(const bf16x8*)(SFt + (et * 16 + lr) * RT_KS + ks * 32 + lq * 8);
        O[et] = __builtin_amdgcn_mfma_f32_16x16x32_bf16(sf, qf[ks], O[et], 0, 0, 0);
      }
    const float ratio = cF / cB;
#pragma unroll
    for (int et = 0; et < 8; ++et) { O[et][0] *= ratio; O[et][1] *= ratio; O[et][2] *= ratio; O[et][3] *= ratio; }
#pragma unroll
    for (int ks = 0; ks < 2; ++ks)
#pragma unroll
      for (int et = 0; et < 8; ++et) {
        const bf16x8 sb = *(const bf16x8*)(SBt + (et * 16 + lr) * RT_KS + ks * 32 + lq * 8);
        O[et] = __builtin_amdgcn_mfma_f32_16x16x32_bf16(sb, qf[ks], O[et], 0, 0, 0);
      }
#pragma unroll
    for (int et = 0; et < 8; ++et) { O[et][0] *= cB; O[et][1] *= cB; O[et][2] *= cB; O[et][3] *= cB; }
  }
#pragma unroll 1
  for (int kc = 0; kc < nkc; ++kc) {
    __syncthreads();
    {
      const int key = tid >> 2, c = tid & 3;
      const bf16_t* rowp = P + (krow0 + kc * 128 + key) * INC;
      const uint4 k0 = *(const uint4*)(rowp + C_RTK + h * 64 + c * 16), k1 = *(const uint4*)(rowp + C_RTK + h * 64 + c * 16 + 8);
      *(uint4*)(Ks + key * RT_KS + c * 16) = k0;
      *(uint4*)(Ks + key * RT_KS + c * 16 + 8) = k1;
#pragma unroll
      for (int c8 = 0; c8 < 4; ++c8) {
        const uint4 uv = *(const uint4*)(rowp + C_RTV + h * 128 + c * 32 + c8 * 8);
        vt_store8(Vt, RT_VS, c * 32 + c8 * 8, key, uv);
      }
    }
    __syncthreads();
    f32x4 S[8];
#pragma unroll
    for (int kt = 0; kt < 8; ++kt) {
      const bf16x8 ka = *(const bf16x8*)(Ks + (kt * 16 + lr) * RT_KS + lq * 8);
      const bf16x8 kb = *(const bf16x8*)(Ks + (kt * 16 + lr) * RT_KS + 32 + lq * 8);
      const f32x4 a = __builtin_amdgcn_mfma_f32_16x16x32_bf16(ka, qf[0], (f32x4){0.f, 0.f, 0.f, 0.f}, 0, 0, 0);
      S[kt] = __builtin_amdgcn_mfma_f32_16x16x32_bf16(kb, qf[1], a, 0, 0, 0);
    }
#pragma unroll
    for (int kt = 0; kt < 8; ++kt) {
#pragma unroll
      for (int r = 0; r < 4; ++r) {
        const int df = iq - (kc * 128 + kt * 16 + 4 * lq + r);
        const float fdf = (float)df;
        float coef = 0.f;
        if (df >= 0) coef += __builtin_amdgcn_exp2f(lgF2 * fdf);
        if (df <= 0) coef += __builtin_amdgcn_exp2f(-lgB2 * fdf);
        S[kt][r] *= coef;
      }
    }
#pragma unroll
    for (int g = 0; g < 4; ++g) {
      union { unsigned u[4]; bf16x8 v; } pf;
      pf.u[0] = cvt_pk_bf16(S[2 * g][0], S[2 * g][1]); pf.u[1] = cvt_pk_bf16(S[2 * g][2], S[2 * g][3]);
      pf.u[2] = cvt_pk_bf16(S[2 * g + 1][0], S[2 * g + 1][1]); pf.u[3] = cvt_pk_bf16(S[2 * g + 1][2], S[2 * g + 1][3]);
#pragma unroll
      for (int et = 0; et < 8; ++et) {
        union { uint2 h2[2]; bf16x8 v; } vf;
        vf.h2[0] = *(const uint2*)(Vt + (et * 16 + lr) * RT_VS + 32 * g + 4 * lq);
        vf.h2[1] = *(const uint2*)(Vt + (et * 16 + lr) * RT_VS + 32 * g + 16 + 4 * lq);
        O[et] = __builtin_amdgcn_mfma_f32_16x16x32_bf16(vf.v, pf.v, O[et], 0, 0, 0);
      }
    }
  }
  float ss = 0.f;
#pragma unroll
  for (int et = 0; et < 8; ++et) { ss = fmaf(O[et][0], O[et][0], ss); ss = fmaf(O[et][1], O[et][1], ss); ss = fmaf(O[et][2], O[et][2], ss); ss = fmaf(O[et][3], O[et][3], ss); }
  ss += __shfl_xor(ss, 16); ss += __shfl_xor(ss, 32);
  const float rr = rsqrtf(ss * (1.f / 128.f) + EPS);
  const bf16_t* gp = P + mq * INC + C_RTG + h * 128;
  bf16_t* dst = Y + mq * 1024 + Y_RT + h * 128;
#pragma unroll
  for (int et = 0; et < 8; ++et) {
    const int e = et * 16 + 4 * lq;
    const uint2 gu = *(const uint2*)(gp + e);
    uint2 ov;
    ov.x = pack2(O[et][0] * rr * siluf(lo16(gu.x)), O[et][1] * rr * siluf(hi16(gu.x)));
    ov.y = pack2(O[et][2] * rr * siluf(lo16(gu.y)), O[et][3] * rr * siluf(hi16(gu.y)));
    *(uint2*)(dst + e) = ov;
  }
}

__device__ __forceinline__ void uv_convert_item(const Params& p, int item) {
  char* ws = p.ws;
  const int tid = opaque_tid();
  const int lane = tid & 63, l = lane & 31, half = lane >> 5, wave = tid >> 6;
#pragma unroll 1
  for (int it = 0; it < 16; ++it) {
    const int row = item * 256 + (wave * 16 + it) * 2 + half;
    const bool isv = row >= 2 * NEXP;
    const int rr = isv ? row - 2 * NEXP : row;
    const float* srow = (isv ? p.peer_v : p.peer_u) + (size_t)rr * 1024;
    float4 v[8];
    float mx = 0.f;
#pragma unroll
    for (int j = 0; j < 8; ++j) {
      v[j] = ((const float4*)srow)[isv ? (l + 32 * j) : (l * 8 + j)];
      mx = fmaxf(mx, fmaxf(fmaxf(fabsf(v[j].x), fabsf(v[j].y)), fmaxf(fabsf(v[j].z), fabsf(v[j].w))));
    }
#pragma unroll
    for (int o = 1; o < 32; o <<= 1) mx = fmaxf(mx, __shfl_xor(mx, o));
    const float scale4 = mx > 0.f ? mx * (1.f / 6.f) : 1.f;
    const float inv4 = 1.f / scale4;
    unsigned w[4] = {0u, 0u, 0u, 0u};
#pragma unroll
    for (int k = 0; k < 32; ++k) {
      const float xv = (k & 3) == 0 ? v[k >> 2].x : (k & 3) == 1 ? v[k >> 2].y : (k & 3) == 2 ? v[k >> 2].z : v[k >> 2].w;
      const float a = fminf(fabsf(xv) * inv4, 6.f);
      float c;
      if (a < 2.f) c = rintf(a * 2.f);
      else if (a < 4.f) c = 4.f + rintf(a - 2.f);
      else c = 6.f + rintf((a - 4.f) * 0.5f);
      unsigned code = (unsigned)c;
      code = code > 7u ? 7u : code;
      code |= (xv < 0.f) ? 8u : 0u;
      w[k >> 3] |= code << (4 * (k & 7));
    }
    char* drow = ws + OFF_U + (size_t)rr * RECB + (isv ? ROWB + l * 16 : 64 * (l & 7) + 16 * (l >> 3));
    *(uint4*)(drow) = make_uint4(w[0], w[1], w[2], w[3]);
    if (l == 0) ((float*)(ws + (isv ? OFF_VSC : OFF_USC)))[rr] = scale4;
  }
}

__device__ __forceinline__ void phase_mix1(const Params& p, int layer, char* smem, int slot = 0) {
  unsigned* ctr = (unsigned*)(p.ws + OFF_CTL) + (layer * 4 + slot);
  const bool nc = layer == 0;
  const int n_dl = 512, n_dc = nc ? 32 : 0, n_nl = 2048, n_ncx = nc ? 64 : 0, n_kv = 1024, n_cs = 32;
  const int total = n_dl + n_dc + n_nl + n_ncx + n_kv + n_cs;
  float* rkv = (float*)(p.ws + OFF_RKV);
  float* rs = (float*)(p.ws + OFF_RS);
  for (;;) {
    int it = next_item(ctr, smem);
    if (it >= total) break;
    if (it < n_dl) { diff_item(p, layer, false, it, smem); continue; } it -= n_dl;
    if (it < n_dc) { diff_item(p, layer, true, it, smem); continue; } it -= n_dc;
    if (it < n_nl) { na_latent_item(p, layer, it, smem); continue; } it -= n_nl;
    if (it < n_ncx) { na_ctx_item(p, it, smem); continue; } it -= n_ncx;
    if (it < n_kv) {
      const int bh = it >> 5, n = it & 31, b = bh >> 2, h = bh & 3;
      ret_kv_item(p, layer, h, (size_t)b * 4096 + n * 128, 128,
                  rkv + ((size_t)(bh * 2 + 0) * 32 + n) * 8192, rkv + ((size_t)(bh * 2 + 1) * 32 + n) * 8192, smem);
      continue;
    }
    it -= n_kv;
    {
      const int bh = it, b = bh >> 2, h = bh & 3;
      ret_kv_item(p, layer, h, (size_t)NLAT + b * 256, 256, rs + (size_t)(bh * 2 + 0) * 8192, rs + (size_t)(bh * 2 + 1) * 8192, smem);
    }
  }
}

__device__ __forceinline__ void phase_mix2(const Params& p, int layer, char* smem, int slot = 1) {
  unsigned* ctr = (unsigned*)(p.ws + OFF_CTL) + (layer * 4 + slot);
  const int n_l = 1024, n_c = layer == 0 ? 64 : 0;
  const float* rkv = (const float*)(p.ws + OFF_RKV);
  for (;;) {
    int it = next_item(ctr, smem);
    if (it >= n_l + n_c) break;
    if (it < n_l) {
      const int bh = it >> 5, n = it & 31, b = bh >> 2, h = bh & 3;
      ret_out_item(p, layer, h, (size_t)b * 4096 + n * 128, 1, 0,
                   rkv + ((size_t)(bh * 2 + 0) * 32 + n) * 8192, rkv + ((size_t)(bh * 2 + 1) * 32 + n) * 8192, 128, smem);
    } else {
      it -= n_l;
      const int bh = it >> 1, half = it & 1, b = bh >> 2, h = bh & 3;
      ret_out_item(p, layer, h, (size_t)NLAT + b * 256, 2, half * 128, nullptr, nullptr, 256, smem);
    }
  }
}

typedef float f32x2 __attribute__((ext_vector_type(2)));
__device__ __forceinline__ unsigned sortable_key(float f, int idx) {
  const unsigned b = __float_as_uint(f);
  const unsigned k = b ^ ((unsigned)((int)b >> 31) | 0x80000000u);
  return (k & ~127u) | (unsigned)(127 - idx);
}
__device__ __forceinline__ float key_value(unsigned k) {
  k &= ~127u;
  const unsigned b = (k & 0x80000000u) ? (k ^ 0x80000000u) : ~k;
  return __uint_as_float(b);
}
#define FP8DOT(acc, H, off, W) { const f32x2 _a = __builtin_amdgcn_cvt_pk_f32_fp8((int)(W), false), _b = __builtin_amdgcn_cvt_pk_f32_fp8((int)(W), true); \
  acc = fmaf(H[(off) + 0], _a.x, acc); acc = fmaf(H[(off) + 1], _a.y, acc); acc = fmaf(H[(off) + 2], _b.x, acc); acc = fmaf(H[(off) + 3], _b.y, acc); }
#define FP8AXPY(O, off, P, W) { const f32x2 _a = __builtin_amdgcn_cvt_pk_f32_fp8((int)(W), false), _b = __builtin_amdgcn_cvt_pk_f32_fp8((int)(W), true); \
  O[(off) + 0] = fmaf(P, _a.x, O[(off) + 0]); O[(off) + 1] = fmaf(P, _a.y, O[(off) + 1]); O[(off) + 2] = fmaf(P, _b.x, O[(off) + 2]); O[(off) + 3] = fmaf(P, _b.y, O[(off) + 3]); }

__device__ __forceinline__ float gelu_erf(float a) {
  const float x = fabsf(a) * 0.70710678118654752f;
  const float t = __builtin_amdgcn_rcpf(fmaf(0.3275911f, x, 1.f));
  float pl = fmaf(1.061405429f, t, -1.453152027f);
  pl = fmaf(pl, t, 1.421413741f); pl = fmaf(pl, t, -0.284496736f); pl = fmaf(pl, t, 0.254829592f);
  const float y = 1.f - pl * t * __builtin_amdgcn_exp2f(-x * x * 1.4426950408889634f);
  const float er = a < 0.f ? -y : y;
  return 0.5f * a * (1.f + er);
}
constexpr int PE_SVS = 132;
constexpr int PE_OFF_SV = 0;
constexpr int PE_OFF_TV = 8 * 16 * PE_SVS * 4;
constexpr int PE_OFF_TI = PE_OFF_TV + 16 * 16 * 16 * 4;
constexpr int PE_OFF_EX = PE_OFF_TI + 16 * 16 * 16 * 4;
constexpr int PE_OFF_GT = PE_OFF_EX + 2 * 16 * 128 * 4;
constexpr int PE_OFF_SU = PE_OFF_GT + 2 * 16 * 128 * 4;
constexpr int PE_OFF_CN = PE_OFF_SU + 2 * 16 * 128 * 4;
constexpr int PE_OFF_CT = PE_OFF_CN + 8 * 16 * 4;
constexpr int PE_OFF_TQ = PE_OFF_CT + 64 * 4;
static_assert(PE_OFF_TQ + 16 <= LDS_BCAST, "PEER LDS map overflows");
#define WAVE_LDS_FENCE() asm volatile("s_waitcnt lgkmcnt(0)" ::: "memory")

__device__ __forceinline__ void peer_select_head(const Params& p, int layer, char* smem, int tok0, int hd, int sw, int buf,
                                                 int lane) {
  const bf16_t* Q = (const bf16_t*)(p.ws + OFF_P);
  const bf16_t* SK = (const bf16_t*)(p.ws + OFF_SUBK) + (size_t)layer * 262144;
  const int lr = lane & 15, lq = lane >> 4;
  unsigned* SV = (unsigned*)(smem + PE_OFF_SV) + sw * 16 * PE_SVS;
  float* TV = (float*)(smem + PE_OFF_TV);
  int* TI = (int*)(smem + PE_OFF_TI);
  int* EX = (int*)(smem + PE_OFF_EX) + buf * 16 * 128;
  float* GT = (float*)(smem + PE_OFF_GT) + buf * 16 * 128;
  int* CN = (int*)(smem + PE_OFF_CN) + sw * 16;
  float* SU = (float*)(smem + PE_OFF_SU) + buf * 16 * 128;
  const float* USC = (const float*)(p.ws + OFF_USC) + layer * NEXP;
  const float* VSC = (const float*)(p.ws + OFF_VSC) + layer * NEXP;
#pragma unroll 1
  for (int pp = 0; pp < 2; ++pp) {
    bf16x8 af[4];
    const bf16_t* qrow = Q + (size_t)(tok0 + lr) * 2048 + hd * 256 + pp * 128;
#pragma unroll
    for (int ks = 0; ks < 4; ++ks) af[ks] = *(const bf16x8*)(qrow + ks * 32 + lq * 8);
    const bf16_t* skb = SK + (size_t)((hd * 2 + pp) * 128) * 128;
    f32x4 acc[8];
    {
      bf16x8 bfr[8][4];
#pragma unroll
      for (int nt = 0; nt < 8; ++nt)
#pragma unroll
        for (int ks = 0; ks < 4; ++ks)
          bfr[nt][ks] = *(const bf16x8*)(skb + (size_t)(nt * 16 + lr) * 128 + ks * 32 + lq * 8);
#pragma unroll
      for (int nt = 0; nt < 8; ++nt) {
        f32x4 a = (f32x4){0.f, 0.f, 0.f, 0.f};
#pragma unroll
        for (int ks = 0; ks < 4; ++ks) a = __builtin_amdgcn_mfma_f32_16x16x32_bf16(af[ks], bfr[nt][ks], a, 0, 0, 0);
        acc[nt] = a;
      }
    }
#pragma unroll
    for (int i = 0; i < 9; ++i) { const int q4 = lane + 64 * i; if (q4 < 16 * PE_SVS / 4) ((uint4*)SV)[q4] = make_uint4(0u, 0u, 0u, 0u); }
    WAVE_LDS_FENCE();
#pragma unroll
    for (int r = 0; r < 4; ++r) {
      const int tk = 4 * lq + r;
      unsigned k[8];
#pragma unroll
      for (int nt = 0; nt < 8; ++nt) k[nt] = sortable_key(acc[nt][r], nt * 16 + lr);
      unsigned m1 = max(k[0], k[1]), m2 = min(k[0], k[1]);
#pragma unroll
      for (int nt = 2; nt < 8; ++nt) { m2 = max(m2, min(m1, k[nt])); m1 = max(m1, k[nt]); }
      const unsigned Ta = row16_min_u32(m1);
      const unsigned Tb = min(row16_kth_largest<11>(m1), row16_kth_largest<5>(m2));
      const unsigned T = max(Ta, Tb);
      int pos = 0;
#pragma unroll
      for (int nt = 0; nt < 8; ++nt) {
        const bool sel = k[nt] >= T;
        const unsigned long long bal = __ballot(sel);
        const unsigned grp16 = (unsigned)(bal >> (16 * lq)) & 0xffffu;
        const int below = __popc(grp16 & ((1u << lr) - 1u));
        if (sel) SV[tk * PE_SVS + pos + below] = k[nt];
        pos += __popc(grp16);
      }
      if (lr == 0) CN[tk] = pos;
    }
    WAVE_LDS_FENCE();
#pragma unroll 1
    for (int pass = 0; pass < 4; ++pass) {
      const int tk = pass * 4 + lq;
      const int cnt = CN[tk];
      const unsigned* row = SV + tk * PE_SVS;
      int cm = cnt;
      cm = max(cm, __shfl_xor(cm, 16)); cm = max(cm, __shfl_xor(cm, 32));
      const int cmax = __builtin_amdgcn_readfirstlane(cm);
      const int nblk = (cmax + 15) >> 4;
#pragma unroll 1
      for (int rd = 0; rd < nblk; ++rd) {
        const int j = rd * 16 + lr;
        const unsigned my = row[j];
        int rank = 0;
#pragma unroll 1
        for (int b4 = 0; b4 < nblk; ++b4) {
          const uint4 v0 = *(const uint4*)(row + b4 * 16), v1 = *(const uint4*)(row + b4 * 16 + 4);
          const uint4 v2 = *(const uint4*)(row + b4 * 16 + 8), v3 = *(const uint4*)(row + b4 * 16 + 12);
          rank += (v0.x > my) ? 1 : 0; rank += (v0.y > my) ? 1 : 0; rank += (v0.z > my) ? 1 : 0; rank += (v0.w > my) ? 1 : 0;
          rank += (v1.x > my) ? 1 : 0; rank += (v1.y > my) ? 1 : 0; rank += (v1.z > my) ? 1 : 0; rank += (v1.w > my) ? 1 : 0;
          rank += (v2.x > my) ? 1 : 0; rank += (v2.y > my) ? 1 : 0; rank += (v2.z > my) ? 1 : 0; rank += (v2.w > my) ? 1 : 0;
          rank += (v3.x > my) ? 1 : 0; rank += (v3.y > my) ? 1 : 0; rank += (v3.z > my) ? 1 : 0; rank += (v3.w > my) ? 1 : 0;
        }
        if (j < cnt && rank < 16) {
          TV[(tk * 16 + hd * 2 + pp) * 16 + rank] = key_value(my);
          TI[(tk * 16 + hd * 2 + pp) * 16 + rank] = 127 - (int)(my & 127u);
        }
      }
    }
    WAVE_LDS_FENCE();
  }
  {
    const int cab = ((const int*)(smem + PE_OFF_CT))[lane];
    const int cand_a = cab >> 4, cand_b = cab & 15;
    unsigned* CWt = SV;
    float vals[16];
#pragma unroll
    for (int tk = 0; tk < 16; ++tk) {
      float val = 0.f;
      unsigned key = 0u;
      if (cand_a >= 0) {
        val = TV[(tk * 16 + hd * 2 + 0) * 16 + cand_a] + TV[(tk * 16 + hd * 2 + 1) * 16 + cand_b];
        const unsigned bb = __float_as_uint(val);
        key = ((bb ^ ((unsigned)((int)bb >> 31) | 0x80000000u)) & ~63u) | (unsigned)(63 - lane);
      }
      vals[tk] = val;
      CWt[tk * 64 + lane] = key;
    }
    WAVE_LDS_FENCE();
#pragma unroll
    for (int tk = 0; tk < 16; ++tk) {
      const unsigned key = CWt[tk * 64 + lane];
      int rank = 0;
#pragma unroll
      for (int i4 = 0; i4 < 13; ++i4) {
        const uint4 v = *(const uint4*)(CWt + tk * 64 + i4 * 4);
        rank += (v.x > key) ? 1 : 0; rank += (v.y > key) ? 1 : 0; rank += (v.z > key) ? 1 : 0; rank += (v.w > key) ? 1 : 0;
      }
      if (cand_a >= 0 && rank < 16) {
        GT[tk * 128 + hd * 16 + rank] = vals[tk];
        EX[tk * 128 + hd * 16 + rank] = TI[(tk * 16 + hd * 2 + 0) * 16 + cand_a] * 128 + TI[(tk * 16 + hd * 2 + 1) * 16 + cand_b];
      }
    }
    WAVE_LDS_FENCE();
#pragma unroll
    for (int pass = 0; pass < 4; ++pass) {
      const int tk = pass * 4 + lq;
      const float g = GT[tk * 128 + hd * 16 + lr];
      const float mx = GT[tk * 128 + hd * 16];
      const float ev = __expf(g - mx);
      float s = ev;
      s += __shfl_xor(s, 1); s += __shfl_xor(s, 2); s += __shfl_xor(s, 4); s += __shfl_xor(s, 8);
      const int ex = EX[tk * 128 + hd * 16 + lr];
      GT[tk * 128 + hd * 16 + lr] = (ev / s) * VSC[ex];
      SU[tk * 128 + hd * 16 + lr] = USC[ex];
    }
    WAVE_LDS_FENCE();
  }
}

typedef float f32x32 __attribute__((ext_vector_type(32)));
typedef int i32x8 __attribute__((ext_vector_type(8)));
typedef int i32x6 __attribute__((ext_vector_type(6)));
typedef unsigned u32x6 __attribute__((ext_vector_type(6)));
#define FP4_AXPY8(O, off, P, W) {                                                                    \
  const f32x2 _q0 = __builtin_amdgcn_cvt_scalef32_pk_f32_fp4((W), 1.0f, 0), _q1 = __builtin_amdgcn_cvt_scalef32_pk_f32_fp4((W), 1.0f, 1); \
  const f32x2 _q2 = __builtin_amdgcn_cvt_scalef32_pk_f32_fp4((W), 1.0f, 2), _q3 = __builtin_amdgcn_cvt_scalef32_pk_f32_fp4((W), 1.0f, 3); \
  O[(off) + 0] = fmaf(P, _q0.x, O[(off) + 0]); O[(off) + 1] = fmaf(P, _q0.y, O[(off) + 1]);          \
  O[(off) + 2] = fmaf(P, _q1.x, O[(off) + 2]); O[(off) + 3] = fmaf(P, _q1.y, O[(off) + 3]);          \
  O[(off) + 4] = fmaf(P, _q2.x, O[(off) + 4]); O[(off) + 5] = fmaf(P, _q2.y, O[(off) + 5]);          \
  O[(off) + 6] = fmaf(P, _q3.x, O[(off) + 6]); O[(off) + 7] = fmaf(P, _q3.y, O[(off) + 7]); }
struct Fp6Row { uint4 a; uint2 b; };
typedef __bf16 bf16x32_t __attribute__((ext_vector_type(32)));
__device__ __forceinline__ bf16x32_t fp6_decode_bf16(const Fp6Row& r) {
  u32x6 w; w[0] = r.a.x; w[1] = r.a.y; w[2] = r.a.z; w[3] = r.a.w; w[4] = r.b.x; w[5] = r.b.y;
  return __builtin_amdgcn_cvt_scalef32_pk32_bf16_fp6(w, 1.0f);
}
__device__ __forceinline__ f32x32 fp6_decode(const Fp6Row& r) {
  u32x6 w; w[0] = r.a.x; w[1] = r.a.y; w[2] = r.a.z; w[3] = r.a.w; w[4] = r.b.x; w[5] = r.b.y;
  return __builtin_amdgcn_cvt_scalef32_pk32_f32_fp6(w, 1.0f);
}
__device__ __forceinline__ void peer_gather_token(const Params& p, int layer, char* smem, int tok, int tl, int buf, int lane, bool dowrite) {
  const bf16_t* H2 = (const bf16_t*)(p.ws + OFF_ACT);
  const char* U6 = p.ws + OFF_U + (size_t)layer * NEXP * RECB;
  const float* mod = (const float*)(p.ws + OFF_MOD) + (size_t)layer * 9 * 6144;
  const int* EX = (const int*)(smem + PE_OFF_EX) + buf * 16 * 128 + tl * 128;
  const float* GT = (const float*)(smem + PE_OFF_GT) + buf * 16 * 128 + tl * 128;
  const float* SU = (const float*)(smem + PE_OFF_SU) + buf * 16 * 128 + tl * 128;
  const int l = lane & 31, hf = lane >> 5;
  float acc[32];
  const int wv = __builtin_amdgcn_readfirstlane(threadIdx.x >> 6);
  unsigned char* XB = (unsigned char*)(smem + PE_OFF_SV) + wv * 16 * PE_SVS * 4;
  float* WD = (float*)(XB + 1024);
#define PE_LOADV(VV, PI) VV = *(const uint4*)(U6 + (size_t)EX[2 * (PI) + hf] * RECB + ROWB + l * 16);
  uint4 v0, v1, v2, v3, v4, v5, v6, v7, v8, v9, v10, v11, v12, v13, v14, v15;
  const int e16 = lane & 15, kg = lane >> 4;
  uint4 qa0, qa1, qa2, qa3, qa4, qa5, qa6, qa7, qb0, qb1, qb2, qb3, qb4, qb5, qb6, qb7, qc0, qc1, qc2, qc3, qc4, qc5, qc6, qc7;
  unsigned char* STG = XB + 1536;
  constexpr int STGP = 576;
#define PE_LOADA1(Q, EB, I) Q##I = *(const uint4*)(U6 + (size_t)EX[(EB) * 16 + 2 * (I) + hf] * RECB + l * 16);
#define PE_LOADA(Q, EB) { PE_LOADA1(Q, EB, 0) PE_LOADA1(Q, EB, 1) PE_LOADA1(Q, EB, 2) PE_LOADA1(Q, EB, 3) PE_LOADA1(Q, EB, 4) PE_LOADA1(Q, EB, 5) PE_LOADA1(Q, EB, 6) PE_LOADA1(Q, EB, 7) }
  PE_LOADA(qa, 0) PE_LOADA(qb, 1)
  float xscale;
  {
    const bf16_t* hr = H2 + (size_t)tok * 1024 + lane * 16;
    const uint4 a = *(const uint4*)hr, b2 = *(const uint4*)(hr + 8);
    float xv[16];
    UNPACK8(xv, 0, a) UNPACK8(xv, 8, b2)
    float mx = 0.f;
#pragma unroll
    for (int i = 0; i < 16; ++i) mx = fmaxf(mx, fabsf(xv[i]));
#pragma unroll
    for (int o = 1; o < 64; o <<= 1) mx = fmaxf(mx, __shfl_xor(mx, o));
    xscale = mx > 0.f ? mx * (1.f / 7.5f) : 1.f;
    const float inv = 1.f / xscale;
    unsigned w0 = 0u, w1 = 0u, w2 = 0u;
#pragma unroll
    for (int i = 0; i < 16; ++i) {
      const float av = fminf(fabsf(xv[i]) * inv, 7.5f);
      float c;
      if (av < 2.f) c = rintf(av * 8.f);
      else if (av < 4.f) c = 16.f + rintf((av - 2.f) * 4.f);
      else c = 24.f + rintf((av - 4.f) * 2.f);
      unsigned code = (unsigned)c;
      code = code > 31u ? 31u : code;
      code |= (xv[i] < 0.f) ? 32u : 0u;
      const int bit = 6 * i, wd = bit >> 5, sh = bit & 31;
      if (wd == 0) w0 |= code << sh; else if (wd == 1) w1 |= code << sh; else w2 |= code << sh;
      if (sh > 26) { if (wd == 0) w1 |= code >> (32 - sh); else if (wd == 1) w2 |= code >> (32 - sh); }
    }
    unsigned* xo = (unsigned*)(XB + lane * 12);
    xo[0] = w0; xo[1] = w1; xo[2] = w2;
  }
  WAVE_LDS_FENCE();
  {
    i32x8 Bx[8];
#pragma unroll
    for (int kb = 0; kb < 8; ++kb) {
      const uint2* bp = (const uint2*)(XB + 192 * kg + 24 * kb);
      const uint2 b0 = bp[0], b1 = bp[1], b2 = bp[2];
      Bx[kb] = (i32x8){(int)b0.x, (int)b0.y, (int)b1.x, (int)b1.y, (int)b2.x, (int)b2.y, 0, 0};
    }
#define PE_MMAU(Q, EB) {                                                                                     \
    uint4 a0_ = {0u, 0u, 0u, 0u}, a1_ = a0_, a2_ = a0_, a3_ = a0_, a4_ = a0_, a5_ = a0_, a6_ = a0_, a7_ = a0_;   \
    const unsigned char* rdp_ = STG + (e16 & 7) * STGP + 16 * kg;                                            \
    { unsigned char* wp_ = STG + hf * STGP + l * 16;                                                         \
      *(uint4*)(wp_) = Q##0; *(uint4*)(wp_ + 2 * STGP) = Q##1; *(uint4*)(wp_ + 4 * STGP) = Q##2; *(uint4*)(wp_ + 6 * STGP) = Q##3; } \
    if (e16 < 8) { a0_ = *(const uint4*)(rdp_); a1_ = *(const uint4*)(rdp_ + 64); a2_ = *(const uint4*)(rdp_ + 128); a3_ = *(const uint4*)(rdp_ + 192); \
                   a4_ = *(const uint4*)(rdp_ + 256); a5_ = *(const uint4*)(rdp_ + 320); a6_ = *(const uint4*)(rdp_ + 384); a7_ = *(const uint4*)(rdp_ + 448); } \
    { unsigned char* wp_ = STG + hf * STGP + l * 16;                                                         \
      *(uint4*)(wp_) = Q##4; *(uint4*)(wp_ + 2 * STGP) = Q##5; *(uint4*)(wp_ + 4 * STGP) = Q##6; *(uint4*)(wp_ + 6 * STGP) = Q##7; } \
    if (e16 >= 8) { a0_ = *(const uint4*)(rdp_); a1_ = *(const uint4*)(rdp_ + 64); a2_ = *(const uint4*)(rdp_ + 128); a3_ = *(const uint4*)(rdp_ + 192); \
                    a4_ = *(const uint4*)(rdp_ + 256); a5_ = *(const uint4*)(rdp_ + 320); a6_ = *(const uint4*)(rdp_ + 384); a7_ = *(const uint4*)(rdp_ + 448); } \
    f32x4 dacc = {0.f, 0.f, 0.f, 0.f};                                                                       \
    _Pragma("unroll") for (int kb = 0; kb < 8; ++kb) {                                                       \
      const uint4 ak_ = kb == 0 ? a0_ : kb == 1 ? a1_ : kb == 2 ? a2_ : kb == 3 ? a3_ : kb == 4 ? a4_ : kb == 5 ? a5_ : kb == 6 ? a6_ : a7_; \
      const i32x8 av = {(int)ak_.x, (int)ak_.y, (int)ak_.z, (int)ak_.w, 0, 0, 0, 0};                         \
      dacc = __builtin_amdgcn_mfma_scale_f32_16x16x128_f8f6f4(av, Bx[kb], dacc, 4, 2, 0, 0x7f7f7f7f, 0, 0x7f7f7f7f); \
    }                                                                                                        \
    asm volatile("" : "+v"(dacc));        \
    if (e16 == 0) *(float4*)(WD + (EB) * 16 + 4 * kg) = (float4){dacc[0], dacc[1], dacc[2], dacc[3]};        \
  }
    PE_LOADA(qc, 2) PE_MMAU(qa, 0)
    PE_LOADA(qa, 3) PE_MMAU(qb, 1)
    PE_LOADA(qb, 4) PE_MMAU(qc, 2)
    PE_LOADA(qc, 5) PE_MMAU(qa, 3)
    PE_LOADA(qa, 6) PE_MMAU(qb, 4)
    PE_LOADA(qb, 7) PE_MMAU(qc, 5)
    PE_LOADV(v0, 0) PE_LOADV(v1, 1) PE_LOADV(v2, 2) PE_LOADV(v3, 3) PE_LOADV(v4, 4) PE_LOADV(v5, 5) PE_MMAU(qa, 6)
    PE_LOADV(v6, 6) PE_LOADV(v7, 7) PE_LOADV(v8, 8) PE_LOADV(v9, 9) PE_LOADV(v10, 10) PE_LOADV(v11, 11) PE_MMAU(qb, 7)
    PE_LOADV(v12, 12) PE_LOADV(v13, 13) PE_LOADV(v14, 14) PE_LOADV(v15, 15)
  }
  WAVE_LDS_FENCE();
#pragma unroll
  for (int q = 0; q < 2; ++q) {
    const int e = lane + 64 * q;
    WD[e] = GT[e] * gelu_erf(WD[e] * SU[e] * xscale);
  }
  WAVE_LDS_FENCE();
#pragma unroll
  for (int i = 0; i < 32; ++i) acc[i] = 0.f;
  int one = 1;
  asm volatile("" : "+s"(one));
  const int b = tok < NLAT ? (tok >> 12) : 8;
  float* xr = tok < NLAT ? p.out + (size_t)tok * 1024 : (float*)(p.ws + OFF_CTXB) + (size_t)(tok - NLAT) * 1024;
  const float* gate = mod + (size_t)b * 6144 + 5 * 1024;
  float4 xv4[4], gv4[4];
#pragma unroll
  for (int jj = 0; jj < 4; ++jj) {
    const int c = (l + 32 * (4 * hf + jj)) * 4;
    xv4[jj] = *(const float4*)(xr + c);
    gv4[jj] = *(const float4*)(gate + c);
  }
#define PE_USEV(VV, PI)                                                               \
  _Pragma("unroll 1") for (int rep_ = 0; rep_ < one; ++rep_) {                        \
    const float w = WD[2 * (PI) + hf];                                                \
    FP4_AXPY8(acc, 0, w, VV.x) FP4_AXPY8(acc, 8, w, VV.y) FP4_AXPY8(acc, 16, w, VV.z) FP4_AXPY8(acc, 24, w, VV.w) \
  }
#pragma unroll 1
  for (int pi = 0; pi < 48; pi += 16) {
    PE_USEV(v0, pi + 0) PE_LOADV(v0, pi + 16)
    PE_USEV(v1, pi + 1) PE_LOADV(v1, pi + 17)
    PE_USEV(v2, pi + 2) PE_LOADV(v2, pi + 18)
    PE_USEV(v3, pi + 3) PE_LOADV(v3, pi + 19)
    PE_USEV(v4, pi + 4) PE_LOADV(v4, pi + 20)
    PE_USEV(v5, pi + 5) PE_LOADV(v5, pi + 21)
    PE_USEV(v6, pi + 6) PE_LOADV(v6, pi + 22)
    PE_USEV(v7, pi + 7) PE_LOADV(v7, pi + 23)
    PE_USEV(v8, pi + 8) PE_LOADV(v8, pi + 24)
    PE_USEV(v9, pi + 9) PE_LOADV(v9, pi + 25)
    PE_USEV(v10, pi + 10) PE_LOADV(v10, pi + 26)
    PE_USEV(v11, pi + 11) PE_LOADV(v11, pi + 27)
    PE_USEV(v12, pi + 12) PE_LOADV(v12, pi + 28)
    PE_USEV(v13, pi + 13) PE_LOADV(v13, pi + 29)
    PE_USEV(v14, pi + 14) PE_LOADV(v14, pi + 30)
    PE_USEV(v15, pi + 15) PE_LOADV(v15, pi + 31)
  }
  PE_USEV(v0, 48) PE_USEV(v1, 49) PE_USEV(v2, 50) PE_USEV(v3, 51) PE_USEV(v4, 52) PE_USEV(v5, 53) PE_USEV(v6, 54) PE_USEV(v7, 55) PE_USEV(v8, 56) PE_USEV(v9, 57) PE_USEV(v10, 58) PE_USEV(v11, 59) PE_USEV(v12, 60) PE_USEV(v13, 61) PE_USEV(v14, 62) PE_USEV(v15, 63)
#pragma unroll
  for (int k = 0; k < 32; ++k) acc[k] += __shfl_xor(acc[k], 32);
  float4 xn[4];
  float ss = 0.f;
#pragma unroll
  for (int jj = 0; jj < 4; ++jj) {
    const int c = (l + 32 * (4 * hf + jj)) * 4;
    const float4 xv = xv4[jj];
    const float4 gv = gv4[jj];
    const float a0 = hf ? acc[16 + 4 * jj + 0] : acc[4 * jj + 0], a1 = hf ? acc[16 + 4 * jj + 1] : acc[4 * jj + 1];
    const float a2 = hf ? acc[16 + 4 * jj + 2] : acc[4 * jj + 2], a3 = hf ? acc[16 + 4 * jj + 3] : acc[4 * jj + 3];
    xn[jj].x = xv.x + gv.x * a0; xn[jj].y = xv.y + gv.y * a1; xn[jj].z = xv.z + gv.z * a2; xn[jj].w = xv.w + gv.w * a3;
    ss += xn[jj].x * xn[jj].x + xn[jj].y * xn[jj].y + xn[jj].z * xn[jj].z + xn[jj].w * xn[jj].w;
  }
  ss = wave_sum(ss);
  const float rinv = rsqrtf(ss * (1.f / 1024.f) + EPS);
  if (layer == 0) {
    const float* mod1 = (const float*)(p.ws + OFF_MOD) + (size_t)9 * 6144 + (size_t)b * 6144;
    const float* g1 = p.norm1_g + 1024;
    bf16_t* act = (bf16_t*)(p.ws + OFF_ACT) + (size_t)tok * 1024;
#pragma unroll
    for (int jj = 0; jj < 4; ++jj) {
      const int c = (l + 32 * (4 * hf + jj)) * 4;
      if (dowrite) *(float4*)(xr + c) = xn[jj]; else asm volatile("" :: "v"(xn[jj].x), "v"(xn[jj].y), "v"(xn[jj].z), "v"(xn[jj].w));
      const float4 gg4 = *(const float4*)(g1 + c);
      const float4 sh = *(const float4*)(mod1 + c);
      const float4 sc = *(const float4*)(mod1 + 1024 + c);
      uint2 o;
      o.x = pack2h(xn[jj].x * rinv * gg4.x * (1.f + sc.x) + sh.x, xn[jj].y * rinv * gg4.y * (1.f + sc.y) + sh.y);
      o.y = pack2h(xn[jj].z * rinv * gg4.z * (1.f + sc.z) + sh.z, xn[jj].w * rinv * gg4.w * (1.f + sc.w) + sh.w);
      if (dowrite) *(uint2*)(act + c) = o; else asm volatile("" :: "v"(o.x), "v"(o.y));
    }
  } else {
#pragma unroll
    for (int jj = 0; jj < 4; ++jj) {
      const int c = (l + 32 * (4 * hf + jj)) * 4;
      const float4 gg4 = *(const float4*)(p.final_g + c);
      float4 o;
      o.x = xn[jj].x * rinv * gg4.x; o.y = xn[jj].y * rinv * gg4.y; o.z = xn[jj].z * rinv * gg4.z; o.w = xn[jj].w * rinv * gg4.w;
      if (dowrite) *(float4*)(xr + c) = o; else asm volatile("" :: "v"(o.x), "v"(o.y), "v"(o.z), "v"(o.w));
    }
  }
}

__device__ __forceinline__ void phase_peer(const Params& p, int layer, char* smem, int ntok, bool dowrite = true) {
  const int tid = opaque_tid(), lane = tid & 63, wave = __builtin_amdgcn_readfirstlane(tid >> 6);
  __syncthreads();
  if (tid < 64) {
    int cab = -1, c = 0;
    for (int a = 0; a < 16; ++a)
      for (int bb = 0; bb < 16; ++bb)
        if ((a + 1) * (bb + 1) <= 16) { if (c == tid) cab = a * 16 + bb; ++c; }
    ((int*)(smem + PE_OFF_CT))[tid] = cab;
  }
  const int ngroups = ntok / 16, G = gridDim.x, g0 = opaque_bid();
  if (tid == 0) { ((int*)(smem + PE_OFF_TQ))[0] = 0; ((int*)(smem + PE_OFF_TQ))[1] = 0; }
  __syncthreads();
  const int R = ngroups / G, rem = ngroups % G;
  const bool split = rem > 0 && 2 * rem <= G;
#define PE_ITEM(r_, grp_, off_, cnt_)                                                                  \
  { grp_ = 0; off_ = 0; cnt_ = 0;                                                                      \
    if ((r_) >= 0 && (r_) < R) { grp_ = g0 + (r_) * G; cnt_ = 16; }                                    \
    else if ((r_) == R) {                                                                              \
      if (split) { if (g0 < 2 * rem) { grp_ = R * G + (g0 >> 1); off_ = (g0 & 1) * 8; cnt_ = 8; } }    \
      else if (g0 < rem) { grp_ = R * G + g0; cnt_ = 16; }                                             \
    } }
#pragma unroll 1
  for (int r = -1;; ++r) {
    int cur, coff, ngat, nxt, noff, ncnt;
    PE_ITEM(r, cur, coff, ngat)
    PE_ITEM(r + 1, nxt, noff, ncnt)
    const int nsel = ncnt > 0 ? 8 : 0;
    if (ngat + nsel == 0) break;
    const int b = r & 1, gper = ngat >> 3, sfirst = (wave & 1) == 0;
#pragma unroll 1
    for (int st = 0; st < 3; ++st) {
      const int slot = sfirst ? st : (st + 1) % 3;
      if (slot == 0) { if (nsel) peer_select_head(p, layer, smem, nxt * 16, wave, wave, b ^ 1, lane); }
      else if (slot - 1 < gper) {
        const int idx = wave * gper + slot - 1;
        peer_gather_token(p, layer, smem, cur * 16 + coff + idx, coff + idx, b, lane, dowrite);
      }
    }
    __syncthreads();
  }
}

template <int layer>
__device__ __forceinline__ void layer_body(const Params& p, char* smem, const XcdBarrier& xb) {
  constexpr bool nc = layer == 0;
  const float* xin = layer == 0 ? p.x : (const float*)p.out;
  if (layer == 0) {
    phase_norm(p, layer, 0, xin, NTOK);
    xcd_barrier(xb);
  }
#if REP_GEMM
  gemm_phase2<EPI_INPROJ>(p, layer, smem, (const bf16_t*)(p.ws + OFF_ACT), (const bf16_t*)(p.ws + OFF_WIN) + (size_t)layer * 3072 * 1024, NTOK, 3072, nullptr);
  xcd_barrier(xb);
#endif
  gemm_phase2<EPI_INPROJ>(p, layer, smem, (const bf16_t*)(p.ws + OFF_ACT), (const bf16_t*)(p.ws + OFF_WIN) + (size_t)layer * 3072 * 1024, NTOK, 3072, nullptr);
  xcd_barrier(xb);
#if REP_MIX1
  phase_mix1(p, layer, smem, 2);
  xcd_barrier(xb);
#endif
  phase_mix1(p, layer, smem);
  xcd_barrier(xb);
  phase_ret_scan(p, layer);
  xcd_barrier(xb);
#if REP_MIX2
  phase_mix2(p, layer, smem, 3);
  xcd_barrier(xb);
#endif
  phase_mix2(p, layer, smem);
  xcd_barrier(xb);
  gemm_phase2<EPI_OUTPROJ>(p, layer, smem, (const bf16_t*)(p.ws + OFF_ACT), (const bf16_t*)(p.ws + OFF_WOUT) + (size_t)layer * 1024 * 1024, nc ? NTOK : NLAT, 1024, xin);
  xcd_barrier(xb);
  phase_norm(p, layer, 1, (const float*)p.out, nc ? NTOK : NLAT);
  xcd_barrier(xb);
  gemm_phase2<EPI_PLAIN>(p, layer, smem, (const bf16_t*)(p.ws + OFF_ACT), (const bf16_t*)(p.ws + OFF_WQ) + (size_t)layer * 2048 * 1024, nc ? NTOK : NLAT, 2048, nullptr);
  xcd_barrier(xb);
#if REP_PEER
  phase_peer(p, layer, smem, nc ? NTOK : NLAT, false);
  xcd_barrier(xb);
#endif
  phase_peer(p, layer, smem, nc ? NTOK : NLAT);
  if (layer == 0) xcd_barrier(xb);
}

__global__ void __launch_bounds__(512) fwd_megakernel(Params p) {
  cg::grid_group grid = cg::this_grid();
  extern __shared__ __attribute__((aligned(16))) char smem[];
  volatile LAS3 unsigned* xst = (volatile LAS3 unsigned*)(smem + LDS_BCAST + 8);
  if (threadIdx.x == 0) { xst[0] = 0u; xst[1] = 0u; }
  phase_prep(p, smem);
  for (int it = blockIdx.x; it < 256; it += gridDim.x) uv_convert_item(p, it);
  grid.sync();
  const XcdBarrier xb = xcd_barrier_post((unsigned*)(p.ws + OFF_XBAR), xst);
  layer_body<0>(p, smem, xb);
  layer_body<1>(p, smem, xb);
}

extern "C" void kernel_launch(void* const* d_in, const int* in_sizes, int n_in, void* d_out,
                              int out_size, void* d_ws, size_t ws_size, hipStream_t stream) {
  constexpr size_t kDynLds = LDS_BYTES;
  static int grid_blocks = 0;
  if (!grid_blocks) {
    int dev = 0, cus = 0, per_cu = 0;
    (void)hipGetDevice(&dev);
    (void)hipDeviceGetAttribute(&cus, hipDeviceAttributeMultiprocessorCount, dev);
    (void)hipFuncSetAttribute((const void*)fwd_megakernel, hipFuncAttributeMaxDynamicSharedMemorySize, (int)kDynLds);
    (void)hipOccupancyMaxActiveBlocksPerMultiprocessor(&per_cu, fwd_megakernel, 512, kDynLds);
    if (per_cu < 1) { fprintf(stderr, "occupancy query says %d blocks/CU\n", per_cu); per_cu = 1; }
    grid_blocks = cus;
    if (ws_size < WS_END) fprintf(stderr, "workspace too small: %zu < %zu\n", ws_size, (size_t)WS_END);
  }
  Params p{};
  p.x = (const float*)d_in[0]; p.c = (const float*)d_in[1]; p.ctx = (const float*)d_in[2]; p.c_ctx = (const float*)d_in[3];
  p.w_ada = (const float*)d_in[4]; p.b_ada = (const float*)d_in[5]; p.norm1_g = (const float*)d_in[6]; p.w_in = (const float*)d_in[7];
  p.na_rpb = (const float*)d_in[8]; p.diff_lambda = (const float*)d_in[9]; p.diff_subln_g = (const float*)d_in[10];
  p.ret_decay_logit = (const float*)d_in[11]; p.w_out = (const float*)d_in[12]; p.norm2_g = (const float*)d_in[13];
  p.peer_wq = (const float*)d_in[14]; p.peer_subkeys = (const float*)d_in[15]; p.peer_u = (const float*)d_in[16];
  p.peer_v = (const float*)d_in[17]; p.final_g = (const float*)d_in[18];
  p.out = (float*)d_out; p.ws = (char*)d_ws;
  void* args[] = {&p};
  hipError_t e = hipLaunchCooperativeKernel((void*)fwd_megakernel, dim3(grid_blocks), dim3(512), args, kDynLds, stream);
  if (e != hipSuccess) fprintf(stderr, "cooperative launch failed: %s (grid %d)\n", hipGetErrorString(e), grid_blocks);
}
```

```cpp
#include <hip/hip_runtime.h>
#include <hip/hip_cooperative_groups.h>
#include <cstdio>
#include <cstdint>
namespace cg = cooperative_groups;

typedef unsigned short bf16_t;
typedef short bf16x8 __attribute__((ext_vector_type(8)));
typedef float f32x4 __attribute__((ext_vector_type(4)));

constexpr int DM = 1024, BATCH = 8, SEQ = 4096, LCTX = 256;
constexpr int NLAT = BATCH * SEQ;
constexpr int NCTX = BATCH * LCTX;
constexpr int NTOK = NLAT + NCTX;
constexpr int INC = 3072;
constexpr int C_NAQ = 0, C_NAK = 256, C_NAV = 512, C_DFQ = 768, C_DFK = 1024, C_DFV = 1280,
              C_RTQ = 1536, C_RTK = 1792, C_RTV = 2048, C_RTG = 2560;
constexpr int Y_NA = 0, Y_DF = 256, Y_RT = 512;
constexpr int NEXP = 16384;
constexpr float EPS = 1e-6f;

constexpr size_t OFF_CTL  = 0;
constexpr size_t OFF_MISC = 4096;
constexpr size_t OFF_ROPE = 8192;
constexpr size_t OFF_MOD  = OFF_ROPE + 12288;
constexpr size_t SZ_MOD   = 2ull * 9 * 6144 * 4;
constexpr size_t OFF_WIN  = OFF_MOD + SZ_MOD;
constexpr size_t SZ_WIN   = 2ull * 3072 * 1024 * 2;
constexpr size_t OFF_WOUT = OFF_WIN + SZ_WIN;
constexpr size_t SZ_WOUT  = 2ull * 1024 * 1024 * 2;
constexpr size_t OFF_WQ   = OFF_WOUT + SZ_WOUT;
constexpr size_t SZ_WQ    = 2ull * 2048 * 1024 * 2;
constexpr size_t OFF_SUBK = OFF_WQ + SZ_WQ;
constexpr size_t SZ_SUBK  = 2ull * 262144 * 2;
constexpr size_t OFF_U    = OFF_SUBK + SZ_SUBK;
constexpr int    ROWB     = 512;
constexpr int    ROWV     = 512;
constexpr int    RECB     = ROWB + ROWV;
constexpr size_t SZ_UV    = 2ull * NEXP * ROWB;
constexpr size_t OFF_V    = OFF_U + SZ_UV;
constexpr size_t OFF_USC  = OFF_V + SZ_UV;
constexpr size_t OFF_VSC  = OFF_USC + 2ull * NEXP * 4;
constexpr size_t OFF_ACT  = OFF_VSC + 2ull * NEXP * 4;
constexpr size_t SZ_ACT   = (size_t)NTOK * 1024 * 2;
constexpr size_t OFF_P    = OFF_ACT + SZ_ACT;
constexpr size_t SZ_P     = (size_t)NTOK * 3072 * 2;
constexpr size_t OFF_CTXB = OFF_P + SZ_P;
constexpr size_t SZ_CTXB  = (size_t)NCTX * 1024 * 4;
constexpr size_t OFF_RKV  = OFF_CTXB + SZ_CTXB;
constexpr size_t SZ_RKV   = 64ull * 32 * 8192 * 4;
constexpr size_t OFF_RS   = OFF_RKV + SZ_RKV;
constexpr size_t SZ_RS    = 64ull * 8192 * 4;
constexpr size_t OFF_XBAR = OFF_RS + SZ_RS;
constexpr size_t WS_END   = OFF_XBAR + 16384;

#ifndef REP_MIX1
#define REP_MIX1 0
#endif
#ifndef REP_MIX2
#define REP_MIX2 0
#endif
#ifndef REP_PEER
#define REP_PEER 0
#endif
#ifndef REP_GEMM
#define REP_GEMM 0
#endif
constexpr int LDS_BYTES = 152 * 1024;
constexpr int LDS_BCAST = LDS_BYTES - 16;

struct Params {
  const float *x, *c, *ctx, *c_ctx, *w_ada, *b_ada, *norm1_g, *w_in, *na_rpb, *diff_lambda, *diff_subln_g,
              *ret_decay_logit, *w_out, *norm2_g, *peer_wq, *peer_subkeys, *peer_u, *peer_v, *final_g;
  float* out;
  char* ws;
};

__device__ __forceinline__ float bf2f(bf16_t v) { return __uint_as_float(((unsigned)v) << 16); }
__device__ __forceinline__ bf16_t f2bf(float f) {
  unsigned u = __float_as_uint(f);
  u += 0x7fffu + ((u >> 16) & 1u);
  return (bf16_t)(u >> 16);
}
__device__ __forceinline__ unsigned pack2(float a, float b) { return (unsigned)f2bf(a) | ((unsigned)f2bf(b) << 16); }
typedef __bf16 bf16x2_t __attribute__((ext_vector_type(2)));
typedef float f32x2_t __attribute__((ext_vector_type(2)));
__device__ __forceinline__ unsigned pack2h(float a, float b) {
  const f32x2_t v = {a, b};
  return __builtin_bit_cast(unsigned, __builtin_convertvector(v, bf16x2_t));
}
__device__ __forceinline__ float lo16(unsigned w) { return __uint_as_float(w << 16); }
__device__ __forceinline__ float hi16(unsigned w) { return __uint_as_float(w & 0xffff0000u); }
#define DPP_ADD(v, CTRL) ((v) + __int_as_float(__builtin_amdgcn_update_dpp(0, __float_as_int(v), (CTRL), 0xf, 0xf, true)))
__device__ __forceinline__ float row16_sum(float v) {
  v = DPP_ADD(v, 0xB1);
  v = DPP_ADD(v, 0x4E);
  v = DPP_ADD(v, 0x141);
  v = DPP_ADD(v, 0x140);
  return v;
}
#define DPP_MOVU(v, CTRL) ((unsigned)__builtin_amdgcn_update_dpp(0, (int)(v), (CTRL), 0xf, 0xf, true))
__device__ __forceinline__ unsigned row16_max_u32(unsigned v) {
  v = max(v, DPP_MOVU(v, 0xB1)); v = max(v, DPP_MOVU(v, 0x4E)); v = max(v, DPP_MOVU(v, 0x141)); v = max(v, DPP_MOVU(v, 0x140));
  return v;
}
__device__ __forceinline__ unsigned row16_min_u32(unsigned v) {
  v = min(v, DPP_MOVU(v, 0xB1)); v = min(v, DPP_MOVU(v, 0x4E)); v = min(v, DPP_MOVU(v, 0x141)); v = min(v, DPP_MOVU(v, 0x140));
  return v;
}
template <int KTH>
__device__ __forceinline__ unsigned row16_kth_largest(unsigned v) {
  int cnt = 0;
#define R8_STEP(N) { const unsigned o = DPP_MOVU(v, 0x120 + (N)); cnt += (o > v) ? 1 : 0; }
  R8_STEP(1) R8_STEP(2) R8_STEP(3) R8_STEP(4) R8_STEP(5) R8_STEP(6) R8_STEP(7) R8_STEP(8)
  R8_STEP(9) R8_STEP(10) R8_STEP(11) R8_STEP(12) R8_STEP(13) R8_STEP(14) R8_STEP(15)
#undef R8_STEP
  return row16_max_u32(cnt >= KTH - 1 ? v : 0u);
}
__device__ __forceinline__ float wave_sum(float v) {
  v = row16_sum(v);
  const int iv = __float_as_int(v);
  const float a = __int_as_float(__builtin_amdgcn_readlane(iv, 0)), b = __int_as_float(__builtin_amdgcn_readlane(iv, 16));
  const float c = __int_as_float(__builtin_amdgcn_readlane(iv, 32)), d = __int_as_float(__builtin_amdgcn_readlane(iv, 48));
  return (a + b) + (c + d);
}
__device__ __forceinline__ float siluf(float x) { return x / (1.f + __expf(-x)); }

__device__ __forceinline__ int opaque_tid() { int t = threadIdx.x; asm volatile("" : "+v"(t)); return t; }
__device__ __forceinline__ int opaque_bid() { int t = blockIdx.x; asm volatile("" : "+s"(t)); return t; }

#define DOT8(acc, Q, off, U)                                                              \
  acc = fmaf(Q[(off) + 0], lo16((U).x), acc); acc = fmaf(Q[(off) + 1], hi16((U).x), acc); \
  acc = fmaf(Q[(off) + 2], lo16((U).y), acc); acc = fmaf(Q[(off) + 3], hi16((U).y), acc); \
  acc = fmaf(Q[(off) + 4], lo16((U).z), acc); acc = fmaf(Q[(off) + 5], hi16((U).z), acc); \
  acc = fmaf(Q[(off) + 6], lo16((U).w), acc); acc = fmaf(Q[(off) + 7], hi16((U).w), acc);
#define AXPY8(O, off, P, U)                                                                   \
  O[(off) + 0] = fmaf(P, lo16((U).x), O[(off) + 0]); O[(off) + 1] = fmaf(P, hi16((U).x), O[(off) + 1]); \
  O[(off) + 2] = fmaf(P, lo16((U).y), O[(off) + 2]); O[(off) + 3] = fmaf(P, hi16((U).y), O[(off) + 3]); \
  O[(off) + 4] = fmaf(P, lo16((U).z), O[(off) + 4]); O[(off) + 5] = fmaf(P, hi16((U).z), O[(off) + 5]); \
  O[(off) + 6] = fmaf(P, lo16((U).w), O[(off) + 6]); O[(off) + 7] = fmaf(P, hi16((U).w), O[(off) + 7]);
#define UNPACK8(Q, off, U)                                                  \
  Q[(off) + 0] = lo16((U).x); Q[(off) + 1] = hi16((U).x); Q[(off) + 2] = lo16((U).y); Q[(off) + 3] = hi16((U).y); \
  Q[(off) + 4] = lo16((U).z); Q[(off) + 5] = hi16((U).z); Q[(off) + 6] = lo16((U).w); Q[(off) + 7] = hi16((U).w);

__device__ __forceinline__ int next_item(unsigned* counter, char* smem) {
  volatile int* bc = (volatile int*)(smem + LDS_BCAST);
  __syncthreads();
  if (threadIdx.x == 0) *bc = (int)atomicAdd(counter, 1u);
  __syncthreads();
  return *bc;
}

#define XB_TMO      128
#define XB_XCNT(j)  (256  + 64 * (j))
#define XB_XSUB(j)  (1280 + 64 * (j))
#define XB_XGEN(j)  (2304 + 64 * (j))
#define XB_TOP      3328
#define XB_TOPGEN   3392
#define XCD_BAR_WORDS 3456
#define XB_SPIN_CAP (1u << 18)
#define LAS3 __attribute__((address_space(3)))
__device__ __forceinline__ unsigned xb_ld(unsigned* p)              { return __hip_atomic_load(p, __ATOMIC_RELAXED, __HIP_MEMORY_SCOPE_AGENT); }
__device__ __forceinline__ unsigned xb_add(unsigned* p, unsigned v) { return __hip_atomic_fetch_add(p, v, __ATOMIC_RELAXED, __HIP_MEMORY_SCOPE_AGENT); }
__device__ __forceinline__ unsigned xb_xcc_id() { return (unsigned)__builtin_amdgcn_s_getreg((3 << 11) | 20) & 0xFu; }
#define XB_SPIN(cond, bar) do { unsigned _sp = 0; while (cond) { __builtin_amdgcn_s_sleep(1); \
    if ((++_sp & 255u) == 0u) { if (xb_ld(&(bar)[XB_TMO])) break; if (_sp > XB_SPIN_CAP) { atomicAdd(&(bar)[XB_TMO], 1u); break; } } } } while (0)
struct XcdBarrier { unsigned* bar; unsigned x; volatile LAS3 unsigned* st; };
__device__ __forceinline__ XcdBarrier xcd_barrier_post(unsigned* bar, volatile LAS3 unsigned* st) {
  XcdBarrier b; b.bar = bar; b.x = xb_xcc_id(); b.st = st;
  if (threadIdx.x == 0) (void)xb_add(&bar[XB_XCNT(b.x)], 1u);
  return b;
}
__device__ __forceinline__ void xcd_barrier_complete(unsigned* bar, unsigned x, unsigned& nloc, unsigned& nx) {
  const unsigned G = gridDim.x * gridDim.y * gridDim.z;
  unsigned sum, cnt, mine, sp = 0u;
  for (;;) {
    sum = 0u; cnt = 0u; mine = 0u;
#pragma unroll
    for (unsigned j = 0; j < 16; ++j) { const unsigned c = xb_ld(&bar[XB_XCNT(j)]); sum += c; cnt += (c > 0u) ? 1u : 0u; mine = (j == x) ? c : mine; }
    if (sum == G) break;
    __builtin_amdgcn_s_sleep(1);
    if ((++sp & 255u) == 0u) { if (xb_ld(&bar[XB_TMO])) break; if (sp > XB_SPIN_CAP) { atomicAdd(&bar[XB_TMO], 1u); break; } }
  }
  nloc = mine > 0u ? mine : 1u; nx = cnt > 0u ? cnt : 1u;
}
__device__ __forceinline__ void xcd_barrier(const XcdBarrier& b) {
  asm volatile("s_waitcnt vmcnt(0)" ::: "memory");
  __syncthreads();
  if (threadIdx.x == 0) {
    unsigned* bar = b.bar;
    __builtin_amdgcn_s_waitcnt(0);
    unsigned nloc = b.st[0], nx = b.st[1];
    if (nloc == 0u) { xcd_barrier_complete(bar, b.x, nloc, nx); b.st[0] = nloc; b.st[1] = nx; }
    const unsigned old = xb_add(&bar[XB_XSUB(b.x)], 1u);
    const unsigned gen = old / nloc;
    if (old + 1u == (gen + 1u) * nloc) {
      __builtin_amdgcn_fence(__ATOMIC_RELEASE, "agent");
      asm volatile("s_waitcnt vmcnt(0)" ::: "memory");
      const unsigned og = xb_add(&bar[XB_TOP], 1u);
      const unsigned tg = og / nx;
      if (og + 1u == (tg + 1u) * nx) xb_add(&bar[XB_TOPGEN], 1u);
      else XB_SPIN(xb_ld(&bar[XB_TOPGEN]) == tg, bar);
      __builtin_amdgcn_fence(__ATOMIC_ACQUIRE, "agent");
      xb_add(&bar[XB_XGEN(b.x)], 1u);
      asm volatile("s_waitcnt vmcnt(0)" ::: "memory");
    } else {
      XB_SPIN(xb_ld(&bar[XB_XGEN(b.x)]) == gen, bar);
      __builtin_amdgcn_fence(__ATOMIC_ACQUIRE, "agent");
      asm volatile("s_waitcnt vmcnt(0)" ::: "memory");
    }
  }
  __syncthreads();
}

__device__ __forceinline__ void transpose_item(const float* src, bf16_t* dst, int K, int N, int item, char* smem) {
  float* t = (float*)smem;
  const int nb = N / 64;
  const int k0 = (item / nb) * 64, n0 = (item % nb) * 64;
  const int tid = opaque_tid();
  __syncthreads();
#pragma unroll
  for (int i = 0; i < 8; ++i) {
    const int k = (tid >> 6) + 8 * i, n = tid & 63;
    t[k * 65 + n] = src[(size_t)(k0 + k) * N + n0 + n];
  }
  __syncthreads();
#pragma unroll
  for (int i = 0; i < 8; ++i) {
    const int n = (tid >> 6) + 8 * i, k = tid & 63;
    dst[(size_t)(n0 + n) * K + k0 + k] = f2bf(t[k * 65 + n]);
  }
}

__device__ __forceinline__ void convert_flat(const float* src, bf16_t* dst, size_t n4) {
  const size_t gt = (size_t)opaque_bid() * blockDim.x + opaque_tid(), gs = (size_t)gridDim.x * blockDim.x;
  for (size_t i = gt; i < n4; i += gs) {
    const float4 v = ((const float4*)src)[i];
    uint2 o; o.x = pack2h(v.x, v.y); o.y = pack2h(v.z, v.w);
    ((uint2*)dst)[i] = o;
  }
}

__device__ __forceinline__ void phase_prep(const Params& p, char* smem) {
  const int tid = opaque_tid();
  char* ws = p.ws;
  if (opaque_bid() == 0) {
    unsigned* ctl = (unsigned*)(ws + OFF_CTL);
    if (tid < 64) ctl[tid] = 0u;
    unsigned* xbar = (unsigned*)(ws + OFF_XBAR);
    for (int i = tid; i < XCD_BAR_WORDS; i += 512) xbar[i] = 0u;
    float* misc = (float*)(ws + OFF_MISC);
    if (tid < 2) {
      const float* lp = p.diff_lambda + tid * 128;
      float s01 = 0.f, s23 = 0.f;
      for (int i = 0; i < 32; ++i) { s01 += lp[i] * lp[32 + i]; s23 += lp[64 + i] * lp[96 + i]; }
      const float lam_init = 0.8f - 0.6f * expf(-0.3f * (float)tid);
      misc[tid] = expf(s01) - expf(s23) + lam_init;
      misc[2 + tid] = lam_init;
    }
    if (tid >= 128 && tid < 256) misc[64 + tid - 128] = 0.f;
    if (tid >= 64 && tid < 80) {
      const int i = tid - 64;
      const float xv = p.ret_decay_logit[i];
      misc[16 + i] = -log1pf(expf(-xv));
    }
    float2* ropeD = (float2*)(ws + OFF_ROPE);
    float2* ropeR = (float2*)(ws + OFF_ROPE + 4096);
    for (int i = tid; i < 64 * 8; i += 512) {
      const int v = i >> 3, f = i & 7;
      const float inv = powf(10000.0f, -(float)(2 * f) / 16.0f);
      const float ang = (float)v * inv;
      ropeD[i] = make_float2(cosf(ang), sinf(ang));
    }
    for (int i = tid; i < 64 * 16; i += 512) {
      const int v = i >> 4, f = i & 15;
      const float inv = powf(10000.0f, -(float)(2 * f) / 32.0f);
      const float ang = (float)v * inv;
      ropeR[i] = make_float2(cosf(ang), sinf(ang));
    }
  }
  {
    float* sc = (float*)smem;
    float* red = (float*)(smem + 9 * 1024 * 4);
    float* mod = (float*)(ws + OFF_MOD);
    for (int item = opaque_bid(); item < 192; item += gridDim.x) {
      const int l = item / 96, cb = item % 96;
      __syncthreads();
      for (int i = tid; i < 9 * 1024; i += 512) {
        const int r = i >> 10, k = i & 1023;
        const float cv = (r < 8) ? p.c[r * 1024 + k] : p.c_ctx[k];
        sc[i] = siluf(cv);
      }
      __syncthreads();
      const int col = tid & 63, ks = tid >> 6;
      float acc[9];
#pragma unroll
      for (int r = 0; r < 9; ++r) acc[r] = 0.f;
      const float* w = p.w_ada + (size_t)l * 1024 * 6144 + cb * 64 + col;
#pragma unroll 1
      for (int k0 = ks * 128; k0 < ks * 128 + 128; k0 += 16) {
        float wv[16];
#pragma unroll
        for (int i = 0; i < 16; ++i) wv[i] = w[(size_t)(k0 + i) * 6144];
#pragma unroll
        for (int i = 0; i < 16; ++i)
#pragma unroll
          for (int r = 0; r < 9; ++r) acc[r] = fmaf(sc[r * 1024 + k0 + i], wv[i], acc[r]);
      }
#pragma unroll
      for (int r = 0; r < 9; ++r) red[(ks * 9 + r) * 64 + col] = acc[r];
      __syncthreads();
      for (int i = tid; i < 576; i += 512) {
        const int r = i >> 6, cc = i & 63;
        float s = 0.f;
#pragma unroll
        for (int k8 = 0; k8 < 8; ++k8) s += red[(k8 * 9 + r) * 64 + cc];
        mod[((size_t)l * 9 + r) * 6144 + cb * 64 + cc] = s + p.b_ada[l * 6144 + cb * 64 + cc];
      }
    }
    __syncthreads();
  }
  for (int item = opaque_bid(); item < 3072; item += gridDim.x) {
    const int l = item / 1536;
    int r = item % 1536;
    if (r < 768) transpose_item(p.w_in + (size_t)l * 1024 * 3072, (bf16_t*)(ws + OFF_WIN) + (size_t)l * 3072 * 1024, 1024, 3072, r, smem);
    else if (r < 1024) transpose_item(p.w_out + (size_t)l * 1024 * 1024, (bf16_t*)(ws + OFF_WOUT) + (size_t)l * 1024 * 1024, 1024, 1024, r - 768, smem);
    else transpose_item(p.peer_wq + (size_t)l * 1024 * 2048, (bf16_t*)(ws + OFF_WQ) + (size_t)l * 2048 * 1024, 1024, 2048, r - 1024, smem);
  }
  {
    const size_t gt = (size_t)opaque_bid() * blockDim.x + opaque_tid(), gs = (size_t)gridDim.x * blockDim.x;
    for (size_t g = gt; g < 2ull * 262144 / 8; g += gs) {
      const int ln = (int)(g & 63), ks = (int)((g >> 6) & 3), nt = (int)((g >> 8) & 7);
      const size_t list = g >> 11;
      const float* sp = p.peer_subkeys + list * 16384 + (size_t)(nt * 16 + (ln & 15)) * 128 + ks * 32 + (ln >> 4) * 8;
      const float4 a = *(const float4*)sp, b2 = *(const float4*)(sp + 4);
      uint4 o; o.x = pack2h(a.x, a.y); o.y = pack2h(a.z, a.w); o.z = pack2h(b2.x, b2.y); o.w = pack2h(b2.z, b2.w);
      *(uint4*)((bf16_t*)(ws + OFF_SUBK) + g * 8) = o;
    }
  }
  {
    const size_t gt = (size_t)opaque_bid() * blockDim.x + tid, gs = (size_t)gridDim.x * blockDim.x;
    float4* dst = (float4*)(ws + OFF_CTXB);
    for (size_t i = gt; i < (size_t)NCTX * 1024 / 4; i += gs) dst[i] = ((const float4*)p.ctx)[i];
  }
}

__device__ __forceinline__ void phase_norm(const Params& p, int layer, int which, const float* xlat, int nrows) {
  const int lane = opaque_tid() & 63;
  const int gw = opaque_bid() * 8 + (opaque_tid() >> 6), nw = gridDim.x * 8;
  const float* g = (which == 0 ? p.norm1_g : p.norm2_g) + layer * 1024;
  const float* mod = (const float*)(p.ws + OFF_MOD) + (size_t)layer * 9 * 6144;
  const float* ctxb = (const float*)(p.ws + OFF_CTXB);
  bf16_t* act = (bf16_t*)(p.ws + OFF_ACT);
  const int sh_off = which == 0 ? 0 : 3 * 1024, sc_off = which == 0 ? 1024 : 4 * 1024;
  for (int row = gw; row < nrows; row += nw) {
    const float* src = row < NLAT ? xlat + (size_t)row * 1024 : ctxb + (size_t)(row - NLAT) * 1024;
    const int b = row < NLAT ? (row >> 12) : 8;
    const float* mrow = mod + (size_t)b * 6144;
    float4 v[4];
    float ss = 0.f;
#pragma unroll
    for (int j = 0; j < 4; ++j) {
      v[j] = ((const float4*)src)[lane + 64 * j];
      ss += v[j].x * v[j].x + v[j].y * v[j].y + v[j].z * v[j].z + v[j].w * v[j].w;
    }
    ss = wave_sum(ss);
    const float r = rsqrtf(ss * (1.f / 1024.f) + EPS);
#pragma unroll
    for (int j = 0; j < 4; ++j) {
      const int c = (lane + 64 * j) * 4;
      const float4 gg = *(const float4*)(g + c);
      const float4 sh = *(const float4*)(mrow + sh_off + c);
      const float4 sc = *(const float4*)(mrow + sc_off + c);
      const float o0 = v[j].x * r * gg.x * (1.f + sc.x) + sh.x;
      const float o1 = v[j].y * r * gg.y * (1.f + sc.y) + sh.y;
      const float o2 = v[j].z * r * gg.z * (1.f + sc.z) + sh.z;
      const float o3 = v[j].w * r * gg.w * (1.f + sc.w) + sh.w;
      uint2 o; o.x = pack2h(o0, o1); o.y = pack2h(o2, o3);
      *(uint2*)(act + (size_t)row * 1024 + c) = o;
    }
  }
}

__device__ __forceinline__ void phase_final(const Params& p) {
  const int lane = opaque_tid() & 63;
  const int gw = opaque_bid() * 8 + (opaque_tid() >> 6), nw = gridDim.x * 8;
  for (int row = gw; row < NLAT; row += nw) {
    float* src = p.out + (size_t)row * 1024;
    float4 v[4];
    float ss = 0.f;
#pragma unroll
    for (int j = 0; j < 4; ++j) {
      v[j] = ((const float4*)src)[lane + 64 * j];
      ss += v[j].x * v[j].x + v[j].y * v[j].y + v[j].z * v[j].z + v[j].w * v[j].w;
    }
    ss = wave_sum(ss);
    const float r = rsqrtf(ss * (1.f / 1024.f) + EPS);
#pragma unroll
    for (int j = 0; j < 4; ++j) {
      const int c = (lane + 64 * j) * 4;
      const float4 gg = *(const float4*)(p.final_g + c);
      float4 o;
      o.x = v[j].x * r * gg.x; o.y = v[j].y * r * gg.y; o.z = v[j].z * r * gg.z; o.w = v[j].w * r * gg.w;
      ((float4*)src)[lane + 64 * j] = o;
    }
  }
}

constexpr int EPI_INPROJ = 0, EPI_OUTPROJ = 1, EPI_PLAIN = 2;
constexpr int GS = 72;
constexpr int G_ASTAGE = 256 * GS * 2;
constexpr int G_BSTAGE = 128 * GS * 2;
constexpr int G_STAGE = G_ASTAGE + G_BSTAGE;

namespace g8 {
constexpr int BM = 256, BK = 64, HALF = 128, NXCD = 8, WGM = 8, HT = HALF * BK;
__device__ __forceinline__ int lds_byte(int r, int c) {
  const int st = (r >> 4) * 2 + (c >> 5), rr = r & 15, cc = c & 31, ob = rr * 64 + cc * 2;
  return st * 1024 + (ob ^ (((ob >> 9) & 1) << 5));
}
__device__ __forceinline__ void stage_rc(int b, int& R, int& C) {
  const int st = b / 1024, sb = b % 1024, swz = sb ^ (((sb >> 9) & 1) << 5);
  R = (st >> 1) * 16 + swz / 64; C = (st & 1) * 32 + (swz % 64) / 2;
}
}

constexpr int G8_ROPE_LDS = 8 * 16384;
template <int EPI>
__device__ __forceinline__ void epi_store8(const Params& p, int layer, char* smem, int m, int n, f32x4 lo, f32x4 hi, const float* xin_lat) {
  float v[8] = {lo[0], lo[1], lo[2], lo[3], hi[0], hi[1], hi[2], hi[3]};
  if constexpr (EPI == EPI_INPROJ) {
    const bool ropeD = (n >= C_DFQ && n < C_DFV), ropeR = (n >= C_RTQ && n < C_RTV);
    if ((ropeD || ropeR) && m < NLAT) {
      const int t = m & 4095, gr = t >> 6, gc = t & 63;
      const float2* tabD = (const float2*)(smem + G8_ROPE_LDS);
      const float2* tabR = (const float2*)(smem + G8_ROPE_LDS + 4096);
      const float2* tb;
      if (ropeD) { const int i0 = (n & 31) >> 1; tb = i0 < 8 ? tabD + gr * 8 + i0 : tabD + gc * 8 + i0 - 8; }
      else { const int i0 = (n & 63) >> 1; tb = i0 < 16 ? tabR + gr * 16 + i0 : tabR + gc * 16 + i0 - 16; }
#pragma unroll
      for (int q = 0; q < 4; ++q) {
        const float2 cs = tb[q];
        const float a0 = v[2 * q] * cs.x - v[2 * q + 1] * cs.y, a1 = v[2 * q] * cs.y + v[2 * q + 1] * cs.x;
        v[2 * q] = a0; v[2 * q + 1] = a1;
      }
    }
    float sc = 1.f;
    if (n < C_NAK) sc = 0.125f * 1.4426950408889634f;
    else if (n >= C_DFQ && n < C_DFK) sc = 0.17677669529663687f * 1.4426950408889634f;
    else if (n >= C_RTK && n < C_RTV) sc = 0.125f;
    uint4 o;
    o.x = pack2h(v[0] * sc, v[1] * sc); o.y = pack2h(v[2] * sc, v[3] * sc); o.z = pack2h(v[4] * sc, v[5] * sc); o.w = pack2h(v[6] * sc, v[7] * sc);
    *(uint4*)((bf16_t*)(p.ws + OFF_P) + (size_t)m * INC + n) = o;
  } else if constexpr (EPI == EPI_OUTPROJ) {
    const float* mod = (const float*)(p.ws + OFF_MOD) + (size_t)layer * 9 * 6144;
    const int b = m < NLAT ? (m >> 12) : 8;
    const float* gp = mod + (size_t)b * 6144 + 2 * 1024 + n;
    const float4 g0 = *(const float4*)gp, g1 = *(const float4*)(gp + 4);
    const float* xi; float* xo;
    if (m < NLAT) { xi = xin_lat + (size_t)m * 1024 + n; xo = p.out + (size_t)m * 1024 + n; }
    else { xo = (float*)(p.ws + OFF_CTXB) + (size_t)(m - NLAT) * 1024 + n; xi = xo; }
    const float4 x0 = *(const float4*)xi, x1 = *(const float4*)(xi + 4);
    float4 o0, o1;
    o0.x = x0.x + g0.x * v[0]; o0.y = x0.y + g0.y * v[1]; o0.z = x0.z + g0.z * v[2]; o0.w = x0.w + g0.w * v[3];
    o1.x = x1.x + g1.x * v[4]; o1.y = x1.y + g1.y * v[5]; o1.z = x1.z + g1.z * v[6]; o1.w = x1.w + g1.w * v[7];
    *(float4*)xo = o0; *(float4*)(xo + 4) = o1;
  } else if constexpr (EPI == EPI_PLAIN) {
    uint4 o;
    o.x = pack2h(v[0], v[1]); o.y = pack2h(v[2], v[3]); o.z = pack2h(v[4], v[5]); o.w = pack2h(v[6], v[7]);
    *(uint4*)((bf16_t*)(p.ws + OFF_P) + ((((size_t)(m >> 4) * 16 + (n >> 7)) * 4 + ((n >> 5) & 3)) * 64 + (m & 15) + 16 * ((n >> 3) & 3)) * 8) = o;
  } else {
    asm volatile("" :: "v"(v[0]), "v"(v[1]), "v"(v[2]), "v"(v[3]), "v"(v[4]), "v"(v[5]), "v"(v[6]), "v"(v[7]));
  }
}

#define G8_LAS __attribute__((address_space(3)))
__device__ __forceinline__ bool g8_next(int i, int nM, int nN, int G, int c, int& pm, int& pn) {
  using namespace g8;
  const int nwg = nM * nN;
  const long Lx = (long)i * G + c;
  if (Lx >= nwg) return false;
  int wgid = (int)Lx;
  { const int q = nwg / NXCD, r = nwg % NXCD, xcd = wgid % NXCD, off = wgid / NXCD; wgid = (xcd < r ? xcd * (q + 1) : r * (q + 1) + (xcd - r) * q) + off; }
  const int nig = WGM * nN, gid = wgid / nig, fm = gid * WGM, gsz = (nM - fm) < WGM ? (nM - fm) : WGM;
  pm = fm + ((wgid % nig) % gsz); pn = (wgid % nig) / gsz;
  return true;
}

template <int EPI>
__device__ __forceinline__ void gemm_phase2(const Params& p, int layer, char* smem, const bf16_t* A, const bf16_t* Bt,
                                            int M, int N, const float* xin_lat) {
  using namespace g8;
  constexpr int K = 1024, nt = K / BK, HTB = HALF * BK * 2;
  G8_LAS unsigned char* lds = (G8_LAS unsigned char*)smem;
  const int tid = opaque_tid();
  const int wid = __builtin_amdgcn_readfirstlane(tid >> 6), lane = tid & 63, wr = wid >> 2, wc = wid & 3, fr = lane & 15, fq = lane >> 4;
  unsigned voff[2], voffB[2];
#pragma unroll
  for (int i = 0; i < 2; ++i) {
    int R, C; stage_rc(tid * 16 + i * 8192, R, C);
    const int rho = R & 31, Rb = (R & ~31) + 8 * ((rho & 15) >> 2) + 4 * (rho >> 4) + (rho & 3);
    voff[i] = (unsigned)(R * K + C) * 2u; voffB[i] = (unsigned)(Rb * K + C) * 2u;
  }
  if constexpr (EPI == EPI_INPROJ) {
    __syncthreads();
    const float4* gsrc = (const float4*)(p.ws + OFF_ROPE);
    float4* ldst = (float4*)(smem + G8_ROPE_LDS);
    for (int i = tid; i < 12288 / 16; i += 512) ldst[i] = gsrc[i];
  }
  constexpr size_t kstep = (size_t)(BK * 2);
  constexpr size_t hstep = (size_t)HALF * K * 2;
  constexpr size_t tstep = 2 * hstep;
  const unsigned ldsw = (unsigned)wid * 1024u;
  const int aoff = lds_byte(wr * 64 + fr, fq * 8), boff = lds_byte(wc * 32 + fr, fq * 8);
#define G8_SA(b, h) (((b) * 2 + (h)) * HTB)
#define G8_SB(b, h) ((4 + (b) * 2 + (h)) * HTB)
#define G8_STAGE_V(bufoff, gbase, VO) do { _Pragma("unroll") for (int _i = 0; _i < 2; ++_i)                                  \
    __builtin_amdgcn_global_load_lds((const unsigned*)((const char*)(gbase) + VO[_i]), (G8_LAS unsigned*)(lds + (bufoff) + ldsw + _i * 8192), 16, 0, 0); } while (0)
#define G8_LDA(dst, b, h) do { _Pragma("unroll") for (int m = 0; m < 4; ++m) _Pragma("unroll") for (int k = 0; k < 2; ++k) dst[m][k] = *(const G8_LAS bf16x8*)(lds + G8_SA(b, h) + aoff + m * 2048 + k * 1024); } while (0)
#define G8_LDB(dst, b, h) do { _Pragma("unroll") for (int n = 0; n < 2; ++n) _Pragma("unroll") for (int k = 0; k < 2; ++k) dst[n][k] = *(const G8_LAS bf16x8*)(lds + G8_SB(b, h) + boff + n * 2048 + k * 1024); } while (0)
#define G8_MMA(ai, bj, At_, Bt_) do { __builtin_amdgcn_s_setprio(1);                                                          \
    _Pragma("unroll") for (int m = 0; m < 4; ++m) _Pragma("unroll") for (int n = 0; n < 2; ++n) _Pragma("unroll") for (int k = 0; k < 2; ++k) \
      acc[ai][bj][m][n] = __builtin_amdgcn_mfma_f32_16x16x32_bf16(Bt_[n][k], At_[m][k], acc[ai][bj][m][n], 0, 0, 0);          \
    __builtin_amdgcn_s_setprio(0); } while (0)
#define G8_WAIT_V(n) asm volatile("s_waitcnt vmcnt(" #n ")" ::: "memory")
#define G8_WAIT_L(n) asm volatile("s_waitcnt lgkmcnt(" #n ")" ::: "memory")
#define G8_BAR __builtin_amdgcn_s_barrier()
#define G8_SCHED __builtin_amdgcn_sched_barrier(0)
  const int nM = M / BM, nN = N / BM, G = gridDim.x, cu = opaque_bid();
  int cpm, cpn, npm = 0, npn = 0, ui = 0;
  __syncthreads();
  if (g8_next(0, nM, nN, G, cu, cpm, cpn)) {
    f32x4 acc[2][2][4][2];
#pragma unroll
    for (int a = 0; a < 2; ++a)
#pragma unroll
      for (int b2 = 0; b2 < 2; ++b2)
#pragma unroll
        for (int m = 0; m < 4; ++m)
#pragma unroll
          for (int n = 0; n < 2; ++n) acc[a][b2][m][n] = (f32x4){0.f, 0.f, 0.f, 0.f};
    bf16x8 At[4][2], B0[2][2], B1[2][2];
    const char* cA = (const char*)A + (size_t)cpm * tstep;
    const char* cB = (const char*)Bt + (size_t)cpn * tstep;
    G8_STAGE_V(G8_SB(0, 0), cB, voffB); G8_STAGE_V(G8_SA(0, 0), cA, voff); G8_STAGE_V(G8_SB(0, 1), cB + hstep, voffB); G8_STAGE_V(G8_SA(0, 1), cA + hstep, voff);
    if (wr == 1) G8_BAR;
    G8_WAIT_V(4); G8_BAR;
    G8_STAGE_V(G8_SB(1, 0), cB + kstep, voffB); G8_STAGE_V(G8_SA(1, 0), cA + kstep, voff); G8_STAGE_V(G8_SB(1, 1), cB + hstep + kstep, voffB);
    G8_WAIT_V(6); G8_BAR;
    for (;;) {
      const bool has_next = g8_next(ui + 1, nM, nN, G, cu, npm, npn);
      const char* nA = has_next ? (const char*)A + (size_t)npm * tstep : cA;
      const char* nB = has_next ? (const char*)Bt + (size_t)npn * tstep : cB;
#pragma unroll 1
      for (int t = 0; t < nt; t += 2) {
        const bool last = (t == nt - 2);
        const char* a1 = cA + (size_t)(t + 1) * kstep;
        const char* a2 = last ? nA : cA + (size_t)(t + 2) * kstep; const char* b2 = last ? nB : cB + (size_t)(t + 2) * kstep;
        const char* a3 = a2 + kstep; const char* b3 = b2 + kstep;
        G8_LDB(B0, 0, 0); G8_SCHED; G8_LDA(At, 0, 0); G8_STAGE_V(G8_SA(1, 1), a1 + hstep, voff);
        G8_WAIT_L(8); G8_BAR; G8_WAIT_L(0); G8_MMA(0, 0, At, B0); G8_BAR; G8_SCHED;
        G8_LDB(B1, 0, 1); G8_STAGE_V(G8_SB(0, 0), b2, voffB);
        G8_BAR; G8_WAIT_L(0); G8_MMA(0, 1, At, B1); G8_BAR;
        G8_LDA(At, 0, 1); G8_STAGE_V(G8_SA(0, 0), a2, voff);
        G8_BAR; G8_WAIT_L(0); G8_MMA(1, 0, At, B0); G8_BAR; G8_SCHED;
        G8_STAGE_V(G8_SB(0, 1), b2 + hstep, voffB);
        G8_WAIT_V(6); G8_BAR; G8_MMA(1, 1, At, B1); G8_BAR;
        G8_LDB(B0, 1, 0); G8_SCHED; G8_LDA(At, 1, 0); G8_STAGE_V(G8_SA(0, 1), a2 + hstep, voff);
        G8_WAIT_L(8); G8_BAR; G8_WAIT_L(0); G8_MMA(0, 0, At, B0); G8_BAR; G8_SCHED;
        G8_LDB(B1, 1, 1); G8_STAGE_V(G8_SB(1, 0), b3, voffB);
        G8_BAR; G8_WAIT_L(0); G8_MMA(0, 1, At, B1); G8_BAR;
        G8_LDA(At, 1, 1); G8_STAGE_V(G8_SA(1, 0), a3, voff);
        G8_BAR; G8_WAIT_L(0); G8_MMA(1, 0, At, B0); G8_BAR; G8_SCHED;
        G8_STAGE_V(G8_SB(1, 1), b3 + hstep, voffB);
        G8_WAIT_V(6); G8_BAR; G8_MMA(1, 1, At, B1); G8_BAR;
      }
      {
        const int brow = cpm * BM, bcol = cpn * BM;
        if constexpr (EPI == EPI_INPROJ) {
          if (bcol == C_DFK) {
#pragma unroll
            for (int bj = 0; bj < 2; ++bj) {
              float mx = 0.f;
#pragma unroll
              for (int ai = 0; ai < 2; ++ai)
#pragma unroll
                for (int m = 0; m < 4; ++m) {
                  float s = 0.f;
#pragma unroll
                  for (int n = 0; n < 2; ++n)
#pragma unroll
                    for (int j = 0; j < 4; ++j) s = fmaf(acc[ai][bj][m][n][j], acc[ai][bj][m][n][j], s);
                  s += __shfl_xor(s, 16); s += __shfl_xor(s, 32);
                  mx = fmaxf(mx, s);
                }
#pragma unroll
              for (int o = 1; o < 16; o <<= 1) mx = fmaxf(mx, __shfl_xor(mx, o));
              if (lane == 0) {
                const int bb = brow < NLAT ? (brow >> 12) : ((brow - NLAT) >> 8);
                unsigned* km = (unsigned*)(p.ws + OFF_MISC) + 64 + layer * 64 + (bb * 4 + bj * 2 + (wc >> 1)) * 2 + (wc & 1);
                atomicMax(km, __float_as_uint(mx));
              }
            }
          }
        }
#pragma unroll
        for (int ai = 0; ai < 2; ++ai)
#pragma unroll
          for (int bj = 0; bj < 2; ++bj)
#pragma unroll
            for (int m = 0; m < 4; ++m)
              epi_store8<EPI>(p, layer, smem, brow + ai * HALF + wr * 64 + m * 16 + fr, bcol + bj * HALF + wc * 32 + fq * 8,
                              acc[ai][bj][m][0], acc[ai][bj][m][1], xin_lat);
      }
      if (!has_next) break;
#pragma unroll
      for (int a = 0; a < 2; ++a)
#pragma unroll
        for (int b2 = 0; b2 < 2; ++b2)
#pragma unroll
          for (int m = 0; m < 4; ++m)
#pragma unroll
            for (int n = 0; n < 2; ++n) acc[a][b2][m][n] = (f32x4){0.f, 0.f, 0.f, 0.f};
      cpm = npm; cpn = npn; cA = nA; cB = nB; ++ui;
    }
    G8_WAIT_V(0);
    if (wr == 0) G8_BAR;
    G8_BAR;
  }
}

__device__ __forceinline__ unsigned cvt_pk_bf16(float lo, float hi) { return pack2h(lo, hi); }
__device__ __forceinline__ void vt_store8(bf16_t* vt, int stride, int d0, int key, uint4 uv) {
  bf16_t* vd = vt + d0 * stride + key;
  vd[0 * stride] = (bf16_t)(uv.x & 0xffffu); vd[1 * stride] = (bf16_t)(uv.x >> 16);
  vd[2 * stride] = (bf16_t)(uv.y & 0xffffu); vd[3 * stride] = (bf16_t)(uv.y >> 16);
  vd[4 * stride] = (bf16_t)(uv.z & 0xffffu); vd[5 * stride] = (bf16_t)(uv.z >> 16);
  vd[6 * stride] = (bf16_t)(uv.w & 0xffffu); vd[7 * stride] = (bf16_t)(uv.w >> 16);
}

constexpr int DKS = 72;
__device__ __forceinline__ void diff_item(const Params& p, int layer, bool ctxq, int item, char* smem) {
  const bf16_t* P = (const bf16_t*)(p.ws + OFF_P);
  bf16_t* Y = (bf16_t*)(p.ws + OFF_ACT);
  const float* misc = (const float*)(p.ws + OFF_MISC);
  const float lam = misc[layer], lam_init = misc[2 + layer];
  const int tid = opaque_tid(), lane = tid & 63, wave = tid >> 6, lr = lane & 15, lq = lane >> 4;
  int b, h, mbase, nkeys;
  if (!ctxq) { b = item >> 6; h = (item >> 4) & 3; mbase = b * 4096 + (item & 15) * 256; nkeys = 256 + 4096; }
  else { b = item >> 2; h = item & 3; mbase = NLAT + b * 256; nkeys = 256; }
  const float kmax0 = sqrtf(misc[64 + layer * 64 + (b * 4 + h) * 2 + 0]), kmax1 = sqrtf(misc[64 + layer * 64 + (b * 4 + h) * 2 + 1]);
  bf16x8 qf[2][2];
  f32x4 C0[2], C1[2];
#pragma unroll
  for (int qt = 0; qt < 2; ++qt) {
    const bf16_t* qr = P + (size_t)(mbase + wave * 32 + qt * 16 + lr) * INC + C_DFQ + h * 64 + lq * 8;
    const uint4 u0 = *(const uint4*)(qr), u1 = *(const uint4*)(qr + 32);
    float s0 = 0.f, s1 = 0.f;
    { float t[8]; UNPACK8(t, 0, u0) _Pragma("unroll") for (int i = 0; i < 8; ++i) s0 = fmaf(t[i], t[i], s0); }
    { float t[8]; UNPACK8(t, 0, u1) _Pragma("unroll") for (int i = 0; i < 8; ++i) s1 = fmaf(t[i], t[i], s1); }
    s0 += __shfl_xor(s0, 16); s0 += __shfl_xor(s0, 32);
    s1 += __shfl_xor(s1, 16); s1 += __shfl_xor(s1, 32);
    const float nm0 = -sqrtf(s0) * kmax0, nm1 = -sqrtf(s1) * kmax1;
    C0[qt] = (f32x4){nm0, nm0, nm0, nm0};
    C1[qt] = (f32x4){nm1, nm1, nm1, nm1};
    union { uint4 u; bf16x8 v; } c0, c1; c0.u = u0; c1.u = u1;
    qf[qt][0] = c0.v; qf[qt][1] = c1.v;
  }
  f32x4 O0[2][4], O1[2][4];
#pragma unroll
  for (int qt = 0; qt < 2; ++qt)
#pragma unroll
    for (int i = 0; i < 4; ++i) { O0[qt][i] = (f32x4){0.f, 0.f, 0.f, 0.f}; O1[qt][i] = (f32x4){0.f, 0.f, 0.f, 0.f}; }
  f32x4 L0[2], L1[2];
#pragma unroll
  for (int qt = 0; qt < 2; ++qt) { L0[qt] = (f32x4){0.f, 0.f, 0.f, 0.f}; L1[qt] = (f32x4){0.f, 0.f, 0.f, 0.f}; }
  const bf16x8 ones8 = {(short)0x3F80, (short)0x3F80, (short)0x3F80, (short)0x3F80, (short)0x3F80, (short)0x3F80, (short)0x3F80, (short)0x3F80};
  const int lkey = tid >> 3, lch = tid & 7;
  constexpr int DBUF = 2 * 128 * DKS * 2;
  uint4 ukA0, ukA1, uvA0, uvA1;
#define DF_GLOAD1(UK, UV, T, I)                                                                     \
  {                                                                                                 \
    const int kk = (T) * 128 + (I) * 64 + lkey;                                                     \
    const size_t row = kk < 256 ? (size_t)(NLAT + b * 256 + kk) : (size_t)(b * 4096 + kk - 256);    \
    UK = *(const uint4*)(P + row * INC + C_DFK + h * 64 + lch * 8);                                 \
    UV = *(const uint4*)(P + row * INC + C_DFV + h * 64 + lch * 8);                                 \
  }
#define DF_LSTORE1(UK, UV, BUF, I)                                                                  \
  {                                                                                                 \
    bf16_t* Ks_ = (bf16_t*)(smem + (BUF) * DBUF) + (I) * 64 * DKS;                                  \
    bf16_t* Vt_ = (bf16_t*)(smem + (BUF) * DBUF) + 128 * DKS + (I) * 64 * DKS;                      \
    *(uint4*)(Ks_ + lkey * DKS + lch * 8) = UK;                                                     \
    vt_store8(Vt_, DKS, lch * 8, lkey, UV);                                                         \
  }
#define DF_GLOAD(S, T) DF_GLOAD1(uk##S##0, uv##S##0, T, 0) DF_GLOAD1(uk##S##1, uv##S##1, T, 1)
#define DF_LSTORE(S, BUF) DF_LSTORE1(uk##S##0, uv##S##0, BUF, 0) DF_LSTORE1(uk##S##1, uv##S##1, BUF, 1)
  const int ntile = nkeys >> 7;
  __syncthreads();
  DF_GLOAD(A, 0)
  DF_LSTORE(A, 0)
  __syncthreads();
#pragma unroll 1
  for (int t = 0; t < ntile; ++t) {
    const int cur = t & 1;
    if (t + 1 < ntile) { DF_GLOAD(A, t + 1) }
#pragma unroll
    for (int sub = 0; sub < 2; ++sub) {
    const bf16_t* Ks = (const bf16_t*)(smem + cur * DBUF) + sub * 64 * DKS;
    const bf16_t* Vt = (const bf16_t*)(smem + cur * DBUF) + 128 * DKS + sub * 64 * DKS;
    union PF { unsigned u[4]; bf16x8 v; };
    PF pf0[2][2], pf1[2][2];
#pragma unroll
    for (int c = 0; c < 2; ++c) {
      f32x4 S[2][4];
#pragma unroll
      for (int kt = 0; kt < 4; ++kt) {
        const bf16x8 kf = *(const bf16x8*)(Ks + (kt * 16 + lr) * DKS + c * 32 + lq * 8);
#pragma unroll
        for (int qt = 0; qt < 2; ++qt) S[qt][kt] = __builtin_amdgcn_mfma_f32_16x16x32_bf16(kf, qf[qt][c], c == 0 ? C0[qt] : C1[qt], 0, 0, 0);
      }
#pragma unroll
      for (int qt = 0; qt < 2; ++qt) {
#pragma unroll
        for (int kt = 0; kt < 4; ++kt) {
#pragma unroll
          for (int r = 0; r < 4; ++r) S[qt][kt][r] = __builtin_amdgcn_exp2f(S[qt][kt][r]);
        }
#pragma unroll
        for (int g = 0; g < 2; ++g) {
          PF t;
          t.u[0] = cvt_pk_bf16(S[qt][2 * g][0], S[qt][2 * g][1]); t.u[1] = cvt_pk_bf16(S[qt][2 * g][2], S[qt][2 * g][3]);
          t.u[2] = cvt_pk_bf16(S[qt][2 * g + 1][0], S[qt][2 * g + 1][1]); t.u[3] = cvt_pk_bf16(S[qt][2 * g + 1][2], S[qt][2 * g + 1][3]);
          if (c == 0) pf0[qt][g] = t; else pf1[qt][g] = t;
        }
      }
    }
#pragma unroll
    for (int g = 0; g < 2; ++g) {
#pragma unroll
      for (int qt = 0; qt < 2; ++qt) {
        L0[qt] = __builtin_amdgcn_mfma_f32_16x16x32_bf16(ones8, pf0[qt][g].v, L0[qt], 0, 0, 0);
        L1[qt] = __builtin_amdgcn_mfma_f32_16x16x32_bf16(ones8, pf1[qt][g].v, L1[qt], 0, 0, 0);
      }
#pragma unroll
      for (int dt = 0; dt < 4; ++dt) {
        union { uint2 h2[2]; bf16x8 v; } vf;
        vf.h2[0] = *(const uint2*)(Vt + (dt * 16 + lr) * DKS + 32 * g + 4 * lq);
        vf.h2[1] = *(const uint2*)(Vt + (dt * 16 + lr) * DKS + 32 * g + 16 + 4 * lq);
#pragma unroll
        for (int qt = 0; qt < 2; ++qt) {
          O0[qt][dt] = __builtin_amdgcn_mfma_f32_16x16x32_bf16(vf.v, pf0[qt][g].v, O0[qt][dt], 0, 0, 0);
          O1[qt][dt] = __builtin_amdgcn_mfma_f32_16x16x32_bf16(vf.v, pf1[qt][g].v, O1[qt][dt], 0, 0, 0);
        }
      }
    }
    }
    if (t + 1 < ntile) { DF_LSTORE(A, cur ^ 1) }
    __syncthreads();
  }
  const float* sg = p.diff_subln_g + layer * 64;
#pragma unroll
  for (int qt = 0; qt < 2; ++qt) {
    const float a0 = L0[qt][0], a1 = L1[qt][0];
    const float i0 = 1.f / a0, i1 = lam / a1;
    float ss = 0.f;
#pragma unroll
    for (int dt = 0; dt < 4; ++dt) {
#pragma unroll
      for (int r = 0; r < 4; ++r) { const float v = O0[qt][dt][r] * i0 - O1[qt][dt][r] * i1; O0[qt][dt][r] = v; ss = fmaf(v, v, ss); }
    }
    ss += __shfl_xor(ss, 16); ss += __shfl_xor(ss, 32);
    const float rr = rsqrtf(ss * (1.f / 64.f) + EPS) * (1.f - lam_init);
    bf16_t* dst = Y + (size_t)(mbase + wave * 32 + qt * 16 + lr) * 1024 + Y_DF + h * 64;
#pragma unroll
    for (int dt = 0; dt < 4; ++dt) {
      const int d = dt * 16 + 4 * lq;
      const float4 g4 = *(const float4*)(sg + d);
      uint2 ov;
      ov.x = pack2(O0[qt][dt][0] * rr * g4.x, O0[qt][dt][1] * rr * g4.y);
      ov.y = pack2(O0[qt][dt][2] * rr * g4.z, O0[qt][dt][3] * rr * g4.w);
      *(uint2*)(dst + d) = ov;
    }
  }
}

constexpr int NA_WS = 520;
constexpr int NA_CS = 264;
constexpr int NA_OFF_VTW = 0;
constexpr int NA_OFF_VTC = 64 * NA_WS * 2;
constexpr int NA_OFF_RPB = NA_OFF_VTC + 64 * NA_CS * 2;
constexpr int NA_OFF_MRG = NA_OFF_RPB + 2048;

#define NA_STEP(KA_EXPR, KB_EXPR, BIAS_EXPR, VT_PTR, VT_STRIDE, VT_KEY0_EXPR)                                    \
  {                                                                                                               \
    f32x4 S[4];                                                                                                   \
    _Pragma("unroll") for (int kt = 0; kt < 4; ++kt) {                                                            \
      f32x4 a = __builtin_amdgcn_mfma_f32_16x16x32_bf16((KA_EXPR), qf[0], (f32x4){0.f, 0.f, 0.f, 0.f}, 0, 0, 0);  \
      S[kt] = __builtin_amdgcn_mfma_f32_16x16x32_bf16((KB_EXPR), qf[1], a, 0, 0, 0);                               \
    }                                                                                                             \
    _Pragma("unroll") for (int kt = 0; kt < 4; ++kt) {                                                            \
      _Pragma("unroll") for (int r = 0; r < 4; ++r) { S[kt][r] += (BIAS_EXPR); }                                  \
    }                                                                                                             \
    float x = fmaxf(fmaxf(S[0][0], S[0][1]), fmaxf(S[0][2], S[0][3]));                                            \
    _Pragma("unroll") for (int kt = 1; kt < 4; ++kt) x = fmaxf(x, fmaxf(fmaxf(S[kt][0], S[kt][1]), fmaxf(S[kt][2], S[kt][3]))); \
    x = fmaxf(x, __shfl_xor(x, 16)); x = fmaxf(x, __shfl_xor(x, 32));                                             \
    const float mn = fmaxf(mrun, x);                                                                              \
    const float al = __builtin_amdgcn_exp2f(mrun - mn);                                                           \
    mrun = mn;                                                                                                    \
    float ps = 0.f;                                                                                               \
    _Pragma("unroll") for (int kt = 0; kt < 4; ++kt) {                                                            \
      _Pragma("unroll") for (int r = 0; r < 4; ++r) { S[kt][r] = __builtin_amdgcn_exp2f(S[kt][r] - mn); ps += S[kt][r]; } \
    }                                                                                                             \
    lrun = lrun * al + ps;                                                                                        \
    _Pragma("unroll") for (int dt = 0; dt < 4; ++dt) {                                                            \
      _Pragma("unroll") for (int r = 0; r < 4; ++r) O[dt][r] *= al;                                               \
    }                                                                                                             \
    _Pragma("unroll") for (int g = 0; g < 2; ++g) {                                                               \
      union { unsigned u[4]; bf16x8 v; } pf;                                                                      \
      pf.u[0] = cvt_pk_bf16(S[2 * g][0], S[2 * g][1]); pf.u[1] = cvt_pk_bf16(S[2 * g][2], S[2 * g][3]);           \
      pf.u[2] = cvt_pk_bf16(S[2 * g + 1][0], S[2 * g + 1][1]); pf.u[3] = cvt_pk_bf16(S[2 * g + 1][2], S[2 * g + 1][3]); \
      const int vk0 = (VT_KEY0_EXPR);                                                                             \
      _Pragma("unroll") for (int dt = 0; dt < 4; ++dt) {                                                          \
        union { uint2 h2[2]; bf16x8 v; } vf;                                                                      \
        vf.h2[0] = *(const uint2*)((VT_PTR) + (dt * 16 + lr) * (VT_STRIDE) + vk0 + 4 * lq);                       \
        vf.h2[1] = *(const uint2*)((VT_PTR) + (dt * 16 + lr) * (VT_STRIDE) + vk0 + 16 + 4 * lq);                  \
        O[dt] = __builtin_amdgcn_mfma_f32_16x16x32_bf16(vf.v, pf.v, O[dt], 0, 0, 0);                              \
      }                                                                                                           \
    }                                                                                                             \
  }

__device__ __forceinline__ void na_latent_item(const Params& p, int layer, int item, char* smem) {
  const bf16_t* P = (const bf16_t*)(p.ws + OFF_P);
  bf16_t* Y = (bf16_t*)(p.ws + OFF_ACT);
  const int b = item >> 8, h = (item >> 6) & 3, grow = item & 63;
  const int tid = opaque_tid(), lane = tid & 63, wave = tid >> 6, lr = lane & 15, lq = lane >> 4;
  const int jt = wave & 3, half = wave >> 2;
  bf16_t* VtW = (bf16_t*)(smem + NA_OFF_VTW);
  bf16_t* VtC = (bf16_t*)(smem + NA_OFF_VTC);
  float* RPB = (float*)(smem + NA_OFF_RPB);
  float* MRG = (float*)(smem + NA_OFF_MRG);
  const int rs = min(max(grow - 4, 0), 56);
  __syncthreads();
  {
    const int ch = tid & 7;
#pragma unroll
    for (int i = 0; i < 8; ++i) {
      const int key = (tid >> 3) + 64 * i;
      const uint4 uv = *(const uint4*)(P + (size_t)(b * 4096 + (rs + (key >> 6)) * 64 + (key & 63)) * INC + C_NAV + h * 64 + ch * 8);
      vt_store8(VtW, NA_WS, ch * 8, key, uv);
    }
#pragma unroll
    for (int i = 0; i < 4; ++i) {
      const int key = (tid >> 3) + 64 * i;
      const uint4 uv = *(const uint4*)(P + (size_t)(NLAT + b * 256 + key) * INC + C_NAV + h * 64 + ch * 8);
      vt_store8(VtC, NA_CS, ch * 8, key, uv);
    }
    if (tid < 465) RPB[tid] = p.na_rpb[(size_t)(layer * 4 + h) * 465 + tid] * 1.4426950408889634f;
  }
  const int qc = jt * 16 + lr;
  const int mq = b * 4096 + grow * 64 + qc;
  bf16x8 qf[2];
  {
    const bf16_t* qr = P + (size_t)mq * INC + C_NAQ + h * 64 + lq * 8;
    qf[0] = *(const bf16x8*)(qr);
    qf[1] = *(const bf16x8*)(qr + 32);
  }
  f32x4 O[4];
#pragma unroll
  for (int i = 0; i < 4; ++i) O[i] = (f32x4){0.f, 0.f, 0.f, 0.f};
  float mrun = -1e30f, lrun = 0.f;
  const int k0 = min(max(jt * 16 - 8, 0), 32);
  const int cs = min(max(qc - 8, 0), 48);
  bf16x8 kfa[2][4], kfb[2][4];
#define NA_LOADK(SET, S_)                                                                                        \
  _Pragma("unroll") for (int kt = 0; kt < 4; ++kt) {                                                             \
    const int t_ = 4 * (S_) + kt;                                                                                \
    const size_t krow = half == 0 ? (size_t)(b * 4096 + (rs + (t_ >> 1)) * 64 + k0 + 16 * (t_ & 1) + lr) : (size_t)(NLAT + b * 256 + 16 * t_ + lr); \
    const bf16_t* kp = P + krow * INC + C_NAK + h * 64 + lq * 8;                                                 \
    kfa[SET][kt] = *(const bf16x8*)(kp); kfb[SET][kt] = *(const bf16x8*)(kp + 32);                               \
  }
  NA_LOADK(0, 0)
  __syncthreads();
#pragma unroll
  for (int s = 0; s < 4; ++s) {
    if (s + 1 < 4) { NA_LOADK((s + 1) & 1, s + 1) }
    if (half == 0) {
      const int wr0 = 2 * s;
      NA_STEP(kfa[s & 1][kt], kfb[s & 1][kt],
              ((k0 + 16 * (kt & 1) + 4 * lq + r) >= cs && (k0 + 16 * (kt & 1) + 4 * lq + r) < cs + 16)
                  ? RPB[(rs + wr0 + (kt >> 1) - grow + 7) * 31 + (k0 + 16 * (kt & 1) + 4 * lq + r) - qc + 15] : -1e30f,
              VtW, NA_WS, (wr0 + g) * 64 + k0)
    } else {
      NA_STEP(kfa[s & 1][kt], kfb[s & 1][kt], 0.f, VtC, NA_CS, s * 64 + 32 * g)
    }
  }
  lrun += __shfl_xor(lrun, 16); lrun += __shfl_xor(lrun, 32);
  float* mg = MRG + (jt * 64 + lane) * 18;
  if (half == 1) {
    mg[0] = mrun; mg[1] = lrun;
#pragma unroll
    for (int dt = 0; dt < 4; ++dt) { mg[2 + dt * 4 + 0] = O[dt][0]; mg[2 + dt * 4 + 1] = O[dt][1]; mg[2 + dt * 4 + 2] = O[dt][2]; mg[2 + dt * 4 + 3] = O[dt][3]; }
  }
  __syncthreads();
  if (half == 0) {
    const float m2 = mg[0], l2 = mg[1];
    const float M = fmaxf(mrun, m2);
    const float f1 = __builtin_amdgcn_exp2f(mrun - M), f2 = __builtin_amdgcn_exp2f(m2 - M);
    const float inv = 1.f / (lrun * f1 + l2 * f2);
    bf16_t* dst = Y + (size_t)mq * 1024 + Y_NA + h * 64;
#pragma unroll
    for (int dt = 0; dt < 4; ++dt) {
      const float o0 = (O[dt][0] * f1 + mg[2 + dt * 4 + 0] * f2) * inv, o1 = (O[dt][1] * f1 + mg[2 + dt * 4 + 1] * f2) * inv;
      const float o2 = (O[dt][2] * f1 + mg[2 + dt * 4 + 2] * f2) * inv, o3 = (O[dt][3] * f1 + mg[2 + dt * 4 + 3] * f2) * inv;
      uint2 ov; ov.x = pack2(o0, o1); ov.y = pack2(o2, o3);
      *(uint2*)(dst + dt * 16 + 4 * lq) = ov;
    }
  }
}

__device__ __forceinline__ void na_ctx_item(const Params& p, int item, char* smem) {
  const bf16_t* P = (const bf16_t*)(p.ws + OFF_P);
  bf16_t* Y = (bf16_t*)(p.ws + OFF_ACT);
  const int b = item >> 3, h = (item >> 1) & 3, qg = item & 1;
  const int tid = opaque_tid(), lane = tid & 63, wave = tid >> 6, lr = lane & 15, lq = lane >> 4;
  bf16_t* VtC = (bf16_t*)(smem + NA_OFF_VTC);
  __syncthreads();
  {
    const int ch = tid & 7;
#pragma unroll
    for (int i = 0; i < 4; ++i) {
      const int key = (tid >> 3) + 64 * i;
      const uint4 uv = *(const uint4*)(P + (size_t)(NLAT + b * 256 + key) * INC + C_NAV + h * 64 + ch * 8);
      vt_store8(VtC, NA_CS, ch * 8, key, uv);
    }
  }
  const int mq = NLAT + b * 256 + qg * 128 + wave * 16 + lr;
  bf16x8 qf[2];
  {
    const bf16_t* qr = P + (size_t)mq * INC + C_NAQ + h * 64 + lq * 8;
    qf[0] = *(const bf16x8*)(qr);
    qf[1] = *(const bf16x8*)(qr + 32);
  }
  f32x4 O[4];
#pragma unroll
  for (int i = 0; i < 4; ++i) O[i] = (f32x4){0.f, 0.f, 0.f, 0.f};
  float mrun = -1e30f, lrun = 0.f;
  __syncthreads();
#pragma unroll 1
  for (int s = 0; s < 4; ++s) {
    NA_STEP(*(const bf16x8*)(P + (size_t)(NLAT + b * 256 + s * 64 + kt * 16 + lr) * INC + C_NAK + h * 64 + lq * 8),
            *(const bf16x8*)(P + (size_t)(NLAT + b * 256 + s * 64 + kt * 16 + lr) * INC + C_NAK + h * 64 + 32 + lq * 8), 0.f, VtC, NA_CS, s * 64 + 32 * g)
  }
  lrun += __shfl_xor(lrun, 16); lrun += __shfl_xor(lrun, 32);
  const float inv = 1.f / lrun;
  bf16_t* dst = Y + (size_t)mq * 1024 + Y_NA + h * 64;
#pragma unroll
  for (int dt = 0; dt < 4; ++dt) {
    uint2 ov; ov.x = pack2(O[dt][0] * inv, O[dt][1] * inv); ov.y = pack2(O[dt][2] * inv, O[dt][3] * inv);
    *(uint2*)(dst + dt * 16 + 4 * lq) = ov;
  }
}

constexpr int KV_S = 136;
constexpr int KV_OFF_KF = 0, KV_OFF_KB = 64 * KV_S * 2, KV_OFF_VT = 2 * 64 * KV_S * 2;
__device__ __forceinline__ void ret_kv_item(const Params& p, int layer, int h, size_t row0, int cnt, float* dstF, float* dstB, char* smem) {
  const bf16_t* P = (const bf16_t*)(p.ws + OFF_P);
  const float* misc = (const float*)(p.ws + OFF_MISC);
  const float lgF2 = misc[16 + layer * 8 + 0 * 4 + h] * 1.4426950408889634f, lgB2 = misc[16 + layer * 8 + 1 * 4 + h] * 1.4426950408889634f;
  const int tid = opaque_tid(), lane = tid & 63, wave = tid >> 6, lr = lane & 15, lq = lane >> 4;
  bf16_t* KFt = (bf16_t*)(smem + KV_OFF_KF);
  bf16_t* KBt = (bf16_t*)(smem + KV_OFF_KB);
  bf16_t* Vt = (bf16_t*)(smem + KV_OFF_VT);
  const int dir = wave >> 2, dt = wave & 3;
  f32x4 acc[8];
#pragma unroll
  for (int i = 0; i < 8; ++i) acc[i] = (f32x4){0.f, 0.f, 0.f, 0.f};
#pragma unroll 1
  for (int kc = 0; kc < (cnt >> 7); ++kc) {
    __syncthreads();
    {
      const int tok = tid >> 2, c = tid & 3;
      const int j = kc * 128 + tok;
      const float wF = __builtin_amdgcn_exp2f(lgF2 * (float)(cnt - 1 - j)), wB = __builtin_amdgcn_exp2f(lgB2 * (float)j);
      const bf16_t* rowp = P + (row0 + j) * INC;
#pragma unroll
      for (int c8 = 0; c8 < 2; ++c8) {
        const uint4 u = *(const uint4*)(rowp + C_RTK + h * 64 + c * 16 + c8 * 8);
        float kv[8];
        UNPACK8(kv, 0, u)
#pragma unroll
        for (int i = 0; i < 8; ++i) {
          KFt[(c * 16 + c8 * 8 + i) * KV_S + tok] = f2bf(kv[i] * wF);
          KBt[(c * 16 + c8 * 8 + i) * KV_S + tok] = f2bf(kv[i] * wB);
        }
      }
#pragma unroll
      for (int c8 = 0; c8 < 4; ++c8) {
        const uint4 uv = *(const uint4*)(rowp + C_RTV + h * 128 + c * 32 + c8 * 8);
        vt_store8(Vt, KV_S, c * 32 + c8 * 8, tok, uv);
      }
    }
    __syncthreads();
    const bf16_t* Kt = dir == 0 ? KFt : KBt;
    bf16x8 af[4];
#pragma unroll
    for (int ks = 0; ks < 4; ++ks) af[ks] = *(const bf16x8*)(Kt + (dt * 16 + lr) * KV_S + ks * 32 + lq * 8);
#pragma unroll
    for (int et = 0; et < 8; ++et) {
#pragma unroll
      for (int ks = 0; ks < 4; ++ks) {
        const bf16x8 bfr = *(const bf16x8*)(Vt + (et * 16 + lr) * KV_S + ks * 32 + lq * 8);
        acc[et] = __builtin_amdgcn_mfma_f32_16x16x32_bf16(af[ks], bfr, acc[et], 0, 0, 0);
      }
    }
  }
  float* dst = dir == 0 ? dstF : dstB;
#pragma unroll
  for (int et = 0; et < 8; ++et) {
#pragma unroll
    for (int r = 0; r < 4; ++r) dst[(dt * 16 + 4 * lq + r) * 128 + et * 16 + lr] = acc[et][r];
  }
}

__device__ __forceinline__ void phase_ret_scan(const Params& p, int layer) {
  const float* misc = (const float*)(p.ws + OFF_MISC);
  float* rkv = (float*)(p.ws + OFF_RKV);
  const float* rs = (const float*)(p.ws + OFF_RS);
  const int gt = opaque_bid() * 512 + opaque_tid(), gs = gridDim.x * 512;
  for (int idx = gt; idx < 64 * 2048; idx += gs) {
    const int seq = idx >> 11, e4 = (idx & 2047) * 4;
    const int dir = seq & 1, h = (seq >> 1) & 3;
    const float cdec = __expf(misc[16 + layer * 8 + dir * 4 + h] * 128.f);
    float4* base = (float4*)(rkv + (size_t)seq * 32 * 8192 + e4);
    float4 v[32];
#pragma unroll
    for (int s = 0; s < 32; ++s) v[s] = base[(size_t)s * 2048];
    float4 st = *(const float4*)(rs + (size_t)seq * 8192 + e4);
    if (dir == 0) {
#pragma unroll
      for (int s = 0; s < 32; ++s) {
        const float4 t = v[s];
        base[(size_t)s * 2048] = st;
        st.x = fmaf(cdec, st.x, t.x); st.y = fmaf(cdec, st.y, t.y); st.z = fmaf(cdec, st.z, t.z); st.w = fmaf(cdec, st.w, t.w);
      }
    } else {
#pragma unroll
      for (int s = 31; s >= 0; --s) {
        const float4 t = v[s];
        base[(size_t)s * 2048] = st;
        st.x = fmaf(cdec, st.x, t.x); st.y = fmaf(cdec, st.y, t.y); st.z = fmaf(cdec, st.z, t.z); st.w = fmaf(cdec, st.w, t.w);
      }
    }
  }
}

constexpr int RT_KS = 72, RT_VS = 136;
constexpr int RT_OFF_K = 0, RT_OFF_VT = 128 * RT_KS * 2, RT_OFF_SF = RT_OFF_VT + 128 * RT_VS * 2, RT_OFF_SB = RT_OFF_SF + 128 * RT_KS * 2;
__device__ __forceinline__ void ret_out_item(const Params& p, int layer, int h, size_t krow0, int nkc, int iq0,
                                             const float* SF, const float* SB, int clen, char* smem) {
  const bf16_t* P = (const bf16_t*)(p.ws + OFF_P);
  bf16_t* Y = (bf16_t*)(p.ws + OFF_ACT);
  const float* misc = (const float*)(p.ws + OFF_MISC);
  const float lgF2 = misc[16 + layer * 8 + 0 * 4 + h] * 1.4426950408889634f, lgB2 = misc[16 + layer * 8 + 1 * 4 + h] * 1.4426950408889634f;
  const int tid = opaque_tid(), lane = tid & 63, wave = tid >> 6, lr = lane & 15, lq = lane >> 4;
  bf16_t* Ks = (bf16_t*)(smem + RT_OFF_K);
  bf16_t* Vt = (bf16_t*)(smem + RT_OFF_VT);
  bf16_t* SFt = (bf16_t*)(smem + RT_OFF_SF);
  bf16_t* SBt = (bf16_t*)(smem + RT_OFF_SB);
  const int iq = iq0 + wave * 16 + lr;
  const size_t mq = krow0 + iq;
  bf16x8 qf[2];
  {
    const bf16_t* qr = P + mq * INC + C_RTQ + h * 64 + lq * 8;
    qf[0] = *(const bf16x8*)(qr);
    qf[1] = *(const bf16x8*)(qr + 32);
  }
  f32x4 O[8];
#pragma unroll
  for (int i = 0; i < 8; ++i) O[i] = (f32x4){0.f, 0.f, 0.f, 0.f};
  if (SF != nullptr) {
    __syncthreads();
    {
      const int d = tid >> 3, e0 = (tid & 7) * 16;
#pragma unroll
      for (int c4 = 0; c4 < 4; ++c4) {
        const float4 a = *(const float4*)(SF + d * 128 + e0 + c4 * 4);
        const float4 bb = *(const float4*)(SB + d * 128 + e0 + c4 * 4);
        SFt[(e0 + c4 * 4 + 0) * RT_KS + d] = f2bf(a.x); SFt[(e0 + c4 * 4 + 1) * RT_KS + d] = f2bf(a.y);
        SFt[(e0 + c4 * 4 + 2) * RT_KS + d] = f2bf(a.z); SFt[(e0 + c4 * 4 + 3) * RT_KS + d] = f2bf(a.w);
        SBt[(e0 + c4 * 4 + 0) * RT_KS + d] = f2bf(bb.x); SBt[(e0 + c4 * 4 + 1) * RT_KS + d] = f2bf(bb.y);
        SBt[(e0 + c4 * 4 + 2) * RT_KS + d] = f2bf(bb.z); SBt[(e0 + c4 * 4 + 3) * RT_KS + d] = f2bf(bb.w);
      }
    }
    __syncthreads();
    const float cF = __builtin_amdgcn_exp2f(lgF2 * (float)(iq + 1)), cB = __builtin_amdgcn_exp2f(lgB2 * (float)(clen - iq));
#pragma unroll
    for (int ks = 0; ks < 2; ++ks)
#pragma unroll
      for (int et = 0; et < 8; ++et) {
        const bf16x8 sf = *(const bf16x8*)(SFt + (et * 16 + lr) * RT_KS + ks * 32 + lq * 8);
        O[et] = __builtin_amdgcn_mfma_f32_16x16x32_bf16(sf, qf[ks], O[et], 0, 0, 0);
      }
    const float ratio = cF / cB;
#pragma unroll
    for (int et = 0; et < 8; ++et) { O[et][0] *= ratio; O[et][1] *= ratio; O[et][2] *= ratio; O[et][3] *= ratio; }
#pragma unroll
    for (int ks = 0; ks < 2; ++ks)
#pragma unroll
      for (int et = 0; et < 8; ++et) {
        const bf16x8 sb = *(const bf16x8*)(SBt + (et * 16 + lr) * RT_KS + ks * 32 + lq * 8);
        O[et] = __builtin_amdgcn_mfma_f32_16x16x32_bf16(sb, qf[ks], O[et], 0, 0, 0);
      }
#pragma unroll
    for (int et = 0; et < 8; ++et) { O[et][0] *= cB; O[et][1] *= cB; O[et][2] *= cB; O[et][3] *= cB; }
  }
#pragma unroll 1
  for (int kc = 0; kc < nkc; ++kc) {
    __syncthreads();
    {
      const int key = tid >> 2, c = tid & 3;
      const bf16_t* rowp = P + (krow0 + kc * 128 + key) * INC;
      const uint4 k0 = *(const uint4*)(rowp + C_RTK + h * 64 + c * 16), k1 = *(const uint4*)(rowp + C_RTK + h * 64 + c * 16 + 8);
      *(uint4*)(Ks + key * RT_KS + c * 16) = k0;
      *(uint4*)(Ks + key * RT_KS + c * 16 + 8) = k1;
#pragma unroll
      for (int c8 = 0; c8 < 4; ++c8) {
        const uint4 uv = *(const uint4*)(rowp + C_RTV + h * 128 + c * 32 + c8 * 8);
        vt_store8(Vt, RT_VS, c * 32 + c8 * 8, key, uv);
      }
    }
    __syncthreads();
    f32x4 S[8];
#pragma unroll
    for (int kt = 0; kt < 8; ++kt) {
      const bf16x8 ka = *(const bf16x8*)(Ks + (kt * 16 + lr) * RT_KS + lq * 8);
      const bf16x8 kb = *(const bf16x8*)(Ks + (kt * 16 + lr) * RT_KS + 32 + lq * 8);
      const f32x4 a = __builtin_amdgcn_mfma_f32_16x16x32_bf16(ka, qf[0], (f32x4){0.f, 0.f, 0.f, 0.f}, 0, 0, 0);
      S[kt] = __builtin_amdgcn_mfma_f32_16x16x32_bf16(kb, qf[1], a, 0, 0, 0);
    }
#pragma unroll
    for (int kt = 0; kt < 8; ++kt) {
#pragma unroll
      for (int r = 0; r < 4; ++r) {
        const int df = iq - (kc * 128 + kt * 16 + 4 * lq + r);
        const float fdf = (float)df;
        float coef = 0.f;
        if (df >= 0) coef += __builtin_amdgcn_exp2f(lgF2 * fdf);
        if (df <= 0) coef += __builtin_amdgcn_exp2f(-lgB2 * fdf);
        S[kt][r] *= coef;
      }
    }
#pragma unroll
    for (int g = 0; g < 4; ++g) {
      union { unsigned u[4]; bf16x8 v; } pf;
      pf.u[0] = cvt_pk_bf16(S[2 * g][0], S[2 * g][1]); pf.u[1] = cvt_pk_bf16(S[2 * g][2], S[2 * g][3]);
      pf.u[2] = cvt_pk_bf16(S[2 * g + 1][0], S[2 * g + 1][1]); pf.u[3] = cvt_pk_bf16(S[2 * g + 1][2], S[2 * g + 1][3]);
#pragma unroll
      for (int et = 0; et < 8; ++et) {
        union { uint2 h2[2]; bf16x8 v; } vf;
        vf.h2[0] = *(const uint2*)(Vt + (et * 16 + lr) * RT_VS + 32 * g + 4 * lq);
        vf.h2[1] = *(const uint2*)(Vt + (et * 16 + lr) * RT_VS + 32 * g + 16 + 4 * lq);
        O[et] = __builtin_amdgcn_mfma_f32_16x16x32_bf16(vf.v, pf.v, O[et], 0, 0, 0);
      }
    }
  }
  float ss = 0.f;
#pragma unroll
  for (int et = 0; et < 8; ++et) { ss = fmaf(O[et][0], O[et][0], ss); ss = fmaf(O[et][1], O[et][1], ss); ss = fmaf(O[et][2], O[et][2], ss); ss = fmaf(O[et][3], O[et][3], ss); }
  ss += __shfl_xor(ss, 16); ss += __shfl_xor(ss, 32);
  const float rr = rsqrtf(ss * (1.f / 128.f) + EPS);
  const bf16_t* gp = P + mq * INC + C_RTG + h * 128;
  bf16_t* dst = Y + mq * 1024 + Y_RT + h * 128;
#pragma unroll
  for (int et = 0; et < 8; ++et) {
    const int e = et * 16 + 4 * lq;
    const uint2 gu = *(const uint2*)(gp + e);
    uint2 ov;
    ov.x = pack2(O[et][0] * rr * siluf(lo16(gu.x)), O[et][1] * rr * siluf(hi16(gu.x)));
    ov.y = pack2(O[et][2] * rr * siluf(lo16(gu.y)), O[et][3] * rr * siluf(hi16(gu.y)));
    *(uint2*)(dst + e) = ov;
  }
}

__device__ __forceinline__ void uv_convert_item(const Params& p, int item) {
  char* ws = p.ws;
  const int tid = opaque_tid();
  const int lane = tid & 63, l = lane & 31, half = lane >> 5, wave = tid >> 6;
#pragma unroll 1
  for (int it = 0; it < 16; ++it) {
    const int row = item * 256 + (wave * 16 + it) * 2 + half;
    const bool isv = row >= 2 * NEXP;
    const int rr = isv ? row - 2 * NEXP : row;
    const float* srow = (isv ? p.peer_v : p.peer_u) + (size_t)rr * 1024;
    float4 v[8];
    float mx = 0.f;
#pragma unroll
    for (int j = 0; j < 8; ++j) {
      v[j] = ((const float4*)srow)[isv ? (l + 32 * j) : (l * 8 + j)];
      mx = fmaxf(mx, fmaxf(fmaxf(fabsf(v[j].x), fabsf(v[j].y)), fmaxf(fabsf(v[j].z), fabsf(v[j].w))));
    }
#pragma unroll
    for (int o = 1; o < 32; o <<= 1) mx = fmaxf(mx, __shfl_xor(mx, o));
    const float scale4 = mx > 0.f ? mx * (1.f / 6.f) : 1.f;
    const float inv4 = 1.f / scale4;
    unsigned w[4] = {0u, 0u, 0u, 0u};
#pragma unroll
    for (int k = 0; k < 32; ++k) {
      const float xv = (k & 3) == 0 ? v[k >> 2].x : (k & 3) == 1 ? v[k >> 2].y : (k & 3) == 2 ? v[k >> 2].z : v[k >> 2].w;
      const float a = fminf(fabsf(xv) * inv4, 6.f);
      float c;
      if (a < 2.f) c = rintf(a * 2.f);
      else if (a < 4.f) c = 4.f + rintf(a - 2.f);
      else c = 6.f + rintf((a - 4.f) * 0.5f);
      unsigned code = (unsigned)c;
      code = code > 7u ? 7u : code;
      code |= (xv < 0.f) ? 8u : 0u;
      w[k >> 3] |= code << (4 * (k & 7));
    }
    char* drow = ws + OFF_U + (size_t)rr * RECB + (isv ? ROWB + l * 16 : 64 * (l & 7) + 16 * (l >> 3));
    *(uint4*)(drow) = make_uint4(w[0], w[1], w[2], w[3]);
    if (l == 0) ((float*)(ws + (isv ? OFF_VSC : OFF_USC)))[rr] = scale4;
  }
}

__device__ __forceinline__ void phase_mix1(const Params& p, int layer, char* smem, int slot = 0) {
  unsigned* ctr = (unsigned*)(p.ws + OFF_CTL) + (layer * 4 + slot);
  const bool nc = layer == 0;
  const int n_dl = 512, n_dc = nc ? 32 : 0, n_nl = 2048, n_ncx = nc ? 64 : 0, n_kv = 1024, n_cs = 32;
  const int total = n_dl + n_dc + n_nl + n_ncx + n_kv + n_cs;
  float* rkv = (float*)(p.ws + OFF_RKV);
  float* rs = (float*)(p.ws + OFF_RS);
  for (;;) {
    int it = next_item(ctr, smem);
    if (it >= total) break;
    if (it < n_dl) { diff_item(p, layer, false, it, smem); continue; } it -= n_dl;
    if (it < n_dc) { diff_item(p, layer, true, it, smem); continue; } it -= n_dc;
    if (it < n_nl) { na_latent_item(p, layer, it, smem); continue; } it -= n_nl;
    if (it < n_ncx) { na_ctx_item(p, it, smem); continue; } it -= n_ncx;
    if (it < n_kv) {
      const int bh = it >> 5, n = it & 31, b = bh >> 2, h = bh & 3;
      ret_kv_item(p, layer, h, (size_t)b * 4096 + n * 128, 128,
                  rkv + ((size_t)(bh * 2 + 0) * 32 + n) * 8192, rkv + ((size_t)(bh * 2 + 1) * 32 + n) * 8192, smem);
      continue;
    }
    it -= n_kv;
    {
      const int bh = it, b = bh >> 2, h = bh & 3;
      ret_kv_item(p, layer, h, (size_t)NLAT + b * 256, 256, rs + (size_t)(bh * 2 + 0) * 8192, rs + (size_t)(bh * 2 + 1) * 8192, smem);
    }
  }
}

__device__ __forceinline__ void phase_mix2(const Params& p, int layer, char* smem, int slot = 1) {
  unsigned* ctr = (unsigned*)(p.ws + OFF_CTL) + (layer * 4 + slot);
  const int n_l = 1024, n_c = layer == 0 ? 64 : 0;
  const float* rkv = (const float*)(p.ws + OFF_RKV);
  for (;;) {
    int it = next_item(ctr, smem);
    if (it >= n_l + n_c) break;
    if (it < n_l) {
      const int bh = it >> 5, n = it & 31, b = bh >> 2, h = bh & 3;
      ret_out_item(p, layer, h, (size_t)b * 4096 + n * 128, 1, 0,
                   rkv + ((size_t)(bh * 2 + 0) * 32 + n) * 8192, rkv + ((size_t)(bh * 2 + 1) * 32 + n) * 8192, 128, smem);
    } else {
      it -= n_l;
      const int bh = it >> 1, half = it & 1, b = bh >> 2, h = bh & 3;
      ret_out_item(p, layer, h, (size_t)NLAT + b * 256, 2, half * 128, nullptr, nullptr, 256, smem);
    }
  }
}

typedef float f32x2 __attribute__((ext_vector_type(2)));
__device__ __forceinline__ unsigned sortable_key(float f, int idx) {
  const unsigned b = __float_as_uint(f);
  const unsigned k = b ^ ((unsigned)((int)b >> 31) | 0x80000000u);
  return (k & ~127u) | (unsigned)(127 - idx);
}
__device__ __forceinline__ float key_value(unsigned k) {
  k &= ~127u;
  const unsigned b = (k & 0x80000000u) ? (k ^ 0x80000000u) : ~k;
  return __uint_as_float(b);
}
#define FP8DOT(acc, H, off, W) { const f32x2 _a = __builtin_amdgcn_cvt_pk_f32_fp8((int)(W), false), _b = __builtin_amdgcn_cvt_pk_f32_fp8((int)(W), true); \
  acc = fmaf(H[(off) + 0], _a.x, acc); acc = fmaf(H[(off) + 1], _a.y, acc); acc = fmaf(H[(off) + 2], _b.x, acc); acc = fmaf(H[(off) + 3], _b.y, acc); }
#define FP8AXPY(O, off, P, W) { const f32x2 _a = __builtin_amdgcn_cvt_pk_f32_fp8((int)(W), false), _b = __builtin_amdgcn_cvt_pk_f32_fp8((int)(W), true); \
  O[(off) + 0] = fmaf(P, _a.x, O[(off) + 0]); O[(off) + 1] = fmaf(P, _a.y, O[(off) + 1]); O[(off) + 2] = fmaf(P, _b.x, O[(off) + 2]); O[(off) + 3] = fmaf(P, _b.y, O[(off) + 3]); }

__device__ __forceinline__ float gelu_erf(float a) {
  const float x = fabsf(a) * 0.70710678118654752f;
  const float t = __builtin_amdgcn_rcpf(fmaf(0.3275911f, x, 1.f));
  float pl = fmaf(1.061405429f, t, -1.453152027f);
  pl = fmaf(pl, t, 1.421413741f); pl = fmaf(pl, t, -0.284496736f); pl = fmaf(pl, t, 0.254829592f);
  const float y = 1.f - pl * t * __builtin_amdgcn_exp2f(-x * x * 1.4426950408889634f);
  const float er = a < 0.f ? -y : y;
  return 0.5f * a * (1.f + er);
}
constexpr int PE_SVS = 132;
constexpr int PE_OFF_SV = 0;
constexpr int PE_OFF_TV = 8 * 16 * PE_SVS * 4;
constexpr int PE_OFF_TI = PE_OFF_TV + 16 * 16 * 16 * 4;
constexpr int PE_OFF_EX = PE_OFF_TI + 16 * 16 * 16 * 4;
constexpr int PE_OFF_GT = PE_OFF_EX + 2 * 16 * 128 * 4;
constexpr int PE_OFF_SU = PE_OFF_GT + 2 * 16 * 128 * 4;
constexpr int PE_OFF_CN = PE_OFF_SU + 2 * 16 * 128 * 4;
constexpr int PE_OFF_CT = PE_OFF_CN + 8 * 16 * 4;
constexpr int PE_OFF_TQ = PE_OFF_CT + 64 * 4;
static_assert(PE_OFF_TQ + 16 <= LDS_BCAST, "PEER LDS map overflows");
#define WAVE_LDS_FENCE() asm volatile("s_waitcnt lgkmcnt(0)" ::: "memory")

__device__ __forceinline__ void peer_select_head(const Params& p, int layer, char* smem, int tok0, int hd, int sw, int buf,
                                                 int lane) {
  const bf16_t* Q = (const bf16_t*)(p.ws + OFF_P);
  const bf16_t* SK = (const bf16_t*)(p.ws + OFF_SUBK) + (size_t)layer * 262144;
  const int lr = lane & 15, lq = lane >> 4;
  unsigned* SV = (unsigned*)(smem + PE_OFF_SV) + sw * 16 * PE_SVS;
  float* TV = (float*)(smem + PE_OFF_TV);
  int* TI = (int*)(smem + PE_OFF_TI);
  int* EX = (int*)(smem + PE_OFF_EX) + buf * 16 * 128;
  float* GT = (float*)(smem + PE_OFF_GT) + buf * 16 * 128;
  int* CN = (int*)(smem + PE_OFF_CN) + sw * 16;
  float* SU = (float*)(smem + PE_OFF_SU) + buf * 16 * 128;
  const float* USC = (const float*)(p.ws + OFF_USC) + layer * NEXP;
  const float* VSC = (const float*)(p.ws + OFF_VSC) + layer * NEXP;
#pragma unroll 1
  for (int pp = 0; pp < 2; ++pp) {
    bf16x8 af[4];
    const bf16_t* qfr = Q + ((((size_t)(tok0 >> 4) * 16 + hd * 2 + pp) * 4) * 64 + lane) * 8;
#pragma unroll
    for (int ks = 0; ks < 4; ++ks) af[ks] = *(const bf16x8*)(qfr + ks * 512);
    const bf16_t* skb = SK + (size_t)((hd * 2 + pp) * 128) * 128;
    f32x4 acc[8];
    {
      bf16x8 bfr[8][4];
#pragma unroll
      for (int nt = 0; nt < 8; ++nt)
#pragma unroll
        for (int ks = 0; ks < 4; ++ks)
          bfr[nt][ks] = *(const bf16x8*)(skb + (size_t)((nt * 4 + ks) * 64 + lane) * 8);
#pragma unroll
      for (int nt = 0; nt < 8; ++nt) {
        f32x4 a = (f32x4){0.f, 0.f, 0.f, 0.f};
#pragma unroll
        for (int ks = 0; ks < 4; ++ks) a = __builtin_amdgcn_mfma_f32_16x16x32_bf16(af[ks], bfr[nt][ks], a, 0, 0, 0);
        acc[nt] = a;
      }
    }
#pragma unroll
    for (int i = 0; i < 9; ++i) { const int q4 = lane + 64 * i; if (q4 < 16 * PE_SVS / 4) ((uint4*)SV)[q4] = make_uint4(0u, 0u, 0u, 0u); }
    WAVE_LDS_FENCE();
#pragma unroll
    for (int r = 0; r < 4; ++r) {
      const int tk = 4 * lq + r;
      unsigned k[8];
#pragma unroll
      for (int nt = 0; nt < 8; ++nt) k[nt] = sortable_key(acc[nt][r], nt * 16 + lr);
      unsigned m1 = max(k[0], k[1]), m2 = min(k[0], k[1]);
#pragma unroll
      for (int nt = 2; nt < 8; ++nt) { m2 = max(m2, min(m1, k[nt])); m1 = max(m1, k[nt]); }
      const unsigned Ta = row16_min_u32(m1);
      const unsigned Tb = min(row16_kth_largest<11>(m1), row16_kth_largest<5>(m2));
      const unsigned T = max(Ta, Tb);
      int pos = 0;
#pragma unroll
      for (int nt = 0; nt < 8; ++nt) {
        const bool sel = k[nt] >= T;
        const unsigned long long bal = __ballot(sel);
        const unsigned grp16 = (unsigned)(bal >> (16 * lq)) & 0xffffu;
        const int below = __popc(grp16 & ((1u << lr) - 1u));
        if (sel) SV[tk * PE_SVS + pos + below] = k[nt];
        pos += __popc(grp16);
      }
      if (lr == 0) CN[tk] = pos;
    }
    WAVE_LDS_FENCE();
#pragma unroll 1
    for (int pass = 0; pass < 4; ++pass) {
      const int tk = pass * 4 + lq;
      const int cnt = CN[tk];
      const unsigned* row = SV + tk * PE_SVS;
      int cm = cnt;
      cm = max(cm, __shfl_xor(cm, 16)); cm = max(cm, __shfl_xor(cm, 32));
      const int cmax = __builtin_amdgcn_readfirstlane(cm);
      const int nblk = (cmax + 15) >> 4;
#pragma unroll 1
      for (int rd = 0; rd < nblk; ++rd) {
        const int j = rd * 16 + lr;
        const unsigned my = row[j];
        int rank = 0;
#pragma unroll 1
        for (int b4 = 0; b4 < nblk; ++b4) {
          const uint4 v0 = *(const uint4*)(row + b4 * 16), v1 = *(const uint4*)(row + b4 * 16 + 4);
          const uint4 v2 = *(const uint4*)(row + b4 * 16 + 8), v3 = *(const uint4*)(row + b4 * 16 + 12);
          rank += (v0.x > my) ? 1 : 0; rank += (v0.y > my) ? 1 : 0; rank += (v0.z > my) ? 1 : 0; rank += (v0.w > my) ? 1 : 0;
          rank += (v1.x > my) ? 1 : 0; rank += (v1.y > my) ? 1 : 0; rank += (v1.z > my) ? 1 : 0; rank += (v1.w > my) ? 1 : 0;
          rank += (v2.x > my) ? 1 : 0; rank += (v2.y > my) ? 1 : 0; rank += (v2.z > my) ? 1 : 0; rank += (v2.w > my) ? 1 : 0;
          rank += (v3.x > my) ? 1 : 0; rank += (v3.y > my) ? 1 : 0; rank += (v3.z > my) ? 1 : 0; rank += (v3.w > my) ? 1 : 0;
        }
        if (j < cnt && rank < 16) {
          TV[(tk * 16 + hd * 2 + pp) * 16 + rank] = key_value(my);
          TI[(tk * 16 + hd * 2 + pp) * 16 + rank] = 127 - (int)(my & 127u);
        }
      }
    }
    WAVE_LDS_FENCE();
  }
  {
    const int cab = ((const int*)(smem + PE_OFF_CT))[lane];
    const int cand_a = cab >> 4, cand_b = cab & 15;
    unsigned* CWt = SV;
    float vals[16];
#pragma unroll
    for (int tk = 0; tk < 16; ++tk) {
      float val = 0.f;
      unsigned key = 0u;
      if (cand_a >= 0) {
        val = TV[(tk * 16 + hd * 2 + 0) * 16 + cand_a] + TV[(tk * 16 + hd * 2 + 1) * 16 + cand_b];
        const unsigned bb = __float_as_uint(val);
        key = ((bb ^ ((unsigned)((int)bb >> 31) | 0x80000000u)) & ~63u) | (unsigned)(63 - lane);
      }
      vals[tk] = val;
      CWt[tk * 64 + lane] = key;
    }
    WAVE_LDS_FENCE();
#pragma unroll
    for (int tk = 0; tk < 16; ++tk) {
      const unsigned key = CWt[tk * 64 + lane];
      int rank = 0;
#pragma unroll
      for (int i4 = 0; i4 < 13; ++i4) {
        const uint4 v = *(const uint4*)(CWt + tk * 64 + i4 * 4);
        rank += (v.x > key) ? 1 : 0; rank += (v.y > key) ? 1 : 0; rank += (v.z > key) ? 1 : 0; rank += (v.w > key) ? 1 : 0;
      }
      if (cand_a >= 0 && rank < 16) {
        GT[tk * 128 + hd * 16 + rank] = vals[tk];
        EX[tk * 128 + hd * 16 + rank] = TI[(tk * 16 + hd * 2 + 0) * 16 + cand_a] * 128 + TI[(tk * 16 + hd * 2 + 1) * 16 + cand_b];
      }
    }
    WAVE_LDS_FENCE();
#pragma unroll
    for (int pass = 0; pass < 4; ++pass) {
      const int tk = pass * 4 + lq;
      const float g = GT[tk * 128 + hd * 16 + lr];
      const float mx = GT[tk * 128 + hd * 16];
      const float ev = __expf(g - mx);
      float s = ev;
      s += __shfl_xor(s, 1); s += __shfl_xor(s, 2); s += __shfl_xor(s, 4); s += __shfl_xor(s, 8);
      const int ex = EX[tk * 128 + hd * 16 + lr];
      GT[tk * 128 + hd * 16 + lr] = (ev / s) * VSC[ex];
      SU[tk * 128 + hd * 16 + lr] = USC[ex];
    }
    WAVE_LDS_FENCE();
  }
}

typedef float f32x32 __attribute__((ext_vector_type(32)));
typedef int i32x8 __attribute__((ext_vector_type(8)));
typedef int i32x6 __attribute__((ext_vector_type(6)));
typedef unsigned u32x6 __attribute__((ext_vector_type(6)));
#define FP4_AXPY8(O, off, P, W) {                                                                    \
  const f32x2 _q0 = __builtin_amdgcn_cvt_scalef32_pk_f32_fp4((W), 1.0f, 0), _q1 = __builtin_amdgcn_cvt_scalef32_pk_f32_fp4((W), 1.0f, 1); \
  const f32x2 _q2 = __builtin_amdgcn_cvt_scalef32_pk_f32_fp4((W), 1.0f, 2), _q3 = __builtin_amdgcn_cvt_scalef32_pk_f32_fp4((W), 1.0f, 3); \
  O[(off) + 0] = fmaf(P, _q0.x, O[(off) + 0]); O[(off) + 1] = fmaf(P, _q0.y, O[(off) + 1]);          \
  O[(off) + 2] = fmaf(P, _q1.x, O[(off) + 2]); O[(off) + 3] = fmaf(P, _q1.y, O[(off) + 3]);          \
  O[(off) + 4] = fmaf(P, _q2.x, O[(off) + 4]); O[(off) + 5] = fmaf(P, _q2.y, O[(off) + 5]);          \
  O[(off) + 6] = fmaf(P, _q3.x, O[(off) + 6]); O[(off) + 7] = fmaf(P, _q3.y, O[(off) + 7]); }
struct Fp6Row { uint4 a; uint2 b; };
typedef __bf16 bf16x32_t __attribute__((ext_vector_type(32)));
__device__ __forceinline__ bf16x32_t fp6_decode_bf16(const Fp6Row& r) {
  u32x6 w; w[0] = r.a.x; w[1] = r.a.y; w[2] = r.a.z; w[3] = r.a.w; w[4] = r.b.x; w[5] = r.b.y;
  return __builtin_amdgcn_cvt_scalef32_pk32_bf16_fp6(w, 1.0f);
}
__device__ __forceinline__ f32x32 fp6_decode(const Fp6Row& r) {
  u32x6 w; w[0] = r.a.x; w[1] = r.a.y; w[2] = r.a.z; w[3] = r.a.w; w[4] = r.b.x; w[5] = r.b.y;
  return __builtin_amdgcn_cvt_scalef32_pk32_f32_fp6(w, 1.0f);
}
__device__ __forceinline__ void peer_gather_token(const Params& p, int layer, char* smem, int tok, int tl, int buf, int lane, bool dowrite) {
  const bf16_t* H2 = (const bf16_t*)(p.ws + OFF_ACT);
  const char* U6 = p.ws + OFF_U + (size_t)layer * NEXP * RECB;
  const float* mod = (const float*)(p.ws + OFF_MOD) + (size_t)layer * 9 * 6144;
  const int* EX = (const int*)(smem + PE_OFF_EX) + buf * 16 * 128 + tl * 128;
  const float* GT = (const float*)(smem + PE_OFF_GT) + buf * 16 * 128 + tl * 128;
  const float* SU = (const float*)(smem + PE_OFF_SU) + buf * 16 * 128 + tl * 128;
  const int l = lane & 31, hf = lane >> 5;
  float acc[32];
  const int wv = __builtin_amdgcn_readfirstlane(threadIdx.x >> 6);
  unsigned char* XB = (unsigned char*)(smem + PE_OFF_SV) + wv * 16 * PE_SVS * 4;
  float* WD = (float*)(XB + 1024);
#define PE_LOADV(VV, PI) VV = *(const uint4*)(U6 + (size_t)EX[2 * (PI) + hf] * RECB + ROWB + l * 16);
  uint4 v0, v1, v2, v3, v4, v5, v6, v7, v8, v9, v10, v11, v12, v13, v14, v15;
  const int e16 = lane & 15, kg = lane >> 4;
  uint4 qa0, qa1, qa2, qa3, qa4, qa5, qa6, qa7, qb0, qb1, qb2, qb3, qb4, qb5, qb6, qb7, qc0, qc1, qc2, qc3, qc4, qc5, qc6, qc7;
  unsigned char* STG = XB + 1536;
  constexpr int STGP = 576;
#define PE_LOADA1(Q, EB, I) Q##I = *(const uint4*)(U6 + (size_t)EX[(EB) * 16 + 2 * (I) + hf] * RECB + l * 16);
#define PE_LOADA(Q, EB) { PE_LOADA1(Q, EB, 0) PE_LOADA1(Q, EB, 1) PE_LOADA1(Q, EB, 2) PE_LOADA1(Q, EB, 3) PE_LOADA1(Q, EB, 4) PE_LOADA1(Q, EB, 5) PE_LOADA1(Q, EB, 6) PE_LOADA1(Q, EB, 7) }
  PE_LOADA(qa, 0) PE_LOADA(qb, 1)
  float xscale;
  {
    const bf16_t* hr = H2 + (size_t)tok * 1024 + lane * 16;
    const uint4 a = *(const uint4*)hr, b2 = *(const uint4*)(hr + 8);
    float xv[16];
    UNPACK8(xv, 0, a) UNPACK8(xv, 8, b2)
    float mx = 0.f;
#pragma unroll
    for (int i = 0; i < 16; ++i) mx = fmaxf(mx, fabsf(xv[i]));
#pragma unroll
    for (int o = 1; o < 64; o <<= 1) mx = fmaxf(mx, __shfl_xor(mx, o));
    xscale = mx > 0.f ? mx * (1.f / 7.5f) : 1.f;
    const float inv = 1.f / xscale;
    unsigned w0 = 0u, w1 = 0u, w2 = 0u;
#pragma unroll
    for (int i = 0; i < 16; ++i) {
      const float av = fminf(fabsf(xv[i]) * inv, 7.5f);
      float c;
      if (av < 2.f) c = rintf(av * 8.f);
      else if (av < 4.f) c = 16.f + rintf((av - 2.f) * 4.f);
      else c = 24.f + rintf((av - 4.f) * 2.f);
      unsigned code = (unsigned)c;
      code = code > 31u ? 31u : code;
      code |= (xv[i] < 0.f) ? 32u : 0u;
      const int bit = 6 * i, wd = bit >> 5, sh = bit & 31;
      if (wd == 0) w0 |= code << sh; else if (wd == 1) w1 |= code << sh; else w2 |= code << sh;
      if (sh > 26) { if (wd == 0) w1 |= code >> (32 - sh); else if (wd == 1) w2 |= code >> (32 - sh); }
    }
    unsigned* xo = (unsigned*)(XB + lane * 12);
    xo[0] = w0; xo[1] = w1; xo[2] = w2;
  }
  WAVE_LDS_FENCE();
  {
    i32x8 Bx[8];
#pragma unroll
    for (int kb = 0; kb < 8; ++kb) {
      const uint2* bp = (const uint2*)(XB + 192 * kg + 24 * kb);
      const uint2 b0 = bp[0], b1 = bp[1], b2 = bp[2];
      Bx[kb] = (i32x8){(int)b0.x, (int)b0.y, (int)b1.x, (int)b1.y, (int)b2.x, (int)b2.y, 0, 0};
    }
#define PE_MMAU(Q, EB) {                                                                                     \
    uint4 a0_ = {0u, 0u, 0u, 0u}, a1_ = a0_, a2_ = a0_, a3_ = a0_, a4_ = a0_, a5_ = a0_, a6_ = a0_, a7_ = a0_;   \
    const unsigned char* rdp_ = STG + (e16 & 7) * STGP + 16 * kg;                                            \
    { unsigned char* wp_ = STG + hf * STGP + l * 16;                                                         \
      *(uint4*)(wp_) = Q##0; *(uint4*)(wp_ + 2 * STGP) = Q##1; *(uint4*)(wp_ + 4 * STGP) = Q##2; *(uint4*)(wp_ + 6 * STGP) = Q##3; } \
    if (e16 < 8) { a0_ = *(const uint4*)(rdp_); a1_ = *(const uint4*)(rdp_ + 64); a2_ = *(const uint4*)(rdp_ + 128); a3_ = *(const uint4*)(rdp_ + 192); \
                   a4_ = *(const uint4*)(rdp_ + 256); a5_ = *(const uint4*)(rdp_ + 320); a6_ = *(const uint4*)(rdp_ + 384); a7_ = *(const uint4*)(rdp_ + 448); } \
    { unsigned char* wp_ = STG + hf * STGP + l * 16;                                                         \
      *(uint4*)(wp_) = Q##4; *(uint4*)(wp_ + 2 * STGP) = Q##5; *(uint4*)(wp_ + 4 * STGP) = Q##6; *(uint4*)(wp_ + 6 * STGP) = Q##7; } \
    if (e16 >= 8) { a0_ = *(const uint4*)(rdp_); a1_ = *(const uint4*)(rdp_ + 64); a2_ = *(const uint4*)(rdp_ + 128); a3_ = *(const uint4*)(rdp_ + 192); \
                    a4_ = *(const uint4*)(rdp_ + 256); a5_ = *(const uint4*)(rdp_ + 320); a6_ = *(const uint4*)(rdp_ + 384); a7_ = *(const uint4*)(rdp_ + 448); } \
    f32x4 dacc = {0.f, 0.f, 0.f, 0.f};                                                                       \
    _Pragma("unroll") for (int kb = 0; kb < 8; ++kb) {                                                       \
      const uint4 ak_ = kb == 0 ? a0_ : kb == 1 ? a1_ : kb == 2 ? a2_ : kb == 3 ? a3_ : kb == 4 ? a4_ : kb == 5 ? a5_ : kb == 6 ? a6_ : a7_; \
      const i32x8 av = {(int)ak_.x, (int)ak_.y, (int)ak_.z, (int)ak_.w, 0, 0, 0, 0};                         \
      dacc = __builtin_amdgcn_mfma_scale_f32_16x16x128_f8f6f4(av, Bx[kb], dacc, 4, 2, 0, 0x7f7f7f7f, 0, 0x7f7f7f7f); \
    }                                                                                                        \
    asm volatile("" : "+v"(dacc));        \
    if (e16 == 0) *(float4*)(WD + (EB) * 16 + 4 * kg) = (float4){dacc[0], dacc[1], dacc[2], dacc[3]};        \
  }
    PE_LOADA(qc, 2) PE_MMAU(qa, 0)
    PE_LOADA(qa, 3) PE_MMAU(qb, 1)
    PE_LOADA(qb, 4) PE_MMAU(qc, 2)
    PE_LOADA(qc, 5) PE_MMAU(qa, 3)
    PE_LOADA(qa, 6) PE_MMAU(qb, 4)
    PE_LOADA(qb, 7) PE_MMAU(qc, 5)
    PE_LOADV(v0, 0) PE_LOADV(v1, 1) PE_LOADV(v2, 2) PE_LOADV(v3, 3) PE_LOADV(v4, 4) PE_LOADV(v5, 5) PE_MMAU(qa, 6)
    PE_LOADV(v6, 6) PE_LOADV(v7, 7) PE_LOADV(v8, 8) PE_LOADV(v9, 9) PE_LOADV(v10, 10) PE_LOADV(v11, 11) PE_MMAU(qb, 7)
    PE_LOADV(v12, 12) PE_LOADV(v13, 13) PE_LOADV(v14, 14) PE_LOADV(v15, 15)
  }
  WAVE_LDS_FENCE();
#pragma unroll
  for (int q = 0; q < 2; ++q) {
    const int e = lane + 64 * q;
    WD[e] = GT[e] * gelu_erf(WD[e] * SU[e] * xscale);
  }
  WAVE_LDS_FENCE();
#pragma unroll
  for (int i = 0; i < 32; ++i) acc[i] = 0.f;
  int one = 1;
  asm volatile("" : "+s"(one));
  const int b = tok < NLAT ? (tok >> 12) : 8;
  float* xr = tok < NLAT ? p.out + (size_t)tok * 1024 : (float*)(p.ws + OFF_CTXB) + (size_t)(tok - NLAT) * 1024;
  const float* gate = mod + (size_t)b * 6144 + 5 * 1024;
  float4 xv4[4], gv4[4];
#pragma unroll
  for (int jj = 0; jj < 4; ++jj) {
    const int c = (l + 32 * (4 * hf + jj)) * 4;
    xv4[jj] = *(const float4*)(xr + c);
    gv4[jj] = *(const float4*)(gate + c);
  }
#define PE_USEV(VV, PI)                                                               \
  _Pragma("unroll 1") for (int rep_ = 0; rep_ < one; ++rep_) {                        \
    const float w = WD[2 * (PI) + hf];                                                \
    FP4_AXPY8(acc, 0, w, VV.x) FP4_AXPY8(acc, 8, w, VV.y) FP4_AXPY8(acc, 16, w, VV.z) FP4_AXPY8(acc, 24, w, VV.w) \
  }
#pragma unroll 1
  for (int pi = 0; pi < 48; pi += 16) {
    PE_USEV(v0, pi + 0) PE_LOADV(v0, pi + 16)
    PE_USEV(v1, pi + 1) PE_LOADV(v1, pi + 17)
    PE_USEV(v2, pi + 2) PE_LOADV(v2, pi + 18)
    PE_USEV(v3, pi + 3) PE_LOADV(v3, pi + 19)
    PE_USEV(v4, pi + 4) PE_LOADV(v4, pi + 20)
    PE_USEV(v5, pi + 5) PE_LOADV(v5, pi + 21)
    PE_USEV(v6, pi + 6) PE_LOADV(v6, pi + 22)
    PE_USEV(v7, pi + 7) PE_LOADV(v7, pi + 23)
    PE_USEV(v8, pi + 8) PE_LOADV(v8, pi + 24)
    PE_USEV(v9, pi + 9) PE_LOADV(v9, pi + 25)
    PE_USEV(v10, pi + 10) PE_LOADV(v10, pi + 26)
    PE_USEV(v11, pi + 11) PE_LOADV(v11, pi + 27)
    PE_USEV(v12, pi + 12) PE_LOADV(v12, pi + 28)
    PE_USEV(v13, pi + 13) PE_LOADV(v13, pi + 29)
    PE_USEV(v14, pi + 14) PE_LOADV(v14, pi + 30)
    PE_USEV(v15, pi + 15) PE_LOADV(v15, pi + 31)
  }
  PE_USEV(v0, 48) PE_USEV(v1, 49) PE_USEV(v2, 50) PE_USEV(v3, 51) PE_USEV(v4, 52) PE_USEV(v5, 53) PE_USEV(v6, 54) PE_USEV(v7, 55) PE_USEV(v8, 56) PE_USEV(v9, 57) PE_USEV(v10, 58) PE_USEV(v11, 59) PE_USEV(v12, 60) PE_USEV(v13, 61) PE_USEV(v14, 62) PE_USEV(v15, 63)
#pragma unroll
  for (int k = 0; k < 32; ++k) acc[k] += __shfl_xor(acc[k], 32);
  float4 xn[4];
  float ss = 0.f;
#pragma unroll
  for (int jj = 0; jj < 4; ++jj) {
    const int c = (l + 32 * (4 * hf + jj)) * 4;
    const float4 xv = xv4[jj];
    const float4 gv = gv4[jj];
    const float a0 = hf ? acc[16 + 4 * jj + 0] : acc[4 * jj + 0], a1 = hf ? acc[16 + 4 * jj + 1] : acc[4 * jj + 1];
    const float a2 = hf ? acc[16 + 4 * jj + 2] : acc[4 * jj + 2], a3 = hf ? acc[16 + 4 * jj + 3] : acc[4 * jj + 3];
    xn[jj].x = xv.x + gv.x * a0; xn[jj].y = xv.y + gv.y * a1; xn[jj].z = xv.z + gv.z * a2; xn[jj].w = xv.w + gv.w * a3;
    ss += xn[jj].x * xn[jj].x + xn[jj].y * xn[jj].y + xn[jj].z * xn[jj].z + xn[jj].w * xn[jj].w;
  }
  ss = wave_sum(ss);
  const float rinv = rsqrtf(ss * (1.f / 1024.f) + EPS);
  if (layer == 0) {
    const float* mod1 = (const float*)(p.ws + OFF_MOD) + (size_t)9 * 6144 + (size_t)b * 6144;
    const float* g1 = p.norm1_g + 1024;
    bf16_t* act = (bf16_t*)(p.ws + OFF_ACT) + (size_t)tok * 1024;
#pragma unroll
    for (int jj = 0; jj < 4; ++jj) {
      const int c = (l + 32 * (4 * hf + jj)) * 4;
      if (dowrite) *(float4*)(xr + c) = xn[jj]; else asm volatile("" :: "v"(xn[jj].x), "v"(xn[jj].y), "v"(xn[jj].z), "v"(xn[jj].w));
      const float4 gg4 = *(const float4*)(g1 + c);
      const float4 sh = *(const float4*)(mod1 + c);
      const float4 sc = *(const float4*)(mod1 + 1024 + c);
      uint2 o;
      o.x = pack2h(xn[jj].x * rinv * gg4.x * (1.f + sc.x) + sh.x, xn[jj].y * rinv * gg4.y * (1.f + sc.y) + sh.y);
      o.y = pack2h(xn[jj].z * rinv * gg4.z * (1.f + sc.z) + sh.z, xn[jj].w * rinv * gg4.w * (1.f + sc.w) + sh.w);
      if (dowrite) *(uint2*)(act + c) = o; else asm volatile("" :: "v"(o.x), "v"(o.y));
    }
  } else {
#pragma unroll
    for (int jj = 0; jj < 4; ++jj) {
      const int c = (l + 32 * (4 * hf + jj)) * 4;
      const float4 gg4 = *(const float4*)(p.final_g + c);
      float4 o;
      o.x = xn[jj].x * rinv * gg4.x; o.y = xn[jj].y * rinv * gg4.y; o.z = xn[jj].z * rinv * gg4.z; o.w = xn[jj].w * rinv * gg4.w;
      if (dowrite) *(float4*)(xr + c) = o; else asm volatile("" :: "v"(o.x), "v"(o.y), "v"(o.z), "v"(o.w));
    }
  }
}

__device__ __forceinline__ void phase_peer(const Params& p, int layer, char* smem, int ntok, bool dowrite = true) {
  const int tid = opaque_tid(), lane = tid & 63, wave = __builtin_amdgcn_readfirstlane(tid >> 6);
  __syncthreads();
  if (tid < 64) {
    int cab = -1, c = 0;
    for (int a = 0; a < 16; ++a)
      for (int bb = 0; bb < 16; ++bb)
        if ((a + 1) * (bb + 1) <= 16) { if (c == tid) cab = a * 16 + bb; ++c; }
    ((int*)(smem + PE_OFF_CT))[tid] = cab;
  }
  const int ngroups = ntok / 16, G = gridDim.x, g0 = opaque_bid();
  if (tid == 0) { ((int*)(smem + PE_OFF_TQ))[0] = 0; ((int*)(smem + PE_OFF_TQ))[1] = 0; }
  __syncthreads();
  const int R = ngroups / G, rem = ngroups % G;
  const bool split = rem > 0 && 2 * rem <= G;
#define PE_ITEM(r_, grp_, off_, cnt_)                                                                  \
  { grp_ = 0; off_ = 0; cnt_ = 0;                                                                      \
    if ((r_) >= 0 && (r_) < R) { grp_ = g0 + (r_) * G; cnt_ = 16; }                                    \
    else if ((r_) == R) {                                                                              \
      if (split) { if (g0 < 2 * rem) { grp_ = R * G + (g0 >> 1); off_ = (g0 & 1) * 8; cnt_ = 8; } }    \
      else if (g0 < rem) { grp_ = R * G + g0; cnt_ = 16; }                                             \
    } }
#pragma unroll 1
  for (int r = -1;; ++r) {
    int cur, coff, ngat, nxt, noff, ncnt;
    PE_ITEM(r, cur, coff, ngat)
    PE_ITEM(r + 1, nxt, noff, ncnt)
    const int nsel = ncnt > 0 ? 8 : 0;
    if (ngat + nsel == 0) break;
    const int b = r & 1, gper = ngat >> 3, sfirst = (wave & 1) == 0;
#pragma unroll 1
    for (int st = 0; st < 3; ++st) {
      const int slot = sfirst ? st : (st + 1) % 3;
      if (slot == 0) { if (nsel) peer_select_head(p, layer, smem, nxt * 16, wave, wave, b ^ 1, lane); }
      else if (slot - 1 < gper) {
        const int idx = wave * gper + slot - 1;
        peer_gather_token(p, layer, smem, cur * 16 + coff + idx, coff + idx, b, lane, dowrite);
      }
    }
    __syncthreads();
  }
}

template <int layer>
__device__ __forceinline__ void layer_body(const Params& p, char* smem, const XcdBarrier& xb) {
  constexpr bool nc = layer == 0;
  const float* xin = layer == 0 ? p.x : (const float*)p.out;
  if (layer == 0) {
    phase_norm(p, layer, 0, xin, NTOK);
    xcd_barrier(xb);
  }
#if REP_GEMM
  gemm_phase2<EPI_INPROJ>(p, layer, smem, (const bf16_t*)(p.ws + OFF_ACT), (const bf16_t*)(p.ws + OFF_WIN) + (size_t)layer * 3072 * 1024, NTOK, 3072, nullptr);
  xcd_barrier(xb);
#endif
  gemm_phase2<EPI_INPROJ>(p, layer, smem, (const bf16_t*)(p.ws + OFF_ACT), (const bf16_t*)(p.ws + OFF_WIN) + (size_t)layer * 3072 * 1024, NTOK, 3072, nullptr);
  xcd_barrier(xb);
#if REP_MIX1
  phase_mix1(p, layer, smem, 2);
  xcd_barrier(xb);
#endif
  phase_mix1(p, layer, smem);
  xcd_barrier(xb);
  phase_ret_scan(p, layer);
  xcd_barrier(xb);
#if REP_MIX2
  phase_mix2(p, layer, smem, 3);
  xcd_barrier(xb);
#endif
  phase_mix2(p, layer, smem);
  xcd_barrier(xb);
  gemm_phase2<EPI_OUTPROJ>(p, layer, smem, (const bf16_t*)(p.ws + OFF_ACT), (const bf16_t*)(p.ws + OFF_WOUT) + (size_t)layer * 1024 * 1024, nc ? NTOK : NLAT, 1024, xin);
  xcd_barrier(xb);
  phase_norm(p, layer, 1, (const float*)p.out, nc ? NTOK : NLAT);
  xcd_barrier(xb);
  gemm_phase2<EPI_PLAIN>(p, layer, smem, (const bf16_t*)(p.ws + OFF_ACT), (const bf16_t*)(p.ws + OFF_WQ) + (size_t)layer * 2048 * 1024, nc ? NTOK : NLAT, 2048, nullptr);
  xcd_barrier(xb);
#if REP_PEER
  phase_peer(p, layer, smem, nc ? NTOK : NLAT, false);
  xcd_barrier(xb);
#endif
  phase_peer(p, layer, smem, nc ? NTOK : NLAT);
  if (layer == 0) xcd_barrier(xb);
}

__global__ void __launch_bounds__(512) fwd_megakernel(Params p) {
  cg::grid_group grid = cg::this_grid();
  extern __shared__ __attribute__((aligned(16))) char smem[];
  volatile LAS3 unsigned* xst = (volatile LAS3 unsigned*)(smem + LDS_BCAST + 8);
  if (threadIdx.x == 0) { xst[0] = 0u; xst[1] = 0u; }
  phase_prep(p, smem);
  for (int it = blockIdx.x; it < 256; it += gridDim.x) uv_convert_item(p, it);
  grid.sync();
  const XcdBarrier xb = xcd_barrier_post((unsigned*)(p.ws + OFF_XBAR), xst);
  layer_body<0>(p, smem, xb);
  layer_body<1>(p, smem, xb);
}

extern "C" void kernel_launch(void* const* d_in, const int* in_sizes, int n_in, void* d_out,
                              int out_size, void* d_ws, size_t ws_size, hipStream_t stream) {
  constexpr size_t kDynLds = LDS_BYTES;
  static int grid_blocks = 0;
  if (!grid_blocks) {
    int dev = 0, cus = 0, per_cu = 0;
    (void)hipGetDevice(&dev);
    (void)hipDeviceGetAttribute(&cus, hipDeviceAttributeMultiprocessorCount, dev);
    (void)hipFuncSetAttribute((const void*)fwd_megakernel, hipFuncAttributeMaxDynamicSharedMemorySize, (int)kDynLds);
    (void)hipOccupancyMaxActiveBlocksPerMultiprocessor(&per_cu, fwd_megakernel, 512, kDynLds);
    if (per_cu < 1) { fprintf(stderr, "occupancy query says %d blocks/CU\n", per_cu); per_cu = 1; }
    grid_blocks = cus;
    if (ws_size < WS_END) fprintf(stderr, "workspace too small: %zu < %zu\n", ws_size, (size_t)WS_END);
  }
  Params p{};
  p.x = (const float*)d_in[0]; p.c = (const float*)d_in[1]; p.ctx = (const float*)d_in[2]; p.c_ctx = (const float*)d_in[3];
  p.w_ada = (const float*)d_in[4]; p.b_ada = (const float*)d_in[5]; p.norm1_g = (const float*)d_in[6]; p.w_in = (const float*)d_in[7];
  p.na_rpb = (const float*)d_in[8]; p.diff_lambda = (const float*)d_in[9]; p.diff_subln_g = (const float*)d_in[10];
  p.ret_decay_logit = (const float*)d_in[11]; p.w_out = (const float*)d_in[12]; p.norm2_g = (const float*)d_in[13];
  p.peer_wq = (const float*)d_in[14]; p.peer_subkeys = (const float*)d_in[15]; p.peer_u = (const float*)d_in[16];
  p.peer_v = (const float*)d_in[17]; p.final_g = (const float*)d_in[18];
  p.out = (float*)d_out; p.ws = (char*)d_ws;
  void* args[] = {&p};
  hipError_t e = hipLaunchCooperativeKernel((void*)fwd_megakernel, dim3(grid_blocks), dim3(512), args, kDynLds, stream);
  if (e != hipSuccess) fprintf(stderr, "cooperative launch failed: %s (grid %d)\n", hipGetErrorString(e), grid_blocks);
}
```

```cpp
#include <hip/hip_runtime.h>
#include <hip/hip_cooperative_groups.h>
#include <cstdio>
#include <cstdint>
namespace cg = cooperative_groups;

typedef unsigned short bf16_t;
typedef short bf16x8 __attribute__((ext_vector_type(8)));
typedef float f32x4 __attribute__((ext_vector_type(4)));

constexpr int DM = 1024, BATCH = 8, SEQ = 4096, LCTX = 256;
constexpr int NLAT = BATCH * SEQ;
constexpr int NCTX = BATCH * LCTX;
constexpr int NTOK = NLAT + NCTX;
constexpr int INC = 3072;
constexpr int C_NAQ = 0, C_NAK = 256, C_NAV = 512, C_DFQ = 768, C_DFK = 1024, C_DFV = 1280,
              C_RTQ = 1536, C_RTK = 1792, C_RTV = 2048, C_RTG = 2560;
constexpr int Y_NA = 0, Y_DF = 256, Y_RT = 512;
constexpr int NEXP = 16384;
constexpr float EPS = 1e-6f;

constexpr size_t OFF_CTL  = 0;
constexpr size_t OFF_MISC = 4096;
constexpr size_t OFF_ROPE = 8192;
constexpr size_t OFF_MOD  = OFF_ROPE + 12288;
constexpr size_t SZ_MOD   = 2ull * 9 * 6144 * 4;
constexpr size_t OFF_WIN  = OFF_MOD + SZ_MOD;
constexpr size_t SZ_WIN   = 2ull * 3072 * 1024 * 2;
constexpr size_t OFF_WOUT = OFF_WIN + SZ_WIN;
constexpr size_t SZ_WOUT  = 2ull * 1024 * 1024 * 2;
constexpr size_t OFF_WQ   = OFF_WOUT + SZ_WOUT;
constexpr size_t SZ_WQ    = 2ull * 2048 * 1024 * 2;
constexpr size_t OFF_SUBK = OFF_WQ + SZ_WQ;
constexpr size_t SZ_SUBK  = 2ull * 262144 * 2;
constexpr size_t OFF_U    = OFF_SUBK + SZ_SUBK;
constexpr int    ROWB     = 512;
constexpr int    ROWV     = 512;
constexpr int    RECB     = ROWB + ROWV;
constexpr size_t SZ_UV    = 2ull * NEXP * ROWB;
constexpr size_t OFF_V    = OFF_U + SZ_UV;
constexpr size_t OFF_USC  = OFF_V + SZ_UV;
constexpr size_t OFF_VSC  = OFF_USC + 2ull * NEXP * 4;
constexpr size_t OFF_ACT  = OFF_VSC + 2ull * NEXP * 4;
constexpr size_t SZ_ACT   = (size_t)NTOK * 1024 * 2;
constexpr size_t OFF_P    = OFF_ACT + SZ_ACT;
constexpr size_t SZ_P     = (size_t)NTOK * 3072 * 2;
constexpr size_t OFF_CTXB = OFF_P + SZ_P;
constexpr size_t SZ_CTXB  = (size_t)NCTX * 1024 * 4;
constexpr size_t OFF_RKV  = OFF_CTXB + SZ_CTXB;
constexpr size_t SZ_RKV   = 64ull * 32 * 8192 * 4;
constexpr size_t OFF_RS   = OFF_RKV + SZ_RKV;
constexpr size_t SZ_RS    = 64ull * 8192 * 4;
constexpr size_t OFF_XBAR = OFF_RS + SZ_RS;
constexpr size_t OFF_RKVH = OFF_XBAR + 16384;
constexpr size_t SZ_RKVH  = 64ull * 32 * 8192 * 2;
constexpr size_t WS_END   = OFF_RKVH + SZ_RKVH;
static_assert(WS_END <= (512ull << 20), "workspace budget");

#ifndef REP_MIX1
#define REP_MIX1 0
#endif
#ifndef REP_MIX2
#define REP_MIX2 0
#endif
#ifndef REP_PEER
#define REP_PEER 0
#endif
#ifndef REP_GEMM
#define REP_GEMM 0
#endif
constexpr int LDS_BYTES = 152 * 1024;
constexpr int LDS_BCAST = LDS_BYTES - 16;

struct Params {
  const float *x, *c, *ctx, *c_ctx, *w_ada, *b_ada, *norm1_g, *w_in, *na_rpb, *diff_lambda, *diff_subln_g,
              *ret_decay_logit, *w_out, *norm2_g, *peer_wq, *peer_subkeys, *peer_u, *peer_v, *final_g;
  float* out;
  char* ws;
};

__device__ __forceinline__ float bf2f(bf16_t v) { return __uint_as_float(((unsigned)v) << 16); }
__device__ __forceinline__ bf16_t f2bf(float f) {
  unsigned u = __float_as_uint(f);
  u += 0x7fffu + ((u >> 16) & 1u);
  return (bf16_t)(u >> 16);
}
__device__ __forceinline__ unsigned pack2(float a, float b) { return (unsigned)f2bf(a) | ((unsigned)f2bf(b) << 16); }
typedef __bf16 bf16x2_t __attribute__((ext_vector_type(2)));
typedef float f32x2_t __attribute__((ext_vector_type(2)));
__device__ __forceinline__ unsigned pack2h(float a, float b) {
  const f32x2_t v = {a, b};
  return __builtin_bit_cast(unsigned, __builtin_convertvector(v, bf16x2_t));
}
__device__ __forceinline__ float lo16(unsigned w) { return __uint_as_float(w << 16); }
__device__ __forceinline__ float hi16(unsigned w) { return __uint_as_float(w & 0xffff0000u); }
typedef unsigned u32x4_t __attribute__((ext_vector_type(4)));
__device__ __forceinline__ uint4 bload16(__amdgpu_buffer_rsrc_t r, int off) {
  const u32x4_t t = __builtin_amdgcn_raw_buffer_load_b128(r, off, 0, 0);
  return make_uint4(t.x, t.y, t.z, t.w);
}
#define DPP_ADD(v, CTRL) ((v) + __int_as_float(__builtin_amdgcn_update_dpp(0, __float_as_int(v), (CTRL), 0xf, 0xf, true)))
__device__ __forceinline__ float row16_sum(float v) {
  v = DPP_ADD(v, 0xB1);
  v = DPP_ADD(v, 0x4E);
  v = DPP_ADD(v, 0x141);
  v = DPP_ADD(v, 0x140);
  return v;
}
#define DPP_MOVU(v, CTRL) ((unsigned)__builtin_amdgcn_update_dpp(0, (int)(v), (CTRL), 0xf, 0xf, true))
__device__ __forceinline__ unsigned row16_max_u32(unsigned v) {
  v = max(v, DPP_MOVU(v, 0xB1)); v = max(v, DPP_MOVU(v, 0x4E)); v = max(v, DPP_MOVU(v, 0x141)); v = max(v, DPP_MOVU(v, 0x140));
  return v;
}
__device__ __forceinline__ unsigned row16_min_u32(unsigned v) {
  v = min(v, DPP_MOVU(v, 0xB1)); v = min(v, DPP_MOVU(v, 0x4E)); v = min(v, DPP_MOVU(v, 0x141)); v = min(v, DPP_MOVU(v, 0x140));
  return v;
}
template <int KTH>
__device__ __forceinline__ unsigned row16_kth_largest(unsigned v) {
  int cnt = 0;
#define R8_STEP(N) { const unsigned o = DPP_MOVU(v, 0x120 + (N)); cnt += (o > v) ? 1 : 0; }
  R8_STEP(1) R8_STEP(2) R8_STEP(3) R8_STEP(4) R8_STEP(5) R8_STEP(6) R8_STEP(7) R8_STEP(8)
  R8_STEP(9) R8_STEP(10) R8_STEP(11) R8_STEP(12) R8_STEP(13) R8_STEP(14) R8_STEP(15)
#undef R8_STEP
  return row16_max_u32(cnt >= KTH - 1 ? v : 0u);
}
__device__ __forceinline__ float wave_sum(float v) {
  v = row16_sum(v);
  const int iv = __float_as_int(v);
  const float a = __int_as_float(__builtin_amdgcn_readlane(iv, 0)), b = __int_as_float(__builtin_amdgcn_readlane(iv, 16));
  const float c = __int_as_float(__builtin_amdgcn_readlane(iv, 32)), d = __int_as_float(__builtin_amdgcn_readlane(iv, 48));
  return (a + b) + (c + d);
}
__device__ __forceinline__ float siluf(float x) { return x / (1.f + __expf(-x)); }

__device__ __forceinline__ int opaque_tid() { int t = threadIdx.x; asm volatile("" : "+v"(t)); return t; }
__device__ __forceinline__ int opaque_bid() { int t = blockIdx.x; asm volatile("" : "+s"(t)); return t; }

#define DOT8(acc, Q, off, U)                                                              \
  acc = fmaf(Q[(off) + 0], lo16((U).x), acc); acc = fmaf(Q[(off) + 1], hi16((U).x), acc); \
  acc = fmaf(Q[(off) + 2], lo16((U).y), acc); acc = fmaf(Q[(off) + 3], hi16((U).y), acc); \
  acc = fmaf(Q[(off) + 4], lo16((U).z), acc); acc = fmaf(Q[(off) + 5], hi16((U).z), acc); \
  acc = fmaf(Q[(off) + 6], lo16((U).w), acc); acc = fmaf(Q[(off) + 7], hi16((U).w), acc);
#define AXPY8(O, off, P, U)                                                                   \
  O[(off) + 0] = fmaf(P, lo16((U).x), O[(off) + 0]); O[(off) + 1] = fmaf(P, hi16((U).x), O[(off) + 1]); \
  O[(off) + 2] = fmaf(P, lo16((U).y), O[(off) + 2]); O[(off) + 3] = fmaf(P, hi16((U).y), O[(off) + 3]); \
  O[(off) + 4] = fmaf(P, lo16((U).z), O[(off) + 4]); O[(off) + 5] = fmaf(P, hi16((U).z), O[(off) + 5]); \
  O[(off) + 6] = fmaf(P, lo16((U).w), O[(off) + 6]); O[(off) + 7] = fmaf(P, hi16((U).w), O[(off) + 7]);
#define UNPACK8(Q, off, U)                                                  \
  Q[(off) + 0] = lo16((U).x); Q[(off) + 1] = hi16((U).x); Q[(off) + 2] = lo16((U).y); Q[(off) + 3] = hi16((U).y); \
  Q[(off) + 4] = lo16((U).z); Q[(off) + 5] = hi16((U).z); Q[(off) + 6] = lo16((U).w); Q[(off) + 7] = hi16((U).w);

__device__ __forceinline__ int next_item(unsigned* counter, char* smem) {
  volatile int* bc = (volatile int*)(smem + LDS_BCAST);
  __syncthreads();
  if (threadIdx.x == 0) *bc = (int)atomicAdd(counter, 1u);
  __syncthreads();
  return *bc;
}

#define XB_TMO      128
#define XB_XCNT(j)  (256  + 64 * (j))
#define XB_XSUB(j)  (1280 + 64 * (j))
#define XB_XGEN(j)  (2304 + 64 * (j))
#define XB_TOP      3328
#define XB_TOPGEN   3392
#define XCD_BAR_WORDS 3456
#define XB_SPIN_CAP (1u << 18)
#define LAS3 __attribute__((address_space(3)))
__device__ __forceinline__ unsigned xb_ld(unsigned* p)              { return __hip_atomic_load(p, __ATOMIC_RELAXED, __HIP_MEMORY_SCOPE_AGENT); }
__device__ __forceinline__ unsigned xb_add(unsigned* p, unsigned v) { return __hip_atomic_fetch_add(p, v, __ATOMIC_RELAXED, __HIP_MEMORY_SCOPE_AGENT); }
__device__ __forceinline__ unsigned xb_xcc_id() { return (unsigned)__builtin_amdgcn_s_getreg((3 << 11) | 20) & 0xFu; }
#define XB_SPIN(cond, bar) do { unsigned _sp = 0; while (cond) { __builtin_amdgcn_s_sleep(1); \
    if ((++_sp & 255u) == 0u) { if (xb_ld(&(bar)[XB_TMO])) break; if (_sp > XB_SPIN_CAP) { atomicAdd(&(bar)[XB_TMO], 1u); break; } } } } while (0)
struct XcdBarrier { unsigned* bar; unsigned x; volatile LAS3 unsigned* st; };
__device__ __forceinline__ XcdBarrier xcd_barrier_post(unsigned* bar, volatile LAS3 unsigned* st) {
  XcdBarrier b; b.bar = bar; b.x = xb_xcc_id(); b.st = st;
  if (threadIdx.x == 0) (void)xb_add(&bar[XB_XCNT(b.x)], 1u);
  return b;
}
__device__ __forceinline__ void xcd_barrier_complete(unsigned* bar, unsigned x, unsigned& nloc, unsigned& nx) {
  const unsigned G = gridDim.x * gridDim.y * gridDim.z;
  unsigned sum, cnt, mine, sp = 0u;
  for (;;) {
    sum = 0u; cnt = 0u; mine = 0u;
#pragma unroll
    for (unsigned j = 0; j < 16; ++j) { const unsigned c = xb_ld(&bar[XB_XCNT(j)]); sum += c; cnt += (c > 0u) ? 1u : 0u; mine = (j == x) ? c : mine; }
    if (sum == G) break;
    __builtin_amdgcn_s_sleep(1);
    if ((++sp & 255u) == 0u) { if (xb_ld(&bar[XB_TMO])) break; if (sp > XB_SPIN_CAP) { atomicAdd(&bar[XB_TMO], 1u); break; } }
  }
  nloc = mine > 0u ? mine : 1u; nx = cnt > 0u ? cnt : 1u;
}
__device__ __forceinline__ void xcd_barrier(const XcdBarrier& b) {
  asm volatile("s_waitcnt vmcnt(0)" ::: "memory");
  __syncthreads();
  if (threadIdx.x == 0) {
    unsigned* bar = b.bar;
    __builtin_amdgcn_s_waitcnt(0);
    unsigned nloc = b.st[0], nx = b.st[1];
    if (nloc == 0u) { xcd_barrier_complete(bar, b.x, nloc, nx); b.st[0] = nloc; b.st[1] = nx; }
    const unsigned old = xb_add(&bar[XB_XSUB(b.x)], 1u);
    const unsigned gen = old / nloc;
    if (old + 1u == (gen + 1u) * nloc) {
      __builtin_amdgcn_fence(__ATOMIC_RELEASE, "agent");
      asm volatile("s_waitcnt vmcnt(0)" ::: "memory");
      const unsigned og = xb_add(&bar[XB_TOP], 1u);
      const unsigned tg = og / nx;
      if (og + 1u == (tg + 1u) * nx) xb_add(&bar[XB_TOPGEN], 1u);
      else XB_SPIN(xb_ld(&bar[XB_TOPGEN]) == tg, bar);
      __builtin_amdgcn_fence(__ATOMIC_ACQUIRE, "agent");
      xb_add(&bar[XB_XGEN(b.x)], 1u);
      asm volatile("s_waitcnt vmcnt(0)" ::: "memory");
    } else {
      XB_SPIN(xb_ld(&bar[XB_XGEN(b.x)]) == gen, bar);
      __builtin_amdgcn_fence(__ATOMIC_ACQUIRE, "agent");
      asm volatile("s_waitcnt vmcnt(0)" ::: "memory");
    }
  }
  __syncthreads();
}

__device__ __forceinline__ void transpose_item(const float* src, bf16_t* dst, int K, int N, int item, char* smem) {
  float* t = (float*)smem;
  const int nb = N / 64;
  const int k0 = (item / nb) * 64, n0 = (item % nb) * 64;
  const int tid = opaque_tid();
  __syncthreads();
#pragma unroll
  for (int i = 0; i < 8; ++i) {
    const int k = (tid >> 6) + 8 * i, n = tid & 63;
    t[k * 65 + n] = src[(size_t)(k0 + k) * N + n0 + n];
  }
  __syncthreads();
#pragma unroll
  for (int i = 0; i < 8; ++i) {
    const int n = (tid >> 6) + 8 * i, k = tid & 63;
    dst[(size_t)(n0 + n) * K + k0 + k] = f2bf(t[k * 65 + n]);
  }
}

__device__ __forceinline__ void convert_flat(const float* src, bf16_t* dst, size_t n4) {
  const size_t gt = (size_t)opaque_bid() * blockDim.x + opaque_tid(), gs = (size_t)gridDim.x * blockDim.x;
  for (size_t i = gt; i < n4; i += gs) {
    const float4 v = ((const float4*)src)[i];
    uint2 o; o.x = pack2h(v.x, v.y); o.y = pack2h(v.z, v.w);
    ((uint2*)dst)[i] = o;
  }
}

__device__ __forceinline__ void phase_prep(const Params& p, char* smem) {
  const int tid = opaque_tid();
  char* ws = p.ws;
  if (opaque_bid() == 0) {
    unsigned* ctl = (unsigned*)(ws + OFF_CTL);
    if (tid < 64) ctl[tid] = 0u;
    unsigned* xbar = (unsigned*)(ws + OFF_XBAR);
    for (int i = tid; i < XCD_BAR_WORDS; i += 512) xbar[i] = 0u;
    float* misc = (float*)(ws + OFF_MISC);
    if (tid < 2) {
      const float* lp = p.diff_lambda + tid * 128;
      float s01 = 0.f, s23 = 0.f;
      for (int i = 0; i < 32; ++i) { s01 += lp[i] * lp[32 + i]; s23 += lp[64 + i] * lp[96 + i]; }
      const float lam_init = 0.8f - 0.6f * expf(-0.3f * (float)tid);
      misc[tid] = expf(s01) - expf(s23) + lam_init;
      misc[2 + tid] = lam_init;
    }
    if (tid >= 128 && tid < 256) misc[64 + tid - 128] = 0.f;
    if (tid >= 64 && tid < 80) {
      const int i = tid - 64;
      const float xv = p.ret_decay_logit[i];
      misc[16 + i] = -log1pf(expf(-xv));
    }
    float2* ropeD = (float2*)(ws + OFF_ROPE);
    float2* ropeR = (float2*)(ws + OFF_ROPE + 4096);
    for (int i = tid; i < 64 * 8; i += 512) {
      const int v = i >> 3, f = i & 7;
      const float inv = powf(10000.0f, -(float)(2 * f) / 16.0f);
      const float ang = (float)v * inv;
      ropeD[i] = make_float2(cosf(ang), sinf(ang));
    }
    for (int i = tid; i < 64 * 16; i += 512) {
      const int v = i >> 4, f = i & 15;
      const float inv = powf(10000.0f, -(float)(2 * f) / 32.0f);
      const float ang = (float)v * inv;
      ropeR[i] = make_float2(cosf(ang), sinf(ang));
    }
  }
  {
    float* sc = (float*)smem;
    float* red = (float*)(smem + 9 * 1024 * 4);
    float* mod = (float*)(ws + OFF_MOD);
    for (int item = opaque_bid(); item < 192; item += gridDim.x) {
      const int l = item / 96, cb = item % 96;
      __syncthreads();
      for (int i = tid; i < 9 * 1024; i += 512) {
        const int r = i >> 10, k = i & 1023;
        const float cv = (r < 8) ? p.c[r * 1024 + k] : p.c_ctx[k];
        sc[i] = siluf(cv);
      }
      __syncthreads();
      const int col = tid & 63, ks = tid >> 6;
      float acc[9];
#pragma unroll
      for (int r = 0; r < 9; ++r) acc[r] = 0.f;
      const float* w = p.w_ada + (size_t)l * 1024 * 6144 + cb * 64 + col;
#pragma unroll 1
      for (int k0 = ks * 128; k0 < ks * 128 + 128; k0 += 16) {
        float wv[16];
#pragma unroll
        for (int i = 0; i < 16; ++i) wv[i] = w[(size_t)(k0 + i) * 6144];
#pragma unroll
        for (int i = 0; i < 16; ++i)
#pragma unroll
          for (int r = 0; r < 9; ++r) acc[r] = fmaf(sc[r * 1024 + k0 + i], wv[i], acc[r]);
      }
#pragma unroll
      for (int r = 0; r < 9; ++r) red[(ks * 9 + r) * 64 + col] = acc[r];
      __syncthreads();
      for (int i = tid; i < 576; i += 512) {
        const int r = i >> 6, cc = i & 63;
        float s = 0.f;
#pragma unroll
        for (int k8 = 0; k8 < 8; ++k8) s += red[(k8 * 9 + r) * 64 + cc];
        mod[((size_t)l * 9 + r) * 6144 + cb * 64 + cc] = s + p.b_ada[l * 6144 + cb * 64 + cc];
      }
    }
    __syncthreads();
  }
  for (int item = opaque_bid(); item < 3072; item += gridDim.x) {
    const int l = item / 1536;
    int r = item % 1536;
    if (r < 768) transpose_item(p.w_in + (size_t)l * 1024 * 3072, (bf16_t*)(ws + OFF_WIN) + (size_t)l * 3072 * 1024, 1024, 3072, r, smem);
    else if (r < 1024) transpose_item(p.w_out + (size_t)l * 1024 * 1024, (bf16_t*)(ws + OFF_WOUT) + (size_t)l * 1024 * 1024, 1024, 1024, r - 768, smem);
    else transpose_item(p.peer_wq + (size_t)l * 1024 * 2048, (bf16_t*)(ws + OFF_WQ) + (size_t)l * 2048 * 1024, 1024, 2048, r - 1024, smem);
  }
  {
    const size_t gt = (size_t)opaque_bid() * blockDim.x + opaque_tid(), gs = (size_t)gridDim.x * blockDim.x;
    for (size_t g = gt; g < 2ull * 262144 / 8; g += gs) {
      const int ln = (int)(g & 63), ks = (int)((g >> 6) & 3), nt = (int)((g >> 8) & 7);
      const size_t list = g >> 11;
      const float* sp = p.peer_subkeys + list * 16384 + (size_t)(nt * 16 + (ln & 15)) * 128 + ks * 32 + (ln >> 4) * 8;
      const float4 a = *(const float4*)sp, b2 = *(const float4*)(sp + 4);
      uint4 o; o.x = pack2h(a.x, a.y); o.y = pack2h(a.z, a.w); o.z = pack2h(b2.x, b2.y); o.w = pack2h(b2.z, b2.w);
      *(uint4*)((bf16_t*)(ws + OFF_SUBK) + g * 8) = o;
    }
  }
  {
    const size_t gt = (size_t)opaque_bid() * blockDim.x + tid, gs = (size_t)gridDim.x * blockDim.x;
    float4* dst = (float4*)(ws + OFF_CTXB);
    for (size_t i = gt; i < (size_t)NCTX * 1024 / 4; i += gs) dst[i] = ((const float4*)p.ctx)[i];
  }
}

__device__ __forceinline__ void phase_norm(const Params& p, int layer, int which, const float* xlat, int nrows) {
  const int lane = opaque_tid() & 63;
  const int gw = opaque_bid() * 8 + (opaque_tid() >> 6), nw = gridDim.x * 8;
  const float* g = (which == 0 ? p.norm1_g : p.norm2_g) + layer * 1024;
  const float* mod = (const float*)(p.ws + OFF_MOD) + (size_t)layer * 9 * 6144;
  const float* ctxb = (const float*)(p.ws + OFF_CTXB);
  bf16_t* act = (bf16_t*)(p.ws + OFF_ACT);
  const int sh_off = which == 0 ? 0 : 3 * 1024, sc_off = which == 0 ? 1024 : 4 * 1024;
  for (int row = gw; row < nrows; row += nw) {
    const float* src = row < NLAT ? xlat + (size_t)row * 1024 : ctxb + (size_t)(row - NLAT) * 1024;
    const int b = row < NLAT ? (row >> 12) : 8;
    const float* mrow = mod + (size_t)b * 6144;
    float4 v[4];
    float ss = 0.f;
#pragma unroll
    for (int j = 0; j < 4; ++j) {
      v[j] = ((const float4*)src)[lane + 64 * j];
      ss += v[j].x * v[j].x + v[j].y * v[j].y + v[j].z * v[j].z + v[j].w * v[j].w;
    }
    ss = wave_sum(ss);
    const float r = rsqrtf(ss * (1.f / 1024.f) + EPS);
#pragma unroll
    for (int j = 0; j < 4; ++j) {
      const int c = (lane + 64 * j) * 4;
      const float4 gg = *(const float4*)(g + c);
      const float4 sh = *(const float4*)(mrow + sh_off + c);
      const float4 sc = *(const float4*)(mrow + sc_off + c);
      const float o0 = v[j].x * r * gg.x * (1.f + sc.x) + sh.x;
      const float o1 = v[j].y * r * gg.y * (1.f + sc.y) + sh.y;
      const float o2 = v[j].z * r * gg.z * (1.f + sc.z) + sh.z;
      const float o3 = v[j].w * r * gg.w * (1.f + sc.w) + sh.w;
      uint2 o; o.x = pack2h(o0, o1); o.y = pack2h(o2, o3);
      *(uint2*)(act + (size_t)row * 1024 + c) = o;
    }
  }
}

__device__ __forceinline__ void phase_final(const Params& p) {
  const int lane = opaque_tid() & 63;
  const int gw = opaque_bid() * 8 + (opaque_tid() >> 6), nw = gridDim.x * 8;
  for (int row = gw; row < NLAT; row += nw) {
    float* src = p.out + (size_t)row * 1024;
    float4 v[4];
    float ss = 0.f;
#pragma unroll
    for (int j = 0; j < 4; ++j) {
      v[j] = ((const float4*)src)[lane + 64 * j];
      ss += v[j].x * v[j].x + v[j].y * v[j].y + v[j].z * v[j].z + v[j].w * v[j].w;
    }
    ss = wave_sum(ss);
    const float r = rsqrtf(ss * (1.f / 1024.f) + EPS);
#pragma unroll
    for (int j = 0; j < 4; ++j) {
      const int c = (lane + 64 * j) * 4;
      const float4 gg = *(const float4*)(p.final_g + c);
      float4 o;
      o.x = v[j].x * r * gg.x; o.y = v[j].y * r * gg.y; o.z = v[j].z * r * gg.z; o.w = v[j].w * r * gg.w;
      ((float4*)src)[lane + 64 * j] = o;
    }
  }
}

constexpr int EPI_INPROJ = 0, EPI_OUTPROJ = 1, EPI_PLAIN = 2;
constexpr int GS = 72;
constexpr int G_ASTAGE = 256 * GS * 2;
constexpr int G_BSTAGE = 128 * GS * 2;
constexpr int G_STAGE = G_ASTAGE + G_BSTAGE;

namespace g8 {
constexpr int BM = 256, BK = 64, HALF = 128, NXCD = 8, WGM = 8, HT = HALF * BK;
__device__ __forceinline__ int lds_byte(int r, int c) {
  const int st = (r >> 4) * 2 + (c >> 5), rr = r & 15, cc = c & 31, ob = rr * 64 + cc * 2;
  return st * 1024 + (ob ^ (((ob >> 9) & 1) << 5));
}
__device__ __forceinline__ void stage_rc(int b, int& R, int& C) {
  const int st = b / 1024, sb = b % 1024, swz = sb ^ (((sb >> 9) & 1) << 5);
  R = (st >> 1) * 16 + swz / 64; C = (st & 1) * 32 + (swz % 64) / 2;
}
}

constexpr int G8_ROPE_LDS = 8 * 16384;
template <int EPI>
__device__ __forceinline__ void epi_store8(const Params& p, int layer, char* smem, int m, int n, f32x4 lo, f32x4 hi, const float* xin_lat) {
  float v[8] = {lo[0], lo[1], lo[2], lo[3], hi[0], hi[1], hi[2], hi[3]};
  if constexpr (EPI == EPI_INPROJ) {
    const bool ropeD = (n >= C_DFQ && n < C_DFV), ropeR = (n >= C_RTQ && n < C_RTV);
    if ((ropeD || ropeR) && m < NLAT) {
      const int t = m & 4095, gr = t >> 6, gc = t & 63;
      const float2* tabD = (const float2*)(smem + G8_ROPE_LDS);
      const float2* tabR = (const float2*)(smem + G8_ROPE_LDS + 4096);
      const float2* tb;
      if (ropeD) { const int i0 = (n & 31) >> 1; tb = i0 < 8 ? tabD + gr * 8 + i0 : tabD + gc * 8 + i0 - 8; }
      else { const int i0 = (n & 63) >> 1; tb = i0 < 16 ? tabR + gr * 16 + i0 : tabR + gc * 16 + i0 - 16; }
#pragma unroll
      for (int q = 0; q < 4; ++q) {
        const float2 cs = tb[q];
        const float a0 = v[2 * q] * cs.x - v[2 * q + 1] * cs.y, a1 = v[2 * q] * cs.y + v[2 * q + 1] * cs.x;
        v[2 * q] = a0; v[2 * q + 1] = a1;
      }
    }
    float sc = 1.f;
    if (n < C_NAK) sc = 0.125f * 1.4426950408889634f;
    else if (n >= C_DFQ && n < C_DFK) sc = 0.17677669529663687f * 1.4426950408889634f;
    else if (n >= C_RTK && n < C_RTV) sc = 0.125f;
    uint4 o;
    o.x = pack2h(v[0] * sc, v[1] * sc); o.y = pack2h(v[2] * sc, v[3] * sc); o.z = pack2h(v[4] * sc, v[5] * sc); o.w = pack2h(v[6] * sc, v[7] * sc);
    *(uint4*)((bf16_t*)(p.ws + OFF_P) + (size_t)m * INC + n) = o;
  } else if constexpr (EPI == EPI_OUTPROJ) {
    const float* mod = (const float*)(p.ws + OFF_MOD) + (size_t)layer * 9 * 6144;
    const int b = m < NLAT ? (m >> 12) : 8;
    const float* gp = mod + (size_t)b * 6144 + 2 * 1024 + n;
    const float4 g0 = *(const float4*)gp, g1 = *(const float4*)(gp + 4);
    const float* xi; float* xo;
    if (m < NLAT) { xi = xin_lat + (size_t)m * 1024 + n; xo = p.out + (size_t)m * 1024 + n; }
    else { xo = (float*)(p.ws + OFF_CTXB) + (size_t)(m - NLAT) * 1024 + n; xi = xo; }
    const float4 x0 = *(const float4*)xi, x1 = *(const float4*)(xi + 4);
    float4 o0, o1;
    o0.x = x0.x + g0.x * v[0]; o0.y = x0.y + g0.y * v[1]; o0.z = x0.z + g0.z * v[2]; o0.w = x0.w + g0.w * v[3];
    o1.x = x1.x + g1.x * v[4]; o1.y = x1.y + g1.y * v[5]; o1.z = x1.z + g1.z * v[6]; o1.w = x1.w + g1.w * v[7];
    *(float4*)xo = o0; *(float4*)(xo + 4) = o1;
  } else if constexpr (EPI == EPI_PLAIN) {
    uint4 o;
    o.x = pack2h(v[0], v[1]); o.y = pack2h(v[2], v[3]); o.z = pack2h(v[4], v[5]); o.w = pack2h(v[6], v[7]);
    *(uint4*)((bf16_t*)(p.ws + OFF_P) + ((((size_t)(m >> 4) * 16 + (n >> 7)) * 4 + ((n >> 5) & 3)) * 64 + (m & 15) + 16 * ((n >> 3) & 3)) * 8) = o;
  } else {
    asm volatile("" :: "v"(v[0]), "v"(v[1]), "v"(v[2]), "v"(v[3]), "v"(v[4]), "v"(v[5]), "v"(v[6]), "v"(v[7]));
  }
}

#define G8_LAS __attribute__((address_space(3)))
__device__ __forceinline__ bool g8_next(int i, int nM, int nN, int G, int c, int& pm, int& pn) {
  using namespace g8;
  const int nwg = nM * nN;
  const long Lx = (long)i * G + c;
  if (Lx >= nwg) return false;
  int wgid = (int)Lx;
  { const int q = nwg / NXCD, r = nwg % NXCD, xcd = wgid % NXCD, off = wgid / NXCD; wgid = (xcd < r ? xcd * (q + 1) : r * (q + 1) + (xcd - r) * q) + off; }
  const int nig = WGM * nN, gid = wgid / nig, fm = gid * WGM, gsz = (nM - fm) < WGM ? (nM - fm) : WGM;
  pm = fm + ((wgid % nig) % gsz); pn = (wgid % nig) / gsz;
  return true;
}

template <int EPI>
__device__ __forceinline__ void gemm_phase2(const Params& p, int layer, char* smem, const bf16_t* A, const bf16_t* Bt,
                                            int M, int N, const float* xin_lat) {
  using namespace g8;
  constexpr int K = 1024, nt = K / BK, HTB = HALF * BK * 2;
  G8_LAS unsigned char* lds = (G8_LAS unsigned char*)smem;
  const int tid = opaque_tid();
  const int wid = __builtin_amdgcn_readfirstlane(tid >> 6), lane = tid & 63, wr = wid >> 2, wc = wid & 3, fr = lane & 15, fq = lane >> 4;
  unsigned voff[2], voffB[2];
#pragma unroll
  for (int i = 0; i < 2; ++i) {
    int R, C; stage_rc(tid * 16 + i * 8192, R, C);
    const int rho = R & 31, Rb = (R & ~31) + 8 * ((rho & 15) >> 2) + 4 * (rho >> 4) + (rho & 3);
    voff[i] = (unsigned)(R * K + C) * 2u; voffB[i] = (unsigned)(Rb * K + C) * 2u;
  }
  if constexpr (EPI == EPI_INPROJ) {
    __syncthreads();
    const float4* gsrc = (const float4*)(p.ws + OFF_ROPE);
    float4* ldst = (float4*)(smem + G8_ROPE_LDS);
    for (int i = tid; i < 12288 / 16; i += 512) ldst[i] = gsrc[i];
  }
  constexpr size_t kstep = (size_t)(BK * 2);
  constexpr size_t hstep = (size_t)HALF * K * 2;
  constexpr size_t tstep = 2 * hstep;
  const unsigned ldsw = (unsigned)wid * 1024u;
  const int aoff = lds_byte(wr * 64 + fr, fq * 8), boff = lds_byte(wc * 32 + fr, fq * 8);
#define G8_SA(b, h) (((b) * 2 + (h)) * HTB)
#define G8_SB(b, h) ((4 + (b) * 2 + (h)) * HTB)
#define G8_STAGE_V(bufoff, gbase, VO) do { _Pragma("unroll") for (int _i = 0; _i < 2; ++_i)                                  \
    __builtin_amdgcn_global_load_lds((const unsigned*)((const char*)(gbase) + VO[_i]), (G8_LAS unsigned*)(lds + (bufoff) + ldsw + _i * 8192), 16, 0, 0); } while (0)
#define G8_LDA(dst, b, h) do { _Pragma("unroll") for (int m = 0; m < 4; ++m) _Pragma("unroll") for (int k = 0; k < 2; ++k) dst[m][k] = *(const G8_LAS bf16x8*)(lds + G8_SA(b, h) + aoff + m * 2048 + k * 1024); } while (0)
#define G8_LDB(dst, b, h) do { _Pragma("unroll") for (int n = 0; n < 2; ++n) _Pragma("unroll") for (int k = 0; k < 2; ++k) dst[n][k] = *(const G8_LAS bf16x8*)(lds + G8_SB(b, h) + boff + n * 2048 + k * 1024); } while (0)
#define G8_MMA(ai, bj, At_, Bt_) do { __builtin_amdgcn_s_setprio(1);                                                          \
    _Pragma("unroll") for (int m = 0; m < 4; ++m) _Pragma("unroll") for (int n = 0; n < 2; ++n) _Pragma("unroll") for (int k = 0; k < 2; ++k) \
      acc[ai][bj][m][n] = __builtin_amdgcn_mfma_f32_16x16x32_bf16(Bt_[n][k], At_[m][k], acc[ai][bj][m][n], 0, 0, 0);          \
    __builtin_amdgcn_s_setprio(0); } while (0)
#define G8_WAIT_V(n) asm volatile("s_waitcnt vmcnt(" #n ")" ::: "memory")
#define G8_WAIT_L(n) asm volatile("s_waitcnt lgkmcnt(" #n ")" ::: "memory")
#define G8_BAR __builtin_amdgcn_s_barrier()
#define G8_SCHED __builtin_amdgcn_sched_barrier(0)
  const int nM = M / BM, nN = N / BM, G = gridDim.x, cu = opaque_bid();
  int cpm, cpn, npm = 0, npn = 0, ui = 0;
  __syncthreads();
  if (g8_next(0, nM, nN, G, cu, cpm, cpn)) {
    f32x4 acc[2][2][4][2];
#pragma unroll
    for (int a = 0; a < 2; ++a)
#pragma unroll
      for (int b2 = 0; b2 < 2; ++b2)
#pragma unroll
        for (int m = 0; m < 4; ++m)
#pragma unroll
          for (int n = 0; n < 2; ++n) acc[a][b2][m][n] = (f32x4){0.f, 0.f, 0.f, 0.f};
    bf16x8 At[4][2], B0[2][2], B1[2][2];
    const char* cA = (const char*)A + (size_t)cpm * tstep;
    const char* cB = (const char*)Bt + (size_t)cpn * tstep;
    G8_STAGE_V(G8_SB(0, 0), cB, voffB); G8_STAGE_V(G8_SA(0, 0), cA, voff); G8_STAGE_V(G8_SB(0, 1), cB + hstep, voffB); G8_STAGE_V(G8_SA(0, 1), cA + hstep, voff);
    if (wr == 1) G8_BAR;
    G8_WAIT_V(4); G8_BAR;
    G8_STAGE_V(G8_SB(1, 0), cB + kstep, voffB); G8_STAGE_V(G8_SA(1, 0), cA + kstep, voff); G8_STAGE_V(G8_SB(1, 1), cB + hstep + kstep, voffB);
    G8_WAIT_V(6); G8_BAR;
    for (;;) {
      const bool has_next = g8_next(ui + 1, nM, nN, G, cu, npm, npn);
      const char* nA = has_next ? (const char*)A + (size_t)npm * tstep : cA;
      const char* nB = has_next ? (const char*)Bt + (size_t)npn * tstep : cB;
#pragma unroll 1
      for (int t = 0; t < nt; t += 2) {
        const bool last = (t == nt - 2);
        const char* a1 = cA + (size_t)(t + 1) * kstep;
        const char* a2 = last ? nA : cA + (size_t)(t + 2) * kstep; const char* b2 = last ? nB : cB + (size_t)(t + 2) * kstep;
        const char* a3 = a2 + kstep; const char* b3 = b2 + kstep;
        G8_LDB(B0, 0, 0); G8_SCHED; G8_LDA(At, 0, 0); G8_STAGE_V(G8_SA(1, 1), a1 + hstep, voff);
        G8_WAIT_L(8); G8_BAR; G8_WAIT_L(0); G8_MMA(0, 0, At, B0); G8_BAR; G8_SCHED;
        G8_LDB(B1, 0, 1); G8_STAGE_V(G8_SB(0, 0), b2, voffB);
        G8_BAR; G8_WAIT_L(0); G8_MMA(0, 1, At, B1); G8_BAR;
        G8_LDA(At, 0, 1); G8_STAGE_V(G8_SA(0, 0), a2, voff);
        G8_BAR; G8_WAIT_L(0); G8_MMA(1, 0, At, B0); G8_BAR; G8_SCHED;
        G8_STAGE_V(G8_SB(0, 1), b2 + hstep, voffB);
        G8_WAIT_V(6); G8_BAR; G8_MMA(1, 1, At, B1); G8_BAR;
        G8_LDB(B0, 1, 0); G8_SCHED; G8_LDA(At, 1, 0); G8_STAGE_V(G8_SA(0, 1), a2 + hstep, voff);
        G8_WAIT_L(8); G8_BAR; G8_WAIT_L(0); G8_MMA(0, 0, At, B0); G8_BAR; G8_SCHED;
        G8_LDB(B1, 1, 1); G8_STAGE_V(G8_SB(1, 0), b3, voffB);
        G8_BAR; G8_WAIT_L(0); G8_MMA(0, 1, At, B1); G8_BAR;
        G8_LDA(At, 1, 1); G8_STAGE_V(G8_SA(1, 0), a3, voff);
        G8_BAR; G8_WAIT_L(0); G8_MMA(1, 0, At, B0); G8_BAR; G8_SCHED;
        G8_STAGE_V(G8_SB(1, 1), b3 + hstep, voffB);
        G8_WAIT_V(6); G8_BAR; G8_MMA(1, 1, At, B1); G8_BAR;
      }
      {
        const int brow = cpm * BM, bcol = cpn * BM;
        if constexpr (EPI == EPI_INPROJ) {
          if (bcol == C_DFK) {
#pragma unroll
            for (int bj = 0; bj < 2; ++bj) {
              float mx = 0.f;
#pragma unroll
              for (int ai = 0; ai < 2; ++ai)
#pragma unroll
                for (int m = 0; m < 4; ++m) {
                  float s = 0.f;
#pragma unroll
                  for (int n = 0; n < 2; ++n)
#pragma unroll
                    for (int j = 0; j < 4; ++j) s = fmaf(acc[ai][bj][m][n][j], acc[ai][bj][m][n][j], s);
                  s += __shfl_xor(s, 16); s += __shfl_xor(s, 32);
                  mx = fmaxf(mx, s);
                }
#pragma unroll
              for (int o = 1; o < 16; o <<= 1) mx = fmaxf(mx, __shfl_xor(mx, o));
              if (lane == 0) {
                const int bb = brow < NLAT ? (brow >> 12) : ((brow - NLAT) >> 8);
                unsigned* km = (unsigned*)(p.ws + OFF_MISC) + 64 + layer * 64 + (bb * 4 + bj * 2 + (wc >> 1)) * 2 + (wc & 1);
                atomicMax(km, __float_as_uint(mx));
              }
            }
          }
        }
#pragma unroll
        for (int ai = 0; ai < 2; ++ai)
#pragma unroll
          for (int bj = 0; bj < 2; ++bj)
#pragma unroll
            for (int m = 0; m < 4; ++m)
              epi_store8<EPI>(p, layer, smem, brow + ai * HALF + wr * 64 + m * 16 + fr, bcol + bj * HALF + wc * 32 + fq * 8,
                              acc[ai][bj][m][0], acc[ai][bj][m][1], xin_lat);
      }
      if (!has_next) break;
#pragma unroll
      for (int a = 0; a < 2; ++a)
#pragma unroll
        for (int b2 = 0; b2 < 2; ++b2)
#pragma unroll
          for (int m = 0; m < 4; ++m)
#pragma unroll
            for (int n = 0; n < 2; ++n) acc[a][b2][m][n] = (f32x4){0.f, 0.f, 0.f, 0.f};
      cpm = npm; cpn = npn; cA = nA; cB = nB; ++ui;
    }
    G8_WAIT_V(0);
    if (wr == 0) G8_BAR;
    G8_BAR;
  }
}

__device__ __forceinline__ unsigned cvt_pk_bf16(float lo, float hi) { return pack2h(lo, hi); }
__device__ __forceinline__ int vt_row(int d) { return (d & ~7) | ((d ^ (d >> 3)) & 7); }
__device__ __forceinline__ void vt_store8(bf16_t* vt, int stride, int d0, int key, uint4 uv) {
  bf16_t* vd = vt + d0 * stride + key;
  const int x = (d0 >> 3) & 7;
  vd[(0 ^ x) * stride] = (bf16_t)(uv.x & 0xffffu); vd[(1 ^ x) * stride] = (bf16_t)(uv.x >> 16);
  vd[(2 ^ x) * stride] = (bf16_t)(uv.y & 0xffffu); vd[(3 ^ x) * stride] = (bf16_t)(uv.y >> 16);
  vd[(4 ^ x) * stride] = (bf16_t)(uv.z & 0xffffu); vd[(5 ^ x) * stride] = (bf16_t)(uv.z >> 16);
  vd[(6 ^ x) * stride] = (bf16_t)(uv.w & 0xffffu); vd[(7 ^ x) * stride] = (bf16_t)(uv.w >> 16);
}

constexpr int DKS = 72;
constexpr int DVS = 80;
typedef short s16x4 __attribute__((ext_vector_type(4)));
__device__ __forceinline__ bf16x8 vt_frag_tr(const bf16_t* p0, const bf16_t* p1) {
  const s16x4 a = __builtin_amdgcn_ds_read_tr16_b64_v4i16((__attribute__((address_space(3))) s16x4*)p0);
  const s16x4 b = __builtin_amdgcn_ds_read_tr16_b64_v4i16((__attribute__((address_space(3))) s16x4*)p1);
  return (bf16x8){a[0], a[1], a[2], a[3], b[0], b[1], b[2], b[3]};
}
__device__ __forceinline__ void diff_item(const Params& p, int layer, bool ctxq, int item, char* smem) {
  const bf16_t* P = (const bf16_t*)(p.ws + OFF_P);
  bf16_t* Y = (bf16_t*)(p.ws + OFF_ACT);
  const float* misc = (const float*)(p.ws + OFF_MISC);
  const float lam = misc[layer], lam_init = misc[2 + layer];
  const int tid = opaque_tid(), lane = tid & 63, wave = tid >> 6, lr = lane & 15, lq = lane >> 4;
  int b, h, mbase, nkeys;
  if (!ctxq) { b = item >> 6; h = (item >> 4) & 3; mbase = b * 4096 + (item & 15) * 256; nkeys = 256 + 4096; }
  else { b = item >> 2; h = item & 3; mbase = NLAT + b * 256; nkeys = 256; }
  const float kmax0 = sqrtf(misc[64 + layer * 64 + (b * 4 + h) * 2 + 0]), kmax1 = sqrtf(misc[64 + layer * 64 + (b * 4 + h) * 2 + 1]);
  bf16x8 qf[2][2];
  f32x4 C0[2], C1[2];
#pragma unroll
  for (int qt = 0; qt < 2; ++qt) {
    const bf16_t* qr = P + (size_t)(mbase + wave * 32 + qt * 16 + lr) * INC + C_DFQ + h * 64 + lq * 8;
    const uint4 u0 = *(const uint4*)(qr), u1 = *(const uint4*)(qr + 32);
    float s0 = 0.f, s1 = 0.f;
    { float t[8]; UNPACK8(t, 0, u0) _Pragma("unroll") for (int i = 0; i < 8; ++i) s0 = fmaf(t[i], t[i], s0); }
    { float t[8]; UNPACK8(t, 0, u1) _Pragma("unroll") for (int i = 0; i < 8; ++i) s1 = fmaf(t[i], t[i], s1); }
    s0 += __shfl_xor(s0, 16); s0 += __shfl_xor(s0, 32);
    s1 += __shfl_xor(s1, 16); s1 += __shfl_xor(s1, 32);
    const float nm0 = -sqrtf(s0) * kmax0, nm1 = -sqrtf(s1) * kmax1;
    C0[qt] = (f32x4){nm0, nm0, nm0, nm0};
    C1[qt] = (f32x4){nm1, nm1, nm1, nm1};
    union { uint4 u; bf16x8 v; } c0, c1; c0.u = u0; c1.u = u1;
    qf[qt][0] = c0.v; qf[qt][1] = c1.v;
  }
  f32x4 O0[2][4], O1[2][4];
#pragma unroll
  for (int qt = 0; qt < 2; ++qt)
#pragma unroll
    for (int i = 0; i < 4; ++i) { O0[qt][i] = (f32x4){0.f, 0.f, 0.f, 0.f}; O1[qt][i] = (f32x4){0.f, 0.f, 0.f, 0.f}; }
  f32x4 L0[2], L1[2];
#pragma unroll
  for (int qt = 0; qt < 2; ++qt) { L0[qt] = (f32x4){0.f, 0.f, 0.f, 0.f}; L1[qt] = (f32x4){0.f, 0.f, 0.f, 0.f}; }
  const bf16x8 ones8 = {(short)0x3F80, (short)0x3F80, (short)0x3F80, (short)0x3F80, (short)0x3F80, (short)0x3F80, (short)0x3F80, (short)0x3F80};
  const int lkey = tid >> 3, lch = tid & 7;
  constexpr int DBUF = 128 * DKS * 2 + 128 * DVS * 2;
  const __amdgpu_buffer_rsrc_t prsrc = __builtin_amdgcn_make_buffer_rsrc((void*)P, 0, NTOK * INC * 2, 0x00020000);
  uint4 ukA0, ukA1, uvA0, uvA1;
#define DF_GLOAD1(UK, UV, T, I)                                                                     \
  {                                                                                                 \
    const int kk = (T) * 128 + (I) * 64 + lkey;                                                     \
    const int row = kk < 256 ? (NLAT + b * 256 + kk) : (b * 4096 + kk - 256);                      \
    const int bo_ = (row * INC + h * 64 + lch * 8) * 2;                                             \
    UK = bload16(prsrc, bo_ + C_DFK * 2);                                                           \
    UV = bload16(prsrc, bo_ + C_DFV * 2);                                                           \
  }
#define DF_LSTORE1(UK, UV, BUF, I)                                                                  \
  {                                                                                                 \
    bf16_t* Ks_ = (bf16_t*)(smem + (BUF) * DBUF) + (I) * 64 * DKS;                                  \
    bf16_t* Vs_ = (bf16_t*)(smem + (BUF) * DBUF) + 128 * DKS + (I) * 64 * DVS;                      \
    *(uint4*)(Ks_ + lkey * DKS + lch * 8) = UK;                                                     \
    *(uint4*)(Vs_ + lkey * DVS + lch * 8) = UV;                                                     \
  }
#define DF_GLOAD(S, T) DF_GLOAD1(uk##S##0, uv##S##0, T, 0) DF_GLOAD1(uk##S##1, uv##S##1, T, 1)
#define DF_LSTORE(S, BUF) DF_LSTORE1(uk##S##0, uv##S##0, BUF, 0) DF_LSTORE1(uk##S##1, uv##S##1, BUF, 1)
  const int ntile = nkeys >> 7;
  __syncthreads();
  DF_GLOAD(A, 0)
  DF_LSTORE(A, 0)
  __syncthreads();
#pragma unroll 1
  for (int t = 0; t < ntile; ++t) {
    const int cur = t & 1;
    if (t + 1 < ntile) { DF_GLOAD(A, t + 1) }
#pragma unroll
    for (int sub = 0; sub < 2; ++sub) {
    const bf16_t* Ks = (const bf16_t*)(smem + cur * DBUF) + sub * 64 * DKS;
    const bf16_t* Vs = (const bf16_t*)(smem + cur * DBUF) + 128 * DKS + sub * 64 * DVS + (4 * lq + (lr >> 2)) * DVS + 4 * (lr & 3);
    union PF { unsigned u[4]; bf16x8 v; };
    PF pf0[2][2], pf1[2][2];
#pragma unroll
    for (int c = 0; c < 2; ++c) {
      f32x4 S[2][4];
#pragma unroll
      for (int kt = 0; kt < 4; ++kt) {
        const bf16x8 kf = *(const bf16x8*)(Ks + (kt * 16 + lr) * DKS + c * 32 + lq * 8);
#pragma unroll
        for (int qt = 0; qt < 2; ++qt) S[qt][kt] = __builtin_amdgcn_mfma_f32_16x16x32_bf16(kf, qf[qt][c], c == 0 ? C0[qt] : C1[qt], 0, 0, 0);
      }
#pragma unroll
      for (int qt = 0; qt < 2; ++qt) {
#pragma unroll
        for (int kt = 0; kt < 4; ++kt) {
#pragma unroll
          for (int r = 0; r < 4; ++r) S[qt][kt][r] = __builtin_amdgcn_exp2f(S[qt][kt][r]);
        }
#pragma unroll
        for (int g = 0; g < 2; ++g) {
          PF t;
          t.u[0] = cvt_pk_bf16(S[qt][2 * g][0], S[qt][2 * g][1]); t.u[1] = cvt_pk_bf16(S[qt][2 * g][2], S[qt][2 * g][3]);
          t.u[2] = cvt_pk_bf16(S[qt][2 * g + 1][0], S[qt][2 * g + 1][1]); t.u[3] = cvt_pk_bf16(S[qt][2 * g + 1][2], S[qt][2 * g + 1][3]);
          if (c == 0) pf0[qt][g] = t; else pf1[qt][g] = t;
        }
      }
    }
#pragma unroll
    for (int g = 0; g < 2; ++g) {
#pragma unroll
      for (int qt = 0; qt < 2; ++qt) {
        L0[qt] = __builtin_amdgcn_mfma_f32_16x16x32_bf16(ones8, pf0[qt][g].v, L0[qt], 0, 0, 0);
        L1[qt] = __builtin_amdgcn_mfma_f32_16x16x32_bf16(ones8, pf1[qt][g].v, L1[qt], 0, 0, 0);
      }
#pragma unroll
      for (int dt = 0; dt < 4; ++dt) {
        const bf16x8 vfv = vt_frag_tr(Vs + (32 * g) * DVS + dt * 16, Vs + (32 * g + 16) * DVS + dt * 16);
#pragma unroll
        for (int qt = 0; qt < 2; ++qt) {
          O0[qt][dt] = __builtin_amdgcn_mfma_f32_16x16x32_bf16(vfv, pf0[qt][g].v, O0[qt][dt], 0, 0, 0);
          O1[qt][dt] = __builtin_amdgcn_mfma_f32_16x16x32_bf16(vfv, pf1[qt][g].v, O1[qt][dt], 0, 0, 0);
        }
      }
    }
    }
    if (t + 1 < ntile) { DF_LSTORE(A, cur ^ 1) }
    __syncthreads();
  }
  const float* sg = p.diff_subln_g + layer * 64;
#pragma unroll
  for (int qt = 0; qt < 2; ++qt) {
    const float a0 = L0[qt][0], a1 = L1[qt][0];
    const float i0 = 1.f / a0, i1 = lam / a1;
    float ss = 0.f;
#pragma unroll
    for (int dt = 0; dt < 4; ++dt) {
#pragma unroll
      for (int r = 0; r < 4; ++r) { const float v = O0[qt][dt][r] * i0 - O1[qt][dt][r] * i1; O0[qt][dt][r] = v; ss = fmaf(v, v, ss); }
    }
    ss += __shfl_xor(ss, 16); ss += __shfl_xor(ss, 32);
    const float rr = rsqrtf(ss * (1.f / 64.f) + EPS) * (1.f - lam_init);
    bf16_t* dst = Y + (size_t)(mbase + wave * 32 + qt * 16 + lr) * 1024 + Y_DF + h * 64;
#pragma unroll
    for (int dt = 0; dt < 4; ++dt) {
      const int d = dt * 16 + 4 * lq;
      const float4 g4 = *(const float4*)(sg + d);
      uint2 ov;
      ov.x = pack2(O0[qt][dt][0] * rr * g4.x, O0[qt][dt][1] * rr * g4.y);
      ov.y = pack2(O0[qt][dt][2] * rr * g4.z, O0[qt][dt][3] * rr * g4.w);
      *(uint2*)(dst + d) = ov;
    }
  }
}

constexpr int NA_WS = DVS;
constexpr int NA_CS = DVS;
constexpr int NA_OFF_VTW = 0;
constexpr int NA_OFF_VTC = 512 * DVS * 2;
constexpr int NA_OFF_RPB = NA_OFF_VTC + 256 * DVS * 2;
constexpr int NA_OFF_MRG = NA_OFF_RPB + 2048;

#define NA_STEP(KA_EXPR, KB_EXPR, BIAS_EXPR, VT_PTR, VT_STRIDE, VT_KEY0_EXPR)                                    \
  {                                                                                                               \
    f32x4 S[4];                                                                                                   \
    _Pragma("unroll") for (int kt = 0; kt < 4; ++kt) {                                                            \
      f32x4 a = __builtin_amdgcn_mfma_f32_16x16x32_bf16((KA_EXPR), qf[0], (f32x4){0.f, 0.f, 0.f, 0.f}, 0, 0, 0);  \
      S[kt] = __builtin_amdgcn_mfma_f32_16x16x32_bf16((KB_EXPR), qf[1], a, 0, 0, 0);                               \
    }                                                                                                             \
    _Pragma("unroll") for (int kt = 0; kt < 4; ++kt) {                                                            \
      _Pragma("unroll") for (int r = 0; r < 4; ++r) { S[kt][r] += (BIAS_EXPR); }                                  \
    }                                                                                                             \
    float x = fmaxf(fmaxf(S[0][0], S[0][1]), fmaxf(S[0][2], S[0][3]));                                            \
    _Pragma("unroll") for (int kt = 1; kt < 4; ++kt) x = fmaxf(x, fmaxf(fmaxf(S[kt][0], S[kt][1]), fmaxf(S[kt][2], S[kt][3]))); \
    x = fmaxf(x, __shfl_xor(x, 16)); x = fmaxf(x, __shfl_xor(x, 32));                                             \
    const float mn = fmaxf(mrun, x);                                                                              \
    const float al = __builtin_amdgcn_exp2f(mrun - mn);                                                           \
    mrun = mn;                                                                                                    \
    float ps = 0.f;                                                                                               \
    _Pragma("unroll") for (int kt = 0; kt < 4; ++kt) {                                                            \
      _Pragma("unroll") for (int r = 0; r < 4; ++r) { S[kt][r] = __builtin_amdgcn_exp2f(S[kt][r] - mn); ps += S[kt][r]; } \
    }                                                                                                             \
    lrun = lrun * al + ps;                                                                                        \
    _Pragma("unroll") for (int dt = 0; dt < 4; ++dt) {                                                            \
      _Pragma("unroll") for (int r = 0; r < 4; ++r) O[dt][r] *= al;                                               \
    }                                                                                                             \
    _Pragma("unroll") for (int g = 0; g < 2; ++g) {                                                               \
      union { unsigned u[4]; bf16x8 v; } pf;                                                                      \
      pf.u[0] = cvt_pk_bf16(S[2 * g][0], S[2 * g][1]); pf.u[1] = cvt_pk_bf16(S[2 * g][2], S[2 * g][3]);           \
      pf.u[2] = cvt_pk_bf16(S[2 * g + 1][0], S[2 * g + 1][1]); pf.u[3] = cvt_pk_bf16(S[2 * g + 1][2], S[2 * g + 1][3]); \
      const int vk0 = (VT_KEY0_EXPR);                                                                             \
      _Pragma("unroll") for (int dt = 0; dt < 4; ++dt) {                                                          \
        const bf16_t* vp_ = (VT_PTR) + (vk0 + 4 * lq + (lr >> 2)) * (VT_STRIDE) + dt * 16 + 4 * (lr & 3);         \
        O[dt] = __builtin_amdgcn_mfma_f32_16x16x32_bf16(vt_frag_tr(vp_, vp_ + 16 * (VT_STRIDE)), pf.v, O[dt], 0, 0, 0); \
      }                                                                                                           \
    }                                                                                                             \
  }

__device__ __forceinline__ void na_latent_item(const Params& p, int layer, int item, char* smem) {
  const bf16_t* P = (const bf16_t*)(p.ws + OFF_P);
  bf16_t* Y = (bf16_t*)(p.ws + OFF_ACT);
  const int b = item >> 8, h = (item >> 6) & 3, grow = item & 63;
  const int tid = opaque_tid(), lane = tid & 63, wave = tid >> 6, lr = lane & 15, lq = lane >> 4;
  const int jt = wave & 3, half = wave >> 2;
  bf16_t* VtW = (bf16_t*)(smem + NA_OFF_VTW);
  bf16_t* VtC = (bf16_t*)(smem + NA_OFF_VTC);
  float* RPB = (float*)(smem + NA_OFF_RPB);
  float* MRG = (float*)(smem + NA_OFF_MRG);
  const int rs = min(max(grow - 4, 0), 56);
  const __amdgpu_buffer_rsrc_t prsrc = __builtin_amdgcn_make_buffer_rsrc((void*)P, 0, NTOK * INC * 2, 0x00020000);
  __syncthreads();
  {
    const int ch = tid & 7;
#pragma unroll
    for (int i = 0; i < 8; ++i) {
      const int key = (tid >> 3) + 64 * i;
      const uint4 uv = bload16(prsrc, ((b * 4096 + (rs + (key >> 6)) * 64 + (key & 63)) * INC + C_NAV + h * 64 + ch * 8) * 2);
      *(uint4*)(VtW + key * NA_WS + ch * 8) = uv;
    }
#pragma unroll
    for (int i = 0; i < 4; ++i) {
      const int key = (tid >> 3) + 64 * i;
      const uint4 uv = bload16(prsrc, ((NLAT + b * 256 + key) * INC + C_NAV + h * 64 + ch * 8) * 2);
      *(uint4*)(VtC + key * NA_CS + ch * 8) = uv;
    }
    if (tid < 465) RPB[tid] = p.na_rpb[(size_t)(layer * 4 + h) * 465 + tid] * 1.4426950408889634f;
  }
  const int qc = jt * 16 + lr;
  const int mq = b * 4096 + grow * 64 + qc;
  bf16x8 qf[2];
  {
    const bf16_t* qr = P + (size_t)mq * INC + C_NAQ + h * 64 + lq * 8;
    qf[0] = *(const bf16x8*)(qr);
    qf[1] = *(const bf16x8*)(qr + 32);
  }
  f32x4 O[4];
#pragma unroll
  for (int i = 0; i < 4; ++i) O[i] = (f32x4){0.f, 0.f, 0.f, 0.f};
  float mrun = -1e30f, lrun = 0.f;
  const int k0 = min(max(jt * 16 - 8, 0), 32);
  const int cs = min(max(qc - 8, 0), 48);
  bf16x8 kfa[2][4], kfb[2][4];
#define NA_LOADK(SET, S_)                                                                                        \
  _Pragma("unroll") for (int kt = 0; kt < 4; ++kt) {                                                             \
    const int t_ = 4 * (S_) + kt;                                                                                \
    const int krow = half == 0 ? (b * 4096 + (rs + (t_ >> 1)) * 64 + k0 + 16 * (t_ & 1) + lr) : (NLAT + b * 256 + 16 * t_ + lr); \
    const int ko_ = (krow * INC + C_NAK + h * 64 + lq * 8) * 2;                                                  \
    { union { uint4 u; bf16x8 v; } ta_, tb_; ta_.u = bload16(prsrc, ko_); tb_.u = bload16(prsrc, ko_ + 64); kfa[SET][kt] = ta_.v; kfb[SET][kt] = tb_.v; } \
  }
  NA_LOADK(0, 0)
  __syncthreads();
#pragma unroll
  for (int s = 0; s < 4; ++s) {
    if (s + 1 < 4) { NA_LOADK((s + 1) & 1, s + 1) }
    if (half == 0) {
      const int wr0 = 2 * s;
      NA_STEP(kfa[s & 1][kt], kfb[s & 1][kt],
              ((k0 + 16 * (kt & 1) + 4 * lq + r) >= cs && (k0 + 16 * (kt & 1) + 4 * lq + r) < cs + 16)
                  ? RPB[(rs + wr0 + (kt >> 1) - grow + 7) * 31 + (k0 + 16 * (kt & 1) + 4 * lq + r) - qc + 15] : -1e30f,
              VtW, NA_WS, (wr0 + g) * 64 + k0)
    } else {
      NA_STEP(kfa[s & 1][kt], kfb[s & 1][kt], 0.f, VtC, NA_CS, s * 64 + 32 * g)
    }
  }
  lrun += __shfl_xor(lrun, 16); lrun += __shfl_xor(lrun, 32);
  float* mg = MRG + (jt * 64 + lane) * 18;
  if (half == 1) {
    mg[0] = mrun; mg[1] = lrun;
#pragma unroll
    for (int dt = 0; dt < 4; ++dt) { mg[2 + dt * 4 + 0] = O[dt][0]; mg[2 + dt * 4 + 1] = O[dt][1]; mg[2 + dt * 4 + 2] = O[dt][2]; mg[2 + dt * 4 + 3] = O[dt][3]; }
  }
  __syncthreads();
  if (half == 0) {
    const float m2 = mg[0], l2 = mg[1];
    const float M = fmaxf(mrun, m2);
    const float f1 = __builtin_amdgcn_exp2f(mrun - M), f2 = __builtin_amdgcn_exp2f(m2 - M);
    const float inv = 1.f / (lrun * f1 + l2 * f2);
    bf16_t* dst = Y + (size_t)mq * 1024 + Y_NA + h * 64;
#pragma unroll
    for (int dt = 0; dt < 4; ++dt) {
      const float o0 = (O[dt][0] * f1 + mg[2 + dt * 4 + 0] * f2) * inv, o1 = (O[dt][1] * f1 + mg[2 + dt * 4 + 1] * f2) * inv;
      const float o2 = (O[dt][2] * f1 + mg[2 + dt * 4 + 2] * f2) * inv, o3 = (O[dt][3] * f1 + mg[2 + dt * 4 + 3] * f2) * inv;
      uint2 ov; ov.x = pack2(o0, o1); ov.y = pack2(o2, o3);
      *(uint2*)(dst + dt * 16 + 4 * lq) = ov;
    }
  }
}

__device__ __forceinline__ void na_ctx_item(const Params& p, int item, char* smem) {
  const bf16_t* P = (const bf16_t*)(p.ws + OFF_P);
  bf16_t* Y = (bf16_t*)(p.ws + OFF_ACT);
  const int b = item >> 3, h = (item >> 1) & 3, qg = item & 1;
  const int tid = opaque_tid(), lane = tid & 63, wave = tid >> 6, lr = lane & 15, lq = lane >> 4;
  bf16_t* VtC = (bf16_t*)(smem + NA_OFF_VTC);
  __syncthreads();
  {
    const int ch = tid & 7;
#pragma unroll
    for (int i = 0; i < 4; ++i) {
      const int key = (tid >> 3) + 64 * i;
      const uint4 uv = *(const uint4*)(P + (size_t)(NLAT + b * 256 + key) * INC + C_NAV + h * 64 + ch * 8);
      *(uint4*)(VtC + key * NA_CS + ch * 8) = uv;
    }
  }
  const int mq = NLAT + b * 256 + qg * 128 + wave * 16 + lr;
  bf16x8 qf[2];
  {
    const bf16_t* qr = P + (size_t)mq * INC + C_NAQ + h * 64 + lq * 8;
    qf[0] = *(const bf16x8*)(qr);
    qf[1] = *(const bf16x8*)(qr + 32);
  }
  f32x4 O[4];
#pragma unroll
  for (int i = 0; i < 4; ++i) O[i] = (f32x4){0.f, 0.f, 0.f, 0.f};
  float mrun = -1e30f, lrun = 0.f;
  __syncthreads();
#pragma unroll 1
  for (int s = 0; s < 4; ++s) {
    NA_STEP(*(const bf16x8*)(P + (size_t)(NLAT + b * 256 + s * 64 + kt * 16 + lr) * INC + C_NAK + h * 64 + lq * 8),
            *(const bf16x8*)(P + (size_t)(NLAT + b * 256 + s * 64 + kt * 16 + lr) * INC + C_NAK + h * 64 + 32 + lq * 8), 0.f, VtC, NA_CS, s * 64 + 32 * g)
  }
  lrun += __shfl_xor(lrun, 16); lrun += __shfl_xor(lrun, 32);
  const float inv = 1.f / lrun;
  bf16_t* dst = Y + (size_t)mq * 1024 + Y_NA + h * 64;
#pragma unroll
  for (int dt = 0; dt < 4; ++dt) {
    uint2 ov; ov.x = pack2(O[dt][0] * inv, O[dt][1] * inv); ov.y = pack2(O[dt][2] * inv, O[dt][3] * inv);
    *(uint2*)(dst + dt * 16 + 4 * lq) = ov;
  }
}

constexpr int KV_S = 136;
constexpr int KV_OFF_KF = 0, KV_OFF_KB = 64 * KV_S * 2, KV_OFF_VT = 2 * 64 * KV_S * 2;
__device__ __forceinline__ void ret_kv_item(const Params& p, int layer, int h, size_t row0, int cnt, float* dstF, float* dstB, char* smem) {
  const bf16_t* P = (const bf16_t*)(p.ws + OFF_P);
  const float* misc = (const float*)(p.ws + OFF_MISC);
  const float lgF2 = misc[16 + layer * 8 + 0 * 4 + h] * 1.4426950408889634f, lgB2 = misc[16 + layer * 8 + 1 * 4 + h] * 1.4426950408889634f;
  const int tid = opaque_tid(), lane = tid & 63, wave = tid >> 6, lr = lane & 15, lq = lane >> 4;
  bf16_t* KFt = (bf16_t*)(smem + KV_OFF_KF);
  bf16_t* KBt = (bf16_t*)(smem + KV_OFF_KB);
  bf16_t* Vt = (bf16_t*)(smem + KV_OFF_VT);
  const int dir = wave >> 2, dt = wave & 3;
  f32x4 acc[8];
#pragma unroll
  for (int i = 0; i < 8; ++i) acc[i] = (f32x4){0.f, 0.f, 0.f, 0.f};
  const int tok = tid >> 2, c = tid & 3;
  const __amdgpu_buffer_rsrc_t prsrc = __builtin_amdgcn_make_buffer_rsrc((void*)P, 0, NTOK * INC * 2, 0x00020000);
  uint4 gk0, gk1, gv0, gv1, gv2, gv3;
#define KV_GLOAD(KC) {                                                                                       \
    const int ro_ = (((int)row0 + (KC) * 128 + tok) * INC) * 2;                                              \
    gk0 = bload16(prsrc, ro_ + (C_RTK + h * 64 + c * 16) * 2); gk1 = bload16(prsrc, ro_ + (C_RTK + h * 64 + c * 16 + 8) * 2); \
    gv0 = bload16(prsrc, ro_ + (C_RTV + h * 128 + c * 32) * 2); gv1 = bload16(prsrc, ro_ + (C_RTV + h * 128 + c * 32 + 8) * 2); \
    gv2 = bload16(prsrc, ro_ + (C_RTV + h * 128 + c * 32 + 16) * 2); gv3 = bload16(prsrc, ro_ + (C_RTV + h * 128 + c * 32 + 24) * 2); }
  KV_GLOAD(0)
#pragma unroll 1
  for (int kc = 0; kc < (cnt >> 7); ++kc) {
    __syncthreads();
    {
      const int j = kc * 128 + tok;
      const float wF = __builtin_amdgcn_exp2f(lgF2 * (float)(cnt - 1 - j)), wB = __builtin_amdgcn_exp2f(lgB2 * (float)j);
#pragma unroll
      for (int c8 = 0; c8 < 2; ++c8) {
        const uint4 u = c8 == 0 ? gk0 : gk1;
        float kv[8];
        UNPACK8(kv, 0, u)
#pragma unroll
        for (int i = 0; i < 8; ++i) {
          KFt[(c * 16 + c8 * 8 + i) * KV_S + tok] = f2bf(kv[i] * wF);
          KBt[(c * 16 + c8 * 8 + i) * KV_S + tok] = f2bf(kv[i] * wB);
        }
      }
      vt_store8(Vt, KV_S, c * 32, tok, gv0); vt_store8(Vt, KV_S, c * 32 + 8, tok, gv1);
      vt_store8(Vt, KV_S, c * 32 + 16, tok, gv2); vt_store8(Vt, KV_S, c * 32 + 24, tok, gv3);
    }
    if (kc + 1 < (cnt >> 7)) KV_GLOAD(kc + 1)
    __syncthreads();
    const bf16_t* Kt = dir == 0 ? KFt : KBt;
    bf16x8 af[4];
#pragma unroll
    for (int ks = 0; ks < 4; ++ks) af[ks] = *(const bf16x8*)(Kt + (dt * 16 + lr) * KV_S + ks * 32 + lq * 8);
#pragma unroll
    for (int et = 0; et < 8; ++et) {
#pragma unroll
      for (int ks = 0; ks < 4; ++ks) {
        const bf16x8 bfr = *(const bf16x8*)(Vt + vt_row(et * 16 + lr) * KV_S + ks * 32 + lq * 8);
        acc[et] = __builtin_amdgcn_mfma_f32_16x16x32_bf16(bfr, af[ks], acc[et], 0, 0, 0);
      }
    }
  }
  float* dst = dir == 0 ? dstF : dstB;
#pragma unroll
  for (int et = 0; et < 8; ++et) {
    *(float4*)(dst + (dt * 16 + lr) * 128 + et * 16 + 4 * lq) = (float4){acc[et][0], acc[et][1], acc[et][2], acc[et][3]};
  }
}

__device__ __forceinline__ void phase_ret_scan(const Params& p, int layer) {
  const float* misc = (const float*)(p.ws + OFF_MISC);
  float* rkv = (float*)(p.ws + OFF_RKV);
  bf16_t* rkvh = (bf16_t*)(p.ws + OFF_RKVH);
  const float* rs = (const float*)(p.ws + OFF_RS);
  const int gt = opaque_bid() * 512 + opaque_tid(), gs = gridDim.x * 512;
  for (int idx = gt; idx < 64 * 2048; idx += gs) {
    const int seq = idx >> 11, e4 = (idx & 2047) * 4;
    const int dir = seq & 1, h = (seq >> 1) & 3;
    const float cdec = __expf(misc[16 + layer * 8 + dir * 4 + h] * 128.f);
    const float4* base = (const float4*)(rkv + (size_t)seq * 32 * 8192 + e4);
    uint2* hbase = (uint2*)(rkvh + (size_t)seq * 32 * 8192 + e4);
    float4 v[32];
#pragma unroll
    for (int s = 0; s < 32; ++s) v[s] = base[(size_t)s * 2048];
    float4 st = *(const float4*)(rs + (size_t)seq * 8192 + e4);
    if (dir == 0) {
#pragma unroll
      for (int s = 0; s < 32; ++s) {
        const float4 t = v[s];
        hbase[(size_t)s * 2048] = make_uint2(pack2h(st.x, st.y), pack2h(st.z, st.w));
        st.x = fmaf(cdec, st.x, t.x); st.y = fmaf(cdec, st.y, t.y); st.z = fmaf(cdec, st.z, t.z); st.w = fmaf(cdec, st.w, t.w);
      }
    } else {
#pragma unroll
      for (int s = 31; s >= 0; --s) {
        const float4 t = v[s];
        hbase[(size_t)s * 2048] = make_uint2(pack2h(st.x, st.y), pack2h(st.z, st.w));
        st.x = fmaf(cdec, st.x, t.x); st.y = fmaf(cdec, st.y, t.y); st.z = fmaf(cdec, st.z, t.z); st.w = fmaf(cdec, st.w, t.w);
      }
    }
  }
}

constexpr int RT_KS = 72, RT_VS = 136, RT_SS = 144;
constexpr int RT_OFF_K = 0, RT_OFF_VT = 128 * RT_KS * 2, RT_OFF_SF = RT_OFF_VT + 128 * RT_VS * 2, RT_OFF_SB = RT_OFF_SF + 128 * RT_KS * 2;
__device__ __forceinline__ void ret_out_item(const Params& p, int layer, int h, size_t krow0, int nkc, int iq0,
                                             const bf16_t* SF, const bf16_t* SB, int clen, char* smem) {
  const bf16_t* P = (const bf16_t*)(p.ws + OFF_P);
  bf16_t* Y = (bf16_t*)(p.ws + OFF_ACT);
  const float* misc = (const float*)(p.ws + OFF_MISC);
  const float lgF2 = misc[16 + layer * 8 + 0 * 4 + h] * 1.4426950408889634f, lgB2 = misc[16 + layer * 8 + 1 * 4 + h] * 1.4426950408889634f;
  const int tid = opaque_tid(), lane = tid & 63, wave = tid >> 6, lr = lane & 15, lq = lane >> 4;
  bf16_t* Ks = (bf16_t*)(smem + RT_OFF_K);
  bf16_t* Vt = (bf16_t*)(smem + RT_OFF_VT);
  bf16_t* SFt = (bf16_t*)(smem + RT_OFF_SF);
  bf16_t* SBt = (bf16_t*)(smem + RT_OFF_SB);
  const int iq = iq0 + wave * 16 + lr;
  const size_t mq = krow0 + iq;
  bf16x8 qf[2];
  {
    const bf16_t* qr = P + mq * INC + C_RTQ + h * 64 + lq * 8;
    qf[0] = *(const bf16x8*)(qr);
    qf[1] = *(const bf16x8*)(qr + 32);
  }
  bf16x8 qp[2];
  {
    const bf16_t* qr = P + mq * INC + C_RTQ + h * 64 + lq * 4;
#pragma unroll
    for (int ks = 0; ks < 2; ++ks) {
      union { uint2 h2[2]; bf16x8 v; } qq;
      qq.h2[0] = *(const uint2*)(qr + 32 * ks); qq.h2[1] = *(const uint2*)(qr + 32 * ks + 16);
      qp[ks] = qq.v;
    }
  }
  const bf16_t* sfb = SFt + (4 * lq + (lr >> 2)) * RT_SS + 4 * (lr & 3);
  const bf16_t* sbb = SBt + (4 * lq + (lr >> 2)) * RT_SS + 4 * (lr & 3);
  uint4 sfa0 = make_uint4(0u, 0u, 0u, 0u), sfa1 = sfa0, sba0 = sfa0, sba1 = sfa0;
  if (SF != nullptr) {
    const bf16_t* sp = SF + (tid >> 3) * 128 + (tid & 7) * 16;
    const bf16_t* bp = SB + (tid >> 3) * 128 + (tid & 7) * 16;
    sfa0 = *(const uint4*)sp; sfa1 = *(const uint4*)(sp + 8);
    sba0 = *(const uint4*)bp; sba1 = *(const uint4*)(bp + 8);
  }
  const int skey = tid >> 2, sc = tid & 3;
  uint4 pk0, pk1, pv0, pv1, pv2, pv3;
#define RT_LOADKV(KC) {                                                                                    \
    const bf16_t* rowp = P + (krow0 + (KC) * 128 + skey) * INC;                                            \
    pk0 = *(const uint4*)(rowp + C_RTK + h * 64 + sc * 16); pk1 = *(const uint4*)(rowp + C_RTK + h * 64 + sc * 16 + 8); \
    pv0 = *(const uint4*)(rowp + C_RTV + h * 128 + sc * 32); pv1 = *(const uint4*)(rowp + C_RTV + h * 128 + sc * 32 + 8); \
    pv2 = *(const uint4*)(rowp + C_RTV + h * 128 + sc * 32 + 16); pv3 = *(const uint4*)(rowp + C_RTV + h * 128 + sc * 32 + 24); }
  RT_LOADKV(0)
  uint2 gu8[8];
  {
    const bf16_t* gp0 = P + mq * INC + C_RTG + h * 128 + 4 * lq;
#pragma unroll
    for (int et = 0; et < 8; ++et) gu8[et] = *(const uint2*)(gp0 + et * 16);
  }
  f32x4 O[8];
#pragma unroll
  for (int i = 0; i < 8; ++i) O[i] = (f32x4){0.f, 0.f, 0.f, 0.f};
  if (SF != nullptr) {
    __syncthreads();
    {
      const int d = tid >> 3, e0 = (tid & 7) * 16;
      *(uint4*)(SFt + d * RT_SS + e0) = sfa0; *(uint4*)(SFt + d * RT_SS + e0 + 8) = sfa1;
      *(uint4*)(SBt + d * RT_SS + e0) = sba0; *(uint4*)(SBt + d * RT_SS + e0 + 8) = sba1;
    }
    __syncthreads();
    const float cF = __builtin_amdgcn_exp2f(lgF2 * (float)(iq + 1)), cB = __builtin_amdgcn_exp2f(lgB2 * (float)(clen - iq));
#pragma unroll
    for (int ks = 0; ks < 2; ++ks)
#pragma unroll
      for (int et = 0; et < 8; ++et) {
        const bf16x8 sf = vt_frag_tr(sfb + (32 * ks) * RT_SS + et * 16, sfb + (32 * ks + 16) * RT_SS + et * 16);
        O[et] = __builtin_amdgcn_mfma_f32_16x16x32_bf16(sf, qp[ks], O[et], 0, 0, 0);
      }
    const float ratio = cF / cB;
#pragma unroll
    for (int et = 0; et < 8; ++et) { O[et][0] *= ratio; O[et][1] *= ratio; O[et][2] *= ratio; O[et][3] *= ratio; }
#pragma unroll
    for (int ks = 0; ks < 2; ++ks)
#pragma unroll
      for (int et = 0; et < 8; ++et) {
        const bf16x8 sb = vt_frag_tr(sbb + (32 * ks) * RT_SS + et * 16, sbb + (32 * ks + 16) * RT_SS + et * 16);
        O[et] = __builtin_amdgcn_mfma_f32_16x16x32_bf16(sb, qp[ks], O[et], 0, 0, 0);
      }
#pragma unroll
    for (int et = 0; et < 8; ++et) { O[et][0] *= cB; O[et][1] *= cB; O[et][2] *= cB; O[et][3] *= cB; }
  }
#pragma unroll 1
  for (int kc = 0; kc < nkc; ++kc) {
    __syncthreads();
    {
      *(uint4*)(Ks + skey * RT_KS + sc * 16) = pk0;
      *(uint4*)(Ks + skey * RT_KS + sc * 16 + 8) = pk1;
      vt_store8(Vt, RT_VS, sc * 32, skey, pv0); vt_store8(Vt, RT_VS, sc * 32 + 8, skey, pv1);
      vt_store8(Vt, RT_VS, sc * 32 + 16, skey, pv2); vt_store8(Vt, RT_VS, sc * 32 + 24, skey, pv3);
    }
    if (kc + 1 < nkc) RT_LOADKV(kc + 1)
    __syncthreads();
    f32x4 S[8];
#pragma unroll
    for (int kt = 0; kt < 8; ++kt) {
      const bf16x8 ka = *(const bf16x8*)(Ks + (kt * 16 + lr) * RT_KS + lq * 8);
      const bf16x8 kb = *(const bf16x8*)(Ks + (kt * 16 + lr) * RT_KS + 32 + lq * 8);
      const f32x4 a = __builtin_amdgcn_mfma_f32_16x16x32_bf16(ka, qf[0], (f32x4){0.f, 0.f, 0.f, 0.f}, 0, 0, 0);
      S[kt] = __builtin_amdgcn_mfma_f32_16x16x32_bf16(kb, qf[1], a, 0, 0, 0);
    }
#pragma unroll
    for (int kt = 0; kt < 8; ++kt) {
#pragma unroll
      for (int r = 0; r < 4; ++r) {
        const int df = iq - (kc * 128 + kt * 16 + 4 * lq + r);
        const float fdf = (float)df;
        float coef = 0.f;
        if (df >= 0) coef += __builtin_amdgcn_exp2f(lgF2 * fdf);
        if (df <= 0) coef += __builtin_amdgcn_exp2f(-lgB2 * fdf);
        S[kt][r] *= coef;
      }
    }
#pragma unroll
    for (int g = 0; g < 4; ++g) {
      union { unsigned u[4]; bf16x8 v; } pf;
      pf.u[0] = cvt_pk_bf16(S[2 * g][0], S[2 * g][1]); pf.u[1] = cvt_pk_bf16(S[2 * g][2], S[2 * g][3]);
      pf.u[2] = cvt_pk_bf16(S[2 * g + 1][0], S[2 * g + 1][1]); pf.u[3] = cvt_pk_bf16(S[2 * g + 1][2], S[2 * g + 1][3]);
#pragma unroll
      for (int et = 0; et < 8; ++et) {
        union { uint2 h2[2]; bf16x8 v; } vf;
        vf.h2[0] = *(const uint2*)(Vt + vt_row(et * 16 + lr) * RT_VS + 32 * g + 4 * lq);
        vf.h2[1] = *(const uint2*)(Vt + vt_row(et * 16 + lr) * RT_VS + 32 * g + 16 + 4 * lq);
        O[et] = __builtin_amdgcn_mfma_f32_16x16x32_bf16(vf.v, pf.v, O[et], 0, 0, 0);
      }
    }
  }
  float ss = 0.f;
#pragma unroll
  for (int et = 0; et < 8; ++et) { ss = fmaf(O[et][0], O[et][0], ss); ss = fmaf(O[et][1], O[et][1], ss); ss = fmaf(O[et][2], O[et][2], ss); ss = fmaf(O[et][3], O[et][3], ss); }
  ss += __shfl_xor(ss, 16); ss += __shfl_xor(ss, 32);
  const float rr = rsqrtf(ss * (1.f / 128.f) + EPS);
  bf16_t* dst = Y + mq * 1024 + Y_RT + h * 128;
#pragma unroll
  for (int et = 0; et < 8; ++et) {
    const int e = et * 16 + 4 * lq;
    const uint2 gu = gu8[et];
    uint2 ov;
    ov.x = pack2(O[et][0] * rr * siluf(lo16(gu.x)), O[et][1] * rr * siluf(hi16(gu.x)));
    ov.y = pack2(O[et][2] * rr * siluf(lo16(gu.y)), O[et][3] * rr * siluf(hi16(gu.y)));
    *(uint2*)(dst + e) = ov;
  }
}

__device__ __forceinline__ void uv_convert_item(const Params& p, int item, char* smem) {
  char* ws = p.ws;
  const int tid = opaque_tid();
  const int lane = tid & 63, l = lane & 31, half = lane >> 5, wave = tid >> 6;
  const bool isv = item * 256 >= 2 * NEXP;
  const float* sbase = (isv ? p.peer_v : p.peer_u) + (size_t)(item * 256 - (isv ? 2 * NEXP : 0) + wave * 32 + half) * 1024;
  float4 v[8];
#pragma unroll
  for (int j = 0; j < 8; ++j) v[j] = ((const float4*)sbase)[l + 32 * j];
#pragma unroll 1
  for (int it = 0; it < 16; ++it) {
    const int row = item * 256 + (wave * 16 + it) * 2 + half;
    const int rr = isv ? row - 2 * NEXP : row;
    float4 vn[8];
    {
      const float* snext = sbase + (size_t)(it + 1 < 16 ? it + 1 : it) * 2048;
#pragma unroll
      for (int j = 0; j < 8; ++j) vn[j] = ((const float4*)snext)[l + 32 * j];
    }
    float mx = 0.f;
#pragma unroll
    for (int j = 0; j < 8; ++j) mx = fmaxf(mx, fmaxf(fmaxf(fabsf(v[j].x), fabsf(v[j].y)), fmaxf(fabsf(v[j].z), fabsf(v[j].w))));
#pragma unroll
    for (int o = 1; o < 32; o <<= 1) mx = fmaxf(mx, __shfl_xor(mx, o));
    const float scale4 = mx > 0.f ? mx * (1.f / 6.f) : 1.f;
    const float inv4 = 1.f / scale4;
    unsigned w[4] = {0u, 0u, 0u, 0u};
#pragma unroll
    for (int j = 0; j < 8; ++j) {
      const float4 q = v[j];
      if ((j & 1) == 0) {
        w[j >> 1] = __builtin_amdgcn_cvt_scalef32_pk_fp4_f32(w[j >> 1], q.x * inv4, q.y * inv4, 1.0f, 0);
        w[j >> 1] = __builtin_amdgcn_cvt_scalef32_pk_fp4_f32(w[j >> 1], q.z * inv4, q.w * inv4, 1.0f, 1);
      } else {
        w[j >> 1] = __builtin_amdgcn_cvt_scalef32_pk_fp4_f32(w[j >> 1], q.x * inv4, q.y * inv4, 1.0f, 2);
        w[j >> 1] = __builtin_amdgcn_cvt_scalef32_pk_fp4_f32(w[j >> 1], q.z * inv4, q.w * inv4, 1.0f, 3);
      }
    }
    uint4 ow = make_uint4(w[0], w[1], w[2], w[3]);
    if (!isv) {
      unsigned short* img = (unsigned short*)(smem + (wave * 2 + half) * 512);
#pragma unroll
      for (int j = 0; j < 8; ++j) img[l + 32 * j] = (unsigned short)((w[j >> 1] >> (16 * (j & 1))) & 0xffffu);
      asm volatile("s_waitcnt lgkmcnt(0)" ::: "memory");
      ow = *(const uint4*)((const char*)img + 16 * l);
    }
    char* drow = ws + OFF_U + (size_t)rr * RECB + (isv ? ROWB + l * 16 : 64 * (l & 7) + 16 * (l >> 3));
    *(uint4*)(drow) = ow;
    if (l == 0) ((float*)(ws + (isv ? OFF_VSC : OFF_USC)))[rr] = scale4;
#pragma unroll
    for (int j = 0; j < 8; ++j) v[j] = vn[j];
  }
}

__device__ __forceinline__ void phase_mix1(const Params& p, int layer, char* smem, int slot = 0) {
  unsigned* ctr = (unsigned*)(p.ws + OFF_CTL) + (layer * 4 + slot);
  const bool nc = layer == 0;
  const int n_dl = 512, n_dc = nc ? 32 : 0, n_nl = 2048, n_ncx = nc ? 64 : 0, n_kv = 1024, n_cs = 32;
  const int n_ro = nc ? 64 : 0;
  const int total = n_dl + n_dc + n_nl + n_ncx + n_kv + n_cs + n_ro;
  float* rkv = (float*)(p.ws + OFF_RKV);
  float* rs = (float*)(p.ws + OFF_RS);
  int it = next_item(ctr, smem);
  while (it < total) {
    unsigned nx = 0u;
    if (threadIdx.x == 0) nx = atomicAdd(ctr, 1u);
    if (it < n_dl) diff_item(p, layer, false, it, smem);
    else if (it < n_dl + n_dc) diff_item(p, layer, true, it - n_dl, smem);
    else if (it < n_dl + n_dc + n_nl) na_latent_item(p, layer, it - n_dl - n_dc, smem);
    else if (it < n_dl + n_dc + n_nl + n_ncx) na_ctx_item(p, it - n_dl - n_dc - n_nl, smem);
    else if (it < n_dl + n_dc + n_nl + n_ncx + n_kv) {
      const int i2 = it - n_dl - n_dc - n_nl - n_ncx;
      const int bh = i2 >> 5, n = i2 & 31, b = bh >> 2, h = bh & 3;
      ret_kv_item(p, layer, h, (size_t)b * 4096 + n * 128, 128,
                  rkv + ((size_t)(bh * 2 + 0) * 32 + n) * 8192, rkv + ((size_t)(bh * 2 + 1) * 32 + n) * 8192, smem);
    } else if (it < n_dl + n_dc + n_nl + n_ncx + n_kv + n_cs) {
      const int bh = it - n_dl - n_dc - n_nl - n_ncx - n_kv, b = bh >> 2, h = bh & 3;
      ret_kv_item(p, layer, h, (size_t)NLAT + b * 256, 256, rs + (size_t)(bh * 2 + 0) * 8192, rs + (size_t)(bh * 2 + 1) * 8192, smem);
    } else {
      const int i2 = it - n_dl - n_dc - n_nl - n_ncx - n_kv - n_cs;
      const int bh = i2 >> 1, half = i2 & 1, b = bh >> 2, h = bh & 3;
      ret_out_item(p, layer, h, (size_t)NLAT + b * 256, 2, half * 128, nullptr, nullptr, 256, smem);
    }
    volatile int* bc = (volatile int*)(smem + LDS_BCAST);
    __syncthreads();
    if (threadIdx.x == 0) *bc = (int)nx;
    __syncthreads();
    it = *bc;
  }
}

__device__ __forceinline__ void phase_mix2(const Params& p, int layer, char* smem, int slot = 1) {
  unsigned* ctr = (unsigned*)(p.ws + OFF_CTL) + (layer * 4 + slot);
  const int n_l = 1024, n_c = 0;
  const bf16_t* rkv = (const bf16_t*)(p.ws + OFF_RKVH);
  (void)ctr;
  for (int it0 = opaque_bid(); it0 < n_l + n_c; it0 += gridDim.x) {
    int it = it0;
    if (it < n_l) {
      const int bh = it >> 5, n = it & 31, b = bh >> 2, h = bh & 3;
      ret_out_item(p, layer, h, (size_t)b * 4096 + n * 128, 1, 0,
                   rkv + ((size_t)(bh * 2 + 0) * 32 + n) * 8192, rkv + ((size_t)(bh * 2 + 1) * 32 + n) * 8192, 128, smem);
    } else {
      it -= n_l;
      const int bh = it >> 1, half = it & 1, b = bh >> 2, h = bh & 3;
      ret_out_item(p, layer, h, (size_t)NLAT + b * 256, 2, half * 128, nullptr, nullptr, 256, smem);
    }
  }
}

typedef float f32x2 __attribute__((ext_vector_type(2)));
__device__ __forceinline__ unsigned sortable_key(float f, int idx) {
  const unsigned b = __float_as_uint(f);
  const unsigned k = b ^ ((unsigned)((int)b >> 31) | 0x80000000u);
  return (k & ~127u) | (unsigned)(127 - idx);
}
__device__ __forceinline__ float key_value(unsigned k) {
  k &= ~127u;
  const unsigned b = (k & 0x80000000u) ? (k ^ 0x80000000u) : ~k;
  return __uint_as_float(b);
}
#define FP8DOT(acc, H, off, W) { const f32x2 _a = __builtin_amdgcn_cvt_pk_f32_fp8((int)(W), false), _b = __builtin_amdgcn_cvt_pk_f32_fp8((int)(W), true); \
  acc = fmaf(H[(off) + 0], _a.x, acc); acc = fmaf(H[(off) + 1], _a.y, acc); acc = fmaf(H[(off) + 2], _b.x, acc); acc = fmaf(H[(off) + 3], _b.y, acc); }
#define FP8AXPY(O, off, P, W) { const f32x2 _a = __builtin_amdgcn_cvt_pk_f32_fp8((int)(W), false), _b = __builtin_amdgcn_cvt_pk_f32_fp8((int)(W), true); \
  O[(off) + 0] = fmaf(P, _a.x, O[(off) + 0]); O[(off) + 1] = fmaf(P, _a.y, O[(off) + 1]); O[(off) + 2] = fmaf(P, _b.x, O[(off) + 2]); O[(off) + 3] = fmaf(P, _b.y, O[(off) + 3]); }

__device__ __forceinline__ float gelu_erf(float a) {
  const float x = fabsf(a) * 0.70710678118654752f;
  const float t = __builtin_amdgcn_rcpf(fmaf(0.3275911f, x, 1.f));
  float pl = fmaf(1.061405429f, t, -1.453152027f);
  pl = fmaf(pl, t, 1.421413741f); pl = fmaf(pl, t, -0.284496736f); pl = fmaf(pl, t, 0.254829592f);
  const float y = 1.f - pl * t * __builtin_amdgcn_exp2f(-x * x * 1.4426950408889634f);
  const float er = a < 0.f ? -y : y;
  return 0.5f * a * (1.f + er);
}
constexpr int PE_SVS = 132;
constexpr int PE_OFF_SV = 0;
constexpr int PE_OFF_TV = 8 * 16 * PE_SVS * 4;
constexpr int PE_OFF_TI = PE_OFF_TV + 16 * 16 * 16 * 4;
constexpr int PE_OFF_EX = PE_OFF_TI + 16 * 16 * 16 * 4;
constexpr int PE_OFF_GT = PE_OFF_EX + 2 * 16 * 128 * 4;
constexpr int PE_OFF_SU = PE_OFF_GT + 2 * 16 * 128 * 4;
constexpr int PE_OFF_CN = PE_OFF_SU + 2 * 16 * 128 * 4;
constexpr int PE_OFF_CT = PE_OFF_CN + 8 * 16 * 4;
constexpr int PE_OFF_TQ = PE_OFF_CT + 64 * 4;
static_assert(PE_OFF_TQ + 16 <= LDS_BCAST, "PEER LDS map overflows");
#define WAVE_LDS_FENCE() asm volatile("s_waitcnt lgkmcnt(0)" ::: "memory")

__device__ __forceinline__ void peer_select_head(const Params& p, int layer, char* smem, int tok0, int hd, int sw, int buf,
                                                 int lane) {
  const bf16_t* Q = (const bf16_t*)(p.ws + OFF_P);
  const bf16_t* SK = (const bf16_t*)(p.ws + OFF_SUBK) + (size_t)layer * 262144;
  const int lr = lane & 15, lq = lane >> 4;
  unsigned* SV = (unsigned*)(smem + PE_OFF_SV) + sw * 16 * PE_SVS;
  float* TV = (float*)(smem + PE_OFF_TV);
  int* TI = (int*)(smem + PE_OFF_TI);
  int* EX = (int*)(smem + PE_OFF_EX) + buf * 16 * 128;
  float* GT = (float*)(smem + PE_OFF_GT) + buf * 16 * 128;
  int* CN = (int*)(smem + PE_OFF_CN) + sw * 16;
  float* SU = (float*)(smem + PE_OFF_SU) + buf * 16 * 128;
  const float* USC = (const float*)(p.ws + OFF_USC) + layer * NEXP;
  const float* VSC = (const float*)(p.ws + OFF_VSC) + layer * NEXP;
  const __amdgpu_buffer_rsrc_t qrsrc = __builtin_amdgcn_make_buffer_rsrc((void*)Q, 0, NTOK * 2048 * 2, 0x00020000);
  const __amdgpu_buffer_rsrc_t srsrc = __builtin_amdgcn_make_buffer_rsrc((void*)SK, 0, 262144 * 2, 0x00020000);
#pragma unroll 1
  for (int pp = 0; pp < 2; ++pp) {
    bf16x8 af[4];
    const int qso = __builtin_amdgcn_readfirstlane((((tok0 >> 4) * 16 + hd * 2 + pp) * 4) * 1024);
#pragma unroll
    for (int ks = 0; ks < 4; ++ks) {
      union { u32x4_t u; bf16x8 v; } t_; t_.u = __builtin_amdgcn_raw_buffer_load_b128(qrsrc, lane * 16 + ks * 1024, qso, 0); af[ks] = t_.v;
    }
    const int sso = __builtin_amdgcn_readfirstlane((hd * 2 + pp) * 32768);
    f32x4 acc[8];
    {
      bf16x8 bfr[8][4];
#pragma unroll
      for (int nt = 0; nt < 8; ++nt)
#pragma unroll
        for (int ks = 0; ks < 4; ++ks) {
          union { u32x4_t u; bf16x8 v; } t_; t_.u = __builtin_amdgcn_raw_buffer_load_b128(srsrc, lane * 16 + ks * 1024, sso + nt * 4096, 0); bfr[nt][ks] = t_.v;
        }
#pragma unroll
      for (int nt = 0; nt < 8; ++nt) {
        f32x4 a = (f32x4){0.f, 0.f, 0.f, 0.f};
#pragma unroll
        for (int ks = 0; ks < 4; ++ks) a = __builtin_amdgcn_mfma_f32_16x16x32_bf16(af[ks], bfr[nt][ks], a, 0, 0, 0);
        acc[nt] = a;
      }
    }
#pragma unroll
    for (int i = 0; i < 9; ++i) { const int q4 = lane + 64 * i; if (q4 < 16 * PE_SVS / 4) ((uint4*)SV)[q4] = make_uint4(0u, 0u, 0u, 0u); }
    WAVE_LDS_FENCE();
#pragma unroll
    for (int r = 0; r < 4; ++r) {
      const int tk = 4 * lq + r;
      unsigned k[8];
#pragma unroll
      for (int nt = 0; nt < 8; ++nt) k[nt] = sortable_key(acc[nt][r], nt * 16 + lr);
      unsigned m1 = max(k[0], k[1]), m2 = min(k[0], k[1]);
#pragma unroll
      for (int nt = 2; nt < 8; ++nt) { m2 = max(m2, min(m1, k[nt])); m1 = max(m1, k[nt]); }
      const unsigned Ta = row16_min_u32(m1);
      const unsigned Tb = min(row16_kth_largest<11>(m1), row16_kth_largest<5>(m2));
      const unsigned T = max(Ta, Tb);
      int pos = 0;
#pragma unroll
      for (int nt = 0; nt < 8; ++nt) {
        const bool sel = k[nt] >= T;
        const unsigned long long bal = __ballot(sel);
        const unsigned grp16 = (unsigned)(bal >> (16 * lq)) & 0xffffu;
        const int below = __popc(grp16 & ((1u << lr) - 1u));
        if (sel) SV[tk * PE_SVS + pos + below] = k[nt];
        pos += __popc(grp16);
      }
      if (lr == 0) CN[tk] = pos;
    }
    WAVE_LDS_FENCE();
#pragma unroll 1
    for (int pass = 0; pass < 4; ++pass) {
      const int tk = pass * 4 + lq;
      const int cnt = CN[tk];
      const unsigned* row = SV + tk * PE_SVS;
      int cm = cnt;
      cm = max(cm, __shfl_xor(cm, 16)); cm = max(cm, __shfl_xor(cm, 32));
      const int cmax = __builtin_amdgcn_readfirstlane(cm);
      const int nblk = (cmax + 15) >> 4;
#pragma unroll 1
      for (int rd = 0; rd < nblk; ++rd) {
        const int j = rd * 16 + lr;
        const unsigned my = row[j];
        int rank = 0;
#pragma unroll 1
        for (int b4 = 0; b4 < nblk; ++b4) {
          const uint4 v0 = *(const uint4*)(row + b4 * 16), v1 = *(const uint4*)(row + b4 * 16 + 4);
          const uint4 v2 = *(const uint4*)(row + b4 * 16 + 8), v3 = *(const uint4*)(row + b4 * 16 + 12);
          rank += (v0.x > my) ? 1 : 0; rank += (v0.y > my) ? 1 : 0; rank += (v0.z > my) ? 1 : 0; rank += (v0.w > my) ? 1 : 0;
          rank += (v1.x > my) ? 1 : 0; rank += (v1.y > my) ? 1 : 0; rank += (v1.z > my) ? 1 : 0; rank += (v1.w > my) ? 1 : 0;
          rank += (v2.x > my) ? 1 : 0; rank += (v2.y > my) ? 1 : 0; rank += (v2.z > my) ? 1 : 0; rank += (v2.w > my) ? 1 : 0;
          rank += (v3.x > my) ? 1 : 0; rank += (v3.y > my) ? 1 : 0; rank += (v3.z > my) ? 1 : 0; rank += (v3.w > my) ? 1 : 0;
        }
        if (j < cnt && rank < 16) {
          TV[(tk * 16 + hd * 2 + pp) * 16 + rank] = key_value(my);
          TI[(tk * 16 + hd * 2 + pp) * 16 + rank] = 127 - (int)(my & 127u);
        }
      }
    }
    WAVE_LDS_FENCE();
  }
  {
    const int cab = ((const int*)(smem + PE_OFF_CT))[lane];
    const int cand_a = cab >> 4, cand_b = cab & 15;
    unsigned* CWt = SV;
    float vals[16];
#pragma unroll
    for (int tk = 0; tk < 16; ++tk) {
      float val = 0.f;
      unsigned key = 0u;
      if (cand_a >= 0) {
        val = TV[(tk * 16 + hd * 2 + 0) * 16 + cand_a] + TV[(tk * 16 + hd * 2 + 1) * 16 + cand_b];
        const unsigned bb = __float_as_uint(val);
        key = ((bb ^ ((unsigned)((int)bb >> 31) | 0x80000000u)) & ~63u) | (unsigned)(63 - lane);
      }
      vals[tk] = val;
      CWt[tk * 64 + lane] = key;
    }
    WAVE_LDS_FENCE();
#pragma unroll
    for (int tk = 0; tk < 16; ++tk) {
      const unsigned key = CWt[tk * 64 + lane];
      int rank = 0;
#pragma unroll
      for (int i4 = 0; i4 < 13; ++i4) {
        const uint4 v = *(const uint4*)(CWt + tk * 64 + i4 * 4);
        rank += (v.x > key) ? 1 : 0; rank += (v.y > key) ? 1 : 0; rank += (v.z > key) ? 1 : 0; rank += (v.w > key) ? 1 : 0;
      }
      if (cand_a >= 0 && rank < 16) {
        GT[tk * 128 + hd * 16 + rank] = vals[tk];
        EX[tk * 128 + hd * 16 + rank] = TI[(tk * 16 + hd * 2 + 0) * 16 + cand_a] * 128 + TI[(tk * 16 + hd * 2 + 1) * 16 + cand_b];
      }
    }
    WAVE_LDS_FENCE();
#pragma unroll
    for (int pass = 0; pass < 4; ++pass) {
      const int tk = pass * 4 + lq;
      const float g = GT[tk * 128 + hd * 16 + lr];
      const float mx = GT[tk * 128 + hd * 16];
      const float ev = __expf(g - mx);
      float s = ev;
      s += __shfl_xor(s, 1); s += __shfl_xor(s, 2); s += __shfl_xor(s, 4); s += __shfl_xor(s, 8);
      const int ex = EX[tk * 128 + hd * 16 + lr];
      GT[tk * 128 + hd * 16 + lr] = (ev / s) * VSC[ex];
      SU[tk * 128 + hd * 16 + lr] = USC[ex];
    }
    WAVE_LDS_FENCE();
  }
}

typedef float f32x32 __attribute__((ext_vector_type(32)));
typedef int i32x8 __attribute__((ext_vector_type(8)));
typedef int i32x6 __attribute__((ext_vector_type(6)));
typedef float f32x16 __attribute__((ext_vector_type(16)));
typedef unsigned u32x6 __attribute__((ext_vector_type(6)));
#define FP4_AXPY8(O, off, P, W) {                                                                    \
  const f32x2 _q0 = __builtin_amdgcn_cvt_scalef32_pk_f32_fp4((W), 1.0f, 0), _q1 = __builtin_amdgcn_cvt_scalef32_pk_f32_fp4((W), 1.0f, 1); \
  const f32x2 _q2 = __builtin_amdgcn_cvt_scalef32_pk_f32_fp4((W), 1.0f, 2), _q3 = __builtin_amdgcn_cvt_scalef32_pk_f32_fp4((W), 1.0f, 3); \
  O[(off) + 0] = fmaf(P, _q0.x, O[(off) + 0]); O[(off) + 1] = fmaf(P, _q0.y, O[(off) + 1]);          \
  O[(off) + 2] = fmaf(P, _q1.x, O[(off) + 2]); O[(off) + 3] = fmaf(P, _q1.y, O[(off) + 3]);          \
  O[(off) + 4] = fmaf(P, _q2.x, O[(off) + 4]); O[(off) + 5] = fmaf(P, _q2.y, O[(off) + 5]);          \
  O[(off) + 6] = fmaf(P, _q3.x, O[(off) + 6]); O[(off) + 7] = fmaf(P, _q3.y, O[(off) + 7]); }
struct Fp6Row { uint4 a; uint2 b; };
typedef __bf16 bf16x32_t __attribute__((ext_vector_type(32)));
__device__ __forceinline__ bf16x32_t fp6_decode_bf16(const Fp6Row& r) {
  u32x6 w; w[0] = r.a.x; w[1] = r.a.y; w[2] = r.a.z; w[3] = r.a.w; w[4] = r.b.x; w[5] = r.b.y;
  return __builtin_amdgcn_cvt_scalef32_pk32_bf16_fp6(w, 1.0f);
}
__device__ __forceinline__ f32x32 fp6_decode(const Fp6Row& r) {
  u32x6 w; w[0] = r.a.x; w[1] = r.a.y; w[2] = r.a.z; w[3] = r.a.w; w[4] = r.b.x; w[5] = r.b.y;
  return __builtin_amdgcn_cvt_scalef32_pk32_f32_fp6(w, 1.0f);
}
__device__ __forceinline__ void peer_gather_token(const Params& p, int layer, char* smem, int tok, int tl, int buf, int lane, bool dowrite) {
  const bf16_t* H2 = (const bf16_t*)(p.ws + OFF_ACT);
  const char* U6 = p.ws + OFF_U + (size_t)layer * NEXP * RECB;
  const float* mod = (const float*)(p.ws + OFF_MOD) + (size_t)layer * 9 * 6144;
  const int* EX = (const int*)(smem + PE_OFF_EX) + buf * 16 * 128 + tl * 128;
  const float* GT = (const float*)(smem + PE_OFF_GT) + buf * 16 * 128 + tl * 128;
  const float* SU = (const float*)(smem + PE_OFF_SU) + buf * 16 * 128 + tl * 128;
  const int l = lane & 31, hf = lane >> 5;
  float acc[32];
  const int wv = __builtin_amdgcn_readfirstlane(threadIdx.x >> 6);
  unsigned char* XB = (unsigned char*)(smem + PE_OFF_SV) + wv * 16 * PE_SVS * 4;
  float* WD = (float*)(XB + 1024);
  const __amdgpu_buffer_rsrc_t ursrc = __builtin_amdgcn_make_buffer_rsrc((void*)U6, 0, NEXP * RECB, 0x00020000);
#define PE_BLOAD(DST, OFF) { const u32x4_t t_ = __builtin_amdgcn_raw_buffer_load_b128(ursrc, (OFF), 0, 0); DST = make_uint4(t_.x, t_.y, t_.z, t_.w); }
#define PE_LOADV(VV, PI) PE_BLOAD(VV, EX[2 * (PI) + hf] * RECB + ROWB + l * 16)
  uint4 v0, v1, v2, v3, v4, v5, v6, v7, v8, v9, v10, v11, v12, v13, v14, v15, v16, v17, v18, v19, v20, v21, v22, v23;
  const int e16 = lane & 15, kg = lane >> 4;
  uint4 qa0, qa1, qa2, qa3, qa4, qa5, qa6, qa7, qb0, qb1, qb2, qb3, qb4, qb5, qb6, qb7, qc0, qc1, qc2, qc3, qc4, qc5, qc6, qc7;
  unsigned char* STG = XB + 1536;
  constexpr int STGP = 576;
#define PE_LOADA1(Q, EB, I) PE_BLOAD(Q##I, EX[(EB) * 16 + 2 * (I) + hf] * RECB + l * 16)
#define PE_LOADA(Q, EB) { PE_LOADA1(Q, EB, 0) PE_LOADA1(Q, EB, 1) PE_LOADA1(Q, EB, 2) PE_LOADA1(Q, EB, 3) PE_LOADA1(Q, EB, 4) PE_LOADA1(Q, EB, 5) PE_LOADA1(Q, EB, 6) PE_LOADA1(Q, EB, 7) }
  PE_LOADA(qa, 0) PE_LOADA(qb, 1)
  float xscale;
  {
    const bf16_t* hr = H2 + (size_t)tok * 1024 + (lane & 31) * 32;
    const uint4 q0 = *(const uint4*)hr, q1 = *(const uint4*)(hr + 8), q2 = *(const uint4*)(hr + 16), q3 = *(const uint4*)(hr + 24);
    const unsigned qw[16] = {q0.x, q0.y, q0.z, q0.w, q1.x, q1.y, q1.z, q1.w, q2.x, q2.y, q2.z, q2.w, q3.x, q3.y, q3.z, q3.w};
    f32x16 xe, xo_;
    float mx = 0.f;
#pragma unroll
    for (int i = 0; i < 16; ++i) { xe[i] = lo16(qw[i]); xo_[i] = hi16(qw[i]); mx = fmaxf(mx, fmaxf(fabsf(xe[i]), fabsf(xo_[i]))); }
#pragma unroll
    for (int o = 1; o < 64; o <<= 1) mx = fmaxf(mx, __shfl_xor(mx, o));
    xscale = mx > 0.f ? mx * (1.f / 7.5f) : 1.f;
    const float inv = 1.f / xscale;
#pragma unroll
    for (int i = 0; i < 16; ++i) { xe[i] *= inv; xo_[i] *= inv; }
    const u32x6 pk = __builtin_amdgcn_cvt_scalef32_2xpk16_fp6_f32(xe, xo_, 1.0f);
    if (lane < 32) {
      uint2* xo = (uint2*)(XB + lane * 24);
      xo[0] = make_uint2(pk[0], pk[1]); xo[1] = make_uint2(pk[2], pk[3]); xo[2] = make_uint2(pk[4], pk[5]);
    }
  }
  WAVE_LDS_FENCE();
  {
    i32x8 Bx[8];
#pragma unroll
    for (int kb = 0; kb < 8; ++kb) {
      const uint2* bp = (const uint2*)(XB + 192 * kg + 24 * kb);
      const uint2 b0 = bp[0], b1 = bp[1], b2 = bp[2];
      Bx[kb] = (i32x8){(int)b0.x, (int)b0.y, (int)b1.x, (int)b1.y, (int)b2.x, (int)b2.y, 0, 0};
    }
#define PE_MMAU(Q, EB) {                                                                                     \
    uint4 a0_ = {0u, 0u, 0u, 0u}, a1_ = a0_, a2_ = a0_, a3_ = a0_, a4_ = a0_, a5_ = a0_, a6_ = a0_, a7_ = a0_;   \
    const unsigned char* rdp_ = STG + (e16 & 7) * STGP + 16 * kg;                                            \
    { unsigned char* wp_ = STG + hf * STGP + l * 16;                                                         \
      *(uint4*)(wp_) = Q##0; *(uint4*)(wp_ + 2 * STGP) = Q##1; *(uint4*)(wp_ + 4 * STGP) = Q##2; *(uint4*)(wp_ + 6 * STGP) = Q##3; } \
    if (e16 < 8) { a0_ = *(const uint4*)(rdp_); a1_ = *(const uint4*)(rdp_ + 64); a2_ = *(const uint4*)(rdp_ + 128); a3_ = *(const uint4*)(rdp_ + 192); \
                   a4_ = *(const uint4*)(rdp_ + 256); a5_ = *(const uint4*)(rdp_ + 320); a6_ = *(const uint4*)(rdp_ + 384); a7_ = *(const uint4*)(rdp_ + 448); } \
    { unsigned char* wp_ = STG + hf * STGP + l * 16;                                                         \
      *(uint4*)(wp_) = Q##4; *(uint4*)(wp_ + 2 * STGP) = Q##5; *(uint4*)(wp_ + 4 * STGP) = Q##6; *(uint4*)(wp_ + 6 * STGP) = Q##7; } \
    if (e16 >= 8) { a0_ = *(const uint4*)(rdp_); a1_ = *(const uint4*)(rdp_ + 64); a2_ = *(const uint4*)(rdp_ + 128); a3_ = *(const uint4*)(rdp_ + 192); \
                    a4_ = *(const uint4*)(rdp_ + 256); a5_ = *(const uint4*)(rdp_ + 320); a6_ = *(const uint4*)(rdp_ + 384); a7_ = *(const uint4*)(rdp_ + 448); } \
    f32x4 dacc = {0.f, 0.f, 0.f, 0.f};                                                                       \
    _Pragma("unroll") for (int kb = 0; kb < 8; ++kb) {                                                       \
      const uint4 ak_ = kb == 0 ? a0_ : kb == 1 ? a1_ : kb == 2 ? a2_ : kb == 3 ? a3_ : kb == 4 ? a4_ : kb == 5 ? a5_ : kb == 6 ? a6_ : a7_; \
      const i32x8 av = {(int)ak_.x, (int)ak_.y, (int)ak_.z, (int)ak_.w, 0, 0, 0, 0};                         \
      dacc = __builtin_amdgcn_mfma_scale_f32_16x16x128_f8f6f4(av, Bx[kb], dacc, 4, 2, 0, 0x7f7f7f7f, 0, 0x7f7f7f7f); \
    }                                                                                                        \
    asm volatile("" : "+v"(dacc));        \
    if (e16 == 0) *(float4*)(WD + (EB) * 16 + 4 * kg) = (float4){dacc[0], dacc[1], dacc[2], dacc[3]};        \
  }
    PE_LOADA(qc, 2) PE_MMAU(qa, 0)
    PE_LOADA(qa, 3) PE_MMAU(qb, 1)
    PE_LOADA(qb, 4) PE_MMAU(qc, 2)
    PE_LOADA(qc, 5) PE_MMAU(qa, 3)
    PE_LOADA(qa, 6) PE_MMAU(qb, 4)
    PE_LOADA(qb, 7) PE_MMAU(qc, 5)
    PE_LOADV(v0, 0) PE_LOADV(v1, 1) PE_LOADV(v2, 2) PE_LOADV(v3, 3) PE_LOADV(v4, 4) PE_LOADV(v5, 5) PE_MMAU(qa, 6)
    PE_LOADV(v6, 6) PE_LOADV(v7, 7) PE_LOADV(v8, 8) PE_LOADV(v9, 9) PE_LOADV(v10, 10) PE_LOADV(v11, 11) PE_MMAU(qb, 7)
    PE_LOADV(v12, 12) PE_LOADV(v13, 13) PE_LOADV(v14, 14) PE_LOADV(v15, 15)
  }
  PE_LOADV(v16, 16) PE_LOADV(v17, 17) PE_LOADV(v18, 18) PE_LOADV(v19, 19) PE_LOADV(v20, 20) PE_LOADV(v21, 21) PE_LOADV(v22, 22) PE_LOADV(v23, 23)
  WAVE_LDS_FENCE();
#pragma unroll
  for (int q = 0; q < 2; ++q) {
    const int e = lane + 64 * q;
    WD[e] = GT[e] * gelu_erf(WD[e] * SU[e] * xscale);
  }
  WAVE_LDS_FENCE();
#pragma unroll
  for (int i = 0; i < 32; ++i) acc[i] = 0.f;
  int one = 1;
  asm volatile("" : "+s"(one));
  const int b = tok < NLAT ? (tok >> 12) : 8;
  float* xr = tok < NLAT ? p.out + (size_t)tok * 1024 : (float*)(p.ws + OFF_CTXB) + (size_t)(tok - NLAT) * 1024;
  const float* gate = mod + (size_t)b * 6144 + 5 * 1024;
  float4 xv4[4], gv4[4];
#define PE_USEV(VV, PI)                                                               \
  _Pragma("unroll 1") for (int rep_ = 0; rep_ < one; ++rep_) {                        \
    const float w = WD[2 * (PI) + hf];                                                \
    FP4_AXPY8(acc, 0, w, VV.x) FP4_AXPY8(acc, 8, w, VV.y) FP4_AXPY8(acc, 16, w, VV.z) FP4_AXPY8(acc, 24, w, VV.w) \
  }
  PE_USEV(v0, 0) PE_LOADV(v0, 24) PE_USEV(v1, 1) PE_LOADV(v1, 25) PE_USEV(v2, 2) PE_LOADV(v2, 26) PE_USEV(v3, 3) PE_LOADV(v3, 27)
  PE_USEV(v4, 4) PE_LOADV(v4, 28) PE_USEV(v5, 5) PE_LOADV(v5, 29) PE_USEV(v6, 6) PE_LOADV(v6, 30) PE_USEV(v7, 7) PE_LOADV(v7, 31)
  PE_USEV(v8, 8) PE_LOADV(v8, 32) PE_USEV(v9, 9) PE_LOADV(v9, 33) PE_USEV(v10, 10) PE_LOADV(v10, 34) PE_USEV(v11, 11) PE_LOADV(v11, 35)
  PE_USEV(v12, 12) PE_LOADV(v12, 36) PE_USEV(v13, 13) PE_LOADV(v13, 37) PE_USEV(v14, 14) PE_LOADV(v14, 38) PE_USEV(v15, 15) PE_LOADV(v15, 39)
  PE_USEV(v16, 16) PE_LOADV(v16, 40) PE_USEV(v17, 17) PE_LOADV(v17, 41) PE_USEV(v18, 18) PE_LOADV(v18, 42) PE_USEV(v19, 19) PE_LOADV(v19, 43)
  PE_USEV(v20, 20) PE_LOADV(v20, 44) PE_USEV(v21, 21) PE_LOADV(v21, 45) PE_USEV(v22, 22) PE_LOADV(v22, 46) PE_USEV(v23, 23) PE_LOADV(v23, 47)
  PE_USEV(v0, 24) PE_LOADV(v0, 48) PE_USEV(v1, 25) PE_LOADV(v1, 49) PE_USEV(v2, 26) PE_LOADV(v2, 50) PE_USEV(v3, 27) PE_LOADV(v3, 51)
  PE_USEV(v4, 28) PE_LOADV(v4, 52) PE_USEV(v5, 29) PE_LOADV(v5, 53) PE_USEV(v6, 30) PE_LOADV(v6, 54) PE_USEV(v7, 31) PE_LOADV(v7, 55)
  PE_USEV(v8, 32) PE_LOADV(v8, 56) PE_USEV(v9, 33) PE_LOADV(v9, 57) PE_USEV(v10, 34) PE_LOADV(v10, 58) PE_USEV(v11, 35) PE_LOADV(v11, 59)
  PE_USEV(v12, 36) PE_LOADV(v12, 60) PE_USEV(v13, 37) PE_LOADV(v13, 61) PE_USEV(v14, 38) PE_LOADV(v14, 62) PE_USEV(v15, 39) PE_LOADV(v15, 63)
  PE_USEV(v16, 40) PE_USEV(v17, 41) PE_USEV(v18, 42) PE_USEV(v19, 43) PE_USEV(v20, 44) PE_USEV(v21, 45) PE_USEV(v22, 46) PE_USEV(v23, 47)
#pragma unroll
  for (int jj = 0; jj < 4; ++jj) {
    const int c = (l + 32 * (4 * hf + jj)) * 4;
    xv4[jj] = *(const float4*)(xr + c);
    gv4[jj] = *(const float4*)(gate + c);
  }
  PE_USEV(v0, 48) PE_USEV(v1, 49) PE_USEV(v2, 50) PE_USEV(v3, 51) PE_USEV(v4, 52) PE_USEV(v5, 53) PE_USEV(v6, 54) PE_USEV(v7, 55)
  PE_USEV(v8, 56) PE_USEV(v9, 57) PE_USEV(v10, 58) PE_USEV(v11, 59) PE_USEV(v12, 60) PE_USEV(v13, 61) PE_USEV(v14, 62) PE_USEV(v15, 63)
#pragma unroll
  for (int k = 0; k < 32; ++k) acc[k] += __shfl_xor(acc[k], 32);
  float4 xn[4];
  float ss = 0.f;
#pragma unroll
  for (int jj = 0; jj < 4; ++jj) {
    const int c = (l + 32 * (4 * hf + jj)) * 4;
    const float4 xv = xv4[jj];
    const float4 gv = gv4[jj];
    const float a0 = hf ? acc[16 + 4 * jj + 0] : acc[4 * jj + 0], a1 = hf ? acc[16 + 4 * jj + 1] : acc[4 * jj + 1];
    const float a2 = hf ? acc[16 + 4 * jj + 2] : acc[4 * jj + 2], a3 = hf ? acc[16 + 4 * jj + 3] : acc[4 * jj + 3];
    xn[jj].x = xv.x + gv.x * a0; xn[jj].y = xv.y + gv.y * a1; xn[jj].z = xv.z + gv.z * a2; xn[jj].w = xv.w + gv.w * a3;
    ss += xn[jj].x * xn[jj].x + xn[jj].y * xn[jj].y + xn[jj].z * xn[jj].z + xn[jj].w * xn[jj].w;
  }
  ss = wave_sum(ss);
  const float rinv = rsqrtf(ss * (1.f / 1024.f) + EPS);
  if (layer == 0) {
    const float* mod1 = (const float*)(p.ws + OFF_MOD) + (size_t)9 * 6144 + (size_t)b * 6144;
    const float* g1 = p.norm1_g + 1024;
    bf16_t* act = (bf16_t*)(p.ws + OFF_ACT) + (size_t)tok * 1024;
#pragma unroll
    for (int jj = 0; jj < 4; ++jj) {
      const int c = (l + 32 * (4 * hf + jj)) * 4;
      if (dowrite) *(float4*)(xr + c) = xn[jj]; else asm volatile("" :: "v"(xn[jj].x), "v"(xn[jj].y), "v"(xn[jj].z), "v"(xn[jj].w));
      const float4 gg4 = *(const float4*)(g1 + c);
      const float4 sh = *(const float4*)(mod1 + c);
      const float4 sc = *(const float4*)(mod1 + 1024 + c);
      uint2 o;
      o.x = pack2h(xn[jj].x * rinv * gg4.x * (1.f + sc.x) + sh.x, xn[jj].y * rinv * gg4.y * (1.f + sc.y) + sh.y);
      o.y = pack2h(xn[jj].z * rinv * gg4.z * (1.f + sc.z) + sh.z, xn[jj].w * rinv * gg4.w * (1.f + sc.w) + sh.w);
      if (dowrite) *(uint2*)(act + c) = o; else asm volatile("" :: "v"(o.x), "v"(o.y));
    }
  } else {
#pragma unroll
    for (int jj = 0; jj < 4; ++jj) {
      const int c = (l + 32 * (4 * hf + jj)) * 4;
      const float4 gg4 = *(const float4*)(p.final_g + c);
      float4 o;
      o.x = xn[jj].x * rinv * gg4.x; o.y = xn[jj].y * rinv * gg4.y; o.z = xn[jj].z * rinv * gg4.z; o.w = xn[jj].w * rinv * gg4.w;
      if (dowrite) *(float4*)(xr + c) = o; else asm volatile("" :: "v"(o.x), "v"(o.y), "v"(o.z), "v"(o.w));
    }
  }
}

__device__ __forceinline__ void phase_peer(const Params& p, int layer, char* smem, int ntok, bool dowrite = true) {
  const int tid = opaque_tid(), lane = tid & 63, wave = __builtin_amdgcn_readfirstlane(tid >> 6);
  __syncthreads();
  if (tid < 64) {
    int cab = -1, c = 0;
    for (int a = 0; a < 16; ++a)
      for (int bb = 0; bb < 16; ++bb)
        if ((a + 1) * (bb + 1) <= 16) { if (c == tid) cab = a * 16 + bb; ++c; }
    ((int*)(smem + PE_OFF_CT))[tid] = cab;
  }
  const int ngroups = ntok / 16, G = gridDim.x, g0 = opaque_bid();
  if (tid == 0) { ((int*)(smem + PE_OFF_TQ))[0] = 0; ((int*)(smem + PE_OFF_TQ))[1] = 0; }
  __syncthreads();
  const int R = ngroups / G, rem = ngroups % G;
  const bool split = rem > 0 && 2 * rem <= G;
#define PE_ITEM(r_, grp_, off_, cnt_)                                                                  \
  { grp_ = 0; off_ = 0; cnt_ = 0;                                                                      \
    if ((r_) >= 0 && (r_) < R) { grp_ = g0 + (r_) * G; cnt_ = 16; }                                    \
    else if ((r_) == R) {                                                                              \
      if (split) { if (g0 < 2 * rem) { grp_ = R * G + (g0 >> 1); off_ = (g0 & 1) * 8; cnt_ = 8; } }    \
      else if (g0 < rem) { grp_ = R * G + g0; cnt_ = 16; }                                             \
    } }
#pragma unroll 1
  for (int r = -1;; ++r) {
    int cur, coff, ngat, nxt, noff, ncnt;
    PE_ITEM(r, cur, coff, ngat)
    PE_ITEM(r + 1, nxt, noff, ncnt)
    const int nsel = ncnt > 0 ? 8 : 0;
    if (ngat + nsel == 0) break;
    const int b = r & 1, gper = ngat >> 3, sfirst = (wave & 1) == 0;
#pragma unroll 1
    for (int st = 0; st < 3; ++st) {
      const int slot = sfirst ? st : (st + 1) % 3;
      if (slot == 0) { if (nsel) peer_select_head(p, layer, smem, nxt * 16, wave, wave, b ^ 1, lane); }
      else if (slot - 1 < gper) {
        const int idx = wave * gper + slot - 1;
        peer_gather_token(p, layer, smem, cur * 16 + coff + idx, coff + idx, b, lane, dowrite);
      }
    }
    __syncthreads();
  }
}

template <int layer>
__device__ __forceinline__ void layer_body(const Params& p, char* smem, const XcdBarrier& xb) {
  constexpr bool nc = layer == 0;
  const float* xin = layer == 0 ? p.x : (const float*)p.out;
  if (layer == 0) {
    phase_norm(p, layer, 0, xin, NTOK);
    xcd_barrier(xb);
  }
#if REP_GEMM
  gemm_phase2<EPI_INPROJ>(p, layer, smem, (const bf16_t*)(p.ws + OFF_ACT), (const bf16_t*)(p.ws + OFF_WIN) + (size_t)layer * 3072 * 1024, NTOK, 3072, nullptr);
  xcd_barrier(xb);
#endif
  gemm_phase2<EPI_INPROJ>(p, layer, smem, (const bf16_t*)(p.ws + OFF_ACT), (const bf16_t*)(p.ws + OFF_WIN) + (size_t)layer * 3072 * 1024, NTOK, 3072, nullptr);
  xcd_barrier(xb);
#if REP_MIX1
  phase_mix1(p, layer, smem, 2);
  xcd_barrier(xb);
#endif
  phase_mix1(p, layer, smem);
  xcd_barrier(xb);
  phase_ret_scan(p, layer);
  xcd_barrier(xb);
#if REP_MIX2
  phase_mix2(p, layer, smem, 3);
  xcd_barrier(xb);
#endif
  phase_mix2(p, layer, smem);
  xcd_barrier(xb);
  gemm_phase2<EPI_OUTPROJ>(p, layer, smem, (const bf16_t*)(p.ws + OFF_ACT), (const bf16_t*)(p.ws + OFF_WOUT) + (size_t)layer * 1024 * 1024, nc ? NTOK : NLAT, 1024, xin);
  xcd_barrier(xb);
  phase_norm(p, layer, 1, (const float*)p.out, nc ? NTOK : NLAT);
  xcd_barrier(xb);
  gemm_phase2<EPI_PLAIN>(p, layer, smem, (const bf16_t*)(p.ws + OFF_ACT), (const bf16_t*)(p.ws + OFF_WQ) + (size_t)layer * 2048 * 1024, nc ? NTOK : NLAT, 2048, nullptr);
  xcd_barrier(xb);
#if REP_PEER
  phase_peer(p, layer, smem, nc ? NTOK : NLAT, false);
  xcd_barrier(xb);
#endif
  phase_peer(p, layer, smem, nc ? NTOK : NLAT);
  if (layer == 0) xcd_barrier(xb);
}

__global__ void __launch_bounds__(512) fwd_megakernel(Params p) {
  cg::grid_group grid = cg::this_grid();
  extern __shared__ __attribute__((aligned(16))) char smem[];
  volatile LAS3 unsigned* xst = (volatile LAS3 unsigned*)(smem + LDS_BCAST + 8);
  if (threadIdx.x == 0) { xst[0] = 0u; xst[1] = 0u; }
  phase_prep(p, smem);
  __syncthreads();
  for (int it = blockIdx.x; it < 256; it += gridDim.x) uv_convert_item(p, it, smem);
  grid.sync();
  const XcdBarrier xb = xcd_barrier_post((unsigned*)(p.ws + OFF_XBAR), xst);
  layer_body<0>(p, smem, xb);
  layer_body<1>(p, smem, xb);
}

extern "C" void kernel_launch(void* const* d_in, const int* in_sizes, int n_in, void* d_out,
                              int out_size, void* d_ws, size_t ws_size, hipStream_t stream) {
  constexpr size_t kDynLds = LDS_BYTES;
  static int grid_blocks = 0;
  if (!grid_blocks) {
    int dev = 0, cus = 0, per_cu = 0;
    (void)hipGetDevice(&dev);
    (void)hipDeviceGetAttribute(&cus, hipDeviceAttributeMultiprocessorCount, dev);
    (void)hipFuncSetAttribute((const void*)fwd_megakernel, hipFuncAttributeMaxDynamicSharedMemorySize, (int)kDynLds);
    (void)hipOccupancyMaxActiveBlocksPerMultiprocessor(&per_cu, fwd_megakernel, 512, kDynLds);
    if (per_cu < 1) { fprintf(stderr, "occupancy query says %d blocks/CU\n", per_cu); per_cu = 1; }
    grid_blocks = cus;
    if (ws_size < WS_END) fprintf(stderr, "workspace too small: %zu < %zu\n", ws_size, (size_t)WS_END);
  }
  Params p{};
  p.x = (const float*)d_in[0]; p.c = (const float*)d_in[1]; p.ctx = (const float*)d_in[2]; p.c_ctx = (const float*)d_in[3];
  p.w_ada = (const float*)d_in[4]; p.b_ada = (const float*)d_in[5]; p.norm1_g = (const float*)d_in[6]; p.w_in = (const float*)d_in[7];
  p.na_rpb = (const float*)d_in[8]; p.diff_lambda = (const float*)d_in[9]; p.diff_subln_g = (const float*)d_in[10];
  p.ret_decay_logit = (const float*)d_in[11]; p.w_out = (const float*)d_in[12]; p.norm2_g = (const float*)d_in[13];
  p.peer_wq = (const float*)d_in[14]; p.peer_subkeys = (const float*)d_in[15]; p.peer_u = (const float*)d_in[16];
  p.peer_v = (const float*)d_in[17]; p.final_g = (const float*)d_in[18];
  p.out = (float*)d_out; p.ws = (char*)d_ws;
  void* args[] = {&p};
  hipError_t e = hipLaunchCooperativeKernel((void*)fwd_megakernel, dim3(grid_blocks), dim3(512), args, kDynLds, stream);
  if (e != hipSuccess) fprintf(stderr, "cooperative launch failed: %s (grid %d)\n", hipGetErrorString(e), grid_blocks);
}
```
